# Optimizing an MI355X kernel written in HIP

```python
import math
import jax, jax.numpy as jnp
from jax import lax
import numpy as np

D_MODEL = 1024
BATCH = 32
SEQ = 2048
DEPTH = 4

CTX_LEN = 256
GRID_W = 64
N_MIXERS = 2
N_HEADS = 16
N_KV_HEADS = 4
HEAD_DIM = D_MODEL // N_HEADS
GROUP = N_HEADS // N_KV_HEADS
Q_WIDTH = N_HEADS * HEAD_DIM
KV_WIDTH = N_KV_HEADS * HEAD_DIM
WINDOW = 128
Q_BLOCK = 128
ROPE_BASE = 10000.0
AXIS_ROT = HEAD_DIM // 2
F_GROUPS = 4
N_EXPERTS = 64
TOP_K = 8
N_EXPERT_GROUPS = 8
TOPK_GROUPS = 4
EXPERT_FF = D_MODEL // 4
SHARED_FF = D_MODEL // 4
ROUTED_SCALE = 2.5
MOE_BLOCK = 128
N_ATTN_LAYERS = (DEPTH + N_MIXERS - 1) // N_MIXERS
N_FNET_LAYERS = DEPTH // N_MIXERS
DEEPNORM_ALPHA = (2.0 * DEPTH) ** 0.25
DEEPNORM_BETA = (8.0 * DEPTH) ** -0.25
LN_EPS = 1e-5
MOD_EPS = 1e-6

kernel_name = "hybrid_swa_fnet_moe_diffusion_trunk"


def _normalize(x, eps):
    xf = x.astype(jnp.float32)
    mu = jnp.mean(xf, axis=-1, keepdims=True)
    var = jnp.mean(jnp.square(xf - mu), axis=-1, keepdims=True)
    return (xf - mu) * lax.rsqrt(var + eps)


def modulate(x, shift, scale):
    return (_normalize(x, MOD_EPS) * (1.0 + scale.astype(jnp.float32)) + shift.astype(jnp.float32)).astype(x.dtype)


def post_norm(x, y, g, b):
    z = DEEPNORM_ALPHA * x.astype(jnp.float32) + y.astype(jnp.float32)
    return (_normalize(z, LN_EPS) * g.astype(jnp.float32) + b.astype(jnp.float32)).astype(x.dtype)


def axial_rope_tables(L):
    rows = L // GRID_W
    r = jnp.repeat(jnp.arange(rows, dtype=jnp.float32), GRID_W)
    col = jnp.tile(jnp.arange(GRID_W, dtype=jnp.float32), rows)
    inv = ROPE_BASE ** (-jnp.arange(0, AXIS_ROT, 2, dtype=jnp.float32) / AXIS_ROT)
    ar = r[:, None] * inv
    ac = col[:, None] * inv
    ang = jnp.concatenate([ar, ar, ac, ac], axis=-1)
    return jnp.cos(ang), jnp.sin(ang)


def _rot_half(t):
    a, b = jnp.split(t, 2, axis=-1)
    return jnp.concatenate([-b, a], axis=-1)


def apply_rope(x, cos, sin):
    xr, xc = jnp.split(x, 2, axis=-1)
    rot = jnp.concatenate([_rot_half(xr), _rot_half(xc)], axis=-1)
    c = cos[None, :, None, :]
    s = sin[None, :, None, :]
    return (x.astype(jnp.float32) * c + rot.astype(jnp.float32) * s).astype(x.dtype)


def sink_attend(qb, keys, values, masks, sinks):
    B, Q = qb.shape[0], qb.shape[1]
    scale = HEAD_DIM ** -0.5
    parts = []
    for kk, m in zip(keys, masks):
        s = jnp.einsum('bqhgd,bkhd->bhgqk', qb, kk).astype(jnp.float32) * scale
        if m is not None:
            s = jnp.where(m, s, -jnp.inf)
        parts.append(s)
    sink = jnp.broadcast_to(sinks.astype(jnp.float32).reshape(1, N_KV_HEADS, GROUP, 1, 1),
                            (B, N_KV_HEADS, GROUP, Q, 1))
    p = jax.nn.softmax(jnp.concatenate(parts + [sink], axis=-1), axis=-1).astype(qb.dtype)
    out = None
    start = 0
    for vv in values:
        n = vv.shape[1]
        o = jnp.einsum('bhgqk,bkhd->bqhgd', p[..., start:start + n], vv)
        out = o if out is None else out + o
        start += n
    return out


def windowed_attention(q, k, v, k_ctx, v_ctx, sinks):
    B, L = q.shape[0], q.shape[1]
    nb = L // Q_BLOCK
    span = Q_BLOCK + 2 * WINDOW
    pad = ((0, 0), (WINDOW, WINDOW), (0, 0), (0, 0))
    k_pad = jnp.pad(k, pad)
    v_pad = jnp.pad(v, pad)
    offs = jnp.arange(span) - WINDOW
    qi = jnp.arange(Q_BLOCK)

    def one_block(b):
        q0 = b * Q_BLOCK
        qb = lax.dynamic_slice_in_dim(q, q0, Q_BLOCK, axis=1)
        kb = lax.dynamic_slice_in_dim(k_pad, q0, span, axis=1)
        vb = lax.dynamic_slice_in_dim(v_pad, q0, span, axis=1)
        kpos = q0 + offs
        mask = (jnp.abs(qi[:, None] - offs[None, :]) <= WINDOW) & ((kpos >= 0) & (kpos < L))[None, :]
        return sink_attend(qb, (kb, k_ctx), (vb, v_ctx), (mask, None), sinks)

    o = lax.map(one_block, jnp.arange(nb))
    return jnp.moveaxis(o, 0, 1).reshape(B, L, N_KV_HEADS, GROUP, HEAD_DIM)


def attention_mixer(u, u_ctx, w_qkv, w_o, sinks, cos, sin, ctx_out):
    B, L, _ = u.shape
    C = u_ctx.shape[1]
    qkv = u @ w_qkv
    q = apply_rope(qkv[..., :Q_WIDTH].reshape(B, L, N_HEADS, HEAD_DIM), cos, sin)
    k = apply_rope(qkv[..., Q_WIDTH:Q_WIDTH + KV_WIDTH].reshape(B, L, N_KV_HEADS, HEAD_DIM), cos, sin)
    v = qkv[..., Q_WIDTH + KV_WIDTH:].reshape(B, L, N_KV_HEADS, HEAD_DIM)
    q = q.reshape(B, L, N_KV_HEADS, GROUP, HEAD_DIM)
    if ctx_out:
        qkv_c = u_ctx @ w_qkv
        q_c = qkv_c[..., :Q_WIDTH].reshape(B, C, N_KV_HEADS, GROUP, HEAD_DIM)
        kv_c = qkv_c[..., Q_WIDTH:]
    else:
        kv_c = u_ctx @ w_qkv[:, Q_WIDTH:]
    k_c = kv_c[..., :KV_WIDTH].reshape(B, C, N_KV_HEADS, HEAD_DIM)
    v_c = kv_c[..., KV_WIDTH:].reshape(B, C, N_KV_HEADS, HEAD_DIM)
    o = windowed_attention(q, k, v, k_c, v_c, sinks)
    y = o.reshape(B, L, Q_WIDTH) @ w_o
    if not ctx_out:
        return y, None
    o_c = sink_attend(q_c, (k_c,), (v_c,), (None,), sinks)
    return y, o_c.reshape(B, C, Q_WIDTH) @ w_o


def fourier_mixer(u, w_f):
    B, L, D = u.shape
    ug = u.reshape(B, L, F_GROUPS, D // F_GROUPS).astype(jnp.float32)
    f = jnp.fft.fft2(ug, axes=(1, 3), norm='ortho').real
    return f.reshape(B, L, D).astype(u.dtype) @ w_f


def moe_ffn(tok, router_w, router_bias, w_gate, w_up, w_down, s_gate, s_up, s_down):
    T, D = tok.shape
    per_group = N_EXPERTS // N_EXPERT_GROUPS
    scores = jax.nn.sigmoid((tok @ router_w).astype(jnp.float32))
    sel = scores + router_bias.astype(jnp.float32)
    group_score = lax.top_k(sel.reshape(T, N_EXPERT_GROUPS, per_group), 2)[0].sum(-1)
    _, top_groups = lax.top_k(group_score, TOPK_GROUPS)
    group_ok = (top_groups[:, :, None] == jnp.arange(N_EXPERT_GROUPS)[None, None, :]).any(axis=1)
    sel = jnp.where(jnp.repeat(group_ok, per_group, axis=1), sel, -jnp.inf)
    _, top_e = lax.top_k(sel, TOP_K)
    wts = jnp.take_along_axis(scores, top_e, axis=-1)
    wts = wts / jnp.sum(wts, axis=-1, keepdims=True) * ROUTED_SCALE

    TK = T * TOP_K
    flat_e = top_e.reshape(-1)
    flat_tok = jnp.arange(TK, dtype=jnp.int32) // TOP_K
    flat_w = wts.reshape(-1)
    order = jnp.argsort(flat_e)
    e_s, tok_s, w_s = flat_e[order], flat_tok[order], flat_w[order]
    counts = jnp.bincount(flat_e, length=N_EXPERTS)
    starts = jnp.cumsum(counts) - counts
    padded = (counts + MOE_BLOCK - 1) // MOE_BLOCK * MOE_BLOCK
    pend = jnp.cumsum(padded)
    pstarts = pend - padded
    dest = pstarts[e_s] + jnp.arange(TK) - starts[e_s]
    n_blocks = -(-TK // MOE_BLOCK) + N_EXPERTS
    cap = n_blocks * MOE_BLOCK
    tok_buf = jnp.full((cap,), T, jnp.int32).at[dest].set(tok_s.astype(jnp.int32))
    w_buf = jnp.zeros((cap,), tok.dtype).at[dest].set(w_s.astype(tok.dtype))
    block_e = jnp.clip(jnp.searchsorted(pend, jnp.arange(n_blocks) * MOE_BLOCK, side='right'), 0, N_EXPERTS - 1)
    x_pad = jnp.concatenate([tok, jnp.zeros((1, D), tok.dtype)], axis=0)

    def body(y, b):
        rows = lax.dynamic_slice_in_dim(tok_buf, b * MOE_BLOCK, MOE_BLOCK)
        wb = lax.dynamic_slice_in_dim(w_buf, b * MOE_BLOCK, MOE_BLOCK)
        e = block_e[b]
        xb = x_pad[rows]
        hb = jax.nn.silu(xb @ w_gate[e]) * (xb @ w_up[e])
        return y.at[rows].add((hb @ w_down[e]) * wb[:, None]), None

    y, _ = lax.scan(body, jnp.zeros_like(x_pad), jnp.arange(n_blocks))
    shared = (jax.nn.silu(tok @ s_gate) * (tok @ s_up)) @ s_down
    return y[:T] + shared


def setup_inputs(seed: int = 0) -> dict:
    key = jax.random.key(seed)
    ks = jax.random.split(key, 20)
    f32 = jnp.float32
    D = D_MODEL

    def nrm(k, shape, s):
        return jax.random.normal(k, shape, f32) * s

    qkv_col_scale = jnp.concatenate([jnp.ones((Q_WIDTH + KV_WIDTH,), f32),
                                     jnp.full((KV_WIDTH,), DEEPNORM_BETA, f32)])
    return {
        "x": nrm(ks[0], (BATCH, SEQ, D), 1.0),
        "c": nrm(ks[1], (BATCH, D), 1.0),
        "ctx": nrm(ks[2], (BATCH, CTX_LEN, D), 1.0),
        "c_ctx": nrm(ks[3], (D,), 1.0),
        "w_ada": nrm(ks[4], (DEPTH, D, 6 * D), D ** -0.5),
        "b_ada": nrm(ks[5], (DEPTH, 6 * D), 0.02),
        "ln_g": 1.0 + nrm(ks[6], (DEPTH, 2, D), 0.02),
        "ln_b": nrm(ks[7], (DEPTH, 2, D), 0.02),
        "attn_w_qkv": nrm(ks[8], (N_ATTN_LAYERS, D, Q_WIDTH + 2 * KV_WIDTH), D ** -0.5) * qkv_col_scale,
        "attn_w_o": nrm(ks[9], (N_ATTN_LAYERS, Q_WIDTH, D), Q_WIDTH ** -0.5 * DEEPNORM_BETA),
        "attn_sinks": nrm(ks[10], (N_ATTN_LAYERS, N_HEADS), 0.5),
        "fnet_w": nrm(ks[11], (N_FNET_LAYERS, D, D), D ** -0.5 * DEEPNORM_BETA),
        "router_w": nrm(ks[12], (DEPTH, D, N_EXPERTS), D ** -0.5),
        "router_bias": nrm(ks[13], (DEPTH, N_EXPERTS), 0.01),
        "exp_w_gate": nrm(ks[14], (DEPTH, N_EXPERTS, D, EXPERT_FF), D ** -0.5),
        "exp_w_up": nrm(ks[15], (DEPTH, N_EXPERTS, D, EXPERT_FF), D ** -0.5),
        "exp_w_down": nrm(ks[16], (DEPTH, N_EXPERTS, EXPERT_FF, D), EXPERT_FF ** -0.5 * DEEPNORM_BETA),
        "sh_w_gate": nrm(ks[17], (DEPTH, D, SHARED_FF), D ** -0.5),
        "sh_w_up": nrm(ks[18], (DEPTH, D, SHARED_FF), D ** -0.5),
        "sh_w_down": nrm(ks[19], (DEPTH, SHARED_FF, D), SHARED_FF ** -0.5 * DEEPNORM_BETA),
    }


def reference(x, c, ctx, c_ctx, w_ada, b_ada, ln_g, ln_b, attn_w_qkv, attn_w_o, attn_sinks, fnet_w,
              router_w, router_bias, exp_w_gate, exp_w_up, exp_w_down, sh_w_gate, sh_w_up, sh_w_down):
    B, L, D = x.shape
    C = ctx.shape[1]
    cos, sin = axial_rope_tables(L)
    h = ctx
    silu_c = jax.nn.silu(c)
    silu_cc = jax.nn.silu(c_ctx)
    for i in range(DEPTH):
        kind = i % N_MIXERS
        j = i // N_MIXERS
        update_ctx = any((l % N_MIXERS) == 0 for l in range(i + 1, DEPTH))
        mod = silu_c @ w_ada[i] + b_ada[i]
        sh1, sc1, g1, sh2, sc2, g2 = [m[:, None, :] for m in jnp.split(mod, 6, axis=-1)]
        csh1, csc1, cg1, csh2, csc2, cg2 = jnp.split(silu_cc @ w_ada[i] + b_ada[i], 6, axis=-1)

        u = modulate(x, sh1, sc1)
        if kind == 0:
            uc = modulate(h, csh1, csc1)
            y, yc = attention_mixer(u, uc, attn_w_qkv[j], attn_w_o[j], attn_sinks[j], cos, sin, update_ctx)
        else:
            y = fourier_mixer(u, fnet_w[j])
            yc = fourier_mixer(modulate(h, csh1, csc1), fnet_w[j]) if update_ctx else None
        x = post_norm(x, g1 * y, ln_g[i, 0], ln_b[i, 0])
        if update_ctx:
            h = post_norm(h, cg1 * yc, ln_g[i, 0], ln_b[i, 0])

        u2 = modulate(x, sh2, sc2)
        if update_ctx:
            u2c = modulate(h, csh2, csc2)
            toks = jnp.concatenate([u2.reshape(-1, D), u2c.reshape(-1, D)], axis=0)
            f = moe_ffn(toks, router_w[i], router_bias[i], exp_w_gate[i], exp_w_up[i], exp_w_down[i],
                        sh_w_gate[i], sh_w_up[i], sh_w_down[i])
            y2 = f[:B * L].reshape(B, L, D)
            h = post_norm(h, cg2 * f[B * L:].reshape(B, C, D), ln_g[i, 1], ln_b[i, 1])
        else:
            y2 = moe_ffn(u2.reshape(-1, D), router_w[i], router_bias[i], exp_w_gate[i], exp_w_up[i],
                         exp_w_down[i], sh_w_gate[i], sh_w_up[i], sh_w_down[i]).reshape(B, L, D)
        x = post_norm(x, g2 * y2, ln_g[i, 1], ln_b[i, 1])
    return x
```

```cpp
#include <hip/hip_runtime.h>
#include <cstdio>
#include <cstdint>

#define LAS __attribute__((address_space(3)))
#define GAS __attribute__((address_space(1)))
typedef unsigned short bf16_t;
typedef short bf16x8 __attribute__((ext_vector_type(8)));
typedef short s16x4 __attribute__((ext_vector_type(4)));
typedef float f32x4 __attribute__((ext_vector_type(4)));
typedef float f32x16 __attribute__((ext_vector_type(16)));
typedef unsigned u32x4 __attribute__((ext_vector_type(4)));
typedef unsigned u32x2 __attribute__((ext_vector_type(2)));

constexpr int D = 1024, NB = 32, SEQ = 2048, T = NB * SEQ, CTXL = 256, TC = NB * CTXL, TT = T + TC;
constexpr int NQKV = 1536, NE = 64;
constexpr float ALPHA = 1.681792830507429f;
constexpr float LN_EPS = 1e-5f, MOD_EPS = 1e-6f;
constexpr float C2 = 0.125f * 1.4426950408889634f;
constexpr float LOG2E = 1.4426950408889634f;
constexpr int NCHUNK = 4;
constexpr int NWAVES = 8, NTHR = 512, GRID = 256;

constexpr size_t MiB = 1u << 20;
constexpr size_t WS_CTL = 0, CTL_BYTES = 1 * MiB;
constexpr size_t WS_ROPEC = 1 * MiB, WS_ROPES = 1 * MiB + 4096, WS_CSN = 1 * MiB + 65536, WS_DLC = 1 * MiB + 524288, WS_DL = 2 * MiB;
constexpr size_t WS_WQKV = 10 * MiB, WS_WO = 16 * MiB, WS_WF = 20 * MiB, WS_WR = 28 * MiB, WS_WSH = 29 * MiB;
constexpr size_t WS_MODP = 36 * MiB, WS_MOD = 49 * MiB;
constexpr size_t WS_EGU = 54 * MiB, WS_ED = 118 * MiB;
constexpr size_t WS_XS = 150 * MiB;
constexpr size_t WS_STOK = 294 * MiB, WS_SDST = 297 * MiB, WS_SW = 300 * MiB, WS_TKE = 303 * MiB, WS_TKW = 306 * MiB;
constexpr size_t WS_R = 309 * MiB;
constexpr size_t WS_Q = WS_R, WS_K = WS_R + 144 * MiB, WS_V = WS_R + 180 * MiB;
constexpr size_t WS_ABT = WS_R, WS_FH = WS_R + 256 * MiB, WS_FH1 = WS_R + 320 * MiB, WS_ABTC = WS_R + 321 * MiB, WS_FC = WS_R + 353 * MiB;
constexpr size_t WS_H = WS_R, WS_HS = WS_R + 320 * MiB, WS_YB = WS_R + 356 * MiB;
constexpr size_t WS_END = WS_YB + 324 * MiB;
constexpr int MAXROWS = 655360;

constexpr int CW_TMO = 0, CW_BAR = 4096, CW_BCNT = 16384;

constexpr int RING_BYTES = 131072;
constexpr int L_MISC = RING_BYTES;
constexpr int L_TSTART = RING_BYTES + 256;
constexpr int L_PREF = L_TSTART + 1040;
constexpr int L_LCNT = L_PREF + 256;
constexpr int L_TSEG = L_LCNT + 256;
constexpr int L_SCAN = L_TSEG + 2560;
constexpr int LDS_BYTES = 139264;
static_assert(L_SCAN + 1024 <= LDS_BYTES, "LDS map");

#define RLX_AGENT __ATOMIC_RELAXED, __HIP_MEMORY_SCOPE_AGENT
#define LDS_WAIT() asm volatile("s_waitcnt lgkmcnt(0)" ::: "memory")
#define VM_WAIT() asm volatile("s_waitcnt vmcnt(0)" ::: "memory")

__device__ __forceinline__ unsigned f2bf(float f) { unsigned u = __builtin_bit_cast(unsigned, f); return (u + 0x7fffu + ((u >> 16) & 1u)) >> 16; }
__device__ __forceinline__ unsigned pk2(float lo, float hi) { return f2bf(lo) | (f2bf(hi) << 16); }
__device__ __forceinline__ unsigned cvt_pk_bf16(float lo, float hi) { unsigned r; asm volatile("v_cvt_pk_bf16_f32 %0, %1, %2" : "=v"(r) : "v"(lo), "v"(hi)); return r; }
__device__ __forceinline__ float bflo(unsigned w) { return __builtin_bit_cast(float, w << 16); }
__device__ __forceinline__ float bfhi(unsigned w) { return __builtin_bit_cast(float, w & 0xffff0000u); }
__device__ __forceinline__ float wave_sum(float v) {
#pragma unroll
    for (int o = 1; o < 64; o <<= 1) v += __shfl_xor(v, o);
    return v;
}

__device__ __forceinline__ int opaque_tid() { int t = threadIdx.x; asm volatile("" : "+v"(t)); return t; }

#define XB_TMO      128
#define XB_XCNT(j)  (256  + 64 * (j))
#define XB_XSUB(j)  (1280 + 64 * (j))
#define XB_XGEN(j)  (2304 + 64 * (j))
#define XB_TOP      3328
#define XB_TOPGEN   3392
#define XCD_BAR_WORDS 3456
#define XB_SPIN_CAP (1u << 22)
__device__ __forceinline__ unsigned xb_ld(unsigned* p)              { return __hip_atomic_load(p, __ATOMIC_RELAXED, __HIP_MEMORY_SCOPE_AGENT); }
__device__ __forceinline__ unsigned xb_add(unsigned* p, unsigned v) { return __hip_atomic_fetch_add(p, v, __ATOMIC_RELAXED, __HIP_MEMORY_SCOPE_AGENT); }
__device__ __forceinline__ unsigned xb_xcc_id() { return (unsigned)__builtin_amdgcn_s_getreg((3 << 11) | 20) & 0xFu; }
#define XB_SPIN(cond, bar) do { unsigned _sp = 0; while (cond) { __builtin_amdgcn_s_sleep(1); \
    if ((++_sp & 255u) == 0u) { if (xb_ld(&(bar)[XB_TMO])) break; if (_sp > XB_SPIN_CAP) { atomicAdd(&(bar)[XB_TMO], 1u); break; } } } } while (0)
struct XcdBarrier { unsigned* bar; unsigned x; volatile LAS unsigned* st; };
__device__ __forceinline__ XcdBarrier xcd_barrier_post(unsigned* bar, volatile LAS unsigned* st) {
    XcdBarrier b; b.bar = bar; b.x = xb_xcc_id(); b.st = st;
    if (threadIdx.x == 0) (void)xb_add(&bar[XB_XCNT(b.x)], 1u);
    return b;
}
__device__ __forceinline__ void xcd_barrier_complete(unsigned* bar, unsigned x, unsigned& nloc, unsigned& nx) {
    const unsigned G = gridDim.x * gridDim.y * gridDim.z;
    unsigned sum, cnt, mine, sp = 0u;
    for (;;) {
        sum = 0u; cnt = 0u; mine = 0u;
#pragma unroll
        for (unsigned j = 0; j < 16; ++j) { const unsigned c = xb_ld(&bar[XB_XCNT(j)]); sum += c; cnt += (c > 0u) ? 1u : 0u; mine = (j == x) ? c : mine; }
        if (sum == G) break;
        __builtin_amdgcn_s_sleep(1);
        if ((++sp & 255u) == 0u) { if (xb_ld(&bar[XB_TMO])) break; if (sp > XB_SPIN_CAP) { atomicAdd(&bar[XB_TMO], 1u); break; } }
    }
    nloc = mine > 0u ? mine : 1u; nx = cnt > 0u ? cnt : 1u;
}
__device__ __forceinline__ void xcd_barrier(const XcdBarrier& b) {
    asm volatile("s_waitcnt vmcnt(0)" ::: "memory");
    __syncthreads();
    if (threadIdx.x == 0) {
        unsigned* bar = b.bar; unsigned bx = b.x; asm volatile("" : "+s"(bx));
        __builtin_amdgcn_s_waitcnt(0);
        unsigned nloc = b.st[0], nx = b.st[1];
        if (nloc == 0u) { xcd_barrier_complete(bar, bx, nloc, nx); b.st[0] = nloc; b.st[1] = nx; }
        const unsigned old = xb_add(&bar[XB_XSUB(bx)], 1u);
        const unsigned gen = old / nloc;
        if (old + 1u == (gen + 1u) * nloc) {
            __builtin_amdgcn_fence(__ATOMIC_RELEASE, "agent");
            asm volatile("s_waitcnt vmcnt(0)" ::: "memory");
            const unsigned og = xb_add(&bar[XB_TOP], 1u);
            const unsigned tg = og / nx;
            if (og + 1u == (tg + 1u) * nx) xb_add(&bar[XB_TOPGEN], 1u);
            else XB_SPIN(xb_ld(&bar[XB_TOPGEN]) == tg, bar);
            __builtin_amdgcn_fence(__ATOMIC_ACQUIRE, "agent");
            xb_add(&bar[XB_XGEN(bx)], 1u);
            asm volatile("s_waitcnt vmcnt(0)" ::: "memory");
        } else {
            XB_SPIN(xb_ld(&bar[XB_XGEN(bx)]) == gen, bar);
            __builtin_amdgcn_fence(__ATOMIC_ACQUIRE, "agent");
            asm volatile("s_waitcnt vmcnt(0)" ::: "memory");
        }
    }
    __syncthreads();
}

namespace pg {
constexpr int BM = 256, BK = 64, HALF = 128, HTB = HALF * BK * 2;
__host__ __device__ __forceinline__ int lds_byte(int r, int c) { const int st = (r >> 4) * 2 + (c >> 5), rr = r & 15, cc = c & 31, ob = rr * 64 + cc * 2; return st * 1024 + (ob ^ (((ob >> 9) & 1) << 5)); }
__host__ __device__ __forceinline__ void stage_rc(int b, int& R, int& C) { const int st = b / 1024, sb = b % 1024, swz = sb ^ (((sb >> 9) & 1) << 5); R = (st >> 1) * 16 + swz / 64; C = (st & 1) * 32 + (swz % 64) / 2; }
__host__ __device__ __forceinline__ int perm32(int rho) { const int n = rho >> 4, i = rho & 15; return 8 * (i >> 2) + 4 * n + (i & 3); }

struct Unit {
    const char* A;
    const char* B;
    const int* gidx;
    int gbase;
    int nt;
    char* out; int ldc; float scale; int flags; int i0; int i1;
    const int* l0; const float* l1;
};

template <class Epi, class Sched, bool GATHER>
__device__ __forceinline__ void gemm_phase(LAS unsigned char* lds, const unsigned lda, const unsigned ldb, const char* gtable, const Sched& S, const Epi& E) {
    const int tid = opaque_tid(), wid = __builtin_amdgcn_readfirstlane(tid >> 6), lane = tid & 63, wr = wid >> 2, wc = wid & 3, fr = lane & 15, fq = lane >> 4;
    unsigned voffA[2], voffB[2];
#pragma unroll
    for (int i = 0; i < 2; ++i) { int R, C; stage_rc(tid * 16 + i * 8192, R, C); const int Rb = (R & ~31) + perm32(R & 31);
        voffA[i] = (unsigned)R * lda + (unsigned)C * 2u; voffB[i] = (unsigned)Rb * ldb + (unsigned)C * 2u; }
    const size_t kstep = (size_t)(BK * 2);
    const size_t hstepA = (size_t)HALF * lda, hstepB = (size_t)HALF * ldb;
    const unsigned ldsw = (unsigned)wid * 1024u;
    const int aoff = lds_byte(wr * 64 + fr, fq * 8), boff = lds_byte(wc * 32 + fr, fq * 8);
#define PG_SA(b, h) (((b) * 2 + (h)) * HTB)
#define PG_SB(b, h) ((4 + (b) * 2 + (h)) * HTB)
#define PG_ST2(bufoff, p0, p1) do { \
        __builtin_amdgcn_global_load_lds((const unsigned*)(p0), (LAS unsigned*)(lds + (bufoff) + ldsw), 16, 0, 0); \
        __builtin_amdgcn_global_load_lds((const unsigned*)(p1), (LAS unsigned*)(lds + (bufoff) + ldsw + 8192), 16, 0, 0); } while (0)
#define PG_STB(bufoff, bp) PG_ST2(bufoff, (bp) + voffB[0], (bp) + voffB[1])
#define PG_STA(bufoff, ap, h, nx) do { if constexpr (GATHER) { PG_ST2(bufoff, (ap) + ((nx) ? nO[h][0] : cO[h][0]), (ap) + ((nx) ? nO[h][1] : cO[h][1])); } \
        else { PG_ST2(bufoff, (ap) + (h) * hstepA + voffA[0], (ap) + (h) * hstepA + voffA[1]); } } while (0)
#define PG_LDA(dst, b, h) do { _Pragma("unroll") for (int m = 0; m < 4; ++m) _Pragma("unroll") for (int k = 0; k < 2; ++k) dst[m][k] = *(const LAS bf16x8*)(lds + PG_SA(b, h) + aoff + m * 2048 + k * 1024); } while (0)
#define PG_LDB(dst, b, h) do { _Pragma("unroll") for (int n = 0; n < 2; ++n) _Pragma("unroll") for (int k = 0; k < 2; ++k) dst[n][k] = *(const LAS bf16x8*)(lds + PG_SB(b, h) + boff + n * 2048 + k * 1024); } while (0)
#define PG_MMA(ai, bj, At, Bt) do { __builtin_amdgcn_s_setprio(1); _Pragma("unroll") for (int m = 0; m < 4; ++m) _Pragma("unroll") for (int n = 0; n < 2; ++n) _Pragma("unroll") for (int k = 0; k < 2; ++k) \
        acc[ai][bj][m][n] = __builtin_amdgcn_mfma_f32_16x16x32_bf16(Bt[n][k], At[m][k], acc[ai][bj][m][n], 0, 0, 0); __builtin_amdgcn_s_setprio(0); } while (0)
#define PG_WAIT_V(n) asm volatile("s_waitcnt vmcnt(" #n ")" ::: "memory")
#define PG_WAIT_L(n) asm volatile("s_waitcnt lgkmcnt(" #n ")" ::: "memory")
#define PG_BAR __builtin_amdgcn_s_barrier()
#define PG_SCHED __builtin_amdgcn_sched_barrier(0)
#define PG_GOFF(dst, u) do { const int tz_ = opaque_tid(); _Pragma("unroll") for (int i = 0; i < 2; ++i) { int R_, C_; stage_rc(tz_ * 16 + i * 8192, R_, C_); \
        _Pragma("unroll") for (int h = 0; h < 2; ++h) { const int rr = h * HALF + R_; \
        const int ix = (u).gidx ? ((const GAS int*)(u).gidx)[rr] : (u).gbase + rr; dst[h][i] = (unsigned)ix * lda + (unsigned)C_ * 2u; } } } while (0)
    Unit cur, nxt; int ui = 0;
    if (!S.next(0, cur)) return;
    f32x4 acc[2][2][4][2];
#pragma unroll
    for (int a = 0; a < 2; ++a)
#pragma unroll
        for (int b = 0; b < 2; ++b)
#pragma unroll
            for (int m = 0; m < 4; ++m)
#pragma unroll
                for (int n = 0; n < 2; ++n) acc[a][b][m][n] = (f32x4){0.f, 0.f, 0.f, 0.f};
    bf16x8 At[4][2], B0[2][2], B1[2][2];
    unsigned cO[2][2] = {{0u, 0u}, {0u, 0u}}, nO[2][2] = {{0u, 0u}, {0u, 0u}};
    if constexpr (GATHER) { PG_GOFF(cO, cur); }
    const char* cA = GATHER ? gtable : cur.A; const char* cB = cur.B;
    PG_STB(PG_SB(0, 0), cB); PG_STB(PG_SB(0, 1), cB + hstepB); PG_STA(PG_SA(0, 0), cA, 0, false); PG_STA(PG_SA(0, 1), cA, 1, false);
    if (wr == 1) PG_BAR;
    PG_WAIT_V(2); PG_BAR;
    PG_STB(PG_SB(1, 0), cB + kstep); PG_STA(PG_SA(1, 0), cA + kstep, 0, false); PG_STB(PG_SB(1, 1), cB + hstepB + kstep);
    PG_WAIT_V(6); PG_BAR;
    for (;;) {
        const bool has_next = S.next(ui + 1, nxt);
        const int nt = cur.nt;
        if constexpr (GATHER) { if (has_next) { PG_GOFF(nO, nxt); } else {
#pragma unroll
            for (int h = 0; h < 2; ++h)
#pragma unroll
                for (int i = 0; i < 2; ++i) nO[h][i] = cO[h][i]; } }
        const char* nA = GATHER ? gtable : (has_next ? nxt.A : cA); const char* nB = has_next ? nxt.B : cB;
#pragma unroll 1
        for (int t = 0; t < nt; t += 2) {
            const bool last = (t == nt - 2);
            const char* a1 = cA + (size_t)(t + 1) * kstep;
            const char* a2 = last ? nA : cA + (size_t)(t + 2) * kstep; const char* b2 = last ? nB : cB + (size_t)(t + 2) * kstep;
            const char* a3 = a2 + kstep; const char* b3 = b2 + kstep;
            PG_LDB(B0, 0, 0); PG_LDB(B1, 0, 1); PG_SCHED; PG_LDA(At, 0, 0); PG_STA(PG_SA(1, 1), a1, 1, false);
            PG_WAIT_V(8); PG_WAIT_L(0); PG_BAR; PG_MMA(0, 0, At, B0); PG_MMA(0, 1, At, B1); PG_BAR; PG_SCHED;
            PG_LDA(At, 0, 1); PG_STB(PG_SB(0, 0), b2); PG_STB(PG_SB(0, 1), b2 + hstepB); PG_STA(PG_SA(0, 0), a2, 0, last);
            PG_WAIT_V(8); PG_WAIT_L(0); PG_BAR; PG_MMA(1, 0, At, B0); PG_MMA(1, 1, At, B1); PG_BAR; PG_SCHED;
            PG_LDB(B0, 1, 0); PG_LDB(B1, 1, 1); PG_SCHED; PG_LDA(At, 1, 0); PG_STA(PG_SA(0, 1), a2, 1, last);
            PG_WAIT_V(8); PG_WAIT_L(0); PG_BAR; PG_MMA(0, 0, At, B0); PG_MMA(0, 1, At, B1); PG_BAR; PG_SCHED;
            PG_LDA(At, 1, 1); PG_STB(PG_SB(1, 0), b3); PG_STB(PG_SB(1, 1), b3 + hstepB); PG_STA(PG_SA(1, 0), a3, 0, last);
            PG_WAIT_V(8); PG_WAIT_L(0); PG_BAR; PG_MMA(1, 0, At, B0); PG_MMA(1, 1, At, B1); PG_BAR; PG_SCHED;
        }
        if (wr == 0) PG_BAR;
        E(acc, cur, wr, wc, fr, fq);
        if (!has_next) break;
#pragma unroll
        for (int a = 0; a < 2; ++a)
#pragma unroll
            for (int b = 0; b < 2; ++b)
#pragma unroll
                for (int m = 0; m < 4; ++m)
#pragma unroll
                    for (int n = 0; n < 2; ++n) acc[a][b][m][n] = (f32x4){0.f, 0.f, 0.f, 0.f};
        cur = nxt; cA = nA; cB = nB; ++ui;
        if constexpr (GATHER) {
#pragma unroll
            for (int h = 0; h < 2; ++h)
#pragma unroll
                for (int i = 0; i < 2; ++i) cO[h][i] = nO[h][i]; }
        if (wr == 1) PG_BAR;
    }
    PG_WAIT_V(0);
    PG_BAR;
#undef PG_SA
#undef PG_SB
#undef PG_ST2
#undef PG_STB
#undef PG_STA
#undef PG_LDA
#undef PG_LDB
#undef PG_MMA
#undef PG_WAIT_V
#undef PG_WAIT_L
#undef PG_BAR
#undef PG_SCHED
#undef PG_GOFF
}

struct EpiStore {
    __device__ __forceinline__ void operator()(const f32x4 (&acc)[2][2][4][2], const Unit& u, int wr, int wc, int fr, int fq) const {
        const float s = u.scale;
#pragma unroll
        for (int ai = 0; ai < 2; ++ai)
#pragma unroll
            for (int m = 0; m < 4; ++m) { const int row = ai * HALF + wr * 64 + m * 16 + fr;
                char* rowp = u.out + (ptrdiff_t)row * u.ldc + (wc * 32 + 8 * fq) * 2;
                if (!((u.flags & 1) && row == 0)) {
#pragma unroll
                for (int bj = 0; bj < 2; ++bj) { const f32x4 v0 = acc[ai][bj][m][0] * s, v1 = acc[ai][bj][m][1] * s;
                    u32x4 w; w.x = cvt_pk_bf16(v0[0], v0[1]); w.y = cvt_pk_bf16(v0[2], v0[3]); w.z = cvt_pk_bf16(v1[0], v1[1]); w.w = cvt_pk_bf16(v1[2], v1[3]);
                    *(u32x4*)(rowp + bj * 256) = w; } } }
    }
};
struct EpiQKV {
    bf16_t* Q; bf16_t* K; bf16_t* V; const float* ropec; const float* ropes;
    __device__ __forceinline__ void operator()(const f32x4 (&acc)[2][2][4][2], const Unit& u, int wr, int wc, int fr, int fq) const {
        const int pm = u.i0, pn = u.i1; const bool lat = pm < (T / 256); const bool rope = lat && pn < 5;
        const float qs = pn < 4 ? C2 : 1.f;
        const int part = wc & 1;
        const int fi0 = 8 * (fq & 1);
        const float sgn = (fq < 2) ? -1.f : 1.f;
#pragma unroll
        for (int ai = 0; ai < 2; ++ai)
#pragma unroll
            for (int m = 0; m < 4; ++m) { const int row = ai * HALF + wr * 64 + m * 16 + fr; const int tok = pm * 256 + row;
                const int tl = tok & (SEQ - 1); const int pos = part ? (tl & 63) : (tl >> 6);
                f32x4 c0 = {1.f, 1.f, 1.f, 1.f}, c1 = c0, s0 = {0.f, 0.f, 0.f, 0.f}, s1 = s0;
                if (rope) { c0 = *(const f32x4*)(ropec + pos * 16 + fi0); c1 = *(const f32x4*)(ropec + pos * 16 + fi0 + 4); s0 = *(const f32x4*)(ropes + pos * 16 + fi0); s1 = *(const f32x4*)(ropes + pos * 16 + fi0 + 4); }
#pragma unroll
                for (int bj = 0; bj < 2; ++bj) { f32x4 v0 = acc[ai][bj][m][0], v1 = acc[ai][bj][m][1];
                    if (rope) { f32x4 p0, p1;
#pragma unroll
                        for (int j = 0; j < 4; ++j) { p0[j] = __shfl_xor(v0[j], 32); p1[j] = __shfl_xor(v1[j], 32); }
                        v0 = v0 * c0 + (p0 * sgn) * s0; v1 = v1 * c1 + (p1 * sgn) * s1; }
                    v0 = v0 * qs; v1 = v1 * qs;
                    u32x4 w; w.x = cvt_pk_bf16(v0[0], v0[1]); w.y = cvt_pk_bf16(v0[2], v0[3]); w.z = cvt_pk_bf16(v1[0], v1[1]); w.w = cvt_pk_bf16(v1[2], v1[3]);
                    const int col = bj * HALF + wc * 32 + 8 * fq;
                    bf16_t* dst = pn < 4 ? Q + (size_t)tok * 1024 + pn * 256 + col : (pn == 4 ? K + (size_t)tok * 256 + col : V + (size_t)tok * 256 + col);
                    *(u32x4*)dst = w; } }
    }
};
struct EpiSilu {
    __device__ __forceinline__ void operator()(const f32x4 (&acc)[2][2][4][2], const Unit& u, int wr, int wc, int fr, int fq) const {
#pragma unroll
        for (int ai = 0; ai < 2; ++ai)
#pragma unroll
            for (int m = 0; m < 4; ++m) { const int row = ai * HALF + wr * 64 + m * 16 + fr;
                float h[8];
#pragma unroll
                for (int n = 0; n < 2; ++n)
#pragma unroll
                    for (int j = 0; j < 4; ++j) { const float g = acc[ai][0][m][n][j], up = acc[ai][1][m][n][j]; h[n * 4 + j] = g / (1.f + __expf(-g)) * up; }
                u32x4 w; w.x = cvt_pk_bf16(h[0], h[1]); w.y = cvt_pk_bf16(h[2], h[3]); w.z = cvt_pk_bf16(h[4], h[5]); w.w = cvt_pk_bf16(h[6], h[7]);
                *(u32x4*)(u.out + (size_t)row * 512 + (wc * 32 + 8 * fq) * 2) = w; }
    }
};
struct EpiScatter {
    __device__ __forceinline__ void operator()(const f32x4 (&acc)[2][2][4][2], const Unit& u, int wr, int wc, int fr, int fq) const {
#pragma unroll
        for (int ai = 0; ai < 2; ++ai)
#pragma unroll
            for (int m = 0; m < 4; ++m) { const int row = ai * HALF + wr * 64 + m * 16 + fr;
                int dst; float w;
                if (u.l0) { dst = u.l0[row]; w = u.l1[row]; } else { dst = (u.i0 + row) * 9 + 8; w = 1.f; }
                if (dst >= 0) { char* rowp = u.out + (size_t)dst * 2048 + (wc * 32 + 8 * fq) * 2;
#pragma unroll
                    for (int bj = 0; bj < 2; ++bj) { const f32x4 v0 = acc[ai][bj][m][0] * w, v1 = acc[ai][bj][m][1] * w;
                        u32x4 o; o.x = cvt_pk_bf16(v0[0], v0[1]); o.y = cvt_pk_bf16(v0[2], v0[3]); o.z = cvt_pk_bf16(v1[0], v1[1]); o.w = cvt_pk_bf16(v1[2], v1[3]);
                        *(u32x4*)(rowp + bj * 256) = o; } } }
    }
};
__device__ __forceinline__ int xcd_remap(int L0, int NU) { const int q = NU >> 3, r = NU & 7, x = L0 & 7, off = L0 >> 3; return (x < r ? x * (q + 1) : r * (q + 1) + (x - r) * q) + off; }
}

namespace attn {
constexpr int SLOTB = 8192;
constexpr int LDS_K = 0, LDS_V = 2 * SLOTB, LDS_WS = 4 * SLOTB, LDS_OST = LDS_WS + NWAVES * 256, LDS_END = LDS_OST + NWAVES * 4096;
static_assert(LDS_END <= RING_BYTES, "attention LDS");
__device__ __forceinline__ int crow(int r, int hi) { return (r & 3) + 8 * (r >> 2) + 4 * hi; }
__device__ __forceinline__ void glds16(const void* gsrc, unsigned lds_dst) { unsigned keep;
    asm volatile("s_mov_b32 %0, m0\n\ts_mov_b32 m0, %2\n\ts_nop 0\n\tglobal_load_lds_dwordx4 %1, off\n\ts_mov_b32 m0, %0" : "=&s"(keep) : "v"(gsrc), "s"(lds_dst) : "memory"); }
__device__ __forceinline__ float rowmax(const f32x16& p0, const f32x16& p1) {
    float a = fmaxf(p0[0], p1[0]);
#pragma unroll
    for (int r = 1; r < 16; ++r) a = fmaxf(a, fmaxf(p0[r], p1[r]));
    auto rr = __builtin_amdgcn_permlane32_swap(__float_as_uint(a), __float_as_uint(a), false, false);
    return fmaxf(__uint_as_float(rr[0]), __uint_as_float(rr[1]));
}
__device__ __forceinline__ void pv(f32x16* o, int vb, bf16x8 pa0, bf16x8 pa1, bf16x8 pa2, bf16x8 pa3) {
#pragma unroll
    for (int d0 = 0; d0 < 2; ++d0) { s16x4 lo[4], hi[4];
#pragma unroll
        for (int ks = 0; ks < 4; ++ks) {
            asm volatile("ds_read_b64_tr_b16 %0,%1 offset:%c2" : "=&v"(lo[ks]) : "v"(vb), "i"(d0 * 4096 + ks * 1024) : "memory");
            asm volatile("ds_read_b64_tr_b16 %0,%1 offset:%c2" : "=&v"(hi[ks]) : "v"(vb), "i"(d0 * 4096 + ks * 1024 + 512) : "memory"); }
        asm volatile("s_waitcnt lgkmcnt(0)" ::: "memory"); __builtin_amdgcn_sched_barrier(0);
#define PK(k) (bf16x8){lo[k][0], lo[k][1], lo[k][2], lo[k][3], hi[k][0], hi[k][1], hi[k][2], hi[k][3]}
        o[d0] = __builtin_amdgcn_mfma_f32_32x32x16_bf16(pa0, PK(0), o[d0], 0, 0, 0);
        o[d0] = __builtin_amdgcn_mfma_f32_32x32x16_bf16(pa1, PK(1), o[d0], 0, 0, 0);
        o[d0] = __builtin_amdgcn_mfma_f32_32x32x16_bf16(pa2, PK(2), o[d0], 0, 0, 0);
        o[d0] = __builtin_amdgcn_mfma_f32_32x32x16_bf16(pa3, PK(3), o[d0], 0, 0, 0);
#undef PK
    }
}
__device__ __forceinline__ void attn_unit(const bf16_t* Q, const bf16_t* K, const bf16_t* V, bf16_t* O, int b, int h, int q0, bool isctx, float sink2, LAS unsigned char* shm) {
    const int tid = opaque_tid(), lane = tid & 63, r32 = lane & 31, hi = lane >> 5; const int wid = __builtin_amdgcn_readfirstlane(tid >> 6);
    const int kvh = h >> 2;
    const long qrow = isctx ? (long)T + b * CTXL + wid * 32 : (long)b * SEQ + q0 + wid * 32;
    const unsigned lds0 = (unsigned)(uintptr_t)shm;
    LAS float* wsf = (LAS float*)(shm + LDS_WS) + wid * 64;
    int jlo = 0, nl = 0;
    if (!isctx) { jlo = (q0 == 0) ? 2 : 0; int jhi = (SEQ - q0 + 128) / 64; if (jhi > 8) jhi = 8; nl = jhi - jlo; }
    const int NT = nl + 4;
    const long lat0 = (long)b * SEQ + q0 - 128 + 64 * jlo, ctx0 = (long)T + b * CTXL;
#define TROW(t) ((t) < nl ? lat0 + 64 * (t) : ctx0 + 64 * ((t) - nl))
    const int kcol = kvh * 64 + wid * 8, vcol = kvh * 64 + (wid >> 2) * 32 + (lane & 3) * 8, vrow = 16 * (wid & 3) + (lane >> 2);
    const unsigned kdst = lds0 + LDS_K + wid * 1024, vdst = lds0 + LDS_V + wid * 1024;
#define DMA_KV(t, slot) do { const long tr_ = TROW(t); glds16(K + (tr_ + lane) * 256 + kcol, (unsigned)__builtin_amdgcn_readfirstlane(kdst + (slot) * SLOTB)); \
        glds16(V + (tr_ + vrow) * 256 + vcol, (unsigned)__builtin_amdgcn_readfirstlane(vdst + (slot) * SLOTB)); } while (0)
    DMA_KV(0, 0);
    bf16x8 qr[4];
#pragma unroll
    for (int d0 = 0; d0 < 4; ++d0) qr[d0] = *(const GAS bf16x8*)(Q + (qrow + r32) * 1024 + h * 64 + d0 * 16 + hi * 8);
    float mrun = sink2, l_reg = (hi == 0) ? 1.f : 0.f;
    f32x16 o[2];
#pragma unroll
    for (int r = 0; r < 16; ++r) { o[0][r] = 0.f; o[1][r] = 0.f; }
    const int vb0 = (int)(lds0 + LDS_V) + ((lane >> 4) & 1) * 32 + (lane & 3) * 8 + (4 * hi + ((lane & 15) >> 2)) * 64;
    const int qw = q0 + wid * 32;
    asm volatile("s_waitcnt vmcnt(0) lgkmcnt(0)\n\ts_barrier" ::: "memory");
    for (int t = 0; t < NT; ++t) {
        const int slot = t & 1;
        if (t + 1 < NT) DMA_KV(t + 1, slot ^ 1);
        const bool latt = t < nl;
        const int ks = q0 - 128 + 64 * (jlo + t);
        bool need = true;
        if (latt) need = (ks + 63 >= qw - 128) && (ks <= qw + 31 + 128);
        if (need) {
            f32x16 p0, p1;
#pragma unroll
            for (int r = 0; r < 16; ++r) { p0[r] = 0.f; p1[r] = 0.f; }
            const LAS unsigned char* kb = shm + LDS_K + slot * SLOTB + hi * 1024 + r32 * 16;
#pragma unroll
            for (int d0 = 0; d0 < 4; ++d0) {
                const bf16x8 b0 = *(const LAS bf16x8*)(kb + d0 * 2048), b1 = *(const LAS bf16x8*)(kb + d0 * 2048 + 512);
                p0 = __builtin_amdgcn_mfma_f32_32x32x16_bf16(b0, qr[d0], p0, 0, 0, 0);
                p1 = __builtin_amdgcn_mfma_f32_32x32x16_bf16(b1, qr[d0], p1, 0, 0, 0); }
            if (latt) { const int dq = qw + r32 - ks;
#pragma unroll
                for (int r = 0; r < 16; ++r) { const int d = dq - crow(r, hi); if (d > 128 || d < -128) p0[r] = -INFINITY; if (d - 32 > 128 || d - 32 < -128) p1[r] = -INFINITY; } }
            const float rm = rowmax(p0, p1);
            const float mnew = fmaxf(mrun, rm);
            if (__any(mnew > mrun)) {
                const float alpha = __builtin_amdgcn_exp2f(mrun - mnew); l_reg *= alpha; mrun = mnew;
                if (hi == 0) wsf[r32] = alpha;
                asm volatile("s_waitcnt lgkmcnt(0)" ::: "memory");
#pragma unroll
                for (int r = 0; r < 16; ++r) { const float f = wsf[crow(r, hi)]; o[0][r] *= f; o[1][r] *= f; }
            }
            float sacc = 0.f;
#pragma unroll
            for (int r = 0; r < 16; ++r) { p0[r] = __builtin_amdgcn_exp2f(p0[r] - mrun); p1[r] = __builtin_amdgcn_exp2f(p1[r] - mrun); sacc += p0[r] + p1[r]; }
            l_reg += sacc;
            u32x4 pw0, pw1, pw2, pw3;
#define PKW(P, B) cvt_pk_bf16(P[B], P[B + 1])
            pw0 = (u32x4){PKW(p0, 0), PKW(p0, 2), PKW(p0, 4), PKW(p0, 6)}; pw1 = (u32x4){PKW(p0, 8), PKW(p0, 10), PKW(p0, 12), PKW(p0, 14)};
            pw2 = (u32x4){PKW(p1, 0), PKW(p1, 2), PKW(p1, 4), PKW(p1, 6)}; pw3 = (u32x4){PKW(p1, 8), PKW(p1, 10), PKW(p1, 12), PKW(p1, 14)};
#undef PKW
            __builtin_amdgcn_sched_barrier(0);
            pv(o, vb0 + slot * SLOTB, __builtin_bit_cast(bf16x8, pw0), __builtin_bit_cast(bf16x8, pw1), __builtin_bit_cast(bf16x8, pw2), __builtin_bit_cast(bf16x8, pw3));
        }
        asm volatile("s_waitcnt vmcnt(0) lgkmcnt(0)\n\ts_barrier" ::: "memory");
    }
    { auto rr = __builtin_amdgcn_permlane32_swap(__float_as_uint(l_reg), __float_as_uint(l_reg), false, false); l_reg = __uint_as_float(rr[0]) + __uint_as_float(rr[1]); }
    if (hi == 0) wsf[32 + r32] = l_reg;
    asm volatile("s_waitcnt lgkmcnt(0)" ::: "memory");
    float rli[16];
#pragma unroll
    for (int r = 0; r < 16; ++r) rli[r] = __builtin_amdgcn_rcpf(wsf[32 + crow(r, hi)]);
    bf16_t* Ow = O + qrow * 1024 + h * 64;
    { LAS bf16_t* stg = (LAS bf16_t*)(shm + LDS_OST) + wid * 2048;
#pragma unroll
      for (int r = 0; r < 16; ++r) { const int orow = crow(r, hi);
#pragma unroll
          for (int d0 = 0; d0 < 2; ++d0) stg[orow * 64 + d0 * 32 + r32] = (bf16_t)f2bf(o[d0][r] * rli[r]); }
      asm volatile("s_waitcnt lgkmcnt(0)" ::: "memory");
#pragma unroll
      for (int i = 0; i < 4; ++i) { const int row = i * 8 + (lane >> 3), ch = lane & 7; const u32x4 v = *(const LAS u32x4*)(stg + row * 64 + ch * 8); *(GAS u32x4*)(Ow + (long)row * 1024 + ch * 8) = v; } }
    asm volatile("s_waitcnt lgkmcnt(0)" ::: "memory");
#undef TROW
#undef DMA_KV
}
}

struct Args {
    const float* in[20];
    float* out; unsigned char* ws;
};
struct Frame {
    LAS unsigned char* lds; unsigned* ctl; unsigned char* ws;
    int tid, lane, wave, gw;
    int blk;
    __device__ __forceinline__ void refresh() { tid = opaque_tid(); lane = tid & 63; wave = __builtin_amdgcn_readfirstlane(tid >> 6); gw = blk * 8 + wave; }
};
constexpr int NGW = GRID * NWAVES;

struct Row { f32x4 v[4]; };
__device__ __forceinline__ void row_load_bf16(Row& r, const bf16_t* p, int lane) {
#pragma unroll
    for (int j = 0; j < 4; ++j) { const u32x2 w = ((const GAS u32x2*)p)[64 * j + lane]; r.v[j] = (f32x4){bflo(w.x), bfhi(w.x), bflo(w.y), bfhi(w.y)}; } }
__device__ __forceinline__ void row_store_bf16(const Row& r, bf16_t* p, int lane) {
#pragma unroll
    for (int j = 0; j < 4; ++j) { u32x2 w; w.x = pk2(r.v[j][0], r.v[j][1]); w.y = pk2(r.v[j][2], r.v[j][3]); ((GAS u32x2*)p)[64 * j + lane] = w; } }
__device__ __forceinline__ void row_load_f32(Row& r, const float* p, int lane) {
#pragma unroll
    for (int j = 0; j < 4; ++j) r.v[j] = ((const GAS f32x4*)p)[64 * j + lane]; }
__device__ __forceinline__ void row_store_f32(const Row& r, float* p, int lane) {
#pragma unroll
    for (int j = 0; j < 4; ++j) ((GAS f32x4*)p)[64 * j + lane] = r.v[j]; }
__device__ __forceinline__ void row_normalize(Row& r, float eps) {
    float s = 0.f;
#pragma unroll
    for (int j = 0; j < 4; ++j) s += (r.v[j][0] + r.v[j][1]) + (r.v[j][2] + r.v[j][3]);
    const float mean = wave_sum(s) * (1.f / D); float q = 0.f;
#pragma unroll
    for (int j = 0; j < 4; ++j) { r.v[j] = r.v[j] - mean; q += (r.v[j][0] * r.v[j][0] + r.v[j][1] * r.v[j][1]) + (r.v[j][2] * r.v[j][2] + r.v[j][3] * r.v[j][3]); }
    const float rstd = 1.f / sqrtf(wave_sum(q) * (1.f / D) + eps);
#pragma unroll
    for (int j = 0; j < 4; ++j) r.v[j] = r.v[j] * rstd;
}
__device__ __forceinline__ void row_modulate(Row& r, const float* sh, const float* sc, int lane) {
    row_normalize(r, MOD_EPS);
#pragma unroll
    for (int j = 0; j < 4; ++j) { const f32x4 a = ((const GAS f32x4*)sc)[64 * j + lane], b = ((const GAS f32x4*)sh)[64 * j + lane]; r.v[j] = r.v[j] * (a + 1.f) + b; }
}
__device__ __forceinline__ int mod_row(int row) { return row < T ? (row >> 11) : 32; }
__device__ __forceinline__ const float* mod_vec(const unsigned char* ws, int layer, int mr, int chunk) { return (const float*)(ws + WS_MOD) + ((size_t)(layer * 33 + mr) * 6 + chunk) * 1024; }

__device__ __forceinline__ void conv_item(const float* W, int N, bf16_t* WT, int Kd, int kd0, int n0, int drow0, bool mirror, LAS float* scr, int lane) {
#pragma unroll 8
    for (int i = 0; i < 32; ++i) { const int kk = 2 * i + (lane >> 5); const int kd = kd0 + kk; const int ks = mirror ? ((kd & ~255) + ((256 - (kd & 255)) & 255)) : kd;
        scr[kk * 33 + (lane & 31)] = ((const GAS float*)W)[(size_t)ks * N + n0 + (lane & 31)]; }
    LDS_WAIT(); asm volatile("" ::: "memory");
    const int c = lane & 7;
#pragma unroll
    for (int j = 0; j < 4; ++j) { const int n = (lane >> 3) + 8 * j; const LAS float* s = scr + (8 * c) * 33 + n;
        u32x4 o; o.x = pk2(s[0 * 33], s[1 * 33]); o.y = pk2(s[2 * 33], s[3 * 33]); o.z = pk2(s[4 * 33], s[5 * 33]); o.w = pk2(s[6 * 33], s[7 * 33]);
        *(GAS u32x4*)(WT + (size_t)(drow0 + n) * Kd + kd0 + 8 * c) = o; }
    LDS_WAIT(); asm volatile("" ::: "memory");
}
__device__ __forceinline__ void conv_matrix_item(const float* W, int K, int N, bf16_t* WT, int mode, int roff, int item, LAS float* scr, int lane) {
    const int nblk = N / 32, kb = item / nblk, nb = item % nblk, n0 = 32 * nb;
    int drow0 = n0 + roff; if (mode == 1) drow0 = (n0 >> 7) * 256 + (n0 & 127); if (mode == 2) drow0 = (n0 >> 7) * 256 + 128 + (n0 & 127);
    conv_item(W, N, WT, K, 64 * kb, n0, drow0, mode == 3, scr, lane);
}
__device__ __forceinline__ void conv_experts(Frame& F, const float* wg, const float* wu, const float* wd, int layer) {
    F.refresh();
    LAS float* scr = (LAS float*)(F.lds + 32768 + F.wave * 8448);
    bf16_t* EGU = (bf16_t*)(F.ws + WS_EGU); bf16_t* ED = (bf16_t*)(F.ws + WS_ED);
    for (int it = F.gw; it < NE * 384; it += NGW) { const int e = it / 384, r = it % 384;
        const size_t eo = ((size_t)layer * NE + e) * (1024 * 256);
        if (r < 128) conv_matrix_item(wg + eo, 1024, 256, EGU + (size_t)e * 512 * 1024, 1, 0, r, scr, F.lane);
        else if (r < 256) conv_matrix_item(wu + eo, 1024, 256, EGU + (size_t)e * 512 * 1024, 2, 0, r - 128, scr, F.lane);
        else conv_matrix_item(wd + eo, 256, 1024, ED + (size_t)e * 1024 * 256, 0, 0, r - 256, scr, F.lane); }
}
__device__ __forceinline__ void conv_small(Frame& F, const Args& a) {
    F.refresh();
    LAS float* scr = (LAS float*)(F.lds + 32768 + F.wave * 8448);
    for (int it = F.gw; it < 6272; it += NGW) {
        if (it < 1536) { const int j = it / 768, r = it % 768; conv_matrix_item(a.in[8] + (size_t)j * 1024 * 1536, 1024, 1536, (bf16_t*)(F.ws + WS_WQKV) + (size_t)j * 1536 * 1024, 0, 0, r, scr, F.lane); }
        else if (it < 2560) { const int q = it - 1536, j = q / 512, r = q % 512; conv_matrix_item(a.in[9] + (size_t)j * 1024 * 1024, 1024, 1024, (bf16_t*)(F.ws + WS_WO) + (size_t)j * 1024 * 1024, 0, 0, r, scr, F.lane); }
        else if (it < 4608) { const int q = it - 2560, j = q / 1024, r = q % 1024; bf16_t* dst = (bf16_t*)(F.ws + WS_WF) + (size_t)j * 2048 * 1024;
            if (r < 512) conv_matrix_item(a.in[11] + (size_t)j * 1024 * 1024, 1024, 1024, dst, 0, 0, r, scr, F.lane);
            else conv_matrix_item(a.in[11] + (size_t)j * 1024 * 1024, 1024, 1024, dst, 3, 1024, r - 512, scr, F.lane); }
        else if (it < 4736) { const int q = it - 4608, l = q / 32, r = q % 32; conv_matrix_item(a.in[12] + (size_t)l * 1024 * 64, 1024, 64, (bf16_t*)(F.ws + WS_WR) + (size_t)l * 64 * 1024, 0, 0, r, scr, F.lane); }
        else { const int q = it - 4736, l = q / 384, r = q % 384; bf16_t* gu = (bf16_t*)(F.ws + WS_WSH + (size_t)l * 1536 * 1024); bf16_t* dn = gu + 512 * 1024;
            if (r < 128) conv_matrix_item(a.in[17] + (size_t)l * 1024 * 256, 1024, 256, gu, 1, 0, r, scr, F.lane);
            else if (r < 256) conv_matrix_item(a.in[18] + (size_t)l * 1024 * 256, 1024, 256, gu, 2, 0, r - 128, scr, F.lane);
            else conv_matrix_item(a.in[19] + (size_t)l * 256 * 1024, 256, 1024, dn, 0, 0, r - 256, scr, F.lane); }
    }
    const int gt = F.blk * NTHR + F.tid, NGT = GRID * NTHR;
    const float TWO_PI = 6.283185307179586f;
    { float* rc = (float*)(F.ws + WS_ROPEC); float* rs = (float*)(F.ws + WS_ROPES);
      for (int i = gt; i < 64 * 16; i += NGT) { const int pos = i >> 4, fi = i & 15; const float inv = exp2f(-(float)fi * (13.287712379549449f / 16.f)); const float ang = (float)pos * inv; rc[i] = cosf(ang); rs[i] = sinf(ang); } }
    { bf16_t* cs = (bf16_t*)(F.ws + WS_CSN);
      for (int i = gt; i < 512 * 256; i += NGT) { const int r = i >> 8, n = i & 255, m = r & 255; const float ang = TWO_PI * (float)((m * n) & 255) * (1.f / 256.f); cs[i] = (bf16_t)f2bf(r < 256 ? cosf(ang) : -sinf(ang)); } }
    { bf16_t* dl = (bf16_t*)(F.ws + WS_DL);
      for (int i = gt; i < 1024 * 4096; i += NGT) { const int k = i >> 12, c = i & 4095, l = c & 2047; const float ang = TWO_PI * (float)((k * l) & 2047) * (1.f / 2048.f); dl[i] = (bf16_t)f2bf(c < 2048 ? cosf(ang) : sinf(ang)); } }
    { bf16_t* dl = (bf16_t*)(F.ws + WS_DLC);
      for (int i = gt; i < 256 * 512; i += NGT) { const int k = i >> 9, c = i & 511, l = c & 255; const float ang = TWO_PI * (float)((k * l) & 255) * (1.f / 256.f); dl[i] = (bf16_t)f2bf(c < 256 ? cosf(ang) : sinf(ang)); } }
}
__device__ __forceinline__ void mod_partials(Frame& F, const Args& a) {
    F.refresh();
    if (F.blk >= 192) return;
    const int l = F.blk / 48, cb = (F.blk % 48) / 4, kc = F.blk & 3;
    LAS float* s = (LAS float*)F.lds;
    for (int i = F.tid; i < 256 * 33; i += NTHR) { const int k = i / 33, r = i % 33; const float c = (r < 32) ? a.in[1][(size_t)r * 1024 + kc * 256 + k] : a.in[3][kc * 256 + k]; s[k * 36 + r] = c / (1.f + __expf(-c)); }
    __syncthreads();
    const int n = cb * 512 + F.tid;
    const GAS float* w = (const GAS float*)a.in[4] + ((size_t)l * 1024 + kc * 256) * 6144 + n;
    float acc[33];
#pragma unroll
    for (int r = 0; r < 33; ++r) acc[r] = 0.f;
#pragma unroll 4
    for (int k = 0; k < 256; ++k) { const float wv = w[(size_t)k * 6144];
#pragma unroll
        for (int r = 0; r < 33; ++r) acc[r] += s[k * 36 + r] * wv; }
    float* part = (float*)(F.ws + WS_MODP) + ((size_t)(kc * 4 + l) * 33) * 6144 + n;
#pragma unroll
    for (int r = 0; r < 33; ++r) part[(size_t)r * 6144] = acc[r];
    __syncthreads();
}
__device__ __forceinline__ void mod_finalize(Frame& F, const Args& a) {
    F.refresh();
    const int gt = F.blk * NTHR + F.tid, NGT = GRID * NTHR; const float* part = (const float*)(F.ws + WS_MODP); float* mod = (float*)(F.ws + WS_MOD);
    for (int i = gt; i < 4 * 33 * 6144; i += NGT) { const int l = i / (33 * 6144), n = i % 6144; float v = a.in[5][l * 6144 + n];
#pragma unroll
        for (int kc = 0; kc < 4; ++kc) v += part[(size_t)kc * 4 * 33 * 6144 + i]; mod[i] = v; }
}
__device__ __forceinline__ void rows_init(Frame& F, const Args& a) {
    F.refresh();
    bf16_t* XS = (bf16_t*)(F.ws + WS_XS); bf16_t* U = (bf16_t*)a.out; const float* part = (const float*)(F.ws + WS_MODP);
    for (int row = F.gw; row < TT; row += NGW) {
        Row r; row_load_f32(r, row < T ? a.in[0] + (size_t)row * D : a.in[2] + (size_t)(row - T) * D, F.lane);
        row_store_bf16(r, XS + (size_t)row * D, F.lane);
        row_normalize(r, MOD_EPS); const int mr = mod_row(row);
#pragma unroll
        for (int j = 0; j < 4; ++j) { const int e = 64 * j + F.lane;
            f32x4 sh = ((const GAS f32x4*)(a.in[5]))[e], sc = ((const GAS f32x4*)(a.in[5] + 1024))[e];
#pragma unroll
            for (int kc = 0; kc < 4; ++kc) { const float* pp = part + ((size_t)(kc * 4 + 0) * 33 + mr) * 6144; sh += ((const GAS f32x4*)pp)[e]; sc += ((const GAS f32x4*)(pp + 1024))[e]; }
            r.v[j] = r.v[j] * (sc + 1.f) + sh; }
        row_store_bf16(r, U + (size_t)row * D, F.lane);
    }
}
__device__ __forceinline__ void rows_post1(Frame& F, const Args& a, int layer, int nrows) {
    F.refresh();
    bf16_t* XS = (bf16_t*)(F.ws + WS_XS); bf16_t* U = (bf16_t*)a.out;
    const float* lg = a.in[6] + (size_t)(layer * 2 + 0) * D; const float* lb = a.in[7] + (size_t)(layer * 2 + 0) * D;
    for (int row = F.gw; row < nrows; row += NGW) { const int mr = mod_row(row);
        Row x, y; row_load_bf16(x, XS + (size_t)row * D, F.lane); row_load_bf16(y, U + (size_t)row * D, F.lane);
        const float* g1 = mod_vec(F.ws, layer, mr, 2);
#pragma unroll
        for (int j = 0; j < 4; ++j) x.v[j] = x.v[j] * ALPHA + ((const GAS f32x4*)g1)[64 * j + F.lane] * y.v[j];
        row_normalize(x, LN_EPS);
#pragma unroll
        for (int j = 0; j < 4; ++j) x.v[j] = x.v[j] * ((const GAS f32x4*)lg)[64 * j + F.lane] + ((const GAS f32x4*)lb)[64 * j + F.lane];
        row_store_bf16(x, XS + (size_t)row * D, F.lane);
        row_modulate(x, mod_vec(F.ws, layer, mr, 3), mod_vec(F.ws, layer, mr, 4), F.lane);
        row_store_bf16(x, U + (size_t)row * D, F.lane);
    }
}
__device__ __forceinline__ void rows_post2(Frame& F, const Args& a, int layer, int t0, int n) {
    F.refresh();
    bf16_t* XS = (bf16_t*)(F.ws + WS_XS); bf16_t* U = (bf16_t*)a.out; const bf16_t* YB = (const bf16_t*)(F.ws + WS_YB);
    const float* lg = a.in[6] + (size_t)(layer * 2 + 1) * D; const float* lb = a.in[7] + (size_t)(layer * 2 + 1) * D;
    for (int i = F.gw; i < n; i += NGW) { const int row = t0 + i; const int mr = mod_row(row);
        Row x, y; row_load_bf16(x, XS + (size_t)row * D, F.lane);
        row_load_bf16(y, YB + (size_t)i * 9 * D, F.lane);
#pragma unroll
        for (int s = 1; s < 9; ++s) { Row z; row_load_bf16(z, YB + ((size_t)i * 9 + s) * D, F.lane);
#pragma unroll
            for (int j = 0; j < 4; ++j) y.v[j] += z.v[j]; }
        const float* g2 = mod_vec(F.ws, layer, mr, 5);
#pragma unroll
        for (int j = 0; j < 4; ++j) x.v[j] = x.v[j] * ALPHA + ((const GAS f32x4*)g2)[64 * j + F.lane] * y.v[j];
        row_normalize(x, LN_EPS);
#pragma unroll
        for (int j = 0; j < 4; ++j) x.v[j] = x.v[j] * ((const GAS f32x4*)lg)[64 * j + F.lane] + ((const GAS f32x4*)lb)[64 * j + F.lane];
        if (layer == 3) { row_store_f32(x, a.out + (size_t)row * D, F.lane); }
        else { row_store_bf16(x, XS + (size_t)row * D, F.lane);
            row_modulate(x, mod_vec(F.ws, layer + 1, mr, 0), mod_vec(F.ws, layer + 1, mr, 1), F.lane);
            row_store_bf16(x, U + (size_t)row * D, F.lane); }
    }
}

__device__ __forceinline__ void route_tokens(Frame& F, const Args& a, int layer, int ntok) {
    F.refresh();
    const int TPB = ntok / GRID;
    const bf16_t* U = (const bf16_t*)a.out; const bf16_t* Wr = (const bf16_t*)(F.ws + WS_WR) + (size_t)layer * 64 * 1024;
    int* tke = (int*)(F.ws + WS_TKE); float* tkw = (float*)(F.ws + WS_TKW);
    LAS int* lcnt = (LAS int*)(F.lds + L_LCNT);
    LAS float* sc = (LAS float*)(F.lds) + F.wave * 1024;
    if (F.tid < 64) lcnt[F.tid] = 0;
    __syncthreads();
    const int lane = F.lane, fr = lane & 15, fq = lane >> 4;
    const float bias = a.in[13][layer * 64 + lane];
    const int ntile = TPB / 16;
    for (int tl = F.wave; tl < ntile; tl += NWAVES) {
        const int t0 = F.blk * TPB + tl * 16;
        f32x4 acc[4];
#pragma unroll
        for (int n = 0; n < 4; ++n) acc[n] = (f32x4){0.f, 0.f, 0.f, 0.f};
        const GAS bf16x8* ap = (const GAS bf16x8*)(U + (size_t)(t0 + fr) * D + fq * 8);
        const GAS bf16x8* bp = (const GAS bf16x8*)(Wr + (size_t)fr * D + fq * 8);
#pragma unroll 4
        for (int ks = 0; ks < 32; ++ks) { const bf16x8 av = ap[ks * 4];
#pragma unroll
            for (int n = 0; n < 4; ++n) { const bf16x8 bv = bp[(size_t)n * 16 * (D / 8) + ks * 4]; acc[n] = __builtin_amdgcn_mfma_f32_16x16x32_bf16(av, bv, acc[n], 0, 0, 0); } }
#pragma unroll
        for (int n = 0; n < 4; ++n)
#pragma unroll
            for (int j = 0; j < 4; ++j) sc[(fq * 4 + j) * 64 + n * 16 + fr] = acc[n][j];
        LDS_WAIT();
        for (int tk = 0; tk < 16; ++tk) {
            const float logit = sc[tk * 64 + lane];
            const float s = 1.f / (1.f + __expf(-logit));
            const float sel = s + bias;
            const int g = lane >> 3;
            float m1 = sel; m1 = fmaxf(m1, __shfl_xor(m1, 1)); m1 = fmaxf(m1, __shfl_xor(m1, 2)); m1 = fmaxf(m1, __shfl_xor(m1, 4));
            const unsigned long long bm = __ballot(sel == m1);
            const unsigned gm = (unsigned)(bm >> (g * 8)) & 0xffu;
            const int first = g * 8 + __builtin_ctz(gm);
            float m2 = (lane == first) ? -INFINITY : sel; m2 = fmaxf(m2, __shfl_xor(m2, 1)); m2 = fmaxf(m2, __shfl_xor(m2, 2)); m2 = fmaxf(m2, __shfl_xor(m2, 4));
            const float gs = m1 + m2;
            float curg = gs; bool gok = false;
#pragma unroll 1
            for (int it = 0; it < 4; ++it) { float mx = curg;
#pragma unroll
                for (int o = 1; o < 64; o <<= 1) mx = fmaxf(mx, __shfl_xor(mx, o));
                const unsigned long long bb = __ballot(curg == mx); const int gi = (int)(__builtin_ctzll(bb) >> 3);
                if (g == gi) { gok = true; curg = -INFINITY; } }
            float cure = gok ? sel : -INFINITY; bool chosen = false; int rk = 0;
#pragma unroll 1
            for (int it = 0; it < 8; ++it) { float mx = cure;
#pragma unroll
                for (int o = 1; o < 64; o <<= 1) mx = fmaxf(mx, __shfl_xor(mx, o));
                const unsigned long long bb = __ballot(cure == mx); const int ei = (int)__builtin_ctzll(bb);
                if (lane == ei) { chosen = true; rk = it; cure = -INFINITY; } }
            const float tot = wave_sum(chosen ? s : 0.f);
            if (chosen) { const int tok = t0 + tk; tke[(size_t)tok * 8 + rk] = lane; tkw[(size_t)tok * 8 + rk] = s / tot * 2.5f; __hip_atomic_fetch_add(&lcnt[lane], 1, __ATOMIC_RELAXED, __HIP_MEMORY_SCOPE_WORKGROUP); }
        }
        LDS_WAIT();
    }
    __syncthreads();
    if (F.tid < 64) F.ctl[CW_BCNT + F.blk * 64 + F.tid] = (unsigned)lcnt[F.tid];
}
__device__ __forceinline__ void build_lists(Frame& F, int ntok) {
    F.refresh();
    const int TPB = ntok / GRID, CH = ntok / NCHUNK;
    LAS int* tstart = (LAS int*)(F.lds + L_TSTART); LAS int* pref = (LAS int*)(F.lds + L_PREF); LAS int* lcnt = (LAS int*)(F.lds + L_LCNT);
    LAS unsigned char* tseg = (LAS unsigned char*)(F.lds + L_TSEG); LAS int* scan = (LAS int*)(F.lds + L_SCAN);
    const unsigned* bcnt = F.ctl + CW_BCNT;
    const int myc = F.blk / 64, mylb = F.blk & 63;
    int nseg = 0;
    if (F.tid < 256) { const int c = F.tid >> 6, e = F.tid & 63; int n = 0, p = 0;
        for (int lb = 0; lb < 64; ++lb) { const int v = (int)__hip_atomic_load(bcnt + (c * 64 + lb) * 64 + e, RLX_AGENT); if (c == myc && lb < mylb) p += v; n += v; }
        nseg = n; scan[F.tid] = (n + 255) >> 8; if (c == myc) pref[e] = p; }
    if (F.tid < 64) lcnt[F.tid] = 0;
    __syncthreads();
    if (F.tid == 0) { int acc = 0; for (int s = 0; s < 256; ++s) { tstart[s] = acc; acc += scan[s]; } tstart[256] = acc; }
    __syncthreads();
    if (F.tid < 256) { const int t0 = tstart[F.tid], t1 = tstart[F.tid + 1]; for (int t = t0; t < t1; ++t) tseg[t] = (unsigned char)F.tid; }
    int* stok = (int*)(F.ws + WS_STOK); int* sdst = (int*)(F.ws + WS_SDST); float* sw = (float*)(F.ws + WS_SW);
    const int* tke = (const int*)(F.ws + WS_TKE); const float* tkw = (const float*)(F.ws + WS_TKW);
    { const int sseg = myc * 64 + mylb;
      if (F.tid == sseg) scan[0] = nseg; }
    __syncthreads();
    { const int sseg = myc * 64 + mylb; const int n = scan[0]; const int base = tstart[sseg] * 256, end = tstart[sseg + 1] * 256;
      for (int p = base + n + F.tid; p < end; p += NTHR) { stok[p] = myc * CH; sdst[p] = -1; sw[p] = 0.f; } }
    for (int tl = F.wave; tl < TPB; tl += NWAVES) { const int tok = F.blk * TPB + tl;
        if (F.lane < 8) { const int e = tke[(size_t)tok * 8 + F.lane]; const float w = tkw[(size_t)tok * 8 + F.lane];
            const int p = tstart[myc * 64 + e] * 256 + pref[e] + __hip_atomic_fetch_add(&lcnt[e], 1, __ATOMIC_RELAXED, __HIP_MEMORY_SCOPE_WORKGROUP);
            stok[p] = tok; sdst[p] = (tok - myc * CH) * 9 + F.lane; sw[p] = w; } }
    __syncthreads();
}

struct SchedQKV {
    const char* U; const char* W; int nfull, nu, c;
    __device__ __forceinline__ bool next(int i, pg::Unit& u) const {
        const int L0 = i * GRID + c; if (L0 >= nu) return false;
        int pm, pn;
        if (L0 < nfull) { const int L = pg::xcd_remap(L0, nfull); const int gid = L / 48, w = L % 48; pm = gid * 8 + (w & 7); pn = w >> 3; }
        else { const int q = L0 - nfull; pm = 256 + (q >> 1); pn = 4 + (q & 1); }
        u.A = U + (size_t)pm * 256 * 2048; u.B = W + (size_t)pn * 256 * 2048; u.gidx = nullptr; u.gbase = 0; u.nt = 16; u.out = nullptr; u.ldc = 0; u.scale = 1.f; u.flags = 0; u.i0 = pm; u.i1 = pn; u.l0 = nullptr; u.l1 = nullptr;
        return true; }
};
struct SchedDense {
    const char* A; const char* W; char* out; int nrt, nct, nt, c; size_t ldA;
    __device__ __forceinline__ bool next(int i, pg::Unit& u) const {
        const int nu = nrt * nct; const int L0 = i * GRID + c; if (L0 >= nu) return false;
        const int L = pg::xcd_remap(L0, nu); const int per = 8 * nct, gid = L / per, w = L % per, fm = gid * 8, gsz = (nrt - fm) < 8 ? (nrt - fm) : 8; const int pm = fm + (w % gsz), pn = w / gsz;
        u.A = A + (size_t)pm * 256 * ldA; u.B = W + (size_t)pn * 256 * ldA; u.gidx = nullptr; u.gbase = 0; u.nt = nt; u.out = out + (size_t)pm * 256 * 2048 + pn * 512; u.ldc = 2048; u.scale = 1.f; u.flags = 0; u.i0 = pm; u.i1 = pn; u.l0 = nullptr; u.l1 = nullptr;
        return true; }
};
struct SchedF1 {
    const char* CS; const char* U; char* ABT; char* ABTC; int nu, c;
    __device__ __forceinline__ bool next(int i, pg::Unit& u) const {
        const int L0 = i * GRID + c; if (L0 >= nu) return false;
        u.gidx = nullptr; u.gbase = 0; u.nt = 4; u.scale = 1.f; u.flags = 0; u.i0 = 0; u.i1 = 0; u.l0 = nullptr; u.l1 = nullptr;
        if (L0 < 2048) { const int L = pg::xcd_remap(L0, 2048); const int pm = L & 1, pn = (L >> 1) & 7, bg = L >> 4, b = bg >> 2, g = bg & 3;
            u.A = CS + (size_t)pm * 256 * 512; u.B = U + ((size_t)b * SEQ + pn * 256) * 2048 + g * 512; u.out = ABT + (size_t)bg * 256 * 8192 + (size_t)(pm * 2048 + pn * 256) * 2; u.ldc = 8192; }
        else { const int q = L0 - 2048; const int pm = q & 1, bg = q >> 1, b = bg >> 2, g = bg & 3;
            u.A = CS + (size_t)pm * 256 * 512; u.B = U + ((size_t)T + b * CTXL) * 2048 + g * 512; u.out = ABTC + (size_t)bg * 256 * 1024 + (size_t)pm * 512; u.ldc = 1024; }
        return true; }
};
struct SchedF2 {
    const char* DL; const char* ABT; char* FH; int c;
    __device__ __forceinline__ bool next(int i, pg::Unit& u) const {
        const int L0 = i * GRID + c; if (L0 >= 512) return false;
        const int L = pg::xcd_remap(L0, 512); const int pm = L & 3, bg = L >> 2, b = bg >> 2, g = bg & 3;
        u.A = DL + (size_t)pm * 256 * 8192; u.B = ABT + (size_t)bg * 256 * 8192; u.gidx = nullptr; u.gbase = 0; u.nt = 64; u.out = FH + ((size_t)b * 1024 + pm * 256) * 2048 + g * 512; u.ldc = 2048; u.scale = 0.001381067932004975f  ; u.flags = 0; u.i0 = 0; u.i1 = 0; u.l0 = nullptr; u.l1 = nullptr;
        return true; }
};
struct SchedF2c {
    const char* DLC; const char* ABTC; char* FC; int c;
    __device__ __forceinline__ bool next(int i, pg::Unit& u) const {
        const int L0 = i * GRID + c; if (L0 >= 128) return false;
        const int bg = L0, b = bg >> 2, g = bg & 3;
        u.A = DLC; u.B = ABTC + (size_t)bg * 256 * 1024; u.gidx = nullptr; u.gbase = 0; u.nt = 8; u.out = FC + ((size_t)b * 256) * 2048 + g * 512; u.ldc = 2048; u.scale = 1.f / 256.f; u.flags = 0; u.i0 = 0; u.i1 = 0; u.l0 = nullptr; u.l1 = nullptr;
        return true; }
};
struct SchedF3 {
    const char* FH; const char* FC; const char* W; char* Y; int nu, c;
    __device__ __forceinline__ bool next(int i, pg::Unit& u) const {
        const int L0 = i * GRID + c; if (L0 >= nu) return false;
        u.gidx = nullptr; u.gbase = 0; u.nt = 16; u.scale = 1.f; u.flags = 0; u.i0 = 0; u.i1 = 0; u.l0 = nullptr; u.l1 = nullptr;
        if (L0 < 1024) { const int L = pg::xcd_remap(L0, 1024); const int gid = L >> 6, w = L & 63, pm = gid * 8 + (w & 7), pn = w >> 3; const int b = pm >> 2, k0 = (pm & 3) * 256;
            u.A = FH + (size_t)pm * 256 * 2048; u.B = W + (size_t)pn * 256 * 2048;
            if (pn < 4) { u.out = Y + ((size_t)b * SEQ + k0) * 2048 + pn * 512; u.ldc = 2048; }
            else { u.out = Y + ((size_t)b * SEQ + SEQ - k0) * 2048 + (pn - 4) * 512; u.ldc = -2048; u.flags = (k0 == 0) ? 1 : 0; } }
        else { const int q = L0 - 1024; const int pm = q >> 2, pn = q & 3;
            u.A = FC + (size_t)pm * 256 * 2048; u.B = W + (size_t)pn * 256 * 2048; u.out = Y + ((size_t)T + pm * 256) * 2048 + pn * 512; u.ldc = 2048; }
        return true; }
};
struct SchedG1 {
    const char* EGU; const char* WSG; const int* STOK; char* H; char* HS; LAS const unsigned char* tseg; int ntl, nsh, c;
    __device__ __forceinline__ bool next(int i, pg::Unit& u) const {
        const int nu = (ntl + nsh) * 2; const int L0 = i * GRID + c; if (L0 >= nu) return false;
        const int L = pg::xcd_remap(L0, nu); const int pm = L >> 1, pn = L & 1;
        u.A = nullptr; u.gbase = 0; u.nt = 16; u.ldc = 512; u.scale = 1.f; u.flags = 0; u.i0 = 0; u.i1 = 0; u.l0 = nullptr; u.l1 = nullptr;
        if (pm < ntl) { const int e = __builtin_amdgcn_readfirstlane((int)tseg[pm]) & 63;
            u.gidx = STOK + (size_t)pm * 256; u.B = EGU + (size_t)e * 512 * 2048 + (size_t)pn * 256 * 2048; u.out = H + (size_t)pm * 256 * 512 + pn * 256; }
        else { const int ps = pm - ntl; u.gidx = nullptr; u.gbase = ps * 256; u.B = WSG + (size_t)pn * 256 * 2048; u.out = HS + (size_t)ps * 256 * 512 + pn * 256; }
        return true; }
};
struct SchedG2 {
    const char* ED; const char* WSD; const char* H; const char* HS; const int* SDST; const float* SW; char* YB; LAS const unsigned char* tseg; int t0, t1, nsh, ch, CH, c;
    __device__ __forceinline__ bool next(int i, pg::Unit& u) const {
        const int nr = t1 - t0; const int nu = (nr + nsh) * 4; const int L0 = i * GRID + c; if (L0 >= nu) return false;
        const int L = pg::xcd_remap(L0, nu); const int q = L >> 2, pn = L & 3;
        u.gidx = nullptr; u.gbase = 0; u.nt = 4; u.ldc = 2048; u.scale = 1.f; u.flags = 0; u.i1 = 0; u.out = YB + pn * 512;
        if (q < nr) { const int pm = t0 + q; const int e = __builtin_amdgcn_readfirstlane((int)tseg[pm]) & 63;
            u.A = H + (size_t)pm * 256 * 512; u.B = ED + (size_t)e * 1024 * 512 + (size_t)pn * 256 * 512; u.l0 = SDST + (size_t)pm * 256; u.l1 = SW + (size_t)pm * 256; u.i0 = 0; }
        else { const int ps = q - nr; u.A = HS + ((size_t)ch * CH + ps * 256) * 512; u.B = WSD + (size_t)pn * 256 * 512; u.l0 = nullptr; u.l1 = nullptr; u.i0 = ps * 256; }
        return true; }
};

__device__ __forceinline__ void fnet_nyquist_rows(Frame& F) {
    F.refresh();
    const bf16_t* ABT = (const bf16_t*)(F.ws + WS_ABT); bf16_t* FH1 = (bf16_t*)(F.ws + WS_FH1);
    for (int r = F.gw; r < 128 * 256; r += NGW) { const int bg = r >> 8, m = r & 255, b = bg >> 2, g = bg & 3;
        const GAS u32x4* p = (const GAS u32x4*)(ABT + (size_t)r * 4096); float s = 0.f;
#pragma unroll
        for (int i = 0; i < 4; ++i) { const u32x4 w = p[i * 64 + F.lane]; s += (bflo(w.x) - bfhi(w.x)) + (bflo(w.y) - bfhi(w.y)) + (bflo(w.z) - bfhi(w.z)) + (bflo(w.w) - bfhi(w.w)); }
        s = wave_sum(s) * 0.001381067932004975f;
        if (F.lane == 0) FH1[(size_t)b * 1024 + g * 256 + m] = (bf16_t)f2bf(s); }
}
__device__ __forceinline__ void fnet_nyquist_out(Frame& F, const Args& a, int jl) {
    F.refresh();
    const bf16_t* FH1 = (const bf16_t*)(F.ws + WS_FH1); const bf16_t* W = (const bf16_t*)(F.ws + WS_WF) + (size_t)jl * 2048 * 1024; bf16_t* Y = (bf16_t*)a.out;
    LAS float* part = (LAS float*)F.lds;
    const int b = F.blk >> 3, n = (F.blk & 7) * 128 + (F.tid & 127), kq = F.tid >> 7;
    const GAS u32x4* wp = (const GAS u32x4*)(W + (size_t)n * 1024 + kq * 256); const GAS u32x4* fp = (const GAS u32x4*)(FH1 + (size_t)b * 1024 + kq * 256);
    float s = 0.f;
#pragma unroll 4
    for (int i = 0; i < 32; ++i) { const u32x4 w = wp[i], f = fp[i];
        s += bflo(w.x) * bflo(f.x) + bfhi(w.x) * bfhi(f.x) + bflo(w.y) * bflo(f.y) + bfhi(w.y) * bfhi(f.y) + bflo(w.z) * bflo(f.z) + bfhi(w.z) * bfhi(f.z) + bflo(w.w) * bflo(f.w) + bfhi(w.w) * bfhi(f.w); }
    part[F.tid] = s;
    __syncthreads();
    if (F.tid < 128) { const float t = (part[F.tid] + part[F.tid + 128]) + (part[F.tid + 256] + part[F.tid + 384]); Y[((size_t)b * SEQ + 1024) * D + n] = (bf16_t)f2bf(t); }
    __syncthreads();
}

#ifndef PH_MASK
#define PH_MASK 0xffffffffu
#endif
#define PH(b) ((PH_MASK >> (b)) & 1u)
__global__ void __launch_bounds__(NTHR, 2) fwd(Args a) {
    extern __shared__ __attribute__((aligned(16))) unsigned char lds_raw[];
    Frame F;
    F.lds = (LAS unsigned char*)lds_raw; F.ws = a.ws; F.ctl = (unsigned*)(a.ws + WS_CTL);
    F.blk = blockIdx.x; F.refresh();
    for (int u = F.tid; u < (LDS_BYTES - RING_BYTES) / 4; u += NTHR) ((LAS unsigned*)(F.lds + RING_BYTES))[u] = 0u;
    __syncthreads();
    const XcdBarrier bar = xcd_barrier_post(F.ctl + CW_BAR, (volatile LAS unsigned*)(F.lds + L_MISC) + 8);
#define GRID_BAR() xcd_barrier(bar)
    unsigned char* ws = a.ws;
    LAS unsigned char* ring = F.lds;
    const int c = F.blk;

    if (PH(0)) { conv_small(F, a);
    __syncthreads();
    mod_partials(F, a); }
    GRID_BAR();
    if (PH(1)) { rows_init(F, a);
    mod_finalize(F, a); }
    GRID_BAR();

    for (int layer = 0; layer < 4; ++layer) {
        const int jl = layer >> 1; const bool upd = layer < 2; const int nrows = upd ? TT : T;
        if ((layer & 1) == 0) {
            if (PH(2)) { SchedQKV S; S.U = (const char*)a.out; S.W = (const char*)(ws + WS_WQKV) + (size_t)jl * 1536 * 2048; S.nfull = (layer == 0) ? 288 * 6 : 256 * 6; S.nu = (layer == 0) ? 288 * 6 : 256 * 6 + 64; S.c = c;
              pg::EpiQKV E; E.Q = (bf16_t*)(ws + WS_Q); E.K = (bf16_t*)(ws + WS_K); E.V = (bf16_t*)(ws + WS_V); E.ropec = (const float*)(ws + WS_ROPEC); E.ropes = (const float*)(ws + WS_ROPES);
              pg::gemm_phase<pg::EpiQKV, SchedQKV, false>(ring, 2048u, 2048u, nullptr, S, E); }
            GRID_BAR();
            if (PH(3)) { const int NU = 4096 + (layer == 0 ? 512 : 0);
              const bf16_t* Qb = (const bf16_t*)(ws + WS_Q); const bf16_t* Kb = (const bf16_t*)(ws + WS_K); const bf16_t* Vb = (const bf16_t*)(ws + WS_V);
              for (int i = 0; i * GRID + c < NU; ++i) { const int id = pg::xcd_remap(i * GRID + c, NU);
                  if (id < 4096) { const int hq = id & 3, qb = (id >> 2) & 7, kvh = (id >> 5) & 3, b = id >> 7, h = kvh * 4 + hq;
                      attn::attn_unit(Qb, Kb, Vb, (bf16_t*)(ws + WS_Q), b, h, qb * 256, false, a.in[10][jl * 16 + h] * LOG2E, ring); }
                  else { const int cid = id - 4096, hq = cid & 3, kvh = (cid >> 2) & 3, b = cid >> 4, h = kvh * 4 + hq;
                      attn::attn_unit(Qb, Kb, Vb, (bf16_t*)(ws + WS_Q), b, h, 0, true, a.in[10][jl * 16 + h] * LOG2E, ring); } } }
            GRID_BAR();
            if (PH(4)) { SchedDense S; S.A = (const char*)(ws + WS_Q); S.W = (const char*)(ws + WS_WO) + (size_t)jl * 1024 * 2048; S.out = (char*)a.out; S.nrt = nrows / 256; S.nct = 4; S.nt = 16; S.c = c; S.ldA = 2048;
              pg::EpiStore E; pg::gemm_phase<pg::EpiStore, SchedDense, false>(ring, 2048u, 2048u, nullptr, S, E); }
            GRID_BAR();
        } else {
            if (PH(5)) { SchedF1 S; S.CS = (const char*)(ws + WS_CSN); S.U = (const char*)a.out; S.ABT = (char*)(ws + WS_ABT); S.ABTC = (char*)(ws + WS_ABTC); S.nu = 2048 + (upd ? 256 : 0); S.c = c;
              pg::EpiStore E; pg::gemm_phase<pg::EpiStore, SchedF1, false>(ring, 512u, 2048u, nullptr, S, E); }
            GRID_BAR();
            if (PH(6)) { SchedF2 S; S.DL = (const char*)(ws + WS_DL); S.ABT = (const char*)(ws + WS_ABT); S.FH = (char*)(ws + WS_FH); S.c = c;
              pg::EpiStore E; pg::gemm_phase<pg::EpiStore, SchedF2, false>(ring, 8192u, 8192u, nullptr, S, E); }
            if (PH(7) && upd) { SchedF2c S; S.DLC = (const char*)(ws + WS_DLC); S.ABTC = (const char*)(ws + WS_ABTC); S.FC = (char*)(ws + WS_FC); S.c = c;
              pg::EpiStore E; pg::gemm_phase<pg::EpiStore, SchedF2c, false>(ring, 1024u, 1024u, nullptr, S, E); }
            if (PH(8)) fnet_nyquist_rows(F);
            GRID_BAR();
            if (PH(9)) { SchedF3 S; S.FH = (const char*)(ws + WS_FH); S.FC = (const char*)(ws + WS_FC); S.W = (const char*)(ws + WS_WF) + (size_t)jl * 2048 * 2048; S.Y = (char*)a.out; S.nu = 1024 + (upd ? 128 : 0); S.c = c;
              pg::EpiStore E; pg::gemm_phase<pg::EpiStore, SchedF3, false>(ring, 2048u, 2048u, nullptr, S, E); }
            if (PH(10)) fnet_nyquist_out(F, a, jl);
            GRID_BAR();
        }
        if (PH(11)) rows_post1(F, a, layer, nrows);
        GRID_BAR();
        if (PH(12)) conv_experts(F, a.in[14], a.in[15], a.in[16], layer);
        __syncthreads();
        if (PH(13)) route_tokens(F, a, layer, nrows);
        GRID_BAR();
        if (PH(14)) build_lists(F, nrows);
        GRID_BAR();
        LAS const int* tstart = (LAS const int*)(F.lds + L_TSTART); LAS const unsigned char* tseg = (LAS const unsigned char*)(F.lds + L_TSEG);
        const int ntl = __builtin_amdgcn_readfirstlane(tstart[256]);
        const char* wsh = (const char*)(ws + WS_WSH) + (size_t)layer * 1536 * 1024;
        if (PH(15)) { SchedG1 S; S.EGU = (const char*)(ws + WS_EGU); S.WSG = wsh; S.STOK = (const int*)(ws + WS_STOK); S.H = (char*)(ws + WS_H); S.HS = (char*)(ws + WS_HS); S.tseg = tseg; S.ntl = ntl; S.nsh = nrows / 256; S.c = c;
          pg::EpiSilu E; pg::gemm_phase<pg::EpiSilu, SchedG1, true>(ring, 2048u, 2048u, (const char*)a.out, S, E); }
        GRID_BAR();
        const int CH = nrows / NCHUNK;
        for (int ch = 0; ch < NCHUNK; ++ch) {
            if (PH(16)) { SchedG2 S; S.ED = (const char*)(ws + WS_ED); S.WSD = wsh + 512 * 2048; S.H = (const char*)(ws + WS_H); S.HS = (const char*)(ws + WS_HS); S.SDST = (const int*)(ws + WS_SDST); S.SW = (const float*)(ws + WS_SW); S.YB = (char*)(ws + WS_YB); S.tseg = tseg;
              S.t0 = __builtin_amdgcn_readfirstlane(tstart[ch * 64]); S.t1 = __builtin_amdgcn_readfirstlane(tstart[ch * 64 + 64]); S.nsh = CH / 256; S.ch = ch; S.CH = CH; S.c = c;
              pg::EpiScatter E; pg::gemm_phase<pg::EpiScatter, SchedG2, false>(ring, 512u, 512u, nullptr, S, E); }
            GRID_BAR();
            if (PH(17)) rows_post2(F, a, layer, ch * CH, CH);
            if (!(layer == 3 && ch == NCHUNK - 1)) GRID_BAR();
        }
    }
}

extern "C" void kernel_launch(void* const* d_in, const int* in_sizes, int n_in, void* d_out, int out_size, void* d_ws, size_t ws_size, hipStream_t stream) {
    static int ready = 0;
    if (ready == 0) {
        if (n_in != 20 || out_size != T * D || ws_size < WS_END) { fprintf(stderr, "kernel_launch: unexpected problem (n_in %d out %d ws %zu need %zu)\n", n_in, out_size, ws_size, (size_t)WS_END); ready = -1; return; }
        if (hipFuncSetAttribute((const void*)fwd, hipFuncAttributeMaxDynamicSharedMemorySize, LDS_BYTES) != hipSuccess) { fprintf(stderr, "kernel_launch: hipFuncSetAttribute failed\n"); ready = -1; return; }
        int per_cu = 0;
        if (hipOccupancyMaxActiveBlocksPerMultiprocessor(&per_cu, (const void*)fwd, NTHR, LDS_BYTES) != hipSuccess || per_cu < 1) fprintf(stderr, "kernel_launch: occupancy query says %d blocks per CU\n", per_cu);
        (void)hipGetLastError();
        ready = 1;
    }
    if (ready < 0) return;
    (void)hipMemsetAsync((char*)d_ws + WS_CTL, 0, CTL_BYTES, stream);
    Args a{};
    for (int i = 0; i < 20; ++i) a.in[i] = (const float*)d_in[i];
    a.out = (float*)d_out; a.ws = (unsigned char*)d_ws;
    hipLaunchKernelGGL(fwd, dim3(GRID), dim3(NTHR), LDS_BYTES, stream, a);
}
```

```cpp
#include <hip/hip_runtime.h>
#include <cstdio>
#include <cstdint>

#define LAS __attribute__((address_space(3)))
#define GAS __attribute__((address_space(1)))
typedef unsigned short bf16_t;
typedef short bf16x8 __attribute__((ext_vector_type(8)));
typedef short s16x4 __attribute__((ext_vector_type(4)));
typedef float f32x4 __attribute__((ext_vector_type(4)));
typedef float f32x16 __attribute__((ext_vector_type(16)));
typedef unsigned u32x4 __attribute__((ext_vector_type(4)));
typedef unsigned u32x2 __attribute__((ext_vector_type(2)));

constexpr int D = 1024, NB = 32, SEQ = 2048, T = NB * SEQ, CTXL = 256, TC = NB * CTXL, TT = T + TC;
constexpr int NQKV = 1536, NE = 64;
constexpr float ALPHA = 1.681792830507429f;
constexpr float LN_EPS = 1e-5f, MOD_EPS = 1e-6f;
constexpr float C2 = 0.125f * 1.4426950408889634f;
constexpr float LOG2E = 1.4426950408889634f;
constexpr int NCHUNK = 4;
constexpr int NWAVES = 8, NTHR = 512, GRID = 256;

constexpr size_t MiB = 1u << 20;
constexpr size_t WS_CTL = 0, CTL_BYTES = 1 * MiB;
constexpr size_t WS_ROPEC = 1 * MiB, WS_ROPES = 1 * MiB + 4096, WS_CSN = 1 * MiB + 65536, WS_DLC = 1 * MiB + 524288, WS_DL = 2 * MiB;
constexpr size_t WS_WQKV = 10 * MiB, WS_WO = 16 * MiB, WS_WF = 20 * MiB, WS_WR = 28 * MiB, WS_WSH = 29 * MiB;
constexpr size_t WS_MODP = 36 * MiB, WS_MOD = 49 * MiB;
constexpr size_t WS_EGU = 54 * MiB, WS_ED = 118 * MiB;
constexpr size_t WS_XS = 150 * MiB;
constexpr size_t WS_STOK = 294 * MiB, WS_SDST = 297 * MiB, WS_SW = 300 * MiB, WS_TKE = 303 * MiB, WS_TKW = 306 * MiB;
constexpr size_t WS_R = 309 * MiB;
constexpr size_t WS_Q = WS_R, WS_K = WS_R + 144 * MiB, WS_V = WS_R + 180 * MiB;
constexpr size_t WS_ABT = WS_R, WS_FH = WS_R + 256 * MiB, WS_FH1 = WS_R + 320 * MiB, WS_ABTC = WS_R + 321 * MiB, WS_FC = WS_R + 353 * MiB;
constexpr size_t WS_H = WS_R, WS_HS = WS_R + 320 * MiB, WS_YB = WS_R + 356 * MiB, WS_YS = WS_R + 676 * MiB;
constexpr size_t WS_END = WS_YS + 36 * MiB;
constexpr int MAXROWS = 655360;

constexpr int CW_TMO = 0, CW_BAR = 4096, CW_BCNT = 16384;

constexpr int RING_BYTES = 131072;
constexpr int L_MISC = RING_BYTES;
constexpr int L_TSTART = RING_BYTES + 256;
constexpr int L_PREF = L_TSTART + 1040;
constexpr int L_LCNT = L_PREF + 256;
constexpr int L_TSEG = L_LCNT + 256;
constexpr int L_SCAN = L_TSEG + 2560;
constexpr int LDS_BYTES = 139264;
static_assert(L_SCAN + 1024 <= LDS_BYTES, "LDS map");

#define RLX_AGENT __ATOMIC_RELAXED, __HIP_MEMORY_SCOPE_AGENT
#define LDS_WAIT() asm volatile("s_waitcnt lgkmcnt(0)" ::: "memory")
#define VM_WAIT() asm volatile("s_waitcnt vmcnt(0)" ::: "memory")

__device__ __forceinline__ unsigned f2bf(float f) { unsigned u = __builtin_bit_cast(unsigned, f); return (u + 0x7fffu + ((u >> 16) & 1u)) >> 16; }
__device__ __forceinline__ unsigned pk2(float lo, float hi) { return f2bf(lo) | (f2bf(hi) << 16); }
typedef float f32x2_t __attribute__((ext_vector_type(2))); typedef __bf16 bf16x2_t __attribute__((ext_vector_type(2)));
__device__ __forceinline__ unsigned cvt_pk_bf16(float lo, float hi) { f32x2_t v = {lo, hi}; bf16x2_t b = __builtin_convertvector(v, bf16x2_t); return __builtin_bit_cast(unsigned, b); }
__device__ __forceinline__ float bflo(unsigned w) { return __builtin_bit_cast(float, w << 16); }
__device__ __forceinline__ float bfhi(unsigned w) { return __builtin_bit_cast(float, w & 0xffff0000u); }
__device__ __forceinline__ float wave_sum(float v) {
#pragma unroll
    for (int o = 1; o < 64; o <<= 1) v += __shfl_xor(v, o);
    return v;
}

__device__ __forceinline__ int opaque_tid() { int t = threadIdx.x; asm volatile("" : "+v"(t)); return t; }

#define XB_TMO      128
#define XB_XCNT(j)  (256  + 64 * (j))
#define XB_XSUB(j)  (1280 + 64 * (j))
#define XB_XGEN(j)  (2304 + 64 * (j))
#define XB_TOP      3328
#define XB_TOPGEN   3392
#define XCD_BAR_WORDS 3456
#define XB_SPIN_CAP (1u << 22)
__device__ __forceinline__ unsigned xb_ld(unsigned* p)              { return __hip_atomic_load(p, __ATOMIC_RELAXED, __HIP_MEMORY_SCOPE_AGENT); }
__device__ __forceinline__ unsigned xb_add(unsigned* p, unsigned v) { return __hip_atomic_fetch_add(p, v, __ATOMIC_RELAXED, __HIP_MEMORY_SCOPE_AGENT); }
__device__ __forceinline__ unsigned xb_xcc_id() { return (unsigned)__builtin_amdgcn_s_getreg((3 << 11) | 20) & 0xFu; }
#define XB_SPIN(cond, bar) do { unsigned _sp = 0; while (cond) { __builtin_amdgcn_s_sleep(1); \
    if ((++_sp & 255u) == 0u) { if (xb_ld(&(bar)[XB_TMO])) break; if (_sp > XB_SPIN_CAP) { atomicAdd(&(bar)[XB_TMO], 1u); break; } } } } while (0)
struct XcdBarrier { unsigned* bar; unsigned x; volatile LAS unsigned* st; };
__device__ __forceinline__ XcdBarrier xcd_barrier_post(unsigned* bar, volatile LAS unsigned* st) {
    XcdBarrier b; b.bar = bar; b.x = xb_xcc_id(); b.st = st;
    if (threadIdx.x == 0) (void)xb_add(&bar[XB_XCNT(b.x)], 1u);
    return b;
}
__device__ __forceinline__ void xcd_barrier_complete(unsigned* bar, unsigned x, unsigned& nloc, unsigned& nx) {
    const unsigned G = gridDim.x * gridDim.y * gridDim.z;
    unsigned sum, cnt, mine, sp = 0u;
    for (;;) {
        sum = 0u; cnt = 0u; mine = 0u;
#pragma unroll
        for (unsigned j = 0; j < 16; ++j) { const unsigned c = xb_ld(&bar[XB_XCNT(j)]); sum += c; cnt += (c > 0u) ? 1u : 0u; mine = (j == x) ? c : mine; }
        if (sum == G) break;
        __builtin_amdgcn_s_sleep(1);
        if ((++sp & 255u) == 0u) { if (xb_ld(&bar[XB_TMO])) break; if (sp > XB_SPIN_CAP) { atomicAdd(&bar[XB_TMO], 1u); break; } }
    }
    nloc = mine > 0u ? mine : 1u; nx = cnt > 0u ? cnt : 1u;
}
__device__ __forceinline__ void xcd_barrier(const XcdBarrier& b) {
    asm volatile("s_waitcnt vmcnt(0)" ::: "memory");
    __syncthreads();
    if (threadIdx.x == 0) {
        unsigned* bar = b.bar; unsigned bx = b.x; asm volatile("" : "+s"(bx));
        __builtin_amdgcn_s_waitcnt(0);
        unsigned nloc = b.st[0], nx = b.st[1];
        if (nloc == 0u) { xcd_barrier_complete(bar, bx, nloc, nx); b.st[0] = nloc; b.st[1] = nx; }
        const unsigned old = xb_add(&bar[XB_XSUB(bx)], 1u);
        const unsigned gen = old / nloc;
        if (old + 1u == (gen + 1u) * nloc) {
            __builtin_amdgcn_fence(__ATOMIC_RELEASE, "agent");
            asm volatile("s_waitcnt vmcnt(0)" ::: "memory");
            const unsigned og = xb_add(&bar[XB_TOP], 1u);
            const unsigned tg = og / nx;
            if (og + 1u == (tg + 1u) * nx) xb_add(&bar[XB_TOPGEN], 1u);
            else XB_SPIN(xb_ld(&bar[XB_TOPGEN]) == tg, bar);
            __builtin_amdgcn_fence(__ATOMIC_ACQUIRE, "agent");
            xb_add(&bar[XB_XGEN(bx)], 1u);
            asm volatile("s_waitcnt vmcnt(0)" ::: "memory");
        } else {
            XB_SPIN(xb_ld(&bar[XB_XGEN(bx)]) == gen, bar);
            __builtin_amdgcn_fence(__ATOMIC_ACQUIRE, "agent");
            asm volatile("s_waitcnt vmcnt(0)" ::: "memory");
        }
    }
    __syncthreads();
}

namespace pg {
constexpr int BM = 256, BK = 64, HALF = 128, HTB = HALF * BK * 2;
__host__ __device__ __forceinline__ int lds_byte(int r, int c) { const int st = (r >> 4) * 2 + (c >> 5), rr = r & 15, cc = c & 31, ob = rr * 64 + cc * 2; return st * 1024 + (ob ^ (((ob >> 9) & 1) << 5)); }
__host__ __device__ __forceinline__ void stage_rc(int b, int& R, int& C) { const int st = b / 1024, sb = b % 1024, swz = sb ^ (((sb >> 9) & 1) << 5); R = (st >> 1) * 16 + swz / 64; C = (st & 1) * 32 + (swz % 64) / 2; }
__host__ __device__ __forceinline__ int perm32(int rho) { const int n = rho >> 4, i = rho & 15; return 8 * (i >> 2) + 4 * n + (i & 3); }

struct Unit {
    const char* A;
    const char* B;
    const int* gidx;
    int gbase;
    int nt;
    char* out; int ldc; float scale; int flags; int i0; int i1;
    const int* l0; const float* l1;
};

template <class Epi, class Sched, bool GATHER>
__device__ __forceinline__ void gemm_phase(LAS unsigned char* lds, const unsigned lda, const unsigned ldb, const char* gtable, const Sched& S, const Epi& E) {
    const int tid = opaque_tid(), wid = __builtin_amdgcn_readfirstlane(tid >> 6), lane = tid & 63, wr = wid >> 2, wc = wid & 3, fr = lane & 15, fq = lane >> 4;
    unsigned voffA[2], voffB[2];
#pragma unroll
    for (int i = 0; i < 2; ++i) { int R, C; stage_rc(tid * 16 + i * 8192, R, C); const int Rb = (R & ~31) + perm32(R & 31);
        voffA[i] = (unsigned)R * lda + (unsigned)C * 2u; voffB[i] = (unsigned)Rb * ldb + (unsigned)C * 2u; }
    const size_t kstep = (size_t)(BK * 2);
    const size_t hstepA = (size_t)HALF * lda, hstepB = (size_t)HALF * ldb;
    const unsigned ldsw = (unsigned)wid * 1024u;
    const int aoff = lds_byte(wr * 64 + fr, fq * 8), boff = lds_byte(wc * 32 + fr, fq * 8);
#define PG_SA(b, h) (((b) * 2 + (h)) * HTB)
#define PG_SB(b, h) ((4 + (b) * 2 + (h)) * HTB)
#define PG_ST2(bufoff, p0, p1) do { \
        __builtin_amdgcn_global_load_lds((const unsigned*)(p0), (LAS unsigned*)(lds + (bufoff) + ldsw), 16, 0, 0); \
        __builtin_amdgcn_global_load_lds((const unsigned*)(p1), (LAS unsigned*)(lds + (bufoff) + ldsw + 8192), 16, 0, 0); } while (0)
#define PG_STB(bufoff, bp) PG_ST2(bufoff, (bp) + voffB[0], (bp) + voffB[1])
#define PG_STA(bufoff, ap, h, nx) do { if constexpr (GATHER) { PG_ST2(bufoff, (ap) + ((nx) ? nO[h][0] : cO[h][0]), (ap) + ((nx) ? nO[h][1] : cO[h][1])); } \
        else { PG_ST2(bufoff, (ap) + (h) * hstepA + voffA[0], (ap) + (h) * hstepA + voffA[1]); } } while (0)
#define PG_LDA(dst, b, h) do { _Pragma("unroll") for (int m = 0; m < 4; ++m) _Pragma("unroll") for (int k = 0; k < 2; ++k) dst[m][k] = *(const LAS bf16x8*)(lds + PG_SA(b, h) + aoff + m * 2048 + k * 1024); } while (0)
#define PG_LDB(dst, b, h) do { _Pragma("unroll") for (int n = 0; n < 2; ++n) _Pragma("unroll") for (int k = 0; k < 2; ++k) dst[n][k] = *(const LAS bf16x8*)(lds + PG_SB(b, h) + boff + n * 2048 + k * 1024); } while (0)
#define PG_MMA(ai, bj, At, Bt) do { __builtin_amdgcn_s_setprio(1); _Pragma("unroll") for (int m = 0; m < 4; ++m) _Pragma("unroll") for (int n = 0; n < 2; ++n) _Pragma("unroll") for (int k = 0; k < 2; ++k) \
        acc[ai][bj][m][n] = __builtin_amdgcn_mfma_f32_16x16x32_bf16(Bt[n][k], At[m][k], acc[ai][bj][m][n], 0, 0, 0); __builtin_amdgcn_s_setprio(0); } while (0)
#define PG_WAIT_V(n) asm volatile("s_waitcnt vmcnt(" #n ")" ::: "memory")
#define PG_WAIT_L(n) asm volatile("s_waitcnt lgkmcnt(" #n ")" ::: "memory")
#define PG_BAR __builtin_amdgcn_s_barrier()
#define PG_SCHED __builtin_amdgcn_sched_barrier(0)
#define PG_GOFF(dst, u) do { const int tz_ = opaque_tid(); _Pragma("unroll") for (int i = 0; i < 2; ++i) { int R_, C_; stage_rc(tz_ * 16 + i * 8192, R_, C_); \
        _Pragma("unroll") for (int h = 0; h < 2; ++h) { const int rr = h * HALF + R_; \
        const int ix = (u).gidx ? ((const GAS int*)(u).gidx)[rr] : (u).gbase + rr; dst[h][i] = (unsigned)ix * lda + (unsigned)C_ * 2u; } } } while (0)
    Unit cur, nxt; int ui = 0;
    if (!S.next(0, cur)) return;
    f32x4 acc[2][2][4][2];
#pragma unroll
    for (int a = 0; a < 2; ++a)
#pragma unroll
        for (int b = 0; b < 2; ++b)
#pragma unroll
            for (int m = 0; m < 4; ++m)
#pragma unroll
                for (int n = 0; n < 2; ++n) acc[a][b][m][n] = (f32x4){0.f, 0.f, 0.f, 0.f};
    bf16x8 At[4][2], B0[2][2], B1[2][2];
    unsigned cO[2][2] = {{0u, 0u}, {0u, 0u}}, nO[2][2] = {{0u, 0u}, {0u, 0u}};
    if constexpr (GATHER) { PG_GOFF(cO, cur); }
    const char* cA = GATHER ? gtable : cur.A; const char* cB = cur.B;
    PG_STB(PG_SB(0, 0), cB); PG_STB(PG_SB(0, 1), cB + hstepB); PG_STA(PG_SA(0, 0), cA, 0, false); PG_STA(PG_SA(0, 1), cA, 1, false);
    if (wr == 1) PG_BAR;
    PG_WAIT_V(2); PG_BAR;
    PG_STB(PG_SB(1, 0), cB + kstep); PG_STA(PG_SA(1, 0), cA + kstep, 0, false); PG_STB(PG_SB(1, 1), cB + hstepB + kstep);
    PG_WAIT_V(6); PG_BAR;
    for (;;) {
        const bool has_next = S.next(ui + 1, nxt);
        const int nt = cur.nt;
        if constexpr (GATHER) { if (has_next) { PG_GOFF(nO, nxt); } else {
#pragma unroll
            for (int h = 0; h < 2; ++h)
#pragma unroll
                for (int i = 0; i < 2; ++i) nO[h][i] = cO[h][i]; } }
        const char* nA = GATHER ? gtable : (has_next ? nxt.A : cA); const char* nB = has_next ? nxt.B : cB;
#pragma unroll 1
        for (int t = 0; t < nt; t += 2) {
            const bool last = (t == nt - 2);
            const char* a1 = cA + (size_t)(t + 1) * kstep;
            const char* a2 = last ? nA : cA + (size_t)(t + 2) * kstep; const char* b2 = last ? nB : cB + (size_t)(t + 2) * kstep;
            const char* a3 = a2 + kstep; const char* b3 = b2 + kstep;
            PG_LDB(B0, 0, 0); PG_LDB(B1, 0, 1); PG_SCHED; PG_LDA(At, 0, 0); PG_STA(PG_SA(1, 1), a1, 1, false);
            PG_WAIT_V(8); PG_WAIT_L(0); PG_BAR; PG_MMA(0, 0, At, B0); PG_MMA(0, 1, At, B1); PG_BAR; PG_SCHED;
            PG_LDA(At, 0, 1); PG_STB(PG_SB(0, 0), b2); PG_STB(PG_SB(0, 1), b2 + hstepB); PG_STA(PG_SA(0, 0), a2, 0, last);
            PG_WAIT_V(8); PG_WAIT_L(0); PG_BAR; PG_MMA(1, 0, At, B0); PG_MMA(1, 1, At, B1); PG_BAR; PG_SCHED;
            PG_LDB(B0, 1, 0); PG_LDB(B1, 1, 1); PG_SCHED; PG_LDA(At, 1, 0); PG_STA(PG_SA(0, 1), a2, 1, last);
            PG_WAIT_V(8); PG_WAIT_L(0); PG_BAR; PG_MMA(0, 0, At, B0); PG_MMA(0, 1, At, B1); PG_BAR; PG_SCHED;
            PG_LDA(At, 1, 1); PG_STB(PG_SB(1, 0), b3); PG_STB(PG_SB(1, 1), b3 + hstepB); PG_STA(PG_SA(1, 0), a3, 0, last);
            PG_WAIT_V(8); PG_WAIT_L(0); PG_BAR; PG_MMA(1, 0, At, B0); PG_MMA(1, 1, At, B1); PG_BAR; PG_SCHED;
        }
        if (wr == 0) PG_BAR;
        E(acc, cur, wr, wc, fr, fq);
        if (!has_next) break;
#pragma unroll
        for (int a = 0; a < 2; ++a)
#pragma unroll
            for (int b = 0; b < 2; ++b)
#pragma unroll
                for (int m = 0; m < 4; ++m)
#pragma unroll
                    for (int n = 0; n < 2; ++n) acc[a][b][m][n] = (f32x4){0.f, 0.f, 0.f, 0.f};
        cur = nxt; cA = nA; cB = nB; ++ui;
        if constexpr (GATHER) {
#pragma unroll
            for (int h = 0; h < 2; ++h)
#pragma unroll
                for (int i = 0; i < 2; ++i) cO[h][i] = nO[h][i]; }
        if (wr == 1) PG_BAR;
    }
    PG_WAIT_V(0);
    PG_BAR;
#undef PG_SA
#undef PG_SB
#undef PG_ST2
#undef PG_STB
#undef PG_STA
#undef PG_LDA
#undef PG_LDB
#undef PG_MMA
#undef PG_WAIT_V
#undef PG_WAIT_L
#undef PG_BAR
#undef PG_SCHED
#undef PG_GOFF
}

struct EpiStore {
    __device__ __forceinline__ void operator()(const f32x4 (&acc)[2][2][4][2], const Unit& u, int wr, int wc, int fr, int fq) const {
        const float s = u.scale;
#pragma unroll
        for (int ai = 0; ai < 2; ++ai)
#pragma unroll
            for (int m = 0; m < 4; ++m) { const int row = ai * HALF + wr * 64 + m * 16 + fr;
                char* rowp = u.out + (ptrdiff_t)row * u.ldc + (wc * 32 + 8 * fq) * 2;
                if (!((u.flags & 1) && row == 0)) {
#pragma unroll
                for (int bj = 0; bj < 2; ++bj) { const f32x4 v0 = acc[ai][bj][m][0] * s, v1 = acc[ai][bj][m][1] * s;
                    u32x4 w; w.x = cvt_pk_bf16(v0[0], v0[1]); w.y = cvt_pk_bf16(v0[2], v0[3]); w.z = cvt_pk_bf16(v1[0], v1[1]); w.w = cvt_pk_bf16(v1[2], v1[3]);
                    *(u32x4*)(rowp + bj * 256) = w; } } }
    }
};
struct EpiQKV {
    bf16_t* Q; bf16_t* K; bf16_t* V; const float* ropec; const float* ropes;
    __device__ __forceinline__ void operator()(const f32x4 (&acc)[2][2][4][2], const Unit& u, int wr, int wc, int fr, int fq) const {
        const int pm = u.i0, pn = u.i1; const bool lat = pm < (T / 256); const bool rope = lat && pn < 5;
        const float qs = pn < 4 ? C2 : 1.f;
        const int part = wc & 1;
        const int fi0 = 8 * (fq & 1);
        const float sgn = (fq < 2) ? -1.f : 1.f;
#pragma unroll
        for (int ai = 0; ai < 2; ++ai)
#pragma unroll
            for (int m = 0; m < 4; ++m) { const int row = ai * HALF + wr * 64 + m * 16 + fr; const int tok = pm * 256 + row;
                const int tl = tok & (SEQ - 1); const int pos = part ? (tl & 63) : (tl >> 6);
                f32x4 c0 = {1.f, 1.f, 1.f, 1.f}, c1 = c0, s0 = {0.f, 0.f, 0.f, 0.f}, s1 = s0;
                if (rope) { c0 = *(const f32x4*)(ropec + pos * 16 + fi0); c1 = *(const f32x4*)(ropec + pos * 16 + fi0 + 4); s0 = *(const f32x4*)(ropes + pos * 16 + fi0); s1 = *(const f32x4*)(ropes + pos * 16 + fi0 + 4); }
#pragma unroll
                for (int bj = 0; bj < 2; ++bj) { f32x4 v0 = acc[ai][bj][m][0], v1 = acc[ai][bj][m][1];
                    if (rope) { f32x4 p0, p1;
#pragma unroll
                        for (int j = 0; j < 4; ++j) { p0[j] = __shfl_xor(v0[j], 32); p1[j] = __shfl_xor(v1[j], 32); }
                        v0 = v0 * c0 + (p0 * sgn) * s0; v1 = v1 * c1 + (p1 * sgn) * s1; }
                    v0 = v0 * qs; v1 = v1 * qs;
                    u32x4 w; w.x = cvt_pk_bf16(v0[0], v0[1]); w.y = cvt_pk_bf16(v0[2], v0[3]); w.z = cvt_pk_bf16(v1[0], v1[1]); w.w = cvt_pk_bf16(v1[2], v1[3]);
                    const int col = bj * HALF + wc * 32 + 8 * fq;
                    bf16_t* dst = pn < 4 ? Q + (size_t)tok * 1024 + pn * 256 + col : (pn == 4 ? K + (size_t)tok * 256 + col : V + (size_t)tok * 256 + col);
                    *(u32x4*)dst = w; } }
    }
};
struct EpiSilu {
    __device__ __forceinline__ void operator()(const f32x4 (&acc)[2][2][4][2], const Unit& u, int wr, int wc, int fr, int fq) const {
#pragma unroll
        for (int ai = 0; ai < 2; ++ai)
#pragma unroll
            for (int m = 0; m < 4; ++m) { const int row = ai * HALF + wr * 64 + m * 16 + fr;
                float h[8];
#pragma unroll
                for (int n = 0; n < 2; ++n)
#pragma unroll
                    for (int j = 0; j < 4; ++j) { const float g = acc[ai][0][m][n][j], up = acc[ai][1][m][n][j]; h[n * 4 + j] = g / (1.f + __expf(-g)) * up; }
                u32x4 w; w.x = cvt_pk_bf16(h[0], h[1]); w.y = cvt_pk_bf16(h[2], h[3]); w.z = cvt_pk_bf16(h[4], h[5]); w.w = cvt_pk_bf16(h[6], h[7]);
                *(u32x4*)(u.out + (size_t)row * 512 + (wc * 32 + 8 * fq) * 2) = w; }
    }
};
struct EpiScatter {
    __device__ __forceinline__ void operator()(const f32x4 (&acc)[2][2][4][2], const Unit& u, int wr, int wc, int fr, int fq) const {
#pragma unroll
        for (int ai = 0; ai < 2; ++ai)
#pragma unroll
            for (int m = 0; m < 4; ++m) { const int row = ai * HALF + wr * 64 + m * 16 + fr;
                int dst; float w;
                if (u.l0) { dst = u.l0[row]; w = u.l1[row]; } else { dst = (u.i0 + row) * 9 + 8; w = 1.f; }
                if (dst >= 0) { char* rowp = u.out + (size_t)dst * 2048 + (wc * 32 + 8 * fq) * 2;
#pragma unroll
                    for (int bj = 0; bj < 2; ++bj) { const f32x4 v0 = acc[ai][bj][m][0] * w, v1 = acc[ai][bj][m][1] * w;
                        u32x4 o; o.x = cvt_pk_bf16(v0[0], v0[1]); o.y = cvt_pk_bf16(v0[2], v0[3]); o.z = cvt_pk_bf16(v1[0], v1[1]); o.w = cvt_pk_bf16(v1[2], v1[3]);
                        *(u32x4*)(rowp + bj * 256) = o; } } }
    }
};
__device__ __forceinline__ int xcd_remap(int L0, int NU) { const int q = NU >> 3, r = NU & 7, x = L0 & 7, off = L0 >> 3; return (x < r ? x * (q + 1) : r * (q + 1) + (x - r) * q) + off; }
}

namespace attn {
constexpr int SLOTB = 8192;
constexpr int LDS_K = 0, LDS_V = 2 * SLOTB, LDS_WS = 4 * SLOTB, LDS_OST = LDS_WS + NWAVES * 256, LDS_END = LDS_OST + NWAVES * 4096;
static_assert(LDS_END <= RING_BYTES, "attention LDS");
__device__ __forceinline__ int crow(int r, int hi) { return (r & 3) + 8 * (r >> 2) + 4 * hi; }
__device__ __forceinline__ void glds16(const void* gsrc, unsigned lds_dst) { unsigned keep;
    asm volatile("s_mov_b32 %0, m0\n\ts_mov_b32 m0, %2\n\ts_nop 0\n\tglobal_load_lds_dwordx4 %1, off\n\ts_mov_b32 m0, %0" : "=&s"(keep) : "v"(gsrc), "s"(lds_dst) : "memory"); }
__device__ __forceinline__ float rowmax(const f32x16& p0, const f32x16& p1) {
    float a = fmaxf(p0[0], p1[0]);
#pragma unroll
    for (int r = 1; r < 16; ++r) a = fmaxf(a, fmaxf(p0[r], p1[r]));
    auto rr = __builtin_amdgcn_permlane32_swap(__float_as_uint(a), __float_as_uint(a), false, false);
    return fmaxf(__uint_as_float(rr[0]), __uint_as_float(rr[1]));
}
typedef short v4i16_t __attribute__((ext_vector_type(4)));
__device__ __forceinline__ s16x4 vtr(const LAS unsigned char* p) { return __builtin_bit_cast(s16x4, __builtin_amdgcn_ds_read_tr16_b64_v4i16((LAS v4i16_t*)p)); }
__device__ __forceinline__ void pv(f32x16* o, const LAS unsigned char* vp, bf16x8 pa0, bf16x8 pa1, bf16x8 pa2, bf16x8 pa3) {
#pragma unroll
    for (int d0 = 0; d0 < 2; ++d0) { s16x4 lo[4], hi[4];
#pragma unroll
        for (int ks = 0; ks < 4; ++ks) { lo[ks] = vtr(vp + d0 * 4096 + ks * 1024); hi[ks] = vtr(vp + d0 * 4096 + ks * 1024 + 512); }
#define PK(k) (bf16x8){lo[k][0], lo[k][1], lo[k][2], lo[k][3], hi[k][0], hi[k][1], hi[k][2], hi[k][3]}
        o[d0] = __builtin_amdgcn_mfma_f32_32x32x16_bf16(pa0, PK(0), o[d0], 0, 0, 0);
        o[d0] = __builtin_amdgcn_mfma_f32_32x32x16_bf16(pa1, PK(1), o[d0], 0, 0, 0);
        o[d0] = __builtin_amdgcn_mfma_f32_32x32x16_bf16(pa2, PK(2), o[d0], 0, 0, 0);
        o[d0] = __builtin_amdgcn_mfma_f32_32x32x16_bf16(pa3, PK(3), o[d0], 0, 0, 0);
#undef PK
    }
}
__device__ __forceinline__ void attn_unit(const bf16_t* Q, const bf16_t* K, const bf16_t* V, bf16_t* O, int b, int h, int q0, bool isctx, float sink2, LAS unsigned char* shm) {
    const int tid = opaque_tid(), lane = tid & 63, r32 = lane & 31, hi = lane >> 5; const int wid = __builtin_amdgcn_readfirstlane(tid >> 6);
    const int kvh = h >> 2;
    const long qrow = isctx ? (long)T + b * CTXL + wid * 32 : (long)b * SEQ + q0 + wid * 32;
    const unsigned lds0 = (unsigned)(uintptr_t)shm;
    LAS float* wsf = (LAS float*)(shm + LDS_WS) + wid * 64;
    int jlo = 0, nl = 0;
    if (!isctx) { jlo = (q0 == 0) ? 2 : 0; int jhi = (SEQ - q0 + 128) / 64; if (jhi > 8) jhi = 8; nl = jhi - jlo; }
    const int NT = nl + 4;
    const long lat0 = (long)b * SEQ + q0 - 128 + 64 * jlo, ctx0 = (long)T + b * CTXL;
#define TROW(t) ((t) < nl ? lat0 + 64 * (t) : ctx0 + 64 * ((t) - nl))
    const int kcol = kvh * 64 + wid * 8, vcol = kvh * 64 + (wid >> 2) * 32 + (lane & 3) * 8, vrow = 16 * (wid & 3) + (lane >> 2);
    const unsigned kdst = lds0 + LDS_K + wid * 1024, vdst = lds0 + LDS_V + wid * 1024;
#define DMA_KV(t, slot) do { const long tr_ = TROW(t); glds16(K + (tr_ + lane) * 256 + kcol, (unsigned)__builtin_amdgcn_readfirstlane(kdst + (slot) * SLOTB)); \
        glds16(V + (tr_ + vrow) * 256 + vcol, (unsigned)__builtin_amdgcn_readfirstlane(vdst + (slot) * SLOTB)); } while (0)
    DMA_KV(0, 0);
    bf16x8 qr[4];
#pragma unroll
    for (int d0 = 0; d0 < 4; ++d0) qr[d0] = *(const GAS bf16x8*)(Q + (qrow + r32) * 1024 + h * 64 + d0 * 16 + hi * 8);
    float mrun = sink2, l_reg = (hi == 0) ? 1.f : 0.f;
    f32x16 o[2];
#pragma unroll
    for (int r = 0; r < 16; ++r) { o[0][r] = 0.f; o[1][r] = 0.f; }
    const LAS unsigned char* vp0 = shm + LDS_V + ((lane >> 4) & 1) * 32 + (lane & 3) * 8 + (4 * hi + ((lane & 15) >> 2)) * 64;
    const int qw = q0 + wid * 32;
    asm volatile("s_waitcnt vmcnt(0) lgkmcnt(0)\n\ts_barrier" ::: "memory");
    for (int t = 0; t < NT; ++t) {
        const int slot = t & 1;
        if (t + 1 < NT) DMA_KV(t + 1, slot ^ 1);
        const bool latt = t < nl;
        const int ks = q0 - 128 + 64 * (jlo + t);
        bool need = true;
        if (latt) need = (ks + 63 >= qw - 128) && (ks <= qw + 31 + 128);
        if (need) {
            f32x16 p0, p1;
#pragma unroll
            for (int r = 0; r < 16; ++r) { p0[r] = 0.f; p1[r] = 0.f; }
            const LAS unsigned char* kb = shm + LDS_K + slot * SLOTB + hi * 1024 + r32 * 16;
#pragma unroll
            for (int d0 = 0; d0 < 4; ++d0) {
                const bf16x8 b0 = *(const LAS bf16x8*)(kb + d0 * 2048), b1 = *(const LAS bf16x8*)(kb + d0 * 2048 + 512);
                p0 = __builtin_amdgcn_mfma_f32_32x32x16_bf16(b0, qr[d0], p0, 0, 0, 0);
                p1 = __builtin_amdgcn_mfma_f32_32x32x16_bf16(b1, qr[d0], p1, 0, 0, 0); }
            if (latt) { const int dq = qw + r32 - ks;
#pragma unroll
                for (int r = 0; r < 16; ++r) { const int d = dq - crow(r, hi); if (d > 128 || d < -128) p0[r] = -INFINITY; if (d - 32 > 128 || d - 32 < -128) p1[r] = -INFINITY; } }
            const float rm = rowmax(p0, p1);
            const float mnew = fmaxf(mrun, rm);
            if (__any(mnew > mrun)) {
                const float alpha = __builtin_amdgcn_exp2f(mrun - mnew); l_reg *= alpha; mrun = mnew;
                if (hi == 0) wsf[r32] = alpha;
                asm volatile("s_waitcnt lgkmcnt(0)" ::: "memory");
#pragma unroll
                for (int r = 0; r < 16; ++r) { const float f = wsf[crow(r, hi)]; o[0][r] *= f; o[1][r] *= f; }
            }
            float sacc = 0.f;
#pragma unroll
            for (int r = 0; r < 16; ++r) { p0[r] = __builtin_amdgcn_exp2f(p0[r] - mrun); p1[r] = __builtin_amdgcn_exp2f(p1[r] - mrun); sacc += p0[r] + p1[r]; }
            l_reg += sacc;
            u32x4 pw0, pw1, pw2, pw3;
#define PKW(P, B) cvt_pk_bf16(P[B], P[B + 1])
            pw0 = (u32x4){PKW(p0, 0), PKW(p0, 2), PKW(p0, 4), PKW(p0, 6)}; pw1 = (u32x4){PKW(p0, 8), PKW(p0, 10), PKW(p0, 12), PKW(p0, 14)};
            pw2 = (u32x4){PKW(p1, 0), PKW(p1, 2), PKW(p1, 4), PKW(p1, 6)}; pw3 = (u32x4){PKW(p1, 8), PKW(p1, 10), PKW(p1, 12), PKW(p1, 14)};
#undef PKW
            __builtin_amdgcn_sched_barrier(0);
            pv(o, vp0 + slot * SLOTB, __builtin_bit_cast(bf16x8, pw0), __builtin_bit_cast(bf16x8, pw1), __builtin_bit_cast(bf16x8, pw2), __builtin_bit_cast(bf16x8, pw3));
        }
        asm volatile("s_waitcnt vmcnt(0) lgkmcnt(0)\n\ts_barrier" ::: "memory");
    }
    { auto rr = __builtin_amdgcn_permlane32_swap(__float_as_uint(l_reg), __float_as_uint(l_reg), false, false); l_reg = __uint_as_float(rr[0]) + __uint_as_float(rr[1]); }
    if (hi == 0) wsf[32 + r32] = l_reg;
    asm volatile("s_waitcnt lgkmcnt(0)" ::: "memory");
    float rli[16];
#pragma unroll
    for (int r = 0; r < 16; ++r) rli[r] = __builtin_amdgcn_rcpf(wsf[32 + crow(r, hi)]);
    bf16_t* Ow = O + qrow * 1024 + h * 64;
    { LAS bf16_t* stg = (LAS bf16_t*)(shm + LDS_OST) + wid * 2048;
#pragma unroll
      for (int r = 0; r < 16; ++r) { const int orow = crow(r, hi);
#pragma unroll
          for (int d0 = 0; d0 < 2; ++d0) stg[orow * 64 + d0 * 32 + r32] = (bf16_t)f2bf(o[d0][r] * rli[r]); }
      asm volatile("s_waitcnt lgkmcnt(0)" ::: "memory");
#pragma unroll
      for (int i = 0; i < 4; ++i) { const int row = i * 8 + (lane >> 3), ch = lane & 7; const u32x4 v = *(const LAS u32x4*)(stg + row * 64 + ch * 8); *(GAS u32x4*)(Ow + (long)row * 1024 + ch * 8) = v; } }
    asm volatile("s_waitcnt lgkmcnt(0)" ::: "memory");
#undef TROW
#undef DMA_KV
}
}

struct Args {
    const float* in[20];
    float* out; unsigned char* ws;
};
struct Frame {
    LAS unsigned char* lds; unsigned* ctl; unsigned char* ws;
    int tid, lane, wave, gw;
    int blk;
    __device__ __forceinline__ void refresh() { tid = opaque_tid(); lane = tid & 63; wave = __builtin_amdgcn_readfirstlane(tid >> 6); gw = blk * 8 + wave;
        asm volatile("" : "+s"(ws)); ctl = (unsigned*)(ws + WS_CTL); }
};
constexpr int NGW = GRID * NWAVES;

struct Row { f32x4 v[4]; };
__device__ __forceinline__ int vq(int q, int lane) { return 128 * (q >> 1) + 2 * lane + (q & 1); }
__device__ __forceinline__ void row_load_bf16(Row& r, const bf16_t* p, int lane) {
#pragma unroll
    for (int j = 0; j < 2; ++j) { const u32x4 w = ((const GAS u32x4*)p)[64 * j + lane]; r.v[2 * j] = (f32x4){bflo(w.x), bfhi(w.x), bflo(w.y), bfhi(w.y)}; r.v[2 * j + 1] = (f32x4){bflo(w.z), bfhi(w.z), bflo(w.w), bfhi(w.w)}; } }
__device__ __forceinline__ void row_store_bf16(const Row& r, bf16_t* p, int lane) {
#pragma unroll
    for (int j = 0; j < 2; ++j) { u32x4 w; w.x = pk2(r.v[2 * j][0], r.v[2 * j][1]); w.y = pk2(r.v[2 * j][2], r.v[2 * j][3]); w.z = pk2(r.v[2 * j + 1][0], r.v[2 * j + 1][1]); w.w = pk2(r.v[2 * j + 1][2], r.v[2 * j + 1][3]); ((GAS u32x4*)p)[64 * j + lane] = w; } }
__device__ __forceinline__ void row_load_f32(Row& r, const float* p, int lane) {
#pragma unroll
    for (int q = 0; q < 4; ++q) r.v[q] = ((const GAS f32x4*)p)[vq(q, lane)]; }
__device__ __forceinline__ void row_store_f32(const Row& r, float* p, int lane) {
#pragma unroll
    for (int q = 0; q < 4; ++q) ((GAS f32x4*)p)[vq(q, lane)] = r.v[q]; }
__device__ __forceinline__ void row_normalize(Row& r, float eps) {
    float s = 0.f;
#pragma unroll
    for (int j = 0; j < 4; ++j) s += (r.v[j][0] + r.v[j][1]) + (r.v[j][2] + r.v[j][3]);
    const float mean = wave_sum(s) * (1.f / D); float q = 0.f;
#pragma unroll
    for (int j = 0; j < 4; ++j) { r.v[j] = r.v[j] - mean; q += (r.v[j][0] * r.v[j][0] + r.v[j][1] * r.v[j][1]) + (r.v[j][2] * r.v[j][2] + r.v[j][3] * r.v[j][3]); }
    const float rstd = 1.f / sqrtf(wave_sum(q) * (1.f / D) + eps);
#pragma unroll
    for (int j = 0; j < 4; ++j) r.v[j] = r.v[j] * rstd;
}
__device__ __forceinline__ void row_modulate(Row& r, const float* sh, const float* sc, int lane) {
    row_normalize(r, MOD_EPS);
#pragma unroll
    for (int j = 0; j < 4; ++j) { const f32x4 a = ((const GAS f32x4*)sc)[vq(j, lane)], b = ((const GAS f32x4*)sh)[vq(j, lane)]; r.v[j] = r.v[j] * (a + 1.f) + b; }
}
__device__ __forceinline__ int mod_row(int row) { return row < T ? (row >> 11) : 32; }
__device__ __forceinline__ const float* mod_vec(const unsigned char* ws, int layer, int mr, int chunk) { return (const float*)(ws + WS_MOD) + ((size_t)(layer * 33 + mr) * 6 + chunk) * 1024; }

__device__ __forceinline__ void conv_item(const float* W, int N, bf16_t* WT, int Kd, int kd0, int n0, int drow0, bool mirror, LAS float* scr, int lane) {
#pragma unroll 8
    for (int i = 0; i < 32; ++i) { const int kk = 2 * i + (lane >> 5); const int kd = kd0 + kk; const int ks = mirror ? ((kd & ~255) + ((256 - (kd & 255)) & 255)) : kd;
        scr[kk * 33 + (lane & 31)] = ((const GAS float*)W)[(size_t)ks * N + n0 + (lane & 31)]; }
    LDS_WAIT(); asm volatile("" ::: "memory");
    const int c = lane & 7;
#pragma unroll
    for (int j = 0; j < 4; ++j) { const int n = (lane >> 3) + 8 * j; const LAS float* s = scr + (8 * c) * 33 + n;
        u32x4 o; o.x = pk2(s[0 * 33], s[1 * 33]); o.y = pk2(s[2 * 33], s[3 * 33]); o.z = pk2(s[4 * 33], s[5 * 33]); o.w = pk2(s[6 * 33], s[7 * 33]);
        *(GAS u32x4*)(WT + (size_t)(drow0 + n) * Kd + kd0 + 8 * c) = o; }
    LDS_WAIT(); asm volatile("" ::: "memory");
}
__device__ __forceinline__ void conv_matrix_item(const float* W, int K, int N, bf16_t* WT, int mode, int roff, int item, LAS float* scr, int lane) {
    const int nblk = N / 32, kb = item / nblk, nb = item % nblk, n0 = 32 * nb;
    int drow0 = n0 + roff; if (mode == 1) drow0 = (n0 >> 7) * 256 + (n0 & 127); if (mode == 2) drow0 = (n0 >> 7) * 256 + 128 + (n0 & 127);
    conv_item(W, N, WT, K, 64 * kb, n0, drow0, mode == 3, scr, lane);
}
__device__ __forceinline__ void conv_item64(const float* W, int N, bf16_t* WT, int Kd, int k0, int n0, int drow0, LAS bf16_t* scr, int lane) {
    f32x4 v[16];
#pragma unroll
    for (int i = 0; i < 16; ++i) v[i] = *(const GAS f32x4*)(W + (size_t)(k0 + 4 * i + (lane >> 4)) * N + n0 + (lane & 15) * 4);
#pragma unroll
    for (int i = 0; i < 16; ++i) { u32x2 w; w.x = pk2(v[i][0], v[i][1]); w.y = pk2(v[i][2], v[i][3]); *(LAS u32x2*)(scr + (4 * i + (lane >> 4)) * 68 + (lane & 15) * 4) = w; }
    LDS_WAIT(); asm volatile("" ::: "memory");
    const int c = lane & 7;
#pragma unroll
    for (int j = 0; j < 8; ++j) { const int n = (lane >> 3) + 8 * j; const LAS bf16_t* p = scr + (8 * c) * 68 + n;
        u32x4 o; o.x = (unsigned)p[0] | ((unsigned)p[68] << 16); o.y = (unsigned)p[2 * 68] | ((unsigned)p[3 * 68] << 16); o.z = (unsigned)p[4 * 68] | ((unsigned)p[5 * 68] << 16); o.w = (unsigned)p[6 * 68] | ((unsigned)p[7 * 68] << 16);
        *(GAS u32x4*)(WT + (size_t)(drow0 + n) * Kd + k0 + 8 * c) = o; }
    LDS_WAIT(); asm volatile("" ::: "memory");
}
__device__ __forceinline__ void conv_experts(Frame& F, const float* wg, const float* wu, const float* wd, int layer) {
    F.refresh();
    LAS bf16_t* scr = (LAS bf16_t*)(F.lds + 32768 + F.wave * 8704);
    bf16_t* EGU = (bf16_t*)(F.ws + WS_EGU); bf16_t* ED = (bf16_t*)(F.ws + WS_ED);
    for (int it = F.gw; it < NE * 192; it += NGW) { const int e = it / 192, r = it % 192;
        const size_t eo = ((size_t)layer * NE + e) * (1024 * 256);
        if (r < 128) { const int q = r & 63, kb = q >> 2, nb = q & 3, n0 = 64 * nb; const int drow0 = (n0 >> 7) * 256 + (r < 64 ? 0 : 128) + (n0 & 127);
            conv_item64((r < 64 ? wg : wu) + eo, 256, EGU + (size_t)e * 512 * 1024, 1024, 64 * kb, n0, drow0, scr, F.lane); }
        else { const int q = r - 128, kb = q >> 4, nb = q & 15; conv_item64(wd + eo, 1024, ED + (size_t)e * 1024 * 256, 256, 64 * kb, 64 * nb, 64 * nb, scr, F.lane); } }
}
__device__ __forceinline__ void conv_small(Frame& F, const Args& a) {
    F.refresh();
    LAS float* scr = (LAS float*)(F.lds + 32768 + F.wave * 8448);
    for (int it = F.gw; it < 6272; it += NGW) {
        if (it < 1536) { const int j = it / 768, r = it % 768; conv_matrix_item(a.in[8] + (size_t)j * 1024 * 1536, 1024, 1536, (bf16_t*)(F.ws + WS_WQKV) + (size_t)j * 1536 * 1024, 0, 0, r, scr, F.lane); }
        else if (it < 2560) { const int q = it - 1536, j = q / 512, r = q % 512; conv_matrix_item(a.in[9] + (size_t)j * 1024 * 1024, 1024, 1024, (bf16_t*)(F.ws + WS_WO) + (size_t)j * 1024 * 1024, 0, 0, r, scr, F.lane); }
        else if (it < 4608) { const int q = it - 2560, j = q / 1024, r = q % 1024; bf16_t* dst = (bf16_t*)(F.ws + WS_WF) + (size_t)j * 2048 * 1024;
            if (r < 512) conv_matrix_item(a.in[11] + (size_t)j * 1024 * 1024, 1024, 1024, dst, 0, 0, r, scr, F.lane);
            else conv_matrix_item(a.in[11] + (size_t)j * 1024 * 1024, 1024, 1024, dst, 3, 1024, r - 512, scr, F.lane); }
        else if (it < 4736) { const int q = it - 4608, l = q / 32, r = q % 32; conv_matrix_item(a.in[12] + (size_t)l * 1024 * 64, 1024, 64, (bf16_t*)(F.ws + WS_WR) + (size_t)l * 64 * 1024, 0, 0, r, scr, F.lane); }
        else { const int q = it - 4736, l = q / 384, r = q % 384; bf16_t* gu = (bf16_t*)(F.ws + WS_WSH + (size_t)l * 1536 * 1024); bf16_t* dn = gu + 512 * 1024;
            if (r < 128) conv_matrix_item(a.in[17] + (size_t)l * 1024 * 256, 1024, 256, gu, 1, 0, r, scr, F.lane);
            else if (r < 256) conv_matrix_item(a.in[18] + (size_t)l * 1024 * 256, 1024, 256, gu, 2, 0, r - 128, scr, F.lane);
            else conv_matrix_item(a.in[19] + (size_t)l * 256 * 1024, 256, 1024, dn, 0, 0, r - 256, scr, F.lane); }
    }
    const int gt = F.blk * NTHR + F.tid, NGT = GRID * NTHR;
    const float TWO_PI = 6.283185307179586f;
    { float* rc = (float*)(F.ws + WS_ROPEC); float* rs = (float*)(F.ws + WS_ROPES);
      for (int i = gt; i < 64 * 16; i += NGT) { const int pos = i >> 4, fi = i & 15; const float inv = exp2f(-(float)fi * (13.287712379549449f / 16.f)); const float ang = (float)pos * inv; rc[i] = cosf(ang); rs[i] = sinf(ang); } }
    { bf16_t* cs = (bf16_t*)(F.ws + WS_CSN);
      for (int i = gt; i < 512 * 256; i += NGT) { const int r = i >> 8, n = i & 255, m = r & 255; const float ang = TWO_PI * (float)((m * n) & 255) * (1.f / 256.f); cs[i] = (bf16_t)f2bf(r < 256 ? cosf(ang) : -sinf(ang)); } }
    { bf16_t* dl = (bf16_t*)(F.ws + WS_DL);
      for (int i = gt; i < 1024 * 4096; i += NGT) { const int k = i >> 12, c = i & 4095, l = c & 2047; const float ang = TWO_PI * (float)((k * l) & 2047) * (1.f / 2048.f); dl[i] = (bf16_t)f2bf(c < 2048 ? cosf(ang) : sinf(ang)); } }
    { bf16_t* dl = (bf16_t*)(F.ws + WS_DLC);
      for (int i = gt; i < 256 * 512; i += NGT) { const int k = i >> 9, c = i & 511, l = c & 255; const float ang = TWO_PI * (float)((k * l) & 255) * (1.f / 256.f); dl[i] = (bf16_t)f2bf(c < 256 ? cosf(ang) : sinf(ang)); } }
}
__device__ __forceinline__ void mod_partials(Frame& F, const Args& a) {
    F.refresh();
    if (F.blk >= 192) return;
    const int l = F.blk / 48, cb = (F.blk % 48) / 4, kc = F.blk & 3;
    LAS float* s = (LAS float*)F.lds;
    for (int i = F.tid; i < 256 * 33; i += NTHR) { const int k = i / 33, r = i % 33; const float c = (r < 32) ? a.in[1][(size_t)r * 1024 + kc * 256 + k] : a.in[3][kc * 256 + k]; s[k * 36 + r] = c / (1.f + __expf(-c)); }
    __syncthreads();
    const int n = cb * 512 + F.tid;
    const GAS float* w = (const GAS float*)a.in[4] + ((size_t)l * 1024 + kc * 256) * 6144 + n;
    float acc[33];
#pragma unroll
    for (int r = 0; r < 33; ++r) acc[r] = 0.f;
#pragma unroll 4
    for (int k = 0; k < 256; ++k) { const float wv = w[(size_t)k * 6144];
#pragma unroll
        for (int r = 0; r < 33; ++r) acc[r] += s[k * 36 + r] * wv; }
    float* part = (float*)(F.ws + WS_MODP) + ((size_t)(kc * 4 + l) * 33) * 6144 + n;
#pragma unroll
    for (int r = 0; r < 33; ++r) part[(size_t)r * 6144] = acc[r];
    __syncthreads();
}
__device__ __forceinline__ void mod_finalize(Frame& F, const Args& a) {
    F.refresh();
    const int gt = F.blk * NTHR + F.tid, NGT = GRID * NTHR; const float* part = (const float*)(F.ws + WS_MODP); float* mod = (float*)(F.ws + WS_MOD);
    for (int i = gt; i < 4 * 33 * 6144; i += NGT) { const int l = i / (33 * 6144), n = i % 6144; float v = a.in[5][l * 6144 + n];
#pragma unroll
        for (int kc = 0; kc < 4; ++kc) v += part[(size_t)kc * 4 * 33 * 6144 + i]; mod[i] = v; }
}
__device__ __forceinline__ void rows_init(Frame& F, const Args& a) {
    F.refresh();
    bf16_t* XS = (bf16_t*)(F.ws + WS_XS); bf16_t* U = (bf16_t*)a.out; const float* part = (const float*)(F.ws + WS_MODP);
    for (int row = F.gw; row < TT; row += NGW) {
        Row r; row_load_f32(r, row < T ? a.in[0] + (size_t)row * D : a.in[2] + (size_t)(row - T) * D, F.lane);
        row_store_bf16(r, XS + (size_t)row * D, F.lane);
        row_normalize(r, MOD_EPS); const int mr = mod_row(row);
#pragma unroll
        for (int j = 0; j < 4; ++j) { const int e = vq(j, F.lane);
            f32x4 sh = ((const GAS f32x4*)(a.in[5]))[e], sc = ((const GAS f32x4*)(a.in[5] + 1024))[e];
#pragma unroll
            for (int kc = 0; kc < 4; ++kc) { const float* pp = part + ((size_t)(kc * 4 + 0) * 33 + mr) * 6144; sh += ((const GAS f32x4*)pp)[e]; sc += ((const GAS f32x4*)(pp + 1024))[e]; }
            r.v[j] = r.v[j] * (sc + 1.f) + sh; }
        row_store_bf16(r, U + (size_t)row * D, F.lane);
    }
}
__device__ __forceinline__ void rows_post1(Frame& F, const Args& a, int layer, int nrows) {
    F.refresh();
    bf16_t* XS = (bf16_t*)(F.ws + WS_XS); bf16_t* U = (bf16_t*)a.out;
    const float* lg = a.in[6] + (size_t)(layer * 2 + 0) * D; const float* lb = a.in[7] + (size_t)(layer * 2 + 0) * D;
    for (int row = F.gw; row < nrows; row += NGW) { const int mr = mod_row(row);
        Row x, y; row_load_bf16(x, XS + (size_t)row * D, F.lane); row_load_bf16(y, U + (size_t)row * D, F.lane);
        const float* g1 = mod_vec(F.ws, layer, mr, 2);
#pragma unroll
        for (int j = 0; j < 4; ++j) x.v[j] = x.v[j] * ALPHA + ((const GAS f32x4*)g1)[vq(j, F.lane)] * y.v[j];
        row_normalize(x, LN_EPS);
#pragma unroll
        for (int j = 0; j < 4; ++j) x.v[j] = x.v[j] * ((const GAS f32x4*)lg)[vq(j, F.lane)] + ((const GAS f32x4*)lb)[vq(j, F.lane)];
        row_store_bf16(x, XS + (size_t)row * D, F.lane);
        row_modulate(x, mod_vec(F.ws, layer, mr, 3), mod_vec(F.ws, layer, mr, 4), F.lane);
        row_store_bf16(x, U + (size_t)row * D, F.lane);
    }
}
__device__ __forceinline__ void rows_post2(Frame& F, const Args& a, int layer, int t0, int n) {
    F.refresh();
    bf16_t* XS = (bf16_t*)(F.ws + WS_XS); bf16_t* U = (bf16_t*)a.out; const bf16_t* YB = (const bf16_t*)(F.ws + WS_YB); const bf16_t* YS = (const bf16_t*)(F.ws + WS_YS);
    const int* spos = (const int*)(F.ws + WS_SDST); const float* tkw = (const float*)(F.ws + WS_TKW);
    const float* lg = a.in[6] + (size_t)(layer * 2 + 1) * D; const float* lb = a.in[7] + (size_t)(layer * 2 + 1) * D;
    for (int i = F.gw; i < n; i += NGW) { const int row = t0 + i; const int mr = mod_row(row);
        Row x, y; row_load_bf16(x, XS + (size_t)row * D, F.lane);
        int pj = 0; float wj = 0.f; if (F.lane < 8) { pj = ((const GAS int*)spos)[(size_t)row * 8 + F.lane]; wj = ((const GAS float*)tkw)[(size_t)row * 8 + F.lane]; }
        row_load_bf16(y, YS + (size_t)i * D, F.lane);
#pragma unroll
        for (int s = 0; s < 8; ++s) { const int ps = __builtin_amdgcn_readlane(pj, s); const float ws_ = __builtin_bit_cast(float, __builtin_amdgcn_readlane(__builtin_bit_cast(int, wj), s));
            Row z; row_load_bf16(z, YB + (size_t)ps * D, F.lane);
#pragma unroll
            for (int j = 0; j < 4; ++j) y.v[j] += z.v[j] * ws_; }
        const float* g2 = mod_vec(F.ws, layer, mr, 5);
#pragma unroll
        for (int j = 0; j < 4; ++j) x.v[j] = x.v[j] * ALPHA + ((const GAS f32x4*)g2)[vq(j, F.lane)] * y.v[j];
        row_normalize(x, LN_EPS);
#pragma unroll
        for (int j = 0; j < 4; ++j) x.v[j] = x.v[j] * ((const GAS f32x4*)lg)[vq(j, F.lane)] + ((const GAS f32x4*)lb)[vq(j, F.lane)];
        if (layer == 3) { row_store_f32(x, a.out + (size_t)row * D, F.lane); }
        else { row_store_bf16(x, XS + (size_t)row * D, F.lane);
            row_modulate(x, mod_vec(F.ws, layer + 1, mr, 0), mod_vec(F.ws, layer + 1, mr, 1), F.lane);
            row_store_bf16(x, U + (size_t)row * D, F.lane); }
    }
}

__device__ __forceinline__ void route_tokens(Frame& F, const Args& a, int layer, int ntok) {
    F.refresh();
    const int TPB = ntok / GRID;
    const bf16_t* U = (const bf16_t*)a.out; const bf16_t* Wr = (const bf16_t*)(F.ws + WS_WR) + (size_t)layer * 64 * 1024;
    int* tke = (int*)(F.ws + WS_TKE); float* tkw = (float*)(F.ws + WS_TKW);
    LAS int* lcnt = (LAS int*)(F.lds + L_LCNT);
    LAS float* sc = (LAS float*)(F.lds) + F.wave * 1024;
    if (F.tid < 64) lcnt[F.tid] = 0;
    __syncthreads();
    const int lane = F.lane, fr = lane & 15, fq = lane >> 4;
    const float bias = a.in[13][layer * 64 + lane];
    const int ntile = TPB / 16;
    for (int tl = F.wave; tl < ntile; tl += NWAVES) {
        const int t0 = F.blk * TPB + tl * 16;
        f32x4 acc[4];
#pragma unroll
        for (int n = 0; n < 4; ++n) acc[n] = (f32x4){0.f, 0.f, 0.f, 0.f};
        const GAS bf16x8* ap = (const GAS bf16x8*)(U + (size_t)(t0 + fr) * D + fq * 8);
        const GAS bf16x8* bp = (const GAS bf16x8*)(Wr + (size_t)fr * D + fq * 8);
#pragma unroll 4
        for (int ks = 0; ks < 32; ++ks) { const bf16x8 av = ap[ks * 4];
#pragma unroll
            for (int n = 0; n < 4; ++n) { const bf16x8 bv = bp[(size_t)n * 16 * (D / 8) + ks * 4]; acc[n] = __builtin_amdgcn_mfma_f32_16x16x32_bf16(av, bv, acc[n], 0, 0, 0); } }
#pragma unroll
        for (int n = 0; n < 4; ++n)
#pragma unroll
            for (int j = 0; j < 4; ++j) sc[(fq * 4 + j) * 64 + n * 16 + fr] = acc[n][j];
        LDS_WAIT();
        for (int tk = 0; tk < 16; ++tk) {
            const float logit = sc[tk * 64 + lane];
            const float s = 1.f / (1.f + __expf(-logit));
            const float sel = s + bias;
            const int g = lane >> 3;
            float m1 = sel; m1 = fmaxf(m1, __shfl_xor(m1, 1)); m1 = fmaxf(m1, __shfl_xor(m1, 2)); m1 = fmaxf(m1, __shfl_xor(m1, 4));
            const unsigned long long bm = __ballot(sel == m1);
            const unsigned gm = (unsigned)(bm >> (g * 8)) & 0xffu;
            const int first = g * 8 + __builtin_ctz(gm);
            float m2 = (lane == first) ? -INFINITY : sel; m2 = fmaxf(m2, __shfl_xor(m2, 1)); m2 = fmaxf(m2, __shfl_xor(m2, 2)); m2 = fmaxf(m2, __shfl_xor(m2, 4));
            const float gs = m1 + m2;
            float curg = gs; bool gok = false;
#pragma unroll 1
            for (int it = 0; it < 4; ++it) { float mx = curg;
#pragma unroll
                for (int o = 1; o < 64; o <<= 1) mx = fmaxf(mx, __shfl_xor(mx, o));
                const unsigned long long bb = __ballot(curg == mx); const int gi = (int)(__builtin_ctzll(bb) >> 3);
                if (g == gi) { gok = true; curg = -INFINITY; } }
            float cure = gok ? sel : -INFINITY; bool chosen = false; int rk = 0;
#pragma unroll 1
            for (int it = 0; it < 8; ++it) { float mx = cure;
#pragma unroll
                for (int o = 1; o < 64; o <<= 1) mx = fmaxf(mx, __shfl_xor(mx, o));
                const unsigned long long bb = __ballot(cure == mx); const int ei = (int)__builtin_ctzll(bb);
                if (lane == ei) { chosen = true; rk = it; cure = -INFINITY; } }
            const float tot = wave_sum(chosen ? s : 0.f);
            if (chosen) { const int tok = t0 + tk; tke[(size_t)tok * 8 + rk] = lane; tkw[(size_t)tok * 8 + rk] = s / tot * 2.5f; __hip_atomic_fetch_add(&lcnt[lane], 1, __ATOMIC_RELAXED, __HIP_MEMORY_SCOPE_WORKGROUP); }
        }
        LDS_WAIT();
    }
    __syncthreads();
    if (F.tid < 64) F.ctl[CW_BCNT + F.blk * 64 + F.tid] = (unsigned)lcnt[F.tid];
}
__device__ __forceinline__ void build_lists(Frame& F, int ntok) {
    F.refresh();
    const int TPB = ntok / GRID, CH = ntok / NCHUNK;
    LAS int* tstart = (LAS int*)(F.lds + L_TSTART); LAS int* pref = (LAS int*)(F.lds + L_PREF); LAS int* lcnt = (LAS int*)(F.lds + L_LCNT);
    LAS unsigned char* tseg = (LAS unsigned char*)(F.lds + L_TSEG); LAS int* scan = (LAS int*)(F.lds + L_SCAN);
    const unsigned* bcnt = F.ctl + CW_BCNT;
    const int myc = F.blk / 64, mylb = F.blk & 63;
    int nseg = 0;
    if (F.tid < 256) { const int c = F.tid >> 6, e = F.tid & 63; int n = 0, p = 0;
        for (int lb = 0; lb < 64; ++lb) { const int v = (int)__hip_atomic_load(bcnt + (c * 64 + lb) * 64 + e, RLX_AGENT); if (c == myc && lb < mylb) p += v; n += v; }
        nseg = n; scan[F.tid] = (n + 255) >> 8; if (c == myc) pref[e] = p; }
    if (F.tid < 64) lcnt[F.tid] = 0;
    __syncthreads();
    if (F.tid == 0) { int acc = 0; for (int s = 0; s < 256; ++s) { tstart[s] = acc; acc += scan[s]; } tstart[256] = acc; }
    __syncthreads();
    if (F.tid < 256) { const int t0 = tstart[F.tid], t1 = tstart[F.tid + 1]; for (int t = t0; t < t1; ++t) tseg[t] = (unsigned char)F.tid; }
    int* stok = (int*)(F.ws + WS_STOK); int* spos = (int*)(F.ws + WS_SDST);
    const int* tke = (const int*)(F.ws + WS_TKE);
    { const int sseg = myc * 64 + mylb;
      if (F.tid == sseg) scan[0] = nseg; }
    __syncthreads();
    { const int sseg = myc * 64 + mylb; const int n = scan[0]; const int base = tstart[sseg] * 256, end = tstart[sseg + 1] * 256;
      for (int p = base + n + F.tid; p < end; p += NTHR) stok[p] = myc * CH; }
    for (int tl = F.wave; tl < TPB; tl += NWAVES) { const int tok = F.blk * TPB + tl;
        if (F.lane < 8) { const int e = tke[(size_t)tok * 8 + F.lane];
            const int p = tstart[myc * 64 + e] * 256 + pref[e] + __hip_atomic_fetch_add(&lcnt[e], 1, __ATOMIC_RELAXED, __HIP_MEMORY_SCOPE_WORKGROUP);
            stok[p] = tok; spos[(size_t)tok * 8 + F.lane] = p - tstart[myc * 64] * 256; } }
    __syncthreads();
}

struct SchedQKV {
    const char* U; const char* W; int nfull, nu, c;
    __device__ __forceinline__ bool next(int i, pg::Unit& u) const {
        const int L0 = i * GRID + c; if (L0 >= nu) return false;
        int pm, pn;
        if (L0 < nfull) { const int L = pg::xcd_remap(L0, nfull); const int gid = L / 48, w = L % 48; pm = gid * 8 + (w & 7); pn = w >> 3; }
        else { const int q = L0 - nfull; pm = 256 + (q >> 1); pn = 4 + (q & 1); }
        u.A = U + (size_t)pm * 256 * 2048; u.B = W + (size_t)pn * 256 * 2048; u.gidx = nullptr; u.gbase = 0; u.nt = 16; u.out = nullptr; u.ldc = 0; u.scale = 1.f; u.flags = 0; u.i0 = pm; u.i1 = pn; u.l0 = nullptr; u.l1 = nullptr;
        return true; }
};
struct SchedDense {
    const char* A; const char* W; char* out; int nrt, nct, nt, c; size_t ldA;
    __device__ __forceinline__ bool next(int i, pg::Unit& u) const {
        const int nu = nrt * nct; const int L0 = i * GRID + c; if (L0 >= nu) return false;
        const int L = pg::xcd_remap(L0, nu); const int per = 8 * nct, gid = L / per, w = L % per, fm = gid * 8, gsz = (nrt - fm) < 8 ? (nrt - fm) : 8; const int pm = fm + (w % gsz), pn = w / gsz;
        u.A = A + (size_t)pm * 256 * ldA; u.B = W + (size_t)pn * 256 * ldA; u.gidx = nullptr; u.gbase = 0; u.nt = nt; u.out = out + (size_t)pm * 256 * 2048 + pn * 512; u.ldc = 2048; u.scale = 1.f; u.flags = 0; u.i0 = pm; u.i1 = pn; u.l0 = nullptr; u.l1 = nullptr;
        return true; }
};
struct SchedF1 {
    const char* CS; const char* U; char* ABT; char* ABTC; int nu, c;
    __device__ __forceinline__ bool next(int i, pg::Unit& u) const {
        const int L0 = i * GRID + c; if (L0 >= nu) return false;
        u.gidx = nullptr; u.gbase = 0; u.nt = 4; u.scale = 1.f; u.flags = 0; u.i0 = 0; u.i1 = 0; u.l0 = nullptr; u.l1 = nullptr;
        if (L0 < 2048) { const int L = pg::xcd_remap(L0, 2048); const int pm = L & 1, pn = (L >> 1) & 7, bg = L >> 4, b = bg >> 2, g = bg & 3;
            u.A = CS + (size_t)pm * 256 * 512; u.B = U + ((size_t)b * SEQ + pn * 256) * 2048 + g * 512; u.out = ABT + (size_t)bg * 256 * 8192 + (size_t)(pm * 2048 + pn * 256) * 2; u.ldc = 8192; }
        else { const int q = L0 - 2048; const int pm = q & 1, bg = q >> 1, b = bg >> 2, g = bg & 3;
            u.A = CS + (size_t)pm * 256 * 512; u.B = U + ((size_t)T + b * CTXL) * 2048 + g * 512; u.out = ABTC + (size_t)bg * 256 * 1024 + (size_t)pm * 512; u.ldc = 1024; }
        return true; }
};
struct SchedF2 {
    const char* DL; const char* ABT; char* FH; int c;
    __device__ __forceinline__ bool next(int i, pg::Unit& u) const {
        const int L0 = i * GRID + c; if (L0 >= 512) return false;
        const int L = pg::xcd_remap(L0, 512); const int pm = L & 3, bg = L >> 2, b = bg >> 2, g = bg & 3;
        u.A = DL + (size_t)pm * 256 * 8192; u.B = ABT + (size_t)bg * 256 * 8192; u.gidx = nullptr; u.gbase = 0; u.nt = 64; u.out = FH + ((size_t)b * 1024 + pm * 256) * 2048 + g * 512; u.ldc = 2048; u.scale = 0.001381067932004975f  ; u.flags = 0; u.i0 = 0; u.i1 = 0; u.l0 = nullptr; u.l1 = nullptr;
        return true; }
};
struct SchedF2c {
    const char* DLC; const char* ABTC; char* FC; int c;
    __device__ __forceinline__ bool next(int i, pg::Unit& u) const {
        const int L0 = i * GRID + c; if (L0 >= 128) return false;
        const int bg = L0, b = bg >> 2, g = bg & 3;
        u.A = DLC; u.B = ABTC + (size_t)bg * 256 * 1024; u.gidx = nullptr; u.gbase = 0; u.nt = 8; u.out = FC + ((size_t)b * 256) * 2048 + g * 512; u.ldc = 2048; u.scale = 1.f / 256.f; u.flags = 0; u.i0 = 0; u.i1 = 0; u.l0 = nullptr; u.l1 = nullptr;
        return true; }
};
struct SchedF3 {
    const char* FH; const char* FC; const char* W; char* Y; int nu, c;
    __device__ __forceinline__ bool next(int i, pg::Unit& u) const {
        const int L0 = i * GRID + c; if (L0 >= nu) return false;
        u.gidx = nullptr; u.gbase = 0; u.nt = 16; u.scale = 1.f; u.flags = 0; u.i0 = 0; u.i1 = 0; u.l0 = nullptr; u.l1 = nullptr;
        if (L0 < 1024) { const int L = pg::xcd_remap(L0, 1024); const int gid = L >> 6, w = L & 63, pm = gid * 8 + (w & 7), pn = w >> 3; const int b = pm >> 2, k0 = (pm & 3) * 256;
            u.A = FH + (size_t)pm * 256 * 2048; u.B = W + (size_t)pn * 256 * 2048;
            if (pn < 4) { u.out = Y + ((size_t)b * SEQ + k0) * 2048 + pn * 512; u.ldc = 2048; }
            else { u.out = Y + ((size_t)b * SEQ + SEQ - k0) * 2048 + (pn - 4) * 512; u.ldc = -2048; u.flags = (k0 == 0) ? 1 : 0; } }
        else { const int q = L0 - 1024; const int pm = q >> 2, pn = q & 3;
            u.A = FC + (size_t)pm * 256 * 2048; u.B = W + (size_t)pn * 256 * 2048; u.out = Y + ((size_t)T + pm * 256) * 2048 + pn * 512; u.ldc = 2048; }
        return true; }
};
struct SchedG1 {
    const char* EGU; const char* WSG; const int* STOK; char* H; char* HS; LAS const unsigned char* tseg; int ntl, nsh, c;
    __device__ __forceinline__ bool next(int i, pg::Unit& u) const {
        const int nu = (ntl + nsh) * 2; const int L0 = i * GRID + c; if (L0 >= nu) return false;
        const int L = pg::xcd_remap(L0, nu); const int pm = L >> 1, pn = L & 1;
        u.A = nullptr; u.gbase = 0; u.nt = 16; u.ldc = 512; u.scale = 1.f; u.flags = 0; u.i0 = 0; u.i1 = 0; u.l0 = nullptr; u.l1 = nullptr;
        if (pm < ntl) { const int e = __builtin_amdgcn_readfirstlane((int)tseg[pm]) & 63;
            u.gidx = STOK + (size_t)pm * 256; u.B = EGU + (size_t)e * 512 * 2048 + (size_t)pn * 256 * 2048; u.out = H + (size_t)pm * 256 * 512 + pn * 256; }
        else { const int ps = pm - ntl; u.gidx = nullptr; u.gbase = ps * 256; u.B = WSG + (size_t)pn * 256 * 2048; u.out = HS + (size_t)ps * 256 * 512 + pn * 256; }
        return true; }
};
struct SchedG2 {
    const char* ED; const char* WSD; const char* H; const char* HS; char* YB; char* YS; LAS const unsigned char* tseg; int t0, t1, nsh, ch, CH, c;
    __device__ __forceinline__ bool next(int i, pg::Unit& u) const {
        const int nr = t1 - t0; const int nu = (nr + nsh) * 4; const int L0 = i * GRID + c; if (L0 >= nu) return false;
        const int L = pg::xcd_remap(L0, nu); const int q = L >> 2, pn = L & 3;
        u.gidx = nullptr; u.gbase = 0; u.nt = 4; u.ldc = 2048; u.scale = 1.f; u.flags = 0; u.i0 = 0; u.i1 = 0; u.l0 = nullptr; u.l1 = nullptr;
        if (q < nr) { const int pm = t0 + q; const int e = __builtin_amdgcn_readfirstlane((int)tseg[pm]) & 63;
            u.A = H + (size_t)pm * 256 * 512; u.B = ED + (size_t)e * 1024 * 512 + (size_t)pn * 256 * 512; u.out = YB + (size_t)q * 256 * 2048 + pn * 512; }
        else { const int ps = q - nr; u.A = HS + ((size_t)ch * CH + ps * 256) * 512; u.B = WSD + (size_t)pn * 256 * 512; u.out = YS + (size_t)ps * 256 * 2048 + pn * 512; }
        return true; }
};

__device__ __forceinline__ void fnet_nyquist_rows(Frame& F) {
    F.refresh();
    const bf16_t* ABT = (const bf16_t*)(F.ws + WS_ABT); bf16_t* FH1 = (bf16_t*)(F.ws + WS_FH1);
    for (int r = F.gw; r < 128 * 256; r += NGW) { const int bg = r >> 8, m = r & 255, b = bg >> 2, g = bg & 3;
        const GAS u32x4* p = (const GAS u32x4*)(ABT + (size_t)r * 4096); float s = 0.f;
#pragma unroll
        for (int i = 0; i < 4; ++i) { const u32x4 w = p[i * 64 + F.lane]; s += (bflo(w.x) - bfhi(w.x)) + (bflo(w.y) - bfhi(w.y)) + (bflo(w.z) - bfhi(w.z)) + (bflo(w.w) - bfhi(w.w)); }
        s = wave_sum(s) * 0.001381067932004975f;
        if (F.lane == 0) FH1[(size_t)b * 1024 + g * 256 + m] = (bf16_t)f2bf(s); }
}
__device__ __forceinline__ void fnet_nyquist_out(Frame& F, const Args& a, int jl) {
    F.refresh();
    const bf16_t* FH1 = (const bf16_t*)(F.ws + WS_FH1); const bf16_t* W = (const bf16_t*)(F.ws + WS_WF) + (size_t)jl * 2048 * 1024; bf16_t* Y = (bf16_t*)a.out;
    LAS float* part = (LAS float*)F.lds;
    const int b = F.blk >> 3, n = (F.blk & 7) * 128 + (F.tid & 127), kq = F.tid >> 7;
    const GAS u32x4* wp = (const GAS u32x4*)(W + (size_t)n * 1024 + kq * 256); const GAS u32x4* fp = (const GAS u32x4*)(FH1 + (size_t)b * 1024 + kq * 256);
    float s = 0.f;
#pragma unroll 4
    for (int i = 0; i < 32; ++i) { const u32x4 w = wp[i], f = fp[i];
        s += bflo(w.x) * bflo(f.x) + bfhi(w.x) * bfhi(f.x) + bflo(w.y) * bflo(f.y) + bfhi(w.y) * bfhi(f.y) + bflo(w.z) * bflo(f.z) + bfhi(w.z) * bfhi(f.z) + bflo(w.w) * bflo(f.w) + bfhi(w.w) * bfhi(f.w); }
    part[F.tid] = s;
    __syncthreads();
    if (F.tid < 128) { const float t = (part[F.tid] + part[F.tid + 128]) + (part[F.tid + 256] + part[F.tid + 384]); Y[((size_t)b * SEQ + 1024) * D + n] = (bf16_t)f2bf(t); }
    __syncthreads();
}


#ifdef SELFCHECK
constexpr int CW_ERR = 1024;
constexpr size_t WS_OCHK = WS_R + 216 * MiB;
__device__ __forceinline__ void chk_report(unsigned* ctl, int id, float got, float ref, float tabs, float trel) {
    float e = fabsf(got - ref) / (tabs + trel * fabsf(ref)); if (!(e == e)) e = 1e30f; atomicMax(ctl + CW_ERR + id, __float_as_uint(e)); }
__device__ __forceinline__ float bf2f(bf16_t b) { return __builtin_bit_cast(float, (unsigned)b << 16); }
__constant__ int chk_toks[16] = {0, 1, 63, 64, 65, 127, 2047, 2048, 2049, 4096, 33000, 65535, 65536, 65537, 70000, 73727};
__constant__ int chk_ks[8] = {0, 1, 2, 255, 256, 1023, 1024, 700};
__constant__ int chk_ms[4] = {0, 1, 128, 255};
__constant__ int chk_ytoks[10] = {0, 1, 1023, 1024, 1025, 2047, 2048, 65535, 65536, 73727};
__constant__ int chk_ns[5] = {0, 1, 255, 256, 1023};
__constant__ int chk_cols[20] = {0, 7, 15, 16, 31, 32, 40, 48, 63, 64, 500, 1023, 1024, 1039, 1040, 1072, 1279, 1280, 1300, 1535};
__device__ __forceinline__ void chk_qkv(Frame& F, const Args& a, int layer, int id) {
    F.refresh(); const bf16_t* U = (const bf16_t*)a.out; const float* W = a.in[8] + (size_t)(layer >> 1) * 1024 * 1536;
    const bf16_t* Qb = (const bf16_t*)(F.ws + WS_Q); const bf16_t* Kb = (const bf16_t*)(F.ws + WS_K); const bf16_t* Vb = (const bf16_t*)(F.ws + WS_V);
    for (int s = F.gw; s < 320; s += NGW) { const int tok = chk_toks[s & 15], col = chk_cols[s >> 4];
        if (layer == 2 && tok >= T && col < 1024) continue;
        const bool rope = (tok < T) && col < 1280; const int hc = col & 63, first = (hc & 31) < 16; const int pcol = rope ? (first ? col + 16 : col - 16) : col;
        float x = 0.f, xp = 0.f;
        for (int k = F.lane; k < 1024; k += 64) { const float u = bf2f(U[(size_t)tok * D + k]); x += u * W[(size_t)k * 1536 + col]; xp += u * W[(size_t)k * 1536 + pcol]; }
        x = wave_sum(x); xp = wave_sum(xp);
        float ref = x;
        if (rope) { const int tl = tok & 2047, part = hc >> 5, pos = part ? (tl & 63) : (tl >> 6), fi = hc & 15; const float ang = (float)pos * powf(10000.f, -(float)fi / 16.f);
            ref = x * cosf(ang) + (first ? -xp : xp) * sinf(ang); }
        if (col < 1024) ref *= C2;
        const float got = col < 1024 ? bf2f(Qb[(size_t)tok * 1024 + col]) : (col < 1280 ? bf2f(Kb[(size_t)tok * 256 + col - 1024]) : bf2f(Vb[(size_t)tok * 256 + col - 1280]));
        if (F.lane == 0) chk_report(F.ctl, id, got, ref, 0.03f, 0.03f); }
}
__device__ __forceinline__ void chk_attn(Frame& F, const Args& a, int layer, int id) {
    F.refresh(); const bf16_t* Qb = (const bf16_t*)(F.ws + WS_Q); const bf16_t* Kb = (const bf16_t*)(F.ws + WS_K); const bf16_t* Vb = (const bf16_t*)(F.ws + WS_V); const bf16_t* Ob = (const bf16_t*)(F.ws + WS_OCHK);
    LAS float* lg = (LAS float*)F.lds + F.wave * 1024;
    for (int s = F.gw; s < 64; s += NGW) { const int tok = chk_toks[s & 15], h = (s >> 4) * 5, kvh = h >> 2;
        if (layer == 2 && tok >= T) continue;
        const bool isctx = tok >= T; const int b = isctx ? (tok - T) / CTXL : tok / SEQ, p = tok & (SEQ - 1);
        int nk = 0; const int lo = isctx ? 0 : (p - 128 < 0 ? 0 : p - 128), hi = isctx ? -1 : (p + 128 > SEQ - 1 ? SEQ - 1 : p + 128);
        const int nlat = isctx ? 0 : hi - lo + 1; nk = nlat + CTXL;
        float mx = a.in[10][(layer >> 1) * 16 + h] * LOG2E; const float sink2 = mx;
        for (int i = F.lane; i < nk; i += 64) { const size_t kr = i < nlat ? (size_t)b * SEQ + lo + i : (size_t)T + b * CTXL + (i - nlat); float d = 0.f;
            for (int e = 0; e < 64; ++e) d += bf2f(Qb[(size_t)tok * 1024 + h * 64 + e]) * bf2f(Kb[kr * 256 + kvh * 64 + e]);
            lg[i] = d; mx = fmaxf(mx, d); }
#pragma unroll
        for (int o = 1; o < 64; o <<= 1) mx = fmaxf(mx, __shfl_xor(mx, o));
        LDS_WAIT();
        float den = 0.f; for (int i = F.lane; i < nk; i += 64) den += exp2f(lg[i] - mx);
        den = wave_sum(den) + exp2f(sink2 - mx);
        float o = 0.f;
        for (int i = 0; i < nk; ++i) { const size_t kr = i < nlat ? (size_t)b * SEQ + lo + i : (size_t)T + b * CTXL + (i - nlat); o += exp2f(lg[i] - mx) * bf2f(Vb[kr * 256 + kvh * 64 + F.lane]); }
        o /= den;
        chk_report(F.ctl, id, bf2f(Ob[(size_t)tok * 1024 + h * 64 + F.lane]), o, 0.01f, 0.03f); chk_report(F.ctl, 32 + (s & 15), bf2f(Ob[(size_t)tok * 1024 + h * 64 + F.lane]), o, 0.01f, 0.03f);
        LDS_WAIT(); }
    __syncthreads();
}
__device__ __forceinline__ void chk_fnet_f(Frame& F, const Args& a, bool upd, int id) {
    F.refresh(); const bf16_t* U = (const bf16_t*)a.out; LAS float* red = (LAS float*)F.lds;
    for (int s = F.blk; s < 128 + (upd ? 64 : 0); s += GRID) {
        const bool cx = s >= 128; const int q = cx ? s - 128 : s; const int m = chk_ms[q & 3], g = ((q >> 2) & 1) * 3, b = ((q >> 3) & 1) * 31; int k = chk_ks[(q >> 4) & 7]; const int L = cx ? CTXL : SEQ; if (cx) k &= 255;
        const size_t row0 = cx ? (size_t)T + b * CTXL : (size_t)b * SEQ;
        float acc = 0.f;
        for (int l = F.wave; l < L; l += NWAVES) { float ca = 0.f, sa = 0.f;
            for (int n = F.lane; n < 256; n += 64) { const float u = bf2f(U[(row0 + l) * D + g * 256 + n]); const float an = 6.283185307179586f * (float)((m * n) & 255) / 256.f; const float sn = __sinf(an), cs = __cosf(an); ca += u * cs; sa += u * sn; }
            ca = wave_sum(ca); sa = wave_sum(sa); const float an = 6.283185307179586f * (float)((k * l) % L) / (float)L; const float sn = __sinf(an), cs = __cosf(an); acc += cs * ca - sn * sa; }
        if (F.lane == 0) red[F.wave] = acc;
        __syncthreads();
        if (F.tid == 0) { float t = 0.f; for (int w = 0; w < NWAVES; ++w) t += red[w]; t *= cx ? (1.f / 256.f) : 0.001381067932004975f;
            float got;
            if (cx) got = bf2f(((const bf16_t*)(F.ws + WS_FC))[((size_t)b * 256 + k) * D + g * 256 + m]);
            else if (k == 1024) got = bf2f(((const bf16_t*)(F.ws + WS_FH1))[(size_t)b * 1024 + g * 256 + m]);
            else got = bf2f(((const bf16_t*)(F.ws + WS_FH))[((size_t)b * 1024 + k) * D + g * 256 + m]);
            chk_report(F.ctl, id, got, t, 0.02f, 0.03f); }
        __syncthreads(); }
}
__device__ __forceinline__ void chk_fnet_y(Frame& F, const Args& a, int jl, bool upd, int id) {
    F.refresh(); const bf16_t* Y = (const bf16_t*)a.out; const float* W = a.in[11] + (size_t)jl * 1024 * 1024;
    const bf16_t* FH = (const bf16_t*)(F.ws + WS_FH); const bf16_t* FH1 = (const bf16_t*)(F.ws + WS_FH1); const bf16_t* FC = (const bf16_t*)(F.ws + WS_FC);
    for (int s = F.gw; s < 50; s += NGW) { const int tok = chk_ytoks[s % 10], n = chk_ns[s / 10]; if (tok >= T && !upd) continue;
        float acc = 0.f;
        for (int j = F.lane; j < 1024; j += 64) { float f;
            if (tok >= T) f = bf2f(FC[(size_t)(tok - T) * D + j]);
            else { const int b = tok >> 11, k = tok & 2047; if (k < 1024) f = bf2f(FH[((size_t)b * 1024 + k) * D + j]); else if (k == 1024) f = bf2f(FH1[(size_t)b * 1024 + j]);
                else f = bf2f(FH[((size_t)b * 1024 + (2048 - k)) * D + (j & ~255) + ((256 - (j & 255)) & 255)]); }
            acc += f * W[(size_t)j * 1024 + n]; }
        acc = wave_sum(acc);
        if (F.lane == 0) chk_report(F.ctl, id, bf2f(Y[(size_t)tok * D + n]), acc, 0.02f, 0.03f); }
}
__device__ __forceinline__ void chk_route(Frame& F, const Args& a, int layer, int ntok, int id) {
    F.refresh(); const bf16_t* U = (const bf16_t*)a.out; const float* Wr = a.in[12] + (size_t)layer * 1024 * 64; const int* tke = (const int*)(F.ws + WS_TKE); const float* tkw = (const float*)(F.ws + WS_TKW);
    for (int s = F.gw; s < 16; s += NGW) { const int tok = chk_toks[s]; if (tok >= ntok) continue; const int lane = F.lane;
        float lgt = 0.f; for (int k = 0; k < 1024; ++k) lgt += bf2f(U[(size_t)tok * D + k]) * Wr[(size_t)k * 64 + lane];
        const float sc = 1.f / (1.f + expf(-lgt)), sel = sc + a.in[13][layer * 64 + lane];
        float g1 = -INFINITY, g2 = -INFINITY;
#pragma unroll 1
        for (int j = 0; j < 8; ++j) { const float v = __shfl(sel, (lane & ~7) + j); if (v > g1) { g2 = g1; g1 = v; } else if (v > g2) g2 = v; }
        const float gs = g1 + g2; int gr = 0;
#pragma unroll 1
        for (int gp = 0; gp < 8; ++gp) { const float v = __shfl(gs, gp * 8); gr += (v > gs || (v == gs && gp < (lane >> 3))) ? 1 : 0; }
        const float sm = gr < 4 ? sel : -INFINITY; int rk = 0;
#pragma unroll 1
        for (int ep = 0; ep < 64; ++ep) { const float v = __shfl(sm, ep); rk += (v > sm || (v == sm && ep < lane)) ? 1 : 0; }
        const float tot = wave_sum(rk < 8 ? sc : 0.f); const float wref = sc / tot * 2.5f;
        int slot = -1; for (int j = 0; j < 8; ++j) if (tke[(size_t)tok * 8 + j] == lane) slot = j;
        float err = 0.f;
        if (slot >= 0) { if (rk >= 10) err = 10.f; else if (rk < 8) err = fabsf(tkw[(size_t)tok * 8 + slot] - wref) / (0.04f * wref); }
        else if (rk < 6) err = 10.f;
        const unsigned long long nsel = __ballot(slot >= 0); if (__builtin_popcountll(nsel) != 8) err = 20.f;
        atomicMax(F.ctl + CW_ERR + id, __float_as_uint(err)); }
}
__device__ __forceinline__ void chk_moe(Frame& F, const Args& a, int layer, int ntok, int ch, int id) {
    F.refresh(); const bf16_t* U = (const bf16_t*)a.out; const int* tke = (const int*)(F.ws + WS_TKE); const float* tkw = (const float*)(F.ws + WS_TKW); const bf16_t* YB = (const bf16_t*)(F.ws + WS_YB);
    const int CH = ntok / NCHUNK; LAS float* hs = (LAS float*)F.lds; LAS float* us = hs + 512; LAS float* pg_ = us + 1024;
    for (int s = F.blk; s < 16; s += GRID) { const int tok = chk_toks[s]; if (tok >= ntok || tok / CH != ch) continue;
        for (int k = F.tid; k < 1024; k += NTHR) us[k] = bf2f(U[(size_t)tok * D + k]);
        __syncthreads();
        float y0 = 0.f, y1 = 0.f;
        for (int j = 0; j < 9; ++j) { const int e = j < 8 ? tke[(size_t)tok * 8 + j] : 0; const float w = j < 8 ? tkw[(size_t)tok * 8 + j] : 1.f;
            const float* wg = j < 8 ? a.in[14] + ((size_t)layer * NE + e) * 262144 : a.in[17] + (size_t)layer * 262144;
            const float* wu = j < 8 ? a.in[15] + ((size_t)layer * NE + e) * 262144 : a.in[18] + (size_t)layer * 262144;
            const float* wd = j < 8 ? a.in[16] + ((size_t)layer * NE + e) * 262144 : a.in[19] + (size_t)layer * 262144;
            const int hh = F.tid & 255, half = F.tid >> 8; float g = 0.f, u = 0.f;
            for (int k = half * 512; k < half * 512 + 512; ++k) { g += us[k] * wg[(size_t)k * 256 + hh]; u += us[k] * wu[(size_t)k * 256 + hh]; }
            pg_[F.tid] = g; pg_[512 + F.tid] = u;
            __syncthreads();
            if (F.tid < 256) { const float gg = pg_[F.tid] + pg_[F.tid + 256], uu = pg_[512 + F.tid] + pg_[512 + F.tid + 256]; hs[F.tid] = gg / (1.f + expf(-gg)) * uu; }
            __syncthreads();
            float t0 = 0.f, t1 = 0.f; for (int q = 0; q < 256; ++q) { t0 += hs[q] * wd[(size_t)q * 1024 + F.tid]; t1 += hs[q] * wd[(size_t)q * 1024 + 512 + F.tid]; }
            y0 += w * t0; y1 += w * t1;
            __syncthreads(); }
        float g0 = 0.f, g1 = 0.f; const int i = tok - ch * CH;
        { const bf16_t* YS = (const bf16_t*)(F.ws + WS_YS); const int* spos = (const int*)(F.ws + WS_SDST); g0 = bf2f(YS[(size_t)i * D + F.tid]); g1 = bf2f(YS[(size_t)i * D + 512 + F.tid]);
          for (int j = 0; j < 8; ++j) { const size_t ps = (size_t)spos[(size_t)tok * 8 + j]; const float w = tkw[(size_t)tok * 8 + j]; g0 += w * bf2f(YB[ps * D + F.tid]); g1 += w * bf2f(YB[ps * D + 512 + F.tid]); } }
        chk_report(F.ctl, id, g0, y0, 0.03f, 0.04f); chk_report(F.ctl, id, g1, y1, 0.03f, 0.04f);
        __syncthreads(); }
}
#endif

#ifndef PH_MASK
#define PH_MASK 0xffffffffu
#endif
#define PH(b) ((PH_MASK >> (b)) & 1u)
__global__ void __launch_bounds__(NTHR, 2) fwd(Args a) {
    extern __shared__ __attribute__((aligned(16))) unsigned char lds_raw[];
    Frame F;
    F.lds = (LAS unsigned char*)lds_raw; F.ws = a.ws; F.ctl = (unsigned*)(a.ws + WS_CTL);
    F.blk = blockIdx.x; F.refresh();
    for (int u = F.tid; u < (LDS_BYTES - RING_BYTES) / 4; u += NTHR) ((LAS unsigned*)(F.lds + RING_BYTES))[u] = 0u;
    __syncthreads();
    const XcdBarrier bar = xcd_barrier_post(F.ctl + CW_BAR, (volatile LAS unsigned*)(F.lds + L_MISC) + 8);
#define GRID_BAR() xcd_barrier(bar)
    LAS unsigned char* ring = F.lds;
    const int c = F.blk;
#define ws (F.ws)
#define NEWPH() F.refresh()

    if (PH(0)) { conv_small(F, a);
    __syncthreads();
    mod_partials(F, a); }
    GRID_BAR();
    if (PH(1)) { rows_init(F, a);
    mod_finalize(F, a); }
    GRID_BAR();

    for (int layer = 0; layer < 4; ++layer) {
        const int jl = layer >> 1; const bool upd = layer < 2; const int nrows = upd ? TT : T;
        if ((layer & 1) == 0) {
            NEWPH();
            if (PH(2)) { SchedQKV S; S.U = (const char*)a.out; S.W = (const char*)(ws + WS_WQKV) + (size_t)jl * 1536 * 2048; S.nfull = (layer == 0) ? 288 * 6 : 256 * 6; S.nu = (layer == 0) ? 288 * 6 : 256 * 6 + 64; S.c = c;
              pg::EpiQKV E; E.Q = (bf16_t*)(ws + WS_Q); E.K = (bf16_t*)(ws + WS_K); E.V = (bf16_t*)(ws + WS_V); E.ropec = (const float*)(ws + WS_ROPEC); E.ropes = (const float*)(ws + WS_ROPES);
              pg::gemm_phase<pg::EpiQKV, SchedQKV, false>(ring, 2048u, 2048u, nullptr, S, E); }
            GRID_BAR();
#ifdef SELFCHECK
            if (SELFCHECK & 1) chk_qkv(F, a, layer, 1 + (layer >> 1));
#define OBUF ((bf16_t*)(ws + WS_OCHK))
#else
#define OBUF ((bf16_t*)(ws + WS_Q))
#endif
            NEWPH();
            if (PH(3)) { const int NU = 4096 + (layer == 0 ? 512 : 0);
              const bf16_t* Qb = (const bf16_t*)(ws + WS_Q); const bf16_t* Kb = (const bf16_t*)(ws + WS_K); const bf16_t* Vb = (const bf16_t*)(ws + WS_V);
              for (int i = 0; i * GRID + c < NU; ++i) { const int id = pg::xcd_remap(i * GRID + c, NU);
                  if (id < 4096) { const int hq = id & 3, qb = (id >> 2) & 7, kvh = (id >> 5) & 3, b = id >> 7, h = kvh * 4 + hq;
                      attn::attn_unit(Qb, Kb, Vb, OBUF, b, h, qb * 256, false, a.in[10][jl * 16 + h] * LOG2E, ring); }
                  else { const int cid = id - 4096, hq = cid & 3, kvh = (cid >> 2) & 3, b = cid >> 4, h = kvh * 4 + hq;
                      attn::attn_unit(Qb, Kb, Vb, OBUF, b, h, 0, true, a.in[10][jl * 16 + h] * LOG2E, ring); } } }
            GRID_BAR();
#ifdef SELFCHECK
            if (SELFCHECK & 1) chk_attn(F, a, layer, 3 + (layer >> 1));
#endif
            NEWPH();
            if (PH(4)) { SchedDense S; S.A = (const char*)OBUF; S.W = (const char*)(ws + WS_WO) + (size_t)jl * 1024 * 2048; S.out = (char*)a.out; S.nrt = nrows / 256; S.nct = 4; S.nt = 16; S.c = c; S.ldA = 2048;
              pg::EpiStore E; pg::gemm_phase<pg::EpiStore, SchedDense, false>(ring, 2048u, 2048u, nullptr, S, E); }
            GRID_BAR();
        } else {
            NEWPH();
            if (PH(5)) { SchedF1 S; S.CS = (const char*)(ws + WS_CSN); S.U = (const char*)a.out; S.ABT = (char*)(ws + WS_ABT); S.ABTC = (char*)(ws + WS_ABTC); S.nu = 2048 + (upd ? 256 : 0); S.c = c;
              pg::EpiStore E; pg::gemm_phase<pg::EpiStore, SchedF1, false>(ring, 512u, 2048u, nullptr, S, E); }
            GRID_BAR();
            NEWPH();
            if (PH(6)) { SchedF2 S; S.DL = (const char*)(ws + WS_DL); S.ABT = (const char*)(ws + WS_ABT); S.FH = (char*)(ws + WS_FH); S.c = c;
              pg::EpiStore E; pg::gemm_phase<pg::EpiStore, SchedF2, false>(ring, 8192u, 8192u, nullptr, S, E); }
            NEWPH();
            if (PH(7) && upd) { SchedF2c S; S.DLC = (const char*)(ws + WS_DLC); S.ABTC = (const char*)(ws + WS_ABTC); S.FC = (char*)(ws + WS_FC); S.c = c;
              pg::EpiStore E; pg::gemm_phase<pg::EpiStore, SchedF2c, false>(ring, 1024u, 1024u, nullptr, S, E); }
            if (PH(8)) fnet_nyquist_rows(F);
            GRID_BAR();
#ifdef SELFCHECK
            if (SELFCHECK & 2) chk_fnet_f(F, a, upd, 5 + (layer >> 1));
            GRID_BAR();
#endif
            NEWPH();
            if (PH(9)) { SchedF3 S; S.FH = (const char*)(ws + WS_FH); S.FC = (const char*)(ws + WS_FC); S.W = (const char*)(ws + WS_WF) + (size_t)jl * 2048 * 2048; S.Y = (char*)a.out; S.nu = 1024 + (upd ? 128 : 0); S.c = c;
              pg::EpiStore E; pg::gemm_phase<pg::EpiStore, SchedF3, false>(ring, 2048u, 2048u, nullptr, S, E); }
            if (PH(10)) fnet_nyquist_out(F, a, jl);
            GRID_BAR();
#ifdef SELFCHECK
            if (SELFCHECK & 8) chk_fnet_y(F, a, jl, upd, 7 + (layer >> 1));
            GRID_BAR();
#endif
        }
        if (PH(11)) rows_post1(F, a, layer, nrows);
        GRID_BAR();
        if (PH(12)) conv_experts(F, a.in[14], a.in[15], a.in[16], layer);
        __syncthreads();
        if (PH(13)) route_tokens(F, a, layer, nrows);
        GRID_BAR();
#ifdef SELFCHECK
        if ((SELFCHECK & 4) && layer < 2) chk_route(F, a, layer, nrows, 9);
#endif
        if (PH(14)) build_lists(F, nrows);
        GRID_BAR();
        LAS const int* tstart = (LAS const int*)(F.lds + L_TSTART); LAS const unsigned char* tseg = (LAS const unsigned char*)(F.lds + L_TSEG);
        const int ntl = __builtin_amdgcn_readfirstlane(tstart[256]);
        NEWPH();
        if (PH(15)) { SchedG1 S; S.EGU = (const char*)(ws + WS_EGU); S.WSG = (const char*)(ws + WS_WSH) + (size_t)layer * 1536 * 1024; S.STOK = (const int*)(ws + WS_STOK); S.H = (char*)(ws + WS_H); S.HS = (char*)(ws + WS_HS); S.tseg = tseg; S.ntl = ntl; S.nsh = nrows / 256; S.c = c;
          pg::EpiSilu E; pg::gemm_phase<pg::EpiSilu, SchedG1, true>(ring, 2048u, 2048u, (const char*)a.out, S, E); }
        GRID_BAR();
        const int CH = nrows / NCHUNK;
        for (int ch = 0; ch < NCHUNK; ++ch) {
            NEWPH();
            if (PH(16)) { SchedG2 S; S.ED = (const char*)(ws + WS_ED); S.WSD = (const char*)(ws + WS_WSH) + (size_t)layer * 1536 * 1024 + 512 * 2048; S.H = (const char*)(ws + WS_H); S.HS = (const char*)(ws + WS_HS); S.YB = (char*)(ws + WS_YB); S.YS = (char*)(ws + WS_YS); S.tseg = tseg;
              S.t0 = __builtin_amdgcn_readfirstlane(tstart[ch * 64]); S.t1 = __builtin_amdgcn_readfirstlane(tstart[ch * 64 + 64]); S.nsh = CH / 256; S.ch = ch; S.CH = CH; S.c = c;
              pg::EpiStore E; pg::gemm_phase<pg::EpiStore, SchedG2, false>(ring, 512u, 512u, nullptr, S, E); }
            GRID_BAR();
#ifdef SELFCHECK
            if ((SELFCHECK & 4) && (layer == 0 || layer == 3)) { if (layer == 0 || ch == 0) chk_moe(F, a, layer, nrows, ch, 10 + (layer == 3)); GRID_BAR(); }
#endif
            if (PH(17)) rows_post2(F, a, layer, ch * CH, CH);
            if (!(layer == 3 && ch == NCHUNK - 1)) GRID_BAR();
        }
    }
#ifdef SELFCHECK
    GRID_BAR();
    { int bad = 0; float be = 0.f; for (int k = 15; k >= 1; --k) { const float e = __uint_as_float(__hip_atomic_load(F.ctl + CW_ERR + k, RLX_AGENT)); if (e > 1.f) { bad = k; be = e; } }
      int wt = 0; float we = 0.f; for (int k = 0; k < 16; ++k) { const float e = __uint_as_float(__hip_atomic_load(F.ctl + CW_ERR + 32 + k, RLX_AGENT)); if (e > we) { we = e; wt = k; } }
      if (bad) { F.refresh(); float cv = 3.f + bad + (be > 8.f ? 0.5f : 0.f);  Row r; for (int j = 0; j < 4; ++j) r.v[j] = (f32x4){cv, cv, cv, cv}; for (int row = F.gw; row < T; row += NGW) row_store_f32(r, a.out + (size_t)row * D, F.lane); } }
#endif
}

#undef ws
#undef NEWPH
extern "C" void kernel_launch(void* const* d_in, const int* in_sizes, int n_in, void* d_out, int out_size, void* d_ws, size_t ws_size, hipStream_t stream) {
    static int ready = 0;
    if (ready == 0) {
        if (n_in != 20 || out_size != T * D || ws_size < WS_END) { fprintf(stderr, "kernel_launch: unexpected problem (n_in %d out %d ws %zu need %zu)\n", n_in, out_size, ws_size, (size_t)WS_END); ready = -1; return; }
        if (hipFuncSetAttribute((const void*)fwd, hipFuncAttributeMaxDynamicSharedMemorySize, LDS_BYTES) != hipSuccess) { fprintf(stderr, "kernel_launch: hipFuncSetAttribute failed\n"); ready = -1; return; }
        int per_cu = 0;
        if (hipOccupancyMaxActiveBlocksPerMultiprocessor(&per_cu, (const void*)fwd, NTHR, LDS_BYTES) != hipSuccess || per_cu < 1) fprintf(stderr, "kernel_launch: occupancy query says %d blocks per CU\n", per_cu);
        (void)hipGetLastError();
        ready = 1;
    }
    if (ready < 0) return;
    (void)hipMemsetAsync((char*)d_ws + WS_CTL, 0, CTL_BYTES, stream);
    Args a{};
    for (int i = 0; i < 20; ++i) a.in[i] = (const float*)d_in[i];
    a.out = (float*)d_out; a.ws = (unsigned char*)d_ws;
    hipLaunchKernelGGL(fwd, dim3(GRID), dim3(NTHR), LDS_BYTES, stream, a);
}
```

```cpp
#include <hip/hip_runtime.h>
#include <cstdio>
#include <cstdint>

#define LAS __attribute__((address_space(3)))
#define GAS __attribute__((address_space(1)))
typedef unsigned short bf16_t;
typedef short bf16x8 __attribute__((ext_vector_type(8)));
typedef short s16x4 __attribute__((ext_vector_type(4)));
typedef float f32x4 __attribute__((ext_vector_type(4)));
typedef float f32x16 __attribute__((ext_vector_type(16)));
typedef unsigned u32x4 __attribute__((ext_vector_type(4)));
typedef unsigned u32x2 __attribute__((ext_vector_type(2)));

constexpr int D = 1024, NB = 32, SEQ = 2048, T = NB * SEQ, CTXL = 256, TC = NB * CTXL, TT = T + TC;
constexpr int NQKV = 1536, NE = 64;
constexpr float ALPHA = 1.681792830507429f;
constexpr float LN_EPS = 1e-5f, MOD_EPS = 1e-6f;
constexpr float C2 = 0.125f * 1.4426950408889634f;
constexpr float LOG2E = 1.4426950408889634f;
constexpr int NCHUNK = 2;
constexpr int NWAVES = 8, NTHR = 512, GRID = 256;

constexpr size_t MiB = 1u << 20;
constexpr size_t WS_CTL = 0, CTL_BYTES = 1 * MiB;
constexpr size_t WS_ROPEC = 1 * MiB, WS_ROPES = 1 * MiB + 4096, WS_CSN = 1 * MiB + 65536, WS_DLC = 1 * MiB + 524288, WS_DL = 2 * MiB;
constexpr size_t WS_WQKV = 10 * MiB, WS_WO = 16 * MiB, WS_WF = 20 * MiB, WS_WR = 28 * MiB, WS_WSH = 29 * MiB;
constexpr size_t WS_MODP = 36 * MiB, WS_MOD = 49 * MiB;
constexpr size_t WS_EGU = 54 * MiB, WS_ED = 118 * MiB;
constexpr size_t WS_XS = 150 * MiB;
constexpr size_t WS_STOK = 294 * MiB, WS_SDST = 297 * MiB, WS_SW = 300 * MiB, WS_TKE = 303 * MiB, WS_TKW = 306 * MiB;
constexpr size_t WS_R = 309 * MiB;
constexpr size_t WS_Q = WS_R, WS_K = WS_R + 144 * MiB, WS_V = WS_R + 180 * MiB;
constexpr size_t WS_ABT = WS_R, WS_FH = WS_R + 256 * MiB, WS_FH1 = WS_R + 320 * MiB, WS_ABTC = WS_R + 321 * MiB, WS_FC = WS_R + 353 * MiB;
constexpr size_t WS_H = WS_R, WS_HS = WS_R + 320 * MiB, WS_YB = WS_R + 356 * MiB, WS_YS = WS_R + 676 * MiB;
constexpr size_t WS_END = WS_YS + 36 * MiB;
constexpr int MAXROWS = 655360;

constexpr int CW_TMO = 0, CW_BAR = 4096, CW_BCNT = 16384;

constexpr int RING_BYTES = 131072;
constexpr int L_MISC = RING_BYTES;
constexpr int L_TSTART = RING_BYTES + 256;
constexpr int L_PREF = L_TSTART + 1040;
constexpr int L_LCNT = L_PREF + 256;
constexpr int L_TSEG = L_LCNT + 256;
constexpr int L_SCAN = L_TSEG + 2560;
constexpr int LDS_BYTES = 139264;
static_assert(L_SCAN + 1024 <= LDS_BYTES, "LDS map");

#define RLX_AGENT __ATOMIC_RELAXED, __HIP_MEMORY_SCOPE_AGENT
#define LDS_WAIT() asm volatile("s_waitcnt lgkmcnt(0)" ::: "memory")
#define VM_WAIT() asm volatile("s_waitcnt vmcnt(0)" ::: "memory")

__device__ __forceinline__ unsigned f2bf(float f) { unsigned u = __builtin_bit_cast(unsigned, f); return (u + 0x7fffu + ((u >> 16) & 1u)) >> 16; }
__device__ __forceinline__ unsigned pk2(float lo, float hi) { return f2bf(lo) | (f2bf(hi) << 16); }
typedef float f32x2_t __attribute__((ext_vector_type(2))); typedef __bf16 bf16x2_t __attribute__((ext_vector_type(2)));
__device__ __forceinline__ unsigned cvt_pk_bf16(float lo, float hi) { f32x2_t v = {lo, hi}; bf16x2_t b = __builtin_convertvector(v, bf16x2_t); return __builtin_bit_cast(unsigned, b); }
__device__ __forceinline__ float bflo(unsigned w) { return __builtin_bit_cast(float, w << 16); }
__device__ __forceinline__ float bfhi(unsigned w) { return __builtin_bit_cast(float, w & 0xffff0000u); }
__device__ __forceinline__ float wave_sum(float v) {
#pragma unroll
    for (int o = 1; o < 64; o <<= 1) v += __shfl_xor(v, o);
    return v;
}

__device__ __forceinline__ int opaque_tid() { int t = threadIdx.x; asm volatile("" : "+v"(t)); return t; }

#define XB_TMO      128
#define XB_XCNT(j)  (256  + 64 * (j))
#define XB_XSUB(j)  (1280 + 64 * (j))
#define XB_XGEN(j)  (2304 + 64 * (j))
#define XB_TOP      3328
#define XB_TOPGEN   3392
#define XCD_BAR_WORDS 3456
#define XB_SPIN_CAP (1u << 22)
__device__ __forceinline__ unsigned xb_ld(unsigned* p)              { return __hip_atomic_load(p, __ATOMIC_RELAXED, __HIP_MEMORY_SCOPE_AGENT); }
__device__ __forceinline__ unsigned xb_add(unsigned* p, unsigned v) { return __hip_atomic_fetch_add(p, v, __ATOMIC_RELAXED, __HIP_MEMORY_SCOPE_AGENT); }
__device__ __forceinline__ unsigned xb_xcc_id() { return (unsigned)__builtin_amdgcn_s_getreg((3 << 11) | 20) & 0xFu; }
#define XB_SPIN(cond, bar) do { unsigned _sp = 0; while (cond) { __builtin_amdgcn_s_sleep(1); \
    if ((++_sp & 255u) == 0u) { if (xb_ld(&(bar)[XB_TMO])) break; if (_sp > XB_SPIN_CAP) { atomicAdd(&(bar)[XB_TMO], 1u); break; } } } } while (0)
struct XcdBarrier { unsigned* bar; unsigned x; volatile LAS unsigned* st; };
__device__ __forceinline__ XcdBarrier xcd_barrier_post(unsigned* bar, volatile LAS unsigned* st) {
    XcdBarrier b; b.bar = bar; b.x = xb_xcc_id(); b.st = st;
    if (threadIdx.x == 0) (void)xb_add(&bar[XB_XCNT(b.x)], 1u);
    return b;
}
__device__ __forceinline__ void xcd_barrier_complete(unsigned* bar, unsigned x, unsigned& nloc, unsigned& nx) {
    const unsigned G = gridDim.x * gridDim.y * gridDim.z;
    unsigned sum, cnt, mine, sp = 0u;
    for (;;) {
        sum = 0u; cnt = 0u; mine = 0u;
#pragma unroll
        for (unsigned j = 0; j < 16; ++j) { const unsigned c = xb_ld(&bar[XB_XCNT(j)]); sum += c; cnt += (c > 0u) ? 1u : 0u; mine = (j == x) ? c : mine; }
        if (sum == G) break;
        __builtin_amdgcn_s_sleep(1);
        if ((++sp & 255u) == 0u) { if (xb_ld(&bar[XB_TMO])) break; if (sp > XB_SPIN_CAP) { atomicAdd(&bar[XB_TMO], 1u); break; } }
    }
    nloc = mine > 0u ? mine : 1u; nx = cnt > 0u ? cnt : 1u;
}
__device__ __forceinline__ void xcd_barrier(const XcdBarrier& b) {
    asm volatile("s_waitcnt vmcnt(0)" ::: "memory");
    __syncthreads();
    if (threadIdx.x == 0) {
        unsigned* bar = b.bar; unsigned bx = b.x; asm volatile("" : "+s"(bx));
        __builtin_amdgcn_s_waitcnt(0);
        unsigned nloc = b.st[0], nx = b.st[1];
        if (nloc == 0u) { xcd_barrier_complete(bar, bx, nloc, nx); b.st[0] = nloc; b.st[1] = nx; }
        const unsigned old = xb_add(&bar[XB_XSUB(bx)], 1u);
        const unsigned gen = old / nloc;
        if (old + 1u == (gen + 1u) * nloc) {
            __builtin_amdgcn_fence(__ATOMIC_RELEASE, "agent");
            asm volatile("s_waitcnt vmcnt(0)" ::: "memory");
            const unsigned og = xb_add(&bar[XB_TOP], 1u);
            const unsigned tg = og / nx;
            if (og + 1u == (tg + 1u) * nx) xb_add(&bar[XB_TOPGEN], 1u);
            else XB_SPIN(xb_ld(&bar[XB_TOPGEN]) == tg, bar);
            __builtin_amdgcn_fence(__ATOMIC_ACQUIRE, "agent");
            xb_add(&bar[XB_XGEN(bx)], 1u);
            asm volatile("s_waitcnt vmcnt(0)" ::: "memory");
        } else {
            XB_SPIN(xb_ld(&bar[XB_XGEN(bx)]) == gen, bar);
            __builtin_amdgcn_fence(__ATOMIC_ACQUIRE, "agent");
            asm volatile("s_waitcnt vmcnt(0)" ::: "memory");
        }
    }
    __syncthreads();
}

namespace pg {
constexpr int BM = 256, BK = 64, HALF = 128, HTB = HALF * BK * 2;
__host__ __device__ __forceinline__ int lds_byte(int r, int c) { const int st = (r >> 4) * 2 + (c >> 5), rr = r & 15, cc = c & 31, ob = rr * 64 + cc * 2; return st * 1024 + (ob ^ (((ob >> 9) & 1) << 5)); }
__host__ __device__ __forceinline__ void stage_rc(int b, int& R, int& C) { const int st = b / 1024, sb = b % 1024, swz = sb ^ (((sb >> 9) & 1) << 5); R = (st >> 1) * 16 + swz / 64; C = (st & 1) * 32 + (swz % 64) / 2; }
__host__ __device__ __forceinline__ int perm32(int rho) { const int n = rho >> 4, i = rho & 15; return 8 * (i >> 2) + 4 * n + (i & 3); }

struct Unit {
    const char* A;
    const char* B;
    const int* gidx;
    int gbase;
    int nt;
    char* out; int ldc; float scale; int flags; int i0; int i1;
    const int* l0; const float* l1;
};

template <class Epi, class Sched, bool GATHER>
__device__ __forceinline__ void gemm_phase(LAS unsigned char* lds, const unsigned lda, const unsigned ldb, const char* gtable, const Sched& S, const Epi& E) {
    const int tid = opaque_tid(), wid = __builtin_amdgcn_readfirstlane(tid >> 6), lane = tid & 63, wr = wid >> 2, wc = wid & 3, fr = lane & 15, fq = lane >> 4;
    unsigned voffA[2], voffB[2];
#pragma unroll
    for (int i = 0; i < 2; ++i) { int R, C; stage_rc(tid * 16 + i * 8192, R, C); const int Rb = (R & ~31) + perm32(R & 31);
        voffA[i] = (unsigned)R * lda + (unsigned)C * 2u; voffB[i] = (unsigned)Rb * ldb + (unsigned)C * 2u; }
    const size_t kstep = (size_t)(BK * 2);
    const size_t hstepA = (size_t)HALF * lda, hstepB = (size_t)HALF * ldb;
    const unsigned ldsw = (unsigned)wid * 1024u;
    const int aoff = lds_byte(wr * 64 + fr, fq * 8), boff = lds_byte(wc * 32 + fr, fq * 8);
#define PG_SA(b, h) (((b) * 2 + (h)) * HTB)
#define PG_SB(b, h) ((4 + (b) * 2 + (h)) * HTB)
#define PG_ST2(bufoff, p0, p1) do { \
        __builtin_amdgcn_global_load_lds((const unsigned*)(p0), (LAS unsigned*)(lds + (bufoff) + ldsw), 16, 0, 0); \
        __builtin_amdgcn_global_load_lds((const unsigned*)(p1), (LAS unsigned*)(lds + (bufoff) + ldsw + 8192), 16, 0, 0); } while (0)
#define PG_STB(bufoff, bp) PG_ST2(bufoff, (bp) + voffB[0], (bp) + voffB[1])
#define PG_STA(bufoff, ap, h, nx) do { if constexpr (GATHER) { PG_ST2(bufoff, (ap) + ((nx) ? nO[h][0] : cO[h][0]), (ap) + ((nx) ? nO[h][1] : cO[h][1])); } \
        else { PG_ST2(bufoff, (ap) + (h) * hstepA + voffA[0], (ap) + (h) * hstepA + voffA[1]); } } while (0)
#define PG_LDA(dst, b, h) do { _Pragma("unroll") for (int m = 0; m < 4; ++m) _Pragma("unroll") for (int k = 0; k < 2; ++k) dst[m][k] = *(const LAS bf16x8*)(lds + PG_SA(b, h) + aoff + m * 2048 + k * 1024); } while (0)
#define PG_LDB(dst, b, h) do { _Pragma("unroll") for (int n = 0; n < 2; ++n) _Pragma("unroll") for (int k = 0; k < 2; ++k) dst[n][k] = *(const LAS bf16x8*)(lds + PG_SB(b, h) + boff + n * 2048 + k * 1024); } while (0)
#define PG_MMA(ai, bj, At, Bt) do { __builtin_amdgcn_s_setprio(1); _Pragma("unroll") for (int m = 0; m < 4; ++m) _Pragma("unroll") for (int n = 0; n < 2; ++n) _Pragma("unroll") for (int k = 0; k < 2; ++k) \
        acc[ai][bj][m][n] = __builtin_amdgcn_mfma_f32_16x16x32_bf16(Bt[n][k], At[m][k], acc[ai][bj][m][n], 0, 0, 0); __builtin_amdgcn_s_setprio(0); } while (0)
#define PG_WAIT_V(n) asm volatile("s_waitcnt vmcnt(" #n ")" ::: "memory")
#define PG_WAIT_L(n) asm volatile("s_waitcnt lgkmcnt(" #n ")" ::: "memory")
#define PG_BAR __builtin_amdgcn_s_barrier()
#define PG_SCHED __builtin_amdgcn_sched_barrier(0)
#define PG_GOFF(dst, u) do { const int tz_ = opaque_tid(); _Pragma("unroll") for (int i = 0; i < 2; ++i) { int R_, C_; stage_rc(tz_ * 16 + i * 8192, R_, C_); \
        _Pragma("unroll") for (int h = 0; h < 2; ++h) { const int rr = h * HALF + R_; \
        const int ix = (u).gidx ? ((const GAS int*)(u).gidx)[rr] : (u).gbase + rr; dst[h][i] = (unsigned)ix * lda + (unsigned)C_ * 2u; } } } while (0)
    Unit cur, nxt; int ui = 0;
    if (!S.next(0, cur)) return;
    f32x4 acc[2][2][4][2];
#pragma unroll
    for (int a = 0; a < 2; ++a)
#pragma unroll
        for (int b = 0; b < 2; ++b)
#pragma unroll
            for (int m = 0; m < 4; ++m)
#pragma unroll
                for (int n = 0; n < 2; ++n) acc[a][b][m][n] = (f32x4){0.f, 0.f, 0.f, 0.f};
    bf16x8 At[4][2], B0[2][2], B1[2][2];
    unsigned cO[2][2] = {{0u, 0u}, {0u, 0u}}, nO[2][2] = {{0u, 0u}, {0u, 0u}};
    if constexpr (GATHER) { PG_GOFF(cO, cur); }
    const char* cA = GATHER ? gtable : cur.A; const char* cB = cur.B;
    PG_STB(PG_SB(0, 0), cB); PG_STB(PG_SB(0, 1), cB + hstepB); PG_STA(PG_SA(0, 0), cA, 0, false); PG_STA(PG_SA(0, 1), cA, 1, false);
    if (wr == 1) PG_BAR;
    PG_WAIT_V(2); PG_BAR;
    PG_STB(PG_SB(1, 0), cB + kstep); PG_STA(PG_SA(1, 0), cA + kstep, 0, false); PG_STB(PG_SB(1, 1), cB + hstepB + kstep);
    PG_WAIT_V(6); PG_BAR;
    for (;;) {
        const bool has_next = S.next(ui + 1, nxt);
        const int nt = cur.nt;
        if constexpr (GATHER) { if (has_next) { PG_GOFF(nO, nxt); } else {
#pragma unroll
            for (int h = 0; h < 2; ++h)
#pragma unroll
                for (int i = 0; i < 2; ++i) nO[h][i] = cO[h][i]; } }
        const char* nA = GATHER ? gtable : (has_next ? nxt.A : cA); const char* nB = has_next ? nxt.B : cB;
#pragma unroll 1
        for (int t = 0; t < nt; t += 2) {
            const bool last = (t == nt - 2);
            const char* a1 = cA + (size_t)(t + 1) * kstep;
            const char* a2 = last ? nA : cA + (size_t)(t + 2) * kstep; const char* b2 = last ? nB : cB + (size_t)(t + 2) * kstep;
            const char* a3 = a2 + kstep; const char* b3 = b2 + kstep;
            PG_LDB(B0, 0, 0); PG_LDB(B1, 0, 1); PG_SCHED; PG_LDA(At, 0, 0); PG_STA(PG_SA(1, 1), a1, 1, false);
            PG_WAIT_V(8); PG_WAIT_L(0); PG_BAR; PG_MMA(0, 0, At, B0); PG_MMA(0, 1, At, B1); PG_BAR; PG_SCHED;
            PG_LDA(At, 0, 1); PG_STB(PG_SB(0, 0), b2); PG_STB(PG_SB(0, 1), b2 + hstepB); PG_STA(PG_SA(0, 0), a2, 0, last);
            PG_WAIT_V(8); PG_WAIT_L(0); PG_BAR; PG_MMA(1, 0, At, B0); PG_MMA(1, 1, At, B1); PG_BAR; PG_SCHED;
            PG_LDB(B0, 1, 0); PG_LDB(B1, 1, 1); PG_SCHED; PG_LDA(At, 1, 0); PG_STA(PG_SA(0, 1), a2, 1, last);
            PG_WAIT_V(8); PG_WAIT_L(0); PG_BAR; PG_MMA(0, 0, At, B0); PG_MMA(0, 1, At, B1); PG_BAR; PG_SCHED;
            PG_LDA(At, 1, 1); PG_STB(PG_SB(1, 0), b3); PG_STB(PG_SB(1, 1), b3 + hstepB); PG_STA(PG_SA(1, 0), a3, 0, last);
            PG_WAIT_V(8); PG_WAIT_L(0); PG_BAR; PG_MMA(1, 0, At, B0); PG_MMA(1, 1, At, B1); PG_BAR; PG_SCHED;
        }
        if (wr == 0) PG_BAR;
        E(acc, cur, wr, wc, fr, fq);
        if (!has_next) break;
#pragma unroll
        for (int a = 0; a < 2; ++a)
#pragma unroll
            for (int b = 0; b < 2; ++b)
#pragma unroll
                for (int m = 0; m < 4; ++m)
#pragma unroll
                    for (int n = 0; n < 2; ++n) acc[a][b][m][n] = (f32x4){0.f, 0.f, 0.f, 0.f};
        cur = nxt; cA = nA; cB = nB; ++ui;
        if constexpr (GATHER) {
#pragma unroll
            for (int h = 0; h < 2; ++h)
#pragma unroll
                for (int i = 0; i < 2; ++i) cO[h][i] = nO[h][i]; }
        if (wr == 1) PG_BAR;
    }
    PG_WAIT_V(0);
    PG_BAR;
#undef PG_SA
#undef PG_SB
#undef PG_ST2
#undef PG_STB
#undef PG_STA
#undef PG_LDA
#undef PG_LDB
#undef PG_MMA
#undef PG_WAIT_V
#undef PG_WAIT_L
#undef PG_BAR
#undef PG_SCHED
#undef PG_GOFF
}

struct EpiStore {
    __device__ __forceinline__ void operator()(const f32x4 (&acc)[2][2][4][2], const Unit& u, int wr, int wc, int fr, int fq) const {
        const float s = u.scale;
#pragma unroll
        for (int ai = 0; ai < 2; ++ai)
#pragma unroll
            for (int m = 0; m < 4; ++m) { const int row = ai * HALF + wr * 64 + m * 16 + fr;
                char* rowp = u.out + (ptrdiff_t)row * u.ldc + (wc * 32 + 8 * fq) * 2;
                if (!((u.flags & 1) && row == 0)) {
#pragma unroll
                for (int bj = 0; bj < 2; ++bj) { const f32x4 v0 = acc[ai][bj][m][0] * s, v1 = acc[ai][bj][m][1] * s;
                    u32x4 w; w.x = cvt_pk_bf16(v0[0], v0[1]); w.y = cvt_pk_bf16(v0[2], v0[3]); w.z = cvt_pk_bf16(v1[0], v1[1]); w.w = cvt_pk_bf16(v1[2], v1[3]);
                    *(u32x4*)(rowp + bj * 256) = w; } } }
    }
};
struct EpiQKV {
    bf16_t* Q; bf16_t* K; bf16_t* V; const float* ropec; const float* ropes;
    __device__ __forceinline__ void operator()(const f32x4 (&acc)[2][2][4][2], const Unit& u, int wr, int wc, int fr, int fq) const {
        const int pm = u.i0, pn = u.i1; const bool lat = pm < (T / 256); const bool rope = lat && pn < 5;
        const float qs = pn < 4 ? C2 : 1.f;
        const int part = wc & 1;
        const int fi0 = 8 * (fq & 1);
        const float sgn = (fq < 2) ? -1.f : 1.f;
#pragma unroll
        for (int ai = 0; ai < 2; ++ai)
#pragma unroll
            for (int m = 0; m < 4; ++m) { const int row = ai * HALF + wr * 64 + m * 16 + fr; const int tok = pm * 256 + row;
                const int tl = tok & (SEQ - 1); const int pos = part ? (tl & 63) : (tl >> 6);
                f32x4 c0 = {1.f, 1.f, 1.f, 1.f}, c1 = c0, s0 = {0.f, 0.f, 0.f, 0.f}, s1 = s0;
                if (rope) { c0 = *(const f32x4*)(ropec + pos * 16 + fi0); c1 = *(const f32x4*)(ropec + pos * 16 + fi0 + 4); s0 = *(const f32x4*)(ropes + pos * 16 + fi0); s1 = *(const f32x4*)(ropes + pos * 16 + fi0 + 4); }
#pragma unroll
                for (int bj = 0; bj < 2; ++bj) { f32x4 v0 = acc[ai][bj][m][0], v1 = acc[ai][bj][m][1];
                    if (rope) { f32x4 p0, p1;
#pragma unroll
                        for (int j = 0; j < 4; ++j) { p0[j] = __shfl_xor(v0[j], 32); p1[j] = __shfl_xor(v1[j], 32); }
                        v0 = v0 * c0 + (p0 * sgn) * s0; v1 = v1 * c1 + (p1 * sgn) * s1; }
                    v0 = v0 * qs; v1 = v1 * qs;
                    u32x4 w; w.x = cvt_pk_bf16(v0[0], v0[1]); w.y = cvt_pk_bf16(v0[2], v0[3]); w.z = cvt_pk_bf16(v1[0], v1[1]); w.w = cvt_pk_bf16(v1[2], v1[3]);
                    const int col = bj * HALF + wc * 32 + 8 * fq;
                    bf16_t* dst = pn < 4 ? Q + (size_t)tok * 1024 + pn * 256 + col : (pn == 4 ? K + (size_t)tok * 256 + col : V + (size_t)tok * 256 + col);
                    *(u32x4*)dst = w; } }
    }
};
struct EpiSilu {
    __device__ __forceinline__ void operator()(const f32x4 (&acc)[2][2][4][2], const Unit& u, int wr, int wc, int fr, int fq) const {
#pragma unroll
        for (int ai = 0; ai < 2; ++ai)
#pragma unroll
            for (int m = 0; m < 4; ++m) { const int row = ai * HALF + wr * 64 + m * 16 + fr;
                float h[8];
#pragma unroll
                for (int n = 0; n < 2; ++n)
#pragma unroll
                    for (int j = 0; j < 4; ++j) { const float g = acc[ai][0][m][n][j], up = acc[ai][1][m][n][j]; h[n * 4 + j] = g / (1.f + __expf(-g)) * up; }
                u32x4 w; w.x = cvt_pk_bf16(h[0], h[1]); w.y = cvt_pk_bf16(h[2], h[3]); w.z = cvt_pk_bf16(h[4], h[5]); w.w = cvt_pk_bf16(h[6], h[7]);
                *(u32x4*)(u.out + (size_t)row * 512 + (wc * 32 + 8 * fq) * 2) = w; }
    }
};
struct EpiScatter {
    __device__ __forceinline__ void operator()(const f32x4 (&acc)[2][2][4][2], const Unit& u, int wr, int wc, int fr, int fq) const {
#pragma unroll
        for (int ai = 0; ai < 2; ++ai)
#pragma unroll
            for (int m = 0; m < 4; ++m) { const int row = ai * HALF + wr * 64 + m * 16 + fr;
                int dst; float w;
                if (u.l0) { dst = u.l0[row]; w = u.l1[row]; } else { dst = (u.i0 + row) * 9 + 8; w = 1.f; }
                if (dst >= 0) { char* rowp = u.out + (size_t)dst * 2048 + (wc * 32 + 8 * fq) * 2;
#pragma unroll
                    for (int bj = 0; bj < 2; ++bj) { const f32x4 v0 = acc[ai][bj][m][0] * w, v1 = acc[ai][bj][m][1] * w;
                        u32x4 o; o.x = cvt_pk_bf16(v0[0], v0[1]); o.y = cvt_pk_bf16(v0[2], v0[3]); o.z = cvt_pk_bf16(v1[0], v1[1]); o.w = cvt_pk_bf16(v1[2], v1[3]);
                        *(u32x4*)(rowp + bj * 256) = o; } } }
    }
};
struct EpiFp8 {
    __device__ __forceinline__ void operator()(const f32x4 (&acc)[2][2][4][2], const Unit& u, int wr, int wc, int fr, int fq) const {
        const int pn = u.i1;
#pragma unroll
        for (int ai = 0; ai < 2; ++ai)
#pragma unroll
            for (int m = 0; m < 4; ++m) { const int row = ai * HALF + wr * 64 + m * 16 + fr;
                char* rowp = u.out + (size_t)row * 1024 + (pn >> 1) * 8 + ((pn & 1) * 32 + 4 * wc + fq) * 16;
#pragma unroll
                for (int bj = 0; bj < 2; ++bj) { const f32x4 v0 = acc[ai][bj][m][0] * 16.f, v1 = acc[ai][bj][m][1] * 16.f;
                    int w0 = 0, w1 = 0;
                    w0 = __builtin_amdgcn_cvt_pk_fp8_f32(v0[0], v0[1], w0, false); w0 = __builtin_amdgcn_cvt_pk_fp8_f32(v0[2], v0[3], w0, true);
                    w1 = __builtin_amdgcn_cvt_pk_fp8_f32(v1[0], v1[1], w1, false); w1 = __builtin_amdgcn_cvt_pk_fp8_f32(v1[2], v1[3], w1, true);
                    u32x2 o; o.x = (unsigned)w0; o.y = (unsigned)w1;
                    *(u32x2*)(rowp + bj * 256) = o; } }
    }
};
__device__ __forceinline__ int xcd_remap(int L0, int NU) { const int q = NU >> 3, r = NU & 7, x = L0 & 7, off = L0 >> 3; return (x < r ? x * (q + 1) : r * (q + 1) + (x - r) * q) + off; }
}

namespace attn {
constexpr int SLOTB = 8192;
constexpr int LDS_K = 0, LDS_V = 2 * SLOTB, LDS_WS = 4 * SLOTB, LDS_OST = LDS_WS + NWAVES * 256, LDS_END = LDS_OST + NWAVES * 4096;
static_assert(LDS_END <= RING_BYTES, "attention LDS");
__device__ __forceinline__ int crow(int r, int hi) { return (r & 3) + 8 * (r >> 2) + 4 * hi; }
__device__ __forceinline__ void glds16(const void* gsrc, unsigned lds_dst) { unsigned keep;
    asm volatile("s_mov_b32 %0, m0\n\ts_mov_b32 m0, %2\n\ts_nop 0\n\tglobal_load_lds_dwordx4 %1, off\n\ts_mov_b32 m0, %0" : "=&s"(keep) : "v"(gsrc), "s"(lds_dst) : "memory"); }
__device__ __forceinline__ float rowmax(const f32x16& p0, const f32x16& p1) {
    float a = fmaxf(p0[0], p1[0]);
#pragma unroll
    for (int r = 1; r < 16; ++r) a = fmaxf(a, fmaxf(p0[r], p1[r]));
    auto rr = __builtin_amdgcn_permlane32_swap(__float_as_uint(a), __float_as_uint(a), false, false);
    return fmaxf(__uint_as_float(rr[0]), __uint_as_float(rr[1]));
}
typedef short v4i16_t __attribute__((ext_vector_type(4)));
__device__ __forceinline__ s16x4 vtr(const LAS unsigned char* p) { return __builtin_bit_cast(s16x4, __builtin_amdgcn_ds_read_tr16_b64_v4i16((LAS v4i16_t*)p)); }
__device__ __forceinline__ void pv(f32x16* o, const LAS unsigned char* vp, bf16x8 pa0, bf16x8 pa1, bf16x8 pa2, bf16x8 pa3) {
#pragma unroll
    for (int d0 = 0; d0 < 2; ++d0) { s16x4 lo[4], hi[4];
#pragma unroll
        for (int ks = 0; ks < 4; ++ks) { lo[ks] = vtr(vp + d0 * 4096 + ks * 1024); hi[ks] = vtr(vp + d0 * 4096 + ks * 1024 + 512); }
#define PK(k) (bf16x8){lo[k][0], lo[k][1], lo[k][2], lo[k][3], hi[k][0], hi[k][1], hi[k][2], hi[k][3]}
        o[d0] = __builtin_amdgcn_mfma_f32_32x32x16_bf16(pa0, PK(0), o[d0], 0, 0, 0);
        o[d0] = __builtin_amdgcn_mfma_f32_32x32x16_bf16(pa1, PK(1), o[d0], 0, 0, 0);
        o[d0] = __builtin_amdgcn_mfma_f32_32x32x16_bf16(pa2, PK(2), o[d0], 0, 0, 0);
        o[d0] = __builtin_amdgcn_mfma_f32_32x32x16_bf16(pa3, PK(3), o[d0], 0, 0, 0);
#undef PK
    }
}
__device__ __forceinline__ void attn_unit(const bf16_t* Q, const bf16_t* K, const bf16_t* V, bf16_t* O, int b, int h, int q0, bool isctx, float sink2, LAS unsigned char* shm) {
    const int tid = opaque_tid(), lane = tid & 63, r32 = lane & 31, hi = lane >> 5; const int wid = __builtin_amdgcn_readfirstlane(tid >> 6);
    const int kvh = h >> 2;
    const long qrow = isctx ? (long)T + b * CTXL + wid * 32 : (long)b * SEQ + q0 + wid * 32;
    const unsigned lds0 = (unsigned)(uintptr_t)shm;
    LAS float* wsf = (LAS float*)(shm + LDS_WS) + wid * 64;
    int jlo = 0, nl = 0;
    if (!isctx) { jlo = (q0 == 0) ? 2 : 0; int jhi = (SEQ - q0 + 128) / 64; if (jhi > 8) jhi = 8; nl = jhi - jlo; }
    const int NT = nl + 4;
    const long lat0 = (long)b * SEQ + q0 - 128 + 64 * jlo, ctx0 = (long)T + b * CTXL;
#define TROW(t) ((t) < nl ? lat0 + 64 * (t) : ctx0 + 64 * ((t) - nl))
    const int kcol = kvh * 64 + wid * 8, vcol = kvh * 64 + (wid >> 2) * 32 + (lane & 3) * 8, vrow = 16 * (wid & 3) + (lane >> 2);
    const unsigned kdst = lds0 + LDS_K + wid * 1024, vdst = lds0 + LDS_V + wid * 1024;
#define DMA_KV(t, slot) do { const long tr_ = TROW(t); glds16(K + (tr_ + lane) * 256 + kcol, (unsigned)__builtin_amdgcn_readfirstlane(kdst + (slot) * SLOTB)); \
        glds16(V + (tr_ + vrow) * 256 + vcol, (unsigned)__builtin_amdgcn_readfirstlane(vdst + (slot) * SLOTB)); } while (0)
    DMA_KV(0, 0);
    bf16x8 qr[4];
#pragma unroll
    for (int d0 = 0; d0 < 4; ++d0) qr[d0] = *(const GAS bf16x8*)(Q + (qrow + r32) * 1024 + h * 64 + d0 * 16 + hi * 8);
    float mrun = sink2, l_reg = (hi == 0) ? 1.f : 0.f;
    f32x16 o[2];
#pragma unroll
    for (int r = 0; r < 16; ++r) { o[0][r] = 0.f; o[1][r] = 0.f; }
    const LAS unsigned char* vp0 = shm + LDS_V + ((lane >> 4) & 1) * 32 + (lane & 3) * 8 + (4 * hi + ((lane & 15) >> 2)) * 64;
    const int qw = q0 + wid * 32;
    asm volatile("s_waitcnt vmcnt(0) lgkmcnt(0)\n\ts_barrier" ::: "memory");
    for (int t = 0; t < NT; ++t) {
        const int slot = t & 1;
        if (t + 1 < NT) DMA_KV(t + 1, slot ^ 1);
        const bool latt = t < nl;
        const int ks = q0 - 128 + 64 * (jlo + t);
        bool need = true;
        if (latt) need = (ks + 63 >= qw - 128) && (ks <= qw + 31 + 128);
        if (need) {
            f32x16 p0, p1;
#pragma unroll
            for (int r = 0; r < 16; ++r) { p0[r] = 0.f; p1[r] = 0.f; }
            const LAS unsigned char* kb = shm + LDS_K + slot * SLOTB + hi * 1024 + r32 * 16;
#pragma unroll
            for (int d0 = 0; d0 < 4; ++d0) {
                const bf16x8 b0 = *(const LAS bf16x8*)(kb + d0 * 2048), b1 = *(const LAS bf16x8*)(kb + d0 * 2048 + 512);
                p0 = __builtin_amdgcn_mfma_f32_32x32x16_bf16(b0, qr[d0], p0, 0, 0, 0);
                p1 = __builtin_amdgcn_mfma_f32_32x32x16_bf16(b1, qr[d0], p1, 0, 0, 0); }
            if (latt) { const int dq = qw + r32 - ks;
#pragma unroll
                for (int r = 0; r < 16; ++r) { const int d = dq - crow(r, hi); if (d > 128 || d < -128) p0[r] = -INFINITY; if (d - 32 > 128 || d - 32 < -128) p1[r] = -INFINITY; } }
            const float rm = rowmax(p0, p1);
            const float mnew = fmaxf(mrun, rm);
            if (__any(mnew > mrun)) {
                const float alpha = __builtin_amdgcn_exp2f(mrun - mnew); l_reg *= alpha; mrun = mnew;
                if (hi == 0) wsf[r32] = alpha;
                asm volatile("s_waitcnt lgkmcnt(0)" ::: "memory");
#pragma unroll
                for (int r = 0; r < 16; ++r) { const float f = wsf[crow(r, hi)]; o[0][r] *= f; o[1][r] *= f; }
            }
            float sacc = 0.f;
#pragma unroll
            for (int r = 0; r < 16; ++r) { p0[r] = __builtin_amdgcn_exp2f(p0[r] - mrun); p1[r] = __builtin_amdgcn_exp2f(p1[r] - mrun); sacc += p0[r] + p1[r]; }
            l_reg += sacc;
            u32x4 pw0, pw1, pw2, pw3;
#define PKW(P, B) cvt_pk_bf16(P[B], P[B + 1])
            pw0 = (u32x4){PKW(p0, 0), PKW(p0, 2), PKW(p0, 4), PKW(p0, 6)}; pw1 = (u32x4){PKW(p0, 8), PKW(p0, 10), PKW(p0, 12), PKW(p0, 14)};
            pw2 = (u32x4){PKW(p1, 0), PKW(p1, 2), PKW(p1, 4), PKW(p1, 6)}; pw3 = (u32x4){PKW(p1, 8), PKW(p1, 10), PKW(p1, 12), PKW(p1, 14)};
#undef PKW
            __builtin_amdgcn_sched_barrier(0);
            pv(o, vp0 + slot * SLOTB, __builtin_bit_cast(bf16x8, pw0), __builtin_bit_cast(bf16x8, pw1), __builtin_bit_cast(bf16x8, pw2), __builtin_bit_cast(bf16x8, pw3));
        }
        asm volatile("s_waitcnt vmcnt(0) lgkmcnt(0)\n\ts_barrier" ::: "memory");
    }
    { auto rr = __builtin_amdgcn_permlane32_swap(__float_as_uint(l_reg), __float_as_uint(l_reg), false, false); l_reg = __uint_as_float(rr[0]) + __uint_as_float(rr[1]); }
    if (hi == 0) wsf[32 + r32] = l_reg;
    asm volatile("s_waitcnt lgkmcnt(0)" ::: "memory");
    float rli[16];
#pragma unroll
    for (int r = 0; r < 16; ++r) rli[r] = __builtin_amdgcn_rcpf(wsf[32 + crow(r, hi)]);
    bf16_t* Ow = O + qrow * 1024 + h * 64;
    { LAS bf16_t* stg = (LAS bf16_t*)(shm + LDS_OST) + wid * 2048;
#pragma unroll
      for (int r = 0; r < 16; ++r) { const int orow = crow(r, hi);
#pragma unroll
          for (int d0 = 0; d0 < 2; ++d0) stg[orow * 64 + d0 * 32 + r32] = (bf16_t)f2bf(o[d0][r] * rli[r]); }
      asm volatile("s_waitcnt lgkmcnt(0)" ::: "memory");
#pragma unroll
      for (int i = 0; i < 4; ++i) { const int row = i * 8 + (lane >> 3), ch = lane & 7; const u32x4 v = *(const LAS u32x4*)(stg + row * 64 + ch * 8); *(GAS u32x4*)(Ow + (long)row * 1024 + ch * 8) = v; } }
    asm volatile("s_waitcnt lgkmcnt(0)" ::: "memory");
#undef TROW
#undef DMA_KV
}
}

struct Args {
    const float* in[20];
    float* out; unsigned char* ws;
};
struct Frame {
    LAS unsigned char* lds; unsigned* ctl; unsigned char* ws;
    int tid, lane, wave, gw;
    int blk;
    __device__ __forceinline__ void refresh() { tid = opaque_tid(); lane = tid & 63; wave = __builtin_amdgcn_readfirstlane(tid >> 6); gw = blk * 8 + wave;
        asm volatile("" : "+s"(ws)); ctl = (unsigned*)(ws + WS_CTL); }
};
constexpr int NGW = GRID * NWAVES;

struct Row { f32x4 v[4]; };
__device__ __forceinline__ int vq(int q, int lane) { return 128 * (q >> 1) + 2 * lane + (q & 1); }
__device__ __forceinline__ void row_load_bf16(Row& r, const bf16_t* p, int lane) {
#pragma unroll
    for (int j = 0; j < 2; ++j) { const u32x4 w = ((const GAS u32x4*)p)[64 * j + lane]; r.v[2 * j] = (f32x4){bflo(w.x), bfhi(w.x), bflo(w.y), bfhi(w.y)}; r.v[2 * j + 1] = (f32x4){bflo(w.z), bfhi(w.z), bflo(w.w), bfhi(w.w)}; } }
__device__ __forceinline__ void row_store_bf16(const Row& r, bf16_t* p, int lane) {
#pragma unroll
    for (int j = 0; j < 2; ++j) { u32x4 w; w.x = pk2(r.v[2 * j][0], r.v[2 * j][1]); w.y = pk2(r.v[2 * j][2], r.v[2 * j][3]); w.z = pk2(r.v[2 * j + 1][0], r.v[2 * j + 1][1]); w.w = pk2(r.v[2 * j + 1][2], r.v[2 * j + 1][3]); ((GAS u32x4*)p)[64 * j + lane] = w; } }
typedef float f32x2v __attribute__((ext_vector_type(2)));
__device__ __forceinline__ void row_load_fp8(Row& r, const unsigned char* p, int lane) {
    const u32x4 w = ((const GAS u32x4*)p)[lane];
#pragma unroll
    for (int q = 0; q < 4; ++q) { const f32x2v lo = __builtin_amdgcn_cvt_pk_f32_fp8((int)w[q], false), hi = __builtin_amdgcn_cvt_pk_f32_fp8((int)w[q], true); r.v[q] = (f32x4){lo[0], lo[1], hi[0], hi[1]}; } }
__device__ __forceinline__ void row_load_f32(Row& r, const float* p, int lane) {
#pragma unroll
    for (int q = 0; q < 4; ++q) r.v[q] = ((const GAS f32x4*)p)[vq(q, lane)]; }
__device__ __forceinline__ void row_store_f32(const Row& r, float* p, int lane) {
#pragma unroll
    for (int q = 0; q < 4; ++q) ((GAS f32x4*)p)[vq(q, lane)] = r.v[q]; }
__device__ __forceinline__ void row_normalize(Row& r, float eps) {
    float s = 0.f;
#pragma unroll
    for (int j = 0; j < 4; ++j) s += (r.v[j][0] + r.v[j][1]) + (r.v[j][2] + r.v[j][3]);
    const float mean = wave_sum(s) * (1.f / D); float q = 0.f;
#pragma unroll
    for (int j = 0; j < 4; ++j) { r.v[j] = r.v[j] - mean; q += (r.v[j][0] * r.v[j][0] + r.v[j][1] * r.v[j][1]) + (r.v[j][2] * r.v[j][2] + r.v[j][3] * r.v[j][3]); }
    const float rstd = 1.f / sqrtf(wave_sum(q) * (1.f / D) + eps);
#pragma unroll
    for (int j = 0; j < 4; ++j) r.v[j] = r.v[j] * rstd;
}
__device__ __forceinline__ void row_modulate(Row& r, const float* sh, const float* sc, int lane) {
    row_normalize(r, MOD_EPS);
#pragma unroll
    for (int j = 0; j < 4; ++j) { const f32x4 a = ((const GAS f32x4*)sc)[vq(j, lane)], b = ((const GAS f32x4*)sh)[vq(j, lane)]; r.v[j] = r.v[j] * (a + 1.f) + b; }
}
__device__ __forceinline__ int mod_row(int row) { return row < T ? (row >> 11) : 32; }
__device__ __forceinline__ const float* mod_vec(const unsigned char* ws, int layer, int mr, int chunk) { return (const float*)(ws + WS_MOD) + ((size_t)(layer * 33 + mr) * 6 + chunk) * 1024; }

__device__ __forceinline__ void conv_item(const float* W, int N, bf16_t* WT, int Kd, int kd0, int n0, int drow0, bool mirror, LAS float* scr, int lane) {
#pragma unroll 8
    for (int i = 0; i < 32; ++i) { const int kk = 2 * i + (lane >> 5); const int kd = kd0 + kk; const int ks = mirror ? ((kd & ~255) + ((256 - (kd & 255)) & 255)) : kd;
        scr[kk * 33 + (lane & 31)] = ((const GAS float*)W)[(size_t)ks * N + n0 + (lane & 31)]; }
    LDS_WAIT(); asm volatile("" ::: "memory");
    const int c = lane & 7;
#pragma unroll
    for (int j = 0; j < 4; ++j) { const int n = (lane >> 3) + 8 * j; const LAS float* s = scr + (8 * c) * 33 + n;
        u32x4 o; o.x = pk2(s[0 * 33], s[1 * 33]); o.y = pk2(s[2 * 33], s[3 * 33]); o.z = pk2(s[4 * 33], s[5 * 33]); o.w = pk2(s[6 * 33], s[7 * 33]);
        *(GAS u32x4*)(WT + (size_t)(drow0 + n) * Kd + kd0 + 8 * c) = o; }
    LDS_WAIT(); asm volatile("" ::: "memory");
}
__device__ __forceinline__ void conv_matrix_item(const float* W, int K, int N, bf16_t* WT, int mode, int roff, int item, LAS float* scr, int lane) {
    const int nblk = N / 32, kb = item / nblk, nb = item % nblk, n0 = 32 * nb;
    int drow0 = n0 + roff; if (mode == 1) drow0 = (n0 >> 7) * 256 + (n0 & 127); if (mode == 2) drow0 = (n0 >> 7) * 256 + 128 + (n0 & 127);
    conv_item(W, N, WT, K, 64 * kb, n0, drow0, mode == 3, scr, lane);
}
__device__ __forceinline__ void conv_item64(const float* W, int N, bf16_t* WT, int Kd, int k0, int n0, int drow0, LAS bf16_t* scr, int lane) {
    f32x4 v[16];
#pragma unroll
    for (int i = 0; i < 16; ++i) v[i] = *(const GAS f32x4*)(W + (size_t)(k0 + 4 * i + (lane >> 4)) * N + n0 + (lane & 15) * 4);
#pragma unroll
    for (int i = 0; i < 16; ++i) { u32x2 w; w.x = pk2(v[i][0], v[i][1]); w.y = pk2(v[i][2], v[i][3]); *(LAS u32x2*)(scr + (4 * i + (lane >> 4)) * 68 + (lane & 15) * 4) = w; }
    LDS_WAIT(); asm volatile("" ::: "memory");
    const int c = lane & 7;
#pragma unroll
    for (int j = 0; j < 8; ++j) { const int n = (lane >> 3) + 8 * j; const LAS bf16_t* p = scr + (8 * c) * 68 + n;
        u32x4 o; o.x = (unsigned)p[0] | ((unsigned)p[68] << 16); o.y = (unsigned)p[2 * 68] | ((unsigned)p[3 * 68] << 16); o.z = (unsigned)p[4 * 68] | ((unsigned)p[5 * 68] << 16); o.w = (unsigned)p[6 * 68] | ((unsigned)p[7 * 68] << 16);
        *(GAS u32x4*)(WT + (size_t)(drow0 + n) * Kd + k0 + 8 * c) = o; }
    LDS_WAIT(); asm volatile("" ::: "memory");
}
__device__ __forceinline__ void conv_experts(Frame& F, const float* wg, const float* wu, const float* wd, int layer) {
    F.refresh();
    LAS bf16_t* scr = (LAS bf16_t*)(F.lds + 32768 + F.wave * 8704);
    bf16_t* EGU = (bf16_t*)(F.ws + WS_EGU); bf16_t* ED = (bf16_t*)(F.ws + WS_ED);
    for (int it = F.gw; it < NE * 192; it += NGW) { const int e = it / 192, r = it % 192;
        const size_t eo = ((size_t)layer * NE + e) * (1024 * 256);
        if (r < 128) { const int q = r & 63, kb = q >> 2, nb = q & 3, n0 = 64 * nb; const int drow0 = (n0 >> 7) * 256 + (r < 64 ? 0 : 128) + (n0 & 127);
            conv_item64((r < 64 ? wg : wu) + eo, 256, EGU + (size_t)e * 512 * 1024, 1024, 64 * kb, n0, drow0, scr, F.lane); }
        else { const int q = r - 128, kb = q >> 4, nb = q & 15; conv_item64(wd + eo, 1024, ED + (size_t)e * 1024 * 256, 256, 64 * kb, 64 * nb, 64 * nb, scr, F.lane); } }
}
__device__ __forceinline__ void conv_small(Frame& F, const Args& a) {
    F.refresh();
    LAS float* scr = (LAS float*)(F.lds + 32768 + F.wave * 8448);
    for (int it = F.gw; it < 6272; it += NGW) {
        if (it < 1536) { const int j = it / 768, r = it % 768; conv_matrix_item(a.in[8] + (size_t)j * 1024 * 1536, 1024, 1536, (bf16_t*)(F.ws + WS_WQKV) + (size_t)j * 1536 * 1024, 0, 0, r, scr, F.lane); }
        else if (it < 2560) { const int q = it - 1536, j = q / 512, r = q % 512; conv_matrix_item(a.in[9] + (size_t)j * 1024 * 1024, 1024, 1024, (bf16_t*)(F.ws + WS_WO) + (size_t)j * 1024 * 1024, 0, 0, r, scr, F.lane); }
        else if (it < 4608) { const int q = it - 2560, j = q / 1024, r = q % 1024; bf16_t* dst = (bf16_t*)(F.ws + WS_WF) + (size_t)j * 2048 * 1024;
            if (r < 512) conv_matrix_item(a.in[11] + (size_t)j * 1024 * 1024, 1024, 1024, dst, 0, 0, r, scr, F.lane);
            else conv_matrix_item(a.in[11] + (size_t)j * 1024 * 1024, 1024, 1024, dst, 3, 1024, r - 512, scr, F.lane); }
        else if (it < 4736) { const int q = it - 4608, l = q / 32, r = q % 32; conv_matrix_item(a.in[12] + (size_t)l * 1024 * 64, 1024, 64, (bf16_t*)(F.ws + WS_WR) + (size_t)l * 64 * 1024, 0, 0, r, scr, F.lane); }
        else { const int q = it - 4736, l = q / 384, r = q % 384; bf16_t* gu = (bf16_t*)(F.ws + WS_WSH + (size_t)l * 1536 * 1024); bf16_t* dn = gu + 512 * 1024;
            if (r < 128) conv_matrix_item(a.in[17] + (size_t)l * 1024 * 256, 1024, 256, gu, 1, 0, r, scr, F.lane);
            else if (r < 256) conv_matrix_item(a.in[18] + (size_t)l * 1024 * 256, 1024, 256, gu, 2, 0, r - 128, scr, F.lane);
            else conv_matrix_item(a.in[19] + (size_t)l * 256 * 1024, 256, 1024, dn, 0, 0, r - 256, scr, F.lane); }
    }
    const int gt = F.blk * NTHR + F.tid, NGT = GRID * NTHR;
    const float TWO_PI = 6.283185307179586f;
    { float* rc = (float*)(F.ws + WS_ROPEC); float* rs = (float*)(F.ws + WS_ROPES);
      for (int i = gt; i < 64 * 16; i += NGT) { const int pos = i >> 4, fi = i & 15; const float inv = exp2f(-(float)fi * (13.287712379549449f / 16.f)); const float ang = (float)pos * inv; rc[i] = cosf(ang); rs[i] = sinf(ang); } }
    { bf16_t* cs = (bf16_t*)(F.ws + WS_CSN);
      for (int i = gt; i < 512 * 256; i += NGT) { const int r = i >> 8, n = i & 255, m = r & 255; const float ang = TWO_PI * (float)((m * n) & 255) * (1.f / 256.f); cs[i] = (bf16_t)f2bf(r < 256 ? cosf(ang) : -sinf(ang)); } }
    { bf16_t* dl = (bf16_t*)(F.ws + WS_DL);
      for (int i = gt; i < 1024 * 4096; i += NGT) { const int k = i >> 12, c = i & 4095, l = c & 2047; const float ang = TWO_PI * (float)((k * l) & 2047) * (1.f / 2048.f); dl[i] = (bf16_t)f2bf(c < 2048 ? cosf(ang) : sinf(ang)); } }
    { bf16_t* dl = (bf16_t*)(F.ws + WS_DLC);
      for (int i = gt; i < 256 * 512; i += NGT) { const int k = i >> 9, c = i & 511, l = c & 255; const float ang = TWO_PI * (float)((k * l) & 255) * (1.f / 256.f); dl[i] = (bf16_t)f2bf(c < 256 ? cosf(ang) : sinf(ang)); } }
}
__device__ __forceinline__ void mod_partials(Frame& F, const Args& a) {
    F.refresh();
    if (F.blk >= 192) return;
    const int l = F.blk / 48, cb = (F.blk % 48) / 4, kc = F.blk & 3;
    LAS float* s = (LAS float*)F.lds;
    for (int i = F.tid; i < 256 * 33; i += NTHR) { const int k = i / 33, r = i % 33; const float c = (r < 32) ? a.in[1][(size_t)r * 1024 + kc * 256 + k] : a.in[3][kc * 256 + k]; s[k * 36 + r] = c / (1.f + __expf(-c)); }
    __syncthreads();
    const int n = cb * 512 + F.tid;
    const GAS float* w = (const GAS float*)a.in[4] + ((size_t)l * 1024 + kc * 256) * 6144 + n;
    float acc[33];
#pragma unroll
    for (int r = 0; r < 33; ++r) acc[r] = 0.f;
#pragma unroll 4
    for (int k = 0; k < 256; ++k) { const float wv = w[(size_t)k * 6144];
#pragma unroll
        for (int r = 0; r < 33; ++r) acc[r] += s[k * 36 + r] * wv; }
    float* part = (float*)(F.ws + WS_MODP) + ((size_t)(kc * 4 + l) * 33) * 6144 + n;
#pragma unroll
    for (int r = 0; r < 33; ++r) part[(size_t)r * 6144] = acc[r];
    __syncthreads();
}
__device__ __forceinline__ void mod_finalize(Frame& F, const Args& a) {
    F.refresh();
    const int gt = F.blk * NTHR + F.tid, NGT = GRID * NTHR; const float* part = (const float*)(F.ws + WS_MODP); float* mod = (float*)(F.ws + WS_MOD);
    for (int i = gt; i < 4 * 33 * 6144; i += NGT) { const int l = i / (33 * 6144), n = i % 6144; float v = a.in[5][l * 6144 + n];
#pragma unroll
        for (int kc = 0; kc < 4; ++kc) v += part[(size_t)kc * 4 * 33 * 6144 + i]; mod[i] = v; }
}
__device__ __forceinline__ void rows_init(Frame& F, const Args& a) {
    F.refresh();
    bf16_t* XS = (bf16_t*)(F.ws + WS_XS); bf16_t* U = (bf16_t*)a.out; const float* part = (const float*)(F.ws + WS_MODP);
    for (int row = F.gw; row < TT; row += NGW) {
        Row r; row_load_f32(r, row < T ? a.in[0] + (size_t)row * D : a.in[2] + (size_t)(row - T) * D, F.lane);
        row_store_bf16(r, XS + (size_t)row * D, F.lane);
        row_normalize(r, MOD_EPS); const int mr = mod_row(row);
#pragma unroll
        for (int j = 0; j < 4; ++j) { const int e = vq(j, F.lane);
            f32x4 sh = ((const GAS f32x4*)(a.in[5]))[e], sc = ((const GAS f32x4*)(a.in[5] + 1024))[e];
#pragma unroll
            for (int kc = 0; kc < 4; ++kc) { const float* pp = part + ((size_t)(kc * 4 + 0) * 33 + mr) * 6144; sh += ((const GAS f32x4*)pp)[e]; sc += ((const GAS f32x4*)(pp + 1024))[e]; }
            r.v[j] = r.v[j] * (sc + 1.f) + sh; }
        row_store_bf16(r, U + (size_t)row * D, F.lane);
    }
}
__device__ __forceinline__ void rows_post1(Frame& F, const Args& a, int layer, int nrows) {
    F.refresh();
    bf16_t* XS = (bf16_t*)(F.ws + WS_XS); bf16_t* U = (bf16_t*)a.out;
    const float* lg = a.in[6] + (size_t)(layer * 2 + 0) * D; const float* lb = a.in[7] + (size_t)(layer * 2 + 0) * D;
    for (int row = F.gw; row < nrows; row += NGW) { const int mr = mod_row(row);
        Row x, y; row_load_bf16(x, XS + (size_t)row * D, F.lane); row_load_bf16(y, U + (size_t)row * D, F.lane);
        const float* g1 = mod_vec(F.ws, layer, mr, 2);
#pragma unroll
        for (int j = 0; j < 4; ++j) x.v[j] = x.v[j] * ALPHA + ((const GAS f32x4*)g1)[vq(j, F.lane)] * y.v[j];
        row_normalize(x, LN_EPS);
#pragma unroll
        for (int j = 0; j < 4; ++j) x.v[j] = x.v[j] * ((const GAS f32x4*)lg)[vq(j, F.lane)] + ((const GAS f32x4*)lb)[vq(j, F.lane)];
        row_store_bf16(x, XS + (size_t)row * D, F.lane);
        row_modulate(x, mod_vec(F.ws, layer, mr, 3), mod_vec(F.ws, layer, mr, 4), F.lane);
        row_store_bf16(x, U + (size_t)row * D, F.lane);
    }
}
__device__ __forceinline__ void rows_post2(Frame& F, const Args& a, int layer, int t0, int n) {
    F.refresh();
    bf16_t* XS = (bf16_t*)(F.ws + WS_XS); bf16_t* U = (bf16_t*)a.out; const unsigned char* YB = (const unsigned char*)(F.ws + WS_YB); const unsigned char* YS = (const unsigned char*)(F.ws + WS_YS);
    const int* spos = (const int*)(F.ws + WS_SDST); const float* tkw = (const float*)(F.ws + WS_TKW);
    const float* lg = a.in[6] + (size_t)(layer * 2 + 1) * D; const float* lb = a.in[7] + (size_t)(layer * 2 + 1) * D;
    for (int i = F.gw; i < n; i += NGW) { const int row = t0 + i; const int mr = mod_row(row);
        Row x, y; row_load_bf16(x, XS + (size_t)row * D, F.lane);
        int pj = 0; float wj = 0.f; if (F.lane < 8) { pj = ((const GAS int*)spos)[(size_t)row * 8 + F.lane]; wj = ((const GAS float*)tkw)[(size_t)row * 8 + F.lane]; }
        row_load_fp8(y, YS + (size_t)i * D, F.lane);
#pragma unroll
        for (int j = 0; j < 4; ++j) y.v[j] = y.v[j] * (1.f / 16.f);
#pragma unroll
        for (int s = 0; s < 8; ++s) { const int ps = __builtin_amdgcn_readlane(pj, s); const float ws_ = __builtin_bit_cast(float, __builtin_amdgcn_readlane(__builtin_bit_cast(int, wj), s));
            Row z; row_load_fp8(z, YB + (size_t)ps * D, F.lane); const float wz = ws_ * (1.f / 16.f);
#pragma unroll
            for (int j = 0; j < 4; ++j) y.v[j] += z.v[j] * wz; }
        const float* g2 = mod_vec(F.ws, layer, mr, 5);
#pragma unroll
        for (int j = 0; j < 4; ++j) x.v[j] = x.v[j] * ALPHA + ((const GAS f32x4*)g2)[vq(j, F.lane)] * y.v[j];
        row_normalize(x, LN_EPS);
#pragma unroll
        for (int j = 0; j < 4; ++j) x.v[j] = x.v[j] * ((const GAS f32x4*)lg)[vq(j, F.lane)] + ((const GAS f32x4*)lb)[vq(j, F.lane)];
        if (layer == 3) { row_store_f32(x, a.out + (size_t)row * D, F.lane); }
        else { row_store_bf16(x, XS + (size_t)row * D, F.lane);
            row_modulate(x, mod_vec(F.ws, layer + 1, mr, 0), mod_vec(F.ws, layer + 1, mr, 1), F.lane);
            row_store_bf16(x, U + (size_t)row * D, F.lane); }
    }
}

__device__ __forceinline__ void route_tokens(Frame& F, const Args& a, int layer, int ntok) {
    F.refresh();
    const int TPB = ntok / GRID;
    const bf16_t* U = (const bf16_t*)a.out; const bf16_t* Wr = (const bf16_t*)(F.ws + WS_WR) + (size_t)layer * 64 * 1024;
    int* tke = (int*)(F.ws + WS_TKE); float* tkw = (float*)(F.ws + WS_TKW);
    LAS int* lcnt = (LAS int*)(F.lds + L_LCNT);
    LAS float* sc = (LAS float*)(F.lds) + F.wave * 1024;
    if (F.tid < 64) lcnt[F.tid] = 0;
    __syncthreads();
    const int lane = F.lane, fr = lane & 15, fq = lane >> 4;
    const float bias = a.in[13][layer * 64 + lane];
    const int ntile = TPB / 16;
    for (int tl = F.wave; tl < ntile; tl += NWAVES) {
        const int t0 = F.blk * TPB + tl * 16;
        f32x4 acc[4];
#pragma unroll
        for (int n = 0; n < 4; ++n) acc[n] = (f32x4){0.f, 0.f, 0.f, 0.f};
        const GAS bf16x8* ap = (const GAS bf16x8*)(U + (size_t)(t0 + fr) * D + fq * 8);
        const GAS bf16x8* bp = (const GAS bf16x8*)(Wr + (size_t)fr * D + fq * 8);
#pragma unroll 4
        for (int ks = 0; ks < 32; ++ks) { const bf16x8 av = ap[ks * 4];
#pragma unroll
            for (int n = 0; n < 4; ++n) { const bf16x8 bv = bp[(size_t)n * 16 * (D / 8) + ks * 4]; acc[n] = __builtin_amdgcn_mfma_f32_16x16x32_bf16(av, bv, acc[n], 0, 0, 0); } }
#pragma unroll
        for (int n = 0; n < 4; ++n)
#pragma unroll
            for (int j = 0; j < 4; ++j) sc[(fq * 4 + j) * 64 + n * 16 + fr] = acc[n][j];
        LDS_WAIT();
        for (int tk = 0; tk < 16; ++tk) {
            const float logit = sc[tk * 64 + lane];
            const float s = 1.f / (1.f + __expf(-logit));
            const float sel = s + bias;
            const int g = lane >> 3;
            float m1 = sel; m1 = fmaxf(m1, __shfl_xor(m1, 1)); m1 = fmaxf(m1, __shfl_xor(m1, 2)); m1 = fmaxf(m1, __shfl_xor(m1, 4));
            const unsigned long long bm = __ballot(sel == m1);
            const unsigned gm = (unsigned)(bm >> (g * 8)) & 0xffu;
            const int first = g * 8 + __builtin_ctz(gm);
            float m2 = (lane == first) ? -INFINITY : sel; m2 = fmaxf(m2, __shfl_xor(m2, 1)); m2 = fmaxf(m2, __shfl_xor(m2, 2)); m2 = fmaxf(m2, __shfl_xor(m2, 4));
            const float gs = m1 + m2;
            float curg = gs; bool gok = false;
#pragma unroll 1
            for (int it = 0; it < 4; ++it) { float mx = curg;
#pragma unroll
                for (int o = 1; o < 64; o <<= 1) mx = fmaxf(mx, __shfl_xor(mx, o));
                const unsigned long long bb = __ballot(curg == mx); const int gi = (int)(__builtin_ctzll(bb) >> 3);
                if (g == gi) { gok = true; curg = -INFINITY; } }
            float cure = gok ? sel : -INFINITY; bool chosen = false; int rk = 0;
#pragma unroll 1
            for (int it = 0; it < 8; ++it) { float mx = cure;
#pragma unroll
                for (int o = 1; o < 64; o <<= 1) mx = fmaxf(mx, __shfl_xor(mx, o));
                const unsigned long long bb = __ballot(cure == mx); const int ei = (int)__builtin_ctzll(bb);
                if (lane == ei) { chosen = true; rk = it; cure = -INFINITY; } }
            const float tot = wave_sum(chosen ? s : 0.f);
            if (chosen) { const int tok = t0 + tk; tke[(size_t)tok * 8 + rk] = lane; tkw[(size_t)tok * 8 + rk] = s / tot * 2.5f; __hip_atomic_fetch_add(&lcnt[lane], 1, __ATOMIC_RELAXED, __HIP_MEMORY_SCOPE_WORKGROUP); }
        }
        LDS_WAIT();
    }
    __syncthreads();
    if (F.tid < 64) F.ctl[CW_BCNT + F.blk * 64 + F.tid] = (unsigned)lcnt[F.tid];
}
__device__ __forceinline__ void build_lists(Frame& F, int ntok) {
    F.refresh();
    constexpr int NSEG = NCHUNK * 64, BPC = GRID / NCHUNK;
    const int TPB = ntok / GRID, CH = ntok / NCHUNK;
    LAS int* tstart = (LAS int*)(F.lds + L_TSTART); LAS int* pref = (LAS int*)(F.lds + L_PREF); LAS int* lcnt = (LAS int*)(F.lds + L_LCNT);
    LAS unsigned char* tseg = (LAS unsigned char*)(F.lds + L_TSEG); LAS int* scan = (LAS int*)(F.lds + L_SCAN);
    const unsigned* bcnt = F.ctl + CW_BCNT;
    const int myc = F.blk / BPC, mylb = F.blk % BPC;
    int nseg = 0;
    if (F.tid < NSEG) { const int c = F.tid >> 6, e = F.tid & 63; int n = 0, p = 0;
        for (int lb = 0; lb < BPC; ++lb) { const int v = (int)__hip_atomic_load(bcnt + (c * BPC + lb) * 64 + e, RLX_AGENT); if (c == myc && lb < mylb) p += v; n += v; }
        nseg = n; scan[F.tid] = (n + 255) >> 8; if (c == myc) pref[e] = p; }
    if (F.tid < 64) lcnt[F.tid] = 0;
    __syncthreads();
    if (F.tid == 0) { int acc = 0; for (int s = 0; s < NSEG; ++s) { tstart[s] = acc; acc += scan[s]; } tstart[NSEG] = acc; }
    __syncthreads();
    if (F.tid < NSEG) { const int t0 = tstart[F.tid], t1 = tstart[F.tid + 1]; for (int t = t0; t < t1; ++t) tseg[t] = (unsigned char)F.tid; }
    int* stok = (int*)(F.ws + WS_STOK); int* spos = (int*)(F.ws + WS_SDST);
    const int* tke = (const int*)(F.ws + WS_TKE);
    { const int sseg = myc * 64 + mylb; if (mylb < 64 && F.tid == sseg) scan[0] = nseg; }
    __syncthreads();
    if (mylb < 64) { const int sseg = myc * 64 + mylb; const int n = scan[0]; const int base = tstart[sseg] * 256, end = tstart[sseg + 1] * 256;
      for (int p = base + n + F.tid; p < end; p += NTHR) stok[p] = myc * CH; }
    for (int tl = F.wave; tl < TPB; tl += NWAVES) { const int tok = F.blk * TPB + tl;
        if (F.lane < 8) { const int e = tke[(size_t)tok * 8 + F.lane];
            const int p = tstart[myc * 64 + e] * 256 + pref[e] + __hip_atomic_fetch_add(&lcnt[e], 1, __ATOMIC_RELAXED, __HIP_MEMORY_SCOPE_WORKGROUP);
            stok[p] = tok; spos[(size_t)tok * 8 + F.lane] = p - tstart[myc * 64] * 256; } }
    __syncthreads();
}

struct SchedQKV {
    const char* U; const char* W; int nfull, nu, c;
    __device__ __forceinline__ bool next(int i, pg::Unit& u) const {
        const int L0 = i * GRID + c; if (L0 >= nu) return false;
        int pm, pn;
        if (L0 < nfull) { const int L = pg::xcd_remap(L0, nfull); const int gid = L / 48, w = L % 48; pm = gid * 8 + (w & 7); pn = w >> 3; }
        else { const int q = L0 - nfull; pm = 256 + (q >> 1); pn = 4 + (q & 1); }
        u.A = U + (size_t)pm * 256 * 2048; u.B = W + (size_t)pn * 256 * 2048; u.gidx = nullptr; u.gbase = 0; u.nt = 16; u.out = nullptr; u.ldc = 0; u.scale = 1.f; u.flags = 0; u.i0 = pm; u.i1 = pn; u.l0 = nullptr; u.l1 = nullptr;
        return true; }
};
struct SchedDense {
    const char* A; const char* W; char* out; int nrt, nct, nt, c; size_t ldA;
    __device__ __forceinline__ bool next(int i, pg::Unit& u) const {
        const int nu = nrt * nct; const int L0 = i * GRID + c; if (L0 >= nu) return false;
        const int L = pg::xcd_remap(L0, nu); const int per = 8 * nct, gid = L / per, w = L % per, fm = gid * 8, gsz = (nrt - fm) < 8 ? (nrt - fm) : 8; const int pm = fm + (w % gsz), pn = w / gsz;
        u.A = A + (size_t)pm * 256 * ldA; u.B = W + (size_t)pn * 256 * ldA; u.gidx = nullptr; u.gbase = 0; u.nt = nt; u.out = out + (size_t)pm * 256 * 2048 + pn * 512; u.ldc = 2048; u.scale = 1.f; u.flags = 0; u.i0 = pm; u.i1 = pn; u.l0 = nullptr; u.l1 = nullptr;
        return true; }
};
struct SchedF1 {
    const char* CS; const char* U; char* ABT; char* ABTC; int nu, c;
    __device__ __forceinline__ bool next(int i, pg::Unit& u) const {
        const int L0 = i * GRID + c; if (L0 >= nu) return false;
        u.gidx = nullptr; u.gbase = 0; u.nt = 4; u.scale = 1.f; u.flags = 0; u.i0 = 0; u.i1 = 0; u.l0 = nullptr; u.l1 = nullptr;
        if (L0 < 2048) { const int L = pg::xcd_remap(L0, 2048); const int pm = L & 1, pn = (L >> 1) & 7, bg = L >> 4, b = bg >> 2, g = bg & 3;
            u.A = CS + (size_t)pm * 256 * 512; u.B = U + ((size_t)b * SEQ + pn * 256) * 2048 + g * 512; u.out = ABT + (size_t)bg * 256 * 8192 + (size_t)(pm * 2048 + pn * 256) * 2; u.ldc = 8192; }
        else { const int q = L0 - 2048; const int pm = q & 1, bg = q >> 1, b = bg >> 2, g = bg & 3;
            u.A = CS + (size_t)pm * 256 * 512; u.B = U + ((size_t)T + b * CTXL) * 2048 + g * 512; u.out = ABTC + (size_t)bg * 256 * 1024 + (size_t)pm * 512; u.ldc = 1024; }
        return true; }
};
struct SchedF2 {
    const char* DL; const char* ABT; char* FH; int c;
    __device__ __forceinline__ bool next(int i, pg::Unit& u) const {
        const int L0 = i * GRID + c; if (L0 >= 512) return false;
        const int L = pg::xcd_remap(L0, 512); const int pm = L & 3, bg = L >> 2, b = bg >> 2, g = bg & 3;
        u.A = DL + (size_t)pm * 256 * 8192; u.B = ABT + (size_t)bg * 256 * 8192; u.gidx = nullptr; u.gbase = 0; u.nt = 64; u.out = FH + ((size_t)b * 1024 + pm * 256) * 2048 + g * 512; u.ldc = 2048; u.scale = 0.001381067932004975f  ; u.flags = 0; u.i0 = 0; u.i1 = 0; u.l0 = nullptr; u.l1 = nullptr;
        return true; }
};
struct SchedF2c {
    const char* DLC; const char* ABTC; char* FC; int c;
    __device__ __forceinline__ bool next(int i, pg::Unit& u) const {
        const int L0 = i * GRID + c; if (L0 >= 128) return false;
        const int bg = L0, b = bg >> 2, g = bg & 3;
        u.A = DLC; u.B = ABTC + (size_t)bg * 256 * 1024; u.gidx = nullptr; u.gbase = 0; u.nt = 8; u.out = FC + ((size_t)b * 256) * 2048 + g * 512; u.ldc = 2048; u.scale = 1.f / 256.f; u.flags = 0; u.i0 = 0; u.i1 = 0; u.l0 = nullptr; u.l1 = nullptr;
        return true; }
};
struct SchedF3 {
    const char* FH; const char* FC; const char* W; char* Y; int nu, c;
    __device__ __forceinline__ bool next(int i, pg::Unit& u) const {
        const int L0 = i * GRID + c; if (L0 >= nu) return false;
        u.gidx = nullptr; u.gbase = 0; u.nt = 16; u.scale = 1.f; u.flags = 0; u.i0 = 0; u.i1 = 0; u.l0 = nullptr; u.l1 = nullptr;
        if (L0 < 1024) { const int L = pg::xcd_remap(L0, 1024); const int gid = L >> 6, w = L & 63, pm = gid * 8 + (w & 7), pn = w >> 3; const int b = pm >> 2, k0 = (pm & 3) * 256;
            u.A = FH + (size_t)pm * 256 * 2048; u.B = W + (size_t)pn * 256 * 2048;
            if (pn < 4) { u.out = Y + ((size_t)b * SEQ + k0) * 2048 + pn * 512; u.ldc = 2048; }
            else { u.out = Y + ((size_t)b * SEQ + SEQ - k0) * 2048 + (pn - 4) * 512; u.ldc = -2048; u.flags = (k0 == 0) ? 1 : 0; } }
        else { const int q = L0 - 1024; const int pm = q >> 2, pn = q & 3;
            u.A = FC + (size_t)pm * 256 * 2048; u.B = W + (size_t)pn * 256 * 2048; u.out = Y + ((size_t)T + pm * 256) * 2048 + pn * 512; u.ldc = 2048; }
        return true; }
};
struct SchedG1 {
    const char* EGU; const char* WSG; const int* STOK; char* H; char* HS; LAS const unsigned char* tseg; int ntl, nsh, c;
    __device__ __forceinline__ bool next(int i, pg::Unit& u) const {
        const int nu = (ntl + nsh) * 2; const int L0 = i * GRID + c; if (L0 >= nu) return false;
        const int L = pg::xcd_remap(L0, nu); const int pm = L >> 1, pn = L & 1;
        u.A = nullptr; u.gbase = 0; u.nt = 16; u.ldc = 512; u.scale = 1.f; u.flags = 0; u.i0 = 0; u.i1 = 0; u.l0 = nullptr; u.l1 = nullptr;
        if (pm < ntl) { const int e = __builtin_amdgcn_readfirstlane((int)tseg[pm]) & 63;
            u.gidx = STOK + (size_t)pm * 256; u.B = EGU + (size_t)e * 512 * 2048 + (size_t)pn * 256 * 2048; u.out = H + (size_t)pm * 256 * 512 + pn * 256; }
        else { const int ps = pm - ntl; u.gidx = nullptr; u.gbase = ps * 256; u.B = WSG + (size_t)pn * 256 * 2048; u.out = HS + (size_t)ps * 256 * 512 + pn * 256; }
        return true; }
};
struct SchedG2 {
    const char* ED; const char* WSD; const char* H; const char* HS; char* YB; char* YS; LAS const unsigned char* tseg; int t0, t1, nsh, ch, CH, c;
    __device__ __forceinline__ bool next(int i, pg::Unit& u) const {
        const int nr = t1 - t0; const int nu = (nr + nsh) * 4; const int L0 = i * GRID + c; if (L0 >= nu) return false;
        const int L = pg::xcd_remap(L0, nu); const int q = L >> 2, pn = L & 3;
        u.gidx = nullptr; u.gbase = 0; u.nt = 4; u.ldc = 1024; u.scale = 1.f; u.flags = 0; u.i0 = 0; u.i1 = pn; u.l0 = nullptr; u.l1 = nullptr;
        if (q < nr) { const int pm = t0 + q; const int e = __builtin_amdgcn_readfirstlane((int)tseg[pm]) & 63;
            u.A = H + (size_t)pm * 256 * 512; u.B = ED + (size_t)e * 1024 * 512 + (size_t)pn * 256 * 512; u.out = YB + (size_t)q * 256 * 1024; }
        else { const int ps = q - nr; u.A = HS + ((size_t)ch * CH + ps * 256) * 512; u.B = WSD + (size_t)pn * 256 * 512; u.out = YS + (size_t)ps * 256 * 1024; }
        return true; }
};

__device__ __forceinline__ void fnet_nyquist_rows(Frame& F) {
    F.refresh();
    const bf16_t* ABT = (const bf16_t*)(F.ws + WS_ABT); bf16_t* FH1 = (bf16_t*)(F.ws + WS_FH1);
    for (int r = F.gw; r < 128 * 256; r += NGW) { const int bg = r >> 8, m = r & 255, b = bg >> 2, g = bg & 3;
        const GAS u32x4* p = (const GAS u32x4*)(ABT + (size_t)r * 4096); float s = 0.f;
#pragma unroll
        for (int i = 0; i < 4; ++i) { const u32x4 w = p[i * 64 + F.lane]; s += (bflo(w.x) - bfhi(w.x)) + (bflo(w.y) - bfhi(w.y)) + (bflo(w.z) - bfhi(w.z)) + (bflo(w.w) - bfhi(w.w)); }
        s = wave_sum(s) * 0.001381067932004975f;
        if (F.lane == 0) FH1[(size_t)b * 1024 + g * 256 + m] = (bf16_t)f2bf(s); }
}
__device__ __forceinline__ void fnet_nyquist_out(Frame& F, const Args& a, int jl) {
    F.refresh();
    const bf16_t* FH1 = (const bf16_t*)(F.ws + WS_FH1); const bf16_t* W = (const bf16_t*)(F.ws + WS_WF) + (size_t)jl * 2048 * 1024; bf16_t* Y = (bf16_t*)a.out;
    LAS float* part = (LAS float*)F.lds;
    const int b = F.blk >> 3, n = (F.blk & 7) * 128 + (F.tid & 127), kq = F.tid >> 7;
    const GAS u32x4* wp = (const GAS u32x4*)(W + (size_t)n * 1024 + kq * 256); const GAS u32x4* fp = (const GAS u32x4*)(FH1 + (size_t)b * 1024 + kq * 256);
    float s = 0.f;
#pragma unroll 4
    for (int i = 0; i < 32; ++i) { const u32x4 w = wp[i], f = fp[i];
        s += bflo(w.x) * bflo(f.x) + bfhi(w.x) * bfhi(f.x) + bflo(w.y) * bflo(f.y) + bfhi(w.y) * bfhi(f.y) + bflo(w.z) * bflo(f.z) + bfhi(w.z) * bfhi(f.z) + bflo(w.w) * bflo(f.w) + bfhi(w.w) * bfhi(f.w); }
    part[F.tid] = s;
    __syncthreads();
    if (F.tid < 128) { const float t = (part[F.tid] + part[F.tid + 128]) + (part[F.tid + 256] + part[F.tid + 384]); Y[((size_t)b * SEQ + 1024) * D + n] = (bf16_t)f2bf(t); }
    __syncthreads();
}


#ifdef SELFCHECK
constexpr int CW_ERR = 1024;
constexpr size_t WS_OCHK = WS_R + 216 * MiB;
__device__ __forceinline__ void chk_report(unsigned* ctl, int id, float got, float ref, float tabs, float trel) {
    float e = fabsf(got - ref) / (tabs + trel * fabsf(ref)); if (!(e == e)) e = 1e30f; atomicMax(ctl + CW_ERR + id, __float_as_uint(e)); }
__device__ __forceinline__ float bf2f(bf16_t b) { return __builtin_bit_cast(float, (unsigned)b << 16); }
__constant__ int chk_toks[16] = {0, 1, 63, 64, 65, 127, 2047, 2048, 2049, 4096, 33000, 65535, 65536, 65537, 70000, 73727};
__constant__ int chk_ks[8] = {0, 1, 2, 255, 256, 1023, 1024, 700};
__constant__ int chk_ms[4] = {0, 1, 128, 255};
__constant__ int chk_ytoks[10] = {0, 1, 1023, 1024, 1025, 2047, 2048, 65535, 65536, 73727};
__constant__ int chk_ns[5] = {0, 1, 255, 256, 1023};
__constant__ int chk_cols[20] = {0, 7, 15, 16, 31, 32, 40, 48, 63, 64, 500, 1023, 1024, 1039, 1040, 1072, 1279, 1280, 1300, 1535};
__device__ __forceinline__ void chk_qkv(Frame& F, const Args& a, int layer, int id) {
    F.refresh(); const bf16_t* U = (const bf16_t*)a.out; const float* W = a.in[8] + (size_t)(layer >> 1) * 1024 * 1536;
    const bf16_t* Qb = (const bf16_t*)(F.ws + WS_Q); const bf16_t* Kb = (const bf16_t*)(F.ws + WS_K); const bf16_t* Vb = (const bf16_t*)(F.ws + WS_V);
    for (int s = F.gw; s < 320; s += NGW) { const int tok = chk_toks[s & 15], col = chk_cols[s >> 4];
        if (layer == 2 && tok >= T && col < 1024) continue;
        const bool rope = (tok < T) && col < 1280; const int hc = col & 63, first = (hc & 31) < 16; const int pcol = rope ? (first ? col + 16 : col - 16) : col;
        float x = 0.f, xp = 0.f;
        for (int k = F.lane; k < 1024; k += 64) { const float u = bf2f(U[(size_t)tok * D + k]); x += u * W[(size_t)k * 1536 + col]; xp += u * W[(size_t)k * 1536 + pcol]; }
        x = wave_sum(x); xp = wave_sum(xp);
        float ref = x;
        if (rope) { const int tl = tok & 2047, part = hc >> 5, pos = part ? (tl & 63) : (tl >> 6), fi = hc & 15; const float ang = (float)pos * powf(10000.f, -(float)fi / 16.f);
            ref = x * cosf(ang) + (first ? -xp : xp) * sinf(ang); }
        if (col < 1024) ref *= C2;
        const float got = col < 1024 ? bf2f(Qb[(size_t)tok * 1024 + col]) : (col < 1280 ? bf2f(Kb[(size_t)tok * 256 + col - 1024]) : bf2f(Vb[(size_t)tok * 256 + col - 1280]));
        if (F.lane == 0) chk_report(F.ctl, id, got, ref, 0.03f, 0.03f); }
}
__device__ __forceinline__ void chk_attn(Frame& F, const Args& a, int layer, int id) {
    F.refresh(); const bf16_t* Qb = (const bf16_t*)(F.ws + WS_Q); const bf16_t* Kb = (const bf16_t*)(F.ws + WS_K); const bf16_t* Vb = (const bf16_t*)(F.ws + WS_V); const bf16_t* Ob = (const bf16_t*)(F.ws + WS_OCHK);
    LAS float* lg = (LAS float*)F.lds + F.wave * 1024;
    for (int s = F.gw; s < 64; s += NGW) { const int tok = chk_toks[s & 15], h = (s >> 4) * 5, kvh = h >> 2;
        if (layer == 2 && tok >= T) continue;
        const bool isctx = tok >= T; const int b = isctx ? (tok - T) / CTXL : tok / SEQ, p = tok & (SEQ - 1);
        int nk = 0; const int lo = isctx ? 0 : (p - 128 < 0 ? 0 : p - 128), hi = isctx ? -1 : (p + 128 > SEQ - 1 ? SEQ - 1 : p + 128);
        const int nlat = isctx ? 0 : hi - lo + 1; nk = nlat + CTXL;
        float mx = a.in[10][(layer >> 1) * 16 + h] * LOG2E; const float sink2 = mx;
        for (int i = F.lane; i < nk; i += 64) { const size_t kr = i < nlat ? (size_t)b * SEQ + lo + i : (size_t)T + b * CTXL + (i - nlat); float d = 0.f;
            for (int e = 0; e < 64; ++e) d += bf2f(Qb[(size_t)tok * 1024 + h * 64 + e]) * bf2f(Kb[kr * 256 + kvh * 64 + e]);
            lg[i] = d; mx = fmaxf(mx, d); }
#pragma unroll
        for (int o = 1; o < 64; o <<= 1) mx = fmaxf(mx, __shfl_xor(mx, o));
        LDS_WAIT();
        float den = 0.f; for (int i = F.lane; i < nk; i += 64) den += exp2f(lg[i] - mx);
        den = wave_sum(den) + exp2f(sink2 - mx);
        float o = 0.f;
        for (int i = 0; i < nk; ++i) { const size_t kr = i < nlat ? (size_t)b * SEQ + lo + i : (size_t)T + b * CTXL + (i - nlat); o += exp2f(lg[i] - mx) * bf2f(Vb[kr * 256 + kvh * 64 + F.lane]); }
        o /= den;
        chk_report(F.ctl, id, bf2f(Ob[(size_t)tok * 1024 + h * 64 + F.lane]), o, 0.01f, 0.03f); chk_report(F.ctl, 32 + (s & 15), bf2f(Ob[(size_t)tok * 1024 + h * 64 + F.lane]), o, 0.01f, 0.03f);
        LDS_WAIT(); }
    __syncthreads();
}
__device__ __forceinline__ void chk_fnet_f(Frame& F, const Args& a, bool upd, int id) {
    F.refresh(); const bf16_t* U = (const bf16_t*)a.out; LAS float* red = (LAS float*)F.lds;
    for (int s = F.blk; s < 128 + (upd ? 64 : 0); s += GRID) {
        const bool cx = s >= 128; const int q = cx ? s - 128 : s; const int m = chk_ms[q & 3], g = ((q >> 2) & 1) * 3, b = ((q >> 3) & 1) * 31; int k = chk_ks[(q >> 4) & 7]; const int L = cx ? CTXL : SEQ; if (cx) k &= 255;
        const size_t row0 = cx ? (size_t)T + b * CTXL : (size_t)b * SEQ;
        float acc = 0.f;
        for (int l = F.wave; l < L; l += NWAVES) { float ca = 0.f, sa = 0.f;
            for (int n = F.lane; n < 256; n += 64) { const float u = bf2f(U[(row0 + l) * D + g * 256 + n]); const float an = 6.283185307179586f * (float)((m * n) & 255) / 256.f; const float sn = __sinf(an), cs = __cosf(an); ca += u * cs; sa += u * sn; }
            ca = wave_sum(ca); sa = wave_sum(sa); const float an = 6.283185307179586f * (float)((k * l) % L) / (float)L; const float sn = __sinf(an), cs = __cosf(an); acc += cs * ca - sn * sa; }
        if (F.lane == 0) red[F.wave] = acc;
        __syncthreads();
        if (F.tid == 0) { float t = 0.f; for (int w = 0; w < NWAVES; ++w) t += red[w]; t *= cx ? (1.f / 256.f) : 0.001381067932004975f;
            float got;
            if (cx) got = bf2f(((const bf16_t*)(F.ws + WS_FC))[((size_t)b * 256 + k) * D + g * 256 + m]);
            else if (k == 1024) got = bf2f(((const bf16_t*)(F.ws + WS_FH1))[(size_t)b * 1024 + g * 256 + m]);
            else got = bf2f(((const bf16_t*)(F.ws + WS_FH))[((size_t)b * 1024 + k) * D + g * 256 + m]);
            chk_report(F.ctl, id, got, t, 0.02f, 0.03f); }
        __syncthreads(); }
}
__device__ __forceinline__ void chk_fnet_y(Frame& F, const Args& a, int jl, bool upd, int id) {
    F.refresh(); const bf16_t* Y = (const bf16_t*)a.out; const float* W = a.in[11] + (size_t)jl * 1024 * 1024;
    const bf16_t* FH = (const bf16_t*)(F.ws + WS_FH); const bf16_t* FH1 = (const bf16_t*)(F.ws + WS_FH1); const bf16_t* FC = (const bf16_t*)(F.ws + WS_FC);
    for (int s = F.gw; s < 50; s += NGW) { const int tok = chk_ytoks[s % 10], n = chk_ns[s / 10]; if (tok >= T && !upd) continue;
        float acc = 0.f;
        for (int j = F.lane; j < 1024; j += 64) { float f;
            if (tok >= T) f = bf2f(FC[(size_t)(tok - T) * D + j]);
            else { const int b = tok >> 11, k = tok & 2047; if (k < 1024) f = bf2f(FH[((size_t)b * 1024 + k) * D + j]); else if (k == 1024) f = bf2f(FH1[(size_t)b * 1024 + j]);
                else f = bf2f(FH[((size_t)b * 1024 + (2048 - k)) * D + (j & ~255) + ((256 - (j & 255)) & 255)]); }
            acc += f * W[(size_t)j * 1024 + n]; }
        acc = wave_sum(acc);
        if (F.lane == 0) chk_report(F.ctl, id, bf2f(Y[(size_t)tok * D + n]), acc, 0.02f, 0.03f); }
}
__device__ __forceinline__ void chk_route(Frame& F, const Args& a, int layer, int ntok, int id) {
    F.refresh(); const bf16_t* U = (const bf16_t*)a.out; const float* Wr = a.in[12] + (size_t)layer * 1024 * 64; const int* tke = (const int*)(F.ws + WS_TKE); const float* tkw = (const float*)(F.ws + WS_TKW);
    for (int s = F.gw; s < 16; s += NGW) { const int tok = chk_toks[s]; if (tok >= ntok) continue; const int lane = F.lane;
        float lgt = 0.f; for (int k = 0; k < 1024; ++k) lgt += bf2f(U[(size_t)tok * D + k]) * Wr[(size_t)k * 64 + lane];
        const float sc = 1.f / (1.f + expf(-lgt)), sel = sc + a.in[13][layer * 64 + lane];
        float g1 = -INFINITY, g2 = -INFINITY;
#pragma unroll 1
        for (int j = 0; j < 8; ++j) { const float v = __shfl(sel, (lane & ~7) + j); if (v > g1) { g2 = g1; g1 = v; } else if (v > g2) g2 = v; }
        const float gs = g1 + g2; int gr = 0;
#pragma unroll 1
        for (int gp = 0; gp < 8; ++gp) { const float v = __shfl(gs, gp * 8); gr += (v > gs || (v == gs && gp < (lane >> 3))) ? 1 : 0; }
        const float sm = gr < 4 ? sel : -INFINITY; int rk = 0;
#pragma unroll 1
        for (int ep = 0; ep < 64; ++ep) { const float v = __shfl(sm, ep); rk += (v > sm || (v == sm && ep < lane)) ? 1 : 0; }
        const float tot = wave_sum(rk < 8 ? sc : 0.f); const float wref = sc / tot * 2.5f;
        int slot = -1; for (int j = 0; j < 8; ++j) if (tke[(size_t)tok * 8 + j] == lane) slot = j;
        float err = 0.f;
        if (slot >= 0) { if (rk >= 10) err = 10.f; else if (rk < 8) err = fabsf(tkw[(size_t)tok * 8 + slot] - wref) / (0.04f * wref); }
        else if (rk < 6) err = 10.f;
        const unsigned long long nsel = __ballot(slot >= 0); if (__builtin_popcountll(nsel) != 8) err = 20.f;
        atomicMax(F.ctl + CW_ERR + id, __float_as_uint(err)); }
}
__device__ __forceinline__ void chk_moe(Frame& F, const Args& a, int layer, int ntok, int ch, int id) {
    F.refresh(); const bf16_t* U = (const bf16_t*)a.out; const int* tke = (const int*)(F.ws + WS_TKE); const float* tkw = (const float*)(F.ws + WS_TKW);
    const int CH = ntok / NCHUNK; LAS float* hs = (LAS float*)F.lds; LAS float* us = hs + 512; LAS float* pg_ = us + 1024;
    for (int s = F.blk; s < 16; s += GRID) { const int tok = chk_toks[s]; if (tok >= ntok || tok / CH != ch) continue;
        for (int k = F.tid; k < 1024; k += NTHR) us[k] = bf2f(U[(size_t)tok * D + k]);
        __syncthreads();
        float y0 = 0.f, y1 = 0.f;
        for (int j = 0; j < 9; ++j) { const int e = j < 8 ? tke[(size_t)tok * 8 + j] : 0; const float w = j < 8 ? tkw[(size_t)tok * 8 + j] : 1.f;
            const float* wg = j < 8 ? a.in[14] + ((size_t)layer * NE + e) * 262144 : a.in[17] + (size_t)layer * 262144;
            const float* wu = j < 8 ? a.in[15] + ((size_t)layer * NE + e) * 262144 : a.in[18] + (size_t)layer * 262144;
            const float* wd = j < 8 ? a.in[16] + ((size_t)layer * NE + e) * 262144 : a.in[19] + (size_t)layer * 262144;
            const int hh = F.tid & 255, half = F.tid >> 8; float g = 0.f, u = 0.f;
            for (int k = half * 512; k < half * 512 + 512; ++k) { g += us[k] * wg[(size_t)k * 256 + hh]; u += us[k] * wu[(size_t)k * 256 + hh]; }
            pg_[F.tid] = g; pg_[512 + F.tid] = u;
            __syncthreads();
            if (F.tid < 256) { const float gg = pg_[F.tid] + pg_[F.tid + 256], uu = pg_[512 + F.tid] + pg_[512 + F.tid + 256]; hs[F.tid] = gg / (1.f + expf(-gg)) * uu; }
            __syncthreads();
            float t0 = 0.f, t1 = 0.f; for (int q = 0; q < 256; ++q) { t0 += hs[q] * wd[(size_t)q * 1024 + F.tid]; t1 += hs[q] * wd[(size_t)q * 1024 + 512 + F.tid]; }
            y0 += w * t0; y1 += w * t1;
            __syncthreads(); }
        float g0 = 0.f, g1 = 0.f; const int i = tok - ch * CH;
        { const unsigned char* YSb = (const unsigned char*)(F.ws + WS_YS); const unsigned char* YBb = (const unsigned char*)(F.ws + WS_YB); const int* spos = (const int*)(F.ws + WS_SDST);
          const int bo = 16 * (F.tid >> 3) + (F.tid & 7);
          auto f8 = [](unsigned char b) { return __builtin_amdgcn_cvt_pk_f32_fp8((int)b, false)[0] * (1.f / 16.f); };
          g0 = f8(YSb[(size_t)i * D + bo]); g1 = f8(YSb[(size_t)i * D + bo + 8]);
          for (int j = 0; j < 8; ++j) { const size_t ps = (size_t)spos[(size_t)tok * 8 + j]; const float w = tkw[(size_t)tok * 8 + j]; g0 += w * f8(YBb[ps * D + bo]); g1 += w * f8(YBb[ps * D + bo + 8]); } }
        chk_report(F.ctl, id, g0, y0, 0.04f, 0.06f); chk_report(F.ctl, id, g1, y1, 0.04f, 0.06f);
        __syncthreads(); }
}
#endif

#ifndef PH_MASK
#define PH_MASK 0xffffffffu
#endif
#define PH(b) ((PH_MASK >> (b)) & 1u)
__global__ void __launch_bounds__(NTHR, 2) fwd(Args a) {
    extern __shared__ __attribute__((aligned(16))) unsigned char lds_raw[];
    Frame F;
    F.lds = (LAS unsigned char*)lds_raw; F.ws = a.ws; F.ctl = (unsigned*)(a.ws + WS_CTL);
    F.blk = blockIdx.x; F.refresh();
    for (int u = F.tid; u < (LDS_BYTES - RING_BYTES) / 4; u += NTHR) ((LAS unsigned*)(F.lds + RING_BYTES))[u] = 0u;
    __syncthreads();
    const XcdBarrier bar = xcd_barrier_post(F.ctl + CW_BAR, (volatile LAS unsigned*)(F.lds + L_MISC) + 8);
#define GRID_BAR() xcd_barrier(bar)
    LAS unsigned char* ring = F.lds;
    const int c = F.blk;
#define ws (F.ws)
#define NEWPH() F.refresh()

    if (PH(0)) { conv_small(F, a);
    __syncthreads();
    mod_partials(F, a); }
    GRID_BAR();
    if (PH(1)) { rows_init(F, a);
    mod_finalize(F, a); }
    GRID_BAR();

    for (int layer = 0; layer < 4; ++layer) {
        const int jl = layer >> 1; const bool upd = layer < 2; const int nrows = upd ? TT : T;
        if ((layer & 1) == 0) {
            NEWPH();
            if (PH(2)) { SchedQKV S; S.U = (const char*)a.out; S.W = (const char*)(ws + WS_WQKV) + (size_t)jl * 1536 * 2048; S.nfull = (layer == 0) ? 288 * 6 : 256 * 6; S.nu = (layer == 0) ? 288 * 6 : 256 * 6 + 64; S.c = c;
              pg::EpiQKV E; E.Q = (bf16_t*)(ws + WS_Q); E.K = (bf16_t*)(ws + WS_K); E.V = (bf16_t*)(ws + WS_V); E.ropec = (const float*)(ws + WS_ROPEC); E.ropes = (const float*)(ws + WS_ROPES);
              pg::gemm_phase<pg::EpiQKV, SchedQKV, false>(ring, 2048u, 2048u, nullptr, S, E); }
            GRID_BAR();
#ifdef SELFCHECK
            if (SELFCHECK & 1) chk_qkv(F, a, layer, 1 + (layer >> 1));
#define OBUF ((bf16_t*)(ws + WS_OCHK))
#else
#define OBUF ((bf16_t*)(ws + WS_Q))
#endif
            NEWPH();
            if (PH(3)) { const int NU = 4096 + (layer == 0 ? 512 : 0);
              const bf16_t* Qb = (const bf16_t*)(ws + WS_Q); const bf16_t* Kb = (const bf16_t*)(ws + WS_K); const bf16_t* Vb = (const bf16_t*)(ws + WS_V);
              for (int i = 0; i * GRID + c < NU; ++i) { const int id = pg::xcd_remap(i * GRID + c, NU);
                  if (id < 4096) { const int hq = id & 3, qb = (id >> 2) & 7, kvh = (id >> 5) & 3, b = id >> 7, h = kvh * 4 + hq;
                      attn::attn_unit(Qb, Kb, Vb, OBUF, b, h, qb * 256, false, a.in[10][jl * 16 + h] * LOG2E, ring); }
                  else { const int cid = id - 4096, hq = cid & 3, kvh = (cid >> 2) & 3, b = cid >> 4, h = kvh * 4 + hq;
                      attn::attn_unit(Qb, Kb, Vb, OBUF, b, h, 0, true, a.in[10][jl * 16 + h] * LOG2E, ring); } } }
            GRID_BAR();
#ifdef SELFCHECK
            if (SELFCHECK & 1) chk_attn(F, a, layer, 3 + (layer >> 1));
#endif
            NEWPH();
            if (PH(4)) { SchedDense S; S.A = (const char*)OBUF; S.W = (const char*)(ws + WS_WO) + (size_t)jl * 1024 * 2048; S.out = (char*)a.out; S.nrt = nrows / 256; S.nct = 4; S.nt = 16; S.c = c; S.ldA = 2048;
              pg::EpiStore E; pg::gemm_phase<pg::EpiStore, SchedDense, false>(ring, 2048u, 2048u, nullptr, S, E); }
            GRID_BAR();
        } else {
            NEWPH();
            if (PH(5)) { SchedF1 S; S.CS = (const char*)(ws + WS_CSN); S.U = (const char*)a.out; S.ABT = (char*)(ws + WS_ABT); S.ABTC = (char*)(ws + WS_ABTC); S.nu = 2048 + (upd ? 256 : 0); S.c = c;
              pg::EpiStore E; pg::gemm_phase<pg::EpiStore, SchedF1, false>(ring, 512u, 2048u, nullptr, S, E); }
            GRID_BAR();
            NEWPH();
            if (PH(6)) { SchedF2 S; S.DL = (const char*)(ws + WS_DL); S.ABT = (const char*)(ws + WS_ABT); S.FH = (char*)(ws + WS_FH); S.c = c;
              pg::EpiStore E; pg::gemm_phase<pg::EpiStore, SchedF2, false>(ring, 8192u, 8192u, nullptr, S, E); }
            NEWPH();
            if (PH(7) && upd) { SchedF2c S; S.DLC = (const char*)(ws + WS_DLC); S.ABTC = (const char*)(ws + WS_ABTC); S.FC = (char*)(ws + WS_FC); S.c = c;
              pg::EpiStore E; pg::gemm_phase<pg::EpiStore, SchedF2c, false>(ring, 1024u, 1024u, nullptr, S, E); }
            if (PH(8)) fnet_nyquist_rows(F);
            GRID_BAR();
#ifdef SELFCHECK
            if (SELFCHECK & 2) chk_fnet_f(F, a, upd, 5 + (layer >> 1));
            GRID_BAR();
#endif
            NEWPH();
            if (PH(9)) { SchedF3 S; S.FH = (const char*)(ws + WS_FH); S.FC = (const char*)(ws + WS_FC); S.W = (const char*)(ws + WS_WF) + (size_t)jl * 2048 * 2048; S.Y = (char*)a.out; S.nu = 1024 + (upd ? 128 : 0); S.c = c;
              pg::EpiStore E; pg::gemm_phase<pg::EpiStore, SchedF3, false>(ring, 2048u, 2048u, nullptr, S, E); }
            if (PH(10)) fnet_nyquist_out(F, a, jl);
            GRID_BAR();
#ifdef SELFCHECK
            if (SELFCHECK & 8) chk_fnet_y(F, a, jl, upd, 7 + (layer >> 1));
            GRID_BAR();
#endif
        }
        if (PH(11)) rows_post1(F, a, layer, nrows);
        GRID_BAR();
        if (PH(12)) conv_experts(F, a.in[14], a.in[15], a.in[16], layer);
        __syncthreads();
        if (PH(13)) route_tokens(F, a, layer, nrows);
        GRID_BAR();
#ifdef SELFCHECK
        if ((SELFCHECK & 4) && layer < 2) chk_route(F, a, layer, nrows, 9);
#endif
        if (PH(14)) build_lists(F, nrows);
        GRID_BAR();
        LAS const int* tstart = (LAS const int*)(F.lds + L_TSTART); LAS const unsigned char* tseg = (LAS const unsigned char*)(F.lds + L_TSEG);
        const int ntl = __builtin_amdgcn_readfirstlane(tstart[NCHUNK * 64]);
        NEWPH();
        if (PH(15)) { SchedG1 S; S.EGU = (const char*)(ws + WS_EGU); S.WSG = (const char*)(ws + WS_WSH) + (size_t)layer * 1536 * 1024; S.STOK = (const int*)(ws + WS_STOK); S.H = (char*)(ws + WS_H); S.HS = (char*)(ws + WS_HS); S.tseg = tseg; S.ntl = ntl; S.nsh = nrows / 256; S.c = c;
          pg::EpiSilu E; pg::gemm_phase<pg::EpiSilu, SchedG1, true>(ring, 2048u, 2048u, (const char*)a.out, S, E); }
        GRID_BAR();
        const int CH = nrows / NCHUNK;
        for (int ch = 0; ch < NCHUNK; ++ch) {
            NEWPH();
            if (PH(16)) { SchedG2 S; S.ED = (const char*)(ws + WS_ED); S.WSD = (const char*)(ws + WS_WSH) + (size_t)layer * 1536 * 1024 + 512 * 2048; S.H = (const char*)(ws + WS_H); S.HS = (const char*)(ws + WS_HS); S.YB = (char*)(ws + WS_YB); S.YS = (char*)(ws + WS_YS); S.tseg = tseg;
              S.t0 = __builtin_amdgcn_readfirstlane(tstart[ch * 64]); S.t1 = __builtin_amdgcn_readfirstlane(tstart[ch * 64 + 64]); S.nsh = CH / 256; S.ch = ch; S.CH = CH; S.c = c;
              pg::EpiFp8 E; pg::gemm_phase<pg::EpiFp8, SchedG2, false>(ring, 512u, 512u, nullptr, S, E); }
            GRID_BAR();
#ifdef SELFCHECK
            if ((SELFCHECK & 4) && (layer == 0 || layer == 3)) { if (layer == 0 || ch == 0) chk_moe(F, a, layer, nrows, ch, 10 + (layer == 3)); GRID_BAR(); }
#endif
            if (PH(17)) rows_post2(F, a, layer, ch * CH, CH);
            if (!(layer == 3 && ch == NCHUNK - 1)) GRID_BAR();
        }
    }
#ifdef SELFCHECK
    GRID_BAR();
    { int bad = 0; float be = 0.f; for (int k = 15; k >= 1; --k) { const float e = __uint_as_float(__hip_atomic_load(F.ctl + CW_ERR + k, RLX_AGENT)); if (e > 1.f) { bad = k; be = e; } }
      int wt = 0; float we = 0.f; for (int k = 0; k < 16; ++k) { const float e = __uint_as_float(__hip_atomic_load(F.ctl + CW_ERR + 32 + k, RLX_AGENT)); if (e > we) { we = e; wt = k; } }
      if (bad) { F.refresh(); float cv = 3.f + bad + (be > 8.f ? 0.5f : 0.f);  Row r; for (int j = 0; j < 4; ++j) r.v[j] = (f32x4){cv, cv, cv, cv}; for (int row = F.gw; row < T; row += NGW) row_store_f32(r, a.out + (size_t)row * D, F.lane); } }
#endif
}

#undef ws
#undef NEWPH
extern "C" void kernel_launch(void* const* d_in, const int* in_sizes, int n_in, void* d_out, int out_size, void* d_ws, size_t ws_size, hipStream_t stream) {
    static int ready = 0;
    if (ready == 0) {
        if (n_in != 20 || out_size != T * D || ws_size < WS_END) { fprintf(stderr, "kernel_launch: unexpected problem (n_in %d out %d ws %zu need %zu)\n", n_in, out_size, ws_size, (size_t)WS_END); ready = -1; return; }
        if (hipFuncSetAttribute((const void*)fwd, hipFuncAttributeMaxDynamicSharedMemorySize, LDS_BYTES) != hipSuccess) { fprintf(stderr, "kernel_launch: hipFuncSetAttribute failed\n"); ready = -1; return; }
        int per_cu = 0;
        if (hipOccupancyMaxActiveBlocksPerMultiprocessor(&per_cu, (const void*)fwd, NTHR, LDS_BYTES) != hipSuccess || per_cu < 1) fprintf(stderr, "kernel_launch: occupancy query says %d blocks per CU\n", per_cu);
        (void)hipGetLastError();
        ready = 1;
    }
    if (ready < 0) return;
    (void)hipMemsetAsync((char*)d_ws + WS_CTL, 0, CTL_BYTES, stream);
    Args a{};
    for (int i = 0; i < 20; ++i) a.in[i] = (const float*)d_in[i];
    a.out = (float*)d_out; a.ws = (unsigned char*)d_ws;
    hipLaunchKernelGGL(fwd, dim3(GRID), dim3(NTHR), LDS_BYTES, stream, a);
}
```

```cpp
#include <hip/hip_runtime.h>
#include <cstdio>
#include <cstdint>

#define LAS __attribute__((address_space(3)))
#define GAS __attribute__((address_space(1)))
typedef unsigned short bf16_t;
typedef short bf16x8 __attribute__((ext_vector_type(8)));
typedef short s16x4 __attribute__((ext_vector_type(4)));
typedef float f32x4 __attribute__((ext_vector_type(4)));
typedef float f32x16 __attribute__((ext_vector_type(16)));
typedef unsigned u32x4 __attribute__((ext_vector_type(4)));
typedef unsigned u32x2 __attribute__((ext_vector_type(2)));

constexpr int D = 1024, NB = 32, SEQ = 2048, T = NB * SEQ, CTXL = 256, TC = NB * CTXL, TT = T + TC;
constexpr int NQKV = 1536, NE = 64;
constexpr float ALPHA = 1.681792830507429f;
constexpr float LN_EPS = 1e-5f, MOD_EPS = 1e-6f;
constexpr float C2 = 0.125f * 1.4426950408889634f;
constexpr float LOG2E = 1.4426950408889634f;
constexpr int NCHUNK = 2;
constexpr int NWAVES = 8, NTHR = 512, GRID = 256;

constexpr size_t MiB = 1u << 20;
constexpr size_t WS_CTL = 0, CTL_BYTES = 1 * MiB;
constexpr size_t WS_ROPEC = 1 * MiB, WS_ROPES = 1 * MiB + 4096, WS_CSN = 1 * MiB + 65536, WS_DLC = 1 * MiB + 524288, WS_DL = 2 * MiB;
constexpr size_t WS_WQKV = 10 * MiB, WS_WO = 16 * MiB, WS_WF = 20 * MiB, WS_WR = 28 * MiB, WS_WSH = 29 * MiB;
constexpr size_t WS_MODP = 36 * MiB, WS_MOD = 49 * MiB;
constexpr size_t WS_EGU = 54 * MiB, WS_ED = 118 * MiB;
constexpr size_t WS_XS = 150 * MiB;
constexpr size_t WS_STOK = 294 * MiB, WS_SDST = 297 * MiB, WS_SW = 300 * MiB, WS_TKE = 303 * MiB, WS_TKW = 306 * MiB;
constexpr size_t WS_R = 309 * MiB;
constexpr size_t WS_Q = WS_R, WS_K = WS_R + 144 * MiB, WS_V = WS_R + 180 * MiB;
constexpr size_t WS_ABT = WS_R, WS_FH = WS_R + 256 * MiB, WS_FH1 = WS_R + 320 * MiB, WS_ABTC = WS_R + 321 * MiB, WS_FC = WS_R + 353 * MiB;
constexpr size_t WS_H = WS_R, WS_HS = WS_R + 320 * MiB, WS_YB = WS_R + 356 * MiB, WS_YS = WS_R + 676 * MiB;
constexpr size_t WS_END = WS_YS + 36 * MiB;
constexpr int MAXROWS = 655360;

constexpr int CW_TMO = 0, CW_BAR = 4096, CW_BCNT = 16384;

constexpr int RING_BYTES = 131072;
constexpr int L_MISC = RING_BYTES;
constexpr int L_TSTART = RING_BYTES + 256;
constexpr int L_PREF = L_TSTART + 1040;
constexpr int L_LCNT = L_PREF + 256;
constexpr int L_TSEG = L_LCNT + 256;
constexpr int L_SCAN = L_TSEG + 2560;
constexpr int LDS_BYTES = 139264;
static_assert(L_SCAN + 1024 <= LDS_BYTES, "LDS map");

#define RLX_AGENT __ATOMIC_RELAXED, __HIP_MEMORY_SCOPE_AGENT
#define LDS_WAIT() asm volatile("s_waitcnt lgkmcnt(0)" ::: "memory")
#define VM_WAIT() asm volatile("s_waitcnt vmcnt(0)" ::: "memory")

__device__ __forceinline__ unsigned f2bf(float f) { unsigned u = __builtin_bit_cast(unsigned, f); return (u + 0x7fffu + ((u >> 16) & 1u)) >> 16; }
__device__ __forceinline__ unsigned pk2(float lo, float hi) { return f2bf(lo) | (f2bf(hi) << 16); }
typedef float f32x2_t __attribute__((ext_vector_type(2))); typedef __bf16 bf16x2_t __attribute__((ext_vector_type(2)));
__device__ __forceinline__ unsigned cvt_pk_bf16(float lo, float hi) { f32x2_t v = {lo, hi}; bf16x2_t b = __builtin_convertvector(v, bf16x2_t); return __builtin_bit_cast(unsigned, b); }
__device__ __forceinline__ float bflo(unsigned w) { return __builtin_bit_cast(float, w << 16); }
__device__ __forceinline__ float bfhi(unsigned w) { return __builtin_bit_cast(float, w & 0xffff0000u); }
__device__ __forceinline__ float wave_sum(float v) {
#pragma unroll
    for (int o = 1; o < 64; o <<= 1) v += __shfl_xor(v, o);
    return v;
}

__device__ __forceinline__ int opaque_tid() { int t = threadIdx.x; asm volatile("" : "+v"(t)); return t; }

#define XB_TMO      128
#define XB_XCNT(j)  (256  + 64 * (j))
#define XB_XSUB(j)  (1280 + 64 * (j))
#define XB_XGEN(j)  (2304 + 64 * (j))
#define XB_TOP      3328
#define XB_TOPGEN   3392
#define XCD_BAR_WORDS 3456
#define XB_SPIN_CAP (1u << 22)
__device__ __forceinline__ unsigned xb_ld(unsigned* p)              { return __hip_atomic_load(p, __ATOMIC_RELAXED, __HIP_MEMORY_SCOPE_AGENT); }
__device__ __forceinline__ unsigned xb_add(unsigned* p, unsigned v) { return __hip_atomic_fetch_add(p, v, __ATOMIC_RELAXED, __HIP_MEMORY_SCOPE_AGENT); }
__device__ __forceinline__ unsigned xb_xcc_id() { return (unsigned)__builtin_amdgcn_s_getreg((3 << 11) | 20) & 0xFu; }
#define XB_SPIN(cond, bar) do { unsigned _sp = 0; while (cond) { __builtin_amdgcn_s_sleep(1); \
    if ((++_sp & 255u) == 0u) { if (xb_ld(&(bar)[XB_TMO])) break; if (_sp > XB_SPIN_CAP) { atomicAdd(&(bar)[XB_TMO], 1u); break; } } } } while (0)
struct XcdBarrier { unsigned* bar; unsigned x; volatile LAS unsigned* st; };
__device__ __forceinline__ XcdBarrier xcd_barrier_post(unsigned* bar, volatile LAS unsigned* st) {
    XcdBarrier b; b.bar = bar; b.x = xb_xcc_id(); b.st = st;
    if (threadIdx.x == 0) (void)xb_add(&bar[XB_XCNT(b.x)], 1u);
    return b;
}
__device__ __forceinline__ void xcd_barrier_complete(unsigned* bar, unsigned x, unsigned& nloc, unsigned& nx) {
    const unsigned G = gridDim.x * gridDim.y * gridDim.z;
    unsigned sum, cnt, mine, sp = 0u;
    for (;;) {
        sum = 0u; cnt = 0u; mine = 0u;
#pragma unroll
        for (unsigned j = 0; j < 16; ++j) { const unsigned c = xb_ld(&bar[XB_XCNT(j)]); sum += c; cnt += (c > 0u) ? 1u : 0u; mine = (j == x) ? c : mine; }
        if (sum == G) break;
        __builtin_amdgcn_s_sleep(1);
        if ((++sp & 255u) == 0u) { if (xb_ld(&bar[XB_TMO])) break; if (sp > XB_SPIN_CAP) { atomicAdd(&bar[XB_TMO], 1u); break; } }
    }
    nloc = mine > 0u ? mine : 1u; nx = cnt > 0u ? cnt : 1u;
}
__device__ __forceinline__ void xcd_barrier(const XcdBarrier& b) {
    asm volatile("s_waitcnt vmcnt(0)" ::: "memory");
    __syncthreads();
    if (threadIdx.x == 0) {
        unsigned* bar = b.bar; unsigned bx = b.x; asm volatile("" : "+s"(bx));
        __builtin_amdgcn_s_waitcnt(0);
        unsigned nloc = b.st[0], nx = b.st[1];
        if (nloc == 0u) { xcd_barrier_complete(bar, bx, nloc, nx); b.st[0] = nloc; b.st[1] = nx; }
        const unsigned old = xb_add(&bar[XB_XSUB(bx)], 1u);
        const unsigned gen = old / nloc;
        if (old + 1u == (gen + 1u) * nloc) {
            __builtin_amdgcn_fence(__ATOMIC_RELEASE, "agent");
            asm volatile("s_waitcnt vmcnt(0)" ::: "memory");
            const unsigned og = xb_add(&bar[XB_TOP], 1u);
            const unsigned tg = og / nx;
            if (og + 1u == (tg + 1u) * nx) xb_add(&bar[XB_TOPGEN], 1u);
            else XB_SPIN(xb_ld(&bar[XB_TOPGEN]) == tg, bar);
            __builtin_amdgcn_fence(__ATOMIC_ACQUIRE, "agent");
            xb_add(&bar[XB_XGEN(bx)], 1u);
            asm volatile("s_waitcnt vmcnt(0)" ::: "memory");
        } else {
            XB_SPIN(xb_ld(&bar[XB_XGEN(bx)]) == gen, bar);
            __builtin_amdgcn_fence(__ATOMIC_ACQUIRE, "agent");
            asm volatile("s_waitcnt vmcnt(0)" ::: "memory");
        }
    }
    __syncthreads();
}

namespace pg {
constexpr int BM = 256, BK = 64, HALF = 128, HTB = HALF * BK * 2;
__host__ __device__ __forceinline__ int lds_byte(int r, int c) { const int st = (r >> 4) * 2 + (c >> 5), rr = r & 15, cc = c & 31, ob = rr * 64 + cc * 2; return st * 1024 + (ob ^ (((ob >> 9) & 1) << 5)); }
__host__ __device__ __forceinline__ void stage_rc(int b, int& R, int& C) { const int st = b / 1024, sb = b % 1024, swz = sb ^ (((sb >> 9) & 1) << 5); R = (st >> 1) * 16 + swz / 64; C = (st & 1) * 32 + (swz % 64) / 2; }
__host__ __device__ __forceinline__ int perm32(int rho) { const int n = rho >> 4, i = rho & 15; return 8 * (i >> 2) + 4 * n + (i & 3); }

struct Unit {
    const char* A;
    const char* B;
    const int* gidx;
    int gbase;
    int nt;
    char* out; int ldc; float scale; int flags; int i0; int i1;
    const int* l0; const float* l1;
};

template <class Epi, class Sched, bool GATHER>
__device__ __forceinline__ void gemm_phase(LAS unsigned char* lds, const unsigned lda, const unsigned ldb, const char* gtable, const Sched& S, const Epi& E) {
    const int tid = opaque_tid(), wid = __builtin_amdgcn_readfirstlane(tid >> 6), lane = tid & 63, wr = wid >> 2, wc = wid & 3, fr = lane & 15, fq = lane >> 4;
    unsigned voffA[2], voffB[2];
#pragma unroll
    for (int i = 0; i < 2; ++i) { int R, C; stage_rc(tid * 16 + i * 8192, R, C); const int Rb = (R & ~31) + perm32(R & 31);
        voffA[i] = (unsigned)R * lda + (unsigned)C * 2u; voffB[i] = (unsigned)Rb * ldb + (unsigned)C * 2u; }
    const size_t kstep = (size_t)(BK * 2);
    const size_t hstepA = (size_t)HALF * lda, hstepB = (size_t)HALF * ldb;
    const unsigned ldsw = (unsigned)wid * 1024u;
    const int aoff = lds_byte(wr * 64 + fr, fq * 8), boff = lds_byte(wc * 32 + fr, fq * 8);
#define PG_SA(b, h) (((b) * 2 + (h)) * HTB)
#define PG_SB(b, h) ((4 + (b) * 2 + (h)) * HTB)
#define PG_ST2(bufoff, p0, p1) do { \
        __builtin_amdgcn_global_load_lds((const unsigned*)(p0), (LAS unsigned*)(lds + (bufoff) + ldsw), 16, 0, 0); \
        __builtin_amdgcn_global_load_lds((const unsigned*)(p1), (LAS unsigned*)(lds + (bufoff) + ldsw + 8192), 16, 0, 0); } while (0)
#define PG_STB(bufoff, bp) PG_ST2(bufoff, (bp) + voffB[0], (bp) + voffB[1])
#define PG_STA(bufoff, ap, h, nx) do { if constexpr (GATHER) { PG_ST2(bufoff, (ap) + ((nx) ? nO[h][0] : cO[h][0]), (ap) + ((nx) ? nO[h][1] : cO[h][1])); } \
        else { PG_ST2(bufoff, (ap) + (h) * hstepA + voffA[0], (ap) + (h) * hstepA + voffA[1]); } } while (0)
#define PG_LDA(dst, b, h) do { _Pragma("unroll") for (int m = 0; m < 4; ++m) _Pragma("unroll") for (int k = 0; k < 2; ++k) dst[m][k] = *(const LAS bf16x8*)(lds + PG_SA(b, h) + aoff + m * 2048 + k * 1024); } while (0)
#define PG_LDB(dst, b, h) do { _Pragma("unroll") for (int n = 0; n < 2; ++n) _Pragma("unroll") for (int k = 0; k < 2; ++k) dst[n][k] = *(const LAS bf16x8*)(lds + PG_SB(b, h) + boff + n * 2048 + k * 1024); } while (0)
#define PG_MMA(ai, bj, At, Bt) do { __builtin_amdgcn_s_setprio(1); _Pragma("unroll") for (int m = 0; m < 4; ++m) _Pragma("unroll") for (int n = 0; n < 2; ++n) _Pragma("unroll") for (int k = 0; k < 2; ++k) \
        acc[ai][bj][m][n] = __builtin_amdgcn_mfma_f32_16x16x32_bf16(Bt[n][k], At[m][k], acc[ai][bj][m][n], 0, 0, 0); __builtin_amdgcn_s_setprio(0); } while (0)
#define PG_WAIT_V(n) asm volatile("s_waitcnt vmcnt(" #n ")" ::: "memory")
#define PG_WAIT_L(n) asm volatile("s_waitcnt lgkmcnt(" #n ")" ::: "memory")
#define PG_BAR __builtin_amdgcn_s_barrier()
#define PG_SCHED __builtin_amdgcn_sched_barrier(0)
#define PG_GOFF(dst, u) do { const int tz_ = opaque_tid(); _Pragma("unroll") for (int i = 0; i < 2; ++i) { int R_, C_; stage_rc(tz_ * 16 + i * 8192, R_, C_); \
        _Pragma("unroll") for (int h = 0; h < 2; ++h) { const int rr = h * HALF + R_; \
        const int ix = (u).gidx ? ((const GAS int*)(u).gidx)[rr] : (u).gbase + rr; dst[h][i] = (unsigned)ix * lda + (unsigned)C_ * 2u; } } } while (0)
#define PG_GIDX(dst, un) do { const int* gi_ = nullptr; int gb_ = 0; const bool ok_ = S.gsrc((un), gi_, gb_); const int tz_ = opaque_tid(); _Pragma("unroll") for (int i = 0; i < 2; ++i) { int R_, C_; stage_rc(tz_ * 16 + i * 8192, R_, C_); \
        _Pragma("unroll") for (int h = 0; h < 2; ++h) { const int rr = h * HALF + R_; dst[h][i] = (ok_ && gi_) ? ((const GAS int*)gi_)[rr] : gb_ + rr; } } } while (0)
#define PG_GCVT(dst, src) do { const int tz_ = opaque_tid(); _Pragma("unroll") for (int i = 0; i < 2; ++i) { int R_, C_; stage_rc(tz_ * 16 + i * 8192, R_, C_); \
        _Pragma("unroll") for (int h = 0; h < 2; ++h) dst[h][i] = (unsigned)src[h][i] * lda + (unsigned)C_ * 2u; } } while (0)
    Unit cur, nxt; int ui = 0;
    if (!S.next(0, cur)) return;
    f32x4 acc[2][2][4][2];
#pragma unroll
    for (int a = 0; a < 2; ++a)
#pragma unroll
        for (int b = 0; b < 2; ++b)
#pragma unroll
            for (int m = 0; m < 4; ++m)
#pragma unroll
                for (int n = 0; n < 2; ++n) acc[a][b][m][n] = (f32x4){0.f, 0.f, 0.f, 0.f};
    bf16x8 At[4][2], B0[2][2], B1[2][2];
    unsigned cO[2][2] = {{0u, 0u}, {0u, 0u}}, nO[2][2] = {{0u, 0u}, {0u, 0u}};
    int gI[2][2] = {{0, 0}, {0, 0}};
    if constexpr (GATHER) { PG_GOFF(cO, cur); PG_GIDX(gI, 1); }
    const char* cA = GATHER ? gtable : cur.A; const char* cB = cur.B;
    PG_STB(PG_SB(0, 0), cB); PG_STB(PG_SB(0, 1), cB + hstepB); PG_STA(PG_SA(0, 0), cA, 0, false); PG_STA(PG_SA(0, 1), cA, 1, false);
    if (wr == 1) PG_BAR;
    PG_WAIT_V(2); PG_BAR;
    PG_STB(PG_SB(1, 0), cB + kstep); PG_STA(PG_SA(1, 0), cA + kstep, 0, false); PG_STB(PG_SB(1, 1), cB + hstepB + kstep);
    PG_WAIT_V(6); PG_BAR;
    for (;;) {
        const bool has_next = S.next(ui + 1, nxt);
        const int nt = cur.nt;
        if constexpr (GATHER) { if (has_next) { PG_GCVT(nO, gI); PG_GIDX(gI, ui + 2); } else {
#pragma unroll
            for (int h = 0; h < 2; ++h)
#pragma unroll
                for (int i = 0; i < 2; ++i) nO[h][i] = cO[h][i]; } }
        const char* nA = GATHER ? gtable : (has_next ? nxt.A : cA); const char* nB = has_next ? nxt.B : cB;
#pragma unroll 1
        for (int t = 0; t < nt; t += 2) {
            const bool last = (t == nt - 2);
            const char* a1 = cA + (size_t)(t + 1) * kstep;
            const char* a2 = last ? nA : cA + (size_t)(t + 2) * kstep; const char* b2 = last ? nB : cB + (size_t)(t + 2) * kstep;
            const char* a3 = a2 + kstep; const char* b3 = b2 + kstep;
            PG_LDB(B0, 0, 0); PG_LDB(B1, 0, 1); PG_SCHED; PG_LDA(At, 0, 0); PG_STA(PG_SA(1, 1), a1, 1, false);
            PG_WAIT_V(8); PG_WAIT_L(0); PG_BAR; PG_MMA(0, 0, At, B0); PG_MMA(0, 1, At, B1); PG_BAR; PG_SCHED;
            PG_LDA(At, 0, 1); PG_STB(PG_SB(0, 0), b2); PG_STB(PG_SB(0, 1), b2 + hstepB); PG_STA(PG_SA(0, 0), a2, 0, last);
            PG_WAIT_V(8); PG_WAIT_L(0); PG_BAR; PG_MMA(1, 0, At, B0); PG_MMA(1, 1, At, B1); PG_BAR; PG_SCHED;
            PG_LDB(B0, 1, 0); PG_LDB(B1, 1, 1); PG_SCHED; PG_LDA(At, 1, 0); PG_STA(PG_SA(0, 1), a2, 1, last);
            PG_WAIT_V(8); PG_WAIT_L(0); PG_BAR; PG_MMA(0, 0, At, B0); PG_MMA(0, 1, At, B1); PG_BAR; PG_SCHED;
            PG_LDA(At, 1, 1); PG_STB(PG_SB(1, 0), b3); PG_STB(PG_SB(1, 1), b3 + hstepB); PG_STA(PG_SA(1, 0), a3, 0, last);
            PG_WAIT_V(8); PG_WAIT_L(0); PG_BAR; PG_MMA(1, 0, At, B0); PG_MMA(1, 1, At, B1); PG_BAR; PG_SCHED;
        }
        if (wr == 0) PG_BAR;
        E(acc, cur, wr, wc, fr, fq);
        if (!has_next) break;
#pragma unroll
        for (int a = 0; a < 2; ++a)
#pragma unroll
            for (int b = 0; b < 2; ++b)
#pragma unroll
                for (int m = 0; m < 4; ++m)
#pragma unroll
                    for (int n = 0; n < 2; ++n) acc[a][b][m][n] = (f32x4){0.f, 0.f, 0.f, 0.f};
        cur = nxt; cA = nA; cB = nB; ++ui;
        if constexpr (GATHER) {
#pragma unroll
            for (int h = 0; h < 2; ++h)
#pragma unroll
                for (int i = 0; i < 2; ++i) cO[h][i] = nO[h][i]; }
        if (wr == 1) PG_BAR;
    }
    PG_WAIT_V(0);
    PG_BAR;
#undef PG_SA
#undef PG_SB
#undef PG_ST2
#undef PG_STB
#undef PG_STA
#undef PG_LDA
#undef PG_LDB
#undef PG_MMA
#undef PG_WAIT_V
#undef PG_WAIT_L
#undef PG_BAR
#undef PG_SCHED
#undef PG_GOFF
#undef PG_GIDX
#undef PG_GCVT
}

struct EpiStore {
    __device__ __forceinline__ void operator()(const f32x4 (&acc)[2][2][4][2], const Unit& u, int wr, int wc, int fr, int fq) const {
        const float s = u.scale;
#pragma unroll
        for (int ai = 0; ai < 2; ++ai)
#pragma unroll
            for (int m = 0; m < 4; ++m) { const int row = ai * HALF + wr * 64 + m * 16 + fr;
                char* rowp = u.out + (ptrdiff_t)row * u.ldc + (wc * 32 + 8 * fq) * 2;
                if (!((u.flags & 1) && row == 0)) {
#pragma unroll
                for (int bj = 0; bj < 2; ++bj) { const f32x4 v0 = acc[ai][bj][m][0] * s, v1 = acc[ai][bj][m][1] * s;
                    u32x4 w; w.x = cvt_pk_bf16(v0[0], v0[1]); w.y = cvt_pk_bf16(v0[2], v0[3]); w.z = cvt_pk_bf16(v1[0], v1[1]); w.w = cvt_pk_bf16(v1[2], v1[3]);
                    *(u32x4*)(rowp + bj * 256) = w; } } }
    }
};
struct EpiQKV {
    bf16_t* Q; bf16_t* K; bf16_t* V; const float* ropec; const float* ropes;
    __device__ __forceinline__ void operator()(const f32x4 (&acc)[2][2][4][2], const Unit& u, int wr, int wc, int fr, int fq) const {
        const int pm = u.i0, pn = u.i1; const bool lat = pm < (T / 256); const bool rope = lat && pn < 5;
        const float qs = pn < 4 ? C2 : 1.f;
        const int part = wc & 1;
        const int fi0 = 8 * (fq & 1);
        const float sgn = (fq < 2) ? -1.f : 1.f;
#pragma unroll
        for (int ai = 0; ai < 2; ++ai)
#pragma unroll
            for (int m = 0; m < 4; ++m) { const int row = ai * HALF + wr * 64 + m * 16 + fr; const int tok = pm * 256 + row;
                const int tl = tok & (SEQ - 1); const int pos = part ? (tl & 63) : (tl >> 6);
                f32x4 c0 = {1.f, 1.f, 1.f, 1.f}, c1 = c0, s0 = {0.f, 0.f, 0.f, 0.f}, s1 = s0;
                if (rope) { c0 = *(const f32x4*)(ropec + pos * 16 + fi0); c1 = *(const f32x4*)(ropec + pos * 16 + fi0 + 4); s0 = *(const f32x4*)(ropes + pos * 16 + fi0); s1 = *(const f32x4*)(ropes + pos * 16 + fi0 + 4); }
#pragma unroll
                for (int bj = 0; bj < 2; ++bj) { f32x4 v0 = acc[ai][bj][m][0], v1 = acc[ai][bj][m][1];
                    if (rope) { f32x4 p0, p1;
#pragma unroll
                        for (int j = 0; j < 4; ++j) { p0[j] = __shfl_xor(v0[j], 32); p1[j] = __shfl_xor(v1[j], 32); }
                        v0 = v0 * c0 + (p0 * sgn) * s0; v1 = v1 * c1 + (p1 * sgn) * s1; }
                    v0 = v0 * qs; v1 = v1 * qs;
                    u32x4 w; w.x = cvt_pk_bf16(v0[0], v0[1]); w.y = cvt_pk_bf16(v0[2], v0[3]); w.z = cvt_pk_bf16(v1[0], v1[1]); w.w = cvt_pk_bf16(v1[2], v1[3]);
                    const int col = bj * HALF + wc * 32 + 8 * fq;
                    bf16_t* dst = pn < 4 ? Q + (size_t)tok * 1024 + pn * 256 + col : (pn == 4 ? K + (size_t)tok * 256 + col : V + (size_t)tok * 256 + col);
                    *(u32x4*)dst = w; } }
    }
};
struct EpiSilu {
    __device__ __forceinline__ void operator()(const f32x4 (&acc)[2][2][4][2], const Unit& u, int wr, int wc, int fr, int fq) const {
#pragma unroll
        for (int ai = 0; ai < 2; ++ai)
#pragma unroll
            for (int m = 0; m < 4; ++m) { const int row = ai * HALF + wr * 64 + m * 16 + fr;
                float h[8];
#pragma unroll
                for (int n = 0; n < 2; ++n)
#pragma unroll
                    for (int j = 0; j < 4; ++j) { const float g = acc[ai][0][m][n][j], up = acc[ai][1][m][n][j]; h[n * 4 + j] = g / (1.f + __expf(-g)) * up; }
                u32x4 w; w.x = cvt_pk_bf16(h[0], h[1]); w.y = cvt_pk_bf16(h[2], h[3]); w.z = cvt_pk_bf16(h[4], h[5]); w.w = cvt_pk_bf16(h[6], h[7]);
                *(u32x4*)(u.out + (size_t)row * 512 + (wc * 32 + 8 * fq) * 2) = w; }
    }
};
struct EpiScatter {
    __device__ __forceinline__ void operator()(const f32x4 (&acc)[2][2][4][2], const Unit& u, int wr, int wc, int fr, int fq) const {
#pragma unroll
        for (int ai = 0; ai < 2; ++ai)
#pragma unroll
            for (int m = 0; m < 4; ++m) { const int row = ai * HALF + wr * 64 + m * 16 + fr;
                int dst; float w;
                if (u.l0) { dst = u.l0[row]; w = u.l1[row]; } else { dst = (u.i0 + row) * 9 + 8; w = 1.f; }
                if (dst >= 0) { char* rowp = u.out + (size_t)dst * 2048 + (wc * 32 + 8 * fq) * 2;
#pragma unroll
                    for (int bj = 0; bj < 2; ++bj) { const f32x4 v0 = acc[ai][bj][m][0] * w, v1 = acc[ai][bj][m][1] * w;
                        u32x4 o; o.x = cvt_pk_bf16(v0[0], v0[1]); o.y = cvt_pk_bf16(v0[2], v0[3]); o.z = cvt_pk_bf16(v1[0], v1[1]); o.w = cvt_pk_bf16(v1[2], v1[3]);
                        *(u32x4*)(rowp + bj * 256) = o; } } }
    }
};
struct EpiFp8 {
    __device__ __forceinline__ void operator()(const f32x4 (&acc)[2][2][4][2], const Unit& u, int wr, int wc, int fr, int fq) const {
        const int pn = u.i1;
#pragma unroll
        for (int ai = 0; ai < 2; ++ai)
#pragma unroll
            for (int m = 0; m < 4; ++m) { const int row = ai * HALF + wr * 64 + m * 16 + fr;
                char* rowp = u.out + (size_t)row * 1024 + (pn >> 1) * 8 + ((pn & 1) * 32 + 4 * wc + fq) * 16;
#pragma unroll
                for (int bj = 0; bj < 2; ++bj) { const f32x4 v0 = acc[ai][bj][m][0] * 16.f, v1 = acc[ai][bj][m][1] * 16.f;
                    int w0 = 0, w1 = 0;
                    w0 = __builtin_amdgcn_cvt_pk_fp8_f32(v0[0], v0[1], w0, false); w0 = __builtin_amdgcn_cvt_pk_fp8_f32(v0[2], v0[3], w0, true);
                    w1 = __builtin_amdgcn_cvt_pk_fp8_f32(v1[0], v1[1], w1, false); w1 = __builtin_amdgcn_cvt_pk_fp8_f32(v1[2], v1[3], w1, true);
                    u32x2 o; o.x = (unsigned)w0; o.y = (unsigned)w1;
                    *(u32x2*)(rowp + bj * 256) = o; } }
    }
};
__device__ __forceinline__ int xcd_remap(int L0, int NU) { const int q = NU >> 3, r = NU & 7, x = L0 & 7, off = L0 >> 3; return (x < r ? x * (q + 1) : r * (q + 1) + (x - r) * q) + off; }
}

namespace attn {
constexpr int SLOTB = 8192;
constexpr int LDS_K = 0, LDS_V = 2 * SLOTB, LDS_WS = 4 * SLOTB, LDS_OST = LDS_WS + NWAVES * 256, LDS_END = LDS_OST + NWAVES * 4096;
static_assert(LDS_END <= RING_BYTES, "attention LDS");
__device__ __forceinline__ int crow(int r, int hi) { return (r & 3) + 8 * (r >> 2) + 4 * hi; }
__device__ __forceinline__ void glds16(const void* gsrc, unsigned lds_dst) { unsigned keep;
    asm volatile("s_mov_b32 %0, m0\n\ts_mov_b32 m0, %2\n\ts_nop 0\n\tglobal_load_lds_dwordx4 %1, off\n\ts_mov_b32 m0, %0" : "=&s"(keep) : "v"(gsrc), "s"(lds_dst) : "memory"); }
__device__ __forceinline__ float rowmax(const f32x16& p0, const f32x16& p1) {
    float a = fmaxf(p0[0], p1[0]);
#pragma unroll
    for (int r = 1; r < 16; ++r) a = fmaxf(a, fmaxf(p0[r], p1[r]));
    auto rr = __builtin_amdgcn_permlane32_swap(__float_as_uint(a), __float_as_uint(a), false, false);
    return fmaxf(__uint_as_float(rr[0]), __uint_as_float(rr[1]));
}
typedef short v4i16_t __attribute__((ext_vector_type(4)));
__device__ __forceinline__ s16x4 vtr(const LAS unsigned char* p) { return __builtin_bit_cast(s16x4, __builtin_amdgcn_ds_read_tr16_b64_v4i16((LAS v4i16_t*)p)); }
__device__ __forceinline__ void pv(f32x16* o, const LAS unsigned char* vp, bf16x8 pa0, bf16x8 pa1, bf16x8 pa2, bf16x8 pa3) {
#pragma unroll
    for (int d0 = 0; d0 < 2; ++d0) { s16x4 lo[4], hi[4];
#pragma unroll
        for (int ks = 0; ks < 4; ++ks) { lo[ks] = vtr(vp + d0 * 4096 + ks * 1024); hi[ks] = vtr(vp + d0 * 4096 + ks * 1024 + 512); }
#define PK(k) (bf16x8){lo[k][0], lo[k][1], lo[k][2], lo[k][3], hi[k][0], hi[k][1], hi[k][2], hi[k][3]}
        o[d0] = __builtin_amdgcn_mfma_f32_32x32x16_bf16(pa0, PK(0), o[d0], 0, 0, 0);
        o[d0] = __builtin_amdgcn_mfma_f32_32x32x16_bf16(pa1, PK(1), o[d0], 0, 0, 0);
        o[d0] = __builtin_amdgcn_mfma_f32_32x32x16_bf16(pa2, PK(2), o[d0], 0, 0, 0);
        o[d0] = __builtin_amdgcn_mfma_f32_32x32x16_bf16(pa3, PK(3), o[d0], 0, 0, 0);
#undef PK
    }
}
__device__ __forceinline__ void attn_unit(const bf16_t* Q, const bf16_t* K, const bf16_t* V, bf16_t* O, int b, int h, int q0, bool isctx, float sink2, LAS unsigned char* shm) {
    const int tid = opaque_tid(), lane = tid & 63, r32 = lane & 31, hi = lane >> 5; const int wid = __builtin_amdgcn_readfirstlane(tid >> 6);
    const int kvh = h >> 2;
    const long qrow = isctx ? (long)T + b * CTXL + wid * 32 : (long)b * SEQ + q0 + wid * 32;
    const unsigned lds0 = (unsigned)(uintptr_t)shm;
    LAS float* wsf = (LAS float*)(shm + LDS_WS) + wid * 64;
    int jlo = 0, nl = 0;
    if (!isctx) { jlo = (q0 == 0) ? 2 : 0; int jhi = (SEQ - q0 + 128) / 64; if (jhi > 8) jhi = 8; nl = jhi - jlo; }
    const int NT = nl + 4;
    const long lat0 = (long)b * SEQ + q0 - 128 + 64 * jlo, ctx0 = (long)T + b * CTXL;
#define TROW(t) ((t) < nl ? lat0 + 64 * (t) : ctx0 + 64 * ((t) - nl))
    const int kcol = kvh * 64 + wid * 8, vcol = kvh * 64 + (wid >> 2) * 32 + (lane & 3) * 8, vrow = 16 * (wid & 3) + (lane >> 2);
    const unsigned kdst = lds0 + LDS_K + wid * 1024, vdst = lds0 + LDS_V + wid * 1024;
#define DMA_KV(t, slot) do { const long tr_ = TROW(t); glds16(K + (tr_ + lane) * 256 + kcol, (unsigned)__builtin_amdgcn_readfirstlane(kdst + (slot) * SLOTB)); \
        glds16(V + (tr_ + vrow) * 256 + vcol, (unsigned)__builtin_amdgcn_readfirstlane(vdst + (slot) * SLOTB)); } while (0)
    DMA_KV(0, 0);
    bf16x8 qr[4];
#pragma unroll
    for (int d0 = 0; d0 < 4; ++d0) qr[d0] = *(const GAS bf16x8*)(Q + (qrow + r32) * 1024 + h * 64 + d0 * 16 + hi * 8);
    float mrun = sink2, l_reg = (hi == 0) ? 1.f : 0.f;
    f32x16 o[2];
#pragma unroll
    for (int r = 0; r < 16; ++r) { o[0][r] = 0.f; o[1][r] = 0.f; }
    const LAS unsigned char* vp0 = shm + LDS_V + ((lane >> 4) & 1) * 32 + (lane & 3) * 8 + (4 * hi + ((lane & 15) >> 2)) * 64;
    const int qw = q0 + wid * 32;
    asm volatile("s_waitcnt vmcnt(0) lgkmcnt(0)\n\ts_barrier" ::: "memory");
    for (int t = 0; t < NT; ++t) {
        const int slot = t & 1;
        if (t + 1 < NT) DMA_KV(t + 1, slot ^ 1);
        const bool latt = t < nl;
        const int ks = q0 - 128 + 64 * (jlo + t);
        bool need = true;
        if (latt) need = (ks + 63 >= qw - 128) && (ks <= qw + 31 + 128);
        if (need) {
            f32x16 p0, p1;
#pragma unroll
            for (int r = 0; r < 16; ++r) { p0[r] = 0.f; p1[r] = 0.f; }
            const LAS unsigned char* kb = shm + LDS_K + slot * SLOTB + hi * 1024 + r32 * 16;
#pragma unroll
            for (int d0 = 0; d0 < 4; ++d0) {
                const bf16x8 b0 = *(const LAS bf16x8*)(kb + d0 * 2048), b1 = *(const LAS bf16x8*)(kb + d0 * 2048 + 512);
                p0 = __builtin_amdgcn_mfma_f32_32x32x16_bf16(b0, qr[d0], p0, 0, 0, 0);
                p1 = __builtin_amdgcn_mfma_f32_32x32x16_bf16(b1, qr[d0], p1, 0, 0, 0); }
            if (latt) { const int dq = qw + r32 - ks;
#pragma unroll
                for (int r = 0; r < 16; ++r) { const int d = dq - crow(r, hi); if (d > 128 || d < -128) p0[r] = -INFINITY; if (d - 32 > 128 || d - 32 < -128) p1[r] = -INFINITY; } }
            const float rm = rowmax(p0, p1);
            const float mnew = fmaxf(mrun, rm);
            if (__any(mnew > mrun)) {
                const float alpha = __builtin_amdgcn_exp2f(mrun - mnew); l_reg *= alpha; mrun = mnew;
                if (hi == 0) wsf[r32] = alpha;
                asm volatile("s_waitcnt lgkmcnt(0)" ::: "memory");
#pragma unroll
                for (int r = 0; r < 16; ++r) { const float f = wsf[crow(r, hi)]; o[0][r] *= f; o[1][r] *= f; }
            }
            float sacc = 0.f;
#pragma unroll
            for (int r = 0; r < 16; ++r) { p0[r] = __builtin_amdgcn_exp2f(p0[r] - mrun); p1[r] = __builtin_amdgcn_exp2f(p1[r] - mrun); sacc += p0[r] + p1[r]; }
            l_reg += sacc;
            u32x4 pw0, pw1, pw2, pw3;
#define PKW(P, B) cvt_pk_bf16(P[B], P[B + 1])
            pw0 = (u32x4){PKW(p0, 0), PKW(p0, 2), PKW(p0, 4), PKW(p0, 6)}; pw1 = (u32x4){PKW(p0, 8), PKW(p0, 10), PKW(p0, 12), PKW(p0, 14)};
            pw2 = (u32x4){PKW(p1, 0), PKW(p1, 2), PKW(p1, 4), PKW(p1, 6)}; pw3 = (u32x4){PKW(p1, 8), PKW(p1, 10), PKW(p1, 12), PKW(p1, 14)};
#undef PKW
            __builtin_amdgcn_sched_barrier(0);
            pv(o, vp0 + slot * SLOTB, __builtin_bit_cast(bf16x8, pw0), __builtin_bit_cast(bf16x8, pw1), __builtin_bit_cast(bf16x8, pw2), __builtin_bit_cast(bf16x8, pw3));
        }
        asm volatile("s_waitcnt vmcnt(0) lgkmcnt(0)\n\ts_barrier" ::: "memory");
    }
    { auto rr = __builtin_amdgcn_permlane32_swap(__float_as_uint(l_reg), __float_as_uint(l_reg), false, false); l_reg = __uint_as_float(rr[0]) + __uint_as_float(rr[1]); }
    if (hi == 0) wsf[32 + r32] = l_reg;
    asm volatile("s_waitcnt lgkmcnt(0)" ::: "memory");
    float rli[16];
#pragma unroll
    for (int r = 0; r < 16; ++r) rli[r] = __builtin_amdgcn_rcpf(wsf[32 + crow(r, hi)]);
    bf16_t* Ow = O + qrow * 1024 + h * 64;
    { LAS bf16_t* stg = (LAS bf16_t*)(shm + LDS_OST) + wid * 2048;
#pragma unroll
      for (int r = 0; r < 16; ++r) { const int orow = crow(r, hi);
#pragma unroll
          for (int d0 = 0; d0 < 2; ++d0) stg[orow * 64 + d0 * 32 + r32] = (bf16_t)f2bf(o[d0][r] * rli[r]); }
      asm volatile("s_waitcnt lgkmcnt(0)" ::: "memory");
#pragma unroll
      for (int i = 0; i < 4; ++i) { const int row = i * 8 + (lane >> 3), ch = lane & 7; const u32x4 v = *(const LAS u32x4*)(stg + row * 64 + ch * 8); *(GAS u32x4*)(Ow + (long)row * 1024 + ch * 8) = v; } }
    asm volatile("s_waitcnt lgkmcnt(0)" ::: "memory");
#undef TROW
#undef DMA_KV
}
}

struct Args {
    const float* in[20];
    float* out; unsigned char* ws;
};
struct Frame {
    LAS unsigned char* lds; unsigned* ctl; unsigned char* ws;
    int tid, lane, wave, gw;
    int blk;
    __device__ __forceinline__ void refresh() { tid = opaque_tid(); lane = tid & 63; wave = __builtin_amdgcn_readfirstlane(tid >> 6); gw = blk * 8 + wave;
        asm volatile("" : "+s"(ws)); ctl = (unsigned*)(ws + WS_CTL); }
};
constexpr int NGW = GRID * NWAVES;

struct Row { f32x4 v[4]; };
__device__ __forceinline__ int vq(int q, int lane) { return 128 * (q >> 1) + 2 * lane + (q & 1); }
__device__ __forceinline__ void row_load_bf16(Row& r, const bf16_t* p, int lane) {
#pragma unroll
    for (int j = 0; j < 2; ++j) { const u32x4 w = ((const GAS u32x4*)p)[64 * j + lane]; r.v[2 * j] = (f32x4){bflo(w.x), bfhi(w.x), bflo(w.y), bfhi(w.y)}; r.v[2 * j + 1] = (f32x4){bflo(w.z), bfhi(w.z), bflo(w.w), bfhi(w.w)}; } }
__device__ __forceinline__ void row_store_bf16(const Row& r, bf16_t* p, int lane) {
#pragma unroll
    for (int j = 0; j < 2; ++j) { u32x4 w; w.x = pk2(r.v[2 * j][0], r.v[2 * j][1]); w.y = pk2(r.v[2 * j][2], r.v[2 * j][3]); w.z = pk2(r.v[2 * j + 1][0], r.v[2 * j + 1][1]); w.w = pk2(r.v[2 * j + 1][2], r.v[2 * j + 1][3]); ((GAS u32x4*)p)[64 * j + lane] = w; } }
typedef float f32x2v __attribute__((ext_vector_type(2)));
__device__ __forceinline__ void row_load_fp8(Row& r, const unsigned char* p, int lane) {
    const u32x4 w = ((const GAS u32x4*)p)[lane];
#pragma unroll
    for (int q = 0; q < 4; ++q) { const f32x2v lo = __builtin_amdgcn_cvt_pk_f32_fp8((int)w[q], false), hi = __builtin_amdgcn_cvt_pk_f32_fp8((int)w[q], true); r.v[q] = (f32x4){lo[0], lo[1], hi[0], hi[1]}; } }
__device__ __forceinline__ void row_load_f32(Row& r, const float* p, int lane) {
#pragma unroll
    for (int q = 0; q < 4; ++q) r.v[q] = ((const GAS f32x4*)p)[vq(q, lane)]; }
__device__ __forceinline__ void row_store_f32(const Row& r, float* p, int lane) {
#pragma unroll
    for (int q = 0; q < 4; ++q) ((GAS f32x4*)p)[vq(q, lane)] = r.v[q]; }
__device__ __forceinline__ void row_normalize(Row& r, float eps) {
    float s = 0.f;
#pragma unroll
    for (int j = 0; j < 4; ++j) s += (r.v[j][0] + r.v[j][1]) + (r.v[j][2] + r.v[j][3]);
    const float mean = wave_sum(s) * (1.f / D); float q = 0.f;
#pragma unroll
    for (int j = 0; j < 4; ++j) { r.v[j] = r.v[j] - mean; q += (r.v[j][0] * r.v[j][0] + r.v[j][1] * r.v[j][1]) + (r.v[j][2] * r.v[j][2] + r.v[j][3] * r.v[j][3]); }
    const float rstd = 1.f / sqrtf(wave_sum(q) * (1.f / D) + eps);
#pragma unroll
    for (int j = 0; j < 4; ++j) r.v[j] = r.v[j] * rstd;
}
__device__ __forceinline__ void row_modulate(Row& r, const float* sh, const float* sc, int lane) {
    row_normalize(r, MOD_EPS);
#pragma unroll
    for (int j = 0; j < 4; ++j) { const f32x4 a = ((const GAS f32x4*)sc)[vq(j, lane)], b = ((const GAS f32x4*)sh)[vq(j, lane)]; r.v[j] = r.v[j] * (a + 1.f) + b; }
}
__device__ __forceinline__ int mod_row(int row) { return row < T ? (row >> 11) : 32; }
__device__ __forceinline__ const float* mod_vec(const unsigned char* ws, int layer, int mr, int chunk) { return (const float*)(ws + WS_MOD) + ((size_t)(layer * 33 + mr) * 6 + chunk) * 1024; }

__device__ __forceinline__ void conv_item(const float* W, int N, bf16_t* WT, int Kd, int kd0, int n0, int drow0, bool mirror, LAS float* scr, int lane) {
#pragma unroll 8
    for (int i = 0; i < 32; ++i) { const int kk = 2 * i + (lane >> 5); const int kd = kd0 + kk; const int ks = mirror ? ((kd & ~255) + ((256 - (kd & 255)) & 255)) : kd;
        scr[kk * 33 + (lane & 31)] = ((const GAS float*)W)[(size_t)ks * N + n0 + (lane & 31)]; }
    LDS_WAIT(); asm volatile("" ::: "memory");
    const int c = lane & 7;
#pragma unroll
    for (int j = 0; j < 4; ++j) { const int n = (lane >> 3) + 8 * j; const LAS float* s = scr + (8 * c) * 33 + n;
        u32x4 o; o.x = pk2(s[0 * 33], s[1 * 33]); o.y = pk2(s[2 * 33], s[3 * 33]); o.z = pk2(s[4 * 33], s[5 * 33]); o.w = pk2(s[6 * 33], s[7 * 33]);
        *(GAS u32x4*)(WT + (size_t)(drow0 + n) * Kd + kd0 + 8 * c) = o; }
    LDS_WAIT(); asm volatile("" ::: "memory");
}
__device__ __forceinline__ void conv_matrix_item(const float* W, int K, int N, bf16_t* WT, int mode, int roff, int item, LAS float* scr, int lane) {
    const int nblk = N / 32, kb = item / nblk, nb = item % nblk, n0 = 32 * nb;
    int drow0 = n0 + roff; if (mode == 1) drow0 = (n0 >> 7) * 256 + (n0 & 127); if (mode == 2) drow0 = (n0 >> 7) * 256 + 128 + (n0 & 127);
    conv_item(W, N, WT, K, 64 * kb, n0, drow0, mode == 3, scr, lane);
}
__device__ __forceinline__ void conv_item64(const float* W, int N, bf16_t* WT, int Kd, int k0, int n0, int drow0, LAS bf16_t* scr, int lane) {
    f32x4 v[16];
#pragma unroll
    for (int i = 0; i < 16; ++i) v[i] = *(const GAS f32x4*)(W + (size_t)(k0 + 4 * i + (lane >> 4)) * N + n0 + (lane & 15) * 4);
#pragma unroll
    for (int i = 0; i < 16; ++i) { u32x2 w; w.x = pk2(v[i][0], v[i][1]); w.y = pk2(v[i][2], v[i][3]); *(LAS u32x2*)(scr + (4 * i + (lane >> 4)) * 68 + (lane & 15) * 4) = w; }
    LDS_WAIT(); asm volatile("" ::: "memory");
    const int c = lane & 7;
#pragma unroll
    for (int j = 0; j < 8; ++j) { const int n = (lane >> 3) + 8 * j; const LAS bf16_t* p = scr + (8 * c) * 68 + n;
        u32x4 o; o.x = (unsigned)p[0] | ((unsigned)p[68] << 16); o.y = (unsigned)p[2 * 68] | ((unsigned)p[3 * 68] << 16); o.z = (unsigned)p[4 * 68] | ((unsigned)p[5 * 68] << 16); o.w = (unsigned)p[6 * 68] | ((unsigned)p[7 * 68] << 16);
        *(GAS u32x4*)(WT + (size_t)(drow0 + n) * Kd + k0 + 8 * c) = o; }
    LDS_WAIT(); asm volatile("" ::: "memory");
}
__device__ __forceinline__ void conv_experts(Frame& F, const float* wg, const float* wu, const float* wd, int layer) {
    F.refresh();
    LAS bf16_t* scr = (LAS bf16_t*)(F.lds + 32768 + F.wave * 8704);
    bf16_t* EGU = (bf16_t*)(F.ws + WS_EGU); bf16_t* ED = (bf16_t*)(F.ws + WS_ED);
    for (int it = F.gw; it < NE * 192; it += NGW) { const int e = it / 192, r = it % 192;
        const size_t eo = ((size_t)layer * NE + e) * (1024 * 256);
        if (r < 128) { const int q = r & 63, kb = q >> 2, nb = q & 3, n0 = 64 * nb; const int drow0 = (n0 >> 7) * 256 + (r < 64 ? 0 : 128) + (n0 & 127);
            conv_item64((r < 64 ? wg : wu) + eo, 256, EGU + (size_t)e * 512 * 1024, 1024, 64 * kb, n0, drow0, scr, F.lane); }
        else { const int q = r - 128, kb = q >> 4, nb = q & 15; conv_item64(wd + eo, 1024, ED + (size_t)e * 1024 * 256, 256, 64 * kb, 64 * nb, 64 * nb, scr, F.lane); } }
}
__device__ __forceinline__ void conv_small(Frame& F, const Args& a) {
    F.refresh();
    LAS float* scr = (LAS float*)(F.lds + 32768 + F.wave * 8448);
    for (int it = F.gw; it < 6272; it += NGW) {
        if (it < 1536) { const int j = it / 768, r = it % 768; conv_matrix_item(a.in[8] + (size_t)j * 1024 * 1536, 1024, 1536, (bf16_t*)(F.ws + WS_WQKV) + (size_t)j * 1536 * 1024, 0, 0, r, scr, F.lane); }
        else if (it < 2560) { const int q = it - 1536, j = q / 512, r = q % 512; conv_matrix_item(a.in[9] + (size_t)j * 1024 * 1024, 1024, 1024, (bf16_t*)(F.ws + WS_WO) + (size_t)j * 1024 * 1024, 0, 0, r, scr, F.lane); }
        else if (it < 4608) { const int q = it - 2560, j = q / 1024, r = q % 1024; bf16_t* dst = (bf16_t*)(F.ws + WS_WF) + (size_t)j * 2048 * 1024;
            if (r < 512) conv_matrix_item(a.in[11] + (size_t)j * 1024 * 1024, 1024, 1024, dst, 0, 0, r, scr, F.lane);
            else conv_matrix_item(a.in[11] + (size_t)j * 1024 * 1024, 1024, 1024, dst, 3, 1024, r - 512, scr, F.lane); }
        else if (it < 4736) { const int q = it - 4608, l = q / 32, r = q % 32; conv_matrix_item(a.in[12] + (size_t)l * 1024 * 64, 1024, 64, (bf16_t*)(F.ws + WS_WR) + (size_t)l * 64 * 1024, 0, 0, r, scr, F.lane); }
        else { const int q = it - 4736, l = q / 384, r = q % 384; bf16_t* gu = (bf16_t*)(F.ws + WS_WSH + (size_t)l * 1536 * 1024); bf16_t* dn = gu + 512 * 1024;
            if (r < 128) conv_matrix_item(a.in[17] + (size_t)l * 1024 * 256, 1024, 256, gu, 1, 0, r, scr, F.lane);
            else if (r < 256) conv_matrix_item(a.in[18] + (size_t)l * 1024 * 256, 1024, 256, gu, 2, 0, r - 128, scr, F.lane);
            else conv_matrix_item(a.in[19] + (size_t)l * 256 * 1024, 256, 1024, dn, 0, 0, r - 256, scr, F.lane); }
    }
    const int gt = F.blk * NTHR + F.tid, NGT = GRID * NTHR;
    const float TWO_PI = 6.283185307179586f;
    { float* rc = (float*)(F.ws + WS_ROPEC); float* rs = (float*)(F.ws + WS_ROPES);
      for (int i = gt; i < 64 * 16; i += NGT) { const int pos = i >> 4, fi = i & 15; const float inv = exp2f(-(float)fi * (13.287712379549449f / 16.f)); const float ang = (float)pos * inv; rc[i] = cosf(ang); rs[i] = sinf(ang); } }
    { bf16_t* cs = (bf16_t*)(F.ws + WS_CSN);
      for (int i = gt; i < 512 * 256; i += NGT) { const int r = i >> 8, n = i & 255, m = r & 255; const float ang = TWO_PI * (float)((m * n) & 255) * (1.f / 256.f); cs[i] = (bf16_t)f2bf(r < 256 ? cosf(ang) : -sinf(ang)); } }
    { bf16_t* dl = (bf16_t*)(F.ws + WS_DL);
      for (int i = gt; i < 1024 * 4096; i += NGT) { const int k = i >> 12, c = i & 4095, l = c & 2047; const float ang = TWO_PI * (float)((k * l) & 2047) * (1.f / 2048.f); dl[i] = (bf16_t)f2bf(c < 2048 ? cosf(ang) : sinf(ang)); } }
    { bf16_t* dl = (bf16_t*)(F.ws + WS_DLC);
      for (int i = gt; i < 256 * 512; i += NGT) { const int k = i >> 9, c = i & 511, l = c & 255; const float ang = TWO_PI * (float)((k * l) & 255) * (1.f / 256.f); dl[i] = (bf16_t)f2bf(c < 256 ? cosf(ang) : sinf(ang)); } }
}
__device__ __forceinline__ void mod_partials(Frame& F, const Args& a) {
    F.refresh();
    if (F.blk >= 192) return;
    const int l = F.blk / 48, cb = (F.blk % 48) / 4, kc = F.blk & 3;
    LAS float* s = (LAS float*)F.lds;
    for (int i = F.tid; i < 256 * 33; i += NTHR) { const int k = i / 33, r = i % 33; const float c = (r < 32) ? a.in[1][(size_t)r * 1024 + kc * 256 + k] : a.in[3][kc * 256 + k]; s[k * 36 + r] = c / (1.f + __expf(-c)); }
    __syncthreads();
    const int n = cb * 512 + F.tid;
    const GAS float* w = (const GAS float*)a.in[4] + ((size_t)l * 1024 + kc * 256) * 6144 + n;
    float acc[33];
#pragma unroll
    for (int r = 0; r < 33; ++r) acc[r] = 0.f;
#pragma unroll 4
    for (int k = 0; k < 256; ++k) { const float wv = w[(size_t)k * 6144];
#pragma unroll
        for (int r = 0; r < 33; ++r) acc[r] += s[k * 36 + r] * wv; }
    float* part = (float*)(F.ws + WS_MODP) + ((size_t)(kc * 4 + l) * 33) * 6144 + n;
#pragma unroll
    for (int r = 0; r < 33; ++r) part[(size_t)r * 6144] = acc[r];
    __syncthreads();
}
__device__ __forceinline__ void mod_finalize(Frame& F, const Args& a) {
    F.refresh();
    const int gt = F.blk * NTHR + F.tid, NGT = GRID * NTHR; const float* part = (const float*)(F.ws + WS_MODP); float* mod = (float*)(F.ws + WS_MOD);
    for (int i = gt; i < 4 * 33 * 6144; i += NGT) { const int l = i / (33 * 6144), n = i % 6144; float v = a.in[5][l * 6144 + n];
#pragma unroll
        for (int kc = 0; kc < 4; ++kc) v += part[(size_t)kc * 4 * 33 * 6144 + i]; mod[i] = v; }
}
__device__ __forceinline__ void rows_init(Frame& F, const Args& a) {
    F.refresh();
    bf16_t* XS = (bf16_t*)(F.ws + WS_XS); bf16_t* U = (bf16_t*)a.out; const float* part = (const float*)(F.ws + WS_MODP);
    for (int row = F.gw; row < TT; row += NGW) {
        Row r; row_load_f32(r, row < T ? a.in[0] + (size_t)row * D : a.in[2] + (size_t)(row - T) * D, F.lane);
        row_store_bf16(r, XS + (size_t)row * D, F.lane);
        row_normalize(r, MOD_EPS); const int mr = mod_row(row);
#pragma unroll
        for (int j = 0; j < 4; ++j) { const int e = vq(j, F.lane);
            f32x4 sh = ((const GAS f32x4*)(a.in[5]))[e], sc = ((const GAS f32x4*)(a.in[5] + 1024))[e];
#pragma unroll
            for (int kc = 0; kc < 4; ++kc) { const float* pp = part + ((size_t)(kc * 4 + 0) * 33 + mr) * 6144; sh += ((const GAS f32x4*)pp)[e]; sc += ((const GAS f32x4*)(pp + 1024))[e]; }
            r.v[j] = r.v[j] * (sc + 1.f) + sh; }
        row_store_bf16(r, U + (size_t)row * D, F.lane);
    }
}
__device__ __forceinline__ void rows_post1(Frame& F, const Args& a, int layer, int nrows) {
    F.refresh();
    bf16_t* XS = (bf16_t*)(F.ws + WS_XS); bf16_t* U = (bf16_t*)a.out;
    const float* lg = a.in[6] + (size_t)(layer * 2 + 0) * D; const float* lb = a.in[7] + (size_t)(layer * 2 + 0) * D;
    const int TPB = nrows / GRID;
    for (int rl = F.wave; rl < TPB; rl += NWAVES) { const int row = F.blk * TPB + rl; const int mr = mod_row(row);
        Row x, y; row_load_bf16(x, XS + (size_t)row * D, F.lane); row_load_bf16(y, U + (size_t)row * D, F.lane);
        const float* g1 = mod_vec(F.ws, layer, mr, 2);
#pragma unroll
        for (int j = 0; j < 4; ++j) x.v[j] = x.v[j] * ALPHA + ((const GAS f32x4*)g1)[vq(j, F.lane)] * y.v[j];
        row_normalize(x, LN_EPS);
#pragma unroll
        for (int j = 0; j < 4; ++j) x.v[j] = x.v[j] * ((const GAS f32x4*)lg)[vq(j, F.lane)] + ((const GAS f32x4*)lb)[vq(j, F.lane)];
        row_store_bf16(x, XS + (size_t)row * D, F.lane);
        row_modulate(x, mod_vec(F.ws, layer, mr, 3), mod_vec(F.ws, layer, mr, 4), F.lane);
        row_store_bf16(x, U + (size_t)row * D, F.lane);
    }
}
__device__ __forceinline__ void rows_post2(Frame& F, const Args& a, int layer, int t0, int n) {
    F.refresh();
    bf16_t* XS = (bf16_t*)(F.ws + WS_XS); bf16_t* U = (bf16_t*)a.out; const unsigned char* YB = (const unsigned char*)(F.ws + WS_YB); const unsigned char* YS = (const unsigned char*)(F.ws + WS_YS);
    const int* spos = (const int*)(F.ws + WS_SDST); const float* tkw = (const float*)(F.ws + WS_TKW);
    const float* lg = a.in[6] + (size_t)(layer * 2 + 1) * D; const float* lb = a.in[7] + (size_t)(layer * 2 + 1) * D;
    for (int i = F.gw; i < n; i += NGW) { const int row = t0 + i; const int mr = mod_row(row);
        Row x, y; row_load_bf16(x, XS + (size_t)row * D, F.lane);
        int pj = 0; float wj = 0.f; if (F.lane < 8) { pj = ((const GAS int*)spos)[(size_t)row * 8 + F.lane]; wj = ((const GAS float*)tkw)[(size_t)row * 8 + F.lane]; }
        row_load_fp8(y, YS + (size_t)i * D, F.lane);
#pragma unroll
        for (int j = 0; j < 4; ++j) y.v[j] = y.v[j] * (1.f / 16.f);
#pragma unroll
        for (int s = 0; s < 8; ++s) { const int ps = __builtin_amdgcn_readlane(pj, s); const float ws_ = __builtin_bit_cast(float, __builtin_amdgcn_readlane(__builtin_bit_cast(int, wj), s));
            Row z; row_load_fp8(z, YB + (size_t)ps * D, F.lane); const float wz = ws_ * (1.f / 16.f);
#pragma unroll
            for (int j = 0; j < 4; ++j) y.v[j] += z.v[j] * wz; }
        const float* g2 = mod_vec(F.ws, layer, mr, 5);
#pragma unroll
        for (int j = 0; j < 4; ++j) x.v[j] = x.v[j] * ALPHA + ((const GAS f32x4*)g2)[vq(j, F.lane)] * y.v[j];
        row_normalize(x, LN_EPS);
#pragma unroll
        for (int j = 0; j < 4; ++j) x.v[j] = x.v[j] * ((const GAS f32x4*)lg)[vq(j, F.lane)] + ((const GAS f32x4*)lb)[vq(j, F.lane)];
        if (layer == 3) { row_store_f32(x, a.out + (size_t)row * D, F.lane); }
        else { row_store_bf16(x, XS + (size_t)row * D, F.lane);
            row_modulate(x, mod_vec(F.ws, layer + 1, mr, 0), mod_vec(F.ws, layer + 1, mr, 1), F.lane);
            row_store_bf16(x, U + (size_t)row * D, F.lane); }
    }
}

__device__ __forceinline__ float wave_max_dpp(float v) {
    int x = __builtin_bit_cast(int, v);
#define DPPMAX(ctrl) { const int y = __builtin_amdgcn_update_dpp(x, x, ctrl, 0xf, 0xf, false); x = __builtin_bit_cast(int, fmaxf(__builtin_bit_cast(float, x), __builtin_bit_cast(float, y))); }
    DPPMAX(0xB1) DPPMAX(0x4E) DPPMAX(0x141) DPPMAX(0x140)
#undef DPPMAX
    const float r0 = __builtin_bit_cast(float, __builtin_amdgcn_readlane(x, 0)), r1 = __builtin_bit_cast(float, __builtin_amdgcn_readlane(x, 16));
    const float r2 = __builtin_bit_cast(float, __builtin_amdgcn_readlane(x, 32)), r3 = __builtin_bit_cast(float, __builtin_amdgcn_readlane(x, 48));
    return fmaxf(fmaxf(r0, r1), fmaxf(r2, r3));
}
__device__ __forceinline__ void route_tokens(Frame& F, const Args& a, int layer, int ntok) {
    F.refresh();
    const int TPB = ntok / GRID;
    const bf16_t* U = (const bf16_t*)a.out; const bf16_t* Wr = (const bf16_t*)(F.ws + WS_WR) + (size_t)layer * 64 * 1024;
    int* tke = (int*)(F.ws + WS_TKE); float* tkw = (float*)(F.ws + WS_TKW);
    LAS int* lcnt = (LAS int*)(F.lds + L_LCNT);
    LAS float* sc = (LAS float*)(F.lds) + F.wave * 1024;
    if (F.tid < 64) lcnt[F.tid] = 0;
    __syncthreads();
    const int lane = F.lane, fr = lane & 15, fq = lane >> 4;
    const float bias = a.in[13][layer * 64 + lane];
    const int ntile = TPB / 16;
    for (int tl = F.wave; tl < ntile; tl += NWAVES) {
        const int t0 = F.blk * TPB + tl * 16;
        f32x4 acc[4];
#pragma unroll
        for (int n = 0; n < 4; ++n) acc[n] = (f32x4){0.f, 0.f, 0.f, 0.f};
        const GAS bf16x8* ap = (const GAS bf16x8*)(U + (size_t)(t0 + fr) * D + fq * 8);
        const GAS bf16x8* bp = (const GAS bf16x8*)(Wr + (size_t)fr * D + fq * 8);
#pragma unroll 4
        for (int ks = 0; ks < 32; ++ks) { const bf16x8 av = ap[ks * 4];
#pragma unroll
            for (int n = 0; n < 4; ++n) { const bf16x8 bv = bp[(size_t)n * 16 * (D / 8) + ks * 4]; acc[n] = __builtin_amdgcn_mfma_f32_16x16x32_bf16(av, bv, acc[n], 0, 0, 0); } }
#pragma unroll
        for (int n = 0; n < 4; ++n)
#pragma unroll
            for (int j = 0; j < 4; ++j) sc[(fq * 4 + j) * 64 + n * 16 + fr] = acc[n][j];
        LDS_WAIT();
        for (int tk = 0; tk < 16; ++tk) {
            const float logit = sc[tk * 64 + lane];
            const float s = 1.f / (1.f + __expf(-logit));
            const float sel = s + bias;
            const int g = lane >> 3;
            float m1 = sel; m1 = fmaxf(m1, __shfl_xor(m1, 1)); m1 = fmaxf(m1, __shfl_xor(m1, 2)); m1 = fmaxf(m1, __shfl_xor(m1, 4));
            const unsigned long long bm = __ballot(sel == m1);
            const unsigned gm = (unsigned)(bm >> (g * 8)) & 0xffu;
            const int first = g * 8 + __builtin_ctz(gm);
            float m2 = (lane == first) ? -INFINITY : sel; m2 = fmaxf(m2, __shfl_xor(m2, 1)); m2 = fmaxf(m2, __shfl_xor(m2, 2)); m2 = fmaxf(m2, __shfl_xor(m2, 4));
            const float gs = m1 + m2;
            float curg = gs; bool gok = false;
#pragma unroll 1
            for (int it = 0; it < 4; ++it) { const float mx = wave_max_dpp(curg);
                const unsigned long long bb = __ballot(curg == mx); const int gi = (int)(__builtin_ctzll(bb) >> 3);
                if (g == gi) { gok = true; curg = -INFINITY; } }
            float cure = gok ? sel : -INFINITY; bool chosen = false; int rk = 0;
#pragma unroll 1
            for (int it = 0; it < 8; ++it) { const float mx = wave_max_dpp(cure);
                const unsigned long long bb = __ballot(cure == mx); const int ei = (int)__builtin_ctzll(bb);
                if (lane == ei) { chosen = true; rk = it; cure = -INFINITY; } }
            const float tot = wave_sum(chosen ? s : 0.f);
            if (chosen) { const int tok = t0 + tk; tke[(size_t)tok * 8 + rk] = lane; tkw[(size_t)tok * 8 + rk] = s / tot * 2.5f; __hip_atomic_fetch_add(&lcnt[lane], 1, __ATOMIC_RELAXED, __HIP_MEMORY_SCOPE_WORKGROUP); }
        }
        LDS_WAIT();
    }
    __syncthreads();
    if (F.tid < 64) F.ctl[CW_BCNT + F.blk * 64 + F.tid] = (unsigned)lcnt[F.tid];
}
__device__ __forceinline__ void build_lists(Frame& F, int ntok) {
    F.refresh();
    constexpr int NSEG = NCHUNK * 64, BPC = GRID / NCHUNK;
    const int TPB = ntok / GRID, CH = ntok / NCHUNK;
    LAS int* tstart = (LAS int*)(F.lds + L_TSTART); LAS int* pref = (LAS int*)(F.lds + L_PREF); LAS int* lcnt = (LAS int*)(F.lds + L_LCNT);
    LAS unsigned char* tseg = (LAS unsigned char*)(F.lds + L_TSEG); LAS int* scan = (LAS int*)(F.lds + L_SCAN);
    const unsigned* bcnt = F.ctl + CW_BCNT;
    const int myc = F.blk / BPC, mylb = F.blk % BPC;
    int nseg = 0;
    LAS int* cntl = (LAS int*)F.lds;
    for (int i = F.tid; i < GRID * 64; i += NTHR) cntl[i] = (int)((const GAS unsigned*)bcnt)[i];
    if (F.tid < 64) lcnt[F.tid] = 0;
    __syncthreads();
    if (F.tid < NSEG) { const int c = F.tid >> 6, e = F.tid & 63; int n = 0, p = 0;
        for (int lb = 0; lb < BPC; ++lb) { const int v = cntl[(c * BPC + lb) * 64 + e]; if (c == myc && lb < mylb) p += v; n += v; }
        nseg = n; scan[F.tid] = (n + 255) >> 8; if (c == myc) pref[e] = p; }
    __syncthreads();
    if (F.tid == 0) { int acc = 0; for (int s = 0; s < NSEG; ++s) { tstart[s] = acc; acc += scan[s]; } tstart[NSEG] = acc; }
    __syncthreads();
    if (F.tid < NSEG) { const int t0 = tstart[F.tid], t1 = tstart[F.tid + 1]; for (int t = t0; t < t1; ++t) tseg[t] = (unsigned char)F.tid; }
    int* stok = (int*)(F.ws + WS_STOK); int* spos = (int*)(F.ws + WS_SDST);
    const int* tke = (const int*)(F.ws + WS_TKE);
    { const int sseg = myc * 64 + mylb; if (mylb < 64 && F.tid == sseg) scan[0] = nseg; }
    __syncthreads();
    if (mylb < 64) { const int sseg = myc * 64 + mylb; const int n = scan[0]; const int base = tstart[sseg] * 256, end = tstart[sseg + 1] * 256;
      for (int p = base + n + F.tid; p < end; p += NTHR) stok[p] = myc * CH; }
    for (int tl = F.wave; tl < TPB; tl += NWAVES) { const int tok = F.blk * TPB + tl;
        if (F.lane < 8) { const int e = tke[(size_t)tok * 8 + F.lane];
            const int p = tstart[myc * 64 + e] * 256 + pref[e] + __hip_atomic_fetch_add(&lcnt[e], 1, __ATOMIC_RELAXED, __HIP_MEMORY_SCOPE_WORKGROUP);
            stok[p] = tok; spos[(size_t)tok * 8 + F.lane] = p - tstart[myc * 64] * 256; } }
    __syncthreads();
}

struct SchedQKV {
    const char* U; const char* W; int nfull, nu, c;
    __device__ __forceinline__ bool next(int i, pg::Unit& u) const {
        const int L0 = i * GRID + c; if (L0 >= nu) return false;
        int pm, pn;
        if (L0 < nfull) { const int L = pg::xcd_remap(L0, nfull); const int gid = L / 48, w = L % 48; pm = gid * 8 + (w & 7); pn = w >> 3; }
        else { const int q = L0 - nfull; pm = 256 + (q >> 1); pn = 4 + (q & 1); }
        u.A = U + (size_t)pm * 256 * 2048; u.B = W + (size_t)pn * 256 * 2048; u.gidx = nullptr; u.gbase = 0; u.nt = 16; u.out = nullptr; u.ldc = 0; u.scale = 1.f; u.flags = 0; u.i0 = pm; u.i1 = pn; u.l0 = nullptr; u.l1 = nullptr;
        return true; }
};
struct SchedDense {
    const char* A; const char* W; char* out; int nrt, nct, nt, c; size_t ldA;
    __device__ __forceinline__ bool next(int i, pg::Unit& u) const {
        const int nu = nrt * nct; const int L0 = i * GRID + c; if (L0 >= nu) return false;
        const int L = pg::xcd_remap(L0, nu); const int per = 8 * nct, gid = L / per, w = L % per, fm = gid * 8, gsz = (nrt - fm) < 8 ? (nrt - fm) : 8; const int pm = fm + (w % gsz), pn = w / gsz;
        u.A = A + (size_t)pm * 256 * ldA; u.B = W + (size_t)pn * 256 * ldA; u.gidx = nullptr; u.gbase = 0; u.nt = nt; u.out = out + (size_t)pm * 256 * 2048 + pn * 512; u.ldc = 2048; u.scale = 1.f; u.flags = 0; u.i0 = pm; u.i1 = pn; u.l0 = nullptr; u.l1 = nullptr;
        return true; }
};
struct SchedF1 {
    const char* CS; const char* U; char* ABT; char* ABTC; int nu, c;
    __device__ __forceinline__ bool next(int i, pg::Unit& u) const {
        const int L0 = i * GRID + c; if (L0 >= nu) return false;
        u.gidx = nullptr; u.gbase = 0; u.nt = 4; u.scale = 1.f; u.flags = 0; u.i0 = 0; u.i1 = 0; u.l0 = nullptr; u.l1 = nullptr;
        if (L0 < 2048) { const int L = pg::xcd_remap(L0, 2048); const int pm = L & 1, pn = (L >> 1) & 7, bg = L >> 4, b = bg >> 2, g = bg & 3;
            u.A = CS + (size_t)pm * 256 * 512; u.B = U + ((size_t)b * SEQ + pn * 256) * 2048 + g * 512; u.out = ABT + (size_t)bg * 256 * 8192 + (size_t)(pm * 2048 + pn * 256) * 2; u.ldc = 8192; }
        else { const int q = L0 - 2048; const int pm = q & 1, bg = q >> 1, b = bg >> 2, g = bg & 3;
            u.A = CS + (size_t)pm * 256 * 512; u.B = U + ((size_t)T + b * CTXL) * 2048 + g * 512; u.out = ABTC + (size_t)bg * 256 * 1024 + (size_t)pm * 512; u.ldc = 1024; }
        return true; }
};
struct SchedF2 {
    const char* DL; const char* ABT; char* FH; int c;
    __device__ __forceinline__ bool next(int i, pg::Unit& u) const {
        const int L0 = i * GRID + c; if (L0 >= 512) return false;
        const int L = pg::xcd_remap(L0, 512); const int pm = L & 3, bg = L >> 2, b = bg >> 2, g = bg & 3;
        u.A = DL + (size_t)pm * 256 * 8192; u.B = ABT + (size_t)bg * 256 * 8192; u.gidx = nullptr; u.gbase = 0; u.nt = 64; u.out = FH + ((size_t)b * 1024 + pm * 256) * 2048 + g * 512; u.ldc = 2048; u.scale = 0.001381067932004975f  ; u.flags = 0; u.i0 = 0; u.i1 = 0; u.l0 = nullptr; u.l1 = nullptr;
        return true; }
};
struct SchedF2c {
    const char* DLC; const char* ABTC; char* FC; int c;
    __device__ __forceinline__ bool next(int i, pg::Unit& u) const {
        const int L0 = i * GRID + c; if (L0 >= 128) return false;
        const int bg = L0, b = bg >> 2, g = bg & 3;
        u.A = DLC; u.B = ABTC + (size_t)bg * 256 * 1024; u.gidx = nullptr; u.gbase = 0; u.nt = 8; u.out = FC + ((size_t)b * 256) * 2048 + g * 512; u.ldc = 2048; u.scale = 1.f / 256.f; u.flags = 0; u.i0 = 0; u.i1 = 0; u.l0 = nullptr; u.l1 = nullptr;
        return true; }
};
struct SchedF3 {
    const char* FH; const char* FC; const char* W; char* Y; int nu, c;
    __device__ __forceinline__ bool next(int i, pg::Unit& u) const {
        const int L0 = i * GRID + c; if (L0 >= nu) return false;
        u.gidx = nullptr; u.gbase = 0; u.nt = 16; u.scale = 1.f; u.flags = 0; u.i0 = 0; u.i1 = 0; u.l0 = nullptr; u.l1 = nullptr;
        if (L0 < 1024) { const int L = pg::xcd_remap(L0, 1024); const int gid = L >> 6, w = L & 63, pm = gid * 8 + (w & 7), pn = w >> 3; const int b = pm >> 2, k0 = (pm & 3) * 256;
            u.A = FH + (size_t)pm * 256 * 2048; u.B = W + (size_t)pn * 256 * 2048;
            if (pn < 4) { u.out = Y + ((size_t)b * SEQ + k0) * 2048 + pn * 512; u.ldc = 2048; }
            else { u.out = Y + ((size_t)b * SEQ + SEQ - k0) * 2048 + (pn - 4) * 512; u.ldc = -2048; u.flags = (k0 == 0) ? 1 : 0; } }
        else { const int q = L0 - 1024; const int pm = q >> 2, pn = q & 3;
            u.A = FC + (size_t)pm * 256 * 2048; u.B = W + (size_t)pn * 256 * 2048; u.out = Y + ((size_t)T + pm * 256) * 2048 + pn * 512; u.ldc = 2048; }
        return true; }
};
struct SchedG1 {
    const char* EGU; const char* WSG; const int* STOK; char* H; char* HS; LAS const unsigned char* tseg; int ntl, nsh, c;
    __device__ __forceinline__ bool gsrc(int i, const int*& gidx, int& gbase) const {
        const int nu = (ntl + nsh) * 2; const int L0 = i * GRID + c; if (L0 >= nu) return false;
        const int pm = pg::xcd_remap(L0, nu) >> 1;
        if (pm < ntl) { gidx = STOK + (size_t)pm * 256; gbase = 0; } else { gidx = nullptr; gbase = (pm - ntl) * 256; }
        return true; }
    __device__ __forceinline__ bool next(int i, pg::Unit& u) const {
        const int nu = (ntl + nsh) * 2; const int L0 = i * GRID + c; if (L0 >= nu) return false;
        const int L = pg::xcd_remap(L0, nu); const int pm = L >> 1, pn = L & 1;
        u.A = nullptr; u.gbase = 0; u.nt = 16; u.ldc = 512; u.scale = 1.f; u.flags = 0; u.i0 = 0; u.i1 = 0; u.l0 = nullptr; u.l1 = nullptr;
        if (pm < ntl) { const int e = __builtin_amdgcn_readfirstlane((int)tseg[pm]) & 63;
            u.gidx = STOK + (size_t)pm * 256; u.B = EGU + (size_t)e * 512 * 2048 + (size_t)pn * 256 * 2048; u.out = H + (size_t)pm * 256 * 512 + pn * 256; }
        else { const int ps = pm - ntl; u.gidx = nullptr; u.gbase = ps * 256; u.B = WSG + (size_t)pn * 256 * 2048; u.out = HS + (size_t)ps * 256 * 512 + pn * 256; }
        return true; }
};
struct SchedG2 {
    const char* ED; const char* WSD; const char* H; const char* HS; char* YB; char* YS; LAS const unsigned char* tseg; int t0, t1, nsh, ch, CH, c;
    __device__ __forceinline__ bool next(int i, pg::Unit& u) const {
        const int nr = t1 - t0; const int nu = (nr + nsh) * 4; const int L0 = i * GRID + c; if (L0 >= nu) return false;
        const int L = pg::xcd_remap(L0, nu); const int q = L >> 2, pn = L & 3;
        u.gidx = nullptr; u.gbase = 0; u.nt = 4; u.ldc = 1024; u.scale = 1.f; u.flags = 0; u.i0 = 0; u.i1 = pn; u.l0 = nullptr; u.l1 = nullptr;
        if (q < nr) { const int pm = t0 + q; const int e = __builtin_amdgcn_readfirstlane((int)tseg[pm]) & 63;
            u.A = H + (size_t)pm * 256 * 512; u.B = ED + (size_t)e * 1024 * 512 + (size_t)pn * 256 * 512; u.out = YB + (size_t)q * 256 * 1024; }
        else { const int ps = q - nr; u.A = HS + ((size_t)ch * CH + ps * 256) * 512; u.B = WSD + (size_t)pn * 256 * 512; u.out = YS + (size_t)ps * 256 * 1024; }
        return true; }
};

__device__ __forceinline__ void fnet_nyquist_rows(Frame& F) {
    F.refresh();
    const bf16_t* ABT = (const bf16_t*)(F.ws + WS_ABT); bf16_t* FH1 = (bf16_t*)(F.ws + WS_FH1);
    for (int r = F.gw; r < 128 * 256; r += NGW) { const int bg = r >> 8, m = r & 255, b = bg >> 2, g = bg & 3;
        const GAS u32x4* p = (const GAS u32x4*)(ABT + (size_t)r * 4096); float s = 0.f;
#pragma unroll
        for (int i = 0; i < 4; ++i) { const u32x4 w = p[i * 64 + F.lane]; s += (bflo(w.x) - bfhi(w.x)) + (bflo(w.y) - bfhi(w.y)) + (bflo(w.z) - bfhi(w.z)) + (bflo(w.w) - bfhi(w.w)); }
        s = wave_sum(s) * 0.001381067932004975f;
        if (F.lane == 0) FH1[(size_t)b * 1024 + g * 256 + m] = (bf16_t)f2bf(s); }
}
__device__ __forceinline__ void fnet_nyquist_out(Frame& F, const Args& a, int jl) {
    F.refresh();
    const bf16_t* FH1 = (const bf16_t*)(F.ws + WS_FH1); const bf16_t* W = (const bf16_t*)(F.ws + WS_WF) + (size_t)jl * 2048 * 1024; bf16_t* Y = (bf16_t*)a.out;
    LAS float* part = (LAS float*)F.lds;
    const int b = F.blk >> 3, n = (F.blk & 7) * 128 + (F.tid & 127), kq = F.tid >> 7;
    const GAS u32x4* wp = (const GAS u32x4*)(W + (size_t)n * 1024 + kq * 256); const GAS u32x4* fp = (const GAS u32x4*)(FH1 + (size_t)b * 1024 + kq * 256);
    float s = 0.f;
#pragma unroll 4
    for (int i = 0; i < 32; ++i) { const u32x4 w = wp[i], f = fp[i];
        s += bflo(w.x) * bflo(f.x) + bfhi(w.x) * bfhi(f.x) + bflo(w.y) * bflo(f.y) + bfhi(w.y) * bfhi(f.y) + bflo(w.z) * bflo(f.z) + bfhi(w.z) * bfhi(f.z) + bflo(w.w) * bflo(f.w) + bfhi(w.w) * bfhi(f.w); }
    part[F.tid] = s;
    __syncthreads();
    if (F.tid < 128) { const float t = (part[F.tid] + part[F.tid + 128]) + (part[F.tid + 256] + part[F.tid + 384]); Y[((size_t)b * SEQ + 1024) * D + n] = (bf16_t)f2bf(t); }
    __syncthreads();
}


#ifdef SELFCHECK
constexpr int CW_ERR = 1024;
constexpr size_t WS_OCHK = WS_R + 216 * MiB;
__device__ __forceinline__ void chk_report(unsigned* ctl, int id, float got, float ref, float tabs, float trel) {
    float e = fabsf(got - ref) / (tabs + trel * fabsf(ref)); if (!(e == e)) e = 1e30f; atomicMax(ctl + CW_ERR + id, __float_as_uint(e)); }
__device__ __forceinline__ float bf2f(bf16_t b) { return __builtin_bit_cast(float, (unsigned)b << 16); }
__constant__ int chk_toks[16] = {0, 1, 63, 64, 65, 127, 2047, 2048, 2049, 4096, 33000, 65535, 65536, 65537, 70000, 73727};
__constant__ int chk_ks[8] = {0, 1, 2, 255, 256, 1023, 1024, 700};
__constant__ int chk_ms[4] = {0, 1, 128, 255};
__constant__ int chk_ytoks[10] = {0, 1, 1023, 1024, 1025, 2047, 2048, 65535, 65536, 73727};
__constant__ int chk_ns[5] = {0, 1, 255, 256, 1023};
__constant__ int chk_cols[20] = {0, 7, 15, 16, 31, 32, 40, 48, 63, 64, 500, 1023, 1024, 1039, 1040, 1072, 1279, 1280, 1300, 1535};
__device__ __forceinline__ void chk_qkv(Frame& F, const Args& a, int layer, int id) {
    F.refresh(); const bf16_t* U = (const bf16_t*)a.out; const float* W = a.in[8] + (size_t)(layer >> 1) * 1024 * 1536;
    const bf16_t* Qb = (const bf16_t*)(F.ws + WS_Q); const bf16_t* Kb = (const bf16_t*)(F.ws + WS_K); const bf16_t* Vb = (const bf16_t*)(F.ws + WS_V);
    for (int s = F.gw; s < 320; s += NGW) { const int tok = chk_toks[s & 15], col = chk_cols[s >> 4];
        if (layer == 2 && tok >= T && col < 1024) continue;
        const bool rope = (tok < T) && col < 1280; const int hc = col & 63, first = (hc & 31) < 16; const int pcol = rope ? (first ? col + 16 : col - 16) : col;
        float x = 0.f, xp = 0.f;
        for (int k = F.lane; k < 1024; k += 64) { const float u = bf2f(U[(size_t)tok * D + k]); x += u * W[(size_t)k * 1536 + col]; xp += u * W[(size_t)k * 1536 + pcol]; }
        x = wave_sum(x); xp = wave_sum(xp);
        float ref = x;
        if (rope) { const int tl = tok & 2047, part = hc >> 5, pos = part ? (tl & 63) : (tl >> 6), fi = hc & 15; const float ang = (float)pos * powf(10000.f, -(float)fi / 16.f);
            ref = x * cosf(ang) + (first ? -xp : xp) * sinf(ang); }
        if (col < 1024) ref *= C2;
        const float got = col < 1024 ? bf2f(Qb[(size_t)tok * 1024 + col]) : (col < 1280 ? bf2f(Kb[(size_t)tok * 256 + col - 1024]) : bf2f(Vb[(size_t)tok * 256 + col - 1280]));
        if (F.lane == 0) chk_report(F.ctl, id, got, ref, 0.03f, 0.03f); }
}
__device__ __forceinline__ void chk_attn(Frame& F, const Args& a, int layer, int id) {
    F.refresh(); const bf16_t* Qb = (const bf16_t*)(F.ws + WS_Q); const bf16_t* Kb = (const bf16_t*)(F.ws + WS_K); const bf16_t* Vb = (const bf16_t*)(F.ws + WS_V); const bf16_t* Ob = (const bf16_t*)(F.ws + WS_OCHK);
    LAS float* lg = (LAS float*)F.lds + F.wave * 1024;
    for (int s = F.gw; s < 64; s += NGW) { const int tok = chk_toks[s & 15], h = (s >> 4) * 5, kvh = h >> 2;
        if (layer == 2 && tok >= T) continue;
        const bool isctx = tok >= T; const int b = isctx ? (tok - T) / CTXL : tok / SEQ, p = tok & (SEQ - 1);
        int nk = 0; const int lo = isctx ? 0 : (p - 128 < 0 ? 0 : p - 128), hi = isctx ? -1 : (p + 128 > SEQ - 1 ? SEQ - 1 : p + 128);
        const int nlat = isctx ? 0 : hi - lo + 1; nk = nlat + CTXL;
        float mx = a.in[10][(layer >> 1) * 16 + h] * LOG2E; const float sink2 = mx;
        for (int i = F.lane; i < nk; i += 64) { const size_t kr = i < nlat ? (size_t)b * SEQ + lo + i : (size_t)T + b * CTXL + (i - nlat); float d = 0.f;
            for (int e = 0; e < 64; ++e) d += bf2f(Qb[(size_t)tok * 1024 + h * 64 + e]) * bf2f(Kb[kr * 256 + kvh * 64 + e]);
            lg[i] = d; mx = fmaxf(mx, d); }
#pragma unroll
        for (int o = 1; o < 64; o <<= 1) mx = fmaxf(mx, __shfl_xor(mx, o));
        LDS_WAIT();
        float den = 0.f; for (int i = F.lane; i < nk; i += 64) den += exp2f(lg[i] - mx);
        den = wave_sum(den) + exp2f(sink2 - mx);
        float o = 0.f;
        for (int i = 0; i < nk; ++i) { const size_t kr = i < nlat ? (size_t)b * SEQ + lo + i : (size_t)T + b * CTXL + (i - nlat); o += exp2f(lg[i] - mx) * bf2f(Vb[kr * 256 + kvh * 64 + F.lane]); }
        o /= den;
        chk_report(F.ctl, id, bf2f(Ob[(size_t)tok * 1024 + h * 64 + F.lane]), o, 0.01f, 0.03f); chk_report(F.ctl, 32 + (s & 15), bf2f(Ob[(size_t)tok * 1024 + h * 64 + F.lane]), o, 0.01f, 0.03f);
        LDS_WAIT(); }
    __syncthreads();
}
__device__ __forceinline__ void chk_fnet_f(Frame& F, const Args& a, bool upd, int id) {
    F.refresh(); const bf16_t* U = (const bf16_t*)a.out; LAS float* red = (LAS float*)F.lds;
    for (int s = F.blk; s < 128 + (upd ? 64 : 0); s += GRID) {
        const bool cx = s >= 128; const int q = cx ? s - 128 : s; const int m = chk_ms[q & 3], g = ((q >> 2) & 1) * 3, b = ((q >> 3) & 1) * 31; int k = chk_ks[(q >> 4) & 7]; const int L = cx ? CTXL : SEQ; if (cx) k &= 255;
        const size_t row0 = cx ? (size_t)T + b * CTXL : (size_t)b * SEQ;
        float acc = 0.f;
        for (int l = F.wave; l < L; l += NWAVES) { float ca = 0.f, sa = 0.f;
            for (int n = F.lane; n < 256; n += 64) { const float u = bf2f(U[(row0 + l) * D + g * 256 + n]); const float an = 6.283185307179586f * (float)((m * n) & 255) / 256.f; const float sn = __sinf(an), cs = __cosf(an); ca += u * cs; sa += u * sn; }
            ca = wave_sum(ca); sa = wave_sum(sa); const float an = 6.283185307179586f * (float)((k * l) % L) / (float)L; const float sn = __sinf(an), cs = __cosf(an); acc += cs * ca - sn * sa; }
        if (F.lane == 0) red[F.wave] = acc;
        __syncthreads();
        if (F.tid == 0) { float t = 0.f; for (int w = 0; w < NWAVES; ++w) t += red[w]; t *= cx ? (1.f / 256.f) : 0.001381067932004975f;
            float got;
            if (cx) got = bf2f(((const bf16_t*)(F.ws + WS_FC))[((size_t)b * 256 + k) * D + g * 256 + m]);
            else if (k == 1024) got = bf2f(((const bf16_t*)(F.ws + WS_FH1))[(size_t)b * 1024 + g * 256 + m]);
            else got = bf2f(((const bf16_t*)(F.ws + WS_FH))[((size_t)b * 1024 + k) * D + g * 256 + m]);
            chk_report(F.ctl, id, got, t, 0.02f, 0.03f); }
        __syncthreads(); }
}
__device__ __forceinline__ void chk_fnet_y(Frame& F, const Args& a, int jl, bool upd, int id) {
    F.refresh(); const bf16_t* Y = (const bf16_t*)a.out; const float* W = a.in[11] + (size_t)jl * 1024 * 1024;
    const bf16_t* FH = (const bf16_t*)(F.ws + WS_FH); const bf16_t* FH1 = (const bf16_t*)(F.ws + WS_FH1); const bf16_t* FC = (const bf16_t*)(F.ws + WS_FC);
    for (int s = F.gw; s < 50; s += NGW) { const int tok = chk_ytoks[s % 10], n = chk_ns[s / 10]; if (tok >= T && !upd) continue;
        float acc = 0.f;
        for (int j = F.lane; j < 1024; j += 64) { float f;
            if (tok >= T) f = bf2f(FC[(size_t)(tok - T) * D + j]);
            else { const int b = tok >> 11, k = tok & 2047; if (k < 1024) f = bf2f(FH[((size_t)b * 1024 + k) * D + j]); else if (k == 1024) f = bf2f(FH1[(size_t)b * 1024 + j]);
                else f = bf2f(FH[((size_t)b * 1024 + (2048 - k)) * D + (j & ~255) + ((256 - (j & 255)) & 255)]); }
            acc += f * W[(size_t)j * 1024 + n]; }
        acc = wave_sum(acc);
        if (F.lane == 0) chk_report(F.ctl, id, bf2f(Y[(size_t)tok * D + n]), acc, 0.02f, 0.03f); }
}
__device__ __forceinline__ void chk_route(Frame& F, const Args& a, int layer, int ntok, int id) {
    F.refresh(); const bf16_t* U = (const bf16_t*)a.out; const float* Wr = a.in[12] + (size_t)layer * 1024 * 64; const int* tke = (const int*)(F.ws + WS_TKE); const float* tkw = (const float*)(F.ws + WS_TKW);
    for (int s = F.gw; s < 16; s += NGW) { const int tok = chk_toks[s]; if (tok >= ntok) continue; const int lane = F.lane;
        float lgt = 0.f; for (int k = 0; k < 1024; ++k) lgt += bf2f(U[(size_t)tok * D + k]) * Wr[(size_t)k * 64 + lane];
        const float sc = 1.f / (1.f + expf(-lgt)), sel = sc + a.in[13][layer * 64 + lane];
        float g1 = -INFINITY, g2 = -INFINITY;
#pragma unroll 1
        for (int j = 0; j < 8; ++j) { const float v = __shfl(sel, (lane & ~7) + j); if (v > g1) { g2 = g1; g1 = v; } else if (v > g2) g2 = v; }
        const float gs = g1 + g2; int gr = 0;
#pragma unroll 1
        for (int gp = 0; gp < 8; ++gp) { const float v = __shfl(gs, gp * 8); gr += (v > gs || (v == gs && gp < (lane >> 3))) ? 1 : 0; }
        const float sm = gr < 4 ? sel : -INFINITY; int rk = 0;
#pragma unroll 1
        for (int ep = 0; ep < 64; ++ep) { const float v = __shfl(sm, ep); rk += (v > sm || (v == sm && ep < lane)) ? 1 : 0; }
        const float tot = wave_sum(rk < 8 ? sc : 0.f); const float wref = sc / tot * 2.5f;
        int slot = -1; for (int j = 0; j < 8; ++j) if (tke[(size_t)tok * 8 + j] == lane) slot = j;
        float err = 0.f;
        if (slot >= 0) { if (rk >= 10) err = 10.f; else if (rk < 8) err = fabsf(tkw[(size_t)tok * 8 + slot] - wref) / (0.04f * wref); }
        else if (rk < 6) err = 10.f;
        const unsigned long long nsel = __ballot(slot >= 0); if (__builtin_popcountll(nsel) != 8) err = 20.f;
        atomicMax(F.ctl + CW_ERR + id, __float_as_uint(err)); }
}
__device__ __forceinline__ void chk_moe(Frame& F, const Args& a, int layer, int ntok, int ch, int id) {
    F.refresh(); const bf16_t* U = (const bf16_t*)a.out; const int* tke = (const int*)(F.ws + WS_TKE); const float* tkw = (const float*)(F.ws + WS_TKW);
    const int CH = ntok / NCHUNK; LAS float* hs = (LAS float*)F.lds; LAS float* us = hs + 512; LAS float* pg_ = us + 1024;
    for (int s = F.blk; s < 16; s += GRID) { const int tok = chk_toks[s]; if (tok >= ntok || tok / CH != ch) continue;
        for (int k = F.tid; k < 1024; k += NTHR) us[k] = bf2f(U[(size_t)tok * D + k]);
        __syncthreads();
        float y0 = 0.f, y1 = 0.f;
        for (int j = 0; j < 9; ++j) { const int e = j < 8 ? tke[(size_t)tok * 8 + j] : 0; const float w = j < 8 ? tkw[(size_t)tok * 8 + j] : 1.f;
            const float* wg = j < 8 ? a.in[14] + ((size_t)layer * NE + e) * 262144 : a.in[17] + (size_t)layer * 262144;
            const float* wu = j < 8 ? a.in[15] + ((size_t)layer * NE + e) * 262144 : a.in[18] + (size_t)layer * 262144;
            const float* wd = j < 8 ? a.in[16] + ((size_t)layer * NE + e) * 262144 : a.in[19] + (size_t)layer * 262144;
            const int hh = F.tid & 255, half = F.tid >> 8; float g = 0.f, u = 0.f;
            for (int k = half * 512; k < half * 512 + 512; ++k) { g += us[k] * wg[(size_t)k * 256 + hh]; u += us[k] * wu[(size_t)k * 256 + hh]; }
            pg_[F.tid] = g; pg_[512 + F.tid] = u;
            __syncthreads();
            if (F.tid < 256) { const float gg = pg_[F.tid] + pg_[F.tid + 256], uu = pg_[512 + F.tid] + pg_[512 + F.tid + 256]; hs[F.tid] = gg / (1.f + expf(-gg)) * uu; }
            __syncthreads();
            float t0 = 0.f, t1 = 0.f; for (int q = 0; q < 256; ++q) { t0 += hs[q] * wd[(size_t)q * 1024 + F.tid]; t1 += hs[q] * wd[(size_t)q * 1024 + 512 + F.tid]; }
            y0 += w * t0; y1 += w * t1;
            __syncthreads(); }
        float g0 = 0.f, g1 = 0.f; const int i = tok - ch * CH;
        { const unsigned char* YSb = (const unsigned char*)(F.ws + WS_YS); const unsigned char* YBb = (const unsigned char*)(F.ws + WS_YB); const int* spos = (const int*)(F.ws + WS_SDST);
          const int bo = 16 * (F.tid >> 3) + (F.tid & 7);
          auto f8 = [](unsigned char b) { return __builtin_amdgcn_cvt_pk_f32_fp8((int)b, false)[0] * (1.f / 16.f); };
          g0 = f8(YSb[(size_t)i * D + bo]); g1 = f8(YSb[(size_t)i * D + bo + 8]);
          for (int j = 0; j < 8; ++j) { const size_t ps = (size_t)spos[(size_t)tok * 8 + j]; const float w = tkw[(size_t)tok * 8 + j]; g0 += w * f8(YBb[ps * D + bo]); g1 += w * f8(YBb[ps * D + bo + 8]); } }
        chk_report(F.ctl, id, g0, y0, 0.04f, 0.06f); chk_report(F.ctl, id, g1, y1, 0.04f, 0.06f);
        __syncthreads(); }
}
#endif

#ifndef PH_MASK
#define PH_MASK 0xffffffffu
#endif
#define PH(b) ((PH_MASK >> (b)) & 1u)
__global__ void __launch_bounds__(NTHR, 2) fwd(Args a) {
    extern __shared__ __attribute__((aligned(16))) unsigned char lds_raw[];
    Frame F;
    F.lds = (LAS unsigned char*)lds_raw; F.ws = a.ws; F.ctl = (unsigned*)(a.ws + WS_CTL);
    F.blk = blockIdx.x; F.refresh();
    for (int u = F.tid; u < (LDS_BYTES - RING_BYTES) / 4; u += NTHR) ((LAS unsigned*)(F.lds + RING_BYTES))[u] = 0u;
    __syncthreads();
    const XcdBarrier bar = xcd_barrier_post(F.ctl + CW_BAR, (volatile LAS unsigned*)(F.lds + L_MISC) + 8);
#define GRID_BAR() xcd_barrier(bar)
    LAS unsigned char* ring = F.lds;
    const int c = F.blk;
#define ws (F.ws)
#define NEWPH() F.refresh()

    if (PH(0)) { conv_small(F, a);
    __syncthreads();
    mod_partials(F, a); }
    GRID_BAR();
    if (PH(1)) { rows_init(F, a);
    mod_finalize(F, a); }
    GRID_BAR();

    for (int layer = 0; layer < 4; ++layer) {
        const int jl = layer >> 1; const bool upd = layer < 2; const int nrows = upd ? TT : T;
        if ((layer & 1) == 0) {
            NEWPH();
            if (PH(2)) { SchedQKV S; S.U = (const char*)a.out; S.W = (const char*)(ws + WS_WQKV) + (size_t)jl * 1536 * 2048; S.nfull = (layer == 0) ? 288 * 6 : 256 * 6; S.nu = (layer == 0) ? 288 * 6 : 256 * 6 + 64; S.c = c;
              pg::EpiQKV E; E.Q = (bf16_t*)(ws + WS_Q); E.K = (bf16_t*)(ws + WS_K); E.V = (bf16_t*)(ws + WS_V); E.ropec = (const float*)(ws + WS_ROPEC); E.ropes = (const float*)(ws + WS_ROPES);
              pg::gemm_phase<pg::EpiQKV, SchedQKV, false>(ring, 2048u, 2048u, nullptr, S, E); }
            GRID_BAR();
#ifdef SELFCHECK
            if (SELFCHECK & 1) chk_qkv(F, a, layer, 1 + (layer >> 1));
#define OBUF ((bf16_t*)(ws + WS_OCHK))
#else
#define OBUF ((bf16_t*)(ws + WS_Q))
#endif
            NEWPH();
            if (PH(3)) { const int NU = 4096 + (layer == 0 ? 512 : 0);
              const bf16_t* Qb = (const bf16_t*)(ws + WS_Q); const bf16_t* Kb = (const bf16_t*)(ws + WS_K); const bf16_t* Vb = (const bf16_t*)(ws + WS_V);
              for (int i = 0; i * GRID + c < NU; ++i) { const int id = pg::xcd_remap(i * GRID + c, NU);
                  if (id < 4096) { const int hq = id & 3, qb = (id >> 2) & 7, kvh = (id >> 5) & 3, b = id >> 7, h = kvh * 4 + hq;
                      attn::attn_unit(Qb, Kb, Vb, OBUF, b, h, qb * 256, false, a.in[10][jl * 16 + h] * LOG2E, ring); }
                  else { const int cid = id - 4096, hq = cid & 3, kvh = (cid >> 2) & 3, b = cid >> 4, h = kvh * 4 + hq;
                      attn::attn_unit(Qb, Kb, Vb, OBUF, b, h, 0, true, a.in[10][jl * 16 + h] * LOG2E, ring); } } }
            GRID_BAR();
#ifdef SELFCHECK
            if (SELFCHECK & 1) chk_attn(F, a, layer, 3 + (layer >> 1));
#endif
            NEWPH();
            if (PH(4)) { SchedDense S; S.A = (const char*)OBUF; S.W = (const char*)(ws + WS_WO) + (size_t)jl * 1024 * 2048; S.out = (char*)a.out; S.nrt = nrows / 256; S.nct = 4; S.nt = 16; S.c = c; S.ldA = 2048;
              pg::EpiStore E; pg::gemm_phase<pg::EpiStore, SchedDense, false>(ring, 2048u, 2048u, nullptr, S, E); }
            GRID_BAR();
        } else {
            NEWPH();
            if (PH(5)) { SchedF1 S; S.CS = (const char*)(ws + WS_CSN); S.U = (const char*)a.out; S.ABT = (char*)(ws + WS_ABT); S.ABTC = (char*)(ws + WS_ABTC); S.nu = 2048 + (upd ? 256 : 0); S.c = c;
              pg::EpiStore E; pg::gemm_phase<pg::EpiStore, SchedF1, false>(ring, 512u, 2048u, nullptr, S, E); }
            GRID_BAR();
            NEWPH();
            if (PH(6)) { SchedF2 S; S.DL = (const char*)(ws + WS_DL); S.ABT = (const char*)(ws + WS_ABT); S.FH = (char*)(ws + WS_FH); S.c = c;
              pg::EpiStore E; pg::gemm_phase<pg::EpiStore, SchedF2, false>(ring, 8192u, 8192u, nullptr, S, E); }
            NEWPH();
            if (PH(7) && upd) { SchedF2c S; S.DLC = (const char*)(ws + WS_DLC); S.ABTC = (const char*)(ws + WS_ABTC); S.FC = (char*)(ws + WS_FC); S.c = c;
              pg::EpiStore E; pg::gemm_phase<pg::EpiStore, SchedF2c, false>(ring, 1024u, 1024u, nullptr, S, E); }
            if (PH(8)) fnet_nyquist_rows(F);
            GRID_BAR();
#ifdef SELFCHECK
            if (SELFCHECK & 2) chk_fnet_f(F, a, upd, 5 + (layer >> 1));
            GRID_BAR();
#endif
            NEWPH();
            if (PH(9)) { SchedF3 S; S.FH = (const char*)(ws + WS_FH); S.FC = (const char*)(ws + WS_FC); S.W = (const char*)(ws + WS_WF) + (size_t)jl * 2048 * 2048; S.Y = (char*)a.out; S.nu = 1024 + (upd ? 128 : 0); S.c = c;
              pg::EpiStore E; pg::gemm_phase<pg::EpiStore, SchedF3, false>(ring, 2048u, 2048u, nullptr, S, E); }
            if (PH(10)) fnet_nyquist_out(F, a, jl);
            GRID_BAR();
#ifdef SELFCHECK
            if (SELFCHECK & 8) chk_fnet_y(F, a, jl, upd, 7 + (layer >> 1));
            GRID_BAR();
#endif
        }
        if (PH(12)) conv_experts(F, a.in[14], a.in[15], a.in[16], layer);
        __syncthreads();
        if (PH(11)) rows_post1(F, a, layer, nrows);
        VM_WAIT(); __syncthreads();
        if (threadIdx.x == 0) { __builtin_amdgcn_fence(__ATOMIC_ACQUIRE, "agent"); VM_WAIT(); }
        __syncthreads();
        if (PH(13)) route_tokens(F, a, layer, nrows);
        GRID_BAR();
#ifdef SELFCHECK
        if ((SELFCHECK & 4) && layer < 2) chk_route(F, a, layer, nrows, 9);
#endif
        if (PH(14)) build_lists(F, nrows);
        GRID_BAR();
        LAS const int* tstart = (LAS const int*)(F.lds + L_TSTART); LAS const unsigned char* tseg = (LAS const unsigned char*)(F.lds + L_TSEG);
        const int ntl = __builtin_amdgcn_readfirstlane(tstart[NCHUNK * 64]);
        NEWPH();
        if (PH(15)) { SchedG1 S; S.EGU = (const char*)(ws + WS_EGU); S.WSG = (const char*)(ws + WS_WSH) + (size_t)layer * 1536 * 1024; S.STOK = (const int*)(ws + WS_STOK); S.H = (char*)(ws + WS_H); S.HS = (char*)(ws + WS_HS); S.tseg = tseg; S.ntl = ntl; S.nsh = nrows / 256; S.c = c;
          pg::EpiSilu E; pg::gemm_phase<pg::EpiSilu, SchedG1, true>(ring, 2048u, 2048u, (const char*)a.out, S, E); }
        GRID_BAR();
        const int CH = nrows / NCHUNK;
        for (int ch = 0; ch < NCHUNK; ++ch) {
            NEWPH();
            if (PH(16)) { SchedG2 S; S.ED = (const char*)(ws + WS_ED); S.WSD = (const char*)(ws + WS_WSH) + (size_t)layer * 1536 * 1024 + 512 * 2048; S.H = (const char*)(ws + WS_H); S.HS = (const char*)(ws + WS_HS); S.YB = (char*)(ws + WS_YB); S.YS = (char*)(ws + WS_YS); S.tseg = tseg;
              S.t0 = __builtin_amdgcn_readfirstlane(tstart[ch * 64]); S.t1 = __builtin_amdgcn_readfirstlane(tstart[ch * 64 + 64]); S.nsh = CH / 256; S.ch = ch; S.CH = CH; S.c = c;
              pg::EpiFp8 E; pg::gemm_phase<pg::EpiFp8, SchedG2, false>(ring, 512u, 512u, nullptr, S, E); }
            GRID_BAR();
#ifdef SELFCHECK
            if ((SELFCHECK & 4) && (layer == 0 || layer == 3)) { if (layer == 0 || ch == 0) chk_moe(F, a, layer, nrows, ch, 10 + (layer == 3)); GRID_BAR(); }
#endif
            if (PH(17)) rows_post2(F, a, layer, ch * CH, CH);
            if (!(layer == 3 && ch == NCHUNK - 1)) GRID_BAR();
        }
    }
#ifdef SELFCHECK
    GRID_BAR();
    { int bad = 0; float be = 0.f; for (int k = 15; k >= 1; --k) { const float e = __uint_as_float(__hip_atomic_load(F.ctl + CW_ERR + k, RLX_AGENT)); if (e > 1.f) { bad = k; be = e; } }
      int wt = 0; float we = 0.f; for (int k = 0; k < 16; ++k) { const float e = __uint_as_float(__hip_atomic_load(F.ctl + CW_ERR + 32 + k, RLX_AGENT)); if (e > we) { we = e; wt = k; } }
      if (bad) { F.refresh(); float cv = 3.f + bad + (be > 8.f ? 0.5f : 0.f);  Row r; for (int j = 0; j < 4; ++j) r.v[j] = (f32x4){cv, cv, cv, cv}; for (int row = F.gw; row < T; row += NGW) row_store_f32(r, a.out + (size_t)row * D, F.lane); } }
#endif
}

#undef ws
#undef NEWPH
extern "C" void kernel_launch(void* const* d_in, const int* in_sizes, int n_in, void* d_out, int out_size, void* d_ws, size_t ws_size, hipStream_t stream) {
    static int ready = 0;
    if (ready == 0) {
        if (n_in != 20 || out_size != T * D || ws_size < WS_END) { fprintf(stderr, "kernel_launch: unexpected problem (n_in %d out %d ws %zu need %zu)\n", n_in, out_size, ws_size, (size_t)WS_END); ready = -1; return; }
        if (hipFuncSetAttribute((const void*)fwd, hipFuncAttributeMaxDynamicSharedMemorySize, LDS_BYTES) != hipSuccess) { fprintf(stderr, "kernel_launch: hipFuncSetAttribute failed\n"); ready = -1; return; }
        int per_cu = 0;
        if (hipOccupancyMaxActiveBlocksPerMultiprocessor(&per_cu, (const void*)fwd, NTHR, LDS_BYTES) != hipSuccess || per_cu < 1) fprintf(stderr, "kernel_launch: occupancy query says %d blocks per CU\n", per_cu);
        (void)hipGetLastError();
        ready = 1;
    }
    if (ready < 0) return;
    (void)hipMemsetAsync((char*)d_ws + WS_CTL, 0, CTL_BYTES, stream);
    Args a{};
    for (int i = 0; i < 20; ++i) a.in[i] = (const float*)d_in[i];
    a.out = (float*)d_out; a.ws = (unsigned char*)d_ws;
    hipLaunchKernelGGL(fwd, dim3(GRID), dim3(NTHR), LDS_BYTES, stream, a);
}
```

```cpp
#include <hip/hip_runtime.h>
#include <cstdio>
#include <cstdint>

#define LAS __attribute__((address_space(3)))
#define GAS __attribute__((address_space(1)))
typedef unsigned short bf16_t;
typedef short bf16x8 __attribute__((ext_vector_type(8)));
typedef short s16x4 __attribute__((ext_vector_type(4)));
typedef float f32x4 __attribute__((ext_vector_type(4)));
typedef float f32x16 __attribute__((ext_vector_type(16)));
typedef unsigned u32x4 __attribute__((ext_vector_type(4)));
typedef unsigned u32x2 __attribute__((ext_vector_type(2)));

constexpr int D = 1024, NB = 32, SEQ = 2048, T = NB * SEQ, CTXL = 256, TC = NB * CTXL, TT = T + TC;
constexpr int NQKV = 1536, NE = 64;
constexpr float ALPHA = 1.681792830507429f;
constexpr float LN_EPS = 1e-5f, MOD_EPS = 1e-6f;
constexpr float C2 = 0.125f * 1.4426950408889634f;
constexpr float LOG2E = 1.4426950408889634f;
constexpr int NCHUNK = 2;
constexpr int NWAVES = 8, NTHR = 512, GRID = 256;

constexpr size_t MiB = 1u << 20;
constexpr size_t WS_CTL = 0, CTL_BYTES = 1 * MiB;
constexpr size_t WS_ROPEC = 1 * MiB, WS_ROPES = 1 * MiB + 4096, WS_CSN = 1 * MiB + 65536, WS_DLC = 1 * MiB + 524288, WS_DL = 2 * MiB;
constexpr size_t WS_WQKV = 10 * MiB, WS_WO = 16 * MiB, WS_WF = 20 * MiB, WS_WR = 28 * MiB, WS_WSH = 29 * MiB;
constexpr size_t WS_MODP = 36 * MiB, WS_MOD = 49 * MiB;
constexpr size_t WS_EGU = 54 * MiB, WS_ED = 118 * MiB;
constexpr size_t WS_XS = 150 * MiB;
constexpr size_t WS_STOK = 294 * MiB, WS_SDST = 297 * MiB, WS_SW = 300 * MiB, WS_TKE = 303 * MiB, WS_TKW = 306 * MiB;
constexpr size_t WS_R = 309 * MiB;
constexpr size_t WS_Q = WS_R, WS_K = WS_R + 144 * MiB, WS_V = WS_R + 180 * MiB;
constexpr size_t WS_ABT = WS_R, WS_FH = WS_R + 256 * MiB, WS_FH1 = WS_R + 320 * MiB, WS_ABTC = WS_R + 321 * MiB, WS_FC = WS_R + 353 * MiB;
constexpr size_t WS_H = WS_R, WS_HS = WS_R + 320 * MiB, WS_YB = WS_R + 356 * MiB, WS_YS = WS_R + 676 * MiB;
constexpr size_t WS_END = WS_YS + 36 * MiB;
constexpr int MAXROWS = 655360;

constexpr int CW_TMO = 0, CW_BAR = 4096, CW_BCNT = 16384;

constexpr int RING_BYTES = 131072;
constexpr int L_MISC = RING_BYTES;
constexpr int L_TSTART = RING_BYTES + 256;
constexpr int L_PREF = L_TSTART + 1040;
constexpr int L_LCNT = L_PREF + 256;
constexpr int L_TSEG = L_LCNT + 256;
constexpr int L_SCAN = L_TSEG + 2560;
constexpr int LDS_BYTES = 139264;
static_assert(L_SCAN + 1024 <= LDS_BYTES, "LDS map");

#define RLX_AGENT __ATOMIC_RELAXED, __HIP_MEMORY_SCOPE_AGENT
#define LDS_WAIT() asm volatile("s_waitcnt lgkmcnt(0)" ::: "memory")
#define VM_WAIT() asm volatile("s_waitcnt vmcnt(0)" ::: "memory")

__device__ __forceinline__ unsigned f2bf(float f) { unsigned u = __builtin_bit_cast(unsigned, f); return (u + 0x7fffu + ((u >> 16) & 1u)) >> 16; }
__device__ __forceinline__ unsigned pk2(float lo, float hi) { return f2bf(lo) | (f2bf(hi) << 16); }
typedef float f32x2_t __attribute__((ext_vector_type(2))); typedef __bf16 bf16x2_t __attribute__((ext_vector_type(2)));
__device__ __forceinline__ unsigned cvt_pk_bf16(float lo, float hi) { f32x2_t v = {lo, hi}; bf16x2_t b = __builtin_convertvector(v, bf16x2_t); return __builtin_bit_cast(unsigned, b); }
__device__ __forceinline__ float bflo(unsigned w) { return __builtin_bit_cast(float, w << 16); }
__device__ __forceinline__ float bfhi(unsigned w) { return __builtin_bit_cast(float, w & 0xffff0000u); }
__device__ __forceinline__ float wave_sum(float v) {
#pragma unroll
    for (int o = 1; o < 64; o <<= 1) v += __shfl_xor(v, o);
    return v;
}

__device__ __forceinline__ int opaque_tid() { int t = threadIdx.x; asm volatile("" : "+v"(t)); return t; }

#define XB_TMO      128
#define XB_XCNT(j)  (256  + 64 * (j))
#define XB_XSUB(j)  (1280 + 64 * (j))
#define XB_XGEN(j)  (2304 + 64 * (j))
#define XB_TOP      3328
#define XB_TOPGEN   3392
#define XCD_BAR_WORDS 3456
#define XB_SPIN_CAP (1u << 22)
__device__ __forceinline__ unsigned xb_ld(unsigned* p)              { return __hip_atomic_load(p, __ATOMIC_RELAXED, __HIP_MEMORY_SCOPE_AGENT); }
__device__ __forceinline__ unsigned xb_add(unsigned* p, unsigned v) { return __hip_atomic_fetch_add(p, v, __ATOMIC_RELAXED, __HIP_MEMORY_SCOPE_AGENT); }
__device__ __forceinline__ unsigned xb_xcc_id() { return (unsigned)__builtin_amdgcn_s_getreg((3 << 11) | 20) & 0xFu; }
#define XB_SPIN(cond, bar) do { unsigned _sp = 0; while (cond) { __builtin_amdgcn_s_sleep(1); \
    if ((++_sp & 255u) == 0u) { if (xb_ld(&(bar)[XB_TMO])) break; if (_sp > XB_SPIN_CAP) { atomicAdd(&(bar)[XB_TMO], 1u); break; } } } } while (0)
struct XcdBarrier { unsigned* bar; unsigned x; volatile LAS unsigned* st; };
__device__ __forceinline__ XcdBarrier xcd_barrier_post(unsigned* bar, volatile LAS unsigned* st) {
    XcdBarrier b; b.bar = bar; b.x = xb_xcc_id(); b.st = st;
    if (threadIdx.x == 0) (void)xb_add(&bar[XB_XCNT(b.x)], 1u);
    return b;
}
__device__ __forceinline__ void xcd_barrier_complete(unsigned* bar, unsigned x, unsigned& nloc, unsigned& nx) {
    const unsigned G = gridDim.x * gridDim.y * gridDim.z;
    unsigned sum, cnt, mine, sp = 0u;
    for (;;) {
        sum = 0u; cnt = 0u; mine = 0u;
#pragma unroll
        for (unsigned j = 0; j < 16; ++j) { const unsigned c = xb_ld(&bar[XB_XCNT(j)]); sum += c; cnt += (c > 0u) ? 1u : 0u; mine = (j == x) ? c : mine; }
        if (sum == G) break;
        __builtin_amdgcn_s_sleep(1);
        if ((++sp & 255u) == 0u) { if (xb_ld(&bar[XB_TMO])) break; if (sp > XB_SPIN_CAP) { atomicAdd(&bar[XB_TMO], 1u); break; } }
    }
    nloc = mine > 0u ? mine : 1u; nx = cnt > 0u ? cnt : 1u;
}
__device__ __forceinline__ void xcd_barrier(const XcdBarrier& b) {
    asm volatile("s_waitcnt vmcnt(0)" ::: "memory");
    __syncthreads();
    if (threadIdx.x == 0) {
        unsigned* bar = b.bar; unsigned bx = b.x; asm volatile("" : "+s"(bx));
        __builtin_amdgcn_s_waitcnt(0);
        unsigned nloc = b.st[0], nx = b.st[1];
        if (nloc == 0u) { xcd_barrier_complete(bar, bx, nloc, nx); b.st[0] = nloc; b.st[1] = nx; }
        const unsigned old = xb_add(&bar[XB_XSUB(bx)], 1u);
        const unsigned gen = old / nloc;
        if (old + 1u == (gen + 1u) * nloc) {
            __builtin_amdgcn_fence(__ATOMIC_RELEASE, "agent");
            asm volatile("s_waitcnt vmcnt(0)" ::: "memory");
            const unsigned og = xb_add(&bar[XB_TOP], 1u);
            const unsigned tg = og / nx;
            if (og + 1u == (tg + 1u) * nx) xb_add(&bar[XB_TOPGEN], 1u);
            else XB_SPIN(xb_ld(&bar[XB_TOPGEN]) == tg, bar);
            __builtin_amdgcn_fence(__ATOMIC_ACQUIRE, "agent");
            xb_add(&bar[XB_XGEN(bx)], 1u);
            asm volatile("s_waitcnt vmcnt(0)" ::: "memory");
        } else {
            XB_SPIN(xb_ld(&bar[XB_XGEN(bx)]) == gen, bar);
            __builtin_amdgcn_fence(__ATOMIC_ACQUIRE, "agent");
            asm volatile("s_waitcnt vmcnt(0)" ::: "memory");
        }
    }
    __syncthreads();
}

namespace pg {
constexpr int BM = 256, BK = 64, HALF = 128, HTB = HALF * BK * 2;
__host__ __device__ __forceinline__ int lds_byte(int r, int c) { const int st = (r >> 4) * 2 + (c >> 5), rr = r & 15, cc = c & 31, ob = rr * 64 + cc * 2; return st * 1024 + (ob ^ (((ob >> 9) & 1) << 5)); }
__host__ __device__ __forceinline__ void stage_rc(int b, int& R, int& C) { const int st = b / 1024, sb = b % 1024, swz = sb ^ (((sb >> 9) & 1) << 5); R = (st >> 1) * 16 + swz / 64; C = (st & 1) * 32 + (swz % 64) / 2; }
__host__ __device__ __forceinline__ int perm32(int rho) { const int n = rho >> 4, i = rho & 15; return 8 * (i >> 2) + 4 * n + (i & 3); }

struct Unit {
    const char* A;
    const char* B;
    const int* gidx;
    int gbase;
    int nt;
    char* out; int ldc; float scale; int flags; int i0; int i1;
    const int* l0; const float* l1;
};

template <class Epi, class Sched, bool GATHER>
__device__ __forceinline__ void gemm_phase(LAS unsigned char* lds, const unsigned lda, const unsigned ldb, const char* gtable, const Sched& S, const Epi& E) {
    const int tid = opaque_tid(), wid = __builtin_amdgcn_readfirstlane(tid >> 6), lane = tid & 63, wr = wid >> 2, wc = wid & 3, fr = lane & 15, fq = lane >> 4;
    unsigned voffA[2], voffB[2];
#pragma unroll
    for (int i = 0; i < 2; ++i) { int R, C; stage_rc(tid * 16 + i * 8192, R, C); const int Rb = (R & ~31) + perm32(R & 31);
        voffA[i] = (unsigned)R * lda + (unsigned)C * 2u; voffB[i] = (unsigned)Rb * ldb + (unsigned)C * 2u; }
    const size_t kstep = (size_t)(BK * 2);
    const size_t hstepA = (size_t)HALF * lda, hstepB = (size_t)HALF * ldb;
    const unsigned ldsw = (unsigned)wid * 1024u;
    const int aoff = lds_byte(wr * 64 + fr, fq * 8), boff = lds_byte(wc * 32 + fr, fq * 8);
#define PG_SA(b, h) (((b) * 2 + (h)) * HTB)
#define PG_SB(b, h) ((4 + (b) * 2 + (h)) * HTB)
#define PG_ST2(bufoff, p0, p1) do { \
        __builtin_amdgcn_global_load_lds((const unsigned*)(p0), (LAS unsigned*)(lds + (bufoff) + ldsw), 16, 0, 0); \
        __builtin_amdgcn_global_load_lds((const unsigned*)(p1), (LAS unsigned*)(lds + (bufoff) + ldsw + 8192), 16, 0, 0); } while (0)
#define PG_STB(bufoff, bp) PG_ST2(bufoff, (bp) + voffB[0], (bp) + voffB[1])
#define PG_STA(bufoff, ap, h, nx) do { if constexpr (GATHER) { PG_ST2(bufoff, (ap) + ((nx) ? nO[h][0] : cO[h][0]), (ap) + ((nx) ? nO[h][1] : cO[h][1])); } \
        else { PG_ST2(bufoff, (ap) + (h) * hstepA + voffA[0], (ap) + (h) * hstepA + voffA[1]); } } while (0)
#define PG_LDA(dst, b, h) do { _Pragma("unroll") for (int m = 0; m < 4; ++m) _Pragma("unroll") for (int k = 0; k < 2; ++k) dst[m][k] = *(const LAS bf16x8*)(lds + PG_SA(b, h) + aoff + m * 2048 + k * 1024); } while (0)
#define PG_LDB(dst, b, h) do { _Pragma("unroll") for (int n = 0; n < 2; ++n) _Pragma("unroll") for (int k = 0; k < 2; ++k) dst[n][k] = *(const LAS bf16x8*)(lds + PG_SB(b, h) + boff + n * 2048 + k * 1024); } while (0)
#define PG_MMA(ai, bj, At, Bt) do { __builtin_amdgcn_s_setprio(1); _Pragma("unroll") for (int m = 0; m < 4; ++m) _Pragma("unroll") for (int n = 0; n < 2; ++n) _Pragma("unroll") for (int k = 0; k < 2; ++k) \
        acc[ai][bj][m][n] = __builtin_amdgcn_mfma_f32_16x16x32_bf16(Bt[n][k], At[m][k], acc[ai][bj][m][n], 0, 0, 0); __builtin_amdgcn_s_setprio(0); } while (0)
#define PG_WAIT_V(n) asm volatile("s_waitcnt vmcnt(" #n ")" ::: "memory")
#define PG_WAIT_L(n) asm volatile("s_waitcnt lgkmcnt(" #n ")" ::: "memory")
#define PG_BAR __builtin_amdgcn_s_barrier()
#define PG_SCHED __builtin_amdgcn_sched_barrier(0)
#define PG_GOFF(dst, u) do { const int tz_ = opaque_tid(); _Pragma("unroll") for (int i = 0; i < 2; ++i) { int R_, C_; stage_rc(tz_ * 16 + i * 8192, R_, C_); \
        _Pragma("unroll") for (int h = 0; h < 2; ++h) { const int rr = h * HALF + R_; \
        const int ix = (u).gidx ? ((const GAS int*)(u).gidx)[rr] : (u).gbase + rr; dst[h][i] = (unsigned)ix * lda + (unsigned)C_ * 2u; } } } while (0)
#define PG_GIDX(dst, un) do { const int* gi_ = nullptr; int gb_ = 0; const bool ok_ = S.gsrc((un), gi_, gb_); const int tz_ = opaque_tid(); _Pragma("unroll") for (int i = 0; i < 2; ++i) { int R_, C_; stage_rc(tz_ * 16 + i * 8192, R_, C_); \
        _Pragma("unroll") for (int h = 0; h < 2; ++h) { const int rr = h * HALF + R_; dst[h][i] = (ok_ && gi_) ? ((const GAS int*)gi_)[rr] : gb_ + rr; } } } while (0)
#define PG_GCVT(dst, src) do { const int tz_ = opaque_tid(); _Pragma("unroll") for (int i = 0; i < 2; ++i) { int R_, C_; stage_rc(tz_ * 16 + i * 8192, R_, C_); \
        _Pragma("unroll") for (int h = 0; h < 2; ++h) dst[h][i] = (unsigned)src[h][i] * lda + (unsigned)C_ * 2u; } } while (0)
    Unit cur, nxt; int ui = 0;
    if (!S.next(0, cur)) return;
    f32x4 acc[2][2][4][2];
#pragma unroll
    for (int a = 0; a < 2; ++a)
#pragma unroll
        for (int b = 0; b < 2; ++b)
#pragma unroll
            for (int m = 0; m < 4; ++m)
#pragma unroll
                for (int n = 0; n < 2; ++n) acc[a][b][m][n] = (f32x4){0.f, 0.f, 0.f, 0.f};
    bf16x8 At[4][2], B0[2][2], B1[2][2];
    unsigned cO[2][2] = {{0u, 0u}, {0u, 0u}}, nO[2][2] = {{0u, 0u}, {0u, 0u}};
    int gI[2][2] = {{0, 0}, {0, 0}};
    if constexpr (GATHER) { PG_GOFF(cO, cur); PG_GIDX(gI, 1); }
    const char* cA = GATHER ? gtable : cur.A; const char* cB = cur.B;
    PG_STB(PG_SB(0, 0), cB); PG_STB(PG_SB(0, 1), cB + hstepB); PG_STA(PG_SA(0, 0), cA, 0, false); PG_STA(PG_SA(0, 1), cA, 1, false);
    if (wr == 1) PG_BAR;
    PG_WAIT_V(2); PG_BAR;
    PG_STB(PG_SB(1, 0), cB + kstep); PG_STA(PG_SA(1, 0), cA + kstep, 0, false); PG_STB(PG_SB(1, 1), cB + hstepB + kstep);
    PG_WAIT_V(6); PG_BAR;
    for (;;) {
        const bool has_next = S.next(ui + 1, nxt);
        const int nt = cur.nt;
        if constexpr (GATHER) { if (has_next) { PG_GCVT(nO, gI); PG_GIDX(gI, ui + 2); } else {
#pragma unroll
            for (int h = 0; h < 2; ++h)
#pragma unroll
                for (int i = 0; i < 2; ++i) nO[h][i] = cO[h][i]; } }
        const char* nA = GATHER ? gtable : (has_next ? nxt.A : cA); const char* nB = has_next ? nxt.B : cB;
#pragma unroll 1
        for (int t = 0; t < nt; t += 2) {
            const bool last = (t == nt - 2);
            const char* a1 = cA + (size_t)(t + 1) * kstep;
            const char* a2 = last ? nA : cA + (size_t)(t + 2) * kstep; const char* b2 = last ? nB : cB + (size_t)(t + 2) * kstep;
            const char* a3 = a2 + kstep; const char* b3 = b2 + kstep;
            PG_LDB(B0, 0, 0); PG_LDB(B1, 0, 1); PG_SCHED; PG_LDA(At, 0, 0); PG_STA(PG_SA(1, 1), a1, 1, false);
            PG_WAIT_V(8); PG_WAIT_L(0); PG_BAR; PG_MMA(0, 0, At, B0); PG_MMA(0, 1, At, B1); PG_BAR; PG_SCHED;
            PG_LDA(At, 0, 1); PG_STB(PG_SB(0, 0), b2); PG_STB(PG_SB(0, 1), b2 + hstepB); PG_STA(PG_SA(0, 0), a2, 0, last);
            PG_WAIT_V(8); PG_WAIT_L(0); PG_BAR; PG_MMA(1, 0, At, B0); PG_MMA(1, 1, At, B1); PG_BAR; PG_SCHED;
            PG_LDB(B0, 1, 0); PG_LDB(B1, 1, 1); PG_SCHED; PG_LDA(At, 1, 0); PG_STA(PG_SA(0, 1), a2, 1, last);
            PG_WAIT_V(8); PG_WAIT_L(0); PG_BAR; PG_MMA(0, 0, At, B0); PG_MMA(0, 1, At, B1); PG_BAR; PG_SCHED;
            PG_LDA(At, 1, 1); PG_STB(PG_SB(1, 0), b3); PG_STB(PG_SB(1, 1), b3 + hstepB); PG_STA(PG_SA(1, 0), a3, 0, last);
            PG_WAIT_V(8); PG_WAIT_L(0); PG_BAR; PG_MMA(1, 0, At, B0); PG_MMA(1, 1, At, B1); PG_BAR; PG_SCHED;
        }
        if (wr == 0) PG_BAR;
        E(acc, cur, wr, wc, fr, fq);
        if (!has_next) break;
#pragma unroll
        for (int a = 0; a < 2; ++a)
#pragma unroll
            for (int b = 0; b < 2; ++b)
#pragma unroll
                for (int m = 0; m < 4; ++m)
#pragma unroll
                    for (int n = 0; n < 2; ++n) acc[a][b][m][n] = (f32x4){0.f, 0.f, 0.f, 0.f};
        cur = nxt; cA = nA; cB = nB; ++ui;
        if constexpr (GATHER) {
#pragma unroll
            for (int h = 0; h < 2; ++h)
#pragma unroll
                for (int i = 0; i < 2; ++i) cO[h][i] = nO[h][i]; }
        if (wr == 1) PG_BAR;
    }
    PG_WAIT_V(0);
    PG_BAR;
#undef PG_SA
#undef PG_SB
#undef PG_ST2
#undef PG_STB
#undef PG_STA
#undef PG_LDA
#undef PG_LDB
#undef PG_MMA
#undef PG_WAIT_V
#undef PG_WAIT_L
#undef PG_BAR
#undef PG_SCHED
#undef PG_GOFF
#undef PG_GIDX
#undef PG_GCVT
}

struct EpiStore {
    __device__ __forceinline__ void operator()(const f32x4 (&acc)[2][2][4][2], const Unit& u, int wr, int wc, int fr, int fq) const {
        const float s = u.scale;
#pragma unroll
        for (int ai = 0; ai < 2; ++ai)
#pragma unroll
            for (int m = 0; m < 4; ++m) { const int row = ai * HALF + wr * 64 + m * 16 + fr;
                char* rowp = u.out + (ptrdiff_t)row * u.ldc + (wc * 32 + 8 * fq) * 2;
                if (!((u.flags & 1) && row == 0)) {
#pragma unroll
                for (int bj = 0; bj < 2; ++bj) { const f32x4 v0 = acc[ai][bj][m][0] * s, v1 = acc[ai][bj][m][1] * s;
                    u32x4 w; w.x = cvt_pk_bf16(v0[0], v0[1]); w.y = cvt_pk_bf16(v0[2], v0[3]); w.z = cvt_pk_bf16(v1[0], v1[1]); w.w = cvt_pk_bf16(v1[2], v1[3]);
                    *(u32x4*)(rowp + bj * 256) = w; } } }
    }
};
struct EpiQKV {
    bf16_t* Q; bf16_t* K; bf16_t* V; const float* ropec; const float* ropes;
    __device__ __forceinline__ void operator()(const f32x4 (&acc)[2][2][4][2], const Unit& u, int wr, int wc, int fr, int fq) const {
        const int pm = u.i0, pn = u.i1; const bool lat = pm < (T / 256); const bool rope = lat && pn < 5;
        const float qs = pn < 4 ? C2 : 1.f;
        const int part = wc & 1;
        const int fi0 = 8 * (fq & 1);
        const float sgn = (fq < 2) ? -1.f : 1.f;
#pragma unroll
        for (int ai = 0; ai < 2; ++ai)
#pragma unroll
            for (int m = 0; m < 4; ++m) { const int row = ai * HALF + wr * 64 + m * 16 + fr; const int tok = pm * 256 + row;
                const int tl = tok & (SEQ - 1); const int pos = part ? (tl & 63) : (tl >> 6);
                f32x4 c0 = {1.f, 1.f, 1.f, 1.f}, c1 = c0, s0 = {0.f, 0.f, 0.f, 0.f}, s1 = s0;
                if (rope) { c0 = *(const f32x4*)(ropec + pos * 16 + fi0); c1 = *(const f32x4*)(ropec + pos * 16 + fi0 + 4); s0 = *(const f32x4*)(ropes + pos * 16 + fi0); s1 = *(const f32x4*)(ropes + pos * 16 + fi0 + 4); }
#pragma unroll
                for (int bj = 0; bj < 2; ++bj) { f32x4 v0 = acc[ai][bj][m][0], v1 = acc[ai][bj][m][1];
                    if (rope) { f32x4 p0, p1;
#pragma unroll
                        for (int j = 0; j < 4; ++j) { p0[j] = __shfl_xor(v0[j], 32); p1[j] = __shfl_xor(v1[j], 32); }
                        v0 = v0 * c0 + (p0 * sgn) * s0; v1 = v1 * c1 + (p1 * sgn) * s1; }
                    v0 = v0 * qs; v1 = v1 * qs;
                    u32x4 w; w.x = cvt_pk_bf16(v0[0], v0[1]); w.y = cvt_pk_bf16(v0[2], v0[3]); w.z = cvt_pk_bf16(v1[0], v1[1]); w.w = cvt_pk_bf16(v1[2], v1[3]);
                    const int col = bj * HALF + wc * 32 + 8 * fq;
                    bf16_t* dst = pn < 4 ? Q + (size_t)tok * 1024 + pn * 256 + col : (pn == 4 ? K + (size_t)tok * 256 + col : V + (size_t)tok * 256 + col);
                    *(u32x4*)dst = w; } }
    }
};
struct EpiSilu {
    __device__ __forceinline__ void operator()(const f32x4 (&acc)[2][2][4][2], const Unit& u, int wr, int wc, int fr, int fq) const {
#pragma unroll
        for (int ai = 0; ai < 2; ++ai)
#pragma unroll
            for (int m = 0; m < 4; ++m) { const int row = ai * HALF + wr * 64 + m * 16 + fr;
                float h[8];
#pragma unroll
                for (int n = 0; n < 2; ++n)
#pragma unroll
                    for (int j = 0; j < 4; ++j) { const float g = acc[ai][0][m][n][j], up = acc[ai][1][m][n][j]; h[n * 4 + j] = g / (1.f + __expf(-g)) * up; }
                u32x4 w; w.x = cvt_pk_bf16(h[0], h[1]); w.y = cvt_pk_bf16(h[2], h[3]); w.z = cvt_pk_bf16(h[4], h[5]); w.w = cvt_pk_bf16(h[6], h[7]);
                *(u32x4*)(u.out + (size_t)row * 512 + (wc * 32 + 8 * fq) * 2) = w; }
    }
};
struct EpiScatter {
    __device__ __forceinline__ void operator()(const f32x4 (&acc)[2][2][4][2], const Unit& u, int wr, int wc, int fr, int fq) const {
#pragma unroll
        for (int ai = 0; ai < 2; ++ai)
#pragma unroll
            for (int m = 0; m < 4; ++m) { const int row = ai * HALF + wr * 64 + m * 16 + fr;
                int dst; float w;
                if (u.l0) { dst = u.l0[row]; w = u.l1[row]; } else { dst = (u.i0 + row) * 9 + 8; w = 1.f; }
                if (dst >= 0) { char* rowp = u.out + (size_t)dst * 2048 + (wc * 32 + 8 * fq) * 2;
#pragma unroll
                    for (int bj = 0; bj < 2; ++bj) { const f32x4 v0 = acc[ai][bj][m][0] * w, v1 = acc[ai][bj][m][1] * w;
                        u32x4 o; o.x = cvt_pk_bf16(v0[0], v0[1]); o.y = cvt_pk_bf16(v0[2], v0[3]); o.z = cvt_pk_bf16(v1[0], v1[1]); o.w = cvt_pk_bf16(v1[2], v1[3]);
                        *(u32x4*)(rowp + bj * 256) = o; } } }
    }
};
struct EpiFp8 {
    __device__ __forceinline__ void operator()(const f32x4 (&acc)[2][2][4][2], const Unit& u, int wr, int wc, int fr, int fq) const {
        const int pn = u.i1;
#pragma unroll
        for (int ai = 0; ai < 2; ++ai)
#pragma unroll
            for (int m = 0; m < 4; ++m) { const int row = ai * HALF + wr * 64 + m * 16 + fr;
                char* rowp = u.out + (size_t)row * 1024 + (pn >> 1) * 8 + ((pn & 1) * 32 + 4 * wc + fq) * 16;
#pragma unroll
                for (int bj = 0; bj < 2; ++bj) { const f32x4 v0 = acc[ai][bj][m][0] * 16.f, v1 = acc[ai][bj][m][1] * 16.f;
                    int w0 = 0, w1 = 0;
                    w0 = __builtin_amdgcn_cvt_pk_fp8_f32(v0[0], v0[1], w0, false); w0 = __builtin_amdgcn_cvt_pk_fp8_f32(v0[2], v0[3], w0, true);
                    w1 = __builtin_amdgcn_cvt_pk_fp8_f32(v1[0], v1[1], w1, false); w1 = __builtin_amdgcn_cvt_pk_fp8_f32(v1[2], v1[3], w1, true);
                    u32x2 o; o.x = (unsigned)w0; o.y = (unsigned)w1;
                    *(u32x2*)(rowp + bj * 256) = o; } }
    }
};
__device__ __forceinline__ int xcd_remap(int L0, int NU) { const int q = NU >> 3, r = NU & 7, x = L0 & 7, off = L0 >> 3; return (x < r ? x * (q + 1) : r * (q + 1) + (x - r) * q) + off; }
}

namespace attn {
constexpr int SLOTB = 8192;
constexpr int LDS_K = 0, LDS_V = 2 * SLOTB, LDS_WS = 4 * SLOTB, LDS_OST = LDS_WS + NWAVES * 256, LDS_END = LDS_OST + NWAVES * 4096;
static_assert(LDS_END <= RING_BYTES, "attention LDS");
__device__ __forceinline__ int crow(int r, int hi) { return (r & 3) + 8 * (r >> 2) + 4 * hi; }
__device__ __forceinline__ void glds16(const void* gsrc, unsigned lds_dst) { unsigned keep;
    asm volatile("s_mov_b32 %0, m0\n\ts_mov_b32 m0, %2\n\ts_nop 0\n\tglobal_load_lds_dwordx4 %1, off\n\ts_mov_b32 m0, %0" : "=&s"(keep) : "v"(gsrc), "s"(lds_dst) : "memory"); }
__device__ __forceinline__ float rowmax(const f32x16& p0, const f32x16& p1) {
    float a = fmaxf(p0[0], p1[0]);
#pragma unroll
    for (int r = 1; r < 16; ++r) a = fmaxf(a, fmaxf(p0[r], p1[r]));
    auto rr = __builtin_amdgcn_permlane32_swap(__float_as_uint(a), __float_as_uint(a), false, false);
    return fmaxf(__uint_as_float(rr[0]), __uint_as_float(rr[1]));
}
typedef short v4i16_t __attribute__((ext_vector_type(4)));
__device__ __forceinline__ s16x4 vtr(const LAS unsigned char* p) { return __builtin_bit_cast(s16x4, __builtin_amdgcn_ds_read_tr16_b64_v4i16((LAS v4i16_t*)p)); }
__device__ __forceinline__ void pv(f32x16* o, const LAS unsigned char* vp, bf16x8 pa0, bf16x8 pa1, bf16x8 pa2, bf16x8 pa3) {
#pragma unroll
    for (int d0 = 0; d0 < 2; ++d0) { s16x4 lo[4], hi[4];
#pragma unroll
        for (int ks = 0; ks < 4; ++ks) { lo[ks] = vtr(vp + d0 * 4096 + ks * 1024); hi[ks] = vtr(vp + d0 * 4096 + ks * 1024 + 512); }
#define PK(k) (bf16x8){lo[k][0], lo[k][1], lo[k][2], lo[k][3], hi[k][0], hi[k][1], hi[k][2], hi[k][3]}
        o[d0] = __builtin_amdgcn_mfma_f32_32x32x16_bf16(pa0, PK(0), o[d0], 0, 0, 0);
        o[d0] = __builtin_amdgcn_mfma_f32_32x32x16_bf16(pa1, PK(1), o[d0], 0, 0, 0);
        o[d0] = __builtin_amdgcn_mfma_f32_32x32x16_bf16(pa2, PK(2), o[d0], 0, 0, 0);
        o[d0] = __builtin_amdgcn_mfma_f32_32x32x16_bf16(pa3, PK(3), o[d0], 0, 0, 0);
#undef PK
    }
}
__device__ __forceinline__ void attn_unit(const bf16_t* Q, const bf16_t* K, const bf16_t* V, bf16_t* O, int b, int h, int q0, bool isctx, float sink2, LAS unsigned char* shm) {
    const int tid = opaque_tid(), lane = tid & 63, r32 = lane & 31, hi = lane >> 5; const int wid = __builtin_amdgcn_readfirstlane(tid >> 6);
    const int kvh = h >> 2;
    const long qrow = isctx ? (long)T + b * CTXL + wid * 32 : (long)b * SEQ + q0 + wid * 32;
    const unsigned lds0 = (unsigned)(uintptr_t)shm;
    LAS float* wsf = (LAS float*)(shm + LDS_WS) + wid * 64;
    int jlo = 0, nl = 0;
    if (!isctx) { jlo = (q0 == 0) ? 2 : 0; int jhi = (SEQ - q0 + 128) / 64; if (jhi > 8) jhi = 8; nl = jhi - jlo; }
    const int NT = nl + 4;
    const long lat0 = (long)b * SEQ + q0 - 128 + 64 * jlo, ctx0 = (long)T + b * CTXL;
#define TROW(t) ((t) < nl ? lat0 + 64 * (t) : ctx0 + 64 * ((t) - nl))
    const int kcol = kvh * 64 + wid * 8, vcol = kvh * 64 + (wid >> 2) * 32 + (lane & 3) * 8, vrow = 16 * (wid & 3) + (lane >> 2);
    const unsigned kdst = lds0 + LDS_K + wid * 1024, vdst = lds0 + LDS_V + wid * 1024;
#define DMA_KV(t, slot) do { const long tr_ = TROW(t); glds16(K + (tr_ + lane) * 256 + kcol, (unsigned)__builtin_amdgcn_readfirstlane(kdst + (slot) * SLOTB)); \
        glds16(V + (tr_ + vrow) * 256 + vcol, (unsigned)__builtin_amdgcn_readfirstlane(vdst + (slot) * SLOTB)); } while (0)
    DMA_KV(0, 0);
    bf16x8 qr[4];
#pragma unroll
    for (int d0 = 0; d0 < 4; ++d0) qr[d0] = *(const GAS bf16x8*)(Q + (qrow + r32) * 1024 + h * 64 + d0 * 16 + hi * 8);
    float mrun = sink2, l_reg = (hi == 0) ? 1.f : 0.f;
    f32x16 o[2];
#pragma unroll
    for (int r = 0; r < 16; ++r) { o[0][r] = 0.f; o[1][r] = 0.f; }
    const LAS unsigned char* vp0 = shm + LDS_V + ((lane >> 4) & 1) * 32 + (lane & 3) * 8 + (4 * hi + ((lane & 15) >> 2)) * 64;
    const int qw = q0 + wid * 32;
    asm volatile("s_waitcnt vmcnt(0) lgkmcnt(0)\n\ts_barrier" ::: "memory");
    for (int t = 0; t < NT; ++t) {
        const int slot = t & 1;
        if (t + 1 < NT) DMA_KV(t + 1, slot ^ 1);
        const bool latt = t < nl;
        const int ks = q0 - 128 + 64 * (jlo + t);
        bool need = true;
        if (latt) need = (ks + 63 >= qw - 128) && (ks <= qw + 31 + 128);
        if (need) {
            f32x16 p0, p1;
#pragma unroll
            for (int r = 0; r < 16; ++r) { p0[r] = 0.f; p1[r] = 0.f; }
            const LAS unsigned char* kb = shm + LDS_K + slot * SLOTB + hi * 1024 + r32 * 16;
#pragma unroll
            for (int d0 = 0; d0 < 4; ++d0) {
                const bf16x8 b0 = *(const LAS bf16x8*)(kb + d0 * 2048), b1 = *(const LAS bf16x8*)(kb + d0 * 2048 + 512);
                p0 = __builtin_amdgcn_mfma_f32_32x32x16_bf16(b0, qr[d0], p0, 0, 0, 0);
                p1 = __builtin_amdgcn_mfma_f32_32x32x16_bf16(b1, qr[d0], p1, 0, 0, 0); }
            if (latt) { const int dq = qw + r32 - ks;
#pragma unroll
                for (int r = 0; r < 16; ++r) { const int d = dq - crow(r, hi); if (d > 128 || d < -128) p0[r] = -INFINITY; if (d - 32 > 128 || d - 32 < -128) p1[r] = -INFINITY; } }
            const float rm = rowmax(p0, p1);
            if (__any(rm > mrun + 8.f)) {
                const float mnew = fmaxf(mrun, rm);
                const float alpha = __builtin_amdgcn_exp2f(mrun - mnew); l_reg *= alpha; mrun = mnew;
                if (hi == 0) wsf[r32] = alpha;
                asm volatile("s_waitcnt lgkmcnt(0)" ::: "memory");
#pragma unroll
                for (int r = 0; r < 16; ++r) { const float f = wsf[crow(r, hi)]; o[0][r] *= f; o[1][r] *= f; }
            }
            float sacc = 0.f;
#pragma unroll
            for (int r = 0; r < 16; ++r) { p0[r] = __builtin_amdgcn_exp2f(p0[r] - mrun); p1[r] = __builtin_amdgcn_exp2f(p1[r] - mrun); sacc += p0[r] + p1[r]; }
            l_reg += sacc;
            u32x4 pw0, pw1, pw2, pw3;
#define PKW(P, B) cvt_pk_bf16(P[B], P[B + 1])
            pw0 = (u32x4){PKW(p0, 0), PKW(p0, 2), PKW(p0, 4), PKW(p0, 6)}; pw1 = (u32x4){PKW(p0, 8), PKW(p0, 10), PKW(p0, 12), PKW(p0, 14)};
            pw2 = (u32x4){PKW(p1, 0), PKW(p1, 2), PKW(p1, 4), PKW(p1, 6)}; pw3 = (u32x4){PKW(p1, 8), PKW(p1, 10), PKW(p1, 12), PKW(p1, 14)};
#undef PKW
            __builtin_amdgcn_sched_barrier(0);
            pv(o, vp0 + slot * SLOTB, __builtin_bit_cast(bf16x8, pw0), __builtin_bit_cast(bf16x8, pw1), __builtin_bit_cast(bf16x8, pw2), __builtin_bit_cast(bf16x8, pw3));
        }
        asm volatile("s_waitcnt vmcnt(0) lgkmcnt(0)\n\ts_barrier" ::: "memory");
    }
    { auto rr = __builtin_amdgcn_permlane32_swap(__float_as_uint(l_reg), __float_as_uint(l_reg), false, false); l_reg = __uint_as_float(rr[0]) + __uint_as_float(rr[1]); }
    if (hi == 0) wsf[32 + r32] = l_reg;
    asm volatile("s_waitcnt lgkmcnt(0)" ::: "memory");
    float rli[16];
#pragma unroll
    for (int r = 0; r < 16; ++r) rli[r] = __builtin_amdgcn_rcpf(wsf[32 + crow(r, hi)]);
    bf16_t* Ow = O + qrow * 1024 + h * 64;
    { LAS bf16_t* stg = (LAS bf16_t*)(shm + LDS_OST) + wid * 2048;
#pragma unroll
      for (int r = 0; r < 16; ++r) { const int orow = crow(r, hi);
#pragma unroll
          for (int d0 = 0; d0 < 2; ++d0) stg[orow * 64 + d0 * 32 + r32] = (bf16_t)f2bf(o[d0][r] * rli[r]); }
      asm volatile("s_waitcnt lgkmcnt(0)" ::: "memory");
#pragma unroll
      for (int i = 0; i < 4; ++i) { const int row = i * 8 + (lane >> 3), ch = lane & 7; const u32x4 v = *(const LAS u32x4*)(stg + row * 64 + ch * 8); *(GAS u32x4*)(Ow + (long)row * 1024 + ch * 8) = v; } }
    asm volatile("s_waitcnt lgkmcnt(0)" ::: "memory");
#undef TROW
#undef DMA_KV
}
}

struct Args {
    const float* in[20];
    float* out; unsigned char* ws;
};
struct Frame {
    LAS unsigned char* lds; unsigned* ctl; unsigned char* ws;
    int tid, lane, wave, gw;
    int blk;
    __device__ __forceinline__ void refresh() { tid = opaque_tid(); lane = tid & 63; wave = __builtin_amdgcn_readfirstlane(tid >> 6); gw = blk * 8 + wave;
        asm volatile("" : "+s"(ws)); ctl = (unsigned*)(ws + WS_CTL); }
};
constexpr int NGW = GRID * NWAVES;

struct Row { f32x4 v[4]; };
__device__ __forceinline__ int vq(int q, int lane) { return 128 * (q >> 1) + 2 * lane + (q & 1); }
__device__ __forceinline__ void row_load_bf16(Row& r, const bf16_t* p, int lane) {
#pragma unroll
    for (int j = 0; j < 2; ++j) { const u32x4 w = ((const GAS u32x4*)p)[64 * j + lane]; r.v[2 * j] = (f32x4){bflo(w.x), bfhi(w.x), bflo(w.y), bfhi(w.y)}; r.v[2 * j + 1] = (f32x4){bflo(w.z), bfhi(w.z), bflo(w.w), bfhi(w.w)}; } }
__device__ __forceinline__ void row_store_bf16(const Row& r, bf16_t* p, int lane) {
#pragma unroll
    for (int j = 0; j < 2; ++j) { u32x4 w; w.x = pk2(r.v[2 * j][0], r.v[2 * j][1]); w.y = pk2(r.v[2 * j][2], r.v[2 * j][3]); w.z = pk2(r.v[2 * j + 1][0], r.v[2 * j + 1][1]); w.w = pk2(r.v[2 * j + 1][2], r.v[2 * j + 1][3]); ((GAS u32x4*)p)[64 * j + lane] = w; } }
typedef float f32x2v __attribute__((ext_vector_type(2)));
__device__ __forceinline__ void row_load_fp8(Row& r, const unsigned char* p, int lane) {
    const u32x4 w = ((const GAS u32x4*)p)[lane];
#pragma unroll
    for (int q = 0; q < 4; ++q) { const f32x2v lo = __builtin_amdgcn_cvt_pk_f32_fp8((int)w[q], false), hi = __builtin_amdgcn_cvt_pk_f32_fp8((int)w[q], true); r.v[q] = (f32x4){lo[0], lo[1], hi[0], hi[1]}; } }
__device__ __forceinline__ void row_load_f32(Row& r, const float* p, int lane) {
#pragma unroll
    for (int q = 0; q < 4; ++q) r.v[q] = ((const GAS f32x4*)p)[vq(q, lane)]; }
__device__ __forceinline__ void row_store_f32(const Row& r, float* p, int lane) {
#pragma unroll
    for (int q = 0; q < 4; ++q) ((GAS f32x4*)p)[vq(q, lane)] = r.v[q]; }
__device__ __forceinline__ void row_normalize(Row& r, float eps) {
    float s = 0.f;
#pragma unroll
    for (int j = 0; j < 4; ++j) s += (r.v[j][0] + r.v[j][1]) + (r.v[j][2] + r.v[j][3]);
    const float mean = wave_sum(s) * (1.f / D); float q = 0.f;
#pragma unroll
    for (int j = 0; j < 4; ++j) { r.v[j] = r.v[j] - mean; q += (r.v[j][0] * r.v[j][0] + r.v[j][1] * r.v[j][1]) + (r.v[j][2] * r.v[j][2] + r.v[j][3] * r.v[j][3]); }
    const float rstd = 1.f / sqrtf(wave_sum(q) * (1.f / D) + eps);
#pragma unroll
    for (int j = 0; j < 4; ++j) r.v[j] = r.v[j] * rstd;
}
__device__ __forceinline__ void row_modulate(Row& r, const float* sh, const float* sc, int lane) {
    row_normalize(r, MOD_EPS);
#pragma unroll
    for (int j = 0; j < 4; ++j) { const f32x4 a = ((const GAS f32x4*)sc)[vq(j, lane)], b = ((const GAS f32x4*)sh)[vq(j, lane)]; r.v[j] = r.v[j] * (a + 1.f) + b; }
}
__device__ __forceinline__ int mod_row(int row) { return row < T ? (row >> 11) : 32; }
__device__ __forceinline__ const float* mod_vec(const unsigned char* ws, int layer, int mr, int chunk) { return (const float*)(ws + WS_MOD) + ((size_t)(layer * 33 + mr) * 6 + chunk) * 1024; }

__device__ __forceinline__ void conv_item(const float* W, int N, bf16_t* WT, int Kd, int kd0, int n0, int drow0, bool mirror, LAS float* scr, int lane) {
#pragma unroll 8
    for (int i = 0; i < 32; ++i) { const int kk = 2 * i + (lane >> 5); const int kd = kd0 + kk; const int ks = mirror ? ((kd & ~255) + ((256 - (kd & 255)) & 255)) : kd;
        scr[kk * 33 + (lane & 31)] = ((const GAS float*)W)[(size_t)ks * N + n0 + (lane & 31)]; }
    LDS_WAIT(); asm volatile("" ::: "memory");
    const int c = lane & 7;
#pragma unroll
    for (int j = 0; j < 4; ++j) { const int n = (lane >> 3) + 8 * j; const LAS float* s = scr + (8 * c) * 33 + n;
        u32x4 o; o.x = pk2(s[0 * 33], s[1 * 33]); o.y = pk2(s[2 * 33], s[3 * 33]); o.z = pk2(s[4 * 33], s[5 * 33]); o.w = pk2(s[6 * 33], s[7 * 33]);
        *(GAS u32x4*)(WT + (size_t)(drow0 + n) * Kd + kd0 + 8 * c) = o; }
    LDS_WAIT(); asm volatile("" ::: "memory");
}
__device__ __forceinline__ void conv_matrix_item(const float* W, int K, int N, bf16_t* WT, int mode, int roff, int item, LAS float* scr, int lane) {
    const int nblk = N / 32, kb = item / nblk, nb = item % nblk, n0 = 32 * nb;
    int drow0 = n0 + roff; if (mode == 1) drow0 = (n0 >> 7) * 256 + (n0 & 127); if (mode == 2) drow0 = (n0 >> 7) * 256 + 128 + (n0 & 127);
    conv_item(W, N, WT, K, 64 * kb, n0, drow0, mode == 3, scr, lane);
}
__device__ __forceinline__ void conv_item64(const float* W, int N, bf16_t* WT, int Kd, int k0, int n0, int drow0, LAS bf16_t* scr, int lane) {
    f32x4 v[16];
#pragma unroll
    for (int i = 0; i < 16; ++i) v[i] = *(const GAS f32x4*)(W + (size_t)(k0 + 4 * i + (lane >> 4)) * N + n0 + (lane & 15) * 4);
#pragma unroll
    for (int i = 0; i < 16; ++i) { u32x2 w; w.x = pk2(v[i][0], v[i][1]); w.y = pk2(v[i][2], v[i][3]); *(LAS u32x2*)(scr + (4 * i + (lane >> 4)) * 68 + (lane & 15) * 4) = w; }
    LDS_WAIT(); asm volatile("" ::: "memory");
    const int c = lane & 7;
#pragma unroll
    for (int j = 0; j < 8; ++j) { const int n = (lane >> 3) + 8 * j; const LAS bf16_t* p = scr + (8 * c) * 68 + n;
        u32x4 o; o.x = (unsigned)p[0] | ((unsigned)p[68] << 16); o.y = (unsigned)p[2 * 68] | ((unsigned)p[3 * 68] << 16); o.z = (unsigned)p[4 * 68] | ((unsigned)p[5 * 68] << 16); o.w = (unsigned)p[6 * 68] | ((unsigned)p[7 * 68] << 16);
        *(GAS u32x4*)(WT + (size_t)(drow0 + n) * Kd + k0 + 8 * c) = o; }
    LDS_WAIT(); asm volatile("" ::: "memory");
}
__device__ __forceinline__ void conv_experts(Frame& F, const float* wg, const float* wu, const float* wd, int layer) {
    F.refresh();
    LAS bf16_t* scr = (LAS bf16_t*)(F.lds + 32768 + F.wave * 8704);
    bf16_t* EGU = (bf16_t*)(F.ws + WS_EGU); bf16_t* ED = (bf16_t*)(F.ws + WS_ED);
    for (int it = F.gw; it < NE * 192; it += NGW) { const int e = it / 192, r = it % 192;
        const size_t eo = ((size_t)layer * NE + e) * (1024 * 256);
        if (r < 128) { const int q = r & 63, kb = q >> 2, nb = q & 3, n0 = 64 * nb; const int drow0 = (n0 >> 7) * 256 + (r < 64 ? 0 : 128) + (n0 & 127);
            conv_item64((r < 64 ? wg : wu) + eo, 256, EGU + (size_t)e * 512 * 1024, 1024, 64 * kb, n0, drow0, scr, F.lane); }
        else { const int q = r - 128, kb = q >> 4, nb = q & 15; conv_item64(wd + eo, 1024, ED + (size_t)e * 1024 * 256, 256, 64 * kb, 64 * nb, 64 * nb, scr, F.lane); } }
}
__device__ __forceinline__ void conv_small(Frame& F, const Args& a) {
    F.refresh();
    LAS float* scr = (LAS float*)(F.lds + 32768 + F.wave * 8448);
    for (int it = F.gw; it < 6272; it += NGW) {
        if (it < 1536) { const int j = it / 768, r = it % 768; conv_matrix_item(a.in[8] + (size_t)j * 1024 * 1536, 1024, 1536, (bf16_t*)(F.ws + WS_WQKV) + (size_t)j * 1536 * 1024, 0, 0, r, scr, F.lane); }
        else if (it < 2560) { const int q = it - 1536, j = q / 512, r = q % 512; conv_matrix_item(a.in[9] + (size_t)j * 1024 * 1024, 1024, 1024, (bf16_t*)(F.ws + WS_WO) + (size_t)j * 1024 * 1024, 0, 0, r, scr, F.lane); }
        else if (it < 4608) { const int q = it - 2560, j = q / 1024, r = q % 1024; bf16_t* dst = (bf16_t*)(F.ws + WS_WF) + (size_t)j * 2048 * 1024;
            if (r < 512) conv_matrix_item(a.in[11] + (size_t)j * 1024 * 1024, 1024, 1024, dst, 0, 0, r, scr, F.lane);
            else conv_matrix_item(a.in[11] + (size_t)j * 1024 * 1024, 1024, 1024, dst, 3, 1024, r - 512, scr, F.lane); }
        else if (it < 4736) { const int q = it - 4608, l = q / 32, r = q % 32; conv_matrix_item(a.in[12] + (size_t)l * 1024 * 64, 1024, 64, (bf16_t*)(F.ws + WS_WR) + (size_t)l * 64 * 1024, 0, 0, r, scr, F.lane); }
        else { const int q = it - 4736, l = q / 384, r = q % 384; bf16_t* gu = (bf16_t*)(F.ws + WS_WSH + (size_t)l * 1536 * 1024); bf16_t* dn = gu + 512 * 1024;
            if (r < 128) conv_matrix_item(a.in[17] + (size_t)l * 1024 * 256, 1024, 256, gu, 1, 0, r, scr, F.lane);
            else if (r < 256) conv_matrix_item(a.in[18] + (size_t)l * 1024 * 256, 1024, 256, gu, 2, 0, r - 128, scr, F.lane);
            else conv_matrix_item(a.in[19] + (size_t)l * 256 * 1024, 256, 1024, dn, 0, 0, r - 256, scr, F.lane); }
    }
    const int gt = F.blk * NTHR + F.tid, NGT = GRID * NTHR;
    const float TWO_PI = 6.283185307179586f;
    { float* rc = (float*)(F.ws + WS_ROPEC); float* rs = (float*)(F.ws + WS_ROPES);
      for (int i = gt; i < 64 * 16; i += NGT) { const int pos = i >> 4, fi = i & 15; const float inv = exp2f(-(float)fi * (13.287712379549449f / 16.f)); const float ang = (float)pos * inv; rc[i] = cosf(ang); rs[i] = sinf(ang); } }
    { bf16_t* cs = (bf16_t*)(F.ws + WS_CSN);
      for (int i = gt; i < 512 * 256; i += NGT) { const int r = i >> 8, n = i & 255, m = r & 255; const float ang = TWO_PI * (float)((m * n) & 255) * (1.f / 256.f); cs[i] = (bf16_t)f2bf(r < 256 ? cosf(ang) : -sinf(ang)); } }
    { bf16_t* dl = (bf16_t*)(F.ws + WS_DL);
      for (int i = gt; i < 1024 * 4096; i += NGT) { const int k = i >> 12, c = i & 4095, l = c & 2047; const float ang = TWO_PI * (float)((k * l) & 2047) * (1.f / 2048.f); dl[i] = (bf16_t)f2bf(c < 2048 ? cosf(ang) : sinf(ang)); } }
    { bf16_t* dl = (bf16_t*)(F.ws + WS_DLC);
      for (int i = gt; i < 256 * 512; i += NGT) { const int k = i >> 9, c = i & 511, l = c & 255; const float ang = TWO_PI * (float)((k * l) & 255) * (1.f / 256.f); dl[i] = (bf16_t)f2bf(c < 256 ? cosf(ang) : sinf(ang)); } }
}
__device__ __forceinline__ void mod_partials(Frame& F, const Args& a) {
    F.refresh();
    if (F.blk >= 192) return;
    const int l = F.blk / 48, cb = (F.blk % 48) / 4, kc = F.blk & 3;
    LAS float* s = (LAS float*)F.lds;
    for (int i = F.tid; i < 256 * 33; i += NTHR) { const int k = i / 33, r = i % 33; const float c = (r < 32) ? a.in[1][(size_t)r * 1024 + kc * 256 + k] : a.in[3][kc * 256 + k]; s[k * 36 + r] = c / (1.f + __expf(-c)); }
    __syncthreads();
    const int n = cb * 512 + F.tid;
    const GAS float* w = (const GAS float*)a.in[4] + ((size_t)l * 1024 + kc * 256) * 6144 + n;
    float acc[33];
#pragma unroll
    for (int r = 0; r < 33; ++r) acc[r] = 0.f;
#pragma unroll 4
    for (int k = 0; k < 256; ++k) { const float wv = w[(size_t)k * 6144];
#pragma unroll
        for (int r = 0; r < 33; ++r) acc[r] += s[k * 36 + r] * wv; }
    float* part = (float*)(F.ws + WS_MODP) + ((size_t)(kc * 4 + l) * 33) * 6144 + n;
#pragma unroll
    for (int r = 0; r < 33; ++r) part[(size_t)r * 6144] = acc[r];
    __syncthreads();
}
__device__ __forceinline__ void mod_finalize(Frame& F, const Args& a) {
    F.refresh();
    const int gt = F.blk * NTHR + F.tid, NGT = GRID * NTHR; const float* part = (const float*)(F.ws + WS_MODP); float* mod = (float*)(F.ws + WS_MOD);
    for (int i = gt; i < 4 * 33 * 6144; i += NGT) { const int l = i / (33 * 6144), n = i % 6144; float v = a.in[5][l * 6144 + n];
#pragma unroll
        for (int kc = 0; kc < 4; ++kc) v += part[(size_t)kc * 4 * 33 * 6144 + i]; mod[i] = v; }
}
__device__ __forceinline__ void rows_init(Frame& F, const Args& a) {
    F.refresh();
    bf16_t* XS = (bf16_t*)(F.ws + WS_XS); bf16_t* U = (bf16_t*)a.out; const float* part = (const float*)(F.ws + WS_MODP);
    for (int row = F.gw; row < TT; row += NGW) {
        Row r; row_load_f32(r, row < T ? a.in[0] + (size_t)row * D : a.in[2] + (size_t)(row - T) * D, F.lane);
        row_store_bf16(r, XS + (size_t)row * D, F.lane);
        row_normalize(r, MOD_EPS); const int mr = mod_row(row);
#pragma unroll
        for (int j = 0; j < 4; ++j) { const int e = vq(j, F.lane);
            f32x4 sh = ((const GAS f32x4*)(a.in[5]))[e], sc = ((const GAS f32x4*)(a.in[5] + 1024))[e];
#pragma unroll
            for (int kc = 0; kc < 4; ++kc) { const float* pp = part + ((size_t)(kc * 4 + 0) * 33 + mr) * 6144; sh += ((const GAS f32x4*)pp)[e]; sc += ((const GAS f32x4*)(pp + 1024))[e]; }
            r.v[j] = r.v[j] * (sc + 1.f) + sh; }
        row_store_bf16(r, U + (size_t)row * D, F.lane);
    }
}
__device__ __forceinline__ void rows_post1(Frame& F, const Args& a, int layer, int nrows) {
    F.refresh();
    bf16_t* XS = (bf16_t*)(F.ws + WS_XS); bf16_t* U = (bf16_t*)a.out;
    const float* lg = a.in[6] + (size_t)(layer * 2 + 0) * D; const float* lb = a.in[7] + (size_t)(layer * 2 + 0) * D;
    const int TPB = nrows / GRID;
    for (int rl = F.wave; rl < TPB; rl += NWAVES) { const int row = F.blk * TPB + rl; const int mr = mod_row(row);
        Row x, y; row_load_bf16(x, XS + (size_t)row * D, F.lane); row_load_bf16(y, U + (size_t)row * D, F.lane);
        const float* g1 = mod_vec(F.ws, layer, mr, 2);
#pragma unroll
        for (int j = 0; j < 4; ++j) x.v[j] = x.v[j] * ALPHA + ((const GAS f32x4*)g1)[vq(j, F.lane)] * y.v[j];
        row_normalize(x, LN_EPS);
#pragma unroll
        for (int j = 0; j < 4; ++j) x.v[j] = x.v[j] * ((const GAS f32x4*)lg)[vq(j, F.lane)] + ((const GAS f32x4*)lb)[vq(j, F.lane)];
        row_store_bf16(x, XS + (size_t)row * D, F.lane);
        row_modulate(x, mod_vec(F.ws, layer, mr, 3), mod_vec(F.ws, layer, mr, 4), F.lane);
        row_store_bf16(x, U + (size_t)row * D, F.lane);
    }
}
__device__ __forceinline__ void rows_post2(Frame& F, const Args& a, int layer, int t0, int n) {
    F.refresh();
    bf16_t* XS = (bf16_t*)(F.ws + WS_XS); bf16_t* U = (bf16_t*)a.out; const unsigned char* YB = (const unsigned char*)(F.ws + WS_YB); const unsigned char* YS = (const unsigned char*)(F.ws + WS_YS);
    const int* spos = (const int*)(F.ws + WS_SDST); const float* tkw = (const float*)(F.ws + WS_TKW);
    const float* lg = a.in[6] + (size_t)(layer * 2 + 1) * D; const float* lb = a.in[7] + (size_t)(layer * 2 + 1) * D;
    for (int i = F.gw; i < n; i += NGW) { const int row = t0 + i; const int mr = mod_row(row);
        Row x, y; row_load_bf16(x, XS + (size_t)row * D, F.lane);
        int pj = 0; float wj = 0.f; if (F.lane < 8) { pj = ((const GAS int*)spos)[(size_t)row * 8 + F.lane]; wj = ((const GAS float*)tkw)[(size_t)row * 8 + F.lane]; }
        row_load_fp8(y, YS + (size_t)i * D, F.lane);
#pragma unroll
        for (int j = 0; j < 4; ++j) y.v[j] = y.v[j] * (1.f / 16.f);
#pragma unroll
        for (int s = 0; s < 8; ++s) { const int ps = __builtin_amdgcn_readlane(pj, s); const float ws_ = __builtin_bit_cast(float, __builtin_amdgcn_readlane(__builtin_bit_cast(int, wj), s));
            Row z; row_load_fp8(z, YB + (size_t)ps * D, F.lane); const float wz = ws_ * (1.f / 16.f);
#pragma unroll
            for (int j = 0; j < 4; ++j) y.v[j] += z.v[j] * wz; }
        const float* g2 = mod_vec(F.ws, layer, mr, 5);
#pragma unroll
        for (int j = 0; j < 4; ++j) x.v[j] = x.v[j] * ALPHA + ((const GAS f32x4*)g2)[vq(j, F.lane)] * y.v[j];
        row_normalize(x, LN_EPS);
#pragma unroll
        for (int j = 0; j < 4; ++j) x.v[j] = x.v[j] * ((const GAS f32x4*)lg)[vq(j, F.lane)] + ((const GAS f32x4*)lb)[vq(j, F.lane)];
        if (layer == 3) { row_store_f32(x, a.out + (size_t)row * D, F.lane); }
        else { row_store_bf16(x, XS + (size_t)row * D, F.lane);
            row_modulate(x, mod_vec(F.ws, layer + 1, mr, 0), mod_vec(F.ws, layer + 1, mr, 1), F.lane);
            row_store_bf16(x, U + (size_t)row * D, F.lane); }
    }
}

__device__ __forceinline__ float wave_max_dpp(float v) {
    int x = __builtin_bit_cast(int, v);
#define DPPMAX(ctrl) { const int y = __builtin_amdgcn_update_dpp(x, x, ctrl, 0xf, 0xf, false); x = __builtin_bit_cast(int, fmaxf(__builtin_bit_cast(float, x), __builtin_bit_cast(float, y))); }
    DPPMAX(0xB1) DPPMAX(0x4E) DPPMAX(0x141) DPPMAX(0x140)
#undef DPPMAX
    const float r0 = __builtin_bit_cast(float, __builtin_amdgcn_readlane(x, 0)), r1 = __builtin_bit_cast(float, __builtin_amdgcn_readlane(x, 16));
    const float r2 = __builtin_bit_cast(float, __builtin_amdgcn_readlane(x, 32)), r3 = __builtin_bit_cast(float, __builtin_amdgcn_readlane(x, 48));
    return fmaxf(fmaxf(r0, r1), fmaxf(r2, r3));
}
__device__ __forceinline__ void route_tokens(Frame& F, const Args& a, int layer, int ntok) {
    F.refresh();
    const int TPB = ntok / GRID;
    const bf16_t* U = (const bf16_t*)a.out; const bf16_t* Wr = (const bf16_t*)(F.ws + WS_WR) + (size_t)layer * 64 * 1024;
    int* tke = (int*)(F.ws + WS_TKE); float* tkw = (float*)(F.ws + WS_TKW);
    LAS int* lcnt = (LAS int*)(F.lds + L_LCNT);
    LAS float* sc = (LAS float*)(F.lds) + F.wave * 1024;
    if (F.tid < 64) lcnt[F.tid] = 0;
    __syncthreads();
    const int lane = F.lane, fr = lane & 15, fq = lane >> 4;
    const float bias = a.in[13][layer * 64 + lane];
    const int ntile = TPB / 16;
    for (int tl = F.wave; tl < ntile; tl += NWAVES) {
        const int t0 = F.blk * TPB + tl * 16;
        f32x4 acc[4];
#pragma unroll
        for (int n = 0; n < 4; ++n) acc[n] = (f32x4){0.f, 0.f, 0.f, 0.f};
        const GAS bf16x8* ap = (const GAS bf16x8*)(U + (size_t)(t0 + fr) * D + fq * 8);
        const GAS bf16x8* bp = (const GAS bf16x8*)(Wr + (size_t)fr * D + fq * 8);
#pragma unroll 4
        for (int ks = 0; ks < 32; ++ks) { const bf16x8 av = ap[ks * 4];
#pragma unroll
            for (int n = 0; n < 4; ++n) { const bf16x8 bv = bp[(size_t)n * 16 * (D / 8) + ks * 4]; acc[n] = __builtin_amdgcn_mfma_f32_16x16x32_bf16(av, bv, acc[n], 0, 0, 0); } }
#pragma unroll
        for (int n = 0; n < 4; ++n)
#pragma unroll
            for (int j = 0; j < 4; ++j) sc[(fq * 4 + j) * 64 + n * 16 + fr] = acc[n][j];
        LDS_WAIT();
        for (int tk = 0; tk < 16; ++tk) {
            const float logit = sc[tk * 64 + lane];
            const float s = 1.f / (1.f + __expf(-logit));
            const float sel = s + bias;
            const int g = lane >> 3;
            float m1 = sel; m1 = fmaxf(m1, __shfl_xor(m1, 1)); m1 = fmaxf(m1, __shfl_xor(m1, 2)); m1 = fmaxf(m1, __shfl_xor(m1, 4));
            const unsigned long long bm = __ballot(sel == m1);
            const unsigned gm = (unsigned)(bm >> (g * 8)) & 0xffu;
            const int first = g * 8 + __builtin_ctz(gm);
            float m2 = (lane == first) ? -INFINITY : sel; m2 = fmaxf(m2, __shfl_xor(m2, 1)); m2 = fmaxf(m2, __shfl_xor(m2, 2)); m2 = fmaxf(m2, __shfl_xor(m2, 4));
            const float gs = m1 + m2;
            float curg = gs; bool gok = false;
#pragma unroll 1
            for (int it = 0; it < 4; ++it) { const float mx = wave_max_dpp(curg);
                const unsigned long long bb = __ballot(curg == mx); const int gi = (int)(__builtin_ctzll(bb) >> 3);
                if (g == gi) { gok = true; curg = -INFINITY; } }
            float cure = gok ? sel : -INFINITY; bool chosen = false; int rk = 0;
#pragma unroll 1
            for (int it = 0; it < 8; ++it) { const float mx = wave_max_dpp(cure);
                const unsigned long long bb = __ballot(cure == mx); const int ei = (int)__builtin_ctzll(bb);
                if (lane == ei) { chosen = true; rk = it; cure = -INFINITY; } }
            const float tot = wave_sum(chosen ? s : 0.f);
            if (chosen) { const int tok = t0 + tk; tke[(size_t)tok * 8 + rk] = lane; tkw[(size_t)tok * 8 + rk] = s / tot * 2.5f; __hip_atomic_fetch_add(&lcnt[lane], 1, __ATOMIC_RELAXED, __HIP_MEMORY_SCOPE_WORKGROUP); }
        }
        LDS_WAIT();
    }
    __syncthreads();
    if (F.tid < 64) F.ctl[CW_BCNT + F.blk * 64 + F.tid] = (unsigned)lcnt[F.tid];
}
__device__ __forceinline__ void build_lists(Frame& F, int ntok) {
    F.refresh();
    constexpr int NSEG = NCHUNK * 64, BPC = GRID / NCHUNK;
    const int TPB = ntok / GRID, CH = ntok / NCHUNK;
    LAS int* tstart = (LAS int*)(F.lds + L_TSTART); LAS int* pref = (LAS int*)(F.lds + L_PREF); LAS int* lcnt = (LAS int*)(F.lds + L_LCNT);
    LAS unsigned char* tseg = (LAS unsigned char*)(F.lds + L_TSEG); LAS int* scan = (LAS int*)(F.lds + L_SCAN);
    const unsigned* bcnt = F.ctl + CW_BCNT;
    const int myc = F.blk / BPC, mylb = F.blk % BPC;
    int nseg = 0;
    LAS int* cntl = (LAS int*)F.lds;
    for (int i = F.tid; i < GRID * 64; i += NTHR) cntl[i] = (int)((const GAS unsigned*)bcnt)[i];
    if (F.tid < 64) lcnt[F.tid] = 0;
    __syncthreads();
    if (F.tid < NSEG) { const int c = F.tid >> 6, e = F.tid & 63; int n = 0, p = 0;
        for (int lb = 0; lb < BPC; ++lb) { const int v = cntl[(c * BPC + lb) * 64 + e]; if (c == myc && lb < mylb) p += v; n += v; }
        nseg = n; scan[F.tid] = (n + 255) >> 8; if (c == myc) pref[e] = p; }
    __syncthreads();
    if (F.tid == 0) { int acc = 0; for (int s = 0; s < NSEG; ++s) { tstart[s] = acc; acc += scan[s]; } tstart[NSEG] = acc; }
    __syncthreads();
    if (F.tid < NSEG) { const int t0 = tstart[F.tid], t1 = tstart[F.tid + 1]; for (int t = t0; t < t1; ++t) tseg[t] = (unsigned char)F.tid; }
    int* stok = (int*)(F.ws + WS_STOK); int* spos = (int*)(F.ws + WS_SDST);
    const int* tke = (const int*)(F.ws + WS_TKE);
    { const int sseg = myc * 64 + mylb; if (mylb < 64 && F.tid == sseg) scan[0] = nseg; }
    __syncthreads();
    if (mylb < 64) { const int sseg = myc * 64 + mylb; const int n = scan[0]; const int base = tstart[sseg] * 256, end = tstart[sseg + 1] * 256;
      for (int p = base + n + F.tid; p < end; p += NTHR) stok[p] = myc * CH; }
    for (int tl = F.wave; tl < TPB; tl += NWAVES) { const int tok = F.blk * TPB + tl;
        if (F.lane < 8) { const int e = tke[(size_t)tok * 8 + F.lane];
            const int p = tstart[myc * 64 + e] * 256 + pref[e] + __hip_atomic_fetch_add(&lcnt[e], 1, __ATOMIC_RELAXED, __HIP_MEMORY_SCOPE_WORKGROUP);
            stok[p] = tok; spos[(size_t)tok * 8 + F.lane] = p - tstart[myc * 64] * 256; } }
    __syncthreads();
}

struct SchedQKV {
    const char* U; const char* W; int nfull, nu, c;
    __device__ __forceinline__ bool next(int i, pg::Unit& u) const {
        const int L0 = i * GRID + c; if (L0 >= nu) return false;
        int pm, pn;
        if (L0 < nfull) { const int L = pg::xcd_remap(L0, nfull); const int gid = L / 48, w = L % 48; pm = gid * 8 + (w & 7); pn = w >> 3; }
        else { const int q = L0 - nfull; pm = 256 + (q >> 1); pn = 4 + (q & 1); }
        u.A = U + (size_t)pm * 256 * 2048; u.B = W + (size_t)pn * 256 * 2048; u.gidx = nullptr; u.gbase = 0; u.nt = 16; u.out = nullptr; u.ldc = 0; u.scale = 1.f; u.flags = 0; u.i0 = pm; u.i1 = pn; u.l0 = nullptr; u.l1 = nullptr;
        return true; }
};
struct SchedDense {
    const char* A; const char* W; char* out; int nrt, nct, nt, c; size_t ldA;
    __device__ __forceinline__ bool next(int i, pg::Unit& u) const {
        const int nu = nrt * nct; const int L0 = i * GRID + c; if (L0 >= nu) return false;
        const int L = pg::xcd_remap(L0, nu); const int per = 8 * nct, gid = L / per, w = L % per, fm = gid * 8, gsz = (nrt - fm) < 8 ? (nrt - fm) : 8; const int pm = fm + (w % gsz), pn = w / gsz;
        u.A = A + (size_t)pm * 256 * ldA; u.B = W + (size_t)pn * 256 * ldA; u.gidx = nullptr; u.gbase = 0; u.nt = nt; u.out = out + (size_t)pm * 256 * 2048 + pn * 512; u.ldc = 2048; u.scale = 1.f; u.flags = 0; u.i0 = pm; u.i1 = pn; u.l0 = nullptr; u.l1 = nullptr;
        return true; }
};
struct SchedF1 {
    const char* CS; const char* U; char* ABT; char* ABTC; int nu, c;
    __device__ __forceinline__ bool next(int i, pg::Unit& u) const {
        const int L0 = i * GRID + c; if (L0 >= nu) return false;
        u.gidx = nullptr; u.gbase = 0; u.nt = 4; u.scale = 1.f; u.flags = 0; u.i0 = 0; u.i1 = 0; u.l0 = nullptr; u.l1 = nullptr;
        if (L0 < 2048) { const int L = pg::xcd_remap(L0, 2048); const int pm = L & 1, pn = (L >> 1) & 7, bg = L >> 4, b = bg >> 2, g = bg & 3;
            u.A = CS + (size_t)pm * 256 * 512; u.B = U + ((size_t)b * SEQ + pn * 256) * 2048 + g * 512; u.out = ABT + (size_t)bg * 256 * 8192 + (size_t)(pm * 2048 + pn * 256) * 2; u.ldc = 8192; }
        else { const int q = L0 - 2048; const int pm = q & 1, bg = q >> 1, b = bg >> 2, g = bg & 3;
            u.A = CS + (size_t)pm * 256 * 512; u.B = U + ((size_t)T + b * CTXL) * 2048 + g * 512; u.out = ABTC + (size_t)bg * 256 * 1024 + (size_t)pm * 512; u.ldc = 1024; }
        return true; }
};
struct SchedF2 {
    const char* DL; const char* ABT; char* FH; int c;
    __device__ __forceinline__ bool next(int i, pg::Unit& u) const {
        const int L0 = i * GRID + c; if (L0 >= 512) return false;
        const int L = pg::xcd_remap(L0, 512); const int pm = L & 3, bg = L >> 2, b = bg >> 2, g = bg & 3;
        u.A = DL + (size_t)pm * 256 * 8192; u.B = ABT + (size_t)bg * 256 * 8192; u.gidx = nullptr; u.gbase = 0; u.nt = 64; u.out = FH + ((size_t)b * 1024 + pm * 256) * 2048 + g * 512; u.ldc = 2048; u.scale = 0.001381067932004975f  ; u.flags = 0; u.i0 = 0; u.i1 = 0; u.l0 = nullptr; u.l1 = nullptr;
        return true; }
};
struct SchedF2c {
    const char* DLC; const char* ABTC; char* FC; int c;
    __device__ __forceinline__ bool next(int i, pg::Unit& u) const {
        const int L0 = i * GRID + c; if (L0 >= 128) return false;
        const int bg = L0, b = bg >> 2, g = bg & 3;
        u.A = DLC; u.B = ABTC + (size_t)bg * 256 * 1024; u.gidx = nullptr; u.gbase = 0; u.nt = 8; u.out = FC + ((size_t)b * 256) * 2048 + g * 512; u.ldc = 2048; u.scale = 1.f / 256.f; u.flags = 0; u.i0 = 0; u.i1 = 0; u.l0 = nullptr; u.l1 = nullptr;
        return true; }
};
struct SchedF3 {
    const char* FH; const char* FC; const char* W; char* Y; int nu, c;
    __device__ __forceinline__ bool next(int i, pg::Unit& u) const {
        const int L0 = i * GRID + c; if (L0 >= nu) return false;
        u.gidx = nullptr; u.gbase = 0; u.nt = 16; u.scale = 1.f; u.flags = 0; u.i0 = 0; u.i1 = 0; u.l0 = nullptr; u.l1 = nullptr;
        if (L0 < 1024) { const int L = pg::xcd_remap(L0, 1024); const int gid = L >> 6, w = L & 63, pm = gid * 8 + (w & 7), pn = w >> 3; const int b = pm >> 2, k0 = (pm & 3) * 256;
            u.A = FH + (size_t)pm * 256 * 2048; u.B = W + (size_t)pn * 256 * 2048;
            if (pn < 4) { u.out = Y + ((size_t)b * SEQ + k0) * 2048 + pn * 512; u.ldc = 2048; }
            else { u.out = Y + ((size_t)b * SEQ + SEQ - k0) * 2048 + (pn - 4) * 512; u.ldc = -2048; u.flags = (k0 == 0) ? 1 : 0; } }
        else { const int q = L0 - 1024; const int pm = q >> 2, pn = q & 3;
            u.A = FC + (size_t)pm * 256 * 2048; u.B = W + (size_t)pn * 256 * 2048; u.out = Y + ((size_t)T + pm * 256) * 2048 + pn * 512; u.ldc = 2048; }
        return true; }
};
struct SchedG1 {
    const char* EGU; const char* WSG; const int* STOK; char* H; char* HS; LAS const unsigned char* tseg; int ntl, nsh, c;
    __device__ __forceinline__ bool gsrc(int i, const int*& gidx, int& gbase) const {
        const int nu = (ntl + nsh) * 2; const int L0 = i * GRID + c; if (L0 >= nu) return false;
        const int pm = pg::xcd_remap(L0, nu) >> 1;
        if (pm < ntl) { gidx = STOK + (size_t)pm * 256; gbase = 0; } else { gidx = nullptr; gbase = (pm - ntl) * 256; }
        return true; }
    __device__ __forceinline__ bool next(int i, pg::Unit& u) const {
        const int nu = (ntl + nsh) * 2; const int L0 = i * GRID + c; if (L0 >= nu) return false;
        const int L = pg::xcd_remap(L0, nu); const int pm = L >> 1, pn = L & 1;
        u.A = nullptr; u.gbase = 0; u.nt = 16; u.ldc = 512; u.scale = 1.f; u.flags = 0; u.i0 = 0; u.i1 = 0; u.l0 = nullptr; u.l1 = nullptr;
        if (pm < ntl) { const int e = __builtin_amdgcn_readfirstlane((int)tseg[pm]) & 63;
            u.gidx = STOK + (size_t)pm * 256; u.B = EGU + (size_t)e * 512 * 2048 + (size_t)pn * 256 * 2048; u.out = H + (size_t)pm * 256 * 512 + pn * 256; }
        else { const int ps = pm - ntl; u.gidx = nullptr; u.gbase = ps * 256; u.B = WSG + (size_t)pn * 256 * 2048; u.out = HS + (size_t)ps * 256 * 512 + pn * 256; }
        return true; }
};
struct SchedG2 {
    const char* ED; const char* WSD; const char* H; const char* HS; char* YB; char* YS; LAS const unsigned char* tseg; int t0, t1, nsh, ch, CH, c;
    __device__ __forceinline__ bool next(int i, pg::Unit& u) const {
        const int nr = t1 - t0; const int nu = (nr + nsh) * 4; const int L0 = i * GRID + c; if (L0 >= nu) return false;
        const int L = pg::xcd_remap(L0, nu); const int q = L >> 2, pn = L & 3;
        u.gidx = nullptr; u.gbase = 0; u.nt = 4; u.ldc = 1024; u.scale = 1.f; u.flags = 0; u.i0 = 0; u.i1 = pn; u.l0 = nullptr; u.l1 = nullptr;
        if (q < nr) { const int pm = t0 + q; const int e = __builtin_amdgcn_readfirstlane((int)tseg[pm]) & 63;
            u.A = H + (size_t)pm * 256 * 512; u.B = ED + (size_t)e * 1024 * 512 + (size_t)pn * 256 * 512; u.out = YB + (size_t)q * 256 * 1024; }
        else { const int ps = q - nr; u.A = HS + ((size_t)ch * CH + ps * 256) * 512; u.B = WSD + (size_t)pn * 256 * 512; u.out = YS + (size_t)ps * 256 * 1024; }
        return true; }
};

__device__ __forceinline__ void fnet_nyquist_rows(Frame& F) {
    F.refresh();
    const bf16_t* ABT = (const bf16_t*)(F.ws + WS_ABT); bf16_t* FH1 = (bf16_t*)(F.ws + WS_FH1);
    for (int r = F.gw; r < 128 * 256; r += NGW) { const int bg = r >> 8, m = r & 255, b = bg >> 2, g = bg & 3;
        const GAS u32x4* p = (const GAS u32x4*)(ABT + (size_t)r * 4096); float s = 0.f;
#pragma unroll
        for (int i = 0; i < 4; ++i) { const u32x4 w = p[i * 64 + F.lane]; s += (bflo(w.x) - bfhi(w.x)) + (bflo(w.y) - bfhi(w.y)) + (bflo(w.z) - bfhi(w.z)) + (bflo(w.w) - bfhi(w.w)); }
        s = wave_sum(s) * 0.001381067932004975f;
        if (F.lane == 0) FH1[(size_t)b * 1024 + g * 256 + m] = (bf16_t)f2bf(s); }
}
__device__ __forceinline__ void fnet_nyquist_out(Frame& F, const Args& a, int jl) {
    F.refresh();
    const bf16_t* FH1 = (const bf16_t*)(F.ws + WS_FH1); const bf16_t* W = (const bf16_t*)(F.ws + WS_WF) + (size_t)jl * 2048 * 1024; bf16_t* Y = (bf16_t*)a.out;
    LAS float* part = (LAS float*)F.lds;
    const int b = F.blk >> 3, n = (F.blk & 7) * 128 + (F.tid & 127), kq = F.tid >> 7;
    const GAS u32x4* wp = (const GAS u32x4*)(W + (size_t)n * 1024 + kq * 256); const GAS u32x4* fp = (const GAS u32x4*)(FH1 + (size_t)b * 1024 + kq * 256);
    float s = 0.f;
#pragma unroll 4
    for (int i = 0; i < 32; ++i) { const u32x4 w = wp[i], f = fp[i];
        s += bflo(w.x) * bflo(f.x) + bfhi(w.x) * bfhi(f.x) + bflo(w.y) * bflo(f.y) + bfhi(w.y) * bfhi(f.y) + bflo(w.z) * bflo(f.z) + bfhi(w.z) * bfhi(f.z) + bflo(w.w) * bflo(f.w) + bfhi(w.w) * bfhi(f.w); }
    part[F.tid] = s;
    __syncthreads();
    if (F.tid < 128) { const float t = (part[F.tid] + part[F.tid + 128]) + (part[F.tid + 256] + part[F.tid + 384]); Y[((size_t)b * SEQ + 1024) * D + n] = (bf16_t)f2bf(t); }
    __syncthreads();
}


#ifdef SELFCHECK
constexpr int CW_ERR = 1024;
constexpr size_t WS_OCHK = WS_R + 216 * MiB;
__device__ __forceinline__ void chk_report(unsigned* ctl, int id, float got, float ref, float tabs, float trel) {
    float e = fabsf(got - ref) / (tabs + trel * fabsf(ref)); if (!(e == e)) e = 1e30f; atomicMax(ctl + CW_ERR + id, __float_as_uint(e)); }
__device__ __forceinline__ float bf2f(bf16_t b) { return __builtin_bit_cast(float, (unsigned)b << 16); }
__constant__ int chk_toks[16] = {0, 1, 63, 64, 65, 127, 2047, 2048, 2049, 4096, 33000, 65535, 65536, 65537, 70000, 73727};
__constant__ int chk_ks[8] = {0, 1, 2, 255, 256, 1023, 1024, 700};
__constant__ int chk_ms[4] = {0, 1, 128, 255};
__constant__ int chk_ytoks[10] = {0, 1, 1023, 1024, 1025, 2047, 2048, 65535, 65536, 73727};
__constant__ int chk_ns[5] = {0, 1, 255, 256, 1023};
__constant__ int chk_cols[20] = {0, 7, 15, 16, 31, 32, 40, 48, 63, 64, 500, 1023, 1024, 1039, 1040, 1072, 1279, 1280, 1300, 1535};
__device__ __forceinline__ void chk_qkv(Frame& F, const Args& a, int layer, int id) {
    F.refresh(); const bf16_t* U = (const bf16_t*)a.out; const float* W = a.in[8] + (size_t)(layer >> 1) * 1024 * 1536;
    const bf16_t* Qb = (const bf16_t*)(F.ws + WS_Q); const bf16_t* Kb = (const bf16_t*)(F.ws + WS_K); const bf16_t* Vb = (const bf16_t*)(F.ws + WS_V);
    for (int s = F.gw; s < 320; s += NGW) { const int tok = chk_toks[s & 15], col = chk_cols[s >> 4];
        if (layer == 2 && tok >= T && col < 1024) continue;
        const bool rope = (tok < T) && col < 1280; const int hc = col & 63, first = (hc & 31) < 16; const int pcol = rope ? (first ? col + 16 : col - 16) : col;
        float x = 0.f, xp = 0.f;
        for (int k = F.lane; k < 1024; k += 64) { const float u = bf2f(U[(size_t)tok * D + k]); x += u * W[(size_t)k * 1536 + col]; xp += u * W[(size_t)k * 1536 + pcol]; }
        x = wave_sum(x); xp = wave_sum(xp);
        float ref = x;
        if (rope) { const int tl = tok & 2047, part = hc >> 5, pos = part ? (tl & 63) : (tl >> 6), fi = hc & 15; const float ang = (float)pos * powf(10000.f, -(float)fi / 16.f);
            ref = x * cosf(ang) + (first ? -xp : xp) * sinf(ang); }
        if (col < 1024) ref *= C2;
        const float got = col < 1024 ? bf2f(Qb[(size_t)tok * 1024 + col]) : (col < 1280 ? bf2f(Kb[(size_t)tok * 256 + col - 1024]) : bf2f(Vb[(size_t)tok * 256 + col - 1280]));
        if (F.lane == 0) chk_report(F.ctl, id, got, ref, 0.03f, 0.03f); }
}
__device__ __forceinline__ void chk_attn(Frame& F, const Args& a, int layer, int id) {
    F.refresh(); const bf16_t* Qb = (const bf16_t*)(F.ws + WS_Q); const bf16_t* Kb = (const bf16_t*)(F.ws + WS_K); const bf16_t* Vb = (const bf16_t*)(F.ws + WS_V); const bf16_t* Ob = (const bf16_t*)(F.ws + WS_OCHK);
    LAS float* lg = (LAS float*)F.lds + F.wave * 1024;
    for (int s = F.gw; s < 64; s += NGW) { const int tok = chk_toks[s & 15], h = (s >> 4) * 5, kvh = h >> 2;
        if (layer == 2 && tok >= T) continue;
        const bool isctx = tok >= T; const int b = isctx ? (tok - T) / CTXL : tok / SEQ, p = tok & (SEQ - 1);
        int nk = 0; const int lo = isctx ? 0 : (p - 128 < 0 ? 0 : p - 128), hi = isctx ? -1 : (p + 128 > SEQ - 1 ? SEQ - 1 : p + 128);
        const int nlat = isctx ? 0 : hi - lo + 1; nk = nlat + CTXL;
        float mx = a.in[10][(layer >> 1) * 16 + h] * LOG2E; const float sink2 = mx;
        for (int i = F.lane; i < nk; i += 64) { const size_t kr = i < nlat ? (size_t)b * SEQ + lo + i : (size_t)T + b * CTXL + (i - nlat); float d = 0.f;
            for (int e = 0; e < 64; ++e) d += bf2f(Qb[(size_t)tok * 1024 + h * 64 + e]) * bf2f(Kb[kr * 256 + kvh * 64 + e]);
            lg[i] = d; mx = fmaxf(mx, d); }
#pragma unroll
        for (int o = 1; o < 64; o <<= 1) mx = fmaxf(mx, __shfl_xor(mx, o));
        LDS_WAIT();
        float den = 0.f; for (int i = F.lane; i < nk; i += 64) den += exp2f(lg[i] - mx);
        den = wave_sum(den) + exp2f(sink2 - mx);
        float o = 0.f;
        for (int i = 0; i < nk; ++i) { const size_t kr = i < nlat ? (size_t)b * SEQ + lo + i : (size_t)T + b * CTXL + (i - nlat); o += exp2f(lg[i] - mx) * bf2f(Vb[kr * 256 + kvh * 64 + F.lane]); }
        o /= den;
        chk_report(F.ctl, id, bf2f(Ob[(size_t)tok * 1024 + h * 64 + F.lane]), o, 0.01f, 0.03f); chk_report(F.ctl, 32 + (s & 15), bf2f(Ob[(size_t)tok * 1024 + h * 64 + F.lane]), o, 0.01f, 0.03f);
        LDS_WAIT(); }
    __syncthreads();
}
__device__ __forceinline__ void chk_fnet_f(Frame& F, const Args& a, bool upd, int id) {
    F.refresh(); const bf16_t* U = (const bf16_t*)a.out; LAS float* red = (LAS float*)F.lds;
    for (int s = F.blk; s < 128 + (upd ? 64 : 0); s += GRID) {
        const bool cx = s >= 128; const int q = cx ? s - 128 : s; const int m = chk_ms[q & 3], g = ((q >> 2) & 1) * 3, b = ((q >> 3) & 1) * 31; int k = chk_ks[(q >> 4) & 7]; const int L = cx ? CTXL : SEQ; if (cx) k &= 255;
        const size_t row0 = cx ? (size_t)T + b * CTXL : (size_t)b * SEQ;
        float acc = 0.f;
        for (int l = F.wave; l < L; l += NWAVES) { float ca = 0.f, sa = 0.f;
            for (int n = F.lane; n < 256; n += 64) { const float u = bf2f(U[(row0 + l) * D + g * 256 + n]); const float an = 6.283185307179586f * (float)((m * n) & 255) / 256.f; const float sn = __sinf(an), cs = __cosf(an); ca += u * cs; sa += u * sn; }
            ca = wave_sum(ca); sa = wave_sum(sa); const float an = 6.283185307179586f * (float)((k * l) % L) / (float)L; const float sn = __sinf(an), cs = __cosf(an); acc += cs * ca - sn * sa; }
        if (F.lane == 0) red[F.wave] = acc;
        __syncthreads();
        if (F.tid == 0) { float t = 0.f; for (int w = 0; w < NWAVES; ++w) t += red[w]; t *= cx ? (1.f / 256.f) : 0.001381067932004975f;
            float got;
            if (cx) got = bf2f(((const bf16_t*)(F.ws + WS_FC))[((size_t)b * 256 + k) * D + g * 256 + m]);
            else if (k == 1024) got = bf2f(((const bf16_t*)(F.ws + WS_FH1))[(size_t)b * 1024 + g * 256 + m]);
            else got = bf2f(((const bf16_t*)(F.ws + WS_FH))[((size_t)b * 1024 + k) * D + g * 256 + m]);
            chk_report(F.ctl, id, got, t, 0.02f, 0.03f); }
        __syncthreads(); }
}
__device__ __forceinline__ void chk_fnet_y(Frame& F, const Args& a, int jl, bool upd, int id) {
    F.refresh(); const bf16_t* Y = (const bf16_t*)a.out; const float* W = a.in[11] + (size_t)jl * 1024 * 1024;
    const bf16_t* FH = (const bf16_t*)(F.ws + WS_FH); const bf16_t* FH1 = (const bf16_t*)(F.ws + WS_FH1); const bf16_t* FC = (const bf16_t*)(F.ws + WS_FC);
    for (int s = F.gw; s < 50; s += NGW) { const int tok = chk_ytoks[s % 10], n = chk_ns[s / 10]; if (tok >= T && !upd) continue;
        float acc = 0.f;
        for (int j = F.lane; j < 1024; j += 64) { float f;
            if (tok >= T) f = bf2f(FC[(size_t)(tok - T) * D + j]);
            else { const int b = tok >> 11, k = tok & 2047; if (k < 1024) f = bf2f(FH[((size_t)b * 1024 + k) * D + j]); else if (k == 1024) f = bf2f(FH1[(size_t)b * 1024 + j]);
                else f = bf2f(FH[((size_t)b * 1024 + (2048 - k)) * D + (j & ~255) + ((256 - (j & 255)) & 255)]); }
            acc += f * W[(size_t)j * 1024 + n]; }
        acc = wave_sum(acc);
        if (F.lane == 0) chk_report(F.ctl, id, bf2f(Y[(size_t)tok * D + n]), acc, 0.02f, 0.03f); }
}
__device__ __forceinline__ void chk_route(Frame& F, const Args& a, int layer, int ntok, int id) {
    F.refresh(); const bf16_t* U = (const bf16_t*)a.out; const float* Wr = a.in[12] + (size_t)layer * 1024 * 64; const int* tke = (const int*)(F.ws + WS_TKE); const float* tkw = (const float*)(F.ws + WS_TKW);
    for (int s = F.gw; s < 16; s += NGW) { const int tok = chk_toks[s]; if (tok >= ntok) continue; const int lane = F.lane;
        float lgt = 0.f; for (int k = 0; k < 1024; ++k) lgt += bf2f(U[(size_t)tok * D + k]) * Wr[(size_t)k * 64 + lane];
        const float sc = 1.f / (1.f + expf(-lgt)), sel = sc + a.in[13][layer * 64 + lane];
        float g1 = -INFINITY, g2 = -INFINITY;
#pragma unroll 1
        for (int j = 0; j < 8; ++j) { const float v = __shfl(sel, (lane & ~7) + j); if (v > g1) { g2 = g1; g1 = v; } else if (v > g2) g2 = v; }
        const float gs = g1 + g2; int gr = 0;
#pragma unroll 1
        for (int gp = 0; gp < 8; ++gp) { const float v = __shfl(gs, gp * 8); gr += (v > gs || (v == gs && gp < (lane >> 3))) ? 1 : 0; }
        const float sm = gr < 4 ? sel : -INFINITY; int rk = 0;
#pragma unroll 1
        for (int ep = 0; ep < 64; ++ep) { const float v = __shfl(sm, ep); rk += (v > sm || (v == sm && ep < lane)) ? 1 : 0; }
        const float tot = wave_sum(rk < 8 ? sc : 0.f); const float wref = sc / tot * 2.5f;
        int slot = -1; for (int j = 0; j < 8; ++j) if (tke[(size_t)tok * 8 + j] == lane) slot = j;
        float err = 0.f;
        if (slot >= 0) { if (rk >= 10) err = 10.f; else if (rk < 8) err = fabsf(tkw[(size_t)tok * 8 + slot] - wref) / (0.04f * wref); }
        else if (rk < 6) err = 10.f;
        const unsigned long long nsel = __ballot(slot >= 0); if (__builtin_popcountll(nsel) != 8) err = 20.f;
        atomicMax(F.ctl + CW_ERR + id, __float_as_uint(err)); }
}
__device__ __forceinline__ void chk_moe(Frame& F, const Args& a, int layer, int ntok, int ch, int id) {
    F.refresh(); const bf16_t* U = (const bf16_t*)a.out; const int* tke = (const int*)(F.ws + WS_TKE); const float* tkw = (const float*)(F.ws + WS_TKW);
    const int CH = ntok / NCHUNK; LAS float* hs = (LAS float*)F.lds; LAS float* us = hs + 512; LAS float* pg_ = us + 1024;
    for (int s = F.blk; s < 16; s += GRID) { const int tok = chk_toks[s]; if (tok >= ntok || tok / CH != ch) continue;
        for (int k = F.tid; k < 1024; k += NTHR) us[k] = bf2f(U[(size_t)tok * D + k]);
        __syncthreads();
        float y0 = 0.f, y1 = 0.f;
        for (int j = 0; j < 9; ++j) { const int e = j < 8 ? tke[(size_t)tok * 8 + j] : 0; const float w = j < 8 ? tkw[(size_t)tok * 8 + j] : 1.f;
            const float* wg = j < 8 ? a.in[14] + ((size_t)layer * NE + e) * 262144 : a.in[17] + (size_t)layer * 262144;
            const float* wu = j < 8 ? a.in[15] + ((size_t)layer * NE + e) * 262144 : a.in[18] + (size_t)layer * 262144;
            const float* wd = j < 8 ? a.in[16] + ((size_t)layer * NE + e) * 262144 : a.in[19] + (size_t)layer * 262144;
            const int hh = F.tid & 255, half = F.tid >> 8; float g = 0.f, u = 0.f;
            for (int k = half * 512; k < half * 512 + 512; ++k) { g += us[k] * wg[(size_t)k * 256 + hh]; u += us[k] * wu[(size_t)k * 256 + hh]; }
            pg_[F.tid] = g; pg_[512 + F.tid] = u;
            __syncthreads();
            if (F.tid < 256) { const float gg = pg_[F.tid] + pg_[F.tid + 256], uu = pg_[512 + F.tid] + pg_[512 + F.tid + 256]; hs[F.tid] = gg / (1.f + expf(-gg)) * uu; }
            __syncthreads();
            float t0 = 0.f, t1 = 0.f; for (int q = 0; q < 256; ++q) { t0 += hs[q] * wd[(size_t)q * 1024 + F.tid]; t1 += hs[q] * wd[(size_t)q * 1024 + 512 + F.tid]; }
            y0 += w * t0; y1 += w * t1;
            __syncthreads(); }
        float g0 = 0.f, g1 = 0.f; const int i = tok - ch * CH;
        { const unsigned char* YSb = (const unsigned char*)(F.ws + WS_YS); const unsigned char* YBb = (const unsigned char*)(F.ws + WS_YB); const int* spos = (const int*)(F.ws + WS_SDST);
          const int bo = 16 * (F.tid >> 3) + (F.tid & 7);
          auto f8 = [](unsigned char b) { return __builtin_amdgcn_cvt_pk_f32_fp8((int)b, false)[0] * (1.f / 16.f); };
          g0 = f8(YSb[(size_t)i * D + bo]); g1 = f8(YSb[(size_t)i * D + bo + 8]);
          for (int j = 0; j < 8; ++j) { const size_t ps = (size_t)spos[(size_t)tok * 8 + j]; const float w = tkw[(size_t)tok * 8 + j]; g0 += w * f8(YBb[ps * D + bo]); g1 += w * f8(YBb[ps * D + bo + 8]); } }
        chk_report(F.ctl, id, g0, y0, 0.04f, 0.06f); chk_report(F.ctl, id, g1, y1, 0.04f, 0.06f);
        __syncthreads(); }
}
#endif

#ifndef PH_MASK
#define PH_MASK 0xffffffffu
#endif
#define PH(b) ((PH_MASK >> (b)) & 1u)
__global__ void __launch_bounds__(NTHR, 2) fwd(Args a) {
    extern __shared__ __attribute__((aligned(16))) unsigned char lds_raw[];
    Frame F;
    F.lds = (LAS unsigned char*)lds_raw; F.ws = a.ws; F.ctl = (unsigned*)(a.ws + WS_CTL);
    F.blk = blockIdx.x; F.refresh();
    for (int u = F.tid; u < (LDS_BYTES - RING_BYTES) / 4; u += NTHR) ((LAS unsigned*)(F.lds + RING_BYTES))[u] = 0u;
    __syncthreads();
    const XcdBarrier bar = xcd_barrier_post(F.ctl + CW_BAR, (volatile LAS unsigned*)(F.lds + L_MISC) + 8);
#define GRID_BAR() xcd_barrier(bar)
    LAS unsigned char* ring = F.lds;
    const int c = F.blk;
#define ws (F.ws)
#define NEWPH() F.refresh()

    if (PH(0)) { conv_small(F, a);
    __syncthreads();
    mod_partials(F, a); }
    GRID_BAR();
    if (PH(1)) { rows_init(F, a);
    mod_finalize(F, a); }
    GRID_BAR();

    for (int layer = 0; layer < 4; ++layer) {
        const int jl = layer >> 1; const bool upd = layer < 2; const int nrows = upd ? TT : T;
        if ((layer & 1) == 0) {
            NEWPH();
            if (PH(2)) { SchedQKV S; S.U = (const char*)a.out; S.W = (const char*)(ws + WS_WQKV) + (size_t)jl * 1536 * 2048; S.nfull = (layer == 0) ? 288 * 6 : 256 * 6; S.nu = (layer == 0) ? 288 * 6 : 256 * 6 + 64; S.c = c;
              pg::EpiQKV E; E.Q = (bf16_t*)(ws + WS_Q); E.K = (bf16_t*)(ws + WS_K); E.V = (bf16_t*)(ws + WS_V); E.ropec = (const float*)(ws + WS_ROPEC); E.ropes = (const float*)(ws + WS_ROPES);
              pg::gemm_phase<pg::EpiQKV, SchedQKV, false>(ring, 2048u, 2048u, nullptr, S, E); }
            GRID_BAR();
#ifdef SELFCHECK
            if (SELFCHECK & 1) chk_qkv(F, a, layer, 1 + (layer >> 1));
#define OBUF ((bf16_t*)(ws + WS_OCHK))
#else
#define OBUF ((bf16_t*)(ws + WS_Q))
#endif
            NEWPH();
            if (PH(3)) { const int NU = 4096 + (layer == 0 ? 512 : 0);
              const bf16_t* Qb = (const bf16_t*)(ws + WS_Q); const bf16_t* Kb = (const bf16_t*)(ws + WS_K); const bf16_t* Vb = (const bf16_t*)(ws + WS_V);
              for (int i = 0; i * GRID + c < NU; ++i) { int id = pg::xcd_remap(i * GRID + c, NU);
                  if (NU > 4096) { const int g9 = id / 9, r9 = id - g9 * 9; id = (r9 < 8) ? g9 * 8 + r9 : 4096 + g9; }
                  if (id < 4096) { const int hq = id & 3, qb = (id >> 2) & 7, kvh = (id >> 5) & 3, b = id >> 7, h = kvh * 4 + hq;
                      attn::attn_unit(Qb, Kb, Vb, OBUF, b, h, qb * 256, false, a.in[10][jl * 16 + h] * LOG2E, ring); }
                  else { const int cid = id - 4096, hq = cid & 3, kvh = (cid >> 2) & 3, b = cid >> 4, h = kvh * 4 + hq;
                      attn::attn_unit(Qb, Kb, Vb, OBUF, b, h, 0, true, a.in[10][jl * 16 + h] * LOG2E, ring); } } }
            GRID_BAR();
#ifdef SELFCHECK
            if (SELFCHECK & 1) chk_attn(F, a, layer, 3 + (layer >> 1));
#endif
            NEWPH();
            if (PH(4)) { SchedDense S; S.A = (const char*)OBUF; S.W = (const char*)(ws + WS_WO) + (size_t)jl * 1024 * 2048; S.out = (char*)a.out; S.nrt = nrows / 256; S.nct = 4; S.nt = 16; S.c = c; S.ldA = 2048;
              pg::EpiStore E; pg::gemm_phase<pg::EpiStore, SchedDense, false>(ring, 2048u, 2048u, nullptr, S, E); }
            GRID_BAR();
        } else {
            NEWPH();
            if (PH(5)) { SchedF1 S; S.CS = (const char*)(ws + WS_CSN); S.U = (const char*)a.out; S.ABT = (char*)(ws + WS_ABT); S.ABTC = (char*)(ws + WS_ABTC); S.nu = 2048 + (upd ? 256 : 0); S.c = c;
              pg::EpiStore E; pg::gemm_phase<pg::EpiStore, SchedF1, false>(ring, 512u, 2048u, nullptr, S, E); }
            GRID_BAR();
            NEWPH();
            if (PH(6)) { SchedF2 S; S.DL = (const char*)(ws + WS_DL); S.ABT = (const char*)(ws + WS_ABT); S.FH = (char*)(ws + WS_FH); S.c = c;
              pg::EpiStore E; pg::gemm_phase<pg::EpiStore, SchedF2, false>(ring, 8192u, 8192u, nullptr, S, E); }
            NEWPH();
            if (PH(7) && upd) { SchedF2c S; S.DLC = (const char*)(ws + WS_DLC); S.ABTC = (const char*)(ws + WS_ABTC); S.FC = (char*)(ws + WS_FC); S.c = c;
              pg::EpiStore E; pg::gemm_phase<pg::EpiStore, SchedF2c, false>(ring, 1024u, 1024u, nullptr, S, E); }
            if (PH(8)) fnet_nyquist_rows(F);
            GRID_BAR();
#ifdef SELFCHECK
            if (SELFCHECK & 2) chk_fnet_f(F, a, upd, 5 + (layer >> 1));
            GRID_BAR();
#endif
            NEWPH();
            if (PH(9)) { SchedF3 S; S.FH = (const char*)(ws + WS_FH); S.FC = (const char*)(ws + WS_FC); S.W = (const char*)(ws + WS_WF) + (size_t)jl * 2048 * 2048; S.Y = (char*)a.out; S.nu = 1024 + (upd ? 128 : 0); S.c = c;
              pg::EpiStore E; pg::gemm_phase<pg::EpiStore, SchedF3, false>(ring, 2048u, 2048u, nullptr, S, E); }
            if (PH(10)) fnet_nyquist_out(F, a, jl);
            GRID_BAR();
#ifdef SELFCHECK
            if (SELFCHECK & 8) chk_fnet_y(F, a, jl, upd, 7 + (layer >> 1));
            GRID_BAR();
#endif
        }
        if (PH(12)) conv_experts(F, a.in[14], a.in[15], a.in[16], layer);
        __syncthreads();
        if (PH(11)) rows_post1(F, a, layer, nrows);
        VM_WAIT(); __syncthreads();
        if (threadIdx.x == 0) { __builtin_amdgcn_fence(__ATOMIC_ACQUIRE, "agent"); VM_WAIT(); }
        __syncthreads();
        if (PH(13)) route_tokens(F, a, layer, nrows);
        GRID_BAR();
#ifdef SELFCHECK
        if ((SELFCHECK & 4) && layer < 2) chk_route(F, a, layer, nrows, 9);
#endif
        if (PH(14)) build_lists(F, nrows);
        GRID_BAR();
        LAS const int* tstart = (LAS const int*)(F.lds + L_TSTART); LAS const unsigned char* tseg = (LAS const unsigned char*)(F.lds + L_TSEG);
        const int ntl = __builtin_amdgcn_readfirstlane(tstart[NCHUNK * 64]);
        NEWPH();
        if (PH(15)) { SchedG1 S; S.EGU = (const char*)(ws + WS_EGU); S.WSG = (const char*)(ws + WS_WSH) + (size_t)layer * 1536 * 1024; S.STOK = (const int*)(ws + WS_STOK); S.H = (char*)(ws + WS_H); S.HS = (char*)(ws + WS_HS); S.tseg = tseg; S.ntl = ntl; S.nsh = nrows / 256; S.c = c;
          pg::EpiSilu E; pg::gemm_phase<pg::EpiSilu, SchedG1, true>(ring, 2048u, 2048u, (const char*)a.out, S, E); }
        GRID_BAR();
        const int CH = nrows / NCHUNK;
        for (int ch = 0; ch < NCHUNK; ++ch) {
            NEWPH();
            if (PH(16)) { SchedG2 S; S.ED = (const char*)(ws + WS_ED); S.WSD = (const char*)(ws + WS_WSH) + (size_t)layer * 1536 * 1024 + 512 * 2048; S.H = (const char*)(ws + WS_H); S.HS = (const char*)(ws + WS_HS); S.YB = (char*)(ws + WS_YB); S.YS = (char*)(ws + WS_YS); S.tseg = tseg;
              S.t0 = __builtin_amdgcn_readfirstlane(tstart[ch * 64]); S.t1 = __builtin_amdgcn_readfirstlane(tstart[ch * 64 + 64]); S.nsh = CH / 256; S.ch = ch; S.CH = CH; S.c = c;
              pg::EpiFp8 E; pg::gemm_phase<pg::EpiFp8, SchedG2, false>(ring, 512u, 512u, nullptr, S, E); }
            GRID_BAR();
#ifdef SELFCHECK
            if ((SELFCHECK & 4) && (layer == 0 || layer == 3)) { if (layer == 0 || ch == 0) chk_moe(F, a, layer, nrows, ch, 10 + (layer == 3)); GRID_BAR(); }
#endif
            if (PH(17)) rows_post2(F, a, layer, ch * CH, CH);
            if (!(layer == 3 && ch == NCHUNK - 1)) GRID_BAR();
        }
    }
#ifdef SELFCHECK
    GRID_BAR();
    { int bad = 0; float be = 0.f; for (int k = 15; k >= 1; --k) { const float e = __uint_as_float(__hip_atomic_load(F.ctl + CW_ERR + k, RLX_AGENT)); if (e > 1.f) { bad = k; be = e; } }
      int wt = 0; float we = 0.f; for (int k = 0; k < 16; ++k) { const float e = __uint_as_float(__hip_atomic_load(F.ctl + CW_ERR + 32 + k, RLX_AGENT)); if (e > we) { we = e; wt = k; } }
      if (bad) { F.refresh(); float cv = 3.f + bad + (be > 8.f ? 0.5f : 0.f);  Row r; for (int j = 0; j < 4; ++j) r.v[j] = (f32x4){cv, cv, cv, cv}; for (int row = F.gw; row < T; row += NGW) row_store_f32(r, a.out + (size_t)row * D, F.lane); } }
#endif
}

#undef ws
#undef NEWPH
extern "C" void kernel_launch(void* const* d_in, const int* in_sizes, int n_in, void* d_out, int out_size, void* d_ws, size_t ws_size, hipStream_t stream) {
    static int ready = 0;
    if (ready == 0) {
        if (n_in != 20 || out_size != T * D || ws_size < WS_END) { fprintf(stderr, "kernel_launch: unexpected problem (n_in %d out %d ws %zu need %zu)\n", n_in, out_size, ws_size, (size_t)WS_END); ready = -1; return; }
        if (hipFuncSetAttribute((const void*)fwd, hipFuncAttributeMaxDynamicSharedMemorySize, LDS_BYTES) != hipSuccess) { fprintf(stderr, "kernel_launch: hipFuncSetAttribute failed\n"); ready = -1; return; }
        int per_cu = 0;
        if (hipOccupancyMaxActiveBlocksPerMultiprocessor(&per_cu, (const void*)fwd, NTHR, LDS_BYTES) != hipSuccess || per_cu < 1) fprintf(stderr, "kernel_launch: occupancy query says %d blocks per CU\n", per_cu);
        (void)hipGetLastError();
        ready = 1;
    }
    if (ready < 0) return;
    (void)hipMemsetAsync((char*)d_ws + WS_CTL, 0, CTL_BYTES, stream);
    Args a{};
    for (int i = 0; i < 20; ++i) a.in[i] = (const float*)d_in[i];
    a.out = (float*)d_out; a.ws = (unsigned char*)d_ws;
    hipLaunchKernelGGL(fwd, dim3(GRID), dim3(NTHR), LDS_BYTES, stream, a);
}
```

```cpp
#include <hip/hip_runtime.h>
#include <cstdio>
#include <cstdint>

#define LAS __attribute__((address_space(3)))
#define GAS __attribute__((address_space(1)))
typedef unsigned short bf16_t;
typedef short bf16x8 __attribute__((ext_vector_type(8)));
typedef short s16x4 __attribute__((ext_vector_type(4)));
typedef float f32x4 __attribute__((ext_vector_type(4)));
typedef float f32x16 __attribute__((ext_vector_type(16)));
typedef unsigned u32x4 __attribute__((ext_vector_type(4)));
typedef unsigned u32x2 __attribute__((ext_vector_type(2)));

constexpr int D = 1024, NB = 32, SEQ = 2048, T = NB * SEQ, CTXL = 256, TC = NB * CTXL, TT = T + TC;
constexpr int NQKV = 1536, NE = 64;
constexpr float ALPHA = 1.681792830507429f;
constexpr float LN_EPS = 1e-5f, MOD_EPS = 1e-6f;
constexpr float C2 = 0.125f * 1.4426950408889634f;
constexpr float LOG2E = 1.4426950408889634f;
constexpr int NCHUNK = 2;
constexpr int NWAVES = 8, NTHR = 512, GRID = 256;

constexpr size_t MiB = 1u << 20;
constexpr size_t WS_CTL = 0, CTL_BYTES = 1 * MiB;
constexpr size_t WS_ROPEC = 1 * MiB, WS_ROPES = 1 * MiB + 4096, WS_CSN = 1 * MiB + 65536, WS_DLC = 1 * MiB + 524288, WS_DL = 2 * MiB;
constexpr size_t WS_WQKV = 10 * MiB, WS_WO = 16 * MiB, WS_WF = 20 * MiB, WS_WR = 28 * MiB, WS_WSH = 29 * MiB;
constexpr size_t WS_MODP = 36 * MiB, WS_MOD = 49 * MiB;
constexpr size_t WS_EGU = 54 * MiB, WS_ED = 118 * MiB;
constexpr size_t WS_XS = 150 * MiB;
constexpr size_t WS_STOK = 294 * MiB, WS_SDST = 297 * MiB, WS_SW = 300 * MiB, WS_TKE = 303 * MiB, WS_TKW = 306 * MiB;
constexpr size_t WS_R = 309 * MiB;
constexpr size_t WS_Q = WS_R, WS_K = WS_R + 144 * MiB, WS_V = WS_R + 180 * MiB;
constexpr size_t WS_ABT = WS_R, WS_FH = WS_R + 256 * MiB, WS_FH1 = WS_R + 320 * MiB, WS_ABTC = WS_R + 321 * MiB, WS_FC = WS_R + 353 * MiB;
constexpr size_t WS_H = WS_R, WS_HS = WS_R + 320 * MiB, WS_YB = WS_R + 356 * MiB, WS_YS = WS_R + 676 * MiB;
constexpr size_t WS_END = WS_YS + 36 * MiB;
constexpr int MAXROWS = 655360;

constexpr int CW_TMO = 0, CW_BAR = 4096, CW_BCNT = 16384;

constexpr int RING_BYTES = 131072;
constexpr int L_MISC = RING_BYTES;
constexpr int L_TSTART = RING_BYTES + 256;
constexpr int L_PREF = L_TSTART + 1040;
constexpr int L_LCNT = L_PREF + 256;
constexpr int L_TSEG = L_LCNT + 256;
constexpr int L_SCAN = L_TSEG + 2560;
constexpr int LDS_BYTES = 139264;
static_assert(L_SCAN + 1024 <= LDS_BYTES, "LDS map");

#define RLX_AGENT __ATOMIC_RELAXED, __HIP_MEMORY_SCOPE_AGENT
#define LDS_WAIT() asm volatile("s_waitcnt lgkmcnt(0)" ::: "memory")
#define VM_WAIT() asm volatile("s_waitcnt vmcnt(0)" ::: "memory")

__device__ __forceinline__ unsigned f2bf(float f) { unsigned u = __builtin_bit_cast(unsigned, f); return (u + 0x7fffu + ((u >> 16) & 1u)) >> 16; }
__device__ __forceinline__ unsigned pk2(float lo, float hi) { return f2bf(lo) | (f2bf(hi) << 16); }
typedef float f32x2_t __attribute__((ext_vector_type(2))); typedef __bf16 bf16x2_t __attribute__((ext_vector_type(2)));
__device__ __forceinline__ unsigned cvt_pk_bf16(float lo, float hi) { f32x2_t v = {lo, hi}; bf16x2_t b = __builtin_convertvector(v, bf16x2_t); return __builtin_bit_cast(unsigned, b); }
__device__ __forceinline__ float bflo(unsigned w) { return __builtin_bit_cast(float, w << 16); }
__device__ __forceinline__ float bfhi(unsigned w) { return __builtin_bit_cast(float, w & 0xffff0000u); }
__device__ __forceinline__ float wave_sum(float v) {
#pragma unroll
    for (int o = 1; o < 64; o <<= 1) v += __shfl_xor(v, o);
    return v;
}

__device__ __forceinline__ int opaque_tid() { int t = threadIdx.x; asm volatile("" : "+v"(t)); return t; }

#define XB_TMO      128
#define XB_XCNT(j)  (256  + 64 * (j))
#define XB_XSUB(j)  (1280 + 64 * (j))
#define XB_XGEN(j)  (2304 + 64 * (j))
#define XB_TOP      3328
#define XB_TOPGEN   3392
#define XCD_BAR_WORDS 3456
#define XB_SPIN_CAP (1u << 22)
__device__ __forceinline__ unsigned xb_ld(unsigned* p)              { return __hip_atomic_load(p, __ATOMIC_RELAXED, __HIP_MEMORY_SCOPE_AGENT); }
__device__ __forceinline__ unsigned xb_add(unsigned* p, unsigned v) { return __hip_atomic_fetch_add(p, v, __ATOMIC_RELAXED, __HIP_MEMORY_SCOPE_AGENT); }
__device__ __forceinline__ unsigned xb_xcc_id() { return (unsigned)__builtin_amdgcn_s_getreg((3 << 11) | 20) & 0xFu; }
#define XB_SPIN(cond, bar) do { unsigned _sp = 0; while (cond) { __builtin_amdgcn_s_sleep(1); \
    if ((++_sp & 255u) == 0u) { if (xb_ld(&(bar)[XB_TMO])) break; if (_sp > XB_SPIN_CAP) { atomicAdd(&(bar)[XB_TMO], 1u); break; } } } } while (0)
struct XcdBarrier { unsigned* bar; unsigned x; volatile LAS unsigned* st; };
__device__ __forceinline__ XcdBarrier xcd_barrier_post(unsigned* bar, volatile LAS unsigned* st) {
    XcdBarrier b; b.bar = bar; b.x = xb_xcc_id(); b.st = st;
    if (threadIdx.x == 0) (void)xb_add(&bar[XB_XCNT(b.x)], 1u);
    return b;
}
__device__ __forceinline__ void xcd_barrier_complete(unsigned* bar, unsigned x, unsigned& nloc, unsigned& nx) {
    const unsigned G = gridDim.x * gridDim.y * gridDim.z;
    unsigned sum, cnt, mine, sp = 0u;
    for (;;) {
        sum = 0u; cnt = 0u; mine = 0u;
#pragma unroll
        for (unsigned j = 0; j < 16; ++j) { const unsigned c = xb_ld(&bar[XB_XCNT(j)]); sum += c; cnt += (c > 0u) ? 1u : 0u; mine = (j == x) ? c : mine; }
        if (sum == G) break;
        __builtin_amdgcn_s_sleep(1);
        if ((++sp & 255u) == 0u) { if (xb_ld(&bar[XB_TMO])) break; if (sp > XB_SPIN_CAP) { atomicAdd(&bar[XB_TMO], 1u); break; } }
    }
    nloc = mine > 0u ? mine : 1u; nx = cnt > 0u ? cnt : 1u;
}
__device__ __forceinline__ void xcd_barrier(const XcdBarrier& b) {
    asm volatile("s_waitcnt vmcnt(0)" ::: "memory");
    __syncthreads();
    if (threadIdx.x == 0) {
        unsigned* bar = b.bar; unsigned bx = b.x; asm volatile("" : "+s"(bx));
        __builtin_amdgcn_s_waitcnt(0);
        unsigned nloc = b.st[0], nx = b.st[1];
        if (nloc == 0u) { xcd_barrier_complete(bar, bx, nloc, nx); b.st[0] = nloc; b.st[1] = nx; }
        const unsigned old = xb_add(&bar[XB_XSUB(bx)], 1u);
        const unsigned gen = old / nloc;
        if (old + 1u == (gen + 1u) * nloc) {
            __builtin_amdgcn_fence(__ATOMIC_RELEASE, "agent");
            asm volatile("s_waitcnt vmcnt(0)" ::: "memory");
            const unsigned og = xb_add(&bar[XB_TOP], 1u);
            const unsigned tg = og / nx;
            if (og + 1u == (tg + 1u) * nx) xb_add(&bar[XB_TOPGEN], 1u);
            else XB_SPIN(xb_ld(&bar[XB_TOPGEN]) == tg, bar);
            __builtin_amdgcn_fence(__ATOMIC_ACQUIRE, "agent");
            xb_add(&bar[XB_XGEN(bx)], 1u);
            asm volatile("s_waitcnt vmcnt(0)" ::: "memory");
        } else {
            XB_SPIN(xb_ld(&bar[XB_XGEN(bx)]) == gen, bar);
            __builtin_amdgcn_fence(__ATOMIC_ACQUIRE, "agent");
            asm volatile("s_waitcnt vmcnt(0)" ::: "memory");
        }
    }
    __syncthreads();
}

namespace pg {
constexpr int BM = 256, BK = 64, HALF = 128, HTB = HALF * BK * 2;
__host__ __device__ __forceinline__ int lds_byte(int r, int c) { const int st = (r >> 4) * 2 + (c >> 5), rr = r & 15, cc = c & 31, ob = rr * 64 + cc * 2; return st * 1024 + (ob ^ (((ob >> 9) & 1) << 5)); }
__host__ __device__ __forceinline__ void stage_rc(int b, int& R, int& C) { const int st = b / 1024, sb = b % 1024, swz = sb ^ (((sb >> 9) & 1) << 5); R = (st >> 1) * 16 + swz / 64; C = (st & 1) * 32 + (swz % 64) / 2; }
__host__ __device__ __forceinline__ int perm32(int rho) { const int n = rho >> 4, i = rho & 15; return 8 * (i >> 2) + 4 * n + (i & 3); }

struct Unit {
    const char* A;
    const char* B;
    const int* gidx;
    int gbase;
    int nt;
    char* out; int ldc; float scale; int flags; int i0; int i1;
    const int* l0; const float* l1;
};

template <class Epi, class Sched, bool GATHER>
__device__ __forceinline__ void gemm_phase(LAS unsigned char* lds, const unsigned lda, const unsigned ldb, const char* gtable, const Sched& S, const Epi& E) {
    const int tid = opaque_tid(), wid = __builtin_amdgcn_readfirstlane(tid >> 6), lane = tid & 63, wr = wid >> 2, wc = wid & 3, fr = lane & 15, fq = lane >> 4;
    unsigned voffA[2], voffB[2];
#pragma unroll
    for (int i = 0; i < 2; ++i) { int R, C; stage_rc(tid * 16 + i * 8192, R, C); const int Rb = (R & ~31) + perm32(R & 31);
        voffA[i] = (unsigned)R * lda + (unsigned)C * 2u; voffB[i] = (unsigned)Rb * ldb + (unsigned)C * 2u; }
    const size_t kstep = (size_t)(BK * 2);
    const size_t hstepA = (size_t)HALF * lda, hstepB = (size_t)HALF * ldb;
    const unsigned ldsw = (unsigned)wid * 1024u;
    const int aoff = lds_byte(wr * 64 + fr, fq * 8), boff = lds_byte(wc * 32 + fr, fq * 8);
#define PG_SA(b, h) (((b) * 2 + (h)) * HTB)
#define PG_SB(b, h) ((4 + (b) * 2 + (h)) * HTB)
#define PG_ST2(bufoff, p0, p1) do { \
        __builtin_amdgcn_global_load_lds((const unsigned*)(p0), (LAS unsigned*)(lds + (bufoff) + ldsw), 16, 0, 0); \
        __builtin_amdgcn_global_load_lds((const unsigned*)(p1), (LAS unsigned*)(lds + (bufoff) + ldsw + 8192), 16, 0, 0); } while (0)
#define PG_STB(bufoff, bp) PG_ST2(bufoff, (bp) + voffB[0], (bp) + voffB[1])
#define PG_STA(bufoff, ap, h, nx) do { if constexpr (GATHER) { PG_ST2(bufoff, (ap) + ((nx) ? nO[h][0] : cO[h][0]), (ap) + ((nx) ? nO[h][1] : cO[h][1])); } \
        else { PG_ST2(bufoff, (ap) + (h) * hstepA + voffA[0], (ap) + (h) * hstepA + voffA[1]); } } while (0)
#define PG_LDA(dst, b, h) do { _Pragma("unroll") for (int m = 0; m < 4; ++m) _Pragma("unroll") for (int k = 0; k < 2; ++k) dst[m][k] = *(const LAS bf16x8*)(lds + PG_SA(b, h) + aoff + m * 2048 + k * 1024); } while (0)
#define PG_LDB(dst, b, h) do { _Pragma("unroll") for (int n = 0; n < 2; ++n) _Pragma("unroll") for (int k = 0; k < 2; ++k) dst[n][k] = *(const LAS bf16x8*)(lds + PG_SB(b, h) + boff + n * 2048 + k * 1024); } while (0)
#define PG_MMA(ai, bj, At, Bt) do { __builtin_amdgcn_s_setprio(1); _Pragma("unroll") for (int m = 0; m < 4; ++m) _Pragma("unroll") for (int n = 0; n < 2; ++n) _Pragma("unroll") for (int k = 0; k < 2; ++k) \
        acc[ai][bj][m][n] = __builtin_amdgcn_mfma_f32_16x16x32_bf16(Bt[n][k], At[m][k], acc[ai][bj][m][n], 0, 0, 0); __builtin_amdgcn_s_setprio(0); } while (0)
#define PG_WAIT_V(n) asm volatile("s_waitcnt vmcnt(" #n ")" ::: "memory")
#define PG_WAIT_L(n) asm volatile("s_waitcnt lgkmcnt(" #n ")" ::: "memory")
#define PG_BAR __builtin_amdgcn_s_barrier()
#define PG_SCHED __builtin_amdgcn_sched_barrier(0)
#define PG_GOFF(dst, u) do { const int tz_ = opaque_tid(); _Pragma("unroll") for (int i = 0; i < 2; ++i) { int R_, C_; stage_rc(tz_ * 16 + i * 8192, R_, C_); \
        _Pragma("unroll") for (int h = 0; h < 2; ++h) { const int rr = h * HALF + R_; \
        const int ix = (u).gidx ? ((const GAS int*)(u).gidx)[rr] : (u).gbase + rr; dst[h][i] = (unsigned)ix * lda + (unsigned)C_ * 2u; } } } while (0)
#define PG_GIDX(dst, un) do { const int* gi_ = nullptr; int gb_ = 0; const bool ok_ = S.gsrc((un), gi_, gb_); const int tz_ = opaque_tid(); _Pragma("unroll") for (int i = 0; i < 2; ++i) { int R_, C_; stage_rc(tz_ * 16 + i * 8192, R_, C_); \
        _Pragma("unroll") for (int h = 0; h < 2; ++h) { const int rr = h * HALF + R_; dst[h][i] = (ok_ && gi_) ? ((const GAS int*)gi_)[rr] : gb_ + rr; } } } while (0)
#define PG_GCVT(dst, src) do { const int tz_ = opaque_tid(); _Pragma("unroll") for (int i = 0; i < 2; ++i) { int R_, C_; stage_rc(tz_ * 16 + i * 8192, R_, C_); \
        _Pragma("unroll") for (int h = 0; h < 2; ++h) dst[h][i] = (unsigned)src[h][i] * lda + (unsigned)C_ * 2u; } } while (0)
    Unit cur, nxt; int ui = 0;
    if (!S.next(0, cur)) return;
    f32x4 acc[2][2][4][2];
#pragma unroll
    for (int a = 0; a < 2; ++a)
#pragma unroll
        for (int b = 0; b < 2; ++b)
#pragma unroll
            for (int m = 0; m < 4; ++m)
#pragma unroll
                for (int n = 0; n < 2; ++n) acc[a][b][m][n] = (f32x4){0.f, 0.f, 0.f, 0.f};
    bf16x8 At[4][2], B0[2][2], B1[2][2];
    unsigned cO[2][2] = {{0u, 0u}, {0u, 0u}}, nO[2][2] = {{0u, 0u}, {0u, 0u}};
    int gI[2][2] = {{0, 0}, {0, 0}};
    if constexpr (GATHER) { PG_GOFF(cO, cur); PG_GIDX(gI, 1); }
    const char* cA = GATHER ? gtable : cur.A; const char* cB = cur.B;
    PG_STB(PG_SB(0, 0), cB); PG_STB(PG_SB(0, 1), cB + hstepB); PG_STA(PG_SA(0, 0), cA, 0, false); PG_STA(PG_SA(0, 1), cA, 1, false);
    if (wr == 1) PG_BAR;
    PG_WAIT_V(2); PG_BAR;
    PG_STB(PG_SB(1, 0), cB + kstep); PG_STA(PG_SA(1, 0), cA + kstep, 0, false); PG_STB(PG_SB(1, 1), cB + hstepB + kstep);
    PG_WAIT_V(6); PG_BAR;
    for (;;) {
        const bool has_next = S.next(ui + 1, nxt);
        const int nt = cur.nt;
        if constexpr (GATHER) { if (has_next) { PG_GCVT(nO, gI); PG_GIDX(gI, ui + 2); } else {
#pragma unroll
            for (int h = 0; h < 2; ++h)
#pragma unroll
                for (int i = 0; i < 2; ++i) nO[h][i] = cO[h][i]; } }
        const char* nA = GATHER ? gtable : (has_next ? nxt.A : cA); const char* nB = has_next ? nxt.B : cB;
#pragma unroll 1
        for (int t = 0; t < nt; t += 2) {
            const bool last = (t == nt - 2);
            const char* a1 = cA + (size_t)(t + 1) * kstep;
            const char* a2 = last ? nA : cA + (size_t)(t + 2) * kstep; const char* b2 = last ? nB : cB + (size_t)(t + 2) * kstep;
            const char* a3 = a2 + kstep; const char* b3 = b2 + kstep;
            PG_LDB(B0, 0, 0); PG_LDB(B1, 0, 1); PG_SCHED; PG_LDA(At, 0, 0); PG_STA(PG_SA(1, 1), a1, 1, false);
            PG_WAIT_V(8); PG_WAIT_L(0); PG_BAR; PG_MMA(0, 0, At, B0); PG_MMA(0, 1, At, B1); PG_BAR; PG_SCHED;
            PG_LDA(At, 0, 1); PG_STB(PG_SB(0, 0), b2); PG_STB(PG_SB(0, 1), b2 + hstepB); PG_STA(PG_SA(0, 0), a2, 0, last);
            PG_WAIT_V(8); PG_WAIT_L(0); PG_BAR; PG_MMA(1, 0, At, B0); PG_MMA(1, 1, At, B1); PG_BAR; PG_SCHED;
            PG_LDB(B0, 1, 0); PG_LDB(B1, 1, 1); PG_SCHED; PG_LDA(At, 1, 0); PG_STA(PG_SA(0, 1), a2, 1, last);
            PG_WAIT_V(8); PG_WAIT_L(0); PG_BAR; PG_MMA(0, 0, At, B0); PG_MMA(0, 1, At, B1); PG_BAR; PG_SCHED;
            PG_LDA(At, 1, 1); PG_STB(PG_SB(1, 0), b3); PG_STB(PG_SB(1, 1), b3 + hstepB); PG_STA(PG_SA(1, 0), a3, 0, last);
            PG_WAIT_V(8); PG_WAIT_L(0); PG_BAR; PG_MMA(1, 0, At, B0); PG_MMA(1, 1, At, B1); PG_BAR; PG_SCHED;
        }
        if (wr == 0) PG_BAR;
        E(acc, cur, wr, wc, fr, fq);
        if (!has_next) break;
#pragma unroll
        for (int a = 0; a < 2; ++a)
#pragma unroll
            for (int b = 0; b < 2; ++b)
#pragma unroll
                for (int m = 0; m < 4; ++m)
#pragma unroll
                    for (int n = 0; n < 2; ++n) acc[a][b][m][n] = (f32x4){0.f, 0.f, 0.f, 0.f};
        cur = nxt; cA = nA; cB = nB; ++ui;
        if constexpr (GATHER) {
#pragma unroll
            for (int h = 0; h < 2; ++h)
#pragma unroll
                for (int i = 0; i < 2; ++i) cO[h][i] = nO[h][i]; }
        if (wr == 1) PG_BAR;
    }
    PG_WAIT_V(0);
    PG_BAR;
#undef PG_SA
#undef PG_SB
#undef PG_ST2
#undef PG_STB
#undef PG_STA
#undef PG_LDA
#undef PG_LDB
#undef PG_MMA
#undef PG_WAIT_V
#undef PG_WAIT_L
#undef PG_BAR
#undef PG_SCHED
#undef PG_GOFF
#undef PG_GIDX
#undef PG_GCVT
}

struct EpiStore {
    __device__ __forceinline__ void operator()(const f32x4 (&acc)[2][2][4][2], const Unit& u, int wr, int wc, int fr, int fq) const {
        const float s = u.scale;
#pragma unroll
        for (int ai = 0; ai < 2; ++ai)
#pragma unroll
            for (int m = 0; m < 4; ++m) { const int row = ai * HALF + wr * 64 + m * 16 + fr;
                char* rowp = u.out + (ptrdiff_t)row * u.ldc + (wc * 32 + 8 * fq) * 2;
                if (!((u.flags & 1) && row == 0)) {
#pragma unroll
                for (int bj = 0; bj < 2; ++bj) { const f32x4 v0 = acc[ai][bj][m][0] * s, v1 = acc[ai][bj][m][1] * s;
                    u32x4 w; w.x = cvt_pk_bf16(v0[0], v0[1]); w.y = cvt_pk_bf16(v0[2], v0[3]); w.z = cvt_pk_bf16(v1[0], v1[1]); w.w = cvt_pk_bf16(v1[2], v1[3]);
                    *(u32x4*)(rowp + bj * 256) = w; } } }
    }
};
struct EpiQKV {
    bf16_t* Q; bf16_t* K; bf16_t* V; const float* ropec; const float* ropes;
    __device__ __forceinline__ void operator()(const f32x4 (&acc)[2][2][4][2], const Unit& u, int wr, int wc, int fr, int fq) const {
        const int pm = u.i0, pn = u.i1; const bool lat = pm < (T / 256); const bool rope = lat && pn < 5;
        const float qs = pn < 4 ? C2 : 1.f;
        const int part = wc & 1;
        const int fi0 = 8 * (fq & 1);
        const float sgn = (fq < 2) ? -1.f : 1.f;
#pragma unroll
        for (int ai = 0; ai < 2; ++ai)
#pragma unroll
            for (int m = 0; m < 4; ++m) { const int row = ai * HALF + wr * 64 + m * 16 + fr; const int tok = pm * 256 + row;
                const int tl = tok & (SEQ - 1); const int pos = part ? (tl & 63) : (tl >> 6);
                f32x4 c0 = {1.f, 1.f, 1.f, 1.f}, c1 = c0, s0 = {0.f, 0.f, 0.f, 0.f}, s1 = s0;
                if (rope) { c0 = *(const f32x4*)(ropec + pos * 16 + fi0); c1 = *(const f32x4*)(ropec + pos * 16 + fi0 + 4); s0 = *(const f32x4*)(ropes + pos * 16 + fi0); s1 = *(const f32x4*)(ropes + pos * 16 + fi0 + 4); }
#pragma unroll
                for (int bj = 0; bj < 2; ++bj) { f32x4 v0 = acc[ai][bj][m][0], v1 = acc[ai][bj][m][1];
                    if (rope) { f32x4 p0, p1;
#pragma unroll
                        for (int j = 0; j < 4; ++j) { p0[j] = __shfl_xor(v0[j], 32); p1[j] = __shfl_xor(v1[j], 32); }
                        v0 = v0 * c0 + (p0 * sgn) * s0; v1 = v1 * c1 + (p1 * sgn) * s1; }
                    v0 = v0 * qs; v1 = v1 * qs;
                    u32x4 w; w.x = cvt_pk_bf16(v0[0], v0[1]); w.y = cvt_pk_bf16(v0[2], v0[3]); w.z = cvt_pk_bf16(v1[0], v1[1]); w.w = cvt_pk_bf16(v1[2], v1[3]);
                    const int col = bj * HALF + wc * 32 + 8 * fq;
                    bf16_t* dst = pn < 4 ? Q + (size_t)tok * 1024 + pn * 256 + col : (pn == 4 ? K + (size_t)tok * 256 + col : V + (size_t)tok * 256 + col);
                    *(u32x4*)dst = w; } }
    }
};
struct EpiSilu {
    __device__ __forceinline__ void operator()(const f32x4 (&acc)[2][2][4][2], const Unit& u, int wr, int wc, int fr, int fq) const {
#pragma unroll
        for (int ai = 0; ai < 2; ++ai)
#pragma unroll
            for (int m = 0; m < 4; ++m) { const int row = ai * HALF + wr * 64 + m * 16 + fr;
                float h[8];
#pragma unroll
                for (int n = 0; n < 2; ++n)
#pragma unroll
                    for (int j = 0; j < 4; ++j) { const float g = acc[ai][0][m][n][j], up = acc[ai][1][m][n][j]; h[n * 4 + j] = g / (1.f + __expf(-g)) * up; }
                u32x4 w; w.x = cvt_pk_bf16(h[0], h[1]); w.y = cvt_pk_bf16(h[2], h[3]); w.z = cvt_pk_bf16(h[4], h[5]); w.w = cvt_pk_bf16(h[6], h[7]);
                *(u32x4*)(u.out + (size_t)row * 512 + (wc * 32 + 8 * fq) * 2) = w; }
    }
};
struct EpiScatter {
    __device__ __forceinline__ void operator()(const f32x4 (&acc)[2][2][4][2], const Unit& u, int wr, int wc, int fr, int fq) const {
#pragma unroll
        for (int ai = 0; ai < 2; ++ai)
#pragma unroll
            for (int m = 0; m < 4; ++m) { const int row = ai * HALF + wr * 64 + m * 16 + fr;
                int dst; float w;
                if (u.l0) { dst = u.l0[row]; w = u.l1[row]; } else { dst = (u.i0 + row) * 9 + 8; w = 1.f; }
                if (dst >= 0) { char* rowp = u.out + (size_t)dst * 2048 + (wc * 32 + 8 * fq) * 2;
#pragma unroll
                    for (int bj = 0; bj < 2; ++bj) { const f32x4 v0 = acc[ai][bj][m][0] * w, v1 = acc[ai][bj][m][1] * w;
                        u32x4 o; o.x = cvt_pk_bf16(v0[0], v0[1]); o.y = cvt_pk_bf16(v0[2], v0[3]); o.z = cvt_pk_bf16(v1[0], v1[1]); o.w = cvt_pk_bf16(v1[2], v1[3]);
                        *(u32x4*)(rowp + bj * 256) = o; } } }
    }
};
struct EpiFp8 {
    __device__ __forceinline__ void operator()(const f32x4 (&acc)[2][2][4][2], const Unit& u, int wr, int wc, int fr, int fq) const {
        const int pn = u.i1;
#pragma unroll
        for (int ai = 0; ai < 2; ++ai)
#pragma unroll
            for (int m = 0; m < 4; ++m) { const int row = ai * HALF + wr * 64 + m * 16 + fr;
                u32x4 o;
#pragma unroll
                for (int bj = 0; bj < 2; ++bj) { const f32x4 v0 = acc[ai][bj][m][0] * 16.f, v1 = acc[ai][bj][m][1] * 16.f;
                    int w0 = 0, w1 = 0;
                    w0 = __builtin_amdgcn_cvt_pk_fp8_f32(v0[0], v0[1], w0, false); w0 = __builtin_amdgcn_cvt_pk_fp8_f32(v0[2], v0[3], w0, true);
                    w1 = __builtin_amdgcn_cvt_pk_fp8_f32(v1[0], v1[1], w1, false); w1 = __builtin_amdgcn_cvt_pk_fp8_f32(v1[2], v1[3], w1, true);
                    o[2 * bj] = (unsigned)w0; o[2 * bj + 1] = (unsigned)w1; }
                *(u32x4*)(u.out + (size_t)row * 1024 + (16 * pn + 4 * wc + fq) * 16) = o; }
    }
};
__device__ __forceinline__ int xcd_remap(int L0, int NU) { const int q = NU >> 3, r = NU & 7, x = L0 & 7, off = L0 >> 3; return (x < r ? x * (q + 1) : r * (q + 1) + (x - r) * q) + off; }
}

namespace attn {
constexpr int SLOTB = 8192;
constexpr int LDS_K = 0, LDS_V = 2 * SLOTB, LDS_WS = 4 * SLOTB, LDS_OST = LDS_WS + NWAVES * 256, LDS_END = LDS_OST + NWAVES * 4096;
static_assert(LDS_END <= RING_BYTES, "attention LDS");
__device__ __forceinline__ int crow(int r, int hi) { return (r & 3) + 8 * (r >> 2) + 4 * hi; }
__device__ __forceinline__ void glds16(const void* gsrc, unsigned lds_dst) { unsigned keep;
    asm volatile("s_mov_b32 %0, m0\n\ts_mov_b32 m0, %2\n\ts_nop 0\n\tglobal_load_lds_dwordx4 %1, off\n\ts_mov_b32 m0, %0" : "=&s"(keep) : "v"(gsrc), "s"(lds_dst) : "memory"); }
__device__ __forceinline__ float rowmax(const f32x16& p0, const f32x16& p1) {
    float a = fmaxf(p0[0], p1[0]);
#pragma unroll
    for (int r = 1; r < 16; ++r) a = fmaxf(a, fmaxf(p0[r], p1[r]));
    auto rr = __builtin_amdgcn_permlane32_swap(__float_as_uint(a), __float_as_uint(a), false, false);
    return fmaxf(__uint_as_float(rr[0]), __uint_as_float(rr[1]));
}
typedef short v4i16_t __attribute__((ext_vector_type(4)));
__device__ __forceinline__ s16x4 vtr(const LAS unsigned char* p) { return __builtin_bit_cast(s16x4, __builtin_amdgcn_ds_read_tr16_b64_v4i16((LAS v4i16_t*)p)); }
__device__ __forceinline__ void pv(f32x16* o, const LAS unsigned char* vp, bf16x8 pa0, bf16x8 pa1, bf16x8 pa2, bf16x8 pa3) {
#pragma unroll
    for (int d0 = 0; d0 < 2; ++d0) { s16x4 lo[4], hi[4];
#pragma unroll
        for (int ks = 0; ks < 4; ++ks) { lo[ks] = vtr(vp + d0 * 4096 + ks * 1024); hi[ks] = vtr(vp + d0 * 4096 + ks * 1024 + 512); }
#define PK(k) (bf16x8){lo[k][0], lo[k][1], lo[k][2], lo[k][3], hi[k][0], hi[k][1], hi[k][2], hi[k][3]}
        o[d0] = __builtin_amdgcn_mfma_f32_32x32x16_bf16(pa0, PK(0), o[d0], 0, 0, 0);
        o[d0] = __builtin_amdgcn_mfma_f32_32x32x16_bf16(pa1, PK(1), o[d0], 0, 0, 0);
        o[d0] = __builtin_amdgcn_mfma_f32_32x32x16_bf16(pa2, PK(2), o[d0], 0, 0, 0);
        o[d0] = __builtin_amdgcn_mfma_f32_32x32x16_bf16(pa3, PK(3), o[d0], 0, 0, 0);
#undef PK
    }
}
__device__ __forceinline__ void attn_unit(const bf16_t* Q, const bf16_t* K, const bf16_t* V, bf16_t* O, int b, int h, int q0, bool isctx, float sink2, LAS unsigned char* shm) {
    const int tid = opaque_tid(), lane = tid & 63, r32 = lane & 31, hi = lane >> 5; const int wid = __builtin_amdgcn_readfirstlane(tid >> 6);
    const int kvh = h >> 2;
    const long qrow = isctx ? (long)T + b * CTXL + wid * 32 : (long)b * SEQ + q0 + wid * 32;
    const unsigned lds0 = (unsigned)(uintptr_t)shm;
    LAS float* wsf = (LAS float*)(shm + LDS_WS) + wid * 64;
    int jlo = 0, nl = 0;
    if (!isctx) { jlo = (q0 == 0) ? 2 : 0; int jhi = (SEQ - q0 + 128) / 64; if (jhi > 8) jhi = 8; nl = jhi - jlo; }
    const int NT = nl + 4;
    const long lat0 = (long)b * SEQ + q0 - 128 + 64 * jlo, ctx0 = (long)T + b * CTXL;
#define TROW(t) ((t) < nl ? lat0 + 64 * (t) : ctx0 + 64 * ((t) - nl))
    const int kcol = kvh * 64 + wid * 8, vcol = kvh * 64 + (wid >> 2) * 32 + (lane & 3) * 8, vrow = 16 * (wid & 3) + (lane >> 2);
    const unsigned kdst = lds0 + LDS_K + wid * 1024, vdst = lds0 + LDS_V + wid * 1024;
#define DMA_KV(t, slot) do { const long tr_ = TROW(t); glds16(K + (tr_ + lane) * 256 + kcol, (unsigned)__builtin_amdgcn_readfirstlane(kdst + (slot) * SLOTB)); \
        glds16(V + (tr_ + vrow) * 256 + vcol, (unsigned)__builtin_amdgcn_readfirstlane(vdst + (slot) * SLOTB)); } while (0)
    DMA_KV(0, 0);
    bf16x8 qr[4];
#pragma unroll
    for (int d0 = 0; d0 < 4; ++d0) qr[d0] = *(const GAS bf16x8*)(Q + (qrow + r32) * 1024 + h * 64 + d0 * 16 + hi * 8);
    float mrun = sink2, l_reg = (hi == 0) ? 1.f : 0.f;
    f32x16 o[2];
#pragma unroll
    for (int r = 0; r < 16; ++r) { o[0][r] = 0.f; o[1][r] = 0.f; }
    const LAS unsigned char* vp0 = shm + LDS_V + ((lane >> 4) & 1) * 32 + (lane & 3) * 8 + (4 * hi + ((lane & 15) >> 2)) * 64;
    const int qw = q0 + wid * 32;
    asm volatile("s_waitcnt vmcnt(0) lgkmcnt(0)\n\ts_barrier" ::: "memory");
    for (int t = 0; t < NT; ++t) {
        const int slot = t & 1;
        if (t + 1 < NT) DMA_KV(t + 1, slot ^ 1);
        const bool latt = t < nl;
        const int ks = q0 - 128 + 64 * (jlo + t);
        bool need = true;
        if (latt) need = (ks + 63 >= qw - 128) && (ks <= qw + 31 + 128);
        if (need) {
            f32x16 p0, p1;
#pragma unroll
            for (int r = 0; r < 16; ++r) { p0[r] = 0.f; p1[r] = 0.f; }
            const LAS unsigned char* kb = shm + LDS_K + slot * SLOTB + hi * 1024 + r32 * 16;
#pragma unroll
            for (int d0 = 0; d0 < 4; ++d0) {
                const bf16x8 b0 = *(const LAS bf16x8*)(kb + d0 * 2048), b1 = *(const LAS bf16x8*)(kb + d0 * 2048 + 512);
                p0 = __builtin_amdgcn_mfma_f32_32x32x16_bf16(b0, qr[d0], p0, 0, 0, 0);
                p1 = __builtin_amdgcn_mfma_f32_32x32x16_bf16(b1, qr[d0], p1, 0, 0, 0); }
            if (latt) { const int dq = qw + r32 - ks;
#pragma unroll
                for (int r = 0; r < 16; ++r) { const int d = dq - crow(r, hi); if (d > 128 || d < -128) p0[r] = -INFINITY; if (d - 32 > 128 || d - 32 < -128) p1[r] = -INFINITY; } }
            const float rm = rowmax(p0, p1);
            if (__any(rm > mrun + 8.f)) {
                const float mnew = fmaxf(mrun, rm);
                const float alpha = __builtin_amdgcn_exp2f(mrun - mnew); l_reg *= alpha; mrun = mnew;
                if (hi == 0) wsf[r32] = alpha;
                asm volatile("s_waitcnt lgkmcnt(0)" ::: "memory");
#pragma unroll
                for (int r = 0; r < 16; ++r) { const float f = wsf[crow(r, hi)]; o[0][r] *= f; o[1][r] *= f; }
            }
            float sacc = 0.f;
#pragma unroll
            for (int r = 0; r < 16; ++r) { p0[r] = __builtin_amdgcn_exp2f(p0[r] - mrun); p1[r] = __builtin_amdgcn_exp2f(p1[r] - mrun); sacc += p0[r] + p1[r]; }
            l_reg += sacc;
            u32x4 pw0, pw1, pw2, pw3;
#define PKW(P, B) cvt_pk_bf16(P[B], P[B + 1])
            pw0 = (u32x4){PKW(p0, 0), PKW(p0, 2), PKW(p0, 4), PKW(p0, 6)}; pw1 = (u32x4){PKW(p0, 8), PKW(p0, 10), PKW(p0, 12), PKW(p0, 14)};
            pw2 = (u32x4){PKW(p1, 0), PKW(p1, 2), PKW(p1, 4), PKW(p1, 6)}; pw3 = (u32x4){PKW(p1, 8), PKW(p1, 10), PKW(p1, 12), PKW(p1, 14)};
#undef PKW
            __builtin_amdgcn_sched_barrier(0);
            pv(o, vp0 + slot * SLOTB, __builtin_bit_cast(bf16x8, pw0), __builtin_bit_cast(bf16x8, pw1), __builtin_bit_cast(bf16x8, pw2), __builtin_bit_cast(bf16x8, pw3));
        }
        asm volatile("s_waitcnt vmcnt(0) lgkmcnt(0)\n\ts_barrier" ::: "memory");
    }
    { auto rr = __builtin_amdgcn_permlane32_swap(__float_as_uint(l_reg), __float_as_uint(l_reg), false, false); l_reg = __uint_as_float(rr[0]) + __uint_as_float(rr[1]); }
    if (hi == 0) wsf[32 + r32] = l_reg;
    asm volatile("s_waitcnt lgkmcnt(0)" ::: "memory");
    float rli[16];
#pragma unroll
    for (int r = 0; r < 16; ++r) rli[r] = __builtin_amdgcn_rcpf(wsf[32 + crow(r, hi)]);
    bf16_t* Ow = O + qrow * 1024 + h * 64;
    { LAS bf16_t* stg = (LAS bf16_t*)(shm + LDS_OST) + wid * 2048;
#pragma unroll
      for (int r = 0; r < 16; ++r) { const int orow = crow(r, hi);
#pragma unroll
          for (int d0 = 0; d0 < 2; ++d0) stg[orow * 64 + d0 * 32 + r32] = (bf16_t)f2bf(o[d0][r] * rli[r]); }
      asm volatile("s_waitcnt lgkmcnt(0)" ::: "memory");
#pragma unroll
      for (int i = 0; i < 4; ++i) { const int row = i * 8 + (lane >> 3), ch = lane & 7; const u32x4 v = *(const LAS u32x4*)(stg + row * 64 + ch * 8); *(GAS u32x4*)(Ow + (long)row * 1024 + ch * 8) = v; } }
    asm volatile("s_waitcnt lgkmcnt(0)" ::: "memory");
#undef TROW
#undef DMA_KV
}
}

struct Args {
    const float* in[20];
    float* out; unsigned char* ws;
};
struct Frame {
    LAS unsigned char* lds; unsigned* ctl; unsigned char* ws;
    int tid, lane, wave, gw;
    int blk;
    __device__ __forceinline__ void refresh() { tid = opaque_tid(); lane = tid & 63; wave = __builtin_amdgcn_readfirstlane(tid >> 6); gw = blk * 8 + wave;
        asm volatile("" : "+s"(ws)); ctl = (unsigned*)(ws + WS_CTL); }
};
constexpr int NGW = GRID * NWAVES;

struct Row { f32x4 v[4]; };
__device__ __forceinline__ int vq(int q, int lane) { return 64 * (lane >> 4) + 2 * (lane & 15) + 32 * (q >> 1) + (q & 1); }
__device__ __forceinline__ int vb(int j, int lane) { return 32 * (lane >> 4) + (lane & 15) + 16 * j; }
__device__ __forceinline__ void row_load_bf16(Row& r, const bf16_t* p, int lane) {
#pragma unroll
    for (int j = 0; j < 2; ++j) { const u32x4 w = ((const GAS u32x4*)p)[vb(j, lane)]; r.v[2 * j] = (f32x4){bflo(w.x), bfhi(w.x), bflo(w.y), bfhi(w.y)}; r.v[2 * j + 1] = (f32x4){bflo(w.z), bfhi(w.z), bflo(w.w), bfhi(w.w)}; } }
__device__ __forceinline__ void row_store_bf16(const Row& r, bf16_t* p, int lane) {
#pragma unroll
    for (int j = 0; j < 2; ++j) { u32x4 w; w.x = pk2(r.v[2 * j][0], r.v[2 * j][1]); w.y = pk2(r.v[2 * j][2], r.v[2 * j][3]); w.z = pk2(r.v[2 * j + 1][0], r.v[2 * j + 1][1]); w.w = pk2(r.v[2 * j + 1][2], r.v[2 * j + 1][3]); ((GAS u32x4*)p)[vb(j, lane)] = w; } }
typedef float f32x2v __attribute__((ext_vector_type(2)));
__device__ __forceinline__ void row_load_fp8(Row& r, const unsigned char* p, int lane) {
    const u32x4 w = ((const GAS u32x4*)p)[lane];
#pragma unroll
    for (int q = 0; q < 4; ++q) { const f32x2v lo = __builtin_amdgcn_cvt_pk_f32_fp8((int)w[q], false), hi = __builtin_amdgcn_cvt_pk_f32_fp8((int)w[q], true); r.v[q] = (f32x4){lo[0], lo[1], hi[0], hi[1]}; } }
__device__ __forceinline__ void row_load_f32(Row& r, const float* p, int lane) {
#pragma unroll
    for (int q = 0; q < 4; ++q) r.v[q] = ((const GAS f32x4*)p)[vq(q, lane)]; }
__device__ __forceinline__ void row_store_f32(const Row& r, float* p, int lane) {
#pragma unroll
    for (int q = 0; q < 4; ++q) ((GAS f32x4*)p)[vq(q, lane)] = r.v[q]; }
__device__ __forceinline__ void row_normalize(Row& r, float eps) {
    float s = 0.f;
#pragma unroll
    for (int j = 0; j < 4; ++j) s += (r.v[j][0] + r.v[j][1]) + (r.v[j][2] + r.v[j][3]);
    const float mean = wave_sum(s) * (1.f / D); float q = 0.f;
#pragma unroll
    for (int j = 0; j < 4; ++j) { r.v[j] = r.v[j] - mean; q += (r.v[j][0] * r.v[j][0] + r.v[j][1] * r.v[j][1]) + (r.v[j][2] * r.v[j][2] + r.v[j][3] * r.v[j][3]); }
    const float rstd = 1.f / sqrtf(wave_sum(q) * (1.f / D) + eps);
#pragma unroll
    for (int j = 0; j < 4; ++j) r.v[j] = r.v[j] * rstd;
}
__device__ __forceinline__ void row_modulate(Row& r, const float* sh, const float* sc, int lane) {
    row_normalize(r, MOD_EPS);
#pragma unroll
    for (int j = 0; j < 4; ++j) { const f32x4 a = ((const GAS f32x4*)sc)[vq(j, lane)], b = ((const GAS f32x4*)sh)[vq(j, lane)]; r.v[j] = r.v[j] * (a + 1.f) + b; }
}
__device__ __forceinline__ int mod_row(int row) { return row < T ? (row >> 11) : 32; }
__device__ __forceinline__ const float* mod_vec(const unsigned char* ws, int layer, int mr, int chunk) { return (const float*)(ws + WS_MOD) + ((size_t)(layer * 33 + mr) * 6 + chunk) * 1024; }

__device__ __forceinline__ void conv_item(const float* W, int N, bf16_t* WT, int Kd, int kd0, int n0, int drow0, bool mirror, LAS float* scr, int lane) {
#pragma unroll 8
    for (int i = 0; i < 32; ++i) { const int kk = 2 * i + (lane >> 5); const int kd = kd0 + kk; const int ks = mirror ? ((kd & ~255) + ((256 - (kd & 255)) & 255)) : kd;
        scr[kk * 33 + (lane & 31)] = ((const GAS float*)W)[(size_t)ks * N + n0 + (lane & 31)]; }
    LDS_WAIT(); asm volatile("" ::: "memory");
    const int c = lane & 7;
#pragma unroll
    for (int j = 0; j < 4; ++j) { const int n = (lane >> 3) + 8 * j; const LAS float* s = scr + (8 * c) * 33 + n;
        u32x4 o; o.x = pk2(s[0 * 33], s[1 * 33]); o.y = pk2(s[2 * 33], s[3 * 33]); o.z = pk2(s[4 * 33], s[5 * 33]); o.w = pk2(s[6 * 33], s[7 * 33]);
        *(GAS u32x4*)(WT + (size_t)(drow0 + n) * Kd + kd0 + 8 * c) = o; }
    LDS_WAIT(); asm volatile("" ::: "memory");
}
__device__ __forceinline__ void conv_matrix_item(const float* W, int K, int N, bf16_t* WT, int mode, int roff, int item, LAS float* scr, int lane) {
    const int nblk = N / 32, kb = item / nblk, nb = item % nblk, n0 = 32 * nb;
    int drow0 = n0 + roff; if (mode == 1) drow0 = (n0 >> 7) * 256 + (n0 & 127); if (mode == 2) drow0 = (n0 >> 7) * 256 + 128 + (n0 & 127);
    conv_item(W, N, WT, K, 64 * kb, n0, drow0, mode == 3, scr, lane);
}
__device__ __forceinline__ void conv_item64(const float* W, int N, bf16_t* WT, int Kd, int k0, int n0, int drow0, LAS bf16_t* scr, int lane) {
    f32x4 v[16];
#pragma unroll
    for (int i = 0; i < 16; ++i) v[i] = *(const GAS f32x4*)(W + (size_t)(k0 + 4 * i + (lane >> 4)) * N + n0 + (lane & 15) * 4);
#pragma unroll
    for (int i = 0; i < 16; ++i) { u32x2 w; w.x = pk2(v[i][0], v[i][1]); w.y = pk2(v[i][2], v[i][3]); *(LAS u32x2*)(scr + (4 * i + (lane >> 4)) * 68 + (lane & 15) * 4) = w; }
    LDS_WAIT(); asm volatile("" ::: "memory");
    const int c = lane & 7;
#pragma unroll
    for (int j = 0; j < 8; ++j) { const int n = (lane >> 3) + 8 * j; const LAS bf16_t* p = scr + (8 * c) * 68 + n;
        u32x4 o; o.x = (unsigned)p[0] | ((unsigned)p[68] << 16); o.y = (unsigned)p[2 * 68] | ((unsigned)p[3 * 68] << 16); o.z = (unsigned)p[4 * 68] | ((unsigned)p[5 * 68] << 16); o.w = (unsigned)p[6 * 68] | ((unsigned)p[7 * 68] << 16);
        *(GAS u32x4*)(WT + (size_t)(drow0 + n) * Kd + k0 + 8 * c) = o; }
    LDS_WAIT(); asm volatile("" ::: "memory");
}
__device__ __forceinline__ void conv_experts(Frame& F, const float* wg, const float* wu, const float* wd, int layer) {
    F.refresh();
    LAS bf16_t* scr = (LAS bf16_t*)(F.lds + 32768 + F.wave * 8704);
    bf16_t* EGU = (bf16_t*)(F.ws + WS_EGU); bf16_t* ED = (bf16_t*)(F.ws + WS_ED);
    for (int it = F.gw; it < NE * 192; it += NGW) { const int e = it / 192, r = it % 192;
        const size_t eo = ((size_t)layer * NE + e) * (1024 * 256);
        if (r < 128) { const int q = r & 63, kb = q >> 2, nb = q & 3, n0 = 64 * nb; const int drow0 = (n0 >> 7) * 256 + (r < 64 ? 0 : 128) + (n0 & 127);
            conv_item64((r < 64 ? wg : wu) + eo, 256, EGU + (size_t)e * 512 * 1024, 1024, 64 * kb, n0, drow0, scr, F.lane); }
        else { const int q = r - 128, kb = q >> 4, nb = q & 15; conv_item64(wd + eo, 1024, ED + (size_t)e * 1024 * 256, 256, 64 * kb, 64 * nb, 64 * nb, scr, F.lane); } }
}
__device__ __forceinline__ void conv_small(Frame& F, const Args& a) {
    F.refresh();
    LAS float* scr = (LAS float*)(F.lds + 32768 + F.wave * 8448);
    for (int it = F.gw; it < 6272; it += NGW) {
        if (it < 1536) { const int j = it / 768, r = it % 768; conv_matrix_item(a.in[8] + (size_t)j * 1024 * 1536, 1024, 1536, (bf16_t*)(F.ws + WS_WQKV) + (size_t)j * 1536 * 1024, 0, 0, r, scr, F.lane); }
        else if (it < 2560) { const int q = it - 1536, j = q / 512, r = q % 512; conv_matrix_item(a.in[9] + (size_t)j * 1024 * 1024, 1024, 1024, (bf16_t*)(F.ws + WS_WO) + (size_t)j * 1024 * 1024, 0, 0, r, scr, F.lane); }
        else if (it < 4608) { const int q = it - 2560, j = q / 1024, r = q % 1024; bf16_t* dst = (bf16_t*)(F.ws + WS_WF) + (size_t)j * 2048 * 1024;
            if (r < 512) conv_matrix_item(a.in[11] + (size_t)j * 1024 * 1024, 1024, 1024, dst, 0, 0, r, scr, F.lane);
            else conv_matrix_item(a.in[11] + (size_t)j * 1024 * 1024, 1024, 1024, dst, 3, 1024, r - 512, scr, F.lane); }
        else if (it < 4736) { const int q = it - 4608, l = q / 32, r = q % 32; conv_matrix_item(a.in[12] + (size_t)l * 1024 * 64, 1024, 64, (bf16_t*)(F.ws + WS_WR) + (size_t)l * 64 * 1024, 0, 0, r, scr, F.lane); }
        else { const int q = it - 4736, l = q / 384, r = q % 384; bf16_t* gu = (bf16_t*)(F.ws + WS_WSH + (size_t)l * 1536 * 1024); bf16_t* dn = gu + 512 * 1024;
            if (r < 128) conv_matrix_item(a.in[17] + (size_t)l * 1024 * 256, 1024, 256, gu, 1, 0, r, scr, F.lane);
            else if (r < 256) conv_matrix_item(a.in[18] + (size_t)l * 1024 * 256, 1024, 256, gu, 2, 0, r - 128, scr, F.lane);
            else conv_matrix_item(a.in[19] + (size_t)l * 256 * 1024, 256, 1024, dn, 0, 0, r - 256, scr, F.lane); }
    }
    const int gt = F.blk * NTHR + F.tid, NGT = GRID * NTHR;
    const float TWO_PI = 6.283185307179586f;
    { float* rc = (float*)(F.ws + WS_ROPEC); float* rs = (float*)(F.ws + WS_ROPES);
      for (int i = gt; i < 64 * 16; i += NGT) { const int pos = i >> 4, fi = i & 15; const float inv = exp2f(-(float)fi * (13.287712379549449f / 16.f)); const float ang = (float)pos * inv; rc[i] = cosf(ang); rs[i] = sinf(ang); } }
    { bf16_t* cs = (bf16_t*)(F.ws + WS_CSN);
      for (int i = gt; i < 512 * 256; i += NGT) { const int r = i >> 8, n = i & 255, m = r & 255; const float ang = TWO_PI * (float)((m * n) & 255) * (1.f / 256.f); cs[i] = (bf16_t)f2bf(r < 256 ? cosf(ang) : -sinf(ang)); } }
    { bf16_t* dl = (bf16_t*)(F.ws + WS_DL);
      for (int i = gt; i < 1024 * 4096; i += NGT) { const int k = i >> 12, c = i & 4095, l = c & 2047; const float ang = TWO_PI * (float)((k * l) & 2047) * (1.f / 2048.f); dl[i] = (bf16_t)f2bf(c < 2048 ? cosf(ang) : sinf(ang)); } }
    { bf16_t* dl = (bf16_t*)(F.ws + WS_DLC);
      for (int i = gt; i < 256 * 512; i += NGT) { const int k = i >> 9, c = i & 511, l = c & 255; const float ang = TWO_PI * (float)((k * l) & 255) * (1.f / 256.f); dl[i] = (bf16_t)f2bf(c < 256 ? cosf(ang) : sinf(ang)); } }
}
__device__ __forceinline__ void mod_partials(Frame& F, const Args& a) {
    F.refresh();
    if (F.blk >= 192) return;
    const int l = F.blk / 48, cb = (F.blk % 48) / 4, kc = F.blk & 3;
    LAS float* s = (LAS float*)F.lds;
    for (int i = F.tid; i < 256 * 33; i += NTHR) { const int k = i / 33, r = i % 33; const float c = (r < 32) ? a.in[1][(size_t)r * 1024 + kc * 256 + k] : a.in[3][kc * 256 + k]; s[k * 36 + r] = c / (1.f + __expf(-c)); }
    __syncthreads();
    const int n = cb * 512 + F.tid;
    const GAS float* w = (const GAS float*)a.in[4] + ((size_t)l * 1024 + kc * 256) * 6144 + n;
    float acc[33];
#pragma unroll
    for (int r = 0; r < 33; ++r) acc[r] = 0.f;
#pragma unroll 4
    for (int k = 0; k < 256; ++k) { const float wv = w[(size_t)k * 6144];
#pragma unroll
        for (int r = 0; r < 33; ++r) acc[r] += s[k * 36 + r] * wv; }
    float* part = (float*)(F.ws + WS_MODP) + ((size_t)(kc * 4 + l) * 33) * 6144 + n;
#pragma unroll
    for (int r = 0; r < 33; ++r) part[(size_t)r * 6144] = acc[r];
    __syncthreads();
}
__device__ __forceinline__ void mod_finalize(Frame& F, const Args& a) {
    F.refresh();
    const int gt = F.blk * NTHR + F.tid, NGT = GRID * NTHR; const float* part = (const float*)(F.ws + WS_MODP); float* mod = (float*)(F.ws + WS_MOD);
    for (int i = gt; i < 4 * 33 * 6144; i += NGT) { const int l = i / (33 * 6144), n = i % 6144; float v = a.in[5][l * 6144 + n];
#pragma unroll
        for (int kc = 0; kc < 4; ++kc) v += part[(size_t)kc * 4 * 33 * 6144 + i]; mod[i] = v; }
}
__device__ __forceinline__ void rows_init(Frame& F, const Args& a) {
    F.refresh();
    bf16_t* XS = (bf16_t*)(F.ws + WS_XS); bf16_t* U = (bf16_t*)a.out; const float* part = (const float*)(F.ws + WS_MODP);
    for (int row = F.gw; row < TT; row += NGW) {
        Row r; row_load_f32(r, row < T ? a.in[0] + (size_t)row * D : a.in[2] + (size_t)(row - T) * D, F.lane);
        row_store_bf16(r, XS + (size_t)row * D, F.lane);
        row_normalize(r, MOD_EPS); const int mr = mod_row(row);
#pragma unroll
        for (int j = 0; j < 4; ++j) { const int e = vq(j, F.lane);
            f32x4 sh = ((const GAS f32x4*)(a.in[5]))[e], sc = ((const GAS f32x4*)(a.in[5] + 1024))[e];
#pragma unroll
            for (int kc = 0; kc < 4; ++kc) { const float* pp = part + ((size_t)(kc * 4 + 0) * 33 + mr) * 6144; sh += ((const GAS f32x4*)pp)[e]; sc += ((const GAS f32x4*)(pp + 1024))[e]; }
            r.v[j] = r.v[j] * (sc + 1.f) + sh; }
        row_store_bf16(r, U + (size_t)row * D, F.lane);
    }
}
__device__ __forceinline__ void rows_post1(Frame& F, const Args& a, int layer, int nrows) {
    F.refresh();
    bf16_t* XS = (bf16_t*)(F.ws + WS_XS); bf16_t* U = (bf16_t*)a.out;
    const float* lg = a.in[6] + (size_t)(layer * 2 + 0) * D; const float* lb = a.in[7] + (size_t)(layer * 2 + 0) * D;
    const int TPB = nrows / GRID;
    for (int rl = F.wave; rl < TPB; rl += NWAVES) { const int row = F.blk * TPB + rl; const int mr = mod_row(row);
        Row x, y; row_load_bf16(x, XS + (size_t)row * D, F.lane); row_load_bf16(y, U + (size_t)row * D, F.lane);
        const float* g1 = mod_vec(F.ws, layer, mr, 2);
#pragma unroll
        for (int j = 0; j < 4; ++j) x.v[j] = x.v[j] * ALPHA + ((const GAS f32x4*)g1)[vq(j, F.lane)] * y.v[j];
        row_normalize(x, LN_EPS);
#pragma unroll
        for (int j = 0; j < 4; ++j) x.v[j] = x.v[j] * ((const GAS f32x4*)lg)[vq(j, F.lane)] + ((const GAS f32x4*)lb)[vq(j, F.lane)];
        row_store_bf16(x, XS + (size_t)row * D, F.lane);
        row_modulate(x, mod_vec(F.ws, layer, mr, 3), mod_vec(F.ws, layer, mr, 4), F.lane);
        row_store_bf16(x, U + (size_t)row * D, F.lane);
    }
}
__device__ __forceinline__ void rows_post2(Frame& F, const Args& a, int layer, int t0, int n) {
    F.refresh();
    bf16_t* XS = (bf16_t*)(F.ws + WS_XS); bf16_t* U = (bf16_t*)a.out; const unsigned char* YB = (const unsigned char*)(F.ws + WS_YB); const unsigned char* YS = (const unsigned char*)(F.ws + WS_YS);
    const int* spos = (const int*)(F.ws + WS_SDST); const float* tkw = (const float*)(F.ws + WS_TKW);
    const float* lg = a.in[6] + (size_t)(layer * 2 + 1) * D; const float* lb = a.in[7] + (size_t)(layer * 2 + 1) * D;
    for (int i = F.gw; i < n; i += NGW) { const int row = t0 + i; const int mr = mod_row(row);
        Row x, y; row_load_bf16(x, XS + (size_t)row * D, F.lane);
        int pj = 0; float wj = 0.f; if (F.lane < 8) { pj = ((const GAS int*)spos)[(size_t)row * 8 + F.lane]; wj = ((const GAS float*)tkw)[(size_t)row * 8 + F.lane]; }
        row_load_fp8(y, YS + (size_t)i * D, F.lane);
#pragma unroll
        for (int j = 0; j < 4; ++j) y.v[j] = y.v[j] * (1.f / 16.f);
#pragma unroll
        for (int s = 0; s < 8; ++s) { const int ps = __builtin_amdgcn_readlane(pj, s); const float ws_ = __builtin_bit_cast(float, __builtin_amdgcn_readlane(__builtin_bit_cast(int, wj), s));
            Row z; row_load_fp8(z, YB + (size_t)ps * D, F.lane); const float wz = ws_ * (1.f / 16.f);
#pragma unroll
            for (int j = 0; j < 4; ++j) y.v[j] += z.v[j] * wz; }
        const float* g2 = mod_vec(F.ws, layer, mr, 5);
#pragma unroll
        for (int j = 0; j < 4; ++j) x.v[j] = x.v[j] * ALPHA + ((const GAS f32x4*)g2)[vq(j, F.lane)] * y.v[j];
        row_normalize(x, LN_EPS);
#pragma unroll
        for (int j = 0; j < 4; ++j) x.v[j] = x.v[j] * ((const GAS f32x4*)lg)[vq(j, F.lane)] + ((const GAS f32x4*)lb)[vq(j, F.lane)];
        if (layer == 3) { row_store_f32(x, a.out + (size_t)row * D, F.lane); }
        else { row_store_bf16(x, XS + (size_t)row * D, F.lane);
            row_modulate(x, mod_vec(F.ws, layer + 1, mr, 0), mod_vec(F.ws, layer + 1, mr, 1), F.lane);
            row_store_bf16(x, U + (size_t)row * D, F.lane); }
    }
}

__device__ __forceinline__ float wave_max_dpp(float v) {
    int x = __builtin_bit_cast(int, v);
#define DPPMAX(ctrl) { const int y = __builtin_amdgcn_update_dpp(x, x, ctrl, 0xf, 0xf, false); x = __builtin_bit_cast(int, fmaxf(__builtin_bit_cast(float, x), __builtin_bit_cast(float, y))); }
    DPPMAX(0xB1) DPPMAX(0x4E) DPPMAX(0x141) DPPMAX(0x140)
#undef DPPMAX
    const float r0 = __builtin_bit_cast(float, __builtin_amdgcn_readlane(x, 0)), r1 = __builtin_bit_cast(float, __builtin_amdgcn_readlane(x, 16));
    const float r2 = __builtin_bit_cast(float, __builtin_amdgcn_readlane(x, 32)), r3 = __builtin_bit_cast(float, __builtin_amdgcn_readlane(x, 48));
    return fmaxf(fmaxf(r0, r1), fmaxf(r2, r3));
}
__device__ __forceinline__ void route_tokens(Frame& F, const Args& a, int layer, int ntok) {
    F.refresh();
    const int TPB = ntok / GRID;
    const bf16_t* U = (const bf16_t*)a.out; const bf16_t* Wr = (const bf16_t*)(F.ws + WS_WR) + (size_t)layer * 64 * 1024;
    int* tke = (int*)(F.ws + WS_TKE); float* tkw = (float*)(F.ws + WS_TKW);
    LAS int* lcnt = (LAS int*)(F.lds + L_LCNT);
    LAS float* sc = (LAS float*)(F.lds) + F.wave * 1024;
    if (F.tid < 64) lcnt[F.tid] = 0;
    __syncthreads();
    const int lane = F.lane, fr = lane & 15, fq = lane >> 4;
    const float bias = a.in[13][layer * 64 + lane];
    const int ntile = TPB / 16;
    for (int tl = F.wave; tl < ntile; tl += NWAVES) {
        const int t0 = F.blk * TPB + tl * 16;
        f32x4 acc[4];
#pragma unroll
        for (int n = 0; n < 4; ++n) acc[n] = (f32x4){0.f, 0.f, 0.f, 0.f};
        const GAS bf16x8* ap = (const GAS bf16x8*)(U + (size_t)(t0 + fr) * D + fq * 8);
        const GAS bf16x8* bp = (const GAS bf16x8*)(Wr + (size_t)fr * D + fq * 8);
#pragma unroll 4
        for (int ks = 0; ks < 32; ++ks) { const bf16x8 av = ap[ks * 4];
#pragma unroll
            for (int n = 0; n < 4; ++n) { const bf16x8 bv = bp[(size_t)n * 16 * (D / 8) + ks * 4]; acc[n] = __builtin_amdgcn_mfma_f32_16x16x32_bf16(av, bv, acc[n], 0, 0, 0); } }
#pragma unroll
        for (int n = 0; n < 4; ++n)
#pragma unroll
            for (int j = 0; j < 4; ++j) sc[(fq * 4 + j) * 64 + n * 16 + fr] = acc[n][j];
        LDS_WAIT();
        for (int tk = 0; tk < 16; ++tk) {
            const float logit = sc[tk * 64 + lane];
            const float s = 1.f / (1.f + __expf(-logit));
            const float sel = s + bias;
            const int g = lane >> 3;
            float m1 = sel; m1 = fmaxf(m1, __shfl_xor(m1, 1)); m1 = fmaxf(m1, __shfl_xor(m1, 2)); m1 = fmaxf(m1, __shfl_xor(m1, 4));
            const unsigned long long bm = __ballot(sel == m1);
            const unsigned gm = (unsigned)(bm >> (g * 8)) & 0xffu;
            const int first = g * 8 + __builtin_ctz(gm);
            float m2 = (lane == first) ? -INFINITY : sel; m2 = fmaxf(m2, __shfl_xor(m2, 1)); m2 = fmaxf(m2, __shfl_xor(m2, 2)); m2 = fmaxf(m2, __shfl_xor(m2, 4));
            const float gs = m1 + m2;
            float curg = gs; bool gok = false;
#pragma unroll 1
            for (int it = 0; it < 4; ++it) { const float mx = wave_max_dpp(curg);
                const unsigned long long bb = __ballot(curg == mx); const int gi = (int)(__builtin_ctzll(bb) >> 3);
                if (g == gi) { gok = true; curg = -INFINITY; } }
            float cure = gok ? sel : -INFINITY; bool chosen = false; int rk = 0;
#pragma unroll 1
            for (int it = 0; it < 8; ++it) { const float mx = wave_max_dpp(cure);
                const unsigned long long bb = __ballot(cure == mx); const int ei = (int)__builtin_ctzll(bb);
                if (lane == ei) { chosen = true; rk = it; cure = -INFINITY; } }
            const float tot = wave_sum(chosen ? s : 0.f);
            if (chosen) { const int tok = t0 + tk; tke[(size_t)tok * 8 + rk] = lane; tkw[(size_t)tok * 8 + rk] = s / tot * 2.5f; __hip_atomic_fetch_add(&lcnt[lane], 1, __ATOMIC_RELAXED, __HIP_MEMORY_SCOPE_WORKGROUP); }
        }
        LDS_WAIT();
    }
    __syncthreads();
    if (F.tid < 64) F.ctl[CW_BCNT + F.blk * 64 + F.tid] = (unsigned)lcnt[F.tid];
}
__device__ __forceinline__ void build_lists(Frame& F, int ntok) {
    F.refresh();
    constexpr int NSEG = NCHUNK * 64, BPC = GRID / NCHUNK;
    const int TPB = ntok / GRID, CH = ntok / NCHUNK;
    LAS int* tstart = (LAS int*)(F.lds + L_TSTART); LAS int* pref = (LAS int*)(F.lds + L_PREF); LAS int* lcnt = (LAS int*)(F.lds + L_LCNT);
    LAS unsigned char* tseg = (LAS unsigned char*)(F.lds + L_TSEG); LAS int* scan = (LAS int*)(F.lds + L_SCAN);
    const unsigned* bcnt = F.ctl + CW_BCNT;
    const int myc = F.blk / BPC, mylb = F.blk % BPC;
    int nseg = 0;
    LAS int* cntl = (LAS int*)F.lds;
    for (int i = F.tid; i < GRID * 64; i += NTHR) cntl[i] = (int)((const GAS unsigned*)bcnt)[i];
    if (F.tid < 64) lcnt[F.tid] = 0;
    __syncthreads();
    if (F.tid < NSEG) { const int c = F.tid >> 6, e = F.tid & 63; int n = 0, p = 0;
        for (int lb = 0; lb < BPC; ++lb) { const int v = cntl[(c * BPC + lb) * 64 + e]; if (c == myc && lb < mylb) p += v; n += v; }
        nseg = n; scan[F.tid] = (n + 255) >> 8; if (c == myc) pref[e] = p; }
    __syncthreads();
    if (F.tid == 0) { int acc = 0; for (int s = 0; s < NSEG; ++s) { tstart[s] = acc; acc += scan[s]; } tstart[NSEG] = acc; }
    __syncthreads();
    if (F.tid < NSEG) { const int t0 = tstart[F.tid], t1 = tstart[F.tid + 1]; for (int t = t0; t < t1; ++t) tseg[t] = (unsigned char)F.tid; }
    int* stok = (int*)(F.ws + WS_STOK); int* spos = (int*)(F.ws + WS_SDST);
    const int* tke = (const int*)(F.ws + WS_TKE);
    { const int sseg = myc * 64 + mylb; if (mylb < 64 && F.tid == sseg) scan[0] = nseg; }
    __syncthreads();
    if (mylb < 64) { const int sseg = myc * 64 + mylb; const int n = scan[0]; const int base = tstart[sseg] * 256, end = tstart[sseg + 1] * 256;
      for (int p = base + n + F.tid; p < end; p += NTHR) stok[p] = myc * CH; }
    for (int tl = F.wave; tl < TPB; tl += NWAVES) { const int tok = F.blk * TPB + tl;
        if (F.lane < 8) { const int e = tke[(size_t)tok * 8 + F.lane];
            const int p = tstart[myc * 64 + e] * 256 + pref[e] + __hip_atomic_fetch_add(&lcnt[e], 1, __ATOMIC_RELAXED, __HIP_MEMORY_SCOPE_WORKGROUP);
            stok[p] = tok; spos[(size_t)tok * 8 + F.lane] = p - tstart[myc * 64] * 256; } }
    __syncthreads();
}

struct SchedQKV {
    const char* U; const char* W; int nfull, nu, c;
    __device__ __forceinline__ bool next(int i, pg::Unit& u) const {
        const int L0 = i * GRID + c; if (L0 >= nu) return false;
        int pm, pn;
        if (L0 < nfull) { const int L = pg::xcd_remap(L0, nfull); const int gid = L / 48, w = L % 48; pm = gid * 8 + (w & 7); pn = w >> 3; }
        else { const int q = L0 - nfull; pm = 256 + (q >> 1); pn = 4 + (q & 1); }
        u.A = U + (size_t)pm * 256 * 2048; u.B = W + (size_t)pn * 256 * 2048; u.gidx = nullptr; u.gbase = 0; u.nt = 16; u.out = nullptr; u.ldc = 0; u.scale = 1.f; u.flags = 0; u.i0 = pm; u.i1 = pn; u.l0 = nullptr; u.l1 = nullptr;
        return true; }
};
struct SchedDense {
    const char* A; const char* W; char* out; int nrt, nct, nt, c; size_t ldA;
    __device__ __forceinline__ bool next(int i, pg::Unit& u) const {
        const int nu = nrt * nct; const int L0 = i * GRID + c; if (L0 >= nu) return false;
        const int L = pg::xcd_remap(L0, nu); const int per = 8 * nct, gid = L / per, w = L % per, fm = gid * 8, gsz = (nrt - fm) < 8 ? (nrt - fm) : 8; const int pm = fm + (w % gsz), pn = w / gsz;
        u.A = A + (size_t)pm * 256 * ldA; u.B = W + (size_t)pn * 256 * ldA; u.gidx = nullptr; u.gbase = 0; u.nt = nt; u.out = out + (size_t)pm * 256 * 2048 + pn * 512; u.ldc = 2048; u.scale = 1.f; u.flags = 0; u.i0 = pm; u.i1 = pn; u.l0 = nullptr; u.l1 = nullptr;
        return true; }
};
struct SchedF1 {
    const char* CS; const char* U; char* ABT; char* ABTC; int nu, c;
    __device__ __forceinline__ bool next(int i, pg::Unit& u) const {
        const int L0 = i * GRID + c; if (L0 >= nu) return false;
        u.gidx = nullptr; u.gbase = 0; u.nt = 4; u.scale = 1.f; u.flags = 0; u.i0 = 0; u.i1 = 0; u.l0 = nullptr; u.l1 = nullptr;
        if (L0 < 2048) { const int L = pg::xcd_remap(L0, 2048); const int pm = L & 1, pn = (L >> 1) & 7, bg = L >> 4, b = bg >> 2, g = bg & 3;
            u.A = CS + (size_t)pm * 256 * 512; u.B = U + ((size_t)b * SEQ + pn * 256) * 2048 + g * 512; u.out = ABT + (size_t)bg * 256 * 8192 + (size_t)(pm * 2048 + pn * 256) * 2; u.ldc = 8192; }
        else { const int q = L0 - 2048; const int pm = q & 1, bg = q >> 1, b = bg >> 2, g = bg & 3;
            u.A = CS + (size_t)pm * 256 * 512; u.B = U + ((size_t)T + b * CTXL) * 2048 + g * 512; u.out = ABTC + (size_t)bg * 256 * 1024 + (size_t)pm * 512; u.ldc = 1024; }
        return true; }
};
struct SchedF2 {
    const char* DL; const char* ABT; char* FH; int c;
    __device__ __forceinline__ bool next(int i, pg::Unit& u) const {
        const int L0 = i * GRID + c; if (L0 >= 512) return false;
        const int L = pg::xcd_remap(L0, 512); const int pm = L & 3, bg = L >> 2, b = bg >> 2, g = bg & 3;
        u.A = DL + (size_t)pm * 256 * 8192; u.B = ABT + (size_t)bg * 256 * 8192; u.gidx = nullptr; u.gbase = 0; u.nt = 64; u.out = FH + ((size_t)b * 1024 + pm * 256) * 2048 + g * 512; u.ldc = 2048; u.scale = 0.001381067932004975f  ; u.flags = 0; u.i0 = 0; u.i1 = 0; u.l0 = nullptr; u.l1 = nullptr;
        return true; }
};
struct SchedF2c {
    const char* DLC; const char* ABTC; char* FC; int c;
    __device__ __forceinline__ bool next(int i, pg::Unit& u) const {
        const int L0 = i * GRID + c; if (L0 >= 128) return false;
        const int bg = L0, b = bg >> 2, g = bg & 3;
        u.A = DLC; u.B = ABTC + (size_t)bg * 256 * 1024; u.gidx = nullptr; u.gbase = 0; u.nt = 8; u.out = FC + ((size_t)b * 256) * 2048 + g * 512; u.ldc = 2048; u.scale = 1.f / 256.f; u.flags = 0; u.i0 = 0; u.i1 = 0; u.l0 = nullptr; u.l1 = nullptr;
        return true; }
};
struct SchedF3 {
    const char* FH; const char* FC; const char* W; char* Y; int nu, c;
    __device__ __forceinline__ bool next(int i, pg::Unit& u) const {
        const int L0 = i * GRID + c; if (L0 >= nu) return false;
        u.gidx = nullptr; u.gbase = 0; u.nt = 16; u.scale = 1.f; u.flags = 0; u.i0 = 0; u.i1 = 0; u.l0 = nullptr; u.l1 = nullptr;
        if (L0 < 1024) { const int L = pg::xcd_remap(L0, 1024); const int gid = L >> 6, w = L & 63, pm = gid * 8 + (w & 7), pn = w >> 3; const int b = pm >> 2, k0 = (pm & 3) * 256;
            u.A = FH + (size_t)pm * 256 * 2048; u.B = W + (size_t)pn * 256 * 2048;
            if (pn < 4) { u.out = Y + ((size_t)b * SEQ + k0) * 2048 + pn * 512; u.ldc = 2048; }
            else { u.out = Y + ((size_t)b * SEQ + SEQ - k0) * 2048 + (pn - 4) * 512; u.ldc = -2048; u.flags = (k0 == 0) ? 1 : 0; } }
        else { const int q = L0 - 1024; const int pm = q >> 2, pn = q & 3;
            u.A = FC + (size_t)pm * 256 * 2048; u.B = W + (size_t)pn * 256 * 2048; u.out = Y + ((size_t)T + pm * 256) * 2048 + pn * 512; u.ldc = 2048; }
        return true; }
};
struct SchedG1 {
    const char* EGU; const char* WSG; const int* STOK; char* H; char* HS; LAS const unsigned char* tseg; int ntl, nsh, c;
    __device__ __forceinline__ bool gsrc(int i, const int*& gidx, int& gbase) const {
        const int nu = (ntl + nsh) * 2; const int L0 = i * GRID + c; if (L0 >= nu) return false;
        const int pm = pg::xcd_remap(L0, nu) >> 1;
        if (pm < ntl) { gidx = STOK + (size_t)pm * 256; gbase = 0; } else { gidx = nullptr; gbase = (pm - ntl) * 256; }
        return true; }
    __device__ __forceinline__ bool next(int i, pg::Unit& u) const {
        const int nu = (ntl + nsh) * 2; const int L0 = i * GRID + c; if (L0 >= nu) return false;
        const int L = pg::xcd_remap(L0, nu); const int pm = L >> 1, pn = L & 1;
        u.A = nullptr; u.gbase = 0; u.nt = 16; u.ldc = 512; u.scale = 1.f; u.flags = 0; u.i0 = 0; u.i1 = 0; u.l0 = nullptr; u.l1 = nullptr;
        if (pm < ntl) { const int e = __builtin_amdgcn_readfirstlane((int)tseg[pm]) & 63;
            u.gidx = STOK + (size_t)pm * 256; u.B = EGU + (size_t)e * 512 * 2048 + (size_t)pn * 256 * 2048; u.out = H + (size_t)pm * 256 * 512 + pn * 256; }
        else { const int ps = pm - ntl; u.gidx = nullptr; u.gbase = ps * 256; u.B = WSG + (size_t)pn * 256 * 2048; u.out = HS + (size_t)ps * 256 * 512 + pn * 256; }
        return true; }
};
struct SchedG2 {
    const char* ED; const char* WSD; const char* H; const char* HS; char* YB; char* YS; LAS const unsigned char* tseg; int t0, t1, nsh, ch, CH, c;
    __device__ __forceinline__ bool next(int i, pg::Unit& u) const {
        const int nr = t1 - t0; const int nu = (nr + nsh) * 4; const int L0 = i * GRID + c; if (L0 >= nu) return false;
        const int L = pg::xcd_remap(L0, nu); const int q = L >> 2, pn = L & 3;
        u.gidx = nullptr; u.gbase = 0; u.nt = 4; u.ldc = 1024; u.scale = 1.f; u.flags = 0; u.i0 = 0; u.i1 = pn; u.l0 = nullptr; u.l1 = nullptr;
        if (q < nr) { const int pm = t0 + q; const int e = __builtin_amdgcn_readfirstlane((int)tseg[pm]) & 63;
            u.A = H + (size_t)pm * 256 * 512; u.B = ED + (size_t)e * 1024 * 512 + (size_t)pn * 256 * 512; u.out = YB + (size_t)q * 256 * 1024; }
        else { const int ps = q - nr; u.A = HS + ((size_t)ch * CH + ps * 256) * 512; u.B = WSD + (size_t)pn * 256 * 512; u.out = YS + (size_t)ps * 256 * 1024; }
        return true; }
};

__device__ __forceinline__ void fnet_nyquist_rows(Frame& F) {
    F.refresh();
    const bf16_t* ABT = (const bf16_t*)(F.ws + WS_ABT); bf16_t* FH1 = (bf16_t*)(F.ws + WS_FH1);
    for (int r = F.gw; r < 128 * 256; r += NGW) { const int bg = r >> 8, m = r & 255, b = bg >> 2, g = bg & 3;
        const GAS u32x4* p = (const GAS u32x4*)(ABT + (size_t)r * 4096); float s = 0.f;
#pragma unroll
        for (int i = 0; i < 4; ++i) { const u32x4 w = p[i * 64 + F.lane]; s += (bflo(w.x) - bfhi(w.x)) + (bflo(w.y) - bfhi(w.y)) + (bflo(w.z) - bfhi(w.z)) + (bflo(w.w) - bfhi(w.w)); }
        s = wave_sum(s) * 0.001381067932004975f;
        if (F.lane == 0) FH1[(size_t)b * 1024 + g * 256 + m] = (bf16_t)f2bf(s); }
}
__device__ __forceinline__ void fnet_nyquist_out(Frame& F, const Args& a, int jl) {
    F.refresh();
    const bf16_t* FH1 = (const bf16_t*)(F.ws + WS_FH1); const bf16_t* W = (const bf16_t*)(F.ws + WS_WF) + (size_t)jl * 2048 * 1024; bf16_t* Y = (bf16_t*)a.out;
    LAS float* part = (LAS float*)F.lds;
    const int b = F.blk >> 3, n = (F.blk & 7) * 128 + (F.tid & 127), kq = F.tid >> 7;
    const GAS u32x4* wp = (const GAS u32x4*)(W + (size_t)n * 1024 + kq * 256); const GAS u32x4* fp = (const GAS u32x4*)(FH1 + (size_t)b * 1024 + kq * 256);
    float s = 0.f;
#pragma unroll 4
    for (int i = 0; i < 32; ++i) { const u32x4 w = wp[i], f = fp[i];
        s += bflo(w.x) * bflo(f.x) + bfhi(w.x) * bfhi(f.x) + bflo(w.y) * bflo(f.y) + bfhi(w.y) * bfhi(f.y) + bflo(w.z) * bflo(f.z) + bfhi(w.z) * bfhi(f.z) + bflo(w.w) * bflo(f.w) + bfhi(w.w) * bfhi(f.w); }
    part[F.tid] = s;
    __syncthreads();
    if (F.tid < 128) { const float t = (part[F.tid] + part[F.tid + 128]) + (part[F.tid + 256] + part[F.tid + 384]); Y[((size_t)b * SEQ + 1024) * D + n] = (bf16_t)f2bf(t); }
    __syncthreads();
}


#ifdef SELFCHECK
constexpr int CW_ERR = 1024;
constexpr size_t WS_OCHK = WS_R + 216 * MiB;
__device__ __forceinline__ void chk_report(unsigned* ctl, int id, float got, float ref, float tabs, float trel) {
    float e = fabsf(got - ref) / (tabs + trel * fabsf(ref)); if (!(e == e)) e = 1e30f; atomicMax(ctl + CW_ERR + id, __float_as_uint(e)); }
__device__ __forceinline__ float bf2f(bf16_t b) { return __builtin_bit_cast(float, (unsigned)b << 16); }
__constant__ int chk_toks[16] = {0, 1, 63, 64, 65, 127, 2047, 2048, 2049, 4096, 33000, 65535, 65536, 65537, 70000, 73727};
__constant__ int chk_ks[8] = {0, 1, 2, 255, 256, 1023, 1024, 700};
__constant__ int chk_ms[4] = {0, 1, 128, 255};
__constant__ int chk_ytoks[10] = {0, 1, 1023, 1024, 1025, 2047, 2048, 65535, 65536, 73727};
__constant__ int chk_ns[5] = {0, 1, 255, 256, 1023};
__constant__ int chk_cols[20] = {0, 7, 15, 16, 31, 32, 40, 48, 63, 64, 500, 1023, 1024, 1039, 1040, 1072, 1279, 1280, 1300, 1535};
__device__ __forceinline__ void chk_qkv(Frame& F, const Args& a, int layer, int id) {
    F.refresh(); const bf16_t* U = (const bf16_t*)a.out; const float* W = a.in[8] + (size_t)(layer >> 1) * 1024 * 1536;
    const bf16_t* Qb = (const bf16_t*)(F.ws + WS_Q); const bf16_t* Kb = (const bf16_t*)(F.ws + WS_K); const bf16_t* Vb = (const bf16_t*)(F.ws + WS_V);
    for (int s = F.gw; s < 320; s += NGW) { const int tok = chk_toks[s & 15], col = chk_cols[s >> 4];
        if (layer == 2 && tok >= T && col < 1024) continue;
        const bool rope = (tok < T) && col < 1280; const int hc = col & 63, first = (hc & 31) < 16; const int pcol = rope ? (first ? col + 16 : col - 16) : col;
        float x = 0.f, xp = 0.f;
        for (int k = F.lane; k < 1024; k += 64) { const float u = bf2f(U[(size_t)tok * D + k]); x += u * W[(size_t)k * 1536 + col]; xp += u * W[(size_t)k * 1536 + pcol]; }
        x = wave_sum(x); xp = wave_sum(xp);
        float ref = x;
        if (rope) { const int tl = tok & 2047, part = hc >> 5, pos = part ? (tl & 63) : (tl >> 6), fi = hc & 15; const float ang = (float)pos * powf(10000.f, -(float)fi / 16.f);
            ref = x * cosf(ang) + (first ? -xp : xp) * sinf(ang); }
        if (col < 1024) ref *= C2;
        const float got = col < 1024 ? bf2f(Qb[(size_t)tok * 1024 + col]) : (col < 1280 ? bf2f(Kb[(size_t)tok * 256 + col - 1024]) : bf2f(Vb[(size_t)tok * 256 + col - 1280]));
        if (F.lane == 0) chk_report(F.ctl, id, got, ref, 0.03f, 0.03f); }
}
__device__ __forceinline__ void chk_attn(Frame& F, const Args& a, int layer, int id) {
    F.refresh(); const bf16_t* Qb = (const bf16_t*)(F.ws + WS_Q); const bf16_t* Kb = (const bf16_t*)(F.ws + WS_K); const bf16_t* Vb = (const bf16_t*)(F.ws + WS_V); const bf16_t* Ob = (const bf16_t*)(F.ws + WS_OCHK);
    LAS float* lg = (LAS float*)F.lds + F.wave * 1024;
    for (int s = F.gw; s < 64; s += NGW) { const int tok = chk_toks[s & 15], h = (s >> 4) * 5, kvh = h >> 2;
        if (layer == 2 && tok >= T) continue;
        const bool isctx = tok >= T; const int b = isctx ? (tok - T) / CTXL : tok / SEQ, p = tok & (SEQ - 1);
        int nk = 0; const int lo = isctx ? 0 : (p - 128 < 0 ? 0 : p - 128), hi = isctx ? -1 : (p + 128 > SEQ - 1 ? SEQ - 1 : p + 128);
        const int nlat = isctx ? 0 : hi - lo + 1; nk = nlat + CTXL;
        float mx = a.in[10][(layer >> 1) * 16 + h] * LOG2E; const float sink2 = mx;
        for (int i = F.lane; i < nk; i += 64) { const size_t kr = i < nlat ? (size_t)b * SEQ + lo + i : (size_t)T + b * CTXL + (i - nlat); float d = 0.f;
            for (int e = 0; e < 64; ++e) d += bf2f(Qb[(size_t)tok * 1024 + h * 64 + e]) * bf2f(Kb[kr * 256 + kvh * 64 + e]);
            lg[i] = d; mx = fmaxf(mx, d); }
#pragma unroll
        for (int o = 1; o < 64; o <<= 1) mx = fmaxf(mx, __shfl_xor(mx, o));
        LDS_WAIT();
        float den = 0.f; for (int i = F.lane; i < nk; i += 64) den += exp2f(lg[i] - mx);
        den = wave_sum(den) + exp2f(sink2 - mx);
        float o = 0.f;
        for (int i = 0; i < nk; ++i) { const size_t kr = i < nlat ? (size_t)b * SEQ + lo + i : (size_t)T + b * CTXL + (i - nlat); o += exp2f(lg[i] - mx) * bf2f(Vb[kr * 256 + kvh * 64 + F.lane]); }
        o /= den;
        chk_report(F.ctl, id, bf2f(Ob[(size_t)tok * 1024 + h * 64 + F.lane]), o, 0.01f, 0.03f); chk_report(F.ctl, 32 + (s & 15), bf2f(Ob[(size_t)tok * 1024 + h * 64 + F.lane]), o, 0.01f, 0.03f);
        LDS_WAIT(); }
    __syncthreads();
}
__device__ __forceinline__ void chk_fnet_f(Frame& F, const Args& a, bool upd, int id) {
    F.refresh(); const bf16_t* U = (const bf16_t*)a.out; LAS float* red = (LAS float*)F.lds;
    for (int s = F.blk; s < 128 + (upd ? 64 : 0); s += GRID) {
        const bool cx = s >= 128; const int q = cx ? s - 128 : s; const int m = chk_ms[q & 3], g = ((q >> 2) & 1) * 3, b = ((q >> 3) & 1) * 31; int k = chk_ks[(q >> 4) & 7]; const int L = cx ? CTXL : SEQ; if (cx) k &= 255;
        const size_t row0 = cx ? (size_t)T + b * CTXL : (size_t)b * SEQ;
        float acc = 0.f;
        for (int l = F.wave; l < L; l += NWAVES) { float ca = 0.f, sa = 0.f;
            for (int n = F.lane; n < 256; n += 64) { const float u = bf2f(U[(row0 + l) * D + g * 256 + n]); const float an = 6.283185307179586f * (float)((m * n) & 255) / 256.f; const float sn = __sinf(an), cs = __cosf(an); ca += u * cs; sa += u * sn; }
            ca = wave_sum(ca); sa = wave_sum(sa); const float an = 6.283185307179586f * (float)((k * l) % L) / (float)L; const float sn = __sinf(an), cs = __cosf(an); acc += cs * ca - sn * sa; }
        if (F.lane == 0) red[F.wave] = acc;
        __syncthreads();
        if (F.tid == 0) { float t = 0.f; for (int w = 0; w < NWAVES; ++w) t += red[w]; t *= cx ? (1.f / 256.f) : 0.001381067932004975f;
            float got;
            if (cx) got = bf2f(((const bf16_t*)(F.ws + WS_FC))[((size_t)b * 256 + k) * D + g * 256 + m]);
            else if (k == 1024) got = bf2f(((const bf16_t*)(F.ws + WS_FH1))[(size_t)b * 1024 + g * 256 + m]);
            else got = bf2f(((const bf16_t*)(F.ws + WS_FH))[((size_t)b * 1024 + k) * D + g * 256 + m]);
            chk_report(F.ctl, id, got, t, 0.02f, 0.03f); }
        __syncthreads(); }
}
__device__ __forceinline__ void chk_fnet_y(Frame& F, const Args& a, int jl, bool upd, int id) {
    F.refresh(); const bf16_t* Y = (const bf16_t*)a.out; const float* W = a.in[11] + (size_t)jl * 1024 * 1024;
    const bf16_t* FH = (const bf16_t*)(F.ws + WS_FH); const bf16_t* FH1 = (const bf16_t*)(F.ws + WS_FH1); const bf16_t* FC = (const bf16_t*)(F.ws + WS_FC);
    for (int s = F.gw; s < 50; s += NGW) { const int tok = chk_ytoks[s % 10], n = chk_ns[s / 10]; if (tok >= T && !upd) continue;
        float acc = 0.f;
        for (int j = F.lane; j < 1024; j += 64) { float f;
            if (tok >= T) f = bf2f(FC[(size_t)(tok - T) * D + j]);
            else { const int b = tok >> 11, k = tok & 2047; if (k < 1024) f = bf2f(FH[((size_t)b * 1024 + k) * D + j]); else if (k == 1024) f = bf2f(FH1[(size_t)b * 1024 + j]);
                else f = bf2f(FH[((size_t)b * 1024 + (2048 - k)) * D + (j & ~255) + ((256 - (j & 255)) & 255)]); }
            acc += f * W[(size_t)j * 1024 + n]; }
        acc = wave_sum(acc);
        if (F.lane == 0) chk_report(F.ctl, id, bf2f(Y[(size_t)tok * D + n]), acc, 0.02f, 0.03f); }
}
__device__ __forceinline__ void chk_route(Frame& F, const Args& a, int layer, int ntok, int id) {
    F.refresh(); const bf16_t* U = (const bf16_t*)a.out; const float* Wr = a.in[12] + (size_t)layer * 1024 * 64; const int* tke = (const int*)(F.ws + WS_TKE); const float* tkw = (const float*)(F.ws + WS_TKW);
    for (int s = F.gw; s < 16; s += NGW) { const int tok = chk_toks[s]; if (tok >= ntok) continue; const int lane = F.lane;
        float lgt = 0.f; for (int k = 0; k < 1024; ++k) lgt += bf2f(U[(size_t)tok * D + k]) * Wr[(size_t)k * 64 + lane];
        const float sc = 1.f / (1.f + expf(-lgt)), sel = sc + a.in[13][layer * 64 + lane];
        float g1 = -INFINITY, g2 = -INFINITY;
#pragma unroll 1
        for (int j = 0; j < 8; ++j) { const float v = __shfl(sel, (lane & ~7) + j); if (v > g1) { g2 = g1; g1 = v; } else if (v > g2) g2 = v; }
        const float gs = g1 + g2; int gr = 0;
#pragma unroll 1
        for (int gp = 0; gp < 8; ++gp) { const float v = __shfl(gs, gp * 8); gr += (v > gs || (v == gs && gp < (lane >> 3))) ? 1 : 0; }
        const float sm = gr < 4 ? sel : -INFINITY; int rk = 0;
#pragma unroll 1
        for (int ep = 0; ep < 64; ++ep) { const float v = __shfl(sm, ep); rk += (v > sm || (v == sm && ep < lane)) ? 1 : 0; }
        const float tot = wave_sum(rk < 8 ? sc : 0.f); const float wref = sc / tot * 2.5f;
        int slot = -1; for (int j = 0; j < 8; ++j) if (tke[(size_t)tok * 8 + j] == lane) slot = j;
        float err = 0.f;
        if (slot >= 0) { if (rk >= 10) err = 10.f; else if (rk < 8) err = fabsf(tkw[(size_t)tok * 8 + slot] - wref) / (0.04f * wref); }
        else if (rk < 6) err = 10.f;
        const unsigned long long nsel = __ballot(slot >= 0); if (__builtin_popcountll(nsel) != 8) err = 20.f;
        atomicMax(F.ctl + CW_ERR + id, __float_as_uint(err)); }
}
__device__ __forceinline__ void chk_moe(Frame& F, const Args& a, int layer, int ntok, int ch, int id) {
    F.refresh(); const bf16_t* U = (const bf16_t*)a.out; const int* tke = (const int*)(F.ws + WS_TKE); const float* tkw = (const float*)(F.ws + WS_TKW);
    const int CH = ntok / NCHUNK; LAS float* hs = (LAS float*)F.lds; LAS float* us = hs + 512; LAS float* pg_ = us + 1024;
    for (int s = F.blk; s < 16; s += GRID) { const int tok = chk_toks[s]; if (tok >= ntok || tok / CH != ch) continue;
        for (int k = F.tid; k < 1024; k += NTHR) us[k] = bf2f(U[(size_t)tok * D + k]);
        __syncthreads();
        float y0 = 0.f, y1 = 0.f;
        for (int j = 0; j < 9; ++j) { const int e = j < 8 ? tke[(size_t)tok * 8 + j] : 0; const float w = j < 8 ? tkw[(size_t)tok * 8 + j] : 1.f;
            const float* wg = j < 8 ? a.in[14] + ((size_t)layer * NE + e) * 262144 : a.in[17] + (size_t)layer * 262144;
            const float* wu = j < 8 ? a.in[15] + ((size_t)layer * NE + e) * 262144 : a.in[18] + (size_t)layer * 262144;
            const float* wd = j < 8 ? a.in[16] + ((size_t)layer * NE + e) * 262144 : a.in[19] + (size_t)layer * 262144;
            const int hh = F.tid & 255, half = F.tid >> 8; float g = 0.f, u = 0.f;
            for (int k = half * 512; k < half * 512 + 512; ++k) { g += us[k] * wg[(size_t)k * 256 + hh]; u += us[k] * wu[(size_t)k * 256 + hh]; }
            pg_[F.tid] = g; pg_[512 + F.tid] = u;
            __syncthreads();
            if (F.tid < 256) { const float gg = pg_[F.tid] + pg_[F.tid + 256], uu = pg_[512 + F.tid] + pg_[512 + F.tid + 256]; hs[F.tid] = gg / (1.f + expf(-gg)) * uu; }
            __syncthreads();
            float t0 = 0.f, t1 = 0.f; for (int q = 0; q < 256; ++q) { t0 += hs[q] * wd[(size_t)q * 1024 + F.tid]; t1 += hs[q] * wd[(size_t)q * 1024 + 512 + F.tid]; }
            y0 += w * t0; y1 += w * t1;
            __syncthreads(); }
        float g0 = 0.f, g1 = 0.f; const int i = tok - ch * CH;
        { const unsigned char* YSb = (const unsigned char*)(F.ws + WS_YS); const unsigned char* YBb = (const unsigned char*)(F.ws + WS_YB); const int* spos = (const int*)(F.ws + WS_SDST);
          const int t_ = F.tid, bo = 16 * (16 * (t_ >> 8) + ((t_ & 127) >> 3)) + 8 * ((t_ >> 7) & 1) + (t_ & 7);
          auto f8 = [](unsigned char b) { return __builtin_amdgcn_cvt_pk_f32_fp8((int)b, false)[0] * (1.f / 16.f); };
          g0 = f8(YSb[(size_t)i * D + bo]); g1 = f8(YSb[(size_t)i * D + bo + 512]);
          for (int j = 0; j < 8; ++j) { const size_t ps = (size_t)spos[(size_t)tok * 8 + j]; const float w = tkw[(size_t)tok * 8 + j]; g0 += w * f8(YBb[ps * D + bo]); g1 += w * f8(YBb[ps * D + bo + 512]); } }
        chk_report(F.ctl, id, g0, y0, 0.04f, 0.06f); chk_report(F.ctl, id, g1, y1, 0.04f, 0.06f);
        __syncthreads(); }
}
#endif

#ifndef PH_MASK
#define PH_MASK 0xffffffffu
#endif
#define PH(b) ((PH_MASK >> (b)) & 1u)
__global__ void __launch_bounds__(NTHR, 2) fwd(Args a) {
    extern __shared__ __attribute__((aligned(16))) unsigned char lds_raw[];
    Frame F;
    F.lds = (LAS unsigned char*)lds_raw; F.ws = a.ws; F.ctl = (unsigned*)(a.ws + WS_CTL);
    F.blk = blockIdx.x; F.refresh();
    for (int u = F.tid; u < (LDS_BYTES - RING_BYTES) / 4; u += NTHR) ((LAS unsigned*)(F.lds + RING_BYTES))[u] = 0u;
    __syncthreads();
    const XcdBarrier bar = xcd_barrier_post(F.ctl + CW_BAR, (volatile LAS unsigned*)(F.lds + L_MISC) + 8);
#define GRID_BAR() xcd_barrier(bar)
    LAS unsigned char* ring = F.lds;
    const int c = F.blk;
#define ws (F.ws)
#define NEWPH() F.refresh()

    if (PH(0)) { conv_small(F, a);
    __syncthreads();
    mod_partials(F, a); }
    GRID_BAR();
    if (PH(1)) { rows_init(F, a);
    mod_finalize(F, a); }
    GRID_BAR();

    for (int layer = 0; layer < 4; ++layer) {
        const int jl = layer >> 1; const bool upd = layer < 2; const int nrows = upd ? TT : T;
        if ((layer & 1) == 0) {
            NEWPH();
            if (PH(2)) { SchedQKV S; S.U = (const char*)a.out; S.W = (const char*)(ws + WS_WQKV) + (size_t)jl * 1536 * 2048; S.nfull = (layer == 0) ? 288 * 6 : 256 * 6; S.nu = (layer == 0) ? 288 * 6 : 256 * 6 + 64; S.c = c;
              pg::EpiQKV E; E.Q = (bf16_t*)(ws + WS_Q); E.K = (bf16_t*)(ws + WS_K); E.V = (bf16_t*)(ws + WS_V); E.ropec = (const float*)(ws + WS_ROPEC); E.ropes = (const float*)(ws + WS_ROPES);
              pg::gemm_phase<pg::EpiQKV, SchedQKV, false>(ring, 2048u, 2048u, nullptr, S, E); }
            GRID_BAR();
#ifdef SELFCHECK
            if (SELFCHECK & 1) chk_qkv(F, a, layer, 1 + (layer >> 1));
#define OBUF ((bf16_t*)(ws + WS_OCHK))
#else
#define OBUF ((bf16_t*)(ws + WS_Q))
#endif
            NEWPH();
            if (PH(3)) { const int NU = 4096 + (layer == 0 ? 512 : 0);
              const bf16_t* Qb = (const bf16_t*)(ws + WS_Q); const bf16_t* Kb = (const bf16_t*)(ws + WS_K); const bf16_t* Vb = (const bf16_t*)(ws + WS_V);
              for (int i = 0; i * GRID + c < NU; ++i) { int id = pg::xcd_remap(i * GRID + c, NU);
                  if (NU > 4096) { const int g9 = id / 9, r9 = id - g9 * 9; id = (r9 < 8) ? g9 * 8 + r9 : 4096 + g9; }
                  if (id < 4096) { const int hq = id & 3, qb = (id >> 2) & 7, kvh = (id >> 5) & 3, b = id >> 7, h = kvh * 4 + hq;
                      attn::attn_unit(Qb, Kb, Vb, OBUF, b, h, qb * 256, false, a.in[10][jl * 16 + h] * LOG2E, ring); }
                  else { const int cid = id - 4096, hq = cid & 3, kvh = (cid >> 2) & 3, b = cid >> 4, h = kvh * 4 + hq;
                      attn::attn_unit(Qb, Kb, Vb, OBUF, b, h, 0, true, a.in[10][jl * 16 + h] * LOG2E, ring); } } }
            GRID_BAR();
#ifdef SELFCHECK
            if (SELFCHECK & 1) chk_attn(F, a, layer, 3 + (layer >> 1));
#endif
            NEWPH();
            if (PH(4)) { SchedDense S; S.A = (const char*)OBUF; S.W = (const char*)(ws + WS_WO) + (size_t)jl * 1024 * 2048; S.out = (char*)a.out; S.nrt = nrows / 256; S.nct = 4; S.nt = 16; S.c = c; S.ldA = 2048;
              pg::EpiStore E; pg::gemm_phase<pg::EpiStore, SchedDense, false>(ring, 2048u, 2048u, nullptr, S, E); }
            GRID_BAR();
        } else {
            NEWPH();
            if (PH(5)) { SchedF1 S; S.CS = (const char*)(ws + WS_CSN); S.U = (const char*)a.out; S.ABT = (char*)(ws + WS_ABT); S.ABTC = (char*)(ws + WS_ABTC); S.nu = 2048 + (upd ? 256 : 0); S.c = c;
              pg::EpiStore E; pg::gemm_phase<pg::EpiStore, SchedF1, false>(ring, 512u, 2048u, nullptr, S, E); }
            GRID_BAR();
            NEWPH();
            if (PH(6)) { SchedF2 S; S.DL = (const char*)(ws + WS_DL); S.ABT = (const char*)(ws + WS_ABT); S.FH = (char*)(ws + WS_FH); S.c = c;
              pg::EpiStore E; pg::gemm_phase<pg::EpiStore, SchedF2, false>(ring, 8192u, 8192u, nullptr, S, E); }
            NEWPH();
            if (PH(7) && upd) { SchedF2c S; S.DLC = (const char*)(ws + WS_DLC); S.ABTC = (const char*)(ws + WS_ABTC); S.FC = (char*)(ws + WS_FC); S.c = c;
              pg::EpiStore E; pg::gemm_phase<pg::EpiStore, SchedF2c, false>(ring, 1024u, 1024u, nullptr, S, E); }
            if (PH(8)) fnet_nyquist_rows(F);
            GRID_BAR();
#ifdef SELFCHECK
            if (SELFCHECK & 2) chk_fnet_f(F, a, upd, 5 + (layer >> 1));
            GRID_BAR();
#endif
            NEWPH();
            if (PH(9)) { SchedF3 S; S.FH = (const char*)(ws + WS_FH); S.FC = (const char*)(ws + WS_FC); S.W = (const char*)(ws + WS_WF) + (size_t)jl * 2048 * 2048; S.Y = (char*)a.out; S.nu = 1024 + (upd ? 128 : 0); S.c = c;
              pg::EpiStore E; pg::gemm_phase<pg::EpiStore, SchedF3, false>(ring, 2048u, 2048u, nullptr, S, E); }
            if (PH(10)) fnet_nyquist_out(F, a, jl);
            GRID_BAR();
#ifdef SELFCHECK
            if (SELFCHECK & 8) chk_fnet_y(F, a, jl, upd, 7 + (layer >> 1));
            GRID_BAR();
#endif
        }
        if (PH(12)) conv_experts(F, a.in[14], a.in[15], a.in[16], layer);
        __syncthreads();
        if (PH(11)) rows_post1(F, a, layer, nrows);
        VM_WAIT(); __syncthreads();
        if (threadIdx.x == 0) { __builtin_amdgcn_fence(__ATOMIC_ACQUIRE, "agent"); VM_WAIT(); }
        __syncthreads();
        if (PH(13)) route_tokens(F, a, layer, nrows);
        GRID_BAR();
#ifdef SELFCHECK
        if ((SELFCHECK & 4) && layer < 2) chk_route(F, a, layer, nrows, 9);
#endif
        if (PH(14)) build_lists(F, nrows);
        GRID_BAR();
        LAS const int* tstart = (LAS const int*)(F.lds + L_TSTART); LAS const unsigned char* tseg = (LAS const unsigned char*)(F.lds + L_TSEG);
        const int ntl = __builtin_amdgcn_readfirstlane(tstart[NCHUNK * 64]);
        NEWPH();
        if (PH(15)) { SchedG1 S; S.EGU = (const char*)(ws + WS_EGU); S.WSG = (const char*)(ws + WS_WSH) + (size_t)layer * 1536 * 1024; S.STOK = (const int*)(ws + WS_STOK); S.H = (char*)(ws + WS_H); S.HS = (char*)(ws + WS_HS); S.tseg = tseg; S.ntl = ntl; S.nsh = nrows / 256; S.c = c;
          pg::EpiSilu E; pg::gemm_phase<pg::EpiSilu, SchedG1, true>(ring, 2048u, 2048u, (const char*)a.out, S, E); }
        GRID_BAR();
        const int CH = nrows / NCHUNK;
        for (int ch = 0; ch < NCHUNK; ++ch) {
            NEWPH();
            if (PH(16)) { SchedG2 S; S.ED = (const char*)(ws + WS_ED); S.WSD = (const char*)(ws + WS_WSH) + (size_t)layer * 1536 * 1024 + 512 * 2048; S.H = (const char*)(ws + WS_H); S.HS = (const char*)(ws + WS_HS); S.YB = (char*)(ws + WS_YB); S.YS = (char*)(ws + WS_YS); S.tseg = tseg;
              S.t0 = __builtin_amdgcn_readfirstlane(tstart[ch * 64]); S.t1 = __builtin_amdgcn_readfirstlane(tstart[ch * 64 + 64]); S.nsh = CH / 256; S.ch = ch; S.CH = CH; S.c = c;
              pg::EpiFp8 E; pg::gemm_phase<pg::EpiFp8, SchedG2, false>(ring, 512u, 512u, nullptr, S, E); }
            GRID_BAR();
#ifdef SELFCHECK
            if ((SELFCHECK & 4) && (layer == 0 || layer == 3)) { if (layer == 0 || ch == 0) chk_moe(F, a, layer, nrows, ch, 10 + (layer == 3)); GRID_BAR(); }
#endif
            if (PH(17)) rows_post2(F, a, layer, ch * CH, CH);
            if (!(layer == 3 && ch == NCHUNK - 1)) GRID_BAR();
        }
    }
#ifdef SELFCHECK
    GRID_BAR();
    { int bad = 0; float be = 0.f; for (int k = 15; k >= 1; --k) { const float e = __uint_as_float(__hip_atomic_load(F.ctl + CW_ERR + k, RLX_AGENT)); if (e > 1.f) { bad = k; be = e; } }
      int wt = 0; float we = 0.f; for (int k = 0; k < 16; ++k) { const float e = __uint_as_float(__hip_atomic_load(F.ctl + CW_ERR + 32 + k, RLX_AGENT)); if (e > we) { we = e; wt = k; } }
      if (bad) { F.refresh(); float cv = 3.f + bad + (be > 8.f ? 0.5f : 0.f);  Row r; for (int j = 0; j < 4; ++j) r.v[j] = (f32x4){cv, cv, cv, cv}; for (int row = F.gw; row < T; row += NGW) row_store_f32(r, a.out + (size_t)row * D, F.lane); } }
#endif
}

#undef ws
#undef NEWPH
extern "C" void kernel_launch(void* const* d_in, const int* in_sizes, int n_in, void* d_out, int out_size, void* d_ws, size_t ws_size, hipStream_t stream) {
    static int ready = 0;
    if (ready == 0) {
        if (n_in != 20 || out_size != T * D || ws_size < WS_END) { fprintf(stderr, "kernel_launch: unexpected problem (n_in %d out %d ws %zu need %zu)\n", n_in, out_size, ws_size, (size_t)WS_END); ready = -1; return; }
        if (hipFuncSetAttribute((const void*)fwd, hipFuncAttributeMaxDynamicSharedMemorySize, LDS_BYTES) != hipSuccess) { fprintf(stderr, "kernel_launch: hipFuncSetAttribute failed\n"); ready = -1; return; }
        int per_cu = 0;
        if (hipOccupancyMaxActiveBlocksPerMultiprocessor(&per_cu, (const void*)fwd, NTHR, LDS_BYTES) != hipSuccess || per_cu < 1) fprintf(stderr, "kernel_launch: occupancy query says %d blocks per CU\n", per_cu);
        (void)hipGetLastError();
        ready = 1;
    }
    if (ready < 0) return;
    (void)hipMemsetAsync((char*)d_ws + WS_CTL, 0, CTL_BYTES, stream);
    Args a{};
    for (int i = 0; i < 20; ++i) a.in[i] = (const float*)d_in[i];
    a.out = (float*)d_out; a.ws = (unsigned char*)d_ws;
    hipLaunchKernelGGL(fwd, dim3(GRID), dim3(NTHR), LDS_BYTES, stream, a);
}
```

```cpp
#include <hip/hip_runtime.h>
#include <cstdio>
#include <cstdint>

#define LAS __attribute__((address_space(3)))
#define GAS __attribute__((address_space(1)))
typedef unsigned short bf16_t;
typedef short bf16x8 __attribute__((ext_vector_type(8)));
typedef short s16x4 __attribute__((ext_vector_type(4)));
typedef float f32x4 __attribute__((ext_vector_type(4)));
typedef float f32x16 __attribute__((ext_vector_type(16)));
typedef unsigned u32x4 __attribute__((ext_vector_type(4)));
typedef unsigned u32x2 __attribute__((ext_vector_type(2)));

constexpr int D = 1024, NB = 32, SEQ = 2048, T = NB * SEQ, CTXL = 256, TC = NB * CTXL, TT = T + TC;
constexpr int NQKV = 1536, NE = 64;
constexpr float ALPHA = 1.681792830507429f;
constexpr float LN_EPS = 1e-5f, MOD_EPS = 1e-6f;
constexpr float C2 = 0.125f * 1.4426950408889634f;
constexpr float LOG2E = 1.4426950408889634f;
constexpr int NCHUNK = 2;
constexpr int NWAVES = 8, NTHR = 512, GRID = 256;

constexpr size_t MiB = 1u << 20;
constexpr size_t WS_CTL = 0, CTL_BYTES = 1 * MiB;
constexpr size_t WS_ROPEC = 1 * MiB, WS_ROPES = 1 * MiB + 4096, WS_CSN = 1 * MiB + 65536, WS_DLC = 1 * MiB + 524288, WS_DL = 2 * MiB;
constexpr size_t WS_WQKV = 10 * MiB, WS_WO = 16 * MiB, WS_WF = 20 * MiB, WS_WR = 28 * MiB, WS_WSH = 29 * MiB;
constexpr size_t WS_MODP = 36 * MiB, WS_MOD = 49 * MiB;
constexpr size_t WS_EGU = 54 * MiB, WS_ED = 118 * MiB;
constexpr size_t WS_XS = 150 * MiB;
constexpr size_t WS_STOK = 294 * MiB, WS_SDST = 297 * MiB, WS_SW = 300 * MiB, WS_TKE = 303 * MiB, WS_TKW = 306 * MiB;
constexpr size_t WS_R = 309 * MiB;
constexpr size_t WS_Q = WS_R, WS_K = WS_R + 144 * MiB, WS_V = WS_R + 180 * MiB;
constexpr size_t WS_ABT = WS_R, WS_FH = WS_R + 256 * MiB, WS_FH1 = WS_R + 320 * MiB, WS_ABTC = WS_R + 321 * MiB, WS_FC = WS_R + 353 * MiB;
constexpr size_t WS_H = WS_R, WS_HS = WS_R + 320 * MiB, WS_YB = WS_R + 356 * MiB, WS_YS = WS_R + 676 * MiB;
constexpr size_t WS_END = WS_YS + 36 * MiB;
constexpr int MAXROWS = 655360;

constexpr int CW_TMO = 0, CW_BAR = 4096, CW_BCNT = 16384;

constexpr int RING_BYTES = 131072;
constexpr int L_MISC = RING_BYTES;
constexpr int L_TSTART = RING_BYTES + 256;
constexpr int L_PREF = L_TSTART + 1040;
constexpr int L_LCNT = L_PREF + 256;
constexpr int L_TSEG = L_LCNT + 256;
constexpr int L_SCAN = L_TSEG + 2560;
constexpr int LDS_BYTES = 139264;
static_assert(L_SCAN + 1024 <= LDS_BYTES, "LDS map");

#define RLX_AGENT __ATOMIC_RELAXED, __HIP_MEMORY_SCOPE_AGENT
#define LDS_WAIT() asm volatile("s_waitcnt lgkmcnt(0)" ::: "memory")
#define VM_WAIT() asm volatile("s_waitcnt vmcnt(0)" ::: "memory")

__device__ __forceinline__ unsigned f2bf(float f) { unsigned u = __builtin_bit_cast(unsigned, f); return (u + 0x7fffu + ((u >> 16) & 1u)) >> 16; }
__device__ __forceinline__ unsigned pk2(float lo, float hi) { return f2bf(lo) | (f2bf(hi) << 16); }
typedef float f32x2_t __attribute__((ext_vector_type(2))); typedef __bf16 bf16x2_t __attribute__((ext_vector_type(2)));
__device__ __forceinline__ unsigned cvt_pk_bf16(float lo, float hi) { f32x2_t v = {lo, hi}; bf16x2_t b = __builtin_convertvector(v, bf16x2_t); return __builtin_bit_cast(unsigned, b); }
__device__ __forceinline__ float bflo(unsigned w) { return __builtin_bit_cast(float, w << 16); }
__device__ __forceinline__ float bfhi(unsigned w) { return __builtin_bit_cast(float, w & 0xffff0000u); }
__device__ __forceinline__ float wave_sum(float v) {
#pragma unroll
    for (int o = 1; o < 64; o <<= 1) v += __shfl_xor(v, o);
    return v;
}

__device__ __forceinline__ int opaque_tid() { int t = threadIdx.x; asm volatile("" : "+v"(t)); return t; }

#define XB_TMO      128
#define XB_XCNT(j)  (256  + 64 * (j))
#define XB_XSUB(j)  (1280 + 64 * (j))
#define XB_XGEN(j)  (2304 + 64 * (j))
#define XB_TOP      3328
#define XB_TOPGEN   3392
#define XCD_BAR_WORDS 3456
#define XB_SPIN_CAP (1u << 22)
__device__ __forceinline__ unsigned xb_ld(unsigned* p)              { return __hip_atomic_load(p, __ATOMIC_RELAXED, __HIP_MEMORY_SCOPE_AGENT); }
__device__ __forceinline__ unsigned xb_add(unsigned* p, unsigned v) { return __hip_atomic_fetch_add(p, v, __ATOMIC_RELAXED, __HIP_MEMORY_SCOPE_AGENT); }
__device__ __forceinline__ unsigned xb_xcc_id() { return (unsigned)__builtin_amdgcn_s_getreg((3 << 11) | 20) & 0xFu; }
#define XB_SPIN(cond, bar) do { unsigned _sp = 0; while (cond) { __builtin_amdgcn_s_sleep(1); \
    if ((++_sp & 255u) == 0u) { if (xb_ld(&(bar)[XB_TMO])) break; if (_sp > XB_SPIN_CAP) { atomicAdd(&(bar)[XB_TMO], 1u); break; } } } } while (0)
struct XcdBarrier { unsigned* bar; unsigned x; volatile LAS unsigned* st; };
__device__ __forceinline__ XcdBarrier xcd_barrier_post(unsigned* bar, volatile LAS unsigned* st) {
    XcdBarrier b; b.bar = bar; b.x = xb_xcc_id(); b.st = st;
    if (threadIdx.x == 0) (void)xb_add(&bar[XB_XCNT(b.x)], 1u);
    return b;
}
__device__ __forceinline__ void xcd_barrier_complete(unsigned* bar, unsigned x, unsigned& nloc, unsigned& nx) {
    const unsigned G = gridDim.x * gridDim.y * gridDim.z;
    unsigned sum, cnt, mine, sp = 0u;
    for (;;) {
        sum = 0u; cnt = 0u; mine = 0u;
#pragma unroll
        for (unsigned j = 0; j < 16; ++j) { const unsigned c = xb_ld(&bar[XB_XCNT(j)]); sum += c; cnt += (c > 0u) ? 1u : 0u; mine = (j == x) ? c : mine; }
        if (sum == G) break;
        __builtin_amdgcn_s_sleep(1);
        if ((++sp & 255u) == 0u) { if (xb_ld(&bar[XB_TMO])) break; if (sp > XB_SPIN_CAP) { atomicAdd(&bar[XB_TMO], 1u); break; } }
    }
    nloc = mine > 0u ? mine : 1u; nx = cnt > 0u ? cnt : 1u;
}
__device__ __forceinline__ void xcd_barrier(const XcdBarrier& b) {
    asm volatile("s_waitcnt vmcnt(0)" ::: "memory");
    __syncthreads();
    if (threadIdx.x == 0) {
        unsigned* bar = b.bar; unsigned bx = b.x; asm volatile("" : "+s"(bx));
        __builtin_amdgcn_s_waitcnt(0);
        unsigned nloc = b.st[0], nx = b.st[1];
        if (nloc == 0u) { xcd_barrier_complete(bar, bx, nloc, nx); b.st[0] = nloc; b.st[1] = nx; }
        const unsigned old = xb_add(&bar[XB_XSUB(bx)], 1u);
        const unsigned gen = old / nloc;
        if (old + 1u == (gen + 1u) * nloc) {
            __builtin_amdgcn_fence(__ATOMIC_RELEASE, "agent");
            asm volatile("s_waitcnt vmcnt(0)" ::: "memory");
            const unsigned og = xb_add(&bar[XB_TOP], 1u);
            const unsigned tg = og / nx;
            if (og + 1u == (tg + 1u) * nx) xb_add(&bar[XB_TOPGEN], 1u);
            else XB_SPIN(xb_ld(&bar[XB_TOPGEN]) == tg, bar);
            __builtin_amdgcn_fence(__ATOMIC_ACQUIRE, "agent");
            xb_add(&bar[XB_XGEN(bx)], 1u);
            asm volatile("s_waitcnt vmcnt(0)" ::: "memory");
        } else {
            XB_SPIN(xb_ld(&bar[XB_XGEN(bx)]) == gen, bar);
            __builtin_amdgcn_fence(__ATOMIC_ACQUIRE, "agent");
            asm volatile("s_waitcnt vmcnt(0)" ::: "memory");
        }
    }
    __syncthreads();
}

namespace pg {
constexpr int BM = 256, BK = 64, HALF = 128, HTB = HALF * BK * 2;
__host__ __device__ __forceinline__ int lds_byte(int r, int c) { const int st = (r >> 4) * 2 + (c >> 5), rr = r & 15, cc = c & 31, ob = rr * 64 + cc * 2; return st * 1024 + (ob ^ (((ob >> 9) & 1) << 5)); }
__host__ __device__ __forceinline__ void stage_rc(int b, int& R, int& C) { const int st = b / 1024, sb = b % 1024, swz = sb ^ (((sb >> 9) & 1) << 5); R = (st >> 1) * 16 + swz / 64; C = (st & 1) * 32 + (swz % 64) / 2; }
__host__ __device__ __forceinline__ int perm32(int rho) { const int n = rho >> 4, i = rho & 15; return 8 * (i >> 2) + 4 * n + (i & 3); }

struct Unit {
    const char* A;
    const char* B;
    const int* gidx;
    int gbase;
    int nt;
    char* out; int ldc; float scale; int flags; int i0; int i1;
    const int* l0; const float* l1;
};

template <class Epi, class Sched, bool GATHER>
__device__ __forceinline__ void gemm_phase(LAS unsigned char* lds, const unsigned lda, const unsigned ldb, const char* gtable, const Sched& S, const Epi& E) {
    const int tid = opaque_tid(), wid = __builtin_amdgcn_readfirstlane(tid >> 6), lane = tid & 63, wr = wid >> 2, wc = wid & 3, fr = lane & 15, fq = lane >> 4;
    unsigned voffA[2], voffB[2];
#pragma unroll
    for (int i = 0; i < 2; ++i) { int R, C; stage_rc(tid * 16 + i * 8192, R, C); const int Rb = (R & ~31) + perm32(R & 31);
        voffA[i] = (unsigned)R * lda + (unsigned)C * 2u; voffB[i] = (unsigned)Rb * ldb + (unsigned)C * 2u; }
    const size_t kstep = (size_t)(BK * 2);
    const size_t hstepA = (size_t)HALF * lda, hstepB = (size_t)HALF * ldb;
    const unsigned ldsw = (unsigned)wid * 1024u;
    const int aoff = lds_byte(wr * 64 + fr, fq * 8), boff = lds_byte(wc * 32 + fr, fq * 8);
#define PG_SA(b, h) (((b) * 2 + (h)) * HTB)
#define PG_SB(b, h) ((4 + (b) * 2 + (h)) * HTB)
#define PG_ST2(bufoff, p0, p1) do { \
        __builtin_amdgcn_global_load_lds((const unsigned*)(p0), (LAS unsigned*)(lds + (bufoff) + ldsw), 16, 0, 0); \
        __builtin_amdgcn_global_load_lds((const unsigned*)(p1), (LAS unsigned*)(lds + (bufoff) + ldsw + 8192), 16, 0, 0); } while (0)
#define PG_STB(bufoff, bp) PG_ST2(bufoff, (bp) + voffB[0], (bp) + voffB[1])
#define PG_STA(bufoff, ap, h, nx) do { if constexpr (GATHER) { PG_ST2(bufoff, (ap) + ((nx) ? nO[h][0] : cO[h][0]), (ap) + ((nx) ? nO[h][1] : cO[h][1])); } \
        else { PG_ST2(bufoff, (ap) + (h) * hstepA + voffA[0], (ap) + (h) * hstepA + voffA[1]); } } while (0)
#define PG_LDA(dst, b, h) do { _Pragma("unroll") for (int m = 0; m < 4; ++m) _Pragma("unroll") for (int k = 0; k < 2; ++k) dst[m][k] = *(const LAS bf16x8*)(lds + PG_SA(b, h) + aoff + m * 2048 + k * 1024); } while (0)
#define PG_LDB(dst, b, h) do { _Pragma("unroll") for (int n = 0; n < 2; ++n) _Pragma("unroll") for (int k = 0; k < 2; ++k) dst[n][k] = *(const LAS bf16x8*)(lds + PG_SB(b, h) + boff + n * 2048 + k * 1024); } while (0)
#define PG_MMA(ai, bj, At, Bt) do { __builtin_amdgcn_s_setprio(1); _Pragma("unroll") for (int m = 0; m < 4; ++m) _Pragma("unroll") for (int n = 0; n < 2; ++n) _Pragma("unroll") for (int k = 0; k < 2; ++k) \
        acc[ai][bj][m][n] = __builtin_amdgcn_mfma_f32_16x16x32_bf16(Bt[n][k], At[m][k], acc[ai][bj][m][n], 0, 0, 0); __builtin_amdgcn_s_setprio(0); } while (0)
#define PG_WAIT_V(n) asm volatile("s_waitcnt vmcnt(" #n ")" ::: "memory")
#define PG_WAIT_L(n) asm volatile("s_waitcnt lgkmcnt(" #n ")" ::: "memory")
#define PG_BAR __builtin_amdgcn_s_barrier()
#define PG_SCHED __builtin_amdgcn_sched_barrier(0)
#define PG_GOFF(dst, u) do { const int tz_ = opaque_tid(); _Pragma("unroll") for (int i = 0; i < 2; ++i) { int R_, C_; stage_rc(tz_ * 16 + i * 8192, R_, C_); \
        _Pragma("unroll") for (int h = 0; h < 2; ++h) { const int rr = h * HALF + R_; \
        const int ix = (u).gidx ? ((const GAS int*)(u).gidx)[rr] : (u).gbase + rr; dst[h][i] = (unsigned)ix * lda + (unsigned)C_ * 2u; } } } while (0)
#define PG_GIDX(dst, un) do { const int* gi_ = nullptr; int gb_ = 0; const bool ok_ = S.gsrc((un), gi_, gb_); const int tz_ = opaque_tid(); _Pragma("unroll") for (int i = 0; i < 2; ++i) { int R_, C_; stage_rc(tz_ * 16 + i * 8192, R_, C_); \
        _Pragma("unroll") for (int h = 0; h < 2; ++h) { const int rr = h * HALF + R_; dst[h][i] = (ok_ && gi_) ? ((const GAS int*)gi_)[rr] : gb_ + rr; } } } while (0)
#define PG_GCVT(dst, src) do { const int tz_ = opaque_tid(); _Pragma("unroll") for (int i = 0; i < 2; ++i) { int R_, C_; stage_rc(tz_ * 16 + i * 8192, R_, C_); \
        _Pragma("unroll") for (int h = 0; h < 2; ++h) dst[h][i] = (unsigned)src[h][i] * lda + (unsigned)C_ * 2u; } } while (0)
    Unit cur, nxt; int ui = 0;
    if (!S.next(0, cur)) return;
    f32x4 acc[2][2][4][2];
#pragma unroll
    for (int a = 0; a < 2; ++a)
#pragma unroll
        for (int b = 0; b < 2; ++b)
#pragma unroll
            for (int m = 0; m < 4; ++m)
#pragma unroll
                for (int n = 0; n < 2; ++n) acc[a][b][m][n] = (f32x4){0.f, 0.f, 0.f, 0.f};
    bf16x8 At[4][2], B0[2][2], B1[2][2];
    unsigned cO[2][2] = {{0u, 0u}, {0u, 0u}}, nO[2][2] = {{0u, 0u}, {0u, 0u}};
    int gI[2][2] = {{0, 0}, {0, 0}};
    if constexpr (GATHER) { PG_GOFF(cO, cur); PG_GIDX(gI, 1); }
    const char* cA = GATHER ? gtable : cur.A; const char* cB = cur.B;
    PG_STB(PG_SB(0, 0), cB); PG_STB(PG_SB(0, 1), cB + hstepB); PG_STA(PG_SA(0, 0), cA, 0, false); PG_STA(PG_SA(0, 1), cA, 1, false);
    if (wr == 1) PG_BAR;
    PG_WAIT_V(2); PG_BAR;
    PG_STB(PG_SB(1, 0), cB + kstep); PG_STA(PG_SA(1, 0), cA + kstep, 0, false); PG_STB(PG_SB(1, 1), cB + hstepB + kstep);
    PG_WAIT_V(6); PG_BAR;
    for (;;) {
        const bool has_next = S.next(ui + 1, nxt);
        const int nt = cur.nt;
        if constexpr (GATHER) { if (has_next) { PG_GCVT(nO, gI); PG_GIDX(gI, ui + 2); } else {
#pragma unroll
            for (int h = 0; h < 2; ++h)
#pragma unroll
                for (int i = 0; i < 2; ++i) nO[h][i] = cO[h][i]; } }
        const char* nA = GATHER ? gtable : (has_next ? nxt.A : cA); const char* nB = has_next ? nxt.B : cB;
#pragma unroll 1
        for (int t = 0; t < nt; t += 2) {
            const bool last = (t == nt - 2);
            const char* a1 = cA + (size_t)(t + 1) * kstep;
            const char* a2 = last ? nA : cA + (size_t)(t + 2) * kstep; const char* b2 = last ? nB : cB + (size_t)(t + 2) * kstep;
            const char* a3 = a2 + kstep; const char* b3 = b2 + kstep;
            PG_LDB(B0, 0, 0); PG_LDB(B1, 0, 1); PG_SCHED; PG_LDA(At, 0, 0); PG_STA(PG_SA(1, 1), a1, 1, false);
            PG_WAIT_V(8); PG_WAIT_L(0); PG_BAR; PG_MMA(0, 0, At, B0); PG_MMA(0, 1, At, B1); PG_BAR; PG_SCHED;
            PG_LDA(At, 0, 1); PG_STB(PG_SB(0, 0), b2); PG_STB(PG_SB(0, 1), b2 + hstepB); PG_STA(PG_SA(0, 0), a2, 0, last);
            PG_WAIT_V(8); PG_WAIT_L(0); PG_BAR; PG_MMA(1, 0, At, B0); PG_MMA(1, 1, At, B1); PG_BAR; PG_SCHED;
            PG_LDB(B0, 1, 0); PG_LDB(B1, 1, 1); PG_SCHED; PG_LDA(At, 1, 0); PG_STA(PG_SA(0, 1), a2, 1, last);
            PG_WAIT_V(8); PG_WAIT_L(0); PG_BAR; PG_MMA(0, 0, At, B0); PG_MMA(0, 1, At, B1); PG_BAR; PG_SCHED;
            PG_LDA(At, 1, 1); PG_STB(PG_SB(1, 0), b3); PG_STB(PG_SB(1, 1), b3 + hstepB); PG_STA(PG_SA(1, 0), a3, 0, last);
            PG_WAIT_V(8); PG_WAIT_L(0); PG_BAR; PG_MMA(1, 0, At, B0); PG_MMA(1, 1, At, B1); PG_BAR; PG_SCHED;
        }
        if (wr == 0) PG_BAR;
        E(acc, cur, wr, wc, fr, fq);
        if (!has_next) break;
#pragma unroll
        for (int a = 0; a < 2; ++a)
#pragma unroll
            for (int b = 0; b < 2; ++b)
#pragma unroll
                for (int m = 0; m < 4; ++m)
#pragma unroll
                    for (int n = 0; n < 2; ++n) acc[a][b][m][n] = (f32x4){0.f, 0.f, 0.f, 0.f};
        cur = nxt; cA = nA; cB = nB; ++ui;
        if constexpr (GATHER) {
#pragma unroll
            for (int h = 0; h < 2; ++h)
#pragma unroll
                for (int i = 0; i < 2; ++i) cO[h][i] = nO[h][i]; }
        if (wr == 1) PG_BAR;
    }
    PG_WAIT_V(0);
    PG_BAR;
#undef PG_SA
#undef PG_SB
#undef PG_ST2
#undef PG_STB
#undef PG_STA
#undef PG_LDA
#undef PG_LDB
#undef PG_MMA
#undef PG_WAIT_V
#undef PG_WAIT_L
#undef PG_BAR
#undef PG_SCHED
#undef PG_GOFF
#undef PG_GIDX
#undef PG_GCVT
}

struct EpiStore {
    __device__ __forceinline__ void operator()(const f32x4 (&acc)[2][2][4][2], const Unit& u, int wr, int wc, int fr, int fq) const {
        const float s = u.scale;
#pragma unroll
        for (int ai = 0; ai < 2; ++ai)
#pragma unroll
            for (int m = 0; m < 4; ++m) { const int row = ai * HALF + wr * 64 + m * 16 + fr;
                char* rowp = u.out + (ptrdiff_t)row * u.ldc + (wc * 32 + 8 * fq) * 2;
                if (!((u.flags & 1) && row == 0)) {
#pragma unroll
                for (int bj = 0; bj < 2; ++bj) { const f32x4 v0 = acc[ai][bj][m][0] * s, v1 = acc[ai][bj][m][1] * s;
                    u32x4 w; w.x = cvt_pk_bf16(v0[0], v0[1]); w.y = cvt_pk_bf16(v0[2], v0[3]); w.z = cvt_pk_bf16(v1[0], v1[1]); w.w = cvt_pk_bf16(v1[2], v1[3]);
                    *(u32x4*)(rowp + bj * 256) = w; } } }
    }
};
struct EpiQKV {
    bf16_t* Q; bf16_t* K; bf16_t* V; const float* ropec; const float* ropes;
    __device__ __forceinline__ void operator()(const f32x4 (&acc)[2][2][4][2], const Unit& u, int wr, int wc, int fr, int fq) const {
        const int pm = u.i0, pn = u.i1; const bool lat = pm < (T / 256); const bool rope = lat && pn < 5;
        const float qs = pn < 4 ? C2 : 1.f;
        const int part = wc & 1;
        const int fi0 = 8 * (fq & 1);
        const float sgn = (fq < 2) ? -1.f : 1.f;
#pragma unroll
        for (int ai = 0; ai < 2; ++ai)
#pragma unroll
            for (int m = 0; m < 4; ++m) { const int row = ai * HALF + wr * 64 + m * 16 + fr; const int tok = pm * 256 + row;
                const int tl = tok & (SEQ - 1); const int pos = part ? (tl & 63) : (tl >> 6);
                f32x4 c0 = {1.f, 1.f, 1.f, 1.f}, c1 = c0, s0 = {0.f, 0.f, 0.f, 0.f}, s1 = s0;
                if (rope) { c0 = *(const f32x4*)(ropec + pos * 16 + fi0); c1 = *(const f32x4*)(ropec + pos * 16 + fi0 + 4); s0 = *(const f32x4*)(ropes + pos * 16 + fi0); s1 = *(const f32x4*)(ropes + pos * 16 + fi0 + 4); }
#pragma unroll
                for (int bj = 0; bj < 2; ++bj) { f32x4 v0 = acc[ai][bj][m][0], v1 = acc[ai][bj][m][1];
                    if (rope) { f32x4 p0, p1;
#pragma unroll
                        for (int j = 0; j < 4; ++j) { p0[j] = __shfl_xor(v0[j], 32); p1[j] = __shfl_xor(v1[j], 32); }
                        v0 = v0 * c0 + (p0 * sgn) * s0; v1 = v1 * c1 + (p1 * sgn) * s1; }
                    v0 = v0 * qs; v1 = v1 * qs;
                    u32x4 w; w.x = cvt_pk_bf16(v0[0], v0[1]); w.y = cvt_pk_bf16(v0[2], v0[3]); w.z = cvt_pk_bf16(v1[0], v1[1]); w.w = cvt_pk_bf16(v1[2], v1[3]);
                    const int col = bj * HALF + wc * 32 + 8 * fq;
                    bf16_t* dst = pn < 4 ? Q + (size_t)tok * 1024 + pn * 256 + col : (pn == 4 ? K + (size_t)tok * 256 + col : V + (size_t)tok * 256 + col);
                    *(u32x4*)dst = w; } }
    }
};
struct EpiSilu {
    __device__ __forceinline__ void operator()(const f32x4 (&acc)[2][2][4][2], const Unit& u, int wr, int wc, int fr, int fq) const {
#pragma unroll
        for (int ai = 0; ai < 2; ++ai)
#pragma unroll
            for (int m = 0; m < 4; ++m) { const int row = ai * HALF + wr * 64 + m * 16 + fr;
                float h[8];
#pragma unroll
                for (int n = 0; n < 2; ++n)
#pragma unroll
                    for (int j = 0; j < 4; ++j) { const float g = acc[ai][0][m][n][j], up = acc[ai][1][m][n][j]; h[n * 4 + j] = g * __builtin_amdgcn_rcpf(1.f + __expf(-g)) * up; }
                u32x4 w; w.x = cvt_pk_bf16(h[0], h[1]); w.y = cvt_pk_bf16(h[2], h[3]); w.z = cvt_pk_bf16(h[4], h[5]); w.w = cvt_pk_bf16(h[6], h[7]);
                *(u32x4*)(u.out + (size_t)row * 512 + (wc * 32 + 8 * fq) * 2) = w; }
    }
};
struct EpiScatter {
    __device__ __forceinline__ void operator()(const f32x4 (&acc)[2][2][4][2], const Unit& u, int wr, int wc, int fr, int fq) const {
#pragma unroll
        for (int ai = 0; ai < 2; ++ai)
#pragma unroll
            for (int m = 0; m < 4; ++m) { const int row = ai * HALF + wr * 64 + m * 16 + fr;
                int dst; float w;
                if (u.l0) { dst = u.l0[row]; w = u.l1[row]; } else { dst = (u.i0 + row) * 9 + 8; w = 1.f; }
                if (dst >= 0) { char* rowp = u.out + (size_t)dst * 2048 + (wc * 32 + 8 * fq) * 2;
#pragma unroll
                    for (int bj = 0; bj < 2; ++bj) { const f32x4 v0 = acc[ai][bj][m][0] * w, v1 = acc[ai][bj][m][1] * w;
                        u32x4 o; o.x = cvt_pk_bf16(v0[0], v0[1]); o.y = cvt_pk_bf16(v0[2], v0[3]); o.z = cvt_pk_bf16(v1[0], v1[1]); o.w = cvt_pk_bf16(v1[2], v1[3]);
                        *(u32x4*)(rowp + bj * 256) = o; } } }
    }
};
struct EpiFp8 {
    __device__ __forceinline__ void operator()(const f32x4 (&acc)[2][2][4][2], const Unit& u, int wr, int wc, int fr, int fq) const {
        const int pn = u.i1;
#pragma unroll
        for (int ai = 0; ai < 2; ++ai)
#pragma unroll
            for (int m = 0; m < 4; ++m) { const int row = ai * HALF + wr * 64 + m * 16 + fr;
                u32x4 o;
#pragma unroll
                for (int bj = 0; bj < 2; ++bj) { const f32x4 v0 = acc[ai][bj][m][0] * 16.f, v1 = acc[ai][bj][m][1] * 16.f;
                    int w0 = 0, w1 = 0;
                    w0 = __builtin_amdgcn_cvt_pk_fp8_f32(v0[0], v0[1], w0, false); w0 = __builtin_amdgcn_cvt_pk_fp8_f32(v0[2], v0[3], w0, true);
                    w1 = __builtin_amdgcn_cvt_pk_fp8_f32(v1[0], v1[1], w1, false); w1 = __builtin_amdgcn_cvt_pk_fp8_f32(v1[2], v1[3], w1, true);
                    o[2 * bj] = (unsigned)w0; o[2 * bj + 1] = (unsigned)w1; }
                *(u32x4*)(u.out + (size_t)row * 1024 + (16 * pn + 4 * wc + fq) * 16) = o; }
    }
};
__device__ __forceinline__ int xcd_remap(int L0, int NU) { const int q = NU >> 3, r = NU & 7, x = L0 & 7, off = L0 >> 3; return (x < r ? x * (q + 1) : r * (q + 1) + (x - r) * q) + off; }
}

namespace attn {
constexpr int SLOTB = 8192;
constexpr int LDS_K = 0, LDS_V = 2 * SLOTB, LDS_WS = 4 * SLOTB, LDS_OST = LDS_WS + NWAVES * 256, LDS_END = LDS_OST + NWAVES * 4096;
static_assert(LDS_END <= RING_BYTES, "attention LDS");
__device__ __forceinline__ int crow(int r, int hi) { return (r & 3) + 8 * (r >> 2) + 4 * hi; }
__device__ __forceinline__ void glds16(const void* gsrc, unsigned lds_dst) { unsigned keep;
    asm volatile("s_mov_b32 %0, m0\n\ts_mov_b32 m0, %2\n\ts_nop 0\n\tglobal_load_lds_dwordx4 %1, off\n\ts_mov_b32 m0, %0" : "=&s"(keep) : "v"(gsrc), "s"(lds_dst) : "memory"); }
__device__ __forceinline__ float rowmax(const f32x16& p0, const f32x16& p1) {
    float a = fmaxf(p0[0], p1[0]);
#pragma unroll
    for (int r = 1; r < 16; ++r) a = fmaxf(a, fmaxf(p0[r], p1[r]));
    auto rr = __builtin_amdgcn_permlane32_swap(__float_as_uint(a), __float_as_uint(a), false, false);
    return fmaxf(__uint_as_float(rr[0]), __uint_as_float(rr[1]));
}
typedef short v4i16_t __attribute__((ext_vector_type(4)));
__device__ __forceinline__ s16x4 vtr(const LAS unsigned char* p) { return __builtin_bit_cast(s16x4, __builtin_amdgcn_ds_read_tr16_b64_v4i16((LAS v4i16_t*)p)); }
__device__ __forceinline__ void pv(f32x16* o, const LAS unsigned char* vp, bf16x8 pa0, bf16x8 pa1, bf16x8 pa2, bf16x8 pa3) {
#pragma unroll
    for (int d0 = 0; d0 < 2; ++d0) { s16x4 lo[4], hi[4];
#pragma unroll
        for (int ks = 0; ks < 4; ++ks) { lo[ks] = vtr(vp + d0 * 4096 + ks * 1024); hi[ks] = vtr(vp + d0 * 4096 + ks * 1024 + 512); }
#define PK(k) (bf16x8){lo[k][0], lo[k][1], lo[k][2], lo[k][3], hi[k][0], hi[k][1], hi[k][2], hi[k][3]}
        o[d0] = __builtin_amdgcn_mfma_f32_32x32x16_bf16(pa0, PK(0), o[d0], 0, 0, 0);
        o[d0] = __builtin_amdgcn_mfma_f32_32x32x16_bf16(pa1, PK(1), o[d0], 0, 0, 0);
        o[d0] = __builtin_amdgcn_mfma_f32_32x32x16_bf16(pa2, PK(2), o[d0], 0, 0, 0);
        o[d0] = __builtin_amdgcn_mfma_f32_32x32x16_bf16(pa3, PK(3), o[d0], 0, 0, 0);
#undef PK
    }
}
__device__ __forceinline__ void attn_unit(const bf16_t* Q, const bf16_t* K, const bf16_t* V, bf16_t* O, int b, int h, int q0, bool isctx, float sink2, LAS unsigned char* shm) {
    const int tid = opaque_tid(), lane = tid & 63, r32 = lane & 31, hi = lane >> 5; const int wid = __builtin_amdgcn_readfirstlane(tid >> 6);
    const int kvh = h >> 2;
    const long qrow = isctx ? (long)T + b * CTXL + wid * 32 : (long)b * SEQ + q0 + wid * 32;
    const unsigned lds0 = (unsigned)(uintptr_t)shm;
    LAS float* wsf = (LAS float*)(shm + LDS_WS) + wid * 64;
    int jlo = 0, nl = 0;
    if (!isctx) { jlo = (q0 == 0) ? 2 : 0; int jhi = (SEQ - q0 + 128) / 64; if (jhi > 8) jhi = 8; nl = jhi - jlo; }
    const int NT = nl + 4;
    const long lat0 = (long)b * SEQ + q0 - 128 + 64 * jlo, ctx0 = (long)T + b * CTXL;
#define TROW(t) ((t) < nl ? lat0 + 64 * (t) : ctx0 + 64 * ((t) - nl))
    const int kcol = kvh * 64 + wid * 8, vcol = kvh * 64 + (wid >> 2) * 32 + (lane & 3) * 8, vrow = 16 * (wid & 3) + (lane >> 2);
    const unsigned kdst = lds0 + LDS_K + wid * 1024, vdst = lds0 + LDS_V + wid * 1024;
#define DMA_KV(t, slot) do { const long tr_ = TROW(t); glds16(K + (tr_ + lane) * 256 + kcol, (unsigned)__builtin_amdgcn_readfirstlane(kdst + (slot) * SLOTB)); \
        glds16(V + (tr_ + vrow) * 256 + vcol, (unsigned)__builtin_amdgcn_readfirstlane(vdst + (slot) * SLOTB)); } while (0)
    DMA_KV(0, 0);
    bf16x8 qr[4];
#pragma unroll
    for (int d0 = 0; d0 < 4; ++d0) qr[d0] = *(const GAS bf16x8*)(Q + (qrow + r32) * 1024 + h * 64 + d0 * 16 + hi * 8);
    float mrun = sink2, l_reg = (hi == 0) ? 1.f : 0.f;
    f32x16 o[2];
#pragma unroll
    for (int r = 0; r < 16; ++r) { o[0][r] = 0.f; o[1][r] = 0.f; }
    const LAS unsigned char* vp0 = shm + LDS_V + ((lane >> 4) & 1) * 32 + (lane & 3) * 8 + (4 * hi + ((lane & 15) >> 2)) * 64;
    const int qw = q0 + wid * 32;
    asm volatile("s_waitcnt vmcnt(0) lgkmcnt(0)\n\ts_barrier" ::: "memory");
    for (int t = 0; t < NT; ++t) {
        const int slot = t & 1;
        if (t + 1 < NT) DMA_KV(t + 1, slot ^ 1);
        const bool latt = t < nl;
        const int ks = q0 - 128 + 64 * (jlo + t);
        bool need = true;
        if (latt) need = (ks + 63 >= qw - 128) && (ks <= qw + 31 + 128);
        if (need) {
            f32x16 p0, p1;
#pragma unroll
            for (int r = 0; r < 16; ++r) { p0[r] = 0.f; p1[r] = 0.f; }
            const LAS unsigned char* kb = shm + LDS_K + slot * SLOTB + hi * 1024 + r32 * 16;
#pragma unroll
            for (int d0 = 0; d0 < 4; ++d0) {
                const bf16x8 b0 = *(const LAS bf16x8*)(kb + d0 * 2048), b1 = *(const LAS bf16x8*)(kb + d0 * 2048 + 512);
                p0 = __builtin_amdgcn_mfma_f32_32x32x16_bf16(b0, qr[d0], p0, 0, 0, 0);
                p1 = __builtin_amdgcn_mfma_f32_32x32x16_bf16(b1, qr[d0], p1, 0, 0, 0); }
            if (latt) { const int dq = qw + r32 - ks;
#pragma unroll
                for (int r = 0; r < 16; ++r) { const int d = dq - crow(r, hi); if (d > 128 || d < -128) p0[r] = -INFINITY; if (d - 32 > 128 || d - 32 < -128) p1[r] = -INFINITY; } }
            const float rm = rowmax(p0, p1);
            if (__any(rm > mrun + 8.f)) {
                const float mnew = fmaxf(mrun, rm);
                const float alpha = __builtin_amdgcn_exp2f(mrun - mnew); l_reg *= alpha; mrun = mnew;
                if (hi == 0) wsf[r32] = alpha;
                asm volatile("s_waitcnt lgkmcnt(0)" ::: "memory");
#pragma unroll
                for (int r = 0; r < 16; ++r) { const float f = wsf[crow(r, hi)]; o[0][r] *= f; o[1][r] *= f; }
            }
            float sacc = 0.f;
#pragma unroll
            for (int r = 0; r < 16; ++r) { p0[r] = __builtin_amdgcn_exp2f(p0[r] - mrun); p1[r] = __builtin_amdgcn_exp2f(p1[r] - mrun); sacc += p0[r] + p1[r]; }
            l_reg += sacc;
            u32x4 pw0, pw1, pw2, pw3;
#define PKW(P, B) cvt_pk_bf16(P[B], P[B + 1])
            pw0 = (u32x4){PKW(p0, 0), PKW(p0, 2), PKW(p0, 4), PKW(p0, 6)}; pw1 = (u32x4){PKW(p0, 8), PKW(p0, 10), PKW(p0, 12), PKW(p0, 14)};
            pw2 = (u32x4){PKW(p1, 0), PKW(p1, 2), PKW(p1, 4), PKW(p1, 6)}; pw3 = (u32x4){PKW(p1, 8), PKW(p1, 10), PKW(p1, 12), PKW(p1, 14)};
#undef PKW
            __builtin_amdgcn_sched_barrier(0);
            pv(o, vp0 + slot * SLOTB, __builtin_bit_cast(bf16x8, pw0), __builtin_bit_cast(bf16x8, pw1), __builtin_bit_cast(bf16x8, pw2), __builtin_bit_cast(bf16x8, pw3));
        }
        asm volatile("s_waitcnt vmcnt(0) lgkmcnt(0)\n\ts_barrier" ::: "memory");
    }
    { auto rr = __builtin_amdgcn_permlane32_swap(__float_as_uint(l_reg), __float_as_uint(l_reg), false, false); l_reg = __uint_as_float(rr[0]) + __uint_as_float(rr[1]); }
    if (hi == 0) wsf[32 + r32] = l_reg;
    asm volatile("s_waitcnt lgkmcnt(0)" ::: "memory");
    float rli[16];
#pragma unroll
    for (int r = 0; r < 16; ++r) rli[r] = __builtin_amdgcn_rcpf(wsf[32 + crow(r, hi)]);
    bf16_t* Ow = O + qrow * 1024 + h * 64;
    { LAS bf16_t* stg = (LAS bf16_t*)(shm + LDS_OST) + wid * 2048;
#pragma unroll
      for (int r = 0; r < 16; ++r) { const int orow = crow(r, hi);
#pragma unroll
          for (int d0 = 0; d0 < 2; ++d0) stg[orow * 64 + d0 * 32 + r32] = (bf16_t)f2bf(o[d0][r] * rli[r]); }
      asm volatile("s_waitcnt lgkmcnt(0)" ::: "memory");
#pragma unroll
      for (int i = 0; i < 4; ++i) { const int row = i * 8 + (lane >> 3), ch = lane & 7; const u32x4 v = *(const LAS u32x4*)(stg + row * 64 + ch * 8); *(GAS u32x4*)(Ow + (long)row * 1024 + ch * 8) = v; } }
    asm volatile("s_waitcnt lgkmcnt(0)" ::: "memory");
#undef TROW
#undef DMA_KV
}
}

struct Args {
    const float* in[20];
    float* out; unsigned char* ws;
};
struct Frame {
    LAS unsigned char* lds; unsigned* ctl; unsigned char* ws;
    int tid, lane, wave, gw;
    int blk;
    __device__ __forceinline__ void refresh() { tid = opaque_tid(); lane = tid & 63; wave = __builtin_amdgcn_readfirstlane(tid >> 6); gw = blk * 8 + wave;
        asm volatile("" : "+s"(ws)); ctl = (unsigned*)(ws + WS_CTL); }
};
constexpr int NGW = GRID * NWAVES;

struct Row { f32x4 v[4]; };
__device__ __forceinline__ int vq(int q, int lane) { return 64 * (lane >> 4) + 2 * (lane & 15) + 32 * (q >> 1) + (q & 1); }
__device__ __forceinline__ int vb(int j, int lane) { return 32 * (lane >> 4) + (lane & 15) + 16 * j; }
__device__ __forceinline__ void row_load_bf16(Row& r, const bf16_t* p, int lane) {
#pragma unroll
    for (int j = 0; j < 2; ++j) { const u32x4 w = ((const GAS u32x4*)p)[vb(j, lane)]; r.v[2 * j] = (f32x4){bflo(w.x), bfhi(w.x), bflo(w.y), bfhi(w.y)}; r.v[2 * j + 1] = (f32x4){bflo(w.z), bfhi(w.z), bflo(w.w), bfhi(w.w)}; } }
__device__ __forceinline__ void row_store_bf16(const Row& r, bf16_t* p, int lane) {
#pragma unroll
    for (int j = 0; j < 2; ++j) { u32x4 w; w.x = pk2(r.v[2 * j][0], r.v[2 * j][1]); w.y = pk2(r.v[2 * j][2], r.v[2 * j][3]); w.z = pk2(r.v[2 * j + 1][0], r.v[2 * j + 1][1]); w.w = pk2(r.v[2 * j + 1][2], r.v[2 * j + 1][3]); ((GAS u32x4*)p)[vb(j, lane)] = w; } }
typedef float f32x2v __attribute__((ext_vector_type(2)));
__device__ __forceinline__ void row_load_fp8(Row& r, const unsigned char* p, int lane) {
    const u32x4 w = ((const GAS u32x4*)p)[lane];
#pragma unroll
    for (int q = 0; q < 4; ++q) { const f32x2v lo = __builtin_amdgcn_cvt_pk_f32_fp8((int)w[q], false), hi = __builtin_amdgcn_cvt_pk_f32_fp8((int)w[q], true); r.v[q] = (f32x4){lo[0], lo[1], hi[0], hi[1]}; } }
__device__ __forceinline__ void row_load_f32(Row& r, const float* p, int lane) {
#pragma unroll
    for (int q = 0; q < 4; ++q) r.v[q] = ((const GAS f32x4*)p)[vq(q, lane)]; }
__device__ __forceinline__ void row_store_f32(const Row& r, float* p, int lane) {
#pragma unroll
    for (int q = 0; q < 4; ++q) ((GAS f32x4*)p)[vq(q, lane)] = r.v[q]; }
__device__ __forceinline__ void row_normalize(Row& r, float eps) {
    float s = 0.f;
#pragma unroll
    for (int j = 0; j < 4; ++j) s += (r.v[j][0] + r.v[j][1]) + (r.v[j][2] + r.v[j][3]);
    const float mean = wave_sum(s) * (1.f / D); float q = 0.f;
#pragma unroll
    for (int j = 0; j < 4; ++j) { r.v[j] = r.v[j] - mean; q += (r.v[j][0] * r.v[j][0] + r.v[j][1] * r.v[j][1]) + (r.v[j][2] * r.v[j][2] + r.v[j][3] * r.v[j][3]); }
    const float rstd = 1.f / sqrtf(wave_sum(q) * (1.f / D) + eps);
#pragma unroll
    for (int j = 0; j < 4; ++j) r.v[j] = r.v[j] * rstd;
}
__device__ __forceinline__ void row_modulate(Row& r, const float* sh, const float* sc, int lane) {
    row_normalize(r, MOD_EPS);
#pragma unroll
    for (int j = 0; j < 4; ++j) { const f32x4 a = ((const GAS f32x4*)sc)[vq(j, lane)], b = ((const GAS f32x4*)sh)[vq(j, lane)]; r.v[j] = r.v[j] * (a + 1.f) + b; }
}
__device__ __forceinline__ int mod_row(int row) { return row < T ? (row >> 11) : 32; }
__device__ __forceinline__ const float* mod_vec(const unsigned char* ws, int layer, int mr, int chunk) { return (const float*)(ws + WS_MOD) + ((size_t)(layer * 33 + mr) * 6 + chunk) * 1024; }

__device__ __forceinline__ void conv_item(const float* W, int N, bf16_t* WT, int Kd, int kd0, int n0, int drow0, bool mirror, LAS float* scr, int lane) {
#pragma unroll 8
    for (int i = 0; i < 32; ++i) { const int kk = 2 * i + (lane >> 5); const int kd = kd0 + kk; const int ks = mirror ? ((kd & ~255) + ((256 - (kd & 255)) & 255)) : kd;
        scr[kk * 33 + (lane & 31)] = ((const GAS float*)W)[(size_t)ks * N + n0 + (lane & 31)]; }
    LDS_WAIT(); asm volatile("" ::: "memory");
    const int c = lane & 7;
#pragma unroll
    for (int j = 0; j < 4; ++j) { const int n = (lane >> 3) + 8 * j; const LAS float* s = scr + (8 * c) * 33 + n;
        u32x4 o; o.x = pk2(s[0 * 33], s[1 * 33]); o.y = pk2(s[2 * 33], s[3 * 33]); o.z = pk2(s[4 * 33], s[5 * 33]); o.w = pk2(s[6 * 33], s[7 * 33]);
        *(GAS u32x4*)(WT + (size_t)(drow0 + n) * Kd + kd0 + 8 * c) = o; }
    LDS_WAIT(); asm volatile("" ::: "memory");
}
__device__ __forceinline__ void conv_matrix_item(const float* W, int K, int N, bf16_t* WT, int mode, int roff, int item, LAS float* scr, int lane) {
    const int nblk = N / 32, kb = item / nblk, nb = item % nblk, n0 = 32 * nb;
    int drow0 = n0 + roff; if (mode == 1) drow0 = (n0 >> 7) * 256 + (n0 & 127); if (mode == 2) drow0 = (n0 >> 7) * 256 + 128 + (n0 & 127);
    conv_item(W, N, WT, K, 64 * kb, n0, drow0, mode == 3, scr, lane);
}
__device__ __forceinline__ void conv_item64(const float* W, int N, bf16_t* WT, int Kd, int k0, int n0, int drow0, LAS bf16_t* scr, int lane) {
    f32x4 v[16];
#pragma unroll
    for (int i = 0; i < 16; ++i) v[i] = *(const GAS f32x4*)(W + (size_t)(k0 + 4 * i + (lane >> 4)) * N + n0 + (lane & 15) * 4);
#pragma unroll
    for (int i = 0; i < 16; ++i) { u32x2 w; w.x = pk2(v[i][0], v[i][1]); w.y = pk2(v[i][2], v[i][3]); *(LAS u32x2*)(scr + (4 * i + (lane >> 4)) * 68 + (lane & 15) * 4) = w; }
    LDS_WAIT(); asm volatile("" ::: "memory");
    const int c = lane & 7;
#pragma unroll
    for (int j = 0; j < 8; ++j) { const int n = (lane >> 3) + 8 * j; const LAS bf16_t* p = scr + (8 * c) * 68 + n;
        u32x4 o; o.x = (unsigned)p[0] | ((unsigned)p[68] << 16); o.y = (unsigned)p[2 * 68] | ((unsigned)p[3 * 68] << 16); o.z = (unsigned)p[4 * 68] | ((unsigned)p[5 * 68] << 16); o.w = (unsigned)p[6 * 68] | ((unsigned)p[7 * 68] << 16);
        *(GAS u32x4*)(WT + (size_t)(drow0 + n) * Kd + k0 + 8 * c) = o; }
    LDS_WAIT(); asm volatile("" ::: "memory");
}
__device__ __forceinline__ void conv_experts(Frame& F, const float* wg, const float* wu, const float* wd, int layer) {
    F.refresh();
    LAS bf16_t* scr = (LAS bf16_t*)(F.lds + 32768 + F.wave * 8704);
    bf16_t* EGU = (bf16_t*)(F.ws + WS_EGU); bf16_t* ED = (bf16_t*)(F.ws + WS_ED);
    for (int it = F.gw; it < NE * 192; it += NGW) { const int e = it / 192, r = it % 192;
        const size_t eo = ((size_t)layer * NE + e) * (1024 * 256);
        if (r < 128) { const int q = r & 63, kb = q >> 2, nb = q & 3, n0 = 64 * nb; const int drow0 = (n0 >> 7) * 256 + (r < 64 ? 0 : 128) + (n0 & 127);
            conv_item64((r < 64 ? wg : wu) + eo, 256, EGU + (size_t)e * 512 * 1024, 1024, 64 * kb, n0, drow0, scr, F.lane); }
        else { const int q = r - 128, kb = q >> 4, nb = q & 15; conv_item64(wd + eo, 1024, ED + (size_t)e * 1024 * 256, 256, 64 * kb, 64 * nb, 64 * nb, scr, F.lane); } }
}
__device__ __forceinline__ void conv_small(Frame& F, const Args& a) {
    F.refresh();
    LAS float* scr = (LAS float*)(F.lds + 32768 + F.wave * 8448);
    for (int it = F.gw; it < 6272; it += NGW) {
        if (it < 1536) { const int j = it / 768, r = it % 768; conv_matrix_item(a.in[8] + (size_t)j * 1024 * 1536, 1024, 1536, (bf16_t*)(F.ws + WS_WQKV) + (size_t)j * 1536 * 1024, 0, 0, r, scr, F.lane); }
        else if (it < 2560) { const int q = it - 1536, j = q / 512, r = q % 512; conv_matrix_item(a.in[9] + (size_t)j * 1024 * 1024, 1024, 1024, (bf16_t*)(F.ws + WS_WO) + (size_t)j * 1024 * 1024, 0, 0, r, scr, F.lane); }
        else if (it < 4608) { const int q = it - 2560, j = q / 1024, r = q % 1024; bf16_t* dst = (bf16_t*)(F.ws + WS_WF) + (size_t)j * 2048 * 1024;
            if (r < 512) conv_matrix_item(a.in[11] + (size_t)j * 1024 * 1024, 1024, 1024, dst, 0, 0, r, scr, F.lane);
            else conv_matrix_item(a.in[11] + (size_t)j * 1024 * 1024, 1024, 1024, dst, 3, 1024, r - 512, scr, F.lane); }
        else if (it < 4736) { const int q = it - 4608, l = q / 32, r = q % 32; conv_matrix_item(a.in[12] + (size_t)l * 1024 * 64, 1024, 64, (bf16_t*)(F.ws + WS_WR) + (size_t)l * 64 * 1024, 0, 0, r, scr, F.lane); }
        else { const int q = it - 4736, l = q / 384, r = q % 384; bf16_t* gu = (bf16_t*)(F.ws + WS_WSH + (size_t)l * 1536 * 1024); bf16_t* dn = gu + 512 * 1024;
            if (r < 128) conv_matrix_item(a.in[17] + (size_t)l * 1024 * 256, 1024, 256, gu, 1, 0, r, scr, F.lane);
            else if (r < 256) conv_matrix_item(a.in[18] + (size_t)l * 1024 * 256, 1024, 256, gu, 2, 0, r - 128, scr, F.lane);
            else conv_matrix_item(a.in[19] + (size_t)l * 256 * 1024, 256, 1024, dn, 0, 0, r - 256, scr, F.lane); }
    }
    const int gt = F.blk * NTHR + F.tid, NGT = GRID * NTHR;
    const float TWO_PI = 6.283185307179586f;
    { float* rc = (float*)(F.ws + WS_ROPEC); float* rs = (float*)(F.ws + WS_ROPES);
      for (int i = gt; i < 64 * 16; i += NGT) { const int pos = i >> 4, fi = i & 15; const float inv = exp2f(-(float)fi * (13.287712379549449f / 16.f)); const float ang = (float)pos * inv; rc[i] = cosf(ang); rs[i] = sinf(ang); } }
    { bf16_t* cs = (bf16_t*)(F.ws + WS_CSN);
      for (int i = gt; i < 512 * 256; i += NGT) { const int r = i >> 8, n = i & 255, m = r & 255; const float ang = TWO_PI * (float)((m * n) & 255) * (1.f / 256.f); cs[i] = (bf16_t)f2bf(r < 256 ? cosf(ang) : -sinf(ang)); } }
    { bf16_t* dl = (bf16_t*)(F.ws + WS_DL);
      for (int i = gt; i < 1024 * 4096; i += NGT) { const int k = i >> 12, c = i & 4095, l = c & 2047; const float ang = TWO_PI * (float)((k * l) & 2047) * (1.f / 2048.f); dl[i] = (bf16_t)f2bf(c < 2048 ? cosf(ang) : sinf(ang)); } }
    { bf16_t* dl = (bf16_t*)(F.ws + WS_DLC);
      for (int i = gt; i < 256 * 512; i += NGT) { const int k = i >> 9, c = i & 511, l = c & 255; const float ang = TWO_PI * (float)((k * l) & 255) * (1.f / 256.f); dl[i] = (bf16_t)f2bf(c < 256 ? cosf(ang) : sinf(ang)); } }
}
__device__ __forceinline__ void mod_partials(Frame& F, const Args& a) {
    F.refresh();
    if (F.blk >= 192) return;
    const int l = F.blk / 48, cb = (F.blk % 48) / 4, kc = F.blk & 3;
    LAS float* s = (LAS float*)F.lds;
    for (int i = F.tid; i < 256 * 33; i += NTHR) { const int k = i / 33, r = i % 33; const float c = (r < 32) ? a.in[1][(size_t)r * 1024 + kc * 256 + k] : a.in[3][kc * 256 + k]; s[k * 36 + r] = c / (1.f + __expf(-c)); }
    __syncthreads();
    const int n = cb * 512 + F.tid;
    const GAS float* w = (const GAS float*)a.in[4] + ((size_t)l * 1024 + kc * 256) * 6144 + n;
    float acc[33];
#pragma unroll
    for (int r = 0; r < 33; ++r) acc[r] = 0.f;
#pragma unroll 4
    for (int k = 0; k < 256; ++k) { const float wv = w[(size_t)k * 6144];
#pragma unroll
        for (int r = 0; r < 33; ++r) acc[r] += s[k * 36 + r] * wv; }
    float* part = (float*)(F.ws + WS_MODP) + ((size_t)(kc * 4 + l) * 33) * 6144 + n;
#pragma unroll
    for (int r = 0; r < 33; ++r) part[(size_t)r * 6144] = acc[r];
    __syncthreads();
}
__device__ __forceinline__ void mod_finalize(Frame& F, const Args& a) {
    F.refresh();
    const int gt = F.blk * NTHR + F.tid, NGT = GRID * NTHR; const float* part = (const float*)(F.ws + WS_MODP); float* mod = (float*)(F.ws + WS_MOD);
    for (int i = gt; i < 4 * 33 * 6144; i += NGT) { const int l = i / (33 * 6144), n = i % 6144; float v = a.in[5][l * 6144 + n];
#pragma unroll
        for (int kc = 0; kc < 4; ++kc) v += part[(size_t)kc * 4 * 33 * 6144 + i]; mod[i] = v; }
}
__device__ __forceinline__ void rows_init(Frame& F, const Args& a) {
    F.refresh();
    bf16_t* XS = (bf16_t*)(F.ws + WS_XS); bf16_t* U = (bf16_t*)a.out; const float* part = (const float*)(F.ws + WS_MODP);
    for (int row = F.gw; row < TT; row += NGW) {
        Row r; row_load_f32(r, row < T ? a.in[0] + (size_t)row * D : a.in[2] + (size_t)(row - T) * D, F.lane);
        row_store_bf16(r, XS + (size_t)row * D, F.lane);
        row_normalize(r, MOD_EPS); const int mr = mod_row(row);
#pragma unroll
        for (int j = 0; j < 4; ++j) { const int e = vq(j, F.lane);
            f32x4 sh = ((const GAS f32x4*)(a.in[5]))[e], sc = ((const GAS f32x4*)(a.in[5] + 1024))[e];
#pragma unroll
            for (int kc = 0; kc < 4; ++kc) { const float* pp = part + ((size_t)(kc * 4 + 0) * 33 + mr) * 6144; sh += ((const GAS f32x4*)pp)[e]; sc += ((const GAS f32x4*)(pp + 1024))[e]; }
            r.v[j] = r.v[j] * (sc + 1.f) + sh; }
        row_store_bf16(r, U + (size_t)row * D, F.lane);
    }
}
__device__ __forceinline__ void rows_post1(Frame& F, const Args& a, int layer, int nrows) {
    F.refresh();
    bf16_t* XS = (bf16_t*)(F.ws + WS_XS); bf16_t* U = (bf16_t*)a.out;
    const float* lg = a.in[6] + (size_t)(layer * 2 + 0) * D; const float* lb = a.in[7] + (size_t)(layer * 2 + 0) * D;
    const int TPB = nrows / GRID;
    for (int rl = F.wave; rl < TPB; rl += NWAVES) { const int row = F.blk * TPB + rl; const int mr = mod_row(row);
        Row x, y; row_load_bf16(x, XS + (size_t)row * D, F.lane); row_load_bf16(y, U + (size_t)row * D, F.lane);
        const float* g1 = mod_vec(F.ws, layer, mr, 2);
#pragma unroll
        for (int j = 0; j < 4; ++j) x.v[j] = x.v[j] * ALPHA + ((const GAS f32x4*)g1)[vq(j, F.lane)] * y.v[j];
        row_normalize(x, LN_EPS);
#pragma unroll
        for (int j = 0; j < 4; ++j) x.v[j] = x.v[j] * ((const GAS f32x4*)lg)[vq(j, F.lane)] + ((const GAS f32x4*)lb)[vq(j, F.lane)];
        row_store_bf16(x, XS + (size_t)row * D, F.lane);
        row_modulate(x, mod_vec(F.ws, layer, mr, 3), mod_vec(F.ws, layer, mr, 4), F.lane);
        row_store_bf16(x, U + (size_t)row * D, F.lane);
    }
}
__device__ __forceinline__ void rows_post2(Frame& F, const Args& a, int layer, int t0, int n) {
    F.refresh();
    bf16_t* XS = (bf16_t*)(F.ws + WS_XS); bf16_t* U = (bf16_t*)a.out; const unsigned char* YB = (const unsigned char*)(F.ws + WS_YB); const unsigned char* YS = (const unsigned char*)(F.ws + WS_YS);
    const int* spos = (const int*)(F.ws + WS_SDST); const float* tkw = (const float*)(F.ws + WS_TKW);
    const float* lg = a.in[6] + (size_t)(layer * 2 + 1) * D; const float* lb = a.in[7] + (size_t)(layer * 2 + 1) * D;
    for (int i = F.gw; i < n; i += NGW) { const int row = t0 + i; const int mr = mod_row(row);
        Row x, y; row_load_bf16(x, XS + (size_t)row * D, F.lane);
        int pj = 0; float wj = 0.f; if (F.lane < 8) { pj = ((const GAS int*)spos)[(size_t)row * 8 + F.lane]; wj = ((const GAS float*)tkw)[(size_t)row * 8 + F.lane]; }
        row_load_fp8(y, YS + (size_t)i * D, F.lane);
#pragma unroll
        for (int j = 0; j < 4; ++j) y.v[j] = y.v[j] * (1.f / 16.f);
#pragma unroll
        for (int s = 0; s < 8; ++s) { const int ps = __builtin_amdgcn_readlane(pj, s); const float ws_ = __builtin_bit_cast(float, __builtin_amdgcn_readlane(__builtin_bit_cast(int, wj), s));
            Row z; row_load_fp8(z, YB + (size_t)ps * D, F.lane); const float wz = ws_ * (1.f / 16.f);
#pragma unroll
            for (int j = 0; j < 4; ++j) y.v[j] += z.v[j] * wz; }
        const float* g2 = mod_vec(F.ws, layer, mr, 5);
#pragma unroll
        for (int j = 0; j < 4; ++j) x.v[j] = x.v[j] * ALPHA + ((const GAS f32x4*)g2)[vq(j, F.lane)] * y.v[j];
        row_normalize(x, LN_EPS);
#pragma unroll
        for (int j = 0; j < 4; ++j) x.v[j] = x.v[j] * ((const GAS f32x4*)lg)[vq(j, F.lane)] + ((const GAS f32x4*)lb)[vq(j, F.lane)];
        if (layer == 3) { row_store_f32(x, a.out + (size_t)row * D, F.lane); }
        else { row_store_bf16(x, XS + (size_t)row * D, F.lane);
            row_modulate(x, mod_vec(F.ws, layer + 1, mr, 0), mod_vec(F.ws, layer + 1, mr, 1), F.lane);
            row_store_bf16(x, U + (size_t)row * D, F.lane); }
    }
}

__device__ __forceinline__ float wave_max_dpp(float v) {
    int x = __builtin_bit_cast(int, v);
#define DPPMAX(ctrl) { const int y = __builtin_amdgcn_update_dpp(x, x, ctrl, 0xf, 0xf, false); x = __builtin_bit_cast(int, fmaxf(__builtin_bit_cast(float, x), __builtin_bit_cast(float, y))); }
    DPPMAX(0xB1) DPPMAX(0x4E) DPPMAX(0x141) DPPMAX(0x140)
#undef DPPMAX
    const float r0 = __builtin_bit_cast(float, __builtin_amdgcn_readlane(x, 0)), r1 = __builtin_bit_cast(float, __builtin_amdgcn_readlane(x, 16));
    const float r2 = __builtin_bit_cast(float, __builtin_amdgcn_readlane(x, 32)), r3 = __builtin_bit_cast(float, __builtin_amdgcn_readlane(x, 48));
    return fmaxf(fmaxf(r0, r1), fmaxf(r2, r3));
}
__device__ __forceinline__ void route_tokens(Frame& F, const Args& a, int layer, int ntok) {
    F.refresh();
    const int TPB = ntok / GRID;
    const bf16_t* U = (const bf16_t*)a.out; const bf16_t* Wr = (const bf16_t*)(F.ws + WS_WR) + (size_t)layer * 64 * 1024;
    int* tke = (int*)(F.ws + WS_TKE); float* tkw = (float*)(F.ws + WS_TKW);
    LAS int* lcnt = (LAS int*)(F.lds + L_LCNT);
    LAS float* sc = (LAS float*)(F.lds) + F.wave * 1024;
    if (F.tid < 64) lcnt[F.tid] = 0;
    __syncthreads();
    const int lane = F.lane, fr = lane & 15, fq = lane >> 4;
    const float bias = a.in[13][layer * 64 + lane];
    const int ntile = TPB / 16;
    for (int tl = F.wave; tl < ntile; tl += NWAVES) {
        const int t0 = F.blk * TPB + tl * 16;
        f32x4 acc[4];
#pragma unroll
        for (int n = 0; n < 4; ++n) acc[n] = (f32x4){0.f, 0.f, 0.f, 0.f};
        const GAS bf16x8* ap = (const GAS bf16x8*)(U + (size_t)(t0 + fr) * D + fq * 8);
        const GAS bf16x8* bp = (const GAS bf16x8*)(Wr + (size_t)fr * D + fq * 8);
#pragma unroll 4
        for (int ks = 0; ks < 32; ++ks) { const bf16x8 av = ap[ks * 4];
#pragma unroll
            for (int n = 0; n < 4; ++n) { const bf16x8 bv = bp[(size_t)n * 16 * (D / 8) + ks * 4]; acc[n] = __builtin_amdgcn_mfma_f32_16x16x32_bf16(av, bv, acc[n], 0, 0, 0); } }
#pragma unroll
        for (int n = 0; n < 4; ++n)
#pragma unroll
            for (int j = 0; j < 4; ++j) sc[(fq * 4 + j) * 64 + n * 16 + fr] = acc[n][j];
        LDS_WAIT();
        for (int tk = 0; tk < 16; ++tk) {
            const float logit = sc[tk * 64 + lane];
            const float s = 1.f / (1.f + __expf(-logit));
            const float sel = s + bias;
            const int g = lane >> 3;
            float m1 = sel; m1 = fmaxf(m1, __shfl_xor(m1, 1)); m1 = fmaxf(m1, __shfl_xor(m1, 2)); m1 = fmaxf(m1, __shfl_xor(m1, 4));
            const unsigned long long bm = __ballot(sel == m1);
            const unsigned gm = (unsigned)(bm >> (g * 8)) & 0xffu;
            const int first = g * 8 + __builtin_ctz(gm);
            float m2 = (lane == first) ? -INFINITY : sel; m2 = fmaxf(m2, __shfl_xor(m2, 1)); m2 = fmaxf(m2, __shfl_xor(m2, 2)); m2 = fmaxf(m2, __shfl_xor(m2, 4));
            const float gs = m1 + m2;
            float curg = gs; bool gok = false;
#pragma unroll 1
            for (int it = 0; it < 4; ++it) { const float mx = wave_max_dpp(curg);
                const unsigned long long bb = __ballot(curg == mx); const int gi = (int)(__builtin_ctzll(bb) >> 3);
                if (g == gi) { gok = true; curg = -INFINITY; } }
            float cure = gok ? sel : -INFINITY; bool chosen = false; int rk = 0;
#pragma unroll 1
            for (int it = 0; it < 8; ++it) { const float mx = wave_max_dpp(cure);
                const unsigned long long bb = __ballot(cure == mx); const int ei = (int)__builtin_ctzll(bb);
                if (lane == ei) { chosen = true; rk = it; cure = -INFINITY; } }
            const float tot = wave_sum(chosen ? s : 0.f);
            if (chosen) { const int tok = t0 + tk; tke[(size_t)tok * 8 + rk] = lane; tkw[(size_t)tok * 8 + rk] = s / tot * 2.5f; __hip_atomic_fetch_add(&lcnt[lane], 1, __ATOMIC_RELAXED, __HIP_MEMORY_SCOPE_WORKGROUP); }
        }
        LDS_WAIT();
    }
    __syncthreads();
    if (F.tid < 64) F.ctl[CW_BCNT + F.blk * 64 + F.tid] = (unsigned)lcnt[F.tid];
}
__device__ __forceinline__ void build_lists(Frame& F, int ntok) {
    F.refresh();
    constexpr int NSEG = NCHUNK * 64, BPC = GRID / NCHUNK;
    const int TPB = ntok / GRID, CH = ntok / NCHUNK;
    LAS int* tstart = (LAS int*)(F.lds + L_TSTART); LAS int* pref = (LAS int*)(F.lds + L_PREF); LAS int* lcnt = (LAS int*)(F.lds + L_LCNT);
    LAS unsigned char* tseg = (LAS unsigned char*)(F.lds + L_TSEG); LAS int* scan = (LAS int*)(F.lds + L_SCAN);
    const unsigned* bcnt = F.ctl + CW_BCNT;
    const int myc = F.blk / BPC, mylb = F.blk % BPC;
    int nseg = 0;
    LAS int* cntl = (LAS int*)F.lds;
    for (int i = F.tid; i < GRID * 64; i += NTHR) cntl[i] = (int)((const GAS unsigned*)bcnt)[i];
    if (F.tid < 64) lcnt[F.tid] = 0;
    __syncthreads();
    if (F.tid < NSEG) { const int c = F.tid >> 6, e = F.tid & 63; int n = 0, p = 0;
        for (int lb = 0; lb < BPC; ++lb) { const int v = cntl[(c * BPC + lb) * 64 + e]; if (c == myc && lb < mylb) p += v; n += v; }
        nseg = n; scan[F.tid] = (n + 255) >> 8; if (c == myc) pref[e] = p; }
    __syncthreads();
    if (F.tid == 0) { int acc = 0; for (int s = 0; s < NSEG; ++s) { tstart[s] = acc; acc += scan[s]; } tstart[NSEG] = acc; }
    __syncthreads();
    if (F.tid < NSEG) { const int t0 = tstart[F.tid], t1 = tstart[F.tid + 1]; for (int t = t0; t < t1; ++t) tseg[t] = (unsigned char)F.tid; }
    int* stok = (int*)(F.ws + WS_STOK); int* spos = (int*)(F.ws + WS_SDST);
    const int* tke = (const int*)(F.ws + WS_TKE);
    { const int sseg = myc * 64 + mylb; if (mylb < 64 && F.tid == sseg) scan[0] = nseg; }
    __syncthreads();
    if (mylb < 64) { const int sseg = myc * 64 + mylb; const int n = scan[0]; const int base = tstart[sseg] * 256, end = tstart[sseg + 1] * 256;
      for (int p = base + n + F.tid; p < end; p += NTHR) stok[p] = myc * CH; }
    for (int tl = F.wave; tl < TPB; tl += NWAVES) { const int tok = F.blk * TPB + tl;
        if (F.lane < 8) { const int e = tke[(size_t)tok * 8 + F.lane];
            const int p = tstart[myc * 64 + e] * 256 + pref[e] + __hip_atomic_fetch_add(&lcnt[e], 1, __ATOMIC_RELAXED, __HIP_MEMORY_SCOPE_WORKGROUP);
            stok[p] = tok; spos[(size_t)tok * 8 + F.lane] = p - tstart[myc * 64] * 256; } }
    __syncthreads();
}

struct SchedQKV {
    const char* U; const char* W; int nfull, nu, c;
    __device__ __forceinline__ bool next(int i, pg::Unit& u) const {
        const int L0 = i * GRID + c; if (L0 >= nu) return false;
        int pm, pn;
        if (L0 < nfull) { const int L = pg::xcd_remap(L0, nfull); const int gid = L / 48, w = L % 48; pm = gid * 8 + (w & 7); pn = w >> 3; }
        else { const int q = L0 - nfull; pm = 256 + (q >> 1); pn = 4 + (q & 1); }
        u.A = U + (size_t)pm * 256 * 2048; u.B = W + (size_t)pn * 256 * 2048; u.gidx = nullptr; u.gbase = 0; u.nt = 16; u.out = nullptr; u.ldc = 0; u.scale = 1.f; u.flags = 0; u.i0 = pm; u.i1 = pn; u.l0 = nullptr; u.l1 = nullptr;
        return true; }
};
struct SchedDense {
    const char* A; const char* W; char* out; int nrt, nct, nt, c; size_t ldA;
    __device__ __forceinline__ bool next(int i, pg::Unit& u) const {
        const int nu = nrt * nct; const int L0 = i * GRID + c; if (L0 >= nu) return false;
        const int L = pg::xcd_remap(L0, nu); const int per = 8 * nct, gid = L / per, w = L % per, fm = gid * 8, gsz = (nrt - fm) < 8 ? (nrt - fm) : 8; const int pm = fm + (w % gsz), pn = w / gsz;
        u.A = A + (size_t)pm * 256 * ldA; u.B = W + (size_t)pn * 256 * ldA; u.gidx = nullptr; u.gbase = 0; u.nt = nt; u.out = out + (size_t)pm * 256 * 2048 + pn * 512; u.ldc = 2048; u.scale = 1.f; u.flags = 0; u.i0 = pm; u.i1 = pn; u.l0 = nullptr; u.l1 = nullptr;
        return true; }
};
struct SchedF1 {
    const char* CS; const char* U; char* ABT; char* ABTC; int nu, c;
    __device__ __forceinline__ bool next(int i, pg::Unit& u) const {
        const int L0 = i * GRID + c; if (L0 >= nu) return false;
        u.gidx = nullptr; u.gbase = 0; u.nt = 4; u.scale = 1.f; u.flags = 0; u.i0 = 0; u.i1 = 0; u.l0 = nullptr; u.l1 = nullptr;
        if (L0 < 2048) { const int L = pg::xcd_remap(L0, 2048); const int pm = L & 1, pn = (L >> 1) & 7, bg = L >> 4, b = bg >> 2, g = bg & 3;
            u.A = CS + (size_t)pm * 256 * 512; u.B = U + ((size_t)b * SEQ + pn * 256) * 2048 + g * 512; u.out = ABT + (size_t)bg * 256 * 8192 + (size_t)(pm * 2048 + pn * 256) * 2; u.ldc = 8192; }
        else { const int q = L0 - 2048; const int pm = q & 1, bg = q >> 1, b = bg >> 2, g = bg & 3;
            u.A = CS + (size_t)pm * 256 * 512; u.B = U + ((size_t)T + b * CTXL) * 2048 + g * 512; u.out = ABTC + (size_t)bg * 256 * 1024 + (size_t)pm * 512; u.ldc = 1024; }
        return true; }
};
struct SchedF2 {
    const char* DL; const char* ABT; char* FH; int c;
    __device__ __forceinline__ bool next(int i, pg::Unit& u) const {
        const int L0 = i * GRID + c; if (L0 >= 512) return false;
        const int L = pg::xcd_remap(L0, 512); const int pm = L & 3, bg = L >> 2, b = bg >> 2, g = bg & 3;
        u.A = DL + (size_t)pm * 256 * 8192; u.B = ABT + (size_t)bg * 256 * 8192; u.gidx = nullptr; u.gbase = 0; u.nt = 64; u.out = FH + ((size_t)b * 1024 + pm * 256) * 2048 + g * 512; u.ldc = 2048; u.scale = 0.001381067932004975f  ; u.flags = 0; u.i0 = 0; u.i1 = 0; u.l0 = nullptr; u.l1 = nullptr;
        return true; }
};
struct SchedF2c {
    const char* DLC; const char* ABTC; char* FC; int c;
    __device__ __forceinline__ bool next(int i, pg::Unit& u) const {
        const int L0 = i * GRID + c; if (L0 >= 128) return false;
        const int bg = L0, b = bg >> 2, g = bg & 3;
        u.A = DLC; u.B = ABTC + (size_t)bg * 256 * 1024; u.gidx = nullptr; u.gbase = 0; u.nt = 8; u.out = FC + ((size_t)b * 256) * 2048 + g * 512; u.ldc = 2048; u.scale = 1.f / 256.f; u.flags = 0; u.i0 = 0; u.i1 = 0; u.l0 = nullptr; u.l1 = nullptr;
        return true; }
};
struct SchedF3 {
    const char* FH; const char* FC; const char* W; char* Y; int nu, c;
    __device__ __forceinline__ bool next(int i, pg::Unit& u) const {
        const int L0 = i * GRID + c; if (L0 >= nu) return false;
        u.gidx = nullptr; u.gbase = 0; u.nt = 16; u.scale = 1.f; u.flags = 0; u.i0 = 0; u.i1 = 0; u.l0 = nullptr; u.l1 = nullptr;
        if (L0 < 1024) { const int L = pg::xcd_remap(L0, 1024); const int gid = L >> 6, w = L & 63, pm = gid * 8 + (w & 7), pn = w >> 3; const int b = pm >> 2, k0 = (pm & 3) * 256;
            u.A = FH + (size_t)pm * 256 * 2048; u.B = W + (size_t)pn * 256 * 2048;
            if (pn < 4) { u.out = Y + ((size_t)b * SEQ + k0) * 2048 + pn * 512; u.ldc = 2048; }
            else { u.out = Y + ((size_t)b * SEQ + SEQ - k0) * 2048 + (pn - 4) * 512; u.ldc = -2048; u.flags = (k0 == 0) ? 1 : 0; } }
        else { const int q = L0 - 1024; const int pm = q >> 2, pn = q & 3;
            u.A = FC + (size_t)pm * 256 * 2048; u.B = W + (size_t)pn * 256 * 2048; u.out = Y + ((size_t)T + pm * 256) * 2048 + pn * 512; u.ldc = 2048; }
        return true; }
};
struct SchedG1 {
    const char* EGU; const char* WSG; const int* STOK; char* H; char* HS; LAS const unsigned char* tseg; int ntl, nsh, c;
    __device__ __forceinline__ bool gsrc(int i, const int*& gidx, int& gbase) const {
        const int nu = (ntl + nsh) * 2; const int L0 = i * GRID + c; if (L0 >= nu) return false;
        const int pm = pg::xcd_remap(L0, nu) >> 1;
        if (pm < ntl) { gidx = STOK + (size_t)pm * 256; gbase = 0; } else { gidx = nullptr; gbase = (pm - ntl) * 256; }
        return true; }
    __device__ __forceinline__ bool next(int i, pg::Unit& u) const {
        const int nu = (ntl + nsh) * 2; const int L0 = i * GRID + c; if (L0 >= nu) return false;
        const int L = pg::xcd_remap(L0, nu); const int pm = L >> 1, pn = L & 1;
        u.A = nullptr; u.gbase = 0; u.nt = 16; u.ldc = 512; u.scale = 1.f; u.flags = 0; u.i0 = 0; u.i1 = 0; u.l0 = nullptr; u.l1 = nullptr;
        if (pm < ntl) { const int e = __builtin_amdgcn_readfirstlane((int)tseg[pm]) & 63;
            u.gidx = STOK + (size_t)pm * 256; u.B = EGU + (size_t)e * 512 * 2048 + (size_t)pn * 256 * 2048; u.out = H + (size_t)pm * 256 * 512 + pn * 256; }
        else { const int ps = pm - ntl; u.gidx = nullptr; u.gbase = ps * 256; u.B = WSG + (size_t)pn * 256 * 2048; u.out = HS + (size_t)ps * 256 * 512 + pn * 256; }
        return true; }
};
struct SchedG2 {
    const char* ED; const char* WSD; const char* H; const char* HS; char* YB; char* YS; LAS const unsigned char* tseg; int t0, t1, nsh, ch, CH, c;
    __device__ __forceinline__ bool next(int i, pg::Unit& u) const {
        const int nr = t1 - t0; const int nu = (nr + nsh) * 4; const int L0 = i * GRID + c; if (L0 >= nu) return false;
        const int L = pg::xcd_remap(L0, nu); const int q = L >> 2, pn = L & 3;
        u.gidx = nullptr; u.gbase = 0; u.nt = 4; u.ldc = 1024; u.scale = 1.f; u.flags = 0; u.i0 = 0; u.i1 = pn; u.l0 = nullptr; u.l1 = nullptr;
        if (q < nr) { const int pm = t0 + q; const int e = __builtin_amdgcn_readfirstlane((int)tseg[pm]) & 63;
            u.A = H + (size_t)pm * 256 * 512; u.B = ED + (size_t)e * 1024 * 512 + (size_t)pn * 256 * 512; u.out = YB + (size_t)q * 256 * 1024; }
        else { const int ps = q - nr; u.A = HS + ((size_t)ch * CH + ps * 256) * 512; u.B = WSD + (size_t)pn * 256 * 512; u.out = YS + (size_t)ps * 256 * 1024; }
        return true; }
};

__device__ __forceinline__ void fnet_nyquist_rows(Frame& F) {
    F.refresh();
    const bf16_t* ABT = (const bf16_t*)(F.ws + WS_ABT); bf16_t* FH1 = (bf16_t*)(F.ws + WS_FH1);
    for (int r = F.gw; r < 128 * 256; r += NGW) { const int bg = r >> 8, m = r & 255, b = bg >> 2, g = bg & 3;
        const GAS u32x4* p = (const GAS u32x4*)(ABT + (size_t)r * 4096); float s = 0.f;
#pragma unroll
        for (int i = 0; i < 4; ++i) { const u32x4 w = p[i * 64 + F.lane]; s += (bflo(w.x) - bfhi(w.x)) + (bflo(w.y) - bfhi(w.y)) + (bflo(w.z) - bfhi(w.z)) + (bflo(w.w) - bfhi(w.w)); }
        s = wave_sum(s) * 0.001381067932004975f;
        if (F.lane == 0) FH1[(size_t)b * 1024 + g * 256 + m] = (bf16_t)f2bf(s); }
}
__device__ __forceinline__ void fnet_nyquist_out(Frame& F, const Args& a, int jl) {
    F.refresh();
    const bf16_t* FH1 = (const bf16_t*)(F.ws + WS_FH1); const bf16_t* W = (const bf16_t*)(F.ws + WS_WF) + (size_t)jl * 2048 * 1024; bf16_t* Y = (bf16_t*)a.out;
    LAS float* part = (LAS float*)F.lds;
    const int b = F.blk >> 3, n = (F.blk & 7) * 128 + (F.tid & 127), kq = F.tid >> 7;
    const GAS u32x4* wp = (const GAS u32x4*)(W + (size_t)n * 1024 + kq * 256); const GAS u32x4* fp = (const GAS u32x4*)(FH1 + (size_t)b * 1024 + kq * 256);
    float s = 0.f;
#pragma unroll 4
    for (int i = 0; i < 32; ++i) { const u32x4 w = wp[i], f = fp[i];
        s += bflo(w.x) * bflo(f.x) + bfhi(w.x) * bfhi(f.x) + bflo(w.y) * bflo(f.y) + bfhi(w.y) * bfhi(f.y) + bflo(w.z) * bflo(f.z) + bfhi(w.z) * bfhi(f.z) + bflo(w.w) * bflo(f.w) + bfhi(w.w) * bfhi(f.w); }
    part[F.tid] = s;
    __syncthreads();
    if (F.tid < 128) { const float t = (part[F.tid] + part[F.tid + 128]) + (part[F.tid + 256] + part[F.tid + 384]); Y[((size_t)b * SEQ + 1024) * D + n] = (bf16_t)f2bf(t); }
    __syncthreads();
}


#ifdef SELFCHECK
constexpr int CW_ERR = 1024;
constexpr size_t WS_OCHK = WS_R + 216 * MiB;
__device__ __forceinline__ void chk_report(unsigned* ctl, int id, float got, float ref, float tabs, float trel) {
    float e = fabsf(got - ref) / (tabs + trel * fabsf(ref)); if (!(e == e)) e = 1e30f; atomicMax(ctl + CW_ERR + id, __float_as_uint(e)); }
__device__ __forceinline__ float bf2f(bf16_t b) { return __builtin_bit_cast(float, (unsigned)b << 16); }
__constant__ int chk_toks[16] = {0, 1, 63, 64, 65, 127, 2047, 2048, 2049, 4096, 33000, 65535, 65536, 65537, 70000, 73727};
__constant__ int chk_ks[8] = {0, 1, 2, 255, 256, 1023, 1024, 700};
__constant__ int chk_ms[4] = {0, 1, 128, 255};
__constant__ int chk_ytoks[10] = {0, 1, 1023, 1024, 1025, 2047, 2048, 65535, 65536, 73727};
__constant__ int chk_ns[5] = {0, 1, 255, 256, 1023};
__constant__ int chk_cols[20] = {0, 7, 15, 16, 31, 32, 40, 48, 63, 64, 500, 1023, 1024, 1039, 1040, 1072, 1279, 1280, 1300, 1535};
__device__ __forceinline__ void chk_qkv(Frame& F, const Args& a, int layer, int id) {
    F.refresh(); const bf16_t* U = (const bf16_t*)a.out; const float* W = a.in[8] + (size_t)(layer >> 1) * 1024 * 1536;
    const bf16_t* Qb = (const bf16_t*)(F.ws + WS_Q); const bf16_t* Kb = (const bf16_t*)(F.ws + WS_K); const bf16_t* Vb = (const bf16_t*)(F.ws + WS_V);
    for (int s = F.gw; s < 320; s += NGW) { const int tok = chk_toks[s & 15], col = chk_cols[s >> 4];
        if (layer == 2 && tok >= T && col < 1024) continue;
        const bool rope = (tok < T) && col < 1280; const int hc = col & 63, first = (hc & 31) < 16; const int pcol = rope ? (first ? col + 16 : col - 16) : col;
        float x = 0.f, xp = 0.f;
        for (int k = F.lane; k < 1024; k += 64) { const float u = bf2f(U[(size_t)tok * D + k]); x += u * W[(size_t)k * 1536 + col]; xp += u * W[(size_t)k * 1536 + pcol]; }
        x = wave_sum(x); xp = wave_sum(xp);
        float ref = x;
        if (rope) { const int tl = tok & 2047, part = hc >> 5, pos = part ? (tl & 63) : (tl >> 6), fi = hc & 15; const float ang = (float)pos * powf(10000.f, -(float)fi / 16.f);
            ref = x * cosf(ang) + (first ? -xp : xp) * sinf(ang); }
        if (col < 1024) ref *= C2;
        const float got = col < 1024 ? bf2f(Qb[(size_t)tok * 1024 + col]) : (col < 1280 ? bf2f(Kb[(size_t)tok * 256 + col - 1024]) : bf2f(Vb[(size_t)tok * 256 + col - 1280]));
        if (F.lane == 0) chk_report(F.ctl, id, got, ref, 0.03f, 0.03f); }
}
__device__ __forceinline__ void chk_attn(Frame& F, const Args& a, int layer, int id) {
    F.refresh(); const bf16_t* Qb = (const bf16_t*)(F.ws + WS_Q); const bf16_t* Kb = (const bf16_t*)(F.ws + WS_K); const bf16_t* Vb = (const bf16_t*)(F.ws + WS_V); const bf16_t* Ob = (const bf16_t*)(F.ws + WS_OCHK);
    LAS float* lg = (LAS float*)F.lds + F.wave * 1024;
    for (int s = F.gw; s < 64; s += NGW) { const int tok = chk_toks[s & 15], h = (s >> 4) * 5, kvh = h >> 2;
        if (layer == 2 && tok >= T) continue;
        const bool isctx = tok >= T; const int b = isctx ? (tok - T) / CTXL : tok / SEQ, p = tok & (SEQ - 1);
        int nk = 0; const int lo = isctx ? 0 : (p - 128 < 0 ? 0 : p - 128), hi = isctx ? -1 : (p + 128 > SEQ - 1 ? SEQ - 1 : p + 128);
        const int nlat = isctx ? 0 : hi - lo + 1; nk = nlat + CTXL;
        float mx = a.in[10][(layer >> 1) * 16 + h] * LOG2E; const float sink2 = mx;
        for (int i = F.lane; i < nk; i += 64) { const size_t kr = i < nlat ? (size_t)b * SEQ + lo + i : (size_t)T + b * CTXL + (i - nlat); float d = 0.f;
            for (int e = 0; e < 64; ++e) d += bf2f(Qb[(size_t)tok * 1024 + h * 64 + e]) * bf2f(Kb[kr * 256 + kvh * 64 + e]);
            lg[i] = d; mx = fmaxf(mx, d); }
#pragma unroll
        for (int o = 1; o < 64; o <<= 1) mx = fmaxf(mx, __shfl_xor(mx, o));
        LDS_WAIT();
        float den = 0.f; for (int i = F.lane; i < nk; i += 64) den += exp2f(lg[i] - mx);
        den = wave_sum(den) + exp2f(sink2 - mx);
        float o = 0.f;
        for (int i = 0; i < nk; ++i) { const size_t kr = i < nlat ? (size_t)b * SEQ + lo + i : (size_t)T + b * CTXL + (i - nlat); o += exp2f(lg[i] - mx) * bf2f(Vb[kr * 256 + kvh * 64 + F.lane]); }
        o /= den;
        chk_report(F.ctl, id, bf2f(Ob[(size_t)tok * 1024 + h * 64 + F.lane]), o, 0.01f, 0.03f); chk_report(F.ctl, 32 + (s & 15), bf2f(Ob[(size_t)tok * 1024 + h * 64 + F.lane]), o, 0.01f, 0.03f);
        LDS_WAIT(); }
    __syncthreads();
}
__device__ __forceinline__ void chk_fnet_f(Frame& F, const Args& a, bool upd, int id) {
    F.refresh(); const bf16_t* U = (const bf16_t*)a.out; LAS float* red = (LAS float*)F.lds;
    for (int s = F.blk; s < 128 + (upd ? 64 : 0); s += GRID) {
        const bool cx = s >= 128; const int q = cx ? s - 128 : s; const int m = chk_ms[q & 3], g = ((q >> 2) & 1) * 3, b = ((q >> 3) & 1) * 31; int k = chk_ks[(q >> 4) & 7]; const int L = cx ? CTXL : SEQ; if (cx) k &= 255;
        const size_t row0 = cx ? (size_t)T + b * CTXL : (size_t)b * SEQ;
        float acc = 0.f;
        for (int l = F.wave; l < L; l += NWAVES) { float ca = 0.f, sa = 0.f;
            for (int n = F.lane; n < 256; n += 64) { const float u = bf2f(U[(row0 + l) * D + g * 256 + n]); const float an = 6.283185307179586f * (float)((m * n) & 255) / 256.f; const float sn = __sinf(an), cs = __cosf(an); ca += u * cs; sa += u * sn; }
            ca = wave_sum(ca); sa = wave_sum(sa); const float an = 6.283185307179586f * (float)((k * l) % L) / (float)L; const float sn = __sinf(an), cs = __cosf(an); acc += cs * ca - sn * sa; }
        if (F.lane == 0) red[F.wave] = acc;
        __syncthreads();
        if (F.tid == 0) { float t = 0.f; for (int w = 0; w < NWAVES; ++w) t += red[w]; t *= cx ? (1.f / 256.f) : 0.001381067932004975f;
            float got;
            if (cx) got = bf2f(((const bf16_t*)(F.ws + WS_FC))[((size_t)b * 256 + k) * D + g * 256 + m]);
            else if (k == 1024) got = bf2f(((const bf16_t*)(F.ws + WS_FH1))[(size_t)b * 1024 + g * 256 + m]);
            else got = bf2f(((const bf16_t*)(F.ws + WS_FH))[((size_t)b * 1024 + k) * D + g * 256 + m]);
            chk_report(F.ctl, id, got, t, 0.02f, 0.03f); }
        __syncthreads(); }
}
__device__ __forceinline__ void chk_fnet_y(Frame& F, const Args& a, int jl, bool upd, int id) {
    F.refresh(); const bf16_t* Y = (const bf16_t*)a.out; const float* W = a.in[11] + (size_t)jl * 1024 * 1024;
    const bf16_t* FH = (const bf16_t*)(F.ws + WS_FH); const bf16_t* FH1 = (const bf16_t*)(F.ws + WS_FH1); const bf16_t* FC = (const bf16_t*)(F.ws + WS_FC);
    for (int s = F.gw; s < 50; s += NGW) { const int tok = chk_ytoks[s % 10], n = chk_ns[s / 10]; if (tok >= T && !upd) continue;
        float acc = 0.f;
        for (int j = F.lane; j < 1024; j += 64) { float f;
            if (tok >= T) f = bf2f(FC[(size_t)(tok - T) * D + j]);
            else { const int b = tok >> 11, k = tok & 2047; if (k < 1024) f = bf2f(FH[((size_t)b * 1024 + k) * D + j]); else if (k == 1024) f = bf2f(FH1[(size_t)b * 1024 + j]);
                else f = bf2f(FH[((size_t)b * 1024 + (2048 - k)) * D + (j & ~255) + ((256 - (j & 255)) & 255)]); }
            acc += f * W[(size_t)j * 1024 + n]; }
        acc = wave_sum(acc);
        if (F.lane == 0) chk_report(F.ctl, id, bf2f(Y[(size_t)tok * D + n]), acc, 0.02f, 0.03f); }
}
__device__ __forceinline__ void chk_route(Frame& F, const Args& a, int layer, int ntok, int id) {
    F.refresh(); const bf16_t* U = (const bf16_t*)a.out; const float* Wr = a.in[12] + (size_t)layer * 1024 * 64; const int* tke = (const int*)(F.ws + WS_TKE); const float* tkw = (const float*)(F.ws + WS_TKW);
    for (int s = F.gw; s < 16; s += NGW) { const int tok = chk_toks[s]; if (tok >= ntok) continue; const int lane = F.lane;
        float lgt = 0.f; for (int k = 0; k < 1024; ++k) lgt += bf2f(U[(size_t)tok * D + k]) * Wr[(size_t)k * 64 + lane];
        const float sc = 1.f / (1.f + expf(-lgt)), sel = sc + a.in[13][layer * 64 + lane];
        float g1 = -INFINITY, g2 = -INFINITY;
#pragma unroll 1
        for (int j = 0; j < 8; ++j) { const float v = __shfl(sel, (lane & ~7) + j); if (v > g1) { g2 = g1; g1 = v; } else if (v > g2) g2 = v; }
        const float gs = g1 + g2; int gr = 0;
#pragma unroll 1
        for (int gp = 0; gp < 8; ++gp) { const float v = __shfl(gs, gp * 8); gr += (v > gs || (v == gs && gp < (lane >> 3))) ? 1 : 0; }
        const float sm = gr < 4 ? sel : -INFINITY; int rk = 0;
#pragma unroll 1
        for (int ep = 0; ep < 64; ++ep) { const float v = __shfl(sm, ep); rk += (v > sm || (v == sm && ep < lane)) ? 1 : 0; }
        const float tot = wave_sum(rk < 8 ? sc : 0.f); const float wref = sc / tot * 2.5f;
        int slot = -1; for (int j = 0; j < 8; ++j) if (tke[(size_t)tok * 8 + j] == lane) slot = j;
        float err = 0.f;
        if (slot >= 0) { if (rk >= 10) err = 10.f; else if (rk < 8) err = fabsf(tkw[(size_t)tok * 8 + slot] - wref) / (0.04f * wref); }
        else if (rk < 6) err = 10.f;
        const unsigned long long nsel = __ballot(slot >= 0); if (__builtin_popcountll(nsel) != 8) err = 20.f;
        atomicMax(F.ctl + CW_ERR + id, __float_as_uint(err)); }
}
__device__ __forceinline__ void chk_moe(Frame& F, const Args& a, int layer, int ntok, int ch, int id) {
    F.refresh(); const bf16_t* U = (const bf16_t*)a.out; const int* tke = (const int*)(F.ws + WS_TKE); const float* tkw = (const float*)(F.ws + WS_TKW);
    const int CH = ntok / NCHUNK; LAS float* hs = (LAS float*)F.lds; LAS float* us = hs + 512; LAS float* pg_ = us + 1024;
    for (int s = F.blk; s < 16; s += GRID) { const int tok = chk_toks[s]; if (tok >= ntok || tok / CH != ch) continue;
        for (int k = F.tid; k < 1024; k += NTHR) us[k] = bf2f(U[(size_t)tok * D + k]);
        __syncthreads();
        float y0 = 0.f, y1 = 0.f;
        for (int j = 0; j < 9; ++j) { const int e = j < 8 ? tke[(size_t)tok * 8 + j] : 0; const float w = j < 8 ? tkw[(size_t)tok * 8 + j] : 1.f;
            const float* wg = j < 8 ? a.in[14] + ((size_t)layer * NE + e) * 262144 : a.in[17] + (size_t)layer * 262144;
            const float* wu = j < 8 ? a.in[15] + ((size_t)layer * NE + e) * 262144 : a.in[18] + (size_t)layer * 262144;
            const float* wd = j < 8 ? a.in[16] + ((size_t)layer * NE + e) * 262144 : a.in[19] + (size_t)layer * 262144;
            const int hh = F.tid & 255, half = F.tid >> 8; float g = 0.f, u = 0.f;
            for (int k = half * 512; k < half * 512 + 512; ++k) { g += us[k] * wg[(size_t)k * 256 + hh]; u += us[k] * wu[(size_t)k * 256 + hh]; }
            pg_[F.tid] = g; pg_[512 + F.tid] = u;
            __syncthreads();
            if (F.tid < 256) { const float gg = pg_[F.tid] + pg_[F.tid + 256], uu = pg_[512 + F.tid] + pg_[512 + F.tid + 256]; hs[F.tid] = gg / (1.f + expf(-gg)) * uu; }
            __syncthreads();
            float t0 = 0.f, t1 = 0.f; for (int q = 0; q < 256; ++q) { t0 += hs[q] * wd[(size_t)q * 1024 + F.tid]; t1 += hs[q] * wd[(size_t)q * 1024 + 512 + F.tid]; }
            y0 += w * t0; y1 += w * t1;
            __syncthreads(); }
        float g0 = 0.f, g1 = 0.f; const int i = tok - ch * CH;
        { const unsigned char* YSb = (const unsigned char*)(F.ws + WS_YS); const unsigned char* YBb = (const unsigned char*)(F.ws + WS_YB); const int* spos = (const int*)(F.ws + WS_SDST);
          const int t_ = F.tid, bo = 16 * (16 * (t_ >> 8) + ((t_ & 127) >> 3)) + 8 * ((t_ >> 7) & 1) + (t_ & 7);
          auto f8 = [](unsigned char b) { return __builtin_amdgcn_cvt_pk_f32_fp8((int)b, false)[0] * (1.f / 16.f); };
          g0 = f8(YSb[(size_t)i * D + bo]); g1 = f8(YSb[(size_t)i * D + bo + 512]);
          for (int j = 0; j < 8; ++j) { const size_t ps = (size_t)spos[(size_t)tok * 8 + j]; const float w = tkw[(size_t)tok * 8 + j]; g0 += w * f8(YBb[ps * D + bo]); g1 += w * f8(YBb[ps * D + bo + 512]); } }
        chk_report(F.ctl, id, g0, y0, 0.04f, 0.06f); chk_report(F.ctl, id, g1, y1, 0.04f, 0.06f);
        __syncthreads(); }
}
#endif

#ifndef PH_MASK
#define PH_MASK 0xffffffffu
#endif
#define PH(b) ((PH_MASK >> (b)) & 1u)
__global__ void __launch_bounds__(NTHR, 2) fwd(Args a) {
    extern __shared__ __attribute__((aligned(16))) unsigned char lds_raw[];
    Frame F;
    F.lds = (LAS unsigned char*)lds_raw; F.ws = a.ws; F.ctl = (unsigned*)(a.ws + WS_CTL);
    F.blk = blockIdx.x; F.refresh();
    for (int u = F.tid; u < (LDS_BYTES - RING_BYTES) / 4; u += NTHR) ((LAS unsigned*)(F.lds + RING_BYTES))[u] = 0u;
    __syncthreads();
    const XcdBarrier bar = xcd_barrier_post(F.ctl + CW_BAR, (volatile LAS unsigned*)(F.lds + L_MISC) + 8);
#define GRID_BAR() xcd_barrier(bar)
    LAS unsigned char* ring = F.lds;
    const int c = F.blk;
#define ws (F.ws)
#define NEWPH() F.refresh()

    if (PH(0)) { conv_small(F, a);
    __syncthreads();
    mod_partials(F, a); }
    GRID_BAR();
    if (PH(1)) { rows_init(F, a);
    mod_finalize(F, a); }
    GRID_BAR();

    for (int layer = 0; layer < 4; ++layer) {
        const int jl = layer >> 1; const bool upd = layer < 2; const int nrows = upd ? TT : T;
        if ((layer & 1) == 0) {
            NEWPH();
            if (PH(2)) { SchedQKV S; S.U = (const char*)a.out; S.W = (const char*)(ws + WS_WQKV) + (size_t)jl * 1536 * 2048; S.nfull = (layer == 0) ? 288 * 6 : 256 * 6; S.nu = (layer == 0) ? 288 * 6 : 256 * 6 + 64; S.c = c;
              pg::EpiQKV E; E.Q = (bf16_t*)(ws + WS_Q); E.K = (bf16_t*)(ws + WS_K); E.V = (bf16_t*)(ws + WS_V); E.ropec = (const float*)(ws + WS_ROPEC); E.ropes = (const float*)(ws + WS_ROPES);
              pg::gemm_phase<pg::EpiQKV, SchedQKV, false>(ring, 2048u, 2048u, nullptr, S, E); }
            GRID_BAR();
#ifdef SELFCHECK
            if (SELFCHECK & 1) chk_qkv(F, a, layer, 1 + (layer >> 1));
#define OBUF ((bf16_t*)(ws + WS_OCHK))
#else
#define OBUF ((bf16_t*)(ws + WS_Q))
#endif
            NEWPH();
            if (PH(3)) { const int NU = 4096 + (layer == 0 ? 512 : 0);
              const bf16_t* Qb = (const bf16_t*)(ws + WS_Q); const bf16_t* Kb = (const bf16_t*)(ws + WS_K); const bf16_t* Vb = (const bf16_t*)(ws + WS_V);
              for (int i = 0; i * GRID + c < NU; ++i) { int id = pg::xcd_remap(i * GRID + c, NU);
                  if (NU > 4096) { const int g9 = id / 9, r9 = id - g9 * 9; id = (r9 < 8) ? g9 * 8 + r9 : 4096 + g9; }
                  if (id < 4096) { const int hq = id & 3, qb = (id >> 2) & 7, kvh = (id >> 5) & 3, b = id >> 7, h = kvh * 4 + hq;
                      attn::attn_unit(Qb, Kb, Vb, OBUF, b, h, qb * 256, false, a.in[10][jl * 16 + h] * LOG2E, ring); }
                  else { const int cid = id - 4096, hq = cid & 3, kvh = (cid >> 2) & 3, b = cid >> 4, h = kvh * 4 + hq;
                      attn::attn_unit(Qb, Kb, Vb, OBUF, b, h, 0, true, a.in[10][jl * 16 + h] * LOG2E, ring); } } }
            GRID_BAR();
#ifdef SELFCHECK
            if (SELFCHECK & 1) chk_attn(F, a, layer, 3 + (layer >> 1));
#endif
            NEWPH();
            if (PH(4)) { SchedDense S; S.A = (const char*)OBUF; S.W = (const char*)(ws + WS_WO) + (size_t)jl * 1024 * 2048; S.out = (char*)a.out; S.nrt = nrows / 256; S.nct = 4; S.nt = 16; S.c = c; S.ldA = 2048;
              pg::EpiStore E; pg::gemm_phase<pg::EpiStore, SchedDense, false>(ring, 2048u, 2048u, nullptr, S, E); }
            GRID_BAR();
        } else {
            NEWPH();
            if (PH(5)) { SchedF1 S; S.CS = (const char*)(ws + WS_CSN); S.U = (const char*)a.out; S.ABT = (char*)(ws + WS_ABT); S.ABTC = (char*)(ws + WS_ABTC); S.nu = 2048 + (upd ? 256 : 0); S.c = c;
              pg::EpiStore E; pg::gemm_phase<pg::EpiStore, SchedF1, false>(ring, 512u, 2048u, nullptr, S, E); }
            GRID_BAR();
            NEWPH();
            if (PH(6)) { SchedF2 S; S.DL = (const char*)(ws + WS_DL); S.ABT = (const char*)(ws + WS_ABT); S.FH = (char*)(ws + WS_FH); S.c = c;
              pg::EpiStore E; pg::gemm_phase<pg::EpiStore, SchedF2, false>(ring, 8192u, 8192u, nullptr, S, E); }
            NEWPH();
            if (PH(7) && upd) { SchedF2c S; S.DLC = (const char*)(ws + WS_DLC); S.ABTC = (const char*)(ws + WS_ABTC); S.FC = (char*)(ws + WS_FC); S.c = c;
              pg::EpiStore E; pg::gemm_phase<pg::EpiStore, SchedF2c, false>(ring, 1024u, 1024u, nullptr, S, E); }
            if (PH(8)) fnet_nyquist_rows(F);
            GRID_BAR();
#ifdef SELFCHECK
            if (SELFCHECK & 2) chk_fnet_f(F, a, upd, 5 + (layer >> 1));
            GRID_BAR();
#endif
            NEWPH();
            if (PH(9)) { SchedF3 S; S.FH = (const char*)(ws + WS_FH); S.FC = (const char*)(ws + WS_FC); S.W = (const char*)(ws + WS_WF) + (size_t)jl * 2048 * 2048; S.Y = (char*)a.out; S.nu = 1024 + (upd ? 128 : 0); S.c = c;
              pg::EpiStore E; pg::gemm_phase<pg::EpiStore, SchedF3, false>(ring, 2048u, 2048u, nullptr, S, E); }
            if (PH(10)) fnet_nyquist_out(F, a, jl);
            GRID_BAR();
#ifdef SELFCHECK
            if (SELFCHECK & 8) chk_fnet_y(F, a, jl, upd, 7 + (layer >> 1));
            GRID_BAR();
#endif
        }
        if (PH(12)) conv_experts(F, a.in[14], a.in[15], a.in[16], layer);
        __syncthreads();
        if (PH(11)) rows_post1(F, a, layer, nrows);
        VM_WAIT(); __syncthreads();
        if (threadIdx.x == 0) { __builtin_amdgcn_fence(__ATOMIC_ACQUIRE, "agent"); VM_WAIT(); }
        __syncthreads();
        if (PH(13)) route_tokens(F, a, layer, nrows);
        GRID_BAR();
#ifdef SELFCHECK
        if ((SELFCHECK & 4) && layer < 2) chk_route(F, a, layer, nrows, 9);
#endif
        if (PH(14)) build_lists(F, nrows);
        GRID_BAR();
        LAS const int* tstart = (LAS const int*)(F.lds + L_TSTART); LAS const unsigned char* tseg = (LAS const unsigned char*)(F.lds + L_TSEG);
        const int ntl = __builtin_amdgcn_readfirstlane(tstart[NCHUNK * 64]);
        NEWPH();
        if (PH(15)) { SchedG1 S; S.EGU = (const char*)(ws + WS_EGU); S.WSG = (const char*)(ws + WS_WSH) + (size_t)layer * 1536 * 1024; S.STOK = (const int*)(ws + WS_STOK); S.H = (char*)(ws + WS_H); S.HS = (char*)(ws + WS_HS); S.tseg = tseg; S.ntl = ntl; S.nsh = nrows / 256; S.c = c;
          pg::EpiSilu E; pg::gemm_phase<pg::EpiSilu, SchedG1, true>(ring, 2048u, 2048u, (const char*)a.out, S, E); }
        GRID_BAR();
        const int CH = nrows / NCHUNK;
        for (int ch = 0; ch < NCHUNK; ++ch) {
            NEWPH();
            if (PH(16)) { SchedG2 S; S.ED = (const char*)(ws + WS_ED); S.WSD = (const char*)(ws + WS_WSH) + (size_t)layer * 1536 * 1024 + 512 * 2048; S.H = (const char*)(ws + WS_H); S.HS = (const char*)(ws + WS_HS); S.YB = (char*)(ws + WS_YB); S.YS = (char*)(ws + WS_YS); S.tseg = tseg;
              S.t0 = __builtin_amdgcn_readfirstlane(tstart[ch * 64]); S.t1 = __builtin_amdgcn_readfirstlane(tstart[ch * 64 + 64]); S.nsh = CH / 256; S.ch = ch; S.CH = CH; S.c = c;
              pg::EpiFp8 E; pg::gemm_phase<pg::EpiFp8, SchedG2, false>(ring, 512u, 512u, nullptr, S, E); }
            GRID_BAR();
#ifdef SELFCHECK
            if ((SELFCHECK & 4) && (layer == 0 || layer == 3)) { if (layer == 0 || ch == 0) chk_moe(F, a, layer, nrows, ch, 10 + (layer == 3)); GRID_BAR(); }
#endif
            if (PH(17)) rows_post2(F, a, layer, ch * CH, CH);
            if (!(layer == 3 && ch == NCHUNK - 1)) GRID_BAR();
        }
    }
#ifdef SELFCHECK
    GRID_BAR();
    { int bad = 0; float be = 0.f; for (int k = 15; k >= 1; --k) { const float e = __uint_as_float(__hip_atomic_load(F.ctl + CW_ERR + k, RLX_AGENT)); if (e > 1.f) { bad = k; be = e; } }
      int wt = 0; float we = 0.f; for (int k = 0; k < 16; ++k) { const float e = __uint_as_float(__hip_atomic_load(F.ctl + CW_ERR + 32 + k, RLX_AGENT)); if (e > we) { we = e; wt = k; } }
      if (bad) { F.refresh(); float cv = 3.f + bad + (be > 8.f ? 0.5f : 0.f);  Row r; for (int j = 0; j < 4; ++j) r.v[j] = (f32x4){cv, cv, cv, cv}; for (int row = F.gw; row < T; row += NGW) row_store_f32(r, a.out + (size_t)row * D, F.lane); } }
#endif
}

#undef ws
#undef NEWPH
extern "C" void kernel_launch(void* const* d_in, const int* in_sizes, int n_in, void* d_out, int out_size, void* d_ws, size_t ws_size, hipStream_t stream) {
    static int ready = 0;
    if (ready == 0) {
        if (n_in != 20 || out_size != T * D || ws_size < WS_END) { fprintf(stderr, "kernel_launch: unexpected problem (n_in %d out %d ws %zu need %zu)\n", n_in, out_size, ws_size, (size_t)WS_END); ready = -1; return; }
        if (hipFuncSetAttribute((const void*)fwd, hipFuncAttributeMaxDynamicSharedMemorySize, LDS_BYTES) != hipSuccess) { fprintf(stderr, "kernel_launch: hipFuncSetAttribute failed\n"); ready = -1; return; }
        int per_cu = 0;
        if (hipOccupancyMaxActiveBlocksPerMultiprocessor(&per_cu, (const void*)fwd, NTHR, LDS_BYTES) != hipSuccess || per_cu < 1) fprintf(stderr, "kernel_launch: occupancy query says %d blocks per CU\n", per_cu);
        (void)hipGetLastError();
        ready = 1;
    }
    if (ready < 0) return;
    (void)hipMemsetAsync((char*)d_ws + WS_CTL, 0, CTL_BYTES, stream);
    Args a{};
    for (int i = 0; i < 20; ++i) a.in[i] = (const float*)d_in[i];
    a.out = (float*)d_out; a.ws = (unsigned char*)d_ws;
    hipLaunchKernelGGL(fwd, dim3(GRID), dim3(NTHR), LDS_BYTES, stream, a);
}
```

```cpp
#include <hip/hip_runtime.h>
#include <cstdio>
#include <cstdint>

#define LAS __attribute__((address_space(3)))
#define GAS __attribute__((address_space(1)))
typedef unsigned short bf16_t;
typedef short bf16x8 __attribute__((ext_vector_type(8)));
typedef short s16x4 __attribute__((ext_vector_type(4)));
typedef float f32x4 __attribute__((ext_vector_type(4)));
typedef float f32x16 __attribute__((ext_vector_type(16)));
typedef unsigned u32x4 __attribute__((ext_vector_type(4)));
typedef unsigned u32x2 __attribute__((ext_vector_type(2)));
typedef int v8i_t __attribute__((ext_vector_type(8)));
typedef int v4i_t __attribute__((ext_vector_type(4)));

constexpr int D = 1024, NB = 32, SEQ = 2048, T = NB * SEQ, CTXL = 256, TC = NB * CTXL, TT = T + TC;
constexpr int NQKV = 1536, NE = 64;
constexpr float ALPHA = 1.681792830507429f;
constexpr float LN_EPS = 1e-5f, MOD_EPS = 1e-6f;
constexpr float C2 = 0.125f * 1.4426950408889634f;
constexpr float LOG2E = 1.4426950408889634f;
constexpr int NCHUNK = 2;
constexpr int NWAVES = 8, NTHR = 512, GRID = 256;

constexpr size_t MiB = 1u << 20;
constexpr size_t WS_CTL = 0, CTL_BYTES = 1 * MiB;
constexpr size_t WS_ROPEC = 1 * MiB, WS_ROPES = 1 * MiB + 4096, WS_CSN = 1 * MiB + 65536, WS_DLC = 1 * MiB + 524288, WS_DL = 2 * MiB;
constexpr size_t WS_WQKV = 10 * MiB, WS_WO = 16 * MiB, WS_WF = 20 * MiB, WS_WR = 28 * MiB, WS_WSH = 29 * MiB;
constexpr size_t WS_MODP = 36 * MiB, WS_MOD = 49 * MiB;
constexpr size_t WS_EGU = 54 * MiB, WS_ED = 118 * MiB;
constexpr size_t WS_XS = 150 * MiB;
constexpr size_t WS_STOK = 294 * MiB, WS_SDST = 297 * MiB, WS_SW = 300 * MiB, WS_TKE = 303 * MiB, WS_TKW = 306 * MiB;
constexpr size_t WS_R = 309 * MiB;
constexpr size_t WS_Q = WS_R, WS_K = WS_R + 144 * MiB, WS_V = WS_R + 180 * MiB;
constexpr size_t WS_ABT = WS_R, WS_FH = WS_R + 256 * MiB, WS_FH1 = WS_R + 320 * MiB, WS_ABTC = WS_R + 321 * MiB, WS_FC = WS_R + 353 * MiB;
constexpr size_t WS_H = WS_R, WS_HS = WS_R + 320 * MiB, WS_YB = WS_R + 356 * MiB, WS_YS = WS_R + 676 * MiB;
constexpr size_t WS_END = WS_YS + 36 * MiB;
constexpr size_t OUT_U8 = 144 * MiB;
constexpr int WSCALE_E8M0 = 121;
constexpr int MAXROWS = 655360;

constexpr int CW_TMO = 0, CW_BAR = 4096, CW_BCNT = 16384;

constexpr int RING_BYTES = 131072;
constexpr int L_MISC = RING_BYTES;
constexpr int L_TSTART = RING_BYTES + 256;
constexpr int L_PREF = L_TSTART + 1040;
constexpr int L_LCNT = L_PREF + 256;
constexpr int L_TSEG = L_LCNT + 256;
constexpr int L_SCAN = L_TSEG + 2560;
constexpr int LDS_BYTES = 139264;
static_assert(L_SCAN + 1024 <= LDS_BYTES, "LDS map");

#define RLX_AGENT __ATOMIC_RELAXED, __HIP_MEMORY_SCOPE_AGENT
#define LDS_WAIT() asm volatile("s_waitcnt lgkmcnt(0)" ::: "memory")
#define VM_WAIT() asm volatile("s_waitcnt vmcnt(0)" ::: "memory")

__device__ __forceinline__ unsigned f2bf(float f) { unsigned u = __builtin_bit_cast(unsigned, f); return (u + 0x7fffu + ((u >> 16) & 1u)) >> 16; }
__device__ __forceinline__ unsigned pk2(float lo, float hi) { return f2bf(lo) | (f2bf(hi) << 16); }
typedef float f32x2_t __attribute__((ext_vector_type(2))); typedef __bf16 bf16x2_t __attribute__((ext_vector_type(2)));
__device__ __forceinline__ unsigned cvt_pk_bf16(float lo, float hi) { f32x2_t v = {lo, hi}; bf16x2_t b = __builtin_convertvector(v, bf16x2_t); return __builtin_bit_cast(unsigned, b); }
__device__ __forceinline__ float bflo(unsigned w) { return __builtin_bit_cast(float, w << 16); }
__device__ __forceinline__ float bfhi(unsigned w) { return __builtin_bit_cast(float, w & 0xffff0000u); }
__device__ __forceinline__ float wave_sum(float v) {
#pragma unroll
    for (int o = 1; o < 64; o <<= 1) v += __shfl_xor(v, o);
    return v;
}

__device__ __forceinline__ int opaque_tid() { int t = threadIdx.x; asm volatile("" : "+v"(t)); return t; }

#define XB_TMO      128
#define XB_XCNT(j)  (256  + 64 * (j))
#define XB_XSUB(j)  (1280 + 64 * (j))
#define XB_XGEN(j)  (2304 + 64 * (j))
#define XB_TOP      3328
#define XB_TOPGEN   3392
#define XCD_BAR_WORDS 3456
#define XB_SPIN_CAP (1u << 22)
__device__ __forceinline__ unsigned xb_ld(unsigned* p)              { return __hip_atomic_load(p, __ATOMIC_RELAXED, __HIP_MEMORY_SCOPE_AGENT); }
__device__ __forceinline__ unsigned xb_add(unsigned* p, unsigned v) { return __hip_atomic_fetch_add(p, v, __ATOMIC_RELAXED, __HIP_MEMORY_SCOPE_AGENT); }
__device__ __forceinline__ unsigned xb_xcc_id() { return (unsigned)__builtin_amdgcn_s_getreg((3 << 11) | 20) & 0xFu; }
#define XB_SPIN(cond, bar) do { unsigned _sp = 0; while (cond) { __builtin_amdgcn_s_sleep(1); \
    if ((++_sp & 255u) == 0u) { if (xb_ld(&(bar)[XB_TMO])) break; if (_sp > XB_SPIN_CAP) { atomicAdd(&(bar)[XB_TMO], 1u); break; } } } } while (0)
struct XcdBarrier { unsigned* bar; unsigned x; volatile LAS unsigned* st; };
__device__ __forceinline__ XcdBarrier xcd_barrier_post(unsigned* bar, volatile LAS unsigned* st) {
    XcdBarrier b; b.bar = bar; b.x = xb_xcc_id(); b.st = st;
    if (threadIdx.x == 0) (void)xb_add(&bar[XB_XCNT(b.x)], 1u);
    return b;
}
__device__ __forceinline__ void xcd_barrier_complete(unsigned* bar, unsigned x, unsigned& nloc, unsigned& nx) {
    const unsigned G = gridDim.x * gridDim.y * gridDim.z;
    unsigned sum, cnt, mine, sp = 0u;
    for (;;) {
        sum = 0u; cnt = 0u; mine = 0u;
#pragma unroll
        for (unsigned j = 0; j < 16; ++j) { const unsigned c = xb_ld(&bar[XB_XCNT(j)]); sum += c; cnt += (c > 0u) ? 1u : 0u; mine = (j == x) ? c : mine; }
        if (sum == G) break;
        __builtin_amdgcn_s_sleep(1);
        if ((++sp & 255u) == 0u) { if (xb_ld(&bar[XB_TMO])) break; if (sp > XB_SPIN_CAP) { atomicAdd(&bar[XB_TMO], 1u); break; } }
    }
    nloc = mine > 0u ? mine : 1u; nx = cnt > 0u ? cnt : 1u;
}
__device__ __forceinline__ void xcd_barrier(const XcdBarrier& b) {
    asm volatile("s_waitcnt vmcnt(0)" ::: "memory");
    __syncthreads();
    if (threadIdx.x == 0) {
        unsigned* bar = b.bar; unsigned bx = b.x; asm volatile("" : "+s"(bx));
        __builtin_amdgcn_s_waitcnt(0);
        unsigned nloc = b.st[0], nx = b.st[1];
        if (nloc == 0u) { xcd_barrier_complete(bar, bx, nloc, nx); b.st[0] = nloc; b.st[1] = nx; }
        const unsigned old = xb_add(&bar[XB_XSUB(bx)], 1u);
        const unsigned gen = old / nloc;
        if (old + 1u == (gen + 1u) * nloc) {
            __builtin_amdgcn_fence(__ATOMIC_RELEASE, "agent");
            asm volatile("s_waitcnt vmcnt(0)" ::: "memory");
            const unsigned og = xb_add(&bar[XB_TOP], 1u);
            const unsigned tg = og / nx;
            if (og + 1u == (tg + 1u) * nx) xb_add(&bar[XB_TOPGEN], 1u);
            else XB_SPIN(xb_ld(&bar[XB_TOPGEN]) == tg, bar);
            __builtin_amdgcn_fence(__ATOMIC_ACQUIRE, "agent");
            xb_add(&bar[XB_XGEN(bx)], 1u);
            asm volatile("s_waitcnt vmcnt(0)" ::: "memory");
        } else {
            XB_SPIN(xb_ld(&bar[XB_XGEN(bx)]) == gen, bar);
            __builtin_amdgcn_fence(__ATOMIC_ACQUIRE, "agent");
            asm volatile("s_waitcnt vmcnt(0)" ::: "memory");
        }
    }
    __syncthreads();
}

namespace pg {
constexpr int BM = 256, BK = 64, HALF = 128, HTB = HALF * BK * 2;
__host__ __device__ __forceinline__ int lds_byte(int r, int c) { const int st = (r >> 4) * 2 + (c >> 5), rr = r & 15, cc = c & 31, ob = rr * 64 + cc * 2; return st * 1024 + (ob ^ (((ob >> 9) & 1) << 5)); }
__host__ __device__ __forceinline__ void stage_rc(int b, int& R, int& C) { const int st = b / 1024, sb = b % 1024, swz = sb ^ (((sb >> 9) & 1) << 5); R = (st >> 1) * 16 + swz / 64; C = (st & 1) * 32 + (swz % 64) / 2; }
__host__ __device__ __forceinline__ int perm32(int rho) { const int n = rho >> 4, i = rho & 15; return 8 * (i >> 2) + 4 * n + (i & 3); }

struct Unit {
    const char* A;
    const char* B;
    const int* gidx;
    int gbase;
    int nt;
    char* out; int ldc; float scale; int flags; int i0; int i1;
};

template <class Epi, class Sched, bool GATHER, bool F8 = false>
__device__ __forceinline__ void gemm_phase(LAS unsigned char* lds, const unsigned lda, const unsigned ldb, const char* gtable, const Sched& S, const Epi& E) {
    const int tid = opaque_tid(), wid = __builtin_amdgcn_readfirstlane(tid >> 6), lane = tid & 63, wr = wid >> 2, wc = wid & 3, fr = lane & 15, fq = lane >> 4;
    unsigned voffA[2], voffB[2];
#pragma unroll
    for (int i = 0; i < 2; ++i) { int R, C; stage_rc(tid * 16 + i * 8192, R, C); const int Rb = (R & ~31) + perm32(R & 31);
        voffA[i] = (unsigned)R * lda + (unsigned)C * 2u; voffB[i] = (unsigned)Rb * ldb + (unsigned)C * 2u; }
    const size_t kstep = (size_t)(BK * 2);
    const size_t hstepA = (size_t)HALF * lda, hstepB = (size_t)HALF * ldb;
    const unsigned ldsw = (unsigned)wid * 1024u;
    const int aoff = lds_byte(wr * 64 + fr, fq * 8), boff = lds_byte(wc * 32 + fr, fq * 8);
#define PG_SA(b, h) (((b) * 2 + (h)) * HTB)
#define PG_SB(b, h) ((4 + (b) * 2 + (h)) * HTB)
#define PG_ST2(bufoff, p0, p1) do { \
        __builtin_amdgcn_global_load_lds((const unsigned*)(p0), (LAS unsigned*)(lds + (bufoff) + ldsw), 16, 0, 0); \
        __builtin_amdgcn_global_load_lds((const unsigned*)(p1), (LAS unsigned*)(lds + (bufoff) + ldsw + 8192), 16, 0, 0); } while (0)
#define PG_STB(bufoff, bp) PG_ST2(bufoff, (bp) + voffB[0], (bp) + voffB[1])
#define PG_STA(bufoff, ap, h, nx) do { if constexpr (GATHER) { PG_ST2(bufoff, (ap) + ((nx) ? nO[h][0] : cO[h][0]), (ap) + ((nx) ? nO[h][1] : cO[h][1])); } \
        else { PG_ST2(bufoff, (ap) + (h) * hstepA + voffA[0], (ap) + (h) * hstepA + voffA[1]); } } while (0)
#define PG_LD8(p) ({ const v4i_t lo_ = *(const LAS v4i_t*)(p), hi_ = *(const LAS v4i_t*)((p) + 1024); __builtin_shufflevector(lo_, hi_, 0, 1, 2, 3, 4, 5, 6, 7); })
#define PG_LDA(dst, b, h) do { if constexpr (F8) { _Pragma("unroll") for (int m = 0; m < 4; ++m) dst##8[m] = PG_LD8(lds + PG_SA(b, h) + aoff + m * 2048); } \
        else { _Pragma("unroll") for (int m = 0; m < 4; ++m) _Pragma("unroll") for (int k = 0; k < 2; ++k) dst[m][k] = *(const LAS bf16x8*)(lds + PG_SA(b, h) + aoff + m * 2048 + k * 1024); } } while (0)
#define PG_LDB(dst, b, h) do { if constexpr (F8) { _Pragma("unroll") for (int n = 0; n < 2; ++n) dst##8[n] = PG_LD8(lds + PG_SB(b, h) + boff + n * 2048); } \
        else { _Pragma("unroll") for (int n = 0; n < 2; ++n) _Pragma("unroll") for (int k = 0; k < 2; ++k) dst[n][k] = *(const LAS bf16x8*)(lds + PG_SB(b, h) + boff + n * 2048 + k * 1024); } } while (0)
#define PG_MMA(ai, bj, At, Bt) do { __builtin_amdgcn_s_setprio(1); _Pragma("unroll") for (int m = 0; m < 4; ++m) _Pragma("unroll") for (int n = 0; n < 2; ++n) { \
        if constexpr (F8) { asm volatile("v_mfma_scale_f32_16x16x128_f8f6f4 %0, %1, %2, %0, %3, %4 op_sel_hi:[0,0,0]" : "+v"(acc[ai][bj][m][n]) : "v"(Bt##8[n]), "v"(At##8[m]), "v"(sc_w), "v"(sc_x)); } \
        else { _Pragma("unroll") for (int k = 0; k < 2; ++k) acc[ai][bj][m][n] = __builtin_amdgcn_mfma_f32_16x16x32_bf16(Bt[n][k], At[m][k], acc[ai][bj][m][n], 0, 0, 0); } } \
        __builtin_amdgcn_s_setprio(0); } while (0)
#define PG_WAIT_V(n) asm volatile("s_waitcnt vmcnt(" #n ")" ::: "memory")
#define PG_WAIT_L(n) asm volatile("s_waitcnt lgkmcnt(" #n ")" ::: "memory")
#define PG_BAR __builtin_amdgcn_s_barrier()
#define PG_SCHED __builtin_amdgcn_sched_barrier(0)
#define PG_GOFF(dst, u) do { const int tz_ = opaque_tid(); _Pragma("unroll") for (int i = 0; i < 2; ++i) { int R_, C_; stage_rc(tz_ * 16 + i * 8192, R_, C_); \
        _Pragma("unroll") for (int h = 0; h < 2; ++h) { const int rr = h * HALF + R_; \
        const int ix = (u).gidx ? ((const GAS int*)(u).gidx)[rr] : (u).gbase + rr; dst[h][i] = (unsigned)ix * lda + (unsigned)C_ * 2u; } } } while (0)
#define PG_GIDX(dst, un) do { const int* gi_ = nullptr; int gb_ = 0; const bool ok_ = S.gsrc((un), gi_, gb_); const int tz_ = opaque_tid(); _Pragma("unroll") for (int i = 0; i < 2; ++i) { int R_, C_; stage_rc(tz_ * 16 + i * 8192, R_, C_); \
        _Pragma("unroll") for (int h = 0; h < 2; ++h) { const int rr = h * HALF + R_; dst[h][i] = (ok_ && gi_) ? ((const GAS int*)gi_)[rr] : gb_ + rr; } } } while (0)
#define PG_GCVT(dst, src) do { const int tz_ = opaque_tid(); _Pragma("unroll") for (int i = 0; i < 2; ++i) { int R_, C_; stage_rc(tz_ * 16 + i * 8192, R_, C_); \
        _Pragma("unroll") for (int h = 0; h < 2; ++h) dst[h][i] = (unsigned)src[h][i] * lda + (unsigned)C_ * 2u; } } while (0)
    Unit cur, nxt; int ui = 0;
    if (!S.next(0, cur)) return;
    f32x4 acc[2][2][4][2];
#pragma unroll
    for (int a = 0; a < 2; ++a)
#pragma unroll
        for (int b = 0; b < 2; ++b)
#pragma unroll
            for (int m = 0; m < 4; ++m)
#pragma unroll
                for (int n = 0; n < 2; ++n) acc[a][b][m][n] = (f32x4){0.f, 0.f, 0.f, 0.f};
    bf16x8 At[4][2], B0[2][2], B1[2][2]; v8i_t At8[4], B08[2], B18[2];
    const int sc_w = WSCALE_E8M0 * 0x01010101, sc_x = 0x7f7f7f7f;
    unsigned cO[2][2] = {{0u, 0u}, {0u, 0u}}, nO[2][2] = {{0u, 0u}, {0u, 0u}};
    if constexpr (GATHER) { PG_GOFF(cO, cur); }
    const char* cA = GATHER ? gtable : cur.A; const char* cB = cur.B;
    PG_STB(PG_SB(0, 0), cB); PG_STB(PG_SB(0, 1), cB + hstepB); PG_STA(PG_SA(0, 0), cA, 0, false); PG_STA(PG_SA(0, 1), cA, 1, false);
    if (wr == 1) PG_BAR;
    PG_WAIT_V(2); PG_BAR;
    PG_STB(PG_SB(1, 0), cB + kstep); PG_STA(PG_SA(1, 0), cA + kstep, 0, false); PG_STB(PG_SB(1, 1), cB + hstepB + kstep);
    PG_WAIT_V(6); PG_BAR;
    for (;;) {
        const bool has_next = S.next(ui + 1, nxt);
        const int nt = cur.nt;
        if constexpr (GATHER) { if (has_next) { PG_GOFF(nO, nxt); } else {
#pragma unroll
            for (int h = 0; h < 2; ++h)
#pragma unroll
                for (int i = 0; i < 2; ++i) nO[h][i] = cO[h][i]; } }
        const char* nA = GATHER ? gtable : (has_next ? nxt.A : cA); const char* nB = has_next ? nxt.B : cB;
#pragma unroll 1
        for (int t = 0; t < nt; t += 2) {
            const bool last = (t == nt - 2);
            const char* a1 = cA + (size_t)(t + 1) * kstep;
            const char* a2 = last ? nA : cA + (size_t)(t + 2) * kstep; const char* b2 = last ? nB : cB + (size_t)(t + 2) * kstep;
            const char* a3 = a2 + kstep; const char* b3 = b2 + kstep;
            PG_LDB(B0, 0, 0); PG_LDB(B1, 0, 1); PG_SCHED; PG_LDA(At, 0, 0); PG_STA(PG_SA(1, 1), a1, 1, false);
            PG_WAIT_V(8); PG_WAIT_L(0); PG_BAR; PG_MMA(0, 0, At, B0); PG_MMA(0, 1, At, B1); PG_BAR; PG_SCHED;
            PG_LDA(At, 0, 1); PG_STB(PG_SB(0, 0), b2); PG_STB(PG_SB(0, 1), b2 + hstepB); PG_STA(PG_SA(0, 0), a2, 0, last);
            PG_WAIT_V(8); PG_WAIT_L(0); PG_BAR; PG_MMA(1, 0, At, B0); PG_MMA(1, 1, At, B1); PG_BAR; PG_SCHED;
            PG_LDB(B0, 1, 0); PG_LDB(B1, 1, 1); PG_SCHED; PG_LDA(At, 1, 0); PG_STA(PG_SA(0, 1), a2, 1, last);
            PG_WAIT_V(8); PG_WAIT_L(0); PG_BAR; PG_MMA(0, 0, At, B0); PG_MMA(0, 1, At, B1); PG_BAR; PG_SCHED;
            PG_LDA(At, 1, 1); PG_STB(PG_SB(1, 0), b3); PG_STB(PG_SB(1, 1), b3 + hstepB); PG_STA(PG_SA(1, 0), a3, 0, last);
            PG_WAIT_V(8); PG_WAIT_L(0); PG_BAR; PG_MMA(1, 0, At, B0); PG_MMA(1, 1, At, B1); PG_BAR; PG_SCHED;
        }
        if (wr == 0) PG_BAR;
        if constexpr (F8) asm volatile("s_nop 15\n\ts_nop 15" ::: "memory");
        E(acc, cur, wr, wc, fr, fq);
        if (!has_next) break;
#pragma unroll
        for (int a = 0; a < 2; ++a)
#pragma unroll
            for (int b = 0; b < 2; ++b)
#pragma unroll
                for (int m = 0; m < 4; ++m)
#pragma unroll
                    for (int n = 0; n < 2; ++n) acc[a][b][m][n] = (f32x4){0.f, 0.f, 0.f, 0.f};
        cur = nxt; cA = nA; cB = nB; ++ui;
        if constexpr (GATHER) {
#pragma unroll
            for (int h = 0; h < 2; ++h)
#pragma unroll
                for (int i = 0; i < 2; ++i) cO[h][i] = nO[h][i]; }
        if (wr == 1) PG_BAR;
    }
    PG_WAIT_V(0);
    PG_BAR;
#undef PG_SA
#undef PG_SB
#undef PG_ST2
#undef PG_STB
#undef PG_STA
#undef PG_LDA
#undef PG_LD8
#undef PG_LDB
#undef PG_MMA
#undef PG_WAIT_V
#undef PG_WAIT_L
#undef PG_BAR
#undef PG_SCHED
#undef PG_GOFF
#undef PG_GIDX
#undef PG_GCVT
}

struct EpiStore {
    __device__ __forceinline__ void operator()(const f32x4 (&acc)[2][2][4][2], const Unit& u, int wr, int wc, int fr, int fq) const {
        asm volatile("" : "+v"(fr), "+v"(fq));
        const float s = u.scale;
#pragma unroll
        for (int ai = 0; ai < 2; ++ai)
#pragma unroll
            for (int m = 0; m < 4; ++m) { const int row = ai * HALF + wr * 64 + m * 16 + fr;
                char* rowp = u.out + (ptrdiff_t)row * u.ldc + (wc * 32 + 8 * fq) * 2;
                if (!((u.flags & 1) && row == 0)) {
#pragma unroll
                for (int bj = 0; bj < 2; ++bj) { const f32x4 v0 = acc[ai][bj][m][0] * s, v1 = acc[ai][bj][m][1] * s;
                    u32x4 w; w.x = cvt_pk_bf16(v0[0], v0[1]); w.y = cvt_pk_bf16(v0[2], v0[3]); w.z = cvt_pk_bf16(v1[0], v1[1]); w.w = cvt_pk_bf16(v1[2], v1[3]);
                    *(u32x4*)(rowp + bj * 256) = w; } } }
    }
};
struct EpiQKV {
    bf16_t* Q; bf16_t* K; bf16_t* V; const float* ropec; const float* ropes;
    __device__ __forceinline__ void operator()(const f32x4 (&acc)[2][2][4][2], const Unit& u, int wr, int wc, int fr, int fq) const {
        asm volatile("" : "+v"(fr), "+v"(fq));
        const int pm = u.i0, pn = u.i1; const bool lat = pm < (T / 256); const bool rope = lat && pn < 5;
        const float qs = pn < 4 ? C2 : 1.f;
        const int part = wc & 1;
        const int fi0 = 8 * (fq & 1);
        const float sgn = (fq < 2) ? -1.f : 1.f;
#pragma unroll
        for (int ai = 0; ai < 2; ++ai)
#pragma unroll
            for (int m = 0; m < 4; ++m) { const int row = ai * HALF + wr * 64 + m * 16 + fr; const int tok = pm * 256 + row;
                const int tl = tok & (SEQ - 1); const int pos = part ? (tl & 63) : (tl >> 6);
                f32x4 c0 = {1.f, 1.f, 1.f, 1.f}, c1 = c0, s0 = {0.f, 0.f, 0.f, 0.f}, s1 = s0;
                if (rope) { c0 = *(const f32x4*)(ropec + pos * 16 + fi0); c1 = *(const f32x4*)(ropec + pos * 16 + fi0 + 4); s0 = *(const f32x4*)(ropes + pos * 16 + fi0); s1 = *(const f32x4*)(ropes + pos * 16 + fi0 + 4); }
#pragma unroll
                for (int bj = 0; bj < 2; ++bj) { f32x4 v0 = acc[ai][bj][m][0], v1 = acc[ai][bj][m][1];
                    if (rope) { f32x4 p0, p1;
#pragma unroll
                        for (int j = 0; j < 4; ++j) { p0[j] = __shfl_xor(v0[j], 32); p1[j] = __shfl_xor(v1[j], 32); }
                        v0 = v0 * c0 + (p0 * sgn) * s0; v1 = v1 * c1 + (p1 * sgn) * s1; }
                    v0 = v0 * qs; v1 = v1 * qs;
                    u32x4 w; w.x = cvt_pk_bf16(v0[0], v0[1]); w.y = cvt_pk_bf16(v0[2], v0[3]); w.z = cvt_pk_bf16(v1[0], v1[1]); w.w = cvt_pk_bf16(v1[2], v1[3]);
                    const int col = bj * HALF + wc * 32 + 8 * fq;
                    bf16_t* dst = pn < 4 ? Q + (size_t)tok * 1024 + pn * 256 + col : (pn == 4 ? K + (size_t)tok * 256 + col : V + (size_t)tok * 256 + col);
                    *(u32x4*)dst = w; } }
    }
};
struct EpiSilu {
    __device__ __forceinline__ void operator()(const f32x4 (&acc)[2][2][4][2], const Unit& u, int wr, int wc, int fr, int fq) const {
        asm volatile("" : "+v"(fr), "+v"(fq));
#pragma unroll
        for (int ai = 0; ai < 2; ++ai)
#pragma unroll
            for (int m = 0; m < 4; ++m) { const int row = ai * HALF + wr * 64 + m * 16 + fr;
                float h[8];
#pragma unroll
                for (int n = 0; n < 2; ++n)
#pragma unroll
                    for (int j = 0; j < 4; ++j) { const float g = acc[ai][0][m][n][j], up = acc[ai][1][m][n][j]; h[n * 4 + j] = g * __builtin_amdgcn_rcpf(1.f + __expf(-g)) * up; }
                int w0 = 0, w1 = 0;
                w0 = __builtin_amdgcn_cvt_pk_fp8_f32(h[0], h[1], w0, false); w0 = __builtin_amdgcn_cvt_pk_fp8_f32(h[2], h[3], w0, true);
                w1 = __builtin_amdgcn_cvt_pk_fp8_f32(h[4], h[5], w1, false); w1 = __builtin_amdgcn_cvt_pk_fp8_f32(h[6], h[7], w1, true);
                u32x2 o; o.x = (unsigned)w0; o.y = (unsigned)w1;
                *(u32x2*)(u.out + (size_t)row * 256 + (wc * 32 + 8 * fq)) = o; }
    }
};
struct EpiFp8 {
    __device__ __forceinline__ void operator()(const f32x4 (&acc)[2][2][4][2], const Unit& u, int wr, int wc, int fr, int fq) const {
        asm volatile("" : "+v"(fr), "+v"(fq));
        const int pn = u.i1;
#pragma unroll
        for (int ai = 0; ai < 2; ++ai)
#pragma unroll
            for (int m = 0; m < 4; ++m) { const int row = ai * HALF + wr * 64 + m * 16 + fr;
                u32x4 o;
#pragma unroll
                for (int bj = 0; bj < 2; ++bj) { const f32x4 v0 = acc[ai][bj][m][0] * 16.f, v1 = acc[ai][bj][m][1] * 16.f;
                    int w0 = 0, w1 = 0;
                    w0 = __builtin_amdgcn_cvt_pk_fp8_f32(v0[0], v0[1], w0, false); w0 = __builtin_amdgcn_cvt_pk_fp8_f32(v0[2], v0[3], w0, true);
                    w1 = __builtin_amdgcn_cvt_pk_fp8_f32(v1[0], v1[1], w1, false); w1 = __builtin_amdgcn_cvt_pk_fp8_f32(v1[2], v1[3], w1, true);
                    o[2 * bj] = (unsigned)w0; o[2 * bj + 1] = (unsigned)w1; }
                *(u32x4*)(u.out + (size_t)row * 1024 + (16 * pn + 4 * wc + fq) * 16) = o; }
    }
};
__device__ __forceinline__ int xcd_remap(int L0, int NU) { const int q = NU >> 3, r = NU & 7, x = L0 & 7, off = L0 >> 3; return (x < r ? x * (q + 1) : r * (q + 1) + (x - r) * q) + off; }
}

namespace attn {
constexpr int SLOTB = 8192;
constexpr int LDS_K = 0, LDS_V = 2 * SLOTB, LDS_WS = 4 * SLOTB, LDS_OST = LDS_WS + NWAVES * 256, LDS_END = LDS_OST + NWAVES * 4096;
static_assert(LDS_END <= RING_BYTES, "attention LDS");
__device__ __forceinline__ int crow(int r, int hi) { return (r & 3) + 8 * (r >> 2) + 4 * hi; }
__device__ __forceinline__ void glds16(const void* gsrc, unsigned lds_dst) { unsigned keep;
    asm volatile("s_mov_b32 %0, m0\n\ts_mov_b32 m0, %2\n\ts_nop 0\n\tglobal_load_lds_dwordx4 %1, off\n\ts_mov_b32 m0, %0" : "=&s"(keep) : "v"(gsrc), "s"(lds_dst) : "memory"); }
__device__ __forceinline__ float rowmax(const f32x16& p0, const f32x16& p1) {
    float a = fmaxf(p0[0], p1[0]);
#pragma unroll
    for (int r = 1; r < 16; ++r) a = fmaxf(a, fmaxf(p0[r], p1[r]));
    auto rr = __builtin_amdgcn_permlane32_swap(__float_as_uint(a), __float_as_uint(a), false, false);
    return fmaxf(__uint_as_float(rr[0]), __uint_as_float(rr[1]));
}
typedef short v4i16_t __attribute__((ext_vector_type(4)));
__device__ __forceinline__ s16x4 vtr(const LAS unsigned char* p) { return __builtin_bit_cast(s16x4, __builtin_amdgcn_ds_read_tr16_b64_v4i16((LAS v4i16_t*)p)); }
__device__ __forceinline__ void pv(f32x16* o, const LAS unsigned char* vp, bf16x8 pa0, bf16x8 pa1, bf16x8 pa2, bf16x8 pa3) {
#pragma unroll
    for (int d0 = 0; d0 < 2; ++d0) { s16x4 lo[4], hi[4];
#pragma unroll
        for (int ks = 0; ks < 4; ++ks) { lo[ks] = vtr(vp + d0 * 4096 + ks * 1024); hi[ks] = vtr(vp + d0 * 4096 + ks * 1024 + 512); }
#define PK(k) (bf16x8){lo[k][0], lo[k][1], lo[k][2], lo[k][3], hi[k][0], hi[k][1], hi[k][2], hi[k][3]}
        o[d0] = __builtin_amdgcn_mfma_f32_32x32x16_bf16(pa0, PK(0), o[d0], 0, 0, 0);
        o[d0] = __builtin_amdgcn_mfma_f32_32x32x16_bf16(pa1, PK(1), o[d0], 0, 0, 0);
        o[d0] = __builtin_amdgcn_mfma_f32_32x32x16_bf16(pa2, PK(2), o[d0], 0, 0, 0);
        o[d0] = __builtin_amdgcn_mfma_f32_32x32x16_bf16(pa3, PK(3), o[d0], 0, 0, 0);
#undef PK
    }
}
__device__ __forceinline__ void attn_unit(const bf16_t* Q, const bf16_t* K, const bf16_t* V, bf16_t* O, int b, int h, int q0, bool isctx, float sink2, LAS unsigned char* shm) {
    const int tid = opaque_tid(), lane = tid & 63, r32 = lane & 31, hi = lane >> 5; const int wid = __builtin_amdgcn_readfirstlane(tid >> 6);
    const int kvh = h >> 2;
    const long qrow = isctx ? (long)T + b * CTXL + wid * 32 : (long)b * SEQ + q0 + wid * 32;
    const unsigned lds0 = (unsigned)(uintptr_t)shm;
    LAS float* wsf = (LAS float*)(shm + LDS_WS) + wid * 64;
    int jlo = 0, nl = 0;
    if (!isctx) { jlo = (q0 == 0) ? 2 : 0; int jhi = (SEQ - q0 + 128) / 64; if (jhi > 8) jhi = 8; nl = jhi - jlo; }
    const int NT = nl + 4;
    const long lat0 = (long)b * SEQ + q0 - 128 + 64 * jlo, ctx0 = (long)T + b * CTXL;
#define TROW(t) ((t) < nl ? lat0 + 64 * (t) : ctx0 + 64 * ((t) - nl))
    const int kcol = kvh * 64 + wid * 8, vcol = kvh * 64 + (wid >> 2) * 32 + (lane & 3) * 8, vrow = 16 * (wid & 3) + (lane >> 2);
    const unsigned kdst = lds0 + LDS_K + wid * 1024, vdst = lds0 + LDS_V + wid * 1024;
#define DMA_KV(t, slot) do { const long tr_ = TROW(t); glds16(K + (tr_ + lane) * 256 + kcol, (unsigned)__builtin_amdgcn_readfirstlane(kdst + (slot) * SLOTB)); \
        glds16(V + (tr_ + vrow) * 256 + vcol, (unsigned)__builtin_amdgcn_readfirstlane(vdst + (slot) * SLOTB)); } while (0)
    DMA_KV(0, 0);
    bf16x8 qr[4];
#pragma unroll
    for (int d0 = 0; d0 < 4; ++d0) qr[d0] = *(const GAS bf16x8*)(Q + (qrow + r32) * 1024 + h * 64 + d0 * 16 + hi * 8);
    float mrun = sink2, l_reg = (hi == 0) ? 1.f : 0.f;
    f32x16 o[2];
#pragma unroll
    for (int r = 0; r < 16; ++r) { o[0][r] = 0.f; o[1][r] = 0.f; }
    const LAS unsigned char* vp0 = shm + LDS_V + ((lane >> 4) & 1) * 32 + (lane & 3) * 8 + (4 * hi + ((lane & 15) >> 2)) * 64;
    const int qw = q0 + wid * 32;
    asm volatile("s_waitcnt vmcnt(0) lgkmcnt(0)\n\ts_barrier" ::: "memory");
    for (int t = 0; t < NT; ++t) {
        const int slot = t & 1;
        if (t + 1 < NT) DMA_KV(t + 1, slot ^ 1);
        const bool latt = t < nl;
        const int ks = q0 - 128 + 64 * (jlo + t);
        bool need = true;
        if (latt) need = (ks + 63 >= qw - 128) && (ks <= qw + 31 + 128);
        if (need) {
            f32x16 p0, p1;
#pragma unroll
            for (int r = 0; r < 16; ++r) { p0[r] = 0.f; p1[r] = 0.f; }
            const LAS unsigned char* kb = shm + LDS_K + slot * SLOTB + hi * 1024 + r32 * 16;
#pragma unroll
            for (int d0 = 0; d0 < 4; ++d0) {
                const bf16x8 b0 = *(const LAS bf16x8*)(kb + d0 * 2048), b1 = *(const LAS bf16x8*)(kb + d0 * 2048 + 512);
                p0 = __builtin_amdgcn_mfma_f32_32x32x16_bf16(b0, qr[d0], p0, 0, 0, 0);
                p1 = __builtin_amdgcn_mfma_f32_32x32x16_bf16(b1, qr[d0], p1, 0, 0, 0); }
            if (latt) { const int dq = qw + r32 - ks;
#pragma unroll
                for (int r = 0; r < 16; ++r) { const int d = dq - crow(r, hi); if (d > 128 || d < -128) p0[r] = -INFINITY; if (d - 32 > 128 || d - 32 < -128) p1[r] = -INFINITY; } }
            const float rm = rowmax(p0, p1);
            if (__any(rm > mrun + 8.f)) {
                const float mnew = fmaxf(mrun, rm);
                const float alpha = __builtin_amdgcn_exp2f(mrun - mnew); l_reg *= alpha; mrun = mnew;
                if (hi == 0) wsf[r32] = alpha;
                asm volatile("s_waitcnt lgkmcnt(0)" ::: "memory");
#pragma unroll
                for (int r = 0; r < 16; ++r) { const float f = wsf[crow(r, hi)]; o[0][r] *= f; o[1][r] *= f; }
            }
            float sacc = 0.f;
#pragma unroll
            for (int r = 0; r < 16; ++r) { p0[r] = __builtin_amdgcn_exp2f(p0[r] - mrun); p1[r] = __builtin_amdgcn_exp2f(p1[r] - mrun); sacc += p0[r] + p1[r]; }
            l_reg += sacc;
            u32x4 pw0, pw1, pw2, pw3;
#define PKW(P, B) cvt_pk_bf16(P[B], P[B + 1])
            pw0 = (u32x4){PKW(p0, 0), PKW(p0, 2), PKW(p0, 4), PKW(p0, 6)}; pw1 = (u32x4){PKW(p0, 8), PKW(p0, 10), PKW(p0, 12), PKW(p0, 14)};
            pw2 = (u32x4){PKW(p1, 0), PKW(p1, 2), PKW(p1, 4), PKW(p1, 6)}; pw3 = (u32x4){PKW(p1, 8), PKW(p1, 10), PKW(p1, 12), PKW(p1, 14)};
#undef PKW
            __builtin_amdgcn_sched_barrier(0);
            pv(o, vp0 + slot * SLOTB, __builtin_bit_cast(bf16x8, pw0), __builtin_bit_cast(bf16x8, pw1), __builtin_bit_cast(bf16x8, pw2), __builtin_bit_cast(bf16x8, pw3));
        }
        asm volatile("s_waitcnt vmcnt(0) lgkmcnt(0)\n\ts_barrier" ::: "memory");
    }
    { auto rr = __builtin_amdgcn_permlane32_swap(__float_as_uint(l_reg), __float_as_uint(l_reg), false, false); l_reg = __uint_as_float(rr[0]) + __uint_as_float(rr[1]); }
    if (hi == 0) wsf[32 + r32] = l_reg;
    asm volatile("s_waitcnt lgkmcnt(0)" ::: "memory");
    float rli[16];
#pragma unroll
    for (int r = 0; r < 16; ++r) rli[r] = __builtin_amdgcn_rcpf(wsf[32 + crow(r, hi)]);
    bf16_t* Ow = O + qrow * 1024 + h * 64;
    { LAS bf16_t* stg = (LAS bf16_t*)(shm + LDS_OST) + wid * 2048;
#pragma unroll
      for (int r = 0; r < 16; ++r) { const int orow = crow(r, hi);
#pragma unroll
          for (int d0 = 0; d0 < 2; ++d0) stg[orow * 64 + d0 * 32 + r32] = (bf16_t)f2bf(o[d0][r] * rli[r]); }
      asm volatile("s_waitcnt lgkmcnt(0)" ::: "memory");
#pragma unroll
      for (int i = 0; i < 4; ++i) { const int row = i * 8 + (lane >> 3), ch = lane & 7; const u32x4 v = *(const LAS u32x4*)(stg + row * 64 + ch * 8); *(GAS u32x4*)(Ow + (long)row * 1024 + ch * 8) = v; } }
    asm volatile("s_waitcnt lgkmcnt(0)" ::: "memory");
#undef TROW
#undef DMA_KV
}
}

struct Args {
    const float* in[20];
    float* out; unsigned char* ws;
};
struct Frame {
    LAS unsigned char* lds; unsigned* ctl; unsigned char* ws;
    int tid, lane, wave, gw;
    int blk;
    __device__ __forceinline__ void refresh() { tid = opaque_tid(); lane = tid & 63; wave = __builtin_amdgcn_readfirstlane(tid >> 6); gw = blk * 8 + wave;
        asm volatile("" : "+s"(ws)); ctl = (unsigned*)(ws + WS_CTL); }
};
constexpr int NGW = GRID * NWAVES;

struct Row { f32x4 v[4]; };
__device__ __forceinline__ int vq(int q, int lane) { return 64 * (lane >> 4) + 2 * (lane & 15) + 32 * (q >> 1) + (q & 1); }
__device__ __forceinline__ int vb(int j, int lane) { return 32 * (lane >> 4) + (lane & 15) + 16 * j; }
__device__ __forceinline__ void row_load_bf16(Row& r, const bf16_t* p, int lane) {
#pragma unroll
    for (int j = 0; j < 2; ++j) { const u32x4 w = ((const GAS u32x4*)p)[vb(j, lane)]; r.v[2 * j] = (f32x4){bflo(w.x), bfhi(w.x), bflo(w.y), bfhi(w.y)}; r.v[2 * j + 1] = (f32x4){bflo(w.z), bfhi(w.z), bflo(w.w), bfhi(w.w)}; } }
__device__ __forceinline__ void row_store_bf16(const Row& r, bf16_t* p, int lane) {
#pragma unroll
    for (int j = 0; j < 2; ++j) { u32x4 w; w.x = pk2(r.v[2 * j][0], r.v[2 * j][1]); w.y = pk2(r.v[2 * j][2], r.v[2 * j][3]); w.z = pk2(r.v[2 * j + 1][0], r.v[2 * j + 1][1]); w.w = pk2(r.v[2 * j + 1][2], r.v[2 * j + 1][3]); ((GAS u32x4*)p)[vb(j, lane)] = w; } }
typedef float f32x2v __attribute__((ext_vector_type(2)));
__device__ __forceinline__ void row_load_fp8(Row& r, const unsigned char* p, int lane) {
    const u32x4 w = ((const GAS u32x4*)p)[lane];
#pragma unroll
    for (int q = 0; q < 4; ++q) { const f32x2v lo = __builtin_amdgcn_cvt_pk_f32_fp8((int)w[q], false), hi = __builtin_amdgcn_cvt_pk_f32_fp8((int)w[q], true); r.v[q] = (f32x4){lo[0], lo[1], hi[0], hi[1]}; } }
__device__ __forceinline__ void row_store_fp8(const Row& r, unsigned char* p, int lane) {
    const int e0 = 256 * (lane >> 4) + 8 * (lane & 15);
#pragma unroll
    for (int j = 0; j < 2; ++j) { int w0 = 0, w1 = 0;
        w0 = __builtin_amdgcn_cvt_pk_fp8_f32(r.v[2 * j][0], r.v[2 * j][1], w0, false); w0 = __builtin_amdgcn_cvt_pk_fp8_f32(r.v[2 * j][2], r.v[2 * j][3], w0, true);
        w1 = __builtin_amdgcn_cvt_pk_fp8_f32(r.v[2 * j + 1][0], r.v[2 * j + 1][1], w1, false); w1 = __builtin_amdgcn_cvt_pk_fp8_f32(r.v[2 * j + 1][2], r.v[2 * j + 1][3], w1, true);
        u32x2 o; o.x = (unsigned)w0; o.y = (unsigned)w1; *(GAS u32x2*)(p + e0 + 128 * j) = o; } }
__device__ __forceinline__ void row_load_f32(Row& r, const float* p, int lane) {
#pragma unroll
    for (int q = 0; q < 4; ++q) r.v[q] = ((const GAS f32x4*)p)[vq(q, lane)]; }
__device__ __forceinline__ void row_store_f32(const Row& r, float* p, int lane) {
#pragma unroll
    for (int q = 0; q < 4; ++q) ((GAS f32x4*)p)[vq(q, lane)] = r.v[q]; }
__device__ __forceinline__ void row_normalize(Row& r, float eps) {
    float s = 0.f;
#pragma unroll
    for (int j = 0; j < 4; ++j) s += (r.v[j][0] + r.v[j][1]) + (r.v[j][2] + r.v[j][3]);
    const float mean = wave_sum(s) * (1.f / D); float q = 0.f;
#pragma unroll
    for (int j = 0; j < 4; ++j) { r.v[j] = r.v[j] - mean; q += (r.v[j][0] * r.v[j][0] + r.v[j][1] * r.v[j][1]) + (r.v[j][2] * r.v[j][2] + r.v[j][3] * r.v[j][3]); }
    const float rstd = 1.f / sqrtf(wave_sum(q) * (1.f / D) + eps);
#pragma unroll
    for (int j = 0; j < 4; ++j) r.v[j] = r.v[j] * rstd;
}
__device__ __forceinline__ void row_modulate(Row& r, const float* sh, const float* sc, int lane) {
    row_normalize(r, MOD_EPS);
#pragma unroll
    for (int j = 0; j < 4; ++j) { const f32x4 a = ((const GAS f32x4*)sc)[vq(j, lane)], b = ((const GAS f32x4*)sh)[vq(j, lane)]; r.v[j] = r.v[j] * (a + 1.f) + b; }
}
__device__ __forceinline__ int mod_row(int row) { return row < T ? (row >> 11) : 32; }
__device__ __forceinline__ const float* mod_vec(const unsigned char* ws, int layer, int mr, int chunk) { return (const float*)(ws + WS_MOD) + ((size_t)(layer * 33 + mr) * 6 + chunk) * 1024; }

__device__ __forceinline__ void conv_item(const float* W, int N, bf16_t* WT, int Kd, int kd0, int n0, int drow0, bool mirror, LAS float* scr, int lane) {
#pragma unroll 8
    for (int i = 0; i < 32; ++i) { const int kk = 2 * i + (lane >> 5); const int kd = kd0 + kk; const int ks = mirror ? ((kd & ~255) + ((256 - (kd & 255)) & 255)) : kd;
        scr[kk * 33 + (lane & 31)] = ((const GAS float*)W)[(size_t)ks * N + n0 + (lane & 31)]; }
    LDS_WAIT(); asm volatile("" ::: "memory");
    const int c = lane & 7;
#pragma unroll
    for (int j = 0; j < 4; ++j) { const int n = (lane >> 3) + 8 * j; const LAS float* s = scr + (8 * c) * 33 + n;
        u32x4 o; o.x = pk2(s[0 * 33], s[1 * 33]); o.y = pk2(s[2 * 33], s[3 * 33]); o.z = pk2(s[4 * 33], s[5 * 33]); o.w = pk2(s[6 * 33], s[7 * 33]);
        *(GAS u32x4*)(WT + (size_t)(drow0 + n) * Kd + kd0 + 8 * c) = o; }
    LDS_WAIT(); asm volatile("" ::: "memory");
}
__device__ __forceinline__ void conv_matrix_item(const float* W, int K, int N, bf16_t* WT, int mode, int roff, int item, LAS float* scr, int lane) {
    const int nblk = N / 32, kb = item / nblk, nb = item % nblk, n0 = 32 * nb;
    int drow0 = n0 + roff; if (mode == 1) drow0 = (n0 >> 7) * 256 + (n0 & 127); if (mode == 2) drow0 = (n0 >> 7) * 256 + 128 + (n0 & 127);
    conv_item(W, N, WT, K, 64 * kb, n0, drow0, mode == 3, scr, lane);
}
__device__ __forceinline__ void conv_item64(const float* W, int N, bf16_t* WT, int Kd, int k0, int n0, int drow0, LAS bf16_t* scr, int lane) {
    f32x4 v[16];
#pragma unroll
    for (int i = 0; i < 16; ++i) v[i] = *(const GAS f32x4*)(W + (size_t)(k0 + 4 * i + (lane >> 4)) * N + n0 + (lane & 15) * 4);
#pragma unroll
    for (int i = 0; i < 16; ++i) { u32x2 w; w.x = pk2(v[i][0], v[i][1]); w.y = pk2(v[i][2], v[i][3]); *(LAS u32x2*)(scr + (4 * i + (lane >> 4)) * 68 + (lane & 15) * 4) = w; }
    LDS_WAIT(); asm volatile("" ::: "memory");
    const int c = lane & 7;
#pragma unroll
    for (int j = 0; j < 8; ++j) { const int n = (lane >> 3) + 8 * j; const LAS bf16_t* p = scr + (8 * c) * 68 + n;
        u32x4 o; o.x = (unsigned)p[0] | ((unsigned)p[68] << 16); o.y = (unsigned)p[2 * 68] | ((unsigned)p[3 * 68] << 16); o.z = (unsigned)p[4 * 68] | ((unsigned)p[5 * 68] << 16); o.w = (unsigned)p[6 * 68] | ((unsigned)p[7 * 68] << 16);
        *(GAS u32x4*)(WT + (size_t)(drow0 + n) * Kd + k0 + 8 * c) = o; }
    LDS_WAIT(); asm volatile("" ::: "memory");
}
__device__ __forceinline__ void conv_item64_f8(const float* W, int N, unsigned char* WT, int Kd, int k0, int n0, int drow0, LAS unsigned char* scr, int lane) {
    f32x4 v[16];
#pragma unroll
    for (int i = 0; i < 16; ++i) v[i] = *(const GAS f32x4*)(W + (size_t)(k0 + 4 * i + (lane >> 4)) * N + n0 + (lane & 15) * 4);
#pragma unroll
    for (int i = 0; i < 16; ++i) { int w = 0; w = __builtin_amdgcn_cvt_pk_fp8_f32(v[i][0] * 64.f, v[i][1] * 64.f, w, false); w = __builtin_amdgcn_cvt_pk_fp8_f32(v[i][2] * 64.f, v[i][3] * 64.f, w, true);
        *(LAS unsigned*)(scr + (4 * i + (lane >> 4)) * 68 + (lane & 15) * 4) = (unsigned)w; }
    LDS_WAIT(); asm volatile("" ::: "memory");
    const int c = lane & 3;
#pragma unroll
    for (int j = 0; j < 4; ++j) { const int n = (lane >> 2) + 16 * j; const LAS unsigned char* p = scr + (16 * c) * 68 + n; u32x4 o;
#pragma unroll
        for (int q = 0; q < 4; ++q) o[q] = (unsigned)p[(4 * q) * 68] | ((unsigned)p[(4 * q + 1) * 68] << 8) | ((unsigned)p[(4 * q + 2) * 68] << 16) | ((unsigned)p[(4 * q + 3) * 68] << 24);
        *(GAS u32x4*)(WT + (size_t)(drow0 + n) * Kd + k0 + 16 * c) = o; }
    LDS_WAIT(); asm volatile("" ::: "memory");
}
__device__ __forceinline__ void conv_experts(Frame& F, const Args& a, int layer) {
    F.refresh();
    LAS unsigned char* scr = F.lds + 32768 + F.wave * 4352;
    unsigned char* EGU = F.ws + WS_EGU; unsigned char* ED = F.ws + WS_ED;
    for (int it = F.gw; it < (NE + 1) * 192; it += NGW) { const int e = it / 192, r = it % 192;
        const float* wg = e < NE ? a.in[14] + ((size_t)layer * NE + e) * 262144 : a.in[17] + (size_t)layer * 262144;
        const float* wu = e < NE ? a.in[15] + ((size_t)layer * NE + e) * 262144 : a.in[18] + (size_t)layer * 262144;
        const float* wd = e < NE ? a.in[16] + ((size_t)layer * NE + e) * 262144 : a.in[19] + (size_t)layer * 262144;
        if (r < 128) { const int q = r & 63, kb = q >> 2, nb = q & 3, n0 = 64 * nb; const int drow0 = (n0 >> 7) * 256 + (r < 64 ? 0 : 128) + (n0 & 127);
            conv_item64_f8(r < 64 ? wg : wu, 256, EGU + (size_t)e * 512 * 1024, 1024, 64 * kb, n0, drow0, scr, F.lane); }
        else { const int q = r - 128, kb = q >> 4, nb = q & 15; conv_item64_f8(wd, 1024, ED + (size_t)e * 1024 * 256, 256, 64 * kb, 64 * nb, 64 * nb, scr, F.lane); } }
}
__device__ __forceinline__ void conv_small(Frame& F, const Args& a) {
    F.refresh();
    LAS float* scr = (LAS float*)(F.lds + 32768 + F.wave * 8448);
    for (int it = F.gw; it < 6272; it += NGW) {
        if (it < 1536) { const int j = it / 768, r = it % 768; conv_matrix_item(a.in[8] + (size_t)j * 1024 * 1536, 1024, 1536, (bf16_t*)(F.ws + WS_WQKV) + (size_t)j * 1536 * 1024, 0, 0, r, scr, F.lane); }
        else if (it < 2560) { const int q = it - 1536, j = q / 512, r = q % 512; conv_matrix_item(a.in[9] + (size_t)j * 1024 * 1024, 1024, 1024, (bf16_t*)(F.ws + WS_WO) + (size_t)j * 1024 * 1024, 0, 0, r, scr, F.lane); }
        else if (it < 4608) { const int q = it - 2560, j = q / 1024, r = q % 1024; bf16_t* dst = (bf16_t*)(F.ws + WS_WF) + (size_t)j * 2048 * 1024;
            if (r < 512) conv_matrix_item(a.in[11] + (size_t)j * 1024 * 1024, 1024, 1024, dst, 0, 0, r, scr, F.lane);
            else conv_matrix_item(a.in[11] + (size_t)j * 1024 * 1024, 1024, 1024, dst, 3, 1024, r - 512, scr, F.lane); }
        else if (it < 4736) { const int q = it - 4608, l = q / 32, r = q % 32; conv_matrix_item(a.in[12] + (size_t)l * 1024 * 64, 1024, 64, (bf16_t*)(F.ws + WS_WR) + (size_t)l * 64 * 1024, 0, 0, r, scr, F.lane); }
        else { const int q = it - 4736, l = q / 384, r = q % 384; bf16_t* gu = (bf16_t*)(F.ws + WS_WSH + (size_t)l * 1536 * 1024); bf16_t* dn = gu + 512 * 1024;
            if (r < 128) conv_matrix_item(a.in[17] + (size_t)l * 1024 * 256, 1024, 256, gu, 1, 0, r, scr, F.lane);
            else if (r < 256) conv_matrix_item(a.in[18] + (size_t)l * 1024 * 256, 1024, 256, gu, 2, 0, r - 128, scr, F.lane);
            else conv_matrix_item(a.in[19] + (size_t)l * 256 * 1024, 256, 1024, dn, 0, 0, r - 256, scr, F.lane); }
    }
    const int gt = F.blk * NTHR + F.tid, NGT = GRID * NTHR;
    const float TWO_PI = 6.283185307179586f;
    { float* rc = (float*)(F.ws + WS_ROPEC); float* rs = (float*)(F.ws + WS_ROPES);
      for (int i = gt; i < 64 * 16; i += NGT) { const int pos = i >> 4, fi = i & 15; const float inv = exp2f(-(float)fi * (13.287712379549449f / 16.f)); const float ang = (float)pos * inv; rc[i] = cosf(ang); rs[i] = sinf(ang); } }
    { bf16_t* cs = (bf16_t*)(F.ws + WS_CSN);
      for (int i = gt; i < 512 * 256; i += NGT) { const int r = i >> 8, n = i & 255, m = r & 255; const float ang = TWO_PI * (float)((m * n) & 255) * (1.f / 256.f); cs[i] = (bf16_t)f2bf(r < 256 ? cosf(ang) : -sinf(ang)); } }
    { bf16_t* dl = (bf16_t*)(F.ws + WS_DL);
      for (int i = gt; i < 1024 * 4096; i += NGT) { const int k = i >> 12, c = i & 4095, l = c & 2047; const float ang = TWO_PI * (float)((k * l) & 2047) * (1.f / 2048.f); dl[i] = (bf16_t)f2bf(c < 2048 ? cosf(ang) : sinf(ang)); } }
    { bf16_t* dl = (bf16_t*)(F.ws + WS_DLC);
      for (int i = gt; i < 256 * 512; i += NGT) { const int k = i >> 9, c = i & 511, l = c & 255; const float ang = TWO_PI * (float)((k * l) & 255) * (1.f / 256.f); dl[i] = (bf16_t)f2bf(c < 256 ? cosf(ang) : sinf(ang)); } }
}
__device__ __forceinline__ void mod_partials(Frame& F, const Args& a) {
    F.refresh();
    if (F.blk >= 192) return;
    const int l = F.blk / 48, cb = (F.blk % 48) / 4, kc = F.blk & 3;
    LAS float* s = (LAS float*)F.lds;
    for (int i = F.tid; i < 256 * 33; i += NTHR) { const int k = i / 33, r = i % 33; const float c = (r < 32) ? a.in[1][(size_t)r * 1024 + kc * 256 + k] : a.in[3][kc * 256 + k]; s[k * 36 + r] = c / (1.f + __expf(-c)); }
    __syncthreads();
    const int n = cb * 512 + F.tid;
    const GAS float* w = (const GAS float*)a.in[4] + ((size_t)l * 1024 + kc * 256) * 6144 + n;
    float acc[33];
#pragma unroll
    for (int r = 0; r < 33; ++r) acc[r] = 0.f;
#pragma unroll 4
    for (int k = 0; k < 256; ++k) { const float wv = w[(size_t)k * 6144];
#pragma unroll
        for (int r = 0; r < 33; ++r) acc[r] += s[k * 36 + r] * wv; }
    float* part = (float*)(F.ws + WS_MODP) + ((size_t)(kc * 4 + l) * 33) * 6144 + n;
#pragma unroll
    for (int r = 0; r < 33; ++r) part[(size_t)r * 6144] = acc[r];
    __syncthreads();
}
__device__ __forceinline__ void mod_finalize(Frame& F, const Args& a) {
    F.refresh();
    const int gt = F.blk * NTHR + F.tid, NGT = GRID * NTHR; const float* part = (const float*)(F.ws + WS_MODP); float* mod = (float*)(F.ws + WS_MOD);
    for (int i = gt; i < 4 * 33 * 6144; i += NGT) { const int l = i / (33 * 6144), n = i % 6144; float v = a.in[5][l * 6144 + n];
#pragma unroll
        for (int kc = 0; kc < 4; ++kc) v += part[(size_t)kc * 4 * 33 * 6144 + i]; mod[i] = v; }
}
__device__ __forceinline__ void rows_init(Frame& F, const Args& a) {
    F.refresh();
    bf16_t* XS = (bf16_t*)(F.ws + WS_XS); bf16_t* U = (bf16_t*)a.out; const float* part = (const float*)(F.ws + WS_MODP);
    for (int row = F.gw; row < TT; row += NGW) {
        Row r; row_load_f32(r, row < T ? a.in[0] + (size_t)row * D : a.in[2] + (size_t)(row - T) * D, F.lane);
        row_store_bf16(r, XS + (size_t)row * D, F.lane);
        row_normalize(r, MOD_EPS); const int mr = mod_row(row);
#pragma unroll
        for (int j = 0; j < 4; ++j) { const int e = vq(j, F.lane);
            f32x4 sh = ((const GAS f32x4*)(a.in[5]))[e], sc = ((const GAS f32x4*)(a.in[5] + 1024))[e];
#pragma unroll
            for (int kc = 0; kc < 4; ++kc) { const float* pp = part + ((size_t)(kc * 4 + 0) * 33 + mr) * 6144; sh += ((const GAS f32x4*)pp)[e]; sc += ((const GAS f32x4*)(pp + 1024))[e]; }
            r.v[j] = r.v[j] * (sc + 1.f) + sh; }
        row_store_bf16(r, U + (size_t)row * D, F.lane);
    }
}
__device__ __forceinline__ void rows_post1(Frame& F, const Args& a, int layer, int nrows) {
    F.refresh();
    bf16_t* XS = (bf16_t*)(F.ws + WS_XS); bf16_t* U = (bf16_t*)a.out;
    const float* lg = a.in[6] + (size_t)(layer * 2 + 0) * D; const float* lb = a.in[7] + (size_t)(layer * 2 + 0) * D;
    const int TPB = nrows / GRID;
    for (int rl = F.wave; rl < TPB; rl += NWAVES) { const int row = F.blk * TPB + rl; const int mr = mod_row(row);
        Row x, y; row_load_bf16(x, XS + (size_t)row * D, F.lane); row_load_bf16(y, U + (size_t)row * D, F.lane);
        const float* g1 = mod_vec(F.ws, layer, mr, 2);
#pragma unroll
        for (int j = 0; j < 4; ++j) x.v[j] = x.v[j] * ALPHA + ((const GAS f32x4*)g1)[vq(j, F.lane)] * y.v[j];
        row_normalize(x, LN_EPS);
#pragma unroll
        for (int j = 0; j < 4; ++j) x.v[j] = x.v[j] * ((const GAS f32x4*)lg)[vq(j, F.lane)] + ((const GAS f32x4*)lb)[vq(j, F.lane)];
        row_store_bf16(x, XS + (size_t)row * D, F.lane);
        row_modulate(x, mod_vec(F.ws, layer, mr, 3), mod_vec(F.ws, layer, mr, 4), F.lane);
        row_store_bf16(x, U + (size_t)row * D, F.lane);
        row_store_fp8(x, (unsigned char*)a.out + OUT_U8 + (size_t)row * D, F.lane);
    }
}
__device__ __forceinline__ void rows_post2(Frame& F, const Args& a, int layer, int t0, int n) {
    F.refresh();
    bf16_t* XS = (bf16_t*)(F.ws + WS_XS); bf16_t* U = (bf16_t*)a.out; const unsigned char* YB = (const unsigned char*)(F.ws + WS_YB); const unsigned char* YS = (const unsigned char*)(F.ws + WS_YS);
    const int* spos = (const int*)(F.ws + WS_SDST); const float* tkw = (const float*)(F.ws + WS_TKW);
    const float* lg = a.in[6] + (size_t)(layer * 2 + 1) * D; const float* lb = a.in[7] + (size_t)(layer * 2 + 1) * D;
    for (int i = F.gw; i < n; i += NGW) { const int row = t0 + i; const int mr = mod_row(row);
        Row x, y; row_load_bf16(x, XS + (size_t)row * D, F.lane);
        int pj = 0; float wj = 0.f; if (F.lane < 8) { pj = ((const GAS int*)spos)[(size_t)row * 8 + F.lane]; wj = ((const GAS float*)tkw)[(size_t)row * 8 + F.lane]; }
        row_load_fp8(y, YS + (size_t)i * D, F.lane);
#pragma unroll
        for (int j = 0; j < 4; ++j) y.v[j] = y.v[j] * (1.f / 16.f);
#pragma unroll
        for (int s = 0; s < 8; ++s) { const int ps = __builtin_amdgcn_readlane(pj, s); const float ws_ = __builtin_bit_cast(float, __builtin_amdgcn_readlane(__builtin_bit_cast(int, wj), s));
            Row z; row_load_fp8(z, YB + (size_t)ps * D, F.lane); const float wz = ws_ * (1.f / 16.f);
#pragma unroll
            for (int j = 0; j < 4; ++j) y.v[j] += z.v[j] * wz; }
        const float* g2 = mod_vec(F.ws, layer, mr, 5);
#pragma unroll
        for (int j = 0; j < 4; ++j) x.v[j] = x.v[j] * ALPHA + ((const GAS f32x4*)g2)[vq(j, F.lane)] * y.v[j];
        row_normalize(x, LN_EPS);
#pragma unroll
        for (int j = 0; j < 4; ++j) x.v[j] = x.v[j] * ((const GAS f32x4*)lg)[vq(j, F.lane)] + ((const GAS f32x4*)lb)[vq(j, F.lane)];
        if (layer == 3) { row_store_f32(x, a.out + (size_t)row * D, F.lane); }
        else { row_store_bf16(x, XS + (size_t)row * D, F.lane);
            row_modulate(x, mod_vec(F.ws, layer + 1, mr, 0), mod_vec(F.ws, layer + 1, mr, 1), F.lane);
            row_store_bf16(x, U + (size_t)row * D, F.lane); }
    }
}

__device__ __forceinline__ float wave_max_dpp(float v) {
    int x = __builtin_bit_cast(int, v);
#define DPPMAX(ctrl) { const int y = __builtin_amdgcn_update_dpp(x, x, ctrl, 0xf, 0xf, false); x = __builtin_bit_cast(int, fmaxf(__builtin_bit_cast(float, x), __builtin_bit_cast(float, y))); }
    DPPMAX(0xB1) DPPMAX(0x4E) DPPMAX(0x141) DPPMAX(0x140)
#undef DPPMAX
    const float r0 = __builtin_bit_cast(float, __builtin_amdgcn_readlane(x, 0)), r1 = __builtin_bit_cast(float, __builtin_amdgcn_readlane(x, 16));
    const float r2 = __builtin_bit_cast(float, __builtin_amdgcn_readlane(x, 32)), r3 = __builtin_bit_cast(float, __builtin_amdgcn_readlane(x, 48));
    return fmaxf(fmaxf(r0, r1), fmaxf(r2, r3));
}
__device__ __forceinline__ void route_tokens(Frame& F, const Args& a, int layer, int ntok) {
    F.refresh();
    const int TPB = ntok / GRID;
    const bf16_t* U = (const bf16_t*)a.out; const bf16_t* Wr = (const bf16_t*)(F.ws + WS_WR) + (size_t)layer * 64 * 1024;
    int* tke = (int*)(F.ws + WS_TKE); float* tkw = (float*)(F.ws + WS_TKW);
    LAS int* lcnt = (LAS int*)(F.lds + L_LCNT);
    LAS float* sc = (LAS float*)(F.lds) + F.wave * 1024;
    if (F.tid < 64) lcnt[F.tid] = 0;
    __syncthreads();
    const int lane = F.lane, fr = lane & 15, fq = lane >> 4;
    const float bias = a.in[13][layer * 64 + lane];
    const int ntile = TPB / 16;
    for (int tl = F.wave; tl < ntile; tl += NWAVES) {
        const int t0 = F.blk * TPB + tl * 16;
        f32x4 acc[4];
#pragma unroll
        for (int n = 0; n < 4; ++n) acc[n] = (f32x4){0.f, 0.f, 0.f, 0.f};
        const GAS bf16x8* ap = (const GAS bf16x8*)(U + (size_t)(t0 + fr) * D + fq * 8);
        const GAS bf16x8* bp = (const GAS bf16x8*)(Wr + (size_t)fr * D + fq * 8);
#pragma unroll 4
        for (int ks = 0; ks < 32; ++ks) { const bf16x8 av = ap[ks * 4];
#pragma unroll
            for (int n = 0; n < 4; ++n) { const bf16x8 bv = bp[(size_t)n * 16 * (D / 8) + ks * 4]; acc[n] = __builtin_amdgcn_mfma_f32_16x16x32_bf16(av, bv, acc[n], 0, 0, 0); } }
#pragma unroll
        for (int n = 0; n < 4; ++n)
#pragma unroll
            for (int j = 0; j < 4; ++j) sc[(fq * 4 + j) * 64 + n * 16 + fr] = acc[n][j];
        LDS_WAIT();
        for (int tk = 0; tk < 16; ++tk) {
            const float logit = sc[tk * 64 + lane];
            const float s = 1.f / (1.f + __expf(-logit));
            const float sel = s + bias;
            const int g = lane >> 3;
            float m1 = sel; m1 = fmaxf(m1, __shfl_xor(m1, 1)); m1 = fmaxf(m1, __shfl_xor(m1, 2)); m1 = fmaxf(m1, __shfl_xor(m1, 4));
            const unsigned long long bm = __ballot(sel == m1);
            const unsigned gm = (unsigned)(bm >> (g * 8)) & 0xffu;
            const int first = g * 8 + __builtin_ctz(gm);
            float m2 = (lane == first) ? -INFINITY : sel; m2 = fmaxf(m2, __shfl_xor(m2, 1)); m2 = fmaxf(m2, __shfl_xor(m2, 2)); m2 = fmaxf(m2, __shfl_xor(m2, 4));
            const float gs = m1 + m2;
            float curg = gs; bool gok = false;
#pragma unroll 1
            for (int it = 0; it < 4; ++it) { const float mx = wave_max_dpp(curg);
                const unsigned long long bb = __ballot(curg == mx); const int gi = (int)(__builtin_ctzll(bb) >> 3);
                if (g == gi) { gok = true; curg = -INFINITY; } }
            float cure = gok ? sel : -INFINITY; bool chosen = false; int rk = 0;
#pragma unroll 1
            for (int it = 0; it < 8; ++it) { const float mx = wave_max_dpp(cure);
                const unsigned long long bb = __ballot(cure == mx); const int ei = (int)__builtin_ctzll(bb);
                if (lane == ei) { chosen = true; rk = it; cure = -INFINITY; } }
            const float tot = wave_sum(chosen ? s : 0.f);
            if (chosen) { const int tok = t0 + tk; tke[(size_t)tok * 8 + rk] = lane; tkw[(size_t)tok * 8 + rk] = s / tot * 2.5f; __hip_atomic_fetch_add(&lcnt[lane], 1, __ATOMIC_RELAXED, __HIP_MEMORY_SCOPE_WORKGROUP); }
        }
        LDS_WAIT();
    }
    __syncthreads();
    if (F.tid < 64) F.ctl[CW_BCNT + F.blk * 64 + F.tid] = (unsigned)lcnt[F.tid];
}
__device__ __forceinline__ void build_lists(Frame& F, int ntok) {
    F.refresh();
    constexpr int NSEG = NCHUNK * 64, BPC = GRID / NCHUNK;
    const int TPB = ntok / GRID, CH = ntok / NCHUNK;
    LAS int* tstart = (LAS int*)(F.lds + L_TSTART); LAS int* pref = (LAS int*)(F.lds + L_PREF); LAS int* lcnt = (LAS int*)(F.lds + L_LCNT);
    LAS unsigned char* tseg = (LAS unsigned char*)(F.lds + L_TSEG); LAS int* scan = (LAS int*)(F.lds + L_SCAN);
    const unsigned* bcnt = F.ctl + CW_BCNT;
    const int myc = F.blk / BPC, mylb = F.blk % BPC;
    int nseg = 0;
    LAS int* cntl = (LAS int*)F.lds;
    for (int i = F.tid; i < GRID * 64; i += NTHR) cntl[i] = (int)((const GAS unsigned*)bcnt)[i];
    if (F.tid < 64) lcnt[F.tid] = 0;
    __syncthreads();
    if (F.tid < NSEG) { const int c = F.tid >> 6, e = F.tid & 63; int n = 0, p = 0;
        for (int lb = 0; lb < BPC; ++lb) { const int v = cntl[(c * BPC + lb) * 64 + e]; if (c == myc && lb < mylb) p += v; n += v; }
        nseg = n; scan[F.tid] = (n + 255) >> 8; if (c == myc) pref[e] = p; }
    __syncthreads();
    if (F.tid == 0) { int acc = 0; for (int s = 0; s < NSEG; ++s) { tstart[s] = acc; acc += scan[s]; } tstart[NSEG] = acc; }
    __syncthreads();
    if (F.tid < NSEG) { const int t0 = tstart[F.tid], t1 = tstart[F.tid + 1]; for (int t = t0; t < t1; ++t) tseg[t] = (unsigned char)F.tid; }
    int* stok = (int*)(F.ws + WS_STOK); int* spos = (int*)(F.ws + WS_SDST);
    const int* tke = (const int*)(F.ws + WS_TKE);
    { const int sseg = myc * 64 + mylb; if (mylb < 64 && F.tid == sseg) scan[0] = nseg; }
    __syncthreads();
    if (mylb < 64) { const int sseg = myc * 64 + mylb; const int n = scan[0]; const int base = tstart[sseg] * 256, end = tstart[sseg + 1] * 256;
      for (int p = base + n + F.tid; p < end; p += NTHR) stok[p] = myc * CH; }
    for (int tl = F.wave; tl < TPB; tl += NWAVES) { const int tok = F.blk * TPB + tl;
        if (F.lane < 8) { const int e = tke[(size_t)tok * 8 + F.lane];
            const int p = tstart[myc * 64 + e] * 256 + pref[e] + __hip_atomic_fetch_add(&lcnt[e], 1, __ATOMIC_RELAXED, __HIP_MEMORY_SCOPE_WORKGROUP);
            stok[p] = tok; spos[(size_t)tok * 8 + F.lane] = p - tstart[myc * 64] * 256; } }
    __syncthreads();
}

struct SchedQKV {
    const char* U; const char* W; int nfull, nu, c;
    __device__ __forceinline__ bool next(int i, pg::Unit& u) const {
        const int L0 = i * GRID + c; if (L0 >= nu) return false;
        int pm, pn;
        if (L0 < nfull) { const int L = pg::xcd_remap(L0, nfull); const int gid = L / 48, w = L % 48; pm = gid * 8 + (w & 7); pn = w >> 3; }
        else { const int q = L0 - nfull; pm = 256 + (q >> 1); pn = 4 + (q & 1); }
        u.A = U + (size_t)pm * 256 * 2048; u.B = W + (size_t)pn * 256 * 2048; u.gidx = nullptr; u.gbase = 0; u.nt = 16; u.out = nullptr; u.ldc = 0; u.scale = 1.f; u.flags = 0; u.i0 = pm; u.i1 = pn;
        return true; }
};
struct SchedDense {
    const char* A; const char* W; char* out; int nrt, nct, nt, c; size_t ldA;
    __device__ __forceinline__ bool next(int i, pg::Unit& u) const {
        const int nu = nrt * nct; const int L0 = i * GRID + c; if (L0 >= nu) return false;
        const int L = pg::xcd_remap(L0, nu); const int per = 8 * nct, gid = L / per, w = L % per, fm = gid * 8, gsz = (nrt - fm) < 8 ? (nrt - fm) : 8; const int pm = fm + (w % gsz), pn = w / gsz;
        u.A = A + (size_t)pm * 256 * ldA; u.B = W + (size_t)pn * 256 * ldA; u.gidx = nullptr; u.gbase = 0; u.nt = nt; u.out = out + (size_t)pm * 256 * 2048 + pn * 512; u.ldc = 2048; u.scale = 1.f; u.flags = 0; u.i0 = pm; u.i1 = pn;
        return true; }
};
struct SchedF1 {
    const char* CS; const char* U; char* ABT; char* ABTC; int nu, c;
    __device__ __forceinline__ bool next(int i, pg::Unit& u) const {
        const int L0 = i * GRID + c; if (L0 >= nu) return false;
        u.gidx = nullptr; u.gbase = 0; u.nt = 4; u.scale = 1.f; u.flags = 0; u.i0 = 0; u.i1 = 0;
        if (L0 < 2048) { const int L = pg::xcd_remap(L0, 2048); const int pm = L & 1, pn = (L >> 1) & 7, bg = L >> 4, b = bg >> 2, g = bg & 3;
            u.A = CS + (size_t)pm * 256 * 512; u.B = U + ((size_t)b * SEQ + pn * 256) * 2048 + g * 512; u.out = ABT + (size_t)bg * 256 * 8192 + (size_t)(pm * 2048 + pn * 256) * 2; u.ldc = 8192; }
        else { const int q = L0 - 2048; const int pm = q & 1, bg = q >> 1, b = bg >> 2, g = bg & 3;
            u.A = CS + (size_t)pm * 256 * 512; u.B = U + ((size_t)T + b * CTXL) * 2048 + g * 512; u.out = ABTC + (size_t)bg * 256 * 1024 + (size_t)pm * 512; u.ldc = 1024; }
        return true; }
};
struct SchedF2 {
    const char* DL; const char* ABT; char* FH; int c;
    __device__ __forceinline__ bool next(int i, pg::Unit& u) const {
        const int L0 = i * GRID + c; if (L0 >= 512) return false;
        const int L = pg::xcd_remap(L0, 512); const int pm = L & 3, bg = L >> 2, b = bg >> 2, g = bg & 3;
        u.A = DL + (size_t)pm * 256 * 8192; u.B = ABT + (size_t)bg * 256 * 8192; u.gidx = nullptr; u.gbase = 0; u.nt = 64; u.out = FH + ((size_t)b * 1024 + pm * 256) * 2048 + g * 512; u.ldc = 2048; u.scale = 0.001381067932004975f  ; u.flags = 0; u.i0 = 0; u.i1 = 0;
        return true; }
};
struct SchedF2c {
    const char* DLC; const char* ABTC; char* FC; int c;
    __device__ __forceinline__ bool next(int i, pg::Unit& u) const {
        const int L0 = i * GRID + c; if (L0 >= 128) return false;
        const int bg = L0, b = bg >> 2, g = bg & 3;
        u.A = DLC; u.B = ABTC + (size_t)bg * 256 * 1024; u.gidx = nullptr; u.gbase = 0; u.nt = 8; u.out = FC + ((size_t)b * 256) * 2048 + g * 512; u.ldc = 2048; u.scale = 1.f / 256.f; u.flags = 0; u.i0 = 0; u.i1 = 0;
        return true; }
};
struct SchedF3 {
    const char* FH; const char* FC; const char* W; char* Y; int nu, c;
    __device__ __forceinline__ bool next(int i, pg::Unit& u) const {
        const int L0 = i * GRID + c; if (L0 >= nu) return false;
        u.gidx = nullptr; u.gbase = 0; u.nt = 16; u.scale = 1.f; u.flags = 0; u.i0 = 0; u.i1 = 0;
        if (L0 < 1024) { const int L = pg::xcd_remap(L0, 1024); const int gid = L >> 6, w = L & 63, pm = gid * 8 + (w & 7), pn = w >> 3; const int b = pm >> 2, k0 = (pm & 3) * 256;
            u.A = FH + (size_t)pm * 256 * 2048; u.B = W + (size_t)pn * 256 * 2048;
            if (pn < 4) { u.out = Y + ((size_t)b * SEQ + k0) * 2048 + pn * 512; u.ldc = 2048; }
            else { u.out = Y + ((size_t)b * SEQ + SEQ - k0) * 2048 + (pn - 4) * 512; u.ldc = -2048; u.flags = (k0 == 0) ? 1 : 0; } }
        else { const int q = L0 - 1024; const int pm = q >> 2, pn = q & 3;
            u.A = FC + (size_t)pm * 256 * 2048; u.B = W + (size_t)pn * 256 * 2048; u.out = Y + ((size_t)T + pm * 256) * 2048 + pn * 512; u.ldc = 2048; }
        return true; }
};
struct SchedG1 {
    const char* EGU; const int* STOK; char* H; char* HS; LAS const unsigned char* tseg; int ntl, nsh, c;
    __device__ __forceinline__ bool gsrc(int i, const int*& gidx, int& gbase) const {
        const int nu = (ntl + nsh) * 2; const int L0 = i * GRID + c; if (L0 >= nu) return false;
        const int pm = pg::xcd_remap(L0, nu) >> 1;
        if (pm < ntl) { gidx = STOK + (size_t)pm * 256; gbase = 0; } else { gidx = nullptr; gbase = (pm - ntl) * 256; }
        return true; }
    __device__ __forceinline__ bool next(int i, pg::Unit& u) const {
        const int nu = (ntl + nsh) * 2; const int L0 = i * GRID + c; if (L0 >= nu) return false;
        const int L = pg::xcd_remap(L0, nu); const int pm = L >> 1, pn = L & 1;
        u.A = nullptr; u.gbase = 0; u.nt = 8; u.ldc = 256; u.scale = 1.f; u.flags = 0; u.i0 = 0; u.i1 = 0;
        if (pm < ntl) { const int e = __builtin_amdgcn_readfirstlane((int)tseg[pm]) & 63;
            u.gidx = STOK + (size_t)pm * 256; u.B = EGU + (size_t)e * 512 * 1024 + (size_t)pn * 256 * 1024; u.out = H + (size_t)pm * 256 * 256 + pn * 128; }
        else { const int ps = pm - ntl; u.gidx = nullptr; u.gbase = ps * 256; u.B = EGU + (size_t)NE * 512 * 1024 + (size_t)pn * 256 * 1024; u.out = HS + (size_t)ps * 256 * 256 + pn * 128; }
        return true; }
};
struct SchedG2 {
    const char* ED; const char* H; const char* HS; char* YB; char* YS; LAS const unsigned char* tseg; int t0, t1, nsh, ch, CH, c;
    __device__ __forceinline__ bool next(int i, pg::Unit& u) const {
        const int nr = t1 - t0; const int nu = (nr + nsh) * 4; const int L0 = i * GRID + c; if (L0 >= nu) return false;
        const int L = pg::xcd_remap(L0, nu); const int q = L >> 2, pn = L & 3;
        u.gidx = nullptr; u.gbase = 0; u.nt = 2; u.ldc = 1024; u.scale = 1.f; u.flags = 0; u.i0 = 0; u.i1 = pn;
        if (q < nr) { const int pm = t0 + q; const int e = __builtin_amdgcn_readfirstlane((int)tseg[pm]) & 63;
            u.A = H + (size_t)pm * 256 * 256; u.B = ED + (size_t)e * 1024 * 256 + (size_t)pn * 256 * 256; u.out = YB + (size_t)q * 256 * 1024; }
        else { const int ps = q - nr; u.A = HS + ((size_t)ch * CH + ps * 256) * 256; u.B = ED + (size_t)NE * 1024 * 256 + (size_t)pn * 256 * 256; u.out = YS + (size_t)ps * 256 * 1024; }
        return true; }
};

__device__ __forceinline__ void fnet_nyquist_rows(Frame& F) {
    F.refresh();
    const bf16_t* ABT = (const bf16_t*)(F.ws + WS_ABT); bf16_t* FH1 = (bf16_t*)(F.ws + WS_FH1);
    for (int r = F.gw; r < 128 * 256; r += NGW) { const int bg = r >> 8, m = r & 255, b = bg >> 2, g = bg & 3;
        const GAS u32x4* p = (const GAS u32x4*)(ABT + (size_t)r * 4096); float s = 0.f;
#pragma unroll
        for (int i = 0; i < 4; ++i) { const u32x4 w = p[i * 64 + F.lane]; s += (bflo(w.x) - bfhi(w.x)) + (bflo(w.y) - bfhi(w.y)) + (bflo(w.z) - bfhi(w.z)) + (bflo(w.w) - bfhi(w.w)); }
        s = wave_sum(s) * 0.001381067932004975f;
        if (F.lane == 0) FH1[(size_t)b * 1024 + g * 256 + m] = (bf16_t)f2bf(s); }
}
__device__ __forceinline__ void fnet_nyquist_out(Frame& F, const Args& a, int jl) {
    F.refresh();
    const bf16_t* FH1 = (const bf16_t*)(F.ws + WS_FH1); const bf16_t* W = (const bf16_t*)(F.ws + WS_WF) + (size_t)jl * 2048 * 1024; bf16_t* Y = (bf16_t*)a.out;
    LAS float* part = (LAS float*)F.lds;
    const int b = F.blk >> 3, n = (F.blk & 7) * 128 + (F.tid & 127), kq = F.tid >> 7;
    const GAS u32x4* wp = (const GAS u32x4*)(W + (size_t)n * 1024 + kq * 256); const GAS u32x4* fp = (const GAS u32x4*)(FH1 + (size_t)b * 1024 + kq * 256);
    float s = 0.f;
#pragma unroll 4
    for (int i = 0; i < 32; ++i) { const u32x4 w = wp[i], f = fp[i];
        s += bflo(w.x) * bflo(f.x) + bfhi(w.x) * bfhi(f.x) + bflo(w.y) * bflo(f.y) + bfhi(w.y) * bfhi(f.y) + bflo(w.z) * bflo(f.z) + bfhi(w.z) * bfhi(f.z) + bflo(w.w) * bflo(f.w) + bfhi(w.w) * bfhi(f.w); }
    part[F.tid] = s;
    __syncthreads();
    if (F.tid < 128) { const float t = (part[F.tid] + part[F.tid + 128]) + (part[F.tid + 256] + part[F.tid + 384]); Y[((size_t)b * SEQ + 1024) * D + n] = (bf16_t)f2bf(t); }
    __syncthreads();
}


#ifdef SELFCHECK
constexpr int CW_ERR = 1024;
constexpr size_t WS_OCHK = WS_R + 216 * MiB;
__device__ __forceinline__ void chk_report(unsigned* ctl, int id, float got, float ref, float tabs, float trel) {
    float e = fabsf(got - ref) / (tabs + trel * fabsf(ref)); if (!(e == e)) e = 1e30f; atomicMax(ctl + CW_ERR + id, __float_as_uint(e)); }
__device__ __forceinline__ float bf2f(bf16_t b) { return __builtin_bit_cast(float, (unsigned)b << 16); }
__constant__ int chk_toks[16] = {0, 1, 63, 64, 65, 127, 2047, 2048, 2049, 4096, 33000, 65535, 65536, 65537, 70000, 73727};
__constant__ int chk_ks[8] = {0, 1, 2, 255, 256, 1023, 1024, 700};
__constant__ int chk_ms[4] = {0, 1, 128, 255};
__constant__ int chk_ytoks[10] = {0, 1, 1023, 1024, 1025, 2047, 2048, 65535, 65536, 73727};
__constant__ int chk_ns[5] = {0, 1, 255, 256, 1023};
__constant__ int chk_cols[20] = {0, 7, 15, 16, 31, 32, 40, 48, 63, 64, 500, 1023, 1024, 1039, 1040, 1072, 1279, 1280, 1300, 1535};
__device__ __forceinline__ void chk_qkv(Frame& F, const Args& a, int layer, int id) {
    F.refresh(); const bf16_t* U = (const bf16_t*)a.out; const float* W = a.in[8] + (size_t)(layer >> 1) * 1024 * 1536;
    const bf16_t* Qb = (const bf16_t*)(F.ws + WS_Q); const bf16_t* Kb = (const bf16_t*)(F.ws + WS_K); const bf16_t* Vb = (const bf16_t*)(F.ws + WS_V);
    for (int s = F.gw; s < 320; s += NGW) { const int tok = chk_toks[s & 15], col = chk_cols[s >> 4];
        if (layer == 2 && tok >= T && col < 1024) continue;
        const bool rope = (tok < T) && col < 1280; const int hc = col & 63, first = (hc & 31) < 16; const int pcol = rope ? (first ? col + 16 : col - 16) : col;
        float x = 0.f, xp = 0.f;
        for (int k = F.lane; k < 1024; k += 64) { const float u = bf2f(U[(size_t)tok * D + k]); x += u * W[(size_t)k * 1536 + col]; xp += u * W[(size_t)k * 1536 + pcol]; }
        x = wave_sum(x); xp = wave_sum(xp);
        float ref = x;
        if (rope) { const int tl = tok & 2047, part = hc >> 5, pos = part ? (tl & 63) : (tl >> 6), fi = hc & 15; const float ang = (float)pos * powf(10000.f, -(float)fi / 16.f);
            ref = x * cosf(ang) + (first ? -xp : xp) * sinf(ang); }
        if (col < 1024) ref *= C2;
        const float got = col < 1024 ? bf2f(Qb[(size_t)tok * 1024 + col]) : (col < 1280 ? bf2f(Kb[(size_t)tok * 256 + col - 1024]) : bf2f(Vb[(size_t)tok * 256 + col - 1280]));
        if (F.lane == 0) chk_report(F.ctl, id, got, ref, 0.03f, 0.03f); }
}
__device__ __forceinline__ void chk_attn(Frame& F, const Args& a, int layer, int id) {
    F.refresh(); const bf16_t* Qb = (const bf16_t*)(F.ws + WS_Q); const bf16_t* Kb = (const bf16_t*)(F.ws + WS_K); const bf16_t* Vb = (const bf16_t*)(F.ws + WS_V); const bf16_t* Ob = (const bf16_t*)(F.ws + WS_OCHK);
    LAS float* lg = (LAS float*)F.lds + F.wave * 1024;
    for (int s = F.gw; s < 64; s += NGW) { const int tok = chk_toks[s & 15], h = (s >> 4) * 5, kvh = h >> 2;
        if (layer == 2 && tok >= T) continue;
        const bool isctx = tok >= T; const int b = isctx ? (tok - T) / CTXL : tok / SEQ, p = tok & (SEQ - 1);
        int nk = 0; const int lo = isctx ? 0 : (p - 128 < 0 ? 0 : p - 128), hi = isctx ? -1 : (p + 128 > SEQ - 1 ? SEQ - 1 : p + 128);
        const int nlat = isctx ? 0 : hi - lo + 1; nk = nlat + CTXL;
        float mx = a.in[10][(layer >> 1) * 16 + h] * LOG2E; const float sink2 = mx;
        for (int i = F.lane; i < nk; i += 64) { const size_t kr = i < nlat ? (size_t)b * SEQ + lo + i : (size_t)T + b * CTXL + (i - nlat); float d = 0.f;
            for (int e = 0; e < 64; ++e) d += bf2f(Qb[(size_t)tok * 1024 + h * 64 + e]) * bf2f(Kb[kr * 256 + kvh * 64 + e]);
            lg[i] = d; mx = fmaxf(mx, d); }
#pragma unroll
        for (int o = 1; o < 64; o <<= 1) mx = fmaxf(mx, __shfl_xor(mx, o));
        LDS_WAIT();
        float den = 0.f; for (int i = F.lane; i < nk; i += 64) den += exp2f(lg[i] - mx);
        den = wave_sum(den) + exp2f(sink2 - mx);
        float o = 0.f;
        for (int i = 0; i < nk; ++i) { const size_t kr = i < nlat ? (size_t)b * SEQ + lo + i : (size_t)T + b * CTXL + (i - nlat); o += exp2f(lg[i] - mx) * bf2f(Vb[kr * 256 + kvh * 64 + F.lane]); }
        o /= den;
        chk_report(F.ctl, id, bf2f(Ob[(size_t)tok * 1024 + h * 64 + F.lane]), o, 0.01f, 0.03f); chk_report(F.ctl, 32 + (s & 15), bf2f(Ob[(size_t)tok * 1024 + h * 64 + F.lane]), o, 0.01f, 0.03f);
        LDS_WAIT(); }
    __syncthreads();
}
__device__ __forceinline__ void chk_fnet_f(Frame& F, const Args& a, bool upd, int id) {
    F.refresh(); const bf16_t* U = (const bf16_t*)a.out; LAS float* red = (LAS float*)F.lds;
    for (int s = F.blk; s < 128 + (upd ? 64 : 0); s += GRID) {
        const bool cx = s >= 128; const int q = cx ? s - 128 : s; const int m = chk_ms[q & 3], g = ((q >> 2) & 1) * 3, b = ((q >> 3) & 1) * 31; int k = chk_ks[(q >> 4) & 7]; const int L = cx ? CTXL : SEQ; if (cx) k &= 255;
        const size_t row0 = cx ? (size_t)T + b * CTXL : (size_t)b * SEQ;
        float acc = 0.f;
        for (int l = F.wave; l < L; l += NWAVES) { float ca = 0.f, sa = 0.f;
            for (int n = F.lane; n < 256; n += 64) { const float u = bf2f(U[(row0 + l) * D + g * 256 + n]); const float an = 6.283185307179586f * (float)((m * n) & 255) / 256.f; const float sn = __sinf(an), cs = __cosf(an); ca += u * cs; sa += u * sn; }
            ca = wave_sum(ca); sa = wave_sum(sa); const float an = 6.283185307179586f * (float)((k * l) % L) / (float)L; const float sn = __sinf(an), cs = __cosf(an); acc += cs * ca - sn * sa; }
        if (F.lane == 0) red[F.wave] = acc;
        __syncthreads();
        if (F.tid == 0) { float t = 0.f; for (int w = 0; w < NWAVES; ++w) t += red[w]; t *= cx ? (1.f / 256.f) : 0.001381067932004975f;
            float got;
            if (cx) got = bf2f(((const bf16_t*)(F.ws + WS_FC))[((size_t)b * 256 + k) * D + g * 256 + m]);
            else if (k == 1024) got = bf2f(((const bf16_t*)(F.ws + WS_FH1))[(size_t)b * 1024 + g * 256 + m]);
            else got = bf2f(((const bf16_t*)(F.ws + WS_FH))[((size_t)b * 1024 + k) * D + g * 256 + m]);
            chk_report(F.ctl, id, got, t, 0.02f, 0.03f); }
        __syncthreads(); }
}
__device__ __forceinline__ void chk_fnet_y(Frame& F, const Args& a, int jl, bool upd, int id) {
    F.refresh(); const bf16_t* Y = (const bf16_t*)a.out; const float* W = a.in[11] + (size_t)jl * 1024 * 1024;
    const bf16_t* FH = (const bf16_t*)(F.ws + WS_FH); const bf16_t* FH1 = (const bf16_t*)(F.ws + WS_FH1); const bf16_t* FC = (const bf16_t*)(F.ws + WS_FC);
    for (int s = F.gw; s < 50; s += NGW) { const int tok = chk_ytoks[s % 10], n = chk_ns[s / 10]; if (tok >= T && !upd) continue;
        float acc = 0.f;
        for (int j = F.lane; j < 1024; j += 64) { float f;
            if (tok >= T) f = bf2f(FC[(size_t)(tok - T) * D + j]);
            else { const int b = tok >> 11, k = tok & 2047; if (k < 1024) f = bf2f(FH[((size_t)b * 1024 + k) * D + j]); else if (k == 1024) f = bf2f(FH1[(size_t)b * 1024 + j]);
                else f = bf2f(FH[((size_t)b * 1024 + (2048 - k)) * D + (j & ~255) + ((256 - (j & 255)) & 255)]); }
            acc += f * W[(size_t)j * 1024 + n]; }
        acc = wave_sum(acc);
        if (F.lane == 0) chk_report(F.ctl, id, bf2f(Y[(size_t)tok * D + n]), acc, 0.02f, 0.03f); }
}
__device__ __forceinline__ void chk_route(Frame& F, const Args& a, int layer, int ntok, int id) {
    F.refresh(); const bf16_t* U = (const bf16_t*)a.out; const float* Wr = a.in[12] + (size_t)layer * 1024 * 64; const int* tke = (const int*)(F.ws + WS_TKE); const float* tkw = (const float*)(F.ws + WS_TKW);
    for (int s = F.gw; s < 16; s += NGW) { const int tok = chk_toks[s]; if (tok >= ntok) continue; const int lane = F.lane;
        float lgt = 0.f; for (int k = 0; k < 1024; ++k) lgt += bf2f(U[(size_t)tok * D + k]) * Wr[(size_t)k * 64 + lane];
        const float sc = 1.f / (1.f + expf(-lgt)), sel = sc + a.in[13][layer * 64 + lane];
        float g1 = -INFINITY, g2 = -INFINITY;
#pragma unroll 1
        for (int j = 0; j < 8; ++j) { const float v = __shfl(sel, (lane & ~7) + j); if (v > g1) { g2 = g1; g1 = v; } else if (v > g2) g2 = v; }
        const float gs = g1 + g2; int gr = 0;
#pragma unroll 1
        for (int gp = 0; gp < 8; ++gp) { const float v = __shfl(gs, gp * 8); gr += (v > gs || (v == gs && gp < (lane >> 3))) ? 1 : 0; }
        const float sm = gr < 4 ? sel : -INFINITY; int rk = 0;
#pragma unroll 1
        for (int ep = 0; ep < 64; ++ep) { const float v = __shfl(sm, ep); rk += (v > sm || (v == sm && ep < lane)) ? 1 : 0; }
        const float tot = wave_sum(rk < 8 ? sc : 0.f); const float wref = sc / tot * 2.5f;
        int slot = -1; for (int j = 0; j < 8; ++j) if (tke[(size_t)tok * 8 + j] == lane) slot = j;
        float err = 0.f;
        if (slot >= 0) { if (rk >= 10) err = 10.f; else if (rk < 8) err = fabsf(tkw[(size_t)tok * 8 + slot] - wref) / (0.04f * wref); }
        else if (rk < 6) err = 10.f;
        const unsigned long long nsel = __ballot(slot >= 0); if (__builtin_popcountll(nsel) != 8) err = 20.f;
        atomicMax(F.ctl + CW_ERR + id, __float_as_uint(err)); }
}
__device__ __forceinline__ void chk_moe(Frame& F, const Args& a, int layer, int ntok, int ch, int id) {
    F.refresh(); const bf16_t* U = (const bf16_t*)a.out; const int* tke = (const int*)(F.ws + WS_TKE); const float* tkw = (const float*)(F.ws + WS_TKW);
    const int CH = ntok / NCHUNK; LAS float* hs = (LAS float*)F.lds; LAS float* us = hs + 512; LAS float* pg_ = us + 1024;
    for (int s = F.blk; s < 16; s += GRID) { const int tok = chk_toks[s]; if (tok >= ntok || tok / CH != ch) continue;
        for (int k = F.tid; k < 1024; k += NTHR) us[k] = bf2f(U[(size_t)tok * D + k]);
        __syncthreads();
        float y0 = 0.f, y1 = 0.f;
        for (int j = 0; j < 9; ++j) { const int e = j < 8 ? tke[(size_t)tok * 8 + j] : 0; const float w = j < 8 ? tkw[(size_t)tok * 8 + j] : 1.f;
            const float* wg = j < 8 ? a.in[14] + ((size_t)layer * NE + e) * 262144 : a.in[17] + (size_t)layer * 262144;
            const float* wu = j < 8 ? a.in[15] + ((size_t)layer * NE + e) * 262144 : a.in[18] + (size_t)layer * 262144;
            const float* wd = j < 8 ? a.in[16] + ((size_t)layer * NE + e) * 262144 : a.in[19] + (size_t)layer * 262144;
            const int hh = F.tid & 255, half = F.tid >> 8; float g = 0.f, u = 0.f;
            for (int k = half * 512; k < half * 512 + 512; ++k) { g += us[k] * wg[(size_t)k * 256 + hh]; u += us[k] * wu[(size_t)k * 256 + hh]; }
            pg_[F.tid] = g; pg_[512 + F.tid] = u;
            __syncthreads();
            if (F.tid < 256) { const float gg = pg_[F.tid] + pg_[F.tid + 256], uu = pg_[512 + F.tid] + pg_[512 + F.tid + 256]; hs[F.tid] = gg / (1.f + expf(-gg)) * uu; }
            __syncthreads();
            float t0 = 0.f, t1 = 0.f; for (int q = 0; q < 256; ++q) { t0 += hs[q] * wd[(size_t)q * 1024 + F.tid]; t1 += hs[q] * wd[(size_t)q * 1024 + 512 + F.tid]; }
            y0 += w * t0; y1 += w * t1;
            __syncthreads(); }
        float g0 = 0.f, g1 = 0.f; const int i = tok - ch * CH;
        { const unsigned char* YSb = (const unsigned char*)(F.ws + WS_YS); const unsigned char* YBb = (const unsigned char*)(F.ws + WS_YB); const int* spos = (const int*)(F.ws + WS_SDST);
          const int t_ = F.tid, bo = 16 * (16 * (t_ >> 8) + ((t_ & 127) >> 3)) + 8 * ((t_ >> 7) & 1) + (t_ & 7);
          auto f8 = [](unsigned char b) { return __builtin_amdgcn_cvt_pk_f32_fp8((int)b, false)[0] * (1.f / 16.f); };
          g0 = f8(YSb[(size_t)i * D + bo]); g1 = f8(YSb[(size_t)i * D + bo + 512]);
          for (int j = 0; j < 8; ++j) { const size_t ps = (size_t)spos[(size_t)tok * 8 + j]; const float w = tkw[(size_t)tok * 8 + j]; g0 += w * f8(YBb[ps * D + bo]); g1 += w * f8(YBb[ps * D + bo + 512]); } }
        chk_report(F.ctl, id, g0, y0, 0.12f, 0.12f); chk_report(F.ctl, id, g1, y1, 0.12f, 0.12f);
        __syncthreads(); }
}
#endif

#ifndef PH_MASK
#define PH_MASK 0xffffffffu
#endif
#define PH(b) ((PH_MASK >> (b)) & 1u)
__global__ void __launch_bounds__(NTHR, 2) fwd(Args a) {
    extern __shared__ __attribute__((aligned(16))) unsigned char lds_raw[];
    Frame F;
    F.lds = (LAS unsigned char*)lds_raw; F.ws = a.ws; F.ctl = (unsigned*)(a.ws + WS_CTL);
    F.blk = blockIdx.x; F.refresh();
    for (int u = F.tid; u < (LDS_BYTES - RING_BYTES) / 4; u += NTHR) ((LAS unsigned*)(F.lds + RING_BYTES))[u] = 0u;
    __syncthreads();
    const XcdBarrier bar = xcd_barrier_post(F.ctl + CW_BAR, (volatile LAS unsigned*)(F.lds + L_MISC) + 8);
#define GRID_BAR() xcd_barrier(bar)
    LAS unsigned char* ring = F.lds;
    const int c = F.blk;
#define ws (F.ws)
#define NEWPH() F.refresh()

    if (PH(0)) { conv_small(F, a);
    __syncthreads();
    mod_partials(F, a); }
    GRID_BAR();
    if (PH(1)) { rows_init(F, a);
    mod_finalize(F, a); }
    GRID_BAR();

    for (int layer = 0; layer < 4; ++layer) {
        const int jl = layer >> 1; const bool upd = layer < 2; const int nrows = upd ? TT : T;
        if ((layer & 1) == 0) {
            NEWPH();
            if (PH(2)) { SchedQKV S; S.U = (const char*)a.out; S.W = (const char*)(ws + WS_WQKV) + (size_t)jl * 1536 * 2048; S.nfull = (layer == 0) ? 288 * 6 : 256 * 6; S.nu = (layer == 0) ? 288 * 6 : 256 * 6 + 64; S.c = c;
              pg::EpiQKV E; E.Q = (bf16_t*)(ws + WS_Q); E.K = (bf16_t*)(ws + WS_K); E.V = (bf16_t*)(ws + WS_V); E.ropec = (const float*)(ws + WS_ROPEC); E.ropes = (const float*)(ws + WS_ROPES);
              pg::gemm_phase<pg::EpiQKV, SchedQKV, false>(ring, 2048u, 2048u, nullptr, S, E); }
            GRID_BAR();
#ifdef SELFCHECK
            if (SELFCHECK & 1) chk_qkv(F, a, layer, 1 + (layer >> 1));
#define OBUF ((bf16_t*)(ws + WS_OCHK))
#else
#define OBUF ((bf16_t*)(ws + WS_Q))
#endif
            NEWPH();
            if (PH(3)) { const int NU = 4096 + (layer == 0 ? 512 : 0);
              const bf16_t* Qb = (const bf16_t*)(ws + WS_Q); const bf16_t* Kb = (const bf16_t*)(ws + WS_K); const bf16_t* Vb = (const bf16_t*)(ws + WS_V);
              for (int i = 0; i * GRID + c < NU; ++i) { int id = pg::xcd_remap(i * GRID + c, NU);
                  if (NU > 4096) { const int g9 = id / 9, r9 = id - g9 * 9; id = (r9 < 8) ? g9 * 8 + r9 : 4096 + g9; }
                  if (id < 4096) { const int hq = id & 3, qb = (id >> 2) & 7, kvh = (id >> 5) & 3, b = id >> 7, h = kvh * 4 + hq;
                      attn::attn_unit(Qb, Kb, Vb, OBUF, b, h, qb * 256, false, a.in[10][jl * 16 + h] * LOG2E, ring); }
                  else { const int cid = id - 4096, hq = cid & 3, kvh = (cid >> 2) & 3, b = cid >> 4, h = kvh * 4 + hq;
                      attn::attn_unit(Qb, Kb, Vb, OBUF, b, h, 0, true, a.in[10][jl * 16 + h] * LOG2E, ring); } } }
            GRID_BAR();
#ifdef SELFCHECK
            if (SELFCHECK & 1) chk_attn(F, a, layer, 3 + (layer >> 1));
#endif
            NEWPH();
            if (PH(4)) { SchedDense S; S.A = (const char*)OBUF; S.W = (const char*)(ws + WS_WO) + (size_t)jl * 1024 * 2048; S.out = (char*)a.out; S.nrt = nrows / 256; S.nct = 4; S.nt = 16; S.c = c; S.ldA = 2048;
              pg::EpiStore E; pg::gemm_phase<pg::EpiStore, SchedDense, false>(ring, 2048u, 2048u, nullptr, S, E); }
            GRID_BAR();
        } else {
            NEWPH();
            if (PH(5)) { SchedF1 S; S.CS = (const char*)(ws + WS_CSN); S.U = (const char*)a.out; S.ABT = (char*)(ws + WS_ABT); S.ABTC = (char*)(ws + WS_ABTC); S.nu = 2048 + (upd ? 256 : 0); S.c = c;
              pg::EpiStore E; pg::gemm_phase<pg::EpiStore, SchedF1, false>(ring, 512u, 2048u, nullptr, S, E); }
            GRID_BAR();
            NEWPH();
            if (PH(6)) { SchedF2 S; S.DL = (const char*)(ws + WS_DL); S.ABT = (const char*)(ws + WS_ABT); S.FH = (char*)(ws + WS_FH); S.c = c;
              pg::EpiStore E; pg::gemm_phase<pg::EpiStore, SchedF2, false>(ring, 8192u, 8192u, nullptr, S, E); }
            NEWPH();
            if (PH(7) && upd) { SchedF2c S; S.DLC = (const char*)(ws + WS_DLC); S.ABTC = (const char*)(ws + WS_ABTC); S.FC = (char*)(ws + WS_FC); S.c = c;
              pg::EpiStore E; pg::gemm_phase<pg::EpiStore, SchedF2c, false>(ring, 1024u, 1024u, nullptr, S, E); }
            if (PH(8)) fnet_nyquist_rows(F);
            GRID_BAR();
#ifdef SELFCHECK
            if (SELFCHECK & 2) chk_fnet_f(F, a, upd, 5 + (layer >> 1));
            GRID_BAR();
#endif
            NEWPH();
            if (PH(9)) { SchedF3 S; S.FH = (const char*)(ws + WS_FH); S.FC = (const char*)(ws + WS_FC); S.W = (const char*)(ws + WS_WF) + (size_t)jl * 2048 * 2048; S.Y = (char*)a.out; S.nu = 1024 + (upd ? 128 : 0); S.c = c;
              pg::EpiStore E; pg::gemm_phase<pg::EpiStore, SchedF3, false>(ring, 2048u, 2048u, nullptr, S, E); }
            if (PH(10)) fnet_nyquist_out(F, a, jl);
            GRID_BAR();
#ifdef SELFCHECK
            if (SELFCHECK & 8) chk_fnet_y(F, a, jl, upd, 7 + (layer >> 1));
            GRID_BAR();
#endif
        }
        if (PH(12)) conv_experts(F, a, layer);
        __syncthreads();
        if (PH(11)) rows_post1(F, a, layer, nrows);
        VM_WAIT(); __syncthreads();
        if (threadIdx.x == 0) { __builtin_amdgcn_fence(__ATOMIC_ACQUIRE, "agent"); VM_WAIT(); }
        __syncthreads();
        if (PH(13)) route_tokens(F, a, layer, nrows);
        GRID_BAR();
#ifdef SELFCHECK
        if ((SELFCHECK & 4) && layer < 2) chk_route(F, a, layer, nrows, 9);
#endif
        if (PH(14)) build_lists(F, nrows);
        GRID_BAR();
        LAS const int* tstart = (LAS const int*)(F.lds + L_TSTART); LAS const unsigned char* tseg = (LAS const unsigned char*)(F.lds + L_TSEG);
        const int ntl = __builtin_amdgcn_readfirstlane(tstart[NCHUNK * 64]);
        NEWPH();
        if (PH(15)) { SchedG1 S; S.EGU = (const char*)(ws + WS_EGU); S.STOK = (const int*)(ws + WS_STOK); S.H = (char*)(ws + WS_H); S.HS = (char*)(ws + WS_HS); S.tseg = tseg; S.ntl = ntl; S.nsh = nrows / 256; S.c = c;
          pg::EpiSilu E; pg::gemm_phase<pg::EpiSilu, SchedG1, true, true>(ring, 1024u, 1024u, (const char*)a.out + OUT_U8, S, E); }
        GRID_BAR();
        const int CH = nrows / NCHUNK;
        for (int ch = 0; ch < NCHUNK; ++ch) {
            NEWPH();
            if (PH(16)) { SchedG2 S; S.ED = (const char*)(ws + WS_ED); S.H = (const char*)(ws + WS_H); S.HS = (const char*)(ws + WS_HS); S.YB = (char*)(ws + WS_YB); S.YS = (char*)(ws + WS_YS); S.tseg = tseg;
              S.t0 = __builtin_amdgcn_readfirstlane(tstart[ch * 64]); S.t1 = __builtin_amdgcn_readfirstlane(tstart[ch * 64 + 64]); S.nsh = CH / 256; S.ch = ch; S.CH = CH; S.c = c;
              pg::EpiFp8 E; pg::gemm_phase<pg::EpiFp8, SchedG2, false, true>(ring, 256u, 256u, nullptr, S, E); }
            GRID_BAR();
#ifdef SELFCHECK
            if ((SELFCHECK & 4) && (layer == 0 || layer == 3)) { if (layer == 0 || ch == 0) chk_moe(F, a, layer, nrows, ch, 10 + (layer == 3)); GRID_BAR(); }
#endif
            if (PH(17)) rows_post2(F, a, layer, ch * CH, CH);
            if (!(layer == 3 && ch == NCHUNK - 1)) GRID_BAR();
        }
    }
#ifdef SELFCHECK
    GRID_BAR();
    { int bad = 0; float be = 0.f; for (int k = 15; k >= 1; --k) { const float e = __uint_as_float(__hip_atomic_load(F.ctl + CW_ERR + k, RLX_AGENT)); if (e > 1.f) { bad = k; be = e; } }
      int wt = 0; float we = 0.f; for (int k = 0; k < 16; ++k) { const float e = __uint_as_float(__hip_atomic_load(F.ctl + CW_ERR + 32 + k, RLX_AGENT)); if (e > we) { we = e; wt = k; } }
      if (bad) { F.refresh(); float cv = 3.f + bad + (be > 8.f ? 0.5f : 0.f);  Row r; for (int j = 0; j < 4; ++j) r.v[j] = (f32x4){cv, cv, cv, cv}; for (int row = F.gw; row < T; row += NGW) row_store_f32(r, a.out + (size_t)row * D, F.lane); } }
#endif
}

#undef ws
#undef NEWPH
extern "C" void kernel_launch(void* const* d_in, const int* in_sizes, int n_in, void* d_out, int out_size, void* d_ws, size_t ws_size, hipStream_t stream) {
    static int ready = 0;
    if (ready == 0) {
        if (n_in != 20 || out_size != T * D || ws_size < WS_END) { fprintf(stderr, "kernel_launch: unexpected problem (n_in %d out %d ws %zu need %zu)\n", n_in, out_size, ws_size, (size_t)WS_END); ready = -1; return; }
        if (hipFuncSetAttribute((const void*)fwd, hipFuncAttributeMaxDynamicSharedMemorySize, LDS_BYTES) != hipSuccess) { fprintf(stderr, "kernel_launch: hipFuncSetAttribute failed\n"); ready = -1; return; }
        int per_cu = 0;
        if (hipOccupancyMaxActiveBlocksPerMultiprocessor(&per_cu, (const void*)fwd, NTHR, LDS_BYTES) != hipSuccess || per_cu < 1) fprintf(stderr, "kernel_launch: occupancy query says %d blocks per CU\n", per_cu);
        (void)hipGetLastError();
        ready = 1;
    }
    if (ready < 0) return;
    (void)hipMemsetAsync((char*)d_ws + WS_CTL, 0, CTL_BYTES, stream);
    Args a{};
    for (int i = 0; i < 20; ++i) a.in[i] = (const float*)d_in[i];
    a.out = (float*)d_out; a.ws = (unsigned char*)d_ws;
    hipLaunchKernelGGL(fwd, dim3(GRID), dim3(NTHR), LDS_BYTES, stream, a);
}
```

```cpp
#include <hip/hip_runtime.h>
#include <cstdio>
#include <cstdint>

#define LAS __attribute__((address_space(3)))
#define GAS __attribute__((address_space(1)))
typedef unsigned short bf16_t;
typedef short bf16x8 __attribute__((ext_vector_type(8)));
typedef short s16x4 __attribute__((ext_vector_type(4)));
typedef float f32x4 __attribute__((ext_vector_type(4)));
typedef float f32x16 __attribute__((ext_vector_type(16)));
typedef unsigned u32x4 __attribute__((ext_vector_type(4)));
typedef unsigned u32x2 __attribute__((ext_vector_type(2)));
typedef int v8i_t __attribute__((ext_vector_type(8)));
typedef int v4i_t __attribute__((ext_vector_type(4)));

constexpr int D = 1024, NB = 32, SEQ = 2048, T = NB * SEQ, CTXL = 256, TC = NB * CTXL, TT = T + TC;
constexpr int NQKV = 1536, NE = 64;
constexpr float ALPHA = 1.681792830507429f;
constexpr float LN_EPS = 1e-5f, MOD_EPS = 1e-6f;
constexpr float C2 = 0.125f * 1.4426950408889634f;
constexpr float LOG2E = 1.4426950408889634f;
constexpr int NCHUNK = 2;
constexpr int NWAVES = 8, NTHR = 512, GRID = 256;

constexpr size_t MiB = 1u << 20;
constexpr size_t WS_CTL = 0, CTL_BYTES = 1 * MiB;
constexpr size_t WS_ROPEC = 1 * MiB, WS_ROPES = 1 * MiB + 4096, WS_CSN = 1 * MiB + 65536, WS_DLC = 1 * MiB + 524288, WS_DL = 2 * MiB;
constexpr size_t WS_WQKV = 10 * MiB, WS_WO = 16 * MiB, WS_WF = 20 * MiB, WS_WR = 28 * MiB, WS_WSH = 29 * MiB;
constexpr size_t WS_MODP = 36 * MiB, WS_MOD = 49 * MiB;
constexpr size_t WS_EGU = 54 * MiB, WS_ED = 118 * MiB;
constexpr size_t WS_XS = 150 * MiB;
constexpr size_t WS_STOK = 294 * MiB, WS_SDST = 297 * MiB, WS_SW = 300 * MiB, WS_TKE = 303 * MiB, WS_TKW = 306 * MiB;
constexpr size_t WS_R = 309 * MiB;
constexpr size_t WS_Q = WS_R, WS_K = WS_R + 144 * MiB, WS_V = WS_R + 180 * MiB;
constexpr size_t WS_ABT = WS_R, WS_FH = WS_R + 256 * MiB, WS_FH1 = WS_R + 320 * MiB, WS_ABTC = WS_R + 321 * MiB, WS_FC = WS_R + 353 * MiB;
constexpr size_t WS_H = WS_R, WS_HS = WS_R + 320 * MiB, WS_YB = WS_R + 356 * MiB, WS_YS = WS_R + 676 * MiB;
constexpr size_t WS_END = WS_YS + 36 * MiB;
constexpr size_t OUT_U8 = 144 * MiB;
constexpr int WSCALE_E8M0 = 121;
constexpr int MAXROWS = 655360;

constexpr int CW_TMO = 0, CW_BAR = 4096, CW_BCNT = 16384;

constexpr int RING_BYTES = 131072;
constexpr int L_MISC = RING_BYTES;
constexpr int L_TSTART = RING_BYTES + 256;
constexpr int L_PREF = L_TSTART + 1040;
constexpr int L_LCNT = L_PREF + 256;
constexpr int L_TSEG = L_LCNT + 256;
constexpr int L_SCAN = L_TSEG + 2560;
constexpr int LDS_BYTES = 139264;
static_assert(L_SCAN + 1024 <= LDS_BYTES, "LDS map");

#define RLX_AGENT __ATOMIC_RELAXED, __HIP_MEMORY_SCOPE_AGENT
#define LDS_WAIT() asm volatile("s_waitcnt lgkmcnt(0)" ::: "memory")
#define VM_WAIT() asm volatile("s_waitcnt vmcnt(0)" ::: "memory")

__device__ __forceinline__ unsigned f2bf(float f) { unsigned u = __builtin_bit_cast(unsigned, f); return (u + 0x7fffu + ((u >> 16) & 1u)) >> 16; }
__device__ __forceinline__ unsigned pk2(float lo, float hi) { return f2bf(lo) | (f2bf(hi) << 16); }
typedef float f32x2_t __attribute__((ext_vector_type(2))); typedef __bf16 bf16x2_t __attribute__((ext_vector_type(2)));
__device__ __forceinline__ unsigned cvt_pk_bf16(float lo, float hi) { f32x2_t v = {lo, hi}; bf16x2_t b = __builtin_convertvector(v, bf16x2_t); return __builtin_bit_cast(unsigned, b); }
__device__ __forceinline__ float bflo(unsigned w) { return __builtin_bit_cast(float, w << 16); }
__device__ __forceinline__ float bfhi(unsigned w) { return __builtin_bit_cast(float, w & 0xffff0000u); }
__device__ __forceinline__ float wave_sum(float v) {
#pragma unroll
    for (int o = 1; o < 64; o <<= 1) v += __shfl_xor(v, o);
    return v;
}

__device__ __forceinline__ unsigned f2f8(float v) { return (unsigned)__builtin_amdgcn_cvt_pk_fp8_f32(v, 0.f, 0, false) & 0xffu; }
__device__ __forceinline__ float f82f(unsigned b) { return __builtin_amdgcn_cvt_pk_f32_fp8((int)(b & 0xffu), false)[0]; }
__device__ __forceinline__ int opaque_tid() { int t = threadIdx.x; asm volatile("" : "+v"(t)); return t; }

#define XB_TMO      128
#define XB_XCNT(j)  (256  + 64 * (j))
#define XB_XSUB(j)  (1280 + 64 * (j))
#define XB_XGEN(j)  (2304 + 64 * (j))
#define XB_TOP      3328
#define XB_TOPGEN   3392
#define XCD_BAR_WORDS 3456
#define XB_SPIN_CAP (1u << 22)
__device__ __forceinline__ unsigned xb_ld(unsigned* p)              { return __hip_atomic_load(p, __ATOMIC_RELAXED, __HIP_MEMORY_SCOPE_AGENT); }
__device__ __forceinline__ unsigned xb_add(unsigned* p, unsigned v) { return __hip_atomic_fetch_add(p, v, __ATOMIC_RELAXED, __HIP_MEMORY_SCOPE_AGENT); }
__device__ __forceinline__ unsigned xb_xcc_id() { return (unsigned)__builtin_amdgcn_s_getreg((3 << 11) | 20) & 0xFu; }
#define XB_SPIN(cond, bar) do { unsigned _sp = 0; while (cond) { __builtin_amdgcn_s_sleep(1); \
    if ((++_sp & 255u) == 0u) { if (xb_ld(&(bar)[XB_TMO])) break; if (_sp > XB_SPIN_CAP) { atomicAdd(&(bar)[XB_TMO], 1u); break; } } } } while (0)
struct XcdBarrier { unsigned* bar; unsigned x; volatile LAS unsigned* st; };
__device__ __forceinline__ XcdBarrier xcd_barrier_post(unsigned* bar, volatile LAS unsigned* st) {
    XcdBarrier b; b.bar = bar; b.x = xb_xcc_id(); b.st = st;
    if (threadIdx.x == 0) (void)xb_add(&bar[XB_XCNT(b.x)], 1u);
    return b;
}
__device__ __forceinline__ void xcd_barrier_complete(unsigned* bar, unsigned x, unsigned& nloc, unsigned& nx) {
    const unsigned G = gridDim.x * gridDim.y * gridDim.z;
    unsigned sum, cnt, mine, sp = 0u;
    for (;;) {
        sum = 0u; cnt = 0u; mine = 0u;
#pragma unroll
        for (unsigned j = 0; j < 16; ++j) { const unsigned c = xb_ld(&bar[XB_XCNT(j)]); sum += c; cnt += (c > 0u) ? 1u : 0u; mine = (j == x) ? c : mine; }
        if (sum == G) break;
        __builtin_amdgcn_s_sleep(1);
        if ((++sp & 255u) == 0u) { if (xb_ld(&bar[XB_TMO])) break; if (sp > XB_SPIN_CAP) { atomicAdd(&bar[XB_TMO], 1u); break; } }
    }
    nloc = mine > 0u ? mine : 1u; nx = cnt > 0u ? cnt : 1u;
}
__device__ __forceinline__ void xcd_barrier(const XcdBarrier& b) {
    asm volatile("s_waitcnt vmcnt(0)" ::: "memory");
    __syncthreads();
    if (threadIdx.x == 0) {
        unsigned* bar = b.bar; unsigned bx = b.x; asm volatile("" : "+s"(bx));
        __builtin_amdgcn_s_waitcnt(0);
        unsigned nloc = b.st[0], nx = b.st[1];
        if (nloc == 0u) { xcd_barrier_complete(bar, bx, nloc, nx); b.st[0] = nloc; b.st[1] = nx; }
        const unsigned old = xb_add(&bar[XB_XSUB(bx)], 1u);
        const unsigned gen = old / nloc;
        if (old + 1u == (gen + 1u) * nloc) {
            __builtin_amdgcn_fence(__ATOMIC_RELEASE, "agent");
            asm volatile("s_waitcnt vmcnt(0)" ::: "memory");
            const unsigned og = xb_add(&bar[XB_TOP], 1u);
            const unsigned tg = og / nx;
            if (og + 1u == (tg + 1u) * nx) xb_add(&bar[XB_TOPGEN], 1u);
            else XB_SPIN(xb_ld(&bar[XB_TOPGEN]) == tg, bar);
            __builtin_amdgcn_fence(__ATOMIC_ACQUIRE, "agent");
            xb_add(&bar[XB_XGEN(bx)], 1u);
            asm volatile("s_waitcnt vmcnt(0)" ::: "memory");
        } else {
            XB_SPIN(xb_ld(&bar[XB_XGEN(bx)]) == gen, bar);
            __builtin_amdgcn_fence(__ATOMIC_ACQUIRE, "agent");
            asm volatile("s_waitcnt vmcnt(0)" ::: "memory");
        }
    }
    __syncthreads();
}

namespace pg {
constexpr int BM = 256, BK = 64, HALF = 128, HTB = HALF * BK * 2;
__host__ __device__ __forceinline__ int lds_byte(int r, int c) { const int st = (r >> 4) * 2 + (c >> 5), rr = r & 15, cc = c & 31, ob = rr * 64 + cc * 2; return st * 1024 + (ob ^ (((ob >> 9) & 1) << 5)); }
__host__ __device__ __forceinline__ void stage_rc(int b, int& R, int& C) { const int st = b / 1024, sb = b % 1024, swz = sb ^ (((sb >> 9) & 1) << 5); R = (st >> 1) * 16 + swz / 64; C = (st & 1) * 32 + (swz % 64) / 2; }
__host__ __device__ __forceinline__ int perm32(int rho) { const int n = rho >> 4, i = rho & 15; return 8 * (i >> 2) + 4 * n + (i & 3); }

struct Unit {
    const char* A;
    const char* B;
    const int* gidx;
    int gbase;
    int nt;
    char* out; int ldc; float scale; int flags; int i0; int i1;
};

template <class Epi, class Sched, bool GATHER, bool F8 = false, int WSC = WSCALE_E8M0>
__device__ __forceinline__ void gemm_phase(LAS unsigned char* lds, const unsigned lda, const unsigned ldb, const char* gtable, const Sched& S, const Epi& E) {
    const int tid = opaque_tid(), wid = __builtin_amdgcn_readfirstlane(tid >> 6), lane = tid & 63, wr = wid >> 2, wc = wid & 3, fr = lane & 15, fq = lane >> 4;
    unsigned voffA[2], voffB[2];
#pragma unroll
    for (int i = 0; i < 2; ++i) { int R, C; stage_rc(tid * 16 + i * 8192, R, C); const int Rb = (R & ~31) + perm32(R & 31);
        voffA[i] = (unsigned)R * lda + (unsigned)C * 2u; voffB[i] = (unsigned)Rb * ldb + (unsigned)C * 2u; }
    const size_t kstep = (size_t)(BK * 2);
    const size_t hstepA = (size_t)HALF * lda, hstepB = (size_t)HALF * ldb;
    const unsigned ldsw = (unsigned)wid * 1024u;
    const int aoff = lds_byte(wr * 64 + fr, fq * 8), boff = lds_byte(wc * 32 + fr, fq * 8);
#define PG_SA(b, h) (((b) * 2 + (h)) * HTB)
#define PG_SB(b, h) ((4 + (b) * 2 + (h)) * HTB)
#define PG_ST2(bufoff, p0, p1) do { \
        __builtin_amdgcn_global_load_lds((const unsigned*)(p0), (LAS unsigned*)(lds + (bufoff) + ldsw), 16, 0, 0); \
        __builtin_amdgcn_global_load_lds((const unsigned*)(p1), (LAS unsigned*)(lds + (bufoff) + ldsw + 8192), 16, 0, 0); } while (0)
#define PG_STB(bufoff, bp) PG_ST2(bufoff, (bp) + voffB[0], (bp) + voffB[1])
#define PG_STA(bufoff, ap, h, nx) do { if constexpr (GATHER) { PG_ST2(bufoff, (ap) + ((nx) ? nO[h][0] : cO[h][0]), (ap) + ((nx) ? nO[h][1] : cO[h][1])); } \
        else { PG_ST2(bufoff, (ap) + (h) * hstepA + voffA[0], (ap) + (h) * hstepA + voffA[1]); } } while (0)
#define PG_LD8(p) ({ const v4i_t lo_ = *(const LAS v4i_t*)(p), hi_ = *(const LAS v4i_t*)((p) + 1024); __builtin_shufflevector(lo_, hi_, 0, 1, 2, 3, 4, 5, 6, 7); })
#define PG_LDA(dst, b, h) do { if constexpr (F8) { _Pragma("unroll") for (int m = 0; m < 4; ++m) dst##8[m] = PG_LD8(lds + PG_SA(b, h) + aoff + m * 2048); } \
        else { _Pragma("unroll") for (int m = 0; m < 4; ++m) _Pragma("unroll") for (int k = 0; k < 2; ++k) dst[m][k] = *(const LAS bf16x8*)(lds + PG_SA(b, h) + aoff + m * 2048 + k * 1024); } } while (0)
#define PG_LDB(dst, b, h) do { if constexpr (F8) { _Pragma("unroll") for (int n = 0; n < 2; ++n) dst##8[n] = PG_LD8(lds + PG_SB(b, h) + boff + n * 2048); } \
        else { _Pragma("unroll") for (int n = 0; n < 2; ++n) _Pragma("unroll") for (int k = 0; k < 2; ++k) dst[n][k] = *(const LAS bf16x8*)(lds + PG_SB(b, h) + boff + n * 2048 + k * 1024); } } while (0)
#define PG_MMA(ai, bj, At, Bt) do { __builtin_amdgcn_s_setprio(1); _Pragma("unroll") for (int m = 0; m < 4; ++m) _Pragma("unroll") for (int n = 0; n < 2; ++n) { \
        if constexpr (F8) { asm volatile("v_mfma_scale_f32_16x16x128_f8f6f4 %0, %1, %2, %0, %3, %4 op_sel_hi:[0,0,0]" : "+v"(acc[ai][bj][m][n]) : "v"(Bt##8[n]), "v"(At##8[m]), "v"(sc_w), "v"(sc_x)); } \
        else { _Pragma("unroll") for (int k = 0; k < 2; ++k) acc[ai][bj][m][n] = __builtin_amdgcn_mfma_f32_16x16x32_bf16(Bt[n][k], At[m][k], acc[ai][bj][m][n], 0, 0, 0); } } \
        __builtin_amdgcn_s_setprio(0); } while (0)
#define PG_WAIT_V(n) asm volatile("s_waitcnt vmcnt(" #n ")" ::: "memory")
#define PG_WAIT_L(n) asm volatile("s_waitcnt lgkmcnt(" #n ")" ::: "memory")
#define PG_BAR __builtin_amdgcn_s_barrier()
#define PG_SCHED __builtin_amdgcn_sched_barrier(0)
#define PG_GOFF(dst, u) do { const int tz_ = opaque_tid(); _Pragma("unroll") for (int i = 0; i < 2; ++i) { int R_, C_; stage_rc(tz_ * 16 + i * 8192, R_, C_); \
        _Pragma("unroll") for (int h = 0; h < 2; ++h) { const int rr = h * HALF + R_; \
        const int ix = (u).gidx ? ((const GAS int*)(u).gidx)[rr] : (u).gbase + rr; dst[h][i] = (unsigned)ix * lda + (unsigned)C_ * 2u; } } } while (0)
#define PG_GIDX(dst, un) do { const int* gi_ = nullptr; int gb_ = 0; const bool ok_ = S.gsrc((un), gi_, gb_); const int tz_ = opaque_tid(); _Pragma("unroll") for (int i = 0; i < 2; ++i) { int R_, C_; stage_rc(tz_ * 16 + i * 8192, R_, C_); \
        _Pragma("unroll") for (int h = 0; h < 2; ++h) { const int rr = h * HALF + R_; dst[h][i] = (ok_ && gi_) ? ((const GAS int*)gi_)[rr] : gb_ + rr; } } } while (0)
#define PG_GCVT(dst, src) do { const int tz_ = opaque_tid(); _Pragma("unroll") for (int i = 0; i < 2; ++i) { int R_, C_; stage_rc(tz_ * 16 + i * 8192, R_, C_); \
        _Pragma("unroll") for (int h = 0; h < 2; ++h) dst[h][i] = (unsigned)src[h][i] * lda + (unsigned)C_ * 2u; } } while (0)
    Unit cur, nxt; int ui = 0;
    if (!S.next(0, cur)) return;
    f32x4 acc[2][2][4][2];
#pragma unroll
    for (int a = 0; a < 2; ++a)
#pragma unroll
        for (int b = 0; b < 2; ++b)
#pragma unroll
            for (int m = 0; m < 4; ++m)
#pragma unroll
                for (int n = 0; n < 2; ++n) acc[a][b][m][n] = (f32x4){0.f, 0.f, 0.f, 0.f};
    bf16x8 At[4][2], B0[2][2], B1[2][2]; v8i_t At8[4], B08[2], B18[2];
    const int sc_w = WSC * 0x01010101, sc_x = 0x7f7f7f7f;
    unsigned cO[2][2] = {{0u, 0u}, {0u, 0u}}, nO[2][2] = {{0u, 0u}, {0u, 0u}};
    if constexpr (GATHER) { PG_GOFF(cO, cur); }
    const char* cA = GATHER ? gtable : cur.A; const char* cB = cur.B;
    PG_STB(PG_SB(0, 0), cB); PG_STB(PG_SB(0, 1), cB + hstepB); PG_STA(PG_SA(0, 0), cA, 0, false); PG_STA(PG_SA(0, 1), cA, 1, false);
    if (wr == 1) PG_BAR;
    PG_WAIT_V(2); PG_BAR;
    PG_STB(PG_SB(1, 0), cB + kstep); PG_STA(PG_SA(1, 0), cA + kstep, 0, false); PG_STB(PG_SB(1, 1), cB + hstepB + kstep);
    PG_WAIT_V(6); PG_BAR;
    for (;;) {
        const bool has_next = S.next(ui + 1, nxt);
        const int nt = cur.nt;
        if constexpr (GATHER) { if (has_next) { PG_GOFF(nO, nxt); } else {
#pragma unroll
            for (int h = 0; h < 2; ++h)
#pragma unroll
                for (int i = 0; i < 2; ++i) nO[h][i] = cO[h][i]; } }
        const char* nA = GATHER ? gtable : (has_next ? nxt.A : cA); const char* nB = has_next ? nxt.B : cB;
#pragma unroll 1
        for (int t = 0; t < nt; t += 2) {
            const bool last = (t == nt - 2);
            const char* a1 = cA + (size_t)(t + 1) * kstep;
            const char* a2 = last ? nA : cA + (size_t)(t + 2) * kstep; const char* b2 = last ? nB : cB + (size_t)(t + 2) * kstep;
            const char* a3 = a2 + kstep; const char* b3 = b2 + kstep;
            PG_LDB(B0, 0, 0); PG_LDB(B1, 0, 1); PG_SCHED; PG_LDA(At, 0, 0); PG_STA(PG_SA(1, 1), a1, 1, false);
            PG_WAIT_V(8); PG_WAIT_L(0); PG_BAR; PG_MMA(0, 0, At, B0); PG_MMA(0, 1, At, B1); PG_BAR; PG_SCHED;
            PG_LDA(At, 0, 1); PG_STB(PG_SB(0, 0), b2); PG_STB(PG_SB(0, 1), b2 + hstepB); PG_STA(PG_SA(0, 0), a2, 0, last);
            PG_WAIT_V(8); PG_WAIT_L(0); PG_BAR; PG_MMA(1, 0, At, B0); PG_MMA(1, 1, At, B1); PG_BAR; PG_SCHED;
            PG_LDB(B0, 1, 0); PG_LDB(B1, 1, 1); PG_SCHED; PG_LDA(At, 1, 0); PG_STA(PG_SA(0, 1), a2, 1, last);
            PG_WAIT_V(8); PG_WAIT_L(0); PG_BAR; PG_MMA(0, 0, At, B0); PG_MMA(0, 1, At, B1); PG_BAR; PG_SCHED;
            PG_LDA(At, 1, 1); PG_STB(PG_SB(1, 0), b3); PG_STB(PG_SB(1, 1), b3 + hstepB); PG_STA(PG_SA(1, 0), a3, 0, last);
            PG_WAIT_V(8); PG_WAIT_L(0); PG_BAR; PG_MMA(1, 0, At, B0); PG_MMA(1, 1, At, B1); PG_BAR; PG_SCHED;
        }
        if (wr == 0) PG_BAR;
        if constexpr (F8) asm volatile("s_nop 15\n\ts_nop 15" ::: "memory");
        E(acc, cur, wr, wc, fr, fq);
        if (!has_next) break;
#pragma unroll
        for (int a = 0; a < 2; ++a)
#pragma unroll
            for (int b = 0; b < 2; ++b)
#pragma unroll
                for (int m = 0; m < 4; ++m)
#pragma unroll
                    for (int n = 0; n < 2; ++n) acc[a][b][m][n] = (f32x4){0.f, 0.f, 0.f, 0.f};
        cur = nxt; cA = nA; cB = nB; ++ui;
        if constexpr (GATHER) {
#pragma unroll
            for (int h = 0; h < 2; ++h)
#pragma unroll
                for (int i = 0; i < 2; ++i) cO[h][i] = nO[h][i]; }
        if (wr == 1) PG_BAR;
    }
    PG_WAIT_V(0);
    PG_BAR;
#undef PG_SA
#undef PG_SB
#undef PG_ST2
#undef PG_STB
#undef PG_STA
#undef PG_LDA
#undef PG_LD8
#undef PG_LDB
#undef PG_MMA
#undef PG_WAIT_V
#undef PG_WAIT_L
#undef PG_BAR
#undef PG_SCHED
#undef PG_GOFF
#undef PG_GIDX
#undef PG_GCVT
}

struct EpiStore {
    __device__ __forceinline__ void operator()(const f32x4 (&acc)[2][2][4][2], const Unit& u, int wr, int wc, int fr, int fq) const {
        asm volatile("" : "+v"(fr), "+v"(fq));
        const float s = u.scale;
#pragma unroll
        for (int ai = 0; ai < 2; ++ai)
#pragma unroll
            for (int m = 0; m < 4; ++m) { const int row = ai * HALF + wr * 64 + m * 16 + fr;
                char* rowp = u.out + (ptrdiff_t)row * u.ldc + (wc * 32 + 8 * fq) * 2;
                if (!((u.flags & 1) && row == 0)) {
#pragma unroll
                for (int bj = 0; bj < 2; ++bj) { const f32x4 v0 = acc[ai][bj][m][0] * s, v1 = acc[ai][bj][m][1] * s;
                    u32x4 w; w.x = cvt_pk_bf16(v0[0], v0[1]); w.y = cvt_pk_bf16(v0[2], v0[3]); w.z = cvt_pk_bf16(v1[0], v1[1]); w.w = cvt_pk_bf16(v1[2], v1[3]);
                    *(u32x4*)(rowp + bj * 256) = w; } } }
    }
};
struct EpiStore8 {
    __device__ __forceinline__ void operator()(const f32x4 (&acc)[2][2][4][2], const Unit& u, int wr, int wc, int fr, int fq) const {
        asm volatile("" : "+v"(fr), "+v"(fq));
        const float s = u.scale;
#pragma unroll
        for (int ai = 0; ai < 2; ++ai)
#pragma unroll
            for (int m = 0; m < 4; ++m) { const int row = ai * HALF + wr * 64 + m * 16 + fr;
                char* rowp = u.out + (ptrdiff_t)row * u.ldc + (wc * 32 + 8 * fq);
#pragma unroll
                for (int bj = 0; bj < 2; ++bj) { const f32x4 v0 = acc[ai][bj][m][0] * s, v1 = acc[ai][bj][m][1] * s; int w0 = 0, w1 = 0;
                    w0 = __builtin_amdgcn_cvt_pk_fp8_f32(v0[0], v0[1], w0, false); w0 = __builtin_amdgcn_cvt_pk_fp8_f32(v0[2], v0[3], w0, true);
                    w1 = __builtin_amdgcn_cvt_pk_fp8_f32(v1[0], v1[1], w1, false); w1 = __builtin_amdgcn_cvt_pk_fp8_f32(v1[2], v1[3], w1, true);
                    u32x2 o; o.x = (unsigned)w0; o.y = (unsigned)w1; *(u32x2*)(rowp + bj * 128) = o; } }
    }
};
struct EpiQKV {
    bf16_t* Q; bf16_t* K; bf16_t* V; const float* ropec; const float* ropes;
    __device__ __forceinline__ void operator()(const f32x4 (&acc)[2][2][4][2], const Unit& u, int wr, int wc, int fr, int fq) const {
        asm volatile("" : "+v"(fr), "+v"(fq));
        const int pm = u.i0, pn = u.i1; const bool lat = pm < (T / 256); const bool rope = lat && pn < 5;
        const float qs = pn < 4 ? C2 : 1.f;
        const int part = wc & 1;
        const int fi0 = 8 * (fq & 1);
        const float sgn = (fq < 2) ? -1.f : 1.f;
#pragma unroll
        for (int ai = 0; ai < 2; ++ai)
#pragma unroll
            for (int m = 0; m < 4; ++m) { const int row = ai * HALF + wr * 64 + m * 16 + fr; const int tok = pm * 256 + row;
                const int tl = tok & (SEQ - 1); const int pos = part ? (tl & 63) : (tl >> 6);
                f32x4 c0 = {1.f, 1.f, 1.f, 1.f}, c1 = c0, s0 = {0.f, 0.f, 0.f, 0.f}, s1 = s0;
                if (rope) { c0 = *(const f32x4*)(ropec + pos * 16 + fi0); c1 = *(const f32x4*)(ropec + pos * 16 + fi0 + 4); s0 = *(const f32x4*)(ropes + pos * 16 + fi0); s1 = *(const f32x4*)(ropes + pos * 16 + fi0 + 4); }
#pragma unroll
                for (int bj = 0; bj < 2; ++bj) { f32x4 v0 = acc[ai][bj][m][0], v1 = acc[ai][bj][m][1];
                    if (rope) { f32x4 p0, p1;
#pragma unroll
                        for (int j = 0; j < 4; ++j) { p0[j] = __shfl_xor(v0[j], 32); p1[j] = __shfl_xor(v1[j], 32); }
                        v0 = v0 * c0 + (p0 * sgn) * s0; v1 = v1 * c1 + (p1 * sgn) * s1; }
                    v0 = v0 * qs; v1 = v1 * qs;
                    u32x4 w; w.x = cvt_pk_bf16(v0[0], v0[1]); w.y = cvt_pk_bf16(v0[2], v0[3]); w.z = cvt_pk_bf16(v1[0], v1[1]); w.w = cvt_pk_bf16(v1[2], v1[3]);
                    const int col = bj * HALF + wc * 32 + 8 * fq;
                    bf16_t* dst = pn < 4 ? Q + (size_t)tok * 1024 + pn * 256 + col : (pn == 4 ? K + (size_t)tok * 256 + col : V + (size_t)tok * 256 + col);
                    *(u32x4*)dst = w; } }
    }
};
struct EpiSilu {
    __device__ __forceinline__ void operator()(const f32x4 (&acc)[2][2][4][2], const Unit& u, int wr, int wc, int fr, int fq) const {
        asm volatile("" : "+v"(fr), "+v"(fq));
#pragma unroll
        for (int ai = 0; ai < 2; ++ai)
#pragma unroll
            for (int m = 0; m < 4; ++m) { const int row = ai * HALF + wr * 64 + m * 16 + fr;
                float h[8];
#pragma unroll
                for (int n = 0; n < 2; ++n)
#pragma unroll
                    for (int j = 0; j < 4; ++j) { const float g = acc[ai][0][m][n][j], up = acc[ai][1][m][n][j]; h[n * 4 + j] = g * __builtin_amdgcn_rcpf(1.f + __expf(-g)) * up; }
                int w0 = 0, w1 = 0;
                w0 = __builtin_amdgcn_cvt_pk_fp8_f32(h[0], h[1], w0, false); w0 = __builtin_amdgcn_cvt_pk_fp8_f32(h[2], h[3], w0, true);
                w1 = __builtin_amdgcn_cvt_pk_fp8_f32(h[4], h[5], w1, false); w1 = __builtin_amdgcn_cvt_pk_fp8_f32(h[6], h[7], w1, true);
                u32x2 o; o.x = (unsigned)w0; o.y = (unsigned)w1;
                *(u32x2*)(u.out + (size_t)row * 256 + (wc * 32 + 8 * fq)) = o; }
    }
};
struct EpiFp8 {
    __device__ __forceinline__ void operator()(const f32x4 (&acc)[2][2][4][2], const Unit& u, int wr, int wc, int fr, int fq) const {
        asm volatile("" : "+v"(fr), "+v"(fq));
        const int pn = u.i1;
#pragma unroll
        for (int ai = 0; ai < 2; ++ai)
#pragma unroll
            for (int m = 0; m < 4; ++m) { const int row = ai * HALF + wr * 64 + m * 16 + fr;
                u32x4 o;
#pragma unroll
                for (int bj = 0; bj < 2; ++bj) { const f32x4 v0 = acc[ai][bj][m][0] * 16.f, v1 = acc[ai][bj][m][1] * 16.f;
                    int w0 = 0, w1 = 0;
                    w0 = __builtin_amdgcn_cvt_pk_fp8_f32(v0[0], v0[1], w0, false); w0 = __builtin_amdgcn_cvt_pk_fp8_f32(v0[2], v0[3], w0, true);
                    w1 = __builtin_amdgcn_cvt_pk_fp8_f32(v1[0], v1[1], w1, false); w1 = __builtin_amdgcn_cvt_pk_fp8_f32(v1[2], v1[3], w1, true);
                    o[2 * bj] = (unsigned)w0; o[2 * bj + 1] = (unsigned)w1; }
                *(u32x4*)(u.out + (size_t)row * 1024 + (16 * pn + 4 * wc + fq) * 16) = o; }
    }
};
__device__ __forceinline__ int xcd_remap(int L0, int NU) { const int q = NU >> 3, r = NU & 7, x = L0 & 7, off = L0 >> 3; return (x < r ? x * (q + 1) : r * (q + 1) + (x - r) * q) + off; }
}

namespace attn {
constexpr int SLOTB = 8192;
constexpr int LDS_K = 0, LDS_V = 2 * SLOTB, LDS_WS = 4 * SLOTB, LDS_OST = LDS_WS + NWAVES * 256, LDS_END = LDS_OST + NWAVES * 4096;
static_assert(LDS_END <= RING_BYTES, "attention LDS");
__device__ __forceinline__ int crow(int r, int hi) { return (r & 3) + 8 * (r >> 2) + 4 * hi; }
__device__ __forceinline__ void glds16(const void* gsrc, unsigned lds_dst) { unsigned keep;
    asm volatile("s_mov_b32 %0, m0\n\ts_mov_b32 m0, %2\n\ts_nop 0\n\tglobal_load_lds_dwordx4 %1, off\n\ts_mov_b32 m0, %0" : "=&s"(keep) : "v"(gsrc), "s"(lds_dst) : "memory"); }
__device__ __forceinline__ float rowmax(const f32x16& p0, const f32x16& p1) {
    float a = fmaxf(p0[0], p1[0]);
#pragma unroll
    for (int r = 1; r < 16; ++r) a = fmaxf(a, fmaxf(p0[r], p1[r]));
    auto rr = __builtin_amdgcn_permlane32_swap(__float_as_uint(a), __float_as_uint(a), false, false);
    return fmaxf(__uint_as_float(rr[0]), __uint_as_float(rr[1]));
}
typedef short v4i16_t __attribute__((ext_vector_type(4)));
__device__ __forceinline__ s16x4 vtr(const LAS unsigned char* p) { return __builtin_bit_cast(s16x4, __builtin_amdgcn_ds_read_tr16_b64_v4i16((LAS v4i16_t*)p)); }
__device__ __forceinline__ void pv(f32x16* o, const LAS unsigned char* vp, bf16x8 pa0, bf16x8 pa1, bf16x8 pa2, bf16x8 pa3) {
#pragma unroll
    for (int d0 = 0; d0 < 2; ++d0) { s16x4 lo[4], hi[4];
#pragma unroll
        for (int ks = 0; ks < 4; ++ks) { lo[ks] = vtr(vp + d0 * 4096 + ks * 1024); hi[ks] = vtr(vp + d0 * 4096 + ks * 1024 + 512); }
#define PK(k) (bf16x8){lo[k][0], lo[k][1], lo[k][2], lo[k][3], hi[k][0], hi[k][1], hi[k][2], hi[k][3]}
        o[d0] = __builtin_amdgcn_mfma_f32_32x32x16_bf16(pa0, PK(0), o[d0], 0, 0, 0);
        o[d0] = __builtin_amdgcn_mfma_f32_32x32x16_bf16(pa1, PK(1), o[d0], 0, 0, 0);
        o[d0] = __builtin_amdgcn_mfma_f32_32x32x16_bf16(pa2, PK(2), o[d0], 0, 0, 0);
        o[d0] = __builtin_amdgcn_mfma_f32_32x32x16_bf16(pa3, PK(3), o[d0], 0, 0, 0);
#undef PK
    }
}
__device__ __forceinline__ void attn_unit(const bf16_t* Q, const bf16_t* K, const bf16_t* V, bf16_t* O, int b, int h, int q0, bool isctx, float sink2, LAS unsigned char* shm) {
    const int tid = opaque_tid(), lane = tid & 63, r32 = lane & 31, hi = lane >> 5; const int wid = __builtin_amdgcn_readfirstlane(tid >> 6);
    const int kvh = h >> 2;
    const long qrow = isctx ? (long)T + b * CTXL + wid * 32 : (long)b * SEQ + q0 + wid * 32;
    const unsigned lds0 = (unsigned)(uintptr_t)shm;
    LAS float* wsf = (LAS float*)(shm + LDS_WS) + wid * 64;
    int jlo = 0, nl = 0;
    if (!isctx) { jlo = (q0 == 0) ? 2 : 0; int jhi = (SEQ - q0 + 128) / 64; if (jhi > 8) jhi = 8; nl = jhi - jlo; }
    const int NT = nl + 4;
    const long lat0 = (long)b * SEQ + q0 - 128 + 64 * jlo, ctx0 = (long)T + b * CTXL;
#define TROW(t) ((t) < nl ? lat0 + 64 * (t) : ctx0 + 64 * ((t) - nl))
    const int kcol = kvh * 64 + wid * 8, vcol = kvh * 64 + (wid >> 2) * 32 + (lane & 3) * 8, vrow = 16 * (wid & 3) + (lane >> 2);
    const unsigned kdst = lds0 + LDS_K + wid * 1024, vdst = lds0 + LDS_V + wid * 1024;
#define DMA_KV(t, slot) do { const long tr_ = TROW(t); glds16(K + (tr_ + lane) * 256 + kcol, (unsigned)__builtin_amdgcn_readfirstlane(kdst + (slot) * SLOTB)); \
        glds16(V + (tr_ + vrow) * 256 + vcol, (unsigned)__builtin_amdgcn_readfirstlane(vdst + (slot) * SLOTB)); } while (0)
    DMA_KV(0, 0);
    bf16x8 qr[4];
#pragma unroll
    for (int d0 = 0; d0 < 4; ++d0) qr[d0] = *(const GAS bf16x8*)(Q + (qrow + r32) * 1024 + h * 64 + d0 * 16 + hi * 8);
    float mrun = sink2, l_reg = (hi == 0) ? 1.f : 0.f;
    f32x16 o[2];
#pragma unroll
    for (int r = 0; r < 16; ++r) { o[0][r] = 0.f; o[1][r] = 0.f; }
    const LAS unsigned char* vp0 = shm + LDS_V + ((lane >> 4) & 1) * 32 + (lane & 3) * 8 + (4 * hi + ((lane & 15) >> 2)) * 64;
    const int qw = q0 + wid * 32;
    asm volatile("s_waitcnt vmcnt(0) lgkmcnt(0)\n\ts_barrier" ::: "memory");
    for (int t = 0; t < NT; ++t) {
        const int slot = t & 1;
        if (t + 1 < NT) DMA_KV(t + 1, slot ^ 1);
        const bool latt = t < nl;
        const int ks = q0 - 128 + 64 * (jlo + t);
        bool need = true;
        if (latt) need = (ks + 63 >= qw - 128) && (ks <= qw + 31 + 128);
        if (need) {
            f32x16 p0, p1;
#pragma unroll
            for (int r = 0; r < 16; ++r) { p0[r] = 0.f; p1[r] = 0.f; }
            const LAS unsigned char* kb = shm + LDS_K + slot * SLOTB + hi * 1024 + r32 * 16;
#pragma unroll
            for (int d0 = 0; d0 < 4; ++d0) {
                const bf16x8 b0 = *(const LAS bf16x8*)(kb + d0 * 2048), b1 = *(const LAS bf16x8*)(kb + d0 * 2048 + 512);
                p0 = __builtin_amdgcn_mfma_f32_32x32x16_bf16(b0, qr[d0], p0, 0, 0, 0);
                p1 = __builtin_amdgcn_mfma_f32_32x32x16_bf16(b1, qr[d0], p1, 0, 0, 0); }
            if (latt) { const int dq = qw + r32 - ks;
#pragma unroll
                for (int r = 0; r < 16; ++r) { const int d = dq - crow(r, hi); if (d > 128 || d < -128) p0[r] = -INFINITY; if (d - 32 > 128 || d - 32 < -128) p1[r] = -INFINITY; } }
            const float rm = rowmax(p0, p1);
            if (__any(rm > mrun + 8.f)) {
                const float mnew = fmaxf(mrun, rm);
                const float alpha = __builtin_amdgcn_exp2f(mrun - mnew); l_reg *= alpha; mrun = mnew;
                if (hi == 0) wsf[r32] = alpha;
                asm volatile("s_waitcnt lgkmcnt(0)" ::: "memory");
#pragma unroll
                for (int r = 0; r < 16; ++r) { const float f = wsf[crow(r, hi)]; o[0][r] *= f; o[1][r] *= f; }
            }
            float sacc = 0.f;
#pragma unroll
            for (int r = 0; r < 16; ++r) { p0[r] = __builtin_amdgcn_exp2f(p0[r] - mrun); p1[r] = __builtin_amdgcn_exp2f(p1[r] - mrun); sacc += p0[r] + p1[r]; }
            l_reg += sacc;
            u32x4 pw0, pw1, pw2, pw3;
#define PKW(P, B) cvt_pk_bf16(P[B], P[B + 1])
            pw0 = (u32x4){PKW(p0, 0), PKW(p0, 2), PKW(p0, 4), PKW(p0, 6)}; pw1 = (u32x4){PKW(p0, 8), PKW(p0, 10), PKW(p0, 12), PKW(p0, 14)};
            pw2 = (u32x4){PKW(p1, 0), PKW(p1, 2), PKW(p1, 4), PKW(p1, 6)}; pw3 = (u32x4){PKW(p1, 8), PKW(p1, 10), PKW(p1, 12), PKW(p1, 14)};
#undef PKW
            __builtin_amdgcn_sched_barrier(0);
            pv(o, vp0 + slot * SLOTB, __builtin_bit_cast(bf16x8, pw0), __builtin_bit_cast(bf16x8, pw1), __builtin_bit_cast(bf16x8, pw2), __builtin_bit_cast(bf16x8, pw3));
        }
        asm volatile("s_waitcnt vmcnt(0) lgkmcnt(0)\n\ts_barrier" ::: "memory");
    }
    { auto rr = __builtin_amdgcn_permlane32_swap(__float_as_uint(l_reg), __float_as_uint(l_reg), false, false); l_reg = __uint_as_float(rr[0]) + __uint_as_float(rr[1]); }
    if (hi == 0) wsf[32 + r32] = l_reg;
    asm volatile("s_waitcnt lgkmcnt(0)" ::: "memory");
    float rli[16];
#pragma unroll
    for (int r = 0; r < 16; ++r) rli[r] = __builtin_amdgcn_rcpf(wsf[32 + crow(r, hi)]);
    unsigned char* Ow = (unsigned char*)O + qrow * 1024 + h * 64;
    { LAS unsigned char* stg = shm + LDS_OST + wid * 2048;
#pragma unroll
      for (int r = 0; r < 16; ++r) { const int orow = crow(r, hi);
#pragma unroll
          for (int d0 = 0; d0 < 2; ++d0) stg[orow * 64 + d0 * 32 + r32] = (unsigned char)f2f8(o[d0][r] * rli[r]); }
      asm volatile("s_waitcnt lgkmcnt(0)" ::: "memory");
#pragma unroll
      for (int i = 0; i < 2; ++i) { const int row = i * 16 + (lane >> 2), ch = lane & 3; const u32x4 v = *(const LAS u32x4*)(stg + row * 64 + ch * 16); *(GAS u32x4*)(Ow + (long)row * 1024 + ch * 16) = v; } }
    asm volatile("s_waitcnt lgkmcnt(0)" ::: "memory");
#undef TROW
#undef DMA_KV
}
}

struct Args {
    const float* in[20];
    float* out; unsigned char* ws;
};
struct Frame {
    LAS unsigned char* lds; unsigned* ctl; unsigned char* ws;
    int tid, lane, wave, gw;
    int blk;
    __device__ __forceinline__ void refresh() { tid = opaque_tid(); lane = tid & 63; wave = __builtin_amdgcn_readfirstlane(tid >> 6); gw = blk * 8 + wave;
        asm volatile("" : "+s"(ws)); ctl = (unsigned*)(ws + WS_CTL); }
};
constexpr int NGW = GRID * NWAVES;

struct Row { f32x4 v[4]; };
__device__ __forceinline__ int vq(int q, int lane) { return 64 * (lane >> 4) + 2 * (lane & 15) + 32 * (q >> 1) + (q & 1); }
__device__ __forceinline__ int vb(int j, int lane) { return 32 * (lane >> 4) + (lane & 15) + 16 * j; }
__device__ __forceinline__ void row_load_bf16(Row& r, const bf16_t* p, int lane) {
#pragma unroll
    for (int j = 0; j < 2; ++j) { const u32x4 w = ((const GAS u32x4*)p)[vb(j, lane)]; r.v[2 * j] = (f32x4){bflo(w.x), bfhi(w.x), bflo(w.y), bfhi(w.y)}; r.v[2 * j + 1] = (f32x4){bflo(w.z), bfhi(w.z), bflo(w.w), bfhi(w.w)}; } }
__device__ __forceinline__ void row_store_bf16(const Row& r, bf16_t* p, int lane) {
#pragma unroll
    for (int j = 0; j < 2; ++j) { u32x4 w; w.x = pk2(r.v[2 * j][0], r.v[2 * j][1]); w.y = pk2(r.v[2 * j][2], r.v[2 * j][3]); w.z = pk2(r.v[2 * j + 1][0], r.v[2 * j + 1][1]); w.w = pk2(r.v[2 * j + 1][2], r.v[2 * j + 1][3]); ((GAS u32x4*)p)[vb(j, lane)] = w; } }
typedef float f32x2v __attribute__((ext_vector_type(2)));
__device__ __forceinline__ void row_load_fp8(Row& r, const unsigned char* p, int lane) {
    const u32x4 w = ((const GAS u32x4*)p)[lane];
#pragma unroll
    for (int q = 0; q < 4; ++q) { const f32x2v lo = __builtin_amdgcn_cvt_pk_f32_fp8((int)w[q], false), hi = __builtin_amdgcn_cvt_pk_f32_fp8((int)w[q], true); r.v[q] = (f32x4){lo[0], lo[1], hi[0], hi[1]}; } }
__device__ __forceinline__ void row_store_fp8(const Row& r, unsigned char* p, int lane) {
    const int e0 = 256 * (lane >> 4) + 8 * (lane & 15);
#pragma unroll
    for (int j = 0; j < 2; ++j) { int w0 = 0, w1 = 0;
        w0 = __builtin_amdgcn_cvt_pk_fp8_f32(r.v[2 * j][0], r.v[2 * j][1], w0, false); w0 = __builtin_amdgcn_cvt_pk_fp8_f32(r.v[2 * j][2], r.v[2 * j][3], w0, true);
        w1 = __builtin_amdgcn_cvt_pk_fp8_f32(r.v[2 * j + 1][0], r.v[2 * j + 1][1], w1, false); w1 = __builtin_amdgcn_cvt_pk_fp8_f32(r.v[2 * j + 1][2], r.v[2 * j + 1][3], w1, true);
        u32x2 o; o.x = (unsigned)w0; o.y = (unsigned)w1; *(GAS u32x2*)(p + e0 + 128 * j) = o; } }
__device__ __forceinline__ void row_load_f32(Row& r, const float* p, int lane) {
#pragma unroll
    for (int q = 0; q < 4; ++q) r.v[q] = ((const GAS f32x4*)p)[vq(q, lane)]; }
__device__ __forceinline__ void row_store_f32(const Row& r, float* p, int lane) {
#pragma unroll
    for (int q = 0; q < 4; ++q) ((GAS f32x4*)p)[vq(q, lane)] = r.v[q]; }
__device__ __forceinline__ void row_normalize(Row& r, float eps) {
    float s = 0.f;
#pragma unroll
    for (int j = 0; j < 4; ++j) s += (r.v[j][0] + r.v[j][1]) + (r.v[j][2] + r.v[j][3]);
    const float mean = wave_sum(s) * (1.f / D); float q = 0.f;
#pragma unroll
    for (int j = 0; j < 4; ++j) { r.v[j] = r.v[j] - mean; q += (r.v[j][0] * r.v[j][0] + r.v[j][1] * r.v[j][1]) + (r.v[j][2] * r.v[j][2] + r.v[j][3] * r.v[j][3]); }
    const float rstd = 1.f / sqrtf(wave_sum(q) * (1.f / D) + eps);
#pragma unroll
    for (int j = 0; j < 4; ++j) r.v[j] = r.v[j] * rstd;
}
__device__ __forceinline__ void row_modulate(Row& r, const float* sh, const float* sc, int lane) {
    row_normalize(r, MOD_EPS);
#pragma unroll
    for (int j = 0; j < 4; ++j) { const f32x4 a = ((const GAS f32x4*)sc)[vq(j, lane)], b = ((const GAS f32x4*)sh)[vq(j, lane)]; r.v[j] = r.v[j] * (a + 1.f) + b; }
}
__device__ __forceinline__ int mod_row(int row) { return row < T ? (row >> 11) : 32; }
__device__ __forceinline__ const float* mod_vec(const unsigned char* ws, int layer, int mr, int chunk) { return (const float*)(ws + WS_MOD) + ((size_t)(layer * 33 + mr) * 6 + chunk) * 1024; }

__device__ __forceinline__ void conv_item(const float* W, int N, bf16_t* WT, int Kd, int kd0, int n0, int drow0, bool mirror, LAS float* scr, int lane) {
#pragma unroll 8
    for (int i = 0; i < 32; ++i) { const int kk = 2 * i + (lane >> 5); const int kd = kd0 + kk; const int ks = mirror ? ((kd & ~255) + ((256 - (kd & 255)) & 255)) : kd;
        scr[kk * 33 + (lane & 31)] = ((const GAS float*)W)[(size_t)ks * N + n0 + (lane & 31)]; }
    LDS_WAIT(); asm volatile("" ::: "memory");
    const int c = lane & 7;
#pragma unroll
    for (int j = 0; j < 4; ++j) { const int n = (lane >> 3) + 8 * j; const LAS float* s = scr + (8 * c) * 33 + n;
        u32x4 o; o.x = pk2(s[0 * 33], s[1 * 33]); o.y = pk2(s[2 * 33], s[3 * 33]); o.z = pk2(s[4 * 33], s[5 * 33]); o.w = pk2(s[6 * 33], s[7 * 33]);
        *(GAS u32x4*)(WT + (size_t)(drow0 + n) * Kd + kd0 + 8 * c) = o; }
    LDS_WAIT(); asm volatile("" ::: "memory");
}
__device__ __forceinline__ void conv_matrix_item(const float* W, int K, int N, bf16_t* WT, int mode, int roff, int item, LAS float* scr, int lane) {
    const int nblk = N / 32, kb = item / nblk, nb = item % nblk, n0 = 32 * nb;
    int drow0 = n0 + roff; if (mode == 1) drow0 = (n0 >> 7) * 256 + (n0 & 127); if (mode == 2) drow0 = (n0 >> 7) * 256 + 128 + (n0 & 127);
    conv_item(W, N, WT, K, 64 * kb, n0, drow0, mode == 3, scr, lane);
}
__device__ __forceinline__ void conv_item64(const float* W, int N, bf16_t* WT, int Kd, int k0, int n0, int drow0, LAS bf16_t* scr, int lane) {
    f32x4 v[16];
#pragma unroll
    for (int i = 0; i < 16; ++i) v[i] = *(const GAS f32x4*)(W + (size_t)(k0 + 4 * i + (lane >> 4)) * N + n0 + (lane & 15) * 4);
#pragma unroll
    for (int i = 0; i < 16; ++i) { u32x2 w; w.x = pk2(v[i][0], v[i][1]); w.y = pk2(v[i][2], v[i][3]); *(LAS u32x2*)(scr + (4 * i + (lane >> 4)) * 68 + (lane & 15) * 4) = w; }
    LDS_WAIT(); asm volatile("" ::: "memory");
    const int c = lane & 7;
#pragma unroll
    for (int j = 0; j < 8; ++j) { const int n = (lane >> 3) + 8 * j; const LAS bf16_t* p = scr + (8 * c) * 68 + n;
        u32x4 o; o.x = (unsigned)p[0] | ((unsigned)p[68] << 16); o.y = (unsigned)p[2 * 68] | ((unsigned)p[3 * 68] << 16); o.z = (unsigned)p[4 * 68] | ((unsigned)p[5 * 68] << 16); o.w = (unsigned)p[6 * 68] | ((unsigned)p[7 * 68] << 16);
        *(GAS u32x4*)(WT + (size_t)(drow0 + n) * Kd + k0 + 8 * c) = o; }
    LDS_WAIT(); asm volatile("" ::: "memory");
}
__device__ __forceinline__ void conv_item64_f8(const float* W, int N, unsigned char* WT, int Kd, int k0, int n0, int drow0, LAS unsigned char* scr, int lane, bool mirror = false) {
    f32x4 v[16];
#pragma unroll
    for (int i = 0; i < 16; ++i) { const int kd = k0 + 4 * i + (lane >> 4); const int ks = mirror ? ((kd & ~255) + ((256 - (kd & 255)) & 255)) : kd; v[i] = *(const GAS f32x4*)(W + (size_t)ks * N + n0 + (lane & 15) * 4); }
#pragma unroll
    for (int i = 0; i < 16; ++i) { int w = 0; w = __builtin_amdgcn_cvt_pk_fp8_f32(v[i][0] * 64.f, v[i][1] * 64.f, w, false); w = __builtin_amdgcn_cvt_pk_fp8_f32(v[i][2] * 64.f, v[i][3] * 64.f, w, true);
        *(LAS unsigned*)(scr + (4 * i + (lane >> 4)) * 68 + (lane & 15) * 4) = (unsigned)w; }
    LDS_WAIT(); asm volatile("" ::: "memory");
    const int c = lane & 3;
#pragma unroll
    for (int j = 0; j < 4; ++j) { const int n = (lane >> 2) + 16 * j; const LAS unsigned char* p = scr + (16 * c) * 68 + n; u32x4 o;
#pragma unroll
        for (int q = 0; q < 4; ++q) o[q] = (unsigned)p[(4 * q) * 68] | ((unsigned)p[(4 * q + 1) * 68] << 8) | ((unsigned)p[(4 * q + 2) * 68] << 16) | ((unsigned)p[(4 * q + 3) * 68] << 24);
        *(GAS u32x4*)(WT + (size_t)(drow0 + n) * Kd + k0 + 16 * c) = o; }
    LDS_WAIT(); asm volatile("" ::: "memory");
}
__device__ __forceinline__ void conv_experts(Frame& F, const Args& a, int layer) {
    F.refresh();
    LAS unsigned char* scr = F.lds + 32768 + F.wave * 4352;
    unsigned char* EGU = F.ws + WS_EGU; unsigned char* ED = F.ws + WS_ED;
    for (int it = F.gw; it < (NE + 1) * 192; it += NGW) { const int e = it / 192, r = it % 192;
        const float* wg = e < NE ? a.in[14] + ((size_t)layer * NE + e) * 262144 : a.in[17] + (size_t)layer * 262144;
        const float* wu = e < NE ? a.in[15] + ((size_t)layer * NE + e) * 262144 : a.in[18] + (size_t)layer * 262144;
        const float* wd = e < NE ? a.in[16] + ((size_t)layer * NE + e) * 262144 : a.in[19] + (size_t)layer * 262144;
        if (r < 128) { const int q = r & 63, kb = q >> 2, nb = q & 3, n0 = 64 * nb; const int drow0 = (n0 >> 7) * 256 + (r < 64 ? 0 : 128) + (n0 & 127);
            conv_item64_f8(r < 64 ? wg : wu, 256, EGU + (size_t)e * 512 * 1024, 1024, 64 * kb, n0, drow0, scr, F.lane); }
        else { const int q = r - 128, kb = q >> 4, nb = q & 15; conv_item64_f8(wd, 1024, ED + (size_t)e * 1024 * 256, 256, 64 * kb, 64 * nb, 64 * nb, scr, F.lane); } }
}
__device__ __forceinline__ void conv_small(Frame& F, const Args& a) {
    F.refresh();
    { LAS unsigned char* scr8 = F.lds + 32768 + F.wave * 4352;
      for (int it = F.gw; it < 2304; it += NGW) {
          if (it < 768) { const int j = it / 384, r = it % 384, kb = r / 24, nb = r % 24; conv_item64_f8(a.in[8] + (size_t)j * 1024 * 1536, 1536, F.ws + WS_WQKV + (size_t)j * 1536 * 1024, 1024, 64 * kb, 64 * nb, 64 * nb, scr8, F.lane); }
          else if (it < 1280) { const int q = it - 768, j = q >> 8, r = q & 255, kb = r >> 4, nb = r & 15; conv_item64_f8(a.in[9] + (size_t)j * 1024 * 1024, 1024, F.ws + WS_WO + (size_t)j * 1024 * 1024, 1024, 64 * kb, 64 * nb, 64 * nb, scr8, F.lane); }
          else { const int q = it - 1280, j = q >> 9, r = q & 511, mir = r >> 8, kb = (r & 255) >> 4, nb = r & 15;
              conv_item64_f8(a.in[11] + (size_t)j * 1024 * 1024, 1024, F.ws + WS_WSH + (size_t)j * 2048 * 1024, 1024, 64 * kb, 64 * nb, 64 * nb + 1024 * mir, scr8, F.lane, mir != 0); } } }
    __syncthreads();
    { LAS float* scr = (LAS float*)(F.lds + 32768 + F.wave * 8448);
      for (int it = F.gw; it < 1152; it += NGW) {
          if (it < 1024) { const int j = it >> 9, r = it & 511; conv_matrix_item(a.in[11] + (size_t)j * 1024 * 1024, 1024, 1024, (bf16_t*)(F.ws + WS_WF) + (size_t)j * 2048 * 1024, 0, 0, r, scr, F.lane); }
          else { const int q = it - 1024, l = q / 32, r = q % 32; conv_matrix_item(a.in[12] + (size_t)l * 1024 * 64, 1024, 64, (bf16_t*)(F.ws + WS_WR) + (size_t)l * 64 * 1024, 0, 0, r, scr, F.lane); } } }
    const int gt = F.blk * NTHR + F.tid, NGT = GRID * NTHR;
    const float TWO_PI = 6.283185307179586f;
    { float* rc = (float*)(F.ws + WS_ROPEC); float* rs = (float*)(F.ws + WS_ROPES);
      for (int i = gt; i < 64 * 16; i += NGT) { const int pos = i >> 4, fi = i & 15; const float inv = exp2f(-(float)fi * (13.287712379549449f / 16.f)); const float ang = (float)pos * inv; rc[i] = cosf(ang); rs[i] = sinf(ang); } }
    { unsigned* cs = (unsigned*)(F.ws + WS_CSN);
      for (int i = gt; i < 512 * 64; i += NGT) { const int r = i >> 6, n4 = (i & 63) * 4, m = r & 255; unsigned w = 0;
#pragma unroll
          for (int q = 0; q < 4; ++q) { const float ang = TWO_PI * (float)((m * (n4 + q)) & 255) * (1.f / 256.f); w |= f2f8(r < 256 ? __cosf(ang) : -__sinf(ang)) << (8 * q); }
          cs[i] = w; } }
    { unsigned* dl = (unsigned*)(F.ws + WS_DL);
      for (int i = gt; i < 1024 * 1024; i += NGT) { const int k = i >> 10, c4 = (i & 1023) * 4; unsigned w = 0;
#pragma unroll
          for (int q = 0; q < 4; ++q) { const int c = c4 + q, l = c & 2047; const float ang = TWO_PI * (float)((k * l) & 2047) * (1.f / 2048.f); w |= f2f8(c < 2048 ? __cosf(ang) : __sinf(ang)) << (8 * q); }
          dl[i] = w; } }
    { unsigned* dl = (unsigned*)(F.ws + WS_DLC);
      for (int i = gt; i < 256 * 128; i += NGT) { const int k = i >> 7, c4 = (i & 127) * 4; unsigned w = 0;
#pragma unroll
          for (int q = 0; q < 4; ++q) { const int c = c4 + q, l = c & 255; const float ang = TWO_PI * (float)((k * l) & 255) * (1.f / 256.f); w |= f2f8(c < 256 ? __cosf(ang) : __sinf(ang)) << (8 * q); }
          dl[i] = w; } }
}
__device__ __forceinline__ void mod_partials(Frame& F, const Args& a) {
    F.refresh();
    if (F.blk >= 192) return;
    const int l = F.blk / 48, cb = (F.blk % 48) / 4, kc = F.blk & 3;
    LAS float* s = (LAS float*)F.lds;
    for (int i = F.tid; i < 256 * 33; i += NTHR) { const int k = i / 33, r = i % 33; const float c = (r < 32) ? a.in[1][(size_t)r * 1024 + kc * 256 + k] : a.in[3][kc * 256 + k]; s[k * 36 + r] = c / (1.f + __expf(-c)); }
    __syncthreads();
    const int n = cb * 512 + F.tid;
    const GAS float* w = (const GAS float*)a.in[4] + ((size_t)l * 1024 + kc * 256) * 6144 + n;
    float acc[33];
#pragma unroll
    for (int r = 0; r < 33; ++r) acc[r] = 0.f;
#pragma unroll 4
    for (int k = 0; k < 256; ++k) { const float wv = w[(size_t)k * 6144];
#pragma unroll
        for (int r = 0; r < 33; ++r) acc[r] += s[k * 36 + r] * wv; }
    float* part = (float*)(F.ws + WS_MODP) + ((size_t)(kc * 4 + l) * 33) * 6144 + n;
#pragma unroll
    for (int r = 0; r < 33; ++r) part[(size_t)r * 6144] = acc[r];
    __syncthreads();
}
__device__ __forceinline__ void mod_finalize(Frame& F, const Args& a) {
    F.refresh();
    const int gt = F.blk * NTHR + F.tid, NGT = GRID * NTHR; const float* part = (const float*)(F.ws + WS_MODP); float* mod = (float*)(F.ws + WS_MOD);
    for (int i = gt; i < 4 * 33 * 6144; i += NGT) { const int l = i / (33 * 6144), n = i % 6144; float v = a.in[5][l * 6144 + n];
#pragma unroll
        for (int kc = 0; kc < 4; ++kc) v += part[(size_t)kc * 4 * 33 * 6144 + i]; mod[i] = v; }
}
__device__ __forceinline__ void rows_init(Frame& F, const Args& a) {
    F.refresh();
    bf16_t* XS = (bf16_t*)(F.ws + WS_XS); bf16_t* U = (bf16_t*)a.out; const float* part = (const float*)(F.ws + WS_MODP);
    for (int row = F.gw; row < TT; row += NGW) {
        Row r; row_load_f32(r, row < T ? a.in[0] + (size_t)row * D : a.in[2] + (size_t)(row - T) * D, F.lane);
        row_store_bf16(r, XS + (size_t)row * D, F.lane);
        row_normalize(r, MOD_EPS); const int mr = mod_row(row);
#pragma unroll
        for (int j = 0; j < 4; ++j) { const int e = vq(j, F.lane);
            f32x4 sh = ((const GAS f32x4*)(a.in[5]))[e], sc = ((const GAS f32x4*)(a.in[5] + 1024))[e];
#pragma unroll
            for (int kc = 0; kc < 4; ++kc) { const float* pp = part + ((size_t)(kc * 4 + 0) * 33 + mr) * 6144; sh += ((const GAS f32x4*)pp)[e]; sc += ((const GAS f32x4*)(pp + 1024))[e]; }
            r.v[j] = r.v[j] * (sc + 1.f) + sh; }
        row_store_fp8(r, (unsigned char*)a.out + OUT_U8 + (size_t)row * D, F.lane);
    }
}
__device__ __forceinline__ void rows_post1(Frame& F, const Args& a, int layer, int nrows) {
    F.refresh();
    bf16_t* XS = (bf16_t*)(F.ws + WS_XS); bf16_t* U = (bf16_t*)a.out;
    const float* lg = a.in[6] + (size_t)(layer * 2 + 0) * D; const float* lb = a.in[7] + (size_t)(layer * 2 + 0) * D;
    const int TPB = nrows / GRID;
    for (int rl = F.wave; rl < TPB; rl += NWAVES) { const int row = F.blk * TPB + rl; const int mr = mod_row(row);
        Row x, y; row_load_bf16(x, XS + (size_t)row * D, F.lane); row_load_bf16(y, U + (size_t)row * D, F.lane);
        const float* g1 = mod_vec(F.ws, layer, mr, 2);
#pragma unroll
        for (int j = 0; j < 4; ++j) x.v[j] = x.v[j] * ALPHA + ((const GAS f32x4*)g1)[vq(j, F.lane)] * y.v[j];
        row_normalize(x, LN_EPS);
#pragma unroll
        for (int j = 0; j < 4; ++j) x.v[j] = x.v[j] * ((const GAS f32x4*)lg)[vq(j, F.lane)] + ((const GAS f32x4*)lb)[vq(j, F.lane)];
        row_store_bf16(x, XS + (size_t)row * D, F.lane);
        row_modulate(x, mod_vec(F.ws, layer, mr, 3), mod_vec(F.ws, layer, mr, 4), F.lane);
        row_store_bf16(x, U + (size_t)row * D, F.lane);
        row_store_fp8(x, (unsigned char*)a.out + OUT_U8 + (size_t)row * D, F.lane);
    }
}
__device__ __forceinline__ void rows_post2(Frame& F, const Args& a, int layer, int t0, int n) {
    F.refresh();
    bf16_t* XS = (bf16_t*)(F.ws + WS_XS); bf16_t* U = (bf16_t*)a.out; const unsigned char* YB = (const unsigned char*)(F.ws + WS_YB); const unsigned char* YS = (const unsigned char*)(F.ws + WS_YS);
    const int* spos = (const int*)(F.ws + WS_SDST); const float* tkw = (const float*)(F.ws + WS_TKW);
    const float* lg = a.in[6] + (size_t)(layer * 2 + 1) * D; const float* lb = a.in[7] + (size_t)(layer * 2 + 1) * D;
    for (int i = F.gw; i < n; i += NGW) { const int row = t0 + i; const int mr = mod_row(row);
        Row x, y; row_load_bf16(x, XS + (size_t)row * D, F.lane);
        int pj = 0; float wj = 0.f; if (F.lane < 8) { pj = ((const GAS int*)spos)[(size_t)row * 8 + F.lane]; wj = ((const GAS float*)tkw)[(size_t)row * 8 + F.lane]; }
        row_load_fp8(y, YS + (size_t)i * D, F.lane);
#pragma unroll
        for (int j = 0; j < 4; ++j) y.v[j] = y.v[j] * (1.f / 16.f);
#pragma unroll
        for (int s = 0; s < 8; ++s) { const int ps = __builtin_amdgcn_readlane(pj, s); const float ws_ = __builtin_bit_cast(float, __builtin_amdgcn_readlane(__builtin_bit_cast(int, wj), s));
            Row z; row_load_fp8(z, YB + (size_t)ps * D, F.lane); const float wz = ws_ * (1.f / 16.f);
#pragma unroll
            for (int j = 0; j < 4; ++j) y.v[j] += z.v[j] * wz; }
        const float* g2 = mod_vec(F.ws, layer, mr, 5);
#pragma unroll
        for (int j = 0; j < 4; ++j) x.v[j] = x.v[j] * ALPHA + ((const GAS f32x4*)g2)[vq(j, F.lane)] * y.v[j];
        row_normalize(x, LN_EPS);
#pragma unroll
        for (int j = 0; j < 4; ++j) x.v[j] = x.v[j] * ((const GAS f32x4*)lg)[vq(j, F.lane)] + ((const GAS f32x4*)lb)[vq(j, F.lane)];
        if (layer == 3) { row_store_f32(x, a.out + (size_t)row * D, F.lane); }
        else { row_store_bf16(x, XS + (size_t)row * D, F.lane);
            row_modulate(x, mod_vec(F.ws, layer + 1, mr, 0), mod_vec(F.ws, layer + 1, mr, 1), F.lane);
            row_store_fp8(x, (unsigned char*)a.out + OUT_U8 + (size_t)row * D, F.lane); }
    }
}

__device__ __forceinline__ float wave_max_dpp(float v) {
    int x = __builtin_bit_cast(int, v);
#define DPPMAX(ctrl) { const int y = __builtin_amdgcn_update_dpp(x, x, ctrl, 0xf, 0xf, false); x = __builtin_bit_cast(int, fmaxf(__builtin_bit_cast(float, x), __builtin_bit_cast(float, y))); }
    DPPMAX(0xB1) DPPMAX(0x4E) DPPMAX(0x141) DPPMAX(0x140)
#undef DPPMAX
    const float r0 = __builtin_bit_cast(float, __builtin_amdgcn_readlane(x, 0)), r1 = __builtin_bit_cast(float, __builtin_amdgcn_readlane(x, 16));
    const float r2 = __builtin_bit_cast(float, __builtin_amdgcn_readlane(x, 32)), r3 = __builtin_bit_cast(float, __builtin_amdgcn_readlane(x, 48));
    return fmaxf(fmaxf(r0, r1), fmaxf(r2, r3));
}
__device__ __forceinline__ void route_tokens(Frame& F, const Args& a, int layer, int ntok) {
    F.refresh();
    const int TPB = ntok / GRID;
    const bf16_t* U = (const bf16_t*)a.out; const bf16_t* Wr = (const bf16_t*)(F.ws + WS_WR) + (size_t)layer * 64 * 1024;
    int* tke = (int*)(F.ws + WS_TKE); float* tkw = (float*)(F.ws + WS_TKW);
    LAS int* lcnt = (LAS int*)(F.lds + L_LCNT);
    LAS float* sc = (LAS float*)(F.lds) + F.wave * 1024;
    if (F.tid < 64) lcnt[F.tid] = 0;
    __syncthreads();
    const int lane = F.lane, fr = lane & 15, fq = lane >> 4;
    const float bias = a.in[13][layer * 64 + lane];
    const int ntile = TPB / 16;
    for (int tl = F.wave; tl < ntile; tl += NWAVES) {
        const int t0 = F.blk * TPB + tl * 16;
        f32x4 acc[4];
#pragma unroll
        for (int n = 0; n < 4; ++n) acc[n] = (f32x4){0.f, 0.f, 0.f, 0.f};
        const GAS bf16x8* ap = (const GAS bf16x8*)(U + (size_t)(t0 + fr) * D + fq * 8);
        const GAS bf16x8* bp = (const GAS bf16x8*)(Wr + (size_t)fr * D + fq * 8);
#pragma unroll 4
        for (int ks = 0; ks < 32; ++ks) { const bf16x8 av = ap[ks * 4];
#pragma unroll
            for (int n = 0; n < 4; ++n) { const bf16x8 bv = bp[(size_t)n * 16 * (D / 8) + ks * 4]; acc[n] = __builtin_amdgcn_mfma_f32_16x16x32_bf16(av, bv, acc[n], 0, 0, 0); } }
#pragma unroll
        for (int n = 0; n < 4; ++n)
#pragma unroll
            for (int j = 0; j < 4; ++j) sc[(fq * 4 + j) * 64 + n * 16 + fr] = acc[n][j];
        LDS_WAIT();
        for (int tk = 0; tk < 16; ++tk) {
            const float logit = sc[tk * 64 + lane];
            const float s = 1.f / (1.f + __expf(-logit));
            const float sel = s + bias;
            const int g = lane >> 3;
            float m1 = sel; m1 = fmaxf(m1, __shfl_xor(m1, 1)); m1 = fmaxf(m1, __shfl_xor(m1, 2)); m1 = fmaxf(m1, __shfl_xor(m1, 4));
            const unsigned long long bm = __ballot(sel == m1);
            const unsigned gm = (unsigned)(bm >> (g * 8)) & 0xffu;
            const int first = g * 8 + __builtin_ctz(gm);
            float m2 = (lane == first) ? -INFINITY : sel; m2 = fmaxf(m2, __shfl_xor(m2, 1)); m2 = fmaxf(m2, __shfl_xor(m2, 2)); m2 = fmaxf(m2, __shfl_xor(m2, 4));
            const float gs = m1 + m2;
            float curg = gs; bool gok = false;
#pragma unroll 1
            for (int it = 0; it < 4; ++it) { const float mx = wave_max_dpp(curg);
                const unsigned long long bb = __ballot(curg == mx); const int gi = (int)(__builtin_ctzll(bb) >> 3);
                if (g == gi) { gok = true; curg = -INFINITY; } }
            float cure = gok ? sel : -INFINITY; bool chosen = false; int rk = 0;
#pragma unroll 1
            for (int it = 0; it < 8; ++it) { const float mx = wave_max_dpp(cure);
                const unsigned long long bb = __ballot(cure == mx); const int ei = (int)__builtin_ctzll(bb);
                if (lane == ei) { chosen = true; rk = it; cure = -INFINITY; } }
            const float tot = wave_sum(chosen ? s : 0.f);
            if (chosen) { const int tok = t0 + tk; tke[(size_t)tok * 8 + rk] = lane; tkw[(size_t)tok * 8 + rk] = s / tot * 2.5f; __hip_atomic_fetch_add(&lcnt[lane], 1, __ATOMIC_RELAXED, __HIP_MEMORY_SCOPE_WORKGROUP); }
        }
        LDS_WAIT();
    }
    __syncthreads();
    if (F.tid < 64) F.ctl[CW_BCNT + F.blk * 64 + F.tid] = (unsigned)lcnt[F.tid];
}
__device__ __forceinline__ void build_lists(Frame& F, int ntok) {
    F.refresh();
    constexpr int NSEG = NCHUNK * 64, BPC = GRID / NCHUNK;
    const int TPB = ntok / GRID, CH = ntok / NCHUNK;
    LAS int* tstart = (LAS int*)(F.lds + L_TSTART); LAS int* pref = (LAS int*)(F.lds + L_PREF); LAS int* lcnt = (LAS int*)(F.lds + L_LCNT);
    LAS unsigned char* tseg = (LAS unsigned char*)(F.lds + L_TSEG); LAS int* scan = (LAS int*)(F.lds + L_SCAN);
    const unsigned* bcnt = F.ctl + CW_BCNT;
    const int myc = F.blk / BPC, mylb = F.blk % BPC;
    int nseg = 0;
    LAS int* cntl = (LAS int*)F.lds;
    for (int i = F.tid; i < GRID * 64; i += NTHR) cntl[i] = (int)((const GAS unsigned*)bcnt)[i];
    if (F.tid < 64) lcnt[F.tid] = 0;
    __syncthreads();
    if (F.tid < NSEG) { const int c = F.tid >> 6, e = F.tid & 63; int n = 0, p = 0;
        for (int lb = 0; lb < BPC; ++lb) { const int v = cntl[(c * BPC + lb) * 64 + e]; if (c == myc && lb < mylb) p += v; n += v; }
        nseg = n; scan[F.tid] = (n + 255) >> 8; if (c == myc) pref[e] = p; }
    __syncthreads();
    if (F.tid == 0) { int acc = 0; for (int s = 0; s < NSEG; ++s) { tstart[s] = acc; acc += scan[s]; } tstart[NSEG] = acc; }
    __syncthreads();
    if (F.tid < NSEG) { const int t0 = tstart[F.tid], t1 = tstart[F.tid + 1]; for (int t = t0; t < t1; ++t) tseg[t] = (unsigned char)F.tid; }
    int* stok = (int*)(F.ws + WS_STOK); int* spos = (int*)(F.ws + WS_SDST);
    const int* tke = (const int*)(F.ws + WS_TKE);
    { const int sseg = myc * 64 + mylb; if (mylb < 64 && F.tid == sseg) scan[0] = nseg; }
    __syncthreads();
    if (mylb < 64) { const int sseg = myc * 64 + mylb; const int n = scan[0]; const int base = tstart[sseg] * 256, end = tstart[sseg + 1] * 256;
      for (int p = base + n + F.tid; p < end; p += NTHR) stok[p] = myc * CH; }
    for (int tl = F.wave; tl < TPB; tl += NWAVES) { const int tok = F.blk * TPB + tl;
        if (F.lane < 8) { const int e = tke[(size_t)tok * 8 + F.lane];
            const int p = tstart[myc * 64 + e] * 256 + pref[e] + __hip_atomic_fetch_add(&lcnt[e], 1, __ATOMIC_RELAXED, __HIP_MEMORY_SCOPE_WORKGROUP);
            stok[p] = tok; spos[(size_t)tok * 8 + F.lane] = p - tstart[myc * 64] * 256; } }
    __syncthreads();
}

struct SchedQKV {
    const char* U; const char* W; int nfull, nu, c;
    __device__ __forceinline__ bool next(int i, pg::Unit& u) const {
        const int L0 = i * GRID + c; if (L0 >= nu) return false;
        int pm, pn;
        if (L0 < nfull) { const int L = pg::xcd_remap(L0, nfull); const int gid = L / 48, w = L % 48; pm = gid * 8 + (w & 7); pn = w >> 3; }
        else { const int q = L0 - nfull; pm = 256 + (q >> 1); pn = 4 + (q & 1); }
        u.A = U + (size_t)pm * 256 * 1024; u.B = W + (size_t)pn * 256 * 1024; u.gidx = nullptr; u.gbase = 0; u.nt = 8; u.out = nullptr; u.ldc = 0; u.scale = 1.f; u.flags = 0; u.i0 = pm; u.i1 = pn;
        return true; }
};
struct SchedDense {
    const char* A; const char* W; char* out; int nrt, nct, nt, c; size_t ldA;
    __device__ __forceinline__ bool next(int i, pg::Unit& u) const {
        const int nu = nrt * nct; const int L0 = i * GRID + c; if (L0 >= nu) return false;
        const int L = pg::xcd_remap(L0, nu); const int per = 8 * nct, gid = L / per, w = L % per, fm = gid * 8, gsz = (nrt - fm) < 8 ? (nrt - fm) : 8; const int pm = fm + (w % gsz), pn = w / gsz;
        u.A = A + (size_t)pm * 256 * ldA; u.B = W + (size_t)pn * 256 * ldA; u.gidx = nullptr; u.gbase = 0; u.nt = nt; u.out = out + (size_t)pm * 256 * 2048 + pn * 512; u.ldc = 2048; u.scale = 1.f; u.flags = 0; u.i0 = pm; u.i1 = pn;
        return true; }
};
struct SchedF1 {
    const char* CS; const char* U; char* ABT; char* ABTC; int nu, c;
    __device__ __forceinline__ bool next(int i, pg::Unit& u) const {
        const int L0 = i * GRID + c; if (L0 >= nu) return false;
        u.gidx = nullptr; u.gbase = 0; u.nt = 2; u.scale = 1.f; u.flags = 0; u.i0 = 0; u.i1 = 0;
        if (L0 < 2048) { const int L = pg::xcd_remap(L0, 2048); const int pm = L & 1, pn = (L >> 1) & 7, bg = L >> 4, b = bg >> 2, g = bg & 3;
            u.A = CS + (size_t)pm * 256 * 256; u.B = U + ((size_t)b * SEQ + pn * 256) * 1024 + g * 256; u.out = ABT + (size_t)bg * 256 * 4096 + (size_t)(pm * 2048 + pn * 256); u.ldc = 4096; }
        else { const int q = L0 - 2048; const int pm = q & 1, bg = q >> 1, b = bg >> 2, g = bg & 3;
            u.A = CS + (size_t)pm * 256 * 256; u.B = U + ((size_t)T + b * CTXL) * 1024 + g * 256; u.out = ABTC + (size_t)bg * 256 * 512 + (size_t)pm * 256; u.ldc = 512; }
        return true; }
};
struct SchedF2 {
    const char* DL; const char* ABT; char* FH; int c;
    __device__ __forceinline__ bool next(int i, pg::Unit& u) const {
        const int L0 = i * GRID + c; if (L0 >= 512) return false;
        const int L = pg::xcd_remap(L0, 512); const int pm = L & 3, bg = L >> 2, b = bg >> 2, g = bg & 3;
        u.A = DL + (size_t)pm * 256 * 4096; u.B = ABT + (size_t)bg * 256 * 4096; u.gidx = nullptr; u.gbase = 0; u.nt = 32; u.out = FH + ((size_t)b * 1024 + pm * 256) * 1024 + g * 256; u.ldc = 1024; u.scale = 0.001381067932004975f  ; u.flags = 0; u.i0 = 0; u.i1 = 0;
        return true; }
};
struct SchedF2c {
    const char* DLC; const char* ABTC; char* FC; int c;
    __device__ __forceinline__ bool next(int i, pg::Unit& u) const {
        const int L0 = i * GRID + c; if (L0 >= 128) return false;
        const int bg = L0, b = bg >> 2, g = bg & 3;
        u.A = DLC; u.B = ABTC + (size_t)bg * 256 * 512; u.gidx = nullptr; u.gbase = 0; u.nt = 4; u.out = FC + ((size_t)b * 256) * 1024 + g * 256; u.ldc = 1024; u.scale = 1.f / 256.f; u.flags = 0; u.i0 = 0; u.i1 = 0;
        return true; }
};
struct SchedF3 {
    const char* FH; const char* FC; const char* W; char* Y; int nu, c;
    __device__ __forceinline__ bool next(int i, pg::Unit& u) const {
        const int L0 = i * GRID + c; if (L0 >= nu) return false;
        u.gidx = nullptr; u.gbase = 0; u.nt = 8; u.scale = 1.f; u.flags = 0; u.i0 = 0; u.i1 = 0;
        if (L0 < 1024) { const int L = pg::xcd_remap(L0, 1024); const int gid = L >> 6, w = L & 63, pm = gid * 8 + (w & 7), pn = w >> 3; const int b = pm >> 2, k0 = (pm & 3) * 256;
            u.A = FH + (size_t)pm * 256 * 1024; u.B = W + (size_t)pn * 256 * 1024;
            if (pn < 4) { u.out = Y + ((size_t)b * SEQ + k0) * 2048 + pn * 512; u.ldc = 2048; }
            else { u.out = Y + ((size_t)b * SEQ + SEQ - k0) * 2048 + (pn - 4) * 512; u.ldc = -2048; u.flags = (k0 == 0) ? 1 : 0; } }
        else { const int q = L0 - 1024; const int pm = q >> 2, pn = q & 3;
            u.A = FC + (size_t)pm * 256 * 1024; u.B = W + (size_t)pn * 256 * 1024; u.out = Y + ((size_t)T + pm * 256) * 2048 + pn * 512; u.ldc = 2048; }
        return true; }
};
struct SchedG1 {
    const char* EGU; const int* STOK; char* H; char* HS; LAS const unsigned char* tseg; int ntl, nsh, c;
    __device__ __forceinline__ bool gsrc(int i, const int*& gidx, int& gbase) const {
        const int nu = (ntl + nsh) * 2; const int L0 = i * GRID + c; if (L0 >= nu) return false;
        const int pm = pg::xcd_remap(L0, nu) >> 1;
        if (pm < ntl) { gidx = STOK + (size_t)pm * 256; gbase = 0; } else { gidx = nullptr; gbase = (pm - ntl) * 256; }
        return true; }
    __device__ __forceinline__ bool next(int i, pg::Unit& u) const {
        const int nu = (ntl + nsh) * 2; const int L0 = i * GRID + c; if (L0 >= nu) return false;
        const int L = pg::xcd_remap(L0, nu); const int pm = L >> 1, pn = L & 1;
        u.A = nullptr; u.gbase = 0; u.nt = 8; u.ldc = 256; u.scale = 1.f; u.flags = 0; u.i0 = 0; u.i1 = 0;
        if (pm < ntl) { const int e = __builtin_amdgcn_readfirstlane((int)tseg[pm]) & 63;
            u.gidx = STOK + (size_t)pm * 256; u.B = EGU + (size_t)e * 512 * 1024 + (size_t)pn * 256 * 1024; u.out = H + (size_t)pm * 256 * 256 + pn * 128; }
        else { const int ps = pm - ntl; u.gidx = nullptr; u.gbase = ps * 256; u.B = EGU + (size_t)NE * 512 * 1024 + (size_t)pn * 256 * 1024; u.out = HS + (size_t)ps * 256 * 256 + pn * 128; }
        return true; }
};
struct SchedG2 {
    const char* ED; const char* H; const char* HS; char* YB; char* YS; LAS const unsigned char* tseg; int t0, t1, nsh, ch, CH, c;
    __device__ __forceinline__ bool next(int i, pg::Unit& u) const {
        const int nr = t1 - t0; const int nu = (nr + nsh) * 4; const int L0 = i * GRID + c; if (L0 >= nu) return false;
        const int L = pg::xcd_remap(L0, nu); const int q = L >> 2, pn = L & 3;
        u.gidx = nullptr; u.gbase = 0; u.nt = 2; u.ldc = 1024; u.scale = 1.f; u.flags = 0; u.i0 = 0; u.i1 = pn;
        if (q < nr) { const int pm = t0 + q; const int e = __builtin_amdgcn_readfirstlane((int)tseg[pm]) & 63;
            u.A = H + (size_t)pm * 256 * 256; u.B = ED + (size_t)e * 1024 * 256 + (size_t)pn * 256 * 256; u.out = YB + (size_t)q * 256 * 1024; }
        else { const int ps = q - nr; u.A = HS + ((size_t)ch * CH + ps * 256) * 256; u.B = ED + (size_t)NE * 1024 * 256 + (size_t)pn * 256 * 256; u.out = YS + (size_t)ps * 256 * 1024; }
        return true; }
};

__device__ __forceinline__ void fnet_nyquist_rows(Frame& F) {
    F.refresh();
    const unsigned char* ABT = F.ws + WS_ABT; bf16_t* FH1 = (bf16_t*)(F.ws + WS_FH1);
    for (int r = F.gw; r < 128 * 256; r += NGW) { const int bg = r >> 8, m = r & 255, b = bg >> 2, g = bg & 3;
        const GAS u32x4* p = (const GAS u32x4*)(ABT + (size_t)r * 4096); float s = 0.f;
#pragma unroll
        for (int i = 0; i < 2; ++i) { const u32x4 w = p[i * 64 + F.lane];
#pragma unroll
            for (int q = 0; q < 4; ++q) { const f32x2v lo = __builtin_amdgcn_cvt_pk_f32_fp8((int)w[q], false), hi = __builtin_amdgcn_cvt_pk_f32_fp8((int)w[q], true); s += (lo[0] - lo[1]) + (hi[0] - hi[1]); } }
        s = wave_sum(s) * 0.001381067932004975f;
        if (F.lane == 0) FH1[(size_t)b * 1024 + g * 256 + m] = (bf16_t)f2bf(s); }
}
__device__ __forceinline__ void fnet_nyquist_out(Frame& F, const Args& a, int jl) {
    F.refresh();
    const bf16_t* FH1 = (const bf16_t*)(F.ws + WS_FH1); const bf16_t* W = (const bf16_t*)(F.ws + WS_WF) + (size_t)jl * 2048 * 1024; bf16_t* Y = (bf16_t*)a.out;
    LAS float* part = (LAS float*)F.lds;
    const int b = F.blk >> 3, n = (F.blk & 7) * 128 + (F.tid & 127), kq = F.tid >> 7;
    const GAS u32x4* wp = (const GAS u32x4*)(W + (size_t)n * 1024 + kq * 256); const GAS u32x4* fp = (const GAS u32x4*)(FH1 + (size_t)b * 1024 + kq * 256);
    float s = 0.f;
#pragma unroll 4
    for (int i = 0; i < 32; ++i) { const u32x4 w = wp[i], f = fp[i];
        s += bflo(w.x) * bflo(f.x) + bfhi(w.x) * bfhi(f.x) + bflo(w.y) * bflo(f.y) + bfhi(w.y) * bfhi(f.y) + bflo(w.z) * bflo(f.z) + bfhi(w.z) * bfhi(f.z) + bflo(w.w) * bflo(f.w) + bfhi(w.w) * bfhi(f.w); }
    part[F.tid] = s;
    __syncthreads();
    if (F.tid < 128) { const float t = (part[F.tid] + part[F.tid + 128]) + (part[F.tid + 256] + part[F.tid + 384]); Y[((size_t)b * SEQ + 1024) * D + n] = (bf16_t)f2bf(t); }
    __syncthreads();
}


#ifdef SELFCHECK
constexpr int CW_ERR = 1024;
constexpr size_t WS_OCHK = WS_R + 216 * MiB;
__device__ __forceinline__ void chk_report(unsigned* ctl, int id, float got, float ref, float tabs, float trel) {
    float e = fabsf(got - ref) / (tabs + trel * fabsf(ref)); if (!(e == e)) e = 1e30f; atomicMax(ctl + CW_ERR + id, __float_as_uint(e)); }
__device__ __forceinline__ float bf2f(bf16_t b) { return __builtin_bit_cast(float, (unsigned)b << 16); }
__constant__ int chk_toks[16] = {0, 1, 63, 64, 65, 127, 2047, 2048, 2049, 4096, 33000, 65535, 65536, 65537, 70000, 73727};
__constant__ int chk_ks[8] = {0, 1, 2, 255, 256, 1023, 1024, 700};
__constant__ int chk_ms[4] = {0, 1, 128, 255};
__constant__ int chk_ytoks[10] = {0, 1, 1023, 1024, 1025, 2047, 2048, 65535, 65536, 73727};
__constant__ int chk_ns[5] = {0, 1, 255, 256, 1023};
__constant__ int chk_cols[20] = {0, 7, 15, 16, 31, 32, 40, 48, 63, 64, 500, 1023, 1024, 1039, 1040, 1072, 1279, 1280, 1300, 1535};
__device__ __forceinline__ void chk_qkv(Frame& F, const Args& a, int layer, int id) {
    F.refresh(); const bf16_t* U = (const bf16_t*)a.out; const float* W = a.in[8] + (size_t)(layer >> 1) * 1024 * 1536;
    const bf16_t* Qb = (const bf16_t*)(F.ws + WS_Q); const bf16_t* Kb = (const bf16_t*)(F.ws + WS_K); const bf16_t* Vb = (const bf16_t*)(F.ws + WS_V);
    for (int s = F.gw; s < 320; s += NGW) { const int tok = chk_toks[s & 15], col = chk_cols[s >> 4];
        if (layer == 2 && tok >= T && col < 1024) continue;
        const bool rope = (tok < T) && col < 1280; const int hc = col & 63, first = (hc & 31) < 16; const int pcol = rope ? (first ? col + 16 : col - 16) : col;
        float x = 0.f, xp = 0.f;
        for (int k = F.lane; k < 1024; k += 64) { const float u = bf2f(U[(size_t)tok * D + k]); x += u * W[(size_t)k * 1536 + col]; xp += u * W[(size_t)k * 1536 + pcol]; }
        x = wave_sum(x); xp = wave_sum(xp);
        float ref = x;
        if (rope) { const int tl = tok & 2047, part = hc >> 5, pos = part ? (tl & 63) : (tl >> 6), fi = hc & 15; const float ang = (float)pos * powf(10000.f, -(float)fi / 16.f);
            ref = x * cosf(ang) + (first ? -xp : xp) * sinf(ang); }
        if (col < 1024) ref *= C2;
        const float got = col < 1024 ? bf2f(Qb[(size_t)tok * 1024 + col]) : (col < 1280 ? bf2f(Kb[(size_t)tok * 256 + col - 1024]) : bf2f(Vb[(size_t)tok * 256 + col - 1280]));
        if (F.lane == 0) chk_report(F.ctl, id, got, ref, 0.03f, 0.03f); }
}
__device__ __forceinline__ void chk_attn(Frame& F, const Args& a, int layer, int id) {
    F.refresh(); const bf16_t* Qb = (const bf16_t*)(F.ws + WS_Q); const bf16_t* Kb = (const bf16_t*)(F.ws + WS_K); const bf16_t* Vb = (const bf16_t*)(F.ws + WS_V); const bf16_t* Ob = (const bf16_t*)(F.ws + WS_OCHK);
    LAS float* lg = (LAS float*)F.lds + F.wave * 1024;
    for (int s = F.gw; s < 64; s += NGW) { const int tok = chk_toks[s & 15], h = (s >> 4) * 5, kvh = h >> 2;
        if (layer == 2 && tok >= T) continue;
        const bool isctx = tok >= T; const int b = isctx ? (tok - T) / CTXL : tok / SEQ, p = tok & (SEQ - 1);
        int nk = 0; const int lo = isctx ? 0 : (p - 128 < 0 ? 0 : p - 128), hi = isctx ? -1 : (p + 128 > SEQ - 1 ? SEQ - 1 : p + 128);
        const int nlat = isctx ? 0 : hi - lo + 1; nk = nlat + CTXL;
        float mx = a.in[10][(layer >> 1) * 16 + h] * LOG2E; const float sink2 = mx;
        for (int i = F.lane; i < nk; i += 64) { const size_t kr = i < nlat ? (size_t)b * SEQ + lo + i : (size_t)T + b * CTXL + (i - nlat); float d = 0.f;
            for (int e = 0; e < 64; ++e) d += bf2f(Qb[(size_t)tok * 1024 + h * 64 + e]) * bf2f(Kb[kr * 256 + kvh * 64 + e]);
            lg[i] = d; mx = fmaxf(mx, d); }
#pragma unroll
        for (int o = 1; o < 64; o <<= 1) mx = fmaxf(mx, __shfl_xor(mx, o));
        LDS_WAIT();
        float den = 0.f; for (int i = F.lane; i < nk; i += 64) den += exp2f(lg[i] - mx);
        den = wave_sum(den) + exp2f(sink2 - mx);
        float o = 0.f;
        for (int i = 0; i < nk; ++i) { const size_t kr = i < nlat ? (size_t)b * SEQ + lo + i : (size_t)T + b * CTXL + (i - nlat); o += exp2f(lg[i] - mx) * bf2f(Vb[kr * 256 + kvh * 64 + F.lane]); }
        o /= den;
        chk_report(F.ctl, id, bf2f(Ob[(size_t)tok * 1024 + h * 64 + F.lane]), o, 0.01f, 0.03f); chk_report(F.ctl, 32 + (s & 15), bf2f(Ob[(size_t)tok * 1024 + h * 64 + F.lane]), o, 0.01f, 0.03f);
        LDS_WAIT(); }
    __syncthreads();
}
__device__ __forceinline__ void chk_fnet_f(Frame& F, const Args& a, bool upd, int id) {
    F.refresh(); const bf16_t* U = (const bf16_t*)a.out; LAS float* red = (LAS float*)F.lds;
    for (int s = F.blk; s < 128 + (upd ? 64 : 0); s += GRID) {
        const bool cx = s >= 128; const int q = cx ? s - 128 : s; const int m = chk_ms[q & 3], g = ((q >> 2) & 1) * 3, b = ((q >> 3) & 1) * 31; int k = chk_ks[(q >> 4) & 7]; const int L = cx ? CTXL : SEQ; if (cx) k &= 255;
        const size_t row0 = cx ? (size_t)T + b * CTXL : (size_t)b * SEQ;
        float acc = 0.f;
        for (int l = F.wave; l < L; l += NWAVES) { float ca = 0.f, sa = 0.f;
            for (int n = F.lane; n < 256; n += 64) { const float u = bf2f(U[(row0 + l) * D + g * 256 + n]); const float an = 6.283185307179586f * (float)((m * n) & 255) / 256.f; const float sn = __sinf(an), cs = __cosf(an); ca += u * cs; sa += u * sn; }
            ca = wave_sum(ca); sa = wave_sum(sa); const float an = 6.283185307179586f * (float)((k * l) % L) / (float)L; const float sn = __sinf(an), cs = __cosf(an); acc += cs * ca - sn * sa; }
        if (F.lane == 0) red[F.wave] = acc;
        __syncthreads();
        if (F.tid == 0) { float t = 0.f; for (int w = 0; w < NWAVES; ++w) t += red[w]; t *= cx ? (1.f / 256.f) : 0.001381067932004975f;
            float got;
            if (cx) got = bf2f(((const bf16_t*)(F.ws + WS_FC))[((size_t)b * 256 + k) * D + g * 256 + m]);
            else if (k == 1024) got = bf2f(((const bf16_t*)(F.ws + WS_FH1))[(size_t)b * 1024 + g * 256 + m]);
            else got = bf2f(((const bf16_t*)(F.ws + WS_FH))[((size_t)b * 1024 + k) * D + g * 256 + m]);
            chk_report(F.ctl, id, got, t, 0.02f, 0.03f); }
        __syncthreads(); }
}
__device__ __forceinline__ void chk_fnet_y(Frame& F, const Args& a, int jl, bool upd, int id) {
    F.refresh(); const bf16_t* Y = (const bf16_t*)a.out; const float* W = a.in[11] + (size_t)jl * 1024 * 1024;
    const bf16_t* FH = (const bf16_t*)(F.ws + WS_FH); const bf16_t* FH1 = (const bf16_t*)(F.ws + WS_FH1); const bf16_t* FC = (const bf16_t*)(F.ws + WS_FC);
    for (int s = F.gw; s < 50; s += NGW) { const int tok = chk_ytoks[s % 10], n = chk_ns[s / 10]; if (tok >= T && !upd) continue;
        float acc = 0.f;
        for (int j = F.lane; j < 1024; j += 64) { float f;
            if (tok >= T) f = bf2f(FC[(size_t)(tok - T) * D + j]);
            else { const int b = tok >> 11, k = tok & 2047; if (k < 1024) f = bf2f(FH[((size_t)b * 1024 + k) * D + j]); else if (k == 1024) f = bf2f(FH1[(size_t)b * 1024 + j]);
                else f = bf2f(FH[((size_t)b * 1024 + (2048 - k)) * D + (j & ~255) + ((256 - (j & 255)) & 255)]); }
            acc += f * W[(size_t)j * 1024 + n]; }
        acc = wave_sum(acc);
        if (F.lane == 0) chk_report(F.ctl, id, bf2f(Y[(size_t)tok * D + n]), acc, 0.02f, 0.03f); }
}
__device__ __forceinline__ void chk_route(Frame& F, const Args& a, int layer, int ntok, int id) {
    F.refresh(); const bf16_t* U = (const bf16_t*)a.out; const float* Wr = a.in[12] + (size_t)layer * 1024 * 64; const int* tke = (const int*)(F.ws + WS_TKE); const float* tkw = (const float*)(F.ws + WS_TKW);
    for (int s = F.gw; s < 16; s += NGW) { const int tok = chk_toks[s]; if (tok >= ntok) continue; const int lane = F.lane;
        float lgt = 0.f; for (int k = 0; k < 1024; ++k) lgt += bf2f(U[(size_t)tok * D + k]) * Wr[(size_t)k * 64 + lane];
        const float sc = 1.f / (1.f + expf(-lgt)), sel = sc + a.in[13][layer * 64 + lane];
        float g1 = -INFINITY, g2 = -INFINITY;
#pragma unroll 1
        for (int j = 0; j < 8; ++j) { const float v = __shfl(sel, (lane & ~7) + j); if (v > g1) { g2 = g1; g1 = v; } else if (v > g2) g2 = v; }
        const float gs = g1 + g2; int gr = 0;
#pragma unroll 1
        for (int gp = 0; gp < 8; ++gp) { const float v = __shfl(gs, gp * 8); gr += (v > gs || (v == gs && gp < (lane >> 3))) ? 1 : 0; }
        const float sm = gr < 4 ? sel : -INFINITY; int rk = 0;
#pragma unroll 1
        for (int ep = 0; ep < 64; ++ep) { const float v = __shfl(sm, ep); rk += (v > sm || (v == sm && ep < lane)) ? 1 : 0; }
        const float tot = wave_sum(rk < 8 ? sc : 0.f); const float wref = sc / tot * 2.5f;
        int slot = -1; for (int j = 0; j < 8; ++j) if (tke[(size_t)tok * 8 + j] == lane) slot = j;
        float err = 0.f;
        if (slot >= 0) { if (rk >= 10) err = 10.f; else if (rk < 8) err = fabsf(tkw[(size_t)tok * 8 + slot] - wref) / (0.04f * wref); }
        else if (rk < 6) err = 10.f;
        const unsigned long long nsel = __ballot(slot >= 0); if (__builtin_popcountll(nsel) != 8) err = 20.f;
        atomicMax(F.ctl + CW_ERR + id, __float_as_uint(err)); }
}
__device__ __forceinline__ void chk_moe(Frame& F, const Args& a, int layer, int ntok, int ch, int id) {
    F.refresh(); const bf16_t* U = (const bf16_t*)a.out; const int* tke = (const int*)(F.ws + WS_TKE); const float* tkw = (const float*)(F.ws + WS_TKW);
    const int CH = ntok / NCHUNK; LAS float* hs = (LAS float*)F.lds; LAS float* us = hs + 512; LAS float* pg_ = us + 1024;
    for (int s = F.blk; s < 16; s += GRID) { const int tok = chk_toks[s]; if (tok >= ntok || tok / CH != ch) continue;
        for (int k = F.tid; k < 1024; k += NTHR) us[k] = bf2f(U[(size_t)tok * D + k]);
        __syncthreads();
        float y0 = 0.f, y1 = 0.f;
        for (int j = 0; j < 9; ++j) { const int e = j < 8 ? tke[(size_t)tok * 8 + j] : 0; const float w = j < 8 ? tkw[(size_t)tok * 8 + j] : 1.f;
            const float* wg = j < 8 ? a.in[14] + ((size_t)layer * NE + e) * 262144 : a.in[17] + (size_t)layer * 262144;
            const float* wu = j < 8 ? a.in[15] + ((size_t)layer * NE + e) * 262144 : a.in[18] + (size_t)layer * 262144;
            const float* wd = j < 8 ? a.in[16] + ((size_t)layer * NE + e) * 262144 : a.in[19] + (size_t)layer * 262144;
            const int hh = F.tid & 255, half = F.tid >> 8; float g = 0.f, u = 0.f;
            for (int k = half * 512; k < half * 512 + 512; ++k) { g += us[k] * wg[(size_t)k * 256 + hh]; u += us[k] * wu[(size_t)k * 256 + hh]; }
            pg_[F.tid] = g; pg_[512 + F.tid] = u;
            __syncthreads();
            if (F.tid < 256) { const float gg = pg_[F.tid] + pg_[F.tid + 256], uu = pg_[512 + F.tid] + pg_[512 + F.tid + 256]; hs[F.tid] = gg / (1.f + expf(-gg)) * uu; }
            __syncthreads();
            float t0 = 0.f, t1 = 0.f; for (int q = 0; q < 256; ++q) { t0 += hs[q] * wd[(size_t)q * 1024 + F.tid]; t1 += hs[q] * wd[(size_t)q * 1024 + 512 + F.tid]; }
            y0 += w * t0; y1 += w * t1;
            __syncthreads(); }
        float g0 = 0.f, g1 = 0.f; const int i = tok - ch * CH;
        { const unsigned char* YSb = (const unsigned char*)(F.ws + WS_YS); const unsigned char* YBb = (const unsigned char*)(F.ws + WS_YB); const int* spos = (const int*)(F.ws + WS_SDST);
          const int t_ = F.tid, bo = 16 * (16 * (t_ >> 8) + ((t_ & 127) >> 3)) + 8 * ((t_ >> 7) & 1) + (t_ & 7);
          auto f8 = [](unsigned char b) { return __builtin_amdgcn_cvt_pk_f32_fp8((int)b, false)[0] * (1.f / 16.f); };
          g0 = f8(YSb[(size_t)i * D + bo]); g1 = f8(YSb[(size_t)i * D + bo + 512]);
          for (int j = 0; j < 8; ++j) { const size_t ps = (size_t)spos[(size_t)tok * 8 + j]; const float w = tkw[(size_t)tok * 8 + j]; g0 += w * f8(YBb[ps * D + bo]); g1 += w * f8(YBb[ps * D + bo + 512]); } }
        chk_report(F.ctl, id, g0, y0, 0.12f, 0.12f); chk_report(F.ctl, id, g1, y1, 0.12f, 0.12f);
        __syncthreads(); }
}
#endif

#ifndef PH_MASK
#define PH_MASK 0xffffffffu
#endif
#define PH(b) ((PH_MASK >> (b)) & 1u)
__global__ void __launch_bounds__(NTHR, 2) fwd(Args a) {
    extern __shared__ __attribute__((aligned(16))) unsigned char lds_raw[];
    Frame F;
    F.lds = (LAS unsigned char*)lds_raw; F.ws = a.ws; F.ctl = (unsigned*)(a.ws + WS_CTL);
    F.blk = blockIdx.x; F.refresh();
    for (int u = F.tid; u < (LDS_BYTES - RING_BYTES) / 4; u += NTHR) ((LAS unsigned*)(F.lds + RING_BYTES))[u] = 0u;
    __syncthreads();
    const XcdBarrier bar = xcd_barrier_post(F.ctl + CW_BAR, (volatile LAS unsigned*)(F.lds + L_MISC) + 8);
#define GRID_BAR() xcd_barrier(bar)
    LAS unsigned char* ring = F.lds;
    const int c = F.blk;
#define ws (F.ws)
#define NEWPH() F.refresh()

    if (PH(0)) { conv_small(F, a);
    __syncthreads();
    mod_partials(F, a); }
    GRID_BAR();
    if (PH(1)) { rows_init(F, a);
    mod_finalize(F, a); }
    GRID_BAR();

    for (int layer = 0; layer < 4; ++layer) {
        const int jl = layer >> 1; const bool upd = layer < 2; const int nrows = upd ? TT : T;
        if ((layer & 1) == 0) {
            NEWPH();
            if (PH(2)) { SchedQKV S; S.U = (const char*)a.out + OUT_U8; S.W = (const char*)(ws + WS_WQKV) + (size_t)jl * 1536 * 1024; S.nfull = (layer == 0) ? 288 * 6 : 256 * 6; S.nu = (layer == 0) ? 288 * 6 : 256 * 6 + 64; S.c = c;
              pg::EpiQKV E; E.Q = (bf16_t*)(ws + WS_Q); E.K = (bf16_t*)(ws + WS_K); E.V = (bf16_t*)(ws + WS_V); E.ropec = (const float*)(ws + WS_ROPEC); E.ropes = (const float*)(ws + WS_ROPES);
              pg::gemm_phase<pg::EpiQKV, SchedQKV, false, true>(ring, 1024u, 1024u, nullptr, S, E); }
            GRID_BAR();
#ifdef SELFCHECK
            if (SELFCHECK & 1) chk_qkv(F, a, layer, 1 + (layer >> 1));
#endif
#define OBUF ((bf16_t*)(ws + WS_R + 216 * MiB))
            NEWPH();
            if (PH(3)) { const int NU = 4096 + (layer == 0 ? 512 : 0);
              const bf16_t* Qb = (const bf16_t*)(ws + WS_Q); const bf16_t* Kb = (const bf16_t*)(ws + WS_K); const bf16_t* Vb = (const bf16_t*)(ws + WS_V);
              for (int i = 0; i * GRID + c < NU; ++i) { int id = pg::xcd_remap(i * GRID + c, NU);
                  if (NU > 4096) { const int g9 = id / 9, r9 = id - g9 * 9; id = (r9 < 8) ? g9 * 8 + r9 : 4096 + g9; }
                  if (id < 4096) { const int hq = id & 3, qb = (id >> 2) & 7, kvh = (id >> 5) & 3, b = id >> 7, h = kvh * 4 + hq;
                      attn::attn_unit(Qb, Kb, Vb, OBUF, b, h, qb * 256, false, a.in[10][jl * 16 + h] * LOG2E, ring); }
                  else { const int cid = id - 4096, hq = cid & 3, kvh = (cid >> 2) & 3, b = cid >> 4, h = kvh * 4 + hq;
                      attn::attn_unit(Qb, Kb, Vb, OBUF, b, h, 0, true, a.in[10][jl * 16 + h] * LOG2E, ring); } } }
            GRID_BAR();
#ifdef SELFCHECK
            if (SELFCHECK & 1) chk_attn(F, a, layer, 3 + (layer >> 1));
#endif
            NEWPH();
            if (PH(4)) { SchedDense S; S.A = (const char*)OBUF; S.W = (const char*)(ws + WS_WO) + (size_t)jl * 1024 * 1024; S.out = (char*)a.out; S.nrt = nrows / 256; S.nct = 4; S.nt = 8; S.c = c; S.ldA = 1024;
              pg::EpiStore E; pg::gemm_phase<pg::EpiStore, SchedDense, false, true>(ring, 1024u, 1024u, nullptr, S, E); }
            GRID_BAR();
        } else {
            NEWPH();
            if (PH(5)) { SchedF1 S; S.CS = (const char*)(ws + WS_CSN); S.U = (const char*)a.out + OUT_U8; S.ABT = (char*)(ws + WS_ABT); S.ABTC = (char*)(ws + WS_ABTC); S.nu = 2048 + (upd ? 256 : 0); S.c = c;
              pg::EpiStore8 E; pg::gemm_phase<pg::EpiStore8, SchedF1, false, true, 127>(ring, 256u, 1024u, nullptr, S, E); }
            GRID_BAR();
            NEWPH();
            if (PH(6)) { SchedF2 S; S.DL = (const char*)(ws + WS_DL); S.ABT = (const char*)(ws + WS_ABT); S.FH = (char*)(ws + WS_FH); S.c = c;
              pg::EpiStore8 E; pg::gemm_phase<pg::EpiStore8, SchedF2, false, true, 127>(ring, 4096u, 4096u, nullptr, S, E); }
            NEWPH();
            if (PH(7) && upd) { SchedF2c S; S.DLC = (const char*)(ws + WS_DLC); S.ABTC = (const char*)(ws + WS_ABTC); S.FC = (char*)(ws + WS_FC); S.c = c;
              pg::EpiStore8 E; pg::gemm_phase<pg::EpiStore8, SchedF2c, false, true, 127>(ring, 512u, 512u, nullptr, S, E); }
            if (PH(8)) fnet_nyquist_rows(F);
            GRID_BAR();
#ifdef SELFCHECK
            if (SELFCHECK & 2) chk_fnet_f(F, a, upd, 5 + (layer >> 1));
            GRID_BAR();
#endif
            NEWPH();
            if (PH(9)) { SchedF3 S; S.FH = (const char*)(ws + WS_FH); S.FC = (const char*)(ws + WS_FC); S.W = (const char*)(ws + WS_WSH) + (size_t)jl * 2048 * 1024; S.Y = (char*)a.out; S.nu = 1024 + (upd ? 128 : 0); S.c = c;
              pg::EpiStore E; pg::gemm_phase<pg::EpiStore, SchedF3, false, true>(ring, 1024u, 1024u, nullptr, S, E); }
            if (PH(10)) fnet_nyquist_out(F, a, jl);
            GRID_BAR();
#ifdef SELFCHECK
            if (SELFCHECK & 8) chk_fnet_y(F, a, jl, upd, 7 + (layer >> 1));
            GRID_BAR();
#endif
        }
        if (PH(12)) conv_experts(F, a, layer);
        __syncthreads();
        if (PH(11)) rows_post1(F, a, layer, nrows);
        VM_WAIT(); __syncthreads();
        if (threadIdx.x == 0) { __builtin_amdgcn_fence(__ATOMIC_ACQUIRE, "agent"); VM_WAIT(); }
        __syncthreads();
        if (PH(13)) route_tokens(F, a, layer, nrows);
        GRID_BAR();
#ifdef SELFCHECK
        if ((SELFCHECK & 4) && layer < 2) chk_route(F, a, layer, nrows, 9);
#endif
        if (PH(14)) build_lists(F, nrows);
        GRID_BAR();
        LAS const int* tstart = (LAS const int*)(F.lds + L_TSTART); LAS const unsigned char* tseg = (LAS const unsigned char*)(F.lds + L_TSEG);
        const int ntl = __builtin_amdgcn_readfirstlane(tstart[NCHUNK * 64]);
        NEWPH();
        if (PH(15)) { SchedG1 S; S.EGU = (const char*)(ws + WS_EGU); S.STOK = (const int*)(ws + WS_STOK); S.H = (char*)(ws + WS_H); S.HS = (char*)(ws + WS_HS); S.tseg = tseg; S.ntl = ntl; S.nsh = nrows / 256; S.c = c;
          pg::EpiSilu E; pg::gemm_phase<pg::EpiSilu, SchedG1, true, true>(ring, 1024u, 1024u, (const char*)a.out + OUT_U8, S, E); }
        GRID_BAR();
        const int CH = nrows / NCHUNK;
        for (int ch = 0; ch < NCHUNK; ++ch) {
            NEWPH();
            if (PH(16)) { SchedG2 S; S.ED = (const char*)(ws + WS_ED); S.H = (const char*)(ws + WS_H); S.HS = (const char*)(ws + WS_HS); S.YB = (char*)(ws + WS_YB); S.YS = (char*)(ws + WS_YS); S.tseg = tseg;
              S.t0 = __builtin_amdgcn_readfirstlane(tstart[ch * 64]); S.t1 = __builtin_amdgcn_readfirstlane(tstart[ch * 64 + 64]); S.nsh = CH / 256; S.ch = ch; S.CH = CH; S.c = c;
              pg::EpiFp8 E; pg::gemm_phase<pg::EpiFp8, SchedG2, false, true>(ring, 256u, 256u, nullptr, S, E); }
            GRID_BAR();
#ifdef SELFCHECK
            if ((SELFCHECK & 4) && (layer == 0 || layer == 3)) { if (layer == 0 || ch == 0) chk_moe(F, a, layer, nrows, ch, 10 + (layer == 3)); GRID_BAR(); }
#endif
            if (PH(17)) rows_post2(F, a, layer, ch * CH, CH);
            if (!(layer == 3 && ch == NCHUNK - 1)) GRID_BAR();
        }
    }
#ifdef SELFCHECK
    GRID_BAR();
    { int bad = 0; float be = 0.f; for (int k = 15; k >= 1; --k) { const float e = __uint_as_float(__hip_atomic_load(F.ctl + CW_ERR + k, RLX_AGENT)); if (e > 1.f) { bad = k; be = e; } }
      int wt = 0; float we = 0.f; for (int k = 0; k < 16; ++k) { const float e = __uint_as_float(__hip_atomic_load(F.ctl + CW_ERR + 32 + k, RLX_AGENT)); if (e > we) { we = e; wt = k; } }
      if (bad) { F.refresh(); float cv = 3.f + bad + (be > 8.f ? 0.5f : 0.f);  Row r; for (int j = 0; j < 4; ++j) r.v[j] = (f32x4){cv, cv, cv, cv}; for (int row = F.gw; row < T; row += NGW) row_store_f32(r, a.out + (size_t)row * D, F.lane); } }
#endif
}

#undef ws
#undef NEWPH
extern "C" void kernel_launch(void* const* d_in, const int* in_sizes, int n_in, void* d_out, int out_size, void* d_ws, size_t ws_size, hipStream_t stream) {
    static int ready = 0;
    if (ready == 0) {
        if (n_in != 20 || out_size != T * D || ws_size < WS_END) { fprintf(stderr, "kernel_launch: unexpected problem (n_in %d out %d ws %zu need %zu)\n", n_in, out_size, ws_size, (size_t)WS_END); ready = -1; return; }
        if (hipFuncSetAttribute((const void*)fwd, hipFuncAttributeMaxDynamicSharedMemorySize, LDS_BYTES) != hipSuccess) { fprintf(stderr, "kernel_launch: hipFuncSetAttribute failed\n"); ready = -1; return; }
        int per_cu = 0;
        if (hipOccupancyMaxActiveBlocksPerMultiprocessor(&per_cu, (const void*)fwd, NTHR, LDS_BYTES) != hipSuccess || per_cu < 1) fprintf(stderr, "kernel_launch: occupancy query says %d blocks per CU\n", per_cu);
        (void)hipGetLastError();
        ready = 1;
    }
    if (ready < 0) return;
    (void)hipMemsetAsync((char*)d_ws + WS_CTL, 0, CTL_BYTES, stream);
    Args a{};
    for (int i = 0; i < 20; ++i) a.in[i] = (const float*)d_in[i];
    a.out = (float*)d_out; a.ws = (unsigned char*)d_ws;
    hipLaunchKernelGGL(fwd, dim3(GRID), dim3(NTHR), LDS_BYTES, stream, a);
}
```

```cpp
#include <hip/hip_runtime.h>
#include <cstdio>
#include <cstdint>

#define LAS __attribute__((address_space(3)))
#define GAS __attribute__((address_space(1)))
typedef unsigned short bf16_t;
typedef short bf16x8 __attribute__((ext_vector_type(8)));
typedef short s16x4 __attribute__((ext_vector_type(4)));
typedef float f32x4 __attribute__((ext_vector_type(4)));
typedef float f32x16 __attribute__((ext_vector_type(16)));
typedef unsigned u32x4 __attribute__((ext_vector_type(4)));
typedef unsigned u32x2 __attribute__((ext_vector_type(2)));
typedef int v8i_t __attribute__((ext_vector_type(8)));
typedef int v4i_t __attribute__((ext_vector_type(4)));

constexpr int D = 1024, NB = 32, SEQ = 2048, T = NB * SEQ, CTXL = 256, TC = NB * CTXL, TT = T + TC;
constexpr int NQKV = 1536, NE = 64;
constexpr float ALPHA = 1.681792830507429f;
constexpr float LN_EPS = 1e-5f, MOD_EPS = 1e-6f;
constexpr float C2 = 0.125f * 1.4426950408889634f;
constexpr float LOG2E = 1.4426950408889634f;
constexpr int NCHUNK = 1;
constexpr int NWAVES = 8, NTHR = 512, GRID = 256;

constexpr size_t MiB = 1u << 20;
constexpr size_t WS_CTL = 0, CTL_BYTES = 1 * MiB;
constexpr size_t WS_ROPEC = 1 * MiB, WS_ROPES = 1 * MiB + 4096, WS_CSN = 1 * MiB + 65536, WS_DLC = 1 * MiB + 524288, WS_DL = 2 * MiB;
constexpr size_t WS_WQKV = 10 * MiB, WS_WO = 16 * MiB, WS_WF = 20 * MiB, WS_WR = 28 * MiB, WS_WSH = 29 * MiB;
constexpr size_t WS_MODP = 36 * MiB, WS_MOD = 49 * MiB;
constexpr size_t WS_EGU = 54 * MiB, WS_ED = 118 * MiB;
constexpr size_t WS_XS = 150 * MiB;
constexpr size_t WS_STOK = 294 * MiB, WS_SDST = 297 * MiB, WS_SW = 300 * MiB, WS_TKE = 303 * MiB, WS_TKW = 306 * MiB;
constexpr size_t WS_R = 309 * MiB;
constexpr size_t WS_Q = WS_R, WS_K = WS_R + 144 * MiB, WS_V = WS_R + 180 * MiB;
constexpr size_t WS_ABT = WS_R, WS_FH = WS_R + 256 * MiB, WS_FH1 = WS_R + 320 * MiB, WS_ABTC = WS_R + 321 * MiB, WS_FC = WS_R + 353 * MiB;
constexpr size_t WS_H = WS_R, WS_HS = WS_R + 160 * MiB, WS_YB = WS_R + 180 * MiB, WS_YS = WS_R + 788 * MiB;
constexpr size_t WS_END = WS_YS + 72 * MiB;
constexpr size_t OUT_U8 = 144 * MiB;
constexpr int WSCALE_E8M0 = 121;
constexpr int MAXROWS = 655360;

constexpr int CW_TMO = 0, CW_BAR = 4096, CW_BCNT = 16384;

constexpr int RING_BYTES = 131072;
constexpr int L_MISC = RING_BYTES;
constexpr int L_TSTART = RING_BYTES + 256;
constexpr int L_PREF = L_TSTART + 1040;
constexpr int L_LCNT = L_PREF + 256;
constexpr int L_TSEG = L_LCNT + 256;
constexpr int L_SCAN = L_TSEG + 2560;
constexpr int LDS_BYTES = 139264;
static_assert(L_SCAN + 1024 <= LDS_BYTES, "LDS map");

#define RLX_AGENT __ATOMIC_RELAXED, __HIP_MEMORY_SCOPE_AGENT
#define LDS_WAIT() asm volatile("s_waitcnt lgkmcnt(0)" ::: "memory")
#define VM_WAIT() asm volatile("s_waitcnt vmcnt(0)" ::: "memory")

__device__ __forceinline__ unsigned f2bf(float f) { unsigned u = __builtin_bit_cast(unsigned, f); return (u + 0x7fffu + ((u >> 16) & 1u)) >> 16; }
__device__ __forceinline__ unsigned pk2(float lo, float hi) { return f2bf(lo) | (f2bf(hi) << 16); }
typedef float f32x2_t __attribute__((ext_vector_type(2))); typedef __bf16 bf16x2_t __attribute__((ext_vector_type(2)));
__device__ __forceinline__ unsigned cvt_pk_bf16(float lo, float hi) { f32x2_t v = {lo, hi}; bf16x2_t b = __builtin_convertvector(v, bf16x2_t); return __builtin_bit_cast(unsigned, b); }
__device__ __forceinline__ float bflo(unsigned w) { return __builtin_bit_cast(float, w << 16); }
__device__ __forceinline__ float bfhi(unsigned w) { return __builtin_bit_cast(float, w & 0xffff0000u); }
__device__ __forceinline__ float wave_sum(float v) {
#pragma unroll
    for (int o = 1; o < 64; o <<= 1) v += __shfl_xor(v, o);
    return v;
}

__device__ __forceinline__ unsigned f2f8(float v) { return (unsigned)__builtin_amdgcn_cvt_pk_fp8_f32(v, 0.f, 0, false) & 0xffu; }
__device__ __forceinline__ float f82f(unsigned b) { return __builtin_amdgcn_cvt_pk_f32_fp8((int)(b & 0xffu), false)[0]; }
__device__ __forceinline__ int opaque_tid() { int t = threadIdx.x; asm volatile("" : "+v"(t)); return t; }

#define XB_TMO      128
#define XB_XCNT(j)  (256  + 64 * (j))
#define XB_XSUB(j)  (1280 + 64 * (j))
#define XB_XGEN(j)  (2304 + 64 * (j))
#define XB_TOP      3328
#define XB_TOPGEN   3392
#define XCD_BAR_WORDS 3456
#define XB_SPIN_CAP (1u << 22)
__device__ __forceinline__ unsigned xb_ld(unsigned* p)              { return __hip_atomic_load(p, __ATOMIC_RELAXED, __HIP_MEMORY_SCOPE_AGENT); }
__device__ __forceinline__ unsigned xb_add(unsigned* p, unsigned v) { return __hip_atomic_fetch_add(p, v, __ATOMIC_RELAXED, __HIP_MEMORY_SCOPE_AGENT); }
__device__ __forceinline__ unsigned xb_xcc_id() { return (unsigned)__builtin_amdgcn_s_getreg((3 << 11) | 20) & 0xFu; }
#define XB_SPIN(cond, bar) do { unsigned _sp = 0; while (cond) { __builtin_amdgcn_s_sleep(1); \
    if ((++_sp & 255u) == 0u) { if (xb_ld(&(bar)[XB_TMO])) break; if (_sp > XB_SPIN_CAP) { atomicAdd(&(bar)[XB_TMO], 1u); break; } } } } while (0)
struct XcdBarrier { unsigned* bar; unsigned x; volatile LAS unsigned* st; };
__device__ __forceinline__ XcdBarrier xcd_barrier_post(unsigned* bar, volatile LAS unsigned* st) {
    XcdBarrier b; b.bar = bar; b.x = xb_xcc_id(); b.st = st;
    if (threadIdx.x == 0) (void)xb_add(&bar[XB_XCNT(b.x)], 1u);
    return b;
}
__device__ __forceinline__ void xcd_barrier_complete(unsigned* bar, unsigned x, unsigned& nloc, unsigned& nx) {
    const unsigned G = gridDim.x * gridDim.y * gridDim.z;
    unsigned sum, cnt, mine, sp = 0u;
    for (;;) {
        sum = 0u; cnt = 0u; mine = 0u;
#pragma unroll
        for (unsigned j = 0; j < 16; ++j) { const unsigned c = xb_ld(&bar[XB_XCNT(j)]); sum += c; cnt += (c > 0u) ? 1u : 0u; mine = (j == x) ? c : mine; }
        if (sum == G) break;
        __builtin_amdgcn_s_sleep(1);
        if ((++sp & 255u) == 0u) { if (xb_ld(&bar[XB_TMO])) break; if (sp > XB_SPIN_CAP) { atomicAdd(&bar[XB_TMO], 1u); break; } }
    }
    nloc = mine > 0u ? mine : 1u; nx = cnt > 0u ? cnt : 1u;
}
__device__ __forceinline__ void xcd_barrier(const XcdBarrier& b) {
    asm volatile("s_waitcnt vmcnt(0)" ::: "memory");
    __syncthreads();
    if (threadIdx.x == 0) {
        unsigned* bar = b.bar; unsigned bx = b.x; asm volatile("" : "+s"(bx));
        __builtin_amdgcn_s_waitcnt(0);
        unsigned nloc = b.st[0], nx = b.st[1];
        if (nloc == 0u) { xcd_barrier_complete(bar, bx, nloc, nx); b.st[0] = nloc; b.st[1] = nx; }
        const unsigned old = xb_add(&bar[XB_XSUB(bx)], 1u);
        const unsigned gen = old / nloc;
        if (old + 1u == (gen + 1u) * nloc) {
            __builtin_amdgcn_fence(__ATOMIC_RELEASE, "agent");
            asm volatile("s_waitcnt vmcnt(0)" ::: "memory");
            const unsigned og = xb_add(&bar[XB_TOP], 1u);
            const unsigned tg = og / nx;
            if (og + 1u == (tg + 1u) * nx) xb_add(&bar[XB_TOPGEN], 1u);
            else XB_SPIN(xb_ld(&bar[XB_TOPGEN]) == tg, bar);
            __builtin_amdgcn_fence(__ATOMIC_ACQUIRE, "agent");
            xb_add(&bar[XB_XGEN(bx)], 1u);
            asm volatile("s_waitcnt vmcnt(0)" ::: "memory");
        } else {
            XB_SPIN(xb_ld(&bar[XB_XGEN(bx)]) == gen, bar);
            __builtin_amdgcn_fence(__ATOMIC_ACQUIRE, "agent");
            asm volatile("s_waitcnt vmcnt(0)" ::: "memory");
        }
    }
    __syncthreads();
}

namespace pg {
constexpr int BM = 256, BK = 64, HALF = 128, HTB = HALF * BK * 2;
__host__ __device__ __forceinline__ int lds_byte(int r, int c) { const int st = (r >> 4) * 2 + (c >> 5), rr = r & 15, cc = c & 31, ob = rr * 64 + cc * 2; return st * 1024 + (ob ^ (((ob >> 9) & 1) << 5)); }
__host__ __device__ __forceinline__ void stage_rc(int b, int& R, int& C) { const int st = b / 1024, sb = b % 1024, swz = sb ^ (((sb >> 9) & 1) << 5); R = (st >> 1) * 16 + swz / 64; C = (st & 1) * 32 + (swz % 64) / 2; }
__host__ __device__ __forceinline__ int perm32(int rho) { const int n = rho >> 4, i = rho & 15; return 8 * (i >> 2) + 4 * n + (i & 3); }

struct Unit {
    const char* A;
    const char* B;
    const int* gidx;
    int gbase;
    int nt;
    char* out; int ldc; float scale; int flags; int i0; int i1;
};

template <class Epi, class Sched, bool GATHER, bool F8 = false, int WSC = WSCALE_E8M0>
__device__ __forceinline__ void gemm_phase(LAS unsigned char* lds, const unsigned lda, const unsigned ldb, const char* gtable, const Sched& S, const Epi& E) {
    const int tid = opaque_tid(), wid = __builtin_amdgcn_readfirstlane(tid >> 6), lane = tid & 63, wr = wid >> 2, wc = wid & 3, fr = lane & 15, fq = lane >> 4;
    unsigned voffA[2], voffB[2];
#pragma unroll
    for (int i = 0; i < 2; ++i) { int R, C; stage_rc(tid * 16 + i * 8192, R, C); const int Rb = (R & ~31) + perm32(R & 31);
        voffA[i] = (unsigned)R * lda + (unsigned)C * 2u; voffB[i] = (unsigned)Rb * ldb + (unsigned)C * 2u; }
    const size_t kstep = (size_t)(BK * 2);
    const size_t hstepA = (size_t)HALF * lda, hstepB = (size_t)HALF * ldb;
    const unsigned ldsw = (unsigned)wid * 1024u;
    const int aoff = lds_byte(wr * 64 + fr, fq * 8), boff = lds_byte(wc * 32 + fr, fq * 8);
#define PG_SA(b, h) (((b) * 2 + (h)) * HTB)
#define PG_SB(b, h) ((4 + (b) * 2 + (h)) * HTB)
#define PG_ST2(bufoff, p0, p1) do { \
        __builtin_amdgcn_global_load_lds((const unsigned*)(p0), (LAS unsigned*)(lds + (bufoff) + ldsw), 16, 0, 0); \
        __builtin_amdgcn_global_load_lds((const unsigned*)(p1), (LAS unsigned*)(lds + (bufoff) + ldsw + 8192), 16, 0, 0); } while (0)
#define PG_STB(bufoff, bp) PG_ST2(bufoff, (bp) + voffB[0], (bp) + voffB[1])
#define PG_STA(bufoff, ap, h, nx) do { if constexpr (GATHER) { PG_ST2(bufoff, (ap) + ((nx) ? nO[h][0] : cO[h][0]), (ap) + ((nx) ? nO[h][1] : cO[h][1])); } \
        else { PG_ST2(bufoff, (ap) + (h) * hstepA + voffA[0], (ap) + (h) * hstepA + voffA[1]); } } while (0)
#define PG_LD8(p) ({ const v4i_t lo_ = *(const LAS v4i_t*)(p), hi_ = *(const LAS v4i_t*)((p) + 1024); __builtin_shufflevector(lo_, hi_, 0, 1, 2, 3, 4, 5, 6, 7); })
#define PG_LDA(dst, b, h) do { if constexpr (F8) { _Pragma("unroll") for (int m = 0; m < 4; ++m) dst##8[m] = PG_LD8(lds + PG_SA(b, h) + aoff + m * 2048); } \
        else { _Pragma("unroll") for (int m = 0; m < 4; ++m) _Pragma("unroll") for (int k = 0; k < 2; ++k) dst[m][k] = *(const LAS bf16x8*)(lds + PG_SA(b, h) + aoff + m * 2048 + k * 1024); } } while (0)
#define PG_LDB(dst, b, h) do { if constexpr (F8) { _Pragma("unroll") for (int n = 0; n < 2; ++n) dst##8[n] = PG_LD8(lds + PG_SB(b, h) + boff + n * 2048); } \
        else { _Pragma("unroll") for (int n = 0; n < 2; ++n) _Pragma("unroll") for (int k = 0; k < 2; ++k) dst[n][k] = *(const LAS bf16x8*)(lds + PG_SB(b, h) + boff + n * 2048 + k * 1024); } } while (0)
#define PG_MMA(ai, bj, At, Bt) do { __builtin_amdgcn_s_setprio(1); _Pragma("unroll") for (int m = 0; m < 4; ++m) _Pragma("unroll") for (int n = 0; n < 2; ++n) { \
        if constexpr (F8) { asm volatile("v_mfma_scale_f32_16x16x128_f8f6f4 %0, %1, %2, %0, %3, %4 op_sel_hi:[0,0,0]" : "+v"(acc[ai][bj][m][n]) : "v"(Bt##8[n]), "v"(At##8[m]), "v"(sc_w), "v"(sc_x)); } \
        else { _Pragma("unroll") for (int k = 0; k < 2; ++k) acc[ai][bj][m][n] = __builtin_amdgcn_mfma_f32_16x16x32_bf16(Bt[n][k], At[m][k], acc[ai][bj][m][n], 0, 0, 0); } } \
        __builtin_amdgcn_s_setprio(0); } while (0)
#define PG_WAIT_V(n) asm volatile("s_waitcnt vmcnt(" #n ")" ::: "memory")
#define PG_WAIT_L(n) asm volatile("s_waitcnt lgkmcnt(" #n ")" ::: "memory")
#define PG_BAR __builtin_amdgcn_s_barrier()
#define PG_SCHED __builtin_amdgcn_sched_barrier(0)
#define PG_GOFF(dst, u) do { const int tz_ = opaque_tid(); _Pragma("unroll") for (int i = 0; i < 2; ++i) { int R_, C_; stage_rc(tz_ * 16 + i * 8192, R_, C_); \
        _Pragma("unroll") for (int h = 0; h < 2; ++h) { const int rr = h * HALF + R_; \
        const int ix = (u).gidx ? ((const GAS int*)(u).gidx)[rr] : (u).gbase + rr; dst[h][i] = (unsigned)ix * lda + (unsigned)C_ * 2u; } } } while (0)
#define PG_GIDX(dst, un) do { const int* gi_ = nullptr; int gb_ = 0; const bool ok_ = S.gsrc((un), gi_, gb_); const int tz_ = opaque_tid(); _Pragma("unroll") for (int i = 0; i < 2; ++i) { int R_, C_; stage_rc(tz_ * 16 + i * 8192, R_, C_); \
        _Pragma("unroll") for (int h = 0; h < 2; ++h) { const int rr = h * HALF + R_; dst[h][i] = (ok_ && gi_) ? ((const GAS int*)gi_)[rr] : gb_ + rr; } } } while (0)
#define PG_GCVT(dst, src) do { const int tz_ = opaque_tid(); _Pragma("unroll") for (int i = 0; i < 2; ++i) { int R_, C_; stage_rc(tz_ * 16 + i * 8192, R_, C_); \
        _Pragma("unroll") for (int h = 0; h < 2; ++h) dst[h][i] = (unsigned)src[h][i] * lda + (unsigned)C_ * 2u; } } while (0)
    Unit cur, nxt; int ui = 0;
    if (!S.next(0, cur)) return;
    f32x4 acc[2][2][4][2];
#pragma unroll
    for (int a = 0; a < 2; ++a)
#pragma unroll
        for (int b = 0; b < 2; ++b)
#pragma unroll
            for (int m = 0; m < 4; ++m)
#pragma unroll
                for (int n = 0; n < 2; ++n) acc[a][b][m][n] = (f32x4){0.f, 0.f, 0.f, 0.f};
    bf16x8 At[4][2], B0[2][2], B1[2][2]; v8i_t At8[4], B08[2], B18[2];
    const int sc_w = WSC * 0x01010101, sc_x = 0x7f7f7f7f;
    unsigned cO[2][2] = {{0u, 0u}, {0u, 0u}}, nO[2][2] = {{0u, 0u}, {0u, 0u}};
    if constexpr (GATHER) { PG_GOFF(cO, cur); }
    const char* cA = GATHER ? gtable : cur.A; const char* cB = cur.B;
    PG_STB(PG_SB(0, 0), cB); PG_STB(PG_SB(0, 1), cB + hstepB); PG_STA(PG_SA(0, 0), cA, 0, false); PG_STA(PG_SA(0, 1), cA, 1, false);
    if (wr == 1) PG_BAR;
    PG_WAIT_V(2); PG_BAR;
    PG_STB(PG_SB(1, 0), cB + kstep); PG_STA(PG_SA(1, 0), cA + kstep, 0, false); PG_STB(PG_SB(1, 1), cB + hstepB + kstep);
    PG_WAIT_V(6); PG_BAR;
    for (;;) {
        const bool has_next = S.next(ui + 1, nxt);
        const int nt = cur.nt;
        if constexpr (GATHER) { if (has_next) { PG_GOFF(nO, nxt); } else {
#pragma unroll
            for (int h = 0; h < 2; ++h)
#pragma unroll
                for (int i = 0; i < 2; ++i) nO[h][i] = cO[h][i]; } }
        const char* nA = GATHER ? gtable : (has_next ? nxt.A : cA); const char* nB = has_next ? nxt.B : cB;
#pragma unroll 1
        for (int t = 0; t < nt; t += 2) {
            const bool last = (t == nt - 2);
            const char* a1 = cA + (size_t)(t + 1) * kstep;
            const char* a2 = last ? nA : cA + (size_t)(t + 2) * kstep; const char* b2 = last ? nB : cB + (size_t)(t + 2) * kstep;
            const char* a3 = a2 + kstep; const char* b3 = b2 + kstep;
            PG_LDB(B0, 0, 0); PG_LDB(B1, 0, 1); PG_SCHED; PG_LDA(At, 0, 0); PG_STA(PG_SA(1, 1), a1, 1, false);
            PG_WAIT_V(8); PG_WAIT_L(0); PG_BAR; PG_MMA(0, 0, At, B0); PG_MMA(0, 1, At, B1); PG_BAR; PG_SCHED;
            PG_LDA(At, 0, 1); PG_STB(PG_SB(0, 0), b2); PG_STB(PG_SB(0, 1), b2 + hstepB); PG_STA(PG_SA(0, 0), a2, 0, last);
            PG_WAIT_V(8); PG_WAIT_L(0); PG_BAR; PG_MMA(1, 0, At, B0); PG_MMA(1, 1, At, B1); PG_BAR; PG_SCHED;
            PG_LDB(B0, 1, 0); PG_LDB(B1, 1, 1); PG_SCHED; PG_LDA(At, 1, 0); PG_STA(PG_SA(0, 1), a2, 1, last);
            PG_WAIT_V(8); PG_WAIT_L(0); PG_BAR; PG_MMA(0, 0, At, B0); PG_MMA(0, 1, At, B1); PG_BAR; PG_SCHED;
            PG_LDA(At, 1, 1); PG_STB(PG_SB(1, 0), b3); PG_STB(PG_SB(1, 1), b3 + hstepB); PG_STA(PG_SA(1, 0), a3, 0, last);
            PG_WAIT_V(8); PG_WAIT_L(0); PG_BAR; PG_MMA(1, 0, At, B0); PG_MMA(1, 1, At, B1); PG_BAR; PG_SCHED;
        }
        if (wr == 0) PG_BAR;
        if constexpr (F8) asm volatile("s_nop 15\n\ts_nop 15" ::: "memory");
        E(acc, cur, wr, wc, fr, fq);
        if (!has_next) break;
#pragma unroll
        for (int a = 0; a < 2; ++a)
#pragma unroll
            for (int b = 0; b < 2; ++b)
#pragma unroll
                for (int m = 0; m < 4; ++m)
#pragma unroll
                    for (int n = 0; n < 2; ++n) acc[a][b][m][n] = (f32x4){0.f, 0.f, 0.f, 0.f};
        cur = nxt; cA = nA; cB = nB; ++ui;
        if constexpr (GATHER) {
#pragma unroll
            for (int h = 0; h < 2; ++h)
#pragma unroll
                for (int i = 0; i < 2; ++i) cO[h][i] = nO[h][i]; }
        if (wr == 1) PG_BAR;
    }
    PG_WAIT_V(0);
    PG_BAR;
#undef PG_SA
#undef PG_SB
#undef PG_ST2
#undef PG_STB
#undef PG_STA
#undef PG_LDA
#undef PG_LD8
#undef PG_LDB
#undef PG_MMA
#undef PG_WAIT_V
#undef PG_WAIT_L
#undef PG_BAR
#undef PG_SCHED
#undef PG_GOFF
#undef PG_GIDX
#undef PG_GCVT
}

struct EpiStore {
    __device__ __forceinline__ void operator()(const f32x4 (&acc)[2][2][4][2], const Unit& u, int wr, int wc, int fr, int fq) const {
        asm volatile("" : "+v"(fr), "+v"(fq));
        const float s = u.scale;
#pragma unroll
        for (int ai = 0; ai < 2; ++ai)
#pragma unroll
            for (int m = 0; m < 4; ++m) { const int row = ai * HALF + wr * 64 + m * 16 + fr;
                char* rowp = u.out + (ptrdiff_t)row * u.ldc + (wc * 32 + 8 * fq) * 2;
                if (!((u.flags & 1) && row == 0)) {
#pragma unroll
                for (int bj = 0; bj < 2; ++bj) { const f32x4 v0 = acc[ai][bj][m][0] * s, v1 = acc[ai][bj][m][1] * s;
                    u32x4 w; w.x = cvt_pk_bf16(v0[0], v0[1]); w.y = cvt_pk_bf16(v0[2], v0[3]); w.z = cvt_pk_bf16(v1[0], v1[1]); w.w = cvt_pk_bf16(v1[2], v1[3]);
                    *(u32x4*)(rowp + bj * 256) = w; } } }
    }
};
struct EpiStore8 {
    __device__ __forceinline__ void operator()(const f32x4 (&acc)[2][2][4][2], const Unit& u, int wr, int wc, int fr, int fq) const {
        asm volatile("" : "+v"(fr), "+v"(fq));
        const float s = u.scale;
#pragma unroll
        for (int ai = 0; ai < 2; ++ai)
#pragma unroll
            for (int m = 0; m < 4; ++m) { const int row = ai * HALF + wr * 64 + m * 16 + fr;
                char* rowp = u.out + (ptrdiff_t)row * u.ldc + (wc * 32 + 8 * fq);
#pragma unroll
                for (int bj = 0; bj < 2; ++bj) { const f32x4 v0 = acc[ai][bj][m][0] * s, v1 = acc[ai][bj][m][1] * s; int w0 = 0, w1 = 0;
                    w0 = __builtin_amdgcn_cvt_pk_fp8_f32(v0[0], v0[1], w0, false); w0 = __builtin_amdgcn_cvt_pk_fp8_f32(v0[2], v0[3], w0, true);
                    w1 = __builtin_amdgcn_cvt_pk_fp8_f32(v1[0], v1[1], w1, false); w1 = __builtin_amdgcn_cvt_pk_fp8_f32(v1[2], v1[3], w1, true);
                    u32x2 o; o.x = (unsigned)w0; o.y = (unsigned)w1; *(u32x2*)(rowp + bj * 128) = o; } }
    }
};
struct EpiQKV {
    bf16_t* Q; bf16_t* K; bf16_t* V; const float* ropec; const float* ropes;
    __device__ __forceinline__ void operator()(const f32x4 (&acc)[2][2][4][2], const Unit& u, int wr, int wc, int fr, int fq) const {
        asm volatile("" : "+v"(fr), "+v"(fq));
        const int pm = u.i0, pn = u.i1; const bool lat = pm < (T / 256); const bool rope = lat && pn < 5;
        const float qs = pn < 4 ? C2 : 1.f;
        const int part = wc & 1;
        const int fi0 = 8 * (fq & 1);
        const float sgn = (fq < 2) ? -1.f : 1.f;
#pragma unroll
        for (int ai = 0; ai < 2; ++ai)
#pragma unroll
            for (int m = 0; m < 4; ++m) { const int row = ai * HALF + wr * 64 + m * 16 + fr; const int tok = pm * 256 + row;
                const int tl = tok & (SEQ - 1); const int pos = part ? (tl & 63) : (tl >> 6);
                f32x4 c0 = {1.f, 1.f, 1.f, 1.f}, c1 = c0, s0 = {0.f, 0.f, 0.f, 0.f}, s1 = s0;
                if (rope) { c0 = *(const f32x4*)(ropec + pos * 16 + fi0); c1 = *(const f32x4*)(ropec + pos * 16 + fi0 + 4); s0 = *(const f32x4*)(ropes + pos * 16 + fi0); s1 = *(const f32x4*)(ropes + pos * 16 + fi0 + 4); }
#pragma unroll
                for (int bj = 0; bj < 2; ++bj) { f32x4 v0 = acc[ai][bj][m][0], v1 = acc[ai][bj][m][1];
                    if (rope) { f32x4 p0, p1;
#pragma unroll
                        for (int j = 0; j < 4; ++j) { p0[j] = __shfl_xor(v0[j], 32); p1[j] = __shfl_xor(v1[j], 32); }
                        v0 = v0 * c0 + (p0 * sgn) * s0; v1 = v1 * c1 + (p1 * sgn) * s1; }
                    v0 = v0 * qs; v1 = v1 * qs;
                    u32x4 w; w.x = cvt_pk_bf16(v0[0], v0[1]); w.y = cvt_pk_bf16(v0[2], v0[3]); w.z = cvt_pk_bf16(v1[0], v1[1]); w.w = cvt_pk_bf16(v1[2], v1[3]);
                    const int col = bj * HALF + wc * 32 + 8 * fq;
                    bf16_t* dst = pn < 4 ? Q + (size_t)tok * 1024 + pn * 256 + col : (pn == 4 ? K + (size_t)tok * 256 + col : V + (size_t)tok * 256 + col);
                    *(u32x4*)dst = w; } }
    }
};
struct EpiSilu {
    __device__ __forceinline__ void operator()(const f32x4 (&acc)[2][2][4][2], const Unit& u, int wr, int wc, int fr, int fq) const {
        asm volatile("" : "+v"(fr), "+v"(fq));
#pragma unroll
        for (int ai = 0; ai < 2; ++ai)
#pragma unroll
            for (int m = 0; m < 4; ++m) { const int row = ai * HALF + wr * 64 + m * 16 + fr;
                float h[8];
#pragma unroll
                for (int n = 0; n < 2; ++n)
#pragma unroll
                    for (int j = 0; j < 4; ++j) { const float g = acc[ai][0][m][n][j], up = acc[ai][1][m][n][j]; h[n * 4 + j] = g * __builtin_amdgcn_rcpf(1.f + __expf(-g)) * up; }
                int w0 = 0, w1 = 0;
                w0 = __builtin_amdgcn_cvt_pk_fp8_f32(h[0], h[1], w0, false); w0 = __builtin_amdgcn_cvt_pk_fp8_f32(h[2], h[3], w0, true);
                w1 = __builtin_amdgcn_cvt_pk_fp8_f32(h[4], h[5], w1, false); w1 = __builtin_amdgcn_cvt_pk_fp8_f32(h[6], h[7], w1, true);
                u32x2 o; o.x = (unsigned)w0; o.y = (unsigned)w1;
                *(u32x2*)(u.out + (size_t)row * 256 + (wc * 32 + 8 * fq)) = o; }
    }
};
struct EpiFp8 {
    __device__ __forceinline__ void operator()(const f32x4 (&acc)[2][2][4][2], const Unit& u, int wr, int wc, int fr, int fq) const {
        asm volatile("" : "+v"(fr), "+v"(fq));
        const int pn = u.i1;
#pragma unroll
        for (int ai = 0; ai < 2; ++ai)
#pragma unroll
            for (int m = 0; m < 4; ++m) { const int row = ai * HALF + wr * 64 + m * 16 + fr;
                u32x4 o;
#pragma unroll
                for (int bj = 0; bj < 2; ++bj) { const f32x4 v0 = acc[ai][bj][m][0] * 16.f, v1 = acc[ai][bj][m][1] * 16.f;
                    int w0 = 0, w1 = 0;
                    w0 = __builtin_amdgcn_cvt_pk_fp8_f32(v0[0], v0[1], w0, false); w0 = __builtin_amdgcn_cvt_pk_fp8_f32(v0[2], v0[3], w0, true);
                    w1 = __builtin_amdgcn_cvt_pk_fp8_f32(v1[0], v1[1], w1, false); w1 = __builtin_amdgcn_cvt_pk_fp8_f32(v1[2], v1[3], w1, true);
                    o[2 * bj] = (unsigned)w0; o[2 * bj + 1] = (unsigned)w1; }
                *(u32x4*)(u.out + (size_t)row * 1024 + (16 * pn + 4 * wc + fq) * 16) = o; }
    }
};
__device__ __forceinline__ int xcd_remap(int L0, int NU) { const int q = NU >> 3, r = NU & 7, x = L0 & 7, off = L0 >> 3; return (x < r ? x * (q + 1) : r * (q + 1) + (x - r) * q) + off; }
}

namespace attn {
constexpr int SLOTB = 8192;
constexpr int LDS_K = 0, LDS_V = 2 * SLOTB, LDS_WS = 4 * SLOTB, LDS_OST = LDS_WS + NWAVES * 256, LDS_END = LDS_OST + NWAVES * 4096;
static_assert(LDS_END <= RING_BYTES, "attention LDS");
__device__ __forceinline__ int crow(int r, int hi) { return (r & 3) + 8 * (r >> 2) + 4 * hi; }
__device__ __forceinline__ void glds16(const void* gsrc, unsigned lds_dst) { unsigned keep;
    asm volatile("s_mov_b32 %0, m0\n\ts_mov_b32 m0, %2\n\ts_nop 0\n\tglobal_load_lds_dwordx4 %1, off\n\ts_mov_b32 m0, %0" : "=&s"(keep) : "v"(gsrc), "s"(lds_dst) : "memory"); }
__device__ __forceinline__ float rowmax(const f32x16& p0, const f32x16& p1) {
    float a = fmaxf(p0[0], p1[0]);
#pragma unroll
    for (int r = 1; r < 16; ++r) a = fmaxf(a, fmaxf(p0[r], p1[r]));
    auto rr = __builtin_amdgcn_permlane32_swap(__float_as_uint(a), __float_as_uint(a), false, false);
    return fmaxf(__uint_as_float(rr[0]), __uint_as_float(rr[1]));
}
typedef short v4i16_t __attribute__((ext_vector_type(4)));
__device__ __forceinline__ s16x4 vtr(const LAS unsigned char* p) { return __builtin_bit_cast(s16x4, __builtin_amdgcn_ds_read_tr16_b64_v4i16((LAS v4i16_t*)p)); }
__device__ __forceinline__ void pv(f32x16* o, const LAS unsigned char* vp, bf16x8 pa0, bf16x8 pa1, bf16x8 pa2, bf16x8 pa3) {
#pragma unroll
    for (int d0 = 0; d0 < 2; ++d0) { s16x4 lo[4], hi[4];
#pragma unroll
        for (int ks = 0; ks < 4; ++ks) { lo[ks] = vtr(vp + d0 * 4096 + ks * 1024); hi[ks] = vtr(vp + d0 * 4096 + ks * 1024 + 512); }
#define PK(k) (bf16x8){lo[k][0], lo[k][1], lo[k][2], lo[k][3], hi[k][0], hi[k][1], hi[k][2], hi[k][3]}
        o[d0] = __builtin_amdgcn_mfma_f32_32x32x16_bf16(pa0, PK(0), o[d0], 0, 0, 0);
        o[d0] = __builtin_amdgcn_mfma_f32_32x32x16_bf16(pa1, PK(1), o[d0], 0, 0, 0);
        o[d0] = __builtin_amdgcn_mfma_f32_32x32x16_bf16(pa2, PK(2), o[d0], 0, 0, 0);
        o[d0] = __builtin_amdgcn_mfma_f32_32x32x16_bf16(pa3, PK(3), o[d0], 0, 0, 0);
#undef PK
    }
}
__device__ __forceinline__ void attn_unit(const bf16_t* Q, const bf16_t* K, const bf16_t* V, bf16_t* O, int b, int h, int q0, bool isctx, float sink2, LAS unsigned char* shm) {
    const int tid = opaque_tid(), lane = tid & 63, r32 = lane & 31, hi = lane >> 5; const int wid = __builtin_amdgcn_readfirstlane(tid >> 6);
    const int kvh = h >> 2;
    const long qrow = isctx ? (long)T + b * CTXL + wid * 32 : (long)b * SEQ + q0 + wid * 32;
    const unsigned lds0 = (unsigned)(uintptr_t)shm;
    LAS float* wsf = (LAS float*)(shm + LDS_WS) + wid * 64;
    int jlo = 0, nl = 0;
    if (!isctx) { jlo = (q0 == 0) ? 2 : 0; int jhi = (SEQ - q0 + 128) / 64; if (jhi > 8) jhi = 8; nl = jhi - jlo; }
    const int NT = nl + 4;
    const long lat0 = (long)b * SEQ + q0 - 128 + 64 * jlo, ctx0 = (long)T + b * CTXL;
#define TROW(t) ((t) < nl ? lat0 + 64 * (t) : ctx0 + 64 * ((t) - nl))
    const int kcol = kvh * 64 + wid * 8, vcol = kvh * 64 + (wid >> 2) * 32 + (lane & 3) * 8, vrow = 16 * (wid & 3) + (lane >> 2);
    const unsigned kdst = lds0 + LDS_K + wid * 1024, vdst = lds0 + LDS_V + wid * 1024;
#define DMA_KV(t, slot) do { const long tr_ = TROW(t); glds16(K + (tr_ + lane) * 256 + kcol, (unsigned)__builtin_amdgcn_readfirstlane(kdst + (slot) * SLOTB)); \
        glds16(V + (tr_ + vrow) * 256 + vcol, (unsigned)__builtin_amdgcn_readfirstlane(vdst + (slot) * SLOTB)); } while (0)
    DMA_KV(0, 0);
    bf16x8 qr[4];
#pragma unroll
    for (int d0 = 0; d0 < 4; ++d0) qr[d0] = *(const GAS bf16x8*)(Q + (qrow + r32) * 1024 + h * 64 + d0 * 16 + hi * 8);
    float mrun = sink2, l_reg = (hi == 0) ? 1.f : 0.f;
    f32x16 o[2];
#pragma unroll
    for (int r = 0; r < 16; ++r) { o[0][r] = 0.f; o[1][r] = 0.f; }
    const LAS unsigned char* vp0 = shm + LDS_V + ((lane >> 4) & 1) * 32 + (lane & 3) * 8 + (4 * hi + ((lane & 15) >> 2)) * 64;
    const int qw = q0 + wid * 32;
    asm volatile("s_waitcnt vmcnt(0) lgkmcnt(0)\n\ts_barrier" ::: "memory");
    for (int t = 0; t < NT; ++t) {
        const int slot = t & 1;
        if (t + 1 < NT) DMA_KV(t + 1, slot ^ 1);
        const bool latt = t < nl;
        const int ks = q0 - 128 + 64 * (jlo + t);
        bool need = true;
        if (latt) need = (ks + 63 >= qw - 128) && (ks <= qw + 31 + 128);
        if (need) {
            f32x16 p0, p1;
#pragma unroll
            for (int r = 0; r < 16; ++r) { p0[r] = 0.f; p1[r] = 0.f; }
            const LAS unsigned char* kb = shm + LDS_K + slot * SLOTB + hi * 1024 + r32 * 16;
#pragma unroll
            for (int d0 = 0; d0 < 4; ++d0) {
                const bf16x8 b0 = *(const LAS bf16x8*)(kb + d0 * 2048), b1 = *(const LAS bf16x8*)(kb + d0 * 2048 + 512);
                p0 = __builtin_amdgcn_mfma_f32_32x32x16_bf16(b0, qr[d0], p0, 0, 0, 0);
                p1 = __builtin_amdgcn_mfma_f32_32x32x16_bf16(b1, qr[d0], p1, 0, 0, 0); }
            if (latt) { const int dq = qw + r32 - ks;
#pragma unroll
                for (int r = 0; r < 16; ++r) { const int d = dq - crow(r, hi); if (d > 128 || d < -128) p0[r] = -INFINITY; if (d - 32 > 128 || d - 32 < -128) p1[r] = -INFINITY; } }
            const float rm = rowmax(p0, p1);
            if (__any(rm > mrun + 8.f)) {
                const float mnew = fmaxf(mrun, rm);
                const float alpha = __builtin_amdgcn_exp2f(mrun - mnew); l_reg *= alpha; mrun = mnew;
                if (hi == 0) wsf[r32] = alpha;
                asm volatile("s_waitcnt lgkmcnt(0)" ::: "memory");
#pragma unroll
                for (int r = 0; r < 16; ++r) { const float f = wsf[crow(r, hi)]; o[0][r] *= f; o[1][r] *= f; }
            }
            float sacc = 0.f;
#pragma unroll
            for (int r = 0; r < 16; ++r) { p0[r] = __builtin_amdgcn_exp2f(p0[r] - mrun); p1[r] = __builtin_amdgcn_exp2f(p1[r] - mrun); sacc += p0[r] + p1[r]; }
            l_reg += sacc;
            u32x4 pw0, pw1, pw2, pw3;
#define PKW(P, B) cvt_pk_bf16(P[B], P[B + 1])
            pw0 = (u32x4){PKW(p0, 0), PKW(p0, 2), PKW(p0, 4), PKW(p0, 6)}; pw1 = (u32x4){PKW(p0, 8), PKW(p0, 10), PKW(p0, 12), PKW(p0, 14)};
            pw2 = (u32x4){PKW(p1, 0), PKW(p1, 2), PKW(p1, 4), PKW(p1, 6)}; pw3 = (u32x4){PKW(p1, 8), PKW(p1, 10), PKW(p1, 12), PKW(p1, 14)};
#undef PKW
            __builtin_amdgcn_sched_barrier(0);
            pv(o, vp0 + slot * SLOTB, __builtin_bit_cast(bf16x8, pw0), __builtin_bit_cast(bf16x8, pw1), __builtin_bit_cast(bf16x8, pw2), __builtin_bit_cast(bf16x8, pw3));
        }
        asm volatile("s_waitcnt vmcnt(0) lgkmcnt(0)\n\ts_barrier" ::: "memory");
    }
    { auto rr = __builtin_amdgcn_permlane32_swap(__float_as_uint(l_reg), __float_as_uint(l_reg), false, false); l_reg = __uint_as_float(rr[0]) + __uint_as_float(rr[1]); }
    if (hi == 0) wsf[32 + r32] = l_reg;
    asm volatile("s_waitcnt lgkmcnt(0)" ::: "memory");
    float rli[16];
#pragma unroll
    for (int r = 0; r < 16; ++r) rli[r] = __builtin_amdgcn_rcpf(wsf[32 + crow(r, hi)]);
    unsigned char* Ow = (unsigned char*)O + qrow * 1024 + h * 64;
    { LAS unsigned char* stg = shm + LDS_OST + wid * 2048;
#pragma unroll
      for (int r = 0; r < 16; ++r) { const int orow = crow(r, hi);
#pragma unroll
          for (int d0 = 0; d0 < 2; ++d0) stg[orow * 64 + d0 * 32 + r32] = (unsigned char)f2f8(o[d0][r] * rli[r]); }
      asm volatile("s_waitcnt lgkmcnt(0)" ::: "memory");
#pragma unroll
      for (int i = 0; i < 2; ++i) { const int row = i * 16 + (lane >> 2), ch = lane & 3; const u32x4 v = *(const LAS u32x4*)(stg + row * 64 + ch * 16); *(GAS u32x4*)(Ow + (long)row * 1024 + ch * 16) = v; } }
    asm volatile("s_waitcnt lgkmcnt(0)" ::: "memory");
#undef TROW
#undef DMA_KV
}
}

struct Args {
    const float* in[20];
    float* out; unsigned char* ws;
};
struct Frame {
    LAS unsigned char* lds; unsigned* ctl; unsigned char* ws;
    int tid, lane, wave, gw;
    int blk;
    __device__ __forceinline__ void refresh() { tid = opaque_tid(); lane = tid & 63; wave = __builtin_amdgcn_readfirstlane(tid >> 6); gw = blk * 8 + wave;
        asm volatile("" : "+s"(ws)); ctl = (unsigned*)(ws + WS_CTL); }
};
constexpr int NGW = GRID * NWAVES;

struct Row { f32x4 v[4]; };
__device__ __forceinline__ int vq(int q, int lane) { return 64 * (lane >> 4) + 2 * (lane & 15) + 32 * (q >> 1) + (q & 1); }
__device__ __forceinline__ int vb(int j, int lane) { return 32 * (lane >> 4) + (lane & 15) + 16 * j; }
__device__ __forceinline__ void row_load_bf16(Row& r, const bf16_t* p, int lane) {
#pragma unroll
    for (int j = 0; j < 2; ++j) { const u32x4 w = ((const GAS u32x4*)p)[vb(j, lane)]; r.v[2 * j] = (f32x4){bflo(w.x), bfhi(w.x), bflo(w.y), bfhi(w.y)}; r.v[2 * j + 1] = (f32x4){bflo(w.z), bfhi(w.z), bflo(w.w), bfhi(w.w)}; } }
__device__ __forceinline__ void row_store_bf16(const Row& r, bf16_t* p, int lane) {
#pragma unroll
    for (int j = 0; j < 2; ++j) { u32x4 w; w.x = pk2(r.v[2 * j][0], r.v[2 * j][1]); w.y = pk2(r.v[2 * j][2], r.v[2 * j][3]); w.z = pk2(r.v[2 * j + 1][0], r.v[2 * j + 1][1]); w.w = pk2(r.v[2 * j + 1][2], r.v[2 * j + 1][3]); ((GAS u32x4*)p)[vb(j, lane)] = w; } }
typedef float f32x2v __attribute__((ext_vector_type(2)));
__device__ __forceinline__ void row_load_fp8(Row& r, const unsigned char* p, int lane) {
    const u32x4 w = ((const GAS u32x4*)p)[lane];
#pragma unroll
    for (int q = 0; q < 4; ++q) { const f32x2v lo = __builtin_amdgcn_cvt_pk_f32_fp8((int)w[q], false), hi = __builtin_amdgcn_cvt_pk_f32_fp8((int)w[q], true); r.v[q] = (f32x4){lo[0], lo[1], hi[0], hi[1]}; } }
__device__ __forceinline__ void row_store_fp8(const Row& r, unsigned char* p, int lane) {
    const int e0 = 256 * (lane >> 4) + 8 * (lane & 15);
#pragma unroll
    for (int j = 0; j < 2; ++j) { int w0 = 0, w1 = 0;
        w0 = __builtin_amdgcn_cvt_pk_fp8_f32(r.v[2 * j][0], r.v[2 * j][1], w0, false); w0 = __builtin_amdgcn_cvt_pk_fp8_f32(r.v[2 * j][2], r.v[2 * j][3], w0, true);
        w1 = __builtin_amdgcn_cvt_pk_fp8_f32(r.v[2 * j + 1][0], r.v[2 * j + 1][1], w1, false); w1 = __builtin_amdgcn_cvt_pk_fp8_f32(r.v[2 * j + 1][2], r.v[2 * j + 1][3], w1, true);
        u32x2 o; o.x = (unsigned)w0; o.y = (unsigned)w1; *(GAS u32x2*)(p + e0 + 128 * j) = o; } }
__device__ __forceinline__ void row_load_f32(Row& r, const float* p, int lane) {
#pragma unroll
    for (int q = 0; q < 4; ++q) r.v[q] = ((const GAS f32x4*)p)[vq(q, lane)]; }
__device__ __forceinline__ void row_store_f32(const Row& r, float* p, int lane) {
#pragma unroll
    for (int q = 0; q < 4; ++q) ((GAS f32x4*)p)[vq(q, lane)] = r.v[q]; }
__device__ __forceinline__ void row_normalize(Row& r, float eps) {
    float s = 0.f;
#pragma unroll
    for (int j = 0; j < 4; ++j) s += (r.v[j][0] + r.v[j][1]) + (r.v[j][2] + r.v[j][3]);
    const float mean = wave_sum(s) * (1.f / D); float q = 0.f;
#pragma unroll
    for (int j = 0; j < 4; ++j) { r.v[j] = r.v[j] - mean; q += (r.v[j][0] * r.v[j][0] + r.v[j][1] * r.v[j][1]) + (r.v[j][2] * r.v[j][2] + r.v[j][3] * r.v[j][3]); }
    const float rstd = 1.f / sqrtf(wave_sum(q) * (1.f / D) + eps);
#pragma unroll
    for (int j = 0; j < 4; ++j) r.v[j] = r.v[j] * rstd;
}
__device__ __forceinline__ void row_modulate(Row& r, const float* sh, const float* sc, int lane) {
    row_normalize(r, MOD_EPS);
#pragma unroll
    for (int j = 0; j < 4; ++j) { const f32x4 a = ((const GAS f32x4*)sc)[vq(j, lane)], b = ((const GAS f32x4*)sh)[vq(j, lane)]; r.v[j] = r.v[j] * (a + 1.f) + b; }
}
__device__ __forceinline__ int mod_row(int row) { return row < T ? (row >> 11) : 32; }
__device__ __forceinline__ const float* mod_vec(const unsigned char* ws, int layer, int mr, int chunk) { return (const float*)(ws + WS_MOD) + ((size_t)(layer * 33 + mr) * 6 + chunk) * 1024; }

__device__ __forceinline__ void conv_item(const float* W, int N, bf16_t* WT, int Kd, int kd0, int n0, int drow0, bool mirror, LAS float* scr, int lane) {
#pragma unroll 8
    for (int i = 0; i < 32; ++i) { const int kk = 2 * i + (lane >> 5); const int kd = kd0 + kk; const int ks = mirror ? ((kd & ~255) + ((256 - (kd & 255)) & 255)) : kd;
        scr[kk * 33 + (lane & 31)] = ((const GAS float*)W)[(size_t)ks * N + n0 + (lane & 31)]; }
    LDS_WAIT(); asm volatile("" ::: "memory");
    const int c = lane & 7;
#pragma unroll
    for (int j = 0; j < 4; ++j) { const int n = (lane >> 3) + 8 * j; const LAS float* s = scr + (8 * c) * 33 + n;
        u32x4 o; o.x = pk2(s[0 * 33], s[1 * 33]); o.y = pk2(s[2 * 33], s[3 * 33]); o.z = pk2(s[4 * 33], s[5 * 33]); o.w = pk2(s[6 * 33], s[7 * 33]);
        *(GAS u32x4*)(WT + (size_t)(drow0 + n) * Kd + kd0 + 8 * c) = o; }
    LDS_WAIT(); asm volatile("" ::: "memory");
}
__device__ __forceinline__ void conv_matrix_item(const float* W, int K, int N, bf16_t* WT, int mode, int roff, int item, LAS float* scr, int lane) {
    const int nblk = N / 32, kb = item / nblk, nb = item % nblk, n0 = 32 * nb;
    int drow0 = n0 + roff; if (mode == 1) drow0 = (n0 >> 7) * 256 + (n0 & 127); if (mode == 2) drow0 = (n0 >> 7) * 256 + 128 + (n0 & 127);
    conv_item(W, N, WT, K, 64 * kb, n0, drow0, mode == 3, scr, lane);
}
__device__ __forceinline__ void conv_item64(const float* W, int N, bf16_t* WT, int Kd, int k0, int n0, int drow0, LAS bf16_t* scr, int lane) {
    f32x4 v[16];
#pragma unroll
    for (int i = 0; i < 16; ++i) v[i] = *(const GAS f32x4*)(W + (size_t)(k0 + 4 * i + (lane >> 4)) * N + n0 + (lane & 15) * 4);
#pragma unroll
    for (int i = 0; i < 16; ++i) { u32x2 w; w.x = pk2(v[i][0], v[i][1]); w.y = pk2(v[i][2], v[i][3]); *(LAS u32x2*)(scr + (4 * i + (lane >> 4)) * 68 + (lane & 15) * 4) = w; }
    LDS_WAIT(); asm volatile("" ::: "memory");
    const int c = lane & 7;
#pragma unroll
    for (int j = 0; j < 8; ++j) { const int n = (lane >> 3) + 8 * j; const LAS bf16_t* p = scr + (8 * c) * 68 + n;
        u32x4 o; o.x = (unsigned)p[0] | ((unsigned)p[68] << 16); o.y = (unsigned)p[2 * 68] | ((unsigned)p[3 * 68] << 16); o.z = (unsigned)p[4 * 68] | ((unsigned)p[5 * 68] << 16); o.w = (unsigned)p[6 * 68] | ((unsigned)p[7 * 68] << 16);
        *(GAS u32x4*)(WT + (size_t)(drow0 + n) * Kd + k0 + 8 * c) = o; }
    LDS_WAIT(); asm volatile("" ::: "memory");
}
__device__ __forceinline__ void conv_item64_f8(const float* W, int N, unsigned char* WT, int Kd, int k0, int n0, int drow0, LAS unsigned char* scr, int lane, bool mirror = false) {
    f32x4 v[16];
#pragma unroll
    for (int i = 0; i < 16; ++i) { const int kd = k0 + 4 * i + (lane >> 4); const int ks = mirror ? ((kd & ~255) + ((256 - (kd & 255)) & 255)) : kd; v[i] = *(const GAS f32x4*)(W + (size_t)ks * N + n0 + (lane & 15) * 4); }
#pragma unroll
    for (int i = 0; i < 16; ++i) { int w = 0; w = __builtin_amdgcn_cvt_pk_fp8_f32(v[i][0] * 64.f, v[i][1] * 64.f, w, false); w = __builtin_amdgcn_cvt_pk_fp8_f32(v[i][2] * 64.f, v[i][3] * 64.f, w, true);
        *(LAS unsigned*)(scr + (4 * i + (lane >> 4)) * 68 + (lane & 15) * 4) = (unsigned)w; }
    LDS_WAIT(); asm volatile("" ::: "memory");
    const int c = lane & 3;
#pragma unroll
    for (int j = 0; j < 4; ++j) { const int n = (lane >> 2) + 16 * j; const LAS unsigned char* p = scr + (16 * c) * 68 + n; u32x4 o;
#pragma unroll
        for (int q = 0; q < 4; ++q) o[q] = (unsigned)p[(4 * q) * 68] | ((unsigned)p[(4 * q + 1) * 68] << 8) | ((unsigned)p[(4 * q + 2) * 68] << 16) | ((unsigned)p[(4 * q + 3) * 68] << 24);
        *(GAS u32x4*)(WT + (size_t)(drow0 + n) * Kd + k0 + 16 * c) = o; }
    LDS_WAIT(); asm volatile("" ::: "memory");
}
__device__ __forceinline__ void conv_experts(Frame& F, const Args& a, int layer) {
    F.refresh();
    LAS unsigned char* scr = F.lds + 32768 + F.wave * 4352;
    unsigned char* EGU = F.ws + WS_EGU; unsigned char* ED = F.ws + WS_ED;
    for (int it = F.gw; it < (NE + 1) * 192; it += NGW) { const int e = it / 192, r = it % 192;
        const float* wg = e < NE ? a.in[14] + ((size_t)layer * NE + e) * 262144 : a.in[17] + (size_t)layer * 262144;
        const float* wu = e < NE ? a.in[15] + ((size_t)layer * NE + e) * 262144 : a.in[18] + (size_t)layer * 262144;
        const float* wd = e < NE ? a.in[16] + ((size_t)layer * NE + e) * 262144 : a.in[19] + (size_t)layer * 262144;
        if (r < 128) { const int q = r & 63, kb = q >> 2, nb = q & 3, n0 = 64 * nb; const int drow0 = (n0 >> 7) * 256 + (r < 64 ? 0 : 128) + (n0 & 127);
            conv_item64_f8(r < 64 ? wg : wu, 256, EGU + (size_t)e * 512 * 1024, 1024, 64 * kb, n0, drow0, scr, F.lane); }
        else { const int q = r - 128, kb = q >> 4, nb = q & 15; conv_item64_f8(wd, 1024, ED + (size_t)e * 1024 * 256, 256, 64 * kb, 64 * nb, 64 * nb, scr, F.lane); } }
}
__device__ __forceinline__ void conv_small(Frame& F, const Args& a) {
    F.refresh();
    { LAS unsigned char* scr8 = F.lds + 32768 + F.wave * 4352;
      for (int it = F.gw; it < 2304; it += NGW) {
          if (it < 768) { const int j = it / 384, r = it % 384, kb = r / 24, nb = r % 24; conv_item64_f8(a.in[8] + (size_t)j * 1024 * 1536, 1536, F.ws + WS_WQKV + (size_t)j * 1536 * 1024, 1024, 64 * kb, 64 * nb, 64 * nb, scr8, F.lane); }
          else if (it < 1280) { const int q = it - 768, j = q >> 8, r = q & 255, kb = r >> 4, nb = r & 15; conv_item64_f8(a.in[9] + (size_t)j * 1024 * 1024, 1024, F.ws + WS_WO + (size_t)j * 1024 * 1024, 1024, 64 * kb, 64 * nb, 64 * nb, scr8, F.lane); }
          else { const int q = it - 1280, j = q >> 9, r = q & 511, mir = r >> 8, kb = (r & 255) >> 4, nb = r & 15;
              conv_item64_f8(a.in[11] + (size_t)j * 1024 * 1024, 1024, F.ws + WS_WSH + (size_t)j * 2048 * 1024, 1024, 64 * kb, 64 * nb, 64 * nb + 1024 * mir, scr8, F.lane, mir != 0); } } }
    __syncthreads();
    { LAS float* scr = (LAS float*)(F.lds + 32768 + F.wave * 8448);
      for (int it = F.gw; it < 1152; it += NGW) {
          if (it < 1024) { const int j = it >> 9, r = it & 511; conv_matrix_item(a.in[11] + (size_t)j * 1024 * 1024, 1024, 1024, (bf16_t*)(F.ws + WS_WF) + (size_t)j * 2048 * 1024, 0, 0, r, scr, F.lane); }
          else { const int q = it - 1024, l = q / 32, r = q % 32; conv_matrix_item(a.in[12] + (size_t)l * 1024 * 64, 1024, 64, (bf16_t*)(F.ws + WS_WR) + (size_t)l * 64 * 1024, 0, 0, r, scr, F.lane); } } }
    const int gt = F.blk * NTHR + F.tid, NGT = GRID * NTHR;
    const float TWO_PI = 6.283185307179586f;
    { float* rc = (float*)(F.ws + WS_ROPEC); float* rs = (float*)(F.ws + WS_ROPES);
      for (int i = gt; i < 64 * 16; i += NGT) { const int pos = i >> 4, fi = i & 15; const float inv = exp2f(-(float)fi * (13.287712379549449f / 16.f)); const float ang = (float)pos * inv; rc[i] = cosf(ang); rs[i] = sinf(ang); } }
    { unsigned* cs = (unsigned*)(F.ws + WS_CSN);
      for (int i = gt; i < 512 * 64; i += NGT) { const int r = i >> 6, n4 = (i & 63) * 4, m = r & 255; unsigned w = 0;
#pragma unroll
          for (int q = 0; q < 4; ++q) { const float ang = TWO_PI * (float)((m * (n4 + q)) & 255) * (1.f / 256.f); w |= f2f8(r < 256 ? __cosf(ang) : -__sinf(ang)) << (8 * q); }
          cs[i] = w; } }
    { unsigned* dl = (unsigned*)(F.ws + WS_DL);
      for (int i = gt; i < 1024 * 1024; i += NGT) { const int k = i >> 10, c4 = (i & 1023) * 4; unsigned w = 0;
#pragma unroll
          for (int q = 0; q < 4; ++q) { const int c = c4 + q, l = c & 2047; const float ang = TWO_PI * (float)((k * l) & 2047) * (1.f / 2048.f); w |= f2f8(c < 2048 ? __cosf(ang) : __sinf(ang)) << (8 * q); }
          dl[i] = w; } }
    { unsigned* dl = (unsigned*)(F.ws + WS_DLC);
      for (int i = gt; i < 256 * 128; i += NGT) { const int k = i >> 7, c4 = (i & 127) * 4; unsigned w = 0;
#pragma unroll
          for (int q = 0; q < 4; ++q) { const int c = c4 + q, l = c & 255; const float ang = TWO_PI * (float)((k * l) & 255) * (1.f / 256.f); w |= f2f8(c < 256 ? __cosf(ang) : __sinf(ang)) << (8 * q); }
          dl[i] = w; } }
}
__device__ __forceinline__ void mod_partials(Frame& F, const Args& a) {
    F.refresh();
    if (F.blk >= 192) return;
    const int l = F.blk / 48, cb = (F.blk % 48) / 4, kc = F.blk & 3;
    LAS float* s = (LAS float*)F.lds;
    for (int i = F.tid; i < 256 * 33; i += NTHR) { const int k = i / 33, r = i % 33; const float c = (r < 32) ? a.in[1][(size_t)r * 1024 + kc * 256 + k] : a.in[3][kc * 256 + k]; s[k * 36 + r] = c / (1.f + __expf(-c)); }
    __syncthreads();
    const int n = cb * 512 + F.tid;
    const GAS float* w = (const GAS float*)a.in[4] + ((size_t)l * 1024 + kc * 256) * 6144 + n;
    float acc[33];
#pragma unroll
    for (int r = 0; r < 33; ++r) acc[r] = 0.f;
#pragma unroll 4
    for (int k = 0; k < 256; ++k) { const float wv = w[(size_t)k * 6144];
#pragma unroll
        for (int r = 0; r < 33; ++r) acc[r] += s[k * 36 + r] * wv; }
    float* part = (float*)(F.ws + WS_MODP) + ((size_t)(kc * 4 + l) * 33) * 6144 + n;
#pragma unroll
    for (int r = 0; r < 33; ++r) part[(size_t)r * 6144] = acc[r];
    __syncthreads();
}
__device__ __forceinline__ void mod_finalize(Frame& F, const Args& a) {
    F.refresh();
    const int gt = F.blk * NTHR + F.tid, NGT = GRID * NTHR; const float* part = (const float*)(F.ws + WS_MODP); float* mod = (float*)(F.ws + WS_MOD);
    for (int i = gt; i < 4 * 33 * 6144; i += NGT) { const int l = i / (33 * 6144), n = i % 6144; float v = a.in[5][l * 6144 + n];
#pragma unroll
        for (int kc = 0; kc < 4; ++kc) v += part[(size_t)kc * 4 * 33 * 6144 + i]; mod[i] = v; }
}
__device__ __forceinline__ void rows_init(Frame& F, const Args& a) {
    F.refresh();
    bf16_t* XS = (bf16_t*)(F.ws + WS_XS); bf16_t* U = (bf16_t*)a.out; const float* part = (const float*)(F.ws + WS_MODP);
    for (int row = F.gw; row < TT; row += NGW) {
        Row r; row_load_f32(r, row < T ? a.in[0] + (size_t)row * D : a.in[2] + (size_t)(row - T) * D, F.lane);
        row_store_bf16(r, XS + (size_t)row * D, F.lane);
        row_normalize(r, MOD_EPS); const int mr = mod_row(row);
#pragma unroll
        for (int j = 0; j < 4; ++j) { const int e = vq(j, F.lane);
            f32x4 sh = ((const GAS f32x4*)(a.in[5]))[e], sc = ((const GAS f32x4*)(a.in[5] + 1024))[e];
#pragma unroll
            for (int kc = 0; kc < 4; ++kc) { const float* pp = part + ((size_t)(kc * 4 + 0) * 33 + mr) * 6144; sh += ((const GAS f32x4*)pp)[e]; sc += ((const GAS f32x4*)(pp + 1024))[e]; }
            r.v[j] = r.v[j] * (sc + 1.f) + sh; }
        row_store_fp8(r, (unsigned char*)a.out + OUT_U8 + (size_t)row * D, F.lane);
    }
}
__device__ __forceinline__ void rows_post1(Frame& F, const Args& a, int layer, int nrows) {
    F.refresh();
    bf16_t* XS = (bf16_t*)(F.ws + WS_XS); bf16_t* U = (bf16_t*)a.out;
    const float* lg = a.in[6] + (size_t)(layer * 2 + 0) * D; const float* lb = a.in[7] + (size_t)(layer * 2 + 0) * D;
    const int TPB = nrows / GRID;
    for (int rl = F.wave; rl < TPB; rl += 2 * NWAVES) {
        const bool two = rl + NWAVES < TPB;
        Row x[2], y[2];
#pragma unroll
        for (int t = 0; t < 2; ++t) if (t == 0 || two) { const int row = F.blk * TPB + rl + t * NWAVES; row_load_bf16(x[t], XS + (size_t)row * D, F.lane); row_load_bf16(y[t], U + (size_t)row * D, F.lane); }
#pragma unroll
        for (int t = 0; t < 2; ++t) if (t == 0 || two) { const int row = F.blk * TPB + rl + t * NWAVES; const int mr = mod_row(row);
            const float* g1 = mod_vec(F.ws, layer, mr, 2);
#pragma unroll
            for (int j = 0; j < 4; ++j) x[t].v[j] = x[t].v[j] * ALPHA + ((const GAS f32x4*)g1)[vq(j, F.lane)] * y[t].v[j];
            row_normalize(x[t], LN_EPS);
#pragma unroll
            for (int j = 0; j < 4; ++j) x[t].v[j] = x[t].v[j] * ((const GAS f32x4*)lg)[vq(j, F.lane)] + ((const GAS f32x4*)lb)[vq(j, F.lane)];
            row_store_bf16(x[t], XS + (size_t)row * D, F.lane);
            row_modulate(x[t], mod_vec(F.ws, layer, mr, 3), mod_vec(F.ws, layer, mr, 4), F.lane);
            row_store_bf16(x[t], U + (size_t)row * D, F.lane);
            row_store_fp8(x[t], (unsigned char*)a.out + OUT_U8 + (size_t)row * D, F.lane); }
    }
}
__device__ __forceinline__ void rows_post2(Frame& F, const Args& a, int layer, int t0, int n) {
    F.refresh();
    bf16_t* XS = (bf16_t*)(F.ws + WS_XS); const unsigned char* YB = (const unsigned char*)(F.ws + WS_YB); const unsigned char* YS = (const unsigned char*)(F.ws + WS_YS);
    const int* spos = (const int*)(F.ws + WS_SDST); const float* tkw = (const float*)(F.ws + WS_TKW);
    const float* lg = a.in[6] + (size_t)(layer * 2 + 1) * D; const float* lb = a.in[7] + (size_t)(layer * 2 + 1) * D;
    for (int i0 = F.gw; i0 < n; i0 += 2 * NGW) {
        const int i1 = i0 + NGW; const bool two = i1 < n;
        int pj[2]; float wj[2];
#pragma unroll
        for (int t = 0; t < 2; ++t) { pj[t] = 0; wj[t] = 0.f; const int row = t0 + (t ? i1 : i0); if ((t == 0 || two) && F.lane < 8) { pj[t] = ((const GAS int*)spos)[(size_t)row * 8 + F.lane]; wj[t] = ((const GAS float*)tkw)[(size_t)row * 8 + F.lane]; } }
        Row x[2], y[2];
#pragma unroll
        for (int t = 0; t < 2; ++t) { const int i = t ? i1 : i0; if (t == 0 || two) { row_load_bf16(x[t], XS + (size_t)(t0 + i) * D, F.lane); row_load_fp8(y[t], YS + (size_t)i * D, F.lane); } }
        u32x4 zr[2][8];
#pragma unroll
        for (int t = 0; t < 2; ++t) if (t == 0 || two) {
#pragma unroll
            for (int s = 0; s < 8; ++s) { const int ps = __builtin_amdgcn_readlane(pj[t], s); zr[t][s] = ((const GAS u32x4*)(YB + (size_t)ps * D))[F.lane]; } }
#pragma unroll
        for (int t = 0; t < 2; ++t) if (t == 0 || two) { const int i = t ? i1 : i0; const int row = t0 + i; const int mr = mod_row(row);
#pragma unroll
            for (int j = 0; j < 4; ++j) y[t].v[j] = y[t].v[j] * (1.f / 16.f);
#pragma unroll
            for (int s = 0; s < 8; ++s) { const float wz = __builtin_bit_cast(float, __builtin_amdgcn_readlane(__builtin_bit_cast(int, wj[t]), s)) * (1.f / 16.f);
#pragma unroll
                for (int j = 0; j < 4; ++j) { const f32x2v lo = __builtin_amdgcn_cvt_pk_f32_fp8((int)zr[t][s][j], false), hi = __builtin_amdgcn_cvt_pk_f32_fp8((int)zr[t][s][j], true); y[t].v[j] += (f32x4){lo[0], lo[1], hi[0], hi[1]} * wz; } }
            const float* g2 = mod_vec(F.ws, layer, mr, 5);
#pragma unroll
            for (int j = 0; j < 4; ++j) x[t].v[j] = x[t].v[j] * ALPHA + ((const GAS f32x4*)g2)[vq(j, F.lane)] * y[t].v[j];
            row_normalize(x[t], LN_EPS);
#pragma unroll
            for (int j = 0; j < 4; ++j) x[t].v[j] = x[t].v[j] * ((const GAS f32x4*)lg)[vq(j, F.lane)] + ((const GAS f32x4*)lb)[vq(j, F.lane)];
            if (layer == 3) { row_store_f32(x[t], a.out + (size_t)row * D, F.lane); }
            else { row_store_bf16(x[t], XS + (size_t)row * D, F.lane);
                row_modulate(x[t], mod_vec(F.ws, layer + 1, mr, 0), mod_vec(F.ws, layer + 1, mr, 1), F.lane);
                row_store_fp8(x[t], (unsigned char*)a.out + OUT_U8 + (size_t)row * D, F.lane); } }
    }
}
__device__ __forceinline__ float wave_max_dpp(float v) {
    int x = __builtin_bit_cast(int, v);
#define DPPMAX(ctrl) { const int y = __builtin_amdgcn_update_dpp(x, x, ctrl, 0xf, 0xf, false); x = __builtin_bit_cast(int, fmaxf(__builtin_bit_cast(float, x), __builtin_bit_cast(float, y))); }
    DPPMAX(0xB1) DPPMAX(0x4E) DPPMAX(0x141) DPPMAX(0x140)
#undef DPPMAX
    const float r0 = __builtin_bit_cast(float, __builtin_amdgcn_readlane(x, 0)), r1 = __builtin_bit_cast(float, __builtin_amdgcn_readlane(x, 16));
    const float r2 = __builtin_bit_cast(float, __builtin_amdgcn_readlane(x, 32)), r3 = __builtin_bit_cast(float, __builtin_amdgcn_readlane(x, 48));
    return fmaxf(fmaxf(r0, r1), fmaxf(r2, r3));
}
__device__ __forceinline__ void route_tokens(Frame& F, const Args& a, int layer, int ntok) {
    F.refresh();
    const int TPB = ntok / GRID;
    const bf16_t* U = (const bf16_t*)a.out; const bf16_t* Wr = (const bf16_t*)(F.ws + WS_WR) + (size_t)layer * 64 * 1024;
    int* tke = (int*)(F.ws + WS_TKE); float* tkw = (float*)(F.ws + WS_TKW);
    LAS int* lcnt = (LAS int*)(F.lds + L_LCNT);
    LAS float* sc = (LAS float*)(F.lds) + F.wave * 1024;
    if (F.tid < 64) lcnt[F.tid] = 0;
    __syncthreads();
    const int lane = F.lane, fr = lane & 15, fq = lane >> 4;
    const float bias = a.in[13][layer * 64 + lane];
    const int ntile = TPB / 16;
    for (int tl = F.wave; tl < ntile; tl += NWAVES) {
        const int t0 = F.blk * TPB + tl * 16;
        f32x4 acc[4];
#pragma unroll
        for (int n = 0; n < 4; ++n) acc[n] = (f32x4){0.f, 0.f, 0.f, 0.f};
        const GAS bf16x8* ap = (const GAS bf16x8*)(U + (size_t)(t0 + fr) * D + fq * 8);
        const GAS bf16x8* bp = (const GAS bf16x8*)(Wr + (size_t)fr * D + fq * 8);
#pragma unroll 4
        for (int ks = 0; ks < 32; ++ks) { const bf16x8 av = ap[ks * 4];
#pragma unroll
            for (int n = 0; n < 4; ++n) { const bf16x8 bv = bp[(size_t)n * 16 * (D / 8) + ks * 4]; acc[n] = __builtin_amdgcn_mfma_f32_16x16x32_bf16(av, bv, acc[n], 0, 0, 0); } }
#pragma unroll
        for (int n = 0; n < 4; ++n)
#pragma unroll
            for (int j = 0; j < 4; ++j) sc[(fq * 4 + j) * 64 + n * 16 + fr] = acc[n][j];
        LDS_WAIT();
        for (int tk = 0; tk < 16; ++tk) {
            const float logit = sc[tk * 64 + lane];
            const float s = 1.f / (1.f + __expf(-logit));
            const float sel = s + bias;
            const int g = lane >> 3;
            float m1 = sel; m1 = fmaxf(m1, __shfl_xor(m1, 1)); m1 = fmaxf(m1, __shfl_xor(m1, 2)); m1 = fmaxf(m1, __shfl_xor(m1, 4));
            const unsigned long long bm = __ballot(sel == m1);
            const unsigned gm = (unsigned)(bm >> (g * 8)) & 0xffu;
            const int first = g * 8 + __builtin_ctz(gm);
            float m2 = (lane == first) ? -INFINITY : sel; m2 = fmaxf(m2, __shfl_xor(m2, 1)); m2 = fmaxf(m2, __shfl_xor(m2, 2)); m2 = fmaxf(m2, __shfl_xor(m2, 4));
            const float gs = m1 + m2;
            float curg = gs; bool gok = false;
#pragma unroll 1
            for (int it = 0; it < 4; ++it) { const float mx = wave_max_dpp(curg);
                const unsigned long long bb = __ballot(curg == mx); const int gi = (int)(__builtin_ctzll(bb) >> 3);
                if (g == gi) { gok = true; curg = -INFINITY; } }
            float cure = gok ? sel : -INFINITY; bool chosen = false; int rk = 0;
#pragma unroll 1
            for (int it = 0; it < 8; ++it) { const float mx = wave_max_dpp(cure);
                const unsigned long long bb = __ballot(cure == mx); const int ei = (int)__builtin_ctzll(bb);
                if (lane == ei) { chosen = true; rk = it; cure = -INFINITY; } }
            const float tot = wave_sum(chosen ? s : 0.f);
            if (chosen) { const int tok = t0 + tk; tke[(size_t)tok * 8 + rk] = lane; tkw[(size_t)tok * 8 + rk] = s / tot * 2.5f; __hip_atomic_fetch_add(&lcnt[lane], 1, __ATOMIC_RELAXED, __HIP_MEMORY_SCOPE_WORKGROUP); }
        }
        LDS_WAIT();
    }
    __syncthreads();
    if (F.tid < 64) F.ctl[CW_BCNT + F.blk * 64 + F.tid] = (unsigned)lcnt[F.tid];
}
__device__ __forceinline__ void build_lists(Frame& F, int ntok) {
    F.refresh();
    constexpr int NSEG = NCHUNK * 64, BPC = GRID / NCHUNK;
    const int TPB = ntok / GRID, CH = ntok / NCHUNK;
    LAS int* tstart = (LAS int*)(F.lds + L_TSTART); LAS int* pref = (LAS int*)(F.lds + L_PREF); LAS int* lcnt = (LAS int*)(F.lds + L_LCNT);
    LAS unsigned char* tseg = (LAS unsigned char*)(F.lds + L_TSEG); LAS int* scan = (LAS int*)(F.lds + L_SCAN);
    const unsigned* bcnt = F.ctl + CW_BCNT;
    const int myc = F.blk / BPC, mylb = F.blk % BPC;
    int nseg = 0;
    LAS int* cntl = (LAS int*)F.lds;
    for (int i = F.tid; i < GRID * 64; i += NTHR) cntl[i] = (int)((const GAS unsigned*)bcnt)[i];
    if (F.tid < 64) lcnt[F.tid] = 0;
    __syncthreads();
    if (F.tid < NSEG) { const int c = F.tid >> 6, e = F.tid & 63; int n = 0, p = 0;
        for (int lb = 0; lb < BPC; ++lb) { const int v = cntl[(c * BPC + lb) * 64 + e]; if (c == myc && lb < mylb) p += v; n += v; }
        nseg = n; scan[F.tid] = (n + 255) >> 8; if (c == myc) pref[e] = p; }
    __syncthreads();
    if (F.tid == 0) { int acc = 0; for (int s = 0; s < NSEG; ++s) { tstart[s] = acc; acc += scan[s]; } tstart[NSEG] = acc; }
    __syncthreads();
    if (F.tid < NSEG) { const int t0 = tstart[F.tid], t1 = tstart[F.tid + 1]; for (int t = t0; t < t1; ++t) tseg[t] = (unsigned char)F.tid; }
    int* stok = (int*)(F.ws + WS_STOK); int* spos = (int*)(F.ws + WS_SDST);
    const int* tke = (const int*)(F.ws + WS_TKE);
    { const int sseg = myc * 64 + mylb; if (mylb < 64 && F.tid == sseg) scan[0] = nseg; }
    __syncthreads();
    if (mylb < 64) { const int sseg = myc * 64 + mylb; const int n = scan[0]; const int base = tstart[sseg] * 256, end = tstart[sseg + 1] * 256;
      for (int p = base + n + F.tid; p < end; p += NTHR) stok[p] = myc * CH; }
    for (int tl = F.wave; tl < TPB; tl += NWAVES) { const int tok = F.blk * TPB + tl;
        if (F.lane < 8) { const int e = tke[(size_t)tok * 8 + F.lane];
            const int p = tstart[myc * 64 + e] * 256 + pref[e] + __hip_atomic_fetch_add(&lcnt[e], 1, __ATOMIC_RELAXED, __HIP_MEMORY_SCOPE_WORKGROUP);
            stok[p] = tok; spos[(size_t)tok * 8 + F.lane] = p - tstart[myc * 64] * 256; } }
    __syncthreads();
}

struct SchedQKV {
    const char* U; const char* W; int nfull, nu, c;
    __device__ __forceinline__ bool next(int i, pg::Unit& u) const {
        const int L0 = i * GRID + c; if (L0 >= nu) return false;
        int pm, pn;
        if (L0 < nfull) { const int L = pg::xcd_remap(L0, nfull); const int gid = L / 48, w = L % 48; pm = gid * 8 + (w & 7); pn = w >> 3; }
        else { const int q = L0 - nfull; pm = 256 + (q >> 1); pn = 4 + (q & 1); }
        u.A = U + (size_t)pm * 256 * 1024; u.B = W + (size_t)pn * 256 * 1024; u.gidx = nullptr; u.gbase = 0; u.nt = 8; u.out = nullptr; u.ldc = 0; u.scale = 1.f; u.flags = 0; u.i0 = pm; u.i1 = pn;
        return true; }
};
struct SchedDense {
    const char* A; const char* W; char* out; int nrt, nct, nt, c; size_t ldA;
    __device__ __forceinline__ bool next(int i, pg::Unit& u) const {
        const int nu = nrt * nct; const int L0 = i * GRID + c; if (L0 >= nu) return false;
        const int L = pg::xcd_remap(L0, nu); const int per = 8 * nct, gid = L / per, w = L % per, fm = gid * 8, gsz = (nrt - fm) < 8 ? (nrt - fm) : 8; const int pm = fm + (w % gsz), pn = w / gsz;
        u.A = A + (size_t)pm * 256 * ldA; u.B = W + (size_t)pn * 256 * ldA; u.gidx = nullptr; u.gbase = 0; u.nt = nt; u.out = out + (size_t)pm * 256 * 2048 + pn * 512; u.ldc = 2048; u.scale = 1.f; u.flags = 0; u.i0 = pm; u.i1 = pn;
        return true; }
};
struct SchedF1 {
    const char* CS; const char* U; char* ABT; char* ABTC; int nu, c;
    __device__ __forceinline__ bool next(int i, pg::Unit& u) const {
        const int L0 = i * GRID + c; if (L0 >= nu) return false;
        u.gidx = nullptr; u.gbase = 0; u.nt = 2; u.scale = 1.f; u.flags = 0; u.i0 = 0; u.i1 = 0;
        if (L0 < 2048) { const int L = pg::xcd_remap(L0, 2048); const int pm = L & 1, pn = (L >> 1) & 7, bg = L >> 4, b = bg >> 2, g = bg & 3;
            u.A = CS + (size_t)pm * 256 * 256; u.B = U + ((size_t)b * SEQ + pn * 256) * 1024 + g * 256; u.out = ABT + (size_t)bg * 256 * 4096 + (size_t)(pm * 2048 + pn * 256); u.ldc = 4096; }
        else { const int q = L0 - 2048; const int pm = q & 1, bg = q >> 1, b = bg >> 2, g = bg & 3;
            u.A = CS + (size_t)pm * 256 * 256; u.B = U + ((size_t)T + b * CTXL) * 1024 + g * 256; u.out = ABTC + (size_t)bg * 256 * 512 + (size_t)pm * 256; u.ldc = 512; }
        return true; }
};
struct SchedF2 {
    const char* DL; const char* ABT; char* FH; int c;
    __device__ __forceinline__ bool next(int i, pg::Unit& u) const {
        const int L0 = i * GRID + c; if (L0 >= 512) return false;
        const int L = pg::xcd_remap(L0, 512); const int pm = L & 3, bg = L >> 2, b = bg >> 2, g = bg & 3;
        u.A = DL + (size_t)pm * 256 * 4096; u.B = ABT + (size_t)bg * 256 * 4096; u.gidx = nullptr; u.gbase = 0; u.nt = 32; u.out = FH + ((size_t)b * 1024 + pm * 256) * 1024 + g * 256; u.ldc = 1024; u.scale = 0.001381067932004975f  ; u.flags = 0; u.i0 = 0; u.i1 = 0;
        return true; }
};
struct SchedF2c {
    const char* DLC; const char* ABTC; char* FC; int c;
    __device__ __forceinline__ bool next(int i, pg::Unit& u) const {
        const int L0 = i * GRID + c; if (L0 >= 128) return false;
        const int bg = L0, b = bg >> 2, g = bg & 3;
        u.A = DLC; u.B = ABTC + (size_t)bg * 256 * 512; u.gidx = nullptr; u.gbase = 0; u.nt = 4; u.out = FC + ((size_t)b * 256) * 1024 + g * 256; u.ldc = 1024; u.scale = 1.f / 256.f; u.flags = 0; u.i0 = 0; u.i1 = 0;
        return true; }
};
struct SchedF3 {
    const char* FH; const char* FC; const char* W; char* Y; int nu, c;
    __device__ __forceinline__ bool next(int i, pg::Unit& u) const {
        const int L0 = i * GRID + c; if (L0 >= nu) return false;
        u.gidx = nullptr; u.gbase = 0; u.nt = 8; u.scale = 1.f; u.flags = 0; u.i0 = 0; u.i1 = 0;
        if (L0 < 1024) { const int L = pg::xcd_remap(L0, 1024); const int gid = L >> 6, w = L & 63, pm = gid * 8 + (w & 7), pn = w >> 3; const int b = pm >> 2, k0 = (pm & 3) * 256;
            u.A = FH + (size_t)pm * 256 * 1024; u.B = W + (size_t)pn * 256 * 1024;
            if (pn < 4) { u.out = Y + ((size_t)b * SEQ + k0) * 2048 + pn * 512; u.ldc = 2048; }
            else { u.out = Y + ((size_t)b * SEQ + SEQ - k0) * 2048 + (pn - 4) * 512; u.ldc = -2048; u.flags = (k0 == 0) ? 1 : 0; } }
        else { const int q = L0 - 1024; const int pm = q >> 2, pn = q & 3;
            u.A = FC + (size_t)pm * 256 * 1024; u.B = W + (size_t)pn * 256 * 1024; u.out = Y + ((size_t)T + pm * 256) * 2048 + pn * 512; u.ldc = 2048; }
        return true; }
};
struct SchedG1 {
    const char* EGU; const int* STOK; char* H; char* HS; LAS const unsigned char* tseg; int ntl, nsh, c;
    __device__ __forceinline__ bool gsrc(int i, const int*& gidx, int& gbase) const {
        const int nu = (ntl + nsh) * 2; const int L0 = i * GRID + c; if (L0 >= nu) return false;
        const int pm = pg::xcd_remap(L0, nu) >> 1;
        if (pm < ntl) { gidx = STOK + (size_t)pm * 256; gbase = 0; } else { gidx = nullptr; gbase = (pm - ntl) * 256; }
        return true; }
    __device__ __forceinline__ bool next(int i, pg::Unit& u) const {
        const int nu = (ntl + nsh) * 2; const int L0 = i * GRID + c; if (L0 >= nu) return false;
        const int L = pg::xcd_remap(L0, nu); const int pm = L >> 1, pn = L & 1;
        u.A = nullptr; u.gbase = 0; u.nt = 8; u.ldc = 256; u.scale = 1.f; u.flags = 0; u.i0 = 0; u.i1 = 0;
        if (pm < ntl) { const int e = __builtin_amdgcn_readfirstlane((int)tseg[pm]) & 63;
            u.gidx = STOK + (size_t)pm * 256; u.B = EGU + (size_t)e * 512 * 1024 + (size_t)pn * 256 * 1024; u.out = H + (size_t)pm * 256 * 256 + pn * 128; }
        else { const int ps = pm - ntl; u.gidx = nullptr; u.gbase = ps * 256; u.B = EGU + (size_t)NE * 512 * 1024 + (size_t)pn * 256 * 1024; u.out = HS + (size_t)ps * 256 * 256 + pn * 128; }
        return true; }
};
struct SchedG2 {
    const char* ED; const char* H; const char* HS; char* YB; char* YS; LAS const unsigned char* tseg; int t0, t1, nsh, ch, CH, c;
    __device__ __forceinline__ bool next(int i, pg::Unit& u) const {
        const int nr = t1 - t0; const int nu = (nr + nsh) * 4; const int L0 = i * GRID + c; if (L0 >= nu) return false;
        const int L = pg::xcd_remap(L0, nu); const int q = L >> 2, pn = L & 3;
        u.gidx = nullptr; u.gbase = 0; u.nt = 2; u.ldc = 1024; u.scale = 1.f; u.flags = 0; u.i0 = 0; u.i1 = pn;
        if (q < nr) { const int pm = t0 + q; const int e = __builtin_amdgcn_readfirstlane((int)tseg[pm]) & 63;
            u.A = H + (size_t)pm * 256 * 256; u.B = ED + (size_t)e * 1024 * 256 + (size_t)pn * 256 * 256; u.out = YB + (size_t)q * 256 * 1024; }
        else { const int ps = q - nr; u.A = HS + ((size_t)ch * CH + ps * 256) * 256; u.B = ED + (size_t)NE * 1024 * 256 + (size_t)pn * 256 * 256; u.out = YS + (size_t)ps * 256 * 1024; }
        return true; }
};

__device__ __forceinline__ void fnet_nyquist_rows(Frame& F) {
    F.refresh();
    const unsigned char* ABT = F.ws + WS_ABT; bf16_t* FH1 = (bf16_t*)(F.ws + WS_FH1);
    for (int r = F.gw; r < 128 * 256; r += NGW) { const int bg = r >> 8, m = r & 255, b = bg >> 2, g = bg & 3;
        const GAS u32x4* p = (const GAS u32x4*)(ABT + (size_t)r * 4096); float s = 0.f;
#pragma unroll
        for (int i = 0; i < 2; ++i) { const u32x4 w = p[i * 64 + F.lane];
#pragma unroll
            for (int q = 0; q < 4; ++q) { const f32x2v lo = __builtin_amdgcn_cvt_pk_f32_fp8((int)w[q], false), hi = __builtin_amdgcn_cvt_pk_f32_fp8((int)w[q], true); s += (lo[0] - lo[1]) + (hi[0] - hi[1]); } }
        s = wave_sum(s) * 0.001381067932004975f;
        if (F.lane == 0) FH1[(size_t)b * 1024 + g * 256 + m] = (bf16_t)f2bf(s); }
}
__device__ __forceinline__ void fnet_nyquist_out(Frame& F, const Args& a, int jl) {
    F.refresh();
    const bf16_t* FH1 = (const bf16_t*)(F.ws + WS_FH1); const bf16_t* W = (const bf16_t*)(F.ws + WS_WF) + (size_t)jl * 2048 * 1024; bf16_t* Y = (bf16_t*)a.out;
    LAS float* part = (LAS float*)F.lds;
    const int b = F.blk >> 3, n = (F.blk & 7) * 128 + (F.tid & 127), kq = F.tid >> 7;
    const GAS u32x4* wp = (const GAS u32x4*)(W + (size_t)n * 1024 + kq * 256); const GAS u32x4* fp = (const GAS u32x4*)(FH1 + (size_t)b * 1024 + kq * 256);
    float s = 0.f;
#pragma unroll 4
    for (int i = 0; i < 32; ++i) { const u32x4 w = wp[i], f = fp[i];
        s += bflo(w.x) * bflo(f.x) + bfhi(w.x) * bfhi(f.x) + bflo(w.y) * bflo(f.y) + bfhi(w.y) * bfhi(f.y) + bflo(w.z) * bflo(f.z) + bfhi(w.z) * bfhi(f.z) + bflo(w.w) * bflo(f.w) + bfhi(w.w) * bfhi(f.w); }
    part[F.tid] = s;
    __syncthreads();
    if (F.tid < 128) { const float t = (part[F.tid] + part[F.tid + 128]) + (part[F.tid + 256] + part[F.tid + 384]); Y[((size_t)b * SEQ + 1024) * D + n] = (bf16_t)f2bf(t); }
    __syncthreads();
}


#ifdef SELFCHECK
constexpr int CW_ERR = 1024;
__device__ __forceinline__ void chk_report(unsigned* ctl, int id, float got, float ref, float tabs, float trel) {
    float e = fabsf(got - ref) / (tabs + trel * fabsf(ref)); if (!(e == e)) e = 1e30f; atomicMax(ctl + CW_ERR + id, __float_as_uint(e)); }
__device__ __forceinline__ float bf2f(bf16_t b) { return __builtin_bit_cast(float, (unsigned)b << 16); }
__constant__ int chk_toks[16] = {0, 1, 63, 64, 65, 127, 2047, 2048, 2049, 4096, 33000, 65535, 65536, 65537, 70000, 73727};
__constant__ int chk_ks[8] = {0, 1, 2, 255, 256, 1023, 1024, 700};
__constant__ int chk_ms[4] = {0, 1, 128, 255};
__constant__ int chk_ytoks[10] = {0, 1, 1023, 1024, 1025, 2047, 2048, 65535, 65536, 73727};
__constant__ int chk_ns[5] = {0, 1, 255, 256, 1023};
__constant__ int chk_cols[20] = {0, 7, 15, 16, 31, 32, 40, 48, 63, 64, 500, 1023, 1024, 1039, 1040, 1072, 1279, 1280, 1300, 1535};
__device__ __forceinline__ void chk_qkv(Frame& F, const Args& a, int layer, int id) {
    F.refresh(); const unsigned char* U = (const unsigned char*)a.out + OUT_U8; const float* W = a.in[8] + (size_t)(layer >> 1) * 1024 * 1536;
    const bf16_t* Qb = (const bf16_t*)(F.ws + WS_Q); const bf16_t* Kb = (const bf16_t*)(F.ws + WS_K); const bf16_t* Vb = (const bf16_t*)(F.ws + WS_V);
    for (int s = F.gw; s < 320; s += NGW) { const int tok = chk_toks[s & 15], col = chk_cols[s >> 4];
        if (layer == 2 && tok >= T && col < 1024) continue;
        const bool rope = (tok < T) && col < 1280; const int hc = col & 63, first = (hc & 31) < 16; const int pcol = rope ? (first ? col + 16 : col - 16) : col;
        float x = 0.f, xp = 0.f;
        for (int k = F.lane; k < 1024; k += 64) { const float u = f82f(U[(size_t)tok * D + k]); x += u * W[(size_t)k * 1536 + col]; xp += u * W[(size_t)k * 1536 + pcol]; }
        x = wave_sum(x); xp = wave_sum(xp);
        float ref = x;
        if (rope) { const int tl = tok & 2047, part = hc >> 5, pos = part ? (tl & 63) : (tl >> 6), fi = hc & 15; const float ang = (float)pos * powf(10000.f, -(float)fi / 16.f);
            ref = x * cosf(ang) + (first ? -xp : xp) * sinf(ang); }
        if (col < 1024) ref *= C2;
        const float got = col < 1024 ? bf2f(Qb[(size_t)tok * 1024 + col]) : (col < 1280 ? bf2f(Kb[(size_t)tok * 256 + col - 1024]) : bf2f(Vb[(size_t)tok * 256 + col - 1280]));
        if (F.lane == 0) chk_report(F.ctl, id, got, ref, 0.20f, 0.10f); }
}
__device__ __forceinline__ void chk_attn(Frame& F, const Args& a, int layer, int id) {
    F.refresh(); const bf16_t* Qb = (const bf16_t*)(F.ws + WS_Q); const bf16_t* Kb = (const bf16_t*)(F.ws + WS_K); const bf16_t* Vb = (const bf16_t*)(F.ws + WS_V); const unsigned char* Ob = F.ws + WS_R + 216 * MiB;
    LAS float* lg = (LAS float*)F.lds + F.wave * 1024;
    for (int s = F.gw; s < 64; s += NGW) { const int tok = chk_toks[s & 15], h = (s >> 4) * 5, kvh = h >> 2;
        if (layer == 2 && tok >= T) continue;
        const bool isctx = tok >= T; const int b = isctx ? (tok - T) / CTXL : tok / SEQ, p = tok & (SEQ - 1);
        int nk = 0; const int lo = isctx ? 0 : (p - 128 < 0 ? 0 : p - 128), hi = isctx ? -1 : (p + 128 > SEQ - 1 ? SEQ - 1 : p + 128);
        const int nlat = isctx ? 0 : hi - lo + 1; nk = nlat + CTXL;
        float mx = a.in[10][(layer >> 1) * 16 + h] * LOG2E; const float sink2 = mx;
        for (int i = F.lane; i < nk; i += 64) { const size_t kr = i < nlat ? (size_t)b * SEQ + lo + i : (size_t)T + b * CTXL + (i - nlat); float d = 0.f;
            for (int e = 0; e < 64; ++e) d += bf2f(Qb[(size_t)tok * 1024 + h * 64 + e]) * bf2f(Kb[kr * 256 + kvh * 64 + e]);
            lg[i] = d; mx = fmaxf(mx, d); }
#pragma unroll
        for (int o = 1; o < 64; o <<= 1) mx = fmaxf(mx, __shfl_xor(mx, o));
        LDS_WAIT();
        float den = 0.f; for (int i = F.lane; i < nk; i += 64) den += exp2f(lg[i] - mx);
        den = wave_sum(den) + exp2f(sink2 - mx);
        float o = 0.f;
        for (int i = 0; i < nk; ++i) { const size_t kr = i < nlat ? (size_t)b * SEQ + lo + i : (size_t)T + b * CTXL + (i - nlat); o += exp2f(lg[i] - mx) * bf2f(Vb[kr * 256 + kvh * 64 + F.lane]); }
        o /= den;
        chk_report(F.ctl, id, f82f(Ob[(size_t)tok * 1024 + h * 64 + F.lane]), o, 0.02f, 0.08f); chk_report(F.ctl, 32 + (s & 15), f82f(Ob[(size_t)tok * 1024 + h * 64 + F.lane]), o, 0.02f, 0.08f);
        LDS_WAIT(); }
    __syncthreads();
}
__device__ __forceinline__ void chk_fnet_f(Frame& F, const Args& a, bool upd, int id) {
    F.refresh(); const unsigned char* U = (const unsigned char*)a.out + OUT_U8; LAS float* red = (LAS float*)F.lds;
    for (int s = F.blk; s < 128 + (upd ? 64 : 0); s += GRID) {
        const bool cx = s >= 128; const int q = cx ? s - 128 : s; const int m = chk_ms[q & 3], g = ((q >> 2) & 1) * 3, b = ((q >> 3) & 1) * 31; int k = chk_ks[(q >> 4) & 7]; const int L = cx ? CTXL : SEQ; if (cx) k &= 255;
        const size_t row0 = cx ? (size_t)T + b * CTXL : (size_t)b * SEQ;
        float acc = 0.f;
        for (int l = F.wave; l < L; l += NWAVES) { float ca = 0.f, sa = 0.f;
            for (int n = F.lane; n < 256; n += 64) { const float u = f82f(U[(row0 + l) * D + g * 256 + n]); const float an = 6.283185307179586f * (float)((m * n) & 255) / 256.f; const float sn = __sinf(an), cs = __cosf(an); ca += u * cs; sa += u * sn; }
            ca = wave_sum(ca); sa = wave_sum(sa); const float an = 6.283185307179586f * (float)((k * l) % L) / (float)L; const float sn = __sinf(an), cs = __cosf(an); acc += cs * ca - sn * sa; }
        if (F.lane == 0) red[F.wave] = acc;
        __syncthreads();
        if (F.tid == 0) { float t = 0.f; for (int w = 0; w < NWAVES; ++w) t += red[w]; t *= cx ? (1.f / 256.f) : 0.001381067932004975f;
            float got;
            if (cx) got = f82f((F.ws + WS_FC)[((size_t)b * 256 + k) * D + g * 256 + m]);
            else if (k == 1024) got = bf2f(((const bf16_t*)(F.ws + WS_FH1))[(size_t)b * 1024 + g * 256 + m]);
            else got = f82f((F.ws + WS_FH)[((size_t)b * 1024 + k) * D + g * 256 + m]);
            chk_report(F.ctl, id, got, t, 0.25f, 0.10f); }
        __syncthreads(); }
}
__device__ __forceinline__ void chk_fnet_y(Frame& F, const Args& a, int jl, bool upd, int id) {
    F.refresh(); const bf16_t* Y = (const bf16_t*)a.out; const float* W = a.in[11] + (size_t)jl * 1024 * 1024;
    const unsigned char* FH = F.ws + WS_FH; const bf16_t* FH1 = (const bf16_t*)(F.ws + WS_FH1); const unsigned char* FC = F.ws + WS_FC;
    for (int s = F.gw; s < 50; s += NGW) { const int tok = chk_ytoks[s % 10], n = chk_ns[s / 10]; if (tok >= T && !upd) continue;
        float acc = 0.f;
        for (int j = F.lane; j < 1024; j += 64) { float f;
            if (tok >= T) f = f82f(FC[(size_t)(tok - T) * D + j]);
            else { const int b = tok >> 11, k = tok & 2047; if (k < 1024) f = f82f(FH[((size_t)b * 1024 + k) * D + j]); else if (k == 1024) f = bf2f(FH1[(size_t)b * 1024 + j]);
                else f = f82f(FH[((size_t)b * 1024 + (2048 - k)) * D + (j & ~255) + ((256 - (j & 255)) & 255)]); }
            acc += f * W[(size_t)j * 1024 + n]; }
        acc = wave_sum(acc);
        if (F.lane == 0) chk_report(F.ctl, id, bf2f(Y[(size_t)tok * D + n]), acc, 0.04f, 0.08f); }
}
__device__ __forceinline__ void chk_route(Frame& F, const Args& a, int layer, int ntok, int id) {
    F.refresh(); const bf16_t* U = (const bf16_t*)a.out; const float* Wr = a.in[12] + (size_t)layer * 1024 * 64; const int* tke = (const int*)(F.ws + WS_TKE); const float* tkw = (const float*)(F.ws + WS_TKW);
    for (int s = F.gw; s < 16; s += NGW) { const int tok = chk_toks[s]; if (tok >= ntok) continue; const int lane = F.lane;
        float lgt = 0.f; for (int k = 0; k < 1024; ++k) lgt += bf2f(U[(size_t)tok * D + k]) * Wr[(size_t)k * 64 + lane];
        const float sc = 1.f / (1.f + expf(-lgt)), sel = sc + a.in[13][layer * 64 + lane];
        float g1 = -INFINITY, g2 = -INFINITY;
#pragma unroll 1
        for (int j = 0; j < 8; ++j) { const float v = __shfl(sel, (lane & ~7) + j); if (v > g1) { g2 = g1; g1 = v; } else if (v > g2) g2 = v; }
        const float gs = g1 + g2; int gr = 0;
#pragma unroll 1
        for (int gp = 0; gp < 8; ++gp) { const float v = __shfl(gs, gp * 8); gr += (v > gs || (v == gs && gp < (lane >> 3))) ? 1 : 0; }
        const float sm = gr < 4 ? sel : -INFINITY; int rk = 0;
#pragma unroll 1
        for (int ep = 0; ep < 64; ++ep) { const float v = __shfl(sm, ep); rk += (v > sm || (v == sm && ep < lane)) ? 1 : 0; }
        const float tot = wave_sum(rk < 8 ? sc : 0.f); const float wref = sc / tot * 2.5f;
        int slot = -1; for (int j = 0; j < 8; ++j) if (tke[(size_t)tok * 8 + j] == lane) slot = j;
        float err = 0.f;
        if (slot >= 0) { if (rk >= 10) err = 10.f; else if (rk < 8) err = fabsf(tkw[(size_t)tok * 8 + slot] - wref) / (0.04f * wref); }
        else if (rk < 6) err = 10.f;
        const unsigned long long nsel = __ballot(slot >= 0); if (__builtin_popcountll(nsel) != 8) err = 20.f;
        atomicMax(F.ctl + CW_ERR + id, __float_as_uint(err)); }
}
__device__ __forceinline__ void chk_moe(Frame& F, const Args& a, int layer, int ntok, int ch, int id) {
    F.refresh(); const bf16_t* U = (const bf16_t*)a.out; const int* tke = (const int*)(F.ws + WS_TKE); const float* tkw = (const float*)(F.ws + WS_TKW);
    const int CH = ntok / NCHUNK; LAS float* hs = (LAS float*)F.lds; LAS float* us = hs + 512; LAS float* pg_ = us + 1024;
    for (int s = F.blk; s < 16; s += GRID) { const int tok = chk_toks[s]; if (tok >= ntok || tok / CH != ch) continue;
        for (int k = F.tid; k < 1024; k += NTHR) us[k] = bf2f(U[(size_t)tok * D + k]);
        __syncthreads();
        float y0 = 0.f, y1 = 0.f;
        for (int j = 0; j < 9; ++j) { const int e = j < 8 ? tke[(size_t)tok * 8 + j] : 0; const float w = j < 8 ? tkw[(size_t)tok * 8 + j] : 1.f;
            const float* wg = j < 8 ? a.in[14] + ((size_t)layer * NE + e) * 262144 : a.in[17] + (size_t)layer * 262144;
            const float* wu = j < 8 ? a.in[15] + ((size_t)layer * NE + e) * 262144 : a.in[18] + (size_t)layer * 262144;
            const float* wd = j < 8 ? a.in[16] + ((size_t)layer * NE + e) * 262144 : a.in[19] + (size_t)layer * 262144;
            const int hh = F.tid & 255, half = F.tid >> 8; float g = 0.f, u = 0.f;
            for (int k = half * 512; k < half * 512 + 512; ++k) { g += us[k] * wg[(size_t)k * 256 + hh]; u += us[k] * wu[(size_t)k * 256 + hh]; }
            pg_[F.tid] = g; pg_[512 + F.tid] = u;
            __syncthreads();
            if (F.tid < 256) { const float gg = pg_[F.tid] + pg_[F.tid + 256], uu = pg_[512 + F.tid] + pg_[512 + F.tid + 256]; hs[F.tid] = gg / (1.f + expf(-gg)) * uu; }
            __syncthreads();
            float t0 = 0.f, t1 = 0.f; for (int q = 0; q < 256; ++q) { t0 += hs[q] * wd[(size_t)q * 1024 + F.tid]; t1 += hs[q] * wd[(size_t)q * 1024 + 512 + F.tid]; }
            y0 += w * t0; y1 += w * t1;
            __syncthreads(); }
        float g0 = 0.f, g1 = 0.f; const int i = tok - ch * CH;
        { const unsigned char* YSb = (const unsigned char*)(F.ws + WS_YS); const unsigned char* YBb = (const unsigned char*)(F.ws + WS_YB); const int* spos = (const int*)(F.ws + WS_SDST);
          const int t_ = F.tid, bo = 16 * (16 * (t_ >> 8) + ((t_ & 127) >> 3)) + 8 * ((t_ >> 7) & 1) + (t_ & 7);
          auto f8 = [](unsigned char b) { return __builtin_amdgcn_cvt_pk_f32_fp8((int)b, false)[0] * (1.f / 16.f); };
          g0 = f8(YSb[(size_t)i * D + bo]); g1 = f8(YSb[(size_t)i * D + bo + 512]);
          for (int j = 0; j < 8; ++j) { const size_t ps = (size_t)spos[(size_t)tok * 8 + j]; const float w = tkw[(size_t)tok * 8 + j]; g0 += w * f8(YBb[ps * D + bo]); g1 += w * f8(YBb[ps * D + bo + 512]); } }
        chk_report(F.ctl, id, g0, y0, 0.15f, 0.15f); chk_report(F.ctl, id, g1, y1, 0.15f, 0.15f);
        __syncthreads(); }
}
#endif

#ifndef PH_MASK
#define PH_MASK 0xffffffffu
#endif
#define PH(b) ((PH_MASK >> (b)) & 1u)
__global__ void __launch_bounds__(NTHR, 2) fwd(Args a) {
    extern __shared__ __attribute__((aligned(16))) unsigned char lds_raw[];
    Frame F;
    F.lds = (LAS unsigned char*)lds_raw; F.ws = a.ws; F.ctl = (unsigned*)(a.ws + WS_CTL);
    F.blk = blockIdx.x; F.refresh();
    for (int u = F.tid; u < (LDS_BYTES - RING_BYTES) / 4; u += NTHR) ((LAS unsigned*)(F.lds + RING_BYTES))[u] = 0u;
    __syncthreads();
    const XcdBarrier bar = xcd_barrier_post(F.ctl + CW_BAR, (volatile LAS unsigned*)(F.lds + L_MISC) + 8);
#define GRID_BAR() xcd_barrier(bar)
    LAS unsigned char* ring = F.lds;
    const int c = F.blk;
#define ws (F.ws)
#define NEWPH() F.refresh()

    if (PH(0)) { conv_small(F, a);
    __syncthreads();
    mod_partials(F, a); }
    GRID_BAR();
    if (PH(1)) { rows_init(F, a);
    mod_finalize(F, a); }
    GRID_BAR();

    for (int layer = 0; layer < 4; ++layer) {
        const int jl = layer >> 1; const bool upd = layer < 2; const int nrows = upd ? TT : T;
        if ((layer & 1) == 0) {
            NEWPH();
            if (PH(2)) { SchedQKV S; S.U = (const char*)a.out + OUT_U8; S.W = (const char*)(ws + WS_WQKV) + (size_t)jl * 1536 * 1024; S.nfull = (layer == 0) ? 288 * 6 : 256 * 6; S.nu = (layer == 0) ? 288 * 6 : 256 * 6 + 64; S.c = c;
              pg::EpiQKV E; E.Q = (bf16_t*)(ws + WS_Q); E.K = (bf16_t*)(ws + WS_K); E.V = (bf16_t*)(ws + WS_V); E.ropec = (const float*)(ws + WS_ROPEC); E.ropes = (const float*)(ws + WS_ROPES);
              pg::gemm_phase<pg::EpiQKV, SchedQKV, false, true>(ring, 1024u, 1024u, nullptr, S, E); }
            GRID_BAR();
#ifdef SELFCHECK
            if (SELFCHECK & 1) chk_qkv(F, a, layer, 1 + (layer >> 1));
#endif
#define OBUF ((bf16_t*)(ws + WS_R + 216 * MiB))
            NEWPH();
            if (PH(3)) { const int NU = 4096 + (layer == 0 ? 512 : 0);
              const bf16_t* Qb = (const bf16_t*)(ws + WS_Q); const bf16_t* Kb = (const bf16_t*)(ws + WS_K); const bf16_t* Vb = (const bf16_t*)(ws + WS_V);
              for (int i = 0; i * GRID + c < NU; ++i) { int id = pg::xcd_remap(i * GRID + c, NU);
                  if (NU > 4096) { const int g9 = id / 9, r9 = id - g9 * 9; id = (r9 < 8) ? g9 * 8 + r9 : 4096 + g9; }
                  if (id < 4096) { const int hq = id & 3, qb = (id >> 2) & 7, kvh = (id >> 5) & 3, b = id >> 7, h = kvh * 4 + hq;
                      attn::attn_unit(Qb, Kb, Vb, OBUF, b, h, qb * 256, false, a.in[10][jl * 16 + h] * LOG2E, ring); }
                  else { const int cid = id - 4096, hq = cid & 3, kvh = (cid >> 2) & 3, b = cid >> 4, h = kvh * 4 + hq;
                      attn::attn_unit(Qb, Kb, Vb, OBUF, b, h, 0, true, a.in[10][jl * 16 + h] * LOG2E, ring); } } }
            GRID_BAR();
#ifdef SELFCHECK
            if (SELFCHECK & 1) chk_attn(F, a, layer, 3 + (layer >> 1));
#endif
            NEWPH();
            if (PH(4)) { SchedDense S; S.A = (const char*)OBUF; S.W = (const char*)(ws + WS_WO) + (size_t)jl * 1024 * 1024; S.out = (char*)a.out; S.nrt = nrows / 256; S.nct = 4; S.nt = 8; S.c = c; S.ldA = 1024;
              pg::EpiStore E; pg::gemm_phase<pg::EpiStore, SchedDense, false, true>(ring, 1024u, 1024u, nullptr, S, E); }
            GRID_BAR();
        } else {
            NEWPH();
            if (PH(5)) { SchedF1 S; S.CS = (const char*)(ws + WS_CSN); S.U = (const char*)a.out + OUT_U8; S.ABT = (char*)(ws + WS_ABT); S.ABTC = (char*)(ws + WS_ABTC); S.nu = 2048 + (upd ? 256 : 0); S.c = c;
              pg::EpiStore8 E; pg::gemm_phase<pg::EpiStore8, SchedF1, false, true, 127>(ring, 256u, 1024u, nullptr, S, E); }
            GRID_BAR();
            NEWPH();
            if (PH(6)) { SchedF2 S; S.DL = (const char*)(ws + WS_DL); S.ABT = (const char*)(ws + WS_ABT); S.FH = (char*)(ws + WS_FH); S.c = c;
              pg::EpiStore8 E; pg::gemm_phase<pg::EpiStore8, SchedF2, false, true, 127>(ring, 4096u, 4096u, nullptr, S, E); }
            NEWPH();
            if (PH(7) && upd) { SchedF2c S; S.DLC = (const char*)(ws + WS_DLC); S.ABTC = (const char*)(ws + WS_ABTC); S.FC = (char*)(ws + WS_FC); S.c = c;
              pg::EpiStore8 E; pg::gemm_phase<pg::EpiStore8, SchedF2c, false, true, 127>(ring, 512u, 512u, nullptr, S, E); }
            if (PH(8)) fnet_nyquist_rows(F);
            GRID_BAR();
#ifdef SELFCHECK
            if (SELFCHECK & 2) chk_fnet_f(F, a, upd, 5 + (layer >> 1));
            GRID_BAR();
#endif
            NEWPH();
            if (PH(9)) { SchedF3 S; S.FH = (const char*)(ws + WS_FH); S.FC = (const char*)(ws + WS_FC); S.W = (const char*)(ws + WS_WSH) + (size_t)jl * 2048 * 1024; S.Y = (char*)a.out; S.nu = 1024 + (upd ? 128 : 0); S.c = c;
              pg::EpiStore E; pg::gemm_phase<pg::EpiStore, SchedF3, false, true>(ring, 1024u, 1024u, nullptr, S, E); }
            if (PH(10)) fnet_nyquist_out(F, a, jl);
            GRID_BAR();
#ifdef SELFCHECK
            if (SELFCHECK & 8) chk_fnet_y(F, a, jl, upd, 7 + (layer >> 1));
            GRID_BAR();
#endif
        }
        if (PH(12)) conv_experts(F, a, layer);
        __syncthreads();
        if (PH(11)) rows_post1(F, a, layer, nrows);
        VM_WAIT(); __syncthreads();
        if (threadIdx.x == 0) { __builtin_amdgcn_fence(__ATOMIC_ACQUIRE, "agent"); VM_WAIT(); }
        __syncthreads();
        if (PH(13)) route_tokens(F, a, layer, nrows);
        GRID_BAR();
#ifdef SELFCHECK
        if ((SELFCHECK & 64) && layer < 2) chk_route(F, a, layer, nrows, 9);
#endif
        if (PH(14)) build_lists(F, nrows);
        GRID_BAR();
        LAS const int* tstart = (LAS const int*)(F.lds + L_TSTART); LAS const unsigned char* tseg = (LAS const unsigned char*)(F.lds + L_TSEG);
        const int ntl = __builtin_amdgcn_readfirstlane(tstart[NCHUNK * 64]);
        NEWPH();
        if (PH(15)) { SchedG1 S; S.EGU = (const char*)(ws + WS_EGU); S.STOK = (const int*)(ws + WS_STOK); S.H = (char*)(ws + WS_H); S.HS = (char*)(ws + WS_HS); S.tseg = tseg; S.ntl = ntl; S.nsh = nrows / 256; S.c = c;
          pg::EpiSilu E; pg::gemm_phase<pg::EpiSilu, SchedG1, true, true>(ring, 1024u, 1024u, (const char*)a.out + OUT_U8, S, E); }
        GRID_BAR();
        const int CH = nrows / NCHUNK;
        for (int ch = 0; ch < NCHUNK; ++ch) {
            NEWPH();
            if (PH(16)) { SchedG2 S; S.ED = (const char*)(ws + WS_ED); S.H = (const char*)(ws + WS_H); S.HS = (const char*)(ws + WS_HS); S.YB = (char*)(ws + WS_YB); S.YS = (char*)(ws + WS_YS); S.tseg = tseg;
              S.t0 = __builtin_amdgcn_readfirstlane(tstart[ch * 64]); S.t1 = __builtin_amdgcn_readfirstlane(tstart[ch * 64 + 64]); S.nsh = CH / 256; S.ch = ch; S.CH = CH; S.c = c;
              pg::EpiFp8 E; pg::gemm_phase<pg::EpiFp8, SchedG2, false, true>(ring, 256u, 256u, nullptr, S, E); }
            GRID_BAR();
#ifdef SELFCHECK
            if ((SELFCHECK & 4) && layer == 0) { chk_moe(F, a, layer, nrows, ch, 10); GRID_BAR(); }
#endif
            if (PH(17)) rows_post2(F, a, layer, ch * CH, CH);
            if (!(layer == 3 && ch == NCHUNK - 1)) GRID_BAR();
        }
    }
#ifdef SELFCHECK
    GRID_BAR();
    { int bad = 0; float be = 0.f; for (int k = 15; k >= 1; --k) { const float e = __uint_as_float(__hip_atomic_load(F.ctl + CW_ERR + k, RLX_AGENT)); if (e > 1.f) { bad = k; be = e; } }
      int wt = 0; float we = 0.f; for (int k = 0; k < 16; ++k) { const float e = __uint_as_float(__hip_atomic_load(F.ctl + CW_ERR + 32 + k, RLX_AGENT)); if (e > we) { we = e; wt = k; } }
      if (bad) { F.refresh(); float cv = 3.f + bad + (be > 8.f ? 0.5f : 0.f);  Row r; for (int j = 0; j < 4; ++j) r.v[j] = (f32x4){cv, cv, cv, cv}; for (int row = F.gw; row < T; row += NGW) row_store_f32(r, a.out + (size_t)row * D, F.lane); } }
#endif
}

#undef ws
#undef NEWPH
extern "C" void kernel_launch(void* const* d_in, const int* in_sizes, int n_in, void* d_out, int out_size, void* d_ws, size_t ws_size, hipStream_t stream) {
    static int ready = 0;
    if (ready == 0) {
        if (n_in != 20 || out_size != T * D || ws_size < WS_END) { fprintf(stderr, "kernel_launch: unexpected problem (n_in %d out %d ws %zu need %zu)\n", n_in, out_size, ws_size, (size_t)WS_END); ready = -1; return; }
        if (hipFuncSetAttribute((const void*)fwd, hipFuncAttributeMaxDynamicSharedMemorySize, LDS_BYTES) != hipSuccess) { fprintf(stderr, "kernel_launch: hipFuncSetAttribute failed\n"); ready = -1; return; }
        int per_cu = 0;
        if (hipOccupancyMaxActiveBlocksPerMultiprocessor(&per_cu, (const void*)fwd, NTHR, LDS_BYTES) != hipSuccess || per_cu < 1) fprintf(stderr, "kernel_launch: occupancy query says %d blocks per CU\n", per_cu);
        (void)hipGetLastError();
        ready = 1;
    }
    if (ready < 0) return;
    (void)hipMemsetAsync((char*)d_ws + WS_CTL, 0, CTL_BYTES, stream);
    Args a{};
    for (int i = 0; i < 20; ++i) a.in[i] = (const float*)d_in[i];
    a.out = (float*)d_out; a.ws = (unsigned char*)d_ws;
    hipLaunchKernelGGL(fwd, dim3(GRID), dim3(NTHR), LDS_BYTES, stream, a);
}
```

```cpp
#include <hip/hip_runtime.h>
#include <cstdio>
#include <cstdint>

#define LAS __attribute__((address_space(3)))
#define GAS __attribute__((address_space(1)))
typedef unsigned short bf16_t;
typedef short bf16x8 __attribute__((ext_vector_type(8)));
typedef short s16x4 __attribute__((ext_vector_type(4)));
typedef float f32x4 __attribute__((ext_vector_type(4)));
typedef float f32x16 __attribute__((ext_vector_type(16)));
typedef unsigned u32x4 __attribute__((ext_vector_type(4)));
typedef unsigned u32x2 __attribute__((ext_vector_type(2)));
typedef int v8i_t __attribute__((ext_vector_type(8)));
typedef int v4i_t __attribute__((ext_vector_type(4)));

constexpr int D = 1024, NB = 32, SEQ = 2048, T = NB * SEQ, CTXL = 256, TC = NB * CTXL, TT = T + TC;
constexpr int NQKV = 1536, NE = 64;
constexpr float ALPHA = 1.681792830507429f;
constexpr float LN_EPS = 1e-5f, MOD_EPS = 1e-6f;
constexpr float C2 = 0.125f * 1.4426950408889634f;
constexpr float LOG2E = 1.4426950408889634f;
constexpr int NCHUNK = 1;
constexpr int NWAVES = 8, NTHR = 512, GRID = 256;

constexpr size_t MiB = 1u << 20;
constexpr size_t WS_CTL = 0, CTL_BYTES = 1 * MiB;
constexpr size_t WS_ROPEC = 1 * MiB, WS_ROPES = 1 * MiB + 4096, WS_CSN = 1 * MiB + 65536, WS_DLC = 1 * MiB + 524288, WS_DL = 2 * MiB;
constexpr size_t WS_WQKV = 10 * MiB, WS_WO = 16 * MiB, WS_WF = 20 * MiB, WS_WR = 28 * MiB, WS_WSH = 29 * MiB;
constexpr size_t WS_MODP = 36 * MiB, WS_MOD = 49 * MiB;
constexpr size_t WS_EGU = 54 * MiB, WS_ED = 118 * MiB;
constexpr size_t WS_XS = 150 * MiB;
constexpr size_t WS_STOK = 294 * MiB, WS_SDST = 297 * MiB, WS_SW = 300 * MiB, WS_TKE = 303 * MiB, WS_TKW = 306 * MiB;
constexpr size_t WS_R = 309 * MiB;
constexpr size_t WS_Q = WS_R, WS_K = WS_R + 144 * MiB, WS_V = WS_R + 180 * MiB;
constexpr size_t WS_ABT = WS_R, WS_FH = WS_R + 256 * MiB, WS_FH1 = WS_R + 320 * MiB, WS_ABTC = WS_R + 321 * MiB, WS_FC = WS_R + 353 * MiB;
constexpr size_t WS_H = WS_R, WS_HS = WS_R + 160 * MiB, WS_YB = WS_R + 180 * MiB, WS_YS = WS_R + 788 * MiB;
constexpr size_t WS_END = WS_YS + 72 * MiB;
constexpr size_t OUT_U8 = 144 * MiB;
constexpr int WSCALE_E8M0 = 121;
constexpr int MAXROWS = 655360;

constexpr int CW_TMO = 0, CW_BAR = 4096, CW_BCNT = 16384;

constexpr int RING_BYTES = 131072;
constexpr int L_MISC = RING_BYTES;
constexpr int L_TSTART = RING_BYTES + 256;
constexpr int L_PREF = L_TSTART + 1040;
constexpr int L_LCNT = L_PREF + 256;
constexpr int L_TSEG = L_LCNT + 256;
constexpr int L_SCAN = L_TSEG + 2560;
constexpr int LDS_BYTES = 139264;
static_assert(L_SCAN + 1024 <= LDS_BYTES, "LDS map");

#define RLX_AGENT __ATOMIC_RELAXED, __HIP_MEMORY_SCOPE_AGENT
#define LDS_WAIT() asm volatile("s_waitcnt lgkmcnt(0)" ::: "memory")
#define VM_WAIT() asm volatile("s_waitcnt vmcnt(0)" ::: "memory")

__device__ __forceinline__ unsigned f2bf(float f) { unsigned u = __builtin_bit_cast(unsigned, f); return (u + 0x7fffu + ((u >> 16) & 1u)) >> 16; }
__device__ __forceinline__ unsigned pk2(float lo, float hi) { return f2bf(lo) | (f2bf(hi) << 16); }
typedef float f32x2_t __attribute__((ext_vector_type(2))); typedef __bf16 bf16x2_t __attribute__((ext_vector_type(2)));
__device__ __forceinline__ unsigned cvt_pk_bf16(float lo, float hi) { f32x2_t v = {lo, hi}; bf16x2_t b = __builtin_convertvector(v, bf16x2_t); return __builtin_bit_cast(unsigned, b); }
__device__ __forceinline__ float bflo(unsigned w) { return __builtin_bit_cast(float, w << 16); }
__device__ __forceinline__ float bfhi(unsigned w) { return __builtin_bit_cast(float, w & 0xffff0000u); }
__device__ __forceinline__ float wave_sum(float v) {
#pragma unroll
    for (int o = 1; o < 64; o <<= 1) v += __shfl_xor(v, o);
    return v;
}

__device__ __forceinline__ unsigned f2f8(float v) { return (unsigned)__builtin_amdgcn_cvt_pk_fp8_f32(v, 0.f, 0, false) & 0xffu; }
__device__ __forceinline__ float f82f(unsigned b) { return __builtin_amdgcn_cvt_pk_f32_fp8((int)(b & 0xffu), false)[0]; }
__device__ __forceinline__ int opaque_tid() { int t = threadIdx.x; asm volatile("" : "+v"(t)); return t; }

#define XB_TMO      128
#define XB_XCNT(j)  (256  + 64 * (j))
#define XB_XSUB(j)  (1280 + 64 * (j))
#define XB_XGEN(j)  (2304 + 64 * (j))
#define XB_TOP      3328
#define XB_TOPGEN   3392
#define XCD_BAR_WORDS 3456
#define XB_SPIN_CAP (1u << 22)
__device__ __forceinline__ unsigned xb_ld(unsigned* p)              { return __hip_atomic_load(p, __ATOMIC_RELAXED, __HIP_MEMORY_SCOPE_AGENT); }
__device__ __forceinline__ unsigned xb_add(unsigned* p, unsigned v) { return __hip_atomic_fetch_add(p, v, __ATOMIC_RELAXED, __HIP_MEMORY_SCOPE_AGENT); }
__device__ __forceinline__ unsigned xb_xcc_id() { return (unsigned)__builtin_amdgcn_s_getreg((3 << 11) | 20) & 0xFu; }
#define XB_SPIN(cond, bar) do { unsigned _sp = 0; while (cond) { __builtin_amdgcn_s_sleep(1); \
    if ((++_sp & 255u) == 0u) { if (xb_ld(&(bar)[XB_TMO])) break; if (_sp > XB_SPIN_CAP) { atomicAdd(&(bar)[XB_TMO], 1u); break; } } } } while (0)
struct XcdBarrier { unsigned* bar; unsigned x; volatile LAS unsigned* st; };
__device__ __forceinline__ XcdBarrier xcd_barrier_post(unsigned* bar, volatile LAS unsigned* st) {
    XcdBarrier b; b.bar = bar; b.x = xb_xcc_id(); b.st = st;
    if (threadIdx.x == 0) (void)xb_add(&bar[XB_XCNT(b.x)], 1u);
    return b;
}
__device__ __forceinline__ void xcd_barrier_complete(unsigned* bar, unsigned x, unsigned& nloc, unsigned& nx) {
    const unsigned G = gridDim.x * gridDim.y * gridDim.z;
    unsigned sum, cnt, mine, sp = 0u;
    for (;;) {
        sum = 0u; cnt = 0u; mine = 0u;
#pragma unroll
        for (unsigned j = 0; j < 16; ++j) { const unsigned c = xb_ld(&bar[XB_XCNT(j)]); sum += c; cnt += (c > 0u) ? 1u : 0u; mine = (j == x) ? c : mine; }
        if (sum == G) break;
        __builtin_amdgcn_s_sleep(1);
        if ((++sp & 255u) == 0u) { if (xb_ld(&bar[XB_TMO])) break; if (sp > XB_SPIN_CAP) { atomicAdd(&bar[XB_TMO], 1u); break; } }
    }
    nloc = mine > 0u ? mine : 1u; nx = cnt > 0u ? cnt : 1u;
}
__device__ __forceinline__ void xcd_barrier(const XcdBarrier& b) {
    asm volatile("s_waitcnt vmcnt(0)" ::: "memory");
    __syncthreads();
    if (threadIdx.x == 0) {
        unsigned* bar = b.bar; unsigned bx = b.x; asm volatile("" : "+s"(bx));
        __builtin_amdgcn_s_waitcnt(0);
        unsigned nloc = b.st[0], nx = b.st[1];
        if (nloc == 0u) { xcd_barrier_complete(bar, bx, nloc, nx); b.st[0] = nloc; b.st[1] = nx; }
        const unsigned old = xb_add(&bar[XB_XSUB(bx)], 1u);
        const unsigned gen = old / nloc;
        if (old + 1u == (gen + 1u) * nloc) {
            __builtin_amdgcn_fence(__ATOMIC_RELEASE, "agent");
            asm volatile("s_waitcnt vmcnt(0)" ::: "memory");
            const unsigned og = xb_add(&bar[XB_TOP], 1u);
            const unsigned tg = og / nx;
            if (og + 1u == (tg + 1u) * nx) xb_add(&bar[XB_TOPGEN], 1u);
            else XB_SPIN(xb_ld(&bar[XB_TOPGEN]) == tg, bar);
            __builtin_amdgcn_fence(__ATOMIC_ACQUIRE, "agent");
            xb_add(&bar[XB_XGEN(bx)], 1u);
            asm volatile("s_waitcnt vmcnt(0)" ::: "memory");
        } else {
            XB_SPIN(xb_ld(&bar[XB_XGEN(bx)]) == gen, bar);
            __builtin_amdgcn_fence(__ATOMIC_ACQUIRE, "agent");
            asm volatile("s_waitcnt vmcnt(0)" ::: "memory");
        }
    }
    __syncthreads();
}

namespace pg {
constexpr int BM = 256, BK = 64, HALF = 128, HTB = HALF * BK * 2;
__host__ __device__ __forceinline__ int lds_byte(int r, int c) { const int st = (r >> 4) * 2 + (c >> 5), rr = r & 15, cc = c & 31, ob = rr * 64 + cc * 2; return st * 1024 + (ob ^ (((ob >> 9) & 1) << 5)); }
__host__ __device__ __forceinline__ void stage_rc(int b, int& R, int& C) { const int st = b / 1024, sb = b % 1024, swz = sb ^ (((sb >> 9) & 1) << 5); R = (st >> 1) * 16 + swz / 64; C = (st & 1) * 32 + (swz % 64) / 2; }
__host__ __device__ __forceinline__ int perm32(int rho) { const int n = rho >> 4, i = rho & 15; return 8 * (i >> 2) + 4 * n + (i & 3); }

struct Unit {
    const char* A;
    const char* B;
    const int* gidx;
    int gbase;
    int nt;
    char* out; int ldc; float scale; int flags; int i0; int i1;
};

template <class Epi, class Sched, bool GATHER, bool F8 = false, int WSC = WSCALE_E8M0>
__device__ __forceinline__ void gemm_phase(LAS unsigned char* lds, const unsigned lda, const unsigned ldb, const char* gtable, const Sched& S, const Epi& E) {
    const int tid = opaque_tid(), wid = __builtin_amdgcn_readfirstlane(tid >> 6), lane = tid & 63, wr = wid >> 2, wc = wid & 3, fr = lane & 15, fq = lane >> 4;
    unsigned voffA[2], voffB[2];
#pragma unroll
    for (int i = 0; i < 2; ++i) { int R, C; stage_rc(tid * 16 + i * 8192, R, C); const int Rb = (R & ~31) + perm32(R & 31);
        voffA[i] = (unsigned)R * lda + (unsigned)C * 2u; voffB[i] = (unsigned)Rb * ldb + (unsigned)C * 2u; }
    const size_t kstep = (size_t)(BK * 2);
    const size_t hstepA = (size_t)HALF * lda, hstepB = (size_t)HALF * ldb;
    const unsigned ldsw = (unsigned)wid * 1024u;
    const int aoff = lds_byte(wr * 64 + fr, fq * 8), boff = lds_byte(wc * 32 + fr, fq * 8);
#define PG_SA(b, h) (((b) * 2 + (h)) * HTB)
#define PG_SB(b, h) ((4 + (b) * 2 + (h)) * HTB)
#define PG_ST2(bufoff, p0, p1) do { \
        __builtin_amdgcn_global_load_lds((const unsigned*)(p0), (LAS unsigned*)(lds + (bufoff) + ldsw), 16, 0, 0); \
        __builtin_amdgcn_global_load_lds((const unsigned*)(p1), (LAS unsigned*)(lds + (bufoff) + ldsw + 8192), 16, 0, 0); } while (0)
#define PG_STB(bufoff, bp) PG_ST2(bufoff, (bp) + voffB[0], (bp) + voffB[1])
#define PG_STA(bufoff, ap, h, nx) do { if constexpr (GATHER) { PG_ST2(bufoff, (ap) + ((nx) ? nO[h][0] : cO[h][0]), (ap) + ((nx) ? nO[h][1] : cO[h][1])); } \
        else { PG_ST2(bufoff, (ap) + (h) * hstepA + voffA[0], (ap) + (h) * hstepA + voffA[1]); } } while (0)
#define PG_LD8(p) ({ const v4i_t lo_ = *(const LAS v4i_t*)(p), hi_ = *(const LAS v4i_t*)((p) + 1024); __builtin_shufflevector(lo_, hi_, 0, 1, 2, 3, 4, 5, 6, 7); })
#define PG_LDA(dst, b, h) do { if constexpr (F8) { _Pragma("unroll") for (int m = 0; m < 4; ++m) dst##8[m] = PG_LD8(lds + PG_SA(b, h) + aoff + m * 2048); } \
        else { _Pragma("unroll") for (int m = 0; m < 4; ++m) _Pragma("unroll") for (int k = 0; k < 2; ++k) dst[m][k] = *(const LAS bf16x8*)(lds + PG_SA(b, h) + aoff + m * 2048 + k * 1024); } } while (0)
#define PG_LDB(dst, b, h) do { if constexpr (F8) { _Pragma("unroll") for (int n = 0; n < 2; ++n) dst##8[n] = PG_LD8(lds + PG_SB(b, h) + boff + n * 2048); } \
        else { _Pragma("unroll") for (int n = 0; n < 2; ++n) _Pragma("unroll") for (int k = 0; k < 2; ++k) dst[n][k] = *(const LAS bf16x8*)(lds + PG_SB(b, h) + boff + n * 2048 + k * 1024); } } while (0)
#define PG_MMA(ai, bj, At, Bt) do { __builtin_amdgcn_s_setprio(1); _Pragma("unroll") for (int m = 0; m < 4; ++m) _Pragma("unroll") for (int n = 0; n < 2; ++n) { \
        if constexpr (F8) { asm volatile("v_mfma_scale_f32_16x16x128_f8f6f4 %0, %1, %2, %0, %3, %4 op_sel_hi:[0,0,0]" : "+v"(acc[ai][bj][m][n]) : "v"(Bt##8[n]), "v"(At##8[m]), "v"(sc_w), "v"(sc_x)); } \
        else { _Pragma("unroll") for (int k = 0; k < 2; ++k) acc[ai][bj][m][n] = __builtin_amdgcn_mfma_f32_16x16x32_bf16(Bt[n][k], At[m][k], acc[ai][bj][m][n], 0, 0, 0); } } \
        __builtin_amdgcn_s_setprio(0); } while (0)
#define PG_WAIT_V(n) asm volatile("s_waitcnt vmcnt(" #n ")" ::: "memory")
#define PG_WAIT_L(n) asm volatile("s_waitcnt lgkmcnt(" #n ")" ::: "memory")
#define PG_BAR __builtin_amdgcn_s_barrier()
#define PG_SCHED __builtin_amdgcn_sched_barrier(0)
#define PG_GOFF(dst, u) do { const int tz_ = opaque_tid(); _Pragma("unroll") for (int i = 0; i < 2; ++i) { int R_, C_; stage_rc(tz_ * 16 + i * 8192, R_, C_); \
        _Pragma("unroll") for (int h = 0; h < 2; ++h) { const int rr = h * HALF + R_; \
        const int ix = (u).gidx ? ((const GAS int*)(u).gidx)[rr] : (u).gbase + rr; dst[h][i] = (unsigned)ix * lda + (unsigned)C_ * 2u; } } } while (0)
#define PG_GIDX(dst, un) do { const int* gi_ = nullptr; int gb_ = 0; const bool ok_ = S.gsrc((un), gi_, gb_); const int tz_ = opaque_tid(); _Pragma("unroll") for (int i = 0; i < 2; ++i) { int R_, C_; stage_rc(tz_ * 16 + i * 8192, R_, C_); \
        _Pragma("unroll") for (int h = 0; h < 2; ++h) { const int rr = h * HALF + R_; dst[h][i] = (ok_ && gi_) ? ((const GAS int*)gi_)[rr] : gb_ + rr; } } } while (0)
#define PG_GCVT(dst, src) do { const int tz_ = opaque_tid(); _Pragma("unroll") for (int i = 0; i < 2; ++i) { int R_, C_; stage_rc(tz_ * 16 + i * 8192, R_, C_); \
        _Pragma("unroll") for (int h = 0; h < 2; ++h) dst[h][i] = (unsigned)src[h][i] * lda + (unsigned)C_ * 2u; } } while (0)
    Unit cur, nxt; int ui = 0;
    if (!S.next(0, cur)) return;
    f32x4 acc[2][2][4][2];
#pragma unroll
    for (int a = 0; a < 2; ++a)
#pragma unroll
        for (int b = 0; b < 2; ++b)
#pragma unroll
            for (int m = 0; m < 4; ++m)
#pragma unroll
                for (int n = 0; n < 2; ++n) acc[a][b][m][n] = (f32x4){0.f, 0.f, 0.f, 0.f};
    bf16x8 At[4][2], B0[2][2], B1[2][2]; v8i_t At8[4], B08[2], B18[2];
    const int sc_w = WSC * 0x01010101, sc_x = 0x7f7f7f7f;
    unsigned cO[2][2] = {{0u, 0u}, {0u, 0u}}, nO[2][2] = {{0u, 0u}, {0u, 0u}};
    if constexpr (GATHER) { PG_GOFF(cO, cur); }
    const char* cA = GATHER ? gtable : cur.A; const char* cB = cur.B;
    PG_STB(PG_SB(0, 0), cB); PG_STB(PG_SB(0, 1), cB + hstepB); PG_STA(PG_SA(0, 0), cA, 0, false); PG_STA(PG_SA(0, 1), cA, 1, false);
    if (wr == 1) PG_BAR;
    PG_WAIT_V(2); PG_BAR;
    PG_STB(PG_SB(1, 0), cB + kstep); PG_STA(PG_SA(1, 0), cA + kstep, 0, false); PG_STB(PG_SB(1, 1), cB + hstepB + kstep);
    PG_WAIT_V(6); PG_BAR;
    for (;;) {
        const bool has_next = S.next(ui + 1, nxt);
        const int nt = cur.nt;
        if constexpr (GATHER) { if (has_next) { PG_GOFF(nO, nxt); } else {
#pragma unroll
            for (int h = 0; h < 2; ++h)
#pragma unroll
                for (int i = 0; i < 2; ++i) nO[h][i] = cO[h][i]; } }
        const char* nA = GATHER ? gtable : (has_next ? nxt.A : cA); const char* nB = has_next ? nxt.B : cB;
#pragma unroll 1
        for (int t = 0; t < nt; t += 2) {
            const bool last = (t == nt - 2);
            const char* a1 = cA + (size_t)(t + 1) * kstep;
            const char* a2 = last ? nA : cA + (size_t)(t + 2) * kstep; const char* b2 = last ? nB : cB + (size_t)(t + 2) * kstep;
            const char* a3 = a2 + kstep; const char* b3 = b2 + kstep;
            PG_LDB(B0, 0, 0); PG_LDB(B1, 0, 1); PG_SCHED; PG_LDA(At, 0, 0); PG_STA(PG_SA(1, 1), a1, 1, false);
            PG_WAIT_V(8); PG_WAIT_L(0); PG_BAR; PG_MMA(0, 0, At, B0); PG_MMA(0, 1, At, B1); PG_BAR; PG_SCHED;
            PG_LDA(At, 0, 1); PG_STB(PG_SB(0, 0), b2); PG_STB(PG_SB(0, 1), b2 + hstepB); PG_STA(PG_SA(0, 0), a2, 0, last);
            PG_WAIT_V(8); PG_WAIT_L(0); PG_BAR; PG_MMA(1, 0, At, B0); PG_MMA(1, 1, At, B1); PG_BAR; PG_SCHED;
            PG_LDB(B0, 1, 0); PG_LDB(B1, 1, 1); PG_SCHED; PG_LDA(At, 1, 0); PG_STA(PG_SA(0, 1), a2, 1, last);
            PG_WAIT_V(8); PG_WAIT_L(0); PG_BAR; PG_MMA(0, 0, At, B0); PG_MMA(0, 1, At, B1); PG_BAR; PG_SCHED;
            PG_LDA(At, 1, 1); PG_STB(PG_SB(1, 0), b3); PG_STB(PG_SB(1, 1), b3 + hstepB); PG_STA(PG_SA(1, 0), a3, 0, last);
            PG_WAIT_V(8); PG_WAIT_L(0); PG_BAR; PG_MMA(1, 0, At, B0); PG_MMA(1, 1, At, B1); PG_BAR; PG_SCHED;
        }
        if (wr == 0) PG_BAR;
        if constexpr (F8) asm volatile("s_nop 15\n\ts_nop 15" ::: "memory");
        E(acc, cur, wr, wc, fr, fq);
        if (!has_next) break;
#pragma unroll
        for (int a = 0; a < 2; ++a)
#pragma unroll
            for (int b = 0; b < 2; ++b)
#pragma unroll
                for (int m = 0; m < 4; ++m)
#pragma unroll
                    for (int n = 0; n < 2; ++n) acc[a][b][m][n] = (f32x4){0.f, 0.f, 0.f, 0.f};
        cur = nxt; cA = nA; cB = nB; ++ui;
        if constexpr (GATHER) {
#pragma unroll
            for (int h = 0; h < 2; ++h)
#pragma unroll
                for (int i = 0; i < 2; ++i) cO[h][i] = nO[h][i]; }
        if (wr == 1) PG_BAR;
    }
    PG_WAIT_V(0);
    PG_BAR;
#undef PG_SA
#undef PG_SB
#undef PG_ST2
#undef PG_STB
#undef PG_STA
#undef PG_LDA
#undef PG_LD8
#undef PG_LDB
#undef PG_MMA
#undef PG_WAIT_V
#undef PG_WAIT_L
#undef PG_BAR
#undef PG_SCHED
#undef PG_GOFF
#undef PG_GIDX
#undef PG_GCVT
}

struct EpiStore {
    __device__ __forceinline__ void operator()(const f32x4 (&acc)[2][2][4][2], const Unit& u, int wr, int wc, int fr, int fq) const {
        asm volatile("" : "+v"(fr), "+v"(fq));
        const float s = u.scale;
#pragma unroll
        for (int ai = 0; ai < 2; ++ai)
#pragma unroll
            for (int m = 0; m < 4; ++m) { const int row = ai * HALF + wr * 64 + m * 16 + fr;
                char* rowp = u.out + (ptrdiff_t)row * u.ldc + (wc * 32 + 8 * fq) * 2;
                if (!((u.flags & 1) && row == 0)) {
#pragma unroll
                for (int bj = 0; bj < 2; ++bj) { const f32x4 v0 = acc[ai][bj][m][0] * s, v1 = acc[ai][bj][m][1] * s;
                    u32x4 w; w.x = cvt_pk_bf16(v0[0], v0[1]); w.y = cvt_pk_bf16(v0[2], v0[3]); w.z = cvt_pk_bf16(v1[0], v1[1]); w.w = cvt_pk_bf16(v1[2], v1[3]);
                    *(u32x4*)(rowp + bj * 256) = w; } } }
    }
};
struct EpiStore8 {
    __device__ __forceinline__ void operator()(const f32x4 (&acc)[2][2][4][2], const Unit& u, int wr, int wc, int fr, int fq) const {
        asm volatile("" : "+v"(fr), "+v"(fq));
        const float s = u.scale;
#pragma unroll
        for (int ai = 0; ai < 2; ++ai)
#pragma unroll
            for (int m = 0; m < 4; ++m) { const int row = ai * HALF + wr * 64 + m * 16 + fr;
                char* rowp = u.out + (ptrdiff_t)row * u.ldc + (wc * 32 + 8 * fq);
#pragma unroll
                for (int bj = 0; bj < 2; ++bj) { const f32x4 v0 = acc[ai][bj][m][0] * s, v1 = acc[ai][bj][m][1] * s; int w0 = 0, w1 = 0;
                    w0 = __builtin_amdgcn_cvt_pk_fp8_f32(v0[0], v0[1], w0, false); w0 = __builtin_amdgcn_cvt_pk_fp8_f32(v0[2], v0[3], w0, true);
                    w1 = __builtin_amdgcn_cvt_pk_fp8_f32(v1[0], v1[1], w1, false); w1 = __builtin_amdgcn_cvt_pk_fp8_f32(v1[2], v1[3], w1, true);
                    u32x2 o; o.x = (unsigned)w0; o.y = (unsigned)w1; *(u32x2*)(rowp + bj * 128) = o; } }
    }
};
struct EpiQKV {
    bf16_t* Q; bf16_t* K; bf16_t* V; const float* ropec; const float* ropes;
    __device__ __forceinline__ void operator()(const f32x4 (&acc)[2][2][4][2], const Unit& u, int wr, int wc, int fr, int fq) const {
        asm volatile("" : "+v"(fr), "+v"(fq));
        const int pm = u.i0, pn = u.i1; const bool lat = pm < (T / 256); const bool rope = lat && pn < 5;
        const float qs = pn < 4 ? C2 : 1.f;
        const int part = wc & 1;
        const int fi0 = 8 * (fq & 1);
        const float sgn = (fq < 2) ? -1.f : 1.f;
#pragma unroll
        for (int ai = 0; ai < 2; ++ai)
#pragma unroll
            for (int m = 0; m < 4; ++m) { const int row = ai * HALF + wr * 64 + m * 16 + fr; const int tok = pm * 256 + row;
                const int tl = tok & (SEQ - 1); const int pos = part ? (tl & 63) : (tl >> 6);
                f32x4 c0 = {1.f, 1.f, 1.f, 1.f}, c1 = c0, s0 = {0.f, 0.f, 0.f, 0.f}, s1 = s0;
                if (rope) { c0 = *(const f32x4*)(ropec + pos * 16 + fi0); c1 = *(const f32x4*)(ropec + pos * 16 + fi0 + 4); s0 = *(const f32x4*)(ropes + pos * 16 + fi0); s1 = *(const f32x4*)(ropes + pos * 16 + fi0 + 4); }
#pragma unroll
                for (int bj = 0; bj < 2; ++bj) { f32x4 v0 = acc[ai][bj][m][0], v1 = acc[ai][bj][m][1];
                    if (rope) { f32x4 p0, p1;
#pragma unroll
                        for (int j = 0; j < 4; ++j) { p0[j] = __shfl_xor(v0[j], 32); p1[j] = __shfl_xor(v1[j], 32); }
                        v0 = v0 * c0 + (p0 * sgn) * s0; v1 = v1 * c1 + (p1 * sgn) * s1; }
                    v0 = v0 * qs; v1 = v1 * qs;
                    u32x4 w; w.x = cvt_pk_bf16(v0[0], v0[1]); w.y = cvt_pk_bf16(v0[2], v0[3]); w.z = cvt_pk_bf16(v1[0], v1[1]); w.w = cvt_pk_bf16(v1[2], v1[3]);
                    const int col = bj * HALF + wc * 32 + 8 * fq;
                    bf16_t* dst = pn < 4 ? Q + (size_t)tok * 1024 + pn * 256 + col : (pn == 4 ? K + (size_t)tok * 256 + col : V + (size_t)tok * 256 + col);
                    *(u32x4*)dst = w; } }
    }
};
struct EpiSilu {
    __device__ __forceinline__ void operator()(const f32x4 (&acc)[2][2][4][2], const Unit& u, int wr, int wc, int fr, int fq) const {
        asm volatile("" : "+v"(fr), "+v"(fq));
#pragma unroll
        for (int ai = 0; ai < 2; ++ai)
#pragma unroll
            for (int m = 0; m < 4; ++m) { const int row = ai * HALF + wr * 64 + m * 16 + fr;
                float h[8];
#pragma unroll
                for (int n = 0; n < 2; ++n)
#pragma unroll
                    for (int j = 0; j < 4; ++j) { const float g = acc[ai][0][m][n][j], up = acc[ai][1][m][n][j]; h[n * 4 + j] = g * __builtin_amdgcn_rcpf(1.f + __expf(-g)) * up; }
                int w0 = 0, w1 = 0;
                w0 = __builtin_amdgcn_cvt_pk_fp8_f32(h[0], h[1], w0, false); w0 = __builtin_amdgcn_cvt_pk_fp8_f32(h[2], h[3], w0, true);
                w1 = __builtin_amdgcn_cvt_pk_fp8_f32(h[4], h[5], w1, false); w1 = __builtin_amdgcn_cvt_pk_fp8_f32(h[6], h[7], w1, true);
                u32x2 o; o.x = (unsigned)w0; o.y = (unsigned)w1;
                *(u32x2*)(u.out + (size_t)row * 256 + (wc * 32 + 8 * fq)) = o; }
    }
};
struct EpiFp8 {
    __device__ __forceinline__ void operator()(const f32x4 (&acc)[2][2][4][2], const Unit& u, int wr, int wc, int fr, int fq) const {
        asm volatile("" : "+v"(fr), "+v"(fq));
        const int pn = u.i1;
#pragma unroll
        for (int ai = 0; ai < 2; ++ai)
#pragma unroll
            for (int m = 0; m < 4; ++m) { const int row = ai * HALF + wr * 64 + m * 16 + fr;
                u32x4 o;
#pragma unroll
                for (int bj = 0; bj < 2; ++bj) { const f32x4 v0 = acc[ai][bj][m][0] * 16.f, v1 = acc[ai][bj][m][1] * 16.f;
                    int w0 = 0, w1 = 0;
                    w0 = __builtin_amdgcn_cvt_pk_fp8_f32(v0[0], v0[1], w0, false); w0 = __builtin_amdgcn_cvt_pk_fp8_f32(v0[2], v0[3], w0, true);
                    w1 = __builtin_amdgcn_cvt_pk_fp8_f32(v1[0], v1[1], w1, false); w1 = __builtin_amdgcn_cvt_pk_fp8_f32(v1[2], v1[3], w1, true);
                    o[2 * bj] = (unsigned)w0; o[2 * bj + 1] = (unsigned)w1; }
                *(u32x4*)(u.out + (size_t)row * 1024 + (16 * pn + 4 * wc + fq) * 16) = o; }
    }
};
__device__ __forceinline__ int xcd_remap(int L0, int NU) { const int q = NU >> 3, r = NU & 7, x = L0 & 7, off = L0 >> 3; return (x < r ? x * (q + 1) : r * (q + 1) + (x - r) * q) + off; }
}

namespace attn {
constexpr int SLOTB = 8192;
constexpr int LDS_K = 0, LDS_V = 2 * SLOTB, LDS_WS = 4 * SLOTB, LDS_OST = LDS_WS + NWAVES * 256, LDS_END = LDS_OST + NWAVES * 4096;
static_assert(LDS_END <= RING_BYTES, "attention LDS");
__device__ __forceinline__ int crow(int r, int hi) { return (r & 3) + 8 * (r >> 2) + 4 * hi; }
__device__ __forceinline__ void glds16(const void* gsrc, unsigned lds_dst) { unsigned keep;
    asm volatile("s_mov_b32 %0, m0\n\ts_mov_b32 m0, %2\n\ts_nop 0\n\tglobal_load_lds_dwordx4 %1, off\n\ts_mov_b32 m0, %0" : "=&s"(keep) : "v"(gsrc), "s"(lds_dst) : "memory"); }
__device__ __forceinline__ float rowmax(const f32x16& p0, const f32x16& p1) {
    float a = fmaxf(p0[0], p1[0]);
#pragma unroll
    for (int r = 1; r < 16; ++r) a = fmaxf(a, fmaxf(p0[r], p1[r]));
    auto rr = __builtin_amdgcn_permlane32_swap(__float_as_uint(a), __float_as_uint(a), false, false);
    return fmaxf(__uint_as_float(rr[0]), __uint_as_float(rr[1]));
}
typedef short v4i16_t __attribute__((ext_vector_type(4)));
__device__ __forceinline__ s16x4 vtr(const LAS unsigned char* p) { return __builtin_bit_cast(s16x4, __builtin_amdgcn_ds_read_tr16_b64_v4i16((LAS v4i16_t*)p)); }
__device__ __forceinline__ void pv(f32x16* o, const LAS unsigned char* vp, bf16x8 pa0, bf16x8 pa1, bf16x8 pa2, bf16x8 pa3) {
#pragma unroll
    for (int d0 = 0; d0 < 2; ++d0) { s16x4 lo[4], hi[4];
#pragma unroll
        for (int ks = 0; ks < 4; ++ks) { lo[ks] = vtr(vp + d0 * 4096 + ks * 1024); hi[ks] = vtr(vp + d0 * 4096 + ks * 1024 + 512); }
#define PK(k) (bf16x8){lo[k][0], lo[k][1], lo[k][2], lo[k][3], hi[k][0], hi[k][1], hi[k][2], hi[k][3]}
        o[d0] = __builtin_amdgcn_mfma_f32_32x32x16_bf16(pa0, PK(0), o[d0], 0, 0, 0);
        o[d0] = __builtin_amdgcn_mfma_f32_32x32x16_bf16(pa1, PK(1), o[d0], 0, 0, 0);
        o[d0] = __builtin_amdgcn_mfma_f32_32x32x16_bf16(pa2, PK(2), o[d0], 0, 0, 0);
        o[d0] = __builtin_amdgcn_mfma_f32_32x32x16_bf16(pa3, PK(3), o[d0], 0, 0, 0);
#undef PK
    }
}
__device__ __forceinline__ void attn_unit(const bf16_t* Q, const bf16_t* K, const bf16_t* V, bf16_t* O, int b, int h, int q0, bool isctx, float sink2, LAS unsigned char* shm) {
    const int tid = opaque_tid(), lane = tid & 63, r32 = lane & 31, hi = lane >> 5; const int wid = __builtin_amdgcn_readfirstlane(tid >> 6);
    const int kvh = h >> 2;
    const long qrow = isctx ? (long)T + b * CTXL + wid * 32 : (long)b * SEQ + q0 + wid * 32;
    const unsigned lds0 = (unsigned)(uintptr_t)shm;
    LAS float* wsf = (LAS float*)(shm + LDS_WS) + wid * 64;
    int jlo = 0, nl = 0;
    if (!isctx) { jlo = (q0 == 0) ? 2 : 0; int jhi = (SEQ - q0 + 128) / 64; if (jhi > 8) jhi = 8; nl = jhi - jlo; }
    const int NT = nl + 4;
    const long lat0 = (long)b * SEQ + q0 - 128 + 64 * jlo, ctx0 = (long)T + b * CTXL;
#define TROW(t) ((t) < nl ? lat0 + 64 * (t) : ctx0 + 64 * ((t) - nl))
    const int kcol = kvh * 64 + wid * 8, vcol = kvh * 64 + (wid >> 2) * 32 + (lane & 3) * 8, vrow = 16 * (wid & 3) + (lane >> 2);
    const unsigned kdst = lds0 + LDS_K + wid * 1024, vdst = lds0 + LDS_V + wid * 1024;
#define DMA_KV(t, slot) do { const long tr_ = TROW(t); glds16(K + (tr_ + lane) * 256 + kcol, (unsigned)__builtin_amdgcn_readfirstlane(kdst + (slot) * SLOTB)); \
        glds16(V + (tr_ + vrow) * 256 + vcol, (unsigned)__builtin_amdgcn_readfirstlane(vdst + (slot) * SLOTB)); } while (0)
    DMA_KV(0, 0);
    bf16x8 qr[4];
#pragma unroll
    for (int d0 = 0; d0 < 4; ++d0) qr[d0] = *(const GAS bf16x8*)(Q + (qrow + r32) * 1024 + h * 64 + d0 * 16 + hi * 8);
    float mrun = sink2, l_reg = (hi == 0) ? 1.f : 0.f;
    f32x16 o[2];
#pragma unroll
    for (int r = 0; r < 16; ++r) { o[0][r] = 0.f; o[1][r] = 0.f; }
    const LAS unsigned char* vp0 = shm + LDS_V + ((lane >> 4) & 1) * 32 + (lane & 3) * 8 + (4 * hi + ((lane & 15) >> 2)) * 64;
    const int qw = q0 + wid * 32;
    asm volatile("s_waitcnt vmcnt(0) lgkmcnt(0)\n\ts_barrier" ::: "memory");
    for (int t = 0; t < NT; ++t) {
        const int slot = t & 1;
        if (t + 1 < NT) DMA_KV(t + 1, slot ^ 1);
        const bool latt = t < nl;
        const int ks = q0 - 128 + 64 * (jlo + t);
        bool need = true;
        if (latt) need = (ks + 63 >= qw - 128) && (ks <= qw + 31 + 128);
        if (need) {
            f32x16 p0, p1;
#pragma unroll
            for (int r = 0; r < 16; ++r) { p0[r] = 0.f; p1[r] = 0.f; }
            const LAS unsigned char* kb = shm + LDS_K + slot * SLOTB + hi * 1024 + r32 * 16;
#pragma unroll
            for (int d0 = 0; d0 < 4; ++d0) {
                const bf16x8 b0 = *(const LAS bf16x8*)(kb + d0 * 2048), b1 = *(const LAS bf16x8*)(kb + d0 * 2048 + 512);
                p0 = __builtin_amdgcn_mfma_f32_32x32x16_bf16(b0, qr[d0], p0, 0, 0, 0);
                p1 = __builtin_amdgcn_mfma_f32_32x32x16_bf16(b1, qr[d0], p1, 0, 0, 0); }
            if (latt) { const int dq = qw + r32 - ks;
#pragma unroll
                for (int r = 0; r < 16; ++r) { const int d = dq - crow(r, hi); if (d > 128 || d < -128) p0[r] = -INFINITY; if (d - 32 > 128 || d - 32 < -128) p1[r] = -INFINITY; } }
            const float rm = rowmax(p0, p1);
            if (__any(rm > mrun + 8.f)) {
                const float mnew = fmaxf(mrun, rm);
                const float alpha = __builtin_amdgcn_exp2f(mrun - mnew); l_reg *= alpha; mrun = mnew;
                if (hi == 0) wsf[r32] = alpha;
                asm volatile("s_waitcnt lgkmcnt(0)" ::: "memory");
#pragma unroll
                for (int r = 0; r < 16; ++r) { const float f = wsf[crow(r, hi)]; o[0][r] *= f; o[1][r] *= f; }
            }
            float sacc = 0.f;
#pragma unroll
            for (int r = 0; r < 16; ++r) { p0[r] = __builtin_amdgcn_exp2f(p0[r] - mrun); p1[r] = __builtin_amdgcn_exp2f(p1[r] - mrun); sacc += p0[r] + p1[r]; }
            l_reg += sacc;
            u32x4 pw0, pw1, pw2, pw3;
#define PKW(P, B) cvt_pk_bf16(P[B], P[B + 1])
            pw0 = (u32x4){PKW(p0, 0), PKW(p0, 2), PKW(p0, 4), PKW(p0, 6)}; pw1 = (u32x4){PKW(p0, 8), PKW(p0, 10), PKW(p0, 12), PKW(p0, 14)};
            pw2 = (u32x4){PKW(p1, 0), PKW(p1, 2), PKW(p1, 4), PKW(p1, 6)}; pw3 = (u32x4){PKW(p1, 8), PKW(p1, 10), PKW(p1, 12), PKW(p1, 14)};
#undef PKW
            __builtin_amdgcn_sched_barrier(0);
            pv(o, vp0 + slot * SLOTB, __builtin_bit_cast(bf16x8, pw0), __builtin_bit_cast(bf16x8, pw1), __builtin_bit_cast(bf16x8, pw2), __builtin_bit_cast(bf16x8, pw3));
        }
        asm volatile("s_waitcnt vmcnt(0) lgkmcnt(0)\n\ts_barrier" ::: "memory");
    }
    { auto rr = __builtin_amdgcn_permlane32_swap(__float_as_uint(l_reg), __float_as_uint(l_reg), false, false); l_reg = __uint_as_float(rr[0]) + __uint_as_float(rr[1]); }
    if (hi == 0) wsf[32 + r32] = l_reg;
    asm volatile("s_waitcnt lgkmcnt(0)" ::: "memory");
    float rli[16];
#pragma unroll
    for (int r = 0; r < 16; ++r) rli[r] = __builtin_amdgcn_rcpf(wsf[32 + crow(r, hi)]);
    unsigned char* Ow = (unsigned char*)O + qrow * 1024 + h * 64;
    { LAS unsigned char* stg = shm + LDS_OST + wid * 2048;
#pragma unroll
      for (int r = 0; r < 16; ++r) { const int orow = crow(r, hi);
#pragma unroll
          for (int d0 = 0; d0 < 2; ++d0) stg[orow * 64 + d0 * 32 + r32] = (unsigned char)f2f8(o[d0][r] * rli[r]); }
      asm volatile("s_waitcnt lgkmcnt(0)" ::: "memory");
#pragma unroll
      for (int i = 0; i < 2; ++i) { const int row = i * 16 + (lane >> 2), ch = lane & 3; const u32x4 v = *(const LAS u32x4*)(stg + row * 64 + ch * 16); *(GAS u32x4*)(Ow + (long)row * 1024 + ch * 16) = v; } }
    asm volatile("s_waitcnt lgkmcnt(0)" ::: "memory");
#undef TROW
#undef DMA_KV
}
}

struct Args {
    const float* in[20];
    float* out; unsigned char* ws;
};
struct Frame {
    LAS unsigned char* lds; unsigned* ctl; unsigned char* ws;
    int tid, lane, wave, gw;
    int blk;
    __device__ __forceinline__ void refresh() { tid = opaque_tid(); lane = tid & 63; wave = __builtin_amdgcn_readfirstlane(tid >> 6); gw = blk * 8 + wave;
        asm volatile("" : "+s"(ws)); ctl = (unsigned*)(ws + WS_CTL); }
};
constexpr int NGW = GRID * NWAVES;

struct Row { f32x4 v[4]; };
__device__ __forceinline__ int vq(int q, int lane) { return 64 * (lane >> 4) + 2 * (lane & 15) + 32 * (q >> 1) + (q & 1); }
__device__ __forceinline__ int vb(int j, int lane) { return 32 * (lane >> 4) + (lane & 15) + 16 * j; }
__device__ __forceinline__ void row_load_bf16(Row& r, const bf16_t* p, int lane) {
#pragma unroll
    for (int j = 0; j < 2; ++j) { const u32x4 w = ((const GAS u32x4*)p)[vb(j, lane)]; r.v[2 * j] = (f32x4){bflo(w.x), bfhi(w.x), bflo(w.y), bfhi(w.y)}; r.v[2 * j + 1] = (f32x4){bflo(w.z), bfhi(w.z), bflo(w.w), bfhi(w.w)}; } }
__device__ __forceinline__ void row_store_bf16(const Row& r, bf16_t* p, int lane) {
#pragma unroll
    for (int j = 0; j < 2; ++j) { u32x4 w; w.x = pk2(r.v[2 * j][0], r.v[2 * j][1]); w.y = pk2(r.v[2 * j][2], r.v[2 * j][3]); w.z = pk2(r.v[2 * j + 1][0], r.v[2 * j + 1][1]); w.w = pk2(r.v[2 * j + 1][2], r.v[2 * j + 1][3]); ((GAS u32x4*)p)[vb(j, lane)] = w; } }
typedef float f32x2v __attribute__((ext_vector_type(2)));
__device__ __forceinline__ void row_load_fp8(Row& r, const unsigned char* p, int lane) {
    const u32x4 w = ((const GAS u32x4*)p)[lane];
#pragma unroll
    for (int q = 0; q < 4; ++q) { const f32x2v lo = __builtin_amdgcn_cvt_pk_f32_fp8((int)w[q], false), hi = __builtin_amdgcn_cvt_pk_f32_fp8((int)w[q], true); r.v[q] = (f32x4){lo[0], lo[1], hi[0], hi[1]}; } }
__device__ __forceinline__ void row_store_fp8(const Row& r, unsigned char* p, int lane) {
    const int e0 = 256 * (lane >> 4) + 8 * (lane & 15);
#pragma unroll
    for (int j = 0; j < 2; ++j) { int w0 = 0, w1 = 0;
        w0 = __builtin_amdgcn_cvt_pk_fp8_f32(r.v[2 * j][0], r.v[2 * j][1], w0, false); w0 = __builtin_amdgcn_cvt_pk_fp8_f32(r.v[2 * j][2], r.v[2 * j][3], w0, true);
        w1 = __builtin_amdgcn_cvt_pk_fp8_f32(r.v[2 * j + 1][0], r.v[2 * j + 1][1], w1, false); w1 = __builtin_amdgcn_cvt_pk_fp8_f32(r.v[2 * j + 1][2], r.v[2 * j + 1][3], w1, true);
        u32x2 o; o.x = (unsigned)w0; o.y = (unsigned)w1; *(GAS u32x2*)(p + e0 + 128 * j) = o; } }
__device__ __forceinline__ void row_load_f32(Row& r, const float* p, int lane) {
#pragma unroll
    for (int q = 0; q < 4; ++q) r.v[q] = ((const GAS f32x4*)p)[vq(q, lane)]; }
__device__ __forceinline__ void row_store_f32(const Row& r, float* p, int lane) {
#pragma unroll
    for (int q = 0; q < 4; ++q) ((GAS f32x4*)p)[vq(q, lane)] = r.v[q]; }
__device__ __forceinline__ void row_normalize(Row& r, float eps) {
    float s = 0.f;
#pragma unroll
    for (int j = 0; j < 4; ++j) s += (r.v[j][0] + r.v[j][1]) + (r.v[j][2] + r.v[j][3]);
    const float mean = wave_sum(s) * (1.f / D); float q = 0.f;
#pragma unroll
    for (int j = 0; j < 4; ++j) { r.v[j] = r.v[j] - mean; q += (r.v[j][0] * r.v[j][0] + r.v[j][1] * r.v[j][1]) + (r.v[j][2] * r.v[j][2] + r.v[j][3] * r.v[j][3]); }
    const float rstd = 1.f / sqrtf(wave_sum(q) * (1.f / D) + eps);
#pragma unroll
    for (int j = 0; j < 4; ++j) r.v[j] = r.v[j] * rstd;
}
__device__ __forceinline__ void row_modulate(Row& r, const float* sh, const float* sc, int lane) {
    row_normalize(r, MOD_EPS);
#pragma unroll
    for (int j = 0; j < 4; ++j) { const f32x4 a = ((const GAS f32x4*)sc)[vq(j, lane)], b = ((const GAS f32x4*)sh)[vq(j, lane)]; r.v[j] = r.v[j] * (a + 1.f) + b; }
}
__device__ __forceinline__ int mod_row(int row) { return row < T ? (row >> 11) : 32; }
__device__ __forceinline__ const float* mod_vec(const unsigned char* ws, int layer, int mr, int chunk) { return (const float*)(ws + WS_MOD) + ((size_t)(layer * 33 + mr) * 6 + chunk) * 1024; }

__device__ __forceinline__ void conv_item(const float* W, int N, bf16_t* WT, int Kd, int kd0, int n0, int drow0, bool mirror, LAS float* scr, int lane) {
#pragma unroll 8
    for (int i = 0; i < 32; ++i) { const int kk = 2 * i + (lane >> 5); const int kd = kd0 + kk; const int ks = mirror ? ((kd & ~255) + ((256 - (kd & 255)) & 255)) : kd;
        scr[kk * 33 + (lane & 31)] = ((const GAS float*)W)[(size_t)ks * N + n0 + (lane & 31)]; }
    LDS_WAIT(); asm volatile("" ::: "memory");
    const int c = lane & 7;
#pragma unroll
    for (int j = 0; j < 4; ++j) { const int n = (lane >> 3) + 8 * j; const LAS float* s = scr + (8 * c) * 33 + n;
        u32x4 o; o.x = pk2(s[0 * 33], s[1 * 33]); o.y = pk2(s[2 * 33], s[3 * 33]); o.z = pk2(s[4 * 33], s[5 * 33]); o.w = pk2(s[6 * 33], s[7 * 33]);
        *(GAS u32x4*)(WT + (size_t)(drow0 + n) * Kd + kd0 + 8 * c) = o; }
    LDS_WAIT(); asm volatile("" ::: "memory");
}
__device__ __forceinline__ void conv_matrix_item(const float* W, int K, int N, bf16_t* WT, int mode, int roff, int item, LAS float* scr, int lane) {
    const int nblk = N / 32, kb = item / nblk, nb = item % nblk, n0 = 32 * nb;
    int drow0 = n0 + roff; if (mode == 1) drow0 = (n0 >> 7) * 256 + (n0 & 127); if (mode == 2) drow0 = (n0 >> 7) * 256 + 128 + (n0 & 127);
    conv_item(W, N, WT, K, 64 * kb, n0, drow0, mode == 3, scr, lane);
}
__device__ __forceinline__ void conv_item64(const float* W, int N, bf16_t* WT, int Kd, int k0, int n0, int drow0, LAS bf16_t* scr, int lane) {
    f32x4 v[16];
#pragma unroll
    for (int i = 0; i < 16; ++i) v[i] = *(const GAS f32x4*)(W + (size_t)(k0 + 4 * i + (lane >> 4)) * N + n0 + (lane & 15) * 4);
#pragma unroll
    for (int i = 0; i < 16; ++i) { u32x2 w; w.x = pk2(v[i][0], v[i][1]); w.y = pk2(v[i][2], v[i][3]); *(LAS u32x2*)(scr + (4 * i + (lane >> 4)) * 68 + (lane & 15) * 4) = w; }
    LDS_WAIT(); asm volatile("" ::: "memory");
    const int c = lane & 7;
#pragma unroll
    for (int j = 0; j < 8; ++j) { const int n = (lane >> 3) + 8 * j; const LAS bf16_t* p = scr + (8 * c) * 68 + n;
        u32x4 o; o.x = (unsigned)p[0] | ((unsigned)p[68] << 16); o.y = (unsigned)p[2 * 68] | ((unsigned)p[3 * 68] << 16); o.z = (unsigned)p[4 * 68] | ((unsigned)p[5 * 68] << 16); o.w = (unsigned)p[6 * 68] | ((unsigned)p[7 * 68] << 16);
        *(GAS u32x4*)(WT + (size_t)(drow0 + n) * Kd + k0 + 8 * c) = o; }
    LDS_WAIT(); asm volatile("" ::: "memory");
}
__device__ __forceinline__ void conv_item64_f8(const float* W, int N, unsigned char* WT, int Kd, int k0, int n0, int drow0, LAS unsigned char* scr, int lane, bool mirror = false) {
    f32x4 v[16];
#pragma unroll
    for (int i = 0; i < 16; ++i) { const int kd = k0 + 4 * i + (lane >> 4); const int ks = mirror ? ((kd & ~255) + ((256 - (kd & 255)) & 255)) : kd; v[i] = *(const GAS f32x4*)(W + (size_t)ks * N + n0 + (lane & 15) * 4); }
#pragma unroll
    for (int i = 0; i < 16; ++i) { int w = 0; w = __builtin_amdgcn_cvt_pk_fp8_f32(v[i][0] * 64.f, v[i][1] * 64.f, w, false); w = __builtin_amdgcn_cvt_pk_fp8_f32(v[i][2] * 64.f, v[i][3] * 64.f, w, true);
        *(LAS unsigned*)(scr + (4 * i + (lane >> 4)) * 68 + (lane & 15) * 4) = (unsigned)w; }
    LDS_WAIT(); asm volatile("" ::: "memory");
    const int c = lane & 3;
#pragma unroll
    for (int j = 0; j < 4; ++j) { const int n = (lane >> 2) + 16 * j; const LAS unsigned char* p = scr + (16 * c) * 68 + n; u32x4 o;
#pragma unroll
        for (int q = 0; q < 4; ++q) o[q] = (unsigned)p[(4 * q) * 68] | ((unsigned)p[(4 * q + 1) * 68] << 8) | ((unsigned)p[(4 * q + 2) * 68] << 16) | ((unsigned)p[(4 * q + 3) * 68] << 24);
        *(GAS u32x4*)(WT + (size_t)(drow0 + n) * Kd + k0 + 16 * c) = o; }
    LDS_WAIT(); asm volatile("" ::: "memory");
}
__device__ __forceinline__ void conv_experts(Frame& F, const Args& a, int layer) {
    F.refresh();
    LAS unsigned char* scr = F.lds + 32768 + F.wave * 4352;
    unsigned char* EGU = F.ws + WS_EGU; unsigned char* ED = F.ws + WS_ED;
    for (int it = F.gw; it < (NE + 1) * 192; it += NGW) { const int e = it / 192, r = it % 192;
        const float* wg = e < NE ? a.in[14] + ((size_t)layer * NE + e) * 262144 : a.in[17] + (size_t)layer * 262144;
        const float* wu = e < NE ? a.in[15] + ((size_t)layer * NE + e) * 262144 : a.in[18] + (size_t)layer * 262144;
        const float* wd = e < NE ? a.in[16] + ((size_t)layer * NE + e) * 262144 : a.in[19] + (size_t)layer * 262144;
        if (r < 128) { const int q = r & 63, kb = q >> 2, nb = q & 3, n0 = 64 * nb; const int drow0 = (n0 >> 7) * 256 + (r < 64 ? 0 : 128) + (n0 & 127);
            conv_item64_f8(r < 64 ? wg : wu, 256, EGU + (size_t)e * 512 * 1024, 1024, 64 * kb, n0, drow0, scr, F.lane); }
        else { const int q = r - 128, kb = q >> 4, nb = q & 15; conv_item64_f8(wd, 1024, ED + (size_t)e * 1024 * 256, 256, 64 * kb, 64 * nb, 64 * nb, scr, F.lane); } }
}
__device__ __forceinline__ void conv_small(Frame& F, const Args& a) {
    F.refresh();
    { LAS unsigned char* scr8 = F.lds + 32768 + F.wave * 4352;
      for (int it = F.gw; it < 2304; it += NGW) {
          if (it < 768) { const int j = it / 384, r = it % 384, kb = r / 24, nb = r % 24; conv_item64_f8(a.in[8] + (size_t)j * 1024 * 1536, 1536, F.ws + WS_WQKV + (size_t)j * 1536 * 1024, 1024, 64 * kb, 64 * nb, 64 * nb, scr8, F.lane); }
          else if (it < 1280) { const int q = it - 768, j = q >> 8, r = q & 255, kb = r >> 4, nb = r & 15; conv_item64_f8(a.in[9] + (size_t)j * 1024 * 1024, 1024, F.ws + WS_WO + (size_t)j * 1024 * 1024, 1024, 64 * kb, 64 * nb, 64 * nb, scr8, F.lane); }
          else { const int q = it - 1280, j = q >> 9, r = q & 511, mir = r >> 8, kb = (r & 255) >> 4, nb = r & 15;
              conv_item64_f8(a.in[11] + (size_t)j * 1024 * 1024, 1024, F.ws + WS_WSH + (size_t)j * 2048 * 1024, 1024, 64 * kb, 64 * nb, 64 * nb + 1024 * mir, scr8, F.lane, mir != 0); } } }
    __syncthreads();
    { LAS float* scr = (LAS float*)(F.lds + 32768 + F.wave * 8448);
      for (int it = F.gw; it < 1152; it += NGW) {
          if (it < 1024) { const int j = it >> 9, r = it & 511; conv_matrix_item(a.in[11] + (size_t)j * 1024 * 1024, 1024, 1024, (bf16_t*)(F.ws + WS_WF) + (size_t)j * 2048 * 1024, 0, 0, r, scr, F.lane); }
          else { const int q = it - 1024, l = q / 32, r = q % 32; conv_matrix_item(a.in[12] + (size_t)l * 1024 * 64, 1024, 64, (bf16_t*)(F.ws + WS_WR) + (size_t)l * 64 * 1024, 0, 0, r, scr, F.lane); } } }
    const int gt = F.blk * NTHR + F.tid, NGT = GRID * NTHR;
    const float TWO_PI = 6.283185307179586f;
    { float* rc = (float*)(F.ws + WS_ROPEC); float* rs = (float*)(F.ws + WS_ROPES);
      for (int i = gt; i < 64 * 16; i += NGT) { const int pos = i >> 4, fi = i & 15; const float inv = exp2f(-(float)fi * (13.287712379549449f / 16.f)); const float ang = (float)pos * inv; rc[i] = cosf(ang); rs[i] = sinf(ang); } }
    { unsigned* cs = (unsigned*)(F.ws + WS_CSN);
      for (int i = gt; i < 512 * 64; i += NGT) { const int r = i >> 6, n4 = (i & 63) * 4, m = r & 255; unsigned w = 0;
#pragma unroll
          for (int q = 0; q < 4; ++q) { const float ang = TWO_PI * (float)((m * (n4 + q)) & 255) * (1.f / 256.f); w |= f2f8(r < 256 ? __cosf(ang) : -__sinf(ang)) << (8 * q); }
          cs[i] = w; } }
    { unsigned* dl = (unsigned*)(F.ws + WS_DL);
      for (int i = gt; i < 1024 * 1024; i += NGT) { const int k = i >> 10, c4 = (i & 1023) * 4; unsigned w = 0;
#pragma unroll
          for (int q = 0; q < 4; ++q) { const int c = c4 + q, l = c & 2047; const float ang = TWO_PI * (float)((k * l) & 2047) * (1.f / 2048.f); w |= f2f8(c < 2048 ? __cosf(ang) : __sinf(ang)) << (8 * q); }
          dl[i] = w; } }
    { unsigned* dl = (unsigned*)(F.ws + WS_DLC);
      for (int i = gt; i < 256 * 128; i += NGT) { const int k = i >> 7, c4 = (i & 127) * 4; unsigned w = 0;
#pragma unroll
          for (int q = 0; q < 4; ++q) { const int c = c4 + q, l = c & 255; const float ang = TWO_PI * (float)((k * l) & 255) * (1.f / 256.f); w |= f2f8(c < 256 ? __cosf(ang) : __sinf(ang)) << (8 * q); }
          dl[i] = w; } }
}
__device__ __forceinline__ void mod_full(Frame& F, const Args& a) {
    F.refresh();
    if (F.blk >= 192) return;
    const int l = F.blk / 48, cb = F.blk % 48; const int col = F.tid & 127, ks = F.tid >> 7; const int n = cb * 128 + col;
    LAS float* s = (LAS float*)F.lds;
    float acc[33];
#pragma unroll
    for (int r = 0; r < 33; ++r) acc[r] = 0.f;
    for (int half = 0; half < 2; ++half) {
        __syncthreads();
        for (int i = F.tid; i < 512 * 33; i += NTHR) { const int k = i / 33, r = i % 33; const float c = (r < 32) ? a.in[1][(size_t)r * 1024 + half * 512 + k] : a.in[3][half * 512 + k]; s[k * 36 + r] = c / (1.f + __expf(-c)); }
        __syncthreads();
        const GAS float* w = (const GAS float*)a.in[4] + ((size_t)l * 1024 + half * 512 + ks * 128) * 6144 + n;
#pragma unroll 1
        for (int kb = 0; kb < 128; kb += 16) { float wv[16];
#pragma unroll
            for (int q = 0; q < 16; ++q) wv[q] = w[(size_t)(kb + q) * 6144];
#pragma unroll
            for (int q = 0; q < 16; ++q) { const LAS float* sr = s + (ks * 128 + kb + q) * 36;
#pragma unroll
                for (int r = 0; r < 33; ++r) acc[r] += sr[r] * wv[q];
                asm volatile("" ::: "memory"); } }
    }
    __syncthreads();
    LAS float* red = (LAS float*)F.lds;
#pragma unroll
    for (int r = 0; r < 33; ++r) red[(ks * 33 + r) * 128 + col] = acc[r];
    __syncthreads();
    float* mod = (float*)(F.ws + WS_MOD);
    for (int i = F.tid; i < 33 * 128; i += NTHR) { const int r = i >> 7, c = i & 127; const int nn = cb * 128 + c;
        mod[((size_t)l * 33 + r) * 6144 + nn] = a.in[5][l * 6144 + nn] + (red[(0 * 33 + r) * 128 + c] + red[(1 * 33 + r) * 128 + c]) + (red[(2 * 33 + r) * 128 + c] + red[(3 * 33 + r) * 128 + c]); }
    __syncthreads();
}
__device__ __forceinline__ void rows_init(Frame& F, const Args& a) {
    F.refresh();
    bf16_t* XS = (bf16_t*)(F.ws + WS_XS);
    for (int r0 = F.gw; r0 < TT; r0 += 2 * NGW) { const int r1 = r0 + NGW; const bool two = r1 < TT;
        Row r[2];
#pragma unroll
        for (int t = 0; t < 2; ++t) if (t == 0 || two) { const int row = t ? r1 : r0; row_load_f32(r[t], row < T ? a.in[0] + (size_t)row * D : a.in[2] + (size_t)(row - T) * D, F.lane); }
#pragma unroll
        for (int t = 0; t < 2; ++t) if (t == 0 || two) { const int row = t ? r1 : r0; const int mr = mod_row(row);
            row_store_bf16(r[t], XS + (size_t)row * D, F.lane);
            row_modulate(r[t], mod_vec(F.ws, 0, mr, 0), mod_vec(F.ws, 0, mr, 1), F.lane);
            row_store_fp8(r[t], (unsigned char*)a.out + OUT_U8 + (size_t)row * D, F.lane); } }
}
__device__ __forceinline__ void rows_post1(Frame& F, const Args& a, int layer, int nrows) {
    F.refresh();
    bf16_t* XS = (bf16_t*)(F.ws + WS_XS); bf16_t* U = (bf16_t*)a.out;
    const float* lg = a.in[6] + (size_t)(layer * 2 + 0) * D; const float* lb = a.in[7] + (size_t)(layer * 2 + 0) * D;
    const int TPB = nrows / GRID;
    for (int rl = F.wave; rl < TPB; rl += 2 * NWAVES) {
        const bool two = rl + NWAVES < TPB;
        Row x[2], y[2];
#pragma unroll
        for (int t = 0; t < 2; ++t) if (t == 0 || two) { const int row = F.blk * TPB + rl + t * NWAVES; row_load_bf16(x[t], XS + (size_t)row * D, F.lane); row_load_bf16(y[t], U + (size_t)row * D, F.lane); }
#pragma unroll
        for (int t = 0; t < 2; ++t) if (t == 0 || two) { const int row = F.blk * TPB + rl + t * NWAVES; const int mr = mod_row(row);
            const float* g1 = mod_vec(F.ws, layer, mr, 2);
#pragma unroll
            for (int j = 0; j < 4; ++j) x[t].v[j] = x[t].v[j] * ALPHA + ((const GAS f32x4*)g1)[vq(j, F.lane)] * y[t].v[j];
            row_normalize(x[t], LN_EPS);
#pragma unroll
            for (int j = 0; j < 4; ++j) x[t].v[j] = x[t].v[j] * ((const GAS f32x4*)lg)[vq(j, F.lane)] + ((const GAS f32x4*)lb)[vq(j, F.lane)];
            row_store_bf16(x[t], XS + (size_t)row * D, F.lane);
            row_modulate(x[t], mod_vec(F.ws, layer, mr, 3), mod_vec(F.ws, layer, mr, 4), F.lane);
            row_store_bf16(x[t], U + (size_t)row * D, F.lane);
            row_store_fp8(x[t], (unsigned char*)a.out + OUT_U8 + (size_t)row * D, F.lane); }
    }
}
__device__ __forceinline__ void rows_post2(Frame& F, const Args& a, int layer, int t0, int n) {
    F.refresh();
    bf16_t* XS = (bf16_t*)(F.ws + WS_XS); const unsigned char* YB = (const unsigned char*)(F.ws + WS_YB); const unsigned char* YS = (const unsigned char*)(F.ws + WS_YS);
    const int* spos = (const int*)(F.ws + WS_SDST); const float* tkw = (const float*)(F.ws + WS_TKW);
    const float* lg = a.in[6] + (size_t)(layer * 2 + 1) * D; const float* lb = a.in[7] + (size_t)(layer * 2 + 1) * D;
    for (int i0 = F.gw; i0 < n; i0 += 2 * NGW) {
        const int i1 = i0 + NGW; const bool two = i1 < n;
        int pj[2]; float wj[2];
#pragma unroll
        for (int t = 0; t < 2; ++t) { pj[t] = 0; wj[t] = 0.f; const int row = t0 + (t ? i1 : i0); if ((t == 0 || two) && F.lane < 8) { pj[t] = ((const GAS int*)spos)[(size_t)row * 8 + F.lane]; wj[t] = ((const GAS float*)tkw)[(size_t)row * 8 + F.lane]; } }
        Row x[2], y[2];
#pragma unroll
        for (int t = 0; t < 2; ++t) { const int i = t ? i1 : i0; if (t == 0 || two) { row_load_bf16(x[t], XS + (size_t)(t0 + i) * D, F.lane); row_load_fp8(y[t], YS + (size_t)i * D, F.lane); } }
        u32x4 zr[2][8];
#pragma unroll
        for (int t = 0; t < 2; ++t) if (t == 0 || two) {
#pragma unroll
            for (int s = 0; s < 8; ++s) { const int ps = __builtin_amdgcn_readlane(pj[t], s); zr[t][s] = ((const GAS u32x4*)(YB + (size_t)ps * D))[F.lane]; } }
#pragma unroll
        for (int t = 0; t < 2; ++t) if (t == 0 || two) { const int i = t ? i1 : i0; const int row = t0 + i; const int mr = mod_row(row);
#pragma unroll
            for (int j = 0; j < 4; ++j) y[t].v[j] = y[t].v[j] * (1.f / 16.f);
#pragma unroll
            for (int s = 0; s < 8; ++s) { const float wz = __builtin_bit_cast(float, __builtin_amdgcn_readlane(__builtin_bit_cast(int, wj[t]), s)) * (1.f / 16.f);
#pragma unroll
                for (int j = 0; j < 4; ++j) { const f32x2v lo = __builtin_amdgcn_cvt_pk_f32_fp8((int)zr[t][s][j], false), hi = __builtin_amdgcn_cvt_pk_f32_fp8((int)zr[t][s][j], true); y[t].v[j] += (f32x4){lo[0], lo[1], hi[0], hi[1]} * wz; } }
            const float* g2 = mod_vec(F.ws, layer, mr, 5);
#pragma unroll
            for (int j = 0; j < 4; ++j) x[t].v[j] = x[t].v[j] * ALPHA + ((const GAS f32x4*)g2)[vq(j, F.lane)] * y[t].v[j];
            row_normalize(x[t], LN_EPS);
#pragma unroll
            for (int j = 0; j < 4; ++j) x[t].v[j] = x[t].v[j] * ((const GAS f32x4*)lg)[vq(j, F.lane)] + ((const GAS f32x4*)lb)[vq(j, F.lane)];
            if (layer == 3) { row_store_f32(x[t], a.out + (size_t)row * D, F.lane); }
            else { row_store_bf16(x[t], XS + (size_t)row * D, F.lane);
                row_modulate(x[t], mod_vec(F.ws, layer + 1, mr, 0), mod_vec(F.ws, layer + 1, mr, 1), F.lane);
                row_store_fp8(x[t], (unsigned char*)a.out + OUT_U8 + (size_t)row * D, F.lane); } }
    }
}
__device__ __forceinline__ float wave_max_dpp(float v) {
    int x = __builtin_bit_cast(int, v);
#define DPPMAX(ctrl) { const int y = __builtin_amdgcn_update_dpp(x, x, ctrl, 0xf, 0xf, false); x = __builtin_bit_cast(int, fmaxf(__builtin_bit_cast(float, x), __builtin_bit_cast(float, y))); }
    DPPMAX(0xB1) DPPMAX(0x4E) DPPMAX(0x141) DPPMAX(0x140)
#undef DPPMAX
    const float r0 = __builtin_bit_cast(float, __builtin_amdgcn_readlane(x, 0)), r1 = __builtin_bit_cast(float, __builtin_amdgcn_readlane(x, 16));
    const float r2 = __builtin_bit_cast(float, __builtin_amdgcn_readlane(x, 32)), r3 = __builtin_bit_cast(float, __builtin_amdgcn_readlane(x, 48));
    return fmaxf(fmaxf(r0, r1), fmaxf(r2, r3));
}
__device__ __forceinline__ void route_tokens(Frame& F, const Args& a, int layer, int ntok) {
    F.refresh();
    const int TPB = ntok / GRID;
    const bf16_t* U = (const bf16_t*)a.out; const bf16_t* Wr = (const bf16_t*)(F.ws + WS_WR) + (size_t)layer * 64 * 1024;
    int* tke = (int*)(F.ws + WS_TKE); float* tkw = (float*)(F.ws + WS_TKW);
    LAS int* lcnt = (LAS int*)(F.lds + L_LCNT);
    LAS float* lg = (LAS float*)(F.lds);
    if (F.tid < 64) lcnt[F.tid] = 0;
    const int lane = F.lane, fr = lane & 15, fq = lane >> 4;
    const int ntile = TPB / 16;
    for (int tl = F.wave; tl < ntile; tl += NWAVES) {
        const int t0 = F.blk * TPB + tl * 16;
        f32x4 acc[4];
#pragma unroll
        for (int n = 0; n < 4; ++n) acc[n] = (f32x4){0.f, 0.f, 0.f, 0.f};
        const GAS bf16x8* ap = (const GAS bf16x8*)(U + (size_t)(t0 + fr) * D + fq * 8);
        const GAS bf16x8* bp = (const GAS bf16x8*)(Wr + (size_t)fr * D + fq * 8);
#pragma unroll 8
        for (int ks = 0; ks < 32; ++ks) { const bf16x8 av = ap[ks * 4];
#pragma unroll
            for (int n = 0; n < 4; ++n) { const bf16x8 bv = bp[(size_t)n * 16 * (D / 8) + ks * 4]; acc[n] = __builtin_amdgcn_mfma_f32_16x16x32_bf16(av, bv, acc[n], 0, 0, 0); } }
#pragma unroll
        for (int n = 0; n < 4; ++n)
#pragma unroll
            for (int j = 0; j < 4; ++j) lg[(tl * 16 + fq * 4 + j) * 65 + n * 16 + fr] = acc[n][j];
    }
    __syncthreads();
    if (F.tid < TPB) {
        const int tok = F.blk * TPB + F.tid; const LAS float* row = lg + F.tid * 65; const float* bias = a.in[13] + layer * 64;
        float sg[64], sel[64];
#pragma unroll
        for (int e = 0; e < 64; ++e) { sg[e] = 1.f / (1.f + __expf(-row[e])); sel[e] = sg[e] + bias[e]; }
        float gs[8];
#pragma unroll
        for (int g = 0; g < 8; ++g) { float m1 = -INFINITY, m2 = -INFINITY;
#pragma unroll
            for (int j = 0; j < 8; ++j) { const float v = sel[g * 8 + j]; const bool gt1 = v > m1; m2 = gt1 ? m1 : fmaxf(m2, v); m1 = gt1 ? v : m1; }
            gs[g] = m1 + m2; }
        unsigned gok = 0;
#pragma unroll
        for (int g = 0; g < 8; ++g) { int rk = 0;
#pragma unroll
            for (int h = 0; h < 8; ++h) rk += (gs[h] > gs[g] || (gs[h] == gs[g] && h < g)) ? 1 : 0;
            gok |= (rk < 4 ? 1u : 0u) << g; }
#pragma unroll
        for (int e = 0; e < 64; ++e) sel[e] = ((gok >> (e >> 3)) & 1u) ? sel[e] : -INFINITY;
        int ce[8]; float cw[8]; float tot = 0.f;
#pragma unroll
        for (int it = 0; it < 8; ++it) { float best = -INFINITY, bs = 0.f; int bi = 0;
#pragma unroll
            for (int e = 0; e < 64; ++e) { const bool b = sel[e] > best; best = b ? sel[e] : best; bs = b ? sg[e] : bs; bi = b ? e : bi; }
#pragma unroll
            for (int e = 0; e < 64; ++e) sel[e] = (e == bi) ? -INFINITY : sel[e];
            ce[it] = bi; cw[it] = bs; tot += bs; }
        const float sc = 2.5f / tot;
#pragma unroll
        for (int it = 0; it < 8; ++it) { tke[(size_t)tok * 8 + it] = ce[it]; tkw[(size_t)tok * 8 + it] = cw[it] * sc; __hip_atomic_fetch_add(&lcnt[ce[it]], 1, __ATOMIC_RELAXED, __HIP_MEMORY_SCOPE_WORKGROUP); }
    }
    __syncthreads();
    if (F.tid < 64) F.ctl[CW_BCNT + F.blk * 64 + F.tid] = (unsigned)lcnt[F.tid];
}
__device__ __forceinline__ void build_lists(Frame& F, int ntok) {
    F.refresh();
    constexpr int NSEG = NCHUNK * 64, BPC = GRID / NCHUNK;
    const int TPB = ntok / GRID, CH = ntok / NCHUNK;
    LAS int* tstart = (LAS int*)(F.lds + L_TSTART); LAS int* pref = (LAS int*)(F.lds + L_PREF); LAS int* lcnt = (LAS int*)(F.lds + L_LCNT);
    LAS unsigned char* tseg = (LAS unsigned char*)(F.lds + L_TSEG); LAS int* scan = (LAS int*)(F.lds + L_SCAN);
    const unsigned* bcnt = F.ctl + CW_BCNT;
    const int myc = F.blk / BPC, mylb = F.blk % BPC;
    int nseg = 0;
    LAS int* cntl = (LAS int*)F.lds;
    for (int i = F.tid; i < GRID * 64; i += NTHR) cntl[i] = (int)((const GAS unsigned*)bcnt)[i];
    if (F.tid < 64) lcnt[F.tid] = 0;
    __syncthreads();
    if (F.tid < NSEG) { const int c = F.tid >> 6, e = F.tid & 63; int n = 0, p = 0;
        for (int lb = 0; lb < BPC; ++lb) { const int v = cntl[(c * BPC + lb) * 64 + e]; if (c == myc && lb < mylb) p += v; n += v; }
        nseg = n; scan[F.tid] = (n + 255) >> 8; if (c == myc) pref[e] = p; }
    __syncthreads();
    if (F.tid == 0) { int acc = 0; for (int s = 0; s < NSEG; ++s) { tstart[s] = acc; acc += scan[s]; } tstart[NSEG] = acc; }
    __syncthreads();
    if (F.tid < NSEG) { const int t0 = tstart[F.tid], t1 = tstart[F.tid + 1]; for (int t = t0; t < t1; ++t) tseg[t] = (unsigned char)F.tid; }
    int* stok = (int*)(F.ws + WS_STOK); int* spos = (int*)(F.ws + WS_SDST);
    const int* tke = (const int*)(F.ws + WS_TKE);
    { const int sseg = myc * 64 + mylb; if (mylb < 64 && F.tid == sseg) scan[0] = nseg; }
    __syncthreads();
    if (mylb < 64) { const int sseg = myc * 64 + mylb; const int n = scan[0]; const int base = tstart[sseg] * 256, end = tstart[sseg + 1] * 256;
      for (int p = base + n + F.tid; p < end; p += NTHR) stok[p] = myc * CH; }
    for (int tl = F.wave; tl < TPB; tl += NWAVES) { const int tok = F.blk * TPB + tl;
        if (F.lane < 8) { const int e = tke[(size_t)tok * 8 + F.lane];
            const int p = tstart[myc * 64 + e] * 256 + pref[e] + __hip_atomic_fetch_add(&lcnt[e], 1, __ATOMIC_RELAXED, __HIP_MEMORY_SCOPE_WORKGROUP);
            stok[p] = tok; spos[(size_t)tok * 8 + F.lane] = p - tstart[myc * 64] * 256; } }
    __syncthreads();
}

struct SchedQKV {
    const char* U; const char* W; int nfull, nu, c;
    __device__ __forceinline__ bool next(int i, pg::Unit& u) const {
        const int L0 = i * GRID + c; if (L0 >= nu) return false;
        int pm, pn;
        if (L0 < nfull) { const int L = pg::xcd_remap(L0, nfull); const int gid = L / 48, w = L % 48; pm = gid * 8 + (w & 7); pn = w >> 3; }
        else { const int q = L0 - nfull; pm = 256 + (q >> 1); pn = 4 + (q & 1); }
        u.A = U + (size_t)pm * 256 * 1024; u.B = W + (size_t)pn * 256 * 1024; u.gidx = nullptr; u.gbase = 0; u.nt = 8; u.out = nullptr; u.ldc = 0; u.scale = 1.f; u.flags = 0; u.i0 = pm; u.i1 = pn;
        return true; }
};
struct SchedDense {
    const char* A; const char* W; char* out; int nrt, nct, nt, c; size_t ldA;
    __device__ __forceinline__ bool next(int i, pg::Unit& u) const {
        const int nu = nrt * nct; const int L0 = i * GRID + c; if (L0 >= nu) return false;
        const int L = pg::xcd_remap(L0, nu); const int per = 8 * nct, gid = L / per, w = L % per, fm = gid * 8, gsz = (nrt - fm) < 8 ? (nrt - fm) : 8; const int pm = fm + (w % gsz), pn = w / gsz;
        u.A = A + (size_t)pm * 256 * ldA; u.B = W + (size_t)pn * 256 * ldA; u.gidx = nullptr; u.gbase = 0; u.nt = nt; u.out = out + (size_t)pm * 256 * 2048 + pn * 512; u.ldc = 2048; u.scale = 1.f; u.flags = 0; u.i0 = pm; u.i1 = pn;
        return true; }
};
struct SchedF1 {
    const char* CS; const char* U; char* ABT; char* ABTC; int nu, c;
    __device__ __forceinline__ bool next(int i, pg::Unit& u) const {
        const int L0 = i * GRID + c; if (L0 >= nu) return false;
        u.gidx = nullptr; u.gbase = 0; u.nt = 2; u.scale = 1.f; u.flags = 0; u.i0 = 0; u.i1 = 0;
        if (L0 < 2048) { const int L = pg::xcd_remap(L0, 2048); const int pm = L & 1, pn = (L >> 1) & 7, bg = L >> 4, b = bg >> 2, g = bg & 3;
            u.A = CS + (size_t)pm * 256 * 256; u.B = U + ((size_t)b * SEQ + pn * 256) * 1024 + g * 256; u.out = ABT + (size_t)bg * 256 * 4096 + (size_t)(pm * 2048 + pn * 256); u.ldc = 4096; }
        else { const int q = L0 - 2048; const int pm = q & 1, bg = q >> 1, b = bg >> 2, g = bg & 3;
            u.A = CS + (size_t)pm * 256 * 256; u.B = U + ((size_t)T + b * CTXL) * 1024 + g * 256; u.out = ABTC + (size_t)bg * 256 * 512 + (size_t)pm * 256; u.ldc = 512; }
        return true; }
};
struct SchedF2 {
    const char* DL; const char* ABT; char* FH; int c;
    __device__ __forceinline__ bool next(int i, pg::Unit& u) const {
        const int L0 = i * GRID + c; if (L0 >= 512) return false;
        const int L = pg::xcd_remap(L0, 512); const int pm = L & 3, bg = L >> 2, b = bg >> 2, g = bg & 3;
        u.A = DL + (size_t)pm * 256 * 4096; u.B = ABT + (size_t)bg * 256 * 4096; u.gidx = nullptr; u.gbase = 0; u.nt = 32; u.out = FH + ((size_t)b * 1024 + pm * 256) * 1024 + g * 256; u.ldc = 1024; u.scale = 0.001381067932004975f  ; u.flags = 0; u.i0 = 0; u.i1 = 0;
        return true; }
};
struct SchedF2c {
    const char* DLC; const char* ABTC; char* FC; int c;
    __device__ __forceinline__ bool next(int i, pg::Unit& u) const {
        const int L0 = i * GRID + c; if (L0 >= 128) return false;
        const int bg = L0, b = bg >> 2, g = bg & 3;
        u.A = DLC; u.B = ABTC + (size_t)bg * 256 * 512; u.gidx = nullptr; u.gbase = 0; u.nt = 4; u.out = FC + ((size_t)b * 256) * 1024 + g * 256; u.ldc = 1024; u.scale = 1.f / 256.f; u.flags = 0; u.i0 = 0; u.i1 = 0;
        return true; }
};
struct SchedF3 {
    const char* FH; const char* FC; const char* W; char* Y; int nu, c;
    __device__ __forceinline__ bool next(int i, pg::Unit& u) const {
        const int L0 = i * GRID + c; if (L0 >= nu) return false;
        u.gidx = nullptr; u.gbase = 0; u.nt = 8; u.scale = 1.f; u.flags = 0; u.i0 = 0; u.i1 = 0;
        if (L0 < 1024) { const int L = pg::xcd_remap(L0, 1024); const int gid = L >> 6, w = L & 63, pm = gid * 8 + (w & 7), pn = w >> 3; const int b = pm >> 2, k0 = (pm & 3) * 256;
            u.A = FH + (size_t)pm * 256 * 1024; u.B = W + (size_t)pn * 256 * 1024;
            if (pn < 4) { u.out = Y + ((size_t)b * SEQ + k0) * 2048 + pn * 512; u.ldc = 2048; }
            else { u.out = Y + ((size_t)b * SEQ + SEQ - k0) * 2048 + (pn - 4) * 512; u.ldc = -2048; u.flags = (k0 == 0) ? 1 : 0; } }
        else { const int q = L0 - 1024; const int pm = q >> 2, pn = q & 3;
            u.A = FC + (size_t)pm * 256 * 1024; u.B = W + (size_t)pn * 256 * 1024; u.out = Y + ((size_t)T + pm * 256) * 2048 + pn * 512; u.ldc = 2048; }
        return true; }
};
struct SchedG1 {
    const char* EGU; const int* STOK; char* H; char* HS; LAS const unsigned char* tseg; int ntl, nsh, c;
    __device__ __forceinline__ bool gsrc(int i, const int*& gidx, int& gbase) const {
        const int nu = (ntl + nsh) * 2; const int L0 = i * GRID + c; if (L0 >= nu) return false;
        const int pm = pg::xcd_remap(L0, nu) >> 1;
        if (pm < ntl) { gidx = STOK + (size_t)pm * 256; gbase = 0; } else { gidx = nullptr; gbase = (pm - ntl) * 256; }
        return true; }
    __device__ __forceinline__ bool next(int i, pg::Unit& u) const {
        const int nu = (ntl + nsh) * 2; const int L0 = i * GRID + c; if (L0 >= nu) return false;
        const int L = pg::xcd_remap(L0, nu); const int pm = L >> 1, pn = L & 1;
        u.A = nullptr; u.gbase = 0; u.nt = 8; u.ldc = 256; u.scale = 1.f; u.flags = 0; u.i0 = 0; u.i1 = 0;
        if (pm < ntl) { const int e = __builtin_amdgcn_readfirstlane((int)tseg[pm]) & 63;
            u.gidx = STOK + (size_t)pm * 256; u.B = EGU + (size_t)e * 512 * 1024 + (size_t)pn * 256 * 1024; u.out = H + (size_t)pm * 256 * 256 + pn * 128; }
        else { const int ps = pm - ntl; u.gidx = nullptr; u.gbase = ps * 256; u.B = EGU + (size_t)NE * 512 * 1024 + (size_t)pn * 256 * 1024; u.out = HS + (size_t)ps * 256 * 256 + pn * 128; }
        return true; }
};
struct SchedG2 {
    const char* ED; const char* H; const char* HS; char* YB; char* YS; LAS const unsigned char* tseg; int t0, t1, nsh, ch, CH, c;
    __device__ __forceinline__ bool next(int i, pg::Unit& u) const {
        const int nr = t1 - t0; const int nu = (nr + nsh) * 4; const int L0 = i * GRID + c; if (L0 >= nu) return false;
        const int L = pg::xcd_remap(L0, nu); const int q = L >> 2, pn = L & 3;
        u.gidx = nullptr; u.gbase = 0; u.nt = 2; u.ldc = 1024; u.scale = 1.f; u.flags = 0; u.i0 = 0; u.i1 = pn;
        if (q < nr) { const int pm = t0 + q; const int e = __builtin_amdgcn_readfirstlane((int)tseg[pm]) & 63;
            u.A = H + (size_t)pm * 256 * 256; u.B = ED + (size_t)e * 1024 * 256 + (size_t)pn * 256 * 256; u.out = YB + (size_t)q * 256 * 1024; }
        else { const int ps = q - nr; u.A = HS + ((size_t)ch * CH + ps * 256) * 256; u.B = ED + (size_t)NE * 1024 * 256 + (size_t)pn * 256 * 256; u.out = YS + (size_t)ps * 256 * 1024; }
        return true; }
};

__device__ __forceinline__ void fnet_nyquist_rows(Frame& F) {
    F.refresh();
    const unsigned char* ABT = F.ws + WS_ABT; bf16_t* FH1 = (bf16_t*)(F.ws + WS_FH1);
    for (int r = F.gw; r < 128 * 256; r += NGW) { const int bg = r >> 8, m = r & 255, b = bg >> 2, g = bg & 3;
        const GAS u32x4* p = (const GAS u32x4*)(ABT + (size_t)r * 4096); float s = 0.f;
#pragma unroll
        for (int i = 0; i < 2; ++i) { const u32x4 w = p[i * 64 + F.lane];
#pragma unroll
            for (int q = 0; q < 4; ++q) { const f32x2v lo = __builtin_amdgcn_cvt_pk_f32_fp8((int)w[q], false), hi = __builtin_amdgcn_cvt_pk_f32_fp8((int)w[q], true); s += (lo[0] - lo[1]) + (hi[0] - hi[1]); } }
        s = wave_sum(s) * 0.001381067932004975f;
        if (F.lane == 0) FH1[(size_t)b * 1024 + g * 256 + m] = (bf16_t)f2bf(s); }
}
__device__ __forceinline__ void fnet_nyquist_out(Frame& F, const Args& a, int jl) {
    F.refresh();
    const bf16_t* FH1 = (const bf16_t*)(F.ws + WS_FH1); const bf16_t* W = (const bf16_t*)(F.ws + WS_WF) + (size_t)jl * 2048 * 1024; bf16_t* Y = (bf16_t*)a.out;
    LAS float* part = (LAS float*)F.lds;
    const int b = F.blk >> 3, n = (F.blk & 7) * 128 + (F.tid & 127), kq = F.tid >> 7;
    const GAS u32x4* wp = (const GAS u32x4*)(W + (size_t)n * 1024 + kq * 256); const GAS u32x4* fp = (const GAS u32x4*)(FH1 + (size_t)b * 1024 + kq * 256);
    float s = 0.f;
#pragma unroll 4
    for (int i = 0; i < 32; ++i) { const u32x4 w = wp[i], f = fp[i];
        s += bflo(w.x) * bflo(f.x) + bfhi(w.x) * bfhi(f.x) + bflo(w.y) * bflo(f.y) + bfhi(w.y) * bfhi(f.y) + bflo(w.z) * bflo(f.z) + bfhi(w.z) * bfhi(f.z) + bflo(w.w) * bflo(f.w) + bfhi(w.w) * bfhi(f.w); }
    part[F.tid] = s;
    __syncthreads();
    if (F.tid < 128) { const float t = (part[F.tid] + part[F.tid + 128]) + (part[F.tid + 256] + part[F.tid + 384]); Y[((size_t)b * SEQ + 1024) * D + n] = (bf16_t)f2bf(t); }
    __syncthreads();
}


#ifdef SELFCHECK
constexpr int CW_ERR = 1024;
__device__ __forceinline__ void chk_report(unsigned* ctl, int id, float got, float ref, float tabs, float trel) {
    float e = fabsf(got - ref) / (tabs + trel * fabsf(ref)); if (!(e == e)) e = 1e30f; atomicMax(ctl + CW_ERR + id, __float_as_uint(e)); }
__device__ __forceinline__ float bf2f(bf16_t b) { return __builtin_bit_cast(float, (unsigned)b << 16); }
__constant__ int chk_toks[16] = {0, 1, 63, 64, 65, 127, 2047, 2048, 2049, 4096, 33000, 65535, 65536, 65537, 70000, 73727};
__constant__ int chk_ks[8] = {0, 1, 2, 255, 256, 1023, 1024, 700};
__constant__ int chk_ms[4] = {0, 1, 128, 255};
__constant__ int chk_ytoks[10] = {0, 1, 1023, 1024, 1025, 2047, 2048, 65535, 65536, 73727};
__constant__ int chk_ns[5] = {0, 1, 255, 256, 1023};
__constant__ int chk_cols[20] = {0, 7, 15, 16, 31, 32, 40, 48, 63, 64, 500, 1023, 1024, 1039, 1040, 1072, 1279, 1280, 1300, 1535};
__device__ __forceinline__ void chk_qkv(Frame& F, const Args& a, int layer, int id) {
    F.refresh(); const unsigned char* U = (const unsigned char*)a.out + OUT_U8; const float* W = a.in[8] + (size_t)(layer >> 1) * 1024 * 1536;
    const bf16_t* Qb = (const bf16_t*)(F.ws + WS_Q); const bf16_t* Kb = (const bf16_t*)(F.ws + WS_K); const bf16_t* Vb = (const bf16_t*)(F.ws + WS_V);
    for (int s = F.gw; s < 320; s += NGW) { const int tok = chk_toks[s & 15], col = chk_cols[s >> 4];
        if (layer == 2 && tok >= T && col < 1024) continue;
        const bool rope = (tok < T) && col < 1280; const int hc = col & 63, first = (hc & 31) < 16; const int pcol = rope ? (first ? col + 16 : col - 16) : col;
        float x = 0.f, xp = 0.f;
        for (int k = F.lane; k < 1024; k += 64) { const float u = f82f(U[(size_t)tok * D + k]); x += u * W[(size_t)k * 1536 + col]; xp += u * W[(size_t)k * 1536 + pcol]; }
        x = wave_sum(x); xp = wave_sum(xp);
        float ref = x;
        if (rope) { const int tl = tok & 2047, part = hc >> 5, pos = part ? (tl & 63) : (tl >> 6), fi = hc & 15; const float ang = (float)pos * powf(10000.f, -(float)fi / 16.f);
            ref = x * cosf(ang) + (first ? -xp : xp) * sinf(ang); }
        if (col < 1024) ref *= C2;
        const float got = col < 1024 ? bf2f(Qb[(size_t)tok * 1024 + col]) : (col < 1280 ? bf2f(Kb[(size_t)tok * 256 + col - 1024]) : bf2f(Vb[(size_t)tok * 256 + col - 1280]));
        if (F.lane == 0) chk_report(F.ctl, id, got, ref, 0.20f, 0.10f); }
}
__device__ __forceinline__ void chk_attn(Frame& F, const Args& a, int layer, int id) {
    F.refresh(); const bf16_t* Qb = (const bf16_t*)(F.ws + WS_Q); const bf16_t* Kb = (const bf16_t*)(F.ws + WS_K); const bf16_t* Vb = (const bf16_t*)(F.ws + WS_V); const unsigned char* Ob = F.ws + WS_R + 216 * MiB;
    LAS float* lg = (LAS float*)F.lds + F.wave * 1024;
    for (int s = F.gw; s < 64; s += NGW) { const int tok = chk_toks[s & 15], h = (s >> 4) * 5, kvh = h >> 2;
        if (layer == 2 && tok >= T) continue;
        const bool isctx = tok >= T; const int b = isctx ? (tok - T) / CTXL : tok / SEQ, p = tok & (SEQ - 1);
        int nk = 0; const int lo = isctx ? 0 : (p - 128 < 0 ? 0 : p - 128), hi = isctx ? -1 : (p + 128 > SEQ - 1 ? SEQ - 1 : p + 128);
        const int nlat = isctx ? 0 : hi - lo + 1; nk = nlat + CTXL;
        float mx = a.in[10][(layer >> 1) * 16 + h] * LOG2E; const float sink2 = mx;
        for (int i = F.lane; i < nk; i += 64) { const size_t kr = i < nlat ? (size_t)b * SEQ + lo + i : (size_t)T + b * CTXL + (i - nlat); float d = 0.f;
            for (int e = 0; e < 64; ++e) d += bf2f(Qb[(size_t)tok * 1024 + h * 64 + e]) * bf2f(Kb[kr * 256 + kvh * 64 + e]);
            lg[i] = d; mx = fmaxf(mx, d); }
#pragma unroll
        for (int o = 1; o < 64; o <<= 1) mx = fmaxf(mx, __shfl_xor(mx, o));
        LDS_WAIT();
        float den = 0.f; for (int i = F.lane; i < nk; i += 64) den += exp2f(lg[i] - mx);
        den = wave_sum(den) + exp2f(sink2 - mx);
        float o = 0.f;
        for (int i = 0; i < nk; ++i) { const size_t kr = i < nlat ? (size_t)b * SEQ + lo + i : (size_t)T + b * CTXL + (i - nlat); o += exp2f(lg[i] - mx) * bf2f(Vb[kr * 256 + kvh * 64 + F.lane]); }
        o /= den;
        chk_report(F.ctl, id, f82f(Ob[(size_t)tok * 1024 + h * 64 + F.lane]), o, 0.02f, 0.08f); chk_report(F.ctl, 32 + (s & 15), f82f(Ob[(size_t)tok * 1024 + h * 64 + F.lane]), o, 0.02f, 0.08f);
        LDS_WAIT(); }
    __syncthreads();
}
__device__ __forceinline__ void chk_fnet_f(Frame& F, const Args& a, bool upd, int id) {
    F.refresh(); const unsigned char* U = (const unsigned char*)a.out + OUT_U8; LAS float* red = (LAS float*)F.lds;
    for (int s = F.blk; s < 128 + (upd ? 64 : 0); s += GRID) {
        const bool cx = s >= 128; const int q = cx ? s - 128 : s; const int m = chk_ms[q & 3], g = ((q >> 2) & 1) * 3, b = ((q >> 3) & 1) * 31; int k = chk_ks[(q >> 4) & 7]; const int L = cx ? CTXL : SEQ; if (cx) k &= 255;
        const size_t row0 = cx ? (size_t)T + b * CTXL : (size_t)b * SEQ;
        float acc = 0.f;
        for (int l = F.wave; l < L; l += NWAVES) { float ca = 0.f, sa = 0.f;
            for (int n = F.lane; n < 256; n += 64) { const float u = f82f(U[(row0 + l) * D + g * 256 + n]); const float an = 6.283185307179586f * (float)((m * n) & 255) / 256.f; const float sn = __sinf(an), cs = __cosf(an); ca += u * cs; sa += u * sn; }
            ca = wave_sum(ca); sa = wave_sum(sa); const float an = 6.283185307179586f * (float)((k * l) % L) / (float)L; const float sn = __sinf(an), cs = __cosf(an); acc += cs * ca - sn * sa; }
        if (F.lane == 0) red[F.wave] = acc;
        __syncthreads();
        if (F.tid == 0) { float t = 0.f; for (int w = 0; w < NWAVES; ++w) t += red[w]; t *= cx ? (1.f / 256.f) : 0.001381067932004975f;
            float got;
            if (cx) got = f82f((F.ws + WS_FC)[((size_t)b * 256 + k) * D + g * 256 + m]);
            else if (k == 1024) got = bf2f(((const bf16_t*)(F.ws + WS_FH1))[(size_t)b * 1024 + g * 256 + m]);
            else got = f82f((F.ws + WS_FH)[((size_t)b * 1024 + k) * D + g * 256 + m]);
            chk_report(F.ctl, id, got, t, 0.25f, 0.10f); }
        __syncthreads(); }
}
__device__ __forceinline__ void chk_fnet_y(Frame& F, const Args& a, int jl, bool upd, int id) {
    F.refresh(); const bf16_t* Y = (const bf16_t*)a.out; const float* W = a.in[11] + (size_t)jl * 1024 * 1024;
    const unsigned char* FH = F.ws + WS_FH; const bf16_t* FH1 = (const bf16_t*)(F.ws + WS_FH1); const unsigned char* FC = F.ws + WS_FC;
    for (int s = F.gw; s < 50; s += NGW) { const int tok = chk_ytoks[s % 10], n = chk_ns[s / 10]; if (tok >= T && !upd) continue;
        float acc = 0.f;
        for (int j = F.lane; j < 1024; j += 64) { float f;
            if (tok >= T) f = f82f(FC[(size_t)(tok - T) * D + j]);
            else { const int b = tok >> 11, k = tok & 2047; if (k < 1024) f = f82f(FH[((size_t)b * 1024 + k) * D + j]); else if (k == 1024) f = bf2f(FH1[(size_t)b * 1024 + j]);
                else f = f82f(FH[((size_t)b * 1024 + (2048 - k)) * D + (j & ~255) + ((256 - (j & 255)) & 255)]); }
            acc += f * W[(size_t)j * 1024 + n]; }
        acc = wave_sum(acc);
        if (F.lane == 0) chk_report(F.ctl, id, bf2f(Y[(size_t)tok * D + n]), acc, 0.04f, 0.08f); }
}
__device__ __forceinline__ void chk_route(Frame& F, const Args& a, int layer, int ntok, int id) {
    F.refresh(); const bf16_t* U = (const bf16_t*)a.out; const float* Wr = a.in[12] + (size_t)layer * 1024 * 64; const int* tke = (const int*)(F.ws + WS_TKE); const float* tkw = (const float*)(F.ws + WS_TKW);
    for (int s = F.gw; s < 16; s += NGW) { const int tok = chk_toks[s]; if (tok >= ntok) continue; const int lane = F.lane;
        float lgt = 0.f; for (int k = 0; k < 1024; ++k) lgt += bf2f(U[(size_t)tok * D + k]) * Wr[(size_t)k * 64 + lane];
        const float sc = 1.f / (1.f + expf(-lgt)), sel = sc + a.in[13][layer * 64 + lane];
        float g1 = -INFINITY, g2 = -INFINITY;
#pragma unroll 1
        for (int j = 0; j < 8; ++j) { const float v = __shfl(sel, (lane & ~7) + j); if (v > g1) { g2 = g1; g1 = v; } else if (v > g2) g2 = v; }
        const float gs = g1 + g2; int gr = 0;
#pragma unroll 1
        for (int gp = 0; gp < 8; ++gp) { const float v = __shfl(gs, gp * 8); gr += (v > gs || (v == gs && gp < (lane >> 3))) ? 1 : 0; }
        const float sm = gr < 4 ? sel : -INFINITY; int rk = 0;
#pragma unroll 1
        for (int ep = 0; ep < 64; ++ep) { const float v = __shfl(sm, ep); rk += (v > sm || (v == sm && ep < lane)) ? 1 : 0; }
        const float tot = wave_sum(rk < 8 ? sc : 0.f); const float wref = sc / tot * 2.5f;
        int slot = -1; for (int j = 0; j < 8; ++j) if (tke[(size_t)tok * 8 + j] == lane) slot = j;
        float err = 0.f;
        if (slot >= 0) { if (rk >= 10) err = 10.f; else if (rk < 8) err = fabsf(tkw[(size_t)tok * 8 + slot] - wref) / (0.04f * wref); }
        else if (rk < 6) err = 10.f;
        const unsigned long long nsel = __ballot(slot >= 0); if (__builtin_popcountll(nsel) != 8) err = 20.f;
        atomicMax(F.ctl + CW_ERR + id, __float_as_uint(err)); }
}
__device__ __forceinline__ void chk_moe(Frame& F, const Args& a, int layer, int ntok, int ch, int id) {
    F.refresh(); const bf16_t* U = (const bf16_t*)a.out; const int* tke = (const int*)(F.ws + WS_TKE); const float* tkw = (const float*)(F.ws + WS_TKW);
    const int CH = ntok / NCHUNK; LAS float* hs = (LAS float*)F.lds; LAS float* us = hs + 512; LAS float* pg_ = us + 1024;
    for (int s = F.blk; s < 16; s += GRID) { const int tok = chk_toks[s]; if (tok >= ntok || tok / CH != ch) continue;
        for (int k = F.tid; k < 1024; k += NTHR) us[k] = bf2f(U[(size_t)tok * D + k]);
        __syncthreads();
        float y0 = 0.f, y1 = 0.f;
        for (int j = 0; j < 9; ++j) { const int e = j < 8 ? tke[(size_t)tok * 8 + j] : 0; const float w = j < 8 ? tkw[(size_t)tok * 8 + j] : 1.f;
            const float* wg = j < 8 ? a.in[14] + ((size_t)layer * NE + e) * 262144 : a.in[17] + (size_t)layer * 262144;
            const float* wu = j < 8 ? a.in[15] + ((size_t)layer * NE + e) * 262144 : a.in[18] + (size_t)layer * 262144;
            const float* wd = j < 8 ? a.in[16] + ((size_t)layer * NE + e) * 262144 : a.in[19] + (size_t)layer * 262144;
            const int hh = F.tid & 255, half = F.tid >> 8; float g = 0.f, u = 0.f;
            for (int k = half * 512; k < half * 512 + 512; ++k) { g += us[k] * wg[(size_t)k * 256 + hh]; u += us[k] * wu[(size_t)k * 256 + hh]; }
            pg_[F.tid] = g; pg_[512 + F.tid] = u;
            __syncthreads();
            if (F.tid < 256) { const float gg = pg_[F.tid] + pg_[F.tid + 256], uu = pg_[512 + F.tid] + pg_[512 + F.tid + 256]; hs[F.tid] = gg / (1.f + expf(-gg)) * uu; }
            __syncthreads();
            float t0 = 0.f, t1 = 0.f; for (int q = 0; q < 256; ++q) { t0 += hs[q] * wd[(size_t)q * 1024 + F.tid]; t1 += hs[q] * wd[(size_t)q * 1024 + 512 + F.tid]; }
            y0 += w * t0; y1 += w * t1;
            __syncthreads(); }
        float g0 = 0.f, g1 = 0.f; const int i = tok - ch * CH;
        { const unsigned char* YSb = (const unsigned char*)(F.ws + WS_YS); const unsigned char* YBb = (const unsigned char*)(F.ws + WS_YB); const int* spos = (const int*)(F.ws + WS_SDST);
          const int t_ = F.tid, bo = 16 * (16 * (t_ >> 8) + ((t_ & 127) >> 3)) + 8 * ((t_ >> 7) & 1) + (t_ & 7);
          auto f8 = [](unsigned char b) { return __builtin_amdgcn_cvt_pk_f32_fp8((int)b, false)[0] * (1.f / 16.f); };
          g0 = f8(YSb[(size_t)i * D + bo]); g1 = f8(YSb[(size_t)i * D + bo + 512]);
          for (int j = 0; j < 8; ++j) { const size_t ps = (size_t)spos[(size_t)tok * 8 + j]; const float w = tkw[(size_t)tok * 8 + j]; g0 += w * f8(YBb[ps * D + bo]); g1 += w * f8(YBb[ps * D + bo + 512]); } }
        chk_report(F.ctl, id, g0, y0, 0.15f, 0.15f); chk_report(F.ctl, id, g1, y1, 0.15f, 0.15f);
        __syncthreads(); }
}
#endif

#ifndef PH_MASK
#define PH_MASK 0xffffffffu
#endif
#define PH(b) ((PH_MASK >> (b)) & 1u)
__global__ void __launch_bounds__(NTHR, 2) fwd(Args a) {
    extern __shared__ __attribute__((aligned(16))) unsigned char lds_raw[];
    Frame F;
    F.lds = (LAS unsigned char*)lds_raw; F.ws = a.ws; F.ctl = (unsigned*)(a.ws + WS_CTL);
    F.blk = blockIdx.x; F.refresh();
    for (int u = F.tid; u < (LDS_BYTES - RING_BYTES) / 4; u += NTHR) ((LAS unsigned*)(F.lds + RING_BYTES))[u] = 0u;
    __syncthreads();
    const XcdBarrier bar = xcd_barrier_post(F.ctl + CW_BAR, (volatile LAS unsigned*)(F.lds + L_MISC) + 8);
#define GRID_BAR() xcd_barrier(bar)
    LAS unsigned char* ring = F.lds;
    const int c = F.blk;
#define ws (F.ws)
#define NEWPH() F.refresh()

    if (PH(0)) { conv_small(F, a);
    __syncthreads();
    mod_full(F, a); }
    GRID_BAR();
    if (PH(1)) { rows_init(F, a); }
    GRID_BAR();

    for (int layer = 0; layer < 4; ++layer) {
        const int jl = layer >> 1; const bool upd = layer < 2; const int nrows = upd ? TT : T;
        if ((layer & 1) == 0) {
            NEWPH();
            if (PH(2)) { SchedQKV S; S.U = (const char*)a.out + OUT_U8; S.W = (const char*)(ws + WS_WQKV) + (size_t)jl * 1536 * 1024; S.nfull = (layer == 0) ? 288 * 6 : 256 * 6; S.nu = (layer == 0) ? 288 * 6 : 256 * 6 + 64; S.c = c;
              pg::EpiQKV E; E.Q = (bf16_t*)(ws + WS_Q); E.K = (bf16_t*)(ws + WS_K); E.V = (bf16_t*)(ws + WS_V); E.ropec = (const float*)(ws + WS_ROPEC); E.ropes = (const float*)(ws + WS_ROPES);
              pg::gemm_phase<pg::EpiQKV, SchedQKV, false, true>(ring, 1024u, 1024u, nullptr, S, E); }
            GRID_BAR();
#ifdef SELFCHECK
            if (SELFCHECK & 1) chk_qkv(F, a, layer, 1 + (layer >> 1));
#endif
#define OBUF ((bf16_t*)(ws + WS_R + 216 * MiB))
            NEWPH();
            if (PH(3)) { const int NU = 4096 + (layer == 0 ? 512 : 0);
              const bf16_t* Qb = (const bf16_t*)(ws + WS_Q); const bf16_t* Kb = (const bf16_t*)(ws + WS_K); const bf16_t* Vb = (const bf16_t*)(ws + WS_V);
              for (int i = 0; i * GRID + c < NU; ++i) { int id = pg::xcd_remap(i * GRID + c, NU);
                  if (NU > 4096) { const int g9 = id / 9, r9 = id - g9 * 9; id = (r9 < 8) ? g9 * 8 + r9 : 4096 + g9; }
                  if (id < 4096) { const int hq = id & 3, qb = (id >> 2) & 7, kvh = (id >> 5) & 3, b = id >> 7, h = kvh * 4 + hq;
                      attn::attn_unit(Qb, Kb, Vb, OBUF, b, h, qb * 256, false, a.in[10][jl * 16 + h] * LOG2E, ring); }
                  else { const int cid = id - 4096, hq = cid & 3, kvh = (cid >> 2) & 3, b = cid >> 4, h = kvh * 4 + hq;
                      attn::attn_unit(Qb, Kb, Vb, OBUF, b, h, 0, true, a.in[10][jl * 16 + h] * LOG2E, ring); } } }
            GRID_BAR();
#ifdef SELFCHECK
            if (SELFCHECK & 1) chk_attn(F, a, layer, 3 + (layer >> 1));
#endif
            NEWPH();
            if (PH(4)) { SchedDense S; S.A = (const char*)OBUF; S.W = (const char*)(ws + WS_WO) + (size_t)jl * 1024 * 1024; S.out = (char*)a.out; S.nrt = nrows / 256; S.nct = 4; S.nt = 8; S.c = c; S.ldA = 1024;
              pg::EpiStore E; pg::gemm_phase<pg::EpiStore, SchedDense, false, true>(ring, 1024u, 1024u, nullptr, S, E); }
            GRID_BAR();
        } else {
            NEWPH();
            if (PH(5)) { SchedF1 S; S.CS = (const char*)(ws + WS_CSN); S.U = (const char*)a.out + OUT_U8; S.ABT = (char*)(ws + WS_ABT); S.ABTC = (char*)(ws + WS_ABTC); S.nu = 2048 + (upd ? 256 : 0); S.c = c;
              pg::EpiStore8 E; pg::gemm_phase<pg::EpiStore8, SchedF1, false, true, 127>(ring, 256u, 1024u, nullptr, S, E); }
            GRID_BAR();
            NEWPH();
            if (PH(6)) { SchedF2 S; S.DL = (const char*)(ws + WS_DL); S.ABT = (const char*)(ws + WS_ABT); S.FH = (char*)(ws + WS_FH); S.c = c;
              pg::EpiStore8 E; pg::gemm_phase<pg::EpiStore8, SchedF2, false, true, 127>(ring, 4096u, 4096u, nullptr, S, E); }
            NEWPH();
            if (PH(7) && upd) { SchedF2c S; S.DLC = (const char*)(ws + WS_DLC); S.ABTC = (const char*)(ws + WS_ABTC); S.FC = (char*)(ws + WS_FC); S.c = c;
              pg::EpiStore8 E; pg::gemm_phase<pg::EpiStore8, SchedF2c, false, true, 127>(ring, 512u, 512u, nullptr, S, E); }
            if (PH(8)) fnet_nyquist_rows(F);
            GRID_BAR();
#ifdef SELFCHECK
            if (SELFCHECK & 2) chk_fnet_f(F, a, upd, 5 + (layer >> 1));
            GRID_BAR();
#endif
            NEWPH();
            if (PH(9)) { SchedF3 S; S.FH = (const char*)(ws + WS_FH); S.FC = (const char*)(ws + WS_FC); S.W = (const char*)(ws + WS_WSH) + (size_t)jl * 2048 * 1024; S.Y = (char*)a.out; S.nu = 1024 + (upd ? 128 : 0); S.c = c;
              pg::EpiStore E; pg::gemm_phase<pg::EpiStore, SchedF3, false, true>(ring, 1024u, 1024u, nullptr, S, E); }
            if (PH(10)) fnet_nyquist_out(F, a, jl);
            GRID_BAR();
#ifdef SELFCHECK
            if (SELFCHECK & 8) chk_fnet_y(F, a, jl, upd, 7 + (layer >> 1));
            GRID_BAR();
#endif
        }
        if (PH(12)) conv_experts(F, a, layer);
        __syncthreads();
        if (PH(11)) rows_post1(F, a, layer, nrows);
        VM_WAIT(); __syncthreads();
        if (threadIdx.x == 0) { __builtin_amdgcn_fence(__ATOMIC_ACQUIRE, "agent"); VM_WAIT(); }
        __syncthreads();
        if (PH(13)) route_tokens(F, a, layer, nrows);
        GRID_BAR();
#ifdef SELFCHECK
        if ((SELFCHECK & 64) && layer < 2) chk_route(F, a, layer, nrows, 9);
#endif
        if (PH(14)) build_lists(F, nrows);
        GRID_BAR();
        LAS const int* tstart = (LAS const int*)(F.lds + L_TSTART); LAS const unsigned char* tseg = (LAS const unsigned char*)(F.lds + L_TSEG);
        const int ntl = __builtin_amdgcn_readfirstlane(tstart[NCHUNK * 64]);
        NEWPH();
        if (PH(15)) { SchedG1 S; S.EGU = (const char*)(ws + WS_EGU); S.STOK = (const int*)(ws + WS_STOK); S.H = (char*)(ws + WS_H); S.HS = (char*)(ws + WS_HS); S.tseg = tseg; S.ntl = ntl; S.nsh = nrows / 256; S.c = c;
          pg::EpiSilu E; pg::gemm_phase<pg::EpiSilu, SchedG1, true, true>(ring, 1024u, 1024u, (const char*)a.out + OUT_U8, S, E); }
        GRID_BAR();
        const int CH = nrows / NCHUNK;
        for (int ch = 0; ch < NCHUNK; ++ch) {
            NEWPH();
            if (PH(16)) { SchedG2 S; S.ED = (const char*)(ws + WS_ED); S.H = (const char*)(ws + WS_H); S.HS = (const char*)(ws + WS_HS); S.YB = (char*)(ws + WS_YB); S.YS = (char*)(ws + WS_YS); S.tseg = tseg;
              S.t0 = __builtin_amdgcn_readfirstlane(tstart[ch * 64]); S.t1 = __builtin_amdgcn_readfirstlane(tstart[ch * 64 + 64]); S.nsh = CH / 256; S.ch = ch; S.CH = CH; S.c = c;
              pg::EpiFp8 E; pg::gemm_phase<pg::EpiFp8, SchedG2, false, true>(ring, 256u, 256u, nullptr, S, E); }
            GRID_BAR();
#ifdef SELFCHECK
            if ((SELFCHECK & 4) && layer == 0) { chk_moe(F, a, layer, nrows, ch, 10); GRID_BAR(); }
#endif
            if (PH(17)) rows_post2(F, a, layer, ch * CH, CH);
            if (!(layer == 3 && ch == NCHUNK - 1)) GRID_BAR();
        }
    }
#ifdef SELFCHECK
    GRID_BAR();
    { int bad = 0; float be = 0.f; for (int k = 15; k >= 1; --k) { const float e = __uint_as_float(__hip_atomic_load(F.ctl + CW_ERR + k, RLX_AGENT)); if (e > 1.f) { bad = k; be = e; } }
      int wt = 0; float we = 0.f; for (int k = 0; k < 16; ++k) { const float e = __uint_as_float(__hip_atomic_load(F.ctl + CW_ERR + 32 + k, RLX_AGENT)); if (e > we) { we = e; wt = k; } }
      if (bad) { F.refresh(); float cv = 3.f + bad + (be > 8.f ? 0.5f : 0.f);  Row r; for (int j = 0; j < 4; ++j) r.v[j] = (f32x4){cv, cv, cv, cv}; for (int row = F.gw; row < T; row += NGW) row_store_f32(r, a.out + (size_t)row * D, F.lane); } }
#endif
}

#undef ws
#undef NEWPH
extern "C" void kernel_launch(void* const* d_in, const int* in_sizes, int n_in, void* d_out, int out_size, void* d_ws, size_t ws_size, hipStream_t stream) {
    static int ready = 0;
    if (ready == 0) {
        if (n_in != 20 || out_size != T * D || ws_size < WS_END) { fprintf(stderr, "kernel_launch: unexpected problem (n_in %d out %d ws %zu need %zu)\n", n_in, out_size, ws_size, (size_t)WS_END); ready = -1; return; }
        if (hipFuncSetAttribute((const void*)fwd, hipFuncAttributeMaxDynamicSharedMemorySize, LDS_BYTES) != hipSuccess) { fprintf(stderr, "kernel_launch: hipFuncSetAttribute failed\n"); ready = -1; return; }
        int per_cu = 0;
        if (hipOccupancyMaxActiveBlocksPerMultiprocessor(&per_cu, (const void*)fwd, NTHR, LDS_BYTES) != hipSuccess || per_cu < 1) fprintf(stderr, "kernel_launch: occupancy query says %d blocks per CU\n", per_cu);
        (void)hipGetLastError();
        ready = 1;
    }
    if (ready < 0) return;
    (void)hipMemsetAsync((char*)d_ws + WS_CTL, 0, CTL_BYTES, stream);
    Args a{};
    for (int i = 0; i < 20; ++i) a.in[i] = (const float*)d_in[i];
    a.out = (float*)d_out; a.ws = (unsigned char*)d_ws;
    hipLaunchKernelGGL(fwd, dim3(GRID), dim3(NTHR), LDS_BYTES, stream, a);
}
```

```cpp
#include <hip/hip_runtime.h>
#include <cstdio>
#include <cstdint>

#define LAS __attribute__((address_space(3)))
#define GAS __attribute__((address_space(1)))
typedef unsigned short bf16_t;
typedef short bf16x8 __attribute__((ext_vector_type(8)));
typedef short s16x4 __attribute__((ext_vector_type(4)));
typedef float f32x4 __attribute__((ext_vector_type(4)));
typedef float f32x16 __attribute__((ext_vector_type(16)));
typedef unsigned u32x4 __attribute__((ext_vector_type(4)));
typedef unsigned u32x2 __attribute__((ext_vector_type(2)));
typedef int v8i_t __attribute__((ext_vector_type(8)));
typedef int v4i_t __attribute__((ext_vector_type(4)));

constexpr int D = 1024, NB = 32, SEQ = 2048, T = NB * SEQ, CTXL = 256, TC = NB * CTXL, TT = T + TC;
constexpr int NQKV = 1536, NE = 64;
constexpr float ALPHA = 1.681792830507429f;
constexpr float LN_EPS = 1e-5f, MOD_EPS = 1e-6f;
constexpr float C2 = 0.125f * 1.4426950408889634f;
constexpr float LOG2E = 1.4426950408889634f;
constexpr int NCHUNK = 1;
constexpr int NWAVES = 8, NTHR = 512, GRID = 256;

constexpr size_t MiB = 1u << 20;
constexpr size_t WS_CTL = 0, CTL_BYTES = 1 * MiB;
constexpr size_t WS_ROPEC = 1 * MiB, WS_ROPES = 1 * MiB + 4096, WS_CSN = 1 * MiB + 65536, WS_DLC = 1 * MiB + 524288, WS_DL = 2 * MiB;
constexpr size_t WS_WQKV = 10 * MiB, WS_WO = 16 * MiB, WS_WF = 20 * MiB, WS_WR = 28 * MiB, WS_WSH = 29 * MiB;
constexpr size_t WS_MODP = 36 * MiB, WS_MOD = 49 * MiB;
constexpr size_t WS_EGU = 54 * MiB, WS_ED = 118 * MiB;
constexpr size_t WS_XS = 150 * MiB;
constexpr size_t WS_STOK = 294 * MiB, WS_SDST = 297 * MiB, WS_SW = 300 * MiB, WS_TKE = 303 * MiB, WS_TKW = 306 * MiB;
constexpr size_t WS_R = 309 * MiB;
constexpr size_t WS_Q = WS_R, WS_K = WS_R + 144 * MiB, WS_V = WS_R + 180 * MiB;
constexpr size_t WS_ABT = WS_R, WS_FH = WS_R + 256 * MiB, WS_FH1 = WS_R + 320 * MiB, WS_ABTC = WS_R + 321 * MiB, WS_FC = WS_R + 353 * MiB;
constexpr size_t WS_H = WS_R, WS_HS = WS_R + 160 * MiB, WS_YB = WS_R + 180 * MiB, WS_YS = WS_R + 788 * MiB;
constexpr size_t WS_END = WS_YS + 72 * MiB;
constexpr size_t OUT_U8 = 144 * MiB;
constexpr int WSCALE_E8M0 = 121;
constexpr int MAXROWS = 655360;

constexpr int CW_TMO = 0, CW_BAR = 4096, CW_BCNT = 16384;

constexpr int RING_BYTES = 131072;
constexpr int L_MISC = RING_BYTES;
constexpr int L_TSTART = RING_BYTES + 256;
constexpr int L_PREF = L_TSTART + 1040;
constexpr int L_LCNT = L_PREF + 256;
constexpr int L_TSEG = L_LCNT + 256;
constexpr int L_SCAN = L_TSEG + 2560;
constexpr int LDS_BYTES = 139264;
static_assert(L_SCAN + 1024 <= LDS_BYTES, "LDS map");

#define RLX_AGENT __ATOMIC_RELAXED, __HIP_MEMORY_SCOPE_AGENT
#define LDS_WAIT() asm volatile("s_waitcnt lgkmcnt(0)" ::: "memory")
#define VM_WAIT() asm volatile("s_waitcnt vmcnt(0)" ::: "memory")

__device__ __forceinline__ unsigned f2bf(float f) { unsigned u = __builtin_bit_cast(unsigned, f); return (u + 0x7fffu + ((u >> 16) & 1u)) >> 16; }
__device__ __forceinline__ unsigned pk2(float lo, float hi) { return f2bf(lo) | (f2bf(hi) << 16); }
typedef float f32x2_t __attribute__((ext_vector_type(2))); typedef __bf16 bf16x2_t __attribute__((ext_vector_type(2)));
__device__ __forceinline__ unsigned cvt_pk_bf16(float lo, float hi) { f32x2_t v = {lo, hi}; bf16x2_t b = __builtin_convertvector(v, bf16x2_t); return __builtin_bit_cast(unsigned, b); }
__device__ __forceinline__ float bflo(unsigned w) { return __builtin_bit_cast(float, w << 16); }
__device__ __forceinline__ float bfhi(unsigned w) { return __builtin_bit_cast(float, w & 0xffff0000u); }
__device__ __forceinline__ float wave_sum(float v) {
#pragma unroll
    for (int o = 1; o < 64; o <<= 1) v += __shfl_xor(v, o);
    return v;
}

__device__ __forceinline__ unsigned f2f8(float v) { return (unsigned)__builtin_amdgcn_cvt_pk_fp8_f32(v, 0.f, 0, false) & 0xffu; }
__device__ __forceinline__ float f82f(unsigned b) { return __builtin_amdgcn_cvt_pk_f32_fp8((int)(b & 0xffu), false)[0]; }
__device__ __forceinline__ int opaque_tid() { int t = threadIdx.x; asm volatile("" : "+v"(t)); return t; }

#define XB_TMO      128
#define XB_XCNT(j)  (256  + 64 * (j))
#define XB_XSUB(j)  (1280 + 64 * (j))
#define XB_XGEN(j)  (2304 + 64 * (j))
#define XB_TOP      3328
#define XB_TOPGEN   3392
#define XCD_BAR_WORDS 3456
#define XB_SPIN_CAP (1u << 22)
__device__ __forceinline__ unsigned xb_ld(unsigned* p)              { return __hip_atomic_load(p, __ATOMIC_RELAXED, __HIP_MEMORY_SCOPE_AGENT); }
__device__ __forceinline__ unsigned xb_add(unsigned* p, unsigned v) { return __hip_atomic_fetch_add(p, v, __ATOMIC_RELAXED, __HIP_MEMORY_SCOPE_AGENT); }
__device__ __forceinline__ unsigned xb_xcc_id() { return (unsigned)__builtin_amdgcn_s_getreg((3 << 11) | 20) & 0xFu; }
#define XB_SPIN(cond, bar) do { unsigned _sp = 0; while (cond) { __builtin_amdgcn_s_sleep(1); \
    if ((++_sp & 255u) == 0u) { if (xb_ld(&(bar)[XB_TMO])) break; if (_sp > XB_SPIN_CAP) { atomicAdd(&(bar)[XB_TMO], 1u); break; } } } } while (0)
struct XcdBarrier { unsigned* bar; unsigned x; volatile LAS unsigned* st; };
__device__ __forceinline__ XcdBarrier xcd_barrier_post(unsigned* bar, volatile LAS unsigned* st) {
    XcdBarrier b; b.bar = bar; b.x = xb_xcc_id(); b.st = st;
    if (threadIdx.x == 0) (void)xb_add(&bar[XB_XCNT(b.x)], 1u);
    return b;
}
__device__ __forceinline__ void xcd_barrier_complete(unsigned* bar, unsigned x, unsigned& nloc, unsigned& nx) {
    const unsigned G = gridDim.x * gridDim.y * gridDim.z;
    unsigned sum, cnt, mine, sp = 0u;
    for (;;) {
        sum = 0u; cnt = 0u; mine = 0u;
#pragma unroll
        for (unsigned j = 0; j < 16; ++j) { const unsigned c = xb_ld(&bar[XB_XCNT(j)]); sum += c; cnt += (c > 0u) ? 1u : 0u; mine = (j == x) ? c : mine; }
        if (sum == G) break;
        __builtin_amdgcn_s_sleep(1);
        if ((++sp & 255u) == 0u) { if (xb_ld(&bar[XB_TMO])) break; if (sp > XB_SPIN_CAP) { atomicAdd(&bar[XB_TMO], 1u); break; } }
    }
    nloc = mine > 0u ? mine : 1u; nx = cnt > 0u ? cnt : 1u;
}
__device__ __forceinline__ void xcd_barrier(const XcdBarrier& b) {
    asm volatile("s_waitcnt vmcnt(0)" ::: "memory");
    __syncthreads();
    if (threadIdx.x == 0) {
        unsigned* bar = b.bar; unsigned bx = b.x; asm volatile("" : "+s"(bx));
        __builtin_amdgcn_s_waitcnt(0);
        unsigned nloc = b.st[0], nx = b.st[1];
        if (nloc == 0u) { xcd_barrier_complete(bar, bx, nloc, nx); b.st[0] = nloc; b.st[1] = nx; }
        const unsigned old = xb_add(&bar[XB_XSUB(bx)], 1u);
        const unsigned gen = old / nloc;
        if (old + 1u == (gen + 1u) * nloc) {
            __builtin_amdgcn_fence(__ATOMIC_RELEASE, "agent");
            asm volatile("s_waitcnt vmcnt(0)" ::: "memory");
            const unsigned og = xb_add(&bar[XB_TOP], 1u);
            const unsigned tg = og / nx;
            if (og + 1u == (tg + 1u) * nx) xb_add(&bar[XB_TOPGEN], 1u);
            else XB_SPIN(xb_ld(&bar[XB_TOPGEN]) == tg, bar);
            __builtin_amdgcn_fence(__ATOMIC_ACQUIRE, "agent");
            xb_add(&bar[XB_XGEN(bx)], 1u);
            asm volatile("s_waitcnt vmcnt(0)" ::: "memory");
        } else {
            XB_SPIN(xb_ld(&bar[XB_XGEN(bx)]) == gen, bar);
            __builtin_amdgcn_fence(__ATOMIC_ACQUIRE, "agent");
            asm volatile("s_waitcnt vmcnt(0)" ::: "memory");
        }
    }
    __syncthreads();
}

namespace pg {
constexpr int BM = 256, BK = 64, HALF = 128, HTB = HALF * BK * 2;
__host__ __device__ __forceinline__ int lds_byte(int r, int c) { const int st = (r >> 4) * 2 + (c >> 5), rr = r & 15, cc = c & 31, ob = rr * 64 + cc * 2; return st * 1024 + (ob ^ (((ob >> 9) & 1) << 5)); }
__host__ __device__ __forceinline__ void stage_rc(int b, int& R, int& C) { const int st = b / 1024, sb = b % 1024, swz = sb ^ (((sb >> 9) & 1) << 5); R = (st >> 1) * 16 + swz / 64; C = (st & 1) * 32 + (swz % 64) / 2; }
__host__ __device__ __forceinline__ int perm32(int rho) { const int n = rho >> 4, i = rho & 15; return 8 * (i >> 2) + 4 * n + (i & 3); }

struct Unit {
    const char* A;
    const char* B;
    const int* gidx;
    int gbase;
    int nt;
    char* out; int ldc; float scale; int flags; int i0; int i1;
};

template <class Epi, class Sched, bool GATHER, bool F8 = false, int WSC = WSCALE_E8M0>
__device__ __forceinline__ void gemm_phase(LAS unsigned char* lds, const unsigned lda, const unsigned ldb, const char* gtable, const Sched& S, const Epi& E) {
    const int tid = opaque_tid(), wid = __builtin_amdgcn_readfirstlane(tid >> 6), lane = tid & 63, wr = wid >> 2, wc = wid & 3, fr = lane & 15, fq = lane >> 4;
    unsigned voffA[2], voffB[2];
#pragma unroll
    for (int i = 0; i < 2; ++i) { int R, C; stage_rc(tid * 16 + i * 8192, R, C); const int Rb = (R & ~31) + perm32(R & 31);
        voffA[i] = (unsigned)R * lda + (unsigned)C * 2u; voffB[i] = (unsigned)Rb * ldb + (unsigned)C * 2u; }
    const size_t kstep = (size_t)(BK * 2);
    const size_t hstepA = (size_t)HALF * lda, hstepB = (size_t)HALF * ldb;
    const unsigned ldsw = (unsigned)wid * 1024u;
    const int aoff = lds_byte(wr * 64 + fr, fq * 8), boff = lds_byte(wc * 32 + fr, fq * 8);
#define PG_SA(b, h) (((b) * 2 + (h)) * HTB)
#define PG_SB(b, h) ((4 + (b) * 2 + (h)) * HTB)
#define PG_ST2(bufoff, p0, p1) do { \
        __builtin_amdgcn_global_load_lds((const unsigned*)(p0), (LAS unsigned*)(lds + (bufoff) + ldsw), 16, 0, 0); \
        __builtin_amdgcn_global_load_lds((const unsigned*)(p1), (LAS unsigned*)(lds + (bufoff) + ldsw + 8192), 16, 0, 0); } while (0)
#define PG_STB(bufoff, bp) PG_ST2(bufoff, (bp) + voffB[0], (bp) + voffB[1])
#define PG_STA(bufoff, ap, h, nx) do { if constexpr (GATHER) { PG_ST2(bufoff, (ap) + ((nx) ? nO[h][0] : cO[h][0]), (ap) + ((nx) ? nO[h][1] : cO[h][1])); } \
        else { PG_ST2(bufoff, (ap) + (h) * hstepA + voffA[0], (ap) + (h) * hstepA + voffA[1]); } } while (0)
#define PG_LD8(p) ({ const v4i_t lo_ = *(const LAS v4i_t*)(p), hi_ = *(const LAS v4i_t*)((p) + 1024); __builtin_shufflevector(lo_, hi_, 0, 1, 2, 3, 4, 5, 6, 7); })
#define PG_LDA(dst, b, h) do { if constexpr (F8) { _Pragma("unroll") for (int m = 0; m < 4; ++m) dst##8[m] = PG_LD8(lds + PG_SA(b, h) + aoff + m * 2048); } \
        else { _Pragma("unroll") for (int m = 0; m < 4; ++m) _Pragma("unroll") for (int k = 0; k < 2; ++k) dst[m][k] = *(const LAS bf16x8*)(lds + PG_SA(b, h) + aoff + m * 2048 + k * 1024); } } while (0)
#define PG_LDB(dst, b, h) do { if constexpr (F8) { _Pragma("unroll") for (int n = 0; n < 2; ++n) dst##8[n] = PG_LD8(lds + PG_SB(b, h) + boff + n * 2048); } \
        else { _Pragma("unroll") for (int n = 0; n < 2; ++n) _Pragma("unroll") for (int k = 0; k < 2; ++k) dst[n][k] = *(const LAS bf16x8*)(lds + PG_SB(b, h) + boff + n * 2048 + k * 1024); } } while (0)
#define PG_MMA(ai, bj, At, Bt) do { __builtin_amdgcn_s_setprio(1); _Pragma("unroll") for (int m = 0; m < 4; ++m) _Pragma("unroll") for (int n = 0; n < 2; ++n) { \
        if constexpr (F8) { asm volatile("v_mfma_scale_f32_16x16x128_f8f6f4 %0, %1, %2, %0, %3, %4 op_sel_hi:[0,0,0]" : "+v"(acc[ai][bj][m][n]) : "v"(Bt##8[n]), "v"(At##8[m]), "v"(sc_w), "v"(sc_x)); } \
        else { _Pragma("unroll") for (int k = 0; k < 2; ++k) acc[ai][bj][m][n] = __builtin_amdgcn_mfma_f32_16x16x32_bf16(Bt[n][k], At[m][k], acc[ai][bj][m][n], 0, 0, 0); } } \
        __builtin_amdgcn_s_setprio(0); } while (0)
#define PG_WAIT_V(n) asm volatile("s_waitcnt vmcnt(" #n ")" ::: "memory")
#define PG_WAIT_L(n) asm volatile("s_waitcnt lgkmcnt(" #n ")" ::: "memory")
#define PG_BAR __builtin_amdgcn_s_barrier()
#define PG_SCHED __builtin_amdgcn_sched_barrier(0)
#define PG_GOFF(dst, u) do { const int tz_ = opaque_tid(); _Pragma("unroll") for (int i = 0; i < 2; ++i) { int R_, C_; stage_rc(tz_ * 16 + i * 8192, R_, C_); \
        _Pragma("unroll") for (int h = 0; h < 2; ++h) { const int rr = h * HALF + R_; \
        const int ix = (u).gidx ? ((const GAS int*)(u).gidx)[rr] : (u).gbase + rr; dst[h][i] = (unsigned)ix * lda + (unsigned)C_ * 2u; } } } while (0)
#define PG_GIDX(dst, un) do { const int* gi_ = nullptr; int gb_ = 0; const bool ok_ = S.gsrc((un), gi_, gb_); const int tz_ = opaque_tid(); _Pragma("unroll") for (int i = 0; i < 2; ++i) { int R_, C_; stage_rc(tz_ * 16 + i * 8192, R_, C_); \
        _Pragma("unroll") for (int h = 0; h < 2; ++h) { const int rr = h * HALF + R_; dst[h][i] = (ok_ && gi_) ? ((const GAS int*)gi_)[rr] : gb_ + rr; } } } while (0)
#define PG_GCVT(dst, src) do { const int tz_ = opaque_tid(); _Pragma("unroll") for (int i = 0; i < 2; ++i) { int R_, C_; stage_rc(tz_ * 16 + i * 8192, R_, C_); \
        _Pragma("unroll") for (int h = 0; h < 2; ++h) dst[h][i] = (unsigned)src[h][i] * lda + (unsigned)C_ * 2u; } } while (0)
    Unit cur, nxt; int ui = 0;
    if (!S.next(0, cur)) return;
    f32x4 acc[2][2][4][2];
#pragma unroll
    for (int a = 0; a < 2; ++a)
#pragma unroll
        for (int b = 0; b < 2; ++b)
#pragma unroll
            for (int m = 0; m < 4; ++m)
#pragma unroll
                for (int n = 0; n < 2; ++n) acc[a][b][m][n] = (f32x4){0.f, 0.f, 0.f, 0.f};
    bf16x8 At[4][2], B0[2][2], B1[2][2]; v8i_t At8[4], B08[2], B18[2];
    const int sc_w = WSC * 0x01010101, sc_x = 0x7f7f7f7f;
    unsigned cO[2][2] = {{0u, 0u}, {0u, 0u}}, nO[2][2] = {{0u, 0u}, {0u, 0u}};
    if constexpr (GATHER) { PG_GOFF(cO, cur); }
    const char* cA = GATHER ? gtable : cur.A; const char* cB = cur.B;
    PG_STB(PG_SB(0, 0), cB); PG_STB(PG_SB(0, 1), cB + hstepB); PG_STA(PG_SA(0, 0), cA, 0, false); PG_STA(PG_SA(0, 1), cA, 1, false);
    if (wr == 1) PG_BAR;
    PG_WAIT_V(2); PG_BAR;
    PG_STB(PG_SB(1, 0), cB + kstep); PG_STA(PG_SA(1, 0), cA + kstep, 0, false); PG_STB(PG_SB(1, 1), cB + hstepB + kstep);
    PG_WAIT_V(6); PG_BAR;
    for (;;) {
        const bool has_next = S.next(ui + 1, nxt);
        const int nt = cur.nt;
        if constexpr (GATHER) { if (has_next) { PG_GOFF(nO, nxt); } else {
#pragma unroll
            for (int h = 0; h < 2; ++h)
#pragma unroll
                for (int i = 0; i < 2; ++i) nO[h][i] = cO[h][i]; } }
        const char* nA = GATHER ? gtable : (has_next ? nxt.A : cA); const char* nB = has_next ? nxt.B : cB;
#pragma unroll 1
        for (int t = 0; t < nt; t += 2) {
            const bool last = (t == nt - 2);
            const char* a1 = cA + (size_t)(t + 1) * kstep;
            const char* a2 = last ? nA : cA + (size_t)(t + 2) * kstep; const char* b2 = last ? nB : cB + (size_t)(t + 2) * kstep;
            const char* a3 = a2 + kstep; const char* b3 = b2 + kstep;
            PG_LDB(B0, 0, 0); PG_LDB(B1, 0, 1); PG_SCHED; PG_LDA(At, 0, 0); PG_STA(PG_SA(1, 1), a1, 1, false);
            PG_WAIT_V(8); PG_WAIT_L(0); PG_BAR; PG_MMA(0, 0, At, B0); PG_MMA(0, 1, At, B1); PG_BAR; PG_SCHED;
            PG_LDA(At, 0, 1); PG_STB(PG_SB(0, 0), b2); PG_STB(PG_SB(0, 1), b2 + hstepB); PG_STA(PG_SA(0, 0), a2, 0, last);
            PG_WAIT_V(8); PG_WAIT_L(0); PG_BAR; PG_MMA(1, 0, At, B0); PG_MMA(1, 1, At, B1); PG_BAR; PG_SCHED;
            PG_LDB(B0, 1, 0); PG_LDB(B1, 1, 1); PG_SCHED; PG_LDA(At, 1, 0); PG_STA(PG_SA(0, 1), a2, 1, last);
            PG_WAIT_V(8); PG_WAIT_L(0); PG_BAR; PG_MMA(0, 0, At, B0); PG_MMA(0, 1, At, B1); PG_BAR; PG_SCHED;
            PG_LDA(At, 1, 1); PG_STB(PG_SB(1, 0), b3); PG_STB(PG_SB(1, 1), b3 + hstepB); PG_STA(PG_SA(1, 0), a3, 0, last);
            PG_WAIT_V(8); PG_WAIT_L(0); PG_BAR; PG_MMA(1, 0, At, B0); PG_MMA(1, 1, At, B1); PG_BAR; PG_SCHED;
        }
        if (wr == 0) PG_BAR;
        if constexpr (F8) asm volatile("s_nop 15\n\ts_nop 15" ::: "memory");
        E(acc, cur, wr, wc, fr, fq);
        if (!has_next) break;
#pragma unroll
        for (int a = 0; a < 2; ++a)
#pragma unroll
            for (int b = 0; b < 2; ++b)
#pragma unroll
                for (int m = 0; m < 4; ++m)
#pragma unroll
                    for (int n = 0; n < 2; ++n) acc[a][b][m][n] = (f32x4){0.f, 0.f, 0.f, 0.f};
        cur = nxt; cA = nA; cB = nB; ++ui;
        if constexpr (GATHER) {
#pragma unroll
            for (int h = 0; h < 2; ++h)
#pragma unroll
                for (int i = 0; i < 2; ++i) cO[h][i] = nO[h][i]; }
        if (wr == 1) PG_BAR;
    }
    PG_WAIT_V(0);
    PG_BAR;
#undef PG_SA
#undef PG_SB
#undef PG_ST2
#undef PG_STB
#undef PG_STA
#undef PG_LDA
#undef PG_LD8
#undef PG_LDB
#undef PG_MMA
#undef PG_WAIT_V
#undef PG_WAIT_L
#undef PG_BAR
#undef PG_SCHED
#undef PG_GOFF
#undef PG_GIDX
#undef PG_GCVT
}

struct EpiStore {
    __device__ __forceinline__ void operator()(const f32x4 (&acc)[2][2][4][2], const Unit& u, int wr, int wc, int fr, int fq) const {
        asm volatile("" : "+v"(fr), "+v"(fq));
        const float s = u.scale;
#pragma unroll
        for (int ai = 0; ai < 2; ++ai)
#pragma unroll
            for (int m = 0; m < 4; ++m) { const int row = ai * HALF + wr * 64 + m * 16 + fr;
                char* rowp = u.out + (ptrdiff_t)row * u.ldc + (wc * 32 + 8 * fq) * 2;
                if (!((u.flags & 1) && row == 0)) {
#pragma unroll
                for (int bj = 0; bj < 2; ++bj) { const f32x4 v0 = acc[ai][bj][m][0] * s, v1 = acc[ai][bj][m][1] * s;
                    u32x4 w; w.x = cvt_pk_bf16(v0[0], v0[1]); w.y = cvt_pk_bf16(v0[2], v0[3]); w.z = cvt_pk_bf16(v1[0], v1[1]); w.w = cvt_pk_bf16(v1[2], v1[3]);
                    *(u32x4*)(rowp + bj * 256) = w; } } }
    }
};
struct EpiStore8 {
    __device__ __forceinline__ void operator()(const f32x4 (&acc)[2][2][4][2], const Unit& u, int wr, int wc, int fr, int fq) const {
        asm volatile("" : "+v"(fr), "+v"(fq));
        const float s = u.scale;
#pragma unroll
        for (int ai = 0; ai < 2; ++ai)
#pragma unroll
            for (int m = 0; m < 4; ++m) { const int row = ai * HALF + wr * 64 + m * 16 + fr;
                char* rowp = u.out + (ptrdiff_t)row * u.ldc + (wc * 32 + 8 * fq);
#pragma unroll
                for (int bj = 0; bj < 2; ++bj) { const f32x4 v0 = acc[ai][bj][m][0] * s, v1 = acc[ai][bj][m][1] * s; int w0 = 0, w1 = 0;
                    w0 = __builtin_amdgcn_cvt_pk_fp8_f32(v0[0], v0[1], w0, false); w0 = __builtin_amdgcn_cvt_pk_fp8_f32(v0[2], v0[3], w0, true);
                    w1 = __builtin_amdgcn_cvt_pk_fp8_f32(v1[0], v1[1], w1, false); w1 = __builtin_amdgcn_cvt_pk_fp8_f32(v1[2], v1[3], w1, true);
                    u32x2 o; o.x = (unsigned)w0; o.y = (unsigned)w1; *(u32x2*)(rowp + bj * 128) = o; } }
    }
};
struct EpiQKV {
    bf16_t* Q; bf16_t* K; bf16_t* V; const float* ropec; const float* ropes;
    __device__ __forceinline__ void operator()(const f32x4 (&acc)[2][2][4][2], const Unit& u, int wr, int wc, int fr, int fq) const {
        asm volatile("" : "+v"(fr), "+v"(fq));
        const int pm = u.i0, pn = u.i1; const bool lat = pm < (T / 256); const bool rope = lat && pn < 5;
        const float qs = pn < 4 ? C2 : 1.f;
        const int part = wc & 1;
        const int fi0 = 8 * (fq & 1);
        const float sgn = (fq < 2) ? -1.f : 1.f;
#pragma unroll
        for (int ai = 0; ai < 2; ++ai)
#pragma unroll
            for (int m = 0; m < 4; ++m) { const int row = ai * HALF + wr * 64 + m * 16 + fr; const int tok = pm * 256 + row;
                const int tl = tok & (SEQ - 1); const int pos = part ? (tl & 63) : (tl >> 6);
                f32x4 c0 = {1.f, 1.f, 1.f, 1.f}, c1 = c0, s0 = {0.f, 0.f, 0.f, 0.f}, s1 = s0;
                if (rope) { c0 = *(const f32x4*)(ropec + pos * 16 + fi0); c1 = *(const f32x4*)(ropec + pos * 16 + fi0 + 4); s0 = *(const f32x4*)(ropes + pos * 16 + fi0); s1 = *(const f32x4*)(ropes + pos * 16 + fi0 + 4); }
#pragma unroll
                for (int bj = 0; bj < 2; ++bj) { f32x4 v0 = acc[ai][bj][m][0], v1 = acc[ai][bj][m][1];
                    if (rope) { f32x4 p0, p1;
#pragma unroll
                        for (int j = 0; j < 4; ++j) { p0[j] = __shfl_xor(v0[j], 32); p1[j] = __shfl_xor(v1[j], 32); }
                        v0 = v0 * c0 + (p0 * sgn) * s0; v1 = v1 * c1 + (p1 * sgn) * s1; }
                    v0 = v0 * qs; v1 = v1 * qs;
                    u32x4 w; w.x = cvt_pk_bf16(v0[0], v0[1]); w.y = cvt_pk_bf16(v0[2], v0[3]); w.z = cvt_pk_bf16(v1[0], v1[1]); w.w = cvt_pk_bf16(v1[2], v1[3]);
                    const int col = bj * HALF + wc * 32 + 8 * fq;
                    bf16_t* dst = pn < 4 ? Q + (size_t)tok * 1024 + pn * 256 + col : (pn == 4 ? K + (size_t)tok * 256 + col : V + (size_t)tok * 256 + col);
                    *(u32x4*)dst = w; } }
    }
};
struct EpiSilu {
    __device__ __forceinline__ void operator()(const f32x4 (&acc)[2][2][4][2], const Unit& u, int wr, int wc, int fr, int fq) const {
        asm volatile("" : "+v"(fr), "+v"(fq));
#pragma unroll
        for (int ai = 0; ai < 2; ++ai)
#pragma unroll
            for (int m = 0; m < 4; ++m) { const int row = ai * HALF + wr * 64 + m * 16 + fr;
                float h[8];
#pragma unroll
                for (int n = 0; n < 2; ++n)
#pragma unroll
                    for (int j = 0; j < 4; ++j) { const float g = acc[ai][0][m][n][j], up = acc[ai][1][m][n][j]; h[n * 4 + j] = g * __builtin_amdgcn_rcpf(1.f + __expf(-g)) * up; }
                int w0 = 0, w1 = 0;
                w0 = __builtin_amdgcn_cvt_pk_fp8_f32(h[0], h[1], w0, false); w0 = __builtin_amdgcn_cvt_pk_fp8_f32(h[2], h[3], w0, true);
                w1 = __builtin_amdgcn_cvt_pk_fp8_f32(h[4], h[5], w1, false); w1 = __builtin_amdgcn_cvt_pk_fp8_f32(h[6], h[7], w1, true);
                u32x2 o; o.x = (unsigned)w0; o.y = (unsigned)w1;
                *(u32x2*)(u.out + (size_t)row * 256 + (wc * 32 + 8 * fq)) = o; }
    }
};
struct EpiFp8 {
    __device__ __forceinline__ void operator()(const f32x4 (&acc)[2][2][4][2], const Unit& u, int wr, int wc, int fr, int fq) const {
        asm volatile("" : "+v"(fr), "+v"(fq));
        const int pn = u.i1;
#pragma unroll
        for (int ai = 0; ai < 2; ++ai)
#pragma unroll
            for (int m = 0; m < 4; ++m) { const int row = ai * HALF + wr * 64 + m * 16 + fr;
                u32x4 o;
#pragma unroll
                for (int bj = 0; bj < 2; ++bj) { const f32x4 v0 = acc[ai][bj][m][0] * 16.f, v1 = acc[ai][bj][m][1] * 16.f;
                    int w0 = 0, w1 = 0;
                    w0 = __builtin_amdgcn_cvt_pk_fp8_f32(v0[0], v0[1], w0, false); w0 = __builtin_amdgcn_cvt_pk_fp8_f32(v0[2], v0[3], w0, true);
                    w1 = __builtin_amdgcn_cvt_pk_fp8_f32(v1[0], v1[1], w1, false); w1 = __builtin_amdgcn_cvt_pk_fp8_f32(v1[2], v1[3], w1, true);
                    o[2 * bj] = (unsigned)w0; o[2 * bj + 1] = (unsigned)w1; }
                *(u32x4*)(u.out + (size_t)row * 1024 + (16 * pn + 4 * wc + fq) * 16) = o; }
    }
};
__device__ __forceinline__ int xcd_remap(int L0, int NU) { const int q = NU >> 3, r = NU & 7, x = L0 & 7, off = L0 >> 3; return (x < r ? x * (q + 1) : r * (q + 1) + (x - r) * q) + off; }
}

namespace attn {
constexpr int SLOTB = 8192;
constexpr int LDS_K = 0, LDS_V = 2 * SLOTB, LDS_WS = 4 * SLOTB, LDS_OST = LDS_WS + NWAVES * 256, LDS_END = LDS_OST + NWAVES * 4096;
static_assert(LDS_END <= RING_BYTES, "attention LDS");
__device__ __forceinline__ int crow(int r, int hi) { return (r & 3) + 8 * (r >> 2) + 4 * hi; }
__device__ __forceinline__ void glds16(const void* gsrc, unsigned lds_dst) { unsigned keep;
    asm volatile("s_mov_b32 %0, m0\n\ts_mov_b32 m0, %2\n\ts_nop 0\n\tglobal_load_lds_dwordx4 %1, off\n\ts_mov_b32 m0, %0" : "=&s"(keep) : "v"(gsrc), "s"(lds_dst) : "memory"); }
__device__ __forceinline__ float rowmax(const f32x16& p0, const f32x16& p1) {
    float a = fmaxf(p0[0], p1[0]);
#pragma unroll
    for (int r = 1; r < 16; ++r) a = fmaxf(a, fmaxf(p0[r], p1[r]));
    auto rr = __builtin_amdgcn_permlane32_swap(__float_as_uint(a), __float_as_uint(a), false, false);
    return fmaxf(__uint_as_float(rr[0]), __uint_as_float(rr[1]));
}
typedef short v4i16_t __attribute__((ext_vector_type(4)));
__device__ __forceinline__ s16x4 vtr(const LAS unsigned char* p) { return __builtin_bit_cast(s16x4, __builtin_amdgcn_ds_read_tr16_b64_v4i16((LAS v4i16_t*)p)); }
__device__ __forceinline__ void pv(f32x16* o, const LAS unsigned char* vp, bf16x8 pa0, bf16x8 pa1, bf16x8 pa2, bf16x8 pa3) {
#pragma unroll
    for (int d0 = 0; d0 < 2; ++d0) { s16x4 lo[4], hi[4];
#pragma unroll
        for (int ks = 0; ks < 4; ++ks) { lo[ks] = vtr(vp + d0 * 4096 + ks * 1024); hi[ks] = vtr(vp + d0 * 4096 + ks * 1024 + 512); }
#define PK(k) (bf16x8){lo[k][0], lo[k][1], lo[k][2], lo[k][3], hi[k][0], hi[k][1], hi[k][2], hi[k][3]}
        o[d0] = __builtin_amdgcn_mfma_f32_32x32x16_bf16(pa0, PK(0), o[d0], 0, 0, 0);
        o[d0] = __builtin_amdgcn_mfma_f32_32x32x16_bf16(pa1, PK(1), o[d0], 0, 0, 0);
        o[d0] = __builtin_amdgcn_mfma_f32_32x32x16_bf16(pa2, PK(2), o[d0], 0, 0, 0);
        o[d0] = __builtin_amdgcn_mfma_f32_32x32x16_bf16(pa3, PK(3), o[d0], 0, 0, 0);
#undef PK
    }
}
__device__ __forceinline__ void attn_unit(const bf16_t* Q, const bf16_t* K, const bf16_t* V, bf16_t* O, int b, int h, int q0, bool isctx, float sink2, LAS unsigned char* shm) {
    const int tid = opaque_tid(), lane = tid & 63, r32 = lane & 31, hi = lane >> 5; const int wid = __builtin_amdgcn_readfirstlane(tid >> 6);
    const int kvh = h >> 2;
    const long qrow = isctx ? (long)T + b * CTXL + wid * 32 : (long)b * SEQ + q0 + wid * 32;
    const unsigned lds0 = (unsigned)(uintptr_t)shm;
    LAS float* wsf = (LAS float*)(shm + LDS_WS) + wid * 64;
    int jlo = 0, nl = 0;
    if (!isctx) { jlo = (q0 == 0) ? 2 : 0; int jhi = (SEQ - q0 + 128) / 64; if (jhi > 8) jhi = 8; nl = jhi - jlo; }
    const int NT = nl + 4;
    const long lat0 = (long)b * SEQ + q0 - 128 + 64 * jlo, ctx0 = (long)T + b * CTXL;
#define TROW(t) ((t) < nl ? lat0 + 64 * (t) : ctx0 + 64 * ((t) - nl))
    const int kcol = kvh * 64 + wid * 8, vcol = kvh * 64 + (wid >> 2) * 32 + (lane & 3) * 8, vrow = 16 * (wid & 3) + (lane >> 2);
    const unsigned kdst = lds0 + LDS_K + wid * 1024, vdst = lds0 + LDS_V + wid * 1024;
#define DMA_KV(t, slot) do { const long tr_ = TROW(t); glds16(K + (tr_ + lane) * 256 + kcol, (unsigned)__builtin_amdgcn_readfirstlane(kdst + (slot) * SLOTB)); \
        glds16(V + (tr_ + vrow) * 256 + vcol, (unsigned)__builtin_amdgcn_readfirstlane(vdst + (slot) * SLOTB)); } while (0)
    DMA_KV(0, 0);
    bf16x8 qr[4];
#pragma unroll
    for (int d0 = 0; d0 < 4; ++d0) qr[d0] = *(const GAS bf16x8*)(Q + (qrow + r32) * 1024 + h * 64 + d0 * 16 + hi * 8);
    float mrun = sink2, l_reg = (hi == 0) ? 1.f : 0.f;
    f32x16 negm;
#pragma unroll
    for (int r = 0; r < 16; ++r) negm[r] = -sink2;
    f32x16 o[2];
#pragma unroll
    for (int r = 0; r < 16; ++r) { o[0][r] = 0.f; o[1][r] = 0.f; }
    const LAS unsigned char* vp0 = shm + LDS_V + ((lane >> 4) & 1) * 32 + (lane & 3) * 8 + (4 * hi + ((lane & 15) >> 2)) * 64;
    const int qw = q0 + wid * 32;
    asm volatile("s_waitcnt vmcnt(0) lgkmcnt(0)\n\ts_barrier" ::: "memory");
    for (int t = 0; t < NT; ++t) {
        const int slot = t & 1;
        if (t + 1 < NT) DMA_KV(t + 1, slot ^ 1);
        const bool latt = t < nl;
        const int ks = q0 - 128 + 64 * (jlo + t);
        bool need = true;
        if (latt) need = (ks + 63 >= qw - 128) && (ks <= qw + 31 + 128);
        if (need) {
            f32x16 p0, p1;
            const LAS unsigned char* kb = shm + LDS_K + slot * SLOTB + hi * 1024 + r32 * 16;
#pragma unroll
            for (int d0 = 0; d0 < 4; ++d0) {
                const bf16x8 b0 = *(const LAS bf16x8*)(kb + d0 * 2048), b1 = *(const LAS bf16x8*)(kb + d0 * 2048 + 512);
                if (d0 == 0) { p0 = __builtin_amdgcn_mfma_f32_32x32x16_bf16(b0, qr[0], negm, 0, 0, 0); p1 = __builtin_amdgcn_mfma_f32_32x32x16_bf16(b1, qr[0], negm, 0, 0, 0); }
                else { p0 = __builtin_amdgcn_mfma_f32_32x32x16_bf16(b0, qr[d0], p0, 0, 0, 0); p1 = __builtin_amdgcn_mfma_f32_32x32x16_bf16(b1, qr[d0], p1, 0, 0, 0); } }
            if (latt && !(ks >= qw - 97 && ks <= qw + 65)) {
                const int dq = qw + r32 - ks;
#pragma unroll
                for (int r = 0; r < 16; ++r) { const int d = dq - crow(r, hi); if (d > 128 || d < -128) p0[r] = -INFINITY; if (d - 32 > 128 || d - 32 < -128) p1[r] = -INFINITY; } }
            const float rm = rowmax(p0, p1);
            if (__any(rm > 8.f)) {
                const float delta = fmaxf(rm, 0.f);
                const float alpha = __builtin_amdgcn_exp2f(-delta); l_reg *= alpha; mrun += delta;
#pragma unroll
                for (int r = 0; r < 16; ++r) { p0[r] -= delta; p1[r] -= delta; negm[r] = -mrun; }
                if (hi == 0) wsf[r32] = alpha;
                asm volatile("s_waitcnt lgkmcnt(0)" ::: "memory");
#pragma unroll
                for (int r = 0; r < 16; ++r) { const float f = wsf[crow(r, hi)]; o[0][r] *= f; o[1][r] *= f; }
            }
            float sacc = 0.f;
#pragma unroll
            for (int r = 0; r < 16; ++r) { p0[r] = __builtin_amdgcn_exp2f(p0[r]); p1[r] = __builtin_amdgcn_exp2f(p1[r]); sacc += p0[r] + p1[r]; }
            l_reg += sacc;
            u32x4 pw0, pw1, pw2, pw3;
#define PKW(P, B) cvt_pk_bf16(P[B], P[B + 1])
            pw0 = (u32x4){PKW(p0, 0), PKW(p0, 2), PKW(p0, 4), PKW(p0, 6)}; pw1 = (u32x4){PKW(p0, 8), PKW(p0, 10), PKW(p0, 12), PKW(p0, 14)};
            pw2 = (u32x4){PKW(p1, 0), PKW(p1, 2), PKW(p1, 4), PKW(p1, 6)}; pw3 = (u32x4){PKW(p1, 8), PKW(p1, 10), PKW(p1, 12), PKW(p1, 14)};
#undef PKW
            __builtin_amdgcn_sched_barrier(0);
            pv(o, vp0 + slot * SLOTB, __builtin_bit_cast(bf16x8, pw0), __builtin_bit_cast(bf16x8, pw1), __builtin_bit_cast(bf16x8, pw2), __builtin_bit_cast(bf16x8, pw3));
        }
        asm volatile("s_waitcnt vmcnt(0) lgkmcnt(0)\n\ts_barrier" ::: "memory");
    }
    { auto rr = __builtin_amdgcn_permlane32_swap(__float_as_uint(l_reg), __float_as_uint(l_reg), false, false); l_reg = __uint_as_float(rr[0]) + __uint_as_float(rr[1]); }
    if (hi == 0) wsf[32 + r32] = l_reg;
    asm volatile("s_waitcnt lgkmcnt(0)" ::: "memory");
    float rli[16];
#pragma unroll
    for (int r = 0; r < 16; ++r) rli[r] = __builtin_amdgcn_rcpf(wsf[32 + crow(r, hi)]);
    unsigned char* Ow = (unsigned char*)O + qrow * 1024 + h * 64;
    { LAS unsigned char* stg = shm + LDS_OST + wid * 2048;
#pragma unroll
      for (int r = 0; r < 16; ++r) { const int orow = crow(r, hi);
#pragma unroll
          for (int d0 = 0; d0 < 2; ++d0) stg[orow * 64 + d0 * 32 + r32] = (unsigned char)f2f8(o[d0][r] * rli[r]); }
      asm volatile("s_waitcnt lgkmcnt(0)" ::: "memory");
#pragma unroll
      for (int i = 0; i < 2; ++i) { const int row = i * 16 + (lane >> 2), ch = lane & 3; const u32x4 v = *(const LAS u32x4*)(stg + row * 64 + ch * 16); *(GAS u32x4*)(Ow + (long)row * 1024 + ch * 16) = v; } }
    asm volatile("s_waitcnt lgkmcnt(0)" ::: "memory");
#undef TROW
#undef DMA_KV
}
}

struct Args {
    const float* in[20];
    float* out; unsigned char* ws;
};
struct Frame {
    LAS unsigned char* lds; unsigned* ctl; unsigned char* ws;
    int tid, lane, wave, gw;
    int blk;
    __device__ __forceinline__ void refresh() { tid = opaque_tid(); lane = tid & 63; wave = __builtin_amdgcn_readfirstlane(tid >> 6); gw = blk * 8 + wave;
        asm volatile("" : "+s"(ws)); ctl = (unsigned*)(ws + WS_CTL); }
};
constexpr int NGW = GRID * NWAVES;

struct Row { f32x4 v[4]; };
__device__ __forceinline__ int vq(int q, int lane) { return 64 * (lane >> 4) + 2 * (lane & 15) + 32 * (q >> 1) + (q & 1); }
__device__ __forceinline__ int vb(int j, int lane) { return 32 * (lane >> 4) + (lane & 15) + 16 * j; }
__device__ __forceinline__ void row_load_bf16(Row& r, const bf16_t* p, int lane) {
#pragma unroll
    for (int j = 0; j < 2; ++j) { const u32x4 w = ((const GAS u32x4*)p)[vb(j, lane)]; r.v[2 * j] = (f32x4){bflo(w.x), bfhi(w.x), bflo(w.y), bfhi(w.y)}; r.v[2 * j + 1] = (f32x4){bflo(w.z), bfhi(w.z), bflo(w.w), bfhi(w.w)}; } }
__device__ __forceinline__ void row_store_bf16(const Row& r, bf16_t* p, int lane) {
#pragma unroll
    for (int j = 0; j < 2; ++j) { u32x4 w; w.x = pk2(r.v[2 * j][0], r.v[2 * j][1]); w.y = pk2(r.v[2 * j][2], r.v[2 * j][3]); w.z = pk2(r.v[2 * j + 1][0], r.v[2 * j + 1][1]); w.w = pk2(r.v[2 * j + 1][2], r.v[2 * j + 1][3]); ((GAS u32x4*)p)[vb(j, lane)] = w; } }
typedef float f32x2v __attribute__((ext_vector_type(2)));
__device__ __forceinline__ void row_load_fp8(Row& r, const unsigned char* p, int lane) {
    const u32x4 w = ((const GAS u32x4*)p)[lane];
#pragma unroll
    for (int q = 0; q < 4; ++q) { const f32x2v lo = __builtin_amdgcn_cvt_pk_f32_fp8((int)w[q], false), hi = __builtin_amdgcn_cvt_pk_f32_fp8((int)w[q], true); r.v[q] = (f32x4){lo[0], lo[1], hi[0], hi[1]}; } }
__device__ __forceinline__ void row_store_fp8(const Row& r, unsigned char* p, int lane) {
    const int e0 = 256 * (lane >> 4) + 8 * (lane & 15);
#pragma unroll
    for (int j = 0; j < 2; ++j) { int w0 = 0, w1 = 0;
        w0 = __builtin_amdgcn_cvt_pk_fp8_f32(r.v[2 * j][0], r.v[2 * j][1], w0, false); w0 = __builtin_amdgcn_cvt_pk_fp8_f32(r.v[2 * j][2], r.v[2 * j][3], w0, true);
        w1 = __builtin_amdgcn_cvt_pk_fp8_f32(r.v[2 * j + 1][0], r.v[2 * j + 1][1], w1, false); w1 = __builtin_amdgcn_cvt_pk_fp8_f32(r.v[2 * j + 1][2], r.v[2 * j + 1][3], w1, true);
        u32x2 o; o.x = (unsigned)w0; o.y = (unsigned)w1; *(GAS u32x2*)(p + e0 + 128 * j) = o; } }
__device__ __forceinline__ void row_load_f32(Row& r, const float* p, int lane) {
#pragma unroll
    for (int q = 0; q < 4; ++q) r.v[q] = ((const GAS f32x4*)p)[vq(q, lane)]; }
__device__ __forceinline__ void row_store_f32(const Row& r, float* p, int lane) {
#pragma unroll
    for (int q = 0; q < 4; ++q) ((GAS f32x4*)p)[vq(q, lane)] = r.v[q]; }
__device__ __forceinline__ void row_normalize(Row& r, float eps) {
    float s = 0.f;
#pragma unroll
    for (int j = 0; j < 4; ++j) s += (r.v[j][0] + r.v[j][1]) + (r.v[j][2] + r.v[j][3]);
    const float mean = wave_sum(s) * (1.f / D); float q = 0.f;
#pragma unroll
    for (int j = 0; j < 4; ++j) { r.v[j] = r.v[j] - mean; q += (r.v[j][0] * r.v[j][0] + r.v[j][1] * r.v[j][1]) + (r.v[j][2] * r.v[j][2] + r.v[j][3] * r.v[j][3]); }
    const float rstd = 1.f / sqrtf(wave_sum(q) * (1.f / D) + eps);
#pragma unroll
    for (int j = 0; j < 4; ++j) r.v[j] = r.v[j] * rstd;
}
__device__ __forceinline__ void row_modulate(Row& r, const float* sh, const float* sc, int lane) {
    row_normalize(r, MOD_EPS);
#pragma unroll
    for (int j = 0; j < 4; ++j) { const f32x4 a = ((const GAS f32x4*)sc)[vq(j, lane)], b = ((const GAS f32x4*)sh)[vq(j, lane)]; r.v[j] = r.v[j] * (a + 1.f) + b; }
}
__device__ __forceinline__ int mod_row(int row) { return row < T ? (row >> 11) : 32; }
__device__ __forceinline__ const float* mod_vec(const unsigned char* ws, int layer, int mr, int chunk) { return (const float*)(ws + WS_MOD) + ((size_t)(layer * 33 + mr) * 6 + chunk) * 1024; }

__device__ __forceinline__ void conv_item(const float* W, int N, bf16_t* WT, int Kd, int kd0, int n0, int drow0, bool mirror, LAS float* scr, int lane) {
#pragma unroll 8
    for (int i = 0; i < 32; ++i) { const int kk = 2 * i + (lane >> 5); const int kd = kd0 + kk; const int ks = mirror ? ((kd & ~255) + ((256 - (kd & 255)) & 255)) : kd;
        scr[kk * 33 + (lane & 31)] = ((const GAS float*)W)[(size_t)ks * N + n0 + (lane & 31)]; }
    LDS_WAIT(); asm volatile("" ::: "memory");
    const int c = lane & 7;
#pragma unroll
    for (int j = 0; j < 4; ++j) { const int n = (lane >> 3) + 8 * j; const LAS float* s = scr + (8 * c) * 33 + n;
        u32x4 o; o.x = pk2(s[0 * 33], s[1 * 33]); o.y = pk2(s[2 * 33], s[3 * 33]); o.z = pk2(s[4 * 33], s[5 * 33]); o.w = pk2(s[6 * 33], s[7 * 33]);
        *(GAS u32x4*)(WT + (size_t)(drow0 + n) * Kd + kd0 + 8 * c) = o; }
    LDS_WAIT(); asm volatile("" ::: "memory");
}
__device__ __forceinline__ void conv_matrix_item(const float* W, int K, int N, bf16_t* WT, int mode, int roff, int item, LAS float* scr, int lane) {
    const int nblk = N / 32, kb = item / nblk, nb = item % nblk, n0 = 32 * nb;
    int drow0 = n0 + roff; if (mode == 1) drow0 = (n0 >> 7) * 256 + (n0 & 127); if (mode == 2) drow0 = (n0 >> 7) * 256 + 128 + (n0 & 127);
    conv_item(W, N, WT, K, 64 * kb, n0, drow0, mode == 3, scr, lane);
}
__device__ __forceinline__ void conv_item64(const float* W, int N, bf16_t* WT, int Kd, int k0, int n0, int drow0, LAS bf16_t* scr, int lane) {
    f32x4 v[16];
#pragma unroll
    for (int i = 0; i < 16; ++i) v[i] = *(const GAS f32x4*)(W + (size_t)(k0 + 4 * i + (lane >> 4)) * N + n0 + (lane & 15) * 4);
#pragma unroll
    for (int i = 0; i < 16; ++i) { u32x2 w; w.x = pk2(v[i][0], v[i][1]); w.y = pk2(v[i][2], v[i][3]); *(LAS u32x2*)(scr + (4 * i + (lane >> 4)) * 68 + (lane & 15) * 4) = w; }
    LDS_WAIT(); asm volatile("" ::: "memory");
    const int c = lane & 7;
#pragma unroll
    for (int j = 0; j < 8; ++j) { const int n = (lane >> 3) + 8 * j; const LAS bf16_t* p = scr + (8 * c) * 68 + n;
        u32x4 o; o.x = (unsigned)p[0] | ((unsigned)p[68] << 16); o.y = (unsigned)p[2 * 68] | ((unsigned)p[3 * 68] << 16); o.z = (unsigned)p[4 * 68] | ((unsigned)p[5 * 68] << 16); o.w = (unsigned)p[6 * 68] | ((unsigned)p[7 * 68] << 16);
        *(GAS u32x4*)(WT + (size_t)(drow0 + n) * Kd + k0 + 8 * c) = o; }
    LDS_WAIT(); asm volatile("" ::: "memory");
}
__device__ __forceinline__ void conv_item64_f8(const float* W, int N, unsigned char* WT, int Kd, int k0, int n0, int drow0, LAS unsigned char* scr, int lane, bool mirror = false) {
    f32x4 v[16];
#pragma unroll
    for (int i = 0; i < 16; ++i) { const int kd = k0 + 4 * i + (lane >> 4); const int ks = mirror ? ((kd & ~255) + ((256 - (kd & 255)) & 255)) : kd; v[i] = *(const GAS f32x4*)(W + (size_t)ks * N + n0 + (lane & 15) * 4); }
#pragma unroll
    for (int i = 0; i < 16; ++i) { int w = 0; w = __builtin_amdgcn_cvt_pk_fp8_f32(v[i][0] * 64.f, v[i][1] * 64.f, w, false); w = __builtin_amdgcn_cvt_pk_fp8_f32(v[i][2] * 64.f, v[i][3] * 64.f, w, true);
        *(LAS unsigned*)(scr + (4 * i + (lane >> 4)) * 68 + (lane & 15) * 4) = (unsigned)w; }
    LDS_WAIT(); asm volatile("" ::: "memory");
    const int c = lane & 3;
#pragma unroll
    for (int j = 0; j < 4; ++j) { const int n = (lane >> 2) + 16 * j; const LAS unsigned char* p = scr + (16 * c) * 68 + n; u32x4 o;
#pragma unroll
        for (int q = 0; q < 4; ++q) o[q] = (unsigned)p[(4 * q) * 68] | ((unsigned)p[(4 * q + 1) * 68] << 8) | ((unsigned)p[(4 * q + 2) * 68] << 16) | ((unsigned)p[(4 * q + 3) * 68] << 24);
        *(GAS u32x4*)(WT + (size_t)(drow0 + n) * Kd + k0 + 16 * c) = o; }
    LDS_WAIT(); asm volatile("" ::: "memory");
}
__device__ __forceinline__ void conv_experts(Frame& F, const Args& a, int layer) {
    F.refresh();
    LAS unsigned char* scr = F.lds + 32768 + F.wave * 4352;
    unsigned char* EGU = F.ws + WS_EGU; unsigned char* ED = F.ws + WS_ED;
    for (int it = F.gw; it < (NE + 1) * 192; it += NGW) { const int e = it / 192, r = it % 192;
        const float* wg = e < NE ? a.in[14] + ((size_t)layer * NE + e) * 262144 : a.in[17] + (size_t)layer * 262144;
        const float* wu = e < NE ? a.in[15] + ((size_t)layer * NE + e) * 262144 : a.in[18] + (size_t)layer * 262144;
        const float* wd = e < NE ? a.in[16] + ((size_t)layer * NE + e) * 262144 : a.in[19] + (size_t)layer * 262144;
        if (r < 128) { const int q = r & 63, kb = q >> 2, nb = q & 3, n0 = 64 * nb; const int drow0 = (n0 >> 7) * 256 + (r < 64 ? 0 : 128) + (n0 & 127);
            conv_item64_f8(r < 64 ? wg : wu, 256, EGU + (size_t)e * 512 * 1024, 1024, 64 * kb, n0, drow0, scr, F.lane); }
        else { const int q = r - 128, kb = q >> 4, nb = q & 15; conv_item64_f8(wd, 1024, ED + (size_t)e * 1024 * 256, 256, 64 * kb, 64 * nb, 64 * nb, scr, F.lane); } }
}
__device__ __forceinline__ void conv_small(Frame& F, const Args& a) {
    F.refresh();
    { LAS unsigned char* scr8 = F.lds + 32768 + F.wave * 4352;
      for (int it = F.gw; it < 2304; it += NGW) {
          if (it < 768) { const int j = it / 384, r = it % 384, kb = r / 24, nb = r % 24; conv_item64_f8(a.in[8] + (size_t)j * 1024 * 1536, 1536, F.ws + WS_WQKV + (size_t)j * 1536 * 1024, 1024, 64 * kb, 64 * nb, 64 * nb, scr8, F.lane); }
          else if (it < 1280) { const int q = it - 768, j = q >> 8, r = q & 255, kb = r >> 4, nb = r & 15; conv_item64_f8(a.in[9] + (size_t)j * 1024 * 1024, 1024, F.ws + WS_WO + (size_t)j * 1024 * 1024, 1024, 64 * kb, 64 * nb, 64 * nb, scr8, F.lane); }
          else { const int q = it - 1280, j = q >> 9, r = q & 511, mir = r >> 8, kb = (r & 255) >> 4, nb = r & 15;
              conv_item64_f8(a.in[11] + (size_t)j * 1024 * 1024, 1024, F.ws + WS_WSH + (size_t)j * 2048 * 1024, 1024, 64 * kb, 64 * nb, 64 * nb + 1024 * mir, scr8, F.lane, mir != 0); } } }
    __syncthreads();
    { LAS float* scr = (LAS float*)(F.lds + 32768 + F.wave * 8448);
      for (int it = F.gw; it < 1152; it += NGW) {
          if (it < 1024) { const int j = it >> 9, r = it & 511; conv_matrix_item(a.in[11] + (size_t)j * 1024 * 1024, 1024, 1024, (bf16_t*)(F.ws + WS_WF) + (size_t)j * 2048 * 1024, 0, 0, r, scr, F.lane); }
          else { const int q = it - 1024, l = q / 32, r = q % 32; conv_matrix_item(a.in[12] + (size_t)l * 1024 * 64, 1024, 64, (bf16_t*)(F.ws + WS_WR) + (size_t)l * 64 * 1024, 0, 0, r, scr, F.lane); } } }
    const int gt = F.blk * NTHR + F.tid, NGT = GRID * NTHR;
    const float TWO_PI = 6.283185307179586f;
    { float* rc = (float*)(F.ws + WS_ROPEC); float* rs = (float*)(F.ws + WS_ROPES);
      for (int i = gt; i < 64 * 16; i += NGT) { const int pos = i >> 4, fi = i & 15; const float inv = exp2f(-(float)fi * (13.287712379549449f / 16.f)); const float ang = (float)pos * inv; rc[i] = cosf(ang); rs[i] = sinf(ang); } }
    { unsigned* cs = (unsigned*)(F.ws + WS_CSN);
      for (int i = gt; i < 512 * 64; i += NGT) { const int r = i >> 6, n4 = (i & 63) * 4, m = r & 255; unsigned w = 0;
#pragma unroll
          for (int q = 0; q < 4; ++q) { const float ang = TWO_PI * (float)((m * (n4 + q)) & 255) * (1.f / 256.f); w |= f2f8(r < 256 ? __cosf(ang) : -__sinf(ang)) << (8 * q); }
          cs[i] = w; } }
    { unsigned* dl = (unsigned*)(F.ws + WS_DL);
      for (int i = gt; i < 1024 * 1024; i += NGT) { const int k = i >> 10, c4 = (i & 1023) * 4; unsigned w = 0;
#pragma unroll
          for (int q = 0; q < 4; ++q) { const int c = c4 + q, l = c & 2047; const float ang = TWO_PI * (float)((k * l) & 2047) * (1.f / 2048.f); w |= f2f8(c < 2048 ? __cosf(ang) : __sinf(ang)) << (8 * q); }
          dl[i] = w; } }
    { unsigned* dl = (unsigned*)(F.ws + WS_DLC);
      for (int i = gt; i < 256 * 128; i += NGT) { const int k = i >> 7, c4 = (i & 127) * 4; unsigned w = 0;
#pragma unroll
          for (int q = 0; q < 4; ++q) { const int c = c4 + q, l = c & 255; const float ang = TWO_PI * (float)((k * l) & 255) * (1.f / 256.f); w |= f2f8(c < 256 ? __cosf(ang) : __sinf(ang)) << (8 * q); }
          dl[i] = w; } }
}
__device__ __forceinline__ void mod_full(Frame& F, const Args& a) {
    F.refresh();
    if (F.blk >= 192) return;
    const int l = F.blk / 48, cb = F.blk % 48; const int col = F.tid & 127, ks = F.tid >> 7; const int n = cb * 128 + col;
    LAS float* s = (LAS float*)F.lds;
    float acc[33];
#pragma unroll
    for (int r = 0; r < 33; ++r) acc[r] = 0.f;
    for (int half = 0; half < 2; ++half) {
        __syncthreads();
        for (int i = F.tid; i < 512 * 33; i += NTHR) { const int k = i / 33, r = i % 33; const float c = (r < 32) ? a.in[1][(size_t)r * 1024 + half * 512 + k] : a.in[3][half * 512 + k]; s[k * 36 + r] = c / (1.f + __expf(-c)); }
        __syncthreads();
        const GAS float* w = (const GAS float*)a.in[4] + ((size_t)l * 1024 + half * 512 + ks * 128) * 6144 + n;
#pragma unroll 1
        for (int kb = 0; kb < 128; kb += 16) { float wv[16];
#pragma unroll
            for (int q = 0; q < 16; ++q) wv[q] = w[(size_t)(kb + q) * 6144];
#pragma unroll
            for (int q = 0; q < 16; ++q) { const LAS float* sr = s + (ks * 128 + kb + q) * 36;
#pragma unroll
                for (int r = 0; r < 33; ++r) acc[r] += sr[r] * wv[q];
                asm volatile("" ::: "memory"); } }
    }
    __syncthreads();
    LAS float* red = (LAS float*)F.lds;
#pragma unroll
    for (int r = 0; r < 33; ++r) red[(ks * 33 + r) * 128 + col] = acc[r];
    __syncthreads();
    float* mod = (float*)(F.ws + WS_MOD);
    for (int i = F.tid; i < 33 * 128; i += NTHR) { const int r = i >> 7, c = i & 127; const int nn = cb * 128 + c;
        mod[((size_t)l * 33 + r) * 6144 + nn] = a.in[5][l * 6144 + nn] + (red[(0 * 33 + r) * 128 + c] + red[(1 * 33 + r) * 128 + c]) + (red[(2 * 33 + r) * 128 + c] + red[(3 * 33 + r) * 128 + c]); }
    __syncthreads();
}
__device__ __forceinline__ void rows_init(Frame& F, const Args& a) {
    F.refresh();
    bf16_t* XS = (bf16_t*)(F.ws + WS_XS);
    for (int r0 = F.gw; r0 < TT; r0 += 2 * NGW) { const int r1 = r0 + NGW; const bool two = r1 < TT;
        Row r[2];
#pragma unroll
        for (int t = 0; t < 2; ++t) if (t == 0 || two) { const int row = t ? r1 : r0; row_load_f32(r[t], row < T ? a.in[0] + (size_t)row * D : a.in[2] + (size_t)(row - T) * D, F.lane); }
#pragma unroll
        for (int t = 0; t < 2; ++t) if (t == 0 || two) { const int row = t ? r1 : r0; const int mr = mod_row(row);
            row_store_bf16(r[t], XS + (size_t)row * D, F.lane);
            row_modulate(r[t], mod_vec(F.ws, 0, mr, 0), mod_vec(F.ws, 0, mr, 1), F.lane);
            row_store_fp8(r[t], (unsigned char*)a.out + OUT_U8 + (size_t)row * D, F.lane); } }
}
__device__ __forceinline__ void rows_post1(Frame& F, const Args& a, int layer, int nrows) {
    F.refresh();
    bf16_t* XS = (bf16_t*)(F.ws + WS_XS); bf16_t* U = (bf16_t*)a.out;
    const float* lg = a.in[6] + (size_t)(layer * 2 + 0) * D; const float* lb = a.in[7] + (size_t)(layer * 2 + 0) * D;
    const int TPB = nrows / GRID;
    for (int rl = F.wave; rl < TPB; rl += 2 * NWAVES) {
        const bool two = rl + NWAVES < TPB;
        Row x[2], y[2];
#pragma unroll
        for (int t = 0; t < 2; ++t) if (t == 0 || two) { const int row = F.blk * TPB + rl + t * NWAVES; row_load_bf16(x[t], XS + (size_t)row * D, F.lane); row_load_bf16(y[t], U + (size_t)row * D, F.lane); }
#pragma unroll
        for (int t = 0; t < 2; ++t) if (t == 0 || two) { const int row = F.blk * TPB + rl + t * NWAVES; const int mr = mod_row(row);
            const float* g1 = mod_vec(F.ws, layer, mr, 2);
#pragma unroll
            for (int j = 0; j < 4; ++j) x[t].v[j] = x[t].v[j] * ALPHA + ((const GAS f32x4*)g1)[vq(j, F.lane)] * y[t].v[j];
            row_normalize(x[t], LN_EPS);
#pragma unroll
            for (int j = 0; j < 4; ++j) x[t].v[j] = x[t].v[j] * ((const GAS f32x4*)lg)[vq(j, F.lane)] + ((const GAS f32x4*)lb)[vq(j, F.lane)];
            row_store_bf16(x[t], XS + (size_t)row * D, F.lane);
            row_modulate(x[t], mod_vec(F.ws, layer, mr, 3), mod_vec(F.ws, layer, mr, 4), F.lane);
            row_store_bf16(x[t], U + (size_t)row * D, F.lane);
            row_store_fp8(x[t], (unsigned char*)a.out + OUT_U8 + (size_t)row * D, F.lane); }
    }
}
__device__ __forceinline__ void rows_post2(Frame& F, const Args& a, int layer, int t0, int n) {
    F.refresh();
    bf16_t* XS = (bf16_t*)(F.ws + WS_XS); const unsigned char* YB = (const unsigned char*)(F.ws + WS_YB); const unsigned char* YS = (const unsigned char*)(F.ws + WS_YS);
    const int* spos = (const int*)(F.ws + WS_SDST); const float* tkw = (const float*)(F.ws + WS_TKW);
    const float* lg = a.in[6] + (size_t)(layer * 2 + 1) * D; const float* lb = a.in[7] + (size_t)(layer * 2 + 1) * D;
    for (int i0 = F.gw; i0 < n; i0 += 2 * NGW) {
        const int i1 = i0 + NGW; const bool two = i1 < n;
        int pj[2]; float wj[2];
#pragma unroll
        for (int t = 0; t < 2; ++t) { pj[t] = 0; wj[t] = 0.f; const int row = t0 + (t ? i1 : i0); if ((t == 0 || two) && F.lane < 8) { pj[t] = ((const GAS int*)spos)[(size_t)row * 8 + F.lane]; wj[t] = ((const GAS float*)tkw)[(size_t)row * 8 + F.lane]; } }
        Row x[2], y[2];
#pragma unroll
        for (int t = 0; t < 2; ++t) { const int i = t ? i1 : i0; if (t == 0 || two) { row_load_bf16(x[t], XS + (size_t)(t0 + i) * D, F.lane); row_load_fp8(y[t], YS + (size_t)i * D, F.lane); } }
        u32x4 zr[2][8];
#pragma unroll
        for (int t = 0; t < 2; ++t) if (t == 0 || two) {
#pragma unroll
            for (int s = 0; s < 8; ++s) { const int ps = __builtin_amdgcn_readlane(pj[t], s); zr[t][s] = ((const GAS u32x4*)(YB + (size_t)ps * D))[F.lane]; } }
#pragma unroll
        for (int t = 0; t < 2; ++t) if (t == 0 || two) { const int i = t ? i1 : i0; const int row = t0 + i; const int mr = mod_row(row);
#pragma unroll
            for (int j = 0; j < 4; ++j) y[t].v[j] = y[t].v[j] * (1.f / 16.f);
#pragma unroll
            for (int s = 0; s < 8; ++s) { const float wz = __builtin_bit_cast(float, __builtin_amdgcn_readlane(__builtin_bit_cast(int, wj[t]), s)) * (1.f / 16.f);
#pragma unroll
                for (int j = 0; j < 4; ++j) { const f32x2v lo = __builtin_amdgcn_cvt_pk_f32_fp8((int)zr[t][s][j], false), hi = __builtin_amdgcn_cvt_pk_f32_fp8((int)zr[t][s][j], true); y[t].v[j] += (f32x4){lo[0], lo[1], hi[0], hi[1]} * wz; } }
            const float* g2 = mod_vec(F.ws, layer, mr, 5);
#pragma unroll
            for (int j = 0; j < 4; ++j) x[t].v[j] = x[t].v[j] * ALPHA + ((const GAS f32x4*)g2)[vq(j, F.lane)] * y[t].v[j];
            row_normalize(x[t], LN_EPS);
#pragma unroll
            for (int j = 0; j < 4; ++j) x[t].v[j] = x[t].v[j] * ((const GAS f32x4*)lg)[vq(j, F.lane)] + ((const GAS f32x4*)lb)[vq(j, F.lane)];
            if (layer == 3) { row_store_f32(x[t], a.out + (size_t)row * D, F.lane); }
            else { row_store_bf16(x[t], XS + (size_t)row * D, F.lane);
                row_modulate(x[t], mod_vec(F.ws, layer + 1, mr, 0), mod_vec(F.ws, layer + 1, mr, 1), F.lane);
                row_store_fp8(x[t], (unsigned char*)a.out + OUT_U8 + (size_t)row * D, F.lane); } }
    }
}
__device__ __forceinline__ float wave_max_dpp(float v) {
    int x = __builtin_bit_cast(int, v);
#define DPPMAX(ctrl) { const int y = __builtin_amdgcn_update_dpp(x, x, ctrl, 0xf, 0xf, false); x = __builtin_bit_cast(int, fmaxf(__builtin_bit_cast(float, x), __builtin_bit_cast(float, y))); }
    DPPMAX(0xB1) DPPMAX(0x4E) DPPMAX(0x141) DPPMAX(0x140)
#undef DPPMAX
    const float r0 = __builtin_bit_cast(float, __builtin_amdgcn_readlane(x, 0)), r1 = __builtin_bit_cast(float, __builtin_amdgcn_readlane(x, 16));
    const float r2 = __builtin_bit_cast(float, __builtin_amdgcn_readlane(x, 32)), r3 = __builtin_bit_cast(float, __builtin_amdgcn_readlane(x, 48));
    return fmaxf(fmaxf(r0, r1), fmaxf(r2, r3));
}
__device__ __forceinline__ void route_tokens(Frame& F, const Args& a, int layer, int ntok) {
    F.refresh();
    const int TPB = ntok / GRID;
    const bf16_t* U = (const bf16_t*)a.out; const bf16_t* Wr = (const bf16_t*)(F.ws + WS_WR) + (size_t)layer * 64 * 1024;
    int* tke = (int*)(F.ws + WS_TKE); float* tkw = (float*)(F.ws + WS_TKW);
    LAS int* lcnt = (LAS int*)(F.lds + L_LCNT);
    LAS float* lg = (LAS float*)(F.lds);
    if (F.tid < 64) lcnt[F.tid] = 0;
    const int lane = F.lane, fr = lane & 15, fq = lane >> 4;
    const int ntile = TPB / 16;
    for (int tl = F.wave; tl < ntile; tl += NWAVES) {
        const int t0 = F.blk * TPB + tl * 16;
        f32x4 acc[4];
#pragma unroll
        for (int n = 0; n < 4; ++n) acc[n] = (f32x4){0.f, 0.f, 0.f, 0.f};
        const GAS bf16x8* ap = (const GAS bf16x8*)(U + (size_t)(t0 + fr) * D + fq * 8);
        const GAS bf16x8* bp = (const GAS bf16x8*)(Wr + (size_t)fr * D + fq * 8);
#pragma unroll 8
        for (int ks = 0; ks < 32; ++ks) { const bf16x8 av = ap[ks * 4];
#pragma unroll
            for (int n = 0; n < 4; ++n) { const bf16x8 bv = bp[(size_t)n * 16 * (D / 8) + ks * 4]; acc[n] = __builtin_amdgcn_mfma_f32_16x16x32_bf16(av, bv, acc[n], 0, 0, 0); } }
#pragma unroll
        for (int n = 0; n < 4; ++n)
#pragma unroll
            for (int j = 0; j < 4; ++j) lg[(tl * 16 + fq * 4 + j) * 65 + n * 16 + fr] = acc[n][j];
    }
    __syncthreads();
    if (F.tid < TPB) {
        const int tok = F.blk * TPB + F.tid; const LAS float* row = lg + F.tid * 65; const float* bias = a.in[13] + layer * 64;
        float sg[64], sel[64];
#pragma unroll
        for (int e = 0; e < 64; ++e) { sg[e] = 1.f / (1.f + __expf(-row[e])); sel[e] = sg[e] + bias[e]; }
        float gs[8];
#pragma unroll
        for (int g = 0; g < 8; ++g) { float m1 = -INFINITY, m2 = -INFINITY;
#pragma unroll
            for (int j = 0; j < 8; ++j) { const float v = sel[g * 8 + j]; const bool gt1 = v > m1; m2 = gt1 ? m1 : fmaxf(m2, v); m1 = gt1 ? v : m1; }
            gs[g] = m1 + m2; }
        unsigned gok = 0;
#pragma unroll
        for (int g = 0; g < 8; ++g) { int rk = 0;
#pragma unroll
            for (int h = 0; h < 8; ++h) rk += (gs[h] > gs[g] || (gs[h] == gs[g] && h < g)) ? 1 : 0;
            gok |= (rk < 4 ? 1u : 0u) << g; }
#pragma unroll
        for (int e = 0; e < 64; ++e) sel[e] = ((gok >> (e >> 3)) & 1u) ? sel[e] : -INFINITY;
        int ce[8]; float cw[8]; float tot = 0.f;
#pragma unroll
        for (int it = 0; it < 8; ++it) { float best = -INFINITY, bs = 0.f; int bi = 0;
#pragma unroll
            for (int e = 0; e < 64; ++e) { const bool b = sel[e] > best; best = b ? sel[e] : best; bs = b ? sg[e] : bs; bi = b ? e : bi; }
#pragma unroll
            for (int e = 0; e < 64; ++e) sel[e] = (e == bi) ? -INFINITY : sel[e];
            ce[it] = bi; cw[it] = bs; tot += bs; }
        const float sc = 2.5f / tot;
#pragma unroll
        for (int it = 0; it < 8; ++it) { tke[(size_t)tok * 8 + it] = ce[it]; tkw[(size_t)tok * 8 + it] = cw[it] * sc; __hip_atomic_fetch_add(&lcnt[ce[it]], 1, __ATOMIC_RELAXED, __HIP_MEMORY_SCOPE_WORKGROUP); }
    }
    __syncthreads();
    if (F.tid < 64) F.ctl[CW_BCNT + F.blk * 64 + F.tid] = (unsigned)lcnt[F.tid];
}
__device__ __forceinline__ void build_lists(Frame& F, int ntok) {
    F.refresh();
    constexpr int NSEG = NCHUNK * 64, BPC = GRID / NCHUNK;
    const int TPB = ntok / GRID, CH = ntok / NCHUNK;
    LAS int* tstart = (LAS int*)(F.lds + L_TSTART); LAS int* pref = (LAS int*)(F.lds + L_PREF); LAS int* lcnt = (LAS int*)(F.lds + L_LCNT);
    LAS unsigned char* tseg = (LAS unsigned char*)(F.lds + L_TSEG); LAS int* scan = (LAS int*)(F.lds + L_SCAN);
    const unsigned* bcnt = F.ctl + CW_BCNT;
    const int myc = F.blk / BPC, mylb = F.blk % BPC;
    int nseg = 0;
    LAS int* cntl = (LAS int*)F.lds;
    for (int i = F.tid; i < GRID * 64; i += NTHR) cntl[i] = (int)((const GAS unsigned*)bcnt)[i];
    if (F.tid < 64) lcnt[F.tid] = 0;
    __syncthreads();
    if (F.tid < NSEG) { const int c = F.tid >> 6, e = F.tid & 63; int n = 0, p = 0;
        for (int lb = 0; lb < BPC; ++lb) { const int v = cntl[(c * BPC + lb) * 64 + e]; if (c == myc && lb < mylb) p += v; n += v; }
        nseg = n; scan[F.tid] = (n + 255) >> 8; if (c == myc) pref[e] = p; }
    __syncthreads();
    if (F.tid == 0) { int acc = 0; for (int s = 0; s < NSEG; ++s) { tstart[s] = acc; acc += scan[s]; } tstart[NSEG] = acc; }
    __syncthreads();
    if (F.tid < NSEG) { const int t0 = tstart[F.tid], t1 = tstart[F.tid + 1]; for (int t = t0; t < t1; ++t) tseg[t] = (unsigned char)F.tid; }
    int* stok = (int*)(F.ws + WS_STOK); int* spos = (int*)(F.ws + WS_SDST);
    const int* tke = (const int*)(F.ws + WS_TKE);
    { const int sseg = myc * 64 + mylb; if (mylb < 64 && F.tid == sseg) scan[0] = nseg; }
    __syncthreads();
    if (mylb < 64) { const int sseg = myc * 64 + mylb; const int n = scan[0]; const int base = tstart[sseg] * 256, end = tstart[sseg + 1] * 256;
      for (int p = base + n + F.tid; p < end; p += NTHR) stok[p] = myc * CH; }
    for (int tl = F.wave; tl < TPB; tl += NWAVES) { const int tok = F.blk * TPB + tl;
        if (F.lane < 8) { const int e = tke[(size_t)tok * 8 + F.lane];
            const int p = tstart[myc * 64 + e] * 256 + pref[e] + __hip_atomic_fetch_add(&lcnt[e], 1, __ATOMIC_RELAXED, __HIP_MEMORY_SCOPE_WORKGROUP);
            stok[p] = tok; spos[(size_t)tok * 8 + F.lane] = p - tstart[myc * 64] * 256; } }
    __syncthreads();
}

struct SchedQKV {
    const char* U; const char* W; int nfull, nu, c;
    __device__ __forceinline__ bool next(int i, pg::Unit& u) const {
        const int L0 = i * GRID + c; if (L0 >= nu) return false;
        int pm, pn;
        if (L0 < nfull) { const int L = pg::xcd_remap(L0, nfull); const int gid = L / 48, w = L % 48; pm = gid * 8 + (w & 7); pn = w >> 3; }
        else { const int q = L0 - nfull; pm = 256 + (q >> 1); pn = 4 + (q & 1); }
        u.A = U + (size_t)pm * 256 * 1024; u.B = W + (size_t)pn * 256 * 1024; u.gidx = nullptr; u.gbase = 0; u.nt = 8; u.out = nullptr; u.ldc = 0; u.scale = 1.f; u.flags = 0; u.i0 = pm; u.i1 = pn;
        return true; }
};
struct SchedDense {
    const char* A; const char* W; char* out; int nrt, nct, nt, c; size_t ldA;
    __device__ __forceinline__ bool next(int i, pg::Unit& u) const {
        const int nu = nrt * nct; const int L0 = i * GRID + c; if (L0 >= nu) return false;
        const int L = pg::xcd_remap(L0, nu); const int per = 8 * nct, gid = L / per, w = L % per, fm = gid * 8, gsz = (nrt - fm) < 8 ? (nrt - fm) : 8; const int pm = fm + (w % gsz), pn = w / gsz;
        u.A = A + (size_t)pm * 256 * ldA; u.B = W + (size_t)pn * 256 * ldA; u.gidx = nullptr; u.gbase = 0; u.nt = nt; u.out = out + (size_t)pm * 256 * 2048 + pn * 512; u.ldc = 2048; u.scale = 1.f; u.flags = 0; u.i0 = pm; u.i1 = pn;
        return true; }
};
struct SchedF1 {
    const char* CS; const char* U; char* ABT; char* ABTC; int nu, c;
    __device__ __forceinline__ bool next(int i, pg::Unit& u) const {
        const int L0 = i * GRID + c; if (L0 >= nu) return false;
        u.gidx = nullptr; u.gbase = 0; u.nt = 2; u.scale = 1.f; u.flags = 0; u.i0 = 0; u.i1 = 0;
        if (L0 < 2048) { const int L = pg::xcd_remap(L0, 2048); const int pm = L & 1, pn = (L >> 1) & 7, bg = L >> 4, b = bg >> 2, g = bg & 3;
            u.A = CS + (size_t)pm * 256 * 256; u.B = U + ((size_t)b * SEQ + pn * 256) * 1024 + g * 256; u.out = ABT + (size_t)bg * 256 * 4096 + (size_t)(pm * 2048 + pn * 256); u.ldc = 4096; }
        else { const int q = L0 - 2048; const int pm = q & 1, bg = q >> 1, b = bg >> 2, g = bg & 3;
            u.A = CS + (size_t)pm * 256 * 256; u.B = U + ((size_t)T + b * CTXL) * 1024 + g * 256; u.out = ABTC + (size_t)bg * 256 * 512 + (size_t)pm * 256; u.ldc = 512; }
        return true; }
};
struct SchedF2 {
    const char* DL; const char* ABT; char* FH; int c;
    __device__ __forceinline__ bool next(int i, pg::Unit& u) const {
        const int L0 = i * GRID + c; if (L0 >= 512) return false;
        const int L = pg::xcd_remap(L0, 512); const int pm = L & 3, bg = L >> 2, b = bg >> 2, g = bg & 3;
        u.A = DL + (size_t)pm * 256 * 4096; u.B = ABT + (size_t)bg * 256 * 4096; u.gidx = nullptr; u.gbase = 0; u.nt = 32; u.out = FH + ((size_t)b * 1024 + pm * 256) * 1024 + g * 256; u.ldc = 1024; u.scale = 0.001381067932004975f  ; u.flags = 0; u.i0 = 0; u.i1 = 0;
        return true; }
};
struct SchedF2c {
    const char* DLC; const char* ABTC; char* FC; int c;
    __device__ __forceinline__ bool next(int i, pg::Unit& u) const {
        const int L0 = i * GRID + c; if (L0 >= 128) return false;
        const int bg = L0, b = bg >> 2, g = bg & 3;
        u.A = DLC; u.B = ABTC + (size_t)bg * 256 * 512; u.gidx = nullptr; u.gbase = 0; u.nt = 4; u.out = FC + ((size_t)b * 256) * 1024 + g * 256; u.ldc = 1024; u.scale = 1.f / 256.f; u.flags = 0; u.i0 = 0; u.i1 = 0;
        return true; }
};
struct SchedF3 {
    const char* FH; const char* FC; const char* W; char* Y; int nu, c;
    __device__ __forceinline__ bool next(int i, pg::Unit& u) const {
        const int L0 = i * GRID + c; if (L0 >= nu) return false;
        u.gidx = nullptr; u.gbase = 0; u.nt = 8; u.scale = 1.f; u.flags = 0; u.i0 = 0; u.i1 = 0;
        if (L0 < 1024) { const int L = pg::xcd_remap(L0, 1024); const int gid = L >> 6, w = L & 63, pm = gid * 8 + (w & 7), pn = w >> 3; const int b = pm >> 2, k0 = (pm & 3) * 256;
            u.A = FH + (size_t)pm * 256 * 1024; u.B = W + (size_t)pn * 256 * 1024;
            if (pn < 4) { u.out = Y + ((size_t)b * SEQ + k0) * 2048 + pn * 512; u.ldc = 2048; }
            else { u.out = Y + ((size_t)b * SEQ + SEQ - k0) * 2048 + (pn - 4) * 512; u.ldc = -2048; u.flags = (k0 == 0) ? 1 : 0; } }
        else { const int q = L0 - 1024; const int pm = q >> 2, pn = q & 3;
            u.A = FC + (size_t)pm * 256 * 1024; u.B = W + (size_t)pn * 256 * 1024; u.out = Y + ((size_t)T + pm * 256) * 2048 + pn * 512; u.ldc = 2048; }
        return true; }
};
struct SchedG1 {
    const char* EGU; const int* STOK; char* H; char* HS; LAS const unsigned char* tseg; int ntl, nsh, c;
    __device__ __forceinline__ bool gsrc(int i, const int*& gidx, int& gbase) const {
        const int nu = (ntl + nsh) * 2; const int L0 = i * GRID + c; if (L0 >= nu) return false;
        const int pm = pg::xcd_remap(L0, nu) >> 1;
        if (pm < ntl) { gidx = STOK + (size_t)pm * 256; gbase = 0; } else { gidx = nullptr; gbase = (pm - ntl) * 256; }
        return true; }
    __device__ __forceinline__ bool next(int i, pg::Unit& u) const {
        const int nu = (ntl + nsh) * 2; const int L0 = i * GRID + c; if (L0 >= nu) return false;
        const int L = pg::xcd_remap(L0, nu); const int pm = L >> 1, pn = L & 1;
        u.A = nullptr; u.gbase = 0; u.nt = 8; u.ldc = 256; u.scale = 1.f; u.flags = 0; u.i0 = 0; u.i1 = 0;
        if (pm < ntl) { const int e = __builtin_amdgcn_readfirstlane((int)tseg[pm]) & 63;
            u.gidx = STOK + (size_t)pm * 256; u.B = EGU + (size_t)e * 512 * 1024 + (size_t)pn * 256 * 1024; u.out = H + (size_t)pm * 256 * 256 + pn * 128; }
        else { const int ps = pm - ntl; u.gidx = nullptr; u.gbase = ps * 256; u.B = EGU + (size_t)NE * 512 * 1024 + (size_t)pn * 256 * 1024; u.out = HS + (size_t)ps * 256 * 256 + pn * 128; }
        return true; }
};
struct SchedG2 {
    const char* ED; const char* H; const char* HS; char* YB; char* YS; LAS const unsigned char* tseg; int t0, t1, nsh, ch, CH, c;
    __device__ __forceinline__ bool next(int i, pg::Unit& u) const {
        const int nr = t1 - t0; const int nu = (nr + nsh) * 4; const int L0 = i * GRID + c; if (L0 >= nu) return false;
        const int L = pg::xcd_remap(L0, nu); const int q = L >> 2, pn = L & 3;
        u.gidx = nullptr; u.gbase = 0; u.nt = 2; u.ldc = 1024; u.scale = 1.f; u.flags = 0; u.i0 = 0; u.i1 = pn;
        if (q < nr) { const int pm = t0 + q; const int e = __builtin_amdgcn_readfirstlane((int)tseg[pm]) & 63;
            u.A = H + (size_t)pm * 256 * 256; u.B = ED + (size_t)e * 1024 * 256 + (size_t)pn * 256 * 256; u.out = YB + (size_t)q * 256 * 1024; }
        else { const int ps = q - nr; u.A = HS + ((size_t)ch * CH + ps * 256) * 256; u.B = ED + (size_t)NE * 1024 * 256 + (size_t)pn * 256 * 256; u.out = YS + (size_t)ps * 256 * 1024; }
        return true; }
};

__device__ __forceinline__ void fnet_nyquist_rows(Frame& F) {
    F.refresh();
    const unsigned char* ABT = F.ws + WS_ABT; bf16_t* FH1 = (bf16_t*)(F.ws + WS_FH1);
    for (int r = F.gw; r < 128 * 256; r += NGW) { const int bg = r >> 8, m = r & 255, b = bg >> 2, g = bg & 3;
        const GAS u32x4* p = (const GAS u32x4*)(ABT + (size_t)r * 4096); float s = 0.f;
#pragma unroll
        for (int i = 0; i < 2; ++i) { const u32x4 w = p[i * 64 + F.lane];
#pragma unroll
            for (int q = 0; q < 4; ++q) { const f32x2v lo = __builtin_amdgcn_cvt_pk_f32_fp8((int)w[q], false), hi = __builtin_amdgcn_cvt_pk_f32_fp8((int)w[q], true); s += (lo[0] - lo[1]) + (hi[0] - hi[1]); } }
        s = wave_sum(s) * 0.001381067932004975f;
        if (F.lane == 0) FH1[(size_t)b * 1024 + g * 256 + m] = (bf16_t)f2bf(s); }
}
__device__ __forceinline__ void fnet_nyquist_out(Frame& F, const Args& a, int jl) {
    F.refresh();
    const bf16_t* FH1 = (const bf16_t*)(F.ws + WS_FH1); const bf16_t* W = (const bf16_t*)(F.ws + WS_WF) + (size_t)jl * 2048 * 1024; bf16_t* Y = (bf16_t*)a.out;
    LAS float* part = (LAS float*)F.lds;
    const int b = F.blk >> 3, n = (F.blk & 7) * 128 + (F.tid & 127), kq = F.tid >> 7;
    const GAS u32x4* wp = (const GAS u32x4*)(W + (size_t)n * 1024 + kq * 256); const GAS u32x4* fp = (const GAS u32x4*)(FH1 + (size_t)b * 1024 + kq * 256);
    float s = 0.f;
#pragma unroll 4
    for (int i = 0; i < 32; ++i) { const u32x4 w = wp[i], f = fp[i];
        s += bflo(w.x) * bflo(f.x) + bfhi(w.x) * bfhi(f.x) + bflo(w.y) * bflo(f.y) + bfhi(w.y) * bfhi(f.y) + bflo(w.z) * bflo(f.z) + bfhi(w.z) * bfhi(f.z) + bflo(w.w) * bflo(f.w) + bfhi(w.w) * bfhi(f.w); }
    part[F.tid] = s;
    __syncthreads();
    if (F.tid < 128) { const float t = (part[F.tid] + part[F.tid + 128]) + (part[F.tid + 256] + part[F.tid + 384]); Y[((size_t)b * SEQ + 1024) * D + n] = (bf16_t)f2bf(t); }
    __syncthreads();
}


#ifdef SELFCHECK
constexpr int CW_ERR = 1024;
__device__ __forceinline__ void chk_report(unsigned* ctl, int id, float got, float ref, float tabs, float trel) {
    float e = fabsf(got - ref) / (tabs + trel * fabsf(ref)); if (!(e == e)) e = 1e30f; atomicMax(ctl + CW_ERR + id, __float_as_uint(e)); }
__device__ __forceinline__ float bf2f(bf16_t b) { return __builtin_bit_cast(float, (unsigned)b << 16); }
__constant__ int chk_toks[16] = {0, 1, 63, 64, 65, 127, 2047, 2048, 2049, 4096, 33000, 65535, 65536, 65537, 70000, 73727};
__constant__ int chk_ks[8] = {0, 1, 2, 255, 256, 1023, 1024, 700};
__constant__ int chk_ms[4] = {0, 1, 128, 255};
__constant__ int chk_ytoks[10] = {0, 1, 1023, 1024, 1025, 2047, 2048, 65535, 65536, 73727};
__constant__ int chk_ns[5] = {0, 1, 255, 256, 1023};
__constant__ int chk_cols[20] = {0, 7, 15, 16, 31, 32, 40, 48, 63, 64, 500, 1023, 1024, 1039, 1040, 1072, 1279, 1280, 1300, 1535};
__device__ __forceinline__ void chk_qkv(Frame& F, const Args& a, int layer, int id) {
    F.refresh(); const unsigned char* U = (const unsigned char*)a.out + OUT_U8; const float* W = a.in[8] + (size_t)(layer >> 1) * 1024 * 1536;
    const bf16_t* Qb = (const bf16_t*)(F.ws + WS_Q); const bf16_t* Kb = (const bf16_t*)(F.ws + WS_K); const bf16_t* Vb = (const bf16_t*)(F.ws + WS_V);
    for (int s = F.gw; s < 320; s += NGW) { const int tok = chk_toks[s & 15], col = chk_cols[s >> 4];
        if (layer == 2 && tok >= T && col < 1024) continue;
        const bool rope = (tok < T) && col < 1280; const int hc = col & 63, first = (hc & 31) < 16; const int pcol = rope ? (first ? col + 16 : col - 16) : col;
        float x = 0.f, xp = 0.f;
        for (int k = F.lane; k < 1024; k += 64) { const float u = f82f(U[(size_t)tok * D + k]); x += u * W[(size_t)k * 1536 + col]; xp += u * W[(size_t)k * 1536 + pcol]; }
        x = wave_sum(x); xp = wave_sum(xp);
        float ref = x;
        if (rope) { const int tl = tok & 2047, part = hc >> 5, pos = part ? (tl & 63) : (tl >> 6), fi = hc & 15; const float ang = (float)pos * powf(10000.f, -(float)fi / 16.f);
            ref = x * cosf(ang) + (first ? -xp : xp) * sinf(ang); }
        if (col < 1024) ref *= C2;
        const float got = col < 1024 ? bf2f(Qb[(size_t)tok * 1024 + col]) : (col < 1280 ? bf2f(Kb[(size_t)tok * 256 + col - 1024]) : bf2f(Vb[(size_t)tok * 256 + col - 1280]));
        if (F.lane == 0) chk_report(F.ctl, id, got, ref, 0.20f, 0.10f); }
}
__device__ __forceinline__ void chk_attn(Frame& F, const Args& a, int layer, int id) {
    F.refresh(); const bf16_t* Qb = (const bf16_t*)(F.ws + WS_Q); const bf16_t* Kb = (const bf16_t*)(F.ws + WS_K); const bf16_t* Vb = (const bf16_t*)(F.ws + WS_V); const unsigned char* Ob = F.ws + WS_R + 216 * MiB;
    LAS float* lg = (LAS float*)F.lds + F.wave * 1024;
    for (int s = F.gw; s < 64; s += NGW) { const int tok = chk_toks[s & 15], h = (s >> 4) * 5, kvh = h >> 2;
        if (layer == 2 && tok >= T) continue;
        const bool isctx = tok >= T; const int b = isctx ? (tok - T) / CTXL : tok / SEQ, p = tok & (SEQ - 1);
        int nk = 0; const int lo = isctx ? 0 : (p - 128 < 0 ? 0 : p - 128), hi = isctx ? -1 : (p + 128 > SEQ - 1 ? SEQ - 1 : p + 128);
        const int nlat = isctx ? 0 : hi - lo + 1; nk = nlat + CTXL;
        float mx = a.in[10][(layer >> 1) * 16 + h] * LOG2E; const float sink2 = mx;
        for (int i = F.lane; i < nk; i += 64) { const size_t kr = i < nlat ? (size_t)b * SEQ + lo + i : (size_t)T + b * CTXL + (i - nlat); float d = 0.f;
            for (int e = 0; e < 64; ++e) d += bf2f(Qb[(size_t)tok * 1024 + h * 64 + e]) * bf2f(Kb[kr * 256 + kvh * 64 + e]);
            lg[i] = d; mx = fmaxf(mx, d); }
#pragma unroll
        for (int o = 1; o < 64; o <<= 1) mx = fmaxf(mx, __shfl_xor(mx, o));
        LDS_WAIT();
        float den = 0.f; for (int i = F.lane; i < nk; i += 64) den += exp2f(lg[i] - mx);
        den = wave_sum(den) + exp2f(sink2 - mx);
        float o = 0.f;
        for (int i = 0; i < nk; ++i) { const size_t kr = i < nlat ? (size_t)b * SEQ + lo + i : (size_t)T + b * CTXL + (i - nlat); o += exp2f(lg[i] - mx) * bf2f(Vb[kr * 256 + kvh * 64 + F.lane]); }
        o /= den;
        chk_report(F.ctl, id, f82f(Ob[(size_t)tok * 1024 + h * 64 + F.lane]), o, 0.02f, 0.08f); chk_report(F.ctl, 32 + (s & 15), f82f(Ob[(size_t)tok * 1024 + h * 64 + F.lane]), o, 0.02f, 0.08f);
        LDS_WAIT(); }
    __syncthreads();
}
__device__ __forceinline__ void chk_fnet_f(Frame& F, const Args& a, bool upd, int id) {
    F.refresh(); const unsigned char* U = (const unsigned char*)a.out + OUT_U8; LAS float* red = (LAS float*)F.lds;
    for (int s = F.blk; s < 128 + (upd ? 64 : 0); s += GRID) {
        const bool cx = s >= 128; const int q = cx ? s - 128 : s; const int m = chk_ms[q & 3], g = ((q >> 2) & 1) * 3, b = ((q >> 3) & 1) * 31; int k = chk_ks[(q >> 4) & 7]; const int L = cx ? CTXL : SEQ; if (cx) k &= 255;
        const size_t row0 = cx ? (size_t)T + b * CTXL : (size_t)b * SEQ;
        float acc = 0.f;
        for (int l = F.wave; l < L; l += NWAVES) { float ca = 0.f, sa = 0.f;
            for (int n = F.lane; n < 256; n += 64) { const float u = f82f(U[(row0 + l) * D + g * 256 + n]); const float an = 6.283185307179586f * (float)((m * n) & 255) / 256.f; const float sn = __sinf(an), cs = __cosf(an); ca += u * cs; sa += u * sn; }
            ca = wave_sum(ca); sa = wave_sum(sa); const float an = 6.283185307179586f * (float)((k * l) % L) / (float)L; const float sn = __sinf(an), cs = __cosf(an); acc += cs * ca - sn * sa; }
        if (F.lane == 0) red[F.wave] = acc;
        __syncthreads();
        if (F.tid == 0) { float t = 0.f; for (int w = 0; w < NWAVES; ++w) t += red[w]; t *= cx ? (1.f / 256.f) : 0.001381067932004975f;
            float got;
            if (cx) got = f82f((F.ws + WS_FC)[((size_t)b * 256 + k) * D + g * 256 + m]);
            else if (k == 1024) got = bf2f(((const bf16_t*)(F.ws + WS_FH1))[(size_t)b * 1024 + g * 256 + m]);
            else got = f82f((F.ws + WS_FH)[((size_t)b * 1024 + k) * D + g * 256 + m]);
            chk_report(F.ctl, id, got, t, 0.25f, 0.10f); }
        __syncthreads(); }
}
__device__ __forceinline__ void chk_fnet_y(Frame& F, const Args& a, int jl, bool upd, int id) {
    F.refresh(); const bf16_t* Y = (const bf16_t*)a.out; const float* W = a.in[11] + (size_t)jl * 1024 * 1024;
    const unsigned char* FH = F.ws + WS_FH; const bf16_t* FH1 = (const bf16_t*)(F.ws + WS_FH1); const unsigned char* FC = F.ws + WS_FC;
    for (int s = F.gw; s < 50; s += NGW) { const int tok = chk_ytoks[s % 10], n = chk_ns[s / 10]; if (tok >= T && !upd) continue;
        float acc = 0.f;
        for (int j = F.lane; j < 1024; j += 64) { float f;
            if (tok >= T) f = f82f(FC[(size_t)(tok - T) * D + j]);
            else { const int b = tok >> 11, k = tok & 2047; if (k < 1024) f = f82f(FH[((size_t)b * 1024 + k) * D + j]); else if (k == 1024) f = bf2f(FH1[(size_t)b * 1024 + j]);
                else f = f82f(FH[((size_t)b * 1024 + (2048 - k)) * D + (j & ~255) + ((256 - (j & 255)) & 255)]); }
            acc += f * W[(size_t)j * 1024 + n]; }
        acc = wave_sum(acc);
        if (F.lane == 0) chk_report(F.ctl, id, bf2f(Y[(size_t)tok * D + n]), acc, 0.04f, 0.08f); }
}
__device__ __forceinline__ void chk_route(Frame& F, const Args& a, int layer, int ntok, int id) {
    F.refresh(); const bf16_t* U = (const bf16_t*)a.out; const float* Wr = a.in[12] + (size_t)layer * 1024 * 64; const int* tke = (const int*)(F.ws + WS_TKE); const float* tkw = (const float*)(F.ws + WS_TKW);
    for (int s = F.gw; s < 16; s += NGW) { const int tok = chk_toks[s]; if (tok >= ntok) continue; const int lane = F.lane;
        float lgt = 0.f; for (int k = 0; k < 1024; ++k) lgt += bf2f(U[(size_t)tok * D + k]) * Wr[(size_t)k * 64 + lane];
        const float sc = 1.f / (1.f + expf(-lgt)), sel = sc + a.in[13][layer * 64 + lane];
        float g1 = -INFINITY, g2 = -INFINITY;
#pragma unroll 1
        for (int j = 0; j < 8; ++j) { const float v = __shfl(sel, (lane & ~7) + j); if (v > g1) { g2 = g1; g1 = v; } else if (v > g2) g2 = v; }
        const float gs = g1 + g2; int gr = 0;
#pragma unroll 1
        for (int gp = 0; gp < 8; ++gp) { const float v = __shfl(gs, gp * 8); gr += (v > gs || (v == gs && gp < (lane >> 3))) ? 1 : 0; }
        const float sm = gr < 4 ? sel : -INFINITY; int rk = 0;
#pragma unroll 1
        for (int ep = 0; ep < 64; ++ep) { const float v = __shfl(sm, ep); rk += (v > sm || (v == sm && ep < lane)) ? 1 : 0; }
        const float tot = wave_sum(rk < 8 ? sc : 0.f); const float wref = sc / tot * 2.5f;
        int slot = -1; for (int j = 0; j < 8; ++j) if (tke[(size_t)tok * 8 + j] == lane) slot = j;
        float err = 0.f;
        if (slot >= 0) { if (rk >= 10) err = 10.f; else if (rk < 8) err = fabsf(tkw[(size_t)tok * 8 + slot] - wref) / (0.04f * wref); }
        else if (rk < 6) err = 10.f;
        const unsigned long long nsel = __ballot(slot >= 0); if (__builtin_popcountll(nsel) != 8) err = 20.f;
        atomicMax(F.ctl + CW_ERR + id, __float_as_uint(err)); }
}
__device__ __forceinline__ void chk_moe(Frame& F, const Args& a, int layer, int ntok, int ch, int id) {
    F.refresh(); const bf16_t* U = (const bf16_t*)a.out; const int* tke = (const int*)(F.ws + WS_TKE); const float* tkw = (const float*)(F.ws + WS_TKW);
    const int CH = ntok / NCHUNK; LAS float* hs = (LAS float*)F.lds; LAS float* us = hs + 512; LAS float* pg_ = us + 1024;
    for (int s = F.blk; s < 16; s += GRID) { const int tok = chk_toks[s]; if (tok >= ntok || tok / CH != ch) continue;
        for (int k = F.tid; k < 1024; k += NTHR) us[k] = bf2f(U[(size_t)tok * D + k]);
        __syncthreads();
        float y0 = 0.f, y1 = 0.f;
        for (int j = 0; j < 9; ++j) { const int e = j < 8 ? tke[(size_t)tok * 8 + j] : 0; const float w = j < 8 ? tkw[(size_t)tok * 8 + j] : 1.f;
            const float* wg = j < 8 ? a.in[14] + ((size_t)layer * NE + e) * 262144 : a.in[17] + (size_t)layer * 262144;
            const float* wu = j < 8 ? a.in[15] + ((size_t)layer * NE + e) * 262144 : a.in[18] + (size_t)layer * 262144;
            const float* wd = j < 8 ? a.in[16] + ((size_t)layer * NE + e) * 262144 : a.in[19] + (size_t)layer * 262144;
            const int hh = F.tid & 255, half = F.tid >> 8; float g = 0.f, u = 0.f;
            for (int k = half * 512; k < half * 512 + 512; ++k) { g += us[k] * wg[(size_t)k * 256 + hh]; u += us[k] * wu[(size_t)k * 256 + hh]; }
            pg_[F.tid] = g; pg_[512 + F.tid] = u;
            __syncthreads();
            if (F.tid < 256) { const float gg = pg_[F.tid] + pg_[F.tid + 256], uu = pg_[512 + F.tid] + pg_[512 + F.tid + 256]; hs[F.tid] = gg / (1.f + expf(-gg)) * uu; }
            __syncthreads();
            float t0 = 0.f, t1 = 0.f; for (int q = 0; q < 256; ++q) { t0 += hs[q] * wd[(size_t)q * 1024 + F.tid]; t1 += hs[q] * wd[(size_t)q * 1024 + 512 + F.tid]; }
            y0 += w * t0; y1 += w * t1;
            __syncthreads(); }
        float g0 = 0.f, g1 = 0.f; const int i = tok - ch * CH;
        { const unsigned char* YSb = (const unsigned char*)(F.ws + WS_YS); const unsigned char* YBb = (const unsigned char*)(F.ws + WS_YB); const int* spos = (const int*)(F.ws + WS_SDST);
          const int t_ = F.tid, bo = 16 * (16 * (t_ >> 8) + ((t_ & 127) >> 3)) + 8 * ((t_ >> 7) & 1) + (t_ & 7);
          auto f8 = [](unsigned char b) { return __builtin_amdgcn_cvt_pk_f32_fp8((int)b, false)[0] * (1.f / 16.f); };
          g0 = f8(YSb[(size_t)i * D + bo]); g1 = f8(YSb[(size_t)i * D + bo + 512]);
          for (int j = 0; j < 8; ++j) { const size_t ps = (size_t)spos[(size_t)tok * 8 + j]; const float w = tkw[(size_t)tok * 8 + j]; g0 += w * f8(YBb[ps * D + bo]); g1 += w * f8(YBb[ps * D + bo + 512]); } }
        chk_report(F.ctl, id, g0, y0, 0.15f, 0.15f); chk_report(F.ctl, id, g1, y1, 0.15f, 0.15f);
        __syncthreads(); }
}
#endif

#ifndef PH_MASK
#define PH_MASK 0xffffffffu
#endif
#define PH(b) ((PH_MASK >> (b)) & 1u)
__global__ void __launch_bounds__(NTHR, 2) fwd(Args a) {
    extern __shared__ __attribute__((aligned(16))) unsigned char lds_raw[];
    Frame F;
    F.lds = (LAS unsigned char*)lds_raw; F.ws = a.ws; F.ctl = (unsigned*)(a.ws + WS_CTL);
    F.blk = blockIdx.x; F.refresh();
    for (int u = F.tid; u < (LDS_BYTES - RING_BYTES) / 4; u += NTHR) ((LAS unsigned*)(F.lds + RING_BYTES))[u] = 0u;
    __syncthreads();
    const XcdBarrier bar = xcd_barrier_post(F.ctl + CW_BAR, (volatile LAS unsigned*)(F.lds + L_MISC) + 8);
#define GRID_BAR() xcd_barrier(bar)
    LAS unsigned char* ring = F.lds;
    const int c = F.blk;
#define ws (F.ws)
#define NEWPH() F.refresh()

    if (PH(0)) { conv_small(F, a);
    __syncthreads();
    mod_full(F, a); }
    GRID_BAR();
    if (PH(1)) { rows_init(F, a); }
    GRID_BAR();

    for (int layer = 0; layer < 4; ++layer) {
        const int jl = layer >> 1; const bool upd = layer < 2; const int nrows = upd ? TT : T;
        if ((layer & 1) == 0) {
            NEWPH();
            if (PH(2)) { SchedQKV S; S.U = (const char*)a.out + OUT_U8; S.W = (const char*)(ws + WS_WQKV) + (size_t)jl * 1536 * 1024; S.nfull = (layer == 0) ? 288 * 6 : 256 * 6; S.nu = (layer == 0) ? 288 * 6 : 256 * 6 + 64; S.c = c;
              pg::EpiQKV E; E.Q = (bf16_t*)(ws + WS_Q); E.K = (bf16_t*)(ws + WS_K); E.V = (bf16_t*)(ws + WS_V); E.ropec = (const float*)(ws + WS_ROPEC); E.ropes = (const float*)(ws + WS_ROPES);
              pg::gemm_phase<pg::EpiQKV, SchedQKV, false, true>(ring, 1024u, 1024u, nullptr, S, E); }
            GRID_BAR();
#ifdef SELFCHECK
            if (SELFCHECK & 1) chk_qkv(F, a, layer, 1 + (layer >> 1));
#endif
#define OBUF ((bf16_t*)(ws + WS_R + 216 * MiB))
            NEWPH();
            if (PH(3)) { const int NU = 4096 + (layer == 0 ? 512 : 0);
              const bf16_t* Qb = (const bf16_t*)(ws + WS_Q); const bf16_t* Kb = (const bf16_t*)(ws + WS_K); const bf16_t* Vb = (const bf16_t*)(ws + WS_V);
              for (int i = 0; i * GRID + c < NU; ++i) { int id = pg::xcd_remap(i * GRID + c, NU);
                  if (NU > 4096) { const int g9 = id / 9, r9 = id - g9 * 9; id = (r9 < 8) ? g9 * 8 + r9 : 4096 + g9; }
                  if (id < 4096) { const int hq = id & 3, qb = (id >> 2) & 7, kvh = (id >> 5) & 3, b = id >> 7, h = kvh * 4 + hq;
                      attn::attn_unit(Qb, Kb, Vb, OBUF, b, h, qb * 256, false, a.in[10][jl * 16 + h] * LOG2E, ring); }
                  else { const int cid = id - 4096, hq = cid & 3, kvh = (cid >> 2) & 3, b = cid >> 4, h = kvh * 4 + hq;
                      attn::attn_unit(Qb, Kb, Vb, OBUF, b, h, 0, true, a.in[10][jl * 16 + h] * LOG2E, ring); } } }
            GRID_BAR();
#ifdef SELFCHECK
            if (SELFCHECK & 1) chk_attn(F, a, layer, 3 + (layer >> 1));
#endif
            NEWPH();
            if (PH(4)) { SchedDense S; S.A = (const char*)OBUF; S.W = (const char*)(ws + WS_WO) + (size_t)jl * 1024 * 1024; S.out = (char*)a.out; S.nrt = nrows / 256; S.nct = 4; S.nt = 8; S.c = c; S.ldA = 1024;
              pg::EpiStore E; pg::gemm_phase<pg::EpiStore, SchedDense, false, true>(ring, 1024u, 1024u, nullptr, S, E); }
            GRID_BAR();
        } else {
            NEWPH();
            if (PH(5)) { SchedF1 S; S.CS = (const char*)(ws + WS_CSN); S.U = (const char*)a.out + OUT_U8; S.ABT = (char*)(ws + WS_ABT); S.ABTC = (char*)(ws + WS_ABTC); S.nu = 2048 + (upd ? 256 : 0); S.c = c;
              pg::EpiStore8 E; pg::gemm_phase<pg::EpiStore8, SchedF1, false, true, 127>(ring, 256u, 1024u, nullptr, S, E); }
            GRID_BAR();
            NEWPH();
            if (PH(6)) { SchedF2 S; S.DL = (const char*)(ws + WS_DL); S.ABT = (const char*)(ws + WS_ABT); S.FH = (char*)(ws + WS_FH); S.c = c;
              pg::EpiStore8 E; pg::gemm_phase<pg::EpiStore8, SchedF2, false, true, 127>(ring, 4096u, 4096u, nullptr, S, E); }
            NEWPH();
            if (PH(7) && upd) { SchedF2c S; S.DLC = (const char*)(ws + WS_DLC); S.ABTC = (const char*)(ws + WS_ABTC); S.FC = (char*)(ws + WS_FC); S.c = c;
              pg::EpiStore8 E; pg::gemm_phase<pg::EpiStore8, SchedF2c, false, true, 127>(ring, 512u, 512u, nullptr, S, E); }
            if (PH(8)) fnet_nyquist_rows(F);
            GRID_BAR();
#ifdef SELFCHECK
            if (SELFCHECK & 2) chk_fnet_f(F, a, upd, 5 + (layer >> 1));
            GRID_BAR();
#endif
            NEWPH();
            if (PH(9)) { SchedF3 S; S.FH = (const char*)(ws + WS_FH); S.FC = (const char*)(ws + WS_FC); S.W = (const char*)(ws + WS_WSH) + (size_t)jl * 2048 * 1024; S.Y = (char*)a.out; S.nu = 1024 + (upd ? 128 : 0); S.c = c;
              pg::EpiStore E; pg::gemm_phase<pg::EpiStore, SchedF3, false, true>(ring, 1024u, 1024u, nullptr, S, E); }
            if (PH(10)) fnet_nyquist_out(F, a, jl);
            GRID_BAR();
#ifdef SELFCHECK
            if (SELFCHECK & 8) chk_fnet_y(F, a, jl, upd, 7 + (layer >> 1));
            GRID_BAR();
#endif
        }
        if (PH(12)) conv_experts(F, a, layer);
        __syncthreads();
        if (PH(11)) rows_post1(F, a, layer, nrows);
        VM_WAIT(); __syncthreads();
        if (threadIdx.x == 0) { __builtin_amdgcn_fence(__ATOMIC_ACQUIRE, "agent"); VM_WAIT(); }
        __syncthreads();
        if (PH(13)) route_tokens(F, a, layer, nrows);
        GRID_BAR();
#ifdef SELFCHECK
        if ((SELFCHECK & 64) && layer < 2) chk_route(F, a, layer, nrows, 9);
#endif
        if (PH(14)) build_lists(F, nrows);
        GRID_BAR();
        LAS const int* tstart = (LAS const int*)(F.lds + L_TSTART); LAS const unsigned char* tseg = (LAS const unsigned char*)(F.lds + L_TSEG);
        const int ntl = __builtin_amdgcn_readfirstlane(tstart[NCHUNK * 64]);
        NEWPH();
        if (PH(15)) { SchedG1 S; S.EGU = (const char*)(ws + WS_EGU); S.STOK = (const int*)(ws + WS_STOK); S.H = (char*)(ws + WS_H); S.HS = (char*)(ws + WS_HS); S.tseg = tseg; S.ntl = ntl; S.nsh = nrows / 256; S.c = c;
          pg::EpiSilu E; pg::gemm_phase<pg::EpiSilu, SchedG1, true, true>(ring, 1024u, 1024u, (const char*)a.out + OUT_U8, S, E); }
        GRID_BAR();
        const int CH = nrows / NCHUNK;
        for (int ch = 0; ch < NCHUNK; ++ch) {
            NEWPH();
            if (PH(16)) { SchedG2 S; S.ED = (const char*)(ws + WS_ED); S.H = (const char*)(ws + WS_H); S.HS = (const char*)(ws + WS_HS); S.YB = (char*)(ws + WS_YB); S.YS = (char*)(ws + WS_YS); S.tseg = tseg;
              S.t0 = __builtin_amdgcn_readfirstlane(tstart[ch * 64]); S.t1 = __builtin_amdgcn_readfirstlane(tstart[ch * 64 + 64]); S.nsh = CH / 256; S.ch = ch; S.CH = CH; S.c = c;
              pg::EpiFp8 E; pg::gemm_phase<pg::EpiFp8, SchedG2, false, true>(ring, 256u, 256u, nullptr, S, E); }
            GRID_BAR();
#ifdef SELFCHECK
            if ((SELFCHECK & 4) && layer == 0) { chk_moe(F, a, layer, nrows, ch, 10); GRID_BAR(); }
#endif
            if (PH(17)) rows_post2(F, a, layer, ch * CH, CH);
            if (!(layer == 3 && ch == NCHUNK - 1)) GRID_BAR();
        }
    }
#ifdef SELFCHECK
    GRID_BAR();
    { int bad = 0; float be = 0.f; for (int k = 15; k >= 1; --k) { const float e = __uint_as_float(__hip_atomic_load(F.ctl + CW_ERR + k, RLX_AGENT)); if (e > 1.f) { bad = k; be = e; } }
      int wt = 0; float we = 0.f; for (int k = 0; k < 16; ++k) { const float e = __uint_as_float(__hip_atomic_load(F.ctl + CW_ERR + 32 + k, RLX_AGENT)); if (e > we) { we = e; wt = k; } }
      if (bad) { F.refresh(); float cv = 3.f + bad + (be > 8.f ? 0.5f : 0.f);  Row r; for (int j = 0; j < 4; ++j) r.v[j] = (f32x4){cv, cv, cv, cv}; for (int row = F.gw; row < T; row += NGW) row_store_f32(r, a.out + (size_t)row * D, F.lane); } }
#endif
}

#undef ws
#undef NEWPH
extern "C" void kernel_launch(void* const* d_in, const int* in_sizes, int n_in, void* d_out, int out_size, void* d_ws, size_t ws_size, hipStream_t stream) {
    static int ready = 0;
    if (ready == 0) {
        if (n_in != 20 || out_size != T * D || ws_size < WS_END) { fprintf(stderr, "kernel_launch: unexpected problem (n_in %d out %d ws %zu need %zu)\n", n_in, out_size, ws_size, (size_t)WS_END); ready = -1; return; }
        if (hipFuncSetAttribute((const void*)fwd, hipFuncAttributeMaxDynamicSharedMemorySize, LDS_BYTES) != hipSuccess) { fprintf(stderr, "kernel_launch: hipFuncSetAttribute failed\n"); ready = -1; return; }
        int per_cu = 0;
        if (hipOccupancyMaxActiveBlocksPerMultiprocessor(&per_cu, (const void*)fwd, NTHR, LDS_BYTES) != hipSuccess || per_cu < 1) fprintf(stderr, "kernel_launch: occupancy query says %d blocks per CU\n", per_cu);
        (void)hipGetLastError();
        ready = 1;
    }
    if (ready < 0) return;
    (void)hipMemsetAsync((char*)d_ws + WS_CTL, 0, CTL_BYTES, stream);
    Args a{};
    for (int i = 0; i < 20; ++i) a.in[i] = (const float*)d_in[i];
    a.out = (float*)d_out; a.ws = (unsigned char*)d_ws;
    hipLaunchKernelGGL(fwd, dim3(GRID), dim3(NTHR), LDS_BYTES, stream, a);
}
```

```cpp
#include <hip/hip_runtime.h>
#include <cstdio>
#include <cstdint>

#define LAS __attribute__((address_space(3)))
#define GAS __attribute__((address_space(1)))
typedef unsigned short bf16_t;
typedef short bf16x8 __attribute__((ext_vector_type(8)));
typedef short s16x4 __attribute__((ext_vector_type(4)));
typedef float f32x4 __attribute__((ext_vector_type(4)));
typedef float f32x16 __attribute__((ext_vector_type(16)));
typedef unsigned u32x4 __attribute__((ext_vector_type(4)));
typedef unsigned u32x2 __attribute__((ext_vector_type(2)));
typedef int v8i_t __attribute__((ext_vector_type(8)));
typedef int v4i_t __attribute__((ext_vector_type(4)));

constexpr int D = 1024, NB = 32, SEQ = 2048, T = NB * SEQ, CTXL = 256, TC = NB * CTXL, TT = T + TC;
constexpr int NQKV = 1536, NE = 64;
constexpr float ALPHA = 1.681792830507429f;
constexpr float LN_EPS = 1e-5f, MOD_EPS = 1e-6f;
constexpr float C2 = 0.125f * 1.4426950408889634f;
constexpr float LOG2E = 1.4426950408889634f;
constexpr int NCHUNK = 1;
constexpr int NWAVES = 8, NTHR = 512, GRID = 256;

constexpr size_t MiB = 1u << 20;
constexpr size_t WS_CTL = 0, CTL_BYTES = 1 * MiB;
constexpr size_t WS_ROPEC = 1 * MiB, WS_ROPES = 1 * MiB + 4096, WS_CSN = 1 * MiB + 65536, WS_DLC = 1 * MiB + 524288, WS_DL = 2 * MiB;
constexpr size_t WS_WQKV = 10 * MiB, WS_WO = 16 * MiB, WS_WF = 20 * MiB, WS_WR = 28 * MiB, WS_WSH = 29 * MiB;
constexpr size_t WS_MODP = 36 * MiB, WS_MOD = 49 * MiB;
constexpr float QSC = 64.f;
constexpr float YSC = 16.f;
constexpr size_t WS_RSTAT = 36 * MiB;
constexpr size_t WS_EGU = 54 * MiB, WS_ED = 118 * MiB;
constexpr size_t WS_XS = 150 * MiB;
constexpr size_t WS_STOK = 294 * MiB, WS_SDST = 297 * MiB, WS_SW = 300 * MiB, WS_TKE = 303 * MiB, WS_TKW = 306 * MiB;
constexpr size_t WS_R = 309 * MiB;
constexpr size_t WS_Q = WS_R, WS_K = WS_R + 144 * MiB, WS_V = WS_R + 180 * MiB;
constexpr size_t WS_ABT = WS_R, WS_FH = WS_R + 256 * MiB, WS_FH1 = WS_R + 320 * MiB, WS_ABTC = WS_R + 321 * MiB, WS_FC = WS_R + 353 * MiB;
constexpr size_t WS_H = WS_R, WS_HS = WS_R + 160 * MiB, WS_YB = WS_R + 180 * MiB, WS_YS = WS_R + 788 * MiB;
constexpr size_t WS_END = WS_YS + 72 * MiB;
constexpr size_t OUT_U8 = 144 * MiB;
constexpr int WSCALE_E8M0 = 121;
constexpr int MAXROWS = 655360;

constexpr int CW_TMO = 0, CW_BAR = 4096, CW_BCNT = 16384;

constexpr int RING_BYTES = 131072;
constexpr int L_MISC = RING_BYTES;
constexpr int L_TSTART = RING_BYTES + 256;
constexpr int L_PREF = L_TSTART + 1040;
constexpr int L_LCNT = L_PREF + 256;
constexpr int L_TSEG = L_LCNT + 256;
constexpr int L_SCAN = L_TSEG + 2560;
constexpr int LDS_BYTES = 139264;
static_assert(L_SCAN + 1024 <= LDS_BYTES, "LDS map");

#define RLX_AGENT __ATOMIC_RELAXED, __HIP_MEMORY_SCOPE_AGENT
#define LDS_WAIT() asm volatile("s_waitcnt lgkmcnt(0)" ::: "memory")
#define VM_WAIT() asm volatile("s_waitcnt vmcnt(0)" ::: "memory")

__device__ __forceinline__ unsigned f2bf(float f) { unsigned u = __builtin_bit_cast(unsigned, f); return (u + 0x7fffu + ((u >> 16) & 1u)) >> 16; }
__device__ __forceinline__ unsigned pk2(float lo, float hi) { return f2bf(lo) | (f2bf(hi) << 16); }
typedef float f32x2_t __attribute__((ext_vector_type(2))); typedef __bf16 bf16x2_t __attribute__((ext_vector_type(2)));
__device__ __forceinline__ unsigned cvt_pk_bf16(float lo, float hi) { f32x2_t v = {lo, hi}; bf16x2_t b = __builtin_convertvector(v, bf16x2_t); return __builtin_bit_cast(unsigned, b); }
__device__ __forceinline__ float bflo(unsigned w) { return __builtin_bit_cast(float, w << 16); }
__device__ __forceinline__ float bfhi(unsigned w) { return __builtin_bit_cast(float, w & 0xffff0000u); }
__device__ __forceinline__ float wave_sum(float v) {
#pragma unroll
    for (int o = 1; o < 64; o <<= 1) v += __shfl_xor(v, o);
    return v;
}

__device__ __forceinline__ unsigned f2f8(float v) { return (unsigned)__builtin_amdgcn_cvt_pk_fp8_f32(v, 0.f, 0, false) & 0xffu; }
__device__ __forceinline__ float f82f(unsigned b) { return __builtin_amdgcn_cvt_pk_f32_fp8((int)(b & 0xffu), false)[0]; }
__device__ __forceinline__ int opaque_tid() { int t = threadIdx.x; asm volatile("" : "+v"(t)); return t; }

#define XB_TMO      128
#define XB_XCNT(j)  (256  + 64 * (j))
#define XB_XSUB(j)  (1280 + 64 * (j))
#define XB_XGEN(j)  (2304 + 64 * (j))
#define XB_TOP      3328
#define XB_TOPGEN   3392
#define XCD_BAR_WORDS 3456
#define XB_SPIN_CAP (1u << 22)
__device__ __forceinline__ unsigned xb_ld(unsigned* p)              { return __hip_atomic_load(p, __ATOMIC_RELAXED, __HIP_MEMORY_SCOPE_AGENT); }
__device__ __forceinline__ unsigned xb_add(unsigned* p, unsigned v) { return __hip_atomic_fetch_add(p, v, __ATOMIC_RELAXED, __HIP_MEMORY_SCOPE_AGENT); }
__device__ __forceinline__ unsigned xb_xcc_id() { return (unsigned)__builtin_amdgcn_s_getreg((3 << 11) | 20) & 0xFu; }
#define XB_SPIN(cond, bar) do { unsigned _sp = 0; while (cond) { __builtin_amdgcn_s_sleep(1); \
    if ((++_sp & 255u) == 0u) { if (xb_ld(&(bar)[XB_TMO])) break; if (_sp > XB_SPIN_CAP) { atomicAdd(&(bar)[XB_TMO], 1u); break; } } } } while (0)
struct XcdBarrier { unsigned* bar; unsigned x; volatile LAS unsigned* st; };
__device__ __forceinline__ XcdBarrier xcd_barrier_post(unsigned* bar, volatile LAS unsigned* st) {
    XcdBarrier b; b.bar = bar; b.x = xb_xcc_id(); b.st = st;
    if (threadIdx.x == 0) (void)xb_add(&bar[XB_XCNT(b.x)], 1u);
    return b;
}
__device__ __forceinline__ void xcd_barrier_complete(unsigned* bar, unsigned x, unsigned& nloc, unsigned& nx) {
    const unsigned G = gridDim.x * gridDim.y * gridDim.z;
    unsigned sum, cnt, mine, sp = 0u;
    for (;;) {
        sum = 0u; cnt = 0u; mine = 0u;
#pragma unroll
        for (unsigned j = 0; j < 16; ++j) { const unsigned c = xb_ld(&bar[XB_XCNT(j)]); sum += c; cnt += (c > 0u) ? 1u : 0u; mine = (j == x) ? c : mine; }
        if (sum == G) break;
        __builtin_amdgcn_s_sleep(1);
        if ((++sp & 255u) == 0u) { if (xb_ld(&bar[XB_TMO])) break; if (sp > XB_SPIN_CAP) { atomicAdd(&bar[XB_TMO], 1u); break; } }
    }
    nloc = mine > 0u ? mine : 1u; nx = cnt > 0u ? cnt : 1u;
}
__device__ __forceinline__ void xcd_barrier(const XcdBarrier& b) {
    asm volatile("s_waitcnt vmcnt(0)" ::: "memory");
    __syncthreads();
    if (threadIdx.x == 0) {
        unsigned* bar = b.bar; unsigned bx = b.x; asm volatile("" : "+s"(bx));
        __builtin_amdgcn_s_waitcnt(0);
        unsigned nloc = b.st[0], nx = b.st[1];
        if (nloc == 0u) { xcd_barrier_complete(bar, bx, nloc, nx); b.st[0] = nloc; b.st[1] = nx; }
        const unsigned old = xb_add(&bar[XB_XSUB(bx)], 1u);
        const unsigned gen = old / nloc;
        if (old + 1u == (gen + 1u) * nloc) {
            __builtin_amdgcn_fence(__ATOMIC_RELEASE, "agent");
            asm volatile("s_waitcnt vmcnt(0)" ::: "memory");
            const unsigned og = xb_add(&bar[XB_TOP], 1u);
            const unsigned tg = og / nx;
            if (og + 1u == (tg + 1u) * nx) xb_add(&bar[XB_TOPGEN], 1u);
            else XB_SPIN(xb_ld(&bar[XB_TOPGEN]) == tg, bar);
            __builtin_amdgcn_fence(__ATOMIC_ACQUIRE, "agent");
            xb_add(&bar[XB_XGEN(bx)], 1u);
            asm volatile("s_waitcnt vmcnt(0)" ::: "memory");
        } else {
            XB_SPIN(xb_ld(&bar[XB_XGEN(bx)]) == gen, bar);
            __builtin_amdgcn_fence(__ATOMIC_ACQUIRE, "agent");
            asm volatile("s_waitcnt vmcnt(0)" ::: "memory");
        }
    }
    __syncthreads();
}

typedef float f32x2v __attribute__((ext_vector_type(2)));
namespace pg {
constexpr int BM = 256, BK = 64, HALF = 128, HTB = HALF * BK * 2;
__host__ __device__ __forceinline__ int lds_byte(int r, int c) { const int st = (r >> 4) * 2 + (c >> 5), rr = r & 15, cc = c & 31, ob = rr * 64 + cc * 2; return st * 1024 + (ob ^ (((ob >> 9) & 1) << 5)); }
__host__ __device__ __forceinline__ void stage_rc(int b, int& R, int& C) { const int st = b / 1024, sb = b % 1024, swz = sb ^ (((sb >> 9) & 1) << 5); R = (st >> 1) * 16 + swz / 64; C = (st & 1) * 32 + (swz % 64) / 2; }
__host__ __device__ __forceinline__ int perm32(int rho) { const int n = rho >> 4, i = rho & 15; return 8 * (i >> 2) + 4 * n + (i & 3); }

struct Unit {
    const char* A;
    const char* B;
    const int* gidx;
    int gbase;
    int nt;
    char* out; int ldc; float scale; int flags; int i0; int i1;
};

template <class Epi, class Sched, bool GATHER, bool F8 = false, int WSC = WSCALE_E8M0>
__device__ __forceinline__ void gemm_phase(LAS unsigned char* lds, const unsigned lda, const unsigned ldb, const char* gtable, const Sched& S, const Epi& E) {
    const int tid = opaque_tid(), wid = __builtin_amdgcn_readfirstlane(tid >> 6), lane = tid & 63, wr = wid >> 2, wc = wid & 3, fr = lane & 15, fq = lane >> 4;
    unsigned voffA[2], voffB[2];
#pragma unroll
    for (int i = 0; i < 2; ++i) { int R, C; stage_rc(tid * 16 + i * 8192, R, C); const int Rb = (R & ~31) + perm32(R & 31);
        voffA[i] = (unsigned)R * lda + (unsigned)C * 2u; voffB[i] = (unsigned)Rb * ldb + (unsigned)C * 2u; }
    const size_t kstep = (size_t)(BK * 2);
    const size_t hstepA = (size_t)HALF * lda, hstepB = (size_t)HALF * ldb;
    const unsigned ldsw = (unsigned)wid * 1024u;
    const int aoff = lds_byte(wr * 64 + fr, fq * 8), boff = lds_byte(wc * 32 + fr, fq * 8);
#define PG_SA(b, h) (((b) * 2 + (h)) * HTB)
#define PG_SB(b, h) ((4 + (b) * 2 + (h)) * HTB)
#define PG_ST2(bufoff, p0, p1) do { \
        __builtin_amdgcn_global_load_lds((const unsigned*)(p0), (LAS unsigned*)(lds + (bufoff) + ldsw), 16, 0, 0); \
        __builtin_amdgcn_global_load_lds((const unsigned*)(p1), (LAS unsigned*)(lds + (bufoff) + ldsw + 8192), 16, 0, 0); } while (0)
#define PG_STB(bufoff, bp) PG_ST2(bufoff, (bp) + voffB[0], (bp) + voffB[1])
#define PG_STA(bufoff, ap, h, nx) do { if constexpr (GATHER) { PG_ST2(bufoff, (ap) + ((nx) ? nO[h][0] : cO[h][0]), (ap) + ((nx) ? nO[h][1] : cO[h][1])); } \
        else { PG_ST2(bufoff, (ap) + (h) * hstepA + voffA[0], (ap) + (h) * hstepA + voffA[1]); } } while (0)
#define PG_LD8(p) ({ const v4i_t lo_ = *(const LAS v4i_t*)(p), hi_ = *(const LAS v4i_t*)((p) + 1024); __builtin_shufflevector(lo_, hi_, 0, 1, 2, 3, 4, 5, 6, 7); })
#define PG_LDA(dst, b, h) do { if constexpr (F8) { _Pragma("unroll") for (int m = 0; m < 4; ++m) dst##8[m] = PG_LD8(lds + PG_SA(b, h) + aoff + m * 2048); } \
        else { _Pragma("unroll") for (int m = 0; m < 4; ++m) _Pragma("unroll") for (int k = 0; k < 2; ++k) dst[m][k] = *(const LAS bf16x8*)(lds + PG_SA(b, h) + aoff + m * 2048 + k * 1024); } } while (0)
#define PG_LDB(dst, b, h) do { if constexpr (F8) { _Pragma("unroll") for (int n = 0; n < 2; ++n) dst##8[n] = PG_LD8(lds + PG_SB(b, h) + boff + n * 2048); } \
        else { _Pragma("unroll") for (int n = 0; n < 2; ++n) _Pragma("unroll") for (int k = 0; k < 2; ++k) dst[n][k] = *(const LAS bf16x8*)(lds + PG_SB(b, h) + boff + n * 2048 + k * 1024); } } while (0)
#define PG_MMA(ai, bj, At, Bt) do { __builtin_amdgcn_s_setprio(1); _Pragma("unroll") for (int m = 0; m < 4; ++m) _Pragma("unroll") for (int n = 0; n < 2; ++n) { \
        if constexpr (F8) { asm volatile("v_mfma_scale_f32_16x16x128_f8f6f4 %0, %1, %2, %0, %3, %4 op_sel_hi:[0,0,0]" : "+v"(acc[ai][bj][m][n]) : "v"(Bt##8[n]), "v"(At##8[m]), "v"(sc_w), "v"(sc_x)); } \
        else { _Pragma("unroll") for (int k = 0; k < 2; ++k) acc[ai][bj][m][n] = __builtin_amdgcn_mfma_f32_16x16x32_bf16(Bt[n][k], At[m][k], acc[ai][bj][m][n], 0, 0, 0); } } \
        __builtin_amdgcn_s_setprio(0); } while (0)
#define PG_WAIT_V(n) asm volatile("s_waitcnt vmcnt(" #n ")" ::: "memory")
#define PG_WAIT_L(n) asm volatile("s_waitcnt lgkmcnt(" #n ")" ::: "memory")
#define PG_BAR __builtin_amdgcn_s_barrier()
#define PG_SCHED __builtin_amdgcn_sched_barrier(0)
#define PG_GOFF(dst, u) do { const int tz_ = opaque_tid(); _Pragma("unroll") for (int i = 0; i < 2; ++i) { int R_, C_; stage_rc(tz_ * 16 + i * 8192, R_, C_); \
        _Pragma("unroll") for (int h = 0; h < 2; ++h) { const int rr = h * HALF + R_; \
        const int ix = (u).gidx ? ((const GAS int*)(u).gidx)[rr] : (u).gbase + rr; dst[h][i] = (unsigned)ix * lda + (unsigned)C_ * 2u; } } } while (0)
#define PG_GIDX(dst, un) do { const int* gi_ = nullptr; int gb_ = 0; const bool ok_ = S.gsrc((un), gi_, gb_); const int tz_ = opaque_tid(); _Pragma("unroll") for (int i = 0; i < 2; ++i) { int R_, C_; stage_rc(tz_ * 16 + i * 8192, R_, C_); \
        _Pragma("unroll") for (int h = 0; h < 2; ++h) { const int rr = h * HALF + R_; dst[h][i] = (ok_ && gi_) ? ((const GAS int*)gi_)[rr] : gb_ + rr; } } } while (0)
#define PG_GCVT(dst, src) do { const int tz_ = opaque_tid(); _Pragma("unroll") for (int i = 0; i < 2; ++i) { int R_, C_; stage_rc(tz_ * 16 + i * 8192, R_, C_); \
        _Pragma("unroll") for (int h = 0; h < 2; ++h) dst[h][i] = (unsigned)src[h][i] * lda + (unsigned)C_ * 2u; } } while (0)
    Unit cur, nxt; int ui = 0;
    if (!S.next(0, cur)) return;
    f32x4 acc[2][2][4][2];
#pragma unroll
    for (int a = 0; a < 2; ++a)
#pragma unroll
        for (int b = 0; b < 2; ++b)
#pragma unroll
            for (int m = 0; m < 4; ++m)
#pragma unroll
                for (int n = 0; n < 2; ++n) acc[a][b][m][n] = (f32x4){0.f, 0.f, 0.f, 0.f};
    bf16x8 At[4][2], B0[2][2], B1[2][2]; v8i_t At8[4], B08[2], B18[2];
    const int sc_w = WSC * 0x01010101, sc_x = 0x7f7f7f7f;
    unsigned cO[2][2] = {{0u, 0u}, {0u, 0u}}, nO[2][2] = {{0u, 0u}, {0u, 0u}};
    if constexpr (GATHER) { PG_GOFF(cO, cur); }
    const char* cA = GATHER ? gtable : cur.A; const char* cB = cur.B;
    PG_STB(PG_SB(0, 0), cB); PG_STB(PG_SB(0, 1), cB + hstepB); PG_STA(PG_SA(0, 0), cA, 0, false); PG_STA(PG_SA(0, 1), cA, 1, false);
    if (wr == 1) PG_BAR;
    PG_WAIT_V(2); PG_BAR;
    PG_STB(PG_SB(1, 0), cB + kstep); PG_STA(PG_SA(1, 0), cA + kstep, 0, false); PG_STB(PG_SB(1, 1), cB + hstepB + kstep);
    PG_WAIT_V(6); PG_BAR;
    for (;;) {
        const bool has_next = S.next(ui + 1, nxt);
        const int nt = cur.nt;
        if constexpr (GATHER) { if (has_next) { PG_GOFF(nO, nxt); } else {
#pragma unroll
            for (int h = 0; h < 2; ++h)
#pragma unroll
                for (int i = 0; i < 2; ++i) nO[h][i] = cO[h][i]; } }
        const char* nA = GATHER ? gtable : (has_next ? nxt.A : cA); const char* nB = has_next ? nxt.B : cB;
#pragma unroll 1
        for (int t = 0; t < nt; t += 2) {
            const bool last = (t == nt - 2);
            const char* a1 = cA + (size_t)(t + 1) * kstep;
            const char* a2 = last ? nA : cA + (size_t)(t + 2) * kstep; const char* b2 = last ? nB : cB + (size_t)(t + 2) * kstep;
            const char* a3 = a2 + kstep; const char* b3 = b2 + kstep;
            const bool after_epi = (Epi::NSTORE > 0) && (t == 0) && (ui > 0);
            PG_LDB(B0, 0, 0); PG_LDB(B1, 0, 1); PG_SCHED; PG_LDA(At, 0, 0); PG_STA(PG_SA(1, 1), a1, 1, false);
            if (after_epi) { if constexpr (Epi::NSTORE == 8) PG_WAIT_V(16); else PG_WAIT_V(24); } else PG_WAIT_V(8);
            PG_WAIT_L(0); PG_BAR; PG_MMA(0, 0, At, B0); PG_MMA(0, 1, At, B1); PG_BAR; PG_SCHED;
            PG_LDA(At, 0, 1); PG_STB(PG_SB(0, 0), b2); PG_STB(PG_SB(0, 1), b2 + hstepB); PG_STA(PG_SA(0, 0), a2, 0, last);
            if (after_epi) { if constexpr (Epi::NSTORE == 8) PG_WAIT_V(16); else PG_WAIT_V(24); } else PG_WAIT_V(8);
            PG_WAIT_L(0); PG_BAR; PG_MMA(1, 0, At, B0); PG_MMA(1, 1, At, B1); PG_BAR; PG_SCHED;
            PG_LDB(B0, 1, 0); PG_LDB(B1, 1, 1); PG_SCHED; PG_LDA(At, 1, 0); PG_STA(PG_SA(0, 1), a2, 1, last);
            PG_WAIT_V(8); PG_WAIT_L(0); PG_BAR; PG_MMA(0, 0, At, B0); PG_MMA(0, 1, At, B1); PG_BAR; PG_SCHED;
            PG_LDA(At, 1, 1); PG_STB(PG_SB(1, 0), b3); PG_STB(PG_SB(1, 1), b3 + hstepB); PG_STA(PG_SA(1, 0), a3, 0, last);
            PG_WAIT_V(8); PG_WAIT_L(0); PG_BAR; PG_MMA(1, 0, At, B0); PG_MMA(1, 1, At, B1); PG_BAR; PG_SCHED;
        }
        if (wr == 0) PG_BAR;
        if constexpr (F8) asm volatile("s_nop 15\n\ts_nop 15" ::: "memory");
        E(acc, cur, wr, wc, fr, fq);
        if (!has_next) break;
#pragma unroll
        for (int a = 0; a < 2; ++a)
#pragma unroll
            for (int b = 0; b < 2; ++b)
#pragma unroll
                for (int m = 0; m < 4; ++m)
#pragma unroll
                    for (int n = 0; n < 2; ++n) acc[a][b][m][n] = (f32x4){0.f, 0.f, 0.f, 0.f};
        cur = nxt; cA = nA; cB = nB; ++ui;
        if constexpr (GATHER) {
#pragma unroll
            for (int h = 0; h < 2; ++h)
#pragma unroll
                for (int i = 0; i < 2; ++i) cO[h][i] = nO[h][i]; }
        if (wr == 1) PG_BAR;
    }
    PG_WAIT_V(0);
    PG_BAR;
#undef PG_SA
#undef PG_SB
#undef PG_ST2
#undef PG_STB
#undef PG_STA
#undef PG_LDA
#undef PG_LD8
#undef PG_LDB
#undef PG_MMA
#undef PG_WAIT_V
#undef PG_WAIT_L
#undef PG_BAR
#undef PG_SCHED
#undef PG_GOFF
#undef PG_GIDX
#undef PG_GCVT
}

struct EpiStore {
    static constexpr int NSTORE = 0;
    __device__ __forceinline__ void operator()(const f32x4 (&acc)[2][2][4][2], const Unit& u, int wr, int wc, int fr, int fq) const {
        asm volatile("" : "+v"(fr), "+v"(fq));
        const float s = u.scale;
#pragma unroll
        for (int ai = 0; ai < 2; ++ai)
#pragma unroll
            for (int m = 0; m < 4; ++m) { const int row = ai * HALF + wr * 64 + m * 16 + fr;
                char* rowp = u.out + (ptrdiff_t)row * u.ldc + (wc * 32 + 8 * fq) * 2;
                if (!((u.flags & 1) && row == 0)) {
#pragma unroll
                for (int bj = 0; bj < 2; ++bj) { const f32x4 v0 = acc[ai][bj][m][0] * s, v1 = acc[ai][bj][m][1] * s;
                    u32x4 w; w.x = cvt_pk_bf16(v0[0], v0[1]); w.y = cvt_pk_bf16(v0[2], v0[3]); w.z = cvt_pk_bf16(v1[0], v1[1]); w.w = cvt_pk_bf16(v1[2], v1[3]);
                    *(u32x4*)(rowp + bj * 256) = w; } } }
    }
};
struct EpiStore8 {
    static constexpr int NSTORE = 16;
    __device__ __forceinline__ void operator()(const f32x4 (&acc)[2][2][4][2], const Unit& u, int wr, int wc, int fr, int fq) const {
        asm volatile("" : "+v"(fr), "+v"(fq));
        const float s = u.scale;
#pragma unroll
        for (int ai = 0; ai < 2; ++ai)
#pragma unroll
            for (int m = 0; m < 4; ++m) { const int row = ai * HALF + wr * 64 + m * 16 + fr;
                char* rowp = u.out + (ptrdiff_t)row * u.ldc + (wc * 32 + 8 * fq);
#pragma unroll
                for (int bj = 0; bj < 2; ++bj) { const f32x4 v0 = acc[ai][bj][m][0] * s, v1 = acc[ai][bj][m][1] * s; int w0 = 0, w1 = 0;
                    w0 = __builtin_amdgcn_cvt_pk_fp8_f32(v0[0], v0[1], w0, false); w0 = __builtin_amdgcn_cvt_pk_fp8_f32(v0[2], v0[3], w0, true);
                    w1 = __builtin_amdgcn_cvt_pk_fp8_f32(v1[0], v1[1], w1, false); w1 = __builtin_amdgcn_cvt_pk_fp8_f32(v1[2], v1[3], w1, true);
                    u32x2 o; o.x = (unsigned)w0; o.y = (unsigned)w1; *(u32x2*)(rowp + bj * 128) = o; } }
    }
};
struct EpiQKV {
    static constexpr int NSTORE = 0;
    bf16_t* Q; bf16_t* K; bf16_t* V; const float* ropec; const float* ropes;
    __device__ __forceinline__ void operator()(const f32x4 (&acc)[2][2][4][2], const Unit& u, int wr, int wc, int fr, int fq) const {
        asm volatile("" : "+v"(fr), "+v"(fq));
        const int pm = u.i0, pn = u.i1; const bool lat = pm < (T / 256); const bool rope = lat && pn < 5;
        const float qs = pn < 4 ? C2 : 1.f;
        const int part = wc & 1;
        const int fi0 = 8 * (fq & 1);
        const float sgn = (fq < 2) ? -1.f : 1.f;
#pragma unroll
        for (int ai = 0; ai < 2; ++ai)
#pragma unroll
            for (int m = 0; m < 4; ++m) { const int row = ai * HALF + wr * 64 + m * 16 + fr; const int tok = pm * 256 + row;
                const int tl = tok & (SEQ - 1); const int pos = part ? (tl & 63) : (tl >> 6);
                f32x4 c0 = {1.f, 1.f, 1.f, 1.f}, c1 = c0, s0 = {0.f, 0.f, 0.f, 0.f}, s1 = s0;
                if (rope) { c0 = *(const f32x4*)(ropec + pos * 16 + fi0); c1 = *(const f32x4*)(ropec + pos * 16 + fi0 + 4); s0 = *(const f32x4*)(ropes + pos * 16 + fi0); s1 = *(const f32x4*)(ropes + pos * 16 + fi0 + 4); }
#pragma unroll
                for (int bj = 0; bj < 2; ++bj) { f32x4 v0 = acc[ai][bj][m][0], v1 = acc[ai][bj][m][1];
                    if (rope) { f32x4 p0, p1;
#pragma unroll
                        for (int j = 0; j < 4; ++j) { p0[j] = __shfl_xor(v0[j], 32); p1[j] = __shfl_xor(v1[j], 32); }
                        v0 = v0 * c0 + (p0 * sgn) * s0; v1 = v1 * c1 + (p1 * sgn) * s1; }
                    v0 = v0 * qs; v1 = v1 * qs;
                    const int col = bj * HALF + wc * 32 + 8 * fq;
                    if (pn < 4) {
#pragma unroll
                        for (int j = 0; j < 4; ++j) { v0[j] = __builtin_amdgcn_fmed3f(v0[j] * QSC, -448.f, 448.f); v1[j] = __builtin_amdgcn_fmed3f(v1[j] * QSC, -448.f, 448.f); }
                        int w0 = 0, w1 = 0;
                        w0 = __builtin_amdgcn_cvt_pk_fp8_f32(v0[0], v0[1], w0, false); w0 = __builtin_amdgcn_cvt_pk_fp8_f32(v0[2], v0[3], w0, true);
                        w1 = __builtin_amdgcn_cvt_pk_fp8_f32(v1[0], v1[1], w1, false); w1 = __builtin_amdgcn_cvt_pk_fp8_f32(v1[2], v1[3], w1, true);
                        u32x2 o; o.x = (unsigned)w0; o.y = (unsigned)w1; *(GAS u32x2*)((unsigned char*)Q + (size_t)tok * 1024 + pn * 256 + col) = o; }
                    else { u32x4 w; w.x = cvt_pk_bf16(v0[0], v0[1]); w.y = cvt_pk_bf16(v0[2], v0[3]); w.z = cvt_pk_bf16(v1[0], v1[1]); w.w = cvt_pk_bf16(v1[2], v1[3]);
                        bf16_t* dst = pn == 4 ? K + (size_t)tok * 256 + col : V + (size_t)tok * 256 + col;
                        *(GAS u32x4*)dst = w; } } }
    }
};
struct EpiSilu {
    static constexpr int NSTORE = 8;
    __device__ __forceinline__ void operator()(const f32x4 (&acc)[2][2][4][2], const Unit& u, int wr, int wc, int fr, int fq) const {
        asm volatile("" : "+v"(fr), "+v"(fq));
#pragma unroll
        for (int ai = 0; ai < 2; ++ai)
#pragma unroll
            for (int m = 0; m < 4; ++m) { const int row = ai * HALF + wr * 64 + m * 16 + fr;
                float h[8];
#pragma unroll
                for (int n = 0; n < 2; ++n)
#pragma unroll
                    for (int j = 0; j < 4; j += 2) {
                        const f32x2v g = {acc[ai][0][m][n][j], acc[ai][0][m][n][j + 1]}, up = {acc[ai][1][m][n][j], acc[ai][1][m][n][j + 1]};
                        const f32x2v t = g * (f32x2v){-1.4426950408889634f, -1.4426950408889634f}, p = g * up;
                        f32x2v e = {__builtin_amdgcn_exp2f(t[0]), __builtin_amdgcn_exp2f(t[1])};
                        e = e + (f32x2v){1.f, 1.f};
                        const f32x2v r = {__builtin_amdgcn_rcpf(e[0]), __builtin_amdgcn_rcpf(e[1])};
                        const f32x2v o2 = p * r; h[n * 4 + j] = o2[0]; h[n * 4 + j + 1] = o2[1]; }
                int w0 = 0, w1 = 0;
                w0 = __builtin_amdgcn_cvt_pk_fp8_f32(h[0], h[1], w0, false); w0 = __builtin_amdgcn_cvt_pk_fp8_f32(h[2], h[3], w0, true);
                w1 = __builtin_amdgcn_cvt_pk_fp8_f32(h[4], h[5], w1, false); w1 = __builtin_amdgcn_cvt_pk_fp8_f32(h[6], h[7], w1, true);
                u32x2 o; o.x = (unsigned)w0; o.y = (unsigned)w1;
                *(u32x2*)(u.out + (size_t)row * 256 + (wc * 32 + 8 * fq)) = o; }
    }
};
struct EpiFp8 {
    static constexpr int NSTORE = 8;
    __device__ __forceinline__ void operator()(const f32x4 (&acc)[2][2][4][2], const Unit& u, int wr, int wc, int fr, int fq) const {
        asm volatile("" : "+v"(fr), "+v"(fq));
        const int pn = u.i1;
#pragma unroll
        for (int ai = 0; ai < 2; ++ai)
#pragma unroll
            for (int m = 0; m < 4; ++m) { const int row = ai * HALF + wr * 64 + m * 16 + fr;
                u32x4 o;
#pragma unroll
                for (int bj = 0; bj < 2; ++bj) { const f32x4 v0 = acc[ai][bj][m][0] * 16.f, v1 = acc[ai][bj][m][1] * 16.f;
                    int w0 = 0, w1 = 0;
                    w0 = __builtin_amdgcn_cvt_pk_fp8_f32(v0[0], v0[1], w0, false); w0 = __builtin_amdgcn_cvt_pk_fp8_f32(v0[2], v0[3], w0, true);
                    w1 = __builtin_amdgcn_cvt_pk_fp8_f32(v1[0], v1[1], w1, false); w1 = __builtin_amdgcn_cvt_pk_fp8_f32(v1[2], v1[3], w1, true);
                    o[2 * bj] = (unsigned)w0; o[2 * bj + 1] = (unsigned)w1; }
                *(u32x4*)(u.out + (size_t)row * 1024 + (16 * pn + 4 * wc + fq) * 16) = o; }
    }
};
struct EpiY8 {
    static constexpr int NSTORE = 0;
    __device__ __forceinline__ void operator()(const f32x4 (&acc)[2][2][4][2], const Unit& u, int wr, int wc, int fr, int fq) const {
        asm volatile("" : "+v"(fr), "+v"(fq));
        const int pn = u.i1; const float s = u.scale * YSC;
#pragma unroll
        for (int ai = 0; ai < 2; ++ai)
#pragma unroll
            for (int m = 0; m < 4; ++m) { const int row = ai * HALF + wr * 64 + m * 16 + fr;
                u32x4 o;
#pragma unroll
                for (int bj = 0; bj < 2; ++bj) { f32x4 v0 = acc[ai][bj][m][0] * s, v1 = acc[ai][bj][m][1] * s;
#pragma unroll
                    for (int j = 0; j < 4; ++j) { v0[j] = __builtin_amdgcn_fmed3f(v0[j], -448.f, 448.f); v1[j] = __builtin_amdgcn_fmed3f(v1[j], -448.f, 448.f); }
                    int w0 = 0, w1 = 0;
                    w0 = __builtin_amdgcn_cvt_pk_fp8_f32(v0[0], v0[1], w0, false); w0 = __builtin_amdgcn_cvt_pk_fp8_f32(v0[2], v0[3], w0, true);
                    w1 = __builtin_amdgcn_cvt_pk_fp8_f32(v1[0], v1[1], w1, false); w1 = __builtin_amdgcn_cvt_pk_fp8_f32(v1[2], v1[3], w1, true);
                    o[2 * bj] = (unsigned)w0; o[2 * bj + 1] = (unsigned)w1; }
                if (!((u.flags & 1) && row == 0)) *(GAS u32x4*)(u.out + (ptrdiff_t)row * u.ldc + (16 * pn + 4 * wc + fq) * 16) = o; }
    }
};
__device__ __forceinline__ int xcd_remap(int L0, int NU) { const int q = NU >> 3, r = NU & 7, x = L0 & 7, off = L0 >> 3; return (x < r ? x * (q + 1) : r * (q + 1) + (x - r) * q) + off; }
}

namespace attn {
constexpr int SLOTB = 8192;
constexpr int LDS_K = 0, LDS_V = 2 * SLOTB, LDS_WS = 4 * SLOTB, LDS_OST = LDS_WS + NWAVES * 256, LDS_END = LDS_OST + NWAVES * 4096;
static_assert(LDS_END <= RING_BYTES, "attention LDS");
__device__ __forceinline__ int crow(int r, int hi) { return (r & 3) + 8 * (r >> 2) + 4 * hi; }
__device__ __forceinline__ void glds16(const void* gsrc, unsigned lds_dst) { unsigned keep;
    asm volatile("s_mov_b32 %0, m0\n\ts_mov_b32 m0, %2\n\ts_nop 0\n\tglobal_load_lds_dwordx4 %1, off\n\ts_mov_b32 m0, %0" : "=&s"(keep) : "v"(gsrc), "s"(lds_dst) : "memory"); }
__device__ __forceinline__ float rowmax(const f32x16& p0, const f32x16& p1) {
    float a = fmaxf(p0[0], p1[0]);
#pragma unroll
    for (int r = 1; r < 16; ++r) a = fmaxf(a, fmaxf(p0[r], p1[r]));
    auto rr = __builtin_amdgcn_permlane32_swap(__float_as_uint(a), __float_as_uint(a), false, false);
    return fmaxf(__uint_as_float(rr[0]), __uint_as_float(rr[1]));
}
typedef short v4i16_t __attribute__((ext_vector_type(4)));
__device__ __forceinline__ s16x4 vtr(const LAS unsigned char* p) { return __builtin_bit_cast(s16x4, __builtin_amdgcn_ds_read_tr16_b64_v4i16((LAS v4i16_t*)p)); }
__device__ __forceinline__ void pv(f32x16* o, const LAS unsigned char* vp, bf16x8 pa0, bf16x8 pa1, bf16x8 pa2, bf16x8 pa3) {
#pragma unroll
    for (int d0 = 0; d0 < 2; ++d0) { s16x4 lo[4], hi[4];
#pragma unroll
        for (int ks = 0; ks < 4; ++ks) { lo[ks] = vtr(vp + d0 * 4096 + ks * 1024); hi[ks] = vtr(vp + d0 * 4096 + ks * 1024 + 512); }
#define PK(k) (bf16x8){lo[k][0], lo[k][1], lo[k][2], lo[k][3], hi[k][0], hi[k][1], hi[k][2], hi[k][3]}
        o[d0] = __builtin_amdgcn_mfma_f32_32x32x16_bf16(pa0, PK(0), o[d0], 0, 0, 0);
        o[d0] = __builtin_amdgcn_mfma_f32_32x32x16_bf16(pa1, PK(1), o[d0], 0, 0, 0);
        o[d0] = __builtin_amdgcn_mfma_f32_32x32x16_bf16(pa2, PK(2), o[d0], 0, 0, 0);
        o[d0] = __builtin_amdgcn_mfma_f32_32x32x16_bf16(pa3, PK(3), o[d0], 0, 0, 0);
#undef PK
    }
}
__device__ __forceinline__ void attn_unit(const bf16_t* Q, const bf16_t* K, const bf16_t* V, bf16_t* O, int b, int h, int q0, bool isctx, float sink2, LAS unsigned char* shm) {
    const int tid = opaque_tid(), lane = tid & 63, r32 = lane & 31, hi = lane >> 5; const int wid = __builtin_amdgcn_readfirstlane(tid >> 6);
    const int kvh = h >> 2;
    const long qrow = isctx ? (long)T + b * CTXL + wid * 32 : (long)b * SEQ + q0 + wid * 32;
    const unsigned lds0 = (unsigned)(uintptr_t)shm;
    LAS float* wsf = (LAS float*)(shm + LDS_WS) + wid * 64;
    int jlo = 0, nl = 0;
    if (!isctx) { jlo = (q0 == 0) ? 2 : 0; int jhi = (SEQ - q0 + 128) / 64; if (jhi > 8) jhi = 8; nl = jhi - jlo; }
    const int NT = nl + 4;
    const long lat0 = (long)b * SEQ + q0 - 128 + 64 * jlo, ctx0 = (long)T + b * CTXL;
#define TROW(t) ((t) < nl ? lat0 + 64 * (t) : ctx0 + 64 * ((t) - nl))
    const int kcol = kvh * 64 + wid * 8, vcol = kvh * 64 + (wid >> 2) * 32 + (lane & 3) * 8, vrow = 16 * (wid & 3) + (lane >> 2);
    const unsigned kdst = lds0 + LDS_K + wid * 1024, vdst = lds0 + LDS_V + wid * 1024;
#define DMA_KV(t, slot) do { const long tr_ = TROW(t); glds16(K + (tr_ + lane) * 256 + kcol, (unsigned)__builtin_amdgcn_readfirstlane(kdst + (slot) * SLOTB)); \
        glds16(V + (tr_ + vrow) * 256 + vcol, (unsigned)__builtin_amdgcn_readfirstlane(vdst + (slot) * SLOTB)); } while (0)
    DMA_KV(0, 0);
    bf16x8 qr[4];
#pragma unroll
    for (int d0 = 0; d0 < 4; ++d0) { const u32x2 w = *(const GAS u32x2*)((const unsigned char*)Q + (qrow + r32) * 1024 + h * 64 + d0 * 16 + hi * 8);
        const f32x2v a0 = __builtin_amdgcn_cvt_pk_f32_fp8((int)w.x, false), a1 = __builtin_amdgcn_cvt_pk_f32_fp8((int)w.x, true), a2 = __builtin_amdgcn_cvt_pk_f32_fp8((int)w.y, false), a3 = __builtin_amdgcn_cvt_pk_f32_fp8((int)w.y, true);
        u32x4 qw; qw.x = cvt_pk_bf16(a0[0] * (1.f / QSC), a0[1] * (1.f / QSC)); qw.y = cvt_pk_bf16(a1[0] * (1.f / QSC), a1[1] * (1.f / QSC)); qw.z = cvt_pk_bf16(a2[0] * (1.f / QSC), a2[1] * (1.f / QSC)); qw.w = cvt_pk_bf16(a3[0] * (1.f / QSC), a3[1] * (1.f / QSC));
        qr[d0] = __builtin_bit_cast(bf16x8, qw); }
    float mrun = sink2, l_reg = (hi == 0) ? 1.f : 0.f;
    f32x16 negm;
#pragma unroll
    for (int r = 0; r < 16; ++r) negm[r] = -sink2;
    f32x16 o[2];
#pragma unroll
    for (int r = 0; r < 16; ++r) { o[0][r] = 0.f; o[1][r] = 0.f; }
    const LAS unsigned char* vp0 = shm + LDS_V + ((lane >> 4) & 1) * 32 + (lane & 3) * 8 + (4 * hi + ((lane & 15) >> 2)) * 64;
    const int qw = q0 + wid * 32;
    asm volatile("s_waitcnt vmcnt(0) lgkmcnt(0)\n\ts_barrier" ::: "memory");
    for (int t = 0; t < NT; ++t) {
        const int slot = t & 1;
        if (t + 1 < NT) DMA_KV(t + 1, slot ^ 1);
        const bool latt = t < nl;
        const int ks = q0 - 128 + 64 * (jlo + t);
        bool need = true;
        if (latt) need = (ks + 63 >= qw - 128) && (ks <= qw + 31 + 128);
        if (need) {
            f32x16 p0, p1;
            const LAS unsigned char* kb = shm + LDS_K + slot * SLOTB + hi * 1024 + r32 * 16;
#pragma unroll
            for (int d0 = 0; d0 < 4; ++d0) {
                const bf16x8 b0 = *(const LAS bf16x8*)(kb + d0 * 2048), b1 = *(const LAS bf16x8*)(kb + d0 * 2048 + 512);
                if (d0 == 0) { p0 = __builtin_amdgcn_mfma_f32_32x32x16_bf16(b0, qr[0], negm, 0, 0, 0); p1 = __builtin_amdgcn_mfma_f32_32x32x16_bf16(b1, qr[0], negm, 0, 0, 0); }
                else { p0 = __builtin_amdgcn_mfma_f32_32x32x16_bf16(b0, qr[d0], p0, 0, 0, 0); p1 = __builtin_amdgcn_mfma_f32_32x32x16_bf16(b1, qr[d0], p1, 0, 0, 0); } }
            if (latt && !(ks >= qw - 97 && ks <= qw + 65)) {
                const int dq = qw + r32 - ks;
#pragma unroll
                for (int r = 0; r < 16; ++r) { const int d = dq - crow(r, hi); if (d > 128 || d < -128) p0[r] = -INFINITY; if (d - 32 > 128 || d - 32 < -128) p1[r] = -INFINITY; } }
            const float rm = rowmax(p0, p1);
            if (__any(rm > 8.f)) {
                const float delta = fmaxf(rm, 0.f);
                const float alpha = __builtin_amdgcn_exp2f(-delta); l_reg *= alpha; mrun += delta;
#pragma unroll
                for (int r = 0; r < 16; ++r) { p0[r] -= delta; p1[r] -= delta; negm[r] = -mrun; }
                if (hi == 0) wsf[r32] = alpha;
                asm volatile("s_waitcnt lgkmcnt(0)" ::: "memory");
#pragma unroll
                for (int r = 0; r < 16; ++r) { const float f = wsf[crow(r, hi)]; o[0][r] *= f; o[1][r] *= f; }
            }
            float sacc = 0.f;
#pragma unroll
            for (int r = 0; r < 16; ++r) { p0[r] = __builtin_amdgcn_exp2f(p0[r]); p1[r] = __builtin_amdgcn_exp2f(p1[r]); sacc += p0[r] + p1[r]; }
            l_reg += sacc;
            u32x4 pw0, pw1, pw2, pw3;
#define PKW(P, B) cvt_pk_bf16(P[B], P[B + 1])
            pw0 = (u32x4){PKW(p0, 0), PKW(p0, 2), PKW(p0, 4), PKW(p0, 6)}; pw1 = (u32x4){PKW(p0, 8), PKW(p0, 10), PKW(p0, 12), PKW(p0, 14)};
            pw2 = (u32x4){PKW(p1, 0), PKW(p1, 2), PKW(p1, 4), PKW(p1, 6)}; pw3 = (u32x4){PKW(p1, 8), PKW(p1, 10), PKW(p1, 12), PKW(p1, 14)};
#undef PKW
            __builtin_amdgcn_sched_barrier(0);
            pv(o, vp0 + slot * SLOTB, __builtin_bit_cast(bf16x8, pw0), __builtin_bit_cast(bf16x8, pw1), __builtin_bit_cast(bf16x8, pw2), __builtin_bit_cast(bf16x8, pw3));
        }
        asm volatile("s_waitcnt vmcnt(0) lgkmcnt(0)\n\ts_barrier" ::: "memory");
    }
    { auto rr = __builtin_amdgcn_permlane32_swap(__float_as_uint(l_reg), __float_as_uint(l_reg), false, false); l_reg = __uint_as_float(rr[0]) + __uint_as_float(rr[1]); }
    if (hi == 0) wsf[32 + r32] = l_reg;
    asm volatile("s_waitcnt lgkmcnt(0)" ::: "memory");
    float rli[16];
#pragma unroll
    for (int r = 0; r < 16; ++r) rli[r] = __builtin_amdgcn_rcpf(wsf[32 + crow(r, hi)]);
    unsigned char* Ow = (unsigned char*)O + qrow * 1024 + h * 64;
    { LAS unsigned char* stg = shm + LDS_OST + wid * 2048;
#pragma unroll
      for (int r = 0; r < 16; ++r) { const int orow = crow(r, hi);
#pragma unroll
          for (int d0 = 0; d0 < 2; ++d0) stg[orow * 64 + d0 * 32 + r32] = (unsigned char)f2f8(o[d0][r] * rli[r]); }
      asm volatile("s_waitcnt lgkmcnt(0)" ::: "memory");
#pragma unroll
      for (int i = 0; i < 2; ++i) { const int row = i * 16 + (lane >> 2), ch = lane & 3; const u32x4 v = *(const LAS u32x4*)(stg + row * 64 + ch * 16); *(GAS u32x4*)(Ow + (long)row * 1024 + ch * 16) = v; } }
    asm volatile("s_waitcnt lgkmcnt(0)" ::: "memory");
#undef TROW
#undef DMA_KV
}
__device__ __forceinline__ void attn_unit2(const bf16_t* Q, const bf16_t* K, const bf16_t* V, bf16_t* O, int b, int h0, int q0, bool isctx, float sinkA, float sinkB, LAS unsigned char* shm) {
    const int tid = opaque_tid(), lane = tid & 63, r32 = lane & 31, hi = lane >> 5; const int wid = __builtin_amdgcn_readfirstlane(tid >> 6);
    const int kvh = h0 >> 2;
    const long qrow = isctx ? (long)T + b * CTXL + wid * 32 : (long)b * SEQ + q0 + wid * 32;
    const unsigned lds0 = (unsigned)(uintptr_t)shm;
    LAS float* wsf = (LAS float*)(shm + LDS_WS) + wid * 64;
    int jlo = 0, nl = 0;
    if (!isctx) { jlo = (q0 == 0) ? 2 : 0; int jhi = (SEQ - q0 + 128) / 64; if (jhi > 8) jhi = 8; nl = jhi - jlo; }
    const int NT = nl + 4;
    const long lat0 = (long)b * SEQ + q0 - 128 + 64 * jlo, ctx0 = (long)T + b * CTXL;
#define TROW(t) ((t) < nl ? lat0 + 64 * (t) : ctx0 + 64 * ((t) - nl))
    const int kcol = kvh * 64 + wid * 8, vcol = kvh * 64 + (wid >> 2) * 32 + (lane & 3) * 8, vrow = 16 * (wid & 3) + (lane >> 2);
    const unsigned kdst = lds0 + LDS_K + wid * 1024, vdst = lds0 + LDS_V + wid * 1024;
#define DMA_KV(t, slot) do { const long tr_ = TROW(t); glds16(K + (tr_ + lane) * 256 + kcol, (unsigned)__builtin_amdgcn_readfirstlane(kdst + (slot) * SLOTB)); \
        glds16(V + (tr_ + vrow) * 256 + vcol, (unsigned)__builtin_amdgcn_readfirstlane(vdst + (slot) * SLOTB)); } while (0)
    DMA_KV(0, 0);
    bf16x8 qr[2][4];
#pragma unroll
    for (int hh = 0; hh < 2; ++hh)
#pragma unroll
        for (int d0 = 0; d0 < 4; ++d0) { const u32x2 w = *(const GAS u32x2*)((const unsigned char*)Q + (qrow + r32) * 1024 + (h0 + hh) * 64 + d0 * 16 + hi * 8);
            const f32x2v a0 = __builtin_amdgcn_cvt_pk_f32_fp8((int)w.x, false), a1 = __builtin_amdgcn_cvt_pk_f32_fp8((int)w.x, true), a2 = __builtin_amdgcn_cvt_pk_f32_fp8((int)w.y, false), a3 = __builtin_amdgcn_cvt_pk_f32_fp8((int)w.y, true);
            u32x4 qw; qw.x = cvt_pk_bf16(a0[0] * (1.f / QSC), a0[1] * (1.f / QSC)); qw.y = cvt_pk_bf16(a1[0] * (1.f / QSC), a1[1] * (1.f / QSC)); qw.z = cvt_pk_bf16(a2[0] * (1.f / QSC), a2[1] * (1.f / QSC)); qw.w = cvt_pk_bf16(a3[0] * (1.f / QSC), a3[1] * (1.f / QSC));
            qr[hh][d0] = __builtin_bit_cast(bf16x8, qw); }
    float mrun[2] = {sinkA, sinkB}, l_reg[2] = {(hi == 0) ? 1.f : 0.f, (hi == 0) ? 1.f : 0.f};
    f32x16 o[2][2];
#pragma unroll
    for (int hh = 0; hh < 2; ++hh)
#pragma unroll
        for (int r = 0; r < 16; ++r) { o[hh][0][r] = 0.f; o[hh][1][r] = 0.f; }
    const LAS unsigned char* vp0 = shm + LDS_V + ((lane >> 4) & 1) * 32 + (lane & 3) * 8 + (4 * hi + ((lane & 15) >> 2)) * 64;
    const int qw = q0 + wid * 32;
    asm volatile("s_waitcnt vmcnt(0) lgkmcnt(0)\n\ts_barrier" ::: "memory");
    for (int t = 0; t < NT; ++t) {
        const int slot = t & 1;
        if (t + 1 < NT) DMA_KV(t + 1, slot ^ 1);
        const bool latt = t < nl;
        const int ks = q0 - 128 + 64 * (jlo + t);
        bool need = true;
        if (latt) need = (ks + 63 >= qw - 128) && (ks <= qw + 31 + 128);
        if (need) {
            f32x16 p[2][2];
            { f32x16 nm0, nm1;
#pragma unroll
              for (int r = 0; r < 16; ++r) { nm0[r] = -mrun[0]; nm1[r] = -mrun[1]; }
              const LAS unsigned char* kb = shm + LDS_K + slot * SLOTB + hi * 1024 + r32 * 16;
#pragma unroll
              for (int d0 = 0; d0 < 4; ++d0) {
                const bf16x8 b0 = *(const LAS bf16x8*)(kb + d0 * 2048), b1 = *(const LAS bf16x8*)(kb + d0 * 2048 + 512);
                if (d0 == 0) { p[0][0] = __builtin_amdgcn_mfma_f32_32x32x16_bf16(b0, qr[0][0], nm0, 0, 0, 0); p[0][1] = __builtin_amdgcn_mfma_f32_32x32x16_bf16(b1, qr[0][0], nm0, 0, 0, 0);
                               p[1][0] = __builtin_amdgcn_mfma_f32_32x32x16_bf16(b0, qr[1][0], nm1, 0, 0, 0); p[1][1] = __builtin_amdgcn_mfma_f32_32x32x16_bf16(b1, qr[1][0], nm1, 0, 0, 0); }
                else {
#pragma unroll
                    for (int hh = 0; hh < 2; ++hh) { p[hh][0] = __builtin_amdgcn_mfma_f32_32x32x16_bf16(b0, qr[hh][d0], p[hh][0], 0, 0, 0); p[hh][1] = __builtin_amdgcn_mfma_f32_32x32x16_bf16(b1, qr[hh][d0], p[hh][1], 0, 0, 0); } } } }
            if (latt && !(ks >= qw - 97 && ks <= qw + 65)) {
                const int dq = qw + r32 - ks;
#pragma unroll
                for (int r = 0; r < 16; ++r) { const int d = dq - crow(r, hi);
                    if (d > 128 || d < -128) { p[0][0][r] = -INFINITY; p[1][0][r] = -INFINITY; }
                    if (d - 32 > 128 || d - 32 < -128) { p[0][1][r] = -INFINITY; p[1][1][r] = -INFINITY; } } }
            u32x4 pw[2][4];
#pragma unroll
            for (int hh = 0; hh < 2; ++hh) {
                const float rm = rowmax(p[hh][0], p[hh][1]);
                if (__any(rm > 8.f)) {
                    const float delta = fmaxf(rm, 0.f);
                    const float alpha = __builtin_amdgcn_exp2f(-delta); l_reg[hh] *= alpha; mrun[hh] += delta;
#pragma unroll
                    for (int r = 0; r < 16; ++r) { p[hh][0][r] -= delta; p[hh][1][r] -= delta; }
                    if (hi == 0) wsf[r32] = alpha;
                    asm volatile("s_waitcnt lgkmcnt(0)" ::: "memory");
#pragma unroll
                    for (int r = 0; r < 16; ++r) { const float f = wsf[crow(r, hi)]; o[hh][0][r] *= f; o[hh][1][r] *= f; }
                    asm volatile("s_waitcnt lgkmcnt(0)" ::: "memory");
                }
                float sacc = 0.f;
#pragma unroll
                for (int r = 0; r < 16; ++r) { p[hh][0][r] = __builtin_amdgcn_exp2f(p[hh][0][r]); p[hh][1][r] = __builtin_amdgcn_exp2f(p[hh][1][r]); sacc += p[hh][0][r] + p[hh][1][r]; }
                l_reg[hh] += sacc;
#define PKW(P, B) cvt_pk_bf16(P[B], P[B + 1])
                pw[hh][0] = (u32x4){PKW(p[hh][0], 0), PKW(p[hh][0], 2), PKW(p[hh][0], 4), PKW(p[hh][0], 6)}; pw[hh][1] = (u32x4){PKW(p[hh][0], 8), PKW(p[hh][0], 10), PKW(p[hh][0], 12), PKW(p[hh][0], 14)};
                pw[hh][2] = (u32x4){PKW(p[hh][1], 0), PKW(p[hh][1], 2), PKW(p[hh][1], 4), PKW(p[hh][1], 6)}; pw[hh][3] = (u32x4){PKW(p[hh][1], 8), PKW(p[hh][1], 10), PKW(p[hh][1], 12), PKW(p[hh][1], 14)};
#undef PKW
            }
            __builtin_amdgcn_sched_barrier(0);
            { const LAS unsigned char* vp = vp0 + slot * SLOTB;
#pragma unroll
              for (int d0 = 0; d0 < 2; ++d0) { s16x4 lo[4], hh4[4];
#pragma unroll
                for (int k4 = 0; k4 < 4; ++k4) { lo[k4] = vtr(vp + d0 * 4096 + k4 * 1024); hh4[k4] = vtr(vp + d0 * 4096 + k4 * 1024 + 512); }
#pragma unroll
                for (int hh = 0; hh < 2; ++hh)
#pragma unroll
                    for (int k4 = 0; k4 < 4; ++k4) { const bf16x8 vb8 = (bf16x8){lo[k4][0], lo[k4][1], lo[k4][2], lo[k4][3], hh4[k4][0], hh4[k4][1], hh4[k4][2], hh4[k4][3]};
                        o[hh][d0] = __builtin_amdgcn_mfma_f32_32x32x16_bf16(__builtin_bit_cast(bf16x8, pw[hh][k4]), vb8, o[hh][d0], 0, 0, 0); } } }
        }
        asm volatile("s_waitcnt vmcnt(0) lgkmcnt(0)\n\ts_barrier" ::: "memory");
    }
#pragma unroll
    for (int hh = 0; hh < 2; ++hh) {
        float lr = l_reg[hh];
        { auto rr = __builtin_amdgcn_permlane32_swap(__float_as_uint(lr), __float_as_uint(lr), false, false); lr = __uint_as_float(rr[0]) + __uint_as_float(rr[1]); }
        if (hi == 0) wsf[32 + r32] = lr;
        asm volatile("s_waitcnt lgkmcnt(0)" ::: "memory");
        float rli[16];
#pragma unroll
        for (int r = 0; r < 16; ++r) rli[r] = __builtin_amdgcn_rcpf(wsf[32 + crow(r, hi)]);
        asm volatile("s_waitcnt lgkmcnt(0)" ::: "memory");
        unsigned char* Ow = (unsigned char*)O + qrow * 1024 + (h0 + hh) * 64;
        LAS unsigned char* stg = shm + LDS_OST + wid * 4096 + hh * 2048;
#pragma unroll
        for (int r = 0; r < 16; ++r) { const int orow = crow(r, hi);
#pragma unroll
            for (int d0 = 0; d0 < 2; ++d0) stg[orow * 64 + d0 * 32 + r32] = (unsigned char)f2f8(o[hh][d0][r] * rli[r]); }
        asm volatile("s_waitcnt lgkmcnt(0)" ::: "memory");
#pragma unroll
        for (int i = 0; i < 2; ++i) { const int row = i * 16 + (lane >> 2), ch = lane & 3; const u32x4 v = *(const LAS u32x4*)(stg + row * 64 + ch * 16); *(GAS u32x4*)(Ow + (long)row * 1024 + ch * 16) = v; }
    }
    asm volatile("s_waitcnt lgkmcnt(0)" ::: "memory");
#undef TROW
#undef DMA_KV
}
}

struct Args {
    const float* in[20];
    float* out; unsigned char* ws;
};
struct Frame {
    LAS unsigned char* lds; unsigned* ctl; unsigned char* ws;
    int tid, lane, wave, gw;
    int blk;
    __device__ __forceinline__ void refresh() { tid = opaque_tid(); lane = tid & 63; wave = __builtin_amdgcn_readfirstlane(tid >> 6); gw = blk * 8 + wave;
        asm volatile("" : "+s"(ws)); ctl = (unsigned*)(ws + WS_CTL); }
};
constexpr int NGW = GRID * NWAVES;

struct Row { f32x4 v[4]; };
__device__ __forceinline__ int vq(int q, int lane) { return 64 * (lane >> 4) + 2 * (lane & 15) + 32 * (q >> 1) + (q & 1); }
__device__ __forceinline__ int vb(int j, int lane) { return 32 * (lane >> 4) + (lane & 15) + 16 * j; }
__device__ __forceinline__ void row_load_bf16(Row& r, const bf16_t* p, int lane) {
#pragma unroll
    for (int j = 0; j < 2; ++j) { const u32x4 w = ((const GAS u32x4*)p)[vb(j, lane)]; r.v[2 * j] = (f32x4){bflo(w.x), bfhi(w.x), bflo(w.y), bfhi(w.y)}; r.v[2 * j + 1] = (f32x4){bflo(w.z), bfhi(w.z), bflo(w.w), bfhi(w.w)}; } }
__device__ __forceinline__ void row_store_bf16(const Row& r, bf16_t* p, int lane) {
#pragma unroll
    for (int j = 0; j < 2; ++j) { u32x4 w; w.x = pk2(r.v[2 * j][0], r.v[2 * j][1]); w.y = pk2(r.v[2 * j][2], r.v[2 * j][3]); w.z = pk2(r.v[2 * j + 1][0], r.v[2 * j + 1][1]); w.w = pk2(r.v[2 * j + 1][2], r.v[2 * j + 1][3]); ((GAS u32x4*)p)[vb(j, lane)] = w; } }
__device__ __forceinline__ void row_load_fp8(Row& r, const unsigned char* p, int lane) {
    const u32x4 w = ((const GAS u32x4*)p)[lane];
#pragma unroll
    for (int q = 0; q < 4; ++q) { const f32x2v lo = __builtin_amdgcn_cvt_pk_f32_fp8((int)w[q], false), hi = __builtin_amdgcn_cvt_pk_f32_fp8((int)w[q], true); r.v[q] = (f32x4){lo[0], lo[1], hi[0], hi[1]}; } }
__device__ __forceinline__ void row_store_fp8(const Row& r, unsigned char* p, int lane) {
    const int e0 = 256 * (lane >> 4) + 8 * (lane & 15);
#pragma unroll
    for (int j = 0; j < 2; ++j) { int w0 = 0, w1 = 0;
        w0 = __builtin_amdgcn_cvt_pk_fp8_f32(r.v[2 * j][0], r.v[2 * j][1], w0, false); w0 = __builtin_amdgcn_cvt_pk_fp8_f32(r.v[2 * j][2], r.v[2 * j][3], w0, true);
        w1 = __builtin_amdgcn_cvt_pk_fp8_f32(r.v[2 * j + 1][0], r.v[2 * j + 1][1], w1, false); w1 = __builtin_amdgcn_cvt_pk_fp8_f32(r.v[2 * j + 1][2], r.v[2 * j + 1][3], w1, true);
        u32x2 o; o.x = (unsigned)w0; o.y = (unsigned)w1; *(GAS u32x2*)(p + e0 + 128 * j) = o; } }
__device__ __forceinline__ void row_load_f32(Row& r, const float* p, int lane) {
#pragma unroll
    for (int q = 0; q < 4; ++q) r.v[q] = ((const GAS f32x4*)p)[vq(q, lane)]; }
__device__ __forceinline__ void row_store_f32(const Row& r, float* p, int lane) {
#pragma unroll
    for (int q = 0; q < 4; ++q) ((GAS f32x4*)p)[vq(q, lane)] = r.v[q]; }
__device__ __forceinline__ void row_normalize(Row& r, float eps) {
    float s = 0.f;
#pragma unroll
    for (int j = 0; j < 4; ++j) s += (r.v[j][0] + r.v[j][1]) + (r.v[j][2] + r.v[j][3]);
    const float mean = wave_sum(s) * (1.f / D); float q = 0.f;
#pragma unroll
    for (int j = 0; j < 4; ++j) { r.v[j] = r.v[j] - mean; q += (r.v[j][0] * r.v[j][0] + r.v[j][1] * r.v[j][1]) + (r.v[j][2] * r.v[j][2] + r.v[j][3] * r.v[j][3]); }
    const float rstd = 1.f / sqrtf(wave_sum(q) * (1.f / D) + eps);
#pragma unroll
    for (int j = 0; j < 4; ++j) r.v[j] = r.v[j] * rstd;
}
__device__ __forceinline__ void row_normalize_stats(Row& r, float eps, float& mean_o, float& rstd_o) {
    float s = 0.f;
#pragma unroll
    for (int j = 0; j < 4; ++j) s += (r.v[j][0] + r.v[j][1]) + (r.v[j][2] + r.v[j][3]);
    const float mean = wave_sum(s) * (1.f / D); float q = 0.f;
#pragma unroll
    for (int j = 0; j < 4; ++j) { r.v[j] = r.v[j] - mean; q += (r.v[j][0] * r.v[j][0] + r.v[j][1] * r.v[j][1]) + (r.v[j][2] * r.v[j][2] + r.v[j][3] * r.v[j][3]); }
    const float rstd = 1.f / sqrtf(wave_sum(q) * (1.f / D) + eps);
#pragma unroll
    for (int j = 0; j < 4; ++j) r.v[j] = r.v[j] * rstd;
    mean_o = mean; rstd_o = rstd;
}
__device__ __forceinline__ void row_modulate(Row& r, const float* sh, const float* sc, int lane) {
    row_normalize(r, MOD_EPS);
#pragma unroll
    for (int j = 0; j < 4; ++j) { const f32x4 a = ((const GAS f32x4*)sc)[vq(j, lane)], b = ((const GAS f32x4*)sh)[vq(j, lane)]; r.v[j] = r.v[j] * (a + 1.f) + b; }
}
__device__ __forceinline__ int mod_row(int row) { return row < T ? (row >> 11) : 32; }
__device__ __forceinline__ const float* mod_vec(const unsigned char* ws, int layer, int mr, int chunk) { return (const float*)(ws + WS_MOD) + ((size_t)(layer * 33 + mr) * 6 + chunk) * 1024; }

__device__ __forceinline__ void conv_item(const float* W, int N, bf16_t* WT, int Kd, int kd0, int n0, int drow0, bool mirror, LAS float* scr, int lane) {
#pragma unroll 8
    for (int i = 0; i < 32; ++i) { const int kk = 2 * i + (lane >> 5); const int kd = kd0 + kk; const int ks = mirror ? ((kd & ~255) + ((256 - (kd & 255)) & 255)) : kd;
        scr[kk * 33 + (lane & 31)] = ((const GAS float*)W)[(size_t)ks * N + n0 + (lane & 31)]; }
    LDS_WAIT(); asm volatile("" ::: "memory");
    const int c = lane & 7;
#pragma unroll
    for (int j = 0; j < 4; ++j) { const int n = (lane >> 3) + 8 * j; const LAS float* s = scr + (8 * c) * 33 + n;
        u32x4 o; o.x = pk2(s[0 * 33], s[1 * 33]); o.y = pk2(s[2 * 33], s[3 * 33]); o.z = pk2(s[4 * 33], s[5 * 33]); o.w = pk2(s[6 * 33], s[7 * 33]);
        *(GAS u32x4*)(WT + (size_t)(drow0 + n) * Kd + kd0 + 8 * c) = o; }
    LDS_WAIT(); asm volatile("" ::: "memory");
}
__device__ __forceinline__ void conv_matrix_item(const float* W, int K, int N, bf16_t* WT, int mode, int roff, int item, LAS float* scr, int lane) {
    const int nblk = N / 32, kb = item / nblk, nb = item % nblk, n0 = 32 * nb;
    int drow0 = n0 + roff; if (mode == 1) drow0 = (n0 >> 7) * 256 + (n0 & 127); if (mode == 2) drow0 = (n0 >> 7) * 256 + 128 + (n0 & 127);
    conv_item(W, N, WT, K, 64 * kb, n0, drow0, mode == 3, scr, lane);
}
__device__ __forceinline__ void conv_item64(const float* W, int N, bf16_t* WT, int Kd, int k0, int n0, int drow0, LAS bf16_t* scr, int lane) {
    f32x4 v[16];
#pragma unroll
    for (int i = 0; i < 16; ++i) v[i] = *(const GAS f32x4*)(W + (size_t)(k0 + 4 * i + (lane >> 4)) * N + n0 + (lane & 15) * 4);
#pragma unroll
    for (int i = 0; i < 16; ++i) { u32x2 w; w.x = pk2(v[i][0], v[i][1]); w.y = pk2(v[i][2], v[i][3]); *(LAS u32x2*)(scr + (4 * i + (lane >> 4)) * 68 + (lane & 15) * 4) = w; }
    LDS_WAIT(); asm volatile("" ::: "memory");
    const int c = lane & 7;
#pragma unroll
    for (int j = 0; j < 8; ++j) { const int n = (lane >> 3) + 8 * j; const LAS bf16_t* p = scr + (8 * c) * 68 + n;
        u32x4 o; o.x = (unsigned)p[0] | ((unsigned)p[68] << 16); o.y = (unsigned)p[2 * 68] | ((unsigned)p[3 * 68] << 16); o.z = (unsigned)p[4 * 68] | ((unsigned)p[5 * 68] << 16); o.w = (unsigned)p[6 * 68] | ((unsigned)p[7 * 68] << 16);
        *(GAS u32x4*)(WT + (size_t)(drow0 + n) * Kd + k0 + 8 * c) = o; }
    LDS_WAIT(); asm volatile("" ::: "memory");
}
__device__ __forceinline__ void conv_item64_f8(const float* W, int N, unsigned char* WT, int Kd, int k0, int n0, int drow0, LAS unsigned char* scr, int lane, bool mirror = false) {
    f32x4 v[16];
#pragma unroll
    for (int i = 0; i < 16; ++i) { const int kd = k0 + 4 * i + (lane >> 4); const int ks = mirror ? ((kd & ~255) + ((256 - (kd & 255)) & 255)) : kd; v[i] = *(const GAS f32x4*)(W + (size_t)ks * N + n0 + (lane & 15) * 4); }
#pragma unroll
    for (int i = 0; i < 16; ++i) { int w = 0; w = __builtin_amdgcn_cvt_pk_fp8_f32(v[i][0] * 64.f, v[i][1] * 64.f, w, false); w = __builtin_amdgcn_cvt_pk_fp8_f32(v[i][2] * 64.f, v[i][3] * 64.f, w, true);
        *(LAS unsigned*)(scr + (4 * i + (lane >> 4)) * 68 + (lane & 15) * 4) = (unsigned)w; }
    LDS_WAIT(); asm volatile("" ::: "memory");
    const int c = lane & 3;
#pragma unroll
    for (int j = 0; j < 4; ++j) { const int n = (lane >> 2) + 16 * j; const LAS unsigned char* p = scr + (16 * c) * 68 + n; u32x4 o;
#pragma unroll
        for (int q = 0; q < 4; ++q) o[q] = (unsigned)p[(4 * q) * 68] | ((unsigned)p[(4 * q + 1) * 68] << 8) | ((unsigned)p[(4 * q + 2) * 68] << 16) | ((unsigned)p[(4 * q + 3) * 68] << 24);
        *(GAS u32x4*)(WT + (size_t)(drow0 + n) * Kd + k0 + 16 * c) = o; }
    LDS_WAIT(); asm volatile("" ::: "memory");
}
__device__ __forceinline__ void conv_experts(Frame& F, const Args& a, int layer) {
    F.refresh();
    LAS unsigned char* scr = F.lds + 32768 + F.wave * 4352;
    unsigned char* EGU = F.ws + WS_EGU; unsigned char* ED = F.ws + WS_ED;
    for (int it = F.gw; it < (NE + 1) * 192; it += NGW) { const int e = it / 192, r = it % 192;
        const float* wg = e < NE ? a.in[14] + ((size_t)layer * NE + e) * 262144 : a.in[17] + (size_t)layer * 262144;
        const float* wu = e < NE ? a.in[15] + ((size_t)layer * NE + e) * 262144 : a.in[18] + (size_t)layer * 262144;
        const float* wd = e < NE ? a.in[16] + ((size_t)layer * NE + e) * 262144 : a.in[19] + (size_t)layer * 262144;
        if (r < 128) { const int q = r & 63, kb = q >> 2, nb = q & 3, n0 = 64 * nb; const int drow0 = (n0 >> 7) * 256 + (r < 64 ? 0 : 128) + (n0 & 127);
            conv_item64_f8(r < 64 ? wg : wu, 256, EGU + (size_t)e * 512 * 1024, 1024, 64 * kb, n0, drow0, scr, F.lane); }
        else { const int q = r - 128, kb = q >> 4, nb = q & 15; conv_item64_f8(wd, 1024, ED + (size_t)e * 1024 * 256, 256, 64 * kb, 64 * nb, 64 * nb, scr, F.lane); } }
}
__device__ __forceinline__ void conv_small(Frame& F, const Args& a) {
    F.refresh();
    { LAS unsigned char* scr8 = F.lds + 32768 + F.wave * 4352;
      for (int it = F.gw; it < 2304; it += NGW) {
          if (it < 768) { const int j = it / 384, r = it % 384, kb = r / 24, nb = r % 24; conv_item64_f8(a.in[8] + (size_t)j * 1024 * 1536, 1536, F.ws + WS_WQKV + (size_t)j * 1536 * 1024, 1024, 64 * kb, 64 * nb, 64 * nb, scr8, F.lane); }
          else if (it < 1280) { const int q = it - 768, j = q >> 8, r = q & 255, kb = r >> 4, nb = r & 15; conv_item64_f8(a.in[9] + (size_t)j * 1024 * 1024, 1024, F.ws + WS_WO + (size_t)j * 1024 * 1024, 1024, 64 * kb, 64 * nb, 64 * nb, scr8, F.lane); }
          else { const int q = it - 1280, j = q >> 9, r = q & 511, mir = r >> 8, kb = (r & 255) >> 4, nb = r & 15;
              conv_item64_f8(a.in[11] + (size_t)j * 1024 * 1024, 1024, F.ws + WS_WSH + (size_t)j * 2048 * 1024, 1024, 64 * kb, 64 * nb, 64 * nb + 1024 * mir, scr8, F.lane, mir != 0); } } }
    __syncthreads();
    { LAS float* scr = (LAS float*)(F.lds + 32768 + F.wave * 8448);
      for (int it = F.gw; it < 1152; it += NGW) {
          if (it < 1024) { const int j = it >> 9, r = it & 511; conv_matrix_item(a.in[11] + (size_t)j * 1024 * 1024, 1024, 1024, (bf16_t*)(F.ws + WS_WF) + (size_t)j * 2048 * 1024, 0, 0, r, scr, F.lane); }
          else { const int q = it - 1024, l = q / 32, r = q % 32; conv_matrix_item(a.in[12] + (size_t)l * 1024 * 64, 1024, 64, (bf16_t*)(F.ws + WS_WR) + (size_t)l * 64 * 1024, 0, 0, r, scr, F.lane); } } }
    const int gt = F.blk * NTHR + F.tid, NGT = GRID * NTHR;
    const float TWO_PI = 6.283185307179586f;
    { float* rc = (float*)(F.ws + WS_ROPEC); float* rs = (float*)(F.ws + WS_ROPES);
      for (int i = gt; i < 64 * 16; i += NGT) { const int pos = i >> 4, fi = i & 15; const float inv = exp2f(-(float)fi * (13.287712379549449f / 16.f)); const float ang = (float)pos * inv; rc[i] = cosf(ang); rs[i] = sinf(ang); } }
    { unsigned* cs = (unsigned*)(F.ws + WS_CSN);
      for (int i = gt; i < 512 * 64; i += NGT) { const int r = i >> 6, n4 = (i & 63) * 4, m = r & 255; unsigned w = 0;
#pragma unroll
          for (int q = 0; q < 4; ++q) { const float ang = TWO_PI * (float)((m * (n4 + q)) & 255) * (1.f / 256.f); w |= f2f8(r < 256 ? __cosf(ang) : -__sinf(ang)) << (8 * q); }
          cs[i] = w; } }
    { unsigned* dl = (unsigned*)(F.ws + WS_DL);
      for (int i = gt; i < 1024 * 1024; i += NGT) { const int k = i >> 10, c4 = (i & 1023) * 4; unsigned w = 0;
#pragma unroll
          for (int q = 0; q < 4; ++q) { const int c = c4 + q, l = c & 2047; const float ang = TWO_PI * (float)((k * l) & 2047) * (1.f / 2048.f); w |= f2f8(c < 2048 ? __cosf(ang) : __sinf(ang)) << (8 * q); }
          dl[i] = w; } }
    { unsigned* dl = (unsigned*)(F.ws + WS_DLC);
      for (int i = gt; i < 256 * 128; i += NGT) { const int k = i >> 7, c4 = (i & 127) * 4; unsigned w = 0;
#pragma unroll
          for (int q = 0; q < 4; ++q) { const int c = c4 + q, l = c & 255; const float ang = TWO_PI * (float)((k * l) & 255) * (1.f / 256.f); w |= f2f8(c < 256 ? __cosf(ang) : __sinf(ang)) << (8 * q); }
          dl[i] = w; } }
}
__device__ __forceinline__ void mod_full(Frame& F, const Args& a) {
    F.refresh();
    if (F.blk >= 192) return;
    const int l = F.blk / 48, cb = F.blk % 48; const int col = F.tid & 127, ks = F.tid >> 7; const int n = cb * 128 + col;
    LAS float* s = (LAS float*)F.lds;
    float acc[33];
#pragma unroll
    for (int r = 0; r < 33; ++r) acc[r] = 0.f;
    for (int half = 0; half < 2; ++half) {
        __syncthreads();
        for (int i = F.tid; i < 512 * 33; i += NTHR) { const int k = i / 33, r = i % 33; const float c = (r < 32) ? a.in[1][(size_t)r * 1024 + half * 512 + k] : a.in[3][half * 512 + k]; s[k * 36 + r] = c / (1.f + __expf(-c)); }
        __syncthreads();
        const GAS float* w = (const GAS float*)a.in[4] + ((size_t)l * 1024 + half * 512 + ks * 128) * 6144 + n;
#pragma unroll 1
        for (int kb = 0; kb < 128; kb += 16) { float wv[16];
#pragma unroll
            for (int q = 0; q < 16; ++q) wv[q] = w[(size_t)(kb + q) * 6144];
#pragma unroll
            for (int q = 0; q < 16; ++q) { const LAS float* sr = s + (ks * 128 + kb + q) * 36;
#pragma unroll
                for (int r = 0; r < 33; ++r) acc[r] += sr[r] * wv[q];
                asm volatile("" ::: "memory"); } }
    }
    __syncthreads();
    LAS float* red = (LAS float*)F.lds;
#pragma unroll
    for (int r = 0; r < 33; ++r) red[(ks * 33 + r) * 128 + col] = acc[r];
    __syncthreads();
    float* mod = (float*)(F.ws + WS_MOD);
    for (int i = F.tid; i < 33 * 128; i += NTHR) { const int r = i >> 7, c = i & 127; const int nn = cb * 128 + c;
        mod[((size_t)l * 33 + r) * 6144 + nn] = a.in[5][l * 6144 + nn] + (red[(0 * 33 + r) * 128 + c] + red[(1 * 33 + r) * 128 + c]) + (red[(2 * 33 + r) * 128 + c] + red[(3 * 33 + r) * 128 + c]); }
    __syncthreads();
}
__device__ __forceinline__ void rows_init(Frame& F, const Args& a) {
    F.refresh();
    bf16_t* XS = (bf16_t*)(F.ws + WS_XS);
    static_assert(TT % (4 * NGW) == 0, "rows_init: four rows per wave and iteration");
    for (int r0 = F.gw; r0 < TT; r0 += 4 * NGW) {
        Row r[4];
#pragma unroll
        for (int t = 0; t < 4; ++t) { const int row = r0 + t * NGW; row_load_f32(r[t], row < T ? a.in[0] + (size_t)row * D : a.in[2] + (size_t)(row - T) * D, F.lane); }
#pragma unroll
        for (int t = 0; t < 4; ++t) { const int row = r0 + t * NGW; const int mr = mod_row(row);
            row_store_bf16(r[t], XS + (size_t)row * D, F.lane);
            row_modulate(r[t], mod_vec(F.ws, 0, mr, 0), mod_vec(F.ws, 0, mr, 1), F.lane);
            row_store_fp8(r[t], (unsigned char*)a.out + OUT_U8 + (size_t)row * D, F.lane);
            asm volatile("" ::: "memory"); } }
}
__device__ __forceinline__ void rows_post1(Frame& F, const Args& a, int layer, int nrows) {
    F.refresh();
    bf16_t* XS = (bf16_t*)(F.ws + WS_XS); const unsigned char* Y8 = (const unsigned char*)a.out;
    const float* lg = a.in[6] + (size_t)(layer * 2 + 0) * D; const float* lb = a.in[7] + (size_t)(layer * 2 + 0) * D;
    const int TPB = nrows / GRID;
    for (int rl = F.wave; rl < TPB; rl += 4 * NWAVES) {
        u32x4 xr[4][2], yr[4];
#pragma unroll
        for (int t = 0; t < 4; ++t) { const int row = F.blk * TPB + rl + t * NWAVES;
#pragma unroll
            for (int j = 0; j < 2; ++j) xr[t][j] = ((const GAS u32x4*)(XS + (size_t)row * D))[vb(j, F.lane)];
            yr[t] = ((const GAS u32x4*)(Y8 + (size_t)row * D))[F.lane]; }
#pragma unroll
        for (int t = 0; t < 4; ++t) { const int row = F.blk * TPB + rl + t * NWAVES; const int mr = mod_row(row);
            Row x, y;
#pragma unroll
            for (int j = 0; j < 2; ++j) { const u32x4 w = xr[t][j];
                x.v[2 * j] = (f32x4){bflo(w.x), bfhi(w.x), bflo(w.y), bfhi(w.y)}; x.v[2 * j + 1] = (f32x4){bflo(w.z), bfhi(w.z), bflo(w.w), bfhi(w.w)}; }
#pragma unroll
            for (int q = 0; q < 4; ++q) { const f32x2v lo = __builtin_amdgcn_cvt_pk_f32_fp8((int)yr[t][q], false), hi = __builtin_amdgcn_cvt_pk_f32_fp8((int)yr[t][q], true); y.v[q] = (f32x4){lo[0], lo[1], hi[0], hi[1]}; }
            const float* g1 = mod_vec(F.ws, layer, mr, 2);
#pragma unroll
            for (int j = 0; j < 4; ++j) x.v[j] = x.v[j] * ALPHA + (((const GAS f32x4*)g1)[vq(j, F.lane)] * (1.f / YSC)) * y.v[j];
            row_normalize(x, LN_EPS);
#pragma unroll
            for (int j = 0; j < 4; ++j) x.v[j] = x.v[j] * ((const GAS f32x4*)lg)[vq(j, F.lane)] + ((const GAS f32x4*)lb)[vq(j, F.lane)];
            row_store_bf16(x, XS + (size_t)row * D, F.lane);
            float mean, rstd; row_normalize_stats(x, MOD_EPS, mean, rstd);
            if (F.lane == 0) { f32x2v st = {mean, rstd}; *(GAS f32x2v*)(F.ws + WS_RSTAT + (size_t)row * 8) = st; }
            { const float* sh = mod_vec(F.ws, layer, mr, 3); const float* sc = mod_vec(F.ws, layer, mr, 4);
#pragma unroll
              for (int j = 0; j < 4; ++j) { const f32x4 av = ((const GAS f32x4*)sc)[vq(j, F.lane)], bv = ((const GAS f32x4*)sh)[vq(j, F.lane)]; x.v[j] = x.v[j] * (av + 1.f) + bv; } }
            row_store_fp8(x, (unsigned char*)a.out + OUT_U8 + (size_t)row * D, F.lane);
            asm volatile("" ::: "memory"); }
    }
}
__device__ __forceinline__ void rows_post2(Frame& F, const Args& a, int layer, int t0, int n) {
    F.refresh();
    bf16_t* XS = (bf16_t*)(F.ws + WS_XS); const unsigned char* YB = (const unsigned char*)(F.ws + WS_YB); const unsigned char* YS = (const unsigned char*)(F.ws + WS_YS);
    const int* spos = (const int*)(F.ws + WS_SDST); const float* tkw = (const float*)(F.ws + WS_TKW);
    const float* lg = a.in[6] + (size_t)(layer * 2 + 1) * D; const float* lb = a.in[7] + (size_t)(layer * 2 + 1) * D;
    for (int i0 = F.gw; i0 < n; i0 += 2 * NGW) {
        const int i1 = i0 + NGW; const bool two = i1 < n;
        int pj[2]; float wj[2];
#pragma unroll
        for (int t = 0; t < 2; ++t) { pj[t] = 0; wj[t] = 0.f; const int row = t0 + (t ? i1 : i0); if ((t == 0 || two) && F.lane < 8) { pj[t] = ((const GAS int*)spos)[(size_t)row * 8 + F.lane]; wj[t] = ((const GAS float*)tkw)[(size_t)row * 8 + F.lane]; } }
        Row x[2], y[2];
#pragma unroll
        for (int t = 0; t < 2; ++t) { const int i = t ? i1 : i0; if (t == 0 || two) { row_load_bf16(x[t], XS + (size_t)(t0 + i) * D, F.lane); row_load_fp8(y[t], YS + (size_t)i * D, F.lane); } }
        u32x4 zr[2][8];
#pragma unroll
        for (int t = 0; t < 2; ++t) if (t == 0 || two) {
#pragma unroll
            for (int s = 0; s < 8; ++s) { const int ps = __builtin_amdgcn_readlane(pj[t], s); zr[t][s] = ((const GAS u32x4*)(YB + (size_t)ps * D))[F.lane]; } }
#pragma unroll
        for (int t = 0; t < 2; ++t) if (t == 0 || two) { const int i = t ? i1 : i0; const int row = t0 + i; const int mr = mod_row(row);
#pragma unroll
            for (int j = 0; j < 4; ++j) y[t].v[j] = y[t].v[j] * (1.f / 16.f);
#pragma unroll
            for (int s = 0; s < 8; ++s) { const float wz = __builtin_bit_cast(float, __builtin_amdgcn_readlane(__builtin_bit_cast(int, wj[t]), s)) * (1.f / 16.f);
#pragma unroll
                for (int j = 0; j < 4; ++j) { const f32x2v lo = __builtin_amdgcn_cvt_pk_f32_fp8((int)zr[t][s][j], false), hi = __builtin_amdgcn_cvt_pk_f32_fp8((int)zr[t][s][j], true); y[t].v[j] += (f32x4){lo[0], lo[1], hi[0], hi[1]} * wz; } }
            const float* g2 = mod_vec(F.ws, layer, mr, 5);
#pragma unroll
            for (int j = 0; j < 4; ++j) x[t].v[j] = x[t].v[j] * ALPHA + ((const GAS f32x4*)g2)[vq(j, F.lane)] * y[t].v[j];
            row_normalize(x[t], LN_EPS);
#pragma unroll
            for (int j = 0; j < 4; ++j) x[t].v[j] = x[t].v[j] * ((const GAS f32x4*)lg)[vq(j, F.lane)] + ((const GAS f32x4*)lb)[vq(j, F.lane)];
            if (layer == 3) { row_store_f32(x[t], a.out + (size_t)row * D, F.lane); }
            else { row_store_bf16(x[t], XS + (size_t)row * D, F.lane);
                row_modulate(x[t], mod_vec(F.ws, layer + 1, mr, 0), mod_vec(F.ws, layer + 1, mr, 1), F.lane);
                row_store_fp8(x[t], (unsigned char*)a.out + OUT_U8 + (size_t)row * D, F.lane); } }
    }
}
__device__ __forceinline__ float wave_max_dpp(float v) {
    int x = __builtin_bit_cast(int, v);
#define DPPMAX(ctrl) { const int y = __builtin_amdgcn_update_dpp(x, x, ctrl, 0xf, 0xf, false); x = __builtin_bit_cast(int, fmaxf(__builtin_bit_cast(float, x), __builtin_bit_cast(float, y))); }
    DPPMAX(0xB1) DPPMAX(0x4E) DPPMAX(0x141) DPPMAX(0x140)
#undef DPPMAX
    const float r0 = __builtin_bit_cast(float, __builtin_amdgcn_readlane(x, 0)), r1 = __builtin_bit_cast(float, __builtin_amdgcn_readlane(x, 16));
    const float r2 = __builtin_bit_cast(float, __builtin_amdgcn_readlane(x, 32)), r3 = __builtin_bit_cast(float, __builtin_amdgcn_readlane(x, 48));
    return fmaxf(fmaxf(r0, r1), fmaxf(r2, r3));
}
__device__ __forceinline__ void route_tokens(Frame& F, const Args& a, int layer, int ntok) {
    F.refresh();
    const int TPB = ntok / GRID;
    const bf16_t* U = (const bf16_t*)(F.ws + WS_XS); const bf16_t* Wr = (const bf16_t*)(F.ws + WS_WR) + (size_t)layer * 64 * 1024;
    int* tke = (int*)(F.ws + WS_TKE); float* tkw = (float*)(F.ws + WS_TKW);
    LAS int* lcnt = (LAS int*)(F.lds + L_LCNT);
    LAS float* lg = (LAS float*)(F.lds);
    if (F.tid < 64) lcnt[F.tid] = 0;
    const int lane = F.lane, fr = lane & 15, fq = lane >> 4;
    const int ntile = TPB / 16;
    constexpr int WPITCH = 1040; constexpr int L_SE = 122880;
    LAS float* sEb = (LAS float*)(F.lds + L_SE);
    f32x4 acc[3][4];
#pragma unroll
    for (int i = 0; i < 3; ++i)
#pragma unroll
        for (int n = 0; n < 4; ++n) acc[i][n] = (f32x4){0.f, 0.f, 0.f, 0.f};
    int grp_of[3] = {0, 0, 0};
    int tl_lo = 0, g = 0;
    while (tl_lo < ntile) {
        const int mr = mod_row(F.blk * TPB + tl_lo * 16); int tl_hi = tl_lo + 1;
        while (tl_hi < ntile && mod_row(F.blk * TPB + tl_hi * 16) == mr) ++tl_hi;
        const float* shv = mod_vec(F.ws, layer, mr, 3); const float* scv = mod_vec(F.ws, layer, mr, 4);
        for (int half = 0; half < 2; ++half) {
            __syncthreads();
            { const int kc = lane, k = half * 512 + kc * 8;
              const f32x4 c0 = *(const GAS f32x4*)(scv + k) + 1.f, c1 = *(const GAS f32x4*)(scv + k + 4) + 1.f, h0 = *(const GAS f32x4*)(shv + k), h1 = *(const GAS f32x4*)(shv + k + 4);
              u32x4 wv[8];
#pragma unroll
              for (int j = 0; j < 8; ++j) wv[j] = *(const GAS u32x4*)(Wr + (size_t)(F.wave + 8 * j) * D + k);
#pragma unroll
              for (int j = 0; j < 8; ++j) { const int e = F.wave + 8 * j; const u32x4 w = wv[j];
                const float w0 = bflo(w.x), w1 = bfhi(w.x), w2 = bflo(w.y), w3 = bfhi(w.y), w4 = bflo(w.z), w5 = bfhi(w.z), w6 = bflo(w.w), w7 = bfhi(w.w);
                u32x4 o; o.x = cvt_pk_bf16(w0 * c0[0], w1 * c0[1]); o.y = cvt_pk_bf16(w2 * c0[2], w3 * c0[3]); o.z = cvt_pk_bf16(w4 * c1[0], w5 * c1[1]); o.w = cvt_pk_bf16(w6 * c1[2], w7 * c1[3]);
                *(LAS u32x4*)(F.lds + e * WPITCH + kc * 16) = o;
                const float se = wave_sum(((bflo(o.x) + bfhi(o.x)) + (bflo(o.y) + bfhi(o.y))) + ((bflo(o.z) + bfhi(o.z)) + (bflo(o.w) + bfhi(o.w))));
                const float be = wave_sum(((w0 * h0[0] + w1 * h0[1]) + (w2 * h0[2] + w3 * h0[3])) + ((w4 * h1[0] + w5 * h1[1]) + (w6 * h1[2] + w7 * h1[3])));
                if (lane == 0) { if (half == 0) { sEb[g * 64 + e] = se; sEb[192 + g * 64 + e] = be; } else { sEb[g * 64 + e] += se; sEb[192 + g * 64 + e] += be; } }
                asm volatile("" ::: "memory"); } }
            __syncthreads();
#pragma unroll
            for (int i = 0; i < 3; ++i) { const int tl = F.wave + 8 * i;
                if (tl >= tl_lo && tl < tl_hi) { const int t0 = F.blk * TPB + tl * 16;
                    const GAS bf16x8* ap = (const GAS bf16x8*)(U + (size_t)(t0 + fr) * D + half * 512 + fq * 8);
                    bf16x8 av[16];
#pragma unroll
                    for (int ks = 0; ks < 16; ++ks) av[ks] = ap[ks * 4];
#pragma unroll
                    for (int ks = 0; ks < 16; ++ks) {
#pragma unroll
                        for (int n = 0; n < 4; ++n) { const bf16x8 bv = *(const LAS bf16x8*)(F.lds + (n * 16 + fr) * WPITCH + (ks * 32 + fq * 8) * 2); acc[i][n] = __builtin_amdgcn_mfma_f32_16x16x32_bf16(av[ks], bv, acc[i][n], 0, 0, 0); }
                        if ((ks & 1) == 1) __builtin_amdgcn_sched_barrier(0); }
                    grp_of[i] = g; } }
        }
        tl_lo = tl_hi; ++g;
    }
    __syncthreads();
#pragma unroll
    for (int i = 0; i < 3; ++i) { const int tl = F.wave + 8 * i;
        if (tl < ntile) { const int t0 = F.blk * TPB + tl * 16; const int gi = grp_of[i];
#pragma unroll
            for (int j = 0; j < 4; ++j) { const f32x2v st = *(const GAS f32x2v*)(F.ws + WS_RSTAT + (size_t)(t0 + fq * 4 + j) * 8);
#pragma unroll
                for (int n = 0; n < 4; ++n) { const float se = sEb[gi * 64 + n * 16 + fr], be = sEb[192 + gi * 64 + n * 16 + fr];
                    lg[(tl * 16 + fq * 4 + j) * 65 + n * 16 + fr] = st[1] * (acc[i][n][j] - st[0] * se) + be; } } } }
    __syncthreads();
    if (F.tid < TPB) {
        const int tok = F.blk * TPB + F.tid; const LAS float* row = lg + F.tid * 65; const float* bias = a.in[13] + layer * 64;
        float sg[64], sel[64];
#pragma unroll
        for (int e = 0; e < 64; ++e) { sg[e] = 1.f / (1.f + __expf(-row[e])); sel[e] = sg[e] + bias[e]; }
        float gs[8];
#pragma unroll
        for (int g = 0; g < 8; ++g) { float m1 = -INFINITY, m2 = -INFINITY;
#pragma unroll
            for (int j = 0; j < 8; ++j) { const float v = sel[g * 8 + j]; const bool gt1 = v > m1; m2 = gt1 ? m1 : fmaxf(m2, v); m1 = gt1 ? v : m1; }
            gs[g] = m1 + m2; }
        unsigned gok = 0;
#pragma unroll
        for (int g = 0; g < 8; ++g) { int rk = 0;
#pragma unroll
            for (int h = 0; h < 8; ++h) rk += (gs[h] > gs[g] || (gs[h] == gs[g] && h < g)) ? 1 : 0;
            gok |= (rk < 4 ? 1u : 0u) << g; }
#pragma unroll
        for (int e = 0; e < 64; ++e) sel[e] = ((gok >> (e >> 3)) & 1u) ? sel[e] : -INFINITY;
        int ce[8]; float cw[8]; float tot = 0.f;
#pragma unroll
        for (int it = 0; it < 8; ++it) { float best = -INFINITY, bs = 0.f; int bi = 0;
#pragma unroll
            for (int e = 0; e < 64; ++e) { const bool b = sel[e] > best; best = b ? sel[e] : best; bs = b ? sg[e] : bs; bi = b ? e : bi; }
#pragma unroll
            for (int e = 0; e < 64; ++e) sel[e] = (e == bi) ? -INFINITY : sel[e];
            ce[it] = bi; cw[it] = bs; tot += bs; }
        const float sc = 2.5f / tot;
#pragma unroll
        for (int it = 0; it < 8; ++it) { tke[(size_t)tok * 8 + it] = ce[it]; tkw[(size_t)tok * 8 + it] = cw[it] * sc; __hip_atomic_fetch_add(&lcnt[ce[it]], 1, __ATOMIC_RELAXED, __HIP_MEMORY_SCOPE_WORKGROUP); }
    }
    __syncthreads();
    if (F.tid < 64) F.ctl[CW_BCNT + F.blk * 64 + F.tid] = (unsigned)lcnt[F.tid];
}
__device__ __forceinline__ void build_lists(Frame& F, int ntok) {
    F.refresh();
    constexpr int NSEG = NCHUNK * 64, BPC = GRID / NCHUNK;
    const int TPB = ntok / GRID, CH = ntok / NCHUNK;
    LAS int* tstart = (LAS int*)(F.lds + L_TSTART); LAS int* pref = (LAS int*)(F.lds + L_PREF); LAS int* lcnt = (LAS int*)(F.lds + L_LCNT);
    LAS unsigned char* tseg = (LAS unsigned char*)(F.lds + L_TSEG); LAS int* scan = (LAS int*)(F.lds + L_SCAN);
    const unsigned* bcnt = F.ctl + CW_BCNT;
    const int myc = F.blk / BPC, mylb = F.blk % BPC;
    int nseg = 0;
    LAS int* cntl = (LAS int*)F.lds;
    for (int i = F.tid; i < GRID * 64; i += NTHR) cntl[i] = (int)((const GAS unsigned*)bcnt)[i];
    if (F.tid < 64) lcnt[F.tid] = 0;
    __syncthreads();
    static_assert(NSEG == 64 && NTHR == 512, "build_lists: one chunk, eight partial sums per expert");
    LAS int* part = (LAS int*)(F.lds + 65536);
    { const int e = F.tid & 63, q = F.tid >> 6; int n = 0, p = 0;
#pragma unroll 8
      for (int lb = q * 32; lb < q * 32 + 32; ++lb) { const int v = cntl[lb * 64 + e]; if (lb < mylb) p += v; n += v; }
      part[q * 64 + e] = n; part[512 + q * 64 + e] = p; }
    __syncthreads();
    if (F.tid < 64) { int n = 0, p = 0;
#pragma unroll
        for (int q = 0; q < 8; ++q) { n += part[q * 64 + F.tid]; p += part[512 + q * 64 + F.tid]; }
        nseg = n; pref[F.tid] = p;
        const int tiles = (n + 255) >> 8; int incl = tiles;
#pragma unroll
        for (int d = 1; d < 64; d <<= 1) { const int o = __shfl_up(incl, d); if (F.lane >= d) incl += o; }
        tstart[F.tid + 1] = incl; if (F.tid == 0) tstart[0] = 0;
        for (int t = incl - tiles; t < incl; ++t) tseg[t] = (unsigned char)F.tid; }
    int* stok = (int*)(F.ws + WS_STOK); int* spos = (int*)(F.ws + WS_SDST);
    const int* tke = (const int*)(F.ws + WS_TKE);
    { const int sseg = myc * 64 + mylb; if (mylb < 64 && F.tid == sseg) scan[0] = nseg; }
    __syncthreads();
    if (mylb < 64) { const int sseg = myc * 64 + mylb; const int n = scan[0]; const int base = tstart[sseg] * 256, end = tstart[sseg + 1] * 256;
      for (int p = base + n + F.tid; p < end; p += NTHR) stok[p] = myc * CH; }
    for (int tb = F.wave * 8; tb < TPB; tb += NWAVES * 8) { const int tl = tb + (F.lane >> 3);
        if (tl < TPB) { const int tok = F.blk * TPB + tl; const int e = tke[(size_t)tok * 8 + (F.lane & 7)];
            const int p = tstart[myc * 64 + e] * 256 + pref[e] + __hip_atomic_fetch_add(&lcnt[e], 1, __ATOMIC_RELAXED, __HIP_MEMORY_SCOPE_WORKGROUP);
            stok[p] = tok; spos[(size_t)tok * 8 + (F.lane & 7)] = p - tstart[myc * 64] * 256; } }
    __syncthreads();
}

struct SchedQKV {
    const char* U; const char* W; int nfull, nu, c;
    __device__ __forceinline__ bool next(int i, pg::Unit& u) const {
        const int L0 = i * GRID + c; if (L0 >= nu) return false;
        int pm, pn;
        if (L0 < nfull) { const int L = pg::xcd_remap(L0, nfull); const int gid = L / 48, w = L % 48; pm = gid * 8 + (w & 7); pn = w >> 3; }
        else { const int q = L0 - nfull; pm = 256 + (q >> 1); pn = 4 + (q & 1); }
        u.A = U + (size_t)pm * 256 * 1024; u.B = W + (size_t)pn * 256 * 1024; u.gidx = nullptr; u.gbase = 0; u.nt = 8; u.out = nullptr; u.ldc = 0; u.scale = 1.f; u.flags = 0; u.i0 = pm; u.i1 = pn;
        return true; }
};
struct SchedDense {
    const char* A; const char* W; char* out; int nrt, nct, nt, c; size_t ldA;
    __device__ __forceinline__ bool next(int i, pg::Unit& u) const {
        const int nu = nrt * nct; const int L0 = i * GRID + c; if (L0 >= nu) return false;
        const int L = pg::xcd_remap(L0, nu); const int per = 8 * nct, gid = L / per, w = L % per, fm = gid * 8, gsz = (nrt - fm) < 8 ? (nrt - fm) : 8; const int pm = fm + (w % gsz), pn = w / gsz;
        u.A = A + (size_t)pm * 256 * ldA; u.B = W + (size_t)pn * 256 * ldA; u.gidx = nullptr; u.gbase = 0; u.nt = nt; u.out = out + (size_t)pm * 256 * 1024; u.ldc = 1024; u.scale = 1.f; u.flags = 0; u.i0 = pm; u.i1 = pn;
        return true; }
};
struct SchedF1 {
    const char* CS; const char* U; char* ABT; char* ABTC; int nu, c;
    __device__ __forceinline__ bool next(int i, pg::Unit& u) const {
        const int L0 = i * GRID + c; if (L0 >= nu) return false;
        u.gidx = nullptr; u.gbase = 0; u.nt = 2; u.scale = 1.f; u.flags = 0; u.i0 = 0; u.i1 = 0;
        if (L0 < 2048) { const int L = pg::xcd_remap(L0, 2048); const int pm = L & 1, pn = (L >> 1) & 7, bg = L >> 4, b = bg >> 2, g = bg & 3;
            u.A = CS + (size_t)pm * 256 * 256; u.B = U + ((size_t)b * SEQ + pn * 256) * 1024 + g * 256; u.out = ABT + (size_t)bg * 256 * 4096 + (size_t)(pm * 2048 + pn * 256); u.ldc = 4096; }
        else { const int q = L0 - 2048; const int pm = q & 1, bg = q >> 1, b = bg >> 2, g = bg & 3;
            u.A = CS + (size_t)pm * 256 * 256; u.B = U + ((size_t)T + b * CTXL) * 1024 + g * 256; u.out = ABTC + (size_t)bg * 256 * 512 + (size_t)pm * 256; u.ldc = 512; }
        return true; }
};
struct SchedF2 {
    const char* DL; const char* ABT; char* FH; int c;
    __device__ __forceinline__ bool next(int i, pg::Unit& u) const {
        const int L0 = i * GRID + c; if (L0 >= 512) return false;
        const int L = pg::xcd_remap(L0, 512); const int pm = L & 3, bg = L >> 2, b = bg >> 2, g = bg & 3;
        u.A = DL + (size_t)pm * 256 * 4096; u.B = ABT + (size_t)bg * 256 * 4096; u.gidx = nullptr; u.gbase = 0; u.nt = 32; u.out = FH + ((size_t)b * 1024 + pm * 256) * 1024 + g * 256; u.ldc = 1024; u.scale = 0.001381067932004975f  ; u.flags = 0; u.i0 = 0; u.i1 = 0;
        return true; }
};
struct SchedF2c {
    const char* DLC; const char* ABTC; char* FC; int c;
    __device__ __forceinline__ bool next(int i, pg::Unit& u) const {
        const int L0 = i * GRID + c; if (L0 >= 128) return false;
        const int bg = L0, b = bg >> 2, g = bg & 3;
        u.A = DLC; u.B = ABTC + (size_t)bg * 256 * 512; u.gidx = nullptr; u.gbase = 0; u.nt = 4; u.out = FC + ((size_t)b * 256) * 1024 + g * 256; u.ldc = 1024; u.scale = 1.f / 256.f; u.flags = 0; u.i0 = 0; u.i1 = 0;
        return true; }
};
struct SchedF3 {
    const char* FH; const char* FC; const char* W; char* Y; int nu, c;
    __device__ __forceinline__ bool next(int i, pg::Unit& u) const {
        const int L0 = i * GRID + c; if (L0 >= nu) return false;
        u.gidx = nullptr; u.gbase = 0; u.nt = 8; u.scale = 1.f; u.flags = 0; u.i0 = 0; u.i1 = 0;
        if (L0 < 1024) { const int L = pg::xcd_remap(L0, 1024); const int gid = L >> 6, w = L & 63, pm = gid * 8 + (w & 7), pn = w >> 3; const int b = pm >> 2, k0 = (pm & 3) * 256;
            u.A = FH + (size_t)pm * 256 * 1024; u.B = W + (size_t)pn * 256 * 1024;
            if (pn < 4) { u.out = Y + ((size_t)b * SEQ + k0) * 1024; u.ldc = 1024; u.i1 = pn; }
            else { u.out = Y + ((size_t)b * SEQ + SEQ - k0) * 1024; u.ldc = -1024; u.i1 = pn - 4; u.flags = (k0 == 0) ? 1 : 0; } }
        else { const int q = L0 - 1024; const int pm = q >> 2, pn = q & 3;
            u.A = FC + (size_t)pm * 256 * 1024; u.B = W + (size_t)pn * 256 * 1024; u.out = Y + ((size_t)T + pm * 256) * 1024; u.ldc = 1024; u.i1 = pn; }
        return true; }
};
struct SchedG1 {
    const char* EGU; const int* STOK; char* H; char* HS; LAS const unsigned char* tseg; int ntl, nsh, c;
    __device__ __forceinline__ bool gsrc(int i, const int*& gidx, int& gbase) const {
        const int nu = (ntl + nsh) * 2; const int L0 = i * GRID + c; if (L0 >= nu) return false;
        const int pm = pg::xcd_remap(L0, nu) >> 1;
        if (pm < ntl) { gidx = STOK + (size_t)pm * 256; gbase = 0; } else { gidx = nullptr; gbase = (pm - ntl) * 256; }
        return true; }
    __device__ __forceinline__ bool next(int i, pg::Unit& u) const {
        const int nu = (ntl + nsh) * 2; const int L0 = i * GRID + c; if (L0 >= nu) return false;
        const int L = pg::xcd_remap(L0, nu); const int pm = L >> 1, pn = L & 1;
        u.A = nullptr; u.gbase = 0; u.nt = 8; u.ldc = 256; u.scale = 1.f; u.flags = 0; u.i0 = 0; u.i1 = 0;
        if (pm < ntl) { const int e = __builtin_amdgcn_readfirstlane((int)tseg[pm]) & 63;
            u.gidx = STOK + (size_t)pm * 256; u.B = EGU + (size_t)e * 512 * 1024 + (size_t)pn * 256 * 1024; u.out = H + (size_t)pm * 256 * 256 + pn * 128; }
        else { const int ps = pm - ntl; u.gidx = nullptr; u.gbase = ps * 256; u.B = EGU + (size_t)NE * 512 * 1024 + (size_t)pn * 256 * 1024; u.out = HS + (size_t)ps * 256 * 256 + pn * 128; }
        return true; }
};
struct SchedG2 {
    const char* ED; const char* H; const char* HS; char* YB; char* YS; LAS const unsigned char* tseg; int t0, t1, nsh, ch, CH, c;
    __device__ __forceinline__ bool next(int i, pg::Unit& u) const {
        const int nr = t1 - t0; const int nu = (nr + nsh) * 4; const int L0 = i * GRID + c; if (L0 >= nu) return false;
        const int L = pg::xcd_remap(L0, nu); const int q = L >> 2, pn = L & 3;
        u.gidx = nullptr; u.gbase = 0; u.nt = 2; u.ldc = 1024; u.scale = 1.f; u.flags = 0; u.i0 = 0; u.i1 = pn;
        if (q < nr) { const int pm = t0 + q; const int e = __builtin_amdgcn_readfirstlane((int)tseg[pm]) & 63;
            u.A = H + (size_t)pm * 256 * 256; u.B = ED + (size_t)e * 1024 * 256 + (size_t)pn * 256 * 256; u.out = YB + (size_t)q * 256 * 1024; }
        else { const int ps = q - nr; u.A = HS + ((size_t)ch * CH + ps * 256) * 256; u.B = ED + (size_t)NE * 1024 * 256 + (size_t)pn * 256 * 256; u.out = YS + (size_t)ps * 256 * 1024; }
        return true; }
};

__device__ __forceinline__ void fnet_nyquist_rows(Frame& F) {
    F.refresh();
    const unsigned char* ABT = F.ws + WS_ABT; bf16_t* FH1 = (bf16_t*)(F.ws + WS_FH1);
    static_assert((128 * 256) % (4 * NGW) == 0, "fnet_nyquist_rows: four rows per wave and step");
    for (int r0 = F.gw; r0 < 128 * 256; r0 += 4 * NGW) {
        u32x4 w[4][2];
#pragma unroll
        for (int t = 0; t < 4; ++t) { const GAS u32x4* p = (const GAS u32x4*)(ABT + (size_t)(r0 + t * NGW) * 4096);
#pragma unroll
            for (int i = 0; i < 2; ++i) w[t][i] = p[i * 64 + F.lane]; }
#pragma unroll
        for (int t = 0; t < 4; ++t) { const int r = r0 + t * NGW; const int bg = r >> 8, m = r & 255, b = bg >> 2, g = bg & 3; float s = 0.f;
#pragma unroll
            for (int i = 0; i < 2; ++i)
#pragma unroll
                for (int q = 0; q < 4; ++q) { const f32x2v lo = __builtin_amdgcn_cvt_pk_f32_fp8((int)w[t][i][q], false), hi = __builtin_amdgcn_cvt_pk_f32_fp8((int)w[t][i][q], true); s += (lo[0] - lo[1]) + (hi[0] - hi[1]); }
            s = wave_sum(s) * 0.001381067932004975f;
            if (F.lane == 0) FH1[(size_t)b * 1024 + g * 256 + m] = (bf16_t)f2bf(s); } }
}
__device__ __forceinline__ void fnet_nyquist_out(Frame& F, const Args& a, int jl) {
    F.refresh();
    const bf16_t* FH1 = (const bf16_t*)(F.ws + WS_FH1); const bf16_t* W = (const bf16_t*)(F.ws + WS_WF) + (size_t)jl * 2048 * 1024; unsigned char* Y = (unsigned char*)a.out;
    LAS float* part = (LAS float*)F.lds;
    const int b = F.blk >> 3, n = (F.blk & 7) * 128 + (F.tid & 127), kq = F.tid >> 7;
    const GAS u32x4* wp = (const GAS u32x4*)(W + (size_t)n * 1024 + kq * 256); const GAS u32x4* fp = (const GAS u32x4*)(FH1 + (size_t)b * 1024 + kq * 256);
    float s = 0.f;
#pragma unroll 4
    for (int i = 0; i < 32; ++i) { const u32x4 w = wp[i], f = fp[i];
        s += bflo(w.x) * bflo(f.x) + bfhi(w.x) * bfhi(f.x) + bflo(w.y) * bflo(f.y) + bfhi(w.y) * bfhi(f.y) + bflo(w.z) * bflo(f.z) + bfhi(w.z) * bfhi(f.z) + bflo(w.w) * bflo(f.w) + bfhi(w.w) * bfhi(f.w); }
    part[F.tid] = s;
    __syncthreads();
    if (F.tid < 128) { const float t = (part[F.tid] + part[F.tid + 128]) + (part[F.tid + 256] + part[F.tid + 384]); const int cc = n & 127;
        Y[((size_t)b * SEQ + 1024) * D + (16 * (n >> 8) + (cc >> 3)) * 16 + 8 * ((n >> 7) & 1) + (cc & 7)] = (unsigned char)f2f8(__builtin_amdgcn_fmed3f(t * YSC, -448.f, 448.f)); }
    __syncthreads();
}


#ifdef SELFCHECK
constexpr int CW_ERR = 1024;
__device__ __forceinline__ void chk_report(unsigned* ctl, int id, float got, float ref, float tabs, float trel) {
    float e = fabsf(got - ref) / (tabs + trel * fabsf(ref)); if (!(e == e)) e = 1e30f; atomicMax(ctl + CW_ERR + id, __float_as_uint(e)); }
__device__ __forceinline__ float bf2f(bf16_t b) { return __builtin_bit_cast(float, (unsigned)b << 16); }
__constant__ int chk_toks[16] = {0, 1, 63, 64, 65, 127, 2047, 2048, 2049, 4096, 33000, 65535, 65536, 65537, 70000, 73727};
__constant__ int chk_ks[8] = {0, 1, 2, 255, 256, 1023, 1024, 700};
__constant__ int chk_ms[4] = {0, 1, 128, 255};
__constant__ int chk_ytoks[10] = {0, 1, 1023, 1024, 1025, 2047, 2048, 65535, 65536, 73727};
__constant__ int chk_ns[5] = {0, 1, 255, 256, 1023};
__constant__ int chk_cols[20] = {0, 7, 15, 16, 31, 32, 40, 48, 63, 64, 500, 1023, 1024, 1039, 1040, 1072, 1279, 1280, 1300, 1535};
__device__ __forceinline__ void chk_qkv(Frame& F, const Args& a, int layer, int id) {
    F.refresh(); const unsigned char* U = (const unsigned char*)a.out + OUT_U8; const float* W = a.in[8] + (size_t)(layer >> 1) * 1024 * 1536;
    const bf16_t* Qb = (const bf16_t*)(F.ws + WS_Q); const bf16_t* Kb = (const bf16_t*)(F.ws + WS_K); const bf16_t* Vb = (const bf16_t*)(F.ws + WS_V);
    for (int s = F.gw; s < 320; s += NGW) { const int tok = chk_toks[s & 15], col = chk_cols[s >> 4];
        if (layer == 2 && tok >= T && col < 1024) continue;
        const bool rope = (tok < T) && col < 1280; const int hc = col & 63, first = (hc & 31) < 16; const int pcol = rope ? (first ? col + 16 : col - 16) : col;
        float x = 0.f, xp = 0.f;
        for (int k = F.lane; k < 1024; k += 64) { const float u = f82f(U[(size_t)tok * D + k]); x += u * W[(size_t)k * 1536 + col]; xp += u * W[(size_t)k * 1536 + pcol]; }
        x = wave_sum(x); xp = wave_sum(xp);
        float ref = x;
        if (rope) { const int tl = tok & 2047, part = hc >> 5, pos = part ? (tl & 63) : (tl >> 6), fi = hc & 15; const float ang = (float)pos * powf(10000.f, -(float)fi / 16.f);
            ref = x * cosf(ang) + (first ? -xp : xp) * sinf(ang); }
        if (col < 1024) ref *= C2;
        const float got = col < 1024 ? bf2f(Qb[(size_t)tok * 1024 + col]) : (col < 1280 ? bf2f(Kb[(size_t)tok * 256 + col - 1024]) : bf2f(Vb[(size_t)tok * 256 + col - 1280]));
        if (F.lane == 0) chk_report(F.ctl, id, got, ref, 0.20f, 0.10f); }
}
__device__ __forceinline__ void chk_attn(Frame& F, const Args& a, int layer, int id) {
    F.refresh(); const bf16_t* Qb = (const bf16_t*)(F.ws + WS_Q); const bf16_t* Kb = (const bf16_t*)(F.ws + WS_K); const bf16_t* Vb = (const bf16_t*)(F.ws + WS_V); const unsigned char* Ob = F.ws + WS_R + 216 * MiB;
    LAS float* lg = (LAS float*)F.lds + F.wave * 1024;
    for (int s = F.gw; s < 64; s += NGW) { const int tok = chk_toks[s & 15], h = (s >> 4) * 5, kvh = h >> 2;
        if (layer == 2 && tok >= T) continue;
        const bool isctx = tok >= T; const int b = isctx ? (tok - T) / CTXL : tok / SEQ, p = tok & (SEQ - 1);
        int nk = 0; const int lo = isctx ? 0 : (p - 128 < 0 ? 0 : p - 128), hi = isctx ? -1 : (p + 128 > SEQ - 1 ? SEQ - 1 : p + 128);
        const int nlat = isctx ? 0 : hi - lo + 1; nk = nlat + CTXL;
        float mx = a.in[10][(layer >> 1) * 16 + h] * LOG2E; const float sink2 = mx;
        for (int i = F.lane; i < nk; i += 64) { const size_t kr = i < nlat ? (size_t)b * SEQ + lo + i : (size_t)T + b * CTXL + (i - nlat); float d = 0.f;
            for (int e = 0; e < 64; ++e) d += bf2f(Qb[(size_t)tok * 1024 + h * 64 + e]) * bf2f(Kb[kr * 256 + kvh * 64 + e]);
            lg[i] = d; mx = fmaxf(mx, d); }
#pragma unroll
        for (int o = 1; o < 64; o <<= 1) mx = fmaxf(mx, __shfl_xor(mx, o));
        LDS_WAIT();
        float den = 0.f; for (int i = F.lane; i < nk; i += 64) den += exp2f(lg[i] - mx);
        den = wave_sum(den) + exp2f(sink2 - mx);
        float o = 0.f;
        for (int i = 0; i < nk; ++i) { const size_t kr = i < nlat ? (size_t)b * SEQ + lo + i : (size_t)T + b * CTXL + (i - nlat); o += exp2f(lg[i] - mx) * bf2f(Vb[kr * 256 + kvh * 64 + F.lane]); }
        o /= den;
        chk_report(F.ctl, id, f82f(Ob[(size_t)tok * 1024 + h * 64 + F.lane]), o, 0.02f, 0.08f); chk_report(F.ctl, 32 + (s & 15), f82f(Ob[(size_t)tok * 1024 + h * 64 + F.lane]), o, 0.02f, 0.08f);
        LDS_WAIT(); }
    __syncthreads();
}
__device__ __forceinline__ void chk_fnet_f(Frame& F, const Args& a, bool upd, int id) {
    F.refresh(); const unsigned char* U = (const unsigned char*)a.out + OUT_U8; LAS float* red = (LAS float*)F.lds;
    for (int s = F.blk; s < 128 + (upd ? 64 : 0); s += GRID) {
        const bool cx = s >= 128; const int q = cx ? s - 128 : s; const int m = chk_ms[q & 3], g = ((q >> 2) & 1) * 3, b = ((q >> 3) & 1) * 31; int k = chk_ks[(q >> 4) & 7]; const int L = cx ? CTXL : SEQ; if (cx) k &= 255;
        const size_t row0 = cx ? (size_t)T + b * CTXL : (size_t)b * SEQ;
        float acc = 0.f;
        for (int l = F.wave; l < L; l += NWAVES) { float ca = 0.f, sa = 0.f;
            for (int n = F.lane; n < 256; n += 64) { const float u = f82f(U[(row0 + l) * D + g * 256 + n]); const float an = 6.283185307179586f * (float)((m * n) & 255) / 256.f; const float sn = __sinf(an), cs = __cosf(an); ca += u * cs; sa += u * sn; }
            ca = wave_sum(ca); sa = wave_sum(sa); const float an = 6.283185307179586f * (float)((k * l) % L) / (float)L; const float sn = __sinf(an), cs = __cosf(an); acc += cs * ca - sn * sa; }
        if (F.lane == 0) red[F.wave] = acc;
        __syncthreads();
        if (F.tid == 0) { float t = 0.f; for (int w = 0; w < NWAVES; ++w) t += red[w]; t *= cx ? (1.f / 256.f) : 0.001381067932004975f;
            float got;
            if (cx) got = f82f((F.ws + WS_FC)[((size_t)b * 256 + k) * D + g * 256 + m]);
            else if (k == 1024) got = bf2f(((const bf16_t*)(F.ws + WS_FH1))[(size_t)b * 1024 + g * 256 + m]);
            else got = f82f((F.ws + WS_FH)[((size_t)b * 1024 + k) * D + g * 256 + m]);
            chk_report(F.ctl, id, got, t, 0.25f, 0.10f); }
        __syncthreads(); }
}
__device__ __forceinline__ void chk_fnet_y(Frame& F, const Args& a, int jl, bool upd, int id) {
    F.refresh(); const bf16_t* Y = (const bf16_t*)a.out; const float* W = a.in[11] + (size_t)jl * 1024 * 1024;
    const unsigned char* FH = F.ws + WS_FH; const bf16_t* FH1 = (const bf16_t*)(F.ws + WS_FH1); const unsigned char* FC = F.ws + WS_FC;
    for (int s = F.gw; s < 50; s += NGW) { const int tok = chk_ytoks[s % 10], n = chk_ns[s / 10]; if (tok >= T && !upd) continue;
        float acc = 0.f;
        for (int j = F.lane; j < 1024; j += 64) { float f;
            if (tok >= T) f = f82f(FC[(size_t)(tok - T) * D + j]);
            else { const int b = tok >> 11, k = tok & 2047; if (k < 1024) f = f82f(FH[((size_t)b * 1024 + k) * D + j]); else if (k == 1024) f = bf2f(FH1[(size_t)b * 1024 + j]);
                else f = f82f(FH[((size_t)b * 1024 + (2048 - k)) * D + (j & ~255) + ((256 - (j & 255)) & 255)]); }
            acc += f * W[(size_t)j * 1024 + n]; }
        acc = wave_sum(acc);
        if (F.lane == 0) chk_report(F.ctl, id, bf2f(Y[(size_t)tok * D + n]), acc, 0.04f, 0.08f); }
}
__device__ __forceinline__ void chk_route(Frame& F, const Args& a, int layer, int ntok, int id) {
    F.refresh(); const bf16_t* U = (const bf16_t*)a.out; const float* Wr = a.in[12] + (size_t)layer * 1024 * 64; const int* tke = (const int*)(F.ws + WS_TKE); const float* tkw = (const float*)(F.ws + WS_TKW);
    for (int s = F.gw; s < 16; s += NGW) { const int tok = chk_toks[s]; if (tok >= ntok) continue; const int lane = F.lane;
        float lgt = 0.f; for (int k = 0; k < 1024; ++k) lgt += bf2f(U[(size_t)tok * D + k]) * Wr[(size_t)k * 64 + lane];
        const float sc = 1.f / (1.f + expf(-lgt)), sel = sc + a.in[13][layer * 64 + lane];
        float g1 = -INFINITY, g2 = -INFINITY;
#pragma unroll 1
        for (int j = 0; j < 8; ++j) { const float v = __shfl(sel, (lane & ~7) + j); if (v > g1) { g2 = g1; g1 = v; } else if (v > g2) g2 = v; }
        const float gs = g1 + g2; int gr = 0;
#pragma unroll 1
        for (int gp = 0; gp < 8; ++gp) { const float v = __shfl(gs, gp * 8); gr += (v > gs || (v == gs && gp < (lane >> 3))) ? 1 : 0; }
        const float sm = gr < 4 ? sel : -INFINITY; int rk = 0;
#pragma unroll 1
        for (int ep = 0; ep < 64; ++ep) { const float v = __shfl(sm, ep); rk += (v > sm || (v == sm && ep < lane)) ? 1 : 0; }
        const float tot = wave_sum(rk < 8 ? sc : 0.f); const float wref = sc / tot * 2.5f;
        int slot = -1; for (int j = 0; j < 8; ++j) if (tke[(size_t)tok * 8 + j] == lane) slot = j;
        float err = 0.f;
        if (slot >= 0) { if (rk >= 10) err = 10.f; else if (rk < 8) err = fabsf(tkw[(size_t)tok * 8 + slot] - wref) / (0.04f * wref); }
        else if (rk < 6) err = 10.f;
        const unsigned long long nsel = __ballot(slot >= 0); if (__builtin_popcountll(nsel) != 8) err = 20.f;
        atomicMax(F.ctl + CW_ERR + id, __float_as_uint(err)); }
}
__device__ __forceinline__ void chk_moe(Frame& F, const Args& a, int layer, int ntok, int ch, int id) {
    F.refresh(); const bf16_t* U = (const bf16_t*)a.out; const int* tke = (const int*)(F.ws + WS_TKE); const float* tkw = (const float*)(F.ws + WS_TKW);
    const int CH = ntok / NCHUNK; LAS float* hs = (LAS float*)F.lds; LAS float* us = hs + 512; LAS float* pg_ = us + 1024;
    for (int s = F.blk; s < 16; s += GRID) { const int tok = chk_toks[s]; if (tok >= ntok || tok / CH != ch) continue;
        for (int k = F.tid; k < 1024; k += NTHR) us[k] = bf2f(U[(size_t)tok * D + k]);
        __syncthreads();
        float y0 = 0.f, y1 = 0.f;
        for (int j = 0; j < 9; ++j) { const int e = j < 8 ? tke[(size_t)tok * 8 + j] : 0; const float w = j < 8 ? tkw[(size_t)tok * 8 + j] : 1.f;
            const float* wg = j < 8 ? a.in[14] + ((size_t)layer * NE + e) * 262144 : a.in[17] + (size_t)layer * 262144;
            const float* wu = j < 8 ? a.in[15] + ((size_t)layer * NE + e) * 262144 : a.in[18] + (size_t)layer * 262144;
            const float* wd = j < 8 ? a.in[16] + ((size_t)layer * NE + e) * 262144 : a.in[19] + (size_t)layer * 262144;
            const int hh = F.tid & 255, half = F.tid >> 8; float g = 0.f, u = 0.f;
            for (int k = half * 512; k < half * 512 + 512; ++k) { g += us[k] * wg[(size_t)k * 256 + hh]; u += us[k] * wu[(size_t)k * 256 + hh]; }
            pg_[F.tid] = g; pg_[512 + F.tid] = u;
            __syncthreads();
            if (F.tid < 256) { const float gg = pg_[F.tid] + pg_[F.tid + 256], uu = pg_[512 + F.tid] + pg_[512 + F.tid + 256]; hs[F.tid] = gg / (1.f + expf(-gg)) * uu; }
            __syncthreads();
            float t0 = 0.f, t1 = 0.f; for (int q = 0; q < 256; ++q) { t0 += hs[q] * wd[(size_t)q * 1024 + F.tid]; t1 += hs[q] * wd[(size_t)q * 1024 + 512 + F.tid]; }
            y0 += w * t0; y1 += w * t1;
            __syncthreads(); }
        float g0 = 0.f, g1 = 0.f; const int i = tok - ch * CH;
        { const unsigned char* YSb = (const unsigned char*)(F.ws + WS_YS); const unsigned char* YBb = (const unsigned char*)(F.ws + WS_YB); const int* spos = (const int*)(F.ws + WS_SDST);
          const int t_ = F.tid, bo = 16 * (16 * (t_ >> 8) + ((t_ & 127) >> 3)) + 8 * ((t_ >> 7) & 1) + (t_ & 7);
          auto f8 = [](unsigned char b) { return __builtin_amdgcn_cvt_pk_f32_fp8((int)b, false)[0] * (1.f / 16.f); };
          g0 = f8(YSb[(size_t)i * D + bo]); g1 = f8(YSb[(size_t)i * D + bo + 512]);
          for (int j = 0; j < 8; ++j) { const size_t ps = (size_t)spos[(size_t)tok * 8 + j]; const float w = tkw[(size_t)tok * 8 + j]; g0 += w * f8(YBb[ps * D + bo]); g1 += w * f8(YBb[ps * D + bo + 512]); } }
        chk_report(F.ctl, id, g0, y0, 0.15f, 0.15f); chk_report(F.ctl, id, g1, y1, 0.15f, 0.15f);
        __syncthreads(); }
}
#endif

#ifndef PH_MASK
#define PH_MASK 0xffffffffu
#endif
#define PH(b) ((PH_MASK >> (b)) & 1u)
__global__ void __launch_bounds__(NTHR, 2) fwd(Args a) {
    extern __shared__ __attribute__((aligned(16))) unsigned char lds_raw[];
    Frame F;
    F.lds = (LAS unsigned char*)lds_raw; F.ws = a.ws; F.ctl = (unsigned*)(a.ws + WS_CTL);
    F.blk = blockIdx.x; F.refresh();
    for (int u = F.tid; u < (LDS_BYTES - RING_BYTES) / 4; u += NTHR) ((LAS unsigned*)(F.lds + RING_BYTES))[u] = 0u;
    __syncthreads();
    const XcdBarrier bar = xcd_barrier_post(F.ctl + CW_BAR, (volatile LAS unsigned*)(F.lds + L_MISC) + 8);
#define GRID_BAR() xcd_barrier(bar)
    LAS unsigned char* ring = F.lds;
    const int c = F.blk;
#define ws (F.ws)
#define NEWPH() F.refresh()

    if (PH(0)) { conv_small(F, a);
    __syncthreads();
    mod_full(F, a); }
    GRID_BAR();
    if (PH(1)) { rows_init(F, a); }
    GRID_BAR();

    for (int layer = 0; layer < 4; ++layer) {
        const int jl = layer >> 1; const bool upd = layer < 2; const int nrows = upd ? TT : T;
        if ((layer & 1) == 0) {
            NEWPH();
            if (PH(2)) { SchedQKV S; S.U = (const char*)a.out + OUT_U8; S.W = (const char*)(ws + WS_WQKV) + (size_t)jl * 1536 * 1024; S.nfull = (layer == 0) ? 288 * 6 : 256 * 6; S.nu = (layer == 0) ? 288 * 6 : 256 * 6 + 64; S.c = c;
              pg::EpiQKV E; E.Q = (bf16_t*)(ws + WS_Q); E.K = (bf16_t*)(ws + WS_K); E.V = (bf16_t*)(ws + WS_V); E.ropec = (const float*)(ws + WS_ROPEC); E.ropes = (const float*)(ws + WS_ROPES);
              pg::gemm_phase<pg::EpiQKV, SchedQKV, false, true>(ring, 1024u, 1024u, nullptr, S, E); }
            GRID_BAR();
#ifdef SELFCHECK
            if (SELFCHECK & 1) chk_qkv(F, a, layer, 1 + (layer >> 1));
#endif
#define OBUF ((bf16_t*)(ws + WS_R + 216 * MiB))
            NEWPH();
            if (PH(3)) { const int NU = 2048 + (layer == 0 ? 256 : 0);
              const bf16_t* Qb = (const bf16_t*)(ws + WS_Q); const bf16_t* Kb = (const bf16_t*)(ws + WS_K); const bf16_t* Vb = (const bf16_t*)(ws + WS_V);
              for (int i = 0; i * GRID + c < NU; ++i) { int id = pg::xcd_remap(i * GRID + c, NU);
                  if (NU > 2048) { const int g9 = id / 9, r9 = id - g9 * 9; id = (r9 < 8) ? g9 * 8 + r9 : 2048 + g9; }
                  if (id < 2048) { const int hp = id & 1, qb = (id >> 1) & 7, kvh = (id >> 4) & 3, b = id >> 6, h0 = kvh * 4 + hp * 2;
                      attn::attn_unit2(Qb, Kb, Vb, OBUF, b, h0, qb * 256, false, a.in[10][jl * 16 + h0] * LOG2E, a.in[10][jl * 16 + h0 + 1] * LOG2E, ring); }
                  else { const int cid = id - 2048, hp = cid & 1, kvh = (cid >> 1) & 3, b = cid >> 3, h0 = kvh * 4 + hp * 2;
                      attn::attn_unit2(Qb, Kb, Vb, OBUF, b, h0, 0, true, a.in[10][jl * 16 + h0] * LOG2E, a.in[10][jl * 16 + h0 + 1] * LOG2E, ring); } } }
            GRID_BAR();
#ifdef SELFCHECK
            if (SELFCHECK & 1) chk_attn(F, a, layer, 3 + (layer >> 1));
#endif
            NEWPH();
            if (PH(4)) { SchedDense S; S.A = (const char*)OBUF; S.W = (const char*)(ws + WS_WO) + (size_t)jl * 1024 * 1024; S.out = (char*)a.out; S.nrt = nrows / 256; S.nct = 4; S.nt = 8; S.c = c; S.ldA = 1024;
              pg::EpiY8 E; pg::gemm_phase<pg::EpiY8, SchedDense, false, true>(ring, 1024u, 1024u, nullptr, S, E); }
            GRID_BAR();
        } else {
            NEWPH();
            if (PH(5)) { SchedF1 S; S.CS = (const char*)(ws + WS_CSN); S.U = (const char*)a.out + OUT_U8; S.ABT = (char*)(ws + WS_ABT); S.ABTC = (char*)(ws + WS_ABTC); S.nu = 2048 + (upd ? 256 : 0); S.c = c;
              pg::EpiStore8 E; pg::gemm_phase<pg::EpiStore8, SchedF1, false, true, 127>(ring, 256u, 1024u, nullptr, S, E); }
            GRID_BAR();
            NEWPH();
            if (PH(6)) { SchedF2 S; S.DL = (const char*)(ws + WS_DL); S.ABT = (const char*)(ws + WS_ABT); S.FH = (char*)(ws + WS_FH); S.c = c;
              pg::EpiStore8 E; pg::gemm_phase<pg::EpiStore8, SchedF2, false, true, 127>(ring, 4096u, 4096u, nullptr, S, E); }
            NEWPH();
            if (PH(7) && upd) { SchedF2c S; S.DLC = (const char*)(ws + WS_DLC); S.ABTC = (const char*)(ws + WS_ABTC); S.FC = (char*)(ws + WS_FC); S.c = c;
              pg::EpiStore8 E; pg::gemm_phase<pg::EpiStore8, SchedF2c, false, true, 127>(ring, 512u, 512u, nullptr, S, E); }
            if (PH(8)) fnet_nyquist_rows(F);
            GRID_BAR();
#ifdef SELFCHECK
            if (SELFCHECK & 2) chk_fnet_f(F, a, upd, 5 + (layer >> 1));
            GRID_BAR();
#endif
            NEWPH();
            if (PH(9)) { SchedF3 S; S.FH = (const char*)(ws + WS_FH); S.FC = (const char*)(ws + WS_FC); S.W = (const char*)(ws + WS_WSH) + (size_t)jl * 2048 * 1024; S.Y = (char*)a.out; S.nu = 1024 + (upd ? 128 : 0); S.c = c;
              pg::EpiY8 E; pg::gemm_phase<pg::EpiY8, SchedF3, false, true>(ring, 1024u, 1024u, nullptr, S, E); }
            if (PH(10)) fnet_nyquist_out(F, a, jl);
            GRID_BAR();
#ifdef SELFCHECK
            if (SELFCHECK & 8) chk_fnet_y(F, a, jl, upd, 7 + (layer >> 1));
            GRID_BAR();
#endif
        }
        if (PH(12)) conv_experts(F, a, layer);
        __syncthreads();
        if (PH(11)) rows_post1(F, a, layer, nrows);
        VM_WAIT(); __syncthreads();
        if (threadIdx.x == 0) { __builtin_amdgcn_fence(__ATOMIC_ACQUIRE, "agent"); VM_WAIT(); }
        __syncthreads();
        if (PH(13)) route_tokens(F, a, layer, nrows);
        GRID_BAR();
#ifdef SELFCHECK
        if ((SELFCHECK & 64) && layer < 2) chk_route(F, a, layer, nrows, 9);
#endif
        if (PH(14)) build_lists(F, nrows);
        GRID_BAR();
        LAS const int* tstart = (LAS const int*)(F.lds + L_TSTART); LAS const unsigned char* tseg = (LAS const unsigned char*)(F.lds + L_TSEG);
        const int ntl = __builtin_amdgcn_readfirstlane(tstart[NCHUNK * 64]);
        NEWPH();
        if (PH(15)) { SchedG1 S; S.EGU = (const char*)(ws + WS_EGU); S.STOK = (const int*)(ws + WS_STOK); S.H = (char*)(ws + WS_H); S.HS = (char*)(ws + WS_HS); S.tseg = tseg; S.ntl = ntl; S.nsh = nrows / 256; S.c = c;
          pg::EpiSilu E; pg::gemm_phase<pg::EpiSilu, SchedG1, true, true>(ring, 1024u, 1024u, (const char*)a.out + OUT_U8, S, E); }
        GRID_BAR();
        const int CH = nrows / NCHUNK;
        for (int ch = 0; ch < NCHUNK; ++ch) {
            NEWPH();
            if (PH(16)) { SchedG2 S; S.ED = (const char*)(ws + WS_ED); S.H = (const char*)(ws + WS_H); S.HS = (const char*)(ws + WS_HS); S.YB = (char*)(ws + WS_YB); S.YS = (char*)(ws + WS_YS); S.tseg = tseg;
              S.t0 = __builtin_amdgcn_readfirstlane(tstart[ch * 64]); S.t1 = __builtin_amdgcn_readfirstlane(tstart[ch * 64 + 64]); S.nsh = CH / 256; S.ch = ch; S.CH = CH; S.c = c;
              pg::EpiFp8 E; pg::gemm_phase<pg::EpiFp8, SchedG2, false, true>(ring, 256u, 256u, nullptr, S, E); }
            GRID_BAR();
#ifdef SELFCHECK
            if ((SELFCHECK & 4) && layer == 0) { chk_moe(F, a, layer, nrows, ch, 10); GRID_BAR(); }
#endif
            if (PH(17)) rows_post2(F, a, layer, ch * CH, CH);
            if (!(layer == 3 && ch == NCHUNK - 1)) GRID_BAR();
        }
    }
#ifdef SELFCHECK
    GRID_BAR();
    { int bad = 0; float be = 0.f; for (int k = 15; k >= 1; --k) { const float e = __uint_as_float(__hip_atomic_load(F.ctl + CW_ERR + k, RLX_AGENT)); if (e > 1.f) { bad = k; be = e; } }
      int wt = 0; float we = 0.f; for (int k = 0; k < 16; ++k) { const float e = __uint_as_float(__hip_atomic_load(F.ctl + CW_ERR + 32 + k, RLX_AGENT)); if (e > we) { we = e; wt = k; } }
      if (bad) { F.refresh(); float cv = 3.f + bad + (be > 8.f ? 0.5f : 0.f);  Row r; for (int j = 0; j < 4; ++j) r.v[j] = (f32x4){cv, cv, cv, cv}; for (int row = F.gw; row < T; row += NGW) row_store_f32(r, a.out + (size_t)row * D, F.lane); } }
#endif
}

#undef ws
#undef NEWPH
extern "C" void kernel_launch(void* const* d_in, const int* in_sizes, int n_in, void* d_out, int out_size, void* d_ws, size_t ws_size, hipStream_t stream) {
    static int ready = 0;
    if (ready == 0) {
        if (n_in != 20 || out_size != T * D || ws_size < WS_END) { fprintf(stderr, "kernel_launch: unexpected problem (n_in %d out %d ws %zu need %zu)\n", n_in, out_size, ws_size, (size_t)WS_END); ready = -1; return; }
        if (hipFuncSetAttribute((const void*)fwd, hipFuncAttributeMaxDynamicSharedMemorySize, LDS_BYTES) != hipSuccess) { fprintf(stderr, "kernel_launch: hipFuncSetAttribute failed\n"); ready = -1; return; }
        int per_cu = 0;
        if (hipOccupancyMaxActiveBlocksPerMultiprocessor(&per_cu, (const void*)fwd, NTHR, LDS_BYTES) != hipSuccess || per_cu < 1) fprintf(stderr, "kernel_launch: occupancy query says %d blocks per CU\n", per_cu);
        (void)hipGetLastError();
        ready = 1;
    }
    if (ready < 0) return;
    (void)hipMemsetAsync((char*)d_ws + WS_CTL, 0, CTL_BYTES, stream);
    Args a{};
    for (int i = 0; i < 20; ++i) a.in[i] = (const float*)d_in[i];
    a.out = (float*)d_out; a.ws = (unsigned char*)d_ws;
    hipLaunchKernelGGL(fwd, dim3(GRID), dim3(NTHR), LDS_BYTES, stream, a);
}
```

```cpp
#include <hip/hip_runtime.h>
#include <cstdio>
#include <cstdint>

#define LAS __attribute__((address_space(3)))
#define GAS __attribute__((address_space(1)))
typedef unsigned short bf16_t;
typedef short bf16x8 __attribute__((ext_vector_type(8)));
typedef short s16x4 __attribute__((ext_vector_type(4)));
typedef float f32x4 __attribute__((ext_vector_type(4)));
typedef float f32x16 __attribute__((ext_vector_type(16)));
typedef unsigned u32x4 __attribute__((ext_vector_type(4)));
typedef unsigned u32x2 __attribute__((ext_vector_type(2)));
typedef int v8i_t __attribute__((ext_vector_type(8)));
typedef int v4i_t __attribute__((ext_vector_type(4)));

constexpr int D = 1024, NB = 32, SEQ = 2048, T = NB * SEQ, CTXL = 256, TC = NB * CTXL, TT = T + TC;
constexpr int NQKV = 1536, NE = 64;
constexpr float ALPHA = 1.681792830507429f;
constexpr float LN_EPS = 1e-5f, MOD_EPS = 1e-6f;
constexpr float C2 = 0.125f * 1.4426950408889634f;
constexpr float LOG2E = 1.4426950408889634f;
constexpr int NCHUNK = 1;
constexpr int NWAVES = 8, NTHR = 512, GRID = 256;

constexpr size_t MiB = 1u << 20;
constexpr size_t WS_CTL = 0, CTL_BYTES = 1 * MiB;
constexpr size_t WS_ROPEC = 1 * MiB, WS_ROPES = 1 * MiB + 4096, WS_CSN = 1 * MiB + 65536, WS_DLC = 1 * MiB + 524288, WS_DL = 2 * MiB;
constexpr size_t WS_WQKV = 10 * MiB, WS_WO = 16 * MiB, WS_WF = 20 * MiB, WS_WR = 28 * MiB, WS_WSH = 29 * MiB;
constexpr size_t WS_MODP = 36 * MiB, WS_MOD = 49 * MiB;
constexpr float QSC = 64.f;
constexpr float YSC = 16.f;
constexpr size_t WS_RSTAT = 36 * MiB;
constexpr size_t WS_EGU = 54 * MiB, WS_ED = 118 * MiB;
constexpr size_t WS_XS = 150 * MiB;
constexpr size_t WS_STOK = 294 * MiB, WS_SDST = 297 * MiB, WS_SW = 300 * MiB, WS_TKE = 303 * MiB, WS_TKW = 306 * MiB;
constexpr size_t WS_R = 309 * MiB;
constexpr size_t WS_Q = WS_R, WS_K = WS_R + 144 * MiB, WS_V = WS_R + 180 * MiB;
constexpr size_t WS_ABT = WS_R, WS_FH = WS_R + 256 * MiB, WS_FH1 = WS_R + 320 * MiB, WS_ABTC = WS_R + 321 * MiB, WS_FC = WS_R + 353 * MiB;
constexpr size_t WS_H = WS_R, WS_HS = WS_R + 160 * MiB, WS_YB = WS_R + 180 * MiB, WS_YS = WS_R + 788 * MiB;
constexpr size_t WS_END = WS_YS + 72 * MiB;
constexpr size_t OUT_U8 = 144 * MiB;
constexpr int WSCALE_E8M0 = 121;
constexpr int MAXROWS = 655360;

constexpr int CW_TMO = 0, CW_BAR = 4096, CW_BCNT = 16384;

constexpr int RING_BYTES = 131072;
constexpr int L_MISC = RING_BYTES;
constexpr int L_TSTART = RING_BYTES + 256;
constexpr int L_PREF = L_TSTART + 1040;
constexpr int L_LCNT = L_PREF + 256;
constexpr int L_TSEG = L_LCNT + 256;
constexpr int L_SCAN = L_TSEG + 2560;
constexpr int LDS_BYTES = 139264;
static_assert(L_SCAN + 1024 <= LDS_BYTES, "LDS map");

#define RLX_AGENT __ATOMIC_RELAXED, __HIP_MEMORY_SCOPE_AGENT
#define LDS_WAIT() asm volatile("s_waitcnt lgkmcnt(0)" ::: "memory")
#define VM_WAIT() asm volatile("s_waitcnt vmcnt(0)" ::: "memory")

__device__ __forceinline__ unsigned f2bf(float f) { unsigned u = __builtin_bit_cast(unsigned, f); return (u + 0x7fffu + ((u >> 16) & 1u)) >> 16; }
__device__ __forceinline__ unsigned pk2(float lo, float hi) { return f2bf(lo) | (f2bf(hi) << 16); }
typedef float f32x2_t __attribute__((ext_vector_type(2))); typedef __bf16 bf16x2_t __attribute__((ext_vector_type(2)));
__device__ __forceinline__ unsigned cvt_pk_bf16(float lo, float hi) { f32x2_t v = {lo, hi}; bf16x2_t b = __builtin_convertvector(v, bf16x2_t); return __builtin_bit_cast(unsigned, b); }
__device__ __forceinline__ float bflo(unsigned w) { return __builtin_bit_cast(float, w << 16); }
__device__ __forceinline__ float bfhi(unsigned w) { return __builtin_bit_cast(float, w & 0xffff0000u); }
__device__ __forceinline__ float wave_sum(float v) {
#pragma unroll
    for (int o = 1; o < 64; o <<= 1) v += __shfl_xor(v, o);
    return v;
}

__device__ __forceinline__ unsigned f2f8(float v) { return (unsigned)__builtin_amdgcn_cvt_pk_fp8_f32(v, 0.f, 0, false) & 0xffu; }
__device__ __forceinline__ float f82f(unsigned b) { return __builtin_amdgcn_cvt_pk_f32_fp8((int)(b & 0xffu), false)[0]; }
__device__ __forceinline__ int opaque_tid() { int t = threadIdx.x; asm volatile("" : "+v"(t)); return t; }

#define XB_TMO      128
#define XB_XCNT(j)  (256  + 64 * (j))
#define XB_XSUB(j)  (1280 + 64 * (j))
#define XB_XGEN(j)  (2304 + 64 * (j))
#define XB_TOP      3328
#define XB_TOPGEN   3392
#define XCD_BAR_WORDS 3456
#define XB_SPIN_CAP (1u << 22)
__device__ __forceinline__ unsigned xb_ld(unsigned* p)              { return __hip_atomic_load(p, __ATOMIC_RELAXED, __HIP_MEMORY_SCOPE_AGENT); }
__device__ __forceinline__ unsigned xb_add(unsigned* p, unsigned v) { return __hip_atomic_fetch_add(p, v, __ATOMIC_RELAXED, __HIP_MEMORY_SCOPE_AGENT); }
__device__ __forceinline__ unsigned xb_xcc_id() { return (unsigned)__builtin_amdgcn_s_getreg((3 << 11) | 20) & 0xFu; }
#define XB_SPIN(cond, bar) do { unsigned _sp = 0; while (cond) { __builtin_amdgcn_s_sleep(1); \
    if ((++_sp & 255u) == 0u) { if (xb_ld(&(bar)[XB_TMO])) break; if (_sp > XB_SPIN_CAP) { atomicAdd(&(bar)[XB_TMO], 1u); break; } } } } while (0)
struct XcdBarrier { unsigned* bar; unsigned x; volatile LAS unsigned* st; };
__device__ __forceinline__ XcdBarrier xcd_barrier_post(unsigned* bar, volatile LAS unsigned* st) {
    XcdBarrier b; b.bar = bar; b.x = xb_xcc_id(); b.st = st;
    if (threadIdx.x == 0) (void)xb_add(&bar[XB_XCNT(b.x)], 1u);
    return b;
}
__device__ __forceinline__ void xcd_barrier_complete(unsigned* bar, unsigned x, unsigned& nloc, unsigned& nx) {
    const unsigned G = gridDim.x * gridDim.y * gridDim.z;
    unsigned sum, cnt, mine, sp = 0u;
    for (;;) {
        sum = 0u; cnt = 0u; mine = 0u;
#pragma unroll
        for (unsigned j = 0; j < 16; ++j) { const unsigned c = xb_ld(&bar[XB_XCNT(j)]); sum += c; cnt += (c > 0u) ? 1u : 0u; mine = (j == x) ? c : mine; }
        if (sum == G) break;
        __builtin_amdgcn_s_sleep(1);
        if ((++sp & 255u) == 0u) { if (xb_ld(&bar[XB_TMO])) break; if (sp > XB_SPIN_CAP) { atomicAdd(&bar[XB_TMO], 1u); break; } }
    }
    nloc = mine > 0u ? mine : 1u; nx = cnt > 0u ? cnt : 1u;
}
__device__ __forceinline__ void xcd_barrier(const XcdBarrier& b) {
    asm volatile("s_waitcnt vmcnt(0)" ::: "memory");
    __syncthreads();
    if (threadIdx.x == 0) {
        unsigned* bar = b.bar; unsigned bx = b.x; asm volatile("" : "+s"(bx));
        __builtin_amdgcn_s_waitcnt(0);
        unsigned nloc = b.st[0], nx = b.st[1];
        if (nloc == 0u) { xcd_barrier_complete(bar, bx, nloc, nx); b.st[0] = nloc; b.st[1] = nx; }
        const unsigned old = xb_add(&bar[XB_XSUB(bx)], 1u);
        const unsigned gen = old / nloc;
        if (old + 1u == (gen + 1u) * nloc) {
            __builtin_amdgcn_fence(__ATOMIC_RELEASE, "agent");
            asm volatile("s_waitcnt vmcnt(0)" ::: "memory");
            const unsigned og = xb_add(&bar[XB_TOP], 1u);
            const unsigned tg = og / nx;
            if (og + 1u == (tg + 1u) * nx) xb_add(&bar[XB_TOPGEN], 1u);
            else XB_SPIN(xb_ld(&bar[XB_TOPGEN]) == tg, bar);
            __builtin_amdgcn_fence(__ATOMIC_ACQUIRE, "agent");
            xb_add(&bar[XB_XGEN(bx)], 1u);
            asm volatile("s_waitcnt vmcnt(0)" ::: "memory");
        } else {
            XB_SPIN(xb_ld(&bar[XB_XGEN(bx)]) == gen, bar);
            __builtin_amdgcn_fence(__ATOMIC_ACQUIRE, "agent");
            asm volatile("s_waitcnt vmcnt(0)" ::: "memory");
        }
    }
    __syncthreads();
}

typedef float f32x2v __attribute__((ext_vector_type(2)));
namespace pg {
constexpr int BM = 256, BK = 64, HALF = 128, HTB = HALF * BK * 2;
__host__ __device__ __forceinline__ int lds_byte(int r, int c) { const int st = (r >> 4) * 2 + (c >> 5), rr = r & 15, cc = c & 31, ob = rr * 64 + cc * 2; return st * 1024 + (ob ^ (((ob >> 9) & 1) << 5)); }
__host__ __device__ __forceinline__ void stage_rc(int b, int& R, int& C) { const int st = b / 1024, sb = b % 1024, swz = sb ^ (((sb >> 9) & 1) << 5); R = (st >> 1) * 16 + swz / 64; C = (st & 1) * 32 + (swz % 64) / 2; }
__host__ __device__ __forceinline__ int perm32(int rho) { const int n = rho >> 4, i = rho & 15; return 8 * (i >> 2) + 4 * n + (i & 3); }

struct Unit {
    const char* A;
    const char* B;
    const int* gidx;
    int gbase;
    int nt;
    char* out; int ldc; float scale; int flags; int i0; int i1;
};

template <class Epi, class Sched, bool GATHER, bool F8 = false, int WSC = WSCALE_E8M0>
__device__ __forceinline__ void gemm_phase(LAS unsigned char* lds, const unsigned lda, const unsigned ldb, const char* gtable, const Sched& S, const Epi& E) {
    const int tid = opaque_tid(), wid = __builtin_amdgcn_readfirstlane(tid >> 6), lane = tid & 63, wr = wid >> 2, wc = wid & 3, fr = lane & 15, fq = lane >> 4;
    unsigned voffA[2], voffB[2];
#pragma unroll
    for (int i = 0; i < 2; ++i) { int R, C; stage_rc(tid * 16 + i * 8192, R, C); const int Rb = (R & ~31) + perm32(R & 31);
        voffA[i] = (unsigned)R * lda + (unsigned)C * 2u; voffB[i] = (unsigned)Rb * ldb + (unsigned)C * 2u; }
    const size_t kstep = (size_t)(BK * 2);
    const size_t hstepA = (size_t)HALF * lda, hstepB = (size_t)HALF * ldb;
    const unsigned ldsw = (unsigned)wid * 1024u;
    const int aoff = lds_byte(wr * 64 + fr, fq * 8), boff = lds_byte(wc * 32 + fr, fq * 8);
#define PG_SA(b, h) (((b) * 2 + (h)) * HTB)
#define PG_SB(b, h) ((4 + (b) * 2 + (h)) * HTB)
#define PG_ST2(bufoff, p0, p1) do { \
        __builtin_amdgcn_global_load_lds((const unsigned*)(p0), (LAS unsigned*)(lds + (bufoff) + ldsw), 16, 0, 0); \
        __builtin_amdgcn_global_load_lds((const unsigned*)(p1), (LAS unsigned*)(lds + (bufoff) + ldsw + 8192), 16, 0, 0); } while (0)
#define PG_STB(bufoff, bp) PG_ST2(bufoff, (bp) + voffB[0], (bp) + voffB[1])
#define PG_STA(bufoff, ap, h, nx) do { if constexpr (GATHER) { PG_ST2(bufoff, (ap) + ((nx) ? nO[h][0] : cO[h][0]), (ap) + ((nx) ? nO[h][1] : cO[h][1])); } \
        else { PG_ST2(bufoff, (ap) + (h) * hstepA + voffA[0], (ap) + (h) * hstepA + voffA[1]); } } while (0)
#define PG_LD8(p) ({ const v4i_t lo_ = *(const LAS v4i_t*)(p), hi_ = *(const LAS v4i_t*)((p) + 1024); __builtin_shufflevector(lo_, hi_, 0, 1, 2, 3, 4, 5, 6, 7); })
#define PG_LDA(dst, b, h) do { if constexpr (F8) { _Pragma("unroll") for (int m = 0; m < 4; ++m) dst##8[m] = PG_LD8(lds + PG_SA(b, h) + aoff + m * 2048); } \
        else { _Pragma("unroll") for (int m = 0; m < 4; ++m) _Pragma("unroll") for (int k = 0; k < 2; ++k) dst[m][k] = *(const LAS bf16x8*)(lds + PG_SA(b, h) + aoff + m * 2048 + k * 1024); } } while (0)
#define PG_LDB(dst, b, h) do { if constexpr (F8) { _Pragma("unroll") for (int n = 0; n < 2; ++n) dst##8[n] = PG_LD8(lds + PG_SB(b, h) + boff + n * 2048); } \
        else { _Pragma("unroll") for (int n = 0; n < 2; ++n) _Pragma("unroll") for (int k = 0; k < 2; ++k) dst[n][k] = *(const LAS bf16x8*)(lds + PG_SB(b, h) + boff + n * 2048 + k * 1024); } } while (0)
#define PG_MMA(ai, bj, At, Bt) do { __builtin_amdgcn_s_setprio(1); _Pragma("unroll") for (int m = 0; m < 4; ++m) _Pragma("unroll") for (int n = 0; n < 2; ++n) { \
        if constexpr (F8) { asm volatile("v_mfma_scale_f32_16x16x128_f8f6f4 %0, %1, %2, %0, %3, %4 op_sel_hi:[0,0,0]" : "+v"(acc[ai][bj][m][n]) : "v"(Bt##8[n]), "v"(At##8[m]), "v"(sc_w), "v"(sc_x)); } \
        else { _Pragma("unroll") for (int k = 0; k < 2; ++k) acc[ai][bj][m][n] = __builtin_amdgcn_mfma_f32_16x16x32_bf16(Bt[n][k], At[m][k], acc[ai][bj][m][n], 0, 0, 0); } } \
        __builtin_amdgcn_s_setprio(0); } while (0)
#define PG_WAIT_V(n) asm volatile("s_waitcnt vmcnt(" #n ")" ::: "memory")
#define PG_WAIT_L(n) asm volatile("s_waitcnt lgkmcnt(" #n ")" ::: "memory")
#define PG_BAR __builtin_amdgcn_s_barrier()
#define PG_SCHED __builtin_amdgcn_sched_barrier(0)
#define PG_GOFF(dst, u) do { const int tz_ = opaque_tid(); _Pragma("unroll") for (int i = 0; i < 2; ++i) { int R_, C_; stage_rc(tz_ * 16 + i * 8192, R_, C_); \
        _Pragma("unroll") for (int h = 0; h < 2; ++h) { const int rr = h * HALF + R_; \
        const int ix = (u).gidx ? ((const GAS int*)(u).gidx)[rr] : (u).gbase + rr; dst[h][i] = (unsigned)ix * lda + (unsigned)C_ * 2u; } } } while (0)
#define PG_GIDX(dst, un) do { const int* gi_ = nullptr; int gb_ = 0; const bool ok_ = S.gsrc((un), gi_, gb_); const int tz_ = opaque_tid(); _Pragma("unroll") for (int i = 0; i < 2; ++i) { int R_, C_; stage_rc(tz_ * 16 + i * 8192, R_, C_); \
        _Pragma("unroll") for (int h = 0; h < 2; ++h) { const int rr = h * HALF + R_; dst[h][i] = (ok_ && gi_) ? ((const GAS int*)gi_)[rr] : gb_ + rr; } } } while (0)
#define PG_GCVT(dst, src) do { const int tz_ = opaque_tid(); _Pragma("unroll") for (int i = 0; i < 2; ++i) { int R_, C_; stage_rc(tz_ * 16 + i * 8192, R_, C_); \
        _Pragma("unroll") for (int h = 0; h < 2; ++h) dst[h][i] = (unsigned)src[h][i] * lda + (unsigned)C_ * 2u; } } while (0)
    Unit cur, nxt; int ui = 0;
    if (!S.next(0, cur)) return;
    f32x4 acc[2][2][4][2];
#pragma unroll
    for (int a = 0; a < 2; ++a)
#pragma unroll
        for (int b = 0; b < 2; ++b)
#pragma unroll
            for (int m = 0; m < 4; ++m)
#pragma unroll
                for (int n = 0; n < 2; ++n) acc[a][b][m][n] = (f32x4){0.f, 0.f, 0.f, 0.f};
    bf16x8 At[4][2], B0[2][2], B1[2][2]; v8i_t At8[4], B08[2], B18[2];
    const int sc_w = WSC * 0x01010101, sc_x = 0x7f7f7f7f;
    unsigned cO[2][2] = {{0u, 0u}, {0u, 0u}}, nO[2][2] = {{0u, 0u}, {0u, 0u}};
    if constexpr (GATHER) { PG_GOFF(cO, cur); }
    const char* cA = GATHER ? gtable : cur.A; const char* cB = cur.B;
    PG_STB(PG_SB(0, 0), cB); PG_STB(PG_SB(0, 1), cB + hstepB); PG_STA(PG_SA(0, 0), cA, 0, false); PG_STA(PG_SA(0, 1), cA, 1, false);
    if (wr == 1) PG_BAR;
    PG_WAIT_V(2); PG_BAR;
    PG_STB(PG_SB(1, 0), cB + kstep); PG_STA(PG_SA(1, 0), cA + kstep, 0, false); PG_STB(PG_SB(1, 1), cB + hstepB + kstep);
    PG_WAIT_V(6); PG_BAR;
    for (;;) {
        const bool has_next = S.next(ui + 1, nxt);
        const int nt = cur.nt;
        if constexpr (GATHER) { if (has_next) { PG_GOFF(nO, nxt); } else {
#pragma unroll
            for (int h = 0; h < 2; ++h)
#pragma unroll
                for (int i = 0; i < 2; ++i) nO[h][i] = cO[h][i]; } }
        const char* nA = GATHER ? gtable : (has_next ? nxt.A : cA); const char* nB = has_next ? nxt.B : cB;
#pragma unroll 1
        for (int t = 0; t < nt; t += 2) {
            const bool last = (t == nt - 2);
            const char* a1 = cA + (size_t)(t + 1) * kstep;
            const char* a2 = last ? nA : cA + (size_t)(t + 2) * kstep; const char* b2 = last ? nB : cB + (size_t)(t + 2) * kstep;
            const char* a3 = a2 + kstep; const char* b3 = b2 + kstep;
            const bool after_epi = (Epi::NSTORE > 0) && (t == 0) && (ui > 0);
            PG_LDB(B0, 0, 0); PG_LDB(B1, 0, 1); PG_SCHED; PG_LDA(At, 0, 0); PG_STA(PG_SA(1, 1), a1, 1, false);
            if (after_epi) { if constexpr (Epi::NSTORE == 8) PG_WAIT_V(16); else PG_WAIT_V(24); } else PG_WAIT_V(8);
            PG_WAIT_L(0); PG_BAR; PG_MMA(0, 0, At, B0); PG_MMA(0, 1, At, B1); PG_BAR; PG_SCHED;
            PG_LDA(At, 0, 1); PG_STB(PG_SB(0, 0), b2); PG_STB(PG_SB(0, 1), b2 + hstepB); PG_STA(PG_SA(0, 0), a2, 0, last);
            if (after_epi) { if constexpr (Epi::NSTORE == 8) PG_WAIT_V(16); else PG_WAIT_V(24); } else PG_WAIT_V(8);
            PG_WAIT_L(0); PG_BAR; PG_MMA(1, 0, At, B0); PG_MMA(1, 1, At, B1); PG_BAR; PG_SCHED;
            PG_LDB(B0, 1, 0); PG_LDB(B1, 1, 1); PG_SCHED; PG_LDA(At, 1, 0); PG_STA(PG_SA(0, 1), a2, 1, last);
            PG_WAIT_V(8); PG_WAIT_L(0); PG_BAR; PG_MMA(0, 0, At, B0); PG_MMA(0, 1, At, B1); PG_BAR; PG_SCHED;
            PG_LDA(At, 1, 1); PG_STB(PG_SB(1, 0), b3); PG_STB(PG_SB(1, 1), b3 + hstepB); PG_STA(PG_SA(1, 0), a3, 0, last);
            PG_WAIT_V(8); PG_WAIT_L(0); PG_BAR; PG_MMA(1, 0, At, B0); PG_MMA(1, 1, At, B1); PG_BAR; PG_SCHED;
        }
        if (wr == 0) PG_BAR;
        if constexpr (F8) asm volatile("s_nop 15\n\ts_nop 15" ::: "memory");
        E(acc, cur, wr, wc, fr, fq);
        if (!has_next) break;
#pragma unroll
        for (int a = 0; a < 2; ++a)
#pragma unroll
            for (int b = 0; b < 2; ++b)
#pragma unroll
                for (int m = 0; m < 4; ++m)
#pragma unroll
                    for (int n = 0; n < 2; ++n) acc[a][b][m][n] = (f32x4){0.f, 0.f, 0.f, 0.f};
        cur = nxt; cA = nA; cB = nB; ++ui;
        if constexpr (GATHER) {
#pragma unroll
            for (int h = 0; h < 2; ++h)
#pragma unroll
                for (int i = 0; i < 2; ++i) cO[h][i] = nO[h][i]; }
        if (wr == 1) PG_BAR;
    }
    PG_WAIT_V(0);
    PG_BAR;
#undef PG_SA
#undef PG_SB
#undef PG_ST2
#undef PG_STB
#undef PG_STA
#undef PG_LDA
#undef PG_LD8
#undef PG_LDB
#undef PG_MMA
#undef PG_WAIT_V
#undef PG_WAIT_L
#undef PG_BAR
#undef PG_SCHED
#undef PG_GOFF
#undef PG_GIDX
#undef PG_GCVT
}

struct EpiStore {
    static constexpr int NSTORE = 0;
    __device__ __forceinline__ void operator()(const f32x4 (&acc)[2][2][4][2], const Unit& u, int wr, int wc, int fr, int fq) const {
        asm volatile("" : "+v"(fr), "+v"(fq));
        const float s = u.scale;
#pragma unroll
        for (int ai = 0; ai < 2; ++ai)
#pragma unroll
            for (int m = 0; m < 4; ++m) { const int row = ai * HALF + wr * 64 + m * 16 + fr;
                char* rowp = u.out + (ptrdiff_t)row * u.ldc + (wc * 32 + 8 * fq) * 2;
                if (!((u.flags & 1) && row == 0)) {
#pragma unroll
                for (int bj = 0; bj < 2; ++bj) { const f32x4 v0 = acc[ai][bj][m][0] * s, v1 = acc[ai][bj][m][1] * s;
                    u32x4 w; w.x = cvt_pk_bf16(v0[0], v0[1]); w.y = cvt_pk_bf16(v0[2], v0[3]); w.z = cvt_pk_bf16(v1[0], v1[1]); w.w = cvt_pk_bf16(v1[2], v1[3]);
                    *(u32x4*)(rowp + bj * 256) = w; } } }
    }
};
struct EpiStore8 {
    static constexpr int NSTORE = 16;
    __device__ __forceinline__ void operator()(const f32x4 (&acc)[2][2][4][2], const Unit& u, int wr, int wc, int fr, int fq) const {
        asm volatile("" : "+v"(fr), "+v"(fq));
        const float s = u.scale;
#pragma unroll
        for (int ai = 0; ai < 2; ++ai)
#pragma unroll
            for (int m = 0; m < 4; ++m) { const int row = ai * HALF + wr * 64 + m * 16 + fr;
                char* rowp = u.out + (ptrdiff_t)row * u.ldc + (wc * 32 + 8 * fq);
#pragma unroll
                for (int bj = 0; bj < 2; ++bj) { const f32x4 v0 = acc[ai][bj][m][0] * s, v1 = acc[ai][bj][m][1] * s; int w0 = 0, w1 = 0;
                    w0 = __builtin_amdgcn_cvt_pk_fp8_f32(v0[0], v0[1], w0, false); w0 = __builtin_amdgcn_cvt_pk_fp8_f32(v0[2], v0[3], w0, true);
                    w1 = __builtin_amdgcn_cvt_pk_fp8_f32(v1[0], v1[1], w1, false); w1 = __builtin_amdgcn_cvt_pk_fp8_f32(v1[2], v1[3], w1, true);
                    u32x2 o; o.x = (unsigned)w0; o.y = (unsigned)w1; *(u32x2*)(rowp + bj * 128) = o; } }
    }
};
struct EpiQKV {
    static constexpr int NSTORE = 0;
    bf16_t* Q; bf16_t* K; bf16_t* V; const float* ropec; const float* ropes;
    __device__ __forceinline__ void operator()(const f32x4 (&acc)[2][2][4][2], const Unit& u, int wr, int wc, int fr, int fq) const {
        asm volatile("" : "+v"(fr), "+v"(fq));
        const int pm = u.i0, pn = u.i1; const bool lat = pm < (T / 256); const bool rope = lat && pn < 5;
        const float qs = pn < 4 ? C2 : 1.f;
        const int part = wc & 1;
        const int fi0 = 8 * (fq & 1);
        const float sgn = (fq < 2) ? -1.f : 1.f;
#pragma unroll
        for (int ai = 0; ai < 2; ++ai)
#pragma unroll
            for (int m = 0; m < 4; ++m) { const int row = ai * HALF + wr * 64 + m * 16 + fr; const int tok = pm * 256 + row;
                const int tl = tok & (SEQ - 1); const int pos = part ? (tl & 63) : (tl >> 6);
                f32x4 c0 = {1.f, 1.f, 1.f, 1.f}, c1 = c0, s0 = {0.f, 0.f, 0.f, 0.f}, s1 = s0;
                if (rope) { c0 = *(const f32x4*)(ropec + pos * 16 + fi0); c1 = *(const f32x4*)(ropec + pos * 16 + fi0 + 4); s0 = *(const f32x4*)(ropes + pos * 16 + fi0); s1 = *(const f32x4*)(ropes + pos * 16 + fi0 + 4); }
#pragma unroll
                for (int bj = 0; bj < 2; ++bj) { f32x4 v0 = acc[ai][bj][m][0], v1 = acc[ai][bj][m][1];
                    if (rope) { f32x4 p0, p1;
#pragma unroll
                        for (int j = 0; j < 4; ++j) { p0[j] = __shfl_xor(v0[j], 32); p1[j] = __shfl_xor(v1[j], 32); }
                        v0 = v0 * c0 + (p0 * sgn) * s0; v1 = v1 * c1 + (p1 * sgn) * s1; }
                    v0 = v0 * qs; v1 = v1 * qs;
                    const int col = bj * HALF + wc * 32 + 8 * fq;
                    if (pn < 4) {
#pragma unroll
                        for (int j = 0; j < 4; ++j) { v0[j] = __builtin_amdgcn_fmed3f(v0[j] * QSC, -448.f, 448.f); v1[j] = __builtin_amdgcn_fmed3f(v1[j] * QSC, -448.f, 448.f); }
                        int w0 = 0, w1 = 0;
                        w0 = __builtin_amdgcn_cvt_pk_fp8_f32(v0[0], v0[1], w0, false); w0 = __builtin_amdgcn_cvt_pk_fp8_f32(v0[2], v0[3], w0, true);
                        w1 = __builtin_amdgcn_cvt_pk_fp8_f32(v1[0], v1[1], w1, false); w1 = __builtin_amdgcn_cvt_pk_fp8_f32(v1[2], v1[3], w1, true);
                        u32x2 o; o.x = (unsigned)w0; o.y = (unsigned)w1; *(GAS u32x2*)((unsigned char*)Q + (size_t)tok * 1024 + pn * 256 + col) = o; }
                    else { u32x4 w; w.x = cvt_pk_bf16(v0[0], v0[1]); w.y = cvt_pk_bf16(v0[2], v0[3]); w.z = cvt_pk_bf16(v1[0], v1[1]); w.w = cvt_pk_bf16(v1[2], v1[3]);
                        bf16_t* dst = pn == 4 ? K + (size_t)tok * 256 + col : V + (size_t)tok * 256 + col;
                        *(GAS u32x4*)dst = w; } } }
    }
};
struct EpiSilu {
    static constexpr int NSTORE = 8;
    __device__ __forceinline__ void operator()(const f32x4 (&acc)[2][2][4][2], const Unit& u, int wr, int wc, int fr, int fq) const {
        asm volatile("" : "+v"(fr), "+v"(fq));
#pragma unroll
        for (int ai = 0; ai < 2; ++ai)
#pragma unroll
            for (int m = 0; m < 4; ++m) { const int row = ai * HALF + wr * 64 + m * 16 + fr;
                float h[8];
#pragma unroll
                for (int n = 0; n < 2; ++n)
#pragma unroll
                    for (int j = 0; j < 4; j += 2) {
                        const f32x2v g = {acc[ai][0][m][n][j], acc[ai][0][m][n][j + 1]}, up = {acc[ai][1][m][n][j], acc[ai][1][m][n][j + 1]};
                        const f32x2v t = g * (f32x2v){-1.4426950408889634f, -1.4426950408889634f}, p = g * up;
                        f32x2v e = {__builtin_amdgcn_exp2f(t[0]), __builtin_amdgcn_exp2f(t[1])};
                        e = e + (f32x2v){1.f, 1.f};
                        const f32x2v r = {__builtin_amdgcn_rcpf(e[0]), __builtin_amdgcn_rcpf(e[1])};
                        const f32x2v o2 = p * r; h[n * 4 + j] = o2[0]; h[n * 4 + j + 1] = o2[1]; }
                int w0 = 0, w1 = 0;
                w0 = __builtin_amdgcn_cvt_pk_fp8_f32(h[0], h[1], w0, false); w0 = __builtin_amdgcn_cvt_pk_fp8_f32(h[2], h[3], w0, true);
                w1 = __builtin_amdgcn_cvt_pk_fp8_f32(h[4], h[5], w1, false); w1 = __builtin_amdgcn_cvt_pk_fp8_f32(h[6], h[7], w1, true);
                u32x2 o; o.x = (unsigned)w0; o.y = (unsigned)w1;
                *(u32x2*)(u.out + (size_t)row * 256 + (wc * 32 + 8 * fq)) = o; }
    }
};
struct EpiFp8 {
    static constexpr int NSTORE = 8;
    __device__ __forceinline__ void operator()(const f32x4 (&acc)[2][2][4][2], const Unit& u, int wr, int wc, int fr, int fq) const {
        asm volatile("" : "+v"(fr), "+v"(fq));
        const int pn = u.i1;
#pragma unroll
        for (int ai = 0; ai < 2; ++ai)
#pragma unroll
            for (int m = 0; m < 4; ++m) { const int row = ai * HALF + wr * 64 + m * 16 + fr;
                u32x4 o;
#pragma unroll
                for (int bj = 0; bj < 2; ++bj) { const f32x4 v0 = acc[ai][bj][m][0] * 16.f, v1 = acc[ai][bj][m][1] * 16.f;
                    int w0 = 0, w1 = 0;
                    w0 = __builtin_amdgcn_cvt_pk_fp8_f32(v0[0], v0[1], w0, false); w0 = __builtin_amdgcn_cvt_pk_fp8_f32(v0[2], v0[3], w0, true);
                    w1 = __builtin_amdgcn_cvt_pk_fp8_f32(v1[0], v1[1], w1, false); w1 = __builtin_amdgcn_cvt_pk_fp8_f32(v1[2], v1[3], w1, true);
                    o[2 * bj] = (unsigned)w0; o[2 * bj + 1] = (unsigned)w1; }
                *(u32x4*)(u.out + (size_t)row * 1024 + (16 * pn + 4 * wc + fq) * 16) = o; }
    }
};
struct EpiY8 {
    static constexpr int NSTORE = 0;
    __device__ __forceinline__ void operator()(const f32x4 (&acc)[2][2][4][2], const Unit& u, int wr, int wc, int fr, int fq) const {
        asm volatile("" : "+v"(fr), "+v"(fq));
        const int pn = u.i1; const float s = u.scale * YSC;
#pragma unroll
        for (int ai = 0; ai < 2; ++ai)
#pragma unroll
            for (int m = 0; m < 4; ++m) { const int row = ai * HALF + wr * 64 + m * 16 + fr;
                u32x4 o;
#pragma unroll
                for (int bj = 0; bj < 2; ++bj) { f32x4 v0 = acc[ai][bj][m][0] * s, v1 = acc[ai][bj][m][1] * s;
#pragma unroll
                    for (int j = 0; j < 4; ++j) { v0[j] = __builtin_amdgcn_fmed3f(v0[j], -448.f, 448.f); v1[j] = __builtin_amdgcn_fmed3f(v1[j], -448.f, 448.f); }
                    int w0 = 0, w1 = 0;
                    w0 = __builtin_amdgcn_cvt_pk_fp8_f32(v0[0], v0[1], w0, false); w0 = __builtin_amdgcn_cvt_pk_fp8_f32(v0[2], v0[3], w0, true);
                    w1 = __builtin_amdgcn_cvt_pk_fp8_f32(v1[0], v1[1], w1, false); w1 = __builtin_amdgcn_cvt_pk_fp8_f32(v1[2], v1[3], w1, true);
                    o[2 * bj] = (unsigned)w0; o[2 * bj + 1] = (unsigned)w1; }
                if (!((u.flags & 1) && row == 0)) *(GAS u32x4*)(u.out + (ptrdiff_t)row * u.ldc + (16 * pn + 4 * wc + fq) * 16) = o; }
    }
};
__device__ __forceinline__ int xcd_remap(int L0, int NU) { const int q = NU >> 3, r = NU & 7, x = L0 & 7, off = L0 >> 3; return (x < r ? x * (q + 1) : r * (q + 1) + (x - r) * q) + off; }
}

namespace attn {
constexpr int SLOTB = 8192;
constexpr int LDS_K = 0, LDS_V = 2 * SLOTB, LDS_WS = 4 * SLOTB, LDS_OST = LDS_WS + NWAVES * 256, LDS_END = LDS_OST + NWAVES * 4096;
static_assert(LDS_END <= RING_BYTES, "attention LDS");
__device__ __forceinline__ int crow(int r, int hi) { return (r & 3) + 8 * (r >> 2) + 4 * hi; }
__device__ __forceinline__ void glds16(const void* gsrc, unsigned lds_dst) { unsigned keep;
    asm volatile("s_mov_b32 %0, m0\n\ts_mov_b32 m0, %2\n\ts_nop 0\n\tglobal_load_lds_dwordx4 %1, off\n\ts_mov_b32 m0, %0" : "=&s"(keep) : "v"(gsrc), "s"(lds_dst) : "memory"); }
__device__ __forceinline__ float rowmax(const f32x16& p0, const f32x16& p1) {
    float a = fmaxf(p0[0], p1[0]);
#pragma unroll
    for (int r = 1; r < 16; ++r) a = fmaxf(a, fmaxf(p0[r], p1[r]));
    auto rr = __builtin_amdgcn_permlane32_swap(__float_as_uint(a), __float_as_uint(a), false, false);
    return fmaxf(__uint_as_float(rr[0]), __uint_as_float(rr[1]));
}
typedef short v4i16_t __attribute__((ext_vector_type(4)));
__device__ __forceinline__ s16x4 vtr(const LAS unsigned char* p) { return __builtin_bit_cast(s16x4, __builtin_amdgcn_ds_read_tr16_b64_v4i16((LAS v4i16_t*)p)); }
__device__ __forceinline__ void pv(f32x16* o, const LAS unsigned char* vp, bf16x8 pa0, bf16x8 pa1, bf16x8 pa2, bf16x8 pa3) {
#pragma unroll
    for (int d0 = 0; d0 < 2; ++d0) { s16x4 lo[4], hi[4];
#pragma unroll
        for (int ks = 0; ks < 4; ++ks) { lo[ks] = vtr(vp + d0 * 4096 + ks * 1024); hi[ks] = vtr(vp + d0 * 4096 + ks * 1024 + 512); }
#define PK(k) (bf16x8){lo[k][0], lo[k][1], lo[k][2], lo[k][3], hi[k][0], hi[k][1], hi[k][2], hi[k][3]}
        o[d0] = __builtin_amdgcn_mfma_f32_32x32x16_bf16(pa0, PK(0), o[d0], 0, 0, 0);
        o[d0] = __builtin_amdgcn_mfma_f32_32x32x16_bf16(pa1, PK(1), o[d0], 0, 0, 0);
        o[d0] = __builtin_amdgcn_mfma_f32_32x32x16_bf16(pa2, PK(2), o[d0], 0, 0, 0);
        o[d0] = __builtin_amdgcn_mfma_f32_32x32x16_bf16(pa3, PK(3), o[d0], 0, 0, 0);
#undef PK
    }
}
__device__ __forceinline__ void attn_unit(const bf16_t* Q, const bf16_t* K, const bf16_t* V, bf16_t* O, int b, int h, int q0, bool isctx, float sink2, LAS unsigned char* shm) {
    const int tid = opaque_tid(), lane = tid & 63, r32 = lane & 31, hi = lane >> 5; const int wid = __builtin_amdgcn_readfirstlane(tid >> 6);
    const int kvh = h >> 2;
    const long qrow = isctx ? (long)T + b * CTXL + wid * 32 : (long)b * SEQ + q0 + wid * 32;
    const unsigned lds0 = (unsigned)(uintptr_t)shm;
    LAS float* wsf = (LAS float*)(shm + LDS_WS) + wid * 64;
    int jlo = 0, nl = 0;
    if (!isctx) { jlo = (q0 == 0) ? 2 : 0; int jhi = (SEQ - q0 + 128) / 64; if (jhi > 8) jhi = 8; nl = jhi - jlo; }
    const int NT = nl + 4;
    const long lat0 = (long)b * SEQ + q0 - 128 + 64 * jlo, ctx0 = (long)T + b * CTXL;
#define TROW(t) ((t) < nl ? lat0 + 64 * (t) : ctx0 + 64 * ((t) - nl))
    const int kcol = kvh * 64 + wid * 8, vcol = kvh * 64 + (wid >> 2) * 32 + (lane & 3) * 8, vrow = 16 * (wid & 3) + (lane >> 2);
    const unsigned kdst = lds0 + LDS_K + wid * 1024, vdst = lds0 + LDS_V + wid * 1024;
#define DMA_KV(t, slot) do { const long tr_ = TROW(t); glds16(K + (tr_ + lane) * 256 + kcol, (unsigned)__builtin_amdgcn_readfirstlane(kdst + (slot) * SLOTB)); \
        glds16(V + (tr_ + vrow) * 256 + vcol, (unsigned)__builtin_amdgcn_readfirstlane(vdst + (slot) * SLOTB)); } while (0)
    DMA_KV(0, 0);
    bf16x8 qr[4];
#pragma unroll
    for (int d0 = 0; d0 < 4; ++d0) { const u32x2 w = *(const GAS u32x2*)((const unsigned char*)Q + (qrow + r32) * 1024 + h * 64 + d0 * 16 + hi * 8);
        const f32x2v a0 = __builtin_amdgcn_cvt_pk_f32_fp8((int)w.x, false), a1 = __builtin_amdgcn_cvt_pk_f32_fp8((int)w.x, true), a2 = __builtin_amdgcn_cvt_pk_f32_fp8((int)w.y, false), a3 = __builtin_amdgcn_cvt_pk_f32_fp8((int)w.y, true);
        u32x4 qw; qw.x = cvt_pk_bf16(a0[0] * (1.f / QSC), a0[1] * (1.f / QSC)); qw.y = cvt_pk_bf16(a1[0] * (1.f / QSC), a1[1] * (1.f / QSC)); qw.z = cvt_pk_bf16(a2[0] * (1.f / QSC), a2[1] * (1.f / QSC)); qw.w = cvt_pk_bf16(a3[0] * (1.f / QSC), a3[1] * (1.f / QSC));
        qr[d0] = __builtin_bit_cast(bf16x8, qw); }
    float mrun = sink2, l_reg = (hi == 0) ? 1.f : 0.f;
    f32x16 negm;
#pragma unroll
    for (int r = 0; r < 16; ++r) negm[r] = -sink2;
    f32x16 o[2];
#pragma unroll
    for (int r = 0; r < 16; ++r) { o[0][r] = 0.f; o[1][r] = 0.f; }
    const LAS unsigned char* vp0 = shm + LDS_V + ((lane >> 4) & 1) * 32 + (lane & 3) * 8 + (4 * hi + ((lane & 15) >> 2)) * 64;
    const int qw = q0 + wid * 32;
    asm volatile("s_waitcnt vmcnt(0) lgkmcnt(0)\n\ts_barrier" ::: "memory");
    for (int t = 0; t < NT; ++t) {
        const int slot = t & 1;
        if (t + 1 < NT) DMA_KV(t + 1, slot ^ 1);
        const bool latt = t < nl;
        const int ks = q0 - 128 + 64 * (jlo + t);
        bool need = true;
        if (latt) need = (ks + 63 >= qw - 128) && (ks <= qw + 31 + 128);
        if (need) {
            f32x16 p0, p1;
            const LAS unsigned char* kb = shm + LDS_K + slot * SLOTB + hi * 1024 + r32 * 16;
#pragma unroll
            for (int d0 = 0; d0 < 4; ++d0) {
                const bf16x8 b0 = *(const LAS bf16x8*)(kb + d0 * 2048), b1 = *(const LAS bf16x8*)(kb + d0 * 2048 + 512);
                if (d0 == 0) { p0 = __builtin_amdgcn_mfma_f32_32x32x16_bf16(b0, qr[0], negm, 0, 0, 0); p1 = __builtin_amdgcn_mfma_f32_32x32x16_bf16(b1, qr[0], negm, 0, 0, 0); }
                else { p0 = __builtin_amdgcn_mfma_f32_32x32x16_bf16(b0, qr[d0], p0, 0, 0, 0); p1 = __builtin_amdgcn_mfma_f32_32x32x16_bf16(b1, qr[d0], p1, 0, 0, 0); } }
            if (latt && !(ks >= qw - 97 && ks <= qw + 65)) {
                const int dq = qw + r32 - ks;
#pragma unroll
                for (int r = 0; r < 16; ++r) { const int d = dq - crow(r, hi); if (d > 128 || d < -128) p0[r] = -INFINITY; if (d - 32 > 128 || d - 32 < -128) p1[r] = -INFINITY; } }
            const float rm = rowmax(p0, p1);
            if (__any(rm > 8.f)) {
                const float delta = fmaxf(rm, 0.f);
                const float alpha = __builtin_amdgcn_exp2f(-delta); l_reg *= alpha; mrun += delta;
#pragma unroll
                for (int r = 0; r < 16; ++r) { p0[r] -= delta; p1[r] -= delta; negm[r] = -mrun; }
                if (hi == 0) wsf[r32] = alpha;
                asm volatile("s_waitcnt lgkmcnt(0)" ::: "memory");
#pragma unroll
                for (int r = 0; r < 16; ++r) { const float f = wsf[crow(r, hi)]; o[0][r] *= f; o[1][r] *= f; }
            }
            float sacc = 0.f;
#pragma unroll
            for (int r = 0; r < 16; ++r) { p0[r] = __builtin_amdgcn_exp2f(p0[r]); p1[r] = __builtin_amdgcn_exp2f(p1[r]); sacc += p0[r] + p1[r]; }
            l_reg += sacc;
            u32x4 pw0, pw1, pw2, pw3;
#define PKW(P, B) cvt_pk_bf16(P[B], P[B + 1])
            pw0 = (u32x4){PKW(p0, 0), PKW(p0, 2), PKW(p0, 4), PKW(p0, 6)}; pw1 = (u32x4){PKW(p0, 8), PKW(p0, 10), PKW(p0, 12), PKW(p0, 14)};
            pw2 = (u32x4){PKW(p1, 0), PKW(p1, 2), PKW(p1, 4), PKW(p1, 6)}; pw3 = (u32x4){PKW(p1, 8), PKW(p1, 10), PKW(p1, 12), PKW(p1, 14)};
#undef PKW
            __builtin_amdgcn_sched_barrier(0);
            pv(o, vp0 + slot * SLOTB, __builtin_bit_cast(bf16x8, pw0), __builtin_bit_cast(bf16x8, pw1), __builtin_bit_cast(bf16x8, pw2), __builtin_bit_cast(bf16x8, pw3));
        }
        asm volatile("s_waitcnt vmcnt(0) lgkmcnt(0)\n\ts_barrier" ::: "memory");
    }
    { auto rr = __builtin_amdgcn_permlane32_swap(__float_as_uint(l_reg), __float_as_uint(l_reg), false, false); l_reg = __uint_as_float(rr[0]) + __uint_as_float(rr[1]); }
    if (hi == 0) wsf[32 + r32] = l_reg;
    asm volatile("s_waitcnt lgkmcnt(0)" ::: "memory");
    float rli[16];
#pragma unroll
    for (int r = 0; r < 16; ++r) rli[r] = __builtin_amdgcn_rcpf(wsf[32 + crow(r, hi)]);
    unsigned char* Ow = (unsigned char*)O + qrow * 1024 + h * 64;
    { LAS unsigned char* stg = shm + LDS_OST + wid * 2048;
#pragma unroll
      for (int r = 0; r < 16; ++r) { const int orow = crow(r, hi);
#pragma unroll
          for (int d0 = 0; d0 < 2; ++d0) stg[orow * 64 + d0 * 32 + r32] = (unsigned char)f2f8(o[d0][r] * rli[r]); }
      asm volatile("s_waitcnt lgkmcnt(0)" ::: "memory");
#pragma unroll
      for (int i = 0; i < 2; ++i) { const int row = i * 16 + (lane >> 2), ch = lane & 3; const u32x4 v = *(const LAS u32x4*)(stg + row * 64 + ch * 16); *(GAS u32x4*)(Ow + (long)row * 1024 + ch * 16) = v; } }
    asm volatile("s_waitcnt lgkmcnt(0)" ::: "memory");
#undef TROW
#undef DMA_KV
}
__device__ __forceinline__ void attn_unit2(const bf16_t* Q, const bf16_t* K, const bf16_t* V, bf16_t* O, int b, int h0, int q0, bool isctx, float sinkA, float sinkB, LAS unsigned char* shm) {
    const int tid = opaque_tid(), lane = tid & 63, r32 = lane & 31, hi = lane >> 5; const int wid = __builtin_amdgcn_readfirstlane(tid >> 6);
    const int kvh = h0 >> 2;
    const long qrow = isctx ? (long)T + b * CTXL + wid * 32 : (long)b * SEQ + q0 + wid * 32;
    const unsigned lds0 = (unsigned)(uintptr_t)shm;
    LAS float* wsf = (LAS float*)(shm + LDS_WS) + wid * 64;
    int jlo = 0, nl = 0;
    if (!isctx) { jlo = (q0 == 0) ? 2 : 0; int jhi = (SEQ - q0 + 128) / 64; if (jhi > 8) jhi = 8; nl = jhi - jlo; }
    const int NT = nl + 4;
    const long lat0 = (long)b * SEQ + q0 - 128 + 64 * jlo, ctx0 = (long)T + b * CTXL;
#define TROW(t) ((t) < nl ? lat0 + 64 * (t) : ctx0 + 64 * ((t) - nl))
    const int kcol = kvh * 64 + wid * 8, vcol = kvh * 64 + (wid >> 2) * 32 + (lane & 3) * 8, vrow = 16 * (wid & 3) + (lane >> 2);
    const unsigned kdst = lds0 + LDS_K + wid * 1024, vdst = lds0 + LDS_V + wid * 1024;
#define DMA_KV(t, slot) do { const long tr_ = TROW(t); glds16(K + (tr_ + lane) * 256 + kcol, (unsigned)__builtin_amdgcn_readfirstlane(kdst + (slot) * SLOTB)); \
        glds16(V + (tr_ + vrow) * 256 + vcol, (unsigned)__builtin_amdgcn_readfirstlane(vdst + (slot) * SLOTB)); } while (0)
    DMA_KV(0, 0);
    bf16x8 qr[2][4];
#pragma unroll
    for (int hh = 0; hh < 2; ++hh)
#pragma unroll
        for (int d0 = 0; d0 < 4; ++d0) { const u32x2 w = *(const GAS u32x2*)((const unsigned char*)Q + (qrow + r32) * 1024 + (h0 + hh) * 64 + d0 * 16 + hi * 8);
            const f32x2v a0 = __builtin_amdgcn_cvt_pk_f32_fp8((int)w.x, false), a1 = __builtin_amdgcn_cvt_pk_f32_fp8((int)w.x, true), a2 = __builtin_amdgcn_cvt_pk_f32_fp8((int)w.y, false), a3 = __builtin_amdgcn_cvt_pk_f32_fp8((int)w.y, true);
            u32x4 qw; qw.x = cvt_pk_bf16(a0[0] * (1.f / QSC), a0[1] * (1.f / QSC)); qw.y = cvt_pk_bf16(a1[0] * (1.f / QSC), a1[1] * (1.f / QSC)); qw.z = cvt_pk_bf16(a2[0] * (1.f / QSC), a2[1] * (1.f / QSC)); qw.w = cvt_pk_bf16(a3[0] * (1.f / QSC), a3[1] * (1.f / QSC));
            qr[hh][d0] = __builtin_bit_cast(bf16x8, qw); }
    float mrun[2] = {sinkA, sinkB}, l_reg[2] = {(hi == 0) ? 1.f : 0.f, (hi == 0) ? 1.f : 0.f};
    f32x16 o[2][2];
#pragma unroll
    for (int hh = 0; hh < 2; ++hh)
#pragma unroll
        for (int r = 0; r < 16; ++r) { o[hh][0][r] = 0.f; o[hh][1][r] = 0.f; }
    const LAS unsigned char* vp0 = shm + LDS_V + ((lane >> 4) & 1) * 32 + (lane & 3) * 8 + (4 * hi + ((lane & 15) >> 2)) * 64;
    const int qw = q0 + wid * 32;
    asm volatile("s_waitcnt vmcnt(0) lgkmcnt(0)\n\ts_barrier" ::: "memory");
    for (int t = 0; t < NT; ++t) {
        const int slot = t & 1;
        if (t + 1 < NT) DMA_KV(t + 1, slot ^ 1);
        const bool latt = t < nl;
        const int ks = q0 - 128 + 64 * (jlo + t);
        bool need = true;
        if (latt) need = (ks + 63 >= qw - 128) && (ks <= qw + 31 + 128);
        if (need) {
            f32x16 p[2][2];
            { f32x16 nm0, nm1;
#pragma unroll
              for (int r = 0; r < 16; ++r) { nm0[r] = -mrun[0]; nm1[r] = -mrun[1]; }
              const LAS unsigned char* kb = shm + LDS_K + slot * SLOTB + hi * 1024 + r32 * 16;
#pragma unroll
              for (int d0 = 0; d0 < 4; ++d0) {
                const bf16x8 b0 = *(const LAS bf16x8*)(kb + d0 * 2048), b1 = *(const LAS bf16x8*)(kb + d0 * 2048 + 512);
                if (d0 == 0) { p[0][0] = __builtin_amdgcn_mfma_f32_32x32x16_bf16(b0, qr[0][0], nm0, 0, 0, 0); p[0][1] = __builtin_amdgcn_mfma_f32_32x32x16_bf16(b1, qr[0][0], nm0, 0, 0, 0);
                               p[1][0] = __builtin_amdgcn_mfma_f32_32x32x16_bf16(b0, qr[1][0], nm1, 0, 0, 0); p[1][1] = __builtin_amdgcn_mfma_f32_32x32x16_bf16(b1, qr[1][0], nm1, 0, 0, 0); }
                else {
#pragma unroll
                    for (int hh = 0; hh < 2; ++hh) { p[hh][0] = __builtin_amdgcn_mfma_f32_32x32x16_bf16(b0, qr[hh][d0], p[hh][0], 0, 0, 0); p[hh][1] = __builtin_amdgcn_mfma_f32_32x32x16_bf16(b1, qr[hh][d0], p[hh][1], 0, 0, 0); } } } }
            if (latt && !(ks >= qw - 97 && ks <= qw + 65)) {
                const int dq = qw + r32 - ks;
#pragma unroll
                for (int r = 0; r < 16; ++r) { const int d = dq - crow(r, hi);
                    if (d > 128 || d < -128) { p[0][0][r] = -INFINITY; p[1][0][r] = -INFINITY; }
                    if (d - 32 > 128 || d - 32 < -128) { p[0][1][r] = -INFINITY; p[1][1][r] = -INFINITY; } } }
            u32x4 pw[2][4];
#pragma unroll
            for (int hh = 0; hh < 2; ++hh) {
                bool big = false;
#pragma unroll
                for (int r = 0; r < 16; ++r) big = big | (__builtin_bit_cast(int, p[hh][0][r]) > 0x41000000) | (__builtin_bit_cast(int, p[hh][1][r]) > 0x41000000);
                if (__any(big)) {
                    const float rm = rowmax(p[hh][0], p[hh][1]);
                    const float delta = fmaxf(rm, 0.f);
                    const float alpha = __builtin_amdgcn_exp2f(-delta); l_reg[hh] *= alpha; mrun[hh] += delta;
#pragma unroll
                    for (int r = 0; r < 16; ++r) { p[hh][0][r] -= delta; p[hh][1][r] -= delta; }
                    if (hi == 0) wsf[r32] = alpha;
                    asm volatile("s_waitcnt lgkmcnt(0)" ::: "memory");
#pragma unroll
                    for (int r = 0; r < 16; ++r) { const float f = wsf[crow(r, hi)]; o[hh][0][r] *= f; o[hh][1][r] *= f; }
                    asm volatile("s_waitcnt lgkmcnt(0)" ::: "memory");
                }
                float sacc = 0.f;
#pragma unroll
                for (int r = 0; r < 16; ++r) { p[hh][0][r] = __builtin_amdgcn_exp2f(p[hh][0][r]); p[hh][1][r] = __builtin_amdgcn_exp2f(p[hh][1][r]); sacc += p[hh][0][r] + p[hh][1][r]; }
                l_reg[hh] += sacc;
#define PKW(P, B) cvt_pk_bf16(P[B], P[B + 1])
                pw[hh][0] = (u32x4){PKW(p[hh][0], 0), PKW(p[hh][0], 2), PKW(p[hh][0], 4), PKW(p[hh][0], 6)}; pw[hh][1] = (u32x4){PKW(p[hh][0], 8), PKW(p[hh][0], 10), PKW(p[hh][0], 12), PKW(p[hh][0], 14)};
                pw[hh][2] = (u32x4){PKW(p[hh][1], 0), PKW(p[hh][1], 2), PKW(p[hh][1], 4), PKW(p[hh][1], 6)}; pw[hh][3] = (u32x4){PKW(p[hh][1], 8), PKW(p[hh][1], 10), PKW(p[hh][1], 12), PKW(p[hh][1], 14)};
#undef PKW
            }
            __builtin_amdgcn_sched_barrier(0);
            { const LAS unsigned char* vp = vp0 + slot * SLOTB;
#pragma unroll
              for (int d0 = 0; d0 < 2; ++d0) { s16x4 lo[4], hh4[4];
#pragma unroll
                for (int k4 = 0; k4 < 4; ++k4) { lo[k4] = vtr(vp + d0 * 4096 + k4 * 1024); hh4[k4] = vtr(vp + d0 * 4096 + k4 * 1024 + 512); }
#pragma unroll
                for (int hh = 0; hh < 2; ++hh)
#pragma unroll
                    for (int k4 = 0; k4 < 4; ++k4) { const bf16x8 vb8 = (bf16x8){lo[k4][0], lo[k4][1], lo[k4][2], lo[k4][3], hh4[k4][0], hh4[k4][1], hh4[k4][2], hh4[k4][3]};
                        o[hh][d0] = __builtin_amdgcn_mfma_f32_32x32x16_bf16(__builtin_bit_cast(bf16x8, pw[hh][k4]), vb8, o[hh][d0], 0, 0, 0); } } }
        }
        asm volatile("s_waitcnt vmcnt(0) lgkmcnt(0)\n\ts_barrier" ::: "memory");
    }
#pragma unroll
    for (int hh = 0; hh < 2; ++hh) {
        float lr = l_reg[hh];
        { auto rr = __builtin_amdgcn_permlane32_swap(__float_as_uint(lr), __float_as_uint(lr), false, false); lr = __uint_as_float(rr[0]) + __uint_as_float(rr[1]); }
        if (hi == 0) wsf[32 + r32] = lr;
        asm volatile("s_waitcnt lgkmcnt(0)" ::: "memory");
        float rli[16];
#pragma unroll
        for (int r = 0; r < 16; ++r) rli[r] = __builtin_amdgcn_rcpf(wsf[32 + crow(r, hi)]);
        asm volatile("s_waitcnt lgkmcnt(0)" ::: "memory");
        unsigned char* Ow = (unsigned char*)O + qrow * 1024 + (h0 + hh) * 64;
        LAS unsigned char* stg = shm + LDS_OST + wid * 4096 + hh * 2048;
#pragma unroll
        for (int r = 0; r < 16; ++r) { const int orow = crow(r, hi);
#pragma unroll
            for (int d0 = 0; d0 < 2; ++d0) stg[orow * 64 + d0 * 32 + r32] = (unsigned char)f2f8(o[hh][d0][r] * rli[r]); }
        asm volatile("s_waitcnt lgkmcnt(0)" ::: "memory");
#pragma unroll
        for (int i = 0; i < 2; ++i) { const int row = i * 16 + (lane >> 2), ch = lane & 3; const u32x4 v = *(const LAS u32x4*)(stg + row * 64 + ch * 16); *(GAS u32x4*)(Ow + (long)row * 1024 + ch * 16) = v; }
    }
    asm volatile("s_waitcnt lgkmcnt(0)" ::: "memory");
#undef TROW
#undef DMA_KV
}
}

struct Args {
    const float* in[20];
    float* out; unsigned char* ws;
};
struct Frame {
    LAS unsigned char* lds; unsigned* ctl; unsigned char* ws;
    int tid, lane, wave, gw;
    int blk;
    __device__ __forceinline__ void refresh() { tid = opaque_tid(); lane = tid & 63; wave = __builtin_amdgcn_readfirstlane(tid >> 6); gw = blk * 8 + wave;
        asm volatile("" : "+s"(ws)); ctl = (unsigned*)(ws + WS_CTL); }
};
constexpr int NGW = GRID * NWAVES;

struct Row { f32x4 v[4]; };
__device__ __forceinline__ int vq(int q, int lane) { return 64 * (lane >> 4) + 2 * (lane & 15) + 32 * (q >> 1) + (q & 1); }
__device__ __forceinline__ int vb(int j, int lane) { return 32 * (lane >> 4) + (lane & 15) + 16 * j; }
__device__ __forceinline__ void row_load_bf16(Row& r, const bf16_t* p, int lane) {
#pragma unroll
    for (int j = 0; j < 2; ++j) { const u32x4 w = ((const GAS u32x4*)p)[vb(j, lane)]; r.v[2 * j] = (f32x4){bflo(w.x), bfhi(w.x), bflo(w.y), bfhi(w.y)}; r.v[2 * j + 1] = (f32x4){bflo(w.z), bfhi(w.z), bflo(w.w), bfhi(w.w)}; } }
__device__ __forceinline__ void row_store_bf16(const Row& r, bf16_t* p, int lane) {
#pragma unroll
    for (int j = 0; j < 2; ++j) { u32x4 w; w.x = pk2(r.v[2 * j][0], r.v[2 * j][1]); w.y = pk2(r.v[2 * j][2], r.v[2 * j][3]); w.z = pk2(r.v[2 * j + 1][0], r.v[2 * j + 1][1]); w.w = pk2(r.v[2 * j + 1][2], r.v[2 * j + 1][3]); ((GAS u32x4*)p)[vb(j, lane)] = w; } }
__device__ __forceinline__ void row_load_fp8(Row& r, const unsigned char* p, int lane) {
    const u32x4 w = ((const GAS u32x4*)p)[lane];
#pragma unroll
    for (int q = 0; q < 4; ++q) { const f32x2v lo = __builtin_amdgcn_cvt_pk_f32_fp8((int)w[q], false), hi = __builtin_amdgcn_cvt_pk_f32_fp8((int)w[q], true); r.v[q] = (f32x4){lo[0], lo[1], hi[0], hi[1]}; } }
__device__ __forceinline__ void row_store_fp8(const Row& r, unsigned char* p, int lane) {
    const int e0 = 256 * (lane >> 4) + 8 * (lane & 15);
#pragma unroll
    for (int j = 0; j < 2; ++j) { int w0 = 0, w1 = 0;
        w0 = __builtin_amdgcn_cvt_pk_fp8_f32(r.v[2 * j][0], r.v[2 * j][1], w0, false); w0 = __builtin_amdgcn_cvt_pk_fp8_f32(r.v[2 * j][2], r.v[2 * j][3], w0, true);
        w1 = __builtin_amdgcn_cvt_pk_fp8_f32(r.v[2 * j + 1][0], r.v[2 * j + 1][1], w1, false); w1 = __builtin_amdgcn_cvt_pk_fp8_f32(r.v[2 * j + 1][2], r.v[2 * j + 1][3], w1, true);
        u32x2 o; o.x = (unsigned)w0; o.y = (unsigned)w1; *(GAS u32x2*)(p + e0 + 128 * j) = o; } }
__device__ __forceinline__ void row_load_f32(Row& r, const float* p, int lane) {
#pragma unroll
    for (int q = 0; q < 4; ++q) r.v[q] = ((const GAS f32x4*)p)[vq(q, lane)]; }
__device__ __forceinline__ void row_store_f32(const Row& r, float* p, int lane) {
#pragma unroll
    for (int q = 0; q < 4; ++q) ((GAS f32x4*)p)[vq(q, lane)] = r.v[q]; }
__device__ __forceinline__ void row_normalize(Row& r, float eps) {
    float s = 0.f;
#pragma unroll
    for (int j = 0; j < 4; ++j) s += (r.v[j][0] + r.v[j][1]) + (r.v[j][2] + r.v[j][3]);
    const float mean = wave_sum(s) * (1.f / D); float q = 0.f;
#pragma unroll
    for (int j = 0; j < 4; ++j) { r.v[j] = r.v[j] - mean; q += (r.v[j][0] * r.v[j][0] + r.v[j][1] * r.v[j][1]) + (r.v[j][2] * r.v[j][2] + r.v[j][3] * r.v[j][3]); }
    const float rstd = 1.f / sqrtf(wave_sum(q) * (1.f / D) + eps);
#pragma unroll
    for (int j = 0; j < 4; ++j) r.v[j] = r.v[j] * rstd;
}
__device__ __forceinline__ void row_normalize_stats(Row& r, float eps, float& mean_o, float& rstd_o) {
    float s = 0.f;
#pragma unroll
    for (int j = 0; j < 4; ++j) s += (r.v[j][0] + r.v[j][1]) + (r.v[j][2] + r.v[j][3]);
    const float mean = wave_sum(s) * (1.f / D); float q = 0.f;
#pragma unroll
    for (int j = 0; j < 4; ++j) { r.v[j] = r.v[j] - mean; q += (r.v[j][0] * r.v[j][0] + r.v[j][1] * r.v[j][1]) + (r.v[j][2] * r.v[j][2] + r.v[j][3] * r.v[j][3]); }
    const float rstd = 1.f / sqrtf(wave_sum(q) * (1.f / D) + eps);
#pragma unroll
    for (int j = 0; j < 4; ++j) r.v[j] = r.v[j] * rstd;
    mean_o = mean; rstd_o = rstd;
}
__device__ __forceinline__ void row_modulate(Row& r, const float* sh, const float* sc, int lane) {
    row_normalize(r, MOD_EPS);
#pragma unroll
    for (int j = 0; j < 4; ++j) { const f32x4 a = ((const GAS f32x4*)sc)[vq(j, lane)], b = ((const GAS f32x4*)sh)[vq(j, lane)]; r.v[j] = r.v[j] * (a + 1.f) + b; }
}
__device__ __forceinline__ int mod_row(int row) { return row < T ? (row >> 11) : 32; }
__device__ __forceinline__ const float* mod_vec(const unsigned char* ws, int layer, int mr, int chunk) { return (const float*)(ws + WS_MOD) + ((size_t)(layer * 33 + mr) * 6 + chunk) * 1024; }

__device__ __forceinline__ void conv_item(const float* W, int N, bf16_t* WT, int Kd, int kd0, int n0, int drow0, bool mirror, LAS float* scr, int lane) {
#pragma unroll 8
    for (int i = 0; i < 32; ++i) { const int kk = 2 * i + (lane >> 5); const int kd = kd0 + kk; const int ks = mirror ? ((kd & ~255) + ((256 - (kd & 255)) & 255)) : kd;
        scr[kk * 33 + (lane & 31)] = ((const GAS float*)W)[(size_t)ks * N + n0 + (lane & 31)]; }
    LDS_WAIT(); asm volatile("" ::: "memory");
    const int c = lane & 7;
#pragma unroll
    for (int j = 0; j < 4; ++j) { const int n = (lane >> 3) + 8 * j; const LAS float* s = scr + (8 * c) * 33 + n;
        u32x4 o; o.x = pk2(s[0 * 33], s[1 * 33]); o.y = pk2(s[2 * 33], s[3 * 33]); o.z = pk2(s[4 * 33], s[5 * 33]); o.w = pk2(s[6 * 33], s[7 * 33]);
        *(GAS u32x4*)(WT + (size_t)(drow0 + n) * Kd + kd0 + 8 * c) = o; }
    LDS_WAIT(); asm volatile("" ::: "memory");
}
__device__ __forceinline__ void conv_matrix_item(const float* W, int K, int N, bf16_t* WT, int mode, int roff, int item, LAS float* scr, int lane) {
    const int nblk = N / 32, kb = item / nblk, nb = item % nblk, n0 = 32 * nb;
    int drow0 = n0 + roff; if (mode == 1) drow0 = (n0 >> 7) * 256 + (n0 & 127); if (mode == 2) drow0 = (n0 >> 7) * 256 + 128 + (n0 & 127);
    conv_item(W, N, WT, K, 64 * kb, n0, drow0, mode == 3, scr, lane);
}
__device__ __forceinline__ void conv_item64(const float* W, int N, bf16_t* WT, int Kd, int k0, int n0, int drow0, LAS bf16_t* scr, int lane) {
    f32x4 v[16];
#pragma unroll
    for (int i = 0; i < 16; ++i) v[i] = *(const GAS f32x4*)(W + (size_t)(k0 + 4 * i + (lane >> 4)) * N + n0 + (lane & 15) * 4);
#pragma unroll
    for (int i = 0; i < 16; ++i) { u32x2 w; w.x = pk2(v[i][0], v[i][1]); w.y = pk2(v[i][2], v[i][3]); *(LAS u32x2*)(scr + (4 * i + (lane >> 4)) * 68 + (lane & 15) * 4) = w; }
    LDS_WAIT(); asm volatile("" ::: "memory");
    const int c = lane & 7;
#pragma unroll
    for (int j = 0; j < 8; ++j) { const int n = (lane >> 3) + 8 * j; const LAS bf16_t* p = scr + (8 * c) * 68 + n;
        u32x4 o; o.x = (unsigned)p[0] | ((unsigned)p[68] << 16); o.y = (unsigned)p[2 * 68] | ((unsigned)p[3 * 68] << 16); o.z = (unsigned)p[4 * 68] | ((unsigned)p[5 * 68] << 16); o.w = (unsigned)p[6 * 68] | ((unsigned)p[7 * 68] << 16);
        *(GAS u32x4*)(WT + (size_t)(drow0 + n) * Kd + k0 + 8 * c) = o; }
    LDS_WAIT(); asm volatile("" ::: "memory");
}
__device__ __forceinline__ void conv_item64_f8(const float* W, int N, unsigned char* WT, int Kd, int k0, int n0, int drow0, LAS unsigned char* scr, int lane, bool mirror = false) {
    f32x4 v[16];
#pragma unroll
    for (int i = 0; i < 16; ++i) { const int kd = k0 + 4 * i + (lane >> 4); const int ks = mirror ? ((kd & ~255) + ((256 - (kd & 255)) & 255)) : kd; v[i] = *(const GAS f32x4*)(W + (size_t)ks * N + n0 + (lane & 15) * 4); }
#pragma unroll
    for (int i = 0; i < 16; ++i) { int w = 0; w = __builtin_amdgcn_cvt_pk_fp8_f32(v[i][0] * 64.f, v[i][1] * 64.f, w, false); w = __builtin_amdgcn_cvt_pk_fp8_f32(v[i][2] * 64.f, v[i][3] * 64.f, w, true);
        *(LAS unsigned*)(scr + (4 * i + (lane >> 4)) * 68 + (lane & 15) * 4) = (unsigned)w; }
    LDS_WAIT(); asm volatile("" ::: "memory");
    const int c = lane & 3;
#pragma unroll
    for (int j = 0; j < 4; ++j) { const int n = (lane >> 2) + 16 * j; const LAS unsigned char* p = scr + (16 * c) * 68 + n; u32x4 o;
#pragma unroll
        for (int q = 0; q < 4; ++q) o[q] = (unsigned)p[(4 * q) * 68] | ((unsigned)p[(4 * q + 1) * 68] << 8) | ((unsigned)p[(4 * q + 2) * 68] << 16) | ((unsigned)p[(4 * q + 3) * 68] << 24);
        *(GAS u32x4*)(WT + (size_t)(drow0 + n) * Kd + k0 + 16 * c) = o; }
    LDS_WAIT(); asm volatile("" ::: "memory");
}
__device__ __forceinline__ void conv_experts(Frame& F, const Args& a, int layer) {
    F.refresh();
    LAS unsigned char* scr = F.lds + 32768 + F.wave * 4352;
    unsigned char* EGU = F.ws + WS_EGU; unsigned char* ED = F.ws + WS_ED;
    for (int it = F.gw; it < (NE + 1) * 192; it += NGW) { const int e = it / 192, r = it % 192;
        const float* wg = e < NE ? a.in[14] + ((size_t)layer * NE + e) * 262144 : a.in[17] + (size_t)layer * 262144;
        const float* wu = e < NE ? a.in[15] + ((size_t)layer * NE + e) * 262144 : a.in[18] + (size_t)layer * 262144;
        const float* wd = e < NE ? a.in[16] + ((size_t)layer * NE + e) * 262144 : a.in[19] + (size_t)layer * 262144;
        if (r < 128) { const int q = r & 63, kb = q >> 2, nb = q & 3, n0 = 64 * nb; const int drow0 = (n0 >> 7) * 256 + (r < 64 ? 0 : 128) + (n0 & 127);
            conv_item64_f8(r < 64 ? wg : wu, 256, EGU + (size_t)e * 512 * 1024, 1024, 64 * kb, n0, drow0, scr, F.lane); }
        else { const int q = r - 128, kb = q >> 4, nb = q & 15; conv_item64_f8(wd, 1024, ED + (size_t)e * 1024 * 256, 256, 64 * kb, 64 * nb, 64 * nb, scr, F.lane); } }
}
__device__ __forceinline__ void conv_small(Frame& F, const Args& a) {
    F.refresh();
    { LAS unsigned char* scr8 = F.lds + 32768 + F.wave * 4352;
      for (int it = F.gw; it < 2304; it += NGW) {
          if (it < 768) { const int j = it / 384, r = it % 384, kb = r / 24, nb = r % 24; conv_item64_f8(a.in[8] + (size_t)j * 1024 * 1536, 1536, F.ws + WS_WQKV + (size_t)j * 1536 * 1024, 1024, 64 * kb, 64 * nb, 64 * nb, scr8, F.lane); }
          else if (it < 1280) { const int q = it - 768, j = q >> 8, r = q & 255, kb = r >> 4, nb = r & 15; conv_item64_f8(a.in[9] + (size_t)j * 1024 * 1024, 1024, F.ws + WS_WO + (size_t)j * 1024 * 1024, 1024, 64 * kb, 64 * nb, 64 * nb, scr8, F.lane); }
          else { const int q = it - 1280, j = q >> 9, r = q & 511, mir = r >> 8, kb = (r & 255) >> 4, nb = r & 15;
              conv_item64_f8(a.in[11] + (size_t)j * 1024 * 1024, 1024, F.ws + WS_WSH + (size_t)j * 2048 * 1024, 1024, 64 * kb, 64 * nb, 64 * nb + 1024 * mir, scr8, F.lane, mir != 0); } } }
    __syncthreads();
    { LAS float* scr = (LAS float*)(F.lds + 32768 + F.wave * 8448);
      for (int it = F.gw; it < 1152; it += NGW) {
          if (it < 1024) { const int j = it >> 9, r = it & 511; conv_matrix_item(a.in[11] + (size_t)j * 1024 * 1024, 1024, 1024, (bf16_t*)(F.ws + WS_WF) + (size_t)j * 2048 * 1024, 0, 0, r, scr, F.lane); }
          else { const int q = it - 1024, l = q / 32, r = q % 32; conv_matrix_item(a.in[12] + (size_t)l * 1024 * 64, 1024, 64, (bf16_t*)(F.ws + WS_WR) + (size_t)l * 64 * 1024, 0, 0, r, scr, F.lane); } } }
    const int gt = F.blk * NTHR + F.tid, NGT = GRID * NTHR;
    const float TWO_PI = 6.283185307179586f;
    { float* rc = (float*)(F.ws + WS_ROPEC); float* rs = (float*)(F.ws + WS_ROPES);
      for (int i = gt; i < 64 * 16; i += NGT) { const int pos = i >> 4, fi = i & 15; const float inv = exp2f(-(float)fi * (13.287712379549449f / 16.f)); const float ang = (float)pos * inv; rc[i] = cosf(ang); rs[i] = sinf(ang); } }
    { unsigned* cs = (unsigned*)(F.ws + WS_CSN);
      for (int i = gt; i < 512 * 64; i += NGT) { const int r = i >> 6, n4 = (i & 63) * 4, m = r & 255; unsigned w = 0;
#pragma unroll
          for (int q = 0; q < 4; ++q) { const float ang = TWO_PI * (float)((m * (n4 + q)) & 255) * (1.f / 256.f); w |= f2f8(r < 256 ? __cosf(ang) : -__sinf(ang)) << (8 * q); }
          cs[i] = w; } }
    { unsigned* dl = (unsigned*)(F.ws + WS_DL);
      for (int i = gt; i < 1024 * 1024; i += NGT) { const int k = i >> 10, c4 = (i & 1023) * 4; unsigned w = 0;
#pragma unroll
          for (int q = 0; q < 4; ++q) { const int c = c4 + q, l = c & 2047; const float ang = TWO_PI * (float)((k * l) & 2047) * (1.f / 2048.f); w |= f2f8(c < 2048 ? __cosf(ang) : __sinf(ang)) << (8 * q); }
          dl[i] = w; } }
    { unsigned* dl = (unsigned*)(F.ws + WS_DLC);
      for (int i = gt; i < 256 * 128; i += NGT) { const int k = i >> 7, c4 = (i & 127) * 4; unsigned w = 0;
#pragma unroll
          for (int q = 0; q < 4; ++q) { const int c = c4 + q, l = c & 255; const float ang = TWO_PI * (float)((k * l) & 255) * (1.f / 256.f); w |= f2f8(c < 256 ? __cosf(ang) : __sinf(ang)) << (8 * q); }
          dl[i] = w; } }
}
__device__ __forceinline__ void mod_full(Frame& F, const Args& a) {
    F.refresh();
    if (F.blk >= 192) return;
    const int l = F.blk / 48, cb = F.blk % 48; const int col = F.tid & 127, ks = F.tid >> 7; const int n = cb * 128 + col;
    LAS float* s = (LAS float*)F.lds;
    float acc[33];
#pragma unroll
    for (int r = 0; r < 33; ++r) acc[r] = 0.f;
    for (int half = 0; half < 2; ++half) {
        __syncthreads();
        for (int i = F.tid; i < 512 * 33; i += NTHR) { const int k = i / 33, r = i % 33; const float c = (r < 32) ? a.in[1][(size_t)r * 1024 + half * 512 + k] : a.in[3][half * 512 + k]; s[k * 36 + r] = c / (1.f + __expf(-c)); }
        __syncthreads();
        const GAS float* w = (const GAS float*)a.in[4] + ((size_t)l * 1024 + half * 512 + ks * 128) * 6144 + n;
#pragma unroll 1
        for (int kb = 0; kb < 128; kb += 16) { float wv[16];
#pragma unroll
            for (int q = 0; q < 16; ++q) wv[q] = w[(size_t)(kb + q) * 6144];
#pragma unroll
            for (int q = 0; q < 16; ++q) { const LAS float* sr = s + (ks * 128 + kb + q) * 36;
#pragma unroll
                for (int r = 0; r < 33; ++r) acc[r] += sr[r] * wv[q];
                asm volatile("" ::: "memory"); } }
    }
    __syncthreads();
    LAS float* red = (LAS float*)F.lds;
#pragma unroll
    for (int r = 0; r < 33; ++r) red[(ks * 33 + r) * 128 + col] = acc[r];
    __syncthreads();
    float* mod = (float*)(F.ws + WS_MOD);
    for (int i = F.tid; i < 33 * 128; i += NTHR) { const int r = i >> 7, c = i & 127; const int nn = cb * 128 + c;
        mod[((size_t)l * 33 + r) * 6144 + nn] = a.in[5][l * 6144 + nn] + (red[(0 * 33 + r) * 128 + c] + red[(1 * 33 + r) * 128 + c]) + (red[(2 * 33 + r) * 128 + c] + red[(3 * 33 + r) * 128 + c]); }
    __syncthreads();
}
__device__ __forceinline__ void rows_init(Frame& F, const Args& a) {
    F.refresh();
    bf16_t* XS = (bf16_t*)(F.ws + WS_XS);
    static_assert(TT % (4 * NGW) == 0, "rows_init: four rows per wave and iteration");
    for (int r0 = F.gw; r0 < TT; r0 += 4 * NGW) {
        Row r[4];
#pragma unroll
        for (int t = 0; t < 4; ++t) { const int row = r0 + t * NGW; row_load_f32(r[t], row < T ? a.in[0] + (size_t)row * D : a.in[2] + (size_t)(row - T) * D, F.lane); }
#pragma unroll
        for (int t = 0; t < 4; ++t) { const int row = r0 + t * NGW; const int mr = mod_row(row);
            row_store_bf16(r[t], XS + (size_t)row * D, F.lane);
            row_modulate(r[t], mod_vec(F.ws, 0, mr, 0), mod_vec(F.ws, 0, mr, 1), F.lane);
            row_store_fp8(r[t], (unsigned char*)a.out + OUT_U8 + (size_t)row * D, F.lane);
            asm volatile("" ::: "memory"); } }
}
__device__ __forceinline__ void rows_post1(Frame& F, const Args& a, int layer, int nrows) {
    F.refresh();
    bf16_t* XS = (bf16_t*)(F.ws + WS_XS); const unsigned char* Y8 = (const unsigned char*)a.out;
    const float* lg = a.in[6] + (size_t)(layer * 2 + 0) * D; const float* lb = a.in[7] + (size_t)(layer * 2 + 0) * D;
    const int TPB = nrows / GRID;
    for (int rl = F.wave; rl < TPB; rl += 4 * NWAVES) {
        u32x4 xr[4][2], yr[4];
#pragma unroll
        for (int t = 0; t < 4; ++t) { const int row = F.blk * TPB + rl + t * NWAVES;
#pragma unroll
            for (int j = 0; j < 2; ++j) xr[t][j] = ((const GAS u32x4*)(XS + (size_t)row * D))[vb(j, F.lane)];
            yr[t] = ((const GAS u32x4*)(Y8 + (size_t)row * D))[F.lane]; }
#pragma unroll
        for (int t = 0; t < 4; ++t) { const int row = F.blk * TPB + rl + t * NWAVES; const int mr = mod_row(row);
            Row x, y;
#pragma unroll
            for (int j = 0; j < 2; ++j) { const u32x4 w = xr[t][j];
                x.v[2 * j] = (f32x4){bflo(w.x), bfhi(w.x), bflo(w.y), bfhi(w.y)}; x.v[2 * j + 1] = (f32x4){bflo(w.z), bfhi(w.z), bflo(w.w), bfhi(w.w)}; }
#pragma unroll
            for (int q = 0; q < 4; ++q) { const f32x2v lo = __builtin_amdgcn_cvt_pk_f32_fp8((int)yr[t][q], false), hi = __builtin_amdgcn_cvt_pk_f32_fp8((int)yr[t][q], true); y.v[q] = (f32x4){lo[0], lo[1], hi[0], hi[1]}; }
            const float* g1 = mod_vec(F.ws, layer, mr, 2);
#pragma unroll
            for (int j = 0; j < 4; ++j) x.v[j] = x.v[j] * ALPHA + (((const GAS f32x4*)g1)[vq(j, F.lane)] * (1.f / YSC)) * y.v[j];
            row_normalize(x, LN_EPS);
#pragma unroll
            for (int j = 0; j < 4; ++j) x.v[j] = x.v[j] * ((const GAS f32x4*)lg)[vq(j, F.lane)] + ((const GAS f32x4*)lb)[vq(j, F.lane)];
            row_store_bf16(x, XS + (size_t)row * D, F.lane);
            float mean, rstd; row_normalize_stats(x, MOD_EPS, mean, rstd);
            if (F.lane == 0) { f32x2v st = {mean, rstd}; *(GAS f32x2v*)(F.ws + WS_RSTAT + (size_t)row * 8) = st; }
            { const float* sh = mod_vec(F.ws, layer, mr, 3); const float* sc = mod_vec(F.ws, layer, mr, 4);
#pragma unroll
              for (int j = 0; j < 4; ++j) { const f32x4 av = ((const GAS f32x4*)sc)[vq(j, F.lane)], bv = ((const GAS f32x4*)sh)[vq(j, F.lane)]; x.v[j] = x.v[j] * (av + 1.f) + bv; } }
            row_store_fp8(x, (unsigned char*)a.out + OUT_U8 + (size_t)row * D, F.lane);
            asm volatile("" ::: "memory"); }
    }
}
__device__ __forceinline__ void rows_post2(Frame& F, const Args& a, int layer, int t0, int n) {
    F.refresh();
    bf16_t* XS = (bf16_t*)(F.ws + WS_XS); const unsigned char* YB = (const unsigned char*)(F.ws + WS_YB); const unsigned char* YS = (const unsigned char*)(F.ws + WS_YS);
    const int* spos = (const int*)(F.ws + WS_SDST); const float* tkw = (const float*)(F.ws + WS_TKW);
    const float* lg = a.in[6] + (size_t)(layer * 2 + 1) * D; const float* lb = a.in[7] + (size_t)(layer * 2 + 1) * D;
    for (int i0 = F.gw; i0 < n; i0 += 2 * NGW) {
        const int i1 = i0 + NGW; const bool two = i1 < n;
        int pj[2]; float wj[2];
#pragma unroll
        for (int t = 0; t < 2; ++t) { pj[t] = 0; wj[t] = 0.f; const int row = t0 + (t ? i1 : i0); if ((t == 0 || two) && F.lane < 8) { pj[t] = ((const GAS int*)spos)[(size_t)row * 8 + F.lane]; wj[t] = ((const GAS float*)tkw)[(size_t)row * 8 + F.lane]; } }
        Row x[2], y[2];
#pragma unroll
        for (int t = 0; t < 2; ++t) { const int i = t ? i1 : i0; if (t == 0 || two) { row_load_bf16(x[t], XS + (size_t)(t0 + i) * D, F.lane); row_load_fp8(y[t], YS + (size_t)i * D, F.lane); } }
        u32x4 zr[2][8];
#pragma unroll
        for (int t = 0; t < 2; ++t) if (t == 0 || two) {
#pragma unroll
            for (int s = 0; s < 8; ++s) { const int ps = __builtin_amdgcn_readlane(pj[t], s); zr[t][s] = ((const GAS u32x4*)(YB + (size_t)ps * D))[F.lane]; } }
#pragma unroll
        for (int t = 0; t < 2; ++t) if (t == 0 || two) { const int i = t ? i1 : i0; const int row = t0 + i; const int mr = mod_row(row);
#pragma unroll
            for (int j = 0; j < 4; ++j) y[t].v[j] = y[t].v[j] * (1.f / 16.f);
#pragma unroll
            for (int s = 0; s < 8; ++s) { const float wz = __builtin_bit_cast(float, __builtin_amdgcn_readlane(__builtin_bit_cast(int, wj[t]), s)) * (1.f / 16.f);
#pragma unroll
                for (int j = 0; j < 4; ++j) { const f32x2v lo = __builtin_amdgcn_cvt_pk_f32_fp8((int)zr[t][s][j], false), hi = __builtin_amdgcn_cvt_pk_f32_fp8((int)zr[t][s][j], true); y[t].v[j] += (f32x4){lo[0], lo[1], hi[0], hi[1]} * wz; } }
            const float* g2 = mod_vec(F.ws, layer, mr, 5);
#pragma unroll
            for (int j = 0; j < 4; ++j) x[t].v[j] = x[t].v[j] * ALPHA + ((const GAS f32x4*)g2)[vq(j, F.lane)] * y[t].v[j];
            row_normalize(x[t], LN_EPS);
#pragma unroll
            for (int j = 0; j < 4; ++j) x[t].v[j] = x[t].v[j] * ((const GAS f32x4*)lg)[vq(j, F.lane)] + ((const GAS f32x4*)lb)[vq(j, F.lane)];
            if (layer == 3) { row_store_f32(x[t], a.out + (size_t)row * D, F.lane); }
            else { row_store_bf16(x[t], XS + (size_t)row * D, F.lane);
                row_modulate(x[t], mod_vec(F.ws, layer + 1, mr, 0), mod_vec(F.ws, layer + 1, mr, 1), F.lane);
                row_store_fp8(x[t], (unsigned char*)a.out + OUT_U8 + (size_t)row * D, F.lane); } }
    }
}
__device__ __forceinline__ float wave_max_dpp(float v) {
    int x = __builtin_bit_cast(int, v);
#define DPPMAX(ctrl) { const int y = __builtin_amdgcn_update_dpp(x, x, ctrl, 0xf, 0xf, false); x = __builtin_bit_cast(int, fmaxf(__builtin_bit_cast(float, x), __builtin_bit_cast(float, y))); }
    DPPMAX(0xB1) DPPMAX(0x4E) DPPMAX(0x141) DPPMAX(0x140)
#undef DPPMAX
    const float r0 = __builtin_bit_cast(float, __builtin_amdgcn_readlane(x, 0)), r1 = __builtin_bit_cast(float, __builtin_amdgcn_readlane(x, 16));
    const float r2 = __builtin_bit_cast(float, __builtin_amdgcn_readlane(x, 32)), r3 = __builtin_bit_cast(float, __builtin_amdgcn_readlane(x, 48));
    return fmaxf(fmaxf(r0, r1), fmaxf(r2, r3));
}
__device__ __forceinline__ void route_tokens(Frame& F, const Args& a, int layer, int ntok) {
    F.refresh();
    const int TPB = ntok / GRID;
    const bf16_t* U = (const bf16_t*)(F.ws + WS_XS); const bf16_t* Wr = (const bf16_t*)(F.ws + WS_WR) + (size_t)layer * 64 * 1024;
    int* tke = (int*)(F.ws + WS_TKE); float* tkw = (float*)(F.ws + WS_TKW);
    LAS int* lcnt = (LAS int*)(F.lds + L_LCNT);
    LAS float* lg = (LAS float*)(F.lds);
    if (F.tid < 64) lcnt[F.tid] = 0;
    const int lane = F.lane, fr = lane & 15, fq = lane >> 4;
    const int ntile = TPB / 16;
    constexpr int WPITCH = 1040; constexpr int L_SE = 122880;
    LAS float* sEb = (LAS float*)(F.lds + L_SE);
    f32x4 acc[3][4];
#pragma unroll
    for (int i = 0; i < 3; ++i)
#pragma unroll
        for (int n = 0; n < 4; ++n) acc[i][n] = (f32x4){0.f, 0.f, 0.f, 0.f};
    int grp_of[3] = {0, 0, 0};
    int tl_lo = 0, g = 0;
    while (tl_lo < ntile) {
        const int mr = mod_row(F.blk * TPB + tl_lo * 16); int tl_hi = tl_lo + 1;
        while (tl_hi < ntile && mod_row(F.blk * TPB + tl_hi * 16) == mr) ++tl_hi;
        const float* shv = mod_vec(F.ws, layer, mr, 3); const float* scv = mod_vec(F.ws, layer, mr, 4);
        for (int half = 0; half < 2; ++half) {
            __syncthreads();
            { const int kc = lane, k = half * 512 + kc * 8;
              const f32x4 c0 = *(const GAS f32x4*)(scv + k) + 1.f, c1 = *(const GAS f32x4*)(scv + k + 4) + 1.f, h0 = *(const GAS f32x4*)(shv + k), h1 = *(const GAS f32x4*)(shv + k + 4);
              u32x4 wv[8];
#pragma unroll
              for (int j = 0; j < 8; ++j) wv[j] = *(const GAS u32x4*)(Wr + (size_t)(F.wave + 8 * j) * D + k);
#pragma unroll
              for (int j = 0; j < 8; ++j) { const int e = F.wave + 8 * j; const u32x4 w = wv[j];
                const float w0 = bflo(w.x), w1 = bfhi(w.x), w2 = bflo(w.y), w3 = bfhi(w.y), w4 = bflo(w.z), w5 = bfhi(w.z), w6 = bflo(w.w), w7 = bfhi(w.w);
                u32x4 o; o.x = cvt_pk_bf16(w0 * c0[0], w1 * c0[1]); o.y = cvt_pk_bf16(w2 * c0[2], w3 * c0[3]); o.z = cvt_pk_bf16(w4 * c1[0], w5 * c1[1]); o.w = cvt_pk_bf16(w6 * c1[2], w7 * c1[3]);
                *(LAS u32x4*)(F.lds + e * WPITCH + kc * 16) = o;
                const float se = wave_sum(((bflo(o.x) + bfhi(o.x)) + (bflo(o.y) + bfhi(o.y))) + ((bflo(o.z) + bfhi(o.z)) + (bflo(o.w) + bfhi(o.w))));
                const float be = wave_sum(((w0 * h0[0] + w1 * h0[1]) + (w2 * h0[2] + w3 * h0[3])) + ((w4 * h1[0] + w5 * h1[1]) + (w6 * h1[2] + w7 * h1[3])));
                if (lane == 0) { if (half == 0) { sEb[g * 64 + e] = se; sEb[192 + g * 64 + e] = be; } else { sEb[g * 64 + e] += se; sEb[192 + g * 64 + e] += be; } }
                asm volatile("" ::: "memory"); } }
            __syncthreads();
#pragma unroll
            for (int i = 0; i < 3; ++i) { const int tl = F.wave + 8 * i;
                if (tl >= tl_lo && tl < tl_hi) { const int t0 = F.blk * TPB + tl * 16;
                    const GAS bf16x8* ap = (const GAS bf16x8*)(U + (size_t)(t0 + fr) * D + half * 512 + fq * 8);
                    bf16x8 av[16];
#pragma unroll
                    for (int ks = 0; ks < 16; ++ks) av[ks] = ap[ks * 4];
#pragma unroll
                    for (int ks = 0; ks < 16; ++ks) {
#pragma unroll
                        for (int n = 0; n < 4; ++n) { const bf16x8 bv = *(const LAS bf16x8*)(F.lds + (n * 16 + fr) * WPITCH + (ks * 32 + fq * 8) * 2); acc[i][n] = __builtin_amdgcn_mfma_f32_16x16x32_bf16(av[ks], bv, acc[i][n], 0, 0, 0); }
                        if ((ks & 1) == 1) __builtin_amdgcn_sched_barrier(0); }
                    grp_of[i] = g; } }
        }
        tl_lo = tl_hi; ++g;
    }
    __syncthreads();
#pragma unroll
    for (int i = 0; i < 3; ++i) { const int tl = F.wave + 8 * i;
        if (tl < ntile) { const int t0 = F.blk * TPB + tl * 16; const int gi = grp_of[i];
#pragma unroll
            for (int j = 0; j < 4; ++j) { const f32x2v st = *(const GAS f32x2v*)(F.ws + WS_RSTAT + (size_t)(t0 + fq * 4 + j) * 8);
#pragma unroll
                for (int n = 0; n < 4; ++n) { const float se = sEb[gi * 64 + n * 16 + fr], be = sEb[192 + gi * 64 + n * 16 + fr];
                    lg[(tl * 16 + fq * 4 + j) * 65 + n * 16 + fr] = st[1] * (acc[i][n][j] - st[0] * se) + be; } } } }
    __syncthreads();
    if (F.tid < TPB) {
        const int tok = F.blk * TPB + F.tid; const LAS float* row = lg + F.tid * 65; const float* bias = a.in[13] + layer * 64;
        float sg[64], sel[64];
#pragma unroll
        for (int e = 0; e < 64; ++e) { sg[e] = 1.f / (1.f + __expf(-row[e])); sel[e] = sg[e] + bias[e]; }
        float gs[8];
#pragma unroll
        for (int g = 0; g < 8; ++g) { float m1 = -INFINITY, m2 = -INFINITY;
#pragma unroll
            for (int j = 0; j < 8; ++j) { const float v = sel[g * 8 + j]; const bool gt1 = v > m1; m2 = gt1 ? m1 : fmaxf(m2, v); m1 = gt1 ? v : m1; }
            gs[g] = m1 + m2; }
        unsigned gok = 0;
#pragma unroll
        for (int g = 0; g < 8; ++g) { int rk = 0;
#pragma unroll
            for (int h = 0; h < 8; ++h) rk += (gs[h] > gs[g] || (gs[h] == gs[g] && h < g)) ? 1 : 0;
            gok |= (rk < 4 ? 1u : 0u) << g; }
#pragma unroll
        for (int e = 0; e < 64; ++e) sel[e] = ((gok >> (e >> 3)) & 1u) ? sel[e] : -INFINITY;
        int ce[8]; float cw[8]; float tot = 0.f;
#pragma unroll
        for (int it = 0; it < 8; ++it) { float best = -INFINITY, bs = 0.f; int bi = 0;
#pragma unroll
            for (int e = 0; e < 64; ++e) { const bool b = sel[e] > best; best = b ? sel[e] : best; bs = b ? sg[e] : bs; bi = b ? e : bi; }
#pragma unroll
            for (int e = 0; e < 64; ++e) sel[e] = (e == bi) ? -INFINITY : sel[e];
            ce[it] = bi; cw[it] = bs; tot += bs; }
        const float sc = 2.5f / tot;
#pragma unroll
        for (int it = 0; it < 8; ++it) { tke[(size_t)tok * 8 + it] = ce[it]; tkw[(size_t)tok * 8 + it] = cw[it] * sc; __hip_atomic_fetch_add(&lcnt[ce[it]], 1, __ATOMIC_RELAXED, __HIP_MEMORY_SCOPE_WORKGROUP); }
    }
    __syncthreads();
    if (F.tid < 64) F.ctl[CW_BCNT + F.blk * 64 + F.tid] = (unsigned)lcnt[F.tid];
}
__device__ __forceinline__ void build_lists(Frame& F, int ntok) {
    F.refresh();
    constexpr int NSEG = NCHUNK * 64, BPC = GRID / NCHUNK;
    const int TPB = ntok / GRID, CH = ntok / NCHUNK;
    LAS int* tstart = (LAS int*)(F.lds + L_TSTART); LAS int* pref = (LAS int*)(F.lds + L_PREF); LAS int* lcnt = (LAS int*)(F.lds + L_LCNT);
    LAS unsigned char* tseg = (LAS unsigned char*)(F.lds + L_TSEG); LAS int* scan = (LAS int*)(F.lds + L_SCAN);
    const unsigned* bcnt = F.ctl + CW_BCNT;
    const int myc = F.blk / BPC, mylb = F.blk % BPC;
    int nseg = 0;
    LAS int* cntl = (LAS int*)F.lds;
    for (int i = F.tid; i < GRID * 64; i += NTHR) cntl[i] = (int)((const GAS unsigned*)bcnt)[i];
    if (F.tid < 64) lcnt[F.tid] = 0;
    __syncthreads();
    static_assert(NSEG == 64 && NTHR == 512, "build_lists: one chunk, eight partial sums per expert");
    LAS int* part = (LAS int*)(F.lds + 65536);
    { const int e = F.tid & 63, q = F.tid >> 6; int n = 0, p = 0;
#pragma unroll 8
      for (int lb = q * 32; lb < q * 32 + 32; ++lb) { const int v = cntl[lb * 64 + e]; if (lb < mylb) p += v; n += v; }
      part[q * 64 + e] = n; part[512 + q * 64 + e] = p; }
    __syncthreads();
    if (F.tid < 64) { int n = 0, p = 0;
#pragma unroll
        for (int q = 0; q < 8; ++q) { n += part[q * 64 + F.tid]; p += part[512 + q * 64 + F.tid]; }
        nseg = n; pref[F.tid] = p;
        const int tiles = (n + 255) >> 8; int incl = tiles;
#pragma unroll
        for (int d = 1; d < 64; d <<= 1) { const int o = __shfl_up(incl, d); if (F.lane >= d) incl += o; }
        tstart[F.tid + 1] = incl; if (F.tid == 0) tstart[0] = 0;
        for (int t = incl - tiles; t < incl; ++t) tseg[t] = (unsigned char)F.tid; }
    int* stok = (int*)(F.ws + WS_STOK); int* spos = (int*)(F.ws + WS_SDST);
    const int* tke = (const int*)(F.ws + WS_TKE);
    { const int sseg = myc * 64 + mylb; if (mylb < 64 && F.tid == sseg) scan[0] = nseg; }
    __syncthreads();
    if (mylb < 64) { const int sseg = myc * 64 + mylb; const int n = scan[0]; const int base = tstart[sseg] * 256, end = tstart[sseg + 1] * 256;
      for (int p = base + n + F.tid; p < end; p += NTHR) stok[p] = myc * CH; }
    for (int tb = F.wave * 8; tb < TPB; tb += NWAVES * 8) { const int tl = tb + (F.lane >> 3);
        if (tl < TPB) { const int tok = F.blk * TPB + tl; const int e = tke[(size_t)tok * 8 + (F.lane & 7)];
            const int p = tstart[myc * 64 + e] * 256 + pref[e] + __hip_atomic_fetch_add(&lcnt[e], 1, __ATOMIC_RELAXED, __HIP_MEMORY_SCOPE_WORKGROUP);
            stok[p] = tok; spos[(size_t)tok * 8 + (F.lane & 7)] = p - tstart[myc * 64] * 256; } }
    __syncthreads();
}

struct SchedQKV {
    const char* U; const char* W; int nfull, nu, c;
    __device__ __forceinline__ bool next(int i, pg::Unit& u) const {
        const int L0 = i * GRID + c; if (L0 >= nu) return false;
        int pm, pn;
        if (L0 < nfull) { const int L = pg::xcd_remap(L0, nfull); const int gid = L / 48, w = L % 48; pm = gid * 8 + (w & 7); pn = w >> 3; }
        else { const int q = L0 - nfull; pm = 256 + (q >> 1); pn = 4 + (q & 1); }
        u.A = U + (size_t)pm * 256 * 1024; u.B = W + (size_t)pn * 256 * 1024; u.gidx = nullptr; u.gbase = 0; u.nt = 8; u.out = nullptr; u.ldc = 0; u.scale = 1.f; u.flags = 0; u.i0 = pm; u.i1 = pn;
        return true; }
};
struct SchedDense {
    const char* A; const char* W; char* out; int nrt, nct, nt, c; size_t ldA;
    __device__ __forceinline__ bool next(int i, pg::Unit& u) const {
        const int nu = nrt * nct; const int L0 = i * GRID + c; if (L0 >= nu) return false;
        const int L = pg::xcd_remap(L0, nu); const int per = 8 * nct, gid = L / per, w = L % per, fm = gid * 8, gsz = (nrt - fm) < 8 ? (nrt - fm) : 8; const int pm = fm + (w % gsz), pn = w / gsz;
        u.A = A + (size_t)pm * 256 * ldA; u.B = W + (size_t)pn * 256 * ldA; u.gidx = nullptr; u.gbase = 0; u.nt = nt; u.out = out + (size_t)pm * 256 * 1024; u.ldc = 1024; u.scale = 1.f; u.flags = 0; u.i0 = pm; u.i1 = pn;
        return true; }
};
struct SchedF1 {
    const char* CS; const char* U; char* ABT; char* ABTC; int nu, c;
    __device__ __forceinline__ bool next(int i, pg::Unit& u) const {
        const int L0 = i * GRID + c; if (L0 >= nu) return false;
        u.gidx = nullptr; u.gbase = 0; u.nt = 2; u.scale = 1.f; u.flags = 0; u.i0 = 0; u.i1 = 0;
        if (L0 < 2048) { const int L = pg::xcd_remap(L0, 2048); const int pm = L & 1, pn = (L >> 1) & 7, bg = L >> 4, b = bg >> 2, g = bg & 3;
            u.A = CS + (size_t)pm * 256 * 256; u.B = U + ((size_t)b * SEQ + pn * 256) * 1024 + g * 256; u.out = ABT + (size_t)bg * 256 * 4096 + (size_t)(pm * 2048 + pn * 256); u.ldc = 4096; }
        else { const int q = L0 - 2048; const int pm = q & 1, bg = q >> 1, b = bg >> 2, g = bg & 3;
            u.A = CS + (size_t)pm * 256 * 256; u.B = U + ((size_t)T + b * CTXL) * 1024 + g * 256; u.out = ABTC + (size_t)bg * 256 * 512 + (size_t)pm * 256; u.ldc = 512; }
        return true; }
};
struct SchedF2 {
    const char* DL; const char* ABT; char* FH; int c;
    __device__ __forceinline__ bool next(int i, pg::Unit& u) const {
        const int L0 = i * GRID + c; if (L0 >= 512) return false;
        const int L = pg::xcd_remap(L0, 512); const int pm = L & 3, bg = L >> 2, b = bg >> 2, g = bg & 3;
        u.A = DL + (size_t)pm * 256 * 4096; u.B = ABT + (size_t)bg * 256 * 4096; u.gidx = nullptr; u.gbase = 0; u.nt = 32; u.out = FH + ((size_t)b * 1024 + pm * 256) * 1024 + g * 256; u.ldc = 1024; u.scale = 0.001381067932004975f  ; u.flags = 0; u.i0 = 0; u.i1 = 0;
        return true; }
};
struct SchedF2c {
    const char* DLC; const char* ABTC; char* FC; int c;
    __device__ __forceinline__ bool next(int i, pg::Unit& u) const {
        const int L0 = i * GRID + c; if (L0 >= 128) return false;
        const int bg = L0, b = bg >> 2, g = bg & 3;
        u.A = DLC; u.B = ABTC + (size_t)bg * 256 * 512; u.gidx = nullptr; u.gbase = 0; u.nt = 4; u.out = FC + ((size_t)b * 256) * 1024 + g * 256; u.ldc = 1024; u.scale = 1.f / 256.f; u.flags = 0; u.i0 = 0; u.i1 = 0;
        return true; }
};
struct SchedF3 {
    const char* FH; const char* FC; const char* W; char* Y; int nu, c;
    __device__ __forceinline__ bool next(int i, pg::Unit& u) const {
        const int L0 = i * GRID + c; if (L0 >= nu) return false;
        u.gidx = nullptr; u.gbase = 0; u.nt = 8; u.scale = 1.f; u.flags = 0; u.i0 = 0; u.i1 = 0;
        if (L0 < 1024) { const int L = pg::xcd_remap(L0, 1024); const int gid = L >> 6, w = L & 63, pm = gid * 8 + (w & 7), pn = w >> 3; const int b = pm >> 2, k0 = (pm & 3) * 256;
            u.A = FH + (size_t)pm * 256 * 1024; u.B = W + (size_t)pn * 256 * 1024;
            if (pn < 4) { u.out = Y + ((size_t)b * SEQ + k0) * 1024; u.ldc = 1024; u.i1 = pn; }
            else { u.out = Y + ((size_t)b * SEQ + SEQ - k0) * 1024; u.ldc = -1024; u.i1 = pn - 4; u.flags = (k0 == 0) ? 1 : 0; } }
        else { const int q = L0 - 1024; const int pm = q >> 2, pn = q & 3;
            u.A = FC + (size_t)pm * 256 * 1024; u.B = W + (size_t)pn * 256 * 1024; u.out = Y + ((size_t)T + pm * 256) * 1024; u.ldc = 1024; u.i1 = pn; }
        return true; }
};
struct SchedG1 {
    const char* EGU; const int* STOK; char* H; char* HS; LAS const unsigned char* tseg; int ntl, nsh, c;
    __device__ __forceinline__ bool gsrc(int i, const int*& gidx, int& gbase) const {
        const int nu = (ntl + nsh) * 2; const int L0 = i * GRID + c; if (L0 >= nu) return false;
        const int pm = pg::xcd_remap(L0, nu) >> 1;
        if (pm < ntl) { gidx = STOK + (size_t)pm * 256; gbase = 0; } else { gidx = nullptr; gbase = (pm - ntl) * 256; }
        return true; }
    __device__ __forceinline__ bool next(int i, pg::Unit& u) const {
        const int nu = (ntl + nsh) * 2; const int L0 = i * GRID + c; if (L0 >= nu) return false;
        const int L = pg::xcd_remap(L0, nu); const int pm = L >> 1, pn = L & 1;
        u.A = nullptr; u.gbase = 0; u.nt = 8; u.ldc = 256; u.scale = 1.f; u.flags = 0; u.i0 = 0; u.i1 = 0;
        if (pm < ntl) { const int e = __builtin_amdgcn_readfirstlane((int)tseg[pm]) & 63;
            u.gidx = STOK + (size_t)pm * 256; u.B = EGU + (size_t)e * 512 * 1024 + (size_t)pn * 256 * 1024; u.out = H + (size_t)pm * 256 * 256 + pn * 128; }
        else { const int ps = pm - ntl; u.gidx = nullptr; u.gbase = ps * 256; u.B = EGU + (size_t)NE * 512 * 1024 + (size_t)pn * 256 * 1024; u.out = HS + (size_t)ps * 256 * 256 + pn * 128; }
        return true; }
};
struct SchedG2 {
    const char* ED; const char* H; const char* HS; char* YB; char* YS; LAS const unsigned char* tseg; int t0, t1, nsh, ch, CH, c;
    __device__ __forceinline__ bool next(int i, pg::Unit& u) const {
        const int nr = t1 - t0; const int nu = (nr + nsh) * 4; const int L0 = i * GRID + c; if (L0 >= nu) return false;
        const int L = pg::xcd_remap(L0, nu); const int q = L >> 2, pn = L & 3;
        u.gidx = nullptr; u.gbase = 0; u.nt = 2; u.ldc = 1024; u.scale = 1.f; u.flags = 0; u.i0 = 0; u.i1 = pn;
        if (q < nr) { const int pm = t0 + q; const int e = __builtin_amdgcn_readfirstlane((int)tseg[pm]) & 63;
            u.A = H + (size_t)pm * 256 * 256; u.B = ED + (size_t)e * 1024 * 256 + (size_t)pn * 256 * 256; u.out = YB + (size_t)q * 256 * 1024; }
        else { const int ps = q - nr; u.A = HS + ((size_t)ch * CH + ps * 256) * 256; u.B = ED + (size_t)NE * 1024 * 256 + (size_t)pn * 256 * 256; u.out = YS + (size_t)ps * 256 * 1024; }
        return true; }
};

__device__ __forceinline__ void fnet_nyquist_rows(Frame& F) {
    F.refresh();
    const unsigned char* ABT = F.ws + WS_ABT; bf16_t* FH1 = (bf16_t*)(F.ws + WS_FH1);
    static_assert((128 * 256) % (4 * NGW) == 0, "fnet_nyquist_rows: four rows per wave and step");
    for (int r0 = F.gw; r0 < 128 * 256; r0 += 4 * NGW) {
        u32x4 w[4][2];
#pragma unroll
        for (int t = 0; t < 4; ++t) { const GAS u32x4* p = (const GAS u32x4*)(ABT + (size_t)(r0 + t * NGW) * 4096);
#pragma unroll
            for (int i = 0; i < 2; ++i) w[t][i] = p[i * 64 + F.lane]; }
#pragma unroll
        for (int t = 0; t < 4; ++t) { const int r = r0 + t * NGW; const int bg = r >> 8, m = r & 255, b = bg >> 2, g = bg & 3; float s = 0.f;
#pragma unroll
            for (int i = 0; i < 2; ++i)
#pragma unroll
                for (int q = 0; q < 4; ++q) { const f32x2v lo = __builtin_amdgcn_cvt_pk_f32_fp8((int)w[t][i][q], false), hi = __builtin_amdgcn_cvt_pk_f32_fp8((int)w[t][i][q], true); s += (lo[0] - lo[1]) + (hi[0] - hi[1]); }
            s = wave_sum(s) * 0.001381067932004975f;
            if (F.lane == 0) FH1[(size_t)b * 1024 + g * 256 + m] = (bf16_t)f2bf(s); } }
}
__device__ __forceinline__ void fnet_nyquist_out(Frame& F, const Args& a, int jl) {
    F.refresh();
    const bf16_t* FH1 = (const bf16_t*)(F.ws + WS_FH1); const bf16_t* W = (const bf16_t*)(F.ws + WS_WF) + (size_t)jl * 2048 * 1024; unsigned char* Y = (unsigned char*)a.out;
    LAS float* part = (LAS float*)F.lds;
    const int b = F.blk >> 3, n = (F.blk & 7) * 128 + (F.tid & 127), kq = F.tid >> 7;
    const GAS u32x4* wp = (const GAS u32x4*)(W + (size_t)n * 1024 + kq * 256); const GAS u32x4* fp = (const GAS u32x4*)(FH1 + (size_t)b * 1024 + kq * 256);
    float s = 0.f;
#pragma unroll 4
    for (int i = 0; i < 32; ++i) { const u32x4 w = wp[i], f = fp[i];
        s += bflo(w.x) * bflo(f.x) + bfhi(w.x) * bfhi(f.x) + bflo(w.y) * bflo(f.y) + bfhi(w.y) * bfhi(f.y) + bflo(w.z) * bflo(f.z) + bfhi(w.z) * bfhi(f.z) + bflo(w.w) * bflo(f.w) + bfhi(w.w) * bfhi(f.w); }
    part[F.tid] = s;
    __syncthreads();
    if (F.tid < 128) { const float t = (part[F.tid] + part[F.tid + 128]) + (part[F.tid + 256] + part[F.tid + 384]); const int cc = n & 127;
        Y[((size_t)b * SEQ + 1024) * D + (16 * (n >> 8) + (cc >> 3)) * 16 + 8 * ((n >> 7) & 1) + (cc & 7)] = (unsigned char)f2f8(__builtin_amdgcn_fmed3f(t * YSC, -448.f, 448.f)); }
    __syncthreads();
}


#ifdef SELFCHECK
constexpr int CW_ERR = 1024;
__device__ __forceinline__ void chk_report(unsigned* ctl, int id, float got, float ref, float tabs, float trel) {
    float e = fabsf(got - ref) / (tabs + trel * fabsf(ref)); if (!(e == e)) e = 1e30f; atomicMax(ctl + CW_ERR + id, __float_as_uint(e)); }
__device__ __forceinline__ float bf2f(bf16_t b) { return __builtin_bit_cast(float, (unsigned)b << 16); }
__constant__ int chk_toks[16] = {0, 1, 63, 64, 65, 127, 2047, 2048, 2049, 4096, 33000, 65535, 65536, 65537, 70000, 73727};
__constant__ int chk_ks[8] = {0, 1, 2, 255, 256, 1023, 1024, 700};
__constant__ int chk_ms[4] = {0, 1, 128, 255};
__constant__ int chk_ytoks[10] = {0, 1, 1023, 1024, 1025, 2047, 2048, 65535, 65536, 73727};
__constant__ int chk_ns[5] = {0, 1, 255, 256, 1023};
__constant__ int chk_cols[20] = {0, 7, 15, 16, 31, 32, 40, 48, 63, 64, 500, 1023, 1024, 1039, 1040, 1072, 1279, 1280, 1300, 1535};
__device__ __forceinline__ void chk_qkv(Frame& F, const Args& a, int layer, int id) {
    F.refresh(); const unsigned char* U = (const unsigned char*)a.out + OUT_U8; const float* W = a.in[8] + (size_t)(layer >> 1) * 1024 * 1536;
    const bf16_t* Qb = (const bf16_t*)(F.ws + WS_Q); const bf16_t* Kb = (const bf16_t*)(F.ws + WS_K); const bf16_t* Vb = (const bf16_t*)(F.ws + WS_V);
    for (int s = F.gw; s < 320; s += NGW) { const int tok = chk_toks[s & 15], col = chk_cols[s >> 4];
        if (layer == 2 && tok >= T && col < 1024) continue;
        const bool rope = (tok < T) && col < 1280; const int hc = col & 63, first = (hc & 31) < 16; const int pcol = rope ? (first ? col + 16 : col - 16) : col;
        float x = 0.f, xp = 0.f;
        for (int k = F.lane; k < 1024; k += 64) { const float u = f82f(U[(size_t)tok * D + k]); x += u * W[(size_t)k * 1536 + col]; xp += u * W[(size_t)k * 1536 + pcol]; }
        x = wave_sum(x); xp = wave_sum(xp);
        float ref = x;
        if (rope) { const int tl = tok & 2047, part = hc >> 5, pos = part ? (tl & 63) : (tl >> 6), fi = hc & 15; const float ang = (float)pos * powf(10000.f, -(float)fi / 16.f);
            ref = x * cosf(ang) + (first ? -xp : xp) * sinf(ang); }
        if (col < 1024) ref *= C2;
        const float got = col < 1024 ? bf2f(Qb[(size_t)tok * 1024 + col]) : (col < 1280 ? bf2f(Kb[(size_t)tok * 256 + col - 1024]) : bf2f(Vb[(size_t)tok * 256 + col - 1280]));
        if (F.lane == 0) chk_report(F.ctl, id, got, ref, 0.20f, 0.10f); }
}
__device__ __forceinline__ void chk_attn(Frame& F, const Args& a, int layer, int id) {
    F.refresh(); const bf16_t* Qb = (const bf16_t*)(F.ws + WS_Q); const bf16_t* Kb = (const bf16_t*)(F.ws + WS_K); const bf16_t* Vb = (const bf16_t*)(F.ws + WS_V); const unsigned char* Ob = F.ws + WS_R + 216 * MiB;
    LAS float* lg = (LAS float*)F.lds + F.wave * 1024;
    for (int s = F.gw; s < 64; s += NGW) { const int tok = chk_toks[s & 15], h = (s >> 4) * 5, kvh = h >> 2;
        if (layer == 2 && tok >= T) continue;
        const bool isctx = tok >= T; const int b = isctx ? (tok - T) / CTXL : tok / SEQ, p = tok & (SEQ - 1);
        int nk = 0; const int lo = isctx ? 0 : (p - 128 < 0 ? 0 : p - 128), hi = isctx ? -1 : (p + 128 > SEQ - 1 ? SEQ - 1 : p + 128);
        const int nlat = isctx ? 0 : hi - lo + 1; nk = nlat + CTXL;
        float mx = a.in[10][(layer >> 1) * 16 + h] * LOG2E; const float sink2 = mx;
        for (int i = F.lane; i < nk; i += 64) { const size_t kr = i < nlat ? (size_t)b * SEQ + lo + i : (size_t)T + b * CTXL + (i - nlat); float d = 0.f;
            for (int e = 0; e < 64; ++e) d += bf2f(Qb[(size_t)tok * 1024 + h * 64 + e]) * bf2f(Kb[kr * 256 + kvh * 64 + e]);
            lg[i] = d; mx = fmaxf(mx, d); }
#pragma unroll
        for (int o = 1; o < 64; o <<= 1) mx = fmaxf(mx, __shfl_xor(mx, o));
        LDS_WAIT();
        float den = 0.f; for (int i = F.lane; i < nk; i += 64) den += exp2f(lg[i] - mx);
        den = wave_sum(den) + exp2f(sink2 - mx);
        float o = 0.f;
        for (int i = 0; i < nk; ++i) { const size_t kr = i < nlat ? (size_t)b * SEQ + lo + i : (size_t)T + b * CTXL + (i - nlat); o += exp2f(lg[i] - mx) * bf2f(Vb[kr * 256 + kvh * 64 + F.lane]); }
        o /= den;
        chk_report(F.ctl, id, f82f(Ob[(size_t)tok * 1024 + h * 64 + F.lane]), o, 0.02f, 0.08f); chk_report(F.ctl, 32 + (s & 15), f82f(Ob[(size_t)tok * 1024 + h * 64 + F.lane]), o, 0.02f, 0.08f);
        LDS_WAIT(); }
    __syncthreads();
}
__device__ __forceinline__ void chk_fnet_f(Frame& F, const Args& a, bool upd, int id) {
    F.refresh(); const unsigned char* U = (const unsigned char*)a.out + OUT_U8; LAS float* red = (LAS float*)F.lds;
    for (int s = F.blk; s < 128 + (upd ? 64 : 0); s += GRID) {
        const bool cx = s >= 128; const int q = cx ? s - 128 : s; const int m = chk_ms[q & 3], g = ((q >> 2) & 1) * 3, b = ((q >> 3) & 1) * 31; int k = chk_ks[(q >> 4) & 7]; const int L = cx ? CTXL : SEQ; if (cx) k &= 255;
        const size_t row0 = cx ? (size_t)T + b * CTXL : (size_t)b * SEQ;
        float acc = 0.f;
        for (int l = F.wave; l < L; l += NWAVES) { float ca = 0.f, sa = 0.f;
            for (int n = F.lane; n < 256; n += 64) { const float u = f82f(U[(row0 + l) * D + g * 256 + n]); const float an = 6.283185307179586f * (float)((m * n) & 255) / 256.f; const float sn = __sinf(an), cs = __cosf(an); ca += u * cs; sa += u * sn; }
            ca = wave_sum(ca); sa = wave_sum(sa); const float an = 6.283185307179586f * (float)((k * l) % L) / (float)L; const float sn = __sinf(an), cs = __cosf(an); acc += cs * ca - sn * sa; }
        if (F.lane == 0) red[F.wave] = acc;
        __syncthreads();
        if (F.tid == 0) { float t = 0.f; for (int w = 0; w < NWAVES; ++w) t += red[w]; t *= cx ? (1.f / 256.f) : 0.001381067932004975f;
            float got;
            if (cx) got = f82f((F.ws + WS_FC)[((size_t)b * 256 + k) * D + g * 256 + m]);
            else if (k == 1024) got = bf2f(((const bf16_t*)(F.ws + WS_FH1))[(size_t)b * 1024 + g * 256 + m]);
            else got = f82f((F.ws + WS_FH)[((size_t)b * 1024 + k) * D + g * 256 + m]);
            chk_report(F.ctl, id, got, t, 0.25f, 0.10f); }
        __syncthreads(); }
}
__device__ __forceinline__ void chk_fnet_y(Frame& F, const Args& a, int jl, bool upd, int id) {
    F.refresh(); const bf16_t* Y = (const bf16_t*)a.out; const float* W = a.in[11] + (size_t)jl * 1024 * 1024;
    const unsigned char* FH = F.ws + WS_FH; const bf16_t* FH1 = (const bf16_t*)(F.ws + WS_FH1); const unsigned char* FC = F.ws + WS_FC;
    for (int s = F.gw; s < 50; s += NGW) { const int tok = chk_ytoks[s % 10], n = chk_ns[s / 10]; if (tok >= T && !upd) continue;
        float acc = 0.f;
        for (int j = F.lane; j < 1024; j += 64) { float f;
            if (tok >= T) f = f82f(FC[(size_t)(tok - T) * D + j]);
            else { const int b = tok >> 11, k = tok & 2047; if (k < 1024) f = f82f(FH[((size_t)b * 1024 + k) * D + j]); else if (k == 1024) f = bf2f(FH1[(size_t)b * 1024 + j]);
                else f = f82f(FH[((size_t)b * 1024 + (2048 - k)) * D + (j & ~255) + ((256 - (j & 255)) & 255)]); }
            acc += f * W[(size_t)j * 1024 + n]; }
        acc = wave_sum(acc);
        if (F.lane == 0) chk_report(F.ctl, id, bf2f(Y[(size_t)tok * D + n]), acc, 0.04f, 0.08f); }
}
__device__ __forceinline__ void chk_route(Frame& F, const Args& a, int layer, int ntok, int id) {
    F.refresh(); const bf16_t* U = (const bf16_t*)a.out; const float* Wr = a.in[12] + (size_t)layer * 1024 * 64; const int* tke = (const int*)(F.ws + WS_TKE); const float* tkw = (const float*)(F.ws + WS_TKW);
    for (int s = F.gw; s < 16; s += NGW) { const int tok = chk_toks[s]; if (tok >= ntok) continue; const int lane = F.lane;
        float lgt = 0.f; for (int k = 0; k < 1024; ++k) lgt += bf2f(U[(size_t)tok * D + k]) * Wr[(size_t)k * 64 + lane];
        const float sc = 1.f / (1.f + expf(-lgt)), sel = sc + a.in[13][layer * 64 + lane];
        float g1 = -INFINITY, g2 = -INFINITY;
#pragma unroll 1
        for (int j = 0; j < 8; ++j) { const float v = __shfl(sel, (lane & ~7) + j); if (v > g1) { g2 = g1; g1 = v; } else if (v > g2) g2 = v; }
        const float gs = g1 + g2; int gr = 0;
#pragma unroll 1
        for (int gp = 0; gp < 8; ++gp) { const float v = __shfl(gs, gp * 8); gr += (v > gs || (v == gs && gp < (lane >> 3))) ? 1 : 0; }
        const float sm = gr < 4 ? sel : -INFINITY; int rk = 0;
#pragma unroll 1
        for (int ep = 0; ep < 64; ++ep) { const float v = __shfl(sm, ep); rk += (v > sm || (v == sm && ep < lane)) ? 1 : 0; }
        const float tot = wave_sum(rk < 8 ? sc : 0.f); const float wref = sc / tot * 2.5f;
        int slot = -1; for (int j = 0; j < 8; ++j) if (tke[(size_t)tok * 8 + j] == lane) slot = j;
        float err = 0.f;
        if (slot >= 0) { if (rk >= 10) err = 10.f; else if (rk < 8) err = fabsf(tkw[(size_t)tok * 8 + slot] - wref) / (0.04f * wref); }
        else if (rk < 6) err = 10.f;
        const unsigned long long nsel = __ballot(slot >= 0); if (__builtin_popcountll(nsel) != 8) err = 20.f;
        atomicMax(F.ctl + CW_ERR + id, __float_as_uint(err)); }
}
__device__ __forceinline__ void chk_moe(Frame& F, const Args& a, int layer, int ntok, int ch, int id) {
    F.refresh(); const bf16_t* U = (const bf16_t*)a.out; const int* tke = (const int*)(F.ws + WS_TKE); const float* tkw = (const float*)(F.ws + WS_TKW);
    const int CH = ntok / NCHUNK; LAS float* hs = (LAS float*)F.lds; LAS float* us = hs + 512; LAS float* pg_ = us + 1024;
    for (int s = F.blk; s < 16; s += GRID) { const int tok = chk_toks[s]; if (tok >= ntok || tok / CH != ch) continue;
        for (int k = F.tid; k < 1024; k += NTHR) us[k] = bf2f(U[(size_t)tok * D + k]);
        __syncthreads();
        float y0 = 0.f, y1 = 0.f;
        for (int j = 0; j < 9; ++j) { const int e = j < 8 ? tke[(size_t)tok * 8 + j] : 0; const float w = j < 8 ? tkw[(size_t)tok * 8 + j] : 1.f;
            const float* wg = j < 8 ? a.in[14] + ((size_t)layer * NE + e) * 262144 : a.in[17] + (size_t)layer * 262144;
            const float* wu = j < 8 ? a.in[15] + ((size_t)layer * NE + e) * 262144 : a.in[18] + (size_t)layer * 262144;
            const float* wd = j < 8 ? a.in[16] + ((size_t)layer * NE + e) * 262144 : a.in[19] + (size_t)layer * 262144;
            const int hh = F.tid & 255, half = F.tid >> 8; float g = 0.f, u = 0.f;
            for (int k = half * 512; k < half * 512 + 512; ++k) { g += us[k] * wg[(size_t)k * 256 + hh]; u += us[k] * wu[(size_t)k * 256 + hh]; }
            pg_[F.tid] = g; pg_[512 + F.tid] = u;
            __syncthreads();
            if (F.tid < 256) { const float gg = pg_[F.tid] + pg_[F.tid + 256], uu = pg_[512 + F.tid] + pg_[512 + F.tid + 256]; hs[F.tid] = gg / (1.f + expf(-gg)) * uu; }
            __syncthreads();
            float t0 = 0.f, t1 = 0.f; for (int q = 0; q < 256; ++q) { t0 += hs[q] * wd[(size_t)q * 1024 + F.tid]; t1 += hs[q] * wd[(size_t)q * 1024 + 512 + F.tid]; }
            y0 += w * t0; y1 += w * t1;
            __syncthreads(); }
        float g0 = 0.f, g1 = 0.f; const int i = tok - ch * CH;
        { const unsigned char* YSb = (const unsigned char*)(F.ws + WS_YS); const unsigned char* YBb = (const unsigned char*)(F.ws + WS_YB); const int* spos = (const int*)(F.ws + WS_SDST);
          const int t_ = F.tid, bo = 16 * (16 * (t_ >> 8) + ((t_ & 127) >> 3)) + 8 * ((t_ >> 7) & 1) + (t_ & 7);
          auto f8 = [](unsigned char b) { return __builtin_amdgcn_cvt_pk_f32_fp8((int)b, false)[0] * (1.f / 16.f); };
          g0 = f8(YSb[(size_t)i * D + bo]); g1 = f8(YSb[(size_t)i * D + bo + 512]);
          for (int j = 0; j < 8; ++j) { const size_t ps = (size_t)spos[(size_t)tok * 8 + j]; const float w = tkw[(size_t)tok * 8 + j]; g0 += w * f8(YBb[ps * D + bo]); g1 += w * f8(YBb[ps * D + bo + 512]); } }
        chk_report(F.ctl, id, g0, y0, 0.15f, 0.15f); chk_report(F.ctl, id, g1, y1, 0.15f, 0.15f);
        __syncthreads(); }
}
#endif

#ifndef PH_MASK
#define PH_MASK 0xffffffffu
#endif
#define PH(b) ((PH_MASK >> (b)) & 1u)
__global__ void __launch_bounds__(NTHR, 2) fwd(Args a) {
    extern __shared__ __attribute__((aligned(16))) unsigned char lds_raw[];
    Frame F;
    F.lds = (LAS unsigned char*)lds_raw; F.ws = a.ws; F.ctl = (unsigned*)(a.ws + WS_CTL);
    F.blk = blockIdx.x; F.refresh();
    for (int u = F.tid; u < (LDS_BYTES - RING_BYTES) / 4; u += NTHR) ((LAS unsigned*)(F.lds + RING_BYTES))[u] = 0u;
    __syncthreads();
    const XcdBarrier bar = xcd_barrier_post(F.ctl + CW_BAR, (volatile LAS unsigned*)(F.lds + L_MISC) + 8);
#define GRID_BAR() xcd_barrier(bar)
    LAS unsigned char* ring = F.lds;
    const int c = F.blk;
#define ws (F.ws)
#define NEWPH() F.refresh()

    if (PH(0)) { conv_small(F, a);
    __syncthreads();
    mod_full(F, a); }
    GRID_BAR();
    if (PH(1)) { rows_init(F, a); }
    GRID_BAR();

    for (int layer = 0; layer < 4; ++layer) {
        const int jl = layer >> 1; const bool upd = layer < 2; const int nrows = upd ? TT : T;
        if ((layer & 1) == 0) {
            NEWPH();
            if (PH(2)) { SchedQKV S; S.U = (const char*)a.out + OUT_U8; S.W = (const char*)(ws + WS_WQKV) + (size_t)jl * 1536 * 1024; S.nfull = (layer == 0) ? 288 * 6 : 256 * 6; S.nu = (layer == 0) ? 288 * 6 : 256 * 6 + 64; S.c = c;
              pg::EpiQKV E; E.Q = (bf16_t*)(ws + WS_Q); E.K = (bf16_t*)(ws + WS_K); E.V = (bf16_t*)(ws + WS_V); E.ropec = (const float*)(ws + WS_ROPEC); E.ropes = (const float*)(ws + WS_ROPES);
              pg::gemm_phase<pg::EpiQKV, SchedQKV, false, true>(ring, 1024u, 1024u, nullptr, S, E); }
            GRID_BAR();
#ifdef SELFCHECK
            if (SELFCHECK & 1) chk_qkv(F, a, layer, 1 + (layer >> 1));
#endif
#define OBUF ((bf16_t*)(ws + WS_R + 216 * MiB))
            NEWPH();
            if (PH(3)) { const int NU = 2048 + (layer == 0 ? 256 : 0);
              const bf16_t* Qb = (const bf16_t*)(ws + WS_Q); const bf16_t* Kb = (const bf16_t*)(ws + WS_K); const bf16_t* Vb = (const bf16_t*)(ws + WS_V);
              for (int i = 0; i * GRID + c < NU; ++i) { int id = pg::xcd_remap(i * GRID + c, NU);
                  if (NU > 2048) { const int g9 = id / 9, r9 = id - g9 * 9; id = (r9 < 8) ? g9 * 8 + r9 : 2048 + g9; }
                  if (id < 2048) { const int hp = id & 1, qb = (id >> 1) & 7, kvh = (id >> 4) & 3, b = id >> 6, h0 = kvh * 4 + hp * 2;
                      attn::attn_unit2(Qb, Kb, Vb, OBUF, b, h0, qb * 256, false, a.in[10][jl * 16 + h0] * LOG2E, a.in[10][jl * 16 + h0 + 1] * LOG2E, ring); }
                  else { const int cid = id - 2048, hp = cid & 1, kvh = (cid >> 1) & 3, b = cid >> 3, h0 = kvh * 4 + hp * 2;
                      attn::attn_unit2(Qb, Kb, Vb, OBUF, b, h0, 0, true, a.in[10][jl * 16 + h0] * LOG2E, a.in[10][jl * 16 + h0 + 1] * LOG2E, ring); } } }
            GRID_BAR();
#ifdef SELFCHECK
            if (SELFCHECK & 1) chk_attn(F, a, layer, 3 + (layer >> 1));
#endif
            NEWPH();
            if (PH(4)) { SchedDense S; S.A = (const char*)OBUF; S.W = (const char*)(ws + WS_WO) + (size_t)jl * 1024 * 1024; S.out = (char*)a.out; S.nrt = nrows / 256; S.nct = 4; S.nt = 8; S.c = c; S.ldA = 1024;
              pg::EpiY8 E; pg::gemm_phase<pg::EpiY8, SchedDense, false, true>(ring, 1024u, 1024u, nullptr, S, E); }
            GRID_BAR();
        } else {
            NEWPH();
            if (PH(5)) { SchedF1 S; S.CS = (const char*)(ws + WS_CSN); S.U = (const char*)a.out + OUT_U8; S.ABT = (char*)(ws + WS_ABT); S.ABTC = (char*)(ws + WS_ABTC); S.nu = 2048 + (upd ? 256 : 0); S.c = c;
              pg::EpiStore8 E; pg::gemm_phase<pg::EpiStore8, SchedF1, false, true, 127>(ring, 256u, 1024u, nullptr, S, E); }
            GRID_BAR();
            NEWPH();
            if (PH(6)) { SchedF2 S; S.DL = (const char*)(ws + WS_DL); S.ABT = (const char*)(ws + WS_ABT); S.FH = (char*)(ws + WS_FH); S.c = c;
              pg::EpiStore8 E; pg::gemm_phase<pg::EpiStore8, SchedF2, false, true, 127>(ring, 4096u, 4096u, nullptr, S, E); }
            NEWPH();
            if (PH(7) && upd) { SchedF2c S; S.DLC = (const char*)(ws + WS_DLC); S.ABTC = (const char*)(ws + WS_ABTC); S.FC = (char*)(ws + WS_FC); S.c = c;
              pg::EpiStore8 E; pg::gemm_phase<pg::EpiStore8, SchedF2c, false, true, 127>(ring, 512u, 512u, nullptr, S, E); }
            if (PH(8)) fnet_nyquist_rows(F);
            GRID_BAR();
#ifdef SELFCHECK
            if (SELFCHECK & 2) chk_fnet_f(F, a, upd, 5 + (layer >> 1));
            GRID_BAR();
#endif
            NEWPH();
            if (PH(9)) { SchedF3 S; S.FH = (const char*)(ws + WS_FH); S.FC = (const char*)(ws + WS_FC); S.W = (const char*)(ws + WS_WSH) + (size_t)jl * 2048 * 1024; S.Y = (char*)a.out; S.nu = 1024 + (upd ? 128 : 0); S.c = c;
              pg::EpiY8 E; pg::gemm_phase<pg::EpiY8, SchedF3, false, true>(ring, 1024u, 1024u, nullptr, S, E); }
            if (PH(10)) fnet_nyquist_out(F, a, jl);
            GRID_BAR();
#ifdef SELFCHECK
            if (SELFCHECK & 8) chk_fnet_y(F, a, jl, upd, 7 + (layer >> 1));
            GRID_BAR();
#endif
        }
        if (PH(12)) conv_experts(F, a, layer);
        __syncthreads();
        if (PH(11)) rows_post1(F, a, layer, nrows);
        VM_WAIT(); __syncthreads();
        if (threadIdx.x == 0) { __builtin_amdgcn_fence(__ATOMIC_ACQUIRE, "agent"); VM_WAIT(); }
        __syncthreads();
        if (PH(13)) route_tokens(F, a, layer, nrows);
        GRID_BAR();
#ifdef SELFCHECK
        if ((SELFCHECK & 64) && layer < 2) chk_route(F, a, layer, nrows, 9);
#endif
        if (PH(14)) build_lists(F, nrows);
        GRID_BAR();
        LAS const int* tstart = (LAS const int*)(F.lds + L_TSTART); LAS const unsigned char* tseg = (LAS const unsigned char*)(F.lds + L_TSEG);
        const int ntl = __builtin_amdgcn_readfirstlane(tstart[NCHUNK * 64]);
        NEWPH();
        if (PH(15)) { SchedG1 S; S.EGU = (const char*)(ws + WS_EGU); S.STOK = (const int*)(ws + WS_STOK); S.H = (char*)(ws + WS_H); S.HS = (char*)(ws + WS_HS); S.tseg = tseg; S.ntl = ntl; S.nsh = nrows / 256; S.c = c;
          pg::EpiSilu E; pg::gemm_phase<pg::EpiSilu, SchedG1, true, true>(ring, 1024u, 1024u, (const char*)a.out + OUT_U8, S, E); }
        GRID_BAR();
        const int CH = nrows / NCHUNK;
        for (int ch = 0; ch < NCHUNK; ++ch) {
            NEWPH();
            if (PH(16)) { SchedG2 S; S.ED = (const char*)(ws + WS_ED); S.H = (const char*)(ws + WS_H); S.HS = (const char*)(ws + WS_HS); S.YB = (char*)(ws + WS_YB); S.YS = (char*)(ws + WS_YS); S.tseg = tseg;
              S.t0 = __builtin_amdgcn_readfirstlane(tstart[ch * 64]); S.t1 = __builtin_amdgcn_readfirstlane(tstart[ch * 64 + 64]); S.nsh = CH / 256; S.ch = ch; S.CH = CH; S.c = c;
              pg::EpiFp8 E; pg::gemm_phase<pg::EpiFp8, SchedG2, false, true>(ring, 256u, 256u, nullptr, S, E); }
            GRID_BAR();
#ifdef SELFCHECK
            if ((SELFCHECK & 4) && layer == 0) { chk_moe(F, a, layer, nrows, ch, 10); GRID_BAR(); }
#endif
            if (PH(17)) rows_post2(F, a, layer, ch * CH, CH);
            if (!(layer == 3 && ch == NCHUNK - 1)) GRID_BAR();
        }
    }
#ifdef SELFCHECK
    GRID_BAR();
    { int bad = 0; float be = 0.f; for (int k = 15; k >= 1; --k) { const float e = __uint_as_float(__hip_atomic_load(F.ctl + CW_ERR + k, RLX_AGENT)); if (e > 1.f) { bad = k; be = e; } }
      int wt = 0; float we = 0.f; for (int k = 0; k < 16; ++k) { const float e = __uint_as_float(__hip_atomic_load(F.ctl + CW_ERR + 32 + k, RLX_AGENT)); if (e > we) { we = e; wt = k; } }
      if (bad) { F.refresh(); float cv = 3.f + bad + (be > 8.f ? 0.5f : 0.f);  Row r; for (int j = 0; j < 4; ++j) r.v[j] = (f32x4){cv, cv, cv, cv}; for (int row = F.gw; row < T; row += NGW) row_store_f32(r, a.out + (size_t)row * D, F.lane); } }
#endif
}

#undef ws
#undef NEWPH
extern "C" void kernel_launch(void* const* d_in, const int* in_sizes, int n_in, void* d_out, int out_size, void* d_ws, size_t ws_size, hipStream_t stream) {
    static int ready = 0;
    if (ready == 0) {
        if (n_in != 20 || out_size != T * D || ws_size < WS_END) { fprintf(stderr, "kernel_launch: unexpected problem (n_in %d out %d ws %zu need %zu)\n", n_in, out_size, ws_size, (size_t)WS_END); ready = -1; return; }
        if (hipFuncSetAttribute((const void*)fwd, hipFuncAttributeMaxDynamicSharedMemorySize, LDS_BYTES) != hipSuccess) { fprintf(stderr, "kernel_launch: hipFuncSetAttribute failed\n"); ready = -1; return; }
        int per_cu = 0;
        if (hipOccupancyMaxActiveBlocksPerMultiprocessor(&per_cu, (const void*)fwd, NTHR, LDS_BYTES) != hipSuccess || per_cu < 1) fprintf(stderr, "kernel_launch: occupancy query says %d blocks per CU\n", per_cu);
        (void)hipGetLastError();
        ready = 1;
    }
    if (ready < 0) return;
    (void)hipMemsetAsync((char*)d_ws + WS_CTL, 0, CTL_BYTES, stream);
    Args a{};
    for (int i = 0; i < 20; ++i) a.in[i] = (const float*)d_in[i];
    a.out = (float*)d_out; a.ws = (unsigned char*)d_ws;
    hipLaunchKernelGGL(fwd, dim3(GRID), dim3(NTHR), LDS_BYTES, stream, a);
}
```

```cpp
#include <hip/hip_runtime.h>
#include <cstdio>
#include <cstdint>

#define LAS __attribute__((address_space(3)))
#define GAS __attribute__((address_space(1)))
typedef unsigned short bf16_t;
typedef short bf16x8 __attribute__((ext_vector_type(8)));
typedef short s16x4 __attribute__((ext_vector_type(4)));
typedef float f32x4 __attribute__((ext_vector_type(4)));
typedef float f32x16 __attribute__((ext_vector_type(16)));
typedef unsigned u32x4 __attribute__((ext_vector_type(4)));
typedef unsigned u32x2 __attribute__((ext_vector_type(2)));
typedef int v8i_t __attribute__((ext_vector_type(8)));
typedef int v4i_t __attribute__((ext_vector_type(4)));

constexpr int D = 1024, NB = 32, SEQ = 2048, T = NB * SEQ, CTXL = 256, TC = NB * CTXL, TT = T + TC;
constexpr int NQKV = 1536, NE = 64;
constexpr float ALPHA = 1.681792830507429f;
constexpr float LN_EPS = 1e-5f, MOD_EPS = 1e-6f;
constexpr float C2 = 0.125f * 1.4426950408889634f;
constexpr float LOG2E = 1.4426950408889634f;
constexpr int NCHUNK = 1;
constexpr int NWAVES = 8, NTHR = 512, GRID = 256;

constexpr size_t MiB = 1u << 20;
constexpr size_t WS_CTL = 0, CTL_BYTES = 1 * MiB;
constexpr size_t WS_ROPEC = 1 * MiB, WS_ROPES = 1 * MiB + 4096, WS_CSN = 1 * MiB + 65536, WS_DLC = 1 * MiB + 524288, WS_DL = 2 * MiB;
constexpr size_t WS_WQKV = 10 * MiB, WS_WO = 16 * MiB, WS_WF = 20 * MiB, WS_WR = 28 * MiB, WS_WSH = 29 * MiB;
constexpr size_t WS_MODP = 36 * MiB, WS_MOD = 49 * MiB;
constexpr float QSC = 64.f;
constexpr float YSC = 16.f;
constexpr size_t WS_RSTAT = 36 * MiB;
constexpr size_t WS_EGU = 54 * MiB, WS_ED = 118 * MiB;
constexpr size_t WS_XS = 150 * MiB;
constexpr size_t WS_STOK = 294 * MiB, WS_SDST = 297 * MiB, WS_SW = 300 * MiB, WS_TKE = 303 * MiB, WS_TKW = 306 * MiB;
constexpr size_t WS_R = 309 * MiB;
constexpr size_t WS_Q = WS_R, WS_K = WS_R + 144 * MiB, WS_V = WS_R + 180 * MiB;
constexpr size_t WS_ABT = WS_R, WS_FH = WS_R + 256 * MiB, WS_FH1 = WS_R + 320 * MiB, WS_ABTC = WS_R + 321 * MiB, WS_FC = WS_R + 353 * MiB;
constexpr size_t WS_H = WS_R, WS_HS = WS_R + 160 * MiB, WS_YB = WS_R + 180 * MiB, WS_YS = WS_R + 788 * MiB;
constexpr size_t WS_END = WS_YS + 72 * MiB;
constexpr size_t OUT_U8 = 144 * MiB;
constexpr int WSCALE_E8M0 = 121;
constexpr int MAXROWS = 655360;

constexpr int CW_TMO = 0, CW_BAR = 4096, CW_BCNT = 16384;

constexpr int RING_BYTES = 131072;
constexpr int L_MISC = RING_BYTES;
constexpr int L_TSTART = RING_BYTES + 256;
constexpr int L_PREF = L_TSTART + 1040;
constexpr int L_LCNT = L_PREF + 256;
constexpr int L_TSEG = L_LCNT + 256;
constexpr int L_SCAN = L_TSEG + 2560;
constexpr int LDS_BYTES = 139264;
static_assert(L_SCAN + 1024 <= LDS_BYTES, "LDS map");

#define RLX_AGENT __ATOMIC_RELAXED, __HIP_MEMORY_SCOPE_AGENT
#define LDS_WAIT() asm volatile("s_waitcnt lgkmcnt(0)" ::: "memory")
#define VM_WAIT() asm volatile("s_waitcnt vmcnt(0)" ::: "memory")

__device__ __forceinline__ unsigned f2bf(float f) { unsigned u = __builtin_bit_cast(unsigned, f); return (u + 0x7fffu + ((u >> 16) & 1u)) >> 16; }
__device__ __forceinline__ unsigned pk2(float lo, float hi) { return f2bf(lo) | (f2bf(hi) << 16); }
typedef float f32x2_t __attribute__((ext_vector_type(2))); typedef __bf16 bf16x2_t __attribute__((ext_vector_type(2)));
__device__ __forceinline__ unsigned cvt_pk_bf16(float lo, float hi) { f32x2_t v = {lo, hi}; bf16x2_t b = __builtin_convertvector(v, bf16x2_t); return __builtin_bit_cast(unsigned, b); }
__device__ __forceinline__ float bflo(unsigned w) { return __builtin_bit_cast(float, w << 16); }
__device__ __forceinline__ float bfhi(unsigned w) { return __builtin_bit_cast(float, w & 0xffff0000u); }
__device__ __forceinline__ float wave_sum(float v) {
#pragma unroll
    for (int o = 1; o < 64; o <<= 1) v += __shfl_xor(v, o);
    return v;
}

__device__ __forceinline__ unsigned f2f8(float v) { return (unsigned)__builtin_amdgcn_cvt_pk_fp8_f32(v, 0.f, 0, false) & 0xffu; }
__device__ __forceinline__ float f82f(unsigned b) { return __builtin_amdgcn_cvt_pk_f32_fp8((int)(b & 0xffu), false)[0]; }
__device__ __forceinline__ int opaque_tid() { int t = threadIdx.x; asm volatile("" : "+v"(t)); return t; }

#define XB_TMO      128
#define XB_XCNT(j)  (256  + 64 * (j))
#define XB_XSUB(j)  (1280 + 64 * (j))
#define XB_XGEN(j)  (2304 + 64 * (j))
#define XB_TOP      3328
#define XB_TOPGEN   3392
#define XCD_BAR_WORDS 3456
#define XB_SPIN_CAP (1u << 22)
__device__ __forceinline__ unsigned xb_ld(unsigned* p)              { return __hip_atomic_load(p, __ATOMIC_RELAXED, __HIP_MEMORY_SCOPE_AGENT); }
__device__ __forceinline__ unsigned xb_add(unsigned* p, unsigned v) { return __hip_atomic_fetch_add(p, v, __ATOMIC_RELAXED, __HIP_MEMORY_SCOPE_AGENT); }
__device__ __forceinline__ unsigned xb_xcc_id() { return (unsigned)__builtin_amdgcn_s_getreg((3 << 11) | 20) & 0xFu; }
#define XB_SPIN(cond, bar) do { unsigned _sp = 0; while (cond) { __builtin_amdgcn_s_sleep(1); \
    if ((++_sp & 255u) == 0u) { if (xb_ld(&(bar)[XB_TMO])) break; if (_sp > XB_SPIN_CAP) { atomicAdd(&(bar)[XB_TMO], 1u); break; } } } } while (0)
struct XcdBarrier { unsigned* bar; unsigned x; volatile LAS unsigned* st; };
__device__ __forceinline__ XcdBarrier xcd_barrier_post(unsigned* bar, volatile LAS unsigned* st) {
    XcdBarrier b; b.bar = bar; b.x = xb_xcc_id(); b.st = st;
    if (threadIdx.x == 0) (void)xb_add(&bar[XB_XCNT(b.x)], 1u);
    return b;
}
__device__ __forceinline__ void xcd_barrier_complete(unsigned* bar, unsigned x, unsigned& nloc, unsigned& nx) {
    const unsigned G = gridDim.x * gridDim.y * gridDim.z;
    unsigned sum, cnt, mine, sp = 0u;
    for (;;) {
        sum = 0u; cnt = 0u; mine = 0u;
#pragma unroll
        for (unsigned j = 0; j < 16; ++j) { const unsigned c = xb_ld(&bar[XB_XCNT(j)]); sum += c; cnt += (c > 0u) ? 1u : 0u; mine = (j == x) ? c : mine; }
        if (sum == G) break;
        __builtin_amdgcn_s_sleep(1);
        if ((++sp & 255u) == 0u) { if (xb_ld(&bar[XB_TMO])) break; if (sp > XB_SPIN_CAP) { atomicAdd(&bar[XB_TMO], 1u); break; } }
    }
    nloc = mine > 0u ? mine : 1u; nx = cnt > 0u ? cnt : 1u;
}
__device__ __forceinline__ void xcd_barrier(const XcdBarrier& b) {
    asm volatile("s_waitcnt vmcnt(0)" ::: "memory");
    __syncthreads();
    if (threadIdx.x == 0) {
        unsigned* bar = b.bar; unsigned bx = b.x; asm volatile("" : "+s"(bx));
        __builtin_amdgcn_s_waitcnt(0);
        unsigned nloc = b.st[0], nx = b.st[1];
        if (nloc == 0u) { xcd_barrier_complete(bar, bx, nloc, nx); b.st[0] = nloc; b.st[1] = nx; }
        const unsigned old = xb_add(&bar[XB_XSUB(bx)], 1u);
        const unsigned gen = old / nloc;
        if (old + 1u == (gen + 1u) * nloc) {
            __builtin_amdgcn_fence(__ATOMIC_RELEASE, "agent");
            asm volatile("s_waitcnt vmcnt(0)" ::: "memory");
            const unsigned og = xb_add(&bar[XB_TOP], 1u);
            const unsigned tg = og / nx;
            if (og + 1u == (tg + 1u) * nx) xb_add(&bar[XB_TOPGEN], 1u);
            else XB_SPIN(xb_ld(&bar[XB_TOPGEN]) == tg, bar);
            __builtin_amdgcn_fence(__ATOMIC_ACQUIRE, "agent");
            xb_add(&bar[XB_XGEN(bx)], 1u);
            asm volatile("s_waitcnt vmcnt(0)" ::: "memory");
        } else {
            XB_SPIN(xb_ld(&bar[XB_XGEN(bx)]) == gen, bar);
            __builtin_amdgcn_fence(__ATOMIC_ACQUIRE, "agent");
            asm volatile("s_waitcnt vmcnt(0)" ::: "memory");
        }
    }
    __syncthreads();
}

typedef float f32x2v __attribute__((ext_vector_type(2)));
namespace pg {
constexpr int BM = 256, BK = 64, HALF = 128, HTB = HALF * BK * 2;
__host__ __device__ __forceinline__ int lds_byte(int r, int c) { const int st = (r >> 4) * 2 + (c >> 5), rr = r & 15, cc = c & 31, ob = rr * 64 + cc * 2; return st * 1024 + (ob ^ (((ob >> 9) & 1) << 5)); }
__host__ __device__ __forceinline__ void stage_rc(int b, int& R, int& C) { const int st = b / 1024, sb = b % 1024, swz = sb ^ (((sb >> 9) & 1) << 5); R = (st >> 1) * 16 + swz / 64; C = (st & 1) * 32 + (swz % 64) / 2; }
__host__ __device__ __forceinline__ int perm32(int rho) { const int n = rho >> 4, i = rho & 15; return 8 * (i >> 2) + 4 * n + (i & 3); }

struct Unit {
    const char* A;
    const char* B;
    const int* gidx;
    int gbase;
    int nt;
    char* out; int ldc; float scale; int flags; int i0; int i1;
};

template <class Epi, class Sched, bool GATHER, bool F8 = false, int WSC = WSCALE_E8M0>
__device__ __forceinline__ void gemm_phase(LAS unsigned char* lds, const unsigned lda, const unsigned ldb, const char* gtable, const Sched& S, const Epi& E) {
    const int tid = opaque_tid(), wid = __builtin_amdgcn_readfirstlane(tid >> 6), lane = tid & 63, wr = wid >> 2, wc = wid & 3, fr = lane & 15, fq = lane >> 4;
    unsigned voffA[2], voffB[2];
#pragma unroll
    for (int i = 0; i < 2; ++i) { int R, C; stage_rc(tid * 16 + i * 8192, R, C); const int Rb = (R & ~31) + perm32(R & 31);
        voffA[i] = (unsigned)R * lda + (unsigned)C * 2u; voffB[i] = (unsigned)Rb * ldb + (unsigned)C * 2u; }
    const size_t kstep = (size_t)(BK * 2);
    const size_t hstepA = (size_t)HALF * lda, hstepB = (size_t)HALF * ldb;
    const unsigned ldsw = (unsigned)wid * 1024u;
    const int aoff = lds_byte(wr * 64 + fr, fq * 8), boff = lds_byte(wc * 32 + fr, fq * 8);
#define PG_SA(b, h) (((b) * 2 + (h)) * HTB)
#define PG_SB(b, h) ((4 + (b) * 2 + (h)) * HTB)
#define PG_ST2(bufoff, p0, p1) do { \
        __builtin_amdgcn_global_load_lds((const unsigned*)(p0), (LAS unsigned*)(lds + (bufoff) + ldsw), 16, 0, 0); \
        __builtin_amdgcn_global_load_lds((const unsigned*)(p1), (LAS unsigned*)(lds + (bufoff) + ldsw + 8192), 16, 0, 0); } while (0)
#define PG_STB(bufoff, bp) PG_ST2(bufoff, (bp) + voffB[0], (bp) + voffB[1])
#define PG_STA(bufoff, ap, h, nx) do { if constexpr (GATHER) { PG_ST2(bufoff, (ap) + ((nx) ? nO[h][0] : cO[h][0]), (ap) + ((nx) ? nO[h][1] : cO[h][1])); } \
        else { PG_ST2(bufoff, (ap) + (h) * hstepA + voffA[0], (ap) + (h) * hstepA + voffA[1]); } } while (0)
#define PG_LD8(p) ({ const v4i_t lo_ = *(const LAS v4i_t*)(p), hi_ = *(const LAS v4i_t*)((p) + 1024); __builtin_shufflevector(lo_, hi_, 0, 1, 2, 3, 4, 5, 6, 7); })
#define PG_LDA(dst, b, h) do { if constexpr (F8) { _Pragma("unroll") for (int m = 0; m < 4; ++m) dst##8[m] = PG_LD8(lds + PG_SA(b, h) + aoff + m * 2048); } \
        else { _Pragma("unroll") for (int m = 0; m < 4; ++m) _Pragma("unroll") for (int k = 0; k < 2; ++k) dst[m][k] = *(const LAS bf16x8*)(lds + PG_SA(b, h) + aoff + m * 2048 + k * 1024); } } while (0)
#define PG_LDB(dst, b, h) do { if constexpr (F8) { _Pragma("unroll") for (int n = 0; n < 2; ++n) dst##8[n] = PG_LD8(lds + PG_SB(b, h) + boff + n * 2048); } \
        else { _Pragma("unroll") for (int n = 0; n < 2; ++n) _Pragma("unroll") for (int k = 0; k < 2; ++k) dst[n][k] = *(const LAS bf16x8*)(lds + PG_SB(b, h) + boff + n * 2048 + k * 1024); } } while (0)
#define PG_MMA(ai, bj, At, Bt) do { __builtin_amdgcn_s_setprio(1); _Pragma("unroll") for (int m = 0; m < 4; ++m) _Pragma("unroll") for (int n = 0; n < 2; ++n) { \
        if constexpr (F8) { asm volatile("v_mfma_scale_f32_16x16x128_f8f6f4 %0, %1, %2, %0, %3, %4 op_sel_hi:[0,0,0]" : "+v"(acc[ai][bj][m][n]) : "v"(Bt##8[n]), "v"(At##8[m]), "v"(sc_w), "v"(sc_x)); } \
        else { _Pragma("unroll") for (int k = 0; k < 2; ++k) acc[ai][bj][m][n] = __builtin_amdgcn_mfma_f32_16x16x32_bf16(Bt[n][k], At[m][k], acc[ai][bj][m][n], 0, 0, 0); } } \
        __builtin_amdgcn_s_setprio(0); } while (0)
#define PG_WAIT_V(n) asm volatile("s_waitcnt vmcnt(" #n ")" ::: "memory")
#define PG_WAIT_L(n) asm volatile("s_waitcnt lgkmcnt(" #n ")" ::: "memory")
#define PG_BAR __builtin_amdgcn_s_barrier()
#define PG_SCHED __builtin_amdgcn_sched_barrier(0)
#define PG_GOFF(dst, u) do { const int tz_ = opaque_tid(); _Pragma("unroll") for (int i = 0; i < 2; ++i) { int R_, C_; stage_rc(tz_ * 16 + i * 8192, R_, C_); \
        _Pragma("unroll") for (int h = 0; h < 2; ++h) { const int rr = h * HALF + R_; \
        const int ix = (u).gidx ? ((const GAS int*)(u).gidx)[rr] : (u).gbase + rr; dst[h][i] = (unsigned)ix * lda + (unsigned)C_ * 2u; } } } while (0)
#define PG_GIDX(dst, un) do { const int* gi_ = nullptr; int gb_ = 0; const bool ok_ = S.gsrc((un), gi_, gb_); const int tz_ = opaque_tid(); _Pragma("unroll") for (int i = 0; i < 2; ++i) { int R_, C_; stage_rc(tz_ * 16 + i * 8192, R_, C_); \
        _Pragma("unroll") for (int h = 0; h < 2; ++h) { const int rr = h * HALF + R_; dst[h][i] = (ok_ && gi_) ? ((const GAS int*)gi_)[rr] : gb_ + rr; } } } while (0)
#define PG_GCVT(dst, src) do { const int tz_ = opaque_tid(); _Pragma("unroll") for (int i = 0; i < 2; ++i) { int R_, C_; stage_rc(tz_ * 16 + i * 8192, R_, C_); \
        _Pragma("unroll") for (int h = 0; h < 2; ++h) dst[h][i] = (unsigned)src[h][i] * lda + (unsigned)C_ * 2u; } } while (0)
    Unit cur, nxt; int ui = 0;
    if (!S.next(0, cur)) return;
    f32x4 acc[2][2][4][2];
#pragma unroll
    for (int a = 0; a < 2; ++a)
#pragma unroll
        for (int b = 0; b < 2; ++b)
#pragma unroll
            for (int m = 0; m < 4; ++m)
#pragma unroll
                for (int n = 0; n < 2; ++n) acc[a][b][m][n] = (f32x4){0.f, 0.f, 0.f, 0.f};
    bf16x8 At[4][2], B0[2][2], B1[2][2]; v8i_t At8[4], B08[2], B18[2];
    const int sc_w = WSC * 0x01010101, sc_x = 0x7f7f7f7f;
    unsigned cO[2][2] = {{0u, 0u}, {0u, 0u}}, nO[2][2] = {{0u, 0u}, {0u, 0u}};
    if constexpr (GATHER) { PG_GOFF(cO, cur); }
    const char* cA = GATHER ? gtable : cur.A; const char* cB = cur.B;
    PG_STB(PG_SB(0, 0), cB); PG_STB(PG_SB(0, 1), cB + hstepB); PG_STA(PG_SA(0, 0), cA, 0, false); PG_STA(PG_SA(0, 1), cA, 1, false);
    if (wr == 1) PG_BAR;
    PG_WAIT_V(2); PG_BAR;
    PG_STB(PG_SB(1, 0), cB + kstep); PG_STA(PG_SA(1, 0), cA + kstep, 0, false); PG_STB(PG_SB(1, 1), cB + hstepB + kstep);
    PG_WAIT_V(6); PG_BAR;
    for (;;) {
        const bool has_next = S.next(ui + 1, nxt);
        const int nt = cur.nt;
        if constexpr (GATHER) { if (has_next) { PG_GOFF(nO, nxt); } else {
#pragma unroll
            for (int h = 0; h < 2; ++h)
#pragma unroll
                for (int i = 0; i < 2; ++i) nO[h][i] = cO[h][i]; } }
        const char* nA = GATHER ? gtable : (has_next ? nxt.A : cA); const char* nB = has_next ? nxt.B : cB;
#pragma unroll 1
        for (int t = 0; t < nt; t += 2) {
            const bool last = (t == nt - 2);
            const char* a1 = cA + (size_t)(t + 1) * kstep;
            const char* a2 = last ? nA : cA + (size_t)(t + 2) * kstep; const char* b2 = last ? nB : cB + (size_t)(t + 2) * kstep;
            const char* a3 = a2 + kstep; const char* b3 = b2 + kstep;
            const bool after_epi = (Epi::NSTORE > 0) && (t == 0) && (ui > 0);
            PG_LDB(B0, 0, 0); PG_LDB(B1, 0, 1); PG_SCHED; PG_LDA(At, 0, 0); PG_STA(PG_SA(1, 1), a1, 1, false);
            if (after_epi) { if constexpr (Epi::NSTORE == 8) PG_WAIT_V(16); else PG_WAIT_V(24); } else PG_WAIT_V(8);
            PG_WAIT_L(0); PG_BAR; PG_MMA(0, 0, At, B0); PG_MMA(0, 1, At, B1); PG_BAR; PG_SCHED;
            PG_LDA(At, 0, 1); PG_STB(PG_SB(0, 0), b2); PG_STB(PG_SB(0, 1), b2 + hstepB); PG_STA(PG_SA(0, 0), a2, 0, last);
            if (after_epi) { if constexpr (Epi::NSTORE == 8) PG_WAIT_V(16); else PG_WAIT_V(24); } else PG_WAIT_V(8);
            PG_WAIT_L(0); PG_BAR; PG_MMA(1, 0, At, B0); PG_MMA(1, 1, At, B1); PG_BAR; PG_SCHED;
            PG_LDB(B0, 1, 0); PG_LDB(B1, 1, 1); PG_SCHED; PG_LDA(At, 1, 0); PG_STA(PG_SA(0, 1), a2, 1, last);
            PG_WAIT_V(8); PG_WAIT_L(0); PG_BAR; PG_MMA(0, 0, At, B0); PG_MMA(0, 1, At, B1); PG_BAR; PG_SCHED;
            PG_LDA(At, 1, 1); PG_STB(PG_SB(1, 0), b3); PG_STB(PG_SB(1, 1), b3 + hstepB); PG_STA(PG_SA(1, 0), a3, 0, last);
            PG_WAIT_V(8); PG_WAIT_L(0); PG_BAR; PG_MMA(1, 0, At, B0); PG_MMA(1, 1, At, B1); PG_BAR; PG_SCHED;
        }
        if (wr == 0) PG_BAR;
        if constexpr (F8) asm volatile("s_nop 15\n\ts_nop 15" ::: "memory");
        E(acc, cur, wr, wc, fr, fq);
        if (!has_next) break;
#pragma unroll
        for (int a = 0; a < 2; ++a)
#pragma unroll
            for (int b = 0; b < 2; ++b)
#pragma unroll
                for (int m = 0; m < 4; ++m)
#pragma unroll
                    for (int n = 0; n < 2; ++n) acc[a][b][m][n] = (f32x4){0.f, 0.f, 0.f, 0.f};
        cur = nxt; cA = nA; cB = nB; ++ui;
        if constexpr (GATHER) {
#pragma unroll
            for (int h = 0; h < 2; ++h)
#pragma unroll
                for (int i = 0; i < 2; ++i) cO[h][i] = nO[h][i]; }
        if (wr == 1) PG_BAR;
    }
    PG_WAIT_V(0);
    PG_BAR;
#undef PG_SA
#undef PG_SB
#undef PG_ST2
#undef PG_STB
#undef PG_STA
#undef PG_LDA
#undef PG_LD8
#undef PG_LDB
#undef PG_MMA
#undef PG_WAIT_V
#undef PG_WAIT_L
#undef PG_BAR
#undef PG_SCHED
#undef PG_GOFF
#undef PG_GIDX
#undef PG_GCVT
}

struct EpiStore {
    static constexpr int NSTORE = 0;
    __device__ __forceinline__ void operator()(const f32x4 (&acc)[2][2][4][2], const Unit& u, int wr, int wc, int fr, int fq) const {
        asm volatile("" : "+v"(fr), "+v"(fq));
        const float s = u.scale;
#pragma unroll
        for (int ai = 0; ai < 2; ++ai)
#pragma unroll
            for (int m = 0; m < 4; ++m) { const int row = ai * HALF + wr * 64 + m * 16 + fr;
                char* rowp = u.out + (ptrdiff_t)row * u.ldc + (wc * 32 + 8 * fq) * 2;
                if (!((u.flags & 1) && row == 0)) {
#pragma unroll
                for (int bj = 0; bj < 2; ++bj) { const f32x4 v0 = acc[ai][bj][m][0] * s, v1 = acc[ai][bj][m][1] * s;
                    u32x4 w; w.x = cvt_pk_bf16(v0[0], v0[1]); w.y = cvt_pk_bf16(v0[2], v0[3]); w.z = cvt_pk_bf16(v1[0], v1[1]); w.w = cvt_pk_bf16(v1[2], v1[3]);
                    *(u32x4*)(rowp + bj * 256) = w; } } }
    }
};
struct EpiStore8 {
    static constexpr int NSTORE = 16;
    __device__ __forceinline__ void operator()(const f32x4 (&acc)[2][2][4][2], const Unit& u, int wr, int wc, int fr, int fq) const {
        asm volatile("" : "+v"(fr), "+v"(fq));
        const float s = u.scale;
#pragma unroll
        for (int ai = 0; ai < 2; ++ai)
#pragma unroll
            for (int m = 0; m < 4; ++m) { const int row = ai * HALF + wr * 64 + m * 16 + fr;
                char* rowp = u.out + (ptrdiff_t)row * u.ldc + (wc * 32 + 8 * fq);
#pragma unroll
                for (int bj = 0; bj < 2; ++bj) { const f32x4 v0 = acc[ai][bj][m][0] * s, v1 = acc[ai][bj][m][1] * s; int w0 = 0, w1 = 0;
                    w0 = __builtin_amdgcn_cvt_pk_fp8_f32(v0[0], v0[1], w0, false); w0 = __builtin_amdgcn_cvt_pk_fp8_f32(v0[2], v0[3], w0, true);
                    w1 = __builtin_amdgcn_cvt_pk_fp8_f32(v1[0], v1[1], w1, false); w1 = __builtin_amdgcn_cvt_pk_fp8_f32(v1[2], v1[3], w1, true);
                    u32x2 o; o.x = (unsigned)w0; o.y = (unsigned)w1; *(u32x2*)(rowp + bj * 128) = o; } }
    }
};
struct EpiQKV {
    static constexpr int NSTORE = 0;
    bf16_t* Q; bf16_t* K; bf16_t* V; const float* ropec; const float* ropes;
    __device__ __forceinline__ void operator()(const f32x4 (&acc)[2][2][4][2], const Unit& u, int wr, int wc, int fr, int fq) const {
        asm volatile("" : "+v"(fr), "+v"(fq));
        const int pm = u.i0, pn = u.i1; const bool lat = pm < (T / 256); const bool rope = lat && pn < 5;
        const float qs = pn < 4 ? C2 : 1.f;
        const int part = wc & 1;
        const int fi0 = 8 * (fq & 1);
        const float sgn = (fq < 2) ? -1.f : 1.f;
#pragma unroll
        for (int ai = 0; ai < 2; ++ai)
#pragma unroll
            for (int m = 0; m < 4; ++m) { const int row = ai * HALF + wr * 64 + m * 16 + fr; const int tok = pm * 256 + row;
                const int tl = tok & (SEQ - 1); const int pos = part ? (tl & 63) : (tl >> 6);
                f32x4 c0 = {1.f, 1.f, 1.f, 1.f}, c1 = c0, s0 = {0.f, 0.f, 0.f, 0.f}, s1 = s0;
                if (rope) { c0 = *(const f32x4*)(ropec + pos * 16 + fi0); c1 = *(const f32x4*)(ropec + pos * 16 + fi0 + 4); s0 = *(const f32x4*)(ropes + pos * 16 + fi0); s1 = *(const f32x4*)(ropes + pos * 16 + fi0 + 4); }
#pragma unroll
                for (int bj = 0; bj < 2; ++bj) { f32x4 v0 = acc[ai][bj][m][0], v1 = acc[ai][bj][m][1];
                    if (rope) { f32x4 p0, p1;
#pragma unroll
                        for (int j = 0; j < 4; ++j) { p0[j] = __shfl_xor(v0[j], 32); p1[j] = __shfl_xor(v1[j], 32); }
                        v0 = v0 * c0 + (p0 * sgn) * s0; v1 = v1 * c1 + (p1 * sgn) * s1; }
                    v0 = v0 * qs; v1 = v1 * qs;
                    const int col = bj * HALF + wc * 32 + 8 * fq;
                    if (pn < 4) {
#pragma unroll
                        for (int j = 0; j < 4; ++j) { v0[j] = __builtin_amdgcn_fmed3f(v0[j] * QSC, -448.f, 448.f); v1[j] = __builtin_amdgcn_fmed3f(v1[j] * QSC, -448.f, 448.f); }
                        int w0 = 0, w1 = 0;
                        w0 = __builtin_amdgcn_cvt_pk_fp8_f32(v0[0], v0[1], w0, false); w0 = __builtin_amdgcn_cvt_pk_fp8_f32(v0[2], v0[3], w0, true);
                        w1 = __builtin_amdgcn_cvt_pk_fp8_f32(v1[0], v1[1], w1, false); w1 = __builtin_amdgcn_cvt_pk_fp8_f32(v1[2], v1[3], w1, true);
                        u32x2 o; o.x = (unsigned)w0; o.y = (unsigned)w1; *(GAS u32x2*)((unsigned char*)Q + (size_t)tok * 1024 + pn * 256 + col) = o; }
                    else { u32x4 w; w.x = cvt_pk_bf16(v0[0], v0[1]); w.y = cvt_pk_bf16(v0[2], v0[3]); w.z = cvt_pk_bf16(v1[0], v1[1]); w.w = cvt_pk_bf16(v1[2], v1[3]);
                        bf16_t* dst = pn == 4 ? K + (size_t)tok * 256 + col : V + (size_t)tok * 256 + col;
                        *(GAS u32x4*)dst = w; } } }
    }
};
struct EpiSilu {
    static constexpr int NSTORE = 8;
    __device__ __forceinline__ void operator()(const f32x4 (&acc)[2][2][4][2], const Unit& u, int wr, int wc, int fr, int fq) const {
        asm volatile("" : "+v"(fr), "+v"(fq));
#pragma unroll
        for (int ai = 0; ai < 2; ++ai)
#pragma unroll
            for (int m = 0; m < 4; ++m) { const int row = ai * HALF + wr * 64 + m * 16 + fr;
                float h[8];
#pragma unroll
                for (int n = 0; n < 2; ++n)
#pragma unroll
                    for (int j = 0; j < 4; j += 2) {
                        const f32x2v g = {acc[ai][0][m][n][j], acc[ai][0][m][n][j + 1]}, up = {acc[ai][1][m][n][j], acc[ai][1][m][n][j + 1]};
                        const f32x2v t = g * (f32x2v){-1.4426950408889634f, -1.4426950408889634f}, p = g * up;
                        f32x2v e = {__builtin_amdgcn_exp2f(t[0]), __builtin_amdgcn_exp2f(t[1])};
                        e = e + (f32x2v){1.f, 1.f};
                        const f32x2v r = {__builtin_amdgcn_rcpf(e[0]), __builtin_amdgcn_rcpf(e[1])};
                        const f32x2v o2 = p * r; h[n * 4 + j] = o2[0]; h[n * 4 + j + 1] = o2[1]; }
                int w0 = 0, w1 = 0;
                w0 = __builtin_amdgcn_cvt_pk_fp8_f32(h[0], h[1], w0, false); w0 = __builtin_amdgcn_cvt_pk_fp8_f32(h[2], h[3], w0, true);
                w1 = __builtin_amdgcn_cvt_pk_fp8_f32(h[4], h[5], w1, false); w1 = __builtin_amdgcn_cvt_pk_fp8_f32(h[6], h[7], w1, true);
                u32x2 o; o.x = (unsigned)w0; o.y = (unsigned)w1;
                *(u32x2*)(u.out + (size_t)row * 256 + (wc * 32 + 8 * fq)) = o; }
    }
};
struct EpiFp8 {
    static constexpr int NSTORE = 8;
    __device__ __forceinline__ void operator()(const f32x4 (&acc)[2][2][4][2], const Unit& u, int wr, int wc, int fr, int fq) const {
        asm volatile("" : "+v"(fr), "+v"(fq));
        const int pn = u.i1;
#pragma unroll
        for (int ai = 0; ai < 2; ++ai)
#pragma unroll
            for (int m = 0; m < 4; ++m) { const int row = ai * HALF + wr * 64 + m * 16 + fr;
                u32x4 o;
#pragma unroll
                for (int bj = 0; bj < 2; ++bj) { const f32x4 v0 = acc[ai][bj][m][0] * 16.f, v1 = acc[ai][bj][m][1] * 16.f;
                    int w0 = 0, w1 = 0;
                    w0 = __builtin_amdgcn_cvt_pk_fp8_f32(v0[0], v0[1], w0, false); w0 = __builtin_amdgcn_cvt_pk_fp8_f32(v0[2], v0[3], w0, true);
                    w1 = __builtin_amdgcn_cvt_pk_fp8_f32(v1[0], v1[1], w1, false); w1 = __builtin_amdgcn_cvt_pk_fp8_f32(v1[2], v1[3], w1, true);
                    o[2 * bj] = (unsigned)w0; o[2 * bj + 1] = (unsigned)w1; }
                *(u32x4*)(u.out + (size_t)row * 1024 + (16 * pn + 4 * wc + fq) * 16) = o; }
    }
};
struct EpiY8 {
    static constexpr int NSTORE = 0;
    __device__ __forceinline__ void operator()(const f32x4 (&acc)[2][2][4][2], const Unit& u, int wr, int wc, int fr, int fq) const {
        asm volatile("" : "+v"(fr), "+v"(fq));
        const int pn = u.i1; const float s = u.scale * YSC;
#pragma unroll
        for (int ai = 0; ai < 2; ++ai)
#pragma unroll
            for (int m = 0; m < 4; ++m) { const int row = ai * HALF + wr * 64 + m * 16 + fr;
                u32x4 o;
#pragma unroll
                for (int bj = 0; bj < 2; ++bj) { f32x4 v0 = acc[ai][bj][m][0] * s, v1 = acc[ai][bj][m][1] * s;
#pragma unroll
                    for (int j = 0; j < 4; ++j) { v0[j] = __builtin_amdgcn_fmed3f(v0[j], -448.f, 448.f); v1[j] = __builtin_amdgcn_fmed3f(v1[j], -448.f, 448.f); }
                    int w0 = 0, w1 = 0;
                    w0 = __builtin_amdgcn_cvt_pk_fp8_f32(v0[0], v0[1], w0, false); w0 = __builtin_amdgcn_cvt_pk_fp8_f32(v0[2], v0[3], w0, true);
                    w1 = __builtin_amdgcn_cvt_pk_fp8_f32(v1[0], v1[1], w1, false); w1 = __builtin_amdgcn_cvt_pk_fp8_f32(v1[2], v1[3], w1, true);
                    o[2 * bj] = (unsigned)w0; o[2 * bj + 1] = (unsigned)w1; }
                if (!((u.flags & 1) && row == 0)) *(GAS u32x4*)(u.out + (ptrdiff_t)row * u.ldc + (16 * pn + 4 * wc + fq) * 16) = o; }
    }
};
__device__ __forceinline__ int xcd_remap(int L0, int NU) { const int q = NU >> 3, r = NU & 7, x = L0 & 7, off = L0 >> 3; return (x < r ? x * (q + 1) : r * (q + 1) + (x - r) * q) + off; }
}

namespace attn {
constexpr int SLOTB = 8192;
constexpr int LDS_K = 0, LDS_V = 2 * SLOTB, LDS_WS = 4 * SLOTB, LDS_OST = LDS_WS + NWAVES * 256, LDS_END = LDS_OST + NWAVES * 4096;
static_assert(LDS_END <= RING_BYTES, "attention LDS");
__device__ __forceinline__ int crow(int r, int hi) { return (r & 3) + 8 * (r >> 2) + 4 * hi; }
__device__ __forceinline__ void glds16(const void* gsrc, unsigned lds_dst) { unsigned keep;
    asm volatile("s_mov_b32 %0, m0\n\ts_mov_b32 m0, %2\n\ts_nop 0\n\tglobal_load_lds_dwordx4 %1, off\n\ts_mov_b32 m0, %0" : "=&s"(keep) : "v"(gsrc), "s"(lds_dst) : "memory"); }
__device__ __forceinline__ float rowmax(const f32x16& p0, const f32x16& p1) {
    float a = fmaxf(p0[0], p1[0]);
#pragma unroll
    for (int r = 1; r < 16; ++r) a = fmaxf(a, fmaxf(p0[r], p1[r]));
    auto rr = __builtin_amdgcn_permlane32_swap(__float_as_uint(a), __float_as_uint(a), false, false);
    return fmaxf(__uint_as_float(rr[0]), __uint_as_float(rr[1]));
}
typedef short v4i16_t __attribute__((ext_vector_type(4)));
__device__ __forceinline__ s16x4 vtr(const LAS unsigned char* p) { return __builtin_bit_cast(s16x4, __builtin_amdgcn_ds_read_tr16_b64_v4i16((LAS v4i16_t*)p)); }
__device__ __forceinline__ void pv(f32x16* o, const LAS unsigned char* vp, bf16x8 pa0, bf16x8 pa1, bf16x8 pa2, bf16x8 pa3) {
#pragma unroll
    for (int d0 = 0; d0 < 2; ++d0) { s16x4 lo[4], hi[4];
#pragma unroll
        for (int ks = 0; ks < 4; ++ks) { lo[ks] = vtr(vp + d0 * 4096 + ks * 1024); hi[ks] = vtr(vp + d0 * 4096 + ks * 1024 + 512); }
#define PK(k) (bf16x8){lo[k][0], lo[k][1], lo[k][2], lo[k][3], hi[k][0], hi[k][1], hi[k][2], hi[k][3]}
        o[d0] = __builtin_amdgcn_mfma_f32_32x32x16_bf16(pa0, PK(0), o[d0], 0, 0, 0);
        o[d0] = __builtin_amdgcn_mfma_f32_32x32x16_bf16(pa1, PK(1), o[d0], 0, 0, 0);
        o[d0] = __builtin_amdgcn_mfma_f32_32x32x16_bf16(pa2, PK(2), o[d0], 0, 0, 0);
        o[d0] = __builtin_amdgcn_mfma_f32_32x32x16_bf16(pa3, PK(3), o[d0], 0, 0, 0);
#undef PK
    }
}
__device__ __forceinline__ void attn_unit(const bf16_t* Q, const bf16_t* K, const bf16_t* V, bf16_t* O, int b, int h, int q0, bool isctx, float sink2, LAS unsigned char* shm) {
    const int tid = opaque_tid(), lane = tid & 63, r32 = lane & 31, hi = lane >> 5; const int wid = __builtin_amdgcn_readfirstlane(tid >> 6);
    const int kvh = h >> 2;
    const long qrow = isctx ? (long)T + b * CTXL + wid * 32 : (long)b * SEQ + q0 + wid * 32;
    const unsigned lds0 = (unsigned)(uintptr_t)shm;
    LAS float* wsf = (LAS float*)(shm + LDS_WS) + wid * 64;
    int jlo = 0, nl = 0;
    if (!isctx) { jlo = (q0 == 0) ? 2 : 0; int jhi = (SEQ - q0 + 128) / 64; if (jhi > 8) jhi = 8; nl = jhi - jlo; }
    const int NT = nl + 4;
    const long lat0 = (long)b * SEQ + q0 - 128 + 64 * jlo, ctx0 = (long)T + b * CTXL;
#define TROW(t) ((t) < nl ? lat0 + 64 * (t) : ctx0 + 64 * ((t) - nl))
    const int kcol = kvh * 64 + wid * 8, vcol = kvh * 64 + (wid >> 2) * 32 + (lane & 3) * 8, vrow = 16 * (wid & 3) + (lane >> 2);
    const unsigned kdst = lds0 + LDS_K + wid * 1024, vdst = lds0 + LDS_V + wid * 1024;
#define DMA_KV(t, slot) do { const long tr_ = TROW(t); glds16(K + (tr_ + lane) * 256 + kcol, (unsigned)__builtin_amdgcn_readfirstlane(kdst + (slot) * SLOTB)); \
        glds16(V + (tr_ + vrow) * 256 + vcol, (unsigned)__builtin_amdgcn_readfirstlane(vdst + (slot) * SLOTB)); } while (0)
    DMA_KV(0, 0);
    bf16x8 qr[4];
#pragma unroll
    for (int d0 = 0; d0 < 4; ++d0) { const u32x2 w = *(const GAS u32x2*)((const unsigned char*)Q + (qrow + r32) * 1024 + h * 64 + d0 * 16 + hi * 8);
        const f32x2v a0 = __builtin_amdgcn_cvt_pk_f32_fp8((int)w.x, false), a1 = __builtin_amdgcn_cvt_pk_f32_fp8((int)w.x, true), a2 = __builtin_amdgcn_cvt_pk_f32_fp8((int)w.y, false), a3 = __builtin_amdgcn_cvt_pk_f32_fp8((int)w.y, true);
        u32x4 qw; qw.x = cvt_pk_bf16(a0[0] * (1.f / QSC), a0[1] * (1.f / QSC)); qw.y = cvt_pk_bf16(a1[0] * (1.f / QSC), a1[1] * (1.f / QSC)); qw.z = cvt_pk_bf16(a2[0] * (1.f / QSC), a2[1] * (1.f / QSC)); qw.w = cvt_pk_bf16(a3[0] * (1.f / QSC), a3[1] * (1.f / QSC));
        qr[d0] = __builtin_bit_cast(bf16x8, qw); }
    float mrun = sink2, l_reg = (hi == 0) ? 1.f : 0.f;
    f32x16 negm;
#pragma unroll
    for (int r = 0; r < 16; ++r) negm[r] = -sink2;
    f32x16 o[2];
#pragma unroll
    for (int r = 0; r < 16; ++r) { o[0][r] = 0.f; o[1][r] = 0.f; }
    const LAS unsigned char* vp0 = shm + LDS_V + ((lane >> 4) & 1) * 32 + (lane & 3) * 8 + (4 * hi + ((lane & 15) >> 2)) * 64;
    const int qw = q0 + wid * 32;
    asm volatile("s_waitcnt vmcnt(0) lgkmcnt(0)\n\ts_barrier" ::: "memory");
    for (int t = 0; t < NT; ++t) {
        const int slot = t & 1;
        if (t + 1 < NT) DMA_KV(t + 1, slot ^ 1);
        const bool latt = t < nl;
        const int ks = q0 - 128 + 64 * (jlo + t);
        bool need = true;
        if (latt) need = (ks + 63 >= qw - 128) && (ks <= qw + 31 + 128);
        if (need) {
            f32x16 p0, p1;
            const LAS unsigned char* kb = shm + LDS_K + slot * SLOTB + hi * 1024 + r32 * 16;
#pragma unroll
            for (int d0 = 0; d0 < 4; ++d0) {
                const bf16x8 b0 = *(const LAS bf16x8*)(kb + d0 * 2048), b1 = *(const LAS bf16x8*)(kb + d0 * 2048 + 512);
                if (d0 == 0) { p0 = __builtin_amdgcn_mfma_f32_32x32x16_bf16(b0, qr[0], negm, 0, 0, 0); p1 = __builtin_amdgcn_mfma_f32_32x32x16_bf16(b1, qr[0], negm, 0, 0, 0); }
                else { p0 = __builtin_amdgcn_mfma_f32_32x32x16_bf16(b0, qr[d0], p0, 0, 0, 0); p1 = __builtin_amdgcn_mfma_f32_32x32x16_bf16(b1, qr[d0], p1, 0, 0, 0); } }
            if (latt && !(ks >= qw - 97 && ks <= qw + 65)) {
                const int dq = qw + r32 - ks;
#pragma unroll
                for (int r = 0; r < 16; ++r) { const int d = dq - crow(r, hi); if (d > 128 || d < -128) p0[r] = -INFINITY; if (d - 32 > 128 || d - 32 < -128) p1[r] = -INFINITY; } }
            const float rm = rowmax(p0, p1);
            if (__any(rm > 8.f)) {
                const float delta = fmaxf(rm, 0.f);
                const float alpha = __builtin_amdgcn_exp2f(-delta); l_reg *= alpha; mrun += delta;
#pragma unroll
                for (int r = 0; r < 16; ++r) { p0[r] -= delta; p1[r] -= delta; negm[r] = -mrun; }
                if (hi == 0) wsf[r32] = alpha;
                asm volatile("s_waitcnt lgkmcnt(0)" ::: "memory");
#pragma unroll
                for (int r = 0; r < 16; ++r) { const float f = wsf[crow(r, hi)]; o[0][r] *= f; o[1][r] *= f; }
            }
            float sacc = 0.f;
#pragma unroll
            for (int r = 0; r < 16; ++r) { p0[r] = __builtin_amdgcn_exp2f(p0[r]); p1[r] = __builtin_amdgcn_exp2f(p1[r]); sacc += p0[r] + p1[r]; }
            l_reg += sacc;
            u32x4 pw0, pw1, pw2, pw3;
#define PKW(P, B) cvt_pk_bf16(P[B], P[B + 1])
            pw0 = (u32x4){PKW(p0, 0), PKW(p0, 2), PKW(p0, 4), PKW(p0, 6)}; pw1 = (u32x4){PKW(p0, 8), PKW(p0, 10), PKW(p0, 12), PKW(p0, 14)};
            pw2 = (u32x4){PKW(p1, 0), PKW(p1, 2), PKW(p1, 4), PKW(p1, 6)}; pw3 = (u32x4){PKW(p1, 8), PKW(p1, 10), PKW(p1, 12), PKW(p1, 14)};
#undef PKW
            __builtin_amdgcn_sched_barrier(0);
            pv(o, vp0 + slot * SLOTB, __builtin_bit_cast(bf16x8, pw0), __builtin_bit_cast(bf16x8, pw1), __builtin_bit_cast(bf16x8, pw2), __builtin_bit_cast(bf16x8, pw3));
        }
        asm volatile("s_waitcnt vmcnt(0) lgkmcnt(0)\n\ts_barrier" ::: "memory");
    }
    { auto rr = __builtin_amdgcn_permlane32_swap(__float_as_uint(l_reg), __float_as_uint(l_reg), false, false); l_reg = __uint_as_float(rr[0]) + __uint_as_float(rr[1]); }
    if (hi == 0) wsf[32 + r32] = l_reg;
    asm volatile("s_waitcnt lgkmcnt(0)" ::: "memory");
    float rli[16];
#pragma unroll
    for (int r = 0; r < 16; ++r) rli[r] = __builtin_amdgcn_rcpf(wsf[32 + crow(r, hi)]);
    unsigned char* Ow = (unsigned char*)O + qrow * 1024 + h * 64;
    { LAS unsigned char* stg = shm + LDS_OST + wid * 2048;
#pragma unroll
      for (int r = 0; r < 16; ++r) { const int orow = crow(r, hi);
#pragma unroll
          for (int d0 = 0; d0 < 2; ++d0) stg[orow * 64 + d0 * 32 + r32] = (unsigned char)f2f8(o[d0][r] * rli[r]); }
      asm volatile("s_waitcnt lgkmcnt(0)" ::: "memory");
#pragma unroll
      for (int i = 0; i < 2; ++i) { const int row = i * 16 + (lane >> 2), ch = lane & 3; const u32x4 v = *(const LAS u32x4*)(stg + row * 64 + ch * 16); *(GAS u32x4*)(Ow + (long)row * 1024 + ch * 16) = v; } }
    asm volatile("s_waitcnt lgkmcnt(0)" ::: "memory");
#undef TROW
#undef DMA_KV
}
__device__ __forceinline__ void attn_unit2(const bf16_t* Q, const bf16_t* K, const bf16_t* V, bf16_t* O, int b, int h0, int q0, bool isctx, float sinkA, float sinkB, LAS unsigned char* shm) {
    const int tid = opaque_tid(), lane = tid & 63, r32 = lane & 31, hi = lane >> 5; const int wid = __builtin_amdgcn_readfirstlane(tid >> 6);
    const int kvh = h0 >> 2;
    const long qrow = isctx ? (long)T + b * CTXL + wid * 32 : (long)b * SEQ + q0 + wid * 32;
    const unsigned lds0 = (unsigned)(uintptr_t)shm;
    LAS float* wsf = (LAS float*)(shm + LDS_WS) + wid * 64;
    int jlo = 0, nl = 0;
    if (!isctx) { jlo = (q0 == 0) ? 2 : 0; int jhi = (SEQ - q0 + 128) / 64; if (jhi > 8) jhi = 8; nl = jhi - jlo; }
    const int NT = nl + 4;
    const long lat0 = (long)b * SEQ + q0 - 128 + 64 * jlo, ctx0 = (long)T + b * CTXL;
#define TROW(t) ((t) < nl ? lat0 + 64 * (t) : ctx0 + 64 * ((t) - nl))
    const int kcol = kvh * 64 + wid * 8, vcol = kvh * 64 + (wid >> 2) * 32 + (lane & 3) * 8, vrow = 16 * (wid & 3) + (lane >> 2);
    const unsigned kdst = lds0 + LDS_K + wid * 1024, vdst = lds0 + LDS_V + wid * 1024;
#define DMA_KV(t, slot) do { const long tr_ = TROW(t); glds16(K + (tr_ + lane) * 256 + kcol, (unsigned)__builtin_amdgcn_readfirstlane(kdst + (slot) * SLOTB)); \
        glds16(V + (tr_ + vrow) * 256 + vcol, (unsigned)__builtin_amdgcn_readfirstlane(vdst + (slot) * SLOTB)); } while (0)
    DMA_KV(0, 0);
    bf16x8 qr[2][4];
#pragma unroll
    for (int hh = 0; hh < 2; ++hh)
#pragma unroll
        for (int d0 = 0; d0 < 4; ++d0) { const u32x2 w = *(const GAS u32x2*)((const unsigned char*)Q + (qrow + r32) * 1024 + (h0 + hh) * 64 + d0 * 16 + hi * 8);
            const f32x2v a0 = __builtin_amdgcn_cvt_pk_f32_fp8((int)w.x, false), a1 = __builtin_amdgcn_cvt_pk_f32_fp8((int)w.x, true), a2 = __builtin_amdgcn_cvt_pk_f32_fp8((int)w.y, false), a3 = __builtin_amdgcn_cvt_pk_f32_fp8((int)w.y, true);
            u32x4 qw; qw.x = cvt_pk_bf16(a0[0] * (1.f / QSC), a0[1] * (1.f / QSC)); qw.y = cvt_pk_bf16(a1[0] * (1.f / QSC), a1[1] * (1.f / QSC)); qw.z = cvt_pk_bf16(a2[0] * (1.f / QSC), a2[1] * (1.f / QSC)); qw.w = cvt_pk_bf16(a3[0] * (1.f / QSC), a3[1] * (1.f / QSC));
            qr[hh][d0] = __builtin_bit_cast(bf16x8, qw); }
    float mrun[2] = {sinkA, sinkB}, l_reg[2] = {(hi == 0) ? 1.f : 0.f, (hi == 0) ? 1.f : 0.f};
    f32x16 o[2][2];
#pragma unroll
    for (int hh = 0; hh < 2; ++hh)
#pragma unroll
        for (int r = 0; r < 16; ++r) { o[hh][0][r] = 0.f; o[hh][1][r] = 0.f; }
    const LAS unsigned char* vp0 = shm + LDS_V + ((lane >> 4) & 1) * 32 + (lane & 3) * 8 + (4 * hi + ((lane & 15) >> 2)) * 64;
    const int qw = q0 + wid * 32;
    asm volatile("s_waitcnt vmcnt(0) lgkmcnt(0)\n\ts_barrier" ::: "memory");
    for (int t = 0; t < NT; ++t) {
        const int slot = t & 1;
        if (t + 1 < NT) DMA_KV(t + 1, slot ^ 1);
        const bool latt = t < nl;
        const int ks = q0 - 128 + 64 * (jlo + t);
        bool need = true;
        if (latt) need = (ks + 63 >= qw - 128) && (ks <= qw + 31 + 128);
        if (need) {
            f32x16 p[2][2];
            { f32x16 nm0, nm1;
#pragma unroll
              for (int r = 0; r < 16; ++r) { nm0[r] = -mrun[0]; nm1[r] = -mrun[1]; }
              const LAS unsigned char* kb = shm + LDS_K + slot * SLOTB + hi * 1024 + r32 * 16;
#pragma unroll
              for (int d0 = 0; d0 < 4; ++d0) {
                const bf16x8 b0 = *(const LAS bf16x8*)(kb + d0 * 2048), b1 = *(const LAS bf16x8*)(kb + d0 * 2048 + 512);
                if (d0 == 0) { p[0][0] = __builtin_amdgcn_mfma_f32_32x32x16_bf16(b0, qr[0][0], nm0, 0, 0, 0); p[0][1] = __builtin_amdgcn_mfma_f32_32x32x16_bf16(b1, qr[0][0], nm0, 0, 0, 0);
                               p[1][0] = __builtin_amdgcn_mfma_f32_32x32x16_bf16(b0, qr[1][0], nm1, 0, 0, 0); p[1][1] = __builtin_amdgcn_mfma_f32_32x32x16_bf16(b1, qr[1][0], nm1, 0, 0, 0); }
                else {
#pragma unroll
                    for (int hh = 0; hh < 2; ++hh) { p[hh][0] = __builtin_amdgcn_mfma_f32_32x32x16_bf16(b0, qr[hh][d0], p[hh][0], 0, 0, 0); p[hh][1] = __builtin_amdgcn_mfma_f32_32x32x16_bf16(b1, qr[hh][d0], p[hh][1], 0, 0, 0); } } } }
            if (latt && !(ks >= qw - 97 && ks <= qw + 65)) {
                const int dq = qw + r32 - ks;
#pragma unroll
                for (int r = 0; r < 16; ++r) { const int d = dq - crow(r, hi);
                    if (d > 128 || d < -128) { p[0][0][r] = -INFINITY; p[1][0][r] = -INFINITY; }
                    if (d - 32 > 128 || d - 32 < -128) { p[0][1][r] = -INFINITY; p[1][1][r] = -INFINITY; } } }
            u32x4 pw[2][4];
#pragma unroll
            for (int hh = 0; hh < 2; ++hh) {
                bool big = false;
#pragma unroll
                for (int r = 0; r < 16; ++r) big = big | (__builtin_bit_cast(int, p[hh][0][r]) > 0x41000000) | (__builtin_bit_cast(int, p[hh][1][r]) > 0x41000000);
                if (__any(big)) {
                    const float rm = rowmax(p[hh][0], p[hh][1]);
                    const float delta = fmaxf(rm, 0.f);
                    const float alpha = __builtin_amdgcn_exp2f(-delta); l_reg[hh] *= alpha; mrun[hh] += delta;
#pragma unroll
                    for (int r = 0; r < 16; ++r) { p[hh][0][r] -= delta; p[hh][1][r] -= delta; }
                    if (hi == 0) wsf[r32] = alpha;
                    asm volatile("s_waitcnt lgkmcnt(0)" ::: "memory");
#pragma unroll
                    for (int r = 0; r < 16; ++r) { const float f = wsf[crow(r, hi)]; o[hh][0][r] *= f; o[hh][1][r] *= f; }
                    asm volatile("s_waitcnt lgkmcnt(0)" ::: "memory");
                }
                float sacc = 0.f;
#pragma unroll
                for (int r = 0; r < 16; ++r) { p[hh][0][r] = __builtin_amdgcn_exp2f(p[hh][0][r]); p[hh][1][r] = __builtin_amdgcn_exp2f(p[hh][1][r]); sacc += p[hh][0][r] + p[hh][1][r]; }
                l_reg[hh] += sacc;
#define PKW(P, B) cvt_pk_bf16(P[B], P[B + 1])
                pw[hh][0] = (u32x4){PKW(p[hh][0], 0), PKW(p[hh][0], 2), PKW(p[hh][0], 4), PKW(p[hh][0], 6)}; pw[hh][1] = (u32x4){PKW(p[hh][0], 8), PKW(p[hh][0], 10), PKW(p[hh][0], 12), PKW(p[hh][0], 14)};
                pw[hh][2] = (u32x4){PKW(p[hh][1], 0), PKW(p[hh][1], 2), PKW(p[hh][1], 4), PKW(p[hh][1], 6)}; pw[hh][3] = (u32x4){PKW(p[hh][1], 8), PKW(p[hh][1], 10), PKW(p[hh][1], 12), PKW(p[hh][1], 14)};
#undef PKW
            }
            __builtin_amdgcn_sched_barrier(0);
            { const LAS unsigned char* vp = vp0 + slot * SLOTB;
#pragma unroll
              for (int d0 = 0; d0 < 2; ++d0) { s16x4 lo[4], hh4[4];
#pragma unroll
                for (int k4 = 0; k4 < 4; ++k4) { lo[k4] = vtr(vp + d0 * 4096 + k4 * 1024); hh4[k4] = vtr(vp + d0 * 4096 + k4 * 1024 + 512); }
#pragma unroll
                for (int hh = 0; hh < 2; ++hh)
#pragma unroll
                    for (int k4 = 0; k4 < 4; ++k4) { const bf16x8 vb8 = (bf16x8){lo[k4][0], lo[k4][1], lo[k4][2], lo[k4][3], hh4[k4][0], hh4[k4][1], hh4[k4][2], hh4[k4][3]};
                        o[hh][d0] = __builtin_amdgcn_mfma_f32_32x32x16_bf16(__builtin_bit_cast(bf16x8, pw[hh][k4]), vb8, o[hh][d0], 0, 0, 0); } } }
        }
        asm volatile("s_waitcnt vmcnt(0) lgkmcnt(0)\n\ts_barrier" ::: "memory");
    }
#pragma unroll
    for (int hh = 0; hh < 2; ++hh) {
        float lr = l_reg[hh];
        { auto rr = __builtin_amdgcn_permlane32_swap(__float_as_uint(lr), __float_as_uint(lr), false, false); lr = __uint_as_float(rr[0]) + __uint_as_float(rr[1]); }
        if (hi == 0) wsf[32 + r32] = lr;
        asm volatile("s_waitcnt lgkmcnt(0)" ::: "memory");
        float rli[16];
#pragma unroll
        for (int r = 0; r < 16; ++r) rli[r] = __builtin_amdgcn_rcpf(wsf[32 + crow(r, hi)]);
        asm volatile("s_waitcnt lgkmcnt(0)" ::: "memory");
        unsigned char* Ow = (unsigned char*)O + qrow * 1024 + (h0 + hh) * 64;
        LAS unsigned char* stg = shm + LDS_OST + wid * 4096 + hh * 2048;
#pragma unroll
        for (int r = 0; r < 16; ++r) { const int orow = crow(r, hi);
#pragma unroll
            for (int d0 = 0; d0 < 2; ++d0) stg[orow * 64 + d0 * 32 + r32] = (unsigned char)f2f8(o[hh][d0][r] * rli[r]); }
        asm volatile("s_waitcnt lgkmcnt(0)" ::: "memory");
#pragma unroll
        for (int i = 0; i < 2; ++i) { const int row = i * 16 + (lane >> 2), ch = lane & 3; const u32x4 v = *(const LAS u32x4*)(stg + row * 64 + ch * 16); *(GAS u32x4*)(Ow + (long)row * 1024 + ch * 16) = v; }
    }
    asm volatile("s_waitcnt lgkmcnt(0)" ::: "memory");
#undef TROW
#undef DMA_KV
}
}

struct Args {
    const float* in[20];
    float* out; unsigned char* ws;
};
struct Frame {
    LAS unsigned char* lds; unsigned* ctl; unsigned char* ws;
    int tid, lane, wave, gw;
    int blk;
    __device__ __forceinline__ void refresh() { tid = opaque_tid(); lane = tid & 63; wave = __builtin_amdgcn_readfirstlane(tid >> 6); gw = blk * 8 + wave;
        asm volatile("" : "+s"(ws)); ctl = (unsigned*)(ws + WS_CTL); }
};
constexpr int NGW = GRID * NWAVES;

struct Row { f32x4 v[4]; };
__device__ __forceinline__ int vq(int q, int lane) { return 64 * (lane >> 4) + 2 * (lane & 15) + 32 * (q >> 1) + (q & 1); }
__device__ __forceinline__ int vb(int j, int lane) { return 32 * (lane >> 4) + (lane & 15) + 16 * j; }
__device__ __forceinline__ void row_load_bf16(Row& r, const bf16_t* p, int lane) {
#pragma unroll
    for (int j = 0; j < 2; ++j) { const u32x4 w = ((const GAS u32x4*)p)[vb(j, lane)]; r.v[2 * j] = (f32x4){bflo(w.x), bfhi(w.x), bflo(w.y), bfhi(w.y)}; r.v[2 * j + 1] = (f32x4){bflo(w.z), bfhi(w.z), bflo(w.w), bfhi(w.w)}; } }
__device__ __forceinline__ void row_store_bf16(const Row& r, bf16_t* p, int lane) {
#pragma unroll
    for (int j = 0; j < 2; ++j) { u32x4 w; w.x = pk2(r.v[2 * j][0], r.v[2 * j][1]); w.y = pk2(r.v[2 * j][2], r.v[2 * j][3]); w.z = pk2(r.v[2 * j + 1][0], r.v[2 * j + 1][1]); w.w = pk2(r.v[2 * j + 1][2], r.v[2 * j + 1][3]); ((GAS u32x4*)p)[vb(j, lane)] = w; } }
__device__ __forceinline__ void row_load_fp8(Row& r, const unsigned char* p, int lane) {
    const u32x4 w = ((const GAS u32x4*)p)[lane];
#pragma unroll
    for (int q = 0; q < 4; ++q) { const f32x2v lo = __builtin_amdgcn_cvt_pk_f32_fp8((int)w[q], false), hi = __builtin_amdgcn_cvt_pk_f32_fp8((int)w[q], true); r.v[q] = (f32x4){lo[0], lo[1], hi[0], hi[1]}; } }
__device__ __forceinline__ void row_store_fp8(const Row& r, unsigned char* p, int lane) {
    const int e0 = 256 * (lane >> 4) + 8 * (lane & 15);
#pragma unroll
    for (int j = 0; j < 2; ++j) { int w0 = 0, w1 = 0;
        w0 = __builtin_amdgcn_cvt_pk_fp8_f32(r.v[2 * j][0], r.v[2 * j][1], w0, false); w0 = __builtin_amdgcn_cvt_pk_fp8_f32(r.v[2 * j][2], r.v[2 * j][3], w0, true);
        w1 = __builtin_amdgcn_cvt_pk_fp8_f32(r.v[2 * j + 1][0], r.v[2 * j + 1][1], w1, false); w1 = __builtin_amdgcn_cvt_pk_fp8_f32(r.v[2 * j + 1][2], r.v[2 * j + 1][3], w1, true);
        u32x2 o; o.x = (unsigned)w0; o.y = (unsigned)w1; *(GAS u32x2*)(p + e0 + 128 * j) = o; } }
__device__ __forceinline__ void row_load_f32(Row& r, const float* p, int lane) {
#pragma unroll
    for (int q = 0; q < 4; ++q) r.v[q] = ((const GAS f32x4*)p)[vq(q, lane)]; }
__device__ __forceinline__ void row_store_f32(const Row& r, float* p, int lane) {
#pragma unroll
    for (int q = 0; q < 4; ++q) ((GAS f32x4*)p)[vq(q, lane)] = r.v[q]; }
__device__ __forceinline__ void row_normalize(Row& r, float eps) {
    float s = 0.f;
#pragma unroll
    for (int j = 0; j < 4; ++j) s += (r.v[j][0] + r.v[j][1]) + (r.v[j][2] + r.v[j][3]);
    const float mean = wave_sum(s) * (1.f / D); float q = 0.f;
#pragma unroll
    for (int j = 0; j < 4; ++j) { r.v[j] = r.v[j] - mean; q += (r.v[j][0] * r.v[j][0] + r.v[j][1] * r.v[j][1]) + (r.v[j][2] * r.v[j][2] + r.v[j][3] * r.v[j][3]); }
    const float rstd = 1.f / sqrtf(wave_sum(q) * (1.f / D) + eps);
#pragma unroll
    for (int j = 0; j < 4; ++j) r.v[j] = r.v[j] * rstd;
}
__device__ __forceinline__ void row_normalize_stats(Row& r, float eps, float& mean_o, float& rstd_o) {
    float s = 0.f;
#pragma unroll
    for (int j = 0; j < 4; ++j) s += (r.v[j][0] + r.v[j][1]) + (r.v[j][2] + r.v[j][3]);
    const float mean = wave_sum(s) * (1.f / D); float q = 0.f;
#pragma unroll
    for (int j = 0; j < 4; ++j) { r.v[j] = r.v[j] - mean; q += (r.v[j][0] * r.v[j][0] + r.v[j][1] * r.v[j][1]) + (r.v[j][2] * r.v[j][2] + r.v[j][3] * r.v[j][3]); }
    const float rstd = 1.f / sqrtf(wave_sum(q) * (1.f / D) + eps);
#pragma unroll
    for (int j = 0; j < 4; ++j) r.v[j] = r.v[j] * rstd;
    mean_o = mean; rstd_o = rstd;
}
__device__ __forceinline__ void row_modulate(Row& r, const float* sh, const float* sc, int lane) {
    row_normalize(r, MOD_EPS);
#pragma unroll
    for (int j = 0; j < 4; ++j) { const f32x4 a = ((const GAS f32x4*)sc)[vq(j, lane)], b = ((const GAS f32x4*)sh)[vq(j, lane)]; r.v[j] = r.v[j] * (a + 1.f) + b; }
}
__device__ __forceinline__ int mod_row(int row) { return row < T ? (row >> 11) : 32; }
__device__ __forceinline__ const float* mod_vec(const unsigned char* ws, int layer, int mr, int chunk) { return (const float*)(ws + WS_MOD) + ((size_t)(layer * 33 + mr) * 6 + chunk) * 1024; }

__device__ __forceinline__ void conv_item(const float* W, int N, bf16_t* WT, int Kd, int kd0, int n0, int drow0, bool mirror, LAS float* scr, int lane) {
#pragma unroll 8
    for (int i = 0; i < 32; ++i) { const int kk = 2 * i + (lane >> 5); const int kd = kd0 + kk; const int ks = mirror ? ((kd & ~255) + ((256 - (kd & 255)) & 255)) : kd;
        scr[kk * 33 + (lane & 31)] = ((const GAS float*)W)[(size_t)ks * N + n0 + (lane & 31)]; }
    LDS_WAIT(); asm volatile("" ::: "memory");
    const int c = lane & 7;
#pragma unroll
    for (int j = 0; j < 4; ++j) { const int n = (lane >> 3) + 8 * j; const LAS float* s = scr + (8 * c) * 33 + n;
        u32x4 o; o.x = pk2(s[0 * 33], s[1 * 33]); o.y = pk2(s[2 * 33], s[3 * 33]); o.z = pk2(s[4 * 33], s[5 * 33]); o.w = pk2(s[6 * 33], s[7 * 33]);
        *(GAS u32x4*)(WT + (size_t)(drow0 + n) * Kd + kd0 + 8 * c) = o; }
    LDS_WAIT(); asm volatile("" ::: "memory");
}
__device__ __forceinline__ void conv_matrix_item(const float* W, int K, int N, bf16_t* WT, int mode, int roff, int item, LAS float* scr, int lane) {
    const int nblk = N / 32, kb = item / nblk, nb = item % nblk, n0 = 32 * nb;
    int drow0 = n0 + roff; if (mode == 1) drow0 = (n0 >> 7) * 256 + (n0 & 127); if (mode == 2) drow0 = (n0 >> 7) * 256 + 128 + (n0 & 127);
    conv_item(W, N, WT, K, 64 * kb, n0, drow0, mode == 3, scr, lane);
}
__device__ __forceinline__ void conv_item64(const float* W, int N, bf16_t* WT, int Kd, int k0, int n0, int drow0, LAS bf16_t* scr, int lane) {
    f32x4 v[16];
#pragma unroll
    for (int i = 0; i < 16; ++i) v[i] = *(const GAS f32x4*)(W + (size_t)(k0 + 4 * i + (lane >> 4)) * N + n0 + (lane & 15) * 4);
#pragma unroll
    for (int i = 0; i < 16; ++i) { u32x2 w; w.x = pk2(v[i][0], v[i][1]); w.y = pk2(v[i][2], v[i][3]); *(LAS u32x2*)(scr + (4 * i + (lane >> 4)) * 68 + (lane & 15) * 4) = w; }
    LDS_WAIT(); asm volatile("" ::: "memory");
    const int c = lane & 7;
#pragma unroll
    for (int j = 0; j < 8; ++j) { const int n = (lane >> 3) + 8 * j; const LAS bf16_t* p = scr + (8 * c) * 68 + n;
        u32x4 o; o.x = (unsigned)p[0] | ((unsigned)p[68] << 16); o.y = (unsigned)p[2 * 68] | ((unsigned)p[3 * 68] << 16); o.z = (unsigned)p[4 * 68] | ((unsigned)p[5 * 68] << 16); o.w = (unsigned)p[6 * 68] | ((unsigned)p[7 * 68] << 16);
        *(GAS u32x4*)(WT + (size_t)(drow0 + n) * Kd + k0 + 8 * c) = o; }
    LDS_WAIT(); asm volatile("" ::: "memory");
}
__device__ __forceinline__ void conv_item64_f8(const float* W, int N, unsigned char* WT, int Kd, int k0, int n0, int drow0, LAS unsigned char* scr, int lane, bool mirror = false) {
    f32x4 v[16];
#pragma unroll
    for (int i = 0; i < 16; ++i) { const int kd = k0 + 4 * i + (lane >> 4); const int ks = mirror ? ((kd & ~255) + ((256 - (kd & 255)) & 255)) : kd; v[i] = *(const GAS f32x4*)(W + (size_t)ks * N + n0 + (lane & 15) * 4); }
#pragma unroll
    for (int i = 0; i < 16; ++i) { int w = 0; w = __builtin_amdgcn_cvt_pk_fp8_f32(v[i][0] * 64.f, v[i][1] * 64.f, w, false); w = __builtin_amdgcn_cvt_pk_fp8_f32(v[i][2] * 64.f, v[i][3] * 64.f, w, true);
        *(LAS unsigned*)(scr + (4 * i + (lane >> 4)) * 68 + (lane & 15) * 4) = (unsigned)w; }
    LDS_WAIT(); asm volatile("" ::: "memory");
    const int c = lane & 3;
#pragma unroll
    for (int j = 0; j < 4; ++j) { const int n = (lane >> 2) + 16 * j; const LAS unsigned char* p = scr + (16 * c) * 68 + n; u32x4 o;
#pragma unroll
        for (int q = 0; q < 4; ++q) o[q] = (unsigned)p[(4 * q) * 68] | ((unsigned)p[(4 * q + 1) * 68] << 8) | ((unsigned)p[(4 * q + 2) * 68] << 16) | ((unsigned)p[(4 * q + 3) * 68] << 24);
        *(GAS u32x4*)(WT + (size_t)(drow0 + n) * Kd + k0 + 16 * c) = o; }
    LDS_WAIT(); asm volatile("" ::: "memory");
}
__device__ __forceinline__ void conv_experts(Frame& F, const Args& a, int layer) {
    F.refresh();
    LAS unsigned char* scr = F.lds + 32768 + F.wave * 4352;
    unsigned char* EGU = F.ws + WS_EGU; unsigned char* ED = F.ws + WS_ED;
    for (int it = F.gw; it < (NE + 1) * 192; it += NGW) { const int e = it / 192, r = it % 192;
        const float* wg = e < NE ? a.in[14] + ((size_t)layer * NE + e) * 262144 : a.in[17] + (size_t)layer * 262144;
        const float* wu = e < NE ? a.in[15] + ((size_t)layer * NE + e) * 262144 : a.in[18] + (size_t)layer * 262144;
        const float* wd = e < NE ? a.in[16] + ((size_t)layer * NE + e) * 262144 : a.in[19] + (size_t)layer * 262144;
        if (r < 128) { const int q = r & 63, kb = q >> 2, nb = q & 3, n0 = 64 * nb; const int drow0 = (n0 >> 7) * 256 + (r < 64 ? 0 : 128) + (n0 & 127);
            conv_item64_f8(r < 64 ? wg : wu, 256, EGU + (size_t)e * 512 * 1024, 1024, 64 * kb, n0, drow0, scr, F.lane); }
        else { const int q = r - 128, kb = q >> 4, nb = q & 15; conv_item64_f8(wd, 1024, ED + (size_t)e * 1024 * 256, 256, 64 * kb, 64 * nb, 64 * nb, scr, F.lane); } }
}
__device__ __forceinline__ void conv_small(Frame& F, const Args& a) {
    F.refresh();
    { LAS unsigned char* scr8 = F.lds + 32768 + F.wave * 4352;
      for (int it = F.gw; it < 2304; it += NGW) {
          if (it < 768) { const int j = it / 384, r = it % 384, kb = r / 24, nb = r % 24; conv_item64_f8(a.in[8] + (size_t)j * 1024 * 1536, 1536, F.ws + WS_WQKV + (size_t)j * 1536 * 1024, 1024, 64 * kb, 64 * nb, 64 * nb, scr8, F.lane); }
          else if (it < 1280) { const int q = it - 768, j = q >> 8, r = q & 255, kb = r >> 4, nb = r & 15; conv_item64_f8(a.in[9] + (size_t)j * 1024 * 1024, 1024, F.ws + WS_WO + (size_t)j * 1024 * 1024, 1024, 64 * kb, 64 * nb, 64 * nb, scr8, F.lane); }
          else { const int q = it - 1280, j = q >> 9, r = q & 511, mir = r >> 8, kb = (r & 255) >> 4, nb = r & 15;
              conv_item64_f8(a.in[11] + (size_t)j * 1024 * 1024, 1024, F.ws + WS_WSH + (size_t)j * 2048 * 1024, 1024, 64 * kb, 64 * nb, 64 * nb + 1024 * mir, scr8, F.lane, mir != 0); } } }
    __syncthreads();
    { LAS float* scr = (LAS float*)(F.lds + 32768 + F.wave * 8448);
      for (int it = F.gw; it < 1152; it += NGW) {
          if (it < 1024) { const int j = it >> 9, r = it & 511; conv_matrix_item(a.in[11] + (size_t)j * 1024 * 1024, 1024, 1024, (bf16_t*)(F.ws + WS_WF) + (size_t)j * 2048 * 1024, 0, 0, r, scr, F.lane); }
          else { const int q = it - 1024, l = q / 32, r = q % 32; conv_matrix_item(a.in[12] + (size_t)l * 1024 * 64, 1024, 64, (bf16_t*)(F.ws + WS_WR) + (size_t)l * 64 * 1024, 0, 0, r, scr, F.lane); } } }
    const int gt = F.blk * NTHR + F.tid, NGT = GRID * NTHR;
    const float TWO_PI = 6.283185307179586f;
    { float* rc = (float*)(F.ws + WS_ROPEC); float* rs = (float*)(F.ws + WS_ROPES);
      for (int i = gt; i < 64 * 16; i += NGT) { const int pos = i >> 4, fi = i & 15; const float inv = exp2f(-(float)fi * (13.287712379549449f / 16.f)); const float ang = (float)pos * inv; rc[i] = cosf(ang); rs[i] = sinf(ang); } }
    { unsigned* cs = (unsigned*)(F.ws + WS_CSN);
      for (int i = gt; i < 512 * 64; i += NGT) { const int r = i >> 6, n4 = (i & 63) * 4, m = r & 255; unsigned w = 0;
#pragma unroll
          for (int q = 0; q < 4; ++q) { const float ang = TWO_PI * (float)((m * (n4 + q)) & 255) * (1.f / 256.f); w |= f2f8(r < 256 ? __cosf(ang) : -__sinf(ang)) << (8 * q); }
          cs[i] = w; } }
    { unsigned* dl = (unsigned*)(F.ws + WS_DL);
      for (int i = gt; i < 1024 * 1024; i += NGT) { const int k = i >> 10, c4 = (i & 1023) * 4; unsigned w = 0;
#pragma unroll
          for (int q = 0; q < 4; ++q) { const int c = c4 + q, l = c & 2047; const float ang = TWO_PI * (float)((k * l) & 2047) * (1.f / 2048.f); w |= f2f8(c < 2048 ? __cosf(ang) : __sinf(ang)) << (8 * q); }
          dl[i] = w; } }
    { unsigned* dl = (unsigned*)(F.ws + WS_DLC);
      for (int i = gt; i < 256 * 128; i += NGT) { const int k = i >> 7, c4 = (i & 127) * 4; unsigned w = 0;
#pragma unroll
          for (int q = 0; q < 4; ++q) { const int c = c4 + q, l = c & 255; const float ang = TWO_PI * (float)((k * l) & 255) * (1.f / 256.f); w |= f2f8(c < 256 ? __cosf(ang) : __sinf(ang)) << (8 * q); }
          dl[i] = w; } }
}
__device__ __forceinline__ void mod_full(Frame& F, const Args& a) {
    F.refresh();
    if (F.blk >= 192) return;
    const int l = F.blk / 48, cb = F.blk % 48; const int g = F.tid & 31, ks = F.tid >> 5; const int n0 = cb * 128;
    LAS float* s = (LAS float*)F.lds;
    f32x4 acc[33];
#pragma unroll
    for (int r = 0; r < 33; ++r) acc[r] = (f32x4){0.f, 0.f, 0.f, 0.f};
    for (int half = 0; half < 2; ++half) {
        __syncthreads();
        for (int i = F.tid; i < 512 * 33; i += NTHR) { const int k = i / 33, r = i % 33; const float c = (r < 32) ? a.in[1][(size_t)r * 1024 + half * 512 + k] : a.in[3][half * 512 + k]; s[k * 36 + r] = c / (1.f + __expf(-c)); }
        __syncthreads();
        const GAS f32x4* w = (const GAS f32x4*)((const GAS float*)a.in[4] + ((size_t)l * 1024 + half * 512 + ks * 32) * 6144 + n0 + 4 * g);
#pragma unroll 1
        for (int kb = 0; kb < 32; kb += 8) { f32x4 wv[8];
#pragma unroll
            for (int q = 0; q < 8; ++q) wv[q] = w[(size_t)(kb + q) * (6144 / 4)];
#pragma unroll
            for (int q = 0; q < 8; ++q) { const LAS float* sr = s + (ks * 32 + kb + q) * 36;
#pragma unroll
                for (int r = 0; r < 33; ++r) acc[r] += wv[q] * sr[r];
                asm volatile("" ::: "memory"); } }
    }
    LAS float* red = (LAS float*)F.lds;
    float* mod = (float*)(F.ws + WS_MOD);
#define MF_PASS(r0, nr) do { __syncthreads(); \
        _Pragma("unroll") for (int rr = 0; rr < (nr); ++rr) *(LAS f32x4*)(red + ((ks * 8 + rr) * 128 + 4 * g)) = acc[(r0) + rr]; \
        __syncthreads(); \
        for (int i = F.tid; i < (nr) * 128; i += NTHR) { const int rr = i >> 7, c = i & 127; float t = 0.f; \
            _Pragma("unroll") for (int k2 = 0; k2 < 16; ++k2) t += red[((k2 * 8 + rr) * 128) + c]; \
            mod[((size_t)l * 33 + (r0) + rr) * 6144 + n0 + c] = a.in[5][l * 6144 + n0 + c] + t; } } while (0)
    MF_PASS(0, 8); MF_PASS(8, 8); MF_PASS(16, 8); MF_PASS(24, 8); MF_PASS(32, 1);
#undef MF_PASS
    __syncthreads();
}
__device__ __forceinline__ void rows_init(Frame& F, const Args& a) {
    F.refresh();
    bf16_t* XS = (bf16_t*)(F.ws + WS_XS);
    static_assert(TT % (4 * NGW) == 0, "rows_init: four rows per wave and iteration");
    for (int r0 = F.gw; r0 < TT; r0 += 4 * NGW) {
        Row r[4];
#pragma unroll
        for (int t = 0; t < 4; ++t) { const int row = r0 + t * NGW; row_load_f32(r[t], row < T ? a.in[0] + (size_t)row * D : a.in[2] + (size_t)(row - T) * D, F.lane); }
#pragma unroll
        for (int t = 0; t < 4; ++t) { const int row = r0 + t * NGW; const int mr = mod_row(row);
            row_store_bf16(r[t], XS + (size_t)row * D, F.lane);
            row_modulate(r[t], mod_vec(F.ws, 0, mr, 0), mod_vec(F.ws, 0, mr, 1), F.lane);
            row_store_fp8(r[t], (unsigned char*)a.out + OUT_U8 + (size_t)row * D, F.lane);
            asm volatile("" ::: "memory"); } }
}
__device__ __forceinline__ void rows_post1(Frame& F, const Args& a, int layer, int nrows) {
    F.refresh();
    bf16_t* XS = (bf16_t*)(F.ws + WS_XS); const unsigned char* Y8 = (const unsigned char*)a.out;
    const float* lg = a.in[6] + (size_t)(layer * 2 + 0) * D; const float* lb = a.in[7] + (size_t)(layer * 2 + 0) * D;
    const int TPB = nrows / GRID;
    for (int rl = F.wave; rl < TPB; rl += 4 * NWAVES) {
        u32x4 xr[4][2], yr[4];
#pragma unroll
        for (int t = 0; t < 4; ++t) { const int row = F.blk * TPB + rl + t * NWAVES;
#pragma unroll
            for (int j = 0; j < 2; ++j) xr[t][j] = ((const GAS u32x4*)(XS + (size_t)row * D))[vb(j, F.lane)];
            yr[t] = ((const GAS u32x4*)(Y8 + (size_t)row * D))[F.lane]; }
#pragma unroll
        for (int t = 0; t < 4; ++t) { const int row = F.blk * TPB + rl + t * NWAVES; const int mr = mod_row(row);
            Row x, y;
#pragma unroll
            for (int j = 0; j < 2; ++j) { const u32x4 w = xr[t][j];
                x.v[2 * j] = (f32x4){bflo(w.x), bfhi(w.x), bflo(w.y), bfhi(w.y)}; x.v[2 * j + 1] = (f32x4){bflo(w.z), bfhi(w.z), bflo(w.w), bfhi(w.w)}; }
#pragma unroll
            for (int q = 0; q < 4; ++q) { const f32x2v lo = __builtin_amdgcn_cvt_pk_f32_fp8((int)yr[t][q], false), hi = __builtin_amdgcn_cvt_pk_f32_fp8((int)yr[t][q], true); y.v[q] = (f32x4){lo[0], lo[1], hi[0], hi[1]}; }
            const float* g1 = mod_vec(F.ws, layer, mr, 2);
#pragma unroll
            for (int j = 0; j < 4; ++j) x.v[j] = x.v[j] * ALPHA + (((const GAS f32x4*)g1)[vq(j, F.lane)] * (1.f / YSC)) * y.v[j];
            row_normalize(x, LN_EPS);
#pragma unroll
            for (int j = 0; j < 4; ++j) x.v[j] = x.v[j] * ((const GAS f32x4*)lg)[vq(j, F.lane)] + ((const GAS f32x4*)lb)[vq(j, F.lane)];
            row_store_bf16(x, XS + (size_t)row * D, F.lane);
            float mean, rstd; row_normalize_stats(x, MOD_EPS, mean, rstd);
            if (F.lane == 0) { f32x2v st = {mean, rstd}; *(GAS f32x2v*)(F.ws + WS_RSTAT + (size_t)row * 8) = st; }
            { const float* sh = mod_vec(F.ws, layer, mr, 3); const float* sc = mod_vec(F.ws, layer, mr, 4);
#pragma unroll
              for (int j = 0; j < 4; ++j) { const f32x4 av = ((const GAS f32x4*)sc)[vq(j, F.lane)], bv = ((const GAS f32x4*)sh)[vq(j, F.lane)]; x.v[j] = x.v[j] * (av + 1.f) + bv; } }
            row_store_fp8(x, (unsigned char*)a.out + OUT_U8 + (size_t)row * D, F.lane);
            asm volatile("" ::: "memory"); }
    }
}
__device__ __forceinline__ void rows_post2(Frame& F, const Args& a, int layer, int t0, int n) {
    F.refresh();
    bf16_t* XS = (bf16_t*)(F.ws + WS_XS); const unsigned char* YB = (const unsigned char*)(F.ws + WS_YB); const unsigned char* YS = (const unsigned char*)(F.ws + WS_YS);
    const int* spos = (const int*)(F.ws + WS_SDST); const float* tkw = (const float*)(F.ws + WS_TKW);
    const float* lg = a.in[6] + (size_t)(layer * 2 + 1) * D; const float* lb = a.in[7] + (size_t)(layer * 2 + 1) * D;
    for (int i0 = F.gw; i0 < n; i0 += 2 * NGW) {
        const int i1 = i0 + NGW; const bool two = i1 < n;
        int pj[2]; float wj[2];
#pragma unroll
        for (int t = 0; t < 2; ++t) { pj[t] = 0; wj[t] = 0.f; const int row = t0 + (t ? i1 : i0); if ((t == 0 || two) && F.lane < 8) { pj[t] = ((const GAS int*)spos)[(size_t)row * 8 + F.lane]; wj[t] = ((const GAS float*)tkw)[(size_t)row * 8 + F.lane]; } }
        Row x[2], y[2];
#pragma unroll
        for (int t = 0; t < 2; ++t) { const int i = t ? i1 : i0; if (t == 0 || two) { row_load_bf16(x[t], XS + (size_t)(t0 + i) * D, F.lane); row_load_fp8(y[t], YS + (size_t)i * D, F.lane); } }
        u32x4 zr[2][8];
#pragma unroll
        for (int t = 0; t < 2; ++t) if (t == 0 || two) {
#pragma unroll
            for (int s = 0; s < 8; ++s) { const int ps = __builtin_amdgcn_readlane(pj[t], s); zr[t][s] = ((const GAS u32x4*)(YB + (size_t)ps * D))[F.lane]; } }
#pragma unroll
        for (int t = 0; t < 2; ++t) if (t == 0 || two) { const int i = t ? i1 : i0; const int row = t0 + i; const int mr = mod_row(row);
#pragma unroll
            for (int j = 0; j < 4; ++j) y[t].v[j] = y[t].v[j] * (1.f / 16.f);
#pragma unroll
            for (int s = 0; s < 8; ++s) { const float wz = __builtin_bit_cast(float, __builtin_amdgcn_readlane(__builtin_bit_cast(int, wj[t]), s)) * (1.f / 16.f);
#pragma unroll
                for (int j = 0; j < 4; ++j) { const f32x2v lo = __builtin_amdgcn_cvt_pk_f32_fp8((int)zr[t][s][j], false), hi = __builtin_amdgcn_cvt_pk_f32_fp8((int)zr[t][s][j], true); y[t].v[j] += (f32x4){lo[0], lo[1], hi[0], hi[1]} * wz; } }
            const float* g2 = mod_vec(F.ws, layer, mr, 5);
#pragma unroll
            for (int j = 0; j < 4; ++j) x[t].v[j] = x[t].v[j] * ALPHA + ((const GAS f32x4*)g2)[vq(j, F.lane)] * y[t].v[j];
            row_normalize(x[t], LN_EPS);
#pragma unroll
            for (int j = 0; j < 4; ++j) x[t].v[j] = x[t].v[j] * ((const GAS f32x4*)lg)[vq(j, F.lane)] + ((const GAS f32x4*)lb)[vq(j, F.lane)];
            if (layer == 3) { row_store_f32(x[t], a.out + (size_t)row * D, F.lane); }
            else { row_store_bf16(x[t], XS + (size_t)row * D, F.lane);
                row_modulate(x[t], mod_vec(F.ws, layer + 1, mr, 0), mod_vec(F.ws, layer + 1, mr, 1), F.lane);
                row_store_fp8(x[t], (unsigned char*)a.out + OUT_U8 + (size_t)row * D, F.lane); } }
    }
}
__device__ __forceinline__ float wave_max_dpp(float v) {
    int x = __builtin_bit_cast(int, v);
#define DPPMAX(ctrl) { const int y = __builtin_amdgcn_update_dpp(x, x, ctrl, 0xf, 0xf, false); x = __builtin_bit_cast(int, fmaxf(__builtin_bit_cast(float, x), __builtin_bit_cast(float, y))); }
    DPPMAX(0xB1) DPPMAX(0x4E) DPPMAX(0x141) DPPMAX(0x140)
#undef DPPMAX
    const float r0 = __builtin_bit_cast(float, __builtin_amdgcn_readlane(x, 0)), r1 = __builtin_bit_cast(float, __builtin_amdgcn_readlane(x, 16));
    const float r2 = __builtin_bit_cast(float, __builtin_amdgcn_readlane(x, 32)), r3 = __builtin_bit_cast(float, __builtin_amdgcn_readlane(x, 48));
    return fmaxf(fmaxf(r0, r1), fmaxf(r2, r3));
}
__device__ __forceinline__ void route_tokens(Frame& F, const Args& a, int layer, int ntok) {
    F.refresh();
    const int TPB = ntok / GRID;
    const bf16_t* U = (const bf16_t*)(F.ws + WS_XS); const bf16_t* Wr = (const bf16_t*)(F.ws + WS_WR) + (size_t)layer * 64 * 1024;
    int* tke = (int*)(F.ws + WS_TKE); float* tkw = (float*)(F.ws + WS_TKW);
    LAS int* lcnt = (LAS int*)(F.lds + L_LCNT);
    LAS float* lg = (LAS float*)(F.lds);
    if (F.tid < 64) lcnt[F.tid] = 0;
    const int lane = F.lane, fr = lane & 15, fq = lane >> 4;
    const int ntile = TPB / 16;
    constexpr int WPITCH = 1040; constexpr int L_SE = 122880;
    LAS float* sEb = (LAS float*)(F.lds + L_SE);
    f32x4 acc[3][4];
#pragma unroll
    for (int i = 0; i < 3; ++i)
#pragma unroll
        for (int n = 0; n < 4; ++n) acc[i][n] = (f32x4){0.f, 0.f, 0.f, 0.f};
    int grp_of[3] = {0, 0, 0};
    int tl_lo = 0, g = 0;
    while (tl_lo < ntile) {
        const int mr = mod_row(F.blk * TPB + tl_lo * 16); int tl_hi = tl_lo + 1;
        while (tl_hi < ntile && mod_row(F.blk * TPB + tl_hi * 16) == mr) ++tl_hi;
        const float* shv = mod_vec(F.ws, layer, mr, 3); const float* scv = mod_vec(F.ws, layer, mr, 4);
        for (int half = 0; half < 2; ++half) {
            __syncthreads();
            { const int kc = lane, k = half * 512 + kc * 8;
              const f32x4 c0 = *(const GAS f32x4*)(scv + k) + 1.f, c1 = *(const GAS f32x4*)(scv + k + 4) + 1.f, h0 = *(const GAS f32x4*)(shv + k), h1 = *(const GAS f32x4*)(shv + k + 4);
              u32x4 wv[8];
#pragma unroll
              for (int j = 0; j < 8; ++j) wv[j] = *(const GAS u32x4*)(Wr + (size_t)(F.wave + 8 * j) * D + k);
#pragma unroll
              for (int j = 0; j < 8; ++j) { const int e = F.wave + 8 * j; const u32x4 w = wv[j];
                const float w0 = bflo(w.x), w1 = bfhi(w.x), w2 = bflo(w.y), w3 = bfhi(w.y), w4 = bflo(w.z), w5 = bfhi(w.z), w6 = bflo(w.w), w7 = bfhi(w.w);
                u32x4 o; o.x = cvt_pk_bf16(w0 * c0[0], w1 * c0[1]); o.y = cvt_pk_bf16(w2 * c0[2], w3 * c0[3]); o.z = cvt_pk_bf16(w4 * c1[0], w5 * c1[1]); o.w = cvt_pk_bf16(w6 * c1[2], w7 * c1[3]);
                *(LAS u32x4*)(F.lds + e * WPITCH + kc * 16) = o;
                const float se = wave_sum(((bflo(o.x) + bfhi(o.x)) + (bflo(o.y) + bfhi(o.y))) + ((bflo(o.z) + bfhi(o.z)) + (bflo(o.w) + bfhi(o.w))));
                const float be = wave_sum(((w0 * h0[0] + w1 * h0[1]) + (w2 * h0[2] + w3 * h0[3])) + ((w4 * h1[0] + w5 * h1[1]) + (w6 * h1[2] + w7 * h1[3])));
                if (lane == 0) { if (half == 0) { sEb[g * 64 + e] = se; sEb[192 + g * 64 + e] = be; } else { sEb[g * 64 + e] += se; sEb[192 + g * 64 + e] += be; } }
                asm volatile("" ::: "memory"); } }
            __syncthreads();
#pragma unroll
            for (int i = 0; i < 3; ++i) { const int tl = F.wave + 8 * i;
                if (tl >= tl_lo && tl < tl_hi) { const int t0 = F.blk * TPB + tl * 16;
                    const GAS bf16x8* ap = (const GAS bf16x8*)(U + (size_t)(t0 + fr) * D + half * 512 + fq * 8);
                    bf16x8 av[16];
#pragma unroll
                    for (int ks = 0; ks < 16; ++ks) av[ks] = ap[ks * 4];
#pragma unroll
                    for (int ks = 0; ks < 16; ++ks) {
#pragma unroll
                        for (int n = 0; n < 4; ++n) { const bf16x8 bv = *(const LAS bf16x8*)(F.lds + (n * 16 + fr) * WPITCH + (ks * 32 + fq * 8) * 2); acc[i][n] = __builtin_amdgcn_mfma_f32_16x16x32_bf16(av[ks], bv, acc[i][n], 0, 0, 0); }
                        if ((ks & 1) == 1) __builtin_amdgcn_sched_barrier(0); }
                    grp_of[i] = g; } }
        }
        tl_lo = tl_hi; ++g;
    }
    __syncthreads();
#pragma unroll
    for (int i = 0; i < 3; ++i) { const int tl = F.wave + 8 * i;
        if (tl < ntile) { const int t0 = F.blk * TPB + tl * 16; const int gi = grp_of[i];
#pragma unroll
            for (int j = 0; j < 4; ++j) { const f32x2v st = *(const GAS f32x2v*)(F.ws + WS_RSTAT + (size_t)(t0 + fq * 4 + j) * 8);
#pragma unroll
                for (int n = 0; n < 4; ++n) { const float se = sEb[gi * 64 + n * 16 + fr], be = sEb[192 + gi * 64 + n * 16 + fr];
                    lg[(tl * 16 + fq * 4 + j) * 65 + n * 16 + fr] = st[1] * (acc[i][n][j] - st[0] * se) + be; } } } }
    __syncthreads();
    if (F.tid < TPB) {
        const int tok = F.blk * TPB + F.tid; const LAS float* row = lg + F.tid * 65; const float* bias = a.in[13] + layer * 64;
        float sg[64], sel[64];
#pragma unroll
        for (int e = 0; e < 64; ++e) { sg[e] = 1.f / (1.f + __expf(-row[e])); sel[e] = sg[e] + bias[e]; }
        float gs[8];
#pragma unroll
        for (int g = 0; g < 8; ++g) { float m1 = -INFINITY, m2 = -INFINITY;
#pragma unroll
            for (int j = 0; j < 8; ++j) { const float v = sel[g * 8 + j]; const bool gt1 = v > m1; m2 = gt1 ? m1 : fmaxf(m2, v); m1 = gt1 ? v : m1; }
            gs[g] = m1 + m2; }
        unsigned gok = 0;
#pragma unroll
        for (int g = 0; g < 8; ++g) { int rk = 0;
#pragma unroll
            for (int h = 0; h < 8; ++h) rk += (gs[h] > gs[g] || (gs[h] == gs[g] && h < g)) ? 1 : 0;
            gok |= (rk < 4 ? 1u : 0u) << g; }
#pragma unroll
        for (int e = 0; e < 64; ++e) sel[e] = ((gok >> (e >> 3)) & 1u) ? sel[e] : -INFINITY;
        int ce[8]; float cw[8]; float tot = 0.f;
#pragma unroll
        for (int it = 0; it < 8; ++it) { float best = -INFINITY, bs = 0.f; int bi = 0;
#pragma unroll
            for (int e = 0; e < 64; ++e) { const bool b = sel[e] > best; best = b ? sel[e] : best; bs = b ? sg[e] : bs; bi = b ? e : bi; }
#pragma unroll
            for (int e = 0; e < 64; ++e) sel[e] = (e == bi) ? -INFINITY : sel[e];
            ce[it] = bi; cw[it] = bs; tot += bs; }
        const float sc = 2.5f / tot;
#pragma unroll
        for (int it = 0; it < 8; ++it) { tke[(size_t)tok * 8 + it] = ce[it]; tkw[(size_t)tok * 8 + it] = cw[it] * sc; __hip_atomic_fetch_add(&lcnt[ce[it]], 1, __ATOMIC_RELAXED, __HIP_MEMORY_SCOPE_WORKGROUP); }
    }
    __syncthreads();
    if (F.tid < 64) F.ctl[CW_BCNT + F.blk * 64 + F.tid] = (unsigned)lcnt[F.tid];
}
__device__ __forceinline__ void build_lists(Frame& F, int ntok) {
    F.refresh();
    constexpr int NSEG = NCHUNK * 64, BPC = GRID / NCHUNK;
    const int TPB = ntok / GRID, CH = ntok / NCHUNK;
    LAS int* tstart = (LAS int*)(F.lds + L_TSTART); LAS int* pref = (LAS int*)(F.lds + L_PREF); LAS int* lcnt = (LAS int*)(F.lds + L_LCNT);
    LAS unsigned char* tseg = (LAS unsigned char*)(F.lds + L_TSEG); LAS int* scan = (LAS int*)(F.lds + L_SCAN);
    const unsigned* bcnt = F.ctl + CW_BCNT;
    const int myc = F.blk / BPC, mylb = F.blk % BPC;
    int nseg = 0;
    LAS int* cntl = (LAS int*)F.lds;
    for (int i = F.tid; i < GRID * 64; i += NTHR) cntl[i] = (int)((const GAS unsigned*)bcnt)[i];
    if (F.tid < 64) lcnt[F.tid] = 0;
    __syncthreads();
    static_assert(NSEG == 64 && NTHR == 512, "build_lists: one chunk, eight partial sums per expert");
    LAS int* part = (LAS int*)(F.lds + 65536);
    { const int e = F.tid & 63, q = F.tid >> 6; int n = 0, p = 0;
#pragma unroll 8
      for (int lb = q * 32; lb < q * 32 + 32; ++lb) { const int v = cntl[lb * 64 + e]; if (lb < mylb) p += v; n += v; }
      part[q * 64 + e] = n; part[512 + q * 64 + e] = p; }
    __syncthreads();
    if (F.tid < 64) { int n = 0, p = 0;
#pragma unroll
        for (int q = 0; q < 8; ++q) { n += part[q * 64 + F.tid]; p += part[512 + q * 64 + F.tid]; }
        nseg = n; pref[F.tid] = p;
        const int tiles = (n + 255) >> 8; int incl = tiles;
#pragma unroll
        for (int d = 1; d < 64; d <<= 1) { const int o = __shfl_up(incl, d); if (F.lane >= d) incl += o; }
        tstart[F.tid + 1] = incl; if (F.tid == 0) tstart[0] = 0;
        for (int t = incl - tiles; t < incl; ++t) tseg[t] = (unsigned char)F.tid; }
    int* stok = (int*)(F.ws + WS_STOK); int* spos = (int*)(F.ws + WS_SDST);
    const int* tke = (const int*)(F.ws + WS_TKE);
    { const int sseg = myc * 64 + mylb; if (mylb < 64 && F.tid == sseg) scan[0] = nseg; }
    __syncthreads();
    if (mylb < 64) { const int sseg = myc * 64 + mylb; const int n = scan[0]; const int base = tstart[sseg] * 256, end = tstart[sseg + 1] * 256;
      for (int p = base + n + F.tid; p < end; p += NTHR) stok[p] = myc * CH; }
    for (int tb = F.wave * 8; tb < TPB; tb += NWAVES * 8) { const int tl = tb + (F.lane >> 3);
        if (tl < TPB) { const int tok = F.blk * TPB + tl; const int e = tke[(size_t)tok * 8 + (F.lane & 7)];
            const int p = tstart[myc * 64 + e] * 256 + pref[e] + __hip_atomic_fetch_add(&lcnt[e], 1, __ATOMIC_RELAXED, __HIP_MEMORY_SCOPE_WORKGROUP);
            stok[p] = tok; spos[(size_t)tok * 8 + (F.lane & 7)] = p - tstart[myc * 64] * 256; } }
    __syncthreads();
}

struct SchedQKV {
    const char* U; const char* W; int nfull, nu, c;
    __device__ __forceinline__ bool next(int i, pg::Unit& u) const {
        const int L0 = i * GRID + c; if (L0 >= nu) return false;
        int pm, pn;
        if (L0 < nfull) { const int L = pg::xcd_remap(L0, nfull); const int gid = L / 48, w = L % 48; pm = gid * 8 + (w & 7); pn = w >> 3; }
        else { const int q = L0 - nfull; pm = 256 + (q >> 1); pn = 4 + (q & 1); }
        u.A = U + (size_t)pm * 256 * 1024; u.B = W + (size_t)pn * 256 * 1024; u.gidx = nullptr; u.gbase = 0; u.nt = 8; u.out = nullptr; u.ldc = 0; u.scale = 1.f; u.flags = 0; u.i0 = pm; u.i1 = pn;
        return true; }
};
struct SchedDense {
    const char* A; const char* W; char* out; int nrt, nct, nt, c; size_t ldA;
    __device__ __forceinline__ bool next(int i, pg::Unit& u) const {
        const int nu = nrt * nct; const int L0 = i * GRID + c; if (L0 >= nu) return false;
        const int L = pg::xcd_remap(L0, nu); const int per = 8 * nct, gid = L / per, w = L % per, fm = gid * 8, gsz = (nrt - fm) < 8 ? (nrt - fm) : 8; const int pm = fm + (w % gsz), pn = w / gsz;
        u.A = A + (size_t)pm * 256 * ldA; u.B = W + (size_t)pn * 256 * ldA; u.gidx = nullptr; u.gbase = 0; u.nt = nt; u.out = out + (size_t)pm * 256 * 1024; u.ldc = 1024; u.scale = 1.f; u.flags = 0; u.i0 = pm; u.i1 = pn;
        return true; }
};
struct SchedF1 {
    const char* CS; const char* U; char* ABT; char* ABTC; int nu, c;
    __device__ __forceinline__ bool next(int i, pg::Unit& u) const {
        const int L0 = i * GRID + c; if (L0 >= nu) return false;
        u.gidx = nullptr; u.gbase = 0; u.nt = 2; u.scale = 1.f; u.flags = 0; u.i0 = 0; u.i1 = 0;
        if (L0 < 2048) { const int L = pg::xcd_remap(L0, 2048); const int pm = L & 1, pn = (L >> 1) & 7, bg = L >> 4, b = bg >> 2, g = bg & 3;
            u.A = CS + (size_t)pm * 256 * 256; u.B = U + ((size_t)b * SEQ + pn * 256) * 1024 + g * 256; u.out = ABT + (size_t)bg * 256 * 4096 + (size_t)(pm * 2048 + pn * 256); u.ldc = 4096; }
        else { const int q = L0 - 2048; const int pm = q & 1, bg = q >> 1, b = bg >> 2, g = bg & 3;
            u.A = CS + (size_t)pm * 256 * 256; u.B = U + ((size_t)T + b * CTXL) * 1024 + g * 256; u.out = ABTC + (size_t)bg * 256 * 512 + (size_t)pm * 256; u.ldc = 512; }
        return true; }
};
struct SchedF2 {
    const char* DL; const char* ABT; char* FH; int c;
    __device__ __forceinline__ bool next(int i, pg::Unit& u) const {
        const int L0 = i * GRID + c; if (L0 >= 512) return false;
        const int L = pg::xcd_remap(L0, 512); const int pm = L & 3, bg = L >> 2, b = bg >> 2, g = bg & 3;
        u.A = DL + (size_t)pm * 256 * 4096; u.B = ABT + (size_t)bg * 256 * 4096; u.gidx = nullptr; u.gbase = 0; u.nt = 32; u.out = FH + ((size_t)b * 1024 + pm * 256) * 1024 + g * 256; u.ldc = 1024; u.scale = 0.001381067932004975f  ; u.flags = 0; u.i0 = 0; u.i1 = 0;
        return true; }
};
struct SchedF2c {
    const char* DLC; const char* ABTC; char* FC; int c;
    __device__ __forceinline__ bool next(int i, pg::Unit& u) const {
        const int L0 = i * GRID + c; if (L0 >= 128) return false;
        const int bg = L0, b = bg >> 2, g = bg & 3;
        u.A = DLC; u.B = ABTC + (size_t)bg * 256 * 512; u.gidx = nullptr; u.gbase = 0; u.nt = 4; u.out = FC + ((size_t)b * 256) * 1024 + g * 256; u.ldc = 1024; u.scale = 1.f / 256.f; u.flags = 0; u.i0 = 0; u.i1 = 0;
        return true; }
};
struct SchedF3 {
    const char* FH; const char* FC; const char* W; char* Y; int nu, c;
    __device__ __forceinline__ bool next(int i, pg::Unit& u) const {
        const int L0 = i * GRID + c; if (L0 >= nu) return false;
        u.gidx = nullptr; u.gbase = 0; u.nt = 8; u.scale = 1.f; u.flags = 0; u.i0 = 0; u.i1 = 0;
        if (L0 < 1024) { const int L = pg::xcd_remap(L0, 1024); const int gid = L >> 6, w = L & 63, pm = gid * 8 + (w & 7), pn = w >> 3; const int b = pm >> 2, k0 = (pm & 3) * 256;
            u.A = FH + (size_t)pm * 256 * 1024; u.B = W + (size_t)pn * 256 * 1024;
            if (pn < 4) { u.out = Y + ((size_t)b * SEQ + k0) * 1024; u.ldc = 1024; u.i1 = pn; }
            else { u.out = Y + ((size_t)b * SEQ + SEQ - k0) * 1024; u.ldc = -1024; u.i1 = pn - 4; u.flags = (k0 == 0) ? 1 : 0; } }
        else { const int q = L0 - 1024; const int pm = q >> 2, pn = q & 3;
            u.A = FC + (size_t)pm * 256 * 1024; u.B = W + (size_t)pn * 256 * 1024; u.out = Y + ((size_t)T + pm * 256) * 1024; u.ldc = 1024; u.i1 = pn; }
        return true; }
};
struct SchedG1 {
    const char* EGU; const int* STOK; char* H; char* HS; LAS const unsigned char* tseg; int ntl, nsh, c;
    __device__ __forceinline__ bool gsrc(int i, const int*& gidx, int& gbase) const {
        const int nu = (ntl + nsh) * 2; const int L0 = i * GRID + c; if (L0 >= nu) return false;
        const int pm = pg::xcd_remap(L0, nu) >> 1;
        if (pm < ntl) { gidx = STOK + (size_t)pm * 256; gbase = 0; } else { gidx = nullptr; gbase = (pm - ntl) * 256; }
        return true; }
    __device__ __forceinline__ bool next(int i, pg::Unit& u) const {
        const int nu = (ntl + nsh) * 2; const int L0 = i * GRID + c; if (L0 >= nu) return false;
        const int L = pg::xcd_remap(L0, nu); const int pm = L >> 1, pn = L & 1;
        u.A = nullptr; u.gbase = 0; u.nt = 8; u.ldc = 256; u.scale = 1.f; u.flags = 0; u.i0 = 0; u.i1 = 0;
        if (pm < ntl) { const int e = __builtin_amdgcn_readfirstlane((int)tseg[pm]) & 63;
            u.gidx = STOK + (size_t)pm * 256; u.B = EGU + (size_t)e * 512 * 1024 + (size_t)pn * 256 * 1024; u.out = H + (size_t)pm * 256 * 256 + pn * 128; }
        else { const int ps = pm - ntl; u.gidx = nullptr; u.gbase = ps * 256; u.B = EGU + (size_t)NE * 512 * 1024 + (size_t)pn * 256 * 1024; u.out = HS + (size_t)ps * 256 * 256 + pn * 128; }
        return true; }
};
struct SchedG2 {
    const char* ED; const char* H; const char* HS; char* YB; char* YS; LAS const unsigned char* tseg; int t0, t1, nsh, ch, CH, c;
    __device__ __forceinline__ bool next(int i, pg::Unit& u) const {
        const int nr = t1 - t0; const int nu = (nr + nsh) * 4; const int L0 = i * GRID + c; if (L0 >= nu) return false;
        const int L = pg::xcd_remap(L0, nu); const int q = L >> 2, pn = L & 3;
        u.gidx = nullptr; u.gbase = 0; u.nt = 2; u.ldc = 1024; u.scale = 1.f; u.flags = 0; u.i0 = 0; u.i1 = pn;
        if (q < nr) { const int pm = t0 + q; const int e = __builtin_amdgcn_readfirstlane((int)tseg[pm]) & 63;
            u.A = H + (size_t)pm * 256 * 256; u.B = ED + (size_t)e * 1024 * 256 + (size_t)pn * 256 * 256; u.out = YB + (size_t)q * 256 * 1024; }
        else { const int ps = q - nr; u.A = HS + ((size_t)ch * CH + ps * 256) * 256; u.B = ED + (size_t)NE * 1024 * 256 + (size_t)pn * 256 * 256; u.out = YS + (size_t)ps * 256 * 1024; }
        return true; }
};

__device__ __forceinline__ void fnet_nyquist_rows(Frame& F) {
    F.refresh();
    const unsigned char* ABT = F.ws + WS_ABT; bf16_t* FH1 = (bf16_t*)(F.ws + WS_FH1);
    static_assert((128 * 256) % (4 * NGW) == 0, "fnet_nyquist_rows: four rows per wave and step");
    for (int r0 = F.gw; r0 < 128 * 256; r0 += 4 * NGW) {
        u32x4 w[4][2];
#pragma unroll
        for (int t = 0; t < 4; ++t) { const GAS u32x4* p = (const GAS u32x4*)(ABT + (size_t)(r0 + t * NGW) * 4096);
#pragma unroll
            for (int i = 0; i < 2; ++i) w[t][i] = p[i * 64 + F.lane]; }
#pragma unroll
        for (int t = 0; t < 4; ++t) { const int r = r0 + t * NGW; const int bg = r >> 8, m = r & 255, b = bg >> 2, g = bg & 3; float s = 0.f;
#pragma unroll
            for (int i = 0; i < 2; ++i)
#pragma unroll
                for (int q = 0; q < 4; ++q) { const f32x2v lo = __builtin_amdgcn_cvt_pk_f32_fp8((int)w[t][i][q], false), hi = __builtin_amdgcn_cvt_pk_f32_fp8((int)w[t][i][q], true); s += (lo[0] - lo[1]) + (hi[0] - hi[1]); }
            s = wave_sum(s) * 0.001381067932004975f;
            if (F.lane == 0) FH1[(size_t)b * 1024 + g * 256 + m] = (bf16_t)f2bf(s); } }
}
__device__ __forceinline__ void fnet_nyquist_out(Frame& F, const Args& a, int jl) {
    F.refresh();
    const bf16_t* FH1 = (const bf16_t*)(F.ws + WS_FH1); const bf16_t* W = (const bf16_t*)(F.ws + WS_WF) + (size_t)jl * 2048 * 1024; unsigned char* Y = (unsigned char*)a.out;
    LAS float* part = (LAS float*)F.lds;
    const int b = F.blk >> 3, n = (F.blk & 7) * 128 + (F.tid & 127), kq = F.tid >> 7;
    const GAS u32x4* wp = (const GAS u32x4*)(W + (size_t)n * 1024 + kq * 256); const GAS u32x4* fp = (const GAS u32x4*)(FH1 + (size_t)b * 1024 + kq * 256);
    float s = 0.f;
#pragma unroll 4
    for (int i = 0; i < 32; ++i) { const u32x4 w = wp[i], f = fp[i];
        s += bflo(w.x) * bflo(f.x) + bfhi(w.x) * bfhi(f.x) + bflo(w.y) * bflo(f.y) + bfhi(w.y) * bfhi(f.y) + bflo(w.z) * bflo(f.z) + bfhi(w.z) * bfhi(f.z) + bflo(w.w) * bflo(f.w) + bfhi(w.w) * bfhi(f.w); }
    part[F.tid] = s;
    __syncthreads();
    if (F.tid < 128) { const float t = (part[F.tid] + part[F.tid + 128]) + (part[F.tid + 256] + part[F.tid + 384]); const int cc = n & 127;
        Y[((size_t)b * SEQ + 1024) * D + (16 * (n >> 8) + (cc >> 3)) * 16 + 8 * ((n >> 7) & 1) + (cc & 7)] = (unsigned char)f2f8(__builtin_amdgcn_fmed3f(t * YSC, -448.f, 448.f)); }
    __syncthreads();
}


#ifdef SELFCHECK
constexpr int CW_ERR = 1024;
__device__ __forceinline__ void chk_report(unsigned* ctl, int id, float got, float ref, float tabs, float trel) {
    float e = fabsf(got - ref) / (tabs + trel * fabsf(ref)); if (!(e == e)) e = 1e30f; atomicMax(ctl + CW_ERR + id, __float_as_uint(e)); }
__device__ __forceinline__ float bf2f(bf16_t b) { return __builtin_bit_cast(float, (unsigned)b << 16); }
__constant__ int chk_toks[16] = {0, 1, 63, 64, 65, 127, 2047, 2048, 2049, 4096, 33000, 65535, 65536, 65537, 70000, 73727};
__constant__ int chk_ks[8] = {0, 1, 2, 255, 256, 1023, 1024, 700};
__constant__ int chk_ms[4] = {0, 1, 128, 255};
__constant__ int chk_ytoks[10] = {0, 1, 1023, 1024, 1025, 2047, 2048, 65535, 65536, 73727};
__constant__ int chk_ns[5] = {0, 1, 255, 256, 1023};
__constant__ int chk_cols[20] = {0, 7, 15, 16, 31, 32, 40, 48, 63, 64, 500, 1023, 1024, 1039, 1040, 1072, 1279, 1280, 1300, 1535};
__device__ __forceinline__ void chk_qkv(Frame& F, const Args& a, int layer, int id) {
    F.refresh(); const unsigned char* U = (const unsigned char*)a.out + OUT_U8; const float* W = a.in[8] + (size_t)(layer >> 1) * 1024 * 1536;
    const bf16_t* Qb = (const bf16_t*)(F.ws + WS_Q); const bf16_t* Kb = (const bf16_t*)(F.ws + WS_K); const bf16_t* Vb = (const bf16_t*)(F.ws + WS_V);
    for (int s = F.gw; s < 320; s += NGW) { const int tok = chk_toks[s & 15], col = chk_cols[s >> 4];
        if (layer == 2 && tok >= T && col < 1024) continue;
        const bool rope = (tok < T) && col < 1280; const int hc = col & 63, first = (hc & 31) < 16; const int pcol = rope ? (first ? col + 16 : col - 16) : col;
        float x = 0.f, xp = 0.f;
        for (int k = F.lane; k < 1024; k += 64) { const float u = f82f(U[(size_t)tok * D + k]); x += u * W[(size_t)k * 1536 + col]; xp += u * W[(size_t)k * 1536 + pcol]; }
        x = wave_sum(x); xp = wave_sum(xp);
        float ref = x;
        if (rope) { const int tl = tok & 2047, part = hc >> 5, pos = part ? (tl & 63) : (tl >> 6), fi = hc & 15; const float ang = (float)pos * powf(10000.f, -(float)fi / 16.f);
            ref = x * cosf(ang) + (first ? -xp : xp) * sinf(ang); }
        if (col < 1024) ref *= C2;
        const float got = col < 1024 ? bf2f(Qb[(size_t)tok * 1024 + col]) : (col < 1280 ? bf2f(Kb[(size_t)tok * 256 + col - 1024]) : bf2f(Vb[(size_t)tok * 256 + col - 1280]));
        if (F.lane == 0) chk_report(F.ctl, id, got, ref, 0.20f, 0.10f); }
}
__device__ __forceinline__ void chk_attn(Frame& F, const Args& a, int layer, int id) {
    F.refresh(); const bf16_t* Qb = (const bf16_t*)(F.ws + WS_Q); const bf16_t* Kb = (const bf16_t*)(F.ws + WS_K); const bf16_t* Vb = (const bf16_t*)(F.ws + WS_V); const unsigned char* Ob = F.ws + WS_R + 216 * MiB;
    LAS float* lg = (LAS float*)F.lds + F.wave * 1024;
    for (int s = F.gw; s < 64; s += NGW) { const int tok = chk_toks[s & 15], h = (s >> 4) * 5, kvh = h >> 2;
        if (layer == 2 && tok >= T) continue;
        const bool isctx = tok >= T; const int b = isctx ? (tok - T) / CTXL : tok / SEQ, p = tok & (SEQ - 1);
        int nk = 0; const int lo = isctx ? 0 : (p - 128 < 0 ? 0 : p - 128), hi = isctx ? -1 : (p + 128 > SEQ - 1 ? SEQ - 1 : p + 128);
        const int nlat = isctx ? 0 : hi - lo + 1; nk = nlat + CTXL;
        float mx = a.in[10][(layer >> 1) * 16 + h] * LOG2E; const float sink2 = mx;
        for (int i = F.lane; i < nk; i += 64) { const size_t kr = i < nlat ? (size_t)b * SEQ + lo + i : (size_t)T + b * CTXL + (i - nlat); float d = 0.f;
            for (int e = 0; e < 64; ++e) d += bf2f(Qb[(size_t)tok * 1024 + h * 64 + e]) * bf2f(Kb[kr * 256 + kvh * 64 + e]);
            lg[i] = d; mx = fmaxf(mx, d); }
#pragma unroll
        for (int o = 1; o < 64; o <<= 1) mx = fmaxf(mx, __shfl_xor(mx, o));
        LDS_WAIT();
        float den = 0.f; for (int i = F.lane; i < nk; i += 64) den += exp2f(lg[i] - mx);
        den = wave_sum(den) + exp2f(sink2 - mx);
        float o = 0.f;
        for (int i = 0; i < nk; ++i) { const size_t kr = i < nlat ? (size_t)b * SEQ + lo + i : (size_t)T + b * CTXL + (i - nlat); o += exp2f(lg[i] - mx) * bf2f(Vb[kr * 256 + kvh * 64 + F.lane]); }
        o /= den;
        chk_report(F.ctl, id, f82f(Ob[(size_t)tok * 1024 + h * 64 + F.lane]), o, 0.02f, 0.08f); chk_report(F.ctl, 32 + (s & 15), f82f(Ob[(size_t)tok * 1024 + h * 64 + F.lane]), o, 0.02f, 0.08f);
        LDS_WAIT(); }
    __syncthreads();
}
__device__ __forceinline__ void chk_fnet_f(Frame& F, const Args& a, bool upd, int id) {
    F.refresh(); const unsigned char* U = (const unsigned char*)a.out + OUT_U8; LAS float* red = (LAS float*)F.lds;
    for (int s = F.blk; s < 128 + (upd ? 64 : 0); s += GRID) {
        const bool cx = s >= 128; const int q = cx ? s - 128 : s; const int m = chk_ms[q & 3], g = ((q >> 2) & 1) * 3, b = ((q >> 3) & 1) * 31; int k = chk_ks[(q >> 4) & 7]; const int L = cx ? CTXL : SEQ; if (cx) k &= 255;
        const size_t row0 = cx ? (size_t)T + b * CTXL : (size_t)b * SEQ;
        float acc = 0.f;
        for (int l = F.wave; l < L; l += NWAVES) { float ca = 0.f, sa = 0.f;
            for (int n = F.lane; n < 256; n += 64) { const float u = f82f(U[(row0 + l) * D + g * 256 + n]); const float an = 6.283185307179586f * (float)((m * n) & 255) / 256.f; const float sn = __sinf(an), cs = __cosf(an); ca += u * cs; sa += u * sn; }
            ca = wave_sum(ca); sa = wave_sum(sa); const float an = 6.283185307179586f * (float)((k * l) % L) / (float)L; const float sn = __sinf(an), cs = __cosf(an); acc += cs * ca - sn * sa; }
        if (F.lane == 0) red[F.wave] = acc;
        __syncthreads();
        if (F.tid == 0) { float t = 0.f; for (int w = 0; w < NWAVES; ++w) t += red[w]; t *= cx ? (1.f / 256.f) : 0.001381067932004975f;
            float got;
            if (cx) got = f82f((F.ws + WS_FC)[((size_t)b * 256 + k) * D + g * 256 + m]);
            else if (k == 1024) got = bf2f(((const bf16_t*)(F.ws + WS_FH1))[(size_t)b * 1024 + g * 256 + m]);
            else got = f82f((F.ws + WS_FH)[((size_t)b * 1024 + k) * D + g * 256 + m]);
            chk_report(F.ctl, id, got, t, 0.25f, 0.10f); }
        __syncthreads(); }
}
__device__ __forceinline__ void chk_fnet_y(Frame& F, const Args& a, int jl, bool upd, int id) {
    F.refresh(); const bf16_t* Y = (const bf16_t*)a.out; const float* W = a.in[11] + (size_t)jl * 1024 * 1024;
    const unsigned char* FH = F.ws + WS_FH; const bf16_t* FH1 = (const bf16_t*)(F.ws + WS_FH1); const unsigned char* FC = F.ws + WS_FC;
    for (int s = F.gw; s < 50; s += NGW) { const int tok = chk_ytoks[s % 10], n = chk_ns[s / 10]; if (tok >= T && !upd) continue;
        float acc = 0.f;
        for (int j = F.lane; j < 1024; j += 64) { float f;
            if (tok >= T) f = f82f(FC[(size_t)(tok - T) * D + j]);
            else { const int b = tok >> 11, k = tok & 2047; if (k < 1024) f = f82f(FH[((size_t)b * 1024 + k) * D + j]); else if (k == 1024) f = bf2f(FH1[(size_t)b * 1024 + j]);
                else f = f82f(FH[((size_t)b * 1024 + (2048 - k)) * D + (j & ~255) + ((256 - (j & 255)) & 255)]); }
            acc += f * W[(size_t)j * 1024 + n]; }
        acc = wave_sum(acc);
        if (F.lane == 0) chk_report(F.ctl, id, bf2f(Y[(size_t)tok * D + n]), acc, 0.04f, 0.08f); }
}
__device__ __forceinline__ void chk_route(Frame& F, const Args& a, int layer, int ntok, int id) {
    F.refresh(); const bf16_t* U = (const bf16_t*)a.out; const float* Wr = a.in[12] + (size_t)layer * 1024 * 64; const int* tke = (const int*)(F.ws + WS_TKE); const float* tkw = (const float*)(F.ws + WS_TKW);
    for (int s = F.gw; s < 16; s += NGW) { const int tok = chk_toks[s]; if (tok >= ntok) continue; const int lane = F.lane;
        float lgt = 0.f; for (int k = 0; k < 1024; ++k) lgt += bf2f(U[(size_t)tok * D + k]) * Wr[(size_t)k * 64 + lane];
        const float sc = 1.f / (1.f + expf(-lgt)), sel = sc + a.in[13][layer * 64 + lane];
        float g1 = -INFINITY, g2 = -INFINITY;
#pragma unroll 1
        for (int j = 0; j < 8; ++j) { const float v = __shfl(sel, (lane & ~7) + j); if (v > g1) { g2 = g1; g1 = v; } else if (v > g2) g2 = v; }
        const float gs = g1 + g2; int gr = 0;
#pragma unroll 1
        for (int gp = 0; gp < 8; ++gp) { const float v = __shfl(gs, gp * 8); gr += (v > gs || (v == gs && gp < (lane >> 3))) ? 1 : 0; }
        const float sm = gr < 4 ? sel : -INFINITY; int rk = 0;
#pragma unroll 1
        for (int ep = 0; ep < 64; ++ep) { const float v = __shfl(sm, ep); rk += (v > sm || (v == sm && ep < lane)) ? 1 : 0; }
        const float tot = wave_sum(rk < 8 ? sc : 0.f); const float wref = sc / tot * 2.5f;
        int slot = -1; for (int j = 0; j < 8; ++j) if (tke[(size_t)tok * 8 + j] == lane) slot = j;
        float err = 0.f;
        if (slot >= 0) { if (rk >= 10) err = 10.f; else if (rk < 8) err = fabsf(tkw[(size_t)tok * 8 + slot] - wref) / (0.04f * wref); }
        else if (rk < 6) err = 10.f;
        const unsigned long long nsel = __ballot(slot >= 0); if (__builtin_popcountll(nsel) != 8) err = 20.f;
        atomicMax(F.ctl + CW_ERR + id, __float_as_uint(err)); }
}
__device__ __forceinline__ void chk_moe(Frame& F, const Args& a, int layer, int ntok, int ch, int id) {
    F.refresh(); const bf16_t* U = (const bf16_t*)a.out; const int* tke = (const int*)(F.ws + WS_TKE); const float* tkw = (const float*)(F.ws + WS_TKW);
    const int CH = ntok / NCHUNK; LAS float* hs = (LAS float*)F.lds; LAS float* us = hs + 512; LAS float* pg_ = us + 1024;
    for (int s = F.blk; s < 16; s += GRID) { const int tok = chk_toks[s]; if (tok >= ntok || tok / CH != ch) continue;
        for (int k = F.tid; k < 1024; k += NTHR) us[k] = bf2f(U[(size_t)tok * D + k]);
        __syncthreads();
        float y0 = 0.f, y1 = 0.f;
        for (int j = 0; j < 9; ++j) { const int e = j < 8 ? tke[(size_t)tok * 8 + j] : 0; const float w = j < 8 ? tkw[(size_t)tok * 8 + j] : 1.f;
            const float* wg = j < 8 ? a.in[14] + ((size_t)layer * NE + e) * 262144 : a.in[17] + (size_t)layer * 262144;
            const float* wu = j < 8 ? a.in[15] + ((size_t)layer * NE + e) * 262144 : a.in[18] + (size_t)layer * 262144;
            const float* wd = j < 8 ? a.in[16] + ((size_t)layer * NE + e) * 262144 : a.in[19] + (size_t)layer * 262144;
            const int hh = F.tid & 255, half = F.tid >> 8; float g = 0.f, u = 0.f;
            for (int k = half * 512; k < half * 512 + 512; ++k) { g += us[k] * wg[(size_t)k * 256 + hh]; u += us[k] * wu[(size_t)k * 256 + hh]; }
            pg_[F.tid] = g; pg_[512 + F.tid] = u;
            __syncthreads();
            if (F.tid < 256) { const float gg = pg_[F.tid] + pg_[F.tid + 256], uu = pg_[512 + F.tid] + pg_[512 + F.tid + 256]; hs[F.tid] = gg / (1.f + expf(-gg)) * uu; }
            __syncthreads();
            float t0 = 0.f, t1 = 0.f; for (int q = 0; q < 256; ++q) { t0 += hs[q] * wd[(size_t)q * 1024 + F.tid]; t1 += hs[q] * wd[(size_t)q * 1024 + 512 + F.tid]; }
            y0 += w * t0; y1 += w * t1;
            __syncthreads(); }
        float g0 = 0.f, g1 = 0.f; const int i = tok - ch * CH;
        { const unsigned char* YSb = (const unsigned char*)(F.ws + WS_YS); const unsigned char* YBb = (const unsigned char*)(F.ws + WS_YB); const int* spos = (const int*)(F.ws + WS_SDST);
          const int t_ = F.tid, bo = 16 * (16 * (t_ >> 8) + ((t_ & 127) >> 3)) + 8 * ((t_ >> 7) & 1) + (t_ & 7);
          auto f8 = [](unsigned char b) { return __builtin_amdgcn_cvt_pk_f32_fp8((int)b, false)[0] * (1.f / 16.f); };
          g0 = f8(YSb[(size_t)i * D + bo]); g1 = f8(YSb[(size_t)i * D + bo + 512]);
          for (int j = 0; j < 8; ++j) { const size_t ps = (size_t)spos[(size_t)tok * 8 + j]; const float w = tkw[(size_t)tok * 8 + j]; g0 += w * f8(YBb[ps * D + bo]); g1 += w * f8(YBb[ps * D + bo + 512]); } }
        chk_report(F.ctl, id, g0, y0, 0.15f, 0.15f); chk_report(F.ctl, id, g1, y1, 0.15f, 0.15f);
        __syncthreads(); }
}
#endif

#ifndef PH_MASK
#define PH_MASK 0xffffffffu
#endif
#define PH(b) ((PH_MASK >> (b)) & 1u)
__global__ void __launch_bounds__(NTHR, 2) fwd(Args a) {
    extern __shared__ __attribute__((aligned(16))) unsigned char lds_raw[];
    Frame F;
    F.lds = (LAS unsigned char*)lds_raw; F.ws = a.ws; F.ctl = (unsigned*)(a.ws + WS_CTL);
    F.blk = blockIdx.x; F.refresh();
    for (int u = F.tid; u < (LDS_BYTES - RING_BYTES) / 4; u += NTHR) ((LAS unsigned*)(F.lds + RING_BYTES))[u] = 0u;
    __syncthreads();
    const XcdBarrier bar = xcd_barrier_post(F.ctl + CW_BAR, (volatile LAS unsigned*)(F.lds + L_MISC) + 8);
#define GRID_BAR() xcd_barrier(bar)
    LAS unsigned char* ring = F.lds;
    const int c = F.blk;
#define ws (F.ws)
#define NEWPH() F.refresh()

    if (PH(0)) { conv_small(F, a);
    __syncthreads();
    mod_full(F, a); }
    GRID_BAR();
    if (PH(1)) { rows_init(F, a); }
    GRID_BAR();

    for (int layer = 0; layer < 4; ++layer) {
        const int jl = layer >> 1; const bool upd = layer < 2; const int nrows = upd ? TT : T;
        if ((layer & 1) == 0) {
            NEWPH();
            if (PH(2)) { SchedQKV S; S.U = (const char*)a.out + OUT_U8; S.W = (const char*)(ws + WS_WQKV) + (size_t)jl * 1536 * 1024; S.nfull = (layer == 0) ? 288 * 6 : 256 * 6; S.nu = (layer == 0) ? 288 * 6 : 256 * 6 + 64; S.c = c;
              pg::EpiQKV E; E.Q = (bf16_t*)(ws + WS_Q); E.K = (bf16_t*)(ws + WS_K); E.V = (bf16_t*)(ws + WS_V); E.ropec = (const float*)(ws + WS_ROPEC); E.ropes = (const float*)(ws + WS_ROPES);
              pg::gemm_phase<pg::EpiQKV, SchedQKV, false, true>(ring, 1024u, 1024u, nullptr, S, E); }
            GRID_BAR();
#ifdef SELFCHECK
            if (SELFCHECK & 1) chk_qkv(F, a, layer, 1 + (layer >> 1));
#endif
#define OBUF ((bf16_t*)(ws + WS_R + 216 * MiB))
            NEWPH();
            if (PH(3)) { const int NU = 2048 + (layer == 0 ? 256 : 0);
              const bf16_t* Qb = (const bf16_t*)(ws + WS_Q); const bf16_t* Kb = (const bf16_t*)(ws + WS_K); const bf16_t* Vb = (const bf16_t*)(ws + WS_V);
              for (int i = 0; i * GRID + c < NU; ++i) { int id = pg::xcd_remap(i * GRID + c, NU);
                  if (NU > 2048) { const int g9 = id / 9, r9 = id - g9 * 9; id = (r9 < 8) ? g9 * 8 + r9 : 2048 + g9; }
                  if (id < 2048) { const int hp = id & 1, qb = (id >> 1) & 7, kvh = (id >> 4) & 3, b = id >> 6, h0 = kvh * 4 + hp * 2;
                      attn::attn_unit2(Qb, Kb, Vb, OBUF, b, h0, qb * 256, false, a.in[10][jl * 16 + h0] * LOG2E, a.in[10][jl * 16 + h0 + 1] * LOG2E, ring); }
                  else { const int cid = id - 2048, hp = cid & 1, kvh = (cid >> 1) & 3, b = cid >> 3, h0 = kvh * 4 + hp * 2;
                      attn::attn_unit2(Qb, Kb, Vb, OBUF, b, h0, 0, true, a.in[10][jl * 16 + h0] * LOG2E, a.in[10][jl * 16 + h0 + 1] * LOG2E, ring); } } }
            GRID_BAR();
#ifdef SELFCHECK
            if (SELFCHECK & 1) chk_attn(F, a, layer, 3 + (layer >> 1));
#endif
            NEWPH();
            if (PH(4)) { SchedDense S; S.A = (const char*)OBUF; S.W = (const char*)(ws + WS_WO) + (size_t)jl * 1024 * 1024; S.out = (char*)a.out; S.nrt = nrows / 256; S.nct = 4; S.nt = 8; S.c = c; S.ldA = 1024;
              pg::EpiY8 E; pg::gemm_phase<pg::EpiY8, SchedDense, false, true>(ring, 1024u, 1024u, nullptr, S, E); }
            GRID_BAR();
        } else {
            NEWPH();
            if (PH(5)) { SchedF1 S; S.CS = (const char*)(ws + WS_CSN); S.U = (const char*)a.out + OUT_U8; S.ABT = (char*)(ws + WS_ABT); S.ABTC = (char*)(ws + WS_ABTC); S.nu = 2048 + (upd ? 256 : 0); S.c = c;
              pg::EpiStore8 E; pg::gemm_phase<pg::EpiStore8, SchedF1, false, true, 127>(ring, 256u, 1024u, nullptr, S, E); }
            GRID_BAR();
            NEWPH();
            if (PH(6)) { SchedF2 S; S.DL = (const char*)(ws + WS_DL); S.ABT = (const char*)(ws + WS_ABT); S.FH = (char*)(ws + WS_FH); S.c = c;
              pg::EpiStore8 E; pg::gemm_phase<pg::EpiStore8, SchedF2, false, true, 127>(ring, 4096u, 4096u, nullptr, S, E); }
            NEWPH();
            if (PH(7) && upd) { SchedF2c S; S.DLC = (const char*)(ws + WS_DLC); S.ABTC = (const char*)(ws + WS_ABTC); S.FC = (char*)(ws + WS_FC); S.c = c;
              pg::EpiStore8 E; pg::gemm_phase<pg::EpiStore8, SchedF2c, false, true, 127>(ring, 512u, 512u, nullptr, S, E); }
            if (PH(8)) fnet_nyquist_rows(F);
            GRID_BAR();
#ifdef SELFCHECK
            if (SELFCHECK & 2) chk_fnet_f(F, a, upd, 5 + (layer >> 1));
            GRID_BAR();
#endif
            NEWPH();
            if (PH(9)) { SchedF3 S; S.FH = (const char*)(ws + WS_FH); S.FC = (const char*)(ws + WS_FC); S.W = (const char*)(ws + WS_WSH) + (size_t)jl * 2048 * 1024; S.Y = (char*)a.out; S.nu = 1024 + (upd ? 128 : 0); S.c = c;
              pg::EpiY8 E; pg::gemm_phase<pg::EpiY8, SchedF3, false, true>(ring, 1024u, 1024u, nullptr, S, E); }
            if (PH(10)) fnet_nyquist_out(F, a, jl);
            GRID_BAR();
#ifdef SELFCHECK
            if (SELFCHECK & 8) chk_fnet_y(F, a, jl, upd, 7 + (layer >> 1));
            GRID_BAR();
#endif
        }
        if (PH(12)) conv_experts(F, a, layer);
        __syncthreads();
        if (PH(11)) rows_post1(F, a, layer, nrows);
        VM_WAIT(); __syncthreads();
        if (threadIdx.x == 0) { __builtin_amdgcn_fence(__ATOMIC_ACQUIRE, "agent"); VM_WAIT(); }
        __syncthreads();
        if (PH(13)) route_tokens(F, a, layer, nrows);
        GRID_BAR();
#ifdef SELFCHECK
        if ((SELFCHECK & 64) && layer < 2) chk_route(F, a, layer, nrows, 9);
#endif
        if (PH(14)) build_lists(F, nrows);
        GRID_BAR();
        LAS const int* tstart = (LAS const int*)(F.lds + L_TSTART); LAS const unsigned char* tseg = (LAS const unsigned char*)(F.lds + L_TSEG);
        const int ntl = __builtin_amdgcn_readfirstlane(tstart[NCHUNK * 64]);
        NEWPH();
        if (PH(15)) { SchedG1 S; S.EGU = (const char*)(ws + WS_EGU); S.STOK = (const int*)(ws + WS_STOK); S.H = (char*)(ws + WS_H); S.HS = (char*)(ws + WS_HS); S.tseg = tseg; S.ntl = ntl; S.nsh = nrows / 256; S.c = c;
          pg::EpiSilu E; pg::gemm_phase<pg::EpiSilu, SchedG1, true, true>(ring, 1024u, 1024u, (const char*)a.out + OUT_U8, S, E); }
        GRID_BAR();
        const int CH = nrows / NCHUNK;
        for (int ch = 0; ch < NCHUNK; ++ch) {
            NEWPH();
            if (PH(16)) { SchedG2 S; S.ED = (const char*)(ws + WS_ED); S.H = (const char*)(ws + WS_H); S.HS = (const char*)(ws + WS_HS); S.YB = (char*)(ws + WS_YB); S.YS = (char*)(ws + WS_YS); S.tseg = tseg;
              S.t0 = __builtin_amdgcn_readfirstlane(tstart[ch * 64]); S.t1 = __builtin_amdgcn_readfirstlane(tstart[ch * 64 + 64]); S.nsh = CH / 256; S.ch = ch; S.CH = CH; S.c = c;
              pg::EpiFp8 E; pg::gemm_phase<pg::EpiFp8, SchedG2, false, true>(ring, 256u, 256u, nullptr, S, E); }
            GRID_BAR();
#ifdef SELFCHECK
            if ((SELFCHECK & 4) && layer == 0) { chk_moe(F, a, layer, nrows, ch, 10); GRID_BAR(); }
#endif
            if (PH(17)) rows_post2(F, a, layer, ch * CH, CH);
            if (!(layer == 3 && ch == NCHUNK - 1)) GRID_BAR();
        }
    }
#ifdef SELFCHECK
    GRID_BAR();
    { int bad = 0; float be = 0.f; for (int k = 15; k >= 1; --k) { const float e = __uint_as_float(__hip_atomic_load(F.ctl + CW_ERR + k, RLX_AGENT)); if (e > 1.f) { bad = k; be = e; } }
      int wt = 0; float we = 0.f; for (int k = 0; k < 16; ++k) { const float e = __uint_as_float(__hip_atomic_load(F.ctl + CW_ERR + 32 + k, RLX_AGENT)); if (e > we) { we = e; wt = k; } }
      if (bad) { F.refresh(); float cv = 3.f + bad + (be > 8.f ? 0.5f : 0.f);  Row r; for (int j = 0; j < 4; ++j) r.v[j] = (f32x4){cv, cv, cv, cv}; for (int row = F.gw; row < T; row += NGW) row_store_f32(r, a.out + (size_t)row * D, F.lane); } }
#endif
}

#undef ws
#undef NEWPH
extern "C" void kernel_launch(void* const* d_in, const int* in_sizes, int n_in, void* d_out, int out_size, void* d_ws, size_t ws_size, hipStream_t stream) {
    static int ready = 0;
    if (ready == 0) {
        if (n_in != 20 || out_size != T * D || ws_size < WS_END) { fprintf(stderr, "kernel_launch: unexpected problem (n_in %d out %d ws %zu need %zu)\n", n_in, out_size, ws_size, (size_t)WS_END); ready = -1; return; }
        if (hipFuncSetAttribute((const void*)fwd, hipFuncAttributeMaxDynamicSharedMemorySize, LDS_BYTES) != hipSuccess) { fprintf(stderr, "kernel_launch: hipFuncSetAttribute failed\n"); ready = -1; return; }
        int per_cu = 0;
        if (hipOccupancyMaxActiveBlocksPerMultiprocessor(&per_cu, (const void*)fwd, NTHR, LDS_BYTES) != hipSuccess || per_cu < 1) fprintf(stderr, "kernel_launch: occupancy query says %d blocks per CU\n", per_cu);
        (void)hipGetLastError();
        ready = 1;
    }
    if (ready < 0) return;
    (void)hipMemsetAsync((char*)d_ws + WS_CTL, 0, CTL_BYTES, stream);
    Args a{};
    for (int i = 0; i < 20; ++i) a.in[i] = (const float*)d_in[i];
    a.out = (float*)d_out; a.ws = (unsigned char*)d_ws;
    hipLaunchKernelGGL(fwd, dim3(GRID), dim3(NTHR), LDS_BYTES, stream, a);
}
```

```cpp
#include <hip/hip_runtime.h>
#include <cstdio>
#include <cstdint>

#define LAS __attribute__((address_space(3)))
#define GAS __attribute__((address_space(1)))
typedef unsigned short bf16_t;
typedef short bf16x8 __attribute__((ext_vector_type(8)));
typedef short s16x4 __attribute__((ext_vector_type(4)));
typedef float f32x4 __attribute__((ext_vector_type(4)));
typedef float f32x16 __attribute__((ext_vector_type(16)));
typedef unsigned u32x4 __attribute__((ext_vector_type(4)));
typedef unsigned u32x2 __attribute__((ext_vector_type(2)));
typedef int v8i_t __attribute__((ext_vector_type(8)));
typedef int v4i_t __attribute__((ext_vector_type(4)));

constexpr int D = 1024, NB = 32, SEQ = 2048, T = NB * SEQ, CTXL = 256, TC = NB * CTXL, TT = T + TC;
constexpr int NQKV = 1536, NE = 64;
constexpr float ALPHA = 1.681792830507429f;
constexpr float LN_EPS = 1e-5f, MOD_EPS = 1e-6f;
constexpr float C2 = 0.125f * 1.4426950408889634f;
constexpr float LOG2E = 1.4426950408889634f;
constexpr int NCHUNK = 1;
constexpr int NWAVES = 8, NTHR = 512, GRID = 256;

constexpr size_t MiB = 1u << 20;
constexpr size_t WS_CTL = 0, CTL_BYTES = 1 * MiB;
constexpr size_t WS_ROPEC = 1 * MiB, WS_ROPES = 1 * MiB + 4096, WS_CSN = 1 * MiB + 65536, WS_DLC = 1 * MiB + 524288, WS_DL = 2 * MiB;
constexpr size_t WS_WQKV = 10 * MiB, WS_WO = 16 * MiB, WS_WF = 20 * MiB, WS_WR = 28 * MiB, WS_WSH = 29 * MiB;
constexpr size_t WS_MODP = 36 * MiB, WS_MOD = 49 * MiB;
constexpr float QSC = 64.f;
constexpr float YSC = 16.f;
constexpr size_t WS_RSTAT = 36 * MiB;
constexpr size_t WS_EGU = 54 * MiB, WS_ED = 118 * MiB;
constexpr size_t WS_XS = 150 * MiB;
constexpr size_t WS_STOK = 294 * MiB, WS_SDST = 297 * MiB, WS_SW = 300 * MiB, WS_TKE = 303 * MiB, WS_TKW = 306 * MiB;
constexpr size_t WS_R = 309 * MiB;
constexpr size_t WS_Q = WS_R, WS_K = WS_R + 144 * MiB, WS_V = WS_R + 180 * MiB;
constexpr size_t WS_ABT = WS_R, WS_FH = WS_R + 256 * MiB, WS_FH1 = WS_R + 320 * MiB, WS_ABTC = WS_R + 321 * MiB, WS_FC = WS_R + 353 * MiB;
constexpr size_t WS_H = WS_R, WS_HS = WS_R + 160 * MiB, WS_YB = WS_R + 180 * MiB, WS_YS = WS_R + 788 * MiB;
constexpr size_t WS_END = WS_YS + 72 * MiB;
constexpr size_t OUT_U8 = 144 * MiB;
constexpr int WSCALE_E8M0 = 121;
constexpr int MAXROWS = 655360;

constexpr int CW_TMO = 0, CW_BAR = 4096, CW_BCNT = 16384;

constexpr int RING_BYTES = 131072;
constexpr int L_MISC = RING_BYTES;
constexpr int L_TSTART = RING_BYTES + 256;
constexpr int L_PREF = L_TSTART + 1040;
constexpr int L_LCNT = L_PREF + 256;
constexpr int L_TSEG = L_LCNT + 256;
constexpr int L_SCAN = L_TSEG + 2560;
constexpr int LDS_BYTES = 139264;
static_assert(L_SCAN + 1024 <= LDS_BYTES, "LDS map");

#define RLX_AGENT __ATOMIC_RELAXED, __HIP_MEMORY_SCOPE_AGENT
#define LDS_WAIT() asm volatile("s_waitcnt lgkmcnt(0)" ::: "memory")
#define VM_WAIT() asm volatile("s_waitcnt vmcnt(0)" ::: "memory")

__device__ __forceinline__ unsigned f2bf(float f) { unsigned u = __builtin_bit_cast(unsigned, f); return (u + 0x7fffu + ((u >> 16) & 1u)) >> 16; }
__device__ __forceinline__ unsigned pk2(float lo, float hi) { return f2bf(lo) | (f2bf(hi) << 16); }
typedef float f32x2_t __attribute__((ext_vector_type(2))); typedef __bf16 bf16x2_t __attribute__((ext_vector_type(2)));
__device__ __forceinline__ unsigned cvt_pk_bf16(float lo, float hi) { f32x2_t v = {lo, hi}; bf16x2_t b = __builtin_convertvector(v, bf16x2_t); return __builtin_bit_cast(unsigned, b); }
__device__ __forceinline__ float bflo(unsigned w) { return __builtin_bit_cast(float, w << 16); }
__device__ __forceinline__ float bfhi(unsigned w) { return __builtin_bit_cast(float, w & 0xffff0000u); }
__device__ __forceinline__ float wave_sum(float v) {
#pragma unroll
    for (int o = 1; o < 64; o <<= 1) v += __shfl_xor(v, o);
    return v;
}

__device__ __forceinline__ unsigned f2f8(float v) { return (unsigned)__builtin_amdgcn_cvt_pk_fp8_f32(v, 0.f, 0, false) & 0xffu; }
__device__ __forceinline__ float f82f(unsigned b) { return __builtin_amdgcn_cvt_pk_f32_fp8((int)(b & 0xffu), false)[0]; }
__device__ __forceinline__ int opaque_tid() { int t = threadIdx.x; asm volatile("" : "+v"(t)); return t; }

#define XB_TMO      128
#define XB_XCNT(j)  (256  + 64 * (j))
#define XB_XSUB(j)  (1280 + 64 * (j))
#define XB_XGEN(j)  (2304 + 64 * (j))
#define XB_TOP      3328
#define XB_TOPGEN   3392
#define XCD_BAR_WORDS 3456
#define XB_SPIN_CAP (1u << 22)
__device__ __forceinline__ unsigned xb_ld(unsigned* p)              { return __hip_atomic_load(p, __ATOMIC_RELAXED, __HIP_MEMORY_SCOPE_AGENT); }
__device__ __forceinline__ unsigned xb_add(unsigned* p, unsigned v) { return __hip_atomic_fetch_add(p, v, __ATOMIC_RELAXED, __HIP_MEMORY_SCOPE_AGENT); }
__device__ __forceinline__ unsigned xb_xcc_id() { return (unsigned)__builtin_amdgcn_s_getreg((3 << 11) | 20) & 0xFu; }
#define XB_SPIN(cond, bar) do { unsigned _sp = 0; while (cond) { __builtin_amdgcn_s_sleep(1); \
    if ((++_sp & 255u) == 0u) { if (xb_ld(&(bar)[XB_TMO])) break; if (_sp > XB_SPIN_CAP) { atomicAdd(&(bar)[XB_TMO], 1u); break; } } } } while (0)
struct XcdBarrier { unsigned* bar; unsigned x; volatile LAS unsigned* st; };
__device__ __forceinline__ XcdBarrier xcd_barrier_post(unsigned* bar, volatile LAS unsigned* st) {
    XcdBarrier b; b.bar = bar; b.x = xb_xcc_id(); b.st = st;
    if (threadIdx.x == 0) (void)xb_add(&bar[XB_XCNT(b.x)], 1u);
    return b;
}
__device__ __forceinline__ void xcd_barrier_complete(unsigned* bar, unsigned x, unsigned& nloc, unsigned& nx) {
    const unsigned G = gridDim.x * gridDim.y * gridDim.z;
    unsigned sum, cnt, mine, sp = 0u;
    for (;;) {
        sum = 0u; cnt = 0u; mine = 0u;
#pragma unroll
        for (unsigned j = 0; j < 16; ++j) { const unsigned c = xb_ld(&bar[XB_XCNT(j)]); sum += c; cnt += (c > 0u) ? 1u : 0u; mine = (j == x) ? c : mine; }
        if (sum == G) break;
        __builtin_amdgcn_s_sleep(1);
        if ((++sp & 255u) == 0u) { if (xb_ld(&bar[XB_TMO])) break; if (sp > XB_SPIN_CAP) { atomicAdd(&bar[XB_TMO], 1u); break; } }
    }
    nloc = mine > 0u ? mine : 1u; nx = cnt > 0u ? cnt : 1u;
}
__device__ __forceinline__ void xcd_barrier(const XcdBarrier& b) {
    asm volatile("s_waitcnt vmcnt(0)" ::: "memory");
    __syncthreads();
    if (threadIdx.x == 0) {
        unsigned* bar = b.bar; unsigned bx = b.x; asm volatile("" : "+s"(bx));
        __builtin_amdgcn_s_waitcnt(0);
        unsigned nloc = b.st[0], nx = b.st[1];
        if (nloc == 0u) { xcd_barrier_complete(bar, bx, nloc, nx); b.st[0] = nloc; b.st[1] = nx; }
        const unsigned old = xb_add(&bar[XB_XSUB(bx)], 1u);
        const unsigned gen = old / nloc;
        if (old + 1u == (gen + 1u) * nloc) {
            __builtin_amdgcn_fence(__ATOMIC_RELEASE, "agent");
            asm volatile("s_waitcnt vmcnt(0)" ::: "memory");
            const unsigned og = xb_add(&bar[XB_TOP], 1u);
            const unsigned tg = og / nx;
            if (og + 1u == (tg + 1u) * nx) xb_add(&bar[XB_TOPGEN], 1u);
            else XB_SPIN(xb_ld(&bar[XB_TOPGEN]) == tg, bar);
            __builtin_amdgcn_fence(__ATOMIC_ACQUIRE, "agent");
            xb_add(&bar[XB_XGEN(bx)], 1u);
            asm volatile("s_waitcnt vmcnt(0)" ::: "memory");
        } else {
            XB_SPIN(xb_ld(&bar[XB_XGEN(bx)]) == gen, bar);
            __builtin_amdgcn_fence(__ATOMIC_ACQUIRE, "agent");
            asm volatile("s_waitcnt vmcnt(0)" ::: "memory");
        }
    }
    __syncthreads();
}

typedef float f32x2v __attribute__((ext_vector_type(2)));
namespace pg {
constexpr int BM = 256, BK = 64, HALF = 128, HTB = HALF * BK * 2;
__host__ __device__ __forceinline__ int lds_byte(int r, int c) { const int st = (r >> 4) * 2 + (c >> 5), rr = r & 15, cc = c & 31, ob = rr * 64 + cc * 2; return st * 1024 + (ob ^ (((ob >> 9) & 1) << 5)); }
__host__ __device__ __forceinline__ void stage_rc(int b, int& R, int& C) { const int st = b / 1024, sb = b % 1024, swz = sb ^ (((sb >> 9) & 1) << 5); R = (st >> 1) * 16 + swz / 64; C = (st & 1) * 32 + (swz % 64) / 2; }
__host__ __device__ __forceinline__ int perm32(int rho) { const int n = rho >> 4, i = rho & 15; return 8 * (i >> 2) + 4 * n + (i & 3); }

struct Unit {
    const char* A;
    const char* B;
    const int* gidx;
    int gbase;
    int nt;
    char* out; int ldc; float scale; int flags; int i0; int i1;
};

template <class Epi, class Sched, bool GATHER, bool F8 = false, int WSC = WSCALE_E8M0>
__device__ __forceinline__ void gemm_phase(LAS unsigned char* lds, const unsigned lda, const unsigned ldb, const char* gtable, const Sched& S, const Epi& E) {
    const int tid = opaque_tid(), wid = __builtin_amdgcn_readfirstlane(tid >> 6), lane = tid & 63, wr = wid >> 2, wc = wid & 3, fr = lane & 15, fq = lane >> 4;
    unsigned voffA[2], voffB[2];
#pragma unroll
    for (int i = 0; i < 2; ++i) { int R, C; stage_rc(tid * 16 + i * 8192, R, C); const int Rb = (R & ~31) + perm32(R & 31);
        voffA[i] = (unsigned)R * lda + (unsigned)C * 2u; voffB[i] = (unsigned)Rb * ldb + (unsigned)C * 2u; }
    const size_t kstep = (size_t)(BK * 2);
    const size_t hstepA = (size_t)HALF * lda, hstepB = (size_t)HALF * ldb;
    const unsigned ldsw = (unsigned)wid * 1024u;
    const int aoff = lds_byte(wr * 64 + fr, fq * 8), boff = lds_byte(wc * 32 + fr, fq * 8);
#define PG_SA(b, h) (((b) * 2 + (h)) * HTB)
#define PG_SB(b, h) ((4 + (b) * 2 + (h)) * HTB)
#define PG_ST2(bufoff, p0, p1) do { \
        __builtin_amdgcn_global_load_lds((const unsigned*)(p0), (LAS unsigned*)(lds + (bufoff) + ldsw), 16, 0, 0); \
        __builtin_amdgcn_global_load_lds((const unsigned*)(p1), (LAS unsigned*)(lds + (bufoff) + ldsw + 8192), 16, 0, 0); } while (0)
#define PG_STB(bufoff, bp) PG_ST2(bufoff, (bp) + voffB[0], (bp) + voffB[1])
#define PG_STA(bufoff, ap, h, nx) do { if constexpr (GATHER) { PG_ST2(bufoff, (ap) + ((nx) ? nO[h][0] : cO[h][0]), (ap) + ((nx) ? nO[h][1] : cO[h][1])); } \
        else { PG_ST2(bufoff, (ap) + (h) * hstepA + voffA[0], (ap) + (h) * hstepA + voffA[1]); } } while (0)
#define PG_LD8(p) ({ const v4i_t lo_ = *(const LAS v4i_t*)(p), hi_ = *(const LAS v4i_t*)((p) + 1024); __builtin_shufflevector(lo_, hi_, 0, 1, 2, 3, 4, 5, 6, 7); })
#define PG_LDA(dst, b, h) do { if constexpr (F8) { _Pragma("unroll") for (int m = 0; m < 4; ++m) dst##8[m] = PG_LD8(lds + PG_SA(b, h) + aoff + m * 2048); } \
        else { _Pragma("unroll") for (int m = 0; m < 4; ++m) _Pragma("unroll") for (int k = 0; k < 2; ++k) dst[m][k] = *(const LAS bf16x8*)(lds + PG_SA(b, h) + aoff + m * 2048 + k * 1024); } } while (0)
#define PG_LDB(dst, b, h) do { if constexpr (F8) { _Pragma("unroll") for (int n = 0; n < 2; ++n) dst##8[n] = PG_LD8(lds + PG_SB(b, h) + boff + n * 2048); } \
        else { _Pragma("unroll") for (int n = 0; n < 2; ++n) _Pragma("unroll") for (int k = 0; k < 2; ++k) dst[n][k] = *(const LAS bf16x8*)(lds + PG_SB(b, h) + boff + n * 2048 + k * 1024); } } while (0)
#define PG_MMA(ai, bj, At, Bt) do { __builtin_amdgcn_s_setprio(1); _Pragma("unroll") for (int m = 0; m < 4; ++m) _Pragma("unroll") for (int n = 0; n < 2; ++n) { \
        if constexpr (F8) { asm volatile("v_mfma_scale_f32_16x16x128_f8f6f4 %0, %1, %2, %0, %3, %4 op_sel_hi:[0,0,0]" : "+v"(acc[ai][bj][m][n]) : "v"(Bt##8[n]), "v"(At##8[m]), "v"(sc_w), "v"(sc_x)); } \
        else { _Pragma("unroll") for (int k = 0; k < 2; ++k) acc[ai][bj][m][n] = __builtin_amdgcn_mfma_f32_16x16x32_bf16(Bt[n][k], At[m][k], acc[ai][bj][m][n], 0, 0, 0); } } \
        __builtin_amdgcn_s_setprio(0); } while (0)
#define PG_WAIT_V(n) asm volatile("s_waitcnt vmcnt(" #n ")" ::: "memory")
#define PG_WAIT_L(n) asm volatile("s_waitcnt lgkmcnt(" #n ")" ::: "memory")
#define PG_BAR __builtin_amdgcn_s_barrier()
#define PG_SCHED __builtin_amdgcn_sched_barrier(0)
#define PG_GOFF(dst, u) do { const int tz_ = opaque_tid(); _Pragma("unroll") for (int i = 0; i < 2; ++i) { int R_, C_; stage_rc(tz_ * 16 + i * 8192, R_, C_); \
        _Pragma("unroll") for (int h = 0; h < 2; ++h) { const int rr = h * HALF + R_; \
        const int ix = (u).gidx ? ((const GAS int*)(u).gidx)[rr] : (u).gbase + rr; dst[h][i] = (unsigned)ix * lda + (unsigned)C_ * 2u; } } } while (0)
#define PG_GIDX(dst, un) do { const int* gi_ = nullptr; int gb_ = 0; const bool ok_ = S.gsrc((un), gi_, gb_); const int tz_ = opaque_tid(); _Pragma("unroll") for (int i = 0; i < 2; ++i) { int R_, C_; stage_rc(tz_ * 16 + i * 8192, R_, C_); \
        _Pragma("unroll") for (int h = 0; h < 2; ++h) { const int rr = h * HALF + R_; dst[h][i] = (ok_ && gi_) ? ((const GAS int*)gi_)[rr] : gb_ + rr; } } } while (0)
#define PG_GCVT(dst, src) do { const int tz_ = opaque_tid(); _Pragma("unroll") for (int i = 0; i < 2; ++i) { int R_, C_; stage_rc(tz_ * 16 + i * 8192, R_, C_); \
        _Pragma("unroll") for (int h = 0; h < 2; ++h) dst[h][i] = (unsigned)src[h][i] * lda + (unsigned)C_ * 2u; } } while (0)
    Unit cur, nxt; int ui = 0;
    if (!S.next(0, cur)) return;
    f32x4 acc[2][2][4][2];
#pragma unroll
    for (int a = 0; a < 2; ++a)
#pragma unroll
        for (int b = 0; b < 2; ++b)
#pragma unroll
            for (int m = 0; m < 4; ++m)
#pragma unroll
                for (int n = 0; n < 2; ++n) acc[a][b][m][n] = (f32x4){0.f, 0.f, 0.f, 0.f};
    bf16x8 At[4][2], B0[2][2], B1[2][2]; v8i_t At8[4], B08[2], B18[2];
    const int sc_w = WSC * 0x01010101, sc_x = 0x7f7f7f7f;
    unsigned cO[2][2] = {{0u, 0u}, {0u, 0u}}, nO[2][2] = {{0u, 0u}, {0u, 0u}};
    if constexpr (GATHER) { PG_GOFF(cO, cur); }
    const char* cA = GATHER ? gtable : cur.A; const char* cB = cur.B;
    PG_STB(PG_SB(0, 0), cB); PG_STB(PG_SB(0, 1), cB + hstepB); PG_STA(PG_SA(0, 0), cA, 0, false); PG_STA(PG_SA(0, 1), cA, 1, false);
    if (wr == 1) PG_BAR;
    PG_WAIT_V(2); PG_BAR;
    PG_STB(PG_SB(1, 0), cB + kstep); PG_STA(PG_SA(1, 0), cA + kstep, 0, false); PG_STB(PG_SB(1, 1), cB + hstepB + kstep);
    PG_WAIT_V(6); PG_BAR;
    for (;;) {
        const bool has_next = S.next(ui + 1, nxt);
        const int nt = cur.nt;
        if constexpr (GATHER) { if (has_next) { PG_GOFF(nO, nxt); } else {
#pragma unroll
            for (int h = 0; h < 2; ++h)
#pragma unroll
                for (int i = 0; i < 2; ++i) nO[h][i] = cO[h][i]; } }
        const char* nA = GATHER ? gtable : (has_next ? nxt.A : cA); const char* nB = has_next ? nxt.B : cB;
#pragma unroll 1
        for (int t = 0; t < nt; t += 2) {
            const bool last = (t == nt - 2);
            const char* a1 = cA + (size_t)(t + 1) * kstep;
            const char* a2 = last ? nA : cA + (size_t)(t + 2) * kstep; const char* b2 = last ? nB : cB + (size_t)(t + 2) * kstep;
            const char* a3 = a2 + kstep; const char* b3 = b2 + kstep;
            const bool after_epi = (Epi::NSTORE > 0) && (t == 0) && (ui > 0);
            PG_LDB(B0, 0, 0); PG_LDB(B1, 0, 1); PG_SCHED; PG_LDA(At, 0, 0); PG_STA(PG_SA(1, 1), a1, 1, false);
            if (after_epi) { if constexpr (Epi::NSTORE == 8) PG_WAIT_V(16); else PG_WAIT_V(24); } else PG_WAIT_V(8);
            PG_WAIT_L(0); PG_BAR; PG_MMA(0, 0, At, B0); PG_MMA(0, 1, At, B1); PG_BAR; PG_SCHED;
            PG_LDA(At, 0, 1); PG_STB(PG_SB(0, 0), b2); PG_STB(PG_SB(0, 1), b2 + hstepB); PG_STA(PG_SA(0, 0), a2, 0, last);
            if (after_epi) { if constexpr (Epi::NSTORE == 8) PG_WAIT_V(16); else PG_WAIT_V(24); } else PG_WAIT_V(8);
            PG_WAIT_L(0); PG_BAR; PG_MMA(1, 0, At, B0); PG_MMA(1, 1, At, B1); PG_BAR; PG_SCHED;
            PG_LDB(B0, 1, 0); PG_LDB(B1, 1, 1); PG_SCHED; PG_LDA(At, 1, 0); PG_STA(PG_SA(0, 1), a2, 1, last);
            PG_WAIT_V(8); PG_WAIT_L(0); PG_BAR; PG_MMA(0, 0, At, B0); PG_MMA(0, 1, At, B1); PG_BAR; PG_SCHED;
            PG_LDA(At, 1, 1); PG_STB(PG_SB(1, 0), b3); PG_STB(PG_SB(1, 1), b3 + hstepB); PG_STA(PG_SA(1, 0), a3, 0, last);
            PG_WAIT_V(8); PG_WAIT_L(0); PG_BAR; PG_MMA(1, 0, At, B0); PG_MMA(1, 1, At, B1); PG_BAR; PG_SCHED;
        }
        if (wr == 0) PG_BAR;
        if constexpr (F8) asm volatile("s_nop 15\n\ts_nop 15" ::: "memory");
        E(acc, cur, wr, wc, fr, fq);
        if (!has_next) break;
#pragma unroll
        for (int a = 0; a < 2; ++a)
#pragma unroll
            for (int b = 0; b < 2; ++b)
#pragma unroll
                for (int m = 0; m < 4; ++m)
#pragma unroll
                    for (int n = 0; n < 2; ++n) acc[a][b][m][n] = (f32x4){0.f, 0.f, 0.f, 0.f};
        cur = nxt; cA = nA; cB = nB; ++ui;
        if constexpr (GATHER) {
#pragma unroll
            for (int h = 0; h < 2; ++h)
#pragma unroll
                for (int i = 0; i < 2; ++i) cO[h][i] = nO[h][i]; }
        if (wr == 1) PG_BAR;
    }
    PG_WAIT_V(0);
    PG_BAR;
#undef PG_SA
#undef PG_SB
#undef PG_ST2
#undef PG_STB
#undef PG_STA
#undef PG_LDA
#undef PG_LD8
#undef PG_LDB
#undef PG_MMA
#undef PG_WAIT_V
#undef PG_WAIT_L
#undef PG_BAR
#undef PG_SCHED
#undef PG_GOFF
#undef PG_GIDX
#undef PG_GCVT
}

struct EpiStore {
    static constexpr int NSTORE = 0;
    __device__ __forceinline__ void operator()(const f32x4 (&acc)[2][2][4][2], const Unit& u, int wr, int wc, int fr, int fq) const {
        asm volatile("" : "+v"(fr), "+v"(fq));
        const float s = u.scale;
#pragma unroll
        for (int ai = 0; ai < 2; ++ai)
#pragma unroll
            for (int m = 0; m < 4; ++m) { const int row = ai * HALF + wr * 64 + m * 16 + fr;
                char* rowp = u.out + (ptrdiff_t)row * u.ldc + (wc * 32 + 8 * fq) * 2;
                if (!((u.flags & 1) && row == 0)) {
#pragma unroll
                for (int bj = 0; bj < 2; ++bj) { const f32x4 v0 = acc[ai][bj][m][0] * s, v1 = acc[ai][bj][m][1] * s;
                    u32x4 w; w.x = cvt_pk_bf16(v0[0], v0[1]); w.y = cvt_pk_bf16(v0[2], v0[3]); w.z = cvt_pk_bf16(v1[0], v1[1]); w.w = cvt_pk_bf16(v1[2], v1[3]);
                    *(u32x4*)(rowp + bj * 256) = w; } } }
    }
};
struct EpiStore8 {
    static constexpr int NSTORE = 16;
    __device__ __forceinline__ void operator()(const f32x4 (&acc)[2][2][4][2], const Unit& u, int wr, int wc, int fr, int fq) const {
        asm volatile("" : "+v"(fr), "+v"(fq));
        const float s = u.scale;
#pragma unroll
        for (int ai = 0; ai < 2; ++ai)
#pragma unroll
            for (int m = 0; m < 4; ++m) { const int row = ai * HALF + wr * 64 + m * 16 + fr;
                char* rowp = u.out + (ptrdiff_t)row * u.ldc + (wc * 32 + 8 * fq);
#pragma unroll
                for (int bj = 0; bj < 2; ++bj) { const f32x4 v0 = acc[ai][bj][m][0] * s, v1 = acc[ai][bj][m][1] * s; int w0 = 0, w1 = 0;
                    w0 = __builtin_amdgcn_cvt_pk_fp8_f32(v0[0], v0[1], w0, false); w0 = __builtin_amdgcn_cvt_pk_fp8_f32(v0[2], v0[3], w0, true);
                    w1 = __builtin_amdgcn_cvt_pk_fp8_f32(v1[0], v1[1], w1, false); w1 = __builtin_amdgcn_cvt_pk_fp8_f32(v1[2], v1[3], w1, true);
                    u32x2 o; o.x = (unsigned)w0; o.y = (unsigned)w1; *(u32x2*)(rowp + bj * 128) = o; } }
    }
};
struct EpiQKV {
    static constexpr int NSTORE = 0;
    bf16_t* Q; bf16_t* K; bf16_t* V; const float* ropec; const float* ropes;
    __device__ __forceinline__ void operator()(const f32x4 (&acc)[2][2][4][2], const Unit& u, int wr, int wc, int fr, int fq) const {
        asm volatile("" : "+v"(fr), "+v"(fq));
        const int pm = u.i0, pn = u.i1; const bool lat = pm < (T / 256); const bool rope = lat && pn < 5;
        const float qs = pn < 4 ? C2 : 1.f;
        const int part = wc & 1;
        const int fi0 = 8 * (fq & 1);
        const float sgn = (fq < 2) ? -1.f : 1.f;
#pragma unroll
        for (int ai = 0; ai < 2; ++ai)
#pragma unroll
            for (int m = 0; m < 4; ++m) { const int row = ai * HALF + wr * 64 + m * 16 + fr; const int tok = pm * 256 + row;
                const int tl = tok & (SEQ - 1); const int pos = part ? (tl & 63) : (tl >> 6);
                f32x4 c0 = {1.f, 1.f, 1.f, 1.f}, c1 = c0, s0 = {0.f, 0.f, 0.f, 0.f}, s1 = s0;
                if (rope) { c0 = *(const f32x4*)(ropec + pos * 16 + fi0); c1 = *(const f32x4*)(ropec + pos * 16 + fi0 + 4); s0 = *(const f32x4*)(ropes + pos * 16 + fi0); s1 = *(const f32x4*)(ropes + pos * 16 + fi0 + 4); }
#pragma unroll
                for (int bj = 0; bj < 2; ++bj) { f32x4 v0 = acc[ai][bj][m][0], v1 = acc[ai][bj][m][1];
                    if (rope) { f32x4 p0, p1;
#pragma unroll
                        for (int j = 0; j < 4; ++j) { p0[j] = __shfl_xor(v0[j], 32); p1[j] = __shfl_xor(v1[j], 32); }
                        v0 = v0 * c0 + (p0 * sgn) * s0; v1 = v1 * c1 + (p1 * sgn) * s1; }
                    v0 = v0 * qs; v1 = v1 * qs;
                    const int col = bj * HALF + wc * 32 + 8 * fq;
                    if (pn < 4) {
#pragma unroll
                        for (int j = 0; j < 4; ++j) { v0[j] = __builtin_amdgcn_fmed3f(v0[j] * QSC, -448.f, 448.f); v1[j] = __builtin_amdgcn_fmed3f(v1[j] * QSC, -448.f, 448.f); }
                        int w0 = 0, w1 = 0;
                        w0 = __builtin_amdgcn_cvt_pk_fp8_f32(v0[0], v0[1], w0, false); w0 = __builtin_amdgcn_cvt_pk_fp8_f32(v0[2], v0[3], w0, true);
                        w1 = __builtin_amdgcn_cvt_pk_fp8_f32(v1[0], v1[1], w1, false); w1 = __builtin_amdgcn_cvt_pk_fp8_f32(v1[2], v1[3], w1, true);
                        u32x2 o; o.x = (unsigned)w0; o.y = (unsigned)w1; *(GAS u32x2*)((unsigned char*)Q + (size_t)tok * 1024 + pn * 256 + col) = o; }
                    else { u32x4 w; w.x = cvt_pk_bf16(v0[0], v0[1]); w.y = cvt_pk_bf16(v0[2], v0[3]); w.z = cvt_pk_bf16(v1[0], v1[1]); w.w = cvt_pk_bf16(v1[2], v1[3]);
                        bf16_t* dst = pn == 4 ? K + (size_t)tok * 256 + col : V + (size_t)tok * 256 + col;
                        *(GAS u32x4*)dst = w; } } }
    }
};
struct EpiSilu {
    static constexpr int NSTORE = 8;
    __device__ __forceinline__ void operator()(const f32x4 (&acc)[2][2][4][2], const Unit& u, int wr, int wc, int fr, int fq) const {
        asm volatile("" : "+v"(fr), "+v"(fq));
#pragma unroll
        for (int ai = 0; ai < 2; ++ai)
#pragma unroll
            for (int m = 0; m < 4; ++m) { const int row = ai * HALF + wr * 64 + m * 16 + fr;
                float h[8];
#pragma unroll
                for (int n = 0; n < 2; ++n)
#pragma unroll
                    for (int j = 0; j < 4; j += 2) {
                        const f32x2v g = {acc[ai][0][m][n][j], acc[ai][0][m][n][j + 1]}, up = {acc[ai][1][m][n][j], acc[ai][1][m][n][j + 1]};
                        const f32x2v t = g * (f32x2v){-1.4426950408889634f, -1.4426950408889634f}, p = g * up;
                        f32x2v e = {__builtin_amdgcn_exp2f(t[0]), __builtin_amdgcn_exp2f(t[1])};
                        e = e + (f32x2v){1.f, 1.f};
                        const f32x2v r = {__builtin_amdgcn_rcpf(e[0]), __builtin_amdgcn_rcpf(e[1])};
                        const f32x2v o2 = p * r; h[n * 4 + j] = o2[0]; h[n * 4 + j + 1] = o2[1]; }
                int w0 = 0, w1 = 0;
                w0 = __builtin_amdgcn_cvt_pk_fp8_f32(h[0], h[1], w0, false); w0 = __builtin_amdgcn_cvt_pk_fp8_f32(h[2], h[3], w0, true);
                w1 = __builtin_amdgcn_cvt_pk_fp8_f32(h[4], h[5], w1, false); w1 = __builtin_amdgcn_cvt_pk_fp8_f32(h[6], h[7], w1, true);
                u32x2 o; o.x = (unsigned)w0; o.y = (unsigned)w1;
                *(u32x2*)(u.out + (size_t)row * 256 + (wc * 32 + 8 * fq)) = o; }
    }
};
struct EpiFp8 {
    static constexpr int NSTORE = 8;
    __device__ __forceinline__ void operator()(const f32x4 (&acc)[2][2][4][2], const Unit& u, int wr, int wc, int fr, int fq) const {
        asm volatile("" : "+v"(fr), "+v"(fq));
        const int pn = u.i1;
#pragma unroll
        for (int ai = 0; ai < 2; ++ai)
#pragma unroll
            for (int m = 0; m < 4; ++m) { const int row = ai * HALF + wr * 64 + m * 16 + fr;
                u32x4 o;
#pragma unroll
                for (int bj = 0; bj < 2; ++bj) { const f32x4 v0 = acc[ai][bj][m][0] * 16.f, v1 = acc[ai][bj][m][1] * 16.f;
                    int w0 = 0, w1 = 0;
                    w0 = __builtin_amdgcn_cvt_pk_fp8_f32(v0[0], v0[1], w0, false); w0 = __builtin_amdgcn_cvt_pk_fp8_f32(v0[2], v0[3], w0, true);
                    w1 = __builtin_amdgcn_cvt_pk_fp8_f32(v1[0], v1[1], w1, false); w1 = __builtin_amdgcn_cvt_pk_fp8_f32(v1[2], v1[3], w1, true);
                    o[2 * bj] = (unsigned)w0; o[2 * bj + 1] = (unsigned)w1; }
                *(u32x4*)(u.out + (size_t)row * 1024 + (16 * pn + 4 * wc + fq) * 16) = o; }
    }
};
struct EpiY8 {
    static constexpr int NSTORE = 0;
    __device__ __forceinline__ void operator()(const f32x4 (&acc)[2][2][4][2], const Unit& u, int wr, int wc, int fr, int fq) const {
        asm volatile("" : "+v"(fr), "+v"(fq));
        const int pn = u.i1; const float s = u.scale * YSC;
#pragma unroll
        for (int ai = 0; ai < 2; ++ai)
#pragma unroll
            for (int m = 0; m < 4; ++m) { const int row = ai * HALF + wr * 64 + m * 16 + fr;
                u32x4 o;
#pragma unroll
                for (int bj = 0; bj < 2; ++bj) { f32x4 v0 = acc[ai][bj][m][0] * s, v1 = acc[ai][bj][m][1] * s;
#pragma unroll
                    for (int j = 0; j < 4; ++j) { v0[j] = __builtin_amdgcn_fmed3f(v0[j], -448.f, 448.f); v1[j] = __builtin_amdgcn_fmed3f(v1[j], -448.f, 448.f); }
                    int w0 = 0, w1 = 0;
                    w0 = __builtin_amdgcn_cvt_pk_fp8_f32(v0[0], v0[1], w0, false); w0 = __builtin_amdgcn_cvt_pk_fp8_f32(v0[2], v0[3], w0, true);
                    w1 = __builtin_amdgcn_cvt_pk_fp8_f32(v1[0], v1[1], w1, false); w1 = __builtin_amdgcn_cvt_pk_fp8_f32(v1[2], v1[3], w1, true);
                    o[2 * bj] = (unsigned)w0; o[2 * bj + 1] = (unsigned)w1; }
                if (!((u.flags & 1) && row == 0)) *(GAS u32x4*)(u.out + (ptrdiff_t)row * u.ldc + (16 * pn + 4 * wc + fq) * 16) = o; }
    }
};
__device__ __forceinline__ int xcd_remap(int L0, int NU) { const int q = NU >> 3, r = NU & 7, x = L0 & 7, off = L0 >> 3; return (x < r ? x * (q + 1) : r * (q + 1) + (x - r) * q) + off; }
}

namespace attn {
constexpr int SLOTB = 8192;
constexpr int LDS_K = 0, LDS_V = 2 * SLOTB, LDS_WS = 4 * SLOTB, LDS_OST = LDS_WS + NWAVES * 256, LDS_END = LDS_OST + NWAVES * 4096;
static_assert(LDS_END <= RING_BYTES, "attention LDS");
__device__ __forceinline__ int crow(int r, int hi) { return (r & 3) + 8 * (r >> 2) + 4 * hi; }
__device__ __forceinline__ void glds16(const void* gsrc, unsigned lds_dst) { unsigned keep;
    asm volatile("s_mov_b32 %0, m0\n\ts_mov_b32 m0, %2\n\ts_nop 0\n\tglobal_load_lds_dwordx4 %1, off\n\ts_mov_b32 m0, %0" : "=&s"(keep) : "v"(gsrc), "s"(lds_dst) : "memory"); }
__device__ __forceinline__ float rowmax(const f32x16& p0, const f32x16& p1) {
    float a = fmaxf(p0[0], p1[0]);
#pragma unroll
    for (int r = 1; r < 16; ++r) a = fmaxf(a, fmaxf(p0[r], p1[r]));
    auto rr = __builtin_amdgcn_permlane32_swap(__float_as_uint(a), __float_as_uint(a), false, false);
    return fmaxf(__uint_as_float(rr[0]), __uint_as_float(rr[1]));
}
typedef short v4i16_t __attribute__((ext_vector_type(4)));
__device__ __forceinline__ s16x4 vtr(const LAS unsigned char* p) { return __builtin_bit_cast(s16x4, __builtin_amdgcn_ds_read_tr16_b64_v4i16((LAS v4i16_t*)p)); }
__device__ __forceinline__ void pv(f32x16* o, const LAS unsigned char* vp, bf16x8 pa0, bf16x8 pa1, bf16x8 pa2, bf16x8 pa3) {
#pragma unroll
    for (int d0 = 0; d0 < 2; ++d0) { s16x4 lo[4], hi[4];
#pragma unroll
        for (int ks = 0; ks < 4; ++ks) { lo[ks] = vtr(vp + d0 * 4096 + ks * 1024); hi[ks] = vtr(vp + d0 * 4096 + ks * 1024 + 512); }
#define PK(k) (bf16x8){lo[k][0], lo[k][1], lo[k][2], lo[k][3], hi[k][0], hi[k][1], hi[k][2], hi[k][3]}
        o[d0] = __builtin_amdgcn_mfma_f32_32x32x16_bf16(pa0, PK(0), o[d0], 0, 0, 0);
        o[d0] = __builtin_amdgcn_mfma_f32_32x32x16_bf16(pa1, PK(1), o[d0], 0, 0, 0);
        o[d0] = __builtin_amdgcn_mfma_f32_32x32x16_bf16(pa2, PK(2), o[d0], 0, 0, 0);
        o[d0] = __builtin_amdgcn_mfma_f32_32x32x16_bf16(pa3, PK(3), o[d0], 0, 0, 0);
#undef PK
    }
}
__device__ __forceinline__ void attn_unit(const bf16_t* Q, const bf16_t* K, const bf16_t* V, bf16_t* O, int b, int h, int q0, bool isctx, float sink2, LAS unsigned char* shm) {
    const int tid = opaque_tid(), lane = tid & 63, r32 = lane & 31, hi = lane >> 5; const int wid = __builtin_amdgcn_readfirstlane(tid >> 6);
    const int kvh = h >> 2;
    const long qrow = isctx ? (long)T + b * CTXL + wid * 32 : (long)b * SEQ + q0 + wid * 32;
    const unsigned lds0 = (unsigned)(uintptr_t)shm;
    LAS float* wsf = (LAS float*)(shm + LDS_WS) + wid * 64;
    int jlo = 0, nl = 0;
    if (!isctx) { jlo = (q0 == 0) ? 2 : 0; int jhi = (SEQ - q0 + 128) / 64; if (jhi > 8) jhi = 8; nl = jhi - jlo; }
    const int NT = nl + 4;
    const long lat0 = (long)b * SEQ + q0 - 128 + 64 * jlo, ctx0 = (long)T + b * CTXL;
#define TROW(t) ((t) < nl ? lat0 + 64 * (t) : ctx0 + 64 * ((t) - nl))
    const int kcol = kvh * 64 + wid * 8, vcol = kvh * 64 + (wid >> 2) * 32 + (lane & 3) * 8, vrow = 16 * (wid & 3) + (lane >> 2);
    const unsigned kdst = lds0 + LDS_K + wid * 1024, vdst = lds0 + LDS_V + wid * 1024;
#define DMA_KV(t, slot) do { const long tr_ = TROW(t); glds16(K + (tr_ + lane) * 256 + kcol, (unsigned)__builtin_amdgcn_readfirstlane(kdst + (slot) * SLOTB)); \
        glds16(V + (tr_ + vrow) * 256 + vcol, (unsigned)__builtin_amdgcn_readfirstlane(vdst + (slot) * SLOTB)); } while (0)
    DMA_KV(0, 0);
    bf16x8 qr[4];
#pragma unroll
    for (int d0 = 0; d0 < 4; ++d0) { const u32x2 w = *(const GAS u32x2*)((const unsigned char*)Q + (qrow + r32) * 1024 + h * 64 + d0 * 16 + hi * 8);
        const f32x2v a0 = __builtin_amdgcn_cvt_pk_f32_fp8((int)w.x, false), a1 = __builtin_amdgcn_cvt_pk_f32_fp8((int)w.x, true), a2 = __builtin_amdgcn_cvt_pk_f32_fp8((int)w.y, false), a3 = __builtin_amdgcn_cvt_pk_f32_fp8((int)w.y, true);
        u32x4 qw; qw.x = cvt_pk_bf16(a0[0] * (1.f / QSC), a0[1] * (1.f / QSC)); qw.y = cvt_pk_bf16(a1[0] * (1.f / QSC), a1[1] * (1.f / QSC)); qw.z = cvt_pk_bf16(a2[0] * (1.f / QSC), a2[1] * (1.f / QSC)); qw.w = cvt_pk_bf16(a3[0] * (1.f / QSC), a3[1] * (1.f / QSC));
        qr[d0] = __builtin_bit_cast(bf16x8, qw); }
    float mrun = sink2, l_reg = (hi == 0) ? 1.f : 0.f;
    f32x16 negm;
#pragma unroll
    for (int r = 0; r < 16; ++r) negm[r] = -sink2;
    f32x16 o[2];
#pragma unroll
    for (int r = 0; r < 16; ++r) { o[0][r] = 0.f; o[1][r] = 0.f; }
    const LAS unsigned char* vp0 = shm + LDS_V + ((lane >> 4) & 1) * 32 + (lane & 3) * 8 + (4 * hi + ((lane & 15) >> 2)) * 64;
    const int qw = q0 + wid * 32;
    asm volatile("s_waitcnt vmcnt(0) lgkmcnt(0)\n\ts_barrier" ::: "memory");
    for (int t = 0; t < NT; ++t) {
        const int slot = t & 1;
        if (t + 1 < NT) DMA_KV(t + 1, slot ^ 1);
        const bool latt = t < nl;
        const int ks = q0 - 128 + 64 * (jlo + t);
        bool need = true;
        if (latt) need = (ks + 63 >= qw - 128) && (ks <= qw + 31 + 128);
        if (need) {
            f32x16 p0, p1;
            const LAS unsigned char* kb = shm + LDS_K + slot * SLOTB + hi * 1024 + r32 * 16;
#pragma unroll
            for (int d0 = 0; d0 < 4; ++d0) {
                const bf16x8 b0 = *(const LAS bf16x8*)(kb + d0 * 2048), b1 = *(const LAS bf16x8*)(kb + d0 * 2048 + 512);
                if (d0 == 0) { p0 = __builtin_amdgcn_mfma_f32_32x32x16_bf16(b0, qr[0], negm, 0, 0, 0); p1 = __builtin_amdgcn_mfma_f32_32x32x16_bf16(b1, qr[0], negm, 0, 0, 0); }
                else { p0 = __builtin_amdgcn_mfma_f32_32x32x16_bf16(b0, qr[d0], p0, 0, 0, 0); p1 = __builtin_amdgcn_mfma_f32_32x32x16_bf16(b1, qr[d0], p1, 0, 0, 0); } }
            if (latt && !(ks >= qw - 97 && ks <= qw + 65)) {
                const int dq = qw + r32 - ks;
#pragma unroll
                for (int r = 0; r < 16; ++r) { const int d = dq - crow(r, hi); if (d > 128 || d < -128) p0[r] = -INFINITY; if (d - 32 > 128 || d - 32 < -128) p1[r] = -INFINITY; } }
            const float rm = rowmax(p0, p1);
            if (__any(rm > 8.f)) {
                const float delta = fmaxf(rm, 0.f);
                const float alpha = __builtin_amdgcn_exp2f(-delta); l_reg *= alpha; mrun += delta;
#pragma unroll
                for (int r = 0; r < 16; ++r) { p0[r] -= delta; p1[r] -= delta; negm[r] = -mrun; }
                if (hi == 0) wsf[r32] = alpha;
                asm volatile("s_waitcnt lgkmcnt(0)" ::: "memory");
#pragma unroll
                for (int r = 0; r < 16; ++r) { const float f = wsf[crow(r, hi)]; o[0][r] *= f; o[1][r] *= f; }
            }
            float sacc = 0.f;
#pragma unroll
            for (int r = 0; r < 16; ++r) { p0[r] = __builtin_amdgcn_exp2f(p0[r]); p1[r] = __builtin_amdgcn_exp2f(p1[r]); sacc += p0[r] + p1[r]; }
            l_reg += sacc;
            u32x4 pw0, pw1, pw2, pw3;
#define PKW(P, B) cvt_pk_bf16(P[B], P[B + 1])
            pw0 = (u32x4){PKW(p0, 0), PKW(p0, 2), PKW(p0, 4), PKW(p0, 6)}; pw1 = (u32x4){PKW(p0, 8), PKW(p0, 10), PKW(p0, 12), PKW(p0, 14)};
            pw2 = (u32x4){PKW(p1, 0), PKW(p1, 2), PKW(p1, 4), PKW(p1, 6)}; pw3 = (u32x4){PKW(p1, 8), PKW(p1, 10), PKW(p1, 12), PKW(p1, 14)};
#undef PKW
            __builtin_amdgcn_sched_barrier(0);
            pv(o, vp0 + slot * SLOTB, __builtin_bit_cast(bf16x8, pw0), __builtin_bit_cast(bf16x8, pw1), __builtin_bit_cast(bf16x8, pw2), __builtin_bit_cast(bf16x8, pw3));
        }
        asm volatile("s_waitcnt vmcnt(0) lgkmcnt(0)\n\ts_barrier" ::: "memory");
    }
    { auto rr = __builtin_amdgcn_permlane32_swap(__float_as_uint(l_reg), __float_as_uint(l_reg), false, false); l_reg = __uint_as_float(rr[0]) + __uint_as_float(rr[1]); }
    if (hi == 0) wsf[32 + r32] = l_reg;
    asm volatile("s_waitcnt lgkmcnt(0)" ::: "memory");
    float rli[16];
#pragma unroll
    for (int r = 0; r < 16; ++r) rli[r] = __builtin_amdgcn_rcpf(wsf[32 + crow(r, hi)]);
    unsigned char* Ow = (unsigned char*)O + qrow * 1024 + h * 64;
    { LAS unsigned char* stg = shm + LDS_OST + wid * 2048;
#pragma unroll
      for (int r = 0; r < 16; ++r) { const int orow = crow(r, hi);
#pragma unroll
          for (int d0 = 0; d0 < 2; ++d0) stg[orow * 64 + d0 * 32 + r32] = (unsigned char)f2f8(o[d0][r] * rli[r]); }
      asm volatile("s_waitcnt lgkmcnt(0)" ::: "memory");
#pragma unroll
      for (int i = 0; i < 2; ++i) { const int row = i * 16 + (lane >> 2), ch = lane & 3; const u32x4 v = *(const LAS u32x4*)(stg + row * 64 + ch * 16); *(GAS u32x4*)(Ow + (long)row * 1024 + ch * 16) = v; } }
    asm volatile("s_waitcnt lgkmcnt(0)" ::: "memory");
#undef TROW
#undef DMA_KV
}
__device__ __forceinline__ void attn_unit2(const bf16_t* Q, const bf16_t* K, const bf16_t* V, bf16_t* O, int b, int h0, int q0, bool isctx, float sinkA, float sinkB, LAS unsigned char* shm) {
    const int tid = opaque_tid(), lane = tid & 63, r32 = lane & 31, hi = lane >> 5; const int wid = __builtin_amdgcn_readfirstlane(tid >> 6);
    const int kvh = h0 >> 2;
    const long qrow = isctx ? (long)T + b * CTXL + wid * 32 : (long)b * SEQ + q0 + wid * 32;
    const unsigned lds0 = (unsigned)(uintptr_t)shm;
    LAS float* wsf = (LAS float*)(shm + LDS_WS) + wid * 64;
    int jlo = 0, nl = 0;
    if (!isctx) { jlo = (q0 == 0) ? 2 : 0; int jhi = (SEQ - q0 + 128) / 64; if (jhi > 8) jhi = 8; nl = jhi - jlo; }
    const int NT = nl + 4;
    const long lat0 = (long)b * SEQ + q0 - 128 + 64 * jlo, ctx0 = (long)T + b * CTXL;
#define TROW(t) ((t) < nl ? lat0 + 64 * (t) : ctx0 + 64 * ((t) - nl))
    const int kcol = kvh * 64 + wid * 8, vcol = kvh * 64 + (wid >> 2) * 32 + (lane & 3) * 8, vrow = 16 * (wid & 3) + (lane >> 2);
    const unsigned kdst = lds0 + LDS_K + wid * 1024, vdst = lds0 + LDS_V + wid * 1024;
#define DMA_KV(t, slot) do { const long tr_ = TROW(t); glds16(K + (tr_ + lane) * 256 + kcol, (unsigned)__builtin_amdgcn_readfirstlane(kdst + (slot) * SLOTB)); \
        glds16(V + (tr_ + vrow) * 256 + vcol, (unsigned)__builtin_amdgcn_readfirstlane(vdst + (slot) * SLOTB)); } while (0)
    DMA_KV(0, 0);
    bf16x8 qr[2][4];
#pragma unroll
    for (int hh = 0; hh < 2; ++hh)
#pragma unroll
        for (int d0 = 0; d0 < 4; ++d0) { const u32x2 w = *(const GAS u32x2*)((const unsigned char*)Q + (qrow + r32) * 1024 + (h0 + hh) * 64 + d0 * 16 + hi * 8);
            const f32x2v a0 = __builtin_amdgcn_cvt_pk_f32_fp8((int)w.x, false), a1 = __builtin_amdgcn_cvt_pk_f32_fp8((int)w.x, true), a2 = __builtin_amdgcn_cvt_pk_f32_fp8((int)w.y, false), a3 = __builtin_amdgcn_cvt_pk_f32_fp8((int)w.y, true);
            u32x4 qw; qw.x = cvt_pk_bf16(a0[0] * (1.f / QSC), a0[1] * (1.f / QSC)); qw.y = cvt_pk_bf16(a1[0] * (1.f / QSC), a1[1] * (1.f / QSC)); qw.z = cvt_pk_bf16(a2[0] * (1.f / QSC), a2[1] * (1.f / QSC)); qw.w = cvt_pk_bf16(a3[0] * (1.f / QSC), a3[1] * (1.f / QSC));
            qr[hh][d0] = __builtin_bit_cast(bf16x8, qw); }
    float mrun[2] = {sinkA, sinkB}, l_reg[2] = {(hi == 0) ? 1.f : 0.f, (hi == 0) ? 1.f : 0.f};
    f32x16 o[2][2];
#pragma unroll
    for (int hh = 0; hh < 2; ++hh)
#pragma unroll
        for (int r = 0; r < 16; ++r) { o[hh][0][r] = 0.f; o[hh][1][r] = 0.f; }
    const LAS unsigned char* vp0 = shm + LDS_V + ((lane >> 4) & 1) * 32 + (lane & 3) * 8 + (4 * hi + ((lane & 15) >> 2)) * 64;
    const int qw = q0 + wid * 32;
    asm volatile("s_waitcnt vmcnt(0) lgkmcnt(0)\n\ts_barrier" ::: "memory");
    for (int t = 0; t < NT; ++t) {
        const int slot = t & 1;
        if (t + 1 < NT) DMA_KV(t + 1, slot ^ 1);
        const bool latt = t < nl;
        const int ks = q0 - 128 + 64 * (jlo + t);
        bool need = true;
        if (latt) need = (ks + 63 >= qw - 128) && (ks <= qw + 31 + 128);
        if (need) {
            f32x16 p[2][2];
            { f32x16 nm0, nm1;
#pragma unroll
              for (int r = 0; r < 16; ++r) { nm0[r] = -mrun[0]; nm1[r] = -mrun[1]; }
              const LAS unsigned char* kb = shm + LDS_K + slot * SLOTB + hi * 1024 + r32 * 16;
#pragma unroll
              for (int d0 = 0; d0 < 4; ++d0) {
                const bf16x8 b0 = *(const LAS bf16x8*)(kb + d0 * 2048), b1 = *(const LAS bf16x8*)(kb + d0 * 2048 + 512);
                if (d0 == 0) { p[0][0] = __builtin_amdgcn_mfma_f32_32x32x16_bf16(b0, qr[0][0], nm0, 0, 0, 0); p[0][1] = __builtin_amdgcn_mfma_f32_32x32x16_bf16(b1, qr[0][0], nm0, 0, 0, 0);
                               p[1][0] = __builtin_amdgcn_mfma_f32_32x32x16_bf16(b0, qr[1][0], nm1, 0, 0, 0); p[1][1] = __builtin_amdgcn_mfma_f32_32x32x16_bf16(b1, qr[1][0], nm1, 0, 0, 0); }
                else {
#pragma unroll
                    for (int hh = 0; hh < 2; ++hh) { p[hh][0] = __builtin_amdgcn_mfma_f32_32x32x16_bf16(b0, qr[hh][d0], p[hh][0], 0, 0, 0); p[hh][1] = __builtin_amdgcn_mfma_f32_32x32x16_bf16(b1, qr[hh][d0], p[hh][1], 0, 0, 0); } } } }
            if (latt && !(ks >= qw - 97 && ks <= qw + 65)) {
                const int dq = qw + r32 - ks;
#pragma unroll
                for (int r = 0; r < 16; ++r) { const int d = dq - crow(r, hi);
                    if (d > 128 || d < -128) { p[0][0][r] = -INFINITY; p[1][0][r] = -INFINITY; }
                    if (d - 32 > 128 || d - 32 < -128) { p[0][1][r] = -INFINITY; p[1][1][r] = -INFINITY; } } }
            u32x4 pw[2][4];
#pragma unroll
            for (int hh = 0; hh < 2; ++hh) {
                bool big = false;
#pragma unroll
                for (int r = 0; r < 16; ++r) big = big | (__builtin_bit_cast(int, p[hh][0][r]) > 0x41000000) | (__builtin_bit_cast(int, p[hh][1][r]) > 0x41000000);
                if (__any(big)) {
                    const float rm = rowmax(p[hh][0], p[hh][1]);
                    const float delta = fmaxf(rm, 0.f);
                    const float alpha = __builtin_amdgcn_exp2f(-delta); l_reg[hh] *= alpha; mrun[hh] += delta;
#pragma unroll
                    for (int r = 0; r < 16; ++r) { p[hh][0][r] -= delta; p[hh][1][r] -= delta; }
                    if (hi == 0) wsf[r32] = alpha;
                    asm volatile("s_waitcnt lgkmcnt(0)" ::: "memory");
#pragma unroll
                    for (int r = 0; r < 16; ++r) { const float f = wsf[crow(r, hi)]; o[hh][0][r] *= f; o[hh][1][r] *= f; }
                    asm volatile("s_waitcnt lgkmcnt(0)" ::: "memory");
                }
                float sacc = 0.f;
#pragma unroll
                for (int r = 0; r < 16; ++r) { p[hh][0][r] = __builtin_amdgcn_exp2f(p[hh][0][r]); p[hh][1][r] = __builtin_amdgcn_exp2f(p[hh][1][r]); sacc += p[hh][0][r] + p[hh][1][r]; }
                l_reg[hh] += sacc;
#define PKW(P, B) cvt_pk_bf16(P[B], P[B + 1])
                pw[hh][0] = (u32x4){PKW(p[hh][0], 0), PKW(p[hh][0], 2), PKW(p[hh][0], 4), PKW(p[hh][0], 6)}; pw[hh][1] = (u32x4){PKW(p[hh][0], 8), PKW(p[hh][0], 10), PKW(p[hh][0], 12), PKW(p[hh][0], 14)};
                pw[hh][2] = (u32x4){PKW(p[hh][1], 0), PKW(p[hh][1], 2), PKW(p[hh][1], 4), PKW(p[hh][1], 6)}; pw[hh][3] = (u32x4){PKW(p[hh][1], 8), PKW(p[hh][1], 10), PKW(p[hh][1], 12), PKW(p[hh][1], 14)};
#undef PKW
            }
            __builtin_amdgcn_sched_barrier(0);
            { const LAS unsigned char* vp = vp0 + slot * SLOTB;
#pragma unroll
              for (int d0 = 0; d0 < 2; ++d0) { s16x4 lo[4], hh4[4];
#pragma unroll
                for (int k4 = 0; k4 < 4; ++k4) { lo[k4] = vtr(vp + d0 * 4096 + k4 * 1024); hh4[k4] = vtr(vp + d0 * 4096 + k4 * 1024 + 512); }
#pragma unroll
                for (int hh = 0; hh < 2; ++hh)
#pragma unroll
                    for (int k4 = 0; k4 < 4; ++k4) { const bf16x8 vb8 = (bf16x8){lo[k4][0], lo[k4][1], lo[k4][2], lo[k4][3], hh4[k4][0], hh4[k4][1], hh4[k4][2], hh4[k4][3]};
                        o[hh][d0] = __builtin_amdgcn_mfma_f32_32x32x16_bf16(__builtin_bit_cast(bf16x8, pw[hh][k4]), vb8, o[hh][d0], 0, 0, 0); } } }
        }
        asm volatile("s_waitcnt vmcnt(0) lgkmcnt(0)\n\ts_barrier" ::: "memory");
    }
#pragma unroll
    for (int hh = 0; hh < 2; ++hh) {
        float lr = l_reg[hh];
        { auto rr = __builtin_amdgcn_permlane32_swap(__float_as_uint(lr), __float_as_uint(lr), false, false); lr = __uint_as_float(rr[0]) + __uint_as_float(rr[1]); }
        if (hi == 0) wsf[32 + r32] = lr;
        asm volatile("s_waitcnt lgkmcnt(0)" ::: "memory");
        float rli[16];
#pragma unroll
        for (int r = 0; r < 16; ++r) rli[r] = __builtin_amdgcn_rcpf(wsf[32 + crow(r, hi)]);
        asm volatile("s_waitcnt lgkmcnt(0)" ::: "memory");
        unsigned char* Ow = (unsigned char*)O + qrow * 1024 + (h0 + hh) * 64;
        LAS unsigned char* stg = shm + LDS_OST + wid * 4096 + hh * 2048;
#pragma unroll
        for (int r = 0; r < 16; ++r) { const int orow = crow(r, hi);
#pragma unroll
            for (int d0 = 0; d0 < 2; ++d0) stg[orow * 64 + d0 * 32 + r32] = (unsigned char)f2f8(o[hh][d0][r] * rli[r]); }
        asm volatile("s_waitcnt lgkmcnt(0)" ::: "memory");
#pragma unroll
        for (int i = 0; i < 2; ++i) { const int row = i * 16 + (lane >> 2), ch = lane & 3; const u32x4 v = *(const LAS u32x4*)(stg + row * 64 + ch * 16); *(GAS u32x4*)(Ow + (long)row * 1024 + ch * 16) = v; }
    }
    asm volatile("s_waitcnt lgkmcnt(0)" ::: "memory");
#undef TROW
#undef DMA_KV
}
}

struct Args {
    const float* in[20];
    float* out; unsigned char* ws;
};
struct Frame {
    LAS unsigned char* lds; unsigned* ctl; unsigned char* ws;
    int tid, lane, wave, gw;
    int blk;
    __device__ __forceinline__ void refresh() { tid = opaque_tid(); lane = tid & 63; wave = __builtin_amdgcn_readfirstlane(tid >> 6); gw = blk * 8 + wave;
        asm volatile("" : "+s"(ws)); ctl = (unsigned*)(ws + WS_CTL); }
};
constexpr int NGW = GRID * NWAVES;

struct Row { f32x4 v[4]; };
__device__ __forceinline__ int vq(int q, int lane) { return 64 * (lane >> 4) + 2 * (lane & 15) + 32 * (q >> 1) + (q & 1); }
__device__ __forceinline__ int vb(int j, int lane) { return 32 * (lane >> 4) + (lane & 15) + 16 * j; }
__device__ __forceinline__ void row_load_bf16(Row& r, const bf16_t* p, int lane) {
#pragma unroll
    for (int j = 0; j < 2; ++j) { const u32x4 w = ((const GAS u32x4*)p)[vb(j, lane)]; r.v[2 * j] = (f32x4){bflo(w.x), bfhi(w.x), bflo(w.y), bfhi(w.y)}; r.v[2 * j + 1] = (f32x4){bflo(w.z), bfhi(w.z), bflo(w.w), bfhi(w.w)}; } }
__device__ __forceinline__ void row_store_bf16(const Row& r, bf16_t* p, int lane) {
#pragma unroll
    for (int j = 0; j < 2; ++j) { u32x4 w; w.x = pk2(r.v[2 * j][0], r.v[2 * j][1]); w.y = pk2(r.v[2 * j][2], r.v[2 * j][3]); w.z = pk2(r.v[2 * j + 1][0], r.v[2 * j + 1][1]); w.w = pk2(r.v[2 * j + 1][2], r.v[2 * j + 1][3]); ((GAS u32x4*)p)[vb(j, lane)] = w; } }
__device__ __forceinline__ void row_load_fp8(Row& r, const unsigned char* p, int lane) {
    const u32x4 w = ((const GAS u32x4*)p)[lane];
#pragma unroll
    for (int q = 0; q < 4; ++q) { const f32x2v lo = __builtin_amdgcn_cvt_pk_f32_fp8((int)w[q], false), hi = __builtin_amdgcn_cvt_pk_f32_fp8((int)w[q], true); r.v[q] = (f32x4){lo[0], lo[1], hi[0], hi[1]}; } }
__device__ __forceinline__ void row_store_fp8(const Row& r, unsigned char* p, int lane) {
    const int e0 = 256 * (lane >> 4) + 8 * (lane & 15);
#pragma unroll
    for (int j = 0; j < 2; ++j) { int w0 = 0, w1 = 0;
        w0 = __builtin_amdgcn_cvt_pk_fp8_f32(r.v[2 * j][0], r.v[2 * j][1], w0, false); w0 = __builtin_amdgcn_cvt_pk_fp8_f32(r.v[2 * j][2], r.v[2 * j][3], w0, true);
        w1 = __builtin_amdgcn_cvt_pk_fp8_f32(r.v[2 * j + 1][0], r.v[2 * j + 1][1], w1, false); w1 = __builtin_amdgcn_cvt_pk_fp8_f32(r.v[2 * j + 1][2], r.v[2 * j + 1][3], w1, true);
        u32x2 o; o.x = (unsigned)w0; o.y = (unsigned)w1; *(GAS u32x2*)(p + e0 + 128 * j) = o; } }
__device__ __forceinline__ void row_load_f32(Row& r, const float* p, int lane) {
#pragma unroll
    for (int q = 0; q < 4; ++q) r.v[q] = ((const GAS f32x4*)p)[vq(q, lane)]; }
__device__ __forceinline__ void row_store_f32(const Row& r, float* p, int lane) {
#pragma unroll
    for (int q = 0; q < 4; ++q) ((GAS f32x4*)p)[vq(q, lane)] = r.v[q]; }
__device__ __forceinline__ void row_normalize(Row& r, float eps) {
    float s = 0.f;
#pragma unroll
    for (int j = 0; j < 4; ++j) s += (r.v[j][0] + r.v[j][1]) + (r.v[j][2] + r.v[j][3]);
    const float mean = wave_sum(s) * (1.f / D); float q = 0.f;
#pragma unroll
    for (int j = 0; j < 4; ++j) { r.v[j] = r.v[j] - mean; q += (r.v[j][0] * r.v[j][0] + r.v[j][1] * r.v[j][1]) + (r.v[j][2] * r.v[j][2] + r.v[j][3] * r.v[j][3]); }
    const float rstd = 1.f / sqrtf(wave_sum(q) * (1.f / D) + eps);
#pragma unroll
    for (int j = 0; j < 4; ++j) r.v[j] = r.v[j] * rstd;
}
__device__ __forceinline__ void row_normalize_stats(Row& r, float eps, float& mean_o, float& rstd_o) {
    float s = 0.f;
#pragma unroll
    for (int j = 0; j < 4; ++j) s += (r.v[j][0] + r.v[j][1]) + (r.v[j][2] + r.v[j][3]);
    const float mean = wave_sum(s) * (1.f / D); float q = 0.f;
#pragma unroll
    for (int j = 0; j < 4; ++j) { r.v[j] = r.v[j] - mean; q += (r.v[j][0] * r.v[j][0] + r.v[j][1] * r.v[j][1]) + (r.v[j][2] * r.v[j][2] + r.v[j][3] * r.v[j][3]); }
    const float rstd = 1.f / sqrtf(wave_sum(q) * (1.f / D) + eps);
#pragma unroll
    for (int j = 0; j < 4; ++j) r.v[j] = r.v[j] * rstd;
    mean_o = mean; rstd_o = rstd;
}
__device__ __forceinline__ void row_modulate(Row& r, const float* sh, const float* sc, int lane) {
    row_normalize(r, MOD_EPS);
#pragma unroll
    for (int j = 0; j < 4; ++j) { const f32x4 a = ((const GAS f32x4*)sc)[vq(j, lane)], b = ((const GAS f32x4*)sh)[vq(j, lane)]; r.v[j] = r.v[j] * (a + 1.f) + b; }
}
__device__ __forceinline__ int mod_row(int row) { return row < T ? (row >> 11) : 32; }
__device__ __forceinline__ const float* mod_vec(const unsigned char* ws, int layer, int mr, int chunk) { return (const float*)(ws + WS_MOD) + ((size_t)(layer * 33 + mr) * 6 + chunk) * 1024; }

__device__ __forceinline__ void conv_item(const float* W, int N, bf16_t* WT, int Kd, int kd0, int n0, int drow0, bool mirror, LAS float* scr, int lane) {
#pragma unroll 8
    for (int i = 0; i < 32; ++i) { const int kk = 2 * i + (lane >> 5); const int kd = kd0 + kk; const int ks = mirror ? ((kd & ~255) + ((256 - (kd & 255)) & 255)) : kd;
        scr[kk * 33 + (lane & 31)] = ((const GAS float*)W)[(size_t)ks * N + n0 + (lane & 31)]; }
    LDS_WAIT(); asm volatile("" ::: "memory");
    const int c = lane & 7;
#pragma unroll
    for (int j = 0; j < 4; ++j) { const int n = (lane >> 3) + 8 * j; const LAS float* s = scr + (8 * c) * 33 + n;
        u32x4 o; o.x = pk2(s[0 * 33], s[1 * 33]); o.y = pk2(s[2 * 33], s[3 * 33]); o.z = pk2(s[4 * 33], s[5 * 33]); o.w = pk2(s[6 * 33], s[7 * 33]);
        *(GAS u32x4*)(WT + (size_t)(drow0 + n) * Kd + kd0 + 8 * c) = o; }
    LDS_WAIT(); asm volatile("" ::: "memory");
}
__device__ __forceinline__ void conv_matrix_item(const float* W, int K, int N, bf16_t* WT, int mode, int roff, int item, LAS float* scr, int lane) {
    const int nblk = N / 32, kb = item / nblk, nb = item % nblk, n0 = 32 * nb;
    int drow0 = n0 + roff; if (mode == 1) drow0 = (n0 >> 7) * 256 + (n0 & 127); if (mode == 2) drow0 = (n0 >> 7) * 256 + 128 + (n0 & 127);
    conv_item(W, N, WT, K, 64 * kb, n0, drow0, mode == 3, scr, lane);
}
__device__ __forceinline__ void conv_item64(const float* W, int N, bf16_t* WT, int Kd, int k0, int n0, int drow0, LAS bf16_t* scr, int lane) {
    f32x4 v[16];
#pragma unroll
    for (int i = 0; i < 16; ++i) v[i] = *(const GAS f32x4*)(W + (size_t)(k0 + 4 * i + (lane >> 4)) * N + n0 + (lane & 15) * 4);
#pragma unroll
    for (int i = 0; i < 16; ++i) { u32x2 w; w.x = pk2(v[i][0], v[i][1]); w.y = pk2(v[i][2], v[i][3]); *(LAS u32x2*)(scr + (4 * i + (lane >> 4)) * 68 + (lane & 15) * 4) = w; }
    LDS_WAIT(); asm volatile("" ::: "memory");
    const int c = lane & 7;
#pragma unroll
    for (int j = 0; j < 8; ++j) { const int n = (lane >> 3) + 8 * j; const LAS bf16_t* p = scr + (8 * c) * 68 + n;
        u32x4 o; o.x = (unsigned)p[0] | ((unsigned)p[68] << 16); o.y = (unsigned)p[2 * 68] | ((unsigned)p[3 * 68] << 16); o.z = (unsigned)p[4 * 68] | ((unsigned)p[5 * 68] << 16); o.w = (unsigned)p[6 * 68] | ((unsigned)p[7 * 68] << 16);
        *(GAS u32x4*)(WT + (size_t)(drow0 + n) * Kd + k0 + 8 * c) = o; }
    LDS_WAIT(); asm volatile("" ::: "memory");
}
__device__ __forceinline__ void conv_item64_f8(const float* W, int N, unsigned char* WT, int Kd, int k0, int n0, int drow0, LAS unsigned char* scr, int lane, bool mirror = false) {
    f32x4 v[16];
#pragma unroll
    for (int i = 0; i < 16; ++i) { const int kd = k0 + 4 * i + (lane >> 4); const int ks = mirror ? ((kd & ~255) + ((256 - (kd & 255)) & 255)) : kd; v[i] = *(const GAS f32x4*)(W + (size_t)ks * N + n0 + (lane & 15) * 4); }
#pragma unroll
    for (int i = 0; i < 16; ++i) { int w = 0; w = __builtin_amdgcn_cvt_pk_fp8_f32(v[i][0] * 64.f, v[i][1] * 64.f, w, false); w = __builtin_amdgcn_cvt_pk_fp8_f32(v[i][2] * 64.f, v[i][3] * 64.f, w, true);
        *(LAS unsigned*)(scr + (4 * i + (lane >> 4)) * 68 + (lane & 15) * 4) = (unsigned)w; }
    LDS_WAIT(); asm volatile("" ::: "memory");
    const int c = lane & 3;
#pragma unroll
    for (int j = 0; j < 4; ++j) { const int n = (lane >> 2) + 16 * j; const LAS unsigned char* p = scr + (16 * c) * 68 + n; u32x4 o;
#pragma unroll
        for (int q = 0; q < 4; ++q) o[q] = (unsigned)p[(4 * q) * 68] | ((unsigned)p[(4 * q + 1) * 68] << 8) | ((unsigned)p[(4 * q + 2) * 68] << 16) | ((unsigned)p[(4 * q + 3) * 68] << 24);
        *(GAS u32x4*)(WT + (size_t)(drow0 + n) * Kd + k0 + 16 * c) = o; }
    LDS_WAIT(); asm volatile("" ::: "memory");
}
__device__ __forceinline__ void conv_experts(Frame& F, const Args& a, int layer) {
    F.refresh();
    LAS unsigned char* scr = F.lds + 32768 + F.wave * 4352;
    unsigned char* EGU = F.ws + WS_EGU; unsigned char* ED = F.ws + WS_ED;
    for (int it = F.gw; it < (NE + 1) * 192; it += NGW) { const int e = it / 192, r = it % 192;
        const float* wg = e < NE ? a.in[14] + ((size_t)layer * NE + e) * 262144 : a.in[17] + (size_t)layer * 262144;
        const float* wu = e < NE ? a.in[15] + ((size_t)layer * NE + e) * 262144 : a.in[18] + (size_t)layer * 262144;
        const float* wd = e < NE ? a.in[16] + ((size_t)layer * NE + e) * 262144 : a.in[19] + (size_t)layer * 262144;
        if (r < 128) { const int q = r & 63, kb = q >> 2, nb = q & 3, n0 = 64 * nb; const int drow0 = (n0 >> 7) * 256 + (r < 64 ? 0 : 128) + (n0 & 127);
            conv_item64_f8(r < 64 ? wg : wu, 256, EGU + (size_t)e * 512 * 1024, 1024, 64 * kb, n0, drow0, scr, F.lane); }
        else { const int q = r - 128, kb = q >> 4, nb = q & 15; conv_item64_f8(wd, 1024, ED + (size_t)e * 1024 * 256, 256, 64 * kb, 64 * nb, 64 * nb, scr, F.lane); } }
}
__device__ __forceinline__ void conv_small(Frame& F, const Args& a) {
    F.refresh();
    { LAS unsigned char* scr8 = F.lds + 32768 + F.wave * 4352;
      for (int it = F.gw; it < 2304; it += NGW) {
          if (it < 768) { const int j = it / 384, r = it % 384, kb = r / 24, nb = r % 24; conv_item64_f8(a.in[8] + (size_t)j * 1024 * 1536, 1536, F.ws + WS_WQKV + (size_t)j * 1536 * 1024, 1024, 64 * kb, 64 * nb, 64 * nb, scr8, F.lane); }
          else if (it < 1280) { const int q = it - 768, j = q >> 8, r = q & 255, kb = r >> 4, nb = r & 15; conv_item64_f8(a.in[9] + (size_t)j * 1024 * 1024, 1024, F.ws + WS_WO + (size_t)j * 1024 * 1024, 1024, 64 * kb, 64 * nb, 64 * nb, scr8, F.lane); }
          else { const int q = it - 1280, j = q >> 9, r = q & 511, mir = r >> 8, kb = (r & 255) >> 4, nb = r & 15;
              conv_item64_f8(a.in[11] + (size_t)j * 1024 * 1024, 1024, F.ws + WS_WSH + (size_t)j * 2048 * 1024, 1024, 64 * kb, 64 * nb, 64 * nb + 1024 * mir, scr8, F.lane, mir != 0); } } }
    __syncthreads();
    { LAS float* scr = (LAS float*)(F.lds + 32768 + F.wave * 8448);
      for (int it = F.gw; it < 1152; it += NGW) {
          if (it < 1024) { const int j = it >> 9, r = it & 511; conv_matrix_item(a.in[11] + (size_t)j * 1024 * 1024, 1024, 1024, (bf16_t*)(F.ws + WS_WF) + (size_t)j * 2048 * 1024, 0, 0, r, scr, F.lane); }
          else { const int q = it - 1024, l = q / 32, r = q % 32; conv_matrix_item(a.in[12] + (size_t)l * 1024 * 64, 1024, 64, (bf16_t*)(F.ws + WS_WR) + (size_t)l * 64 * 1024, 0, 0, r, scr, F.lane); } } }
    const int gt = F.blk * NTHR + F.tid, NGT = GRID * NTHR;
    const float TWO_PI = 6.283185307179586f;
    { float* rc = (float*)(F.ws + WS_ROPEC); float* rs = (float*)(F.ws + WS_ROPES);
      for (int i = gt; i < 64 * 16; i += NGT) { const int pos = i >> 4, fi = i & 15; const float inv = exp2f(-(float)fi * (13.287712379549449f / 16.f)); const float ang = (float)pos * inv; rc[i] = cosf(ang); rs[i] = sinf(ang); } }
    { unsigned* cs = (unsigned*)(F.ws + WS_CSN);
      for (int i = gt; i < 512 * 64; i += NGT) { const int r = i >> 6, n4 = (i & 63) * 4, m = r & 255; unsigned w = 0;
#pragma unroll
          for (int q = 0; q < 4; ++q) { const float ang = TWO_PI * (float)((m * (n4 + q)) & 255) * (1.f / 256.f); w |= f2f8(r < 256 ? __cosf(ang) : -__sinf(ang)) << (8 * q); }
          cs[i] = w; } }
    { unsigned* dl = (unsigned*)(F.ws + WS_DL);
      for (int i = gt; i < 1024 * 1024; i += NGT) { const int k = i >> 10, c4 = (i & 1023) * 4; unsigned w = 0;
#pragma unroll
          for (int q = 0; q < 4; ++q) { const int c = c4 + q, l = c & 2047; const float ang = TWO_PI * (float)((k * l) & 2047) * (1.f / 2048.f); w |= f2f8(c < 2048 ? __cosf(ang) : __sinf(ang)) << (8 * q); }
          dl[i] = w; } }
    { unsigned* dl = (unsigned*)(F.ws + WS_DLC);
      for (int i = gt; i < 256 * 128; i += NGT) { const int k = i >> 7, c4 = (i & 127) * 4; unsigned w = 0;
#pragma unroll
          for (int q = 0; q < 4; ++q) { const int c = c4 + q, l = c & 255; const float ang = TWO_PI * (float)((k * l) & 255) * (1.f / 256.f); w |= f2f8(c < 256 ? __cosf(ang) : __sinf(ang)) << (8 * q); }
          dl[i] = w; } }
}
__device__ __forceinline__ void mod_full(Frame& F, const Args& a) {
    F.refresh();
    if (F.blk >= 192) return;
    const int l = F.blk / 48, cb = F.blk % 48; const int g = F.tid & 31, ks = F.tid >> 5; const int n0 = cb * 128;
    LAS float* s = (LAS float*)F.lds;
    f32x4 acc[33];
#pragma unroll
    for (int r = 0; r < 33; ++r) acc[r] = (f32x4){0.f, 0.f, 0.f, 0.f};
    for (int half = 0; half < 2; ++half) {
        __syncthreads();
        for (int i = F.tid; i < 512 * 33; i += NTHR) { const int k = i / 33, r = i % 33; const float c = (r < 32) ? a.in[1][(size_t)r * 1024 + half * 512 + k] : a.in[3][half * 512 + k]; s[k * 36 + r] = c / (1.f + __expf(-c)); }
        __syncthreads();
        const GAS f32x4* w = (const GAS f32x4*)((const GAS float*)a.in[4] + ((size_t)l * 1024 + half * 512 + ks * 32) * 6144 + n0 + 4 * g);
#pragma unroll 1
        for (int kb = 0; kb < 32; kb += 8) { f32x4 wv[8];
#pragma unroll
            for (int q = 0; q < 8; ++q) wv[q] = w[(size_t)(kb + q) * (6144 / 4)];
#pragma unroll
            for (int q = 0; q < 8; ++q) { const LAS float* sr = s + (ks * 32 + kb + q) * 36;
#pragma unroll
                for (int r = 0; r < 33; ++r) acc[r] += wv[q] * sr[r];
                asm volatile("" ::: "memory"); } }
    }
    LAS float* red = (LAS float*)F.lds;
    float* mod = (float*)(F.ws + WS_MOD);
#define MF_PASS(r0, nr) do { __syncthreads(); \
        _Pragma("unroll") for (int rr = 0; rr < (nr); ++rr) *(LAS f32x4*)(red + ((ks * 8 + rr) * 128 + 4 * g)) = acc[(r0) + rr]; \
        __syncthreads(); \
        for (int i = F.tid; i < (nr) * 128; i += NTHR) { const int rr = i >> 7, c = i & 127; float t = 0.f; \
            _Pragma("unroll") for (int k2 = 0; k2 < 16; ++k2) t += red[((k2 * 8 + rr) * 128) + c]; \
            mod[((size_t)l * 33 + (r0) + rr) * 6144 + n0 + c] = a.in[5][l * 6144 + n0 + c] + t; } } while (0)
    MF_PASS(0, 8); MF_PASS(8, 8); MF_PASS(16, 8); MF_PASS(24, 8); MF_PASS(32, 1);
#undef MF_PASS
    __syncthreads();
}
__device__ __forceinline__ void rows_init(Frame& F, const Args& a) {
    F.refresh();
    bf16_t* XS = (bf16_t*)(F.ws + WS_XS);
    static_assert(TT % (4 * NGW) == 0, "rows_init: four rows per wave and iteration");
    for (int r0 = F.gw; r0 < TT; r0 += 4 * NGW) {
        Row r[4];
#pragma unroll
        for (int t = 0; t < 4; ++t) { const int row = r0 + t * NGW; row_load_f32(r[t], row < T ? a.in[0] + (size_t)row * D : a.in[2] + (size_t)(row - T) * D, F.lane); }
#pragma unroll
        for (int t = 0; t < 4; ++t) { const int row = r0 + t * NGW; const int mr = mod_row(row);
            row_store_bf16(r[t], XS + (size_t)row * D, F.lane);
            row_modulate(r[t], mod_vec(F.ws, 0, mr, 0), mod_vec(F.ws, 0, mr, 1), F.lane);
            row_store_fp8(r[t], (unsigned char*)a.out + OUT_U8 + (size_t)row * D, F.lane);
            asm volatile("" ::: "memory"); } }
}
__device__ __forceinline__ void rows_post1(Frame& F, const Args& a, int layer, int nrows) {
    F.refresh();
    bf16_t* XS = (bf16_t*)(F.ws + WS_XS); const unsigned char* Y8 = (const unsigned char*)a.out;
    const float* lg = a.in[6] + (size_t)(layer * 2 + 0) * D; const float* lb = a.in[7] + (size_t)(layer * 2 + 0) * D;
    const int TPB = nrows / GRID;
    for (int rl = F.wave; rl < TPB; rl += 4 * NWAVES) {
        u32x4 xr[4][2], yr[4];
#pragma unroll
        for (int t = 0; t < 4; ++t) { const int row = F.blk * TPB + rl + t * NWAVES;
#pragma unroll
            for (int j = 0; j < 2; ++j) xr[t][j] = ((const GAS u32x4*)(XS + (size_t)row * D))[vb(j, F.lane)];
            yr[t] = ((const GAS u32x4*)(Y8 + (size_t)row * D))[F.lane]; }
#pragma unroll
        for (int t = 0; t < 4; ++t) { const int row = F.blk * TPB + rl + t * NWAVES; const int mr = mod_row(row);
            Row x, y;
#pragma unroll
            for (int j = 0; j < 2; ++j) { const u32x4 w = xr[t][j];
                x.v[2 * j] = (f32x4){bflo(w.x), bfhi(w.x), bflo(w.y), bfhi(w.y)}; x.v[2 * j + 1] = (f32x4){bflo(w.z), bfhi(w.z), bflo(w.w), bfhi(w.w)}; }
#pragma unroll
            for (int q = 0; q < 4; ++q) { const f32x2v lo = __builtin_amdgcn_cvt_pk_f32_fp8((int)yr[t][q], false), hi = __builtin_amdgcn_cvt_pk_f32_fp8((int)yr[t][q], true); y.v[q] = (f32x4){lo[0], lo[1], hi[0], hi[1]}; }
            const float* g1 = mod_vec(F.ws, layer, mr, 2);
#pragma unroll
            for (int j = 0; j < 4; ++j) x.v[j] = x.v[j] * ALPHA + (((const GAS f32x4*)g1)[vq(j, F.lane)] * (1.f / YSC)) * y.v[j];
            row_normalize(x, LN_EPS);
#pragma unroll
            for (int j = 0; j < 4; ++j) x.v[j] = x.v[j] * ((const GAS f32x4*)lg)[vq(j, F.lane)] + ((const GAS f32x4*)lb)[vq(j, F.lane)];
            row_store_bf16(x, XS + (size_t)row * D, F.lane);
            float mean, rstd; row_normalize_stats(x, MOD_EPS, mean, rstd);
            if (F.lane == 0) { f32x2v st = {mean, rstd}; *(GAS f32x2v*)(F.ws + WS_RSTAT + (size_t)row * 8) = st; }
            { const float* sh = mod_vec(F.ws, layer, mr, 3); const float* sc = mod_vec(F.ws, layer, mr, 4);
#pragma unroll
              for (int j = 0; j < 4; ++j) { const f32x4 av = ((const GAS f32x4*)sc)[vq(j, F.lane)], bv = ((const GAS f32x4*)sh)[vq(j, F.lane)]; x.v[j] = x.v[j] * (av + 1.f) + bv; } }
            row_store_fp8(x, (unsigned char*)a.out + OUT_U8 + (size_t)row * D, F.lane);
            asm volatile("" ::: "memory"); }
    }
}
__device__ __forceinline__ void rows_post2(Frame& F, const Args& a, int layer, int t0, int n) {
    F.refresh();
    bf16_t* XS = (bf16_t*)(F.ws + WS_XS); const unsigned char* YB = (const unsigned char*)(F.ws + WS_YB); const unsigned char* YS = (const unsigned char*)(F.ws + WS_YS);
    const int* spos = (const int*)(F.ws + WS_SDST); const float* tkw = (const float*)(F.ws + WS_TKW);
    const float* lg = a.in[6] + (size_t)(layer * 2 + 1) * D; const float* lb = a.in[7] + (size_t)(layer * 2 + 1) * D;
    for (int i0 = F.gw; i0 < n; i0 += 2 * NGW) {
        const int i1 = i0 + NGW; const bool two = i1 < n;
        int pj[2]; float wj[2];
#pragma unroll
        for (int t = 0; t < 2; ++t) { pj[t] = 0; wj[t] = 0.f; const int row = t0 + (t ? i1 : i0); if ((t == 0 || two) && F.lane < 8) { pj[t] = ((const GAS int*)spos)[(size_t)row * 8 + F.lane]; wj[t] = ((const GAS float*)tkw)[(size_t)row * 8 + F.lane]; } }
        Row x[2], y[2];
#pragma unroll
        for (int t = 0; t < 2; ++t) { const int i = t ? i1 : i0; if (t == 0 || two) { row_load_bf16(x[t], XS + (size_t)(t0 + i) * D, F.lane); row_load_fp8(y[t], YS + (size_t)i * D, F.lane); } }
        u32x4 zr[2][8];
#pragma unroll
        for (int t = 0; t < 2; ++t) if (t == 0 || two) {
#pragma unroll
            for (int s = 0; s < 8; ++s) { const int ps = __builtin_amdgcn_readlane(pj[t], s); zr[t][s] = ((const GAS u32x4*)(YB + (size_t)ps * D))[F.lane]; } }
#pragma unroll
        for (int t = 0; t < 2; ++t) if (t == 0 || two) { const int i = t ? i1 : i0; const int row = t0 + i; const int mr = mod_row(row);
#pragma unroll
            for (int j = 0; j < 4; ++j) y[t].v[j] = y[t].v[j] * (1.f / 16.f);
#pragma unroll
            for (int s = 0; s < 8; ++s) { const float wz = __builtin_bit_cast(float, __builtin_amdgcn_readlane(__builtin_bit_cast(int, wj[t]), s)) * (1.f / 16.f);
#pragma unroll
                for (int j = 0; j < 4; ++j) { const f32x2v lo = __builtin_amdgcn_cvt_pk_f32_fp8((int)zr[t][s][j], false), hi = __builtin_amdgcn_cvt_pk_f32_fp8((int)zr[t][s][j], true); y[t].v[j] += (f32x4){lo[0], lo[1], hi[0], hi[1]} * wz; } }
            const float* g2 = mod_vec(F.ws, layer, mr, 5);
#pragma unroll
            for (int j = 0; j < 4; ++j) x[t].v[j] = x[t].v[j] * ALPHA + ((const GAS f32x4*)g2)[vq(j, F.lane)] * y[t].v[j];
            row_normalize(x[t], LN_EPS);
#pragma unroll
            for (int j = 0; j < 4; ++j) x[t].v[j] = x[t].v[j] * ((const GAS f32x4*)lg)[vq(j, F.lane)] + ((const GAS f32x4*)lb)[vq(j, F.lane)];
            if (layer == 3) { row_store_f32(x[t], a.out + (size_t)row * D, F.lane); }
            else { row_store_bf16(x[t], XS + (size_t)row * D, F.lane);
                row_modulate(x[t], mod_vec(F.ws, layer + 1, mr, 0), mod_vec(F.ws, layer + 1, mr, 1), F.lane);
                row_store_fp8(x[t], (unsigned char*)a.out + OUT_U8 + (size_t)row * D, F.lane); } }
    }
}
__device__ __forceinline__ float wave_max_dpp(float v) {
    int x = __builtin_bit_cast(int, v);
#define DPPMAX(ctrl) { const int y = __builtin_amdgcn_update_dpp(x, x, ctrl, 0xf, 0xf, false); x = __builtin_bit_cast(int, fmaxf(__builtin_bit_cast(float, x), __builtin_bit_cast(float, y))); }
    DPPMAX(0xB1) DPPMAX(0x4E) DPPMAX(0x141) DPPMAX(0x140)
#undef DPPMAX
    const float r0 = __builtin_bit_cast(float, __builtin_amdgcn_readlane(x, 0)), r1 = __builtin_bit_cast(float, __builtin_amdgcn_readlane(x, 16));
    const float r2 = __builtin_bit_cast(float, __builtin_amdgcn_readlane(x, 32)), r3 = __builtin_bit_cast(float, __builtin_amdgcn_readlane(x, 48));
    return fmaxf(fmaxf(r0, r1), fmaxf(r2, r3));
}
__device__ __forceinline__ void route_tokens(Frame& F, const Args& a, int layer, int ntok) {
    F.refresh();
    const int TPB = ntok / GRID;
    const bf16_t* U = (const bf16_t*)(F.ws + WS_XS); const bf16_t* Wr = (const bf16_t*)(F.ws + WS_WR) + (size_t)layer * 64 * 1024;
    int* tke = (int*)(F.ws + WS_TKE); float* tkw = (float*)(F.ws + WS_TKW);
    LAS int* lcnt = (LAS int*)(F.lds + L_LCNT);
    LAS float* lg = (LAS float*)(F.lds);
    if (F.tid < 64) lcnt[F.tid] = 0;
    const int lane = F.lane, fr = lane & 15, fq = lane >> 4;
    const int ntile = TPB / 16;
    constexpr int WPITCH = 1040; constexpr int L_SE = 122880;
    LAS float* sEb = (LAS float*)(F.lds + L_SE);
    f32x4 acc[3][4];
#pragma unroll
    for (int i = 0; i < 3; ++i)
#pragma unroll
        for (int n = 0; n < 4; ++n) acc[i][n] = (f32x4){0.f, 0.f, 0.f, 0.f};
    int grp_of[3] = {0, 0, 0};
    int tl_lo = 0, g = 0;
    while (tl_lo < ntile) {
        const int mr = mod_row(F.blk * TPB + tl_lo * 16); int tl_hi = tl_lo + 1;
        while (tl_hi < ntile && mod_row(F.blk * TPB + tl_hi * 16) == mr) ++tl_hi;
        const float* shv = mod_vec(F.ws, layer, mr, 3); const float* scv = mod_vec(F.ws, layer, mr, 4);
        for (int half = 0; half < 2; ++half) {
            __syncthreads();
            { const int kc = lane, k = half * 512 + kc * 8;
              const f32x4 c0 = *(const GAS f32x4*)(scv + k) + 1.f, c1 = *(const GAS f32x4*)(scv + k + 4) + 1.f, h0 = *(const GAS f32x4*)(shv + k), h1 = *(const GAS f32x4*)(shv + k + 4);
              u32x4 wv[8];
#pragma unroll
              for (int j = 0; j < 8; ++j) wv[j] = *(const GAS u32x4*)(Wr + (size_t)(F.wave + 8 * j) * D + k);
#pragma unroll
              for (int j = 0; j < 8; ++j) { const int e = F.wave + 8 * j; const u32x4 w = wv[j];
                const float w0 = bflo(w.x), w1 = bfhi(w.x), w2 = bflo(w.y), w3 = bfhi(w.y), w4 = bflo(w.z), w5 = bfhi(w.z), w6 = bflo(w.w), w7 = bfhi(w.w);
                u32x4 o; o.x = cvt_pk_bf16(w0 * c0[0], w1 * c0[1]); o.y = cvt_pk_bf16(w2 * c0[2], w3 * c0[3]); o.z = cvt_pk_bf16(w4 * c1[0], w5 * c1[1]); o.w = cvt_pk_bf16(w6 * c1[2], w7 * c1[3]);
                *(LAS u32x4*)(F.lds + e * WPITCH + kc * 16) = o;
                const float se = wave_sum(((bflo(o.x) + bfhi(o.x)) + (bflo(o.y) + bfhi(o.y))) + ((bflo(o.z) + bfhi(o.z)) + (bflo(o.w) + bfhi(o.w))));
                const float be = wave_sum(((w0 * h0[0] + w1 * h0[1]) + (w2 * h0[2] + w3 * h0[3])) + ((w4 * h1[0] + w5 * h1[1]) + (w6 * h1[2] + w7 * h1[3])));
                if (lane == 0) { if (half == 0) { sEb[g * 64 + e] = se; sEb[192 + g * 64 + e] = be; } else { sEb[g * 64 + e] += se; sEb[192 + g * 64 + e] += be; } }
                asm volatile("" ::: "memory"); } }
            __syncthreads();
#pragma unroll
            for (int i = 0; i < 3; ++i) { const int tl = F.wave + 8 * i;
                if (tl >= tl_lo && tl < tl_hi) { const int t0 = F.blk * TPB + tl * 16;
                    const GAS bf16x8* ap = (const GAS bf16x8*)(U + (size_t)(t0 + fr) * D + half * 512 + fq * 8);
                    bf16x8 av[16];
#pragma unroll
                    for (int ks = 0; ks < 16; ++ks) av[ks] = ap[ks * 4];
#pragma unroll
                    for (int ks = 0; ks < 16; ++ks) {
#pragma unroll
                        for (int n = 0; n < 4; ++n) { const bf16x8 bv = *(const LAS bf16x8*)(F.lds + (n * 16 + fr) * WPITCH + (ks * 32 + fq * 8) * 2); acc[i][n] = __builtin_amdgcn_mfma_f32_16x16x32_bf16(av[ks], bv, acc[i][n], 0, 0, 0); }
                        if ((ks & 1) == 1) __builtin_amdgcn_sched_barrier(0); }
                    grp_of[i] = g; } }
        }
        tl_lo = tl_hi; ++g;
    }
    __syncthreads();
#pragma unroll
    for (int i = 0; i < 3; ++i) { const int tl = F.wave + 8 * i;
        if (tl < ntile) { const int t0 = F.blk * TPB + tl * 16; const int gi = grp_of[i];
#pragma unroll
            for (int j = 0; j < 4; ++j) { const f32x2v st = *(const GAS f32x2v*)(F.ws + WS_RSTAT + (size_t)(t0 + fq * 4 + j) * 8);
#pragma unroll
                for (int n = 0; n < 4; ++n) { const float se = sEb[gi * 64 + n * 16 + fr], be = sEb[192 + gi * 64 + n * 16 + fr];
                    lg[(tl * 16 + fq * 4 + j) * 65 + n * 16 + fr] = st[1] * (acc[i][n][j] - st[0] * se) + be; } } } }
    __syncthreads();
    if (F.tid < TPB) {
        const int tok = F.blk * TPB + F.tid; const LAS float* row = lg + F.tid * 65; const float* bias = a.in[13] + layer * 64;
        float sg[64], sel[64];
#pragma unroll
        for (int e = 0; e < 64; ++e) { sg[e] = 1.f / (1.f + __expf(-row[e])); sel[e] = sg[e] + bias[e]; }
        float gs[8];
#pragma unroll
        for (int g = 0; g < 8; ++g) { float m1 = -INFINITY, m2 = -INFINITY;
#pragma unroll
            for (int j = 0; j < 8; ++j) { const float v = sel[g * 8 + j]; const bool gt1 = v > m1; m2 = gt1 ? m1 : fmaxf(m2, v); m1 = gt1 ? v : m1; }
            gs[g] = m1 + m2; }
        unsigned gok = 0;
#pragma unroll
        for (int g = 0; g < 8; ++g) { int rk = 0;
#pragma unroll
            for (int h = 0; h < 8; ++h) rk += (gs[h] > gs[g] || (gs[h] == gs[g] && h < g)) ? 1 : 0;
            gok |= (rk < 4 ? 1u : 0u) << g; }
#pragma unroll
        for (int e = 0; e < 64; ++e) sel[e] = ((gok >> (e >> 3)) & 1u) ? sel[e] : -INFINITY;
        int ce[8]; float cw[8]; float tot = 0.f;
#pragma unroll
        for (int it = 0; it < 8; ++it) { float best = -INFINITY, bs = 0.f; int bi = 0;
#pragma unroll
            for (int e = 0; e < 64; ++e) { const bool b = sel[e] > best; best = b ? sel[e] : best; bs = b ? sg[e] : bs; bi = b ? e : bi; }
#pragma unroll
            for (int e = 0; e < 64; ++e) sel[e] = (e == bi) ? -INFINITY : sel[e];
            ce[it] = bi; cw[it] = bs; tot += bs; }
        const float sc = 2.5f / tot;
#pragma unroll
        for (int it = 0; it < 8; ++it) { tke[(size_t)tok * 8 + it] = ce[it]; tkw[(size_t)tok * 8 + it] = cw[it] * sc; __hip_atomic_fetch_add(&lcnt[ce[it]], 1, __ATOMIC_RELAXED, __HIP_MEMORY_SCOPE_WORKGROUP); }
    }
    __syncthreads();
    if (F.tid < 64) F.ctl[CW_BCNT + F.blk * 64 + F.tid] = (unsigned)lcnt[F.tid];
}
__device__ __forceinline__ void build_lists(Frame& F, int ntok) {
    F.refresh();
    constexpr int NSEG = NCHUNK * 64, BPC = GRID / NCHUNK;
    const int TPB = ntok / GRID, CH = ntok / NCHUNK;
    LAS int* tstart = (LAS int*)(F.lds + L_TSTART); LAS int* pref = (LAS int*)(F.lds + L_PREF); LAS int* lcnt = (LAS int*)(F.lds + L_LCNT);
    LAS unsigned char* tseg = (LAS unsigned char*)(F.lds + L_TSEG); LAS int* scan = (LAS int*)(F.lds + L_SCAN);
    const unsigned* bcnt = F.ctl + CW_BCNT;
    const int myc = F.blk / BPC, mylb = F.blk % BPC;
    int nseg = 0;
    LAS int* cntl = (LAS int*)F.lds;
    for (int i = F.tid; i < GRID * 64; i += NTHR) cntl[i] = (int)((const GAS unsigned*)bcnt)[i];
    if (F.tid < 64) lcnt[F.tid] = 0;
    __syncthreads();
    static_assert(NSEG == 64 && NTHR == 512, "build_lists: one chunk, eight partial sums per expert");
    LAS int* part = (LAS int*)(F.lds + 65536);
    { const int e = F.tid & 63, q = F.tid >> 6; int n = 0, p = 0;
#pragma unroll 8
      for (int lb = q * 32; lb < q * 32 + 32; ++lb) { const int v = cntl[lb * 64 + e]; if (lb < mylb) p += v; n += v; }
      part[q * 64 + e] = n; part[512 + q * 64 + e] = p; }
    __syncthreads();
    if (F.tid < 64) { int n = 0, p = 0;
#pragma unroll
        for (int q = 0; q < 8; ++q) { n += part[q * 64 + F.tid]; p += part[512 + q * 64 + F.tid]; }
        nseg = n; pref[F.tid] = p;
        const int tiles = (n + 255) >> 8; int incl = tiles;
#pragma unroll
        for (int d = 1; d < 64; d <<= 1) { const int o = __shfl_up(incl, d); if (F.lane >= d) incl += o; }
        tstart[F.tid + 1] = incl; if (F.tid == 0) tstart[0] = 0;
        for (int t = incl - tiles; t < incl; ++t) tseg[t] = (unsigned char)F.tid; }
    int* stok = (int*)(F.ws + WS_STOK); int* spos = (int*)(F.ws + WS_SDST);
    const int* tke = (const int*)(F.ws + WS_TKE);
    { const int sseg = myc * 64 + mylb; if (mylb < 64 && F.tid == sseg) scan[0] = nseg; }
    __syncthreads();
    if (mylb < 64) { const int sseg = myc * 64 + mylb; const int n = scan[0]; const int base = tstart[sseg] * 256, end = tstart[sseg + 1] * 256;
      for (int p = base + n + F.tid; p < end; p += NTHR) stok[p] = myc * CH; }
    for (int tb = F.wave * 8; tb < TPB; tb += NWAVES * 8) { const int tl = tb + (F.lane >> 3);
        if (tl < TPB) { const int tok = F.blk * TPB + tl; const int e = tke[(size_t)tok * 8 + (F.lane & 7)];
            const int p = tstart[myc * 64 + e] * 256 + pref[e] + __hip_atomic_fetch_add(&lcnt[e], 1, __ATOMIC_RELAXED, __HIP_MEMORY_SCOPE_WORKGROUP);
            stok[p] = tok; spos[(size_t)tok * 8 + (F.lane & 7)] = p - tstart[myc * 64] * 256; } }
    __syncthreads();
}

struct SchedQKV {
    const char* U; const char* W; int nfull, nu, c;
    __device__ __forceinline__ bool next(int i, pg::Unit& u) const {
        const int L0 = i * GRID + c; if (L0 >= nu) return false;
        int pm, pn;
        if (L0 < nfull) { const int L = pg::xcd_remap(L0, nfull); const int gid = L / 48, w = L % 48; pm = gid * 8 + (w & 7); pn = w >> 3; }
        else { const int q = L0 - nfull; pm = 256 + (q >> 1); pn = 4 + (q & 1); }
        u.A = U + (size_t)pm * 256 * 1024; u.B = W + (size_t)pn * 256 * 1024; u.gidx = nullptr; u.gbase = 0; u.nt = 8; u.out = nullptr; u.ldc = 0; u.scale = 1.f; u.flags = 0; u.i0 = pm; u.i1 = pn;
        return true; }
};
struct SchedDense {
    const char* A; const char* W; char* out; int nrt, nct, nt, c; size_t ldA;
    __device__ __forceinline__ bool next(int i, pg::Unit& u) const {
        const int nu = nrt * nct; const int L0 = i * GRID + c; if (L0 >= nu) return false;
        const int L = pg::xcd_remap(L0, nu); const int per = 8 * nct, gid = L / per, w = L % per, fm = gid * 8, gsz = (nrt - fm) < 8 ? (nrt - fm) : 8; const int pm = fm + (w % gsz), pn = w / gsz;
        u.A = A + (size_t)pm * 256 * ldA; u.B = W + (size_t)pn * 256 * ldA; u.gidx = nullptr; u.gbase = 0; u.nt = nt; u.out = out + (size_t)pm * 256 * 1024; u.ldc = 1024; u.scale = 1.f; u.flags = 0; u.i0 = pm; u.i1 = pn;
        return true; }
};
struct SchedF1 {
    const char* CS; const char* U; char* ABT; char* ABTC; int nu, c;
    __device__ __forceinline__ bool next(int i, pg::Unit& u) const {
        const int L0 = i * GRID + c; if (L0 >= nu) return false;
        u.gidx = nullptr; u.gbase = 0; u.nt = 2; u.scale = 1.f; u.flags = 0; u.i0 = 0; u.i1 = 0;
        if (L0 < 2048) { const int L = pg::xcd_remap(L0, 2048); const int pm = L & 1, pn = (L >> 1) & 7, bg = L >> 4, b = bg >> 2, g = bg & 3;
            u.A = CS + (size_t)pm * 256 * 256; u.B = U + ((size_t)b * SEQ + pn * 256) * 1024 + g * 256; u.out = ABT + (size_t)bg * 256 * 4096 + (size_t)(pm * 2048 + pn * 256); u.ldc = 4096; }
        else { const int q = L0 - 2048; const int pm = q & 1, bg = q >> 1, b = bg >> 2, g = bg & 3;
            u.A = CS + (size_t)pm * 256 * 256; u.B = U + ((size_t)T + b * CTXL) * 1024 + g * 256; u.out = ABTC + (size_t)bg * 256 * 512 + (size_t)pm * 256; u.ldc = 512; }
        return true; }
};
struct SchedF2 {
    const char* DL; const char* ABT; char* FH; int c;
    __device__ __forceinline__ bool next(int i, pg::Unit& u) const {
        const int L0 = i * GRID + c; if (L0 >= 512) return false;
        const int L = pg::xcd_remap(L0, 512); const int pm = L & 3, bg = L >> 2, b = bg >> 2, g = bg & 3;
        u.A = DL + (size_t)pm * 256 * 4096; u.B = ABT + (size_t)bg * 256 * 4096; u.gidx = nullptr; u.gbase = 0; u.nt = 32; u.out = FH + ((size_t)b * 1024 + pm * 256) * 1024 + g * 256; u.ldc = 1024; u.scale = 0.001381067932004975f  ; u.flags = 0; u.i0 = 0; u.i1 = 0;
        return true; }
};
struct SchedF2c {
    const char* DLC; const char* ABTC; char* FC; int c;
    __device__ __forceinline__ bool next(int i, pg::Unit& u) const {
        const int L0 = i * GRID + c; if (L0 >= 128) return false;
        const int bg = L0, b = bg >> 2, g = bg & 3;
        u.A = DLC; u.B = ABTC + (size_t)bg * 256 * 512; u.gidx = nullptr; u.gbase = 0; u.nt = 4; u.out = FC + ((size_t)b * 256) * 1024 + g * 256; u.ldc = 1024; u.scale = 1.f / 256.f; u.flags = 0; u.i0 = 0; u.i1 = 0;
        return true; }
};
struct SchedF3 {
    const char* FH; const char* FC; const char* W; char* Y; int nu, c;
    __device__ __forceinline__ bool next(int i, pg::Unit& u) const {
        const int L0 = i * GRID + c; if (L0 >= nu) return false;
        u.gidx = nullptr; u.gbase = 0; u.nt = 8; u.scale = 1.f; u.flags = 0; u.i0 = 0; u.i1 = 0;
        if (L0 < 1024) { const int L = pg::xcd_remap(L0, 1024); const int gid = L >> 6, w = L & 63, pm = gid * 8 + (w & 7), pn = w >> 3; const int b = pm >> 2, k0 = (pm & 3) * 256;
            u.A = FH + (size_t)pm * 256 * 1024; u.B = W + (size_t)pn * 256 * 1024;
            if (pn < 4) { u.out = Y + ((size_t)b * SEQ + k0) * 1024; u.ldc = 1024; u.i1 = pn; }
            else { u.out = Y + ((size_t)b * SEQ + SEQ - k0) * 1024; u.ldc = -1024; u.i1 = pn - 4; u.flags = (k0 == 0) ? 1 : 0; } }
        else { const int q = L0 - 1024; const int pm = q >> 2, pn = q & 3;
            u.A = FC + (size_t)pm * 256 * 1024; u.B = W + (size_t)pn * 256 * 1024; u.out = Y + ((size_t)T + pm * 256) * 1024; u.ldc = 1024; u.i1 = pn; }
        return true; }
};
struct SchedG1 {
    const char* EGU; const int* STOK; char* H; char* HS; LAS const unsigned char* tseg; int ntl, nsh, c;
    __device__ __forceinline__ bool gsrc(int i, const int*& gidx, int& gbase) const {
        const int nu = (ntl + nsh) * 2; const int L0 = i * GRID + c; if (L0 >= nu) return false;
        const int pm = pg::xcd_remap(L0, nu) >> 1;
        if (pm < ntl) { gidx = STOK + (size_t)pm * 256; gbase = 0; } else { gidx = nullptr; gbase = (pm - ntl) * 256; }
        return true; }
    __device__ __forceinline__ bool next(int i, pg::Unit& u) const {
        const int nu = (ntl + nsh) * 2; const int L0 = i * GRID + c; if (L0 >= nu) return false;
        const int L = pg::xcd_remap(L0, nu); const int pm = L >> 1, pn = L & 1;
        u.A = nullptr; u.gbase = 0; u.nt = 8; u.ldc = 256; u.scale = 1.f; u.flags = 0; u.i0 = 0; u.i1 = 0;
        if (pm < ntl) { const int e = __builtin_amdgcn_readfirstlane((int)tseg[pm]) & 63;
            u.gidx = STOK + (size_t)pm * 256; u.B = EGU + (size_t)e * 512 * 1024 + (size_t)pn * 256 * 1024; u.out = H + (size_t)pm * 256 * 256 + pn * 128; }
        else { const int ps = pm - ntl; u.gidx = nullptr; u.gbase = ps * 256; u.B = EGU + (size_t)NE * 512 * 1024 + (size_t)pn * 256 * 1024; u.out = HS + (size_t)ps * 256 * 256 + pn * 128; }
        return true; }
};
struct SchedG2 {
    const char* ED; const char* H; const char* HS; char* YB; char* YS; LAS const unsigned char* tseg; int t0, t1, nsh, ch, CH, c;
    __device__ __forceinline__ bool next(int i, pg::Unit& u) const {
        const int nr = t1 - t0; const int nu = (nr + nsh) * 4; const int L0 = i * GRID + c; if (L0 >= nu) return false;
        const int L = pg::xcd_remap(L0, nu); const int q = L >> 2, pn = L & 3;
        u.gidx = nullptr; u.gbase = 0; u.nt = 2; u.ldc = 1024; u.scale = 1.f; u.flags = 0; u.i0 = 0; u.i1 = pn;
        if (q < nr) { const int pm = t0 + q; const int e = __builtin_amdgcn_readfirstlane((int)tseg[pm]) & 63;
            u.A = H + (size_t)pm * 256 * 256; u.B = ED + (size_t)e * 1024 * 256 + (size_t)pn * 256 * 256; u.out = YB + (size_t)q * 256 * 1024; }
        else { const int ps = q - nr; u.A = HS + ((size_t)ch * CH + ps * 256) * 256; u.B = ED + (size_t)NE * 1024 * 256 + (size_t)pn * 256 * 256; u.out = YS + (size_t)ps * 256 * 1024; }
        return true; }
};

__device__ __forceinline__ void fnet_nyquist_rows(Frame& F) {
    F.refresh();
    const unsigned char* ABT = F.ws + WS_ABT; bf16_t* FH1 = (bf16_t*)(F.ws + WS_FH1);
    static_assert((128 * 256) % (4 * NGW) == 0, "fnet_nyquist_rows: four rows per wave and step");
    for (int r0 = F.gw; r0 < 128 * 256; r0 += 4 * NGW) {
        u32x4 w[4][2];
#pragma unroll
        for (int t = 0; t < 4; ++t) { const GAS u32x4* p = (const GAS u32x4*)(ABT + (size_t)(r0 + t * NGW) * 4096);
#pragma unroll
            for (int i = 0; i < 2; ++i) w[t][i] = p[i * 64 + F.lane]; }
#pragma unroll
        for (int t = 0; t < 4; ++t) { const int r = r0 + t * NGW; const int bg = r >> 8, m = r & 255, b = bg >> 2, g = bg & 3; float s = 0.f;
#pragma unroll
            for (int i = 0; i < 2; ++i)
#pragma unroll
                for (int q = 0; q < 4; ++q) { const f32x2v lo = __builtin_amdgcn_cvt_pk_f32_fp8((int)w[t][i][q], false), hi = __builtin_amdgcn_cvt_pk_f32_fp8((int)w[t][i][q], true); s += (lo[0] - lo[1]) + (hi[0] - hi[1]); }
            s = wave_sum(s) * 0.001381067932004975f;
            if (F.lane == 0) FH1[(size_t)b * 1024 + g * 256 + m] = (bf16_t)f2bf(s); } }
}
__device__ __forceinline__ void fnet_nyquist_out(Frame& F, const Args& a, int jl) {
    F.refresh();
    const bf16_t* FH1 = (const bf16_t*)(F.ws + WS_FH1); const bf16_t* W = (const bf16_t*)(F.ws + WS_WF) + (size_t)jl * 2048 * 1024; unsigned char* Y = (unsigned char*)a.out;
    LAS float* part = (LAS float*)F.lds;
    const int b = F.blk >> 3, n = (F.blk & 7) * 128 + (F.tid & 127), kq = F.tid >> 7;
    const GAS u32x4* wp = (const GAS u32x4*)(W + (size_t)n * 1024 + kq * 256); const GAS u32x4* fp = (const GAS u32x4*)(FH1 + (size_t)b * 1024 + kq * 256);
    float s = 0.f;
#pragma unroll 4
    for (int i = 0; i < 32; ++i) { const u32x4 w = wp[i], f = fp[i];
        s += bflo(w.x) * bflo(f.x) + bfhi(w.x) * bfhi(f.x) + bflo(w.y) * bflo(f.y) + bfhi(w.y) * bfhi(f.y) + bflo(w.z) * bflo(f.z) + bfhi(w.z) * bfhi(f.z) + bflo(w.w) * bflo(f.w) + bfhi(w.w) * bfhi(f.w); }
    part[F.tid] = s;
    __syncthreads();
    if (F.tid < 128) { const float t = (part[F.tid] + part[F.tid + 128]) + (part[F.tid + 256] + part[F.tid + 384]); const int cc = n & 127;
        Y[((size_t)b * SEQ + 1024) * D + (16 * (n >> 8) + (cc >> 3)) * 16 + 8 * ((n >> 7) & 1) + (cc & 7)] = (unsigned char)f2f8(__builtin_amdgcn_fmed3f(t * YSC, -448.f, 448.f)); }
    __syncthreads();
}


#ifdef SELFCHECK
constexpr int CW_ERR = 1024;
__device__ __forceinline__ void chk_report(unsigned* ctl, int id, float got, float ref, float tabs, float trel) {
    float e = fabsf(got - ref) / (tabs + trel * fabsf(ref)); if (!(e == e)) e = 1e30f; atomicMax(ctl + CW_ERR + id, __float_as_uint(e)); }
__device__ __forceinline__ float bf2f(bf16_t b) { return __builtin_bit_cast(float, (unsigned)b << 16); }
__constant__ int chk_toks[16] = {0, 1, 63, 64, 65, 127, 2047, 2048, 2049, 4096, 33000, 65535, 65536, 65537, 70000, 73727};
__constant__ int chk_ks[8] = {0, 1, 2, 255, 256, 1023, 1024, 700};
__constant__ int chk_ms[4] = {0, 1, 128, 255};
__constant__ int chk_ytoks[10] = {0, 1, 1023, 1024, 1025, 2047, 2048, 65535, 65536, 73727};
__constant__ int chk_ns[5] = {0, 1, 255, 256, 1023};
__constant__ int chk_cols[20] = {0, 7, 15, 16, 31, 32, 40, 48, 63, 64, 500, 1023, 1024, 1039, 1040, 1072, 1279, 1280, 1300, 1535};
__device__ __forceinline__ void chk_qkv(Frame& F, const Args& a, int layer, int id) {
    F.refresh(); const unsigned char* U = (const unsigned char*)a.out + OUT_U8; const float* W = a.in[8] + (size_t)(layer >> 1) * 1024 * 1536;
    const bf16_t* Qb = (const bf16_t*)(F.ws + WS_Q); const bf16_t* Kb = (const bf16_t*)(F.ws + WS_K); const bf16_t* Vb = (const bf16_t*)(F.ws + WS_V);
    for (int s = F.gw; s < 320; s += NGW) { const int tok = chk_toks[s & 15], col = chk_cols[s >> 4];
        if (layer == 2 && tok >= T && col < 1024) continue;
        const bool rope = (tok < T) && col < 1280; const int hc = col & 63, first = (hc & 31) < 16; const int pcol = rope ? (first ? col + 16 : col - 16) : col;
        float x = 0.f, xp = 0.f;
        for (int k = F.lane; k < 1024; k += 64) { const float u = f82f(U[(size_t)tok * D + k]); x += u * W[(size_t)k * 1536 + col]; xp += u * W[(size_t)k * 1536 + pcol]; }
        x = wave_sum(x); xp = wave_sum(xp);
        float ref = x;
        if (rope) { const int tl = tok & 2047, part = hc >> 5, pos = part ? (tl & 63) : (tl >> 6), fi = hc & 15; const float ang = (float)pos * powf(10000.f, -(float)fi / 16.f);
            ref = x * cosf(ang) + (first ? -xp : xp) * sinf(ang); }
        if (col < 1024) ref *= C2;
        const float got = col < 1024 ? bf2f(Qb[(size_t)tok * 1024 + col]) : (col < 1280 ? bf2f(Kb[(size_t)tok * 256 + col - 1024]) : bf2f(Vb[(size_t)tok * 256 + col - 1280]));
        if (F.lane == 0) chk_report(F.ctl, id, got, ref, 0.20f, 0.10f); }
}
__device__ __forceinline__ void chk_attn(Frame& F, const Args& a, int layer, int id) {
    F.refresh(); const bf16_t* Qb = (const bf16_t*)(F.ws + WS_Q); const bf16_t* Kb = (const bf16_t*)(F.ws + WS_K); const bf16_t* Vb = (const bf16_t*)(F.ws + WS_V); const unsigned char* Ob = F.ws + WS_R + 216 * MiB;
    LAS float* lg = (LAS float*)F.lds + F.wave * 1024;
    for (int s = F.gw; s < 64; s += NGW) { const int tok = chk_toks[s & 15], h = (s >> 4) * 5, kvh = h >> 2;
        if (layer == 2 && tok >= T) continue;
        const bool isctx = tok >= T; const int b = isctx ? (tok - T) / CTXL : tok / SEQ, p = tok & (SEQ - 1);
        int nk = 0; const int lo = isctx ? 0 : (p - 128 < 0 ? 0 : p - 128), hi = isctx ? -1 : (p + 128 > SEQ - 1 ? SEQ - 1 : p + 128);
        const int nlat = isctx ? 0 : hi - lo + 1; nk = nlat + CTXL;
        float mx = a.in[10][(layer >> 1) * 16 + h] * LOG2E; const float sink2 = mx;
        for (int i = F.lane; i < nk; i += 64) { const size_t kr = i < nlat ? (size_t)b * SEQ + lo + i : (size_t)T + b * CTXL + (i - nlat); float d = 0.f;
            for (int e = 0; e < 64; ++e) d += bf2f(Qb[(size_t)tok * 1024 + h * 64 + e]) * bf2f(Kb[kr * 256 + kvh * 64 + e]);
            lg[i] = d; mx = fmaxf(mx, d); }
#pragma unroll
        for (int o = 1; o < 64; o <<= 1) mx = fmaxf(mx, __shfl_xor(mx, o));
        LDS_WAIT();
        float den = 0.f; for (int i = F.lane; i < nk; i += 64) den += exp2f(lg[i] - mx);
        den = wave_sum(den) + exp2f(sink2 - mx);
        float o = 0.f;
        for (int i = 0; i < nk; ++i) { const size_t kr = i < nlat ? (size_t)b * SEQ + lo + i : (size_t)T + b * CTXL + (i - nlat); o += exp2f(lg[i] - mx) * bf2f(Vb[kr * 256 + kvh * 64 + F.lane]); }
        o /= den;
        chk_report(F.ctl, id, f82f(Ob[(size_t)tok * 1024 + h * 64 + F.lane]), o, 0.02f, 0.08f); chk_report(F.ctl, 32 + (s & 15), f82f(Ob[(size_t)tok * 1024 + h * 64 + F.lane]), o, 0.02f, 0.08f);
        LDS_WAIT(); }
    __syncthreads();
}
__device__ __forceinline__ void chk_fnet_f(Frame& F, const Args& a, bool upd, int id) {
    F.refresh(); const unsigned char* U = (const unsigned char*)a.out + OUT_U8; LAS float* red = (LAS float*)F.lds;
    for (int s = F.blk; s < 128 + (upd ? 64 : 0); s += GRID) {
        const bool cx = s >= 128; const int q = cx ? s - 128 : s; const int m = chk_ms[q & 3], g = ((q >> 2) & 1) * 3, b = ((q >> 3) & 1) * 31; int k = chk_ks[(q >> 4) & 7]; const int L = cx ? CTXL : SEQ; if (cx) k &= 255;
        const size_t row0 = cx ? (size_t)T + b * CTXL : (size_t)b * SEQ;
        float acc = 0.f;
        for (int l = F.wave; l < L; l += NWAVES) { float ca = 0.f, sa = 0.f;
            for (int n = F.lane; n < 256; n += 64) { const float u = f82f(U[(row0 + l) * D + g * 256 + n]); const float an = 6.283185307179586f * (float)((m * n) & 255) / 256.f; const float sn = __sinf(an), cs = __cosf(an); ca += u * cs; sa += u * sn; }
            ca = wave_sum(ca); sa = wave_sum(sa); const float an = 6.283185307179586f * (float)((k * l) % L) / (float)L; const float sn = __sinf(an), cs = __cosf(an); acc += cs * ca - sn * sa; }
        if (F.lane == 0) red[F.wave] = acc;
        __syncthreads();
        if (F.tid == 0) { float t = 0.f; for (int w = 0; w < NWAVES; ++w) t += red[w]; t *= cx ? (1.f / 256.f) : 0.001381067932004975f;
            float got;
            if (cx) got = f82f((F.ws + WS_FC)[((size_t)b * 256 + k) * D + g * 256 + m]);
            else if (k == 1024) got = bf2f(((const bf16_t*)(F.ws + WS_FH1))[(size_t)b * 1024 + g * 256 + m]);
            else got = f82f((F.ws + WS_FH)[((size_t)b * 1024 + k) * D + g * 256 + m]);
            chk_report(F.ctl, id, got, t, 0.25f, 0.10f); }
        __syncthreads(); }
}
__device__ __forceinline__ void chk_fnet_y(Frame& F, const Args& a, int jl, bool upd, int id) {
    F.refresh(); const bf16_t* Y = (const bf16_t*)a.out; const float* W = a.in[11] + (size_t)jl * 1024 * 1024;
    const unsigned char* FH = F.ws + WS_FH; const bf16_t* FH1 = (const bf16_t*)(F.ws + WS_FH1); const unsigned char* FC = F.ws + WS_FC;
    for (int s = F.gw; s < 50; s += NGW) { const int tok = chk_ytoks[s % 10], n = chk_ns[s / 10]; if (tok >= T && !upd) continue;
        float acc = 0.f;
        for (int j = F.lane; j < 1024; j += 64) { float f;
            if (tok >= T) f = f82f(FC[(size_t)(tok - T) * D + j]);
            else { const int b = tok >> 11, k = tok & 2047; if (k < 1024) f = f82f(FH[((size_t)b * 1024 + k) * D + j]); else if (k == 1024) f = bf2f(FH1[(size_t)b * 1024 + j]);
                else f = f82f(FH[((size_t)b * 1024 + (2048 - k)) * D + (j & ~255) + ((256 - (j & 255)) & 255)]); }
            acc += f * W[(size_t)j * 1024 + n]; }
        acc = wave_sum(acc);
        if (F.lane == 0) chk_report(F.ctl, id, bf2f(Y[(size_t)tok * D + n]), acc, 0.04f, 0.08f); }
}
__device__ __forceinline__ void chk_route(Frame& F, const Args& a, int layer, int ntok, int id) {
    F.refresh(); const bf16_t* U = (const bf16_t*)a.out; const float* Wr = a.in[12] + (size_t)layer * 1024 * 64; const int* tke = (const int*)(F.ws + WS_TKE); const float* tkw = (const float*)(F.ws + WS_TKW);
    for (int s = F.gw; s < 16; s += NGW) { const int tok = chk_toks[s]; if (tok >= ntok) continue; const int lane = F.lane;
        float lgt = 0.f; for (int k = 0; k < 1024; ++k) lgt += bf2f(U[(size_t)tok * D + k]) * Wr[(size_t)k * 64 + lane];
        const float sc = 1.f / (1.f + expf(-lgt)), sel = sc + a.in[13][layer * 64 + lane];
        float g1 = -INFINITY, g2 = -INFINITY;
#pragma unroll 1
        for (int j = 0; j < 8; ++j) { const float v = __shfl(sel, (lane & ~7) + j); if (v > g1) { g2 = g1; g1 = v; } else if (v > g2) g2 = v; }
        const float gs = g1 + g2; int gr = 0;
#pragma unroll 1
        for (int gp = 0; gp < 8; ++gp) { const float v = __shfl(gs, gp * 8); gr += (v > gs || (v == gs && gp < (lane >> 3))) ? 1 : 0; }
        const float sm = gr < 4 ? sel : -INFINITY; int rk = 0;
#pragma unroll 1
        for (int ep = 0; ep < 64; ++ep) { const float v = __shfl(sm, ep); rk += (v > sm || (v == sm && ep < lane)) ? 1 : 0; }
        const float tot = wave_sum(rk < 8 ? sc : 0.f); const float wref = sc / tot * 2.5f;
        int slot = -1; for (int j = 0; j < 8; ++j) if (tke[(size_t)tok * 8 + j] == lane) slot = j;
        float err = 0.f;
        if (slot >= 0) { if (rk >= 10) err = 10.f; else if (rk < 8) err = fabsf(tkw[(size_t)tok * 8 + slot] - wref) / (0.04f * wref); }
        else if (rk < 6) err = 10.f;
        const unsigned long long nsel = __ballot(slot >= 0); if (__builtin_popcountll(nsel) != 8) err = 20.f;
        atomicMax(F.ctl + CW_ERR + id, __float_as_uint(err)); }
}
__device__ __forceinline__ void chk_moe(Frame& F, const Args& a, int layer, int ntok, int ch, int id) {
    F.refresh(); const bf16_t* U = (const bf16_t*)a.out; const int* tke = (const int*)(F.ws + WS_TKE); const float* tkw = (const float*)(F.ws + WS_TKW);
    const int CH = ntok / NCHUNK; LAS float* hs = (LAS float*)F.lds; LAS float* us = hs + 512; LAS float* pg_ = us + 1024;
    for (int s = F.blk; s < 16; s += GRID) { const int tok = chk_toks[s]; if (tok >= ntok || tok / CH != ch) continue;
        for (int k = F.tid; k < 1024; k += NTHR) us[k] = bf2f(U[(size_t)tok * D + k]);
        __syncthreads();
        float y0 = 0.f, y1 = 0.f;
        for (int j = 0; j < 9; ++j) { const int e = j < 8 ? tke[(size_t)tok * 8 + j] : 0; const float w = j < 8 ? tkw[(size_t)tok * 8 + j] : 1.f;
            const float* wg = j < 8 ? a.in[14] + ((size_t)layer * NE + e) * 262144 : a.in[17] + (size_t)layer * 262144;
            const float* wu = j < 8 ? a.in[15] + ((size_t)layer * NE + e) * 262144 : a.in[18] + (size_t)layer * 262144;
            const float* wd = j < 8 ? a.in[16] + ((size_t)layer * NE + e) * 262144 : a.in[19] + (size_t)layer * 262144;
            const int hh = F.tid & 255, half = F.tid >> 8; float g = 0.f, u = 0.f;
            for (int k = half * 512; k < half * 512 + 512; ++k) { g += us[k] * wg[(size_t)k * 256 + hh]; u += us[k] * wu[(size_t)k * 256 + hh]; }
            pg_[F.tid] = g; pg_[512 + F.tid] = u;
            __syncthreads();
            if (F.tid < 256) { const float gg = pg_[F.tid] + pg_[F.tid + 256], uu = pg_[512 + F.tid] + pg_[512 + F.tid + 256]; hs[F.tid] = gg / (1.f + expf(-gg)) * uu; }
            __syncthreads();
            float t0 = 0.f, t1 = 0.f; for (int q = 0; q < 256; ++q) { t0 += hs[q] * wd[(size_t)q * 1024 + F.tid]; t1 += hs[q] * wd[(size_t)q * 1024 + 512 + F.tid]; }
            y0 += w * t0; y1 += w * t1;
            __syncthreads(); }
        float g0 = 0.f, g1 = 0.f; const int i = tok - ch * CH;
        { const unsigned char* YSb = (const unsigned char*)(F.ws + WS_YS); const unsigned char* YBb = (const unsigned char*)(F.ws + WS_YB); const int* spos = (const int*)(F.ws + WS_SDST);
          const int t_ = F.tid, bo = 16 * (16 * (t_ >> 8) + ((t_ & 127) >> 3)) + 8 * ((t_ >> 7) & 1) + (t_ & 7);
          auto f8 = [](unsigned char b) { return __builtin_amdgcn_cvt_pk_f32_fp8((int)b, false)[0] * (1.f / 16.f); };
          g0 = f8(YSb[(size_t)i * D + bo]); g1 = f8(YSb[(size_t)i * D + bo + 512]);
          for (int j = 0; j < 8; ++j) { const size_t ps = (size_t)spos[(size_t)tok * 8 + j]; const float w = tkw[(size_t)tok * 8 + j]; g0 += w * f8(YBb[ps * D + bo]); g1 += w * f8(YBb[ps * D + bo + 512]); } }
        chk_report(F.ctl, id, g0, y0, 0.15f, 0.15f); chk_report(F.ctl, id, g1, y1, 0.15f, 0.15f);
        __syncthreads(); }
}
#endif

#ifndef PH_MASK
#define PH_MASK 0xffffffffu
#endif
#define PH(b) ((PH_MASK >> (b)) & 1u)
__global__ void __launch_bounds__(NTHR, 2) fwd(Args a) {
    extern __shared__ __attribute__((aligned(16))) unsigned char lds_raw[];
    Frame F;
    F.lds = (LAS unsigned char*)lds_raw; F.ws = a.ws; F.ctl = (unsigned*)(a.ws + WS_CTL);
    F.blk = blockIdx.x; F.refresh();
    for (int u = F.tid; u < (LDS_BYTES - RING_BYTES) / 4; u += NTHR) ((LAS unsigned*)(F.lds + RING_BYTES))[u] = 0u;
    __syncthreads();
    const XcdBarrier bar = xcd_barrier_post(F.ctl + CW_BAR, (volatile LAS unsigned*)(F.lds + L_MISC) + 8);
#define GRID_BAR() xcd_barrier(bar)
    LAS unsigned char* ring = F.lds;
    const int c = F.blk;
#define ws (F.ws)
#define NEWPH() F.refresh()

    if (PH(0)) { conv_small(F, a);
    __syncthreads();
    mod_full(F, a); }
    GRID_BAR();
    if (PH(1)) { rows_init(F, a); }
    GRID_BAR();

    for (int layer = 0; layer < 4; ++layer) {
        const int jl = layer >> 1; const bool upd = layer < 2; const int nrows = upd ? TT : T;
        if ((layer & 1) == 0) {
            NEWPH();
            if (PH(2)) { SchedQKV S; S.U = (const char*)a.out + OUT_U8; S.W = (const char*)(ws + WS_WQKV) + (size_t)jl * 1536 * 1024; S.nfull = (layer == 0) ? 288 * 6 : 256 * 6; S.nu = (layer == 0) ? 288 * 6 : 256 * 6 + 64; S.c = c;
              pg::EpiQKV E; E.Q = (bf16_t*)(ws + WS_Q); E.K = (bf16_t*)(ws + WS_K); E.V = (bf16_t*)(ws + WS_V); E.ropec = (const float*)(ws + WS_ROPEC); E.ropes = (const float*)(ws + WS_ROPES);
              pg::gemm_phase<pg::EpiQKV, SchedQKV, false, true>(ring, 1024u, 1024u, nullptr, S, E); }
            GRID_BAR();
#ifdef SELFCHECK
            if (SELFCHECK & 1) chk_qkv(F, a, layer, 1 + (layer >> 1));
#endif
#define OBUF ((bf16_t*)(ws + WS_R + 216 * MiB))
            NEWPH();
            if (PH(3)) { const int NU = 2048 + (layer == 0 ? 256 : 0);
              const bf16_t* Qb = (const bf16_t*)(ws + WS_Q); const bf16_t* Kb = (const bf16_t*)(ws + WS_K); const bf16_t* Vb = (const bf16_t*)(ws + WS_V);
              for (int i = 0; i * GRID + c < NU; ++i) { int id = pg::xcd_remap(i * GRID + c, NU);
                  if (NU > 2048) { const int g9 = id / 9, r9 = id - g9 * 9; id = (r9 < 8) ? g9 * 8 + r9 : 2048 + g9; }
                  if (id < 2048) { const int hp = id & 1, qb = (id >> 1) & 7, kvh = (id >> 4) & 3, b = id >> 6, h0 = kvh * 4 + hp * 2;
                      attn::attn_unit2(Qb, Kb, Vb, OBUF, b, h0, qb * 256, false, a.in[10][jl * 16 + h0] * LOG2E, a.in[10][jl * 16 + h0 + 1] * LOG2E, ring); }
                  else { const int cid = id - 2048, hp = cid & 1, kvh = (cid >> 1) & 3, b = cid >> 3, h0 = kvh * 4 + hp * 2;
                      attn::attn_unit2(Qb, Kb, Vb, OBUF, b, h0, 0, true, a.in[10][jl * 16 + h0] * LOG2E, a.in[10][jl * 16 + h0 + 1] * LOG2E, ring); } } }
            GRID_BAR();
#ifdef SELFCHECK
            if (SELFCHECK & 1) chk_attn(F, a, layer, 3 + (layer >> 1));
#endif
            NEWPH();
            if (PH(4)) { SchedDense S; S.A = (const char*)OBUF; S.W = (const char*)(ws + WS_WO) + (size_t)jl * 1024 * 1024; S.out = (char*)a.out; S.nrt = nrows / 256; S.nct = 4; S.nt = 8; S.c = c; S.ldA = 1024;
              pg::EpiY8 E; pg::gemm_phase<pg::EpiY8, SchedDense, false, true>(ring, 1024u, 1024u, nullptr, S, E); }
            GRID_BAR();
        } else {
            NEWPH();
            if (PH(5)) { SchedF1 S; S.CS = (const char*)(ws + WS_CSN); S.U = (const char*)a.out + OUT_U8; S.ABT = (char*)(ws + WS_ABT); S.ABTC = (char*)(ws + WS_ABTC); S.nu = 2048 + (upd ? 256 : 0); S.c = c;
              pg::EpiStore8 E; pg::gemm_phase<pg::EpiStore8, SchedF1, false, true, 127>(ring, 256u, 1024u, nullptr, S, E); }
            GRID_BAR();
            NEWPH();
            if (PH(6)) { SchedF2 S; S.DL = (const char*)(ws + WS_DL); S.ABT = (const char*)(ws + WS_ABT); S.FH = (char*)(ws + WS_FH); S.c = c;
              pg::EpiStore8 E; pg::gemm_phase<pg::EpiStore8, SchedF2, false, true, 127>(ring, 4096u, 4096u, nullptr, S, E); }
            NEWPH();
            if (PH(7) && upd) { SchedF2c S; S.DLC = (const char*)(ws + WS_DLC); S.ABTC = (const char*)(ws + WS_ABTC); S.FC = (char*)(ws + WS_FC); S.c = c;
              pg::EpiStore8 E; pg::gemm_phase<pg::EpiStore8, SchedF2c, false, true, 127>(ring, 512u, 512u, nullptr, S, E); }
            if (PH(8)) fnet_nyquist_rows(F);
            GRID_BAR();
#ifdef SELFCHECK
            if (SELFCHECK & 2) chk_fnet_f(F, a, upd, 5 + (layer >> 1));
            GRID_BAR();
#endif
            NEWPH();
            if (PH(9)) { SchedF3 S; S.FH = (const char*)(ws + WS_FH); S.FC = (const char*)(ws + WS_FC); S.W = (const char*)(ws + WS_WSH) + (size_t)jl * 2048 * 1024; S.Y = (char*)a.out; S.nu = 1024 + (upd ? 128 : 0); S.c = c;
              pg::EpiY8 E; pg::gemm_phase<pg::EpiY8, SchedF3, false, true>(ring, 1024u, 1024u, nullptr, S, E); }
            if (PH(10)) fnet_nyquist_out(F, a, jl);
            GRID_BAR();
#ifdef SELFCHECK
            if (SELFCHECK & 8) chk_fnet_y(F, a, jl, upd, 7 + (layer >> 1));
            GRID_BAR();
#endif
        }
        const bool conv_first = ((c >> 3) & 1) == 0;
        if (PH(12) && conv_first) conv_experts(F, a, layer);
        __syncthreads();
        if (PH(11)) rows_post1(F, a, layer, nrows);
        VM_WAIT(); __syncthreads();
        if (threadIdx.x == 0) { __builtin_amdgcn_fence(__ATOMIC_ACQUIRE, "agent"); VM_WAIT(); }
        __syncthreads();
        if (PH(13)) route_tokens(F, a, layer, nrows);
        __syncthreads();
        if (PH(12) && !conv_first) conv_experts(F, a, layer);
        GRID_BAR();
#ifdef SELFCHECK
        if ((SELFCHECK & 64) && layer < 2) chk_route(F, a, layer, nrows, 9);
#endif
        if (PH(14)) build_lists(F, nrows);
        GRID_BAR();
        LAS const int* tstart = (LAS const int*)(F.lds + L_TSTART); LAS const unsigned char* tseg = (LAS const unsigned char*)(F.lds + L_TSEG);
        const int ntl = __builtin_amdgcn_readfirstlane(tstart[NCHUNK * 64]);
        NEWPH();
        if (PH(15)) { SchedG1 S; S.EGU = (const char*)(ws + WS_EGU); S.STOK = (const int*)(ws + WS_STOK); S.H = (char*)(ws + WS_H); S.HS = (char*)(ws + WS_HS); S.tseg = tseg; S.ntl = ntl; S.nsh = nrows / 256; S.c = c;
          pg::EpiSilu E; pg::gemm_phase<pg::EpiSilu, SchedG1, true, true>(ring, 1024u, 1024u, (const char*)a.out + OUT_U8, S, E); }
        GRID_BAR();
        const int CH = nrows / NCHUNK;
        for (int ch = 0; ch < NCHUNK; ++ch) {
            NEWPH();
            if (PH(16)) { SchedG2 S; S.ED = (const char*)(ws + WS_ED); S.H = (const char*)(ws + WS_H); S.HS = (const char*)(ws + WS_HS); S.YB = (char*)(ws + WS_YB); S.YS = (char*)(ws + WS_YS); S.tseg = tseg;
              S.t0 = __builtin_amdgcn_readfirstlane(tstart[ch * 64]); S.t1 = __builtin_amdgcn_readfirstlane(tstart[ch * 64 + 64]); S.nsh = CH / 256; S.ch = ch; S.CH = CH; S.c = c;
              pg::EpiFp8 E; pg::gemm_phase<pg::EpiFp8, SchedG2, false, true>(ring, 256u, 256u, nullptr, S, E); }
            GRID_BAR();
#ifdef SELFCHECK
            if ((SELFCHECK & 4) && layer == 0) { chk_moe(F, a, layer, nrows, ch, 10); GRID_BAR(); }
#endif
            if (PH(17)) rows_post2(F, a, layer, ch * CH, CH);
            if (!(layer == 3 && ch == NCHUNK - 1)) GRID_BAR();
        }
    }
#ifdef SELFCHECK
    GRID_BAR();
    { int bad = 0; float be = 0.f; for (int k = 15; k >= 1; --k) { const float e = __uint_as_float(__hip_atomic_load(F.ctl + CW_ERR + k, RLX_AGENT)); if (e > 1.f) { bad = k; be = e; } }
      int wt = 0; float we = 0.f; for (int k = 0; k < 16; ++k) { const float e = __uint_as_float(__hip_atomic_load(F.ctl + CW_ERR + 32 + k, RLX_AGENT)); if (e > we) { we = e; wt = k; } }
      if (bad) { F.refresh(); float cv = 3.f + bad + (be > 8.f ? 0.5f : 0.f);  Row r; for (int j = 0; j < 4; ++j) r.v[j] = (f32x4){cv, cv, cv, cv}; for (int row = F.gw; row < T; row += NGW) row_store_f32(r, a.out + (size_t)row * D, F.lane); } }
#endif
}

#undef ws
#undef NEWPH
extern "C" void kernel_launch(void* const* d_in, const int* in_sizes, int n_in, void* d_out, int out_size, void* d_ws, size_t ws_size, hipStream_t stream) {
    static int ready = 0;
    if (ready == 0) {
        if (n_in != 20 || out_size != T * D || ws_size < WS_END) { fprintf(stderr, "kernel_launch: unexpected problem (n_in %d out %d ws %zu need %zu)\n", n_in, out_size, ws_size, (size_t)WS_END); ready = -1; return; }
        if (hipFuncSetAttribute((const void*)fwd, hipFuncAttributeMaxDynamicSharedMemorySize, LDS_BYTES) != hipSuccess) { fprintf(stderr, "kernel_launch: hipFuncSetAttribute failed\n"); ready = -1; return; }
        int per_cu = 0;
        if (hipOccupancyMaxActiveBlocksPerMultiprocessor(&per_cu, (const void*)fwd, NTHR, LDS_BYTES) != hipSuccess || per_cu < 1) fprintf(stderr, "kernel_launch: occupancy query says %d blocks per CU\n", per_cu);
        (void)hipGetLastError();
        ready = 1;
    }
    if (ready < 0) return;
    (void)hipMemsetAsync((char*)d_ws + WS_CTL, 0, CTL_BYTES, stream);
    Args a{};
    for (int i = 0; i < 20; ++i) a.in[i] = (const float*)d_in[i];
    a.out = (float*)d_out; a.ws = (unsigned char*)d_ws;
    hipLaunchKernelGGL(fwd, dim3(GRID), dim3(NTHR), LDS_BYTES, stream, a);
}
```

```cpp
#include <hip/hip_runtime.h>
#include <cstdio>
#include <cstdint>

#define LAS __attribute__((address_space(3)))
#define GAS __attribute__((address_space(1)))
typedef unsigned short bf16_t;
typedef short bf16x8 __attribute__((ext_vector_type(8)));
typedef short s16x4 __attribute__((ext_vector_type(4)));
typedef float f32x4 __attribute__((ext_vector_type(4)));
typedef float f32x16 __attribute__((ext_vector_type(16)));
typedef unsigned u32x4 __attribute__((ext_vector_type(4)));
typedef unsigned u32x2 __attribute__((ext_vector_type(2)));
typedef int v8i_t __attribute__((ext_vector_type(8)));
typedef int v4i_t __attribute__((ext_vector_type(4)));

constexpr int D = 1024, NB = 32, SEQ = 2048, T = NB * SEQ, CTXL = 256, TC = NB * CTXL, TT = T + TC;
constexpr int NQKV = 1536, NE = 64;
constexpr float ALPHA = 1.681792830507429f;
constexpr float LN_EPS = 1e-5f, MOD_EPS = 1e-6f;
constexpr float C2 = 0.125f * 1.4426950408889634f;
constexpr float LOG2E = 1.4426950408889634f;
constexpr int NCHUNK = 1;
constexpr int NWAVES = 8, NTHR = 512, GRID = 256;

constexpr size_t MiB = 1u << 20;
constexpr size_t WS_CTL = 0, CTL_BYTES = 1 * MiB;
constexpr size_t WS_ROPEC = 1 * MiB, WS_ROPES = 1 * MiB + 4096, WS_CSN = 1 * MiB + 65536, WS_DLC = 1 * MiB + 524288, WS_DL = 2 * MiB;
constexpr size_t WS_WQKV = 10 * MiB, WS_WO = 16 * MiB, WS_WF = 20 * MiB, WS_WR = 28 * MiB, WS_WSH = 29 * MiB;
constexpr size_t WS_MODP = 36 * MiB, WS_MOD = 49 * MiB;
constexpr float QSC = 64.f;
constexpr float YSC = 16.f;
constexpr size_t WS_RSTAT = 36 * MiB;
constexpr size_t WS_EGU = 54 * MiB, WS_ED = 118 * MiB;
constexpr size_t WS_XS = 150 * MiB;
constexpr size_t WS_STOK = 294 * MiB, WS_SDST = 297 * MiB, WS_SW = 300 * MiB, WS_TKE = 303 * MiB, WS_TKW = 306 * MiB;
constexpr size_t WS_R = 309 * MiB;
constexpr size_t WS_Q = WS_R, WS_K = WS_R + 144 * MiB, WS_V = WS_R + 180 * MiB;
constexpr size_t WS_ABT = WS_R, WS_FH = WS_R + 256 * MiB, WS_FH1 = WS_R + 320 * MiB, WS_ABTC = WS_R + 321 * MiB, WS_FC = WS_R + 353 * MiB;
constexpr size_t WS_H = WS_R, WS_HS = WS_R + 160 * MiB, WS_YB = WS_R + 180 * MiB, WS_YS = WS_R + 788 * MiB;
constexpr size_t WS_END = WS_YS + 72 * MiB;
constexpr size_t OUT_U8 = 144 * MiB;
constexpr int WSCALE_E8M0 = 121;
constexpr int MAXROWS = 655360;

constexpr int CW_TMO = 0, CW_BAR = 4096, CW_BCNT = 16384;

constexpr int RING_BYTES = 131072;
constexpr int L_MISC = RING_BYTES;
constexpr int L_TSTART = RING_BYTES + 256;
constexpr int L_PREF = L_TSTART + 1040;
constexpr int L_LCNT = L_PREF + 256;
constexpr int L_TSEG = L_LCNT + 256;
constexpr int L_SCAN = L_TSEG + 2560;
constexpr int LDS_BYTES = 139264;
static_assert(L_SCAN + 1024 <= LDS_BYTES, "LDS map");

#define RLX_AGENT __ATOMIC_RELAXED, __HIP_MEMORY_SCOPE_AGENT
#define LDS_WAIT() asm volatile("s_waitcnt lgkmcnt(0)" ::: "memory")
#define VM_WAIT() asm volatile("s_waitcnt vmcnt(0)" ::: "memory")

__device__ __forceinline__ unsigned f2bf(float f) { unsigned u = __builtin_bit_cast(unsigned, f); return (u + 0x7fffu + ((u >> 16) & 1u)) >> 16; }
__device__ __forceinline__ unsigned pk2(float lo, float hi) { return f2bf(lo) | (f2bf(hi) << 16); }
typedef float f32x2_t __attribute__((ext_vector_type(2))); typedef __bf16 bf16x2_t __attribute__((ext_vector_type(2)));
__device__ __forceinline__ unsigned cvt_pk_bf16(float lo, float hi) { f32x2_t v = {lo, hi}; bf16x2_t b = __builtin_convertvector(v, bf16x2_t); return __builtin_bit_cast(unsigned, b); }
__device__ __forceinline__ float bflo(unsigned w) { return __builtin_bit_cast(float, w << 16); }
__device__ __forceinline__ float bfhi(unsigned w) { return __builtin_bit_cast(float, w & 0xffff0000u); }
__device__ __forceinline__ float wave_sum(float v) {
#pragma unroll
    for (int o = 1; o < 64; o <<= 1) v += __shfl_xor(v, o);
    return v;
}

__device__ __forceinline__ unsigned f2f8(float v) { return (unsigned)__builtin_amdgcn_cvt_pk_fp8_f32(v, 0.f, 0, false) & 0xffu; }
__device__ __forceinline__ float f82f(unsigned b) { return __builtin_amdgcn_cvt_pk_f32_fp8((int)(b & 0xffu), false)[0]; }
__device__ __forceinline__ int opaque_tid() { int t = threadIdx.x; asm volatile("" : "+v"(t)); return t; }

#define XB_TMO      128
#define XB_XCNT(j)  (256  + 64 * (j))
#define XB_XSUB(j)  (1280 + 64 * (j))
#define XB_XGEN(j)  (2304 + 64 * (j))
#define XB_TOP      3328
#define XB_TOPGEN   3392
#define XCD_BAR_WORDS 3456
#define XB_SPIN_CAP (1u << 22)
__device__ __forceinline__ unsigned xb_ld(unsigned* p)              { return __hip_atomic_load(p, __ATOMIC_RELAXED, __HIP_MEMORY_SCOPE_AGENT); }
__device__ __forceinline__ unsigned xb_add(unsigned* p, unsigned v) { return __hip_atomic_fetch_add(p, v, __ATOMIC_RELAXED, __HIP_MEMORY_SCOPE_AGENT); }
__device__ __forceinline__ unsigned xb_xcc_id() { return (unsigned)__builtin_amdgcn_s_getreg((3 << 11) | 20) & 0xFu; }
#define XB_SPIN(cond, bar) do { unsigned _sp = 0; while (cond) { __builtin_amdgcn_s_sleep(1); \
    if ((++_sp & 255u) == 0u) { if (xb_ld(&(bar)[XB_TMO])) break; if (_sp > XB_SPIN_CAP) { atomicAdd(&(bar)[XB_TMO], 1u); break; } } } } while (0)
struct XcdBarrier { unsigned* bar; unsigned x; volatile LAS unsigned* st; };
__device__ __forceinline__ XcdBarrier xcd_barrier_post(unsigned* bar, volatile LAS unsigned* st) {
    XcdBarrier b; b.bar = bar; b.x = xb_xcc_id(); b.st = st;
    if (threadIdx.x == 0) (void)xb_add(&bar[XB_XCNT(b.x)], 1u);
    return b;
}
__device__ __forceinline__ void xcd_barrier_complete(unsigned* bar, unsigned x, unsigned& nloc, unsigned& nx) {
    const unsigned G = gridDim.x * gridDim.y * gridDim.z;
    unsigned sum, cnt, mine, sp = 0u;
    for (;;) {
        sum = 0u; cnt = 0u; mine = 0u;
#pragma unroll
        for (unsigned j = 0; j < 16; ++j) { const unsigned c = xb_ld(&bar[XB_XCNT(j)]); sum += c; cnt += (c > 0u) ? 1u : 0u; mine = (j == x) ? c : mine; }
        if (sum == G) break;
        __builtin_amdgcn_s_sleep(1);
        if ((++sp & 255u) == 0u) { if (xb_ld(&bar[XB_TMO])) break; if (sp > XB_SPIN_CAP) { atomicAdd(&bar[XB_TMO], 1u); break; } }
    }
    nloc = mine > 0u ? mine : 1u; nx = cnt > 0u ? cnt : 1u;
}
__device__ __forceinline__ void xcd_barrier(const XcdBarrier& b) {
    asm volatile("s_waitcnt vmcnt(0)" ::: "memory");
    __syncthreads();
    if (threadIdx.x == 0) {
        unsigned* bar = b.bar; unsigned bx = b.x; asm volatile("" : "+s"(bx));
        __builtin_amdgcn_s_waitcnt(0);
        unsigned nloc = b.st[0], nx = b.st[1];
        if (nloc == 0u) { xcd_barrier_complete(bar, bx, nloc, nx); b.st[0] = nloc; b.st[1] = nx; }
        const unsigned old = xb_add(&bar[XB_XSUB(bx)], 1u);
        const unsigned gen = old / nloc;
        if (old + 1u == (gen + 1u) * nloc) {
            __builtin_amdgcn_fence(__ATOMIC_RELEASE, "agent");
            asm volatile("s_waitcnt vmcnt(0)" ::: "memory");
            const unsigned og = xb_add(&bar[XB_TOP], 1u);
            const unsigned tg = og / nx;
            if (og + 1u == (tg + 1u) * nx) xb_add(&bar[XB_TOPGEN], 1u);
            else XB_SPIN(xb_ld(&bar[XB_TOPGEN]) == tg, bar);
            __builtin_amdgcn_fence(__ATOMIC_ACQUIRE, "agent");
            xb_add(&bar[XB_XGEN(bx)], 1u);
            asm volatile("s_waitcnt vmcnt(0)" ::: "memory");
        } else {
            XB_SPIN(xb_ld(&bar[XB_XGEN(bx)]) == gen, bar);
            __builtin_amdgcn_fence(__ATOMIC_ACQUIRE, "agent");
            asm volatile("s_waitcnt vmcnt(0)" ::: "memory");
        }
    }
    __syncthreads();
}

typedef float f32x2v __attribute__((ext_vector_type(2)));
namespace pg {
constexpr int BM = 256, BK = 64, HALF = 128, HTB = HALF * BK * 2;
__host__ __device__ __forceinline__ int lds_byte(int r, int c) { const int st = (r >> 4) * 2 + (c >> 5), rr = r & 15, cc = c & 31, ob = rr * 64 + cc * 2; return st * 1024 + (ob ^ (((ob >> 9) & 1) << 5)); }
__host__ __device__ __forceinline__ void stage_rc(int b, int& R, int& C) { const int st = b / 1024, sb = b % 1024, swz = sb ^ (((sb >> 9) & 1) << 5); R = (st >> 1) * 16 + swz / 64; C = (st & 1) * 32 + (swz % 64) / 2; }
__host__ __device__ __forceinline__ int perm32(int rho) { const int n = rho >> 4, i = rho & 15; return 8 * (i >> 2) + 4 * n + (i & 3); }

struct Unit {
    const char* A;
    const char* B;
    const int* gidx;
    int gbase;
    int nt;
    char* out; int ldc; float scale; int flags; int i0; int i1;
};

template <class Epi, class Sched, bool GATHER, bool F8 = false, int WSC = WSCALE_E8M0>
__device__ __forceinline__ void gemm_phase(LAS unsigned char* lds, const unsigned lda, const unsigned ldb, const char* gtable, const Sched& S, const Epi& E) {
    const int tid = opaque_tid(), wid = __builtin_amdgcn_readfirstlane(tid >> 6), lane = tid & 63, wr = wid >> 2, wc = wid & 3, fr = lane & 15, fq = lane >> 4;
    unsigned voffA[2], voffB[2];
#pragma unroll
    for (int i = 0; i < 2; ++i) { int R, C; stage_rc(tid * 16 + i * 8192, R, C); const int Rb = (R & ~31) + perm32(R & 31);
        voffA[i] = (unsigned)R * lda + (unsigned)C * 2u; voffB[i] = (unsigned)Rb * ldb + (unsigned)C * 2u; }
    const size_t kstep = (size_t)(BK * 2);
    const size_t hstepA = (size_t)HALF * lda, hstepB = (size_t)HALF * ldb;
    const unsigned ldsw = (unsigned)wid * 1024u;
    const int aoff = lds_byte(wr * 64 + fr, fq * 8), boff = lds_byte(wc * 32 + fr, fq * 8);
#define PG_SA(b, h) (((b) * 2 + (h)) * HTB)
#define PG_SB(b, h) ((4 + (b) * 2 + (h)) * HTB)
#define PG_ST2(bufoff, p0, p1) do { \
        __builtin_amdgcn_global_load_lds((const unsigned*)(p0), (LAS unsigned*)(lds + (bufoff) + ldsw), 16, 0, 0); \
        __builtin_amdgcn_global_load_lds((const unsigned*)(p1), (LAS unsigned*)(lds + (bufoff) + ldsw + 8192), 16, 0, 0); } while (0)
#define PG_STB(bufoff, bp) PG_ST2(bufoff, (bp) + voffB[0], (bp) + voffB[1])
#define PG_STA(bufoff, ap, h, nx) do { if constexpr (GATHER) { PG_ST2(bufoff, (ap) + ((nx) ? nO[h][0] : cO[h][0]), (ap) + ((nx) ? nO[h][1] : cO[h][1])); } \
        else { PG_ST2(bufoff, (ap) + (h) * hstepA + voffA[0], (ap) + (h) * hstepA + voffA[1]); } } while (0)
#define PG_LD8(p) ({ const v4i_t lo_ = *(const LAS v4i_t*)(p), hi_ = *(const LAS v4i_t*)((p) + 1024); __builtin_shufflevector(lo_, hi_, 0, 1, 2, 3, 4, 5, 6, 7); })
#define PG_LDA(dst, b, h) do { if constexpr (F8) { _Pragma("unroll") for (int m = 0; m < 4; ++m) dst##8[m] = PG_LD8(lds + PG_SA(b, h) + aoff + m * 2048); } \
        else { _Pragma("unroll") for (int m = 0; m < 4; ++m) _Pragma("unroll") for (int k = 0; k < 2; ++k) dst[m][k] = *(const LAS bf16x8*)(lds + PG_SA(b, h) + aoff + m * 2048 + k * 1024); } } while (0)
#define PG_LDB(dst, b, h) do { if constexpr (F8) { _Pragma("unroll") for (int n = 0; n < 2; ++n) dst##8[n] = PG_LD8(lds + PG_SB(b, h) + boff + n * 2048); } \
        else { _Pragma("unroll") for (int n = 0; n < 2; ++n) _Pragma("unroll") for (int k = 0; k < 2; ++k) dst[n][k] = *(const LAS bf16x8*)(lds + PG_SB(b, h) + boff + n * 2048 + k * 1024); } } while (0)
#define PG_MMA(ai, bj, At, Bt) do { __builtin_amdgcn_s_setprio(1); _Pragma("unroll") for (int m = 0; m < 4; ++m) _Pragma("unroll") for (int n = 0; n < 2; ++n) { \
        if constexpr (F8) { asm volatile("v_mfma_scale_f32_16x16x128_f8f6f4 %0, %1, %2, %0, %3, %4 op_sel_hi:[0,0,0]" : "+v"(acc[ai][bj][m][n]) : "v"(Bt##8[n]), "v"(At##8[m]), "v"(sc_w), "v"(sc_x)); } \
        else { _Pragma("unroll") for (int k = 0; k < 2; ++k) acc[ai][bj][m][n] = __builtin_amdgcn_mfma_f32_16x16x32_bf16(Bt[n][k], At[m][k], acc[ai][bj][m][n], 0, 0, 0); } } \
        __builtin_amdgcn_s_setprio(0); } while (0)
#define PG_WAIT_V(n) asm volatile("s_waitcnt vmcnt(" #n ")" ::: "memory")
#define PG_WAIT_L(n) asm volatile("s_waitcnt lgkmcnt(" #n ")" ::: "memory")
#define PG_BAR __builtin_amdgcn_s_barrier()
#define PG_SCHED __builtin_amdgcn_sched_barrier(0)
#define PG_GOFF(dst, u) do { const int tz_ = opaque_tid(); _Pragma("unroll") for (int i = 0; i < 2; ++i) { int R_, C_; stage_rc(tz_ * 16 + i * 8192, R_, C_); \
        _Pragma("unroll") for (int h = 0; h < 2; ++h) { const int rr = h * HALF + R_; \
        const int ix = (u).gidx ? ((const GAS int*)(u).gidx)[rr] : (u).gbase + rr; dst[h][i] = (unsigned)ix * lda + (unsigned)C_ * 2u; } } } while (0)
#define PG_GIDX(dst, un) do { const int* gi_ = nullptr; int gb_ = 0; const bool ok_ = S.gsrc((un), gi_, gb_); const int tz_ = opaque_tid(); _Pragma("unroll") for (int i = 0; i < 2; ++i) { int R_, C_; stage_rc(tz_ * 16 + i * 8192, R_, C_); \
        _Pragma("unroll") for (int h = 0; h < 2; ++h) { const int rr = h * HALF + R_; dst[h][i] = (ok_ && gi_) ? ((const GAS int*)gi_)[rr] : gb_ + rr; } } } while (0)
#define PG_GCVT(dst, src) do { const int tz_ = opaque_tid(); _Pragma("unroll") for (int i = 0; i < 2; ++i) { int R_, C_; stage_rc(tz_ * 16 + i * 8192, R_, C_); \
        _Pragma("unroll") for (int h = 0; h < 2; ++h) dst[h][i] = (unsigned)src[h][i] * lda + (unsigned)C_ * 2u; } } while (0)
    Unit cur, nxt; int ui = 0;
    if (!S.next(0, cur)) return;
    f32x4 acc[2][2][4][2];
#pragma unroll
    for (int a = 0; a < 2; ++a)
#pragma unroll
        for (int b = 0; b < 2; ++b)
#pragma unroll
            for (int m = 0; m < 4; ++m)
#pragma unroll
                for (int n = 0; n < 2; ++n) acc[a][b][m][n] = (f32x4){0.f, 0.f, 0.f, 0.f};
    bf16x8 At[4][2], B0[2][2], B1[2][2]; v8i_t At8[4], B08[2], B18[2];
    const int sc_w = WSC * 0x01010101, sc_x = 0x7f7f7f7f;
    unsigned cO[2][2] = {{0u, 0u}, {0u, 0u}}, nO[2][2] = {{0u, 0u}, {0u, 0u}};
    if constexpr (GATHER) { PG_GOFF(cO, cur); }
    const char* cA = GATHER ? gtable : cur.A; const char* cB = cur.B;
    PG_STB(PG_SB(0, 0), cB); PG_STB(PG_SB(0, 1), cB + hstepB); PG_STA(PG_SA(0, 0), cA, 0, false); PG_STA(PG_SA(0, 1), cA, 1, false);
    if (wr == 1) PG_BAR;
    PG_WAIT_V(2); PG_BAR;
    PG_STB(PG_SB(1, 0), cB + kstep); PG_STA(PG_SA(1, 0), cA + kstep, 0, false); PG_STB(PG_SB(1, 1), cB + hstepB + kstep);
    PG_WAIT_V(6); PG_BAR;
    for (;;) {
        const bool has_next = S.next(ui + 1, nxt);
        const int nt = cur.nt;
        if constexpr (GATHER) { if (has_next) { PG_GOFF(nO, nxt); } else {
#pragma unroll
            for (int h = 0; h < 2; ++h)
#pragma unroll
                for (int i = 0; i < 2; ++i) nO[h][i] = cO[h][i]; } }
        const char* nA = GATHER ? gtable : (has_next ? nxt.A : cA); const char* nB = has_next ? nxt.B : cB;
#pragma unroll 1
        for (int t = 0; t < nt; t += 2) {
            const bool last = (t == nt - 2);
            const char* a1 = cA + (size_t)(t + 1) * kstep;
            const char* a2 = last ? nA : cA + (size_t)(t + 2) * kstep; const char* b2 = last ? nB : cB + (size_t)(t + 2) * kstep;
            const char* a3 = a2 + kstep; const char* b3 = b2 + kstep;
            const bool after_epi = (Epi::NSTORE > 0) && (t == 0) && (ui > 0);
            PG_LDB(B0, 0, 0); PG_LDB(B1, 0, 1); PG_SCHED; PG_LDA(At, 0, 0); PG_STA(PG_SA(1, 1), a1, 1, false);
            if (after_epi) { if constexpr (Epi::NSTORE == 8) PG_WAIT_V(16); else PG_WAIT_V(24); } else PG_WAIT_V(8);
            PG_WAIT_L(0); PG_BAR; PG_MMA(0, 0, At, B0); PG_MMA(0, 1, At, B1); PG_BAR; PG_SCHED;
            PG_LDA(At, 0, 1); PG_STB(PG_SB(0, 0), b2); PG_STB(PG_SB(0, 1), b2 + hstepB); PG_STA(PG_SA(0, 0), a2, 0, last);
            if (after_epi) { if constexpr (Epi::NSTORE == 8) PG_WAIT_V(16); else PG_WAIT_V(24); } else PG_WAIT_V(8);
            PG_WAIT_L(0); PG_BAR; PG_MMA(1, 0, At, B0); PG_MMA(1, 1, At, B1); PG_BAR; PG_SCHED;
            PG_LDB(B0, 1, 0); PG_LDB(B1, 1, 1); PG_SCHED; PG_LDA(At, 1, 0); PG_STA(PG_SA(0, 1), a2, 1, last);
            PG_WAIT_V(8); PG_WAIT_L(0); PG_BAR; PG_MMA(0, 0, At, B0); PG_MMA(0, 1, At, B1); PG_BAR; PG_SCHED;
            PG_LDA(At, 1, 1); PG_STB(PG_SB(1, 0), b3); PG_STB(PG_SB(1, 1), b3 + hstepB); PG_STA(PG_SA(1, 0), a3, 0, last);
            PG_WAIT_V(8); PG_WAIT_L(0); PG_BAR; PG_MMA(1, 0, At, B0); PG_MMA(1, 1, At, B1); PG_BAR; PG_SCHED;
        }
        if (wr == 0) PG_BAR;
        if constexpr (F8) asm volatile("s_nop 15\n\ts_nop 15" ::: "memory");
        E(acc, cur, wr, wc, fr, fq);
        if (!has_next) break;
#pragma unroll
        for (int a = 0; a < 2; ++a)
#pragma unroll
            for (int b = 0; b < 2; ++b)
#pragma unroll
                for (int m = 0; m < 4; ++m)
#pragma unroll
                    for (int n = 0; n < 2; ++n) acc[a][b][m][n] = (f32x4){0.f, 0.f, 0.f, 0.f};
        cur = nxt; cA = nA; cB = nB; ++ui;
        if constexpr (GATHER) {
#pragma unroll
            for (int h = 0; h < 2; ++h)
#pragma unroll
                for (int i = 0; i < 2; ++i) cO[h][i] = nO[h][i]; }
        if (wr == 1) PG_BAR;
    }
    PG_WAIT_V(0);
    PG_BAR;
#undef PG_SA
#undef PG_SB
#undef PG_ST2
#undef PG_STB
#undef PG_STA
#undef PG_LDA
#undef PG_LD8
#undef PG_LDB
#undef PG_MMA
#undef PG_WAIT_V
#undef PG_WAIT_L
#undef PG_BAR
#undef PG_SCHED
#undef PG_GOFF
#undef PG_GIDX
#undef PG_GCVT
}

struct EpiStore {
    static constexpr int NSTORE = 0;
    __device__ __forceinline__ void operator()(const f32x4 (&acc)[2][2][4][2], const Unit& u, int wr, int wc, int fr, int fq) const {
        asm volatile("" : "+v"(fr), "+v"(fq));
        const float s = u.scale;
#pragma unroll
        for (int ai = 0; ai < 2; ++ai)
#pragma unroll
            for (int m = 0; m < 4; ++m) { const int row = ai * HALF + wr * 64 + m * 16 + fr;
                char* rowp = u.out + (ptrdiff_t)row * u.ldc + (wc * 32 + 8 * fq) * 2;
                if (!((u.flags & 1) && row == 0)) {
#pragma unroll
                for (int bj = 0; bj < 2; ++bj) { const f32x4 v0 = acc[ai][bj][m][0] * s, v1 = acc[ai][bj][m][1] * s;
                    u32x4 w; w.x = cvt_pk_bf16(v0[0], v0[1]); w.y = cvt_pk_bf16(v0[2], v0[3]); w.z = cvt_pk_bf16(v1[0], v1[1]); w.w = cvt_pk_bf16(v1[2], v1[3]);
                    *(u32x4*)(rowp + bj * 256) = w; } } }
    }
};
struct EpiStore8 {
    static constexpr int NSTORE = 16;
    __device__ __forceinline__ void operator()(const f32x4 (&acc)[2][2][4][2], const Unit& u, int wr, int wc, int fr, int fq) const {
        asm volatile("" : "+v"(fr), "+v"(fq));
        const float s = u.scale;
#pragma unroll
        for (int ai = 0; ai < 2; ++ai)
#pragma unroll
            for (int m = 0; m < 4; ++m) { const int row = ai * HALF + wr * 64 + m * 16 + fr;
                char* rowp = u.out + (ptrdiff_t)row * u.ldc + (wc * 32 + 8 * fq);
#pragma unroll
                for (int bj = 0; bj < 2; ++bj) { const f32x4 v0 = acc[ai][bj][m][0] * s, v1 = acc[ai][bj][m][1] * s; int w0 = 0, w1 = 0;
                    w0 = __builtin_amdgcn_cvt_pk_fp8_f32(v0[0], v0[1], w0, false); w0 = __builtin_amdgcn_cvt_pk_fp8_f32(v0[2], v0[3], w0, true);
                    w1 = __builtin_amdgcn_cvt_pk_fp8_f32(v1[0], v1[1], w1, false); w1 = __builtin_amdgcn_cvt_pk_fp8_f32(v1[2], v1[3], w1, true);
                    u32x2 o; o.x = (unsigned)w0; o.y = (unsigned)w1; *(u32x2*)(rowp + bj * 128) = o; } }
    }
};
struct EpiQKV {
    static constexpr int NSTORE = 0;
    bf16_t* Q; bf16_t* K; bf16_t* V; const float* ropec; const float* ropes;
    __device__ __forceinline__ void operator()(const f32x4 (&acc)[2][2][4][2], const Unit& u, int wr, int wc, int fr, int fq) const {
        asm volatile("" : "+v"(fr), "+v"(fq));
        const int pm = u.i0, pn = u.i1; const bool lat = pm < (T / 256); const bool rope = lat && pn < 5;
        const float qs = pn < 4 ? C2 : 1.f;
        const int part = wc & 1;
        const int fi0 = 8 * (fq & 1);
        const float sgn = (fq < 2) ? -1.f : 1.f;
#pragma unroll
        for (int ai = 0; ai < 2; ++ai)
#pragma unroll
            for (int m = 0; m < 4; ++m) { const int row = ai * HALF + wr * 64 + m * 16 + fr; const int tok = pm * 256 + row;
                const int tl = tok & (SEQ - 1); const int pos = part ? (tl & 63) : (tl >> 6);
                f32x4 c0 = {1.f, 1.f, 1.f, 1.f}, c1 = c0, s0 = {0.f, 0.f, 0.f, 0.f}, s1 = s0;
                if (rope) { c0 = *(const f32x4*)(ropec + pos * 16 + fi0); c1 = *(const f32x4*)(ropec + pos * 16 + fi0 + 4); s0 = *(const f32x4*)(ropes + pos * 16 + fi0); s1 = *(const f32x4*)(ropes + pos * 16 + fi0 + 4); }
#pragma unroll
                for (int bj = 0; bj < 2; ++bj) { f32x4 v0 = acc[ai][bj][m][0], v1 = acc[ai][bj][m][1];
                    if (rope) { f32x4 p0, p1;
#pragma unroll
                        for (int j = 0; j < 4; ++j) { p0[j] = __shfl_xor(v0[j], 32); p1[j] = __shfl_xor(v1[j], 32); }
                        v0 = v0 * c0 + (p0 * sgn) * s0; v1 = v1 * c1 + (p1 * sgn) * s1; }
                    v0 = v0 * qs; v1 = v1 * qs;
                    const int col = bj * HALF + wc * 32 + 8 * fq;
                    if (pn < 4) {
#pragma unroll
                        for (int j = 0; j < 4; ++j) { v0[j] = __builtin_amdgcn_fmed3f(v0[j] * QSC, -448.f, 448.f); v1[j] = __builtin_amdgcn_fmed3f(v1[j] * QSC, -448.f, 448.f); }
                        int w0 = 0, w1 = 0;
                        w0 = __builtin_amdgcn_cvt_pk_fp8_f32(v0[0], v0[1], w0, false); w0 = __builtin_amdgcn_cvt_pk_fp8_f32(v0[2], v0[3], w0, true);
                        w1 = __builtin_amdgcn_cvt_pk_fp8_f32(v1[0], v1[1], w1, false); w1 = __builtin_amdgcn_cvt_pk_fp8_f32(v1[2], v1[3], w1, true);
                        u32x2 o; o.x = (unsigned)w0; o.y = (unsigned)w1; *(GAS u32x2*)((unsigned char*)Q + (size_t)tok * 1024 + pn * 256 + col) = o; }
                    else { u32x4 w; w.x = cvt_pk_bf16(v0[0], v0[1]); w.y = cvt_pk_bf16(v0[2], v0[3]); w.z = cvt_pk_bf16(v1[0], v1[1]); w.w = cvt_pk_bf16(v1[2], v1[3]);
                        bf16_t* dst = pn == 4 ? K + (size_t)tok * 256 + col : V + (size_t)tok * 256 + col;
                        *(GAS u32x4*)dst = w; } } }
    }
};
struct EpiSilu {
    static constexpr int NSTORE = 8;
    __device__ __forceinline__ void operator()(const f32x4 (&acc)[2][2][4][2], const Unit& u, int wr, int wc, int fr, int fq) const {
        asm volatile("" : "+v"(fr), "+v"(fq));
#pragma unroll
        for (int ai = 0; ai < 2; ++ai)
#pragma unroll
            for (int m = 0; m < 4; ++m) { const int row = ai * HALF + wr * 64 + m * 16 + fr;
                float h[8];
#pragma unroll
                for (int n = 0; n < 2; ++n)
#pragma unroll
                    for (int j = 0; j < 4; j += 2) {
                        const f32x2v g = {acc[ai][0][m][n][j], acc[ai][0][m][n][j + 1]}, up = {acc[ai][1][m][n][j], acc[ai][1][m][n][j + 1]};
                        const f32x2v t = g * (f32x2v){-1.4426950408889634f, -1.4426950408889634f}, p = g * up;
                        f32x2v e = {__builtin_amdgcn_exp2f(t[0]), __builtin_amdgcn_exp2f(t[1])};
                        e = e + (f32x2v){1.f, 1.f};
                        const f32x2v r = {__builtin_amdgcn_rcpf(e[0]), __builtin_amdgcn_rcpf(e[1])};
                        const f32x2v o2 = p * r; h[n * 4 + j] = o2[0]; h[n * 4 + j + 1] = o2[1]; }
                int w0 = 0, w1 = 0;
                w0 = __builtin_amdgcn_cvt_pk_fp8_f32(h[0], h[1], w0, false); w0 = __builtin_amdgcn_cvt_pk_fp8_f32(h[2], h[3], w0, true);
                w1 = __builtin_amdgcn_cvt_pk_fp8_f32(h[4], h[5], w1, false); w1 = __builtin_amdgcn_cvt_pk_fp8_f32(h[6], h[7], w1, true);
                u32x2 o; o.x = (unsigned)w0; o.y = (unsigned)w1;
                *(u32x2*)(u.out + (size_t)row * 256 + (wc * 32 + 8 * fq)) = o; }
    }
};
struct EpiFp8 {
    static constexpr int NSTORE = 8;
    __device__ __forceinline__ void operator()(const f32x4 (&acc)[2][2][4][2], const Unit& u, int wr, int wc, int fr, int fq) const {
        asm volatile("" : "+v"(fr), "+v"(fq));
        const int pn = u.i1;
#pragma unroll
        for (int ai = 0; ai < 2; ++ai)
#pragma unroll
            for (int m = 0; m < 4; ++m) { const int row = ai * HALF + wr * 64 + m * 16 + fr;
                u32x4 o;
#pragma unroll
                for (int bj = 0; bj < 2; ++bj) { const f32x4 v0 = acc[ai][bj][m][0] * 16.f, v1 = acc[ai][bj][m][1] * 16.f;
                    int w0 = 0, w1 = 0;
                    w0 = __builtin_amdgcn_cvt_pk_fp8_f32(v0[0], v0[1], w0, false); w0 = __builtin_amdgcn_cvt_pk_fp8_f32(v0[2], v0[3], w0, true);
                    w1 = __builtin_amdgcn_cvt_pk_fp8_f32(v1[0], v1[1], w1, false); w1 = __builtin_amdgcn_cvt_pk_fp8_f32(v1[2], v1[3], w1, true);
                    o[2 * bj] = (unsigned)w0; o[2 * bj + 1] = (unsigned)w1; }
                *(u32x4*)(u.out + (size_t)row * 1024 + (16 * pn + 4 * wc + fq) * 16) = o; }
    }
};
struct EpiY8 {
    static constexpr int NSTORE = 0;
    __device__ __forceinline__ void operator()(const f32x4 (&acc)[2][2][4][2], const Unit& u, int wr, int wc, int fr, int fq) const {
        asm volatile("" : "+v"(fr), "+v"(fq));
        const int pn = u.i1; const float s = u.scale * YSC;
#pragma unroll
        for (int ai = 0; ai < 2; ++ai)
#pragma unroll
            for (int m = 0; m < 4; ++m) { const int row = ai * HALF + wr * 64 + m * 16 + fr;
                u32x4 o;
#pragma unroll
                for (int bj = 0; bj < 2; ++bj) { f32x4 v0 = acc[ai][bj][m][0] * s, v1 = acc[ai][bj][m][1] * s;
#pragma unroll
                    for (int j = 0; j < 4; ++j) { v0[j] = __builtin_amdgcn_fmed3f(v0[j], -448.f, 448.f); v1[j] = __builtin_amdgcn_fmed3f(v1[j], -448.f, 448.f); }
                    int w0 = 0, w1 = 0;
                    w0 = __builtin_amdgcn_cvt_pk_fp8_f32(v0[0], v0[1], w0, false); w0 = __builtin_amdgcn_cvt_pk_fp8_f32(v0[2], v0[3], w0, true);
                    w1 = __builtin_amdgcn_cvt_pk_fp8_f32(v1[0], v1[1], w1, false); w1 = __builtin_amdgcn_cvt_pk_fp8_f32(v1[2], v1[3], w1, true);
                    o[2 * bj] = (unsigned)w0; o[2 * bj + 1] = (unsigned)w1; }
                if (!((u.flags & 1) && row == 0)) *(GAS u32x4*)(u.out + (ptrdiff_t)row * u.ldc + (16 * pn + 4 * wc + fq) * 16) = o; }
    }
};
__device__ __forceinline__ int xcd_remap(int L0, int NU) { const int q = NU >> 3, r = NU & 7, x = L0 & 7, off = L0 >> 3; return (x < r ? x * (q + 1) : r * (q + 1) + (x - r) * q) + off; }
}

namespace attn {
constexpr int SLOTB = 8192;
constexpr int LDS_K = 0, LDS_V = 2 * SLOTB, LDS_WS = 4 * SLOTB, LDS_OST = LDS_WS + NWAVES * 256, LDS_END = LDS_OST + NWAVES * 4096;
static_assert(LDS_END <= RING_BYTES, "attention LDS");
__device__ __forceinline__ int crow(int r, int hi) { return (r & 3) + 8 * (r >> 2) + 4 * hi; }
__device__ __forceinline__ void glds16(const void* gsrc, unsigned lds_dst) { unsigned keep;
    asm volatile("s_mov_b32 %0, m0\n\ts_mov_b32 m0, %2\n\ts_nop 0\n\tglobal_load_lds_dwordx4 %1, off\n\ts_mov_b32 m0, %0" : "=&s"(keep) : "v"(gsrc), "s"(lds_dst) : "memory"); }
__device__ __forceinline__ float rowmax(const f32x16& p0, const f32x16& p1) {
    float a = fmaxf(p0[0], p1[0]);
#pragma unroll
    for (int r = 1; r < 16; ++r) a = fmaxf(a, fmaxf(p0[r], p1[r]));
    auto rr = __builtin_amdgcn_permlane32_swap(__float_as_uint(a), __float_as_uint(a), false, false);
    return fmaxf(__uint_as_float(rr[0]), __uint_as_float(rr[1]));
}
typedef short v4i16_t __attribute__((ext_vector_type(4)));
__device__ __forceinline__ s16x4 vtr(const LAS unsigned char* p) { return __builtin_bit_cast(s16x4, __builtin_amdgcn_ds_read_tr16_b64_v4i16((LAS v4i16_t*)p)); }
__device__ __forceinline__ void pv(f32x16* o, const LAS unsigned char* vp, bf16x8 pa0, bf16x8 pa1, bf16x8 pa2, bf16x8 pa3) {
#pragma unroll
    for (int d0 = 0; d0 < 2; ++d0) { s16x4 lo[4], hi[4];
#pragma unroll
        for (int ks = 0; ks < 4; ++ks) { lo[ks] = vtr(vp + d0 * 4096 + ks * 1024); hi[ks] = vtr(vp + d0 * 4096 + ks * 1024 + 512); }
#define PK(k) (bf16x8){lo[k][0], lo[k][1], lo[k][2], lo[k][3], hi[k][0], hi[k][1], hi[k][2], hi[k][3]}
        o[d0] = __builtin_amdgcn_mfma_f32_32x32x16_bf16(pa0, PK(0), o[d0], 0, 0, 0);
        o[d0] = __builtin_amdgcn_mfma_f32_32x32x16_bf16(pa1, PK(1), o[d0], 0, 0, 0);
        o[d0] = __builtin_amdgcn_mfma_f32_32x32x16_bf16(pa2, PK(2), o[d0], 0, 0, 0);
        o[d0] = __builtin_amdgcn_mfma_f32_32x32x16_bf16(pa3, PK(3), o[d0], 0, 0, 0);
#undef PK
    }
}
__device__ __forceinline__ void attn_unit(const bf16_t* Q, const bf16_t* K, const bf16_t* V, bf16_t* O, int b, int h, int q0, bool isctx, float sink2, LAS unsigned char* shm) {
    const int tid = opaque_tid(), lane = tid & 63, r32 = lane & 31, hi = lane >> 5; const int wid = __builtin_amdgcn_readfirstlane(tid >> 6);
    const int kvh = h >> 2;
    const long qrow = isctx ? (long)T + b * CTXL + wid * 32 : (long)b * SEQ + q0 + wid * 32;
    const unsigned lds0 = (unsigned)(uintptr_t)shm;
    LAS float* wsf = (LAS float*)(shm + LDS_WS) + wid * 64;
    int jlo = 0, nl = 0;
    if (!isctx) { jlo = (q0 == 0) ? 2 : 0; int jhi = (SEQ - q0 + 128) / 64; if (jhi > 8) jhi = 8; nl = jhi - jlo; }
    const int NT = nl + 4;
    const long lat0 = (long)b * SEQ + q0 - 128 + 64 * jlo, ctx0 = (long)T + b * CTXL;
#define TROW(t) ((t) < nl ? lat0 + 64 * (t) : ctx0 + 64 * ((t) - nl))
    const int kcol = kvh * 64 + wid * 8, vcol = kvh * 64 + (wid >> 2) * 32 + (lane & 3) * 8, vrow = 16 * (wid & 3) + (lane >> 2);
    const unsigned kdst = lds0 + LDS_K + wid * 1024, vdst = lds0 + LDS_V + wid * 1024;
#define DMA_KV(t, slot) do { const long tr_ = TROW(t); glds16(K + (tr_ + lane) * 256 + kcol, (unsigned)__builtin_amdgcn_readfirstlane(kdst + (slot) * SLOTB)); \
        glds16(V + (tr_ + vrow) * 256 + vcol, (unsigned)__builtin_amdgcn_readfirstlane(vdst + (slot) * SLOTB)); } while (0)
    DMA_KV(0, 0);
    bf16x8 qr[4];
#pragma unroll
    for (int d0 = 0; d0 < 4; ++d0) { const u32x2 w = *(const GAS u32x2*)((const unsigned char*)Q + (qrow + r32) * 1024 + h * 64 + d0 * 16 + hi * 8);
        const f32x2v a0 = __builtin_amdgcn_cvt_pk_f32_fp8((int)w.x, false), a1 = __builtin_amdgcn_cvt_pk_f32_fp8((int)w.x, true), a2 = __builtin_amdgcn_cvt_pk_f32_fp8((int)w.y, false), a3 = __builtin_amdgcn_cvt_pk_f32_fp8((int)w.y, true);
        u32x4 qw; qw.x = cvt_pk_bf16(a0[0] * (1.f / QSC), a0[1] * (1.f / QSC)); qw.y = cvt_pk_bf16(a1[0] * (1.f / QSC), a1[1] * (1.f / QSC)); qw.z = cvt_pk_bf16(a2[0] * (1.f / QSC), a2[1] * (1.f / QSC)); qw.w = cvt_pk_bf16(a3[0] * (1.f / QSC), a3[1] * (1.f / QSC));
        qr[d0] = __builtin_bit_cast(bf16x8, qw); }
    float mrun = sink2, l_reg = (hi == 0) ? 1.f : 0.f;
    f32x16 negm;
#pragma unroll
    for (int r = 0; r < 16; ++r) negm[r] = -sink2;
    f32x16 o[2];
#pragma unroll
    for (int r = 0; r < 16; ++r) { o[0][r] = 0.f; o[1][r] = 0.f; }
    const LAS unsigned char* vp0 = shm + LDS_V + ((lane >> 4) & 1) * 32 + (lane & 3) * 8 + (4 * hi + ((lane & 15) >> 2)) * 64;
    const int qw = q0 + wid * 32;
    asm volatile("s_waitcnt vmcnt(0) lgkmcnt(0)\n\ts_barrier" ::: "memory");
    for (int t = 0; t < NT; ++t) {
        const int slot = t & 1;
        if (t + 1 < NT) DMA_KV(t + 1, slot ^ 1);
        const bool latt = t < nl;
        const int ks = q0 - 128 + 64 * (jlo + t);
        bool need = true;
        if (latt) need = (ks + 63 >= qw - 128) && (ks <= qw + 31 + 128);
        if (need) {
            f32x16 p0, p1;
            const LAS unsigned char* kb = shm + LDS_K + slot * SLOTB + hi * 1024 + r32 * 16;
#pragma unroll
            for (int d0 = 0; d0 < 4; ++d0) {
                const bf16x8 b0 = *(const LAS bf16x8*)(kb + d0 * 2048), b1 = *(const LAS bf16x8*)(kb + d0 * 2048 + 512);
                if (d0 == 0) { p0 = __builtin_amdgcn_mfma_f32_32x32x16_bf16(b0, qr[0], negm, 0, 0, 0); p1 = __builtin_amdgcn_mfma_f32_32x32x16_bf16(b1, qr[0], negm, 0, 0, 0); }
                else { p0 = __builtin_amdgcn_mfma_f32_32x32x16_bf16(b0, qr[d0], p0, 0, 0, 0); p1 = __builtin_amdgcn_mfma_f32_32x32x16_bf16(b1, qr[d0], p1, 0, 0, 0); } }
            if (latt && !(ks >= qw - 97 && ks <= qw + 65)) {
                const int dq = qw + r32 - ks;
#pragma unroll
                for (int r = 0; r < 16; ++r) { const int d = dq - crow(r, hi); if (d > 128 || d < -128) p0[r] = -INFINITY; if (d - 32 > 128 || d - 32 < -128) p1[r] = -INFINITY; } }
            const float rm = rowmax(p0, p1);
            if (__any(rm > 8.f)) {
                const float delta = fmaxf(rm, 0.f);
                const float alpha = __builtin_amdgcn_exp2f(-delta); l_reg *= alpha; mrun += delta;
#pragma unroll
                for (int r = 0; r < 16; ++r) { p0[r] -= delta; p1[r] -= delta; negm[r] = -mrun; }
                if (hi == 0) wsf[r32] = alpha;
                asm volatile("s_waitcnt lgkmcnt(0)" ::: "memory");
#pragma unroll
                for (int r = 0; r < 16; ++r) { const float f = wsf[crow(r, hi)]; o[0][r] *= f; o[1][r] *= f; }
            }
            float sacc = 0.f;
#pragma unroll
            for (int r = 0; r < 16; ++r) { p0[r] = __builtin_amdgcn_exp2f(p0[r]); p1[r] = __builtin_amdgcn_exp2f(p1[r]); sacc += p0[r] + p1[r]; }
            l_reg += sacc;
            u32x4 pw0, pw1, pw2, pw3;
#define PKW(P, B) cvt_pk_bf16(P[B], P[B + 1])
            pw0 = (u32x4){PKW(p0, 0), PKW(p0, 2), PKW(p0, 4), PKW(p0, 6)}; pw1 = (u32x4){PKW(p0, 8), PKW(p0, 10), PKW(p0, 12), PKW(p0, 14)};
            pw2 = (u32x4){PKW(p1, 0), PKW(p1, 2), PKW(p1, 4), PKW(p1, 6)}; pw3 = (u32x4){PKW(p1, 8), PKW(p1, 10), PKW(p1, 12), PKW(p1, 14)};
#undef PKW
            __builtin_amdgcn_sched_barrier(0);
            pv(o, vp0 + slot * SLOTB, __builtin_bit_cast(bf16x8, pw0), __builtin_bit_cast(bf16x8, pw1), __builtin_bit_cast(bf16x8, pw2), __builtin_bit_cast(bf16x8, pw3));
        }
        asm volatile("s_waitcnt vmcnt(0) lgkmcnt(0)\n\ts_barrier" ::: "memory");
    }
    { auto rr = __builtin_amdgcn_permlane32_swap(__float_as_uint(l_reg), __float_as_uint(l_reg), false, false); l_reg = __uint_as_float(rr[0]) + __uint_as_float(rr[1]); }
    if (hi == 0) wsf[32 + r32] = l_reg;
    asm volatile("s_waitcnt lgkmcnt(0)" ::: "memory");
    float rli[16];
#pragma unroll
    for (int r = 0; r < 16; ++r) rli[r] = __builtin_amdgcn_rcpf(wsf[32 + crow(r, hi)]);
    unsigned char* Ow = (unsigned char*)O + qrow * 1024 + h * 64;
    { LAS unsigned char* stg = shm + LDS_OST + wid * 2048;
#pragma unroll
      for (int r = 0; r < 16; ++r) { const int orow = crow(r, hi);
#pragma unroll
          for (int d0 = 0; d0 < 2; ++d0) stg[orow * 64 + d0 * 32 + r32] = (unsigned char)f2f8(o[d0][r] * rli[r]); }
      asm volatile("s_waitcnt lgkmcnt(0)" ::: "memory");
#pragma unroll
      for (int i = 0; i < 2; ++i) { const int row = i * 16 + (lane >> 2), ch = lane & 3; const u32x4 v = *(const LAS u32x4*)(stg + row * 64 + ch * 16); *(GAS u32x4*)(Ow + (long)row * 1024 + ch * 16) = v; } }
    asm volatile("s_waitcnt lgkmcnt(0)" ::: "memory");
#undef TROW
#undef DMA_KV
}
__device__ __forceinline__ void attn_unit2(const bf16_t* Q, const bf16_t* K, const bf16_t* V, bf16_t* O, int b, int h0, int q0, bool isctx, float sinkA, float sinkB, LAS unsigned char* shm) {
    const int tid = opaque_tid(), lane = tid & 63, r32 = lane & 31, hi = lane >> 5; const int wid = __builtin_amdgcn_readfirstlane(tid >> 6);
    const int kvh = h0 >> 2;
    const long qrow = isctx ? (long)T + b * CTXL + wid * 32 : (long)b * SEQ + q0 + wid * 32;
    const unsigned lds0 = (unsigned)(uintptr_t)shm;
    LAS float* wsf = (LAS float*)(shm + LDS_WS) + wid * 64;
    int jlo = 0, nl = 0;
    if (!isctx) { jlo = (q0 == 0) ? 2 : 0; int jhi = (SEQ - q0 + 128) / 64; if (jhi > 8) jhi = 8; nl = jhi - jlo; }
    const int NT = nl + 4;
    const long lat0 = (long)b * SEQ + q0 - 128 + 64 * jlo, ctx0 = (long)T + b * CTXL;
#define TROW(t) ((t) < nl ? lat0 + 64 * (t) : ctx0 + 64 * ((t) - nl))
    const int kcol = kvh * 64 + wid * 8, vcol = kvh * 64 + (wid >> 2) * 32 + (lane & 3) * 8, vrow = 16 * (wid & 3) + (lane >> 2);
    const unsigned kdst = lds0 + LDS_K + wid * 1024, vdst = lds0 + LDS_V + wid * 1024;
#define DMA_KV(t, slot) do { const long tr_ = TROW(t); glds16(K + (tr_ + lane) * 256 + kcol, (unsigned)__builtin_amdgcn_readfirstlane(kdst + (slot) * SLOTB)); \
        glds16(V + (tr_ + vrow) * 256 + vcol, (unsigned)__builtin_amdgcn_readfirstlane(vdst + (slot) * SLOTB)); } while (0)
    DMA_KV(0, 0);
    bf16x8 qr[2][4];
#pragma unroll
    for (int hh = 0; hh < 2; ++hh)
#pragma unroll
        for (int d0 = 0; d0 < 4; ++d0) { const u32x2 w = *(const GAS u32x2*)((const unsigned char*)Q + (qrow + r32) * 1024 + (h0 + hh) * 64 + d0 * 16 + hi * 8);
            const f32x2v a0 = __builtin_amdgcn_cvt_pk_f32_fp8((int)w.x, false), a1 = __builtin_amdgcn_cvt_pk_f32_fp8((int)w.x, true), a2 = __builtin_amdgcn_cvt_pk_f32_fp8((int)w.y, false), a3 = __builtin_amdgcn_cvt_pk_f32_fp8((int)w.y, true);
            u32x4 qw; qw.x = cvt_pk_bf16(a0[0] * (1.f / QSC), a0[1] * (1.f / QSC)); qw.y = cvt_pk_bf16(a1[0] * (1.f / QSC), a1[1] * (1.f / QSC)); qw.z = cvt_pk_bf16(a2[0] * (1.f / QSC), a2[1] * (1.f / QSC)); qw.w = cvt_pk_bf16(a3[0] * (1.f / QSC), a3[1] * (1.f / QSC));
            qr[hh][d0] = __builtin_bit_cast(bf16x8, qw); }
    float mrun[2] = {sinkA, sinkB}, l_reg[2] = {(hi == 0) ? 1.f : 0.f, (hi == 0) ? 1.f : 0.f};
    f32x16 o[2][2];
#pragma unroll
    for (int hh = 0; hh < 2; ++hh)
#pragma unroll
        for (int r = 0; r < 16; ++r) { o[hh][0][r] = 0.f; o[hh][1][r] = 0.f; }
    const LAS unsigned char* vp0 = shm + LDS_V + ((lane >> 4) & 1) * 32 + (lane & 3) * 8 + (4 * hi + ((lane & 15) >> 2)) * 64;
    const int qw = q0 + wid * 32;
    asm volatile("s_waitcnt vmcnt(0) lgkmcnt(0)\n\ts_barrier" ::: "memory");
    for (int t = 0; t < NT; ++t) {
        const int slot = t & 1;
        if (t + 1 < NT) DMA_KV(t + 1, slot ^ 1);
        const bool latt = t < nl;
        const int ks = q0 - 128 + 64 * (jlo + t);
        bool need = true;
        if (latt) need = (ks + 63 >= qw - 128) && (ks <= qw + 31 + 128);
        if (need) {
            f32x16 p[2][2];
            { f32x16 nm0, nm1;
#pragma unroll
              for (int r = 0; r < 16; ++r) { nm0[r] = -mrun[0]; nm1[r] = -mrun[1]; }
              const LAS unsigned char* kb = shm + LDS_K + slot * SLOTB + hi * 1024 + r32 * 16;
#pragma unroll
              for (int d0 = 0; d0 < 4; ++d0) {
                const bf16x8 b0 = *(const LAS bf16x8*)(kb + d0 * 2048), b1 = *(const LAS bf16x8*)(kb + d0 * 2048 + 512);
                if (d0 == 0) { p[0][0] = __builtin_amdgcn_mfma_f32_32x32x16_bf16(b0, qr[0][0], nm0, 0, 0, 0); p[0][1] = __builtin_amdgcn_mfma_f32_32x32x16_bf16(b1, qr[0][0], nm0, 0, 0, 0);
                               p[1][0] = __builtin_amdgcn_mfma_f32_32x32x16_bf16(b0, qr[1][0], nm1, 0, 0, 0); p[1][1] = __builtin_amdgcn_mfma_f32_32x32x16_bf16(b1, qr[1][0], nm1, 0, 0, 0); }
                else {
#pragma unroll
                    for (int hh = 0; hh < 2; ++hh) { p[hh][0] = __builtin_amdgcn_mfma_f32_32x32x16_bf16(b0, qr[hh][d0], p[hh][0], 0, 0, 0); p[hh][1] = __builtin_amdgcn_mfma_f32_32x32x16_bf16(b1, qr[hh][d0], p[hh][1], 0, 0, 0); } } } }
            if (latt && !(ks >= qw - 97 && ks <= qw + 65)) {
                const int dq = qw + r32 - ks;
#pragma unroll
                for (int r = 0; r < 16; ++r) { const int d = dq - crow(r, hi);
                    if (d > 128 || d < -128) { p[0][0][r] = -INFINITY; p[1][0][r] = -INFINITY; }
                    if (d - 32 > 128 || d - 32 < -128) { p[0][1][r] = -INFINITY; p[1][1][r] = -INFINITY; } } }
            u32x4 pw[2][4];
#pragma unroll
            for (int hh = 0; hh < 2; ++hh) {
                bool big = false;
#pragma unroll
                for (int r = 0; r < 16; ++r) big = big | (__builtin_bit_cast(int, p[hh][0][r]) > 0x41000000) | (__builtin_bit_cast(int, p[hh][1][r]) > 0x41000000);
                if (__any(big)) {
                    const float rm = rowmax(p[hh][0], p[hh][1]);
                    const float delta = fmaxf(rm, 0.f);
                    const float alpha = __builtin_amdgcn_exp2f(-delta); l_reg[hh] *= alpha; mrun[hh] += delta;
#pragma unroll
                    for (int r = 0; r < 16; ++r) { p[hh][0][r] -= delta; p[hh][1][r] -= delta; }
                    if (hi == 0) wsf[r32] = alpha;
                    asm volatile("s_waitcnt lgkmcnt(0)" ::: "memory");
#pragma unroll
                    for (int r = 0; r < 16; ++r) { const float f = wsf[crow(r, hi)]; o[hh][0][r] *= f; o[hh][1][r] *= f; }
                    asm volatile("s_waitcnt lgkmcnt(0)" ::: "memory");
                }
                float sacc = 0.f;
#pragma unroll
                for (int r = 0; r < 16; ++r) { p[hh][0][r] = __builtin_amdgcn_exp2f(p[hh][0][r]); p[hh][1][r] = __builtin_amdgcn_exp2f(p[hh][1][r]); sacc += p[hh][0][r] + p[hh][1][r]; }
                l_reg[hh] += sacc;
#define PKW(P, B) cvt_pk_bf16(P[B], P[B + 1])
                pw[hh][0] = (u32x4){PKW(p[hh][0], 0), PKW(p[hh][0], 2), PKW(p[hh][0], 4), PKW(p[hh][0], 6)}; pw[hh][1] = (u32x4){PKW(p[hh][0], 8), PKW(p[hh][0], 10), PKW(p[hh][0], 12), PKW(p[hh][0], 14)};
                pw[hh][2] = (u32x4){PKW(p[hh][1], 0), PKW(p[hh][1], 2), PKW(p[hh][1], 4), PKW(p[hh][1], 6)}; pw[hh][3] = (u32x4){PKW(p[hh][1], 8), PKW(p[hh][1], 10), PKW(p[hh][1], 12), PKW(p[hh][1], 14)};
#undef PKW
            }
            __builtin_amdgcn_sched_barrier(0);
            { const LAS unsigned char* vp = vp0 + slot * SLOTB;
#pragma unroll
              for (int d0 = 0; d0 < 2; ++d0) { s16x4 lo[4], hh4[4];
#pragma unroll
                for (int k4 = 0; k4 < 4; ++k4) { lo[k4] = vtr(vp + d0 * 4096 + k4 * 1024); hh4[k4] = vtr(vp + d0 * 4096 + k4 * 1024 + 512); }
#pragma unroll
                for (int hh = 0; hh < 2; ++hh)
#pragma unroll
                    for (int k4 = 0; k4 < 4; ++k4) { const bf16x8 vb8 = (bf16x8){lo[k4][0], lo[k4][1], lo[k4][2], lo[k4][3], hh4[k4][0], hh4[k4][1], hh4[k4][2], hh4[k4][3]};
                        o[hh][d0] = __builtin_amdgcn_mfma_f32_32x32x16_bf16(__builtin_bit_cast(bf16x8, pw[hh][k4]), vb8, o[hh][d0], 0, 0, 0); } } }
        }
        asm volatile("s_waitcnt vmcnt(0) lgkmcnt(0)\n\ts_barrier" ::: "memory");
    }
#pragma unroll
    for (int hh = 0; hh < 2; ++hh) {
        float lr = l_reg[hh];
        { auto rr = __builtin_amdgcn_permlane32_swap(__float_as_uint(lr), __float_as_uint(lr), false, false); lr = __uint_as_float(rr[0]) + __uint_as_float(rr[1]); }
        if (hi == 0) wsf[32 + r32] = lr;
        asm volatile("s_waitcnt lgkmcnt(0)" ::: "memory");
        float rli[16];
#pragma unroll
        for (int r = 0; r < 16; ++r) rli[r] = __builtin_amdgcn_rcpf(wsf[32 + crow(r, hi)]);
        asm volatile("s_waitcnt lgkmcnt(0)" ::: "memory");
        unsigned char* Ow = (unsigned char*)O + qrow * 1024 + (h0 + hh) * 64;
        LAS unsigned char* stg = shm + LDS_OST + wid * 4096 + hh * 2048;
#pragma unroll
        for (int r = 0; r < 16; ++r) { const int orow = crow(r, hi);
#pragma unroll
            for (int d0 = 0; d0 < 2; ++d0) stg[orow * 64 + d0 * 32 + r32] = (unsigned char)f2f8(o[hh][d0][r] * rli[r]); }
        asm volatile("s_waitcnt lgkmcnt(0)" ::: "memory");
#pragma unroll
        for (int i = 0; i < 2; ++i) { const int row = i * 16 + (lane >> 2), ch = lane & 3; const u32x4 v = *(const LAS u32x4*)(stg + row * 64 + ch * 16); *(GAS u32x4*)(Ow + (long)row * 1024 + ch * 16) = v; }
    }
    asm volatile("s_waitcnt lgkmcnt(0)" ::: "memory");
#undef TROW
#undef DMA_KV
}
}

struct Args {
    const float* in[20];
    float* out; unsigned char* ws;
};
struct Frame {
    LAS unsigned char* lds; unsigned* ctl; unsigned char* ws;
    int tid, lane, wave, gw;
    int blk;
    __device__ __forceinline__ void refresh() { tid = opaque_tid(); lane = tid & 63; wave = __builtin_amdgcn_readfirstlane(tid >> 6); gw = blk * 8 + wave;
        asm volatile("" : "+s"(ws)); ctl = (unsigned*)(ws + WS_CTL); }
};
constexpr int NGW = GRID * NWAVES;

struct Row { f32x4 v[4]; };
__device__ __forceinline__ int vq(int q, int lane) { return 64 * (lane >> 4) + 2 * (lane & 15) + 32 * (q >> 1) + (q & 1); }
__device__ __forceinline__ int vb(int j, int lane) { return 32 * (lane >> 4) + (lane & 15) + 16 * j; }
__device__ __forceinline__ void row_load_bf16(Row& r, const bf16_t* p, int lane) {
#pragma unroll
    for (int j = 0; j < 2; ++j) { const u32x4 w = ((const GAS u32x4*)p)[vb(j, lane)]; r.v[2 * j] = (f32x4){bflo(w.x), bfhi(w.x), bflo(w.y), bfhi(w.y)}; r.v[2 * j + 1] = (f32x4){bflo(w.z), bfhi(w.z), bflo(w.w), bfhi(w.w)}; } }
__device__ __forceinline__ void row_store_bf16(const Row& r, bf16_t* p, int lane) {
#pragma unroll
    for (int j = 0; j < 2; ++j) { u32x4 w; w.x = pk2(r.v[2 * j][0], r.v[2 * j][1]); w.y = pk2(r.v[2 * j][2], r.v[2 * j][3]); w.z = pk2(r.v[2 * j + 1][0], r.v[2 * j + 1][1]); w.w = pk2(r.v[2 * j + 1][2], r.v[2 * j + 1][3]); ((GAS u32x4*)p)[vb(j, lane)] = w; } }
__device__ __forceinline__ void row_load_fp8(Row& r, const unsigned char* p, int lane) {
    const u32x4 w = __builtin_nontemporal_load((const GAS u32x4*)p + lane);
#pragma unroll
    for (int q = 0; q < 4; ++q) { const f32x2v lo = __builtin_amdgcn_cvt_pk_f32_fp8((int)w[q], false), hi = __builtin_amdgcn_cvt_pk_f32_fp8((int)w[q], true); r.v[q] = (f32x4){lo[0], lo[1], hi[0], hi[1]}; } }
__device__ __forceinline__ void row_store_fp8(const Row& r, unsigned char* p, int lane) {
    const int e0 = 256 * (lane >> 4) + 8 * (lane & 15);
#pragma unroll
    for (int j = 0; j < 2; ++j) { int w0 = 0, w1 = 0;
        w0 = __builtin_amdgcn_cvt_pk_fp8_f32(r.v[2 * j][0], r.v[2 * j][1], w0, false); w0 = __builtin_amdgcn_cvt_pk_fp8_f32(r.v[2 * j][2], r.v[2 * j][3], w0, true);
        w1 = __builtin_amdgcn_cvt_pk_fp8_f32(r.v[2 * j + 1][0], r.v[2 * j + 1][1], w1, false); w1 = __builtin_amdgcn_cvt_pk_fp8_f32(r.v[2 * j + 1][2], r.v[2 * j + 1][3], w1, true);
        u32x2 o; o.x = (unsigned)w0; o.y = (unsigned)w1; *(GAS u32x2*)(p + e0 + 128 * j) = o; } }
__device__ __forceinline__ void row_load_f32(Row& r, const float* p, int lane) {
#pragma unroll
    for (int q = 0; q < 4; ++q) r.v[q] = __builtin_nontemporal_load((const GAS f32x4*)p + vq(q, lane)); }
__device__ __forceinline__ void row_store_f32(const Row& r, float* p, int lane) {
#pragma unroll
    for (int q = 0; q < 4; ++q) __builtin_nontemporal_store(r.v[q], (GAS f32x4*)p + vq(q, lane)); }
__device__ __forceinline__ void row_normalize(Row& r, float eps) {
    float s = 0.f;
#pragma unroll
    for (int j = 0; j < 4; ++j) s += (r.v[j][0] + r.v[j][1]) + (r.v[j][2] + r.v[j][3]);
    const float mean = wave_sum(s) * (1.f / D); float q = 0.f;
#pragma unroll
    for (int j = 0; j < 4; ++j) { r.v[j] = r.v[j] - mean; q += (r.v[j][0] * r.v[j][0] + r.v[j][1] * r.v[j][1]) + (r.v[j][2] * r.v[j][2] + r.v[j][3] * r.v[j][3]); }
    const float rstd = 1.f / sqrtf(wave_sum(q) * (1.f / D) + eps);
#pragma unroll
    for (int j = 0; j < 4; ++j) r.v[j] = r.v[j] * rstd;
}
__device__ __forceinline__ void row_normalize_stats(Row& r, float eps, float& mean_o, float& rstd_o) {
    float s = 0.f;
#pragma unroll
    for (int j = 0; j < 4; ++j) s += (r.v[j][0] + r.v[j][1]) + (r.v[j][2] + r.v[j][3]);
    const float mean = wave_sum(s) * (1.f / D); float q = 0.f;
#pragma unroll
    for (int j = 0; j < 4; ++j) { r.v[j] = r.v[j] - mean; q += (r.v[j][0] * r.v[j][0] + r.v[j][1] * r.v[j][1]) + (r.v[j][2] * r.v[j][2] + r.v[j][3] * r.v[j][3]); }
    const float rstd = 1.f / sqrtf(wave_sum(q) * (1.f / D) + eps);
#pragma unroll
    for (int j = 0; j < 4; ++j) r.v[j] = r.v[j] * rstd;
    mean_o = mean; rstd_o = rstd;
}
__device__ __forceinline__ void row_modulate(Row& r, const float* sh, const float* sc, int lane) {
    row_normalize(r, MOD_EPS);
#pragma unroll
    for (int j = 0; j < 4; ++j) { const f32x4 a = ((const GAS f32x4*)sc)[vq(j, lane)], b = ((const GAS f32x4*)sh)[vq(j, lane)]; r.v[j] = r.v[j] * (a + 1.f) + b; }
}
__device__ __forceinline__ int mod_row(int row) { return row < T ? (row >> 11) : 32; }
__device__ __forceinline__ const float* mod_vec(const unsigned char* ws, int layer, int mr, int chunk) { return (const float*)(ws + WS_MOD) + ((size_t)(layer * 33 + mr) * 6 + chunk) * 1024; }

__device__ __forceinline__ void conv_item(const float* W, int N, bf16_t* WT, int Kd, int kd0, int n0, int drow0, bool mirror, LAS float* scr, int lane) {
#pragma unroll 8
    for (int i = 0; i < 32; ++i) { const int kk = 2 * i + (lane >> 5); const int kd = kd0 + kk; const int ks = mirror ? ((kd & ~255) + ((256 - (kd & 255)) & 255)) : kd;
        scr[kk * 33 + (lane & 31)] = ((const GAS float*)W)[(size_t)ks * N + n0 + (lane & 31)]; }
    LDS_WAIT(); asm volatile("" ::: "memory");
    const int c = lane & 7;
#pragma unroll
    for (int j = 0; j < 4; ++j) { const int n = (lane >> 3) + 8 * j; const LAS float* s = scr + (8 * c) * 33 + n;
        u32x4 o; o.x = pk2(s[0 * 33], s[1 * 33]); o.y = pk2(s[2 * 33], s[3 * 33]); o.z = pk2(s[4 * 33], s[5 * 33]); o.w = pk2(s[6 * 33], s[7 * 33]);
        *(GAS u32x4*)(WT + (size_t)(drow0 + n) * Kd + kd0 + 8 * c) = o; }
    LDS_WAIT(); asm volatile("" ::: "memory");
}
__device__ __forceinline__ void conv_matrix_item(const float* W, int K, int N, bf16_t* WT, int mode, int roff, int item, LAS float* scr, int lane) {
    const int nblk = N / 32, kb = item / nblk, nb = item % nblk, n0 = 32 * nb;
    int drow0 = n0 + roff; if (mode == 1) drow0 = (n0 >> 7) * 256 + (n0 & 127); if (mode == 2) drow0 = (n0 >> 7) * 256 + 128 + (n0 & 127);
    conv_item(W, N, WT, K, 64 * kb, n0, drow0, mode == 3, scr, lane);
}
__device__ __forceinline__ void conv_item64(const float* W, int N, bf16_t* WT, int Kd, int k0, int n0, int drow0, LAS bf16_t* scr, int lane) {
    f32x4 v[16];
#pragma unroll
    for (int i = 0; i < 16; ++i) v[i] = *(const GAS f32x4*)(W + (size_t)(k0 + 4 * i + (lane >> 4)) * N + n0 + (lane & 15) * 4);
#pragma unroll
    for (int i = 0; i < 16; ++i) { u32x2 w; w.x = pk2(v[i][0], v[i][1]); w.y = pk2(v[i][2], v[i][3]); *(LAS u32x2*)(scr + (4 * i + (lane >> 4)) * 68 + (lane & 15) * 4) = w; }
    LDS_WAIT(); asm volatile("" ::: "memory");
    const int c = lane & 7;
#pragma unroll
    for (int j = 0; j < 8; ++j) { const int n = (lane >> 3) + 8 * j; const LAS bf16_t* p = scr + (8 * c) * 68 + n;
        u32x4 o; o.x = (unsigned)p[0] | ((unsigned)p[68] << 16); o.y = (unsigned)p[2 * 68] | ((unsigned)p[3 * 68] << 16); o.z = (unsigned)p[4 * 68] | ((unsigned)p[5 * 68] << 16); o.w = (unsigned)p[6 * 68] | ((unsigned)p[7 * 68] << 16);
        *(GAS u32x4*)(WT + (size_t)(drow0 + n) * Kd + k0 + 8 * c) = o; }
    LDS_WAIT(); asm volatile("" ::: "memory");
}
__device__ __forceinline__ void conv_item64_f8(const float* W, int N, unsigned char* WT, int Kd, int k0, int n0, int drow0, LAS unsigned char* scr, int lane, bool mirror = false) {
    f32x4 v[16];
#pragma unroll
    for (int i = 0; i < 16; ++i) { const int kd = k0 + 4 * i + (lane >> 4); const int ks = mirror ? ((kd & ~255) + ((256 - (kd & 255)) & 255)) : kd; v[i] = __builtin_nontemporal_load((const GAS f32x4*)(W + (size_t)ks * N + n0 + (lane & 15) * 4)); }
#pragma unroll
    for (int i = 0; i < 16; ++i) { int w = 0; w = __builtin_amdgcn_cvt_pk_fp8_f32(v[i][0] * 64.f, v[i][1] * 64.f, w, false); w = __builtin_amdgcn_cvt_pk_fp8_f32(v[i][2] * 64.f, v[i][3] * 64.f, w, true);
        *(LAS unsigned*)(scr + (4 * i + (lane >> 4)) * 68 + (lane & 15) * 4) = (unsigned)w; }
    LDS_WAIT(); asm volatile("" ::: "memory");
    const int c = lane & 3;
#pragma unroll
    for (int j = 0; j < 4; ++j) { const int n = (lane >> 2) + 16 * j; const LAS unsigned char* p = scr + (16 * c) * 68 + n; u32x4 o;
#pragma unroll
        for (int q = 0; q < 4; ++q) o[q] = (unsigned)p[(4 * q) * 68] | ((unsigned)p[(4 * q + 1) * 68] << 8) | ((unsigned)p[(4 * q + 2) * 68] << 16) | ((unsigned)p[(4 * q + 3) * 68] << 24);
        *(GAS u32x4*)(WT + (size_t)(drow0 + n) * Kd + k0 + 16 * c) = o; }
    LDS_WAIT(); asm volatile("" ::: "memory");
}
__device__ __forceinline__ void conv_experts(Frame& F, const Args& a, int layer) {
    F.refresh();
    LAS unsigned char* scr = F.lds + 32768 + F.wave * 4352;
    unsigned char* EGU = F.ws + WS_EGU; unsigned char* ED = F.ws + WS_ED;
    for (int it = F.gw; it < (NE + 1) * 192; it += NGW) { const int e = it / 192, r = it % 192;
        const float* wg = e < NE ? a.in[14] + ((size_t)layer * NE + e) * 262144 : a.in[17] + (size_t)layer * 262144;
        const float* wu = e < NE ? a.in[15] + ((size_t)layer * NE + e) * 262144 : a.in[18] + (size_t)layer * 262144;
        const float* wd = e < NE ? a.in[16] + ((size_t)layer * NE + e) * 262144 : a.in[19] + (size_t)layer * 262144;
        if (r < 128) { const int q = r & 63, kb = q >> 2, nb = q & 3, n0 = 64 * nb; const int drow0 = (n0 >> 7) * 256 + (r < 64 ? 0 : 128) + (n0 & 127);
            conv_item64_f8(r < 64 ? wg : wu, 256, EGU + (size_t)e * 512 * 1024, 1024, 64 * kb, n0, drow0, scr, F.lane); }
        else { const int q = r - 128, kb = q >> 4, nb = q & 15; conv_item64_f8(wd, 1024, ED + (size_t)e * 1024 * 256, 256, 64 * kb, 64 * nb, 64 * nb, scr, F.lane); } }
}
__device__ __forceinline__ void conv_small(Frame& F, const Args& a) {
    F.refresh();
    { LAS unsigned char* scr8 = F.lds + 32768 + F.wave * 4352;
      for (int it = F.gw; it < 2304; it += NGW) {
          if (it < 768) { const int j = it / 384, r = it % 384, kb = r / 24, nb = r % 24; conv_item64_f8(a.in[8] + (size_t)j * 1024 * 1536, 1536, F.ws + WS_WQKV + (size_t)j * 1536 * 1024, 1024, 64 * kb, 64 * nb, 64 * nb, scr8, F.lane); }
          else if (it < 1280) { const int q = it - 768, j = q >> 8, r = q & 255, kb = r >> 4, nb = r & 15; conv_item64_f8(a.in[9] + (size_t)j * 1024 * 1024, 1024, F.ws + WS_WO + (size_t)j * 1024 * 1024, 1024, 64 * kb, 64 * nb, 64 * nb, scr8, F.lane); }
          else { const int q = it - 1280, j = q >> 9, r = q & 511, mir = r >> 8, kb = (r & 255) >> 4, nb = r & 15;
              conv_item64_f8(a.in[11] + (size_t)j * 1024 * 1024, 1024, F.ws + WS_WSH + (size_t)j * 2048 * 1024, 1024, 64 * kb, 64 * nb, 64 * nb + 1024 * mir, scr8, F.lane, mir != 0); } } }
    __syncthreads();
    { LAS float* scr = (LAS float*)(F.lds + 32768 + F.wave * 8448);
      for (int it = F.gw; it < 1152; it += NGW) {
          if (it < 1024) { const int j = it >> 9, r = it & 511; conv_matrix_item(a.in[11] + (size_t)j * 1024 * 1024, 1024, 1024, (bf16_t*)(F.ws + WS_WF) + (size_t)j * 2048 * 1024, 0, 0, r, scr, F.lane); }
          else { const int q = it - 1024, l = q / 32, r = q % 32; conv_matrix_item(a.in[12] + (size_t)l * 1024 * 64, 1024, 64, (bf16_t*)(F.ws + WS_WR) + (size_t)l * 64 * 1024, 0, 0, r, scr, F.lane); } } }
    const int gt = F.blk * NTHR + F.tid, NGT = GRID * NTHR;
    const float TWO_PI = 6.283185307179586f;
    { float* rc = (float*)(F.ws + WS_ROPEC); float* rs = (float*)(F.ws + WS_ROPES);
      for (int i = gt; i < 64 * 16; i += NGT) { const int pos = i >> 4, fi = i & 15; const float inv = exp2f(-(float)fi * (13.287712379549449f / 16.f)); const float ang = (float)pos * inv; rc[i] = cosf(ang); rs[i] = sinf(ang); } }
    { unsigned* cs = (unsigned*)(F.ws + WS_CSN);
      for (int i = gt; i < 512 * 64; i += NGT) { const int r = i >> 6, n4 = (i & 63) * 4, m = r & 255; unsigned w = 0;
#pragma unroll
          for (int q = 0; q < 4; ++q) { const float ang = TWO_PI * (float)((m * (n4 + q)) & 255) * (1.f / 256.f); w |= f2f8(r < 256 ? __cosf(ang) : -__sinf(ang)) << (8 * q); }
          cs[i] = w; } }
    { unsigned* dl = (unsigned*)(F.ws + WS_DL);
      for (int i = gt; i < 1024 * 1024; i += NGT) { const int k = i >> 10, c4 = (i & 1023) * 4; unsigned w = 0;
#pragma unroll
          for (int q = 0; q < 4; ++q) { const int c = c4 + q, l = c & 2047; const float ang = TWO_PI * (float)((k * l) & 2047) * (1.f / 2048.f); w |= f2f8(c < 2048 ? __cosf(ang) : __sinf(ang)) << (8 * q); }
          dl[i] = w; } }
    { unsigned* dl = (unsigned*)(F.ws + WS_DLC);
      for (int i = gt; i < 256 * 128; i += NGT) { const int k = i >> 7, c4 = (i & 127) * 4; unsigned w = 0;
#pragma unroll
          for (int q = 0; q < 4; ++q) { const int c = c4 + q, l = c & 255; const float ang = TWO_PI * (float)((k * l) & 255) * (1.f / 256.f); w |= f2f8(c < 256 ? __cosf(ang) : __sinf(ang)) << (8 * q); }
          dl[i] = w; } }
}
__device__ __forceinline__ void mod_full(Frame& F, const Args& a) {
    F.refresh();
    if (F.blk >= 192) return;
    const int l = F.blk / 48, cb = F.blk % 48; const int g = F.tid & 31, ks = F.tid >> 5; const int n0 = cb * 128;
    LAS float* s = (LAS float*)F.lds;
    f32x4 acc[33];
#pragma unroll
    for (int r = 0; r < 33; ++r) acc[r] = (f32x4){0.f, 0.f, 0.f, 0.f};
    for (int half = 0; half < 2; ++half) {
        __syncthreads();
        for (int i = F.tid; i < 512 * 33; i += NTHR) { const int k = i / 33, r = i % 33; const float c = (r < 32) ? a.in[1][(size_t)r * 1024 + half * 512 + k] : a.in[3][half * 512 + k]; s[k * 36 + r] = c / (1.f + __expf(-c)); }
        __syncthreads();
        const GAS f32x4* w = (const GAS f32x4*)((const GAS float*)a.in[4] + ((size_t)l * 1024 + half * 512 + ks * 32) * 6144 + n0 + 4 * g);
#pragma unroll 1
        for (int kb = 0; kb < 32; kb += 8) { f32x4 wv[8];
#pragma unroll
            for (int q = 0; q < 8; ++q) wv[q] = __builtin_nontemporal_load(w + (size_t)(kb + q) * (6144 / 4));
#pragma unroll
            for (int q = 0; q < 8; ++q) { const LAS float* sr = s + (ks * 32 + kb + q) * 36;
#pragma unroll
                for (int r = 0; r < 33; ++r) acc[r] += wv[q] * sr[r];
                asm volatile("" ::: "memory"); } }
    }
    LAS float* red = (LAS float*)F.lds;
    float* mod = (float*)(F.ws + WS_MOD);
#define MF_PASS(r0, nr) do { __syncthreads(); \
        _Pragma("unroll") for (int rr = 0; rr < (nr); ++rr) *(LAS f32x4*)(red + ((ks * 8 + rr) * 128 + 4 * g)) = acc[(r0) + rr]; \
        __syncthreads(); \
        for (int i = F.tid; i < (nr) * 128; i += NTHR) { const int rr = i >> 7, c = i & 127; float t = 0.f; \
            _Pragma("unroll") for (int k2 = 0; k2 < 16; ++k2) t += red[((k2 * 8 + rr) * 128) + c]; \
            mod[((size_t)l * 33 + (r0) + rr) * 6144 + n0 + c] = a.in[5][l * 6144 + n0 + c] + t; } } while (0)
    MF_PASS(0, 8); MF_PASS(8, 8); MF_PASS(16, 8); MF_PASS(24, 8); MF_PASS(32, 1);
#undef MF_PASS
    __syncthreads();
}
__device__ __forceinline__ void rows_init(Frame& F, const Args& a) {
    F.refresh();
    bf16_t* XS = (bf16_t*)(F.ws + WS_XS);
    static_assert(TT % (4 * NGW) == 0, "rows_init: four rows per wave and iteration");
    for (int r0 = F.gw; r0 < TT; r0 += 4 * NGW) {
        Row r[4];
#pragma unroll
        for (int t = 0; t < 4; ++t) { const int row = r0 + t * NGW; row_load_f32(r[t], row < T ? a.in[0] + (size_t)row * D : a.in[2] + (size_t)(row - T) * D, F.lane); }
#pragma unroll
        for (int t = 0; t < 4; ++t) { const int row = r0 + t * NGW; const int mr = mod_row(row);
            row_store_bf16(r[t], XS + (size_t)row * D, F.lane);
            row_modulate(r[t], mod_vec(F.ws, 0, mr, 0), mod_vec(F.ws, 0, mr, 1), F.lane);
            row_store_fp8(r[t], (unsigned char*)a.out + OUT_U8 + (size_t)row * D, F.lane);
            asm volatile("" ::: "memory"); } }
}
__device__ __forceinline__ void rows_post1(Frame& F, const Args& a, int layer, int nrows) {
    F.refresh();
    bf16_t* XS = (bf16_t*)(F.ws + WS_XS); const unsigned char* Y8 = (const unsigned char*)a.out;
    const float* lg = a.in[6] + (size_t)(layer * 2 + 0) * D; const float* lb = a.in[7] + (size_t)(layer * 2 + 0) * D;
    const int TPB = nrows / GRID;
    for (int rl = F.wave; rl < TPB; rl += 4 * NWAVES) {
        u32x4 xr[4][2], yr[4];
#pragma unroll
        for (int t = 0; t < 4; ++t) { const int row = F.blk * TPB + rl + t * NWAVES;
#pragma unroll
            for (int j = 0; j < 2; ++j) xr[t][j] = ((const GAS u32x4*)(XS + (size_t)row * D))[vb(j, F.lane)];
            yr[t] = __builtin_nontemporal_load((const GAS u32x4*)(Y8 + (size_t)row * D) + F.lane); }
#pragma unroll
        for (int t = 0; t < 4; ++t) { const int row = F.blk * TPB + rl + t * NWAVES; const int mr = mod_row(row);
            Row x, y;
#pragma unroll
            for (int j = 0; j < 2; ++j) { const u32x4 w = xr[t][j];
                x.v[2 * j] = (f32x4){bflo(w.x), bfhi(w.x), bflo(w.y), bfhi(w.y)}; x.v[2 * j + 1] = (f32x4){bflo(w.z), bfhi(w.z), bflo(w.w), bfhi(w.w)}; }
#pragma unroll
            for (int q = 0; q < 4; ++q) { const f32x2v lo = __builtin_amdgcn_cvt_pk_f32_fp8((int)yr[t][q], false), hi = __builtin_amdgcn_cvt_pk_f32_fp8((int)yr[t][q], true); y.v[q] = (f32x4){lo[0], lo[1], hi[0], hi[1]}; }
            const float* g1 = mod_vec(F.ws, layer, mr, 2);
#pragma unroll
            for (int j = 0; j < 4; ++j) x.v[j] = x.v[j] * ALPHA + (((const GAS f32x4*)g1)[vq(j, F.lane)] * (1.f / YSC)) * y.v[j];
            row_normalize(x, LN_EPS);
#pragma unroll
            for (int j = 0; j < 4; ++j) x.v[j] = x.v[j] * ((const GAS f32x4*)lg)[vq(j, F.lane)] + ((const GAS f32x4*)lb)[vq(j, F.lane)];
            row_store_bf16(x, XS + (size_t)row * D, F.lane);
            float mean, rstd; row_normalize_stats(x, MOD_EPS, mean, rstd);
            if (F.lane == 0) { f32x2v st = {mean, rstd}; *(GAS f32x2v*)(F.ws + WS_RSTAT + (size_t)row * 8) = st; }
            { const float* sh = mod_vec(F.ws, layer, mr, 3); const float* sc = mod_vec(F.ws, layer, mr, 4);
#pragma unroll
              for (int j = 0; j < 4; ++j) { const f32x4 av = ((const GAS f32x4*)sc)[vq(j, F.lane)], bv = ((const GAS f32x4*)sh)[vq(j, F.lane)]; x.v[j] = x.v[j] * (av + 1.f) + bv; } }
            row_store_fp8(x, (unsigned char*)a.out + OUT_U8 + (size_t)row * D, F.lane);
            asm volatile("" ::: "memory"); }
    }
}
__device__ __forceinline__ void rows_post2(Frame& F, const Args& a, int layer, int t0, int n) {
    F.refresh();
    bf16_t* XS = (bf16_t*)(F.ws + WS_XS); const unsigned char* YB = (const unsigned char*)(F.ws + WS_YB); const unsigned char* YS = (const unsigned char*)(F.ws + WS_YS);
    const int* spos = (const int*)(F.ws + WS_SDST); const float* tkw = (const float*)(F.ws + WS_TKW);
    const float* lg = a.in[6] + (size_t)(layer * 2 + 1) * D; const float* lb = a.in[7] + (size_t)(layer * 2 + 1) * D;
    for (int i0 = F.gw; i0 < n; i0 += 2 * NGW) {
        const int i1 = i0 + NGW; const bool two = i1 < n;
        int pj[2]; float wj[2];
#pragma unroll
        for (int t = 0; t < 2; ++t) { pj[t] = 0; wj[t] = 0.f; const int row = t0 + (t ? i1 : i0); if ((t == 0 || two) && F.lane < 8) { pj[t] = ((const GAS int*)spos)[(size_t)row * 8 + F.lane]; wj[t] = ((const GAS float*)tkw)[(size_t)row * 8 + F.lane]; } }
        Row x[2], y[2];
#pragma unroll
        for (int t = 0; t < 2; ++t) { const int i = t ? i1 : i0; if (t == 0 || two) { row_load_bf16(x[t], XS + (size_t)(t0 + i) * D, F.lane); row_load_fp8(y[t], YS + (size_t)i * D, F.lane); } }
        u32x4 zr[2][8];
#pragma unroll
        for (int t = 0; t < 2; ++t) if (t == 0 || two) {
#pragma unroll
            for (int s = 0; s < 8; ++s) { const int ps = __builtin_amdgcn_readlane(pj[t], s); zr[t][s] = __builtin_nontemporal_load((const GAS u32x4*)(YB + (size_t)ps * D) + F.lane); } }
#pragma unroll
        for (int t = 0; t < 2; ++t) if (t == 0 || two) { const int i = t ? i1 : i0; const int row = t0 + i; const int mr = mod_row(row);
#pragma unroll
            for (int j = 0; j < 4; ++j) y[t].v[j] = y[t].v[j] * (1.f / 16.f);
#pragma unroll
            for (int s = 0; s < 8; ++s) { const float wz = __builtin_bit_cast(float, __builtin_amdgcn_readlane(__builtin_bit_cast(int, wj[t]), s)) * (1.f / 16.f);
#pragma unroll
                for (int j = 0; j < 4; ++j) { const f32x2v lo = __builtin_amdgcn_cvt_pk_f32_fp8((int)zr[t][s][j], false), hi = __builtin_amdgcn_cvt_pk_f32_fp8((int)zr[t][s][j], true); y[t].v[j] += (f32x4){lo[0], lo[1], hi[0], hi[1]} * wz; } }
            const float* g2 = mod_vec(F.ws, layer, mr, 5);
#pragma unroll
            for (int j = 0; j < 4; ++j) x[t].v[j] = x[t].v[j] * ALPHA + ((const GAS f32x4*)g2)[vq(j, F.lane)] * y[t].v[j];
            row_normalize(x[t], LN_EPS);
#pragma unroll
            for (int j = 0; j < 4; ++j) x[t].v[j] = x[t].v[j] * ((const GAS f32x4*)lg)[vq(j, F.lane)] + ((const GAS f32x4*)lb)[vq(j, F.lane)];
            if (layer == 3) { row_store_f32(x[t], a.out + (size_t)row * D, F.lane); }
            else { row_store_bf16(x[t], XS + (size_t)row * D, F.lane);
                row_modulate(x[t], mod_vec(F.ws, layer + 1, mr, 0), mod_vec(F.ws, layer + 1, mr, 1), F.lane);
                row_store_fp8(x[t], (unsigned char*)a.out + OUT_U8 + (size_t)row * D, F.lane); } }
    }
}
__device__ __forceinline__ float wave_max_dpp(float v) {
    int x = __builtin_bit_cast(int, v);
#define DPPMAX(ctrl) { const int y = __builtin_amdgcn_update_dpp(x, x, ctrl, 0xf, 0xf, false); x = __builtin_bit_cast(int, fmaxf(__builtin_bit_cast(float, x), __builtin_bit_cast(float, y))); }
    DPPMAX(0xB1) DPPMAX(0x4E) DPPMAX(0x141) DPPMAX(0x140)
#undef DPPMAX
    const float r0 = __builtin_bit_cast(float, __builtin_amdgcn_readlane(x, 0)), r1 = __builtin_bit_cast(float, __builtin_amdgcn_readlane(x, 16));
    const float r2 = __builtin_bit_cast(float, __builtin_amdgcn_readlane(x, 32)), r3 = __builtin_bit_cast(float, __builtin_amdgcn_readlane(x, 48));
    return fmaxf(fmaxf(r0, r1), fmaxf(r2, r3));
}
__device__ __forceinline__ void route_tokens(Frame& F, const Args& a, int layer, int ntok) {
    F.refresh();
    const int TPB = ntok / GRID;
    const bf16_t* U = (const bf16_t*)(F.ws + WS_XS); const bf16_t* Wr = (const bf16_t*)(F.ws + WS_WR) + (size_t)layer * 64 * 1024;
    int* tke = (int*)(F.ws + WS_TKE); float* tkw = (float*)(F.ws + WS_TKW);
    LAS int* lcnt = (LAS int*)(F.lds + L_LCNT);
    LAS float* lg = (LAS float*)(F.lds);
    if (F.tid < 64) lcnt[F.tid] = 0;
    const int lane = F.lane, fr = lane & 15, fq = lane >> 4;
    const int ntile = TPB / 16;
    constexpr int WPITCH = 1040; constexpr int L_SE = 122880;
    LAS float* sEb = (LAS float*)(F.lds + L_SE);
    f32x4 acc[3][4];
#pragma unroll
    for (int i = 0; i < 3; ++i)
#pragma unroll
        for (int n = 0; n < 4; ++n) acc[i][n] = (f32x4){0.f, 0.f, 0.f, 0.f};
    int grp_of[3] = {0, 0, 0};
    int tl_lo = 0, g = 0;
    while (tl_lo < ntile) {
        const int mr = mod_row(F.blk * TPB + tl_lo * 16); int tl_hi = tl_lo + 1;
        while (tl_hi < ntile && mod_row(F.blk * TPB + tl_hi * 16) == mr) ++tl_hi;
        const float* shv = mod_vec(F.ws, layer, mr, 3); const float* scv = mod_vec(F.ws, layer, mr, 4);
        for (int half = 0; half < 2; ++half) {
            __syncthreads();
            { const int kc = lane, k = half * 512 + kc * 8;
              const f32x4 c0 = *(const GAS f32x4*)(scv + k) + 1.f, c1 = *(const GAS f32x4*)(scv + k + 4) + 1.f, h0 = *(const GAS f32x4*)(shv + k), h1 = *(const GAS f32x4*)(shv + k + 4);
              u32x4 wv[8];
#pragma unroll
              for (int j = 0; j < 8; ++j) wv[j] = *(const GAS u32x4*)(Wr + (size_t)(F.wave + 8 * j) * D + k);
#pragma unroll
              for (int j = 0; j < 8; ++j) { const int e = F.wave + 8 * j; const u32x4 w = wv[j];
                const float w0 = bflo(w.x), w1 = bfhi(w.x), w2 = bflo(w.y), w3 = bfhi(w.y), w4 = bflo(w.z), w5 = bfhi(w.z), w6 = bflo(w.w), w7 = bfhi(w.w);
                u32x4 o; o.x = cvt_pk_bf16(w0 * c0[0], w1 * c0[1]); o.y = cvt_pk_bf16(w2 * c0[2], w3 * c0[3]); o.z = cvt_pk_bf16(w4 * c1[0], w5 * c1[1]); o.w = cvt_pk_bf16(w6 * c1[2], w7 * c1[3]);
                *(LAS u32x4*)(F.lds + e * WPITCH + kc * 16) = o;
                const float se = wave_sum(((bflo(o.x) + bfhi(o.x)) + (bflo(o.y) + bfhi(o.y))) + ((bflo(o.z) + bfhi(o.z)) + (bflo(o.w) + bfhi(o.w))));
                const float be = wave_sum(((w0 * h0[0] + w1 * h0[1]) + (w2 * h0[2] + w3 * h0[3])) + ((w4 * h1[0] + w5 * h1[1]) + (w6 * h1[2] + w7 * h1[3])));
                if (lane == 0) { if (half == 0) { sEb[g * 64 + e] = se; sEb[192 + g * 64 + e] = be; } else { sEb[g * 64 + e] += se; sEb[192 + g * 64 + e] += be; } }
                asm volatile("" ::: "memory"); } }
            __syncthreads();
#pragma unroll
            for (int i = 0; i < 3; ++i) { const int tl = F.wave + 8 * i;
                if (tl >= tl_lo && tl < tl_hi) { const int t0 = F.blk * TPB + tl * 16;
                    const GAS bf16x8* ap = (const GAS bf16x8*)(U + (size_t)(t0 + fr) * D + half * 512 + fq * 8);
                    bf16x8 av[16];
#pragma unroll
                    for (int ks = 0; ks < 16; ++ks) av[ks] = ap[ks * 4];
#pragma unroll
                    for (int ks = 0; ks < 16; ++ks) {
#pragma unroll
                        for (int n = 0; n < 4; ++n) { const bf16x8 bv = *(const LAS bf16x8*)(F.lds + (n * 16 + fr) * WPITCH + (ks * 32 + fq * 8) * 2); acc[i][n] = __builtin_amdgcn_mfma_f32_16x16x32_bf16(av[ks], bv, acc[i][n], 0, 0, 0); }
                        if ((ks & 1) == 1) __builtin_amdgcn_sched_barrier(0); }
                    grp_of[i] = g; } }
        }
        tl_lo = tl_hi; ++g;
    }
    __syncthreads();
#pragma unroll
    for (int i = 0; i < 3; ++i) { const int tl = F.wave + 8 * i;
        if (tl < ntile) { const int t0 = F.blk * TPB + tl * 16; const int gi = grp_of[i];
#pragma unroll
            for (int j = 0; j < 4; ++j) { const f32x2v st = *(const GAS f32x2v*)(F.ws + WS_RSTAT + (size_t)(t0 + fq * 4 + j) * 8);
#pragma unroll
                for (int n = 0; n < 4; ++n) { const float se = sEb[gi * 64 + n * 16 + fr], be = sEb[192 + gi * 64 + n * 16 + fr];
                    lg[(tl * 16 + fq * 4 + j) * 65 + n * 16 + fr] = st[1] * (acc[i][n][j] - st[0] * se) + be; } } } }
    __syncthreads();
    if (F.tid < TPB) {
        const int tok = F.blk * TPB + F.tid; const LAS float* row = lg + F.tid * 65; const float* bias = a.in[13] + layer * 64;
        float sg[64], sel[64];
#pragma unroll
        for (int e = 0; e < 64; ++e) { sg[e] = 1.f / (1.f + __expf(-row[e])); sel[e] = sg[e] + bias[e]; }
        float gs[8];
#pragma unroll
        for (int g = 0; g < 8; ++g) { float m1 = -INFINITY, m2 = -INFINITY;
#pragma unroll
            for (int j = 0; j < 8; ++j) { const float v = sel[g * 8 + j]; const bool gt1 = v > m1; m2 = gt1 ? m1 : fmaxf(m2, v); m1 = gt1 ? v : m1; }
            gs[g] = m1 + m2; }
        unsigned gok = 0;
#pragma unroll
        for (int g = 0; g < 8; ++g) { int rk = 0;
#pragma unroll
            for (int h = 0; h < 8; ++h) rk += (gs[h] > gs[g] || (gs[h] == gs[g] && h < g)) ? 1 : 0;
            gok |= (rk < 4 ? 1u : 0u) << g; }
#pragma unroll
        for (int e = 0; e < 64; ++e) sel[e] = ((gok >> (e >> 3)) & 1u) ? sel[e] : -INFINITY;
        int ce[8]; float cw[8]; float tot = 0.f;
#pragma unroll
        for (int it = 0; it < 8; ++it) { float best = -INFINITY, bs = 0.f; int bi = 0;
#pragma unroll
            for (int e = 0; e < 64; ++e) { const bool b = sel[e] > best; best = b ? sel[e] : best; bs = b ? sg[e] : bs; bi = b ? e : bi; }
#pragma unroll
            for (int e = 0; e < 64; ++e) sel[e] = (e == bi) ? -INFINITY : sel[e];
            ce[it] = bi; cw[it] = bs; tot += bs; }
        const float sc = 2.5f / tot;
#pragma unroll
        for (int it = 0; it < 8; ++it) { tke[(size_t)tok * 8 + it] = ce[it]; tkw[(size_t)tok * 8 + it] = cw[it] * sc; __hip_atomic_fetch_add(&lcnt[ce[it]], 1, __ATOMIC_RELAXED, __HIP_MEMORY_SCOPE_WORKGROUP); }
    }
    __syncthreads();
    if (F.tid < 64) F.ctl[CW_BCNT + F.blk * 64 + F.tid] = (unsigned)lcnt[F.tid];
}
__device__ __forceinline__ void build_lists(Frame& F, int ntok) {
    F.refresh();
    constexpr int NSEG = NCHUNK * 64, BPC = GRID / NCHUNK;
    const int TPB = ntok / GRID, CH = ntok / NCHUNK;
    LAS int* tstart = (LAS int*)(F.lds + L_TSTART); LAS int* pref = (LAS int*)(F.lds + L_PREF); LAS int* lcnt = (LAS int*)(F.lds + L_LCNT);
    LAS unsigned char* tseg = (LAS unsigned char*)(F.lds + L_TSEG); LAS int* scan = (LAS int*)(F.lds + L_SCAN);
    const unsigned* bcnt = F.ctl + CW_BCNT;
    const int myc = F.blk / BPC, mylb = F.blk % BPC;
    int nseg = 0;
    LAS int* cntl = (LAS int*)F.lds;
    for (int i = F.tid; i < GRID * 64; i += NTHR) cntl[i] = (int)((const GAS unsigned*)bcnt)[i];
    if (F.tid < 64) lcnt[F.tid] = 0;
    __syncthreads();
    static_assert(NSEG == 64 && NTHR == 512, "build_lists: one chunk, eight partial sums per expert");
    LAS int* part = (LAS int*)(F.lds + 65536);
    { const int e = F.tid & 63, q = F.tid >> 6; int n = 0, p = 0;
#pragma unroll 8
      for (int lb = q * 32; lb < q * 32 + 32; ++lb) { const int v = cntl[lb * 64 + e]; if (lb < mylb) p += v; n += v; }
      part[q * 64 + e] = n; part[512 + q * 64 + e] = p; }
    __syncthreads();
    if (F.tid < 64) { int n = 0, p = 0;
#pragma unroll
        for (int q = 0; q < 8; ++q) { n += part[q * 64 + F.tid]; p += part[512 + q * 64 + F.tid]; }
        nseg = n; pref[F.tid] = p;
        const int tiles = (n + 255) >> 8; int incl = tiles;
#pragma unroll
        for (int d = 1; d < 64; d <<= 1) { const int o = __shfl_up(incl, d); if (F.lane >= d) incl += o; }
        tstart[F.tid + 1] = incl; if (F.tid == 0) tstart[0] = 0;
        for (int t = incl - tiles; t < incl; ++t) tseg[t] = (unsigned char)F.tid; }
    int* stok = (int*)(F.ws + WS_STOK); int* spos = (int*)(F.ws + WS_SDST);
    const int* tke = (const int*)(F.ws + WS_TKE);
    { const int sseg = myc * 64 + mylb; if (mylb < 64 && F.tid == sseg) scan[0] = nseg; }
    __syncthreads();
    if (mylb < 64) { const int sseg = myc * 64 + mylb; const int n = scan[0]; const int base = tstart[sseg] * 256, end = tstart[sseg + 1] * 256;
      for (int p = base + n + F.tid; p < end; p += NTHR) stok[p] = myc * CH; }
    for (int tb = F.wave * 8; tb < TPB; tb += NWAVES * 8) { const int tl = tb + (F.lane >> 3);
        if (tl < TPB) { const int tok = F.blk * TPB + tl; const int e = tke[(size_t)tok * 8 + (F.lane & 7)];
            const int p = tstart[myc * 64 + e] * 256 + pref[e] + __hip_atomic_fetch_add(&lcnt[e], 1, __ATOMIC_RELAXED, __HIP_MEMORY_SCOPE_WORKGROUP);
            stok[p] = tok; spos[(size_t)tok * 8 + (F.lane & 7)] = p - tstart[myc * 64] * 256; } }
    __syncthreads();
}

struct SchedQKV {
    const char* U; const char* W; int nfull, nu, c;
    __device__ __forceinline__ bool next(int i, pg::Unit& u) const {
        const int L0 = i * GRID + c; if (L0 >= nu) return false;
        int pm, pn;
        if (L0 < nfull) { const int L = pg::xcd_remap(L0, nfull); const int gid = L / 48, w = L % 48; pm = gid * 8 + (w & 7); pn = w >> 3; }
        else { const int q = L0 - nfull; pm = 256 + (q >> 1); pn = 4 + (q & 1); }
        u.A = U + (size_t)pm * 256 * 1024; u.B = W + (size_t)pn * 256 * 1024; u.gidx = nullptr; u.gbase = 0; u.nt = 8; u.out = nullptr; u.ldc = 0; u.scale = 1.f; u.flags = 0; u.i0 = pm; u.i1 = pn;
        return true; }
};
struct SchedDense {
    const char* A; const char* W; char* out; int nrt, nct, nt, c; size_t ldA;
    __device__ __forceinline__ bool next(int i, pg::Unit& u) const {
        const int nu = nrt * nct; const int L0 = i * GRID + c; if (L0 >= nu) return false;
        const int L = pg::xcd_remap(L0, nu); const int per = 8 * nct, gid = L / per, w = L % per, fm = gid * 8, gsz = (nrt - fm) < 8 ? (nrt - fm) : 8; const int pm = fm + (w % gsz), pn = w / gsz;
        u.A = A + (size_t)pm * 256 * ldA; u.B = W + (size_t)pn * 256 * ldA; u.gidx = nullptr; u.gbase = 0; u.nt = nt; u.out = out + (size_t)pm * 256 * 1024; u.ldc = 1024; u.scale = 1.f; u.flags = 0; u.i0 = pm; u.i1 = pn;
        return true; }
};
struct SchedF1 {
    const char* CS; const char* U; char* ABT; char* ABTC; int nu, c;
    __device__ __forceinline__ bool next(int i, pg::Unit& u) const {
        const int L0 = i * GRID + c; if (L0 >= nu) return false;
        u.gidx = nullptr; u.gbase = 0; u.nt = 2; u.scale = 1.f; u.flags = 0; u.i0 = 0; u.i1 = 0;
        if (L0 < 2048) { const int L = pg::xcd_remap(L0, 2048); const int pm = L & 1, pn = (L >> 1) & 7, bg = L >> 4, b = bg >> 2, g = bg & 3;
            u.A = CS + (size_t)pm * 256 * 256; u.B = U + ((size_t)b * SEQ + pn * 256) * 1024 + g * 256; u.out = ABT + (size_t)bg * 256 * 4096 + (size_t)(pm * 2048 + pn * 256); u.ldc = 4096; }
        else { const int q = L0 - 2048; const int pm = q & 1, bg = q >> 1, b = bg >> 2, g = bg & 3;
            u.A = CS + (size_t)pm * 256 * 256; u.B = U + ((size_t)T + b * CTXL) * 1024 + g * 256; u.out = ABTC + (size_t)bg * 256 * 512 + (size_t)pm * 256; u.ldc = 512; }
        return true; }
};
struct SchedF2 {
    const char* DL; const char* ABT; char* FH; int c;
    __device__ __forceinline__ bool next(int i, pg::Unit& u) const {
        const int L0 = i * GRID + c; if (L0 >= 512) return false;
        const int L = pg::xcd_remap(L0, 512); const int pm = L & 3, bg = L >> 2, b = bg >> 2, g = bg & 3;
        u.A = DL + (size_t)pm * 256 * 4096; u.B = ABT + (size_t)bg * 256 * 4096; u.gidx = nullptr; u.gbase = 0; u.nt = 32; u.out = FH + ((size_t)b * 1024 + pm * 256) * 1024 + g * 256; u.ldc = 1024; u.scale = 0.001381067932004975f  ; u.flags = 0; u.i0 = 0; u.i1 = 0;
        return true; }
};
struct SchedF2c {
    const char* DLC; const char* ABTC; char* FC; int c;
    __device__ __forceinline__ bool next(int i, pg::Unit& u) const {
        const int L0 = i * GRID + c; if (L0 >= 128) return false;
        const int bg = L0, b = bg >> 2, g = bg & 3;
        u.A = DLC; u.B = ABTC + (size_t)bg * 256 * 512; u.gidx = nullptr; u.gbase = 0; u.nt = 4; u.out = FC + ((size_t)b * 256) * 1024 + g * 256; u.ldc = 1024; u.scale = 1.f / 256.f; u.flags = 0; u.i0 = 0; u.i1 = 0;
        return true; }
};
struct SchedF3 {
    const char* FH; const char* FC; const char* W; char* Y; int nu, c;
    __device__ __forceinline__ bool next(int i, pg::Unit& u) const {
        const int L0 = i * GRID + c; if (L0 >= nu) return false;
        u.gidx = nullptr; u.gbase = 0; u.nt = 8; u.scale = 1.f; u.flags = 0; u.i0 = 0; u.i1 = 0;
        if (L0 < 1024) { const int L = pg::xcd_remap(L0, 1024); const int gid = L >> 6, w = L & 63, pm = gid * 8 + (w & 7), pn = w >> 3; const int b = pm >> 2, k0 = (pm & 3) * 256;
            u.A = FH + (size_t)pm * 256 * 1024; u.B = W + (size_t)pn * 256 * 1024;
            if (pn < 4) { u.out = Y + ((size_t)b * SEQ + k0) * 1024; u.ldc = 1024; u.i1 = pn; }
            else { u.out = Y + ((size_t)b * SEQ + SEQ - k0) * 1024; u.ldc = -1024; u.i1 = pn - 4; u.flags = (k0 == 0) ? 1 : 0; } }
        else { const int q = L0 - 1024; const int pm = q >> 2, pn = q & 3;
            u.A = FC + (size_t)pm * 256 * 1024; u.B = W + (size_t)pn * 256 * 1024; u.out = Y + ((size_t)T + pm * 256) * 1024; u.ldc = 1024; u.i1 = pn; }
        return true; }
};
struct SchedG1 {
    const char* EGU; const int* STOK; char* H; char* HS; LAS const unsigned char* tseg; int ntl, nsh, c;
    __device__ __forceinline__ bool gsrc(int i, const int*& gidx, int& gbase) const {
        const int nu = (ntl + nsh) * 2; const int L0 = i * GRID + c; if (L0 >= nu) return false;
        const int pm = pg::xcd_remap(L0, nu) >> 1;
        if (pm < ntl) { gidx = STOK + (size_t)pm * 256; gbase = 0; } else { gidx = nullptr; gbase = (pm - ntl) * 256; }
        return true; }
    __device__ __forceinline__ bool next(int i, pg::Unit& u) const {
        const int nu = (ntl + nsh) * 2; const int L0 = i * GRID + c; if (L0 >= nu) return false;
        const int L = pg::xcd_remap(L0, nu); const int pm = L >> 1, pn = L & 1;
        u.A = nullptr; u.gbase = 0; u.nt = 8; u.ldc = 256; u.scale = 1.f; u.flags = 0; u.i0 = 0; u.i1 = 0;
        if (pm < ntl) { const int e = __builtin_amdgcn_readfirstlane((int)tseg[pm]) & 63;
            u.gidx = STOK + (size_t)pm * 256; u.B = EGU + (size_t)e * 512 * 1024 + (size_t)pn * 256 * 1024; u.out = H + (size_t)pm * 256 * 256 + pn * 128; }
        else { const int ps = pm - ntl; u.gidx = nullptr; u.gbase = ps * 256; u.B = EGU + (size_t)NE * 512 * 1024 + (size_t)pn * 256 * 1024; u.out = HS + (size_t)ps * 256 * 256 + pn * 128; }
        return true; }
};
struct SchedG2 {
    const char* ED; const char* H; const char* HS; char* YB; char* YS; LAS const unsigned char* tseg; int t0, t1, nsh, ch, CH, c;
    __device__ __forceinline__ bool next(int i, pg::Unit& u) const {
        const int nr = t1 - t0; const int nu = (nr + nsh) * 4; const int L0 = i * GRID + c; if (L0 >= nu) return false;
        const int L = pg::xcd_remap(L0, nu); const int q = L >> 2, pn = L & 3;
        u.gidx = nullptr; u.gbase = 0; u.nt = 2; u.ldc = 1024; u.scale = 1.f; u.flags = 0; u.i0 = 0; u.i1 = pn;
        if (q < nr) { const int pm = t0 + q; const int e = __builtin_amdgcn_readfirstlane((int)tseg[pm]) & 63;
            u.A = H + (size_t)pm * 256 * 256; u.B = ED + (size_t)e * 1024 * 256 + (size_t)pn * 256 * 256; u.out = YB + (size_t)q * 256 * 1024; }
        else { const int ps = q - nr; u.A = HS + ((size_t)ch * CH + ps * 256) * 256; u.B = ED + (size_t)NE * 1024 * 256 + (size_t)pn * 256 * 256; u.out = YS + (size_t)ps * 256 * 1024; }
        return true; }
};

__device__ __forceinline__ void fnet_nyquist_rows(Frame& F) {
    F.refresh();
    const unsigned char* ABT = F.ws + WS_ABT; bf16_t* FH1 = (bf16_t*)(F.ws + WS_FH1);
    static_assert((128 * 256) % (4 * NGW) == 0, "fnet_nyquist_rows: four rows per wave and step");
    for (int r0 = F.gw; r0 < 128 * 256; r0 += 4 * NGW) {
        u32x4 w[4][2];
#pragma unroll
        for (int t = 0; t < 4; ++t) { const GAS u32x4* p = (const GAS u32x4*)(ABT + (size_t)(r0 + t * NGW) * 4096);
#pragma unroll
            for (int i = 0; i < 2; ++i) w[t][i] = p[i * 64 + F.lane]; }
#pragma unroll
        for (int t = 0; t < 4; ++t) { const int r = r0 + t * NGW; const int bg = r >> 8, m = r & 255, b = bg >> 2, g = bg & 3; float s = 0.f;
#pragma unroll
            for (int i = 0; i < 2; ++i)
#pragma unroll
                for (int q = 0; q < 4; ++q) { const f32x2v lo = __builtin_amdgcn_cvt_pk_f32_fp8((int)w[t][i][q], false), hi = __builtin_amdgcn_cvt_pk_f32_fp8((int)w[t][i][q], true); s += (lo[0] - lo[1]) + (hi[0] - hi[1]); }
            s = wave_sum(s) * 0.001381067932004975f;
            if (F.lane == 0) FH1[(size_t)b * 1024 + g * 256 + m] = (bf16_t)f2bf(s); } }
}
__device__ __forceinline__ void fnet_nyquist_out(Frame& F, const Args& a, int jl) {
    F.refresh();
    const bf16_t* FH1 = (const bf16_t*)(F.ws + WS_FH1); const bf16_t* W = (const bf16_t*)(F.ws + WS_WF) + (size_t)jl * 2048 * 1024; unsigned char* Y = (unsigned char*)a.out;
    LAS float* part = (LAS float*)F.lds;
    const int b = F.blk >> 3, n = (F.blk & 7) * 128 + (F.tid & 127), kq = F.tid >> 7;
    const GAS u32x4* wp = (const GAS u32x4*)(W + (size_t)n * 1024 + kq * 256); const GAS u32x4* fp = (const GAS u32x4*)(FH1 + (size_t)b * 1024 + kq * 256);
    float s = 0.f;
#pragma unroll 4
    for (int i = 0; i < 32; ++i) { const u32x4 w = wp[i], f = fp[i];
        s += bflo(w.x) * bflo(f.x) + bfhi(w.x) * bfhi(f.x) + bflo(w.y) * bflo(f.y) + bfhi(w.y) * bfhi(f.y) + bflo(w.z) * bflo(f.z) + bfhi(w.z) * bfhi(f.z) + bflo(w.w) * bflo(f.w) + bfhi(w.w) * bfhi(f.w); }
    part[F.tid] = s;
    __syncthreads();
    if (F.tid < 128) { const float t = (part[F.tid] + part[F.tid + 128]) + (part[F.tid + 256] + part[F.tid + 384]); const int cc = n & 127;
        Y[((size_t)b * SEQ + 1024) * D + (16 * (n >> 8) + (cc >> 3)) * 16 + 8 * ((n >> 7) & 1) + (cc & 7)] = (unsigned char)f2f8(__builtin_amdgcn_fmed3f(t * YSC, -448.f, 448.f)); }
    __syncthreads();
}


#ifdef SELFCHECK
constexpr int CW_ERR = 1024;
__device__ __forceinline__ void chk_report(unsigned* ctl, int id, float got, float ref, float tabs, float trel) {
    float e = fabsf(got - ref) / (tabs + trel * fabsf(ref)); if (!(e == e)) e = 1e30f; atomicMax(ctl + CW_ERR + id, __float_as_uint(e)); }
__device__ __forceinline__ float bf2f(bf16_t b) { return __builtin_bit_cast(float, (unsigned)b << 16); }
__constant__ int chk_toks[16] = {0, 1, 63, 64, 65, 127, 2047, 2048, 2049, 4096, 33000, 65535, 65536, 65537, 70000, 73727};
__constant__ int chk_ks[8] = {0, 1, 2, 255, 256, 1023, 1024, 700};
__constant__ int chk_ms[4] = {0, 1, 128, 255};
__constant__ int chk_ytoks[10] = {0, 1, 1023, 1024, 1025, 2047, 2048, 65535, 65536, 73727};
__constant__ int chk_ns[5] = {0, 1, 255, 256, 1023};
__constant__ int chk_cols[20] = {0, 7, 15, 16, 31, 32, 40, 48, 63, 64, 500, 1023, 1024, 1039, 1040, 1072, 1279, 1280, 1300, 1535};
__device__ __forceinline__ void chk_qkv(Frame& F, const Args& a, int layer, int id) {
    F.refresh(); const unsigned char* U = (const unsigned char*)a.out + OUT_U8; const float* W = a.in[8] + (size_t)(layer >> 1) * 1024 * 1536;
    const bf16_t* Qb = (const bf16_t*)(F.ws + WS_Q); const bf16_t* Kb = (const bf16_t*)(F.ws + WS_K); const bf16_t* Vb = (const bf16_t*)(F.ws + WS_V);
    for (int s = F.gw; s < 320; s += NGW) { const int tok = chk_toks[s & 15], col = chk_cols[s >> 4];
        if (layer == 2 && tok >= T && col < 1024) continue;
        const bool rope = (tok < T) && col < 1280; const int hc = col & 63, first = (hc & 31) < 16; const int pcol = rope ? (first ? col + 16 : col - 16) : col;
        float x = 0.f, xp = 0.f;
        for (int k = F.lane; k < 1024; k += 64) { const float u = f82f(U[(size_t)tok * D + k]); x += u * W[(size_t)k * 1536 + col]; xp += u * W[(size_t)k * 1536 + pcol]; }
        x = wave_sum(x); xp = wave_sum(xp);
        float ref = x;
        if (rope) { const int tl = tok & 2047, part = hc >> 5, pos = part ? (tl & 63) : (tl >> 6), fi = hc & 15; const float ang = (float)pos * powf(10000.f, -(float)fi / 16.f);
            ref = x * cosf(ang) + (first ? -xp : xp) * sinf(ang); }
        if (col < 1024) ref *= C2;
        const float got = col < 1024 ? bf2f(Qb[(size_t)tok * 1024 + col]) : (col < 1280 ? bf2f(Kb[(size_t)tok * 256 + col - 1024]) : bf2f(Vb[(size_t)tok * 256 + col - 1280]));
        if (F.lane == 0) chk_report(F.ctl, id, got, ref, 0.20f, 0.10f); }
}
__device__ __forceinline__ void chk_attn(Frame& F, const Args& a, int layer, int id) {
    F.refresh(); const bf16_t* Qb = (const bf16_t*)(F.ws + WS_Q); const bf16_t* Kb = (const bf16_t*)(F.ws + WS_K); const bf16_t* Vb = (const bf16_t*)(F.ws + WS_V); const unsigned char* Ob = F.ws + WS_R + 216 * MiB;
    LAS float* lg = (LAS float*)F.lds + F.wave * 1024;
    for (int s = F.gw; s < 64; s += NGW) { const int tok = chk_toks[s & 15], h = (s >> 4) * 5, kvh = h >> 2;
        if (layer == 2 && tok >= T) continue;
        const bool isctx = tok >= T; const int b = isctx ? (tok - T) / CTXL : tok / SEQ, p = tok & (SEQ - 1);
        int nk = 0; const int lo = isctx ? 0 : (p - 128 < 0 ? 0 : p - 128), hi = isctx ? -1 : (p + 128 > SEQ - 1 ? SEQ - 1 : p + 128);
        const int nlat = isctx ? 0 : hi - lo + 1; nk = nlat + CTXL;
        float mx = a.in[10][(layer >> 1) * 16 + h] * LOG2E; const float sink2 = mx;
        for (int i = F.lane; i < nk; i += 64) { const size_t kr = i < nlat ? (size_t)b * SEQ + lo + i : (size_t)T + b * CTXL + (i - nlat); float d = 0.f;
            for (int e = 0; e < 64; ++e) d += bf2f(Qb[(size_t)tok * 1024 + h * 64 + e]) * bf2f(Kb[kr * 256 + kvh * 64 + e]);
            lg[i] = d; mx = fmaxf(mx, d); }
#pragma unroll
        for (int o = 1; o < 64; o <<= 1) mx = fmaxf(mx, __shfl_xor(mx, o));
        LDS_WAIT();
        float den = 0.f; for (int i = F.lane; i < nk; i += 64) den += exp2f(lg[i] - mx);
        den = wave_sum(den) + exp2f(sink2 - mx);
        float o = 0.f;
        for (int i = 0; i < nk; ++i) { const size_t kr = i < nlat ? (size_t)b * SEQ + lo + i : (size_t)T + b * CTXL + (i - nlat); o += exp2f(lg[i] - mx) * bf2f(Vb[kr * 256 + kvh * 64 + F.lane]); }
        o /= den;
        chk_report(F.ctl, id, f82f(Ob[(size_t)tok * 1024 + h * 64 + F.lane]), o, 0.02f, 0.08f); chk_report(F.ctl, 32 + (s & 15), f82f(Ob[(size_t)tok * 1024 + h * 64 + F.lane]), o, 0.02f, 0.08f);
        LDS_WAIT(); }
    __syncthreads();
}
__device__ __forceinline__ void chk_fnet_f(Frame& F, const Args& a, bool upd, int id) {
    F.refresh(); const unsigned char* U = (const unsigned char*)a.out + OUT_U8; LAS float* red = (LAS float*)F.lds;
    for (int s = F.blk; s < 128 + (upd ? 64 : 0); s += GRID) {
        const bool cx = s >= 128; const int q = cx ? s - 128 : s; const int m = chk_ms[q & 3], g = ((q >> 2) & 1) * 3, b = ((q >> 3) & 1) * 31; int k = chk_ks[(q >> 4) & 7]; const int L = cx ? CTXL : SEQ; if (cx) k &= 255;
        const size_t row0 = cx ? (size_t)T + b * CTXL : (size_t)b * SEQ;
        float acc = 0.f;
        for (int l = F.wave; l < L; l += NWAVES) { float ca = 0.f, sa = 0.f;
            for (int n = F.lane; n < 256; n += 64) { const float u = f82f(U[(row0 + l) * D + g * 256 + n]); const float an = 6.283185307179586f * (float)((m * n) & 255) / 256.f; const float sn = __sinf(an), cs = __cosf(an); ca += u * cs; sa += u * sn; }
            ca = wave_sum(ca); sa = wave_sum(sa); const float an = 6.283185307179586f * (float)((k * l) % L) / (float)L; const float sn = __sinf(an), cs = __cosf(an); acc += cs * ca - sn * sa; }
        if (F.lane == 0) red[F.wave] = acc;
        __syncthreads();
        if (F.tid == 0) { float t = 0.f; for (int w = 0; w < NWAVES; ++w) t += red[w]; t *= cx ? (1.f / 256.f) : 0.001381067932004975f;
            float got;
            if (cx) got = f82f((F.ws + WS_FC)[((size_t)b * 256 + k) * D + g * 256 + m]);
            else if (k == 1024) got = bf2f(((const bf16_t*)(F.ws + WS_FH1))[(size_t)b * 1024 + g * 256 + m]);
            else got = f82f((F.ws + WS_FH)[((size_t)b * 1024 + k) * D + g * 256 + m]);
            chk_report(F.ctl, id, got, t, 0.25f, 0.10f); }
        __syncthreads(); }
}
__device__ __forceinline__ void chk_fnet_y(Frame& F, const Args& a, int jl, bool upd, int id) {
    F.refresh(); const bf16_t* Y = (const bf16_t*)a.out; const float* W = a.in[11] + (size_t)jl * 1024 * 1024;
    const unsigned char* FH = F.ws + WS_FH; const bf16_t* FH1 = (const bf16_t*)(F.ws + WS_FH1); const unsigned char* FC = F.ws + WS_FC;
    for (int s = F.gw; s < 50; s += NGW) { const int tok = chk_ytoks[s % 10], n = chk_ns[s / 10]; if (tok >= T && !upd) continue;
        float acc = 0.f;
        for (int j = F.lane; j < 1024; j += 64) { float f;
            if (tok >= T) f = f82f(FC[(size_t)(tok - T) * D + j]);
            else { const int b = tok >> 11, k = tok & 2047; if (k < 1024) f = f82f(FH[((size_t)b * 1024 + k) * D + j]); else if (k == 1024) f = bf2f(FH1[(size_t)b * 1024 + j]);
                else f = f82f(FH[((size_t)b * 1024 + (2048 - k)) * D + (j & ~255) + ((256 - (j & 255)) & 255)]); }
            acc += f * W[(size_t)j * 1024 + n]; }
        acc = wave_sum(acc);
        if (F.lane == 0) chk_report(F.ctl, id, bf2f(Y[(size_t)tok * D + n]), acc, 0.04f, 0.08f); }
}
__device__ __forceinline__ void chk_route(Frame& F, const Args& a, int layer, int ntok, int id) {
    F.refresh(); const bf16_t* U = (const bf16_t*)a.out; const float* Wr = a.in[12] + (size_t)layer * 1024 * 64; const int* tke = (const int*)(F.ws + WS_TKE); const float* tkw = (const float*)(F.ws + WS_TKW);
    for (int s = F.gw; s < 16; s += NGW) { const int tok = chk_toks[s]; if (tok >= ntok) continue; const int lane = F.lane;
        float lgt = 0.f; for (int k = 0; k < 1024; ++k) lgt += bf2f(U[(size_t)tok * D + k]) * Wr[(size_t)k * 64 + lane];
        const float sc = 1.f / (1.f + expf(-lgt)), sel = sc + a.in[13][layer * 64 + lane];
        float g1 = -INFINITY, g2 = -INFINITY;
#pragma unroll 1
        for (int j = 0; j < 8; ++j) { const float v = __shfl(sel, (lane & ~7) + j); if (v > g1) { g2 = g1; g1 = v; } else if (v > g2) g2 = v; }
        const float gs = g1 + g2; int gr = 0;
#pragma unroll 1
        for (int gp = 0; gp < 8; ++gp) { const float v = __shfl(gs, gp * 8); gr += (v > gs || (v == gs && gp < (lane >> 3))) ? 1 : 0; }
        const float sm = gr < 4 ? sel : -INFINITY; int rk = 0;
#pragma unroll 1
        for (int ep = 0; ep < 64; ++ep) { const float v = __shfl(sm, ep); rk += (v > sm || (v == sm && ep < lane)) ? 1 : 0; }
        const float tot = wave_sum(rk < 8 ? sc : 0.f); const float wref = sc / tot * 2.5f;
        int slot = -1; for (int j = 0; j < 8; ++j) if (tke[(size_t)tok * 8 + j] == lane) slot = j;
        float err = 0.f;
        if (slot >= 0) { if (rk >= 10) err = 10.f; else if (rk < 8) err = fabsf(tkw[(size_t)tok * 8 + slot] - wref) / (0.04f * wref); }
        else if (rk < 6) err = 10.f;
        const unsigned long long nsel = __ballot(slot >= 0); if (__builtin_popcountll(nsel) != 8) err = 20.f;
        atomicMax(F.ctl + CW_ERR + id, __float_as_uint(err)); }
}
__device__ __forceinline__ void chk_moe(Frame& F, const Args& a, int layer, int ntok, int ch, int id) {
    F.refresh(); const bf16_t* U = (const bf16_t*)a.out; const int* tke = (const int*)(F.ws + WS_TKE); const float* tkw = (const float*)(F.ws + WS_TKW);
    const int CH = ntok / NCHUNK; LAS float* hs = (LAS float*)F.lds; LAS float* us = hs + 512; LAS float* pg_ = us + 1024;
    for (int s = F.blk; s < 16; s += GRID) { const int tok = chk_toks[s]; if (tok >= ntok || tok / CH != ch) continue;
        for (int k = F.tid; k < 1024; k += NTHR) us[k] = bf2f(U[(size_t)tok * D + k]);
        __syncthreads();
        float y0 = 0.f, y1 = 0.f;
        for (int j = 0; j < 9; ++j) { const int e = j < 8 ? tke[(size_t)tok * 8 + j] : 0; const float w = j < 8 ? tkw[(size_t)tok * 8 + j] : 1.f;
            const float* wg = j < 8 ? a.in[14] + ((size_t)layer * NE + e) * 262144 : a.in[17] + (size_t)layer * 262144;
            const float* wu = j < 8 ? a.in[15] + ((size_t)layer * NE + e) * 262144 : a.in[18] + (size_t)layer * 262144;
            const float* wd = j < 8 ? a.in[16] + ((size_t)layer * NE + e) * 262144 : a.in[19] + (size_t)layer * 262144;
            const int hh = F.tid & 255, half = F.tid >> 8; float g = 0.f, u = 0.f;
            for (int k = half * 512; k < half * 512 + 512; ++k) { g += us[k] * wg[(size_t)k * 256 + hh]; u += us[k] * wu[(size_t)k * 256 + hh]; }
            pg_[F.tid] = g; pg_[512 + F.tid] = u;
            __syncthreads();
            if (F.tid < 256) { const float gg = pg_[F.tid] + pg_[F.tid + 256], uu = pg_[512 + F.tid] + pg_[512 + F.tid + 256]; hs[F.tid] = gg / (1.f + expf(-gg)) * uu; }
            __syncthreads();
            float t0 = 0.f, t1 = 0.f; for (int q = 0; q < 256; ++q) { t0 += hs[q] * wd[(size_t)q * 1024 + F.tid]; t1 += hs[q] * wd[(size_t)q * 1024 + 512 + F.tid]; }
            y0 += w * t0; y1 += w * t1;
            __syncthreads(); }
        float g0 = 0.f, g1 = 0.f; const int i = tok - ch * CH;
        { const unsigned char* YSb = (const unsigned char*)(F.ws + WS_YS); const unsigned char* YBb = (const unsigned char*)(F.ws + WS_YB); const int* spos = (const int*)(F.ws + WS_SDST);
          const int t_ = F.tid, bo = 16 * (16 * (t_ >> 8) + ((t_ & 127) >> 3)) + 8 * ((t_ >> 7) & 1) + (t_ & 7);
          auto f8 = [](unsigned char b) { return __builtin_amdgcn_cvt_pk_f32_fp8((int)b, false)[0] * (1.f / 16.f); };
          g0 = f8(YSb[(size_t)i * D + bo]); g1 = f8(YSb[(size_t)i * D + bo + 512]);
          for (int j = 0; j < 8; ++j) { const size_t ps = (size_t)spos[(size_t)tok * 8 + j]; const float w = tkw[(size_t)tok * 8 + j]; g0 += w * f8(YBb[ps * D + bo]); g1 += w * f8(YBb[ps * D + bo + 512]); } }
        chk_report(F.ctl, id, g0, y0, 0.15f, 0.15f); chk_report(F.ctl, id, g1, y1, 0.15f, 0.15f);
        __syncthreads(); }
}
#endif

#ifndef PH_MASK
#define PH_MASK 0xffffffffu
#endif
#define PH(b) ((PH_MASK >> (b)) & 1u)
__global__ void __launch_bounds__(NTHR, 2) fwd(Args a) {
    extern __shared__ __attribute__((aligned(16))) unsigned char lds_raw[];
    Frame F;
    F.lds = (LAS unsigned char*)lds_raw; F.ws = a.ws; F.ctl = (unsigned*)(a.ws + WS_CTL);
    F.blk = blockIdx.x; F.refresh();
    for (int u = F.tid; u < (LDS_BYTES - RING_BYTES) / 4; u += NTHR) ((LAS unsigned*)(F.lds + RING_BYTES))[u] = 0u;
    __syncthreads();
    const XcdBarrier bar = xcd_barrier_post(F.ctl + CW_BAR, (volatile LAS unsigned*)(F.lds + L_MISC) + 8);
#define GRID_BAR() xcd_barrier(bar)
    LAS unsigned char* ring = F.lds;
    const int c = F.blk;
#define ws (F.ws)
#define NEWPH() F.refresh()

    if (PH(0)) { conv_small(F, a);
    __syncthreads();
    mod_full(F, a); }
    GRID_BAR();
    if (PH(1)) { rows_init(F, a); }
    GRID_BAR();

    for (int layer = 0; layer < 4; ++layer) {
        const int jl = layer >> 1; const bool upd = layer < 2; const int nrows = upd ? TT : T;
        if ((layer & 1) == 0) {
            NEWPH();
            if (PH(2)) { SchedQKV S; S.U = (const char*)a.out + OUT_U8; S.W = (const char*)(ws + WS_WQKV) + (size_t)jl * 1536 * 1024; S.nfull = (layer == 0) ? 288 * 6 : 256 * 6; S.nu = (layer == 0) ? 288 * 6 : 256 * 6 + 64; S.c = c;
              pg::EpiQKV E; E.Q = (bf16_t*)(ws + WS_Q); E.K = (bf16_t*)(ws + WS_K); E.V = (bf16_t*)(ws + WS_V); E.ropec = (const float*)(ws + WS_ROPEC); E.ropes = (const float*)(ws + WS_ROPES);
              pg::gemm_phase<pg::EpiQKV, SchedQKV, false, true>(ring, 1024u, 1024u, nullptr, S, E); }
            GRID_BAR();
#ifdef SELFCHECK
            if (SELFCHECK & 1) chk_qkv(F, a, layer, 1 + (layer >> 1));
#endif
#define OBUF ((bf16_t*)(ws + WS_R + 216 * MiB))
            NEWPH();
            if (PH(3)) { const int NU = 2048 + (layer == 0 ? 256 : 0);
              const bf16_t* Qb = (const bf16_t*)(ws + WS_Q); const bf16_t* Kb = (const bf16_t*)(ws + WS_K); const bf16_t* Vb = (const bf16_t*)(ws + WS_V);
              for (int i = 0; i * GRID + c < NU; ++i) { int id = pg::xcd_remap(i * GRID + c, NU);
                  if (NU > 2048) { const int g9 = id / 9, r9 = id - g9 * 9; id = (r9 < 8) ? g9 * 8 + r9 : 2048 + g9; }
                  if (id < 2048) { const int hp = id & 1, qb = (id >> 1) & 7, kvh = (id >> 4) & 3, b = id >> 6, h0 = kvh * 4 + hp * 2;
                      attn::attn_unit2(Qb, Kb, Vb, OBUF, b, h0, qb * 256, false, a.in[10][jl * 16 + h0] * LOG2E, a.in[10][jl * 16 + h0 + 1] * LOG2E, ring); }
                  else { const int cid = id - 2048, hp = cid & 1, kvh = (cid >> 1) & 3, b = cid >> 3, h0 = kvh * 4 + hp * 2;
                      attn::attn_unit2(Qb, Kb, Vb, OBUF, b, h0, 0, true, a.in[10][jl * 16 + h0] * LOG2E, a.in[10][jl * 16 + h0 + 1] * LOG2E, ring); } } }
            GRID_BAR();
#ifdef SELFCHECK
            if (SELFCHECK & 1) chk_attn(F, a, layer, 3 + (layer >> 1));
#endif
            NEWPH();
            if (PH(4)) { SchedDense S; S.A = (const char*)OBUF; S.W = (const char*)(ws + WS_WO) + (size_t)jl * 1024 * 1024; S.out = (char*)a.out; S.nrt = nrows / 256; S.nct = 4; S.nt = 8; S.c = c; S.ldA = 1024;
              pg::EpiY8 E; pg::gemm_phase<pg::EpiY8, SchedDense, false, true>(ring, 1024u, 1024u, nullptr, S, E); }
            GRID_BAR();
        } else {
            NEWPH();
            if (PH(5)) { SchedF1 S; S.CS = (const char*)(ws + WS_CSN); S.U = (const char*)a.out + OUT_U8; S.ABT = (char*)(ws + WS_ABT); S.ABTC = (char*)(ws + WS_ABTC); S.nu = 2048 + (upd ? 256 : 0); S.c = c;
              pg::EpiStore8 E; pg::gemm_phase<pg::EpiStore8, SchedF1, false, true, 127>(ring, 256u, 1024u, nullptr, S, E); }
            GRID_BAR();
            NEWPH();
            if (PH(6)) { SchedF2 S; S.DL = (const char*)(ws + WS_DL); S.ABT = (const char*)(ws + WS_ABT); S.FH = (char*)(ws + WS_FH); S.c = c;
              pg::EpiStore8 E; pg::gemm_phase<pg::EpiStore8, SchedF2, false, true, 127>(ring, 4096u, 4096u, nullptr, S, E); }
            NEWPH();
            if (PH(7) && upd) { SchedF2c S; S.DLC = (const char*)(ws + WS_DLC); S.ABTC = (const char*)(ws + WS_ABTC); S.FC = (char*)(ws + WS_FC); S.c = c;
              pg::EpiStore8 E; pg::gemm_phase<pg::EpiStore8, SchedF2c, false, true, 127>(ring, 512u, 512u, nullptr, S, E); }
            if (PH(8)) fnet_nyquist_rows(F);
            GRID_BAR();
#ifdef SELFCHECK
            if (SELFCHECK & 2) chk_fnet_f(F, a, upd, 5 + (layer >> 1));
            GRID_BAR();
#endif
            NEWPH();
            if (PH(9)) { SchedF3 S; S.FH = (const char*)(ws + WS_FH); S.FC = (const char*)(ws + WS_FC); S.W = (const char*)(ws + WS_WSH) + (size_t)jl * 2048 * 1024; S.Y = (char*)a.out; S.nu = 1024 + (upd ? 128 : 0); S.c = c;
              pg::EpiY8 E; pg::gemm_phase<pg::EpiY8, SchedF3, false, true>(ring, 1024u, 1024u, nullptr, S, E); }
            if (PH(10)) fnet_nyquist_out(F, a, jl);
            GRID_BAR();
#ifdef SELFCHECK
            if (SELFCHECK & 8) chk_fnet_y(F, a, jl, upd, 7 + (layer >> 1));
            GRID_BAR();
#endif
        }
        const bool conv_first = ((c >> 3) & 1) == 0;
        if (PH(12) && conv_first) conv_experts(F, a, layer);
        __syncthreads();
        if (PH(11)) rows_post1(F, a, layer, nrows);
        VM_WAIT(); __syncthreads();
        if (threadIdx.x == 0) { __builtin_amdgcn_fence(__ATOMIC_ACQUIRE, "agent"); VM_WAIT(); }
        __syncthreads();
        if (PH(13)) route_tokens(F, a, layer, nrows);
        __syncthreads();
        if (PH(12) && !conv_first) conv_experts(F, a, layer);
        GRID_BAR();
#ifdef SELFCHECK
        if ((SELFCHECK & 64) && layer < 2) chk_route(F, a, layer, nrows, 9);
#endif
        if (PH(14)) build_lists(F, nrows);
        GRID_BAR();
        LAS const int* tstart = (LAS const int*)(F.lds + L_TSTART); LAS const unsigned char* tseg = (LAS const unsigned char*)(F.lds + L_TSEG);
        const int ntl = __builtin_amdgcn_readfirstlane(tstart[NCHUNK * 64]);
        NEWPH();
        if (PH(15)) { SchedG1 S; S.EGU = (const char*)(ws + WS_EGU); S.STOK = (const int*)(ws + WS_STOK); S.H = (char*)(ws + WS_H); S.HS = (char*)(ws + WS_HS); S.tseg = tseg; S.ntl = ntl; S.nsh = nrows / 256; S.c = c;
          pg::EpiSilu E; pg::gemm_phase<pg::EpiSilu, SchedG1, true, true>(ring, 1024u, 1024u, (const char*)a.out + OUT_U8, S, E); }
        GRID_BAR();
        const int CH = nrows / NCHUNK;
        for (int ch = 0; ch < NCHUNK; ++ch) {
            NEWPH();
            if (PH(16)) { SchedG2 S; S.ED = (const char*)(ws + WS_ED); S.H = (const char*)(ws + WS_H); S.HS = (const char*)(ws + WS_HS); S.YB = (char*)(ws + WS_YB); S.YS = (char*)(ws + WS_YS); S.tseg = tseg;
              S.t0 = __builtin_amdgcn_readfirstlane(tstart[ch * 64]); S.t1 = __builtin_amdgcn_readfirstlane(tstart[ch * 64 + 64]); S.nsh = CH / 256; S.ch = ch; S.CH = CH; S.c = c;
              pg::EpiFp8 E; pg::gemm_phase<pg::EpiFp8, SchedG2, false, true>(ring, 256u, 256u, nullptr, S, E); }
            GRID_BAR();
#ifdef SELFCHECK
            if ((SELFCHECK & 4) && layer == 0) { chk_moe(F, a, layer, nrows, ch, 10); GRID_BAR(); }
#endif
            if (PH(17)) rows_post2(F, a, layer, ch * CH, CH);
            if (!(layer == 3 && ch == NCHUNK - 1)) GRID_BAR();
        }
    }
#ifdef SELFCHECK
    GRID_BAR();
    { int bad = 0; float be = 0.f; for (int k = 15; k >= 1; --k) { const float e = __uint_as_float(__hip_atomic_load(F.ctl + CW_ERR + k, RLX_AGENT)); if (e > 1.f) { bad = k; be = e; } }
      int wt = 0; float we = 0.f; for (int k = 0; k < 16; ++k) { const float e = __uint_as_float(__hip_atomic_load(F.ctl + CW_ERR + 32 + k, RLX_AGENT)); if (e > we) { we = e; wt = k; } }
      if (bad) { F.refresh(); float cv = 3.f + bad + (be > 8.f ? 0.5f : 0.f);  Row r; for (int j = 0; j < 4; ++j) r.v[j] = (f32x4){cv, cv, cv, cv}; for (int row = F.gw; row < T; row += NGW) row_store_f32(r, a.out + (size_t)row * D, F.lane); } }
#endif
}

#undef ws
#undef NEWPH
extern "C" void kernel_launch(void* const* d_in, const int* in_sizes, int n_in, void* d_out, int out_size, void* d_ws, size_t ws_size, hipStream_t stream) {
    static int ready = 0;
    if (ready == 0) {
        if (n_in != 20 || out_size != T * D || ws_size < WS_END) { fprintf(stderr, "kernel_launch: unexpected problem (n_in %d out %d ws %zu need %zu)\n", n_in, out_size, ws_size, (size_t)WS_END); ready = -1; return; }
        if (hipFuncSetAttribute((const void*)fwd, hipFuncAttributeMaxDynamicSharedMemorySize, LDS_BYTES) != hipSuccess) { fprintf(stderr, "kernel_launch: hipFuncSetAttribute failed\n"); ready = -1; return; }
        int per_cu = 0;
        if (hipOccupancyMaxActiveBlocksPerMultiprocessor(&per_cu, (const void*)fwd, NTHR, LDS_BYTES) != hipSuccess || per_cu < 1) fprintf(stderr, "kernel_launch: occupancy query says %d blocks per CU\n", per_cu);
        (void)hipGetLastError();
        ready = 1;
    }
    if (ready < 0) return;
    (void)hipMemsetAsync((char*)d_ws + WS_CTL, 0, CTL_BYTES, stream);
    Args a{};
    for (int i = 0; i < 20; ++i) a.in[i] = (const float*)d_in[i];
    a.out = (float*)d_out; a.ws = (unsigned char*)d_ws;
    hipLaunchKernelGGL(fwd, dim3(GRID), dim3(NTHR), LDS_BYTES, stream, a);
}
```

```cpp
#include <hip/hip_runtime.h>
#include <cstdio>
#include <cstdint>

#define LAS __attribute__((address_space(3)))
#define GAS __attribute__((address_space(1)))
typedef unsigned short bf16_t;
typedef short bf16x8 __attribute__((ext_vector_type(8)));
typedef short s16x4 __attribute__((ext_vector_type(4)));
typedef float f32x4 __attribute__((ext_vector_type(4)));
typedef float f32x16 __attribute__((ext_vector_type(16)));
typedef unsigned u32x4 __attribute__((ext_vector_type(4)));
typedef unsigned u32x2 __attribute__((ext_vector_type(2)));
typedef int v8i_t __attribute__((ext_vector_type(8)));
typedef int v4i_t __attribute__((ext_vector_type(4)));

constexpr int D = 1024, NB = 32, SEQ = 2048, T = NB * SEQ, CTXL = 256, TC = NB * CTXL, TT = T + TC;
constexpr int NQKV = 1536, NE = 64;
constexpr float ALPHA = 1.681792830507429f;
constexpr float LN_EPS = 1e-5f, MOD_EPS = 1e-6f;
constexpr float C2 = 0.125f * 1.4426950408889634f;
constexpr float LOG2E = 1.4426950408889634f;
constexpr int NCHUNK = 1;
constexpr int NWAVES = 8, NTHR = 512, GRID = 256;

constexpr size_t MiB = 1u << 20;
constexpr size_t WS_CTL = 0, CTL_BYTES = 1 * MiB;
constexpr size_t WS_ROPEC = 1 * MiB, WS_ROPES = 1 * MiB + 4096, WS_CSN = 1 * MiB + 65536, WS_DLC = 1 * MiB + 524288, WS_DL = 2 * MiB;
constexpr size_t WS_WQKV = 10 * MiB, WS_WO = 16 * MiB, WS_WF = 20 * MiB, WS_WR = 28 * MiB, WS_WSH = 29 * MiB;
constexpr size_t WS_MODP = 36 * MiB, WS_MOD = 49 * MiB;
constexpr float QSC = 64.f;
constexpr float YSC = 16.f;
constexpr size_t WS_RSTAT = 36 * MiB;
constexpr size_t WS_EGU = 54 * MiB, WS_ED = 118 * MiB;
constexpr size_t WS_XS = 150 * MiB;
constexpr size_t WS_STOK = 294 * MiB, WS_SDST = 297 * MiB, WS_SW = 300 * MiB, WS_TKE = 303 * MiB, WS_TKW = 306 * MiB;
constexpr size_t WS_R = 309 * MiB;
constexpr size_t WS_Q = WS_R, WS_K = WS_R + 144 * MiB, WS_V = WS_R + 180 * MiB;
constexpr size_t WS_ABT = WS_R, WS_FH = WS_R + 256 * MiB, WS_FH1 = WS_R + 320 * MiB, WS_ABTC = WS_R + 321 * MiB, WS_FC = WS_R + 353 * MiB;
constexpr size_t WS_H = WS_R, WS_HS = WS_R + 160 * MiB, WS_YB = WS_R + 180 * MiB, WS_YS = WS_R + 788 * MiB;
constexpr size_t WS_END = WS_YS + 72 * MiB;
constexpr size_t OUT_U8 = 144 * MiB;
constexpr int WSCALE_E8M0 = 121;
constexpr int MAXROWS = 655360;

constexpr int CW_TMO = 0, CW_BAR = 4096, CW_BCNT = 16384;

constexpr int RING_BYTES = 131072;
constexpr int L_MISC = RING_BYTES;
constexpr int L_TSTART = RING_BYTES + 256;
constexpr int L_PREF = L_TSTART + 1040;
constexpr int L_LCNT = L_PREF + 256;
constexpr int L_TSEG = L_LCNT + 256;
constexpr int L_SCAN = L_TSEG + 2560;
constexpr int LDS_BYTES = 139264;
static_assert(L_SCAN + 1024 <= LDS_BYTES, "LDS map");

#define RLX_AGENT __ATOMIC_RELAXED, __HIP_MEMORY_SCOPE_AGENT
#define LDS_WAIT() asm volatile("s_waitcnt lgkmcnt(0)" ::: "memory")
#define VM_WAIT() asm volatile("s_waitcnt vmcnt(0)" ::: "memory")

__device__ __forceinline__ unsigned f2bf(float f) { unsigned u = __builtin_bit_cast(unsigned, f); return (u + 0x7fffu + ((u >> 16) & 1u)) >> 16; }
__device__ __forceinline__ unsigned pk2(float lo, float hi) { return f2bf(lo) | (f2bf(hi) << 16); }
typedef float f32x2_t __attribute__((ext_vector_type(2))); typedef __bf16 bf16x2_t __attribute__((ext_vector_type(2)));
__device__ __forceinline__ unsigned cvt_pk_bf16(float lo, float hi) { f32x2_t v = {lo, hi}; bf16x2_t b = __builtin_convertvector(v, bf16x2_t); return __builtin_bit_cast(unsigned, b); }
__device__ __forceinline__ float bflo(unsigned w) { return __builtin_bit_cast(float, w << 16); }
__device__ __forceinline__ float bfhi(unsigned w) { return __builtin_bit_cast(float, w & 0xffff0000u); }
__device__ __forceinline__ float wave_sum(float v) {
#pragma unroll
    for (int o = 1; o < 64; o <<= 1) v += __shfl_xor(v, o);
    return v;
}

__device__ __forceinline__ unsigned f2f8(float v) { return (unsigned)__builtin_amdgcn_cvt_pk_fp8_f32(v, 0.f, 0, false) & 0xffu; }
__device__ __forceinline__ float f82f(unsigned b) { return __builtin_amdgcn_cvt_pk_f32_fp8((int)(b & 0xffu), false)[0]; }
__device__ __forceinline__ int opaque_tid() { int t = threadIdx.x; asm volatile("" : "+v"(t)); return t; }

#define XB_TMO      128
#define XB_XCNT(j)  (256  + 64 * (j))
#define XB_XSUB(j)  (1280 + 64 * (j))
#define XB_XGEN(j)  (2304 + 64 * (j))
#define XB_TOP      3328
#define XB_TOPGEN   3392
#define XCD_BAR_WORDS 3456
#define XB_SPIN_CAP (1u << 22)
__device__ __forceinline__ unsigned xb_ld(unsigned* p)              { return __hip_atomic_load(p, __ATOMIC_RELAXED, __HIP_MEMORY_SCOPE_AGENT); }
__device__ __forceinline__ unsigned xb_add(unsigned* p, unsigned v) { return __hip_atomic_fetch_add(p, v, __ATOMIC_RELAXED, __HIP_MEMORY_SCOPE_AGENT); }
__device__ __forceinline__ unsigned xb_xcc_id() { return (unsigned)__builtin_amdgcn_s_getreg((3 << 11) | 20) & 0xFu; }
#define XB_SPIN(cond, bar) do { unsigned _sp = 0; while (cond) { __builtin_amdgcn_s_sleep(1); \
    if ((++_sp & 255u) == 0u) { if (xb_ld(&(bar)[XB_TMO])) break; if (_sp > XB_SPIN_CAP) { atomicAdd(&(bar)[XB_TMO], 1u); break; } } } } while (0)
struct XcdBarrier { unsigned* bar; unsigned x; volatile LAS unsigned* st; };
__device__ __forceinline__ XcdBarrier xcd_barrier_post(unsigned* bar, volatile LAS unsigned* st) {
    XcdBarrier b; b.bar = bar; b.x = xb_xcc_id(); b.st = st;
    if (threadIdx.x == 0) (void)xb_add(&bar[XB_XCNT(b.x)], 1u);
    return b;
}
__device__ __forceinline__ void xcd_barrier_complete(unsigned* bar, unsigned x, unsigned& nloc, unsigned& nx) {
    const unsigned G = gridDim.x * gridDim.y * gridDim.z;
    unsigned sum, cnt, mine, sp = 0u;
    for (;;) {
        sum = 0u; cnt = 0u; mine = 0u;
#pragma unroll
        for (unsigned j = 0; j < 16; ++j) { const unsigned c = xb_ld(&bar[XB_XCNT(j)]); sum += c; cnt += (c > 0u) ? 1u : 0u; mine = (j == x) ? c : mine; }
        if (sum == G) break;
        __builtin_amdgcn_s_sleep(1);
        if ((++sp & 255u) == 0u) { if (xb_ld(&bar[XB_TMO])) break; if (sp > XB_SPIN_CAP) { atomicAdd(&bar[XB_TMO], 1u); break; } }
    }
    nloc = mine > 0u ? mine : 1u; nx = cnt > 0u ? cnt : 1u;
}
__device__ __forceinline__ void xcd_barrier(const XcdBarrier& b) {
    asm volatile("s_waitcnt vmcnt(0)" ::: "memory");
    __syncthreads();
    if (threadIdx.x == 0) {
        unsigned* bar = b.bar; unsigned bx = b.x; asm volatile("" : "+s"(bx));
        __builtin_amdgcn_s_waitcnt(0);
        unsigned nloc = b.st[0], nx = b.st[1];
        if (nloc == 0u) { xcd_barrier_complete(bar, bx, nloc, nx); b.st[0] = nloc; b.st[1] = nx; }
        const unsigned old = xb_add(&bar[XB_XSUB(bx)], 1u);
        const unsigned gen = old / nloc;
        if (old + 1u == (gen + 1u) * nloc) {
            __builtin_amdgcn_fence(__ATOMIC_RELEASE, "agent");
            asm volatile("s_waitcnt vmcnt(0)" ::: "memory");
            const unsigned og = xb_add(&bar[XB_TOP], 1u);
            const unsigned tg = og / nx;
            if (og + 1u == (tg + 1u) * nx) xb_add(&bar[XB_TOPGEN], 1u);
            else XB_SPIN(xb_ld(&bar[XB_TOPGEN]) == tg, bar);
            __builtin_amdgcn_fence(__ATOMIC_ACQUIRE, "agent");
            xb_add(&bar[XB_XGEN(bx)], 1u);
            asm volatile("s_waitcnt vmcnt(0)" ::: "memory");
        } else {
            XB_SPIN(xb_ld(&bar[XB_XGEN(bx)]) == gen, bar);
            __builtin_amdgcn_fence(__ATOMIC_ACQUIRE, "agent");
            asm volatile("s_waitcnt vmcnt(0)" ::: "memory");
        }
    }
    __syncthreads();
}

typedef float f32x2v __attribute__((ext_vector_type(2)));
namespace pg {
constexpr int BM = 256, BK = 64, HALF = 128, HTB = HALF * BK * 2;
__host__ __device__ __forceinline__ int lds_byte(int r, int c) { const int st = (r >> 4) * 2 + (c >> 5), rr = r & 15, cc = c & 31, ob = rr * 64 + cc * 2; return st * 1024 + (ob ^ (((ob >> 9) & 1) << 5)); }
__host__ __device__ __forceinline__ void stage_rc(int b, int& R, int& C) { const int st = b / 1024, sb = b % 1024, swz = sb ^ (((sb >> 9) & 1) << 5); R = (st >> 1) * 16 + swz / 64; C = (st & 1) * 32 + (swz % 64) / 2; }
__host__ __device__ __forceinline__ int perm32(int rho) { const int n = rho >> 4, i = rho & 15; return 8 * (i >> 2) + 4 * n + (i & 3); }

struct Unit {
    const char* A;
    const char* B;
    const int* gidx;
    int gbase;
    int nt;
    char* out; int ldc; float scale; int flags; int i0; int i1;
};

template <class Epi, class Sched, bool GATHER, bool F8 = false, int WSC = WSCALE_E8M0>
__device__ __forceinline__ void gemm_phase(LAS unsigned char* lds, const unsigned lda, const unsigned ldb, const char* gtable, const Sched& S, const Epi& E) {
    const int tid = opaque_tid(), wid = __builtin_amdgcn_readfirstlane(tid >> 6), lane = tid & 63, wr = wid >> 2, wc = wid & 3, fr = lane & 15, fq = lane >> 4;
    unsigned voffA[2], voffB[2];
#pragma unroll
    for (int i = 0; i < 2; ++i) { int R, C; stage_rc(tid * 16 + i * 8192, R, C); const int Rb = (R & ~31) + perm32(R & 31);
        voffA[i] = (unsigned)R * lda + (unsigned)C * 2u; voffB[i] = (unsigned)Rb * ldb + (unsigned)C * 2u; }
    const size_t kstep = (size_t)(BK * 2);
    const size_t hstepA = (size_t)HALF * lda, hstepB = (size_t)HALF * ldb;
    const unsigned ldsw = (unsigned)wid * 1024u;
    const int aoff = lds_byte(wr * 64 + fr, fq * 8), boff = lds_byte(wc * 32 + fr, fq * 8);
#define PG_SA(b, h) (((b) * 2 + (h)) * HTB)
#define PG_SB(b, h) ((4 + (b) * 2 + (h)) * HTB)
#define PG_ST2(bufoff, p0, p1) do { \
        __builtin_amdgcn_global_load_lds((const unsigned*)(p0), (LAS unsigned*)(lds + (bufoff) + ldsw), 16, 0, 0); \
        __builtin_amdgcn_global_load_lds((const unsigned*)(p1), (LAS unsigned*)(lds + (bufoff) + ldsw + 8192), 16, 0, 0); } while (0)
#define PG_STB(bufoff, bp) PG_ST2(bufoff, (bp) + voffB[0], (bp) + voffB[1])
#define PG_STA(bufoff, ap, h, nx) do { if constexpr (GATHER) { PG_ST2(bufoff, (ap) + ((nx) ? nO[h][0] : cO[h][0]), (ap) + ((nx) ? nO[h][1] : cO[h][1])); } \
        else { PG_ST2(bufoff, (ap) + (h) * hstepA + voffA[0], (ap) + (h) * hstepA + voffA[1]); } } while (0)
#define PG_LD8(p) ({ const v4i_t lo_ = *(const LAS v4i_t*)(p), hi_ = *(const LAS v4i_t*)((p) + 1024); __builtin_shufflevector(lo_, hi_, 0, 1, 2, 3, 4, 5, 6, 7); })
#define PG_LDA(dst, b, h) do { if constexpr (F8) { _Pragma("unroll") for (int m = 0; m < 4; ++m) dst##8[m] = PG_LD8(lds + PG_SA(b, h) + aoff + m * 2048); } \
        else { _Pragma("unroll") for (int m = 0; m < 4; ++m) _Pragma("unroll") for (int k = 0; k < 2; ++k) dst[m][k] = *(const LAS bf16x8*)(lds + PG_SA(b, h) + aoff + m * 2048 + k * 1024); } } while (0)
#define PG_LDB(dst, b, h) do { if constexpr (F8) { _Pragma("unroll") for (int n = 0; n < 2; ++n) dst##8[n] = PG_LD8(lds + PG_SB(b, h) + boff + n * 2048); } \
        else { _Pragma("unroll") for (int n = 0; n < 2; ++n) _Pragma("unroll") for (int k = 0; k < 2; ++k) dst[n][k] = *(const LAS bf16x8*)(lds + PG_SB(b, h) + boff + n * 2048 + k * 1024); } } while (0)
#define PG_MMA(ai, bj, At, Bt) do { __builtin_amdgcn_s_setprio(1); _Pragma("unroll") for (int m = 0; m < 4; ++m) _Pragma("unroll") for (int n = 0; n < 2; ++n) { \
        if constexpr (F8) { asm volatile("v_mfma_scale_f32_16x16x128_f8f6f4 %0, %1, %2, %0, %3, %4 op_sel_hi:[0,0,0]" : "+v"(acc[ai][bj][m][n]) : "v"(Bt##8[n]), "v"(At##8[m]), "v"(sc_w), "v"(sc_x)); } \
        else { _Pragma("unroll") for (int k = 0; k < 2; ++k) acc[ai][bj][m][n] = __builtin_amdgcn_mfma_f32_16x16x32_bf16(Bt[n][k], At[m][k], acc[ai][bj][m][n], 0, 0, 0); } } \
        __builtin_amdgcn_s_setprio(0); } while (0)
#define PG_WAIT_V(n) asm volatile("s_waitcnt vmcnt(" #n ")" ::: "memory")
#define PG_WAIT_L(n) asm volatile("s_waitcnt lgkmcnt(" #n ")" ::: "memory")
#define PG_BAR __builtin_amdgcn_s_barrier()
#define PG_SCHED __builtin_amdgcn_sched_barrier(0)
#define PG_GOFF(dst, u) do { const int tz_ = opaque_tid(); _Pragma("unroll") for (int i = 0; i < 2; ++i) { int R_, C_; stage_rc(tz_ * 16 + i * 8192, R_, C_); \
        _Pragma("unroll") for (int h = 0; h < 2; ++h) { const int rr = h * HALF + R_; \
        const int ix = (u).gidx ? ((const GAS int*)(u).gidx)[rr] : (u).gbase + rr; dst[h][i] = (unsigned)ix * lda + (unsigned)C_ * 2u; } } } while (0)
#define PG_GIDX(dst, un) do { const int* gi_ = nullptr; int gb_ = 0; const bool ok_ = S.gsrc((un), gi_, gb_); const int tz_ = opaque_tid(); _Pragma("unroll") for (int i = 0; i < 2; ++i) { int R_, C_; stage_rc(tz_ * 16 + i * 8192, R_, C_); \
        _Pragma("unroll") for (int h = 0; h < 2; ++h) { const int rr = h * HALF + R_; dst[h][i] = (ok_ && gi_) ? ((const GAS int*)gi_)[rr] : gb_ + rr; } } } while (0)
#define PG_GCVT(dst, src) do { const int tz_ = opaque_tid(); _Pragma("unroll") for (int i = 0; i < 2; ++i) { int R_, C_; stage_rc(tz_ * 16 + i * 8192, R_, C_); \
        _Pragma("unroll") for (int h = 0; h < 2; ++h) dst[h][i] = (unsigned)src[h][i] * lda + (unsigned)C_ * 2u; } } while (0)
    Unit cur, nxt; int ui = 0;
    if (!S.next(0, cur)) return;
    f32x4 acc[2][2][4][2];
#pragma unroll
    for (int a = 0; a < 2; ++a)
#pragma unroll
        for (int b = 0; b < 2; ++b)
#pragma unroll
            for (int m = 0; m < 4; ++m)
#pragma unroll
                for (int n = 0; n < 2; ++n) acc[a][b][m][n] = (f32x4){0.f, 0.f, 0.f, 0.f};
    bf16x8 At[4][2], B0[2][2], B1[2][2]; v8i_t At8[4], B08[2], B18[2];
    const int sc_w = WSC * 0x01010101, sc_x = 0x7f7f7f7f;
    unsigned cO[2][2] = {{0u, 0u}, {0u, 0u}}, nO[2][2] = {{0u, 0u}, {0u, 0u}};
    if constexpr (GATHER) { PG_GOFF(cO, cur); }
    const char* cA = GATHER ? gtable : cur.A; const char* cB = cur.B;
    PG_STB(PG_SB(0, 0), cB); PG_STB(PG_SB(0, 1), cB + hstepB); PG_STA(PG_SA(0, 0), cA, 0, false); PG_STA(PG_SA(0, 1), cA, 1, false);
    if (wr == 1) PG_BAR;
    PG_WAIT_V(2); PG_BAR;
    PG_STB(PG_SB(1, 0), cB + kstep); PG_STA(PG_SA(1, 0), cA + kstep, 0, false); PG_STB(PG_SB(1, 1), cB + hstepB + kstep);
    PG_WAIT_V(6); PG_BAR;
    for (;;) {
        const bool has_next = S.next(ui + 1, nxt);
        const int nt = cur.nt;
        if constexpr (GATHER) { if (has_next) { PG_GOFF(nO, nxt); } else {
#pragma unroll
            for (int h = 0; h < 2; ++h)
#pragma unroll
                for (int i = 0; i < 2; ++i) nO[h][i] = cO[h][i]; } }
        const char* nA = GATHER ? gtable : (has_next ? nxt.A : cA); const char* nB = has_next ? nxt.B : cB;
#pragma unroll 1
        for (int t = 0; t < nt; t += 2) {
            const bool last = (t == nt - 2);
            const char* a1 = cA + (size_t)(t + 1) * kstep;
            const char* a2 = last ? nA : cA + (size_t)(t + 2) * kstep; const char* b2 = last ? nB : cB + (size_t)(t + 2) * kstep;
            const char* a3 = a2 + kstep; const char* b3 = b2 + kstep;
            const bool after_epi = (Epi::NSTORE > 0) && (t == 0) && (ui > 0);
            PG_LDB(B0, 0, 0); PG_LDB(B1, 0, 1); PG_SCHED; PG_LDA(At, 0, 0); PG_STA(PG_SA(1, 1), a1, 1, false);
            if (after_epi) { if constexpr (Epi::NSTORE == 8) PG_WAIT_V(16); else PG_WAIT_V(24); } else PG_WAIT_V(8);
            PG_WAIT_L(0); PG_BAR; PG_MMA(0, 0, At, B0); PG_MMA(0, 1, At, B1); PG_BAR; PG_SCHED;
            PG_LDA(At, 0, 1); PG_STB(PG_SB(0, 0), b2); PG_STB(PG_SB(0, 1), b2 + hstepB); PG_STA(PG_SA(0, 0), a2, 0, last);
            if (after_epi) { if constexpr (Epi::NSTORE == 8) PG_WAIT_V(16); else PG_WAIT_V(24); } else PG_WAIT_V(8);
            PG_WAIT_L(0); PG_BAR; PG_MMA(1, 0, At, B0); PG_MMA(1, 1, At, B1); PG_BAR; PG_SCHED;
            PG_LDB(B0, 1, 0); PG_LDB(B1, 1, 1); PG_SCHED; PG_LDA(At, 1, 0); PG_STA(PG_SA(0, 1), a2, 1, last);
            PG_WAIT_V(8); PG_WAIT_L(0); PG_BAR; PG_MMA(0, 0, At, B0); PG_MMA(0, 1, At, B1); PG_BAR; PG_SCHED;
            PG_LDA(At, 1, 1); PG_STB(PG_SB(1, 0), b3); PG_STB(PG_SB(1, 1), b3 + hstepB); PG_STA(PG_SA(1, 0), a3, 0, last);
            PG_WAIT_V(8); PG_WAIT_L(0); PG_BAR; PG_MMA(1, 0, At, B0); PG_MMA(1, 1, At, B1); PG_BAR; PG_SCHED;
        }
        if (wr == 0) PG_BAR;
        if constexpr (F8) asm volatile("s_nop 15\n\ts_nop 15" ::: "memory");
        E(acc, cur, wr, wc, fr, fq);
        if (!has_next) break;
#pragma unroll
        for (int a = 0; a < 2; ++a)
#pragma unroll
            for (int b = 0; b < 2; ++b)
#pragma unroll
                for (int m = 0; m < 4; ++m)
#pragma unroll
                    for (int n = 0; n < 2; ++n) acc[a][b][m][n] = (f32x4){0.f, 0.f, 0.f, 0.f};
        cur = nxt; cA = nA; cB = nB; ++ui;
        if constexpr (GATHER) {
#pragma unroll
            for (int h = 0; h < 2; ++h)
#pragma unroll
                for (int i = 0; i < 2; ++i) cO[h][i] = nO[h][i]; }
        if (wr == 1) PG_BAR;
    }
    PG_WAIT_V(0);
    PG_BAR;
#undef PG_SA
#undef PG_SB
#undef PG_ST2
#undef PG_STB
#undef PG_STA
#undef PG_LDA
#undef PG_LD8
#undef PG_LDB
#undef PG_MMA
#undef PG_WAIT_V
#undef PG_WAIT_L
#undef PG_BAR
#undef PG_SCHED
#undef PG_GOFF
#undef PG_GIDX
#undef PG_GCVT
}

struct EpiStore {
    static constexpr int NSTORE = 0;
    __device__ __forceinline__ void operator()(const f32x4 (&acc)[2][2][4][2], const Unit& u, int wr, int wc, int fr, int fq) const {
        asm volatile("" : "+v"(fr), "+v"(fq));
        const float s = u.scale;
#pragma unroll
        for (int ai = 0; ai < 2; ++ai)
#pragma unroll
            for (int m = 0; m < 4; ++m) { const int row = ai * HALF + wr * 64 + m * 16 + fr;
                char* rowp = u.out + (ptrdiff_t)row * u.ldc + (wc * 32 + 8 * fq) * 2;
                if (!((u.flags & 1) && row == 0)) {
#pragma unroll
                for (int bj = 0; bj < 2; ++bj) { const f32x4 v0 = acc[ai][bj][m][0] * s, v1 = acc[ai][bj][m][1] * s;
                    u32x4 w; w.x = cvt_pk_bf16(v0[0], v0[1]); w.y = cvt_pk_bf16(v0[2], v0[3]); w.z = cvt_pk_bf16(v1[0], v1[1]); w.w = cvt_pk_bf16(v1[2], v1[3]);
                    *(u32x4*)(rowp + bj * 256) = w; } } }
    }
};
struct EpiStore8 {
    static constexpr int NSTORE = 16;
    __device__ __forceinline__ void operator()(const f32x4 (&acc)[2][2][4][2], const Unit& u, int wr, int wc, int fr, int fq) const {
        asm volatile("" : "+v"(fr), "+v"(fq));
        const float s = u.scale;
#pragma unroll
        for (int ai = 0; ai < 2; ++ai)
#pragma unroll
            for (int m = 0; m < 4; ++m) { const int row = ai * HALF + wr * 64 + m * 16 + fr;
                char* rowp = u.out + (ptrdiff_t)row * u.ldc + (wc * 32 + 8 * fq);
#pragma unroll
                for (int bj = 0; bj < 2; ++bj) { const f32x4 v0 = acc[ai][bj][m][0] * s, v1 = acc[ai][bj][m][1] * s; int w0 = 0, w1 = 0;
                    w0 = __builtin_amdgcn_cvt_pk_fp8_f32(v0[0], v0[1], w0, false); w0 = __builtin_amdgcn_cvt_pk_fp8_f32(v0[2], v0[3], w0, true);
                    w1 = __builtin_amdgcn_cvt_pk_fp8_f32(v1[0], v1[1], w1, false); w1 = __builtin_amdgcn_cvt_pk_fp8_f32(v1[2], v1[3], w1, true);
                    u32x2 o; o.x = (unsigned)w0; o.y = (unsigned)w1; *(u32x2*)(rowp + bj * 128) = o; } }
    }
};
struct EpiQKV {
    static constexpr int NSTORE = 0;
    bf16_t* Q; bf16_t* K; bf16_t* V; const float* ropec; const float* ropes;
    __device__ __forceinline__ void operator()(const f32x4 (&acc)[2][2][4][2], const Unit& u, int wr, int wc, int fr, int fq) const {
        asm volatile("" : "+v"(fr), "+v"(fq));
        const int pm = u.i0, pn = u.i1; const bool lat = pm < (T / 256); const bool rope = lat && pn < 5;
        const float qs = pn < 4 ? C2 : 1.f;
        const int part = wc & 1;
        const int fi0 = 8 * (fq & 1);
        const float sgn = (fq < 2) ? -1.f : 1.f;
#pragma unroll
        for (int ai = 0; ai < 2; ++ai)
#pragma unroll
            for (int m = 0; m < 4; ++m) { const int row = ai * HALF + wr * 64 + m * 16 + fr; const int tok = pm * 256 + row;
                const int tl = tok & (SEQ - 1); const int pos = part ? (tl & 63) : (tl >> 6);
                f32x4 c0 = {1.f, 1.f, 1.f, 1.f}, c1 = c0, s0 = {0.f, 0.f, 0.f, 0.f}, s1 = s0;
                if (rope) { c0 = *(const f32x4*)(ropec + pos * 16 + fi0); c1 = *(const f32x4*)(ropec + pos * 16 + fi0 + 4); s0 = *(const f32x4*)(ropes + pos * 16 + fi0); s1 = *(const f32x4*)(ropes + pos * 16 + fi0 + 4); }
#pragma unroll
                for (int bj = 0; bj < 2; ++bj) { f32x4 v0 = acc[ai][bj][m][0], v1 = acc[ai][bj][m][1];
                    if (rope) { f32x4 p0, p1;
#pragma unroll
                        for (int j = 0; j < 4; ++j) { p0[j] = __shfl_xor(v0[j], 32); p1[j] = __shfl_xor(v1[j], 32); }
                        v0 = v0 * c0 + (p0 * sgn) * s0; v1 = v1 * c1 + (p1 * sgn) * s1; }
                    v0 = v0 * qs; v1 = v1 * qs;
                    const int col = bj * HALF + wc * 32 + 8 * fq;
                    if (pn < 4) {
#pragma unroll
                        for (int j = 0; j < 4; ++j) { v0[j] = __builtin_amdgcn_fmed3f(v0[j] * QSC, -448.f, 448.f); v1[j] = __builtin_amdgcn_fmed3f(v1[j] * QSC, -448.f, 448.f); }
                        int w0 = 0, w1 = 0;
                        w0 = __builtin_amdgcn_cvt_pk_fp8_f32(v0[0], v0[1], w0, false); w0 = __builtin_amdgcn_cvt_pk_fp8_f32(v0[2], v0[3], w0, true);
                        w1 = __builtin_amdgcn_cvt_pk_fp8_f32(v1[0], v1[1], w1, false); w1 = __builtin_amdgcn_cvt_pk_fp8_f32(v1[2], v1[3], w1, true);
                        u32x2 o; o.x = (unsigned)w0; o.y = (unsigned)w1; *(GAS u32x2*)((unsigned char*)Q + (size_t)tok * 1024 + pn * 256 + col) = o; }
                    else { u32x4 w; w.x = cvt_pk_bf16(v0[0], v0[1]); w.y = cvt_pk_bf16(v0[2], v0[3]); w.z = cvt_pk_bf16(v1[0], v1[1]); w.w = cvt_pk_bf16(v1[2], v1[3]);
                        bf16_t* dst = pn == 4 ? K + (size_t)tok * 256 + col : V + (size_t)tok * 256 + col;
                        *(GAS u32x4*)dst = w; } } }
    }
};
struct EpiSilu {
    static constexpr int NSTORE = 8;
    __device__ __forceinline__ void operator()(const f32x4 (&acc)[2][2][4][2], const Unit& u, int wr, int wc, int fr, int fq) const {
        asm volatile("" : "+v"(fr), "+v"(fq));
#pragma unroll
        for (int ai = 0; ai < 2; ++ai)
#pragma unroll
            for (int m = 0; m < 4; ++m) { const int row = ai * HALF + wr * 64 + m * 16 + fr;
                float h[8];
#pragma unroll
                for (int n = 0; n < 2; ++n)
#pragma unroll
                    for (int j = 0; j < 4; j += 2) {
                        const f32x2v g = {acc[ai][0][m][n][j], acc[ai][0][m][n][j + 1]}, up = {acc[ai][1][m][n][j], acc[ai][1][m][n][j + 1]};
                        const f32x2v t = g * (f32x2v){-1.4426950408889634f, -1.4426950408889634f}, p = g * up;
                        f32x2v e = {__builtin_amdgcn_exp2f(t[0]), __builtin_amdgcn_exp2f(t[1])};
                        e = e + (f32x2v){1.f, 1.f};
                        const f32x2v r = {__builtin_amdgcn_rcpf(e[0]), __builtin_amdgcn_rcpf(e[1])};
                        const f32x2v o2 = p * r; h[n * 4 + j] = o2[0]; h[n * 4 + j + 1] = o2[1]; }
                int w0 = 0, w1 = 0;
                w0 = __builtin_amdgcn_cvt_pk_fp8_f32(h[0], h[1], w0, false); w0 = __builtin_amdgcn_cvt_pk_fp8_f32(h[2], h[3], w0, true);
                w1 = __builtin_amdgcn_cvt_pk_fp8_f32(h[4], h[5], w1, false); w1 = __builtin_amdgcn_cvt_pk_fp8_f32(h[6], h[7], w1, true);
                u32x2 o; o.x = (unsigned)w0; o.y = (unsigned)w1;
                *(u32x2*)(u.out + (size_t)row * 256 + (wc * 32 + 8 * fq)) = o; }
    }
};
struct EpiFp8 {
    static constexpr int NSTORE = 8;
    __device__ __forceinline__ void operator()(const f32x4 (&acc)[2][2][4][2], const Unit& u, int wr, int wc, int fr, int fq) const {
        asm volatile("" : "+v"(fr), "+v"(fq));
        const int pn = u.i1;
#pragma unroll
        for (int ai = 0; ai < 2; ++ai)
#pragma unroll
            for (int m = 0; m < 4; ++m) { const int row = ai * HALF + wr * 64 + m * 16 + fr;
                u32x4 o;
#pragma unroll
                for (int bj = 0; bj < 2; ++bj) { const f32x4 v0 = acc[ai][bj][m][0] * 16.f, v1 = acc[ai][bj][m][1] * 16.f;
                    int w0 = 0, w1 = 0;
                    w0 = __builtin_amdgcn_cvt_pk_fp8_f32(v0[0], v0[1], w0, false); w0 = __builtin_amdgcn_cvt_pk_fp8_f32(v0[2], v0[3], w0, true);
                    w1 = __builtin_amdgcn_cvt_pk_fp8_f32(v1[0], v1[1], w1, false); w1 = __builtin_amdgcn_cvt_pk_fp8_f32(v1[2], v1[3], w1, true);
                    o[2 * bj] = (unsigned)w0; o[2 * bj + 1] = (unsigned)w1; }
                *(u32x4*)(u.out + (size_t)row * 1024 + (16 * pn + 4 * wc + fq) * 16) = o; }
    }
};
struct EpiY8 {
    static constexpr int NSTORE = 0;
    __device__ __forceinline__ void operator()(const f32x4 (&acc)[2][2][4][2], const Unit& u, int wr, int wc, int fr, int fq) const {
        asm volatile("" : "+v"(fr), "+v"(fq));
        const int pn = u.i1; const float s = u.scale * YSC;
#pragma unroll
        for (int ai = 0; ai < 2; ++ai)
#pragma unroll
            for (int m = 0; m < 4; ++m) { const int row = ai * HALF + wr * 64 + m * 16 + fr;
                u32x4 o;
#pragma unroll
                for (int bj = 0; bj < 2; ++bj) { f32x4 v0 = acc[ai][bj][m][0] * s, v1 = acc[ai][bj][m][1] * s;
#pragma unroll
                    for (int j = 0; j < 4; ++j) { v0[j] = __builtin_amdgcn_fmed3f(v0[j], -448.f, 448.f); v1[j] = __builtin_amdgcn_fmed3f(v1[j], -448.f, 448.f); }
                    int w0 = 0, w1 = 0;
                    w0 = __builtin_amdgcn_cvt_pk_fp8_f32(v0[0], v0[1], w0, false); w0 = __builtin_amdgcn_cvt_pk_fp8_f32(v0[2], v0[3], w0, true);
                    w1 = __builtin_amdgcn_cvt_pk_fp8_f32(v1[0], v1[1], w1, false); w1 = __builtin_amdgcn_cvt_pk_fp8_f32(v1[2], v1[3], w1, true);
                    o[2 * bj] = (unsigned)w0; o[2 * bj + 1] = (unsigned)w1; }
                if (!((u.flags & 1) && row == 0)) *(GAS u32x4*)(u.out + (ptrdiff_t)row * u.ldc + (16 * pn + 4 * wc + fq) * 16) = o; }
    }
};
__device__ __forceinline__ int xcd_remap(int L0, int NU) { const int q = NU >> 3, r = NU & 7, x = L0 & 7, off = L0 >> 3; return (x < r ? x * (q + 1) : r * (q + 1) + (x - r) * q) + off; }
}

namespace attn {
constexpr int SLOTB = 8192;
constexpr int LDS_K = 0, LDS_V = 2 * SLOTB, LDS_WS = 4 * SLOTB, LDS_OST = LDS_WS + NWAVES * 256, LDS_END = LDS_OST + NWAVES * 4096;
static_assert(LDS_END <= RING_BYTES, "attention LDS");
__device__ __forceinline__ int crow(int r, int hi) { return (r & 3) + 8 * (r >> 2) + 4 * hi; }
__device__ __forceinline__ void glds16(const void* gsrc, unsigned lds_dst) { unsigned keep;
    asm volatile("s_mov_b32 %0, m0\n\ts_mov_b32 m0, %2\n\ts_nop 0\n\tglobal_load_lds_dwordx4 %1, off\n\ts_mov_b32 m0, %0" : "=&s"(keep) : "v"(gsrc), "s"(lds_dst) : "memory"); }
__device__ __forceinline__ float rowmax(const f32x16& p0, const f32x16& p1) {
    float a = fmaxf(p0[0], p1[0]);
#pragma unroll
    for (int r = 1; r < 16; ++r) a = fmaxf(a, fmaxf(p0[r], p1[r]));
    auto rr = __builtin_amdgcn_permlane32_swap(__float_as_uint(a), __float_as_uint(a), false, false);
    return fmaxf(__uint_as_float(rr[0]), __uint_as_float(rr[1]));
}
typedef short v4i16_t __attribute__((ext_vector_type(4)));
__device__ __forceinline__ s16x4 vtr(const LAS unsigned char* p) { return __builtin_bit_cast(s16x4, __builtin_amdgcn_ds_read_tr16_b64_v4i16((LAS v4i16_t*)p)); }
__device__ __forceinline__ void pv(f32x16* o, const LAS unsigned char* vp, bf16x8 pa0, bf16x8 pa1, bf16x8 pa2, bf16x8 pa3) {
#pragma unroll
    for (int d0 = 0; d0 < 2; ++d0) { s16x4 lo[4], hi[4];
#pragma unroll
        for (int ks = 0; ks < 4; ++ks) { lo[ks] = vtr(vp + d0 * 4096 + ks * 1024); hi[ks] = vtr(vp + d0 * 4096 + ks * 1024 + 512); }
#define PK(k) (bf16x8){lo[k][0], lo[k][1], lo[k][2], lo[k][3], hi[k][0], hi[k][1], hi[k][2], hi[k][3]}
        o[d0] = __builtin_amdgcn_mfma_f32_32x32x16_bf16(pa0, PK(0), o[d0], 0, 0, 0);
        o[d0] = __builtin_amdgcn_mfma_f32_32x32x16_bf16(pa1, PK(1), o[d0], 0, 0, 0);
        o[d0] = __builtin_amdgcn_mfma_f32_32x32x16_bf16(pa2, PK(2), o[d0], 0, 0, 0);
        o[d0] = __builtin_amdgcn_mfma_f32_32x32x16_bf16(pa3, PK(3), o[d0], 0, 0, 0);
#undef PK
    }
}
__device__ __forceinline__ void attn_unit(const bf16_t* Q, const bf16_t* K, const bf16_t* V, bf16_t* O, int b, int h, int q0, bool isctx, float sink2, LAS unsigned char* shm) {
    const int tid = opaque_tid(), lane = tid & 63, r32 = lane & 31, hi = lane >> 5; const int wid = __builtin_amdgcn_readfirstlane(tid >> 6);
    const int kvh = h >> 2;
    const long qrow = isctx ? (long)T + b * CTXL + wid * 32 : (long)b * SEQ + q0 + wid * 32;
    const unsigned lds0 = (unsigned)(uintptr_t)shm;
    LAS float* wsf = (LAS float*)(shm + LDS_WS) + wid * 64;
    int jlo = 0, nl = 0;
    if (!isctx) { jlo = (q0 == 0) ? 2 : 0; int jhi = (SEQ - q0 + 128) / 64; if (jhi > 8) jhi = 8; nl = jhi - jlo; }
    const int NT = nl + 4;
    const long lat0 = (long)b * SEQ + q0 - 128 + 64 * jlo, ctx0 = (long)T + b * CTXL;
#define TROW(t) ((t) < nl ? lat0 + 64 * (t) : ctx0 + 64 * ((t) - nl))
    const int kcol = kvh * 64 + wid * 8, vcol = kvh * 64 + (wid >> 2) * 32 + (lane & 3) * 8, vrow = 16 * (wid & 3) + (lane >> 2);
    const unsigned kdst = lds0 + LDS_K + wid * 1024, vdst = lds0 + LDS_V + wid * 1024;
#define DMA_KV(t, slot) do { const long tr_ = TROW(t); glds16(K + (tr_ + lane) * 256 + kcol, (unsigned)__builtin_amdgcn_readfirstlane(kdst + (slot) * SLOTB)); \
        glds16(V + (tr_ + vrow) * 256 + vcol, (unsigned)__builtin_amdgcn_readfirstlane(vdst + (slot) * SLOTB)); } while (0)
    DMA_KV(0, 0);
    bf16x8 qr[4];
#pragma unroll
    for (int d0 = 0; d0 < 4; ++d0) { const u32x2 w = *(const GAS u32x2*)((const unsigned char*)Q + (qrow + r32) * 1024 + h * 64 + d0 * 16 + hi * 8);
        const f32x2v a0 = __builtin_amdgcn_cvt_pk_f32_fp8((int)w.x, false), a1 = __builtin_amdgcn_cvt_pk_f32_fp8((int)w.x, true), a2 = __builtin_amdgcn_cvt_pk_f32_fp8((int)w.y, false), a3 = __builtin_amdgcn_cvt_pk_f32_fp8((int)w.y, true);
        u32x4 qw; qw.x = cvt_pk_bf16(a0[0] * (1.f / QSC), a0[1] * (1.f / QSC)); qw.y = cvt_pk_bf16(a1[0] * (1.f / QSC), a1[1] * (1.f / QSC)); qw.z = cvt_pk_bf16(a2[0] * (1.f / QSC), a2[1] * (1.f / QSC)); qw.w = cvt_pk_bf16(a3[0] * (1.f / QSC), a3[1] * (1.f / QSC));
        qr[d0] = __builtin_bit_cast(bf16x8, qw); }
    float mrun = sink2, l_reg = (hi == 0) ? 1.f : 0.f;
    f32x16 negm;
#pragma unroll
    for (int r = 0; r < 16; ++r) negm[r] = -sink2;
    f32x16 o[2];
#pragma unroll
    for (int r = 0; r < 16; ++r) { o[0][r] = 0.f; o[1][r] = 0.f; }
    const LAS unsigned char* vp0 = shm + LDS_V + ((lane >> 4) & 1) * 32 + (lane & 3) * 8 + (4 * hi + ((lane & 15) >> 2)) * 64;
    const int qw = q0 + wid * 32;
    asm volatile("s_waitcnt vmcnt(0) lgkmcnt(0)\n\ts_barrier" ::: "memory");
    for (int t = 0; t < NT; ++t) {
        const int slot = t & 1;
        if (t + 1 < NT) DMA_KV(t + 1, slot ^ 1);
        const bool latt = t < nl;
        const int ks = q0 - 128 + 64 * (jlo + t);
        bool need = true;
        if (latt) need = (ks + 63 >= qw - 128) && (ks <= qw + 31 + 128);
        if (need) {
            f32x16 p0, p1;
            const LAS unsigned char* kb = shm + LDS_K + slot * SLOTB + hi * 1024 + r32 * 16;
#pragma unroll
            for (int d0 = 0; d0 < 4; ++d0) {
                const bf16x8 b0 = *(const LAS bf16x8*)(kb + d0 * 2048), b1 = *(const LAS bf16x8*)(kb + d0 * 2048 + 512);
                if (d0 == 0) { p0 = __builtin_amdgcn_mfma_f32_32x32x16_bf16(b0, qr[0], negm, 0, 0, 0); p1 = __builtin_amdgcn_mfma_f32_32x32x16_bf16(b1, qr[0], negm, 0, 0, 0); }
                else { p0 = __builtin_amdgcn_mfma_f32_32x32x16_bf16(b0, qr[d0], p0, 0, 0, 0); p1 = __builtin_amdgcn_mfma_f32_32x32x16_bf16(b1, qr[d0], p1, 0, 0, 0); } }
            if (latt && !(ks >= qw - 97 && ks <= qw + 65)) {
                const int dq = qw + r32 - ks;
#pragma unroll
                for (int r = 0; r < 16; ++r) { const int d = dq - crow(r, hi); if (d > 128 || d < -128) p0[r] = -INFINITY; if (d - 32 > 128 || d - 32 < -128) p1[r] = -INFINITY; } }
            const float rm = rowmax(p0, p1);
            if (__any(rm > 8.f)) {
                const float delta = fmaxf(rm, 0.f);
                const float alpha = __builtin_amdgcn_exp2f(-delta); l_reg *= alpha; mrun += delta;
#pragma unroll
                for (int r = 0; r < 16; ++r) { p0[r] -= delta; p1[r] -= delta; negm[r] = -mrun; }
                if (hi == 0) wsf[r32] = alpha;
                asm volatile("s_waitcnt lgkmcnt(0)" ::: "memory");
#pragma unroll
                for (int r = 0; r < 16; ++r) { const float f = wsf[crow(r, hi)]; o[0][r] *= f; o[1][r] *= f; }
            }
            float sacc = 0.f;
#pragma unroll
            for (int r = 0; r < 16; ++r) { p0[r] = __builtin_amdgcn_exp2f(p0[r]); p1[r] = __builtin_amdgcn_exp2f(p1[r]); sacc += p0[r] + p1[r]; }
            l_reg += sacc;
            u32x4 pw0, pw1, pw2, pw3;
#define PKW(P, B) cvt_pk_bf16(P[B], P[B + 1])
            pw0 = (u32x4){PKW(p0, 0), PKW(p0, 2), PKW(p0, 4), PKW(p0, 6)}; pw1 = (u32x4){PKW(p0, 8), PKW(p0, 10), PKW(p0, 12), PKW(p0, 14)};
            pw2 = (u32x4){PKW(p1, 0), PKW(p1, 2), PKW(p1, 4), PKW(p1, 6)}; pw3 = (u32x4){PKW(p1, 8), PKW(p1, 10), PKW(p1, 12), PKW(p1, 14)};
#undef PKW
            __builtin_amdgcn_sched_barrier(0);
            pv(o, vp0 + slot * SLOTB, __builtin_bit_cast(bf16x8, pw0), __builtin_bit_cast(bf16x8, pw1), __builtin_bit_cast(bf16x8, pw2), __builtin_bit_cast(bf16x8, pw3));
        }
        asm volatile("s_waitcnt vmcnt(0) lgkmcnt(0)\n\ts_barrier" ::: "memory");
    }
    { auto rr = __builtin_amdgcn_permlane32_swap(__float_as_uint(l_reg), __float_as_uint(l_reg), false, false); l_reg = __uint_as_float(rr[0]) + __uint_as_float(rr[1]); }
    if (hi == 0) wsf[32 + r32] = l_reg;
    asm volatile("s_waitcnt lgkmcnt(0)" ::: "memory");
    float rli[16];
#pragma unroll
    for (int r = 0; r < 16; ++r) rli[r] = __builtin_amdgcn_rcpf(wsf[32 + crow(r, hi)]);
    unsigned char* Ow = (unsigned char*)O + qrow * 1024 + h * 64;
    { LAS unsigned char* stg = shm + LDS_OST + wid * 2048;
#pragma unroll
      for (int r = 0; r < 16; ++r) { const int orow = crow(r, hi);
#pragma unroll
          for (int d0 = 0; d0 < 2; ++d0) stg[orow * 64 + d0 * 32 + r32] = (unsigned char)f2f8(o[d0][r] * rli[r]); }
      asm volatile("s_waitcnt lgkmcnt(0)" ::: "memory");
#pragma unroll
      for (int i = 0; i < 2; ++i) { const int row = i * 16 + (lane >> 2), ch = lane & 3; const u32x4 v = *(const LAS u32x4*)(stg + row * 64 + ch * 16); *(GAS u32x4*)(Ow + (long)row * 1024 + ch * 16) = v; } }
    asm volatile("s_waitcnt lgkmcnt(0)" ::: "memory");
#undef TROW
#undef DMA_KV
}
__device__ __forceinline__ void attn_unit2(const bf16_t* Q, const bf16_t* K, const bf16_t* V, bf16_t* O, int b, int h0, int q0, bool isctx, float sinkA, float sinkB, LAS unsigned char* shm) {
    const int tid = opaque_tid(), lane = tid & 63, r32 = lane & 31, hi = lane >> 5; const int wid = __builtin_amdgcn_readfirstlane(tid >> 6);
    const int kvh = h0 >> 2;
    const long qrow = isctx ? (long)T + b * CTXL + wid * 32 : (long)b * SEQ + q0 + wid * 32;
    const unsigned lds0 = (unsigned)(uintptr_t)shm;
    LAS float* wsf = (LAS float*)(shm + LDS_WS) + wid * 64;
    int jlo = 0, nl = 0;
    if (!isctx) { jlo = (q0 == 0) ? 2 : 0; int jhi = (SEQ - q0 + 128) / 64; if (jhi > 8) jhi = 8; nl = jhi - jlo; }
    const int NT = nl + 4;
    const long lat0 = (long)b * SEQ + q0 - 128 + 64 * jlo, ctx0 = (long)T + b * CTXL;
#define TROW(t) ((t) < nl ? lat0 + 64 * (t) : ctx0 + 64 * ((t) - nl))
    const int kcol = kvh * 64 + wid * 8, vcol = kvh * 64 + (wid >> 2) * 32 + (lane & 3) * 8, vrow = 16 * (wid & 3) + (lane >> 2);
    const unsigned kdst = lds0 + LDS_K + wid * 1024, vdst = lds0 + LDS_V + wid * 1024;
#define DMA_KV(t, slot) do { const long tr_ = TROW(t); glds16(K + (tr_ + lane) * 256 + kcol, (unsigned)__builtin_amdgcn_readfirstlane(kdst + (slot) * SLOTB)); \
        glds16(V + (tr_ + vrow) * 256 + vcol, (unsigned)__builtin_amdgcn_readfirstlane(vdst + (slot) * SLOTB)); } while (0)
    DMA_KV(0, 0);
    bf16x8 qr[2][4];
#pragma unroll
    for (int hh = 0; hh < 2; ++hh)
#pragma unroll
        for (int d0 = 0; d0 < 4; ++d0) { const u32x2 w = __builtin_nontemporal_load((const GAS u32x2*)((const unsigned char*)Q + (qrow + r32) * 1024 + (h0 + hh) * 64 + d0 * 16 + hi * 8));
            const f32x2v a0 = __builtin_amdgcn_cvt_pk_f32_fp8((int)w.x, false), a1 = __builtin_amdgcn_cvt_pk_f32_fp8((int)w.x, true), a2 = __builtin_amdgcn_cvt_pk_f32_fp8((int)w.y, false), a3 = __builtin_amdgcn_cvt_pk_f32_fp8((int)w.y, true);
            u32x4 qw; qw.x = cvt_pk_bf16(a0[0] * (1.f / QSC), a0[1] * (1.f / QSC)); qw.y = cvt_pk_bf16(a1[0] * (1.f / QSC), a1[1] * (1.f / QSC)); qw.z = cvt_pk_bf16(a2[0] * (1.f / QSC), a2[1] * (1.f / QSC)); qw.w = cvt_pk_bf16(a3[0] * (1.f / QSC), a3[1] * (1.f / QSC));
            qr[hh][d0] = __builtin_bit_cast(bf16x8, qw); }
    float mrun[2] = {sinkA, sinkB}, l_reg[2] = {(hi == 0) ? 1.f : 0.f, (hi == 0) ? 1.f : 0.f};
    f32x16 o[2][2];
#pragma unroll
    for (int hh = 0; hh < 2; ++hh)
#pragma unroll
        for (int r = 0; r < 16; ++r) { o[hh][0][r] = 0.f; o[hh][1][r] = 0.f; }
    const LAS unsigned char* vp0 = shm + LDS_V + ((lane >> 4) & 1) * 32 + (lane & 3) * 8 + (4 * hi + ((lane & 15) >> 2)) * 64;
    const int qw = q0 + wid * 32;
    asm volatile("s_waitcnt vmcnt(0) lgkmcnt(0)\n\ts_barrier" ::: "memory");
    for (int t = 0; t < NT; ++t) {
        const int slot = t & 1;
        if (t + 1 < NT) DMA_KV(t + 1, slot ^ 1);
        const bool latt = t < nl;
        const int ks = q0 - 128 + 64 * (jlo + t);
        bool need = true;
        if (latt) need = (ks + 63 >= qw - 128) && (ks <= qw + 31 + 128);
        if (need) {
            f32x16 p[2][2];
            { f32x16 nm0, nm1;
#pragma unroll
              for (int r = 0; r < 16; ++r) { nm0[r] = -mrun[0]; nm1[r] = -mrun[1]; }
              const LAS unsigned char* kb = shm + LDS_K + slot * SLOTB + hi * 1024 + r32 * 16;
#pragma unroll
              for (int d0 = 0; d0 < 4; ++d0) {
                const bf16x8 b0 = *(const LAS bf16x8*)(kb + d0 * 2048), b1 = *(const LAS bf16x8*)(kb + d0 * 2048 + 512);
                if (d0 == 0) { p[0][0] = __builtin_amdgcn_mfma_f32_32x32x16_bf16(b0, qr[0][0], nm0, 0, 0, 0); p[0][1] = __builtin_amdgcn_mfma_f32_32x32x16_bf16(b1, qr[0][0], nm0, 0, 0, 0);
                               p[1][0] = __builtin_amdgcn_mfma_f32_32x32x16_bf16(b0, qr[1][0], nm1, 0, 0, 0); p[1][1] = __builtin_amdgcn_mfma_f32_32x32x16_bf16(b1, qr[1][0], nm1, 0, 0, 0); }
                else {
#pragma unroll
                    for (int hh = 0; hh < 2; ++hh) { p[hh][0] = __builtin_amdgcn_mfma_f32_32x32x16_bf16(b0, qr[hh][d0], p[hh][0], 0, 0, 0); p[hh][1] = __builtin_amdgcn_mfma_f32_32x32x16_bf16(b1, qr[hh][d0], p[hh][1], 0, 0, 0); } } } }
            if (latt && !(ks >= qw - 97 && ks <= qw + 65)) {
                const int dq = qw + r32 - ks;
#pragma unroll
                for (int r = 0; r < 16; ++r) { const int d = dq - crow(r, hi);
                    if (d > 128 || d < -128) { p[0][0][r] = -INFINITY; p[1][0][r] = -INFINITY; }
                    if (d - 32 > 128 || d - 32 < -128) { p[0][1][r] = -INFINITY; p[1][1][r] = -INFINITY; } } }
            u32x4 pw[2][4];
#pragma unroll
            for (int hh = 0; hh < 2; ++hh) {
                bool big = false;
#pragma unroll
                for (int r = 0; r < 16; ++r) big = big | (__builtin_bit_cast(int, p[hh][0][r]) > 0x41000000) | (__builtin_bit_cast(int, p[hh][1][r]) > 0x41000000);
                if (__any(big)) {
                    const float rm = rowmax(p[hh][0], p[hh][1]);
                    const float delta = fmaxf(rm, 0.f);
                    const float alpha = __builtin_amdgcn_exp2f(-delta); l_reg[hh] *= alpha; mrun[hh] += delta;
#pragma unroll
                    for (int r = 0; r < 16; ++r) { p[hh][0][r] -= delta; p[hh][1][r] -= delta; }
                    if (hi == 0) wsf[r32] = alpha;
                    asm volatile("s_waitcnt lgkmcnt(0)" ::: "memory");
#pragma unroll
                    for (int r = 0; r < 16; ++r) { const float f = wsf[crow(r, hi)]; o[hh][0][r] *= f; o[hh][1][r] *= f; }
                    asm volatile("s_waitcnt lgkmcnt(0)" ::: "memory");
                }
                float sacc = 0.f;
#pragma unroll
                for (int r = 0; r < 16; ++r) { p[hh][0][r] = __builtin_amdgcn_exp2f(p[hh][0][r]); p[hh][1][r] = __builtin_amdgcn_exp2f(p[hh][1][r]); sacc += p[hh][0][r] + p[hh][1][r]; }
                l_reg[hh] += sacc;
#define PKW(P, B) cvt_pk_bf16(P[B], P[B + 1])
                pw[hh][0] = (u32x4){PKW(p[hh][0], 0), PKW(p[hh][0], 2), PKW(p[hh][0], 4), PKW(p[hh][0], 6)}; pw[hh][1] = (u32x4){PKW(p[hh][0], 8), PKW(p[hh][0], 10), PKW(p[hh][0], 12), PKW(p[hh][0], 14)};
                pw[hh][2] = (u32x4){PKW(p[hh][1], 0), PKW(p[hh][1], 2), PKW(p[hh][1], 4), PKW(p[hh][1], 6)}; pw[hh][3] = (u32x4){PKW(p[hh][1], 8), PKW(p[hh][1], 10), PKW(p[hh][1], 12), PKW(p[hh][1], 14)};
#undef PKW
            }
            __builtin_amdgcn_sched_barrier(0);
            { const LAS unsigned char* vp = vp0 + slot * SLOTB;
#pragma unroll
              for (int d0 = 0; d0 < 2; ++d0) { s16x4 lo[4], hh4[4];
#pragma unroll
                for (int k4 = 0; k4 < 4; ++k4) { lo[k4] = vtr(vp + d0 * 4096 + k4 * 1024); hh4[k4] = vtr(vp + d0 * 4096 + k4 * 1024 + 512); }
#pragma unroll
                for (int hh = 0; hh < 2; ++hh)
#pragma unroll
                    for (int k4 = 0; k4 < 4; ++k4) { const bf16x8 vb8 = (bf16x8){lo[k4][0], lo[k4][1], lo[k4][2], lo[k4][3], hh4[k4][0], hh4[k4][1], hh4[k4][2], hh4[k4][3]};
                        o[hh][d0] = __builtin_amdgcn_mfma_f32_32x32x16_bf16(__builtin_bit_cast(bf16x8, pw[hh][k4]), vb8, o[hh][d0], 0, 0, 0); } } }
        }
        asm volatile("s_waitcnt vmcnt(0) lgkmcnt(0)\n\ts_barrier" ::: "memory");
    }
#pragma unroll
    for (int hh = 0; hh < 2; ++hh) {
        float lr = l_reg[hh];
        { auto rr = __builtin_amdgcn_permlane32_swap(__float_as_uint(lr), __float_as_uint(lr), false, false); lr = __uint_as_float(rr[0]) + __uint_as_float(rr[1]); }
        if (hi == 0) wsf[32 + r32] = lr;
        asm volatile("s_waitcnt lgkmcnt(0)" ::: "memory");
        float rli[16];
#pragma unroll
        for (int r = 0; r < 16; ++r) rli[r] = __builtin_amdgcn_rcpf(wsf[32 + crow(r, hi)]);
        asm volatile("s_waitcnt lgkmcnt(0)" ::: "memory");
        unsigned char* Ow = (unsigned char*)O + qrow * 1024 + (h0 + hh) * 64;
        LAS unsigned char* stg = shm + LDS_OST + wid * 4096 + hh * 2048;
#pragma unroll
        for (int r = 0; r < 16; ++r) { const int orow = crow(r, hi);
#pragma unroll
            for (int d0 = 0; d0 < 2; ++d0) stg[orow * 64 + d0 * 32 + r32] = (unsigned char)f2f8(o[hh][d0][r] * rli[r]); }
        asm volatile("s_waitcnt lgkmcnt(0)" ::: "memory");
#pragma unroll
        for (int i = 0; i < 2; ++i) { const int row = i * 16 + (lane >> 2), ch = lane & 3; const u32x4 v = *(const LAS u32x4*)(stg + row * 64 + ch * 16); *(GAS u32x4*)(Ow + (long)row * 1024 + ch * 16) = v; }
    }
    asm volatile("s_waitcnt lgkmcnt(0)" ::: "memory");
#undef TROW
#undef DMA_KV
}
}

struct Args {
    const float* in[20];
    float* out; unsigned char* ws;
};
struct Frame {
    LAS unsigned char* lds; unsigned* ctl; unsigned char* ws;
    int tid, lane, wave, gw;
    int blk;
    __device__ __forceinline__ void refresh() { tid = opaque_tid(); lane = tid & 63; wave = __builtin_amdgcn_readfirstlane(tid >> 6); gw = blk * 8 + wave;
        asm volatile("" : "+s"(ws)); ctl = (unsigned*)(ws + WS_CTL); }
};
constexpr int NGW = GRID * NWAVES;

struct Row { f32x4 v[4]; };
__device__ __forceinline__ int vq(int q, int lane) { return 64 * (lane >> 4) + 2 * (lane & 15) + 32 * (q >> 1) + (q & 1); }
__device__ __forceinline__ int vb(int j, int lane) { return 32 * (lane >> 4) + (lane & 15) + 16 * j; }
__device__ __forceinline__ void row_load_bf16(Row& r, const bf16_t* p, int lane) {
#pragma unroll
    for (int j = 0; j < 2; ++j) { const u32x4 w = __builtin_nontemporal_load((const GAS u32x4*)p + vb(j, lane)); r.v[2 * j] = (f32x4){bflo(w.x), bfhi(w.x), bflo(w.y), bfhi(w.y)}; r.v[2 * j + 1] = (f32x4){bflo(w.z), bfhi(w.z), bflo(w.w), bfhi(w.w)}; } }
__device__ __forceinline__ void row_store_bf16(const Row& r, bf16_t* p, int lane) {
#pragma unroll
    for (int j = 0; j < 2; ++j) { u32x4 w; w.x = pk2(r.v[2 * j][0], r.v[2 * j][1]); w.y = pk2(r.v[2 * j][2], r.v[2 * j][3]); w.z = pk2(r.v[2 * j + 1][0], r.v[2 * j + 1][1]); w.w = pk2(r.v[2 * j + 1][2], r.v[2 * j + 1][3]); ((GAS u32x4*)p)[vb(j, lane)] = w; } }
__device__ __forceinline__ void row_load_fp8(Row& r, const unsigned char* p, int lane) {
    const u32x4 w = __builtin_nontemporal_load((const GAS u32x4*)p + lane);
#pragma unroll
    for (int q = 0; q < 4; ++q) { const f32x2v lo = __builtin_amdgcn_cvt_pk_f32_fp8((int)w[q], false), hi = __builtin_amdgcn_cvt_pk_f32_fp8((int)w[q], true); r.v[q] = (f32x4){lo[0], lo[1], hi[0], hi[1]}; } }
__device__ __forceinline__ void row_store_fp8(const Row& r, unsigned char* p, int lane) {
    const int e0 = 256 * (lane >> 4) + 8 * (lane & 15);
#pragma unroll
    for (int j = 0; j < 2; ++j) { int w0 = 0, w1 = 0;
        w0 = __builtin_amdgcn_cvt_pk_fp8_f32(r.v[2 * j][0], r.v[2 * j][1], w0, false); w0 = __builtin_amdgcn_cvt_pk_fp8_f32(r.v[2 * j][2], r.v[2 * j][3], w0, true);
        w1 = __builtin_amdgcn_cvt_pk_fp8_f32(r.v[2 * j + 1][0], r.v[2 * j + 1][1], w1, false); w1 = __builtin_amdgcn_cvt_pk_fp8_f32(r.v[2 * j + 1][2], r.v[2 * j + 1][3], w1, true);
        u32x2 o; o.x = (unsigned)w0; o.y = (unsigned)w1; *(GAS u32x2*)(p + e0 + 128 * j) = o; } }
__device__ __forceinline__ void row_load_f32(Row& r, const float* p, int lane) {
#pragma unroll
    for (int q = 0; q < 4; ++q) r.v[q] = __builtin_nontemporal_load((const GAS f32x4*)p + vq(q, lane)); }
__device__ __forceinline__ void row_store_f32(const Row& r, float* p, int lane) {
#pragma unroll
    for (int q = 0; q < 4; ++q) ((GAS f32x4*)p)[vq(q, lane)] = r.v[q]; }
__device__ __forceinline__ void row_normalize(Row& r, float eps) {
    float s = 0.f;
#pragma unroll
    for (int j = 0; j < 4; ++j) s += (r.v[j][0] + r.v[j][1]) + (r.v[j][2] + r.v[j][3]);
    const float mean = wave_sum(s) * (1.f / D); float q = 0.f;
#pragma unroll
    for (int j = 0; j < 4; ++j) { r.v[j] = r.v[j] - mean; q += (r.v[j][0] * r.v[j][0] + r.v[j][1] * r.v[j][1]) + (r.v[j][2] * r.v[j][2] + r.v[j][3] * r.v[j][3]); }
    const float rstd = 1.f / sqrtf(wave_sum(q) * (1.f / D) + eps);
#pragma unroll
    for (int j = 0; j < 4; ++j) r.v[j] = r.v[j] * rstd;
}
__device__ __forceinline__ void row_normalize_stats(Row& r, float eps, float& mean_o, float& rstd_o) {
    float s = 0.f;
#pragma unroll
    for (int j = 0; j < 4; ++j) s += (r.v[j][0] + r.v[j][1]) + (r.v[j][2] + r.v[j][3]);
    const float mean = wave_sum(s) * (1.f / D); float q = 0.f;
#pragma unroll
    for (int j = 0; j < 4; ++j) { r.v[j] = r.v[j] - mean; q += (r.v[j][0] * r.v[j][0] + r.v[j][1] * r.v[j][1]) + (r.v[j][2] * r.v[j][2] + r.v[j][3] * r.v[j][3]); }
    const float rstd = 1.f / sqrtf(wave_sum(q) * (1.f / D) + eps);
#pragma unroll
    for (int j = 0; j < 4; ++j) r.v[j] = r.v[j] * rstd;
    mean_o = mean; rstd_o = rstd;
}
__device__ __forceinline__ void row_modulate(Row& r, const float* sh, const float* sc, int lane) {
    row_normalize(r, MOD_EPS);
#pragma unroll
    for (int j = 0; j < 4; ++j) { const f32x4 a = ((const GAS f32x4*)sc)[vq(j, lane)], b = ((const GAS f32x4*)sh)[vq(j, lane)]; r.v[j] = r.v[j] * (a + 1.f) + b; }
}
__device__ __forceinline__ int mod_row(int row) { return row < T ? (row >> 11) : 32; }
__device__ __forceinline__ const float* mod_vec(const unsigned char* ws, int layer, int mr, int chunk) { return (const float*)(ws + WS_MOD) + ((size_t)(layer * 33 + mr) * 6 + chunk) * 1024; }

__device__ __forceinline__ void conv_item(const float* W, int N, bf16_t* WT, int Kd, int kd0, int n0, int drow0, bool mirror, LAS float* scr, int lane) {
#pragma unroll 8
    for (int i = 0; i < 32; ++i) { const int kk = 2 * i + (lane >> 5); const int kd = kd0 + kk; const int ks = mirror ? ((kd & ~255) + ((256 - (kd & 255)) & 255)) : kd;
        scr[kk * 33 + (lane & 31)] = ((const GAS float*)W)[(size_t)ks * N + n0 + (lane & 31)]; }
    LDS_WAIT(); asm volatile("" ::: "memory");
    const int c = lane & 7;
#pragma unroll
    for (int j = 0; j < 4; ++j) { const int n = (lane >> 3) + 8 * j; const LAS float* s = scr + (8 * c) * 33 + n;
        u32x4 o; o.x = pk2(s[0 * 33], s[1 * 33]); o.y = pk2(s[2 * 33], s[3 * 33]); o.z = pk2(s[4 * 33], s[5 * 33]); o.w = pk2(s[6 * 33], s[7 * 33]);
        *(GAS u32x4*)(WT + (size_t)(drow0 + n) * Kd + kd0 + 8 * c) = o; }
    LDS_WAIT(); asm volatile("" ::: "memory");
}
__device__ __forceinline__ void conv_matrix_item(const float* W, int K, int N, bf16_t* WT, int mode, int roff, int item, LAS float* scr, int lane) {
    const int nblk = N / 32, kb = item / nblk, nb = item % nblk, n0 = 32 * nb;
    int drow0 = n0 + roff; if (mode == 1) drow0 = (n0 >> 7) * 256 + (n0 & 127); if (mode == 2) drow0 = (n0 >> 7) * 256 + 128 + (n0 & 127);
    conv_item(W, N, WT, K, 64 * kb, n0, drow0, mode == 3, scr, lane);
}
__device__ __forceinline__ void conv_item64(const float* W, int N, bf16_t* WT, int Kd, int k0, int n0, int drow0, LAS bf16_t* scr, int lane) {
    f32x4 v[16];
#pragma unroll
    for (int i = 0; i < 16; ++i) v[i] = *(const GAS f32x4*)(W + (size_t)(k0 + 4 * i + (lane >> 4)) * N + n0 + (lane & 15) * 4);
#pragma unroll
    for (int i = 0; i < 16; ++i) { u32x2 w; w.x = pk2(v[i][0], v[i][1]); w.y = pk2(v[i][2], v[i][3]); *(LAS u32x2*)(scr + (4 * i + (lane >> 4)) * 68 + (lane & 15) * 4) = w; }
    LDS_WAIT(); asm volatile("" ::: "memory");
    const int c = lane & 7;
#pragma unroll
    for (int j = 0; j < 8; ++j) { const int n = (lane >> 3) + 8 * j; const LAS bf16_t* p = scr + (8 * c) * 68 + n;
        u32x4 o; o.x = (unsigned)p[0] | ((unsigned)p[68] << 16); o.y = (unsigned)p[2 * 68] | ((unsigned)p[3 * 68] << 16); o.z = (unsigned)p[4 * 68] | ((unsigned)p[5 * 68] << 16); o.w = (unsigned)p[6 * 68] | ((unsigned)p[7 * 68] << 16);
        *(GAS u32x4*)(WT + (size_t)(drow0 + n) * Kd + k0 + 8 * c) = o; }
    LDS_WAIT(); asm volatile("" ::: "memory");
}
__device__ __forceinline__ void conv_item64_f8(const float* W, int N, unsigned char* WT, int Kd, int k0, int n0, int drow0, LAS unsigned char* scr, int lane, bool mirror = false) {
    f32x4 v[16];
#pragma unroll
    for (int i = 0; i < 16; ++i) { const int kd = k0 + 4 * i + (lane >> 4); const int ks = mirror ? ((kd & ~255) + ((256 - (kd & 255)) & 255)) : kd; v[i] = __builtin_nontemporal_load((const GAS f32x4*)(W + (size_t)ks * N + n0 + (lane & 15) * 4)); }
#pragma unroll
    for (int i = 0; i < 16; ++i) { int w = 0; w = __builtin_amdgcn_cvt_pk_fp8_f32(v[i][0] * 64.f, v[i][1] * 64.f, w, false); w = __builtin_amdgcn_cvt_pk_fp8_f32(v[i][2] * 64.f, v[i][3] * 64.f, w, true);
        *(LAS unsigned*)(scr + (4 * i + (lane >> 4)) * 68 + (lane & 15) * 4) = (unsigned)w; }
    LDS_WAIT(); asm volatile("" ::: "memory");
    const int c = lane & 3;
#pragma unroll
    for (int j = 0; j < 4; ++j) { const int n = (lane >> 2) + 16 * j; const LAS unsigned char* p = scr + (16 * c) * 68 + n; u32x4 o;
#pragma unroll
        for (int q = 0; q < 4; ++q) o[q] = (unsigned)p[(4 * q) * 68] | ((unsigned)p[(4 * q + 1) * 68] << 8) | ((unsigned)p[(4 * q + 2) * 68] << 16) | ((unsigned)p[(4 * q + 3) * 68] << 24);
        *(GAS u32x4*)(WT + (size_t)(drow0 + n) * Kd + k0 + 16 * c) = o; }
    LDS_WAIT(); asm volatile("" ::: "memory");
}
__device__ __forceinline__ void conv_experts(Frame& F, const Args& a, int layer) {
    F.refresh();
    LAS unsigned char* scr = F.lds + 32768 + F.wave * 4352;
    unsigned char* EGU = F.ws + WS_EGU; unsigned char* ED = F.ws + WS_ED;
    for (int it = F.gw; it < (NE + 1) * 192; it += NGW) { const int e = it / 192, r = it % 192;
        const float* wg = e < NE ? a.in[14] + ((size_t)layer * NE + e) * 262144 : a.in[17] + (size_t)layer * 262144;
        const float* wu = e < NE ? a.in[15] + ((size_t)layer * NE + e) * 262144 : a.in[18] + (size_t)layer * 262144;
        const float* wd = e < NE ? a.in[16] + ((size_t)layer * NE + e) * 262144 : a.in[19] + (size_t)layer * 262144;
        if (r < 128) { const int q = r & 63, kb = q >> 2, nb = q & 3, n0 = 64 * nb; const int drow0 = (n0 >> 7) * 256 + (r < 64 ? 0 : 128) + (n0 & 127);
            conv_item64_f8(r < 64 ? wg : wu, 256, EGU + (size_t)e * 512 * 1024, 1024, 64 * kb, n0, drow0, scr, F.lane); }
        else { const int q = r - 128, kb = q >> 4, nb = q & 15; conv_item64_f8(wd, 1024, ED + (size_t)e * 1024 * 256, 256, 64 * kb, 64 * nb, 64 * nb, scr, F.lane); } }
}
__device__ __forceinline__ void conv_small(Frame& F, const Args& a) {
    F.refresh();
    { LAS unsigned char* scr8 = F.lds + 32768 + F.wave * 4352;
      for (int it = F.gw; it < 2304; it += NGW) {
          if (it < 768) { const int j = it / 384, r = it % 384, kb = r / 24, nb = r % 24; conv_item64_f8(a.in[8] + (size_t)j * 1024 * 1536, 1536, F.ws + WS_WQKV + (size_t)j * 1536 * 1024, 1024, 64 * kb, 64 * nb, 64 * nb, scr8, F.lane); }
          else if (it < 1280) { const int q = it - 768, j = q >> 8, r = q & 255, kb = r >> 4, nb = r & 15; conv_item64_f8(a.in[9] + (size_t)j * 1024 * 1024, 1024, F.ws + WS_WO + (size_t)j * 1024 * 1024, 1024, 64 * kb, 64 * nb, 64 * nb, scr8, F.lane); }
          else { const int q = it - 1280, j = q >> 9, r = q & 511, mir = r >> 8, kb = (r & 255) >> 4, nb = r & 15;
              conv_item64_f8(a.in[11] + (size_t)j * 1024 * 1024, 1024, F.ws + WS_WSH + (size_t)j * 2048 * 1024, 1024, 64 * kb, 64 * nb, 64 * nb + 1024 * mir, scr8, F.lane, mir != 0); } } }
    __syncthreads();
    { LAS float* scr = (LAS float*)(F.lds + 32768 + F.wave * 8448);
      for (int it = F.gw; it < 1152; it += NGW) {
          if (it < 1024) { const int j = it >> 9, r = it & 511; conv_matrix_item(a.in[11] + (size_t)j * 1024 * 1024, 1024, 1024, (bf16_t*)(F.ws + WS_WF) + (size_t)j * 2048 * 1024, 0, 0, r, scr, F.lane); }
          else { const int q = it - 1024, l = q / 32, r = q % 32; conv_matrix_item(a.in[12] + (size_t)l * 1024 * 64, 1024, 64, (bf16_t*)(F.ws + WS_WR) + (size_t)l * 64 * 1024, 0, 0, r, scr, F.lane); } } }
    const int gt = F.blk * NTHR + F.tid, NGT = GRID * NTHR;
    const float TWO_PI = 6.283185307179586f;
    { float* rc = (float*)(F.ws + WS_ROPEC); float* rs = (float*)(F.ws + WS_ROPES);
      for (int i = gt; i < 64 * 16; i += NGT) { const int pos = i >> 4, fi = i & 15; const float inv = exp2f(-(float)fi * (13.287712379549449f / 16.f)); const float ang = (float)pos * inv; rc[i] = cosf(ang); rs[i] = sinf(ang); } }
    { unsigned* cs = (unsigned*)(F.ws + WS_CSN);
      for (int i = gt; i < 512 * 64; i += NGT) { const int r = i >> 6, n4 = (i & 63) * 4, m = r & 255; unsigned w = 0;
#pragma unroll
          for (int q = 0; q < 4; ++q) { const float ang = TWO_PI * (float)((m * (n4 + q)) & 255) * (1.f / 256.f); w |= f2f8(r < 256 ? __cosf(ang) : -__sinf(ang)) << (8 * q); }
          cs[i] = w; } }
    { unsigned* dl = (unsigned*)(F.ws + WS_DL);
      for (int i = gt; i < 1024 * 1024; i += NGT) { const int k = i >> 10, c4 = (i & 1023) * 4; unsigned w = 0;
#pragma unroll
          for (int q = 0; q < 4; ++q) { const int c = c4 + q, l = c & 2047; const float ang = TWO_PI * (float)((k * l) & 2047) * (1.f / 2048.f); w |= f2f8(c < 2048 ? __cosf(ang) : __sinf(ang)) << (8 * q); }
          dl[i] = w; } }
    { unsigned* dl = (unsigned*)(F.ws + WS_DLC);
      for (int i = gt; i < 256 * 128; i += NGT) { const int k = i >> 7, c4 = (i & 127) * 4; unsigned w = 0;
#pragma unroll
          for (int q = 0; q < 4; ++q) { const int c = c4 + q, l = c & 255; const float ang = TWO_PI * (float)((k * l) & 255) * (1.f / 256.f); w |= f2f8(c < 256 ? __cosf(ang) : __sinf(ang)) << (8 * q); }
          dl[i] = w; } }
}
__device__ __forceinline__ void mod_full(Frame& F, const Args& a) {
    F.refresh();
    if (F.blk >= 192) return;
    const int l = F.blk / 48, cb = F.blk % 48; const int g = F.tid & 31, ks = F.tid >> 5; const int n0 = cb * 128;
    LAS float* s = (LAS float*)F.lds;
    f32x4 acc[33];
#pragma unroll
    for (int r = 0; r < 33; ++r) acc[r] = (f32x4){0.f, 0.f, 0.f, 0.f};
    for (int half = 0; half < 2; ++half) {
        __syncthreads();
        for (int i = F.tid; i < 512 * 33; i += NTHR) { const int k = i / 33, r = i % 33; const float c = (r < 32) ? a.in[1][(size_t)r * 1024 + half * 512 + k] : a.in[3][half * 512 + k]; s[k * 36 + r] = c / (1.f + __expf(-c)); }
        __syncthreads();
        const GAS f32x4* w = (const GAS f32x4*)((const GAS float*)a.in[4] + ((size_t)l * 1024 + half * 512 + ks * 32) * 6144 + n0 + 4 * g);
#pragma unroll 1
        for (int kb = 0; kb < 32; kb += 8) { f32x4 wv[8];
#pragma unroll
            for (int q = 0; q < 8; ++q) wv[q] = __builtin_nontemporal_load(w + (size_t)(kb + q) * (6144 / 4));
#pragma unroll
            for (int q = 0; q < 8; ++q) { const LAS float* sr = s + (ks * 32 + kb + q) * 36;
#pragma unroll
                for (int r = 0; r < 33; ++r) acc[r] += wv[q] * sr[r];
                asm volatile("" ::: "memory"); } }
    }
    LAS float* red = (LAS float*)F.lds;
    float* mod = (float*)(F.ws + WS_MOD);
#define MF_PASS(r0, nr) do { __syncthreads(); \
        _Pragma("unroll") for (int rr = 0; rr < (nr); ++rr) *(LAS f32x4*)(red + ((ks * 8 + rr) * 128 + 4 * g)) = acc[(r0) + rr]; \
        __syncthreads(); \
        for (int i = F.tid; i < (nr) * 128; i += NTHR) { const int rr = i >> 7, c = i & 127; float t = 0.f; \
            _Pragma("unroll") for (int k2 = 0; k2 < 16; ++k2) t += red[((k2 * 8 + rr) * 128) + c]; \
            mod[((size_t)l * 33 + (r0) + rr) * 6144 + n0 + c] = a.in[5][l * 6144 + n0 + c] + t; } } while (0)
    MF_PASS(0, 8); MF_PASS(8, 8); MF_PASS(16, 8); MF_PASS(24, 8); MF_PASS(32, 1);
#undef MF_PASS
    __syncthreads();
}
__device__ __forceinline__ void rows_init(Frame& F, const Args& a) {
    F.refresh();
    bf16_t* XS = (bf16_t*)(F.ws + WS_XS);
    static_assert(TT % (4 * NGW) == 0, "rows_init: four rows per wave and iteration");
    for (int r0 = F.gw; r0 < TT; r0 += 4 * NGW) {
        Row r[4];
#pragma unroll
        for (int t = 0; t < 4; ++t) { const int row = r0 + t * NGW; row_load_f32(r[t], row < T ? a.in[0] + (size_t)row * D : a.in[2] + (size_t)(row - T) * D, F.lane); }
#pragma unroll
        for (int t = 0; t < 4; ++t) { const int row = r0 + t * NGW; const int mr = mod_row(row);
            row_store_bf16(r[t], XS + (size_t)row * D, F.lane);
            row_modulate(r[t], mod_vec(F.ws, 0, mr, 0), mod_vec(F.ws, 0, mr, 1), F.lane);
            row_store_fp8(r[t], (unsigned char*)a.out + OUT_U8 + (size_t)row * D, F.lane);
            asm volatile("" ::: "memory"); } }
}
__device__ __forceinline__ void rows_post1(Frame& F, const Args& a, int layer, int nrows) {
    F.refresh();
    bf16_t* XS = (bf16_t*)(F.ws + WS_XS); const unsigned char* Y8 = (const unsigned char*)a.out;
    const float* lg = a.in[6] + (size_t)(layer * 2 + 0) * D; const float* lb = a.in[7] + (size_t)(layer * 2 + 0) * D;
    const int TPB = nrows / GRID;
    for (int rl = F.wave; rl < TPB; rl += 4 * NWAVES) {
        u32x4 xr[4][2], yr[4];
#pragma unroll
        for (int t = 0; t < 4; ++t) { const int row = F.blk * TPB + rl + t * NWAVES;
#pragma unroll
            for (int j = 0; j < 2; ++j) xr[t][j] = __builtin_nontemporal_load((const GAS u32x4*)(XS + (size_t)row * D) + vb(j, F.lane));
            yr[t] = __builtin_nontemporal_load((const GAS u32x4*)(Y8 + (size_t)row * D) + F.lane); }
#pragma unroll
        for (int t = 0; t < 4; ++t) { const int row = F.blk * TPB + rl + t * NWAVES; const int mr = mod_row(row);
            Row x, y;
#pragma unroll
            for (int j = 0; j < 2; ++j) { const u32x4 w = xr[t][j];
                x.v[2 * j] = (f32x4){bflo(w.x), bfhi(w.x), bflo(w.y), bfhi(w.y)}; x.v[2 * j + 1] = (f32x4){bflo(w.z), bfhi(w.z), bflo(w.w), bfhi(w.w)}; }
#pragma unroll
            for (int q = 0; q < 4; ++q) { const f32x2v lo = __builtin_amdgcn_cvt_pk_f32_fp8((int)yr[t][q], false), hi = __builtin_amdgcn_cvt_pk_f32_fp8((int)yr[t][q], true); y.v[q] = (f32x4){lo[0], lo[1], hi[0], hi[1]}; }
            const float* g1 = mod_vec(F.ws, layer, mr, 2);
#pragma unroll
            for (int j = 0; j < 4; ++j) x.v[j] = x.v[j] * ALPHA + (((const GAS f32x4*)g1)[vq(j, F.lane)] * (1.f / YSC)) * y.v[j];
            row_normalize(x, LN_EPS);
#pragma unroll
            for (int j = 0; j < 4; ++j) x.v[j] = x.v[j] * ((const GAS f32x4*)lg)[vq(j, F.lane)] + ((const GAS f32x4*)lb)[vq(j, F.lane)];
            row_store_bf16(x, XS + (size_t)row * D, F.lane);
            float mean, rstd; row_normalize_stats(x, MOD_EPS, mean, rstd);
            if (F.lane == 0) { f32x2v st = {mean, rstd}; *(GAS f32x2v*)(F.ws + WS_RSTAT + (size_t)row * 8) = st; }
            { const float* sh = mod_vec(F.ws, layer, mr, 3); const float* sc = mod_vec(F.ws, layer, mr, 4);
#pragma unroll
              for (int j = 0; j < 4; ++j) { const f32x4 av = ((const GAS f32x4*)sc)[vq(j, F.lane)], bv = ((const GAS f32x4*)sh)[vq(j, F.lane)]; x.v[j] = x.v[j] * (av + 1.f) + bv; } }
            row_store_fp8(x, (unsigned char*)a.out + OUT_U8 + (size_t)row * D, F.lane);
            asm volatile("" ::: "memory"); }
    }
}
__device__ __forceinline__ void rows_post2(Frame& F, const Args& a, int layer, int t0, int n) {
    F.refresh();
    bf16_t* XS = (bf16_t*)(F.ws + WS_XS); const unsigned char* YB = (const unsigned char*)(F.ws + WS_YB); const unsigned char* YS = (const unsigned char*)(F.ws + WS_YS);
    const int* spos = (const int*)(F.ws + WS_SDST); const float* tkw = (const float*)(F.ws + WS_TKW);
    const float* lg = a.in[6] + (size_t)(layer * 2 + 1) * D; const float* lb = a.in[7] + (size_t)(layer * 2 + 1) * D;
    for (int i0 = F.gw; i0 < n; i0 += 2 * NGW) {
        const int i1 = i0 + NGW; const bool two = i1 < n;
        int pj[2]; float wj[2];
#pragma unroll
        for (int t = 0; t < 2; ++t) { pj[t] = 0; wj[t] = 0.f; const int row = t0 + (t ? i1 : i0); if ((t == 0 || two) && F.lane < 8) { pj[t] = ((const GAS int*)spos)[(size_t)row * 8 + F.lane]; wj[t] = ((const GAS float*)tkw)[(size_t)row * 8 + F.lane]; } }
        Row x[2], y[2];
#pragma unroll
        for (int t = 0; t < 2; ++t) { const int i = t ? i1 : i0; if (t == 0 || two) { row_load_bf16(x[t], XS + (size_t)(t0 + i) * D, F.lane); row_load_fp8(y[t], YS + (size_t)i * D, F.lane); } }
        u32x4 zr[2][8];
#pragma unroll
        for (int t = 0; t < 2; ++t) if (t == 0 || two) {
#pragma unroll
            for (int s = 0; s < 8; ++s) { const int ps = __builtin_amdgcn_readlane(pj[t], s); zr[t][s] = __builtin_nontemporal_load((const GAS u32x4*)(YB + (size_t)ps * D) + F.lane); } }
#pragma unroll
        for (int t = 0; t < 2; ++t) if (t == 0 || two) { const int i = t ? i1 : i0; const int row = t0 + i; const int mr = mod_row(row);
#pragma unroll
            for (int j = 0; j < 4; ++j) y[t].v[j] = y[t].v[j] * (1.f / 16.f);
#pragma unroll
            for (int s = 0; s < 8; ++s) { const float wz = __builtin_bit_cast(float, __builtin_amdgcn_readlane(__builtin_bit_cast(int, wj[t]), s)) * (1.f / 16.f);
#pragma unroll
                for (int j = 0; j < 4; ++j) { const f32x2v lo = __builtin_amdgcn_cvt_pk_f32_fp8((int)zr[t][s][j], false), hi = __builtin_amdgcn_cvt_pk_f32_fp8((int)zr[t][s][j], true); y[t].v[j] += (f32x4){lo[0], lo[1], hi[0], hi[1]} * wz; } }
            const float* g2 = mod_vec(F.ws, layer, mr, 5);
#pragma unroll
            for (int j = 0; j < 4; ++j) x[t].v[j] = x[t].v[j] * ALPHA + ((const GAS f32x4*)g2)[vq(j, F.lane)] * y[t].v[j];
            row_normalize(x[t], LN_EPS);
#pragma unroll
            for (int j = 0; j < 4; ++j) x[t].v[j] = x[t].v[j] * ((const GAS f32x4*)lg)[vq(j, F.lane)] + ((const GAS f32x4*)lb)[vq(j, F.lane)];
            if (layer == 3) { row_store_f32(x[t], a.out + (size_t)row * D, F.lane); }
            else { row_store_bf16(x[t], XS + (size_t)row * D, F.lane);
                row_modulate(x[t], mod_vec(F.ws, layer + 1, mr, 0), mod_vec(F.ws, layer + 1, mr, 1), F.lane);
                row_store_fp8(x[t], (unsigned char*)a.out + OUT_U8 + (size_t)row * D, F.lane); } }
    }
}
__device__ __forceinline__ float wave_max_dpp(float v) {
    int x = __builtin_bit_cast(int, v);
#define DPPMAX(ctrl) { const int y = __builtin_amdgcn_update_dpp(x, x, ctrl, 0xf, 0xf, false); x = __builtin_bit_cast(int, fmaxf(__builtin_bit_cast(float, x), __builtin_bit_cast(float, y))); }
    DPPMAX(0xB1) DPPMAX(0x4E) DPPMAX(0x141) DPPMAX(0x140)
#undef DPPMAX
    const float r0 = __builtin_bit_cast(float, __builtin_amdgcn_readlane(x, 0)), r1 = __builtin_bit_cast(float, __builtin_amdgcn_readlane(x, 16));
    const float r2 = __builtin_bit_cast(float, __builtin_amdgcn_readlane(x, 32)), r3 = __builtin_bit_cast(float, __builtin_amdgcn_readlane(x, 48));
    return fmaxf(fmaxf(r0, r1), fmaxf(r2, r3));
}
__device__ __forceinline__ void route_tokens(Frame& F, const Args& a, int layer, int ntok) {
    F.refresh();
    const int TPB = ntok / GRID;
    const bf16_t* U = (const bf16_t*)(F.ws + WS_XS); const bf16_t* Wr = (const bf16_t*)(F.ws + WS_WR) + (size_t)layer * 64 * 1024;
    int* tke = (int*)(F.ws + WS_TKE); float* tkw = (float*)(F.ws + WS_TKW);
    LAS int* lcnt = (LAS int*)(F.lds + L_LCNT);
    LAS float* lg = (LAS float*)(F.lds);
    if (F.tid < 64) lcnt[F.tid] = 0;
    const int lane = F.lane, fr = lane & 15, fq = lane >> 4;
    const int ntile = TPB / 16;
    constexpr int WPITCH = 1040; constexpr int L_SE = 122880;
    LAS float* sEb = (LAS float*)(F.lds + L_SE);
    f32x4 acc[3][4];
#pragma unroll
    for (int i = 0; i < 3; ++i)
#pragma unroll
        for (int n = 0; n < 4; ++n) acc[i][n] = (f32x4){0.f, 0.f, 0.f, 0.f};
    int grp_of[3] = {0, 0, 0};
    int tl_lo = 0, g = 0;
    while (tl_lo < ntile) {
        const int mr = mod_row(F.blk * TPB + tl_lo * 16); int tl_hi = tl_lo + 1;
        while (tl_hi < ntile && mod_row(F.blk * TPB + tl_hi * 16) == mr) ++tl_hi;
        const float* shv = mod_vec(F.ws, layer, mr, 3); const float* scv = mod_vec(F.ws, layer, mr, 4);
        for (int half = 0; half < 2; ++half) {
            __syncthreads();
            { const int kc = lane, k = half * 512 + kc * 8;
              const f32x4 c0 = *(const GAS f32x4*)(scv + k) + 1.f, c1 = *(const GAS f32x4*)(scv + k + 4) + 1.f, h0 = *(const GAS f32x4*)(shv + k), h1 = *(const GAS f32x4*)(shv + k + 4);
              u32x4 wv[8];
#pragma unroll
              for (int j = 0; j < 8; ++j) wv[j] = *(const GAS u32x4*)(Wr + (size_t)(F.wave + 8 * j) * D + k);
#pragma unroll
              for (int j = 0; j < 8; ++j) { const int e = F.wave + 8 * j; const u32x4 w = wv[j];
                const float w0 = bflo(w.x), w1 = bfhi(w.x), w2 = bflo(w.y), w3 = bfhi(w.y), w4 = bflo(w.z), w5 = bfhi(w.z), w6 = bflo(w.w), w7 = bfhi(w.w);
                u32x4 o; o.x = cvt_pk_bf16(w0 * c0[0], w1 * c0[1]); o.y = cvt_pk_bf16(w2 * c0[2], w3 * c0[3]); o.z = cvt_pk_bf16(w4 * c1[0], w5 * c1[1]); o.w = cvt_pk_bf16(w6 * c1[2], w7 * c1[3]);
                *(LAS u32x4*)(F.lds + e * WPITCH + kc * 16) = o;
                const float se = wave_sum(((bflo(o.x) + bfhi(o.x)) + (bflo(o.y) + bfhi(o.y))) + ((bflo(o.z) + bfhi(o.z)) + (bflo(o.w) + bfhi(o.w))));
                const float be = wave_sum(((w0 * h0[0] + w1 * h0[1]) + (w2 * h0[2] + w3 * h0[3])) + ((w4 * h1[0] + w5 * h1[1]) + (w6 * h1[2] + w7 * h1[3])));
                if (lane == 0) { if (half == 0) { sEb[g * 64 + e] = se; sEb[192 + g * 64 + e] = be; } else { sEb[g * 64 + e] += se; sEb[192 + g * 64 + e] += be; } }
                asm volatile("" ::: "memory"); } }
            __syncthreads();
#pragma unroll
            for (int i = 0; i < 3; ++i) { const int tl = F.wave + 8 * i;
                if (tl >= tl_lo && tl < tl_hi) { const int t0 = F.blk * TPB + tl * 16;
                    const GAS bf16x8* ap = (const GAS bf16x8*)(U + (size_t)(t0 + fr) * D + half * 512 + fq * 8);
                    bf16x8 av[16];
#pragma unroll
                    for (int ks = 0; ks < 16; ++ks) av[ks] = ap[ks * 4];
#pragma unroll
                    for (int ks = 0; ks < 16; ++ks) {
#pragma unroll
                        for (int n = 0; n < 4; ++n) { const bf16x8 bv = *(const LAS bf16x8*)(F.lds + (n * 16 + fr) * WPITCH + (ks * 32 + fq * 8) * 2); acc[i][n] = __builtin_amdgcn_mfma_f32_16x16x32_bf16(av[ks], bv, acc[i][n], 0, 0, 0); }
                        if ((ks & 1) == 1) __builtin_amdgcn_sched_barrier(0); }
                    grp_of[i] = g; } }
        }
        tl_lo = tl_hi; ++g;
    }
    __syncthreads();
#pragma unroll
    for (int i = 0; i < 3; ++i) { const int tl = F.wave + 8 * i;
        if (tl < ntile) { const int t0 = F.blk * TPB + tl * 16; const int gi = grp_of[i];
#pragma unroll
            for (int j = 0; j < 4; ++j) { const f32x2v st = *(const GAS f32x2v*)(F.ws + WS_RSTAT + (size_t)(t0 + fq * 4 + j) * 8);
#pragma unroll
                for (int n = 0; n < 4; ++n) { const float se = sEb[gi * 64 + n * 16 + fr], be = sEb[192 + gi * 64 + n * 16 + fr];
                    lg[(tl * 16 + fq * 4 + j) * 65 + n * 16 + fr] = st[1] * (acc[i][n][j] - st[0] * se) + be; } } } }
    __syncthreads();
    if (F.tid < TPB) {
        const int tok = F.blk * TPB + F.tid; const LAS float* row = lg + F.tid * 65; const float* bias = a.in[13] + layer * 64;
        float sg[64], sel[64];
#pragma unroll
        for (int e = 0; e < 64; ++e) { sg[e] = 1.f / (1.f + __expf(-row[e])); sel[e] = sg[e] + bias[e]; }
        float gs[8];
#pragma unroll
        for (int g = 0; g < 8; ++g) { float m1 = -INFINITY, m2 = -INFINITY;
#pragma unroll
            for (int j = 0; j < 8; ++j) { const float v = sel[g * 8 + j]; const bool gt1 = v > m1; m2 = gt1 ? m1 : fmaxf(m2, v); m1 = gt1 ? v : m1; }
            gs[g] = m1 + m2; }
        unsigned gok = 0;
#pragma unroll
        for (int g = 0; g < 8; ++g) { int rk = 0;
#pragma unroll
            for (int h = 0; h < 8; ++h) rk += (gs[h] > gs[g] || (gs[h] == gs[g] && h < g)) ? 1 : 0;
            gok |= (rk < 4 ? 1u : 0u) << g; }
#pragma unroll
        for (int e = 0; e < 64; ++e) sel[e] = ((gok >> (e >> 3)) & 1u) ? sel[e] : -INFINITY;
        int ce[8]; float cw[8]; float tot = 0.f;
#pragma unroll
        for (int it = 0; it < 8; ++it) { float best = -INFINITY, bs = 0.f; int bi = 0;
#pragma unroll
            for (int e = 0; e < 64; ++e) { const bool b = sel[e] > best; best = b ? sel[e] : best; bs = b ? sg[e] : bs; bi = b ? e : bi; }
#pragma unroll
            for (int e = 0; e < 64; ++e) sel[e] = (e == bi) ? -INFINITY : sel[e];
            ce[it] = bi; cw[it] = bs; tot += bs; }
        const float sc = 2.5f / tot;
#pragma unroll
        for (int it = 0; it < 8; ++it) { tke[(size_t)tok * 8 + it] = ce[it]; tkw[(size_t)tok * 8 + it] = cw[it] * sc; __hip_atomic_fetch_add(&lcnt[ce[it]], 1, __ATOMIC_RELAXED, __HIP_MEMORY_SCOPE_WORKGROUP); }
    }
    __syncthreads();
    if (F.tid < 64) F.ctl[CW_BCNT + F.blk * 64 + F.tid] = (unsigned)lcnt[F.tid];
}
__device__ __forceinline__ void build_lists(Frame& F, int ntok) {
    F.refresh();
    constexpr int NSEG = NCHUNK * 64, BPC = GRID / NCHUNK;
    const int TPB = ntok / GRID, CH = ntok / NCHUNK;
    LAS int* tstart = (LAS int*)(F.lds + L_TSTART); LAS int* pref = (LAS int*)(F.lds + L_PREF); LAS int* lcnt = (LAS int*)(F.lds + L_LCNT);
    LAS unsigned char* tseg = (LAS unsigned char*)(F.lds + L_TSEG); LAS int* scan = (LAS int*)(F.lds + L_SCAN);
    const unsigned* bcnt = F.ctl + CW_BCNT;
    const int myc = F.blk / BPC, mylb = F.blk % BPC;
    int nseg = 0;
    LAS int* cntl = (LAS int*)F.lds;
    for (int i = F.tid; i < GRID * 64; i += NTHR) cntl[i] = (int)((const GAS unsigned*)bcnt)[i];
    if (F.tid < 64) lcnt[F.tid] = 0;
    __syncthreads();
    static_assert(NSEG == 64 && NTHR == 512, "build_lists: one chunk, eight partial sums per expert");
    LAS int* part = (LAS int*)(F.lds + 65536);
    { const int e = F.tid & 63, q = F.tid >> 6; int n = 0, p = 0;
#pragma unroll 8
      for (int lb = q * 32; lb < q * 32 + 32; ++lb) { const int v = cntl[lb * 64 + e]; if (lb < mylb) p += v; n += v; }
      part[q * 64 + e] = n; part[512 + q * 64 + e] = p; }
    __syncthreads();
    if (F.tid < 64) { int n = 0, p = 0;
#pragma unroll
        for (int q = 0; q < 8; ++q) { n += part[q * 64 + F.tid]; p += part[512 + q * 64 + F.tid]; }
        nseg = n; pref[F.tid] = p;
        const int tiles = (n + 255) >> 8; int incl = tiles;
#pragma unroll
        for (int d = 1; d < 64; d <<= 1) { const int o = __shfl_up(incl, d); if (F.lane >= d) incl += o; }
        tstart[F.tid + 1] = incl; if (F.tid == 0) tstart[0] = 0;
        for (int t = incl - tiles; t < incl; ++t) tseg[t] = (unsigned char)F.tid; }
    int* stok = (int*)(F.ws + WS_STOK); int* spos = (int*)(F.ws + WS_SDST);
    const int* tke = (const int*)(F.ws + WS_TKE);
    { const int sseg = myc * 64 + mylb; if (mylb < 64 && F.tid == sseg) scan[0] = nseg; }
    __syncthreads();
    if (mylb < 64) { const int sseg = myc * 64 + mylb; const int n = scan[0]; const int base = tstart[sseg] * 256, end = tstart[sseg + 1] * 256;
      for (int p = base + n + F.tid; p < end; p += NTHR) stok[p] = myc * CH; }
    for (int tb = F.wave * 8; tb < TPB; tb += NWAVES * 8) { const int tl = tb + (F.lane >> 3);
        if (tl < TPB) { const int tok = F.blk * TPB + tl; const int e = tke[(size_t)tok * 8 + (F.lane & 7)];
            const int p = tstart[myc * 64 + e] * 256 + pref[e] + __hip_atomic_fetch_add(&lcnt[e], 1, __ATOMIC_RELAXED, __HIP_MEMORY_SCOPE_WORKGROUP);
            stok[p] = tok; spos[(size_t)tok * 8 + (F.lane & 7)] = p - tstart[myc * 64] * 256; } }
    __syncthreads();
}

struct SchedQKV {
    const char* U; const char* W; int nfull, nu, c;
    __device__ __forceinline__ bool next(int i, pg::Unit& u) const {
        const int L0 = i * GRID + c; if (L0 >= nu) return false;
        int pm, pn;
        if (L0 < nfull) { const int L = pg::xcd_remap(L0, nfull); const int gid = L / 48, w = L % 48; pm = gid * 8 + (w & 7); pn = w >> 3; }
        else { const int q = L0 - nfull; pm = 256 + (q >> 1); pn = 4 + (q & 1); }
        u.A = U + (size_t)pm * 256 * 1024; u.B = W + (size_t)pn * 256 * 1024; u.gidx = nullptr; u.gbase = 0; u.nt = 8; u.out = nullptr; u.ldc = 0; u.scale = 1.f; u.flags = 0; u.i0 = pm; u.i1 = pn;
        return true; }
};
struct SchedDense {
    const char* A; const char* W; char* out; int nrt, nct, nt, c; size_t ldA;
    __device__ __forceinline__ bool next(int i, pg::Unit& u) const {
        const int nu = nrt * nct; const int L0 = i * GRID + c; if (L0 >= nu) return false;
        const int L = pg::xcd_remap(L0, nu); const int per = 8 * nct, gid = L / per, w = L % per, fm = gid * 8, gsz = (nrt - fm) < 8 ? (nrt - fm) : 8; const int pm = fm + (w % gsz), pn = w / gsz;
        u.A = A + (size_t)pm * 256 * ldA; u.B = W + (size_t)pn * 256 * ldA; u.gidx = nullptr; u.gbase = 0; u.nt = nt; u.out = out + (size_t)pm * 256 * 1024; u.ldc = 1024; u.scale = 1.f; u.flags = 0; u.i0 = pm; u.i1 = pn;
        return true; }
};
struct SchedF1 {
    const char* CS; const char* U; char* ABT; char* ABTC; int nu, c;
    __device__ __forceinline__ bool next(int i, pg::Unit& u) const {
        const int L0 = i * GRID + c; if (L0 >= nu) return false;
        u.gidx = nullptr; u.gbase = 0; u.nt = 2; u.scale = 1.f; u.flags = 0; u.i0 = 0; u.i1 = 0;
        if (L0 < 2048) { const int L = pg::xcd_remap(L0, 2048); const int pm = L & 1, pn = (L >> 1) & 7, bg = L >> 4, b = bg >> 2, g = bg & 3;
            u.A = CS + (size_t)pm * 256 * 256; u.B = U + ((size_t)b * SEQ + pn * 256) * 1024 + g * 256; u.out = ABT + (size_t)bg * 256 * 4096 + (size_t)(pm * 2048 + pn * 256); u.ldc = 4096; }
        else { const int q = L0 - 2048; const int pm = q & 1, bg = q >> 1, b = bg >> 2, g = bg & 3;
            u.A = CS + (size_t)pm * 256 * 256; u.B = U + ((size_t)T + b * CTXL) * 1024 + g * 256; u.out = ABTC + (size_t)bg * 256 * 512 + (size_t)pm * 256; u.ldc = 512; }
        return true; }
};
struct SchedF2 {
    const char* DL; const char* ABT; char* FH; int c;
    __device__ __forceinline__ bool next(int i, pg::Unit& u) const {
        const int L0 = i * GRID + c; if (L0 >= 512) return false;
        const int L = pg::xcd_remap(L0, 512); const int pm = L & 3, bg = L >> 2, b = bg >> 2, g = bg & 3;
        u.A = DL + (size_t)pm * 256 * 4096; u.B = ABT + (size_t)bg * 256 * 4096; u.gidx = nullptr; u.gbase = 0; u.nt = 32; u.out = FH + ((size_t)b * 1024 + pm * 256) * 1024 + g * 256; u.ldc = 1024; u.scale = 0.001381067932004975f  ; u.flags = 0; u.i0 = 0; u.i1 = 0;
        return true; }
};
struct SchedF2c {
    const char* DLC; const char* ABTC; char* FC; int c;
    __device__ __forceinline__ bool next(int i, pg::Unit& u) const {
        const int L0 = i * GRID + c; if (L0 >= 128) return false;
        const int bg = L0, b = bg >> 2, g = bg & 3;
        u.A = DLC; u.B = ABTC + (size_t)bg * 256 * 512; u.gidx = nullptr; u.gbase = 0; u.nt = 4; u.out = FC + ((size_t)b * 256) * 1024 + g * 256; u.ldc = 1024; u.scale = 1.f / 256.f; u.flags = 0; u.i0 = 0; u.i1 = 0;
        return true; }
};
struct SchedF3 {
    const char* FH; const char* FC; const char* W; char* Y; int nu, c;
    __device__ __forceinline__ bool next(int i, pg::Unit& u) const {
        const int L0 = i * GRID + c; if (L0 >= nu) return false;
        u.gidx = nullptr; u.gbase = 0; u.nt = 8; u.scale = 1.f; u.flags = 0; u.i0 = 0; u.i1 = 0;
        if (L0 < 1024) { const int L = pg::xcd_remap(L0, 1024); const int gid = L >> 6, w = L & 63, pm = gid * 8 + (w & 7), pn = w >> 3; const int b = pm >> 2, k0 = (pm & 3) * 256;
            u.A = FH + (size_t)pm * 256 * 1024; u.B = W + (size_t)pn * 256 * 1024;
            if (pn < 4) { u.out = Y + ((size_t)b * SEQ + k0) * 1024; u.ldc = 1024; u.i1 = pn; }
            else { u.out = Y + ((size_t)b * SEQ + SEQ - k0) * 1024; u.ldc = -1024; u.i1 = pn - 4; u.flags = (k0 == 0) ? 1 : 0; } }
        else { const int q = L0 - 1024; const int pm = q >> 2, pn = q & 3;
            u.A = FC + (size_t)pm * 256 * 1024; u.B = W + (size_t)pn * 256 * 1024; u.out = Y + ((size_t)T + pm * 256) * 1024; u.ldc = 1024; u.i1 = pn; }
        return true; }
};
struct SchedG1 {
    const char* EGU; const int* STOK; char* H; char* HS; LAS const unsigned char* tseg; int ntl, nsh, c;
    __device__ __forceinline__ bool gsrc(int i, const int*& gidx, int& gbase) const {
        const int nu = (ntl + nsh) * 2; const int L0 = i * GRID + c; if (L0 >= nu) return false;
        const int pm = pg::xcd_remap(L0, nu) >> 1;
        if (pm < ntl) { gidx = STOK + (size_t)pm * 256; gbase = 0; } else { gidx = nullptr; gbase = (pm - ntl) * 256; }
        return true; }
    __device__ __forceinline__ bool next(int i, pg::Unit& u) const {
        const int nu = (ntl + nsh) * 2; const int L0 = i * GRID + c; if (L0 >= nu) return false;
        const int L = pg::xcd_remap(L0, nu); const int pm = L >> 1, pn = L & 1;
        u.A = nullptr; u.gbase = 0; u.nt = 8; u.ldc = 256; u.scale = 1.f; u.flags = 0; u.i0 = 0; u.i1 = 0;
        if (pm < ntl) { const int e = __builtin_amdgcn_readfirstlane((int)tseg[pm]) & 63;
            u.gidx = STOK + (size_t)pm * 256; u.B = EGU + (size_t)e * 512 * 1024 + (size_t)pn * 256 * 1024; u.out = H + (size_t)pm * 256 * 256 + pn * 128; }
        else { const int ps = pm - ntl; u.gidx = nullptr; u.gbase = ps * 256; u.B = EGU + (size_t)NE * 512 * 1024 + (size_t)pn * 256 * 1024; u.out = HS + (size_t)ps * 256 * 256 + pn * 128; }
        return true; }
};
struct SchedG2 {
    const char* ED; const char* H; const char* HS; char* YB; char* YS; LAS const unsigned char* tseg; int t0, t1, nsh, ch, CH, c;
    __device__ __forceinline__ bool next(int i, pg::Unit& u) const {
        const int nr = t1 - t0; const int nu = (nr + nsh) * 4; const int L0 = i * GRID + c; if (L0 >= nu) return false;
        const int L = pg::xcd_remap(L0, nu); const int q = L >> 2, pn = L & 3;
        u.gidx = nullptr; u.gbase = 0; u.nt = 2; u.ldc = 1024; u.scale = 1.f; u.flags = 0; u.i0 = 0; u.i1 = pn;
        if (q < nr) { const int pm = t0 + q; const int e = __builtin_amdgcn_readfirstlane((int)tseg[pm]) & 63;
            u.A = H + (size_t)pm * 256 * 256; u.B = ED + (size_t)e * 1024 * 256 + (size_t)pn * 256 * 256; u.out = YB + (size_t)q * 256 * 1024; }
        else { const int ps = q - nr; u.A = HS + ((size_t)ch * CH + ps * 256) * 256; u.B = ED + (size_t)NE * 1024 * 256 + (size_t)pn * 256 * 256; u.out = YS + (size_t)ps * 256 * 1024; }
        return true; }
};

__device__ __forceinline__ void fnet_nyquist_rows(Frame& F) {
    F.refresh();
    const unsigned char* ABT = F.ws + WS_ABT; bf16_t* FH1 = (bf16_t*)(F.ws + WS_FH1);
    static_assert((128 * 256) % (4 * NGW) == 0, "fnet_nyquist_rows: four rows per wave and step");
    for (int r0 = F.gw; r0 < 128 * 256; r0 += 4 * NGW) {
        u32x4 w[4][2];
#pragma unroll
        for (int t = 0; t < 4; ++t) { const GAS u32x4* p = (const GAS u32x4*)(ABT + (size_t)(r0 + t * NGW) * 4096);
#pragma unroll
            for (int i = 0; i < 2; ++i) w[t][i] = p[i * 64 + F.lane]; }
#pragma unroll
        for (int t = 0; t < 4; ++t) { const int r = r0 + t * NGW; const int bg = r >> 8, m = r & 255, b = bg >> 2, g = bg & 3; float s = 0.f;
#pragma unroll
            for (int i = 0; i < 2; ++i)
#pragma unroll
                for (int q = 0; q < 4; ++q) { const f32x2v lo = __builtin_amdgcn_cvt_pk_f32_fp8((int)w[t][i][q], false), hi = __builtin_amdgcn_cvt_pk_f32_fp8((int)w[t][i][q], true); s += (lo[0] - lo[1]) + (hi[0] - hi[1]); }
            s = wave_sum(s) * 0.001381067932004975f;
            if (F.lane == 0) FH1[(size_t)b * 1024 + g * 256 + m] = (bf16_t)f2bf(s); } }
}
__device__ __forceinline__ void fnet_nyquist_out(Frame& F, const Args& a, int jl) {
    F.refresh();
    const bf16_t* FH1 = (const bf16_t*)(F.ws + WS_FH1); const bf16_t* W = (const bf16_t*)(F.ws + WS_WF) + (size_t)jl * 2048 * 1024; unsigned char* Y = (unsigned char*)a.out;
    LAS float* part = (LAS float*)F.lds;
    const int b = F.blk >> 3, n = (F.blk & 7) * 128 + (F.tid & 127), kq = F.tid >> 7;
    const GAS u32x4* wp = (const GAS u32x4*)(W + (size_t)n * 1024 + kq * 256); const GAS u32x4* fp = (const GAS u32x4*)(FH1 + (size_t)b * 1024 + kq * 256);
    float s = 0.f;
#pragma unroll 4
    for (int i = 0; i < 32; ++i) { const u32x4 w = wp[i], f = fp[i];
        s += bflo(w.x) * bflo(f.x) + bfhi(w.x) * bfhi(f.x) + bflo(w.y) * bflo(f.y) + bfhi(w.y) * bfhi(f.y) + bflo(w.z) * bflo(f.z) + bfhi(w.z) * bfhi(f.z) + bflo(w.w) * bflo(f.w) + bfhi(w.w) * bfhi(f.w); }
    part[F.tid] = s;
    __syncthreads();
    if (F.tid < 128) { const float t = (part[F.tid] + part[F.tid + 128]) + (part[F.tid + 256] + part[F.tid + 384]); const int cc = n & 127;
        Y[((size_t)b * SEQ + 1024) * D + (16 * (n >> 8) + (cc >> 3)) * 16 + 8 * ((n >> 7) & 1) + (cc & 7)] = (unsigned char)f2f8(__builtin_amdgcn_fmed3f(t * YSC, -448.f, 448.f)); }
    __syncthreads();
}


#ifdef SELFCHECK
constexpr int CW_ERR = 1024;
__device__ __forceinline__ void chk_report(unsigned* ctl, int id, float got, float ref, float tabs, float trel) {
    float e = fabsf(got - ref) / (tabs + trel * fabsf(ref)); if (!(e == e)) e = 1e30f; atomicMax(ctl + CW_ERR + id, __float_as_uint(e)); }
__device__ __forceinline__ float bf2f(bf16_t b) { return __builtin_bit_cast(float, (unsigned)b << 16); }
__constant__ int chk_toks[16] = {0, 1, 63, 64, 65, 127, 2047, 2048, 2049, 4096, 33000, 65535, 65536, 65537, 70000, 73727};
__constant__ int chk_ks[8] = {0, 1, 2, 255, 256, 1023, 1024, 700};
__constant__ int chk_ms[4] = {0, 1, 128, 255};
__constant__ int chk_ytoks[10] = {0, 1, 1023, 1024, 1025, 2047, 2048, 65535, 65536, 73727};
__constant__ int chk_ns[5] = {0, 1, 255, 256, 1023};
__constant__ int chk_cols[20] = {0, 7, 15, 16, 31, 32, 40, 48, 63, 64, 500, 1023, 1024, 1039, 1040, 1072, 1279, 1280, 1300, 1535};
__device__ __forceinline__ void chk_qkv(Frame& F, const Args& a, int layer, int id) {
    F.refresh(); const unsigned char* U = (const unsigned char*)a.out + OUT_U8; const float* W = a.in[8] + (size_t)(layer >> 1) * 1024 * 1536;
    const bf16_t* Qb = (const bf16_t*)(F.ws + WS_Q); const bf16_t* Kb = (const bf16_t*)(F.ws + WS_K); const bf16_t* Vb = (const bf16_t*)(F.ws + WS_V);
    for (int s = F.gw; s < 320; s += NGW) { const int tok = chk_toks[s & 15], col = chk_cols[s >> 4];
        if (layer == 2 && tok >= T && col < 1024) continue;
        const bool rope = (tok < T) && col < 1280; const int hc = col & 63, first = (hc & 31) < 16; const int pcol = rope ? (first ? col + 16 : col - 16) : col;
        float x = 0.f, xp = 0.f;
        for (int k = F.lane; k < 1024; k += 64) { const float u = f82f(U[(size_t)tok * D + k]); x += u * W[(size_t)k * 1536 + col]; xp += u * W[(size_t)k * 1536 + pcol]; }
        x = wave_sum(x); xp = wave_sum(xp);
        float ref = x;
        if (rope) { const int tl = tok & 2047, part = hc >> 5, pos = part ? (tl & 63) : (tl >> 6), fi = hc & 15; const float ang = (float)pos * powf(10000.f, -(float)fi / 16.f);
            ref = x * cosf(ang) + (first ? -xp : xp) * sinf(ang); }
        if (col < 1024) ref *= C2;
        const float got = col < 1024 ? bf2f(Qb[(size_t)tok * 1024 + col]) : (col < 1280 ? bf2f(Kb[(size_t)tok * 256 + col - 1024]) : bf2f(Vb[(size_t)tok * 256 + col - 1280]));
        if (F.lane == 0) chk_report(F.ctl, id, got, ref, 0.20f, 0.10f); }
}
__device__ __forceinline__ void chk_attn(Frame& F, const Args& a, int layer, int id) {
    F.refresh(); const bf16_t* Qb = (const bf16_t*)(F.ws + WS_Q); const bf16_t* Kb = (const bf16_t*)(F.ws + WS_K); const bf16_t* Vb = (const bf16_t*)(F.ws + WS_V); const unsigned char* Ob = F.ws + WS_R + 216 * MiB;
    LAS float* lg = (LAS float*)F.lds + F.wave * 1024;
    for (int s = F.gw; s < 64; s += NGW) { const int tok = chk_toks[s & 15], h = (s >> 4) * 5, kvh = h >> 2;
        if (layer == 2 && tok >= T) continue;
        const bool isctx = tok >= T; const int b = isctx ? (tok - T) / CTXL : tok / SEQ, p = tok & (SEQ - 1);
        int nk = 0; const int lo = isctx ? 0 : (p - 128 < 0 ? 0 : p - 128), hi = isctx ? -1 : (p + 128 > SEQ - 1 ? SEQ - 1 : p + 128);
        const int nlat = isctx ? 0 : hi - lo + 1; nk = nlat + CTXL;
        float mx = a.in[10][(layer >> 1) * 16 + h] * LOG2E; const float sink2 = mx;
        for (int i = F.lane; i < nk; i += 64) { const size_t kr = i < nlat ? (size_t)b * SEQ + lo + i : (size_t)T + b * CTXL + (i - nlat); float d = 0.f;
            for (int e = 0; e < 64; ++e) d += bf2f(Qb[(size_t)tok * 1024 + h * 64 + e]) * bf2f(Kb[kr * 256 + kvh * 64 + e]);
            lg[i] = d; mx = fmaxf(mx, d); }
#pragma unroll
        for (int o = 1; o < 64; o <<= 1) mx = fmaxf(mx, __shfl_xor(mx, o));
        LDS_WAIT();
        float den = 0.f; for (int i = F.lane; i < nk; i += 64) den += exp2f(lg[i] - mx);
        den = wave_sum(den) + exp2f(sink2 - mx);
        float o = 0.f;
        for (int i = 0; i < nk; ++i) { const size_t kr = i < nlat ? (size_t)b * SEQ + lo + i : (size_t)T + b * CTXL + (i - nlat); o += exp2f(lg[i] - mx) * bf2f(Vb[kr * 256 + kvh * 64 + F.lane]); }
        o /= den;
        chk_report(F.ctl, id, f82f(Ob[(size_t)tok * 1024 + h * 64 + F.lane]), o, 0.02f, 0.08f); chk_report(F.ctl, 32 + (s & 15), f82f(Ob[(size_t)tok * 1024 + h * 64 + F.lane]), o, 0.02f, 0.08f);
        LDS_WAIT(); }
    __syncthreads();
}
__device__ __forceinline__ void chk_fnet_f(Frame& F, const Args& a, bool upd, int id) {
    F.refresh(); const unsigned char* U = (const unsigned char*)a.out + OUT_U8; LAS float* red = (LAS float*)F.lds;
    for (int s = F.blk; s < 128 + (upd ? 64 : 0); s += GRID) {
        const bool cx = s >= 128; const int q = cx ? s - 128 : s; const int m = chk_ms[q & 3], g = ((q >> 2) & 1) * 3, b = ((q >> 3) & 1) * 31; int k = chk_ks[(q >> 4) & 7]; const int L = cx ? CTXL : SEQ; if (cx) k &= 255;
        const size_t row0 = cx ? (size_t)T + b * CTXL : (size_t)b * SEQ;
        float acc = 0.f;
        for (int l = F.wave; l < L; l += NWAVES) { float ca = 0.f, sa = 0.f;
            for (int n = F.lane; n < 256; n += 64) { const float u = f82f(U[(row0 + l) * D + g * 256 + n]); const float an = 6.283185307179586f * (float)((m * n) & 255) / 256.f; const float sn = __sinf(an), cs = __cosf(an); ca += u * cs; sa += u * sn; }
            ca = wave_sum(ca); sa = wave_sum(sa); const float an = 6.283185307179586f * (float)((k * l) % L) / (float)L; const float sn = __sinf(an), cs = __cosf(an); acc += cs * ca - sn * sa; }
        if (F.lane == 0) red[F.wave] = acc;
        __syncthreads();
        if (F.tid == 0) { float t = 0.f; for (int w = 0; w < NWAVES; ++w) t += red[w]; t *= cx ? (1.f / 256.f) : 0.001381067932004975f;
            float got;
            if (cx) got = f82f((F.ws + WS_FC)[((size_t)b * 256 + k) * D + g * 256 + m]);
            else if (k == 1024) got = bf2f(((const bf16_t*)(F.ws + WS_FH1))[(size_t)b * 1024 + g * 256 + m]);
            else got = f82f((F.ws + WS_FH)[((size_t)b * 1024 + k) * D + g * 256 + m]);
            chk_report(F.ctl, id, got, t, 0.25f, 0.10f); }
        __syncthreads(); }
}
__device__ __forceinline__ void chk_fnet_y(Frame& F, const Args& a, int jl, bool upd, int id) {
    F.refresh(); const bf16_t* Y = (const bf16_t*)a.out; const float* W = a.in[11] + (size_t)jl * 1024 * 1024;
    const unsigned char* FH = F.ws + WS_FH; const bf16_t* FH1 = (const bf16_t*)(F.ws + WS_FH1); const unsigned char* FC = F.ws + WS_FC;
    for (int s = F.gw; s < 50; s += NGW) { const int tok = chk_ytoks[s % 10], n = chk_ns[s / 10]; if (tok >= T && !upd) continue;
        float acc = 0.f;
        for (int j = F.lane; j < 1024; j += 64) { float f;
            if (tok >= T) f = f82f(FC[(size_t)(tok - T) * D + j]);
            else { const int b = tok >> 11, k = tok & 2047; if (k < 1024) f = f82f(FH[((size_t)b * 1024 + k) * D + j]); else if (k == 1024) f = bf2f(FH1[(size_t)b * 1024 + j]);
                else f = f82f(FH[((size_t)b * 1024 + (2048 - k)) * D + (j & ~255) + ((256 - (j & 255)) & 255)]); }
            acc += f * W[(size_t)j * 1024 + n]; }
        acc = wave_sum(acc);
        if (F.lane == 0) chk_report(F.ctl, id, bf2f(Y[(size_t)tok * D + n]), acc, 0.04f, 0.08f); }
}
__device__ __forceinline__ void chk_route(Frame& F, const Args& a, int layer, int ntok, int id) {
    F.refresh(); const bf16_t* U = (const bf16_t*)a.out; const float* Wr = a.in[12] + (size_t)layer * 1024 * 64; const int* tke = (const int*)(F.ws + WS_TKE); const float* tkw = (const float*)(F.ws + WS_TKW);
    for (int s = F.gw; s < 16; s += NGW) { const int tok = chk_toks[s]; if (tok >= ntok) continue; const int lane = F.lane;
        float lgt = 0.f; for (int k = 0; k < 1024; ++k) lgt += bf2f(U[(size_t)tok * D + k]) * Wr[(size_t)k * 64 + lane];
        const float sc = 1.f / (1.f + expf(-lgt)), sel = sc + a.in[13][layer * 64 + lane];
        float g1 = -INFINITY, g2 = -INFINITY;
#pragma unroll 1
        for (int j = 0; j < 8; ++j) { const float v = __shfl(sel, (lane & ~7) + j); if (v > g1) { g2 = g1; g1 = v; } else if (v > g2) g2 = v; }
        const float gs = g1 + g2; int gr = 0;
#pragma unroll 1
        for (int gp = 0; gp < 8; ++gp) { const float v = __shfl(gs, gp * 8); gr += (v > gs || (v == gs && gp < (lane >> 3))) ? 1 : 0; }
        const float sm = gr < 4 ? sel : -INFINITY; int rk = 0;
#pragma unroll 1
        for (int ep = 0; ep < 64; ++ep) { const float v = __shfl(sm, ep); rk += (v > sm || (v == sm && ep < lane)) ? 1 : 0; }
        const float tot = wave_sum(rk < 8 ? sc : 0.f); const float wref = sc / tot * 2.5f;
        int slot = -1; for (int j = 0; j < 8; ++j) if (tke[(size_t)tok * 8 + j] == lane) slot = j;
        float err = 0.f;
        if (slot >= 0) { if (rk >= 10) err = 10.f; else if (rk < 8) err = fabsf(tkw[(size_t)tok * 8 + slot] - wref) / (0.04f * wref); }
        else if (rk < 6) err = 10.f;
        const unsigned long long nsel = __ballot(slot >= 0); if (__builtin_popcountll(nsel) != 8) err = 20.f;
        atomicMax(F.ctl + CW_ERR + id, __float_as_uint(err)); }
}
__device__ __forceinline__ void chk_moe(Frame& F, const Args& a, int layer, int ntok, int ch, int id) {
    F.refresh(); const bf16_t* U = (const bf16_t*)a.out; const int* tke = (const int*)(F.ws + WS_TKE); const float* tkw = (const float*)(F.ws + WS_TKW);
    const int CH = ntok / NCHUNK; LAS float* hs = (LAS float*)F.lds; LAS float* us = hs + 512; LAS float* pg_ = us + 1024;
    for (int s = F.blk; s < 16; s += GRID) { const int tok = chk_toks[s]; if (tok >= ntok || tok / CH != ch) continue;
        for (int k = F.tid; k < 1024; k += NTHR) us[k] = bf2f(U[(size_t)tok * D + k]);
        __syncthreads();
        float y0 = 0.f, y1 = 0.f;
        for (int j = 0; j < 9; ++j) { const int e = j < 8 ? tke[(size_t)tok * 8 + j] : 0; const float w = j < 8 ? tkw[(size_t)tok * 8 + j] : 1.f;
            const float* wg = j < 8 ? a.in[14] + ((size_t)layer * NE + e) * 262144 : a.in[17] + (size_t)layer * 262144;
            const float* wu = j < 8 ? a.in[15] + ((size_t)layer * NE + e) * 262144 : a.in[18] + (size_t)layer * 262144;
            const float* wd = j < 8 ? a.in[16] + ((size_t)layer * NE + e) * 262144 : a.in[19] + (size_t)layer * 262144;
            const int hh = F.tid & 255, half = F.tid >> 8; float g = 0.f, u = 0.f;
            for (int k = half * 512; k < half * 512 + 512; ++k) { g += us[k] * wg[(size_t)k * 256 + hh]; u += us[k] * wu[(size_t)k * 256 + hh]; }
            pg_[F.tid] = g; pg_[512 + F.tid] = u;
            __syncthreads();
            if (F.tid < 256) { const float gg = pg_[F.tid] + pg_[F.tid + 256], uu = pg_[512 + F.tid] + pg_[512 + F.tid + 256]; hs[F.tid] = gg / (1.f + expf(-gg)) * uu; }
            __syncthreads();
            float t0 = 0.f, t1 = 0.f; for (int q = 0; q < 256; ++q) { t0 += hs[q] * wd[(size_t)q * 1024 + F.tid]; t1 += hs[q] * wd[(size_t)q * 1024 + 512 + F.tid]; }
            y0 += w * t0; y1 += w * t1;
            __syncthreads(); }
        float g0 = 0.f, g1 = 0.f; const int i = tok - ch * CH;
        { const unsigned char* YSb = (const unsigned char*)(F.ws + WS_YS); const unsigned char* YBb = (const unsigned char*)(F.ws + WS_YB); const int* spos = (const int*)(F.ws + WS_SDST);
          const int t_ = F.tid, bo = 16 * (16 * (t_ >> 8) + ((t_ & 127) >> 3)) + 8 * ((t_ >> 7) & 1) + (t_ & 7);
          auto f8 = [](unsigned char b) { return __builtin_amdgcn_cvt_pk_f32_fp8((int)b, false)[0] * (1.f / 16.f); };
          g0 = f8(YSb[(size_t)i * D + bo]); g1 = f8(YSb[(size_t)i * D + bo + 512]);
          for (int j = 0; j < 8; ++j) { const size_t ps = (size_t)spos[(size_t)tok * 8 + j]; const float w = tkw[(size_t)tok * 8 + j]; g0 += w * f8(YBb[ps * D + bo]); g1 += w * f8(YBb[ps * D + bo + 512]); } }
        chk_report(F.ctl, id, g0, y0, 0.15f, 0.15f); chk_report(F.ctl, id, g1, y1, 0.15f, 0.15f);
        __syncthreads(); }
}
#endif

#ifndef PH_MASK
#define PH_MASK 0xffffffffu
#endif
#define PH(b) ((PH_MASK >> (b)) & 1u)
__global__ void __launch_bounds__(NTHR, 2) fwd(Args a) {
    extern __shared__ __attribute__((aligned(16))) unsigned char lds_raw[];
    Frame F;
    F.lds = (LAS unsigned char*)lds_raw; F.ws = a.ws; F.ctl = (unsigned*)(a.ws + WS_CTL);
    F.blk = blockIdx.x; F.refresh();
    for (int u = F.tid; u < (LDS_BYTES - RING_BYTES) / 4; u += NTHR) ((LAS unsigned*)(F.lds + RING_BYTES))[u] = 0u;
    __syncthreads();
    const XcdBarrier bar = xcd_barrier_post(F.ctl + CW_BAR, (volatile LAS unsigned*)(F.lds + L_MISC) + 8);
#define GRID_BAR() xcd_barrier(bar)
    LAS unsigned char* ring = F.lds;
    const int c = F.blk;
#define ws (F.ws)
#define NEWPH() F.refresh()

    if (PH(0)) { conv_small(F, a);
    __syncthreads();
    mod_full(F, a); }
    GRID_BAR();
    if (PH(1)) { rows_init(F, a); }
    GRID_BAR();

    for (int layer = 0; layer < 4; ++layer) {
        const int jl = layer >> 1; const bool upd = layer < 2; const int nrows = upd ? TT : T;
        if ((layer & 1) == 0) {
            NEWPH();
            if (PH(2)) { SchedQKV S; S.U = (const char*)a.out + OUT_U8; S.W = (const char*)(ws + WS_WQKV) + (size_t)jl * 1536 * 1024; S.nfull = (layer == 0) ? 288 * 6 : 256 * 6; S.nu = (layer == 0) ? 288 * 6 : 256 * 6 + 64; S.c = c;
              pg::EpiQKV E; E.Q = (bf16_t*)(ws + WS_Q); E.K = (bf16_t*)(ws + WS_K); E.V = (bf16_t*)(ws + WS_V); E.ropec = (const float*)(ws + WS_ROPEC); E.ropes = (const float*)(ws + WS_ROPES);
              pg::gemm_phase<pg::EpiQKV, SchedQKV, false, true>(ring, 1024u, 1024u, nullptr, S, E); }
            GRID_BAR();
#ifdef SELFCHECK
            if (SELFCHECK & 1) chk_qkv(F, a, layer, 1 + (layer >> 1));
#endif
#define OBUF ((bf16_t*)(ws + WS_R + 216 * MiB))
            NEWPH();
            if (PH(3)) { const int NU = 2048 + (layer == 0 ? 256 : 0);
              const bf16_t* Qb = (const bf16_t*)(ws + WS_Q); const bf16_t* Kb = (const bf16_t*)(ws + WS_K); const bf16_t* Vb = (const bf16_t*)(ws + WS_V);
              for (int i = 0; i * GRID + c < NU; ++i) { int id = pg::xcd_remap(i * GRID + c, NU);
                  if (NU > 2048) { const int g9 = id / 9, r9 = id - g9 * 9; id = (r9 < 8) ? g9 * 8 + r9 : 2048 + g9; }
                  if (id < 2048) { const int hp = id & 1, qb = (id >> 1) & 7, kvh = (id >> 4) & 3, b = id >> 6, h0 = kvh * 4 + hp * 2;
                      attn::attn_unit2(Qb, Kb, Vb, OBUF, b, h0, qb * 256, false, a.in[10][jl * 16 + h0] * LOG2E, a.in[10][jl * 16 + h0 + 1] * LOG2E, ring); }
                  else { const int cid = id - 2048, hp = cid & 1, kvh = (cid >> 1) & 3, b = cid >> 3, h0 = kvh * 4 + hp * 2;
                      attn::attn_unit2(Qb, Kb, Vb, OBUF, b, h0, 0, true, a.in[10][jl * 16 + h0] * LOG2E, a.in[10][jl * 16 + h0 + 1] * LOG2E, ring); } } }
            GRID_BAR();
#ifdef SELFCHECK
            if (SELFCHECK & 1) chk_attn(F, a, layer, 3 + (layer >> 1));
#endif
            NEWPH();
            if (PH(4)) { SchedDense S; S.A = (const char*)OBUF; S.W = (const char*)(ws + WS_WO) + (size_t)jl * 1024 * 1024; S.out = (char*)a.out; S.nrt = nrows / 256; S.nct = 4; S.nt = 8; S.c = c; S.ldA = 1024;
              pg::EpiY8 E; pg::gemm_phase<pg::EpiY8, SchedDense, false, true>(ring, 1024u, 1024u, nullptr, S, E); }
            GRID_BAR();
        } else {
            NEWPH();
            if (PH(5)) { SchedF1 S; S.CS = (const char*)(ws + WS_CSN); S.U = (const char*)a.out + OUT_U8; S.ABT = (char*)(ws + WS_ABT); S.ABTC = (char*)(ws + WS_ABTC); S.nu = 2048 + (upd ? 256 : 0); S.c = c;
              pg::EpiStore8 E; pg::gemm_phase<pg::EpiStore8, SchedF1, false, true, 127>(ring, 256u, 1024u, nullptr, S, E); }
            GRID_BAR();
            NEWPH();
            if (PH(6)) { SchedF2 S; S.DL = (const char*)(ws + WS_DL); S.ABT = (const char*)(ws + WS_ABT); S.FH = (char*)(ws + WS_FH); S.c = c;
              pg::EpiStore8 E; pg::gemm_phase<pg::EpiStore8, SchedF2, false, true, 127>(ring, 4096u, 4096u, nullptr, S, E); }
            NEWPH();
            if (PH(7) && upd) { SchedF2c S; S.DLC = (const char*)(ws + WS_DLC); S.ABTC = (const char*)(ws + WS_ABTC); S.FC = (char*)(ws + WS_FC); S.c = c;
              pg::EpiStore8 E; pg::gemm_phase<pg::EpiStore8, SchedF2c, false, true, 127>(ring, 512u, 512u, nullptr, S, E); }
            if (PH(8)) fnet_nyquist_rows(F);
            GRID_BAR();
#ifdef SELFCHECK
            if (SELFCHECK & 2) chk_fnet_f(F, a, upd, 5 + (layer >> 1));
            GRID_BAR();
#endif
            NEWPH();
            if (PH(9)) { SchedF3 S; S.FH = (const char*)(ws + WS_FH); S.FC = (const char*)(ws + WS_FC); S.W = (const char*)(ws + WS_WSH) + (size_t)jl * 2048 * 1024; S.Y = (char*)a.out; S.nu = 1024 + (upd ? 128 : 0); S.c = c;
              pg::EpiY8 E; pg::gemm_phase<pg::EpiY8, SchedF3, false, true>(ring, 1024u, 1024u, nullptr, S, E); }
            if (PH(10)) fnet_nyquist_out(F, a, jl);
            GRID_BAR();
#ifdef SELFCHECK
            if (SELFCHECK & 8) chk_fnet_y(F, a, jl, upd, 7 + (layer >> 1));
            GRID_BAR();
#endif
        }
        const bool conv_first = ((c >> 3) & 1) == 0;
        if (PH(12) && conv_first) conv_experts(F, a, layer);
        __syncthreads();
        if (PH(11)) rows_post1(F, a, layer, nrows);
        VM_WAIT(); __syncthreads();
        if (threadIdx.x == 0) { __builtin_amdgcn_fence(__ATOMIC_ACQUIRE, "agent"); VM_WAIT(); }
        __syncthreads();
        if (PH(13)) route_tokens(F, a, layer, nrows);
        __syncthreads();
        if (PH(12) && !conv_first) conv_experts(F, a, layer);
        GRID_BAR();
#ifdef SELFCHECK
        if ((SELFCHECK & 64) && layer < 2) chk_route(F, a, layer, nrows, 9);
#endif
        if (PH(14)) build_lists(F, nrows);
        GRID_BAR();
        LAS const int* tstart = (LAS const int*)(F.lds + L_TSTART); LAS const unsigned char* tseg = (LAS const unsigned char*)(F.lds + L_TSEG);
        const int ntl = __builtin_amdgcn_readfirstlane(tstart[NCHUNK * 64]);
        NEWPH();
        if (PH(15)) { SchedG1 S; S.EGU = (const char*)(ws + WS_EGU); S.STOK = (const int*)(ws + WS_STOK); S.H = (char*)(ws + WS_H); S.HS = (char*)(ws + WS_HS); S.tseg = tseg; S.ntl = ntl; S.nsh = nrows / 256; S.c = c;
          pg::EpiSilu E; pg::gemm_phase<pg::EpiSilu, SchedG1, true, true>(ring, 1024u, 1024u, (const char*)a.out + OUT_U8, S, E); }
        GRID_BAR();
        const int CH = nrows / NCHUNK;
        for (int ch = 0; ch < NCHUNK; ++ch) {
            NEWPH();
            if (PH(16)) { SchedG2 S; S.ED = (const char*)(ws + WS_ED); S.H = (const char*)(ws + WS_H); S.HS = (const char*)(ws + WS_HS); S.YB = (char*)(ws + WS_YB); S.YS = (char*)(ws + WS_YS); S.tseg = tseg;
              S.t0 = __builtin_amdgcn_readfirstlane(tstart[ch * 64]); S.t1 = __builtin_amdgcn_readfirstlane(tstart[ch * 64 + 64]); S.nsh = CH / 256; S.ch = ch; S.CH = CH; S.c = c;
              pg::EpiFp8 E; pg::gemm_phase<pg::EpiFp8, SchedG2, false, true>(ring, 256u, 256u, nullptr, S, E); }
            GRID_BAR();
#ifdef SELFCHECK
            if ((SELFCHECK & 4) && layer == 0) { chk_moe(F, a, layer, nrows, ch, 10); GRID_BAR(); }
#endif
            if (PH(17)) rows_post2(F, a, layer, ch * CH, CH);
            if (!(layer == 3 && ch == NCHUNK - 1)) GRID_BAR();
        }
    }
#ifdef SELFCHECK
    GRID_BAR();
    { int bad = 0; float be = 0.f; for (int k = 15; k >= 1; --k) { const float e = __uint_as_float(__hip_atomic_load(F.ctl + CW_ERR + k, RLX_AGENT)); if (e > 1.f) { bad = k; be = e; } }
      int wt = 0; float we = 0.f; for (int k = 0; k < 16; ++k) { const float e = __uint_as_float(__hip_atomic_load(F.ctl + CW_ERR + 32 + k, RLX_AGENT)); if (e > we) { we = e; wt = k; } }
      if (bad) { F.refresh(); float cv = 3.f + bad + (be > 8.f ? 0.5f : 0.f);  Row r; for (int j = 0; j < 4; ++j) r.v[j] = (f32x4){cv, cv, cv, cv}; for (int row = F.gw; row < T; row += NGW) row_store_f32(r, a.out + (size_t)row * D, F.lane); } }
#endif
}

#undef ws
#undef NEWPH
extern "C" void kernel_launch(void* const* d_in, const int* in_sizes, int n_in, void* d_out, int out_size, void* d_ws, size_t ws_size, hipStream_t stream) {
    static int ready = 0;
    if (ready == 0) {
        if (n_in != 20 || out_size != T * D || ws_size < WS_END) { fprintf(stderr, "kernel_launch: unexpected problem (n_in %d out %d ws %zu need %zu)\n", n_in, out_size, ws_size, (size_t)WS_END); ready = -1; return; }
        if (hipFuncSetAttribute((const void*)fwd, hipFuncAttributeMaxDynamicSharedMemorySize, LDS_BYTES) != hipSuccess) { fprintf(stderr, "kernel_launch: hipFuncSetAttribute failed\n"); ready = -1; return; }
        int per_cu = 0;
        if (hipOccupancyMaxActiveBlocksPerMultiprocessor(&per_cu, (const void*)fwd, NTHR, LDS_BYTES) != hipSuccess || per_cu < 1) fprintf(stderr, "kernel_launch: occupancy query says %d blocks per CU\n", per_cu);
        (void)hipGetLastError();
        ready = 1;
    }
    if (ready < 0) return;
    (void)hipMemsetAsync((char*)d_ws + WS_CTL, 0, CTL_BYTES, stream);
    Args a{};
    for (int i = 0; i < 20; ++i) a.in[i] = (const float*)d_in[i];
    a.out = (float*)d_out; a.ws = (unsigned char*)d_ws;
    hipLaunchKernelGGL(fwd, dim3(GRID), dim3(NTHR), LDS_BYTES, stream, a);
}
```

```cpp
#include <hip/hip_runtime.h>
#include <cstdio>
#include <cstdint>

#define LAS __attribute__((address_space(3)))
#define GAS __attribute__((address_space(1)))
typedef unsigned short bf16_t;
typedef short bf16x8 __attribute__((ext_vector_type(8)));
typedef short s16x4 __attribute__((ext_vector_type(4)));
typedef float f32x4 __attribute__((ext_vector_type(4)));
typedef float f32x16 __attribute__((ext_vector_type(16)));
typedef unsigned u32x4 __attribute__((ext_vector_type(4)));
typedef unsigned u32x2 __attribute__((ext_vector_type(2)));
typedef int v8i_t __attribute__((ext_vector_type(8)));
typedef int v4i_t __attribute__((ext_vector_type(4)));

constexpr int D = 1024, NB = 32, SEQ = 2048, T = NB * SEQ, CTXL = 256, TC = NB * CTXL, TT = T + TC;
constexpr int NQKV = 1536, NE = 64;
constexpr float ALPHA = 1.681792830507429f;
constexpr float LN_EPS = 1e-5f, MOD_EPS = 1e-6f;
constexpr float C2 = 0.125f * 1.4426950408889634f;
constexpr float LOG2E = 1.4426950408889634f;
constexpr int NCHUNK = 1;
constexpr int NWAVES = 8, NTHR = 512, GRID = 256;

constexpr size_t MiB = 1u << 20;
constexpr size_t WS_CTL = 0, CTL_BYTES = 1 * MiB;
constexpr size_t WS_ROPEC = 1 * MiB, WS_ROPES = 1 * MiB + 4096, WS_CSN = 1 * MiB + 65536, WS_DLC = 1 * MiB + 524288, WS_DL = 2 * MiB;
constexpr size_t WS_WQKV = 10 * MiB, WS_WO = 16 * MiB, WS_WF = 20 * MiB, WS_WR = 28 * MiB, WS_WSH = 29 * MiB;
constexpr size_t WS_MODP = 36 * MiB, WS_MOD = 49 * MiB;
constexpr float QSC = 64.f;
constexpr float YSC = 16.f;
constexpr size_t WS_RSTAT = 36 * MiB;
constexpr size_t WS_EGU = 54 * MiB, WS_ED = 118 * MiB;
constexpr size_t WS_XS = 150 * MiB;
constexpr size_t WS_STOK = 294 * MiB, WS_SDST = 297 * MiB, WS_SW = 300 * MiB, WS_TKE = 303 * MiB, WS_TKW = 306 * MiB;
constexpr size_t WS_R = 309 * MiB;
constexpr size_t WS_Q = WS_R, WS_K = WS_R + 144 * MiB, WS_V = WS_R + 180 * MiB;
constexpr size_t WS_ABT = WS_R, WS_FH = WS_R + 256 * MiB, WS_FH1 = WS_R + 320 * MiB, WS_ABTC = WS_R + 321 * MiB, WS_FC = WS_R + 353 * MiB;
constexpr size_t WS_H = WS_R, WS_HS = WS_R + 160 * MiB, WS_YB = WS_R + 180 * MiB, WS_YS = WS_R + 788 * MiB;
constexpr size_t WS_END = WS_YS + 72 * MiB;
constexpr size_t OUT_U8 = 144 * MiB;
constexpr int WSCALE_E8M0 = 121;
constexpr int MAXROWS = 655360;

constexpr int CW_TMO = 0, CW_BAR = 4096, CW_BCNT = 16384;

constexpr int RING_BYTES = 131072;
constexpr int L_MISC = RING_BYTES;
constexpr int L_TSTART = RING_BYTES + 256;
constexpr int L_PREF = L_TSTART + 1040;
constexpr int L_LCNT = L_PREF + 256;
constexpr int L_TSEG = L_LCNT + 256;
constexpr int L_SCAN = L_TSEG + 2560;
constexpr int LDS_BYTES = 139264;
static_assert(L_SCAN + 1024 <= LDS_BYTES, "LDS map");

#define RLX_AGENT __ATOMIC_RELAXED, __HIP_MEMORY_SCOPE_AGENT
#define LDS_WAIT() asm volatile("s_waitcnt lgkmcnt(0)" ::: "memory")
#define VM_WAIT() asm volatile("s_waitcnt vmcnt(0)" ::: "memory")

__device__ __forceinline__ unsigned f2bf(float f) { unsigned u = __builtin_bit_cast(unsigned, f); return (u + 0x7fffu + ((u >> 16) & 1u)) >> 16; }
__device__ __forceinline__ unsigned pk2(float lo, float hi) { return f2bf(lo) | (f2bf(hi) << 16); }
typedef float f32x2_t __attribute__((ext_vector_type(2))); typedef __bf16 bf16x2_t __attribute__((ext_vector_type(2)));
__device__ __forceinline__ unsigned cvt_pk_bf16(float lo, float hi) { f32x2_t v = {lo, hi}; bf16x2_t b = __builtin_convertvector(v, bf16x2_t); return __builtin_bit_cast(unsigned, b); }
__device__ __forceinline__ float bflo(unsigned w) { return __builtin_bit_cast(float, w << 16); }
__device__ __forceinline__ float bfhi(unsigned w) { return __builtin_bit_cast(float, w & 0xffff0000u); }
__device__ __forceinline__ float wave_sum(float v) {
#pragma unroll
    for (int o = 1; o < 64; o <<= 1) v += __shfl_xor(v, o);
    return v;
}

__device__ __forceinline__ unsigned f2f8(float v) { return (unsigned)__builtin_amdgcn_cvt_pk_fp8_f32(v, 0.f, 0, false) & 0xffu; }
__device__ __forceinline__ float f82f(unsigned b) { return __builtin_amdgcn_cvt_pk_f32_fp8((int)(b & 0xffu), false)[0]; }
__device__ __forceinline__ int opaque_tid() { int t = threadIdx.x; asm volatile("" : "+v"(t)); return t; }

#define XB_TMO      128
#define XB_XCNT(j)  (256  + 64 * (j))
#define XB_XSUB(j)  (1280 + 64 * (j))
#define XB_XGEN(j)  (2304 + 64 * (j))
#define XB_TOP      3328
#define XB_TOPGEN   3392
#define XCD_BAR_WORDS 3456
#define XB_SPIN_CAP (1u << 22)
__device__ __forceinline__ unsigned xb_ld(unsigned* p)              { return __hip_atomic_load(p, __ATOMIC_RELAXED, __HIP_MEMORY_SCOPE_AGENT); }
__device__ __forceinline__ unsigned xb_add(unsigned* p, unsigned v) { return __hip_atomic_fetch_add(p, v, __ATOMIC_RELAXED, __HIP_MEMORY_SCOPE_AGENT); }
__device__ __forceinline__ unsigned xb_xcc_id() { return (unsigned)__builtin_amdgcn_s_getreg((3 << 11) | 20) & 0xFu; }
#define XB_SPIN(cond, bar) do { unsigned _sp = 0; while (cond) { __builtin_amdgcn_s_sleep(1); \
    if ((++_sp & 255u) == 0u) { if (xb_ld(&(bar)[XB_TMO])) break; if (_sp > XB_SPIN_CAP) { atomicAdd(&(bar)[XB_TMO], 1u); break; } } } } while (0)
struct XcdBarrier { unsigned* bar; unsigned x; volatile LAS unsigned* st; };
__device__ __forceinline__ XcdBarrier xcd_barrier_post(unsigned* bar, volatile LAS unsigned* st) {
    XcdBarrier b; b.bar = bar; b.x = xb_xcc_id(); b.st = st;
    if (threadIdx.x == 0) (void)xb_add(&bar[XB_XCNT(b.x)], 1u);
    return b;
}
__device__ __forceinline__ void xcd_barrier_complete(unsigned* bar, unsigned x, unsigned& nloc, unsigned& nx) {
    const unsigned G = gridDim.x * gridDim.y * gridDim.z;
    unsigned sum, cnt, mine, sp = 0u;
    for (;;) {
        sum = 0u; cnt = 0u; mine = 0u;
#pragma unroll
        for (unsigned j = 0; j < 16; ++j) { const unsigned c = xb_ld(&bar[XB_XCNT(j)]); sum += c; cnt += (c > 0u) ? 1u : 0u; mine = (j == x) ? c : mine; }
        if (sum == G) break;
        __builtin_amdgcn_s_sleep(1);
        if ((++sp & 255u) == 0u) { if (xb_ld(&bar[XB_TMO])) break; if (sp > XB_SPIN_CAP) { atomicAdd(&bar[XB_TMO], 1u); break; } }
    }
    nloc = mine > 0u ? mine : 1u; nx = cnt > 0u ? cnt : 1u;
}
__device__ __forceinline__ void xcd_barrier(const XcdBarrier& b) {
    asm volatile("s_waitcnt vmcnt(0)" ::: "memory");
    __syncthreads();
    if (threadIdx.x == 0) {
        unsigned* bar = b.bar; unsigned bx = b.x; asm volatile("" : "+s"(bx));
        __builtin_amdgcn_s_waitcnt(0);
        unsigned nloc = b.st[0], nx = b.st[1];
        if (nloc == 0u) { xcd_barrier_complete(bar, bx, nloc, nx); b.st[0] = nloc; b.st[1] = nx; }
        const unsigned old = xb_add(&bar[XB_XSUB(bx)], 1u);
        const unsigned gen = old / nloc;
        if (old + 1u == (gen + 1u) * nloc) {
            __builtin_amdgcn_fence(__ATOMIC_RELEASE, "agent");
            asm volatile("s_waitcnt vmcnt(0)" ::: "memory");
            const unsigned og = xb_add(&bar[XB_TOP], 1u);
            const unsigned tg = og / nx;
            if (og + 1u == (tg + 1u) * nx) xb_add(&bar[XB_TOPGEN], 1u);
            else XB_SPIN(xb_ld(&bar[XB_TOPGEN]) == tg, bar);
            __builtin_amdgcn_fence(__ATOMIC_ACQUIRE, "agent");
            xb_add(&bar[XB_XGEN(bx)], 1u);
            asm volatile("s_waitcnt vmcnt(0)" ::: "memory");
        } else {
            XB_SPIN(xb_ld(&bar[XB_XGEN(bx)]) == gen, bar);
            __builtin_amdgcn_fence(__ATOMIC_ACQUIRE, "agent");
            asm volatile("s_waitcnt vmcnt(0)" ::: "memory");
        }
    }
    __syncthreads();
}

typedef float f32x2v __attribute__((ext_vector_type(2)));
namespace pg {
constexpr int BM = 256, BK = 64, HALF = 128, HTB = HALF * BK * 2;
__host__ __device__ __forceinline__ int lds_byte(int r, int c) { const int st = (r >> 4) * 2 + (c >> 5), rr = r & 15, cc = c & 31, ob = rr * 64 + cc * 2; return st * 1024 + (ob ^ (((ob >> 9) & 1) << 5)); }
__host__ __device__ __forceinline__ void stage_rc(int b, int& R, int& C) { const int st = b / 1024, sb = b % 1024, swz = sb ^ (((sb >> 9) & 1) << 5); R = (st >> 1) * 16 + swz / 64; C = (st & 1) * 32 + (swz % 64) / 2; }
__host__ __device__ __forceinline__ int perm32(int rho) { const int n = rho >> 4, i = rho & 15; return 8 * (i >> 2) + 4 * n + (i & 3); }

struct Unit {
    const char* A;
    const char* B;
    const int* gidx;
    int gbase;
    int nt;
    char* out; int ldc; float scale; int flags; int i0; int i1;
};

template <class Epi, class Sched, bool GATHER, bool F8 = false, int WSC = WSCALE_E8M0>
__device__ __forceinline__ void gemm_phase(LAS unsigned char* lds, const unsigned lda, const unsigned ldb, const char* gtable, const Sched& S, const Epi& E) {
    const int tid = opaque_tid(), wid = __builtin_amdgcn_readfirstlane(tid >> 6), lane = tid & 63, wr = wid >> 2, wc = wid & 3, fr = lane & 15, fq = lane >> 4;
    unsigned voffA[2], voffB[2];
#pragma unroll
    for (int i = 0; i < 2; ++i) { int R, C; stage_rc(tid * 16 + i * 8192, R, C); const int Rb = (R & ~31) + perm32(R & 31);
        voffA[i] = (unsigned)R * lda + (unsigned)C * 2u; voffB[i] = (unsigned)Rb * ldb + (unsigned)C * 2u; }
    const size_t kstep = (size_t)(BK * 2);
    const size_t hstepA = (size_t)HALF * lda, hstepB = (size_t)HALF * ldb;
    const unsigned ldsw = (unsigned)wid * 1024u;
    const int aoff = lds_byte(wr * 64 + fr, fq * 8), boff = lds_byte(wc * 32 + fr, fq * 8);
#define PG_SA(b, h) (((b) * 2 + (h)) * HTB)
#define PG_SB(b, h) ((4 + (b) * 2 + (h)) * HTB)
#define PG_ST2(bufoff, p0, p1) do { \
        __builtin_amdgcn_global_load_lds((const unsigned*)(p0), (LAS unsigned*)(lds + (bufoff) + ldsw), 16, 0, 0); \
        __builtin_amdgcn_global_load_lds((const unsigned*)(p1), (LAS unsigned*)(lds + (bufoff) + ldsw + 8192), 16, 0, 0); } while (0)
#define PG_STB(bufoff, bp) PG_ST2(bufoff, (bp) + voffB[0], (bp) + voffB[1])
#define PG_STA(bufoff, ap, h, nx) do { if constexpr (GATHER) { PG_ST2(bufoff, (ap) + ((nx) ? nO[h][0] : cO[h][0]), (ap) + ((nx) ? nO[h][1] : cO[h][1])); } \
        else { PG_ST2(bufoff, (ap) + (h) * hstepA + voffA[0], (ap) + (h) * hstepA + voffA[1]); } } while (0)
#define PG_LD8(p) ({ const v4i_t lo_ = *(const LAS v4i_t*)(p), hi_ = *(const LAS v4i_t*)((p) + 1024); __builtin_shufflevector(lo_, hi_, 0, 1, 2, 3, 4, 5, 6, 7); })
#define PG_LDA(dst, b, h) do { if constexpr (F8) { _Pragma("unroll") for (int m = 0; m < 4; ++m) dst##8[m] = PG_LD8(lds + PG_SA(b, h) + aoff + m * 2048); } \
        else { _Pragma("unroll") for (int m = 0; m < 4; ++m) _Pragma("unroll") for (int k = 0; k < 2; ++k) dst[m][k] = *(const LAS bf16x8*)(lds + PG_SA(b, h) + aoff + m * 2048 + k * 1024); } } while (0)
#define PG_LDB(dst, b, h) do { if constexpr (F8) { _Pragma("unroll") for (int n = 0; n < 2; ++n) dst##8[n] = PG_LD8(lds + PG_SB(b, h) + boff + n * 2048); } \
        else { _Pragma("unroll") for (int n = 0; n < 2; ++n) _Pragma("unroll") for (int k = 0; k < 2; ++k) dst[n][k] = *(const LAS bf16x8*)(lds + PG_SB(b, h) + boff + n * 2048 + k * 1024); } } while (0)
#define PG_MMA(ai, bj, At, Bt) do { __builtin_amdgcn_s_setprio(1); _Pragma("unroll") for (int m = 0; m < 4; ++m) _Pragma("unroll") for (int n = 0; n < 2; ++n) { \
        if constexpr (F8) { asm volatile("v_mfma_scale_f32_16x16x128_f8f6f4 %0, %1, %2, %0, %3, %4 op_sel_hi:[0,0,0]" : "+v"(acc[ai][bj][m][n]) : "v"(Bt##8[n]), "v"(At##8[m]), "v"(sc_w), "v"(sc_x)); } \
        else { _Pragma("unroll") for (int k = 0; k < 2; ++k) acc[ai][bj][m][n] = __builtin_amdgcn_mfma_f32_16x16x32_bf16(Bt[n][k], At[m][k], acc[ai][bj][m][n], 0, 0, 0); } } \
        __builtin_amdgcn_s_setprio(0); } while (0)
#define PG_WAIT_V(n) asm volatile("s_waitcnt vmcnt(" #n ")" ::: "memory")
#define PG_WAIT_L(n) asm volatile("s_waitcnt lgkmcnt(" #n ")" ::: "memory")
#define PG_BAR __builtin_amdgcn_s_barrier()
#define PG_SCHED __builtin_amdgcn_sched_barrier(0)
#define PG_GOFF(dst, u) do { const int tz_ = opaque_tid(); _Pragma("unroll") for (int i = 0; i < 2; ++i) { int R_, C_; stage_rc(tz_ * 16 + i * 8192, R_, C_); \
        _Pragma("unroll") for (int h = 0; h < 2; ++h) { const int rr = h * HALF + R_; \
        const int ix = (u).gidx ? ((const GAS int*)(u).gidx)[rr] : (u).gbase + rr; dst[h][i] = (unsigned)ix * lda + (unsigned)C_ * 2u; } } } while (0)
#define PG_GIDX(dst, un) do { const int* gi_ = nullptr; int gb_ = 0; const bool ok_ = S.gsrc((un), gi_, gb_); const int tz_ = opaque_tid(); _Pragma("unroll") for (int i = 0; i < 2; ++i) { int R_, C_; stage_rc(tz_ * 16 + i * 8192, R_, C_); \
        _Pragma("unroll") for (int h = 0; h < 2; ++h) { const int rr = h * HALF + R_; dst[h][i] = (ok_ && gi_) ? ((const GAS int*)gi_)[rr] : gb_ + rr; } } } while (0)
#define PG_GCVT(dst, src) do { const int tz_ = opaque_tid(); _Pragma("unroll") for (int i = 0; i < 2; ++i) { int R_, C_; stage_rc(tz_ * 16 + i * 8192, R_, C_); \
        _Pragma("unroll") for (int h = 0; h < 2; ++h) dst[h][i] = (unsigned)src[h][i] * lda + (unsigned)C_ * 2u; } } while (0)
    Unit cur, nxt; int ui = 0;
    if (!S.next(0, cur)) return;
    f32x4 acc[2][2][4][2];
#pragma unroll
    for (int a = 0; a < 2; ++a)
#pragma unroll
        for (int b = 0; b < 2; ++b)
#pragma unroll
            for (int m = 0; m < 4; ++m)
#pragma unroll
                for (int n = 0; n < 2; ++n) acc[a][b][m][n] = (f32x4){0.f, 0.f, 0.f, 0.f};
    bf16x8 At[4][2], B0[2][2], B1[2][2]; v8i_t At8[4], B08[2], B18[2];
    const int sc_w = WSC * 0x01010101, sc_x = 0x7f7f7f7f;
    unsigned cO[2][2] = {{0u, 0u}, {0u, 0u}}, nO[2][2] = {{0u, 0u}, {0u, 0u}};
    if constexpr (GATHER) { PG_GOFF(cO, cur); }
    const char* cA = GATHER ? gtable : cur.A; const char* cB = cur.B;
    PG_STB(PG_SB(0, 0), cB); PG_STB(PG_SB(0, 1), cB + hstepB); PG_STA(PG_SA(0, 0), cA, 0, false); PG_STA(PG_SA(0, 1), cA, 1, false);
    if (wr == 1) PG_BAR;
    PG_WAIT_V(2); PG_BAR;
    PG_STB(PG_SB(1, 0), cB + kstep); PG_STA(PG_SA(1, 0), cA + kstep, 0, false); PG_STB(PG_SB(1, 1), cB + hstepB + kstep);
    PG_WAIT_V(6); PG_BAR;
    for (;;) {
        const bool has_next = S.next(ui + 1, nxt);
        const int nt = cur.nt;
        if constexpr (GATHER) { if (has_next) { PG_GOFF(nO, nxt); } else {
#pragma unroll
            for (int h = 0; h < 2; ++h)
#pragma unroll
                for (int i = 0; i < 2; ++i) nO[h][i] = cO[h][i]; } }
        const char* nA = GATHER ? gtable : (has_next ? nxt.A : cA); const char* nB = has_next ? nxt.B : cB;
#pragma unroll 1
        for (int t = 0; t < nt; t += 2) {
            const bool last = (t == nt - 2);
            const char* a1 = cA + (size_t)(t + 1) * kstep;
            const char* a2 = last ? nA : cA + (size_t)(t + 2) * kstep; const char* b2 = last ? nB : cB + (size_t)(t + 2) * kstep;
            const char* a3 = a2 + kstep; const char* b3 = b2 + kstep;
            const bool after_epi = (Epi::NSTORE > 0) && (t == 0) && (ui > 0);
            PG_LDB(B0, 0, 0); PG_LDB(B1, 0, 1); PG_SCHED; PG_LDA(At, 0, 0); PG_STA(PG_SA(1, 1), a1, 1, false);
            if (after_epi) { if constexpr (Epi::NSTORE == 8) PG_WAIT_V(16); else PG_WAIT_V(24); } else PG_WAIT_V(8);
            PG_WAIT_L(0); PG_BAR; PG_MMA(0, 0, At, B0); PG_MMA(0, 1, At, B1); PG_BAR; PG_SCHED;
            PG_LDA(At, 0, 1); PG_STB(PG_SB(0, 0), b2); PG_STB(PG_SB(0, 1), b2 + hstepB); PG_STA(PG_SA(0, 0), a2, 0, last);
            if (after_epi) { if constexpr (Epi::NSTORE == 8) PG_WAIT_V(16); else PG_WAIT_V(24); } else PG_WAIT_V(8);
            PG_WAIT_L(0); PG_BAR; PG_MMA(1, 0, At, B0); PG_MMA(1, 1, At, B1); PG_BAR; PG_SCHED;
            PG_LDB(B0, 1, 0); PG_LDB(B1, 1, 1); PG_SCHED; PG_LDA(At, 1, 0); PG_STA(PG_SA(0, 1), a2, 1, last);
            PG_WAIT_V(8); PG_WAIT_L(0); PG_BAR; PG_MMA(0, 0, At, B0); PG_MMA(0, 1, At, B1); PG_BAR; PG_SCHED;
            PG_LDA(At, 1, 1); PG_STB(PG_SB(1, 0), b3); PG_STB(PG_SB(1, 1), b3 + hstepB); PG_STA(PG_SA(1, 0), a3, 0, last);
            PG_WAIT_V(8); PG_WAIT_L(0); PG_BAR; PG_MMA(1, 0, At, B0); PG_MMA(1, 1, At, B1); PG_BAR; PG_SCHED;
        }
        if (wr == 0) PG_BAR;
        if constexpr (F8) asm volatile("s_nop 15\n\ts_nop 15" ::: "memory");
        E(acc, cur, wr, wc, fr, fq);
        if (!has_next) break;
#pragma unroll
        for (int a = 0; a < 2; ++a)
#pragma unroll
            for (int b = 0; b < 2; ++b)
#pragma unroll
                for (int m = 0; m < 4; ++m)
#pragma unroll
                    for (int n = 0; n < 2; ++n) acc[a][b][m][n] = (f32x4){0.f, 0.f, 0.f, 0.f};
        cur = nxt; cA = nA; cB = nB; ++ui;
        if constexpr (GATHER) {
#pragma unroll
            for (int h = 0; h < 2; ++h)
#pragma unroll
                for (int i = 0; i < 2; ++i) cO[h][i] = nO[h][i]; }
        if (wr == 1) PG_BAR;
    }
    PG_WAIT_V(0);
    PG_BAR;
#undef PG_SA
#undef PG_SB
#undef PG_ST2
#undef PG_STB
#undef PG_STA
#undef PG_LDA
#undef PG_LD8
#undef PG_LDB
#undef PG_MMA
#undef PG_WAIT_V
#undef PG_WAIT_L
#undef PG_BAR
#undef PG_SCHED
#undef PG_GOFF
#undef PG_GIDX
#undef PG_GCVT
}

struct EpiStore {
    static constexpr int NSTORE = 0;
    __device__ __forceinline__ void operator()(const f32x4 (&acc)[2][2][4][2], const Unit& u, int wr, int wc, int fr, int fq) const {
        asm volatile("" : "+v"(fr), "+v"(fq));
        const float s = u.scale;
#pragma unroll
        for (int ai = 0; ai < 2; ++ai)
#pragma unroll
            for (int m = 0; m < 4; ++m) { const int row = ai * HALF + wr * 64 + m * 16 + fr;
                char* rowp = u.out + (ptrdiff_t)row * u.ldc + (wc * 32 + 8 * fq) * 2;
                if (!((u.flags & 1) && row == 0)) {
#pragma unroll
                for (int bj = 0; bj < 2; ++bj) { const f32x4 v0 = acc[ai][bj][m][0] * s, v1 = acc[ai][bj][m][1] * s;
                    u32x4 w; w.x = cvt_pk_bf16(v0[0], v0[1]); w.y = cvt_pk_bf16(v0[2], v0[3]); w.z = cvt_pk_bf16(v1[0], v1[1]); w.w = cvt_pk_bf16(v1[2], v1[3]);
                    *(u32x4*)(rowp + bj * 256) = w; } } }
    }
};
struct EpiStore8 {
    static constexpr int NSTORE = 16;
    __device__ __forceinline__ void operator()(const f32x4 (&acc)[2][2][4][2], const Unit& u, int wr, int wc, int fr, int fq) const {
        asm volatile("" : "+v"(fr), "+v"(fq));
        const float s = u.scale;
#pragma unroll
        for (int ai = 0; ai < 2; ++ai)
#pragma unroll
            for (int m = 0; m < 4; ++m) { const int row = ai * HALF + wr * 64 + m * 16 + fr;
                char* rowp = u.out + (ptrdiff_t)row * u.ldc + (wc * 32 + 8 * fq);
#pragma unroll
                for (int bj = 0; bj < 2; ++bj) { const f32x4 v0 = acc[ai][bj][m][0] * s, v1 = acc[ai][bj][m][1] * s; int w0 = 0, w1 = 0;
                    w0 = __builtin_amdgcn_cvt_pk_fp8_f32(v0[0], v0[1], w0, false); w0 = __builtin_amdgcn_cvt_pk_fp8_f32(v0[2], v0[3], w0, true);
                    w1 = __builtin_amdgcn_cvt_pk_fp8_f32(v1[0], v1[1], w1, false); w1 = __builtin_amdgcn_cvt_pk_fp8_f32(v1[2], v1[3], w1, true);
                    u32x2 o; o.x = (unsigned)w0; o.y = (unsigned)w1; *(u32x2*)(rowp + bj * 128) = o; } }
    }
};
struct EpiQKV {
    static constexpr int NSTORE = 0;
    bf16_t* Q; bf16_t* K; bf16_t* V; const float* ropec; const float* ropes;
    __device__ __forceinline__ void operator()(const f32x4 (&acc)[2][2][4][2], const Unit& u, int wr, int wc, int fr, int fq) const {
        asm volatile("" : "+v"(fr), "+v"(fq));
        const int pm = u.i0, pn = u.i1; const bool lat = pm < (T / 256); const bool rope = lat && pn < 5;
        const float qs = pn < 4 ? C2 : 1.f;
        const int part = wc & 1;
        const int fi0 = 8 * (fq & 1);
        const float sgn = (fq < 2) ? -1.f : 1.f;
#pragma unroll
        for (int ai = 0; ai < 2; ++ai)
#pragma unroll
            for (int m = 0; m < 4; ++m) { const int row = ai * HALF + wr * 64 + m * 16 + fr; const int tok = pm * 256 + row;
                const int tl = tok & (SEQ - 1); const int pos = part ? (tl & 63) : (tl >> 6);
                f32x4 c0 = {1.f, 1.f, 1.f, 1.f}, c1 = c0, s0 = {0.f, 0.f, 0.f, 0.f}, s1 = s0;
                if (rope) { c0 = *(const f32x4*)(ropec + pos * 16 + fi0); c1 = *(const f32x4*)(ropec + pos * 16 + fi0 + 4); s0 = *(const f32x4*)(ropes + pos * 16 + fi0); s1 = *(const f32x4*)(ropes + pos * 16 + fi0 + 4); }
#pragma unroll
                for (int bj = 0; bj < 2; ++bj) { f32x4 v0 = acc[ai][bj][m][0], v1 = acc[ai][bj][m][1];
                    if (rope) { f32x4 p0, p1;
#pragma unroll
                        for (int j = 0; j < 4; ++j) { p0[j] = __shfl_xor(v0[j], 32); p1[j] = __shfl_xor(v1[j], 32); }
                        v0 = v0 * c0 + (p0 * sgn) * s0; v1 = v1 * c1 + (p1 * sgn) * s1; }
                    v0 = v0 * qs; v1 = v1 * qs;
                    const int col = bj * HALF + wc * 32 + 8 * fq;
                    if (pn < 4) {
#pragma unroll
                        for (int j = 0; j < 4; ++j) { v0[j] = __builtin_amdgcn_fmed3f(v0[j] * QSC, -448.f, 448.f); v1[j] = __builtin_amdgcn_fmed3f(v1[j] * QSC, -448.f, 448.f); }
                        int w0 = 0, w1 = 0;
                        w0 = __builtin_amdgcn_cvt_pk_fp8_f32(v0[0], v0[1], w0, false); w0 = __builtin_amdgcn_cvt_pk_fp8_f32(v0[2], v0[3], w0, true);
                        w1 = __builtin_amdgcn_cvt_pk_fp8_f32(v1[0], v1[1], w1, false); w1 = __builtin_amdgcn_cvt_pk_fp8_f32(v1[2], v1[3], w1, true);
                        u32x2 o; o.x = (unsigned)w0; o.y = (unsigned)w1; *(GAS u32x2*)((unsigned char*)Q + (size_t)tok * 1024 + pn * 256 + col) = o; }
                    else { u32x4 w; w.x = cvt_pk_bf16(v0[0], v0[1]); w.y = cvt_pk_bf16(v0[2], v0[3]); w.z = cvt_pk_bf16(v1[0], v1[1]); w.w = cvt_pk_bf16(v1[2], v1[3]);
                        bf16_t* dst = pn == 4 ? K + (size_t)tok * 256 + col : V + (size_t)tok * 256 + col;
                        *(GAS u32x4*)dst = w; } } }
    }
};
struct EpiSilu {
    static constexpr int NSTORE = 8;
    __device__ __forceinline__ void operator()(const f32x4 (&acc)[2][2][4][2], const Unit& u, int wr, int wc, int fr, int fq) const {
        asm volatile("" : "+v"(fr), "+v"(fq));
#pragma unroll
        for (int ai = 0; ai < 2; ++ai)
#pragma unroll
            for (int m = 0; m < 4; ++m) { const int row = ai * HALF + wr * 64 + m * 16 + fr;
                float h[8];
#pragma unroll
                for (int n = 0; n < 2; ++n)
#pragma unroll
                    for (int j = 0; j < 4; j += 2) {
                        const f32x2v g = {acc[ai][0][m][n][j], acc[ai][0][m][n][j + 1]}, up = {acc[ai][1][m][n][j], acc[ai][1][m][n][j + 1]};
                        const f32x2v t = g * (f32x2v){-1.4426950408889634f, -1.4426950408889634f}, p = g * up;
                        f32x2v e = {__builtin_amdgcn_exp2f(t[0]), __builtin_amdgcn_exp2f(t[1])};
                        e = e + (f32x2v){1.f, 1.f};
                        const f32x2v r = {__builtin_amdgcn_rcpf(e[0]), __builtin_amdgcn_rcpf(e[1])};
                        const f32x2v o2 = p * r; h[n * 4 + j] = o2[0]; h[n * 4 + j + 1] = o2[1]; }
                int w0 = 0, w1 = 0;
                w0 = __builtin_amdgcn_cvt_pk_fp8_f32(h[0], h[1], w0, false); w0 = __builtin_amdgcn_cvt_pk_fp8_f32(h[2], h[3], w0, true);
                w1 = __builtin_amdgcn_cvt_pk_fp8_f32(h[4], h[5], w1, false); w1 = __builtin_amdgcn_cvt_pk_fp8_f32(h[6], h[7], w1, true);
                u32x2 o; o.x = (unsigned)w0; o.y = (unsigned)w1;
                *(u32x2*)(u.out + (size_t)row * 256 + (wc * 32 + 8 * fq)) = o; }
    }
};
struct EpiFp8 {
    static constexpr int NSTORE = 8;
    __device__ __forceinline__ void operator()(const f32x4 (&acc)[2][2][4][2], const Unit& u, int wr, int wc, int fr, int fq) const {
        asm volatile("" : "+v"(fr), "+v"(fq));
        const int pn = u.i1;
#pragma unroll
        for (int ai = 0; ai < 2; ++ai)
#pragma unroll
            for (int m = 0; m < 4; ++m) { const int row = ai * HALF + wr * 64 + m * 16 + fr;
                u32x4 o;
#pragma unroll
                for (int bj = 0; bj < 2; ++bj) { const f32x4 v0 = acc[ai][bj][m][0] * 16.f, v1 = acc[ai][bj][m][1] * 16.f;
                    int w0 = 0, w1 = 0;
                    w0 = __builtin_amdgcn_cvt_pk_fp8_f32(v0[0], v0[1], w0, false); w0 = __builtin_amdgcn_cvt_pk_fp8_f32(v0[2], v0[3], w0, true);
                    w1 = __builtin_amdgcn_cvt_pk_fp8_f32(v1[0], v1[1], w1, false); w1 = __builtin_amdgcn_cvt_pk_fp8_f32(v1[2], v1[3], w1, true);
                    o[2 * bj] = (unsigned)w0; o[2 * bj + 1] = (unsigned)w1; }
                *(u32x4*)(u.out + (size_t)row * 1024 + (16 * pn + 4 * wc + fq) * 16) = o; }
    }
};
struct EpiY8 {
    static constexpr int NSTORE = 0;
    __device__ __forceinline__ void operator()(const f32x4 (&acc)[2][2][4][2], const Unit& u, int wr, int wc, int fr, int fq) const {
        asm volatile("" : "+v"(fr), "+v"(fq));
        const int pn = u.i1; const float s = u.scale * YSC;
#pragma unroll
        for (int ai = 0; ai < 2; ++ai)
#pragma unroll
            for (int m = 0; m < 4; ++m) { const int row = ai * HALF + wr * 64 + m * 16 + fr;
                u32x4 o;
#pragma unroll
                for (int bj = 0; bj < 2; ++bj) { f32x4 v0 = acc[ai][bj][m][0] * s, v1 = acc[ai][bj][m][1] * s;
#pragma unroll
                    for (int j = 0; j < 4; ++j) { v0[j] = __builtin_amdgcn_fmed3f(v0[j], -448.f, 448.f); v1[j] = __builtin_amdgcn_fmed3f(v1[j], -448.f, 448.f); }
                    int w0 = 0, w1 = 0;
                    w0 = __builtin_amdgcn_cvt_pk_fp8_f32(v0[0], v0[1], w0, false); w0 = __builtin_amdgcn_cvt_pk_fp8_f32(v0[2], v0[3], w0, true);
                    w1 = __builtin_amdgcn_cvt_pk_fp8_f32(v1[0], v1[1], w1, false); w1 = __builtin_amdgcn_cvt_pk_fp8_f32(v1[2], v1[3], w1, true);
                    o[2 * bj] = (unsigned)w0; o[2 * bj + 1] = (unsigned)w1; }
                if (!((u.flags & 1) && row == 0)) *(GAS u32x4*)(u.out + (ptrdiff_t)row * u.ldc + (16 * pn + 4 * wc + fq) * 16) = o; }
    }
};
__device__ __forceinline__ int xcd_remap(int L0, int NU) { const int q = NU >> 3, r = NU & 7, x = L0 & 7, off = L0 >> 3; return (x < r ? x * (q + 1) : r * (q + 1) + (x - r) * q) + off; }
}

namespace attn {
constexpr int SLOTB = 8192;
constexpr int LDS_K = 0, LDS_V = 2 * SLOTB, LDS_WS = 4 * SLOTB, LDS_OST = LDS_WS + NWAVES * 256, LDS_END = LDS_OST + NWAVES * 4096;
static_assert(LDS_END <= RING_BYTES, "attention LDS");
__device__ __forceinline__ int crow(int r, int hi) { return (r & 3) + 8 * (r >> 2) + 4 * hi; }
__device__ __forceinline__ void glds16(const void* gsrc, unsigned lds_dst) { unsigned keep;
    asm volatile("s_mov_b32 %0, m0\n\ts_mov_b32 m0, %2\n\ts_nop 0\n\tglobal_load_lds_dwordx4 %1, off\n\ts_mov_b32 m0, %0" : "=&s"(keep) : "v"(gsrc), "s"(lds_dst) : "memory"); }
__device__ __forceinline__ float rowmax(const f32x16& p0, const f32x16& p1) {
    float a = fmaxf(p0[0], p1[0]);
#pragma unroll
    for (int r = 1; r < 16; ++r) a = fmaxf(a, fmaxf(p0[r], p1[r]));
    auto rr = __builtin_amdgcn_permlane32_swap(__float_as_uint(a), __float_as_uint(a), false, false);
    return fmaxf(__uint_as_float(rr[0]), __uint_as_float(rr[1]));
}
typedef short v4i16_t __attribute__((ext_vector_type(4)));
__device__ __forceinline__ s16x4 vtr(const LAS unsigned char* p) { return __builtin_bit_cast(s16x4, __builtin_amdgcn_ds_read_tr16_b64_v4i16((LAS v4i16_t*)p)); }
__device__ __forceinline__ void pv(f32x16* o, const LAS unsigned char* vp, bf16x8 pa0, bf16x8 pa1, bf16x8 pa2, bf16x8 pa3) {
#pragma unroll
    for (int d0 = 0; d0 < 2; ++d0) { s16x4 lo[4], hi[4];
#pragma unroll
        for (int ks = 0; ks < 4; ++ks) { lo[ks] = vtr(vp + d0 * 4096 + ks * 1024); hi[ks] = vtr(vp + d0 * 4096 + ks * 1024 + 512); }
#define PK(k) (bf16x8){lo[k][0], lo[k][1], lo[k][2], lo[k][3], hi[k][0], hi[k][1], hi[k][2], hi[k][3]}
        o[d0] = __builtin_amdgcn_mfma_f32_32x32x16_bf16(pa0, PK(0), o[d0], 0, 0, 0);
        o[d0] = __builtin_amdgcn_mfma_f32_32x32x16_bf16(pa1, PK(1), o[d0], 0, 0, 0);
        o[d0] = __builtin_amdgcn_mfma_f32_32x32x16_bf16(pa2, PK(2), o[d0], 0, 0, 0);
        o[d0] = __builtin_amdgcn_mfma_f32_32x32x16_bf16(pa3, PK(3), o[d0], 0, 0, 0);
#undef PK
    }
}
__device__ __forceinline__ void attn_unit(const bf16_t* Q, const bf16_t* K, const bf16_t* V, bf16_t* O, int b, int h, int q0, bool isctx, float sink2, LAS unsigned char* shm) {
    const int tid = opaque_tid(), lane = tid & 63, r32 = lane & 31, hi = lane >> 5; const int wid = __builtin_amdgcn_readfirstlane(tid >> 6);
    const int kvh = h >> 2;
    const long qrow = isctx ? (long)T + b * CTXL + wid * 32 : (long)b * SEQ + q0 + wid * 32;
    const unsigned lds0 = (unsigned)(uintptr_t)shm;
    LAS float* wsf = (LAS float*)(shm + LDS_WS) + wid * 64;
    int jlo = 0, nl = 0;
    if (!isctx) { jlo = (q0 == 0) ? 2 : 0; int jhi = (SEQ - q0 + 128) / 64; if (jhi > 8) jhi = 8; nl = jhi - jlo; }
    const int NT = nl + 4;
    const long lat0 = (long)b * SEQ + q0 - 128 + 64 * jlo, ctx0 = (long)T + b * CTXL;
#define TROW(t) ((t) < nl ? lat0 + 64 * (t) : ctx0 + 64 * ((t) - nl))
    const int kcol = kvh * 64 + wid * 8, vcol = kvh * 64 + (wid >> 2) * 32 + (lane & 3) * 8, vrow = 16 * (wid & 3) + (lane >> 2);
    const unsigned kdst = lds0 + LDS_K + wid * 1024, vdst = lds0 + LDS_V + wid * 1024;
#define DMA_KV(t, slot) do { const long tr_ = TROW(t); glds16(K + (tr_ + lane) * 256 + kcol, (unsigned)__builtin_amdgcn_readfirstlane(kdst + (slot) * SLOTB)); \
        glds16(V + (tr_ + vrow) * 256 + vcol, (unsigned)__builtin_amdgcn_readfirstlane(vdst + (slot) * SLOTB)); } while (0)
    DMA_KV(0, 0);
    bf16x8 qr[4];
#pragma unroll
    for (int d0 = 0; d0 < 4; ++d0) { const u32x2 w = *(const GAS u32x2*)((const unsigned char*)Q + (qrow + r32) * 1024 + h * 64 + d0 * 16 + hi * 8);
        const f32x2v a0 = __builtin_amdgcn_cvt_pk_f32_fp8((int)w.x, false), a1 = __builtin_amdgcn_cvt_pk_f32_fp8((int)w.x, true), a2 = __builtin_amdgcn_cvt_pk_f32_fp8((int)w.y, false), a3 = __builtin_amdgcn_cvt_pk_f32_fp8((int)w.y, true);
        u32x4 qw; qw.x = cvt_pk_bf16(a0[0] * (1.f / QSC), a0[1] * (1.f / QSC)); qw.y = cvt_pk_bf16(a1[0] * (1.f / QSC), a1[1] * (1.f / QSC)); qw.z = cvt_pk_bf16(a2[0] * (1.f / QSC), a2[1] * (1.f / QSC)); qw.w = cvt_pk_bf16(a3[0] * (1.f / QSC), a3[1] * (1.f / QSC));
        qr[d0] = __builtin_bit_cast(bf16x8, qw); }
    float mrun = sink2, l_reg = (hi == 0) ? 1.f : 0.f;
    f32x16 negm;
#pragma unroll
    for (int r = 0; r < 16; ++r) negm[r] = -sink2;
    f32x16 o[2];
#pragma unroll
    for (int r = 0; r < 16; ++r) { o[0][r] = 0.f; o[1][r] = 0.f; }
    const LAS unsigned char* vp0 = shm + LDS_V + ((lane >> 4) & 1) * 32 + (lane & 3) * 8 + (4 * hi + ((lane & 15) >> 2)) * 64;
    const int qw = q0 + wid * 32;
    asm volatile("s_waitcnt vmcnt(0) lgkmcnt(0)\n\ts_barrier" ::: "memory");
    for (int t = 0; t < NT; ++t) {
        const int slot = t & 1;
        if (t + 1 < NT) DMA_KV(t + 1, slot ^ 1);
        const bool latt = t < nl;
        const int ks = q0 - 128 + 64 * (jlo + t);
        bool need = true;
        if (latt) need = (ks + 63 >= qw - 128) && (ks <= qw + 31 + 128);
        if (need) {
            f32x16 p0, p1;
            const LAS unsigned char* kb = shm + LDS_K + slot * SLOTB + hi * 1024 + r32 * 16;
#pragma unroll
            for (int d0 = 0; d0 < 4; ++d0) {
                const bf16x8 b0 = *(const LAS bf16x8*)(kb + d0 * 2048), b1 = *(const LAS bf16x8*)(kb + d0 * 2048 + 512);
                if (d0 == 0) { p0 = __builtin_amdgcn_mfma_f32_32x32x16_bf16(b0, qr[0], negm, 0, 0, 0); p1 = __builtin_amdgcn_mfma_f32_32x32x16_bf16(b1, qr[0], negm, 0, 0, 0); }
                else { p0 = __builtin_amdgcn_mfma_f32_32x32x16_bf16(b0, qr[d0], p0, 0, 0, 0); p1 = __builtin_amdgcn_mfma_f32_32x32x16_bf16(b1, qr[d0], p1, 0, 0, 0); } }
            if (latt && !(ks >= qw - 97 && ks <= qw + 65)) {
                const int dq = qw + r32 - ks;
#pragma unroll
                for (int r = 0; r < 16; ++r) { const int d = dq - crow(r, hi); if (d > 128 || d < -128) p0[r] = -INFINITY; if (d - 32 > 128 || d - 32 < -128) p1[r] = -INFINITY; } }
            const float rm = rowmax(p0, p1);
            if (__any(rm > 8.f)) {
                const float delta = fmaxf(rm, 0.f);
                const float alpha = __builtin_amdgcn_exp2f(-delta); l_reg *= alpha; mrun += delta;
#pragma unroll
                for (int r = 0; r < 16; ++r) { p0[r] -= delta; p1[r] -= delta; negm[r] = -mrun; }
                if (hi == 0) wsf[r32] = alpha;
                asm volatile("s_waitcnt lgkmcnt(0)" ::: "memory");
#pragma unroll
                for (int r = 0; r < 16; ++r) { const float f = wsf[crow(r, hi)]; o[0][r] *= f; o[1][r] *= f; }
            }
            float sacc = 0.f;
#pragma unroll
            for (int r = 0; r < 16; ++r) { p0[r] = __builtin_amdgcn_exp2f(p0[r]); p1[r] = __builtin_amdgcn_exp2f(p1[r]); sacc += p0[r] + p1[r]; }
            l_reg += sacc;
            u32x4 pw0, pw1, pw2, pw3;
#define PKW(P, B) cvt_pk_bf16(P[B], P[B + 1])
            pw0 = (u32x4){PKW(p0, 0), PKW(p0, 2), PKW(p0, 4), PKW(p0, 6)}; pw1 = (u32x4){PKW(p0, 8), PKW(p0, 10), PKW(p0, 12), PKW(p0, 14)};
            pw2 = (u32x4){PKW(p1, 0), PKW(p1, 2), PKW(p1, 4), PKW(p1, 6)}; pw3 = (u32x4){PKW(p1, 8), PKW(p1, 10), PKW(p1, 12), PKW(p1, 14)};
#undef PKW
            __builtin_amdgcn_sched_barrier(0);
            pv(o, vp0 + slot * SLOTB, __builtin_bit_cast(bf16x8, pw0), __builtin_bit_cast(bf16x8, pw1), __builtin_bit_cast(bf16x8, pw2), __builtin_bit_cast(bf16x8, pw3));
        }
        asm volatile("s_waitcnt vmcnt(0) lgkmcnt(0)\n\ts_barrier" ::: "memory");
    }
    { auto rr = __builtin_amdgcn_permlane32_swap(__float_as_uint(l_reg), __float_as_uint(l_reg), false, false); l_reg = __uint_as_float(rr[0]) + __uint_as_float(rr[1]); }
    if (hi == 0) wsf[32 + r32] = l_reg;
    asm volatile("s_waitcnt lgkmcnt(0)" ::: "memory");
    float rli[16];
#pragma unroll
    for (int r = 0; r < 16; ++r) rli[r] = __builtin_amdgcn_rcpf(wsf[32 + crow(r, hi)]);
    unsigned char* Ow = (unsigned char*)O + qrow * 1024 + h * 64;
    { LAS unsigned char* stg = shm + LDS_OST + wid * 2048;
#pragma unroll
      for (int r = 0; r < 16; ++r) { const int orow = crow(r, hi);
#pragma unroll
          for (int d0 = 0; d0 < 2; ++d0) stg[orow * 64 + d0 * 32 + r32] = (unsigned char)f2f8(o[d0][r] * rli[r]); }
      asm volatile("s_waitcnt lgkmcnt(0)" ::: "memory");
#pragma unroll
      for (int i = 0; i < 2; ++i) { const int row = i * 16 + (lane >> 2), ch = lane & 3; const u32x4 v = *(const LAS u32x4*)(stg + row * 64 + ch * 16); *(GAS u32x4*)(Ow + (long)row * 1024 + ch * 16) = v; } }
    asm volatile("s_waitcnt lgkmcnt(0)" ::: "memory");
#undef TROW
#undef DMA_KV
}
__device__ __forceinline__ void attn_unit2(const bf16_t* Q, const bf16_t* K, const bf16_t* V, bf16_t* O, int b, int h0, int q0, bool isctx, float sinkA, float sinkB, LAS unsigned char* shm) {
    const int tid = opaque_tid(), lane = tid & 63, r32 = lane & 31, hi = lane >> 5; const int wid = __builtin_amdgcn_readfirstlane(tid >> 6);
    const int kvh = h0 >> 2;
    const long qrow = isctx ? (long)T + b * CTXL + wid * 32 : (long)b * SEQ + q0 + wid * 32;
    const unsigned lds0 = (unsigned)(uintptr_t)shm;
    LAS float* wsf = (LAS float*)(shm + LDS_WS) + wid * 64;
    int jlo = 0, nl = 0;
    if (!isctx) { jlo = (q0 == 0) ? 2 : 0; int jhi = (SEQ - q0 + 128) / 64; if (jhi > 8) jhi = 8; nl = jhi - jlo; }
    const int NT = nl + 4;
    const long lat0 = (long)b * SEQ + q0 - 128 + 64 * jlo, ctx0 = (long)T + b * CTXL;
#define TROW(t) ((t) < nl ? lat0 + 64 * (t) : ctx0 + 64 * ((t) - nl))
    const int kcol = kvh * 64 + wid * 8, vcol = kvh * 64 + (wid >> 2) * 32 + (lane & 3) * 8, vrow = 16 * (wid & 3) + (lane >> 2);
    const unsigned kdst = lds0 + LDS_K + wid * 1024, vdst = lds0 + LDS_V + wid * 1024;
#define DMA_KV(t, slot) do { const long tr_ = TROW(t); glds16(K + (tr_ + lane) * 256 + kcol, (unsigned)__builtin_amdgcn_readfirstlane(kdst + (slot) * SLOTB)); \
        glds16(V + (tr_ + vrow) * 256 + vcol, (unsigned)__builtin_amdgcn_readfirstlane(vdst + (slot) * SLOTB)); } while (0)
    DMA_KV(0, 0);
    bf16x8 qr[2][4];
#pragma unroll
    for (int hh = 0; hh < 2; ++hh)
#pragma unroll
        for (int d0 = 0; d0 < 4; ++d0) { const u32x2 w = __builtin_nontemporal_load((const GAS u32x2*)((const unsigned char*)Q + (qrow + r32) * 1024 + (h0 + hh) * 64 + d0 * 16 + hi * 8));
            const f32x2v a0 = __builtin_amdgcn_cvt_pk_f32_fp8((int)w.x, false), a1 = __builtin_amdgcn_cvt_pk_f32_fp8((int)w.x, true), a2 = __builtin_amdgcn_cvt_pk_f32_fp8((int)w.y, false), a3 = __builtin_amdgcn_cvt_pk_f32_fp8((int)w.y, true);
            u32x4 qw; qw.x = cvt_pk_bf16(a0[0] * (1.f / QSC), a0[1] * (1.f / QSC)); qw.y = cvt_pk_bf16(a1[0] * (1.f / QSC), a1[1] * (1.f / QSC)); qw.z = cvt_pk_bf16(a2[0] * (1.f / QSC), a2[1] * (1.f / QSC)); qw.w = cvt_pk_bf16(a3[0] * (1.f / QSC), a3[1] * (1.f / QSC));
            qr[hh][d0] = __builtin_bit_cast(bf16x8, qw); }
    float mrun[2] = {sinkA, sinkB}, l_reg[2] = {(hi == 0) ? 1.f : 0.f, (hi == 0) ? 1.f : 0.f};
    f32x16 o[2][2];
#pragma unroll
    for (int hh = 0; hh < 2; ++hh)
#pragma unroll
        for (int r = 0; r < 16; ++r) { o[hh][0][r] = 0.f; o[hh][1][r] = 0.f; }
    const LAS unsigned char* vp0 = shm + LDS_V + ((lane >> 4) & 1) * 32 + (lane & 3) * 8 + (4 * hi + ((lane & 15) >> 2)) * 64;
    const int qw = q0 + wid * 32;
    asm volatile("s_waitcnt vmcnt(0) lgkmcnt(0)\n\ts_barrier" ::: "memory");
    for (int t = 0; t < NT; ++t) {
        const int slot = t & 1;
        if (t + 1 < NT) DMA_KV(t + 1, slot ^ 1);
        const bool latt = t < nl;
        const int ks = q0 - 128 + 64 * (jlo + t);
        bool need = true;
        if (latt) need = (ks + 63 >= qw - 128) && (ks <= qw + 31 + 128);
        if (need) {
            f32x16 p[2][2];
            { f32x16 nm0, nm1;
#pragma unroll
              for (int r = 0; r < 16; ++r) { nm0[r] = -mrun[0]; nm1[r] = -mrun[1]; }
              const LAS unsigned char* kb = shm + LDS_K + slot * SLOTB + hi * 1024 + r32 * 16;
#pragma unroll
              for (int d0 = 0; d0 < 4; ++d0) {
                const bf16x8 b0 = *(const LAS bf16x8*)(kb + d0 * 2048), b1 = *(const LAS bf16x8*)(kb + d0 * 2048 + 512);
                if (d0 == 0) { p[0][0] = __builtin_amdgcn_mfma_f32_32x32x16_bf16(b0, qr[0][0], nm0, 0, 0, 0); p[0][1] = __builtin_amdgcn_mfma_f32_32x32x16_bf16(b1, qr[0][0], nm0, 0, 0, 0);
                               p[1][0] = __builtin_amdgcn_mfma_f32_32x32x16_bf16(b0, qr[1][0], nm1, 0, 0, 0); p[1][1] = __builtin_amdgcn_mfma_f32_32x32x16_bf16(b1, qr[1][0], nm1, 0, 0, 0); }
                else {
#pragma unroll
                    for (int hh = 0; hh < 2; ++hh) { p[hh][0] = __builtin_amdgcn_mfma_f32_32x32x16_bf16(b0, qr[hh][d0], p[hh][0], 0, 0, 0); p[hh][1] = __builtin_amdgcn_mfma_f32_32x32x16_bf16(b1, qr[hh][d0], p[hh][1], 0, 0, 0); } } } }
            if (latt && !(ks >= qw - 97 && ks <= qw + 65)) {
                const int dq = qw + r32 - ks;
#pragma unroll
                for (int r = 0; r < 16; ++r) { const int d = dq - crow(r, hi);
                    if (d > 128 || d < -128) { p[0][0][r] = -INFINITY; p[1][0][r] = -INFINITY; }
                    if (d - 32 > 128 || d - 32 < -128) { p[0][1][r] = -INFINITY; p[1][1][r] = -INFINITY; } } }
            u32x4 pw[2][4];
#pragma unroll
            for (int hh = 0; hh < 2; ++hh) {
                bool big = false;
#pragma unroll
                for (int r = 0; r < 16; ++r) big = big | (__builtin_bit_cast(int, p[hh][0][r]) > 0x41000000) | (__builtin_bit_cast(int, p[hh][1][r]) > 0x41000000);
                if (__any(big)) {
                    const float rm = rowmax(p[hh][0], p[hh][1]);
                    const float delta = fmaxf(rm, 0.f);
                    const float alpha = __builtin_amdgcn_exp2f(-delta); l_reg[hh] *= alpha; mrun[hh] += delta;
#pragma unroll
                    for (int r = 0; r < 16; ++r) { p[hh][0][r] -= delta; p[hh][1][r] -= delta; }
                    if (hi == 0) wsf[r32] = alpha;
                    asm volatile("s_waitcnt lgkmcnt(0)" ::: "memory");
#pragma unroll
                    for (int r = 0; r < 16; ++r) { const float f = wsf[crow(r, hi)]; o[hh][0][r] *= f; o[hh][1][r] *= f; }
                    asm volatile("s_waitcnt lgkmcnt(0)" ::: "memory");
                }
                float sacc = 0.f;
#pragma unroll
                for (int r = 0; r < 16; ++r) { p[hh][0][r] = __builtin_amdgcn_exp2f(p[hh][0][r]); p[hh][1][r] = __builtin_amdgcn_exp2f(p[hh][1][r]); sacc += p[hh][0][r] + p[hh][1][r]; }
                l_reg[hh] += sacc;
#define PKW(P, B) cvt_pk_bf16(P[B], P[B + 1])
                pw[hh][0] = (u32x4){PKW(p[hh][0], 0), PKW(p[hh][0], 2), PKW(p[hh][0], 4), PKW(p[hh][0], 6)}; pw[hh][1] = (u32x4){PKW(p[hh][0], 8), PKW(p[hh][0], 10), PKW(p[hh][0], 12), PKW(p[hh][0], 14)};
                pw[hh][2] = (u32x4){PKW(p[hh][1], 0), PKW(p[hh][1], 2), PKW(p[hh][1], 4), PKW(p[hh][1], 6)}; pw[hh][3] = (u32x4){PKW(p[hh][1], 8), PKW(p[hh][1], 10), PKW(p[hh][1], 12), PKW(p[hh][1], 14)};
#undef PKW
            }
            __builtin_amdgcn_sched_barrier(0);
            { const LAS unsigned char* vp = vp0 + slot * SLOTB;
#pragma unroll
              for (int d0 = 0; d0 < 2; ++d0) { s16x4 lo[4], hh4[4];
#pragma unroll
                for (int k4 = 0; k4 < 4; ++k4) { lo[k4] = vtr(vp + d0 * 4096 + k4 * 1024); hh4[k4] = vtr(vp + d0 * 4096 + k4 * 1024 + 512); }
#pragma unroll
                for (int hh = 0; hh < 2; ++hh)
#pragma unroll
                    for (int k4 = 0; k4 < 4; ++k4) { const bf16x8 vb8 = (bf16x8){lo[k4][0], lo[k4][1], lo[k4][2], lo[k4][3], hh4[k4][0], hh4[k4][1], hh4[k4][2], hh4[k4][3]};
                        o[hh][d0] = __builtin_amdgcn_mfma_f32_32x32x16_bf16(__builtin_bit_cast(bf16x8, pw[hh][k4]), vb8, o[hh][d0], 0, 0, 0); } } }
        }
        asm volatile("s_waitcnt vmcnt(0) lgkmcnt(0)\n\ts_barrier" ::: "memory");
    }
#pragma unroll
    for (int hh = 0; hh < 2; ++hh) {
        float lr = l_reg[hh];
        { auto rr = __builtin_amdgcn_permlane32_swap(__float_as_uint(lr), __float_as_uint(lr), false, false); lr = __uint_as_float(rr[0]) + __uint_as_float(rr[1]); }
        if (hi == 0) wsf[32 + r32] = lr;
        asm volatile("s_waitcnt lgkmcnt(0)" ::: "memory");
        float rli[16];
#pragma unroll
        for (int r = 0; r < 16; ++r) rli[r] = __builtin_amdgcn_rcpf(wsf[32 + crow(r, hi)]);
        asm volatile("s_waitcnt lgkmcnt(0)" ::: "memory");
        unsigned char* Ow = (unsigned char*)O + qrow * 1024 + (h0 + hh) * 64;
        LAS unsigned char* stg = shm + LDS_OST + wid * 4096 + hh * 2048;
#pragma unroll
        for (int r = 0; r < 16; ++r) { const int orow = crow(r, hi);
#pragma unroll
            for (int d0 = 0; d0 < 2; ++d0) stg[orow * 64 + d0 * 32 + r32] = (unsigned char)f2f8(o[hh][d0][r] * rli[r]); }
        asm volatile("s_waitcnt lgkmcnt(0)" ::: "memory");
#pragma unroll
        for (int i = 0; i < 2; ++i) { const int row = i * 16 + (lane >> 2), ch = lane & 3; const u32x4 v = *(const LAS u32x4*)(stg + row * 64 + ch * 16); *(GAS u32x4*)(Ow + (long)row * 1024 + ch * 16) = v; }
    }
    asm volatile("s_waitcnt lgkmcnt(0)" ::: "memory");
#undef TROW
#undef DMA_KV
}
}

struct Args {
    const float* in[20];
    float* out; unsigned char* ws;
};
struct Frame {
    LAS unsigned char* lds; unsigned* ctl; unsigned char* ws;
    int tid, lane, wave, gw;
    int blk;
    __device__ __forceinline__ void refresh() { tid = opaque_tid(); lane = tid & 63; wave = __builtin_amdgcn_readfirstlane(tid >> 6); gw = blk * 8 + wave;
        asm volatile("" : "+s"(ws)); ctl = (unsigned*)(ws + WS_CTL); }
};
constexpr int NGW = GRID * NWAVES;

struct Row { f32x4 v[4]; };
__device__ __forceinline__ int vq(int q, int lane) { return 64 * (lane >> 4) + 2 * (lane & 15) + 32 * (q >> 1) + (q & 1); }
__device__ __forceinline__ int vb(int j, int lane) { return 32 * (lane >> 4) + (lane & 15) + 16 * j; }
__device__ __forceinline__ void row_load_bf16(Row& r, const bf16_t* p, int lane) {
#pragma unroll
    for (int j = 0; j < 2; ++j) { const u32x4 w = __builtin_nontemporal_load((const GAS u32x4*)p + vb(j, lane)); r.v[2 * j] = (f32x4){bflo(w.x), bfhi(w.x), bflo(w.y), bfhi(w.y)}; r.v[2 * j + 1] = (f32x4){bflo(w.z), bfhi(w.z), bflo(w.w), bfhi(w.w)}; } }
__device__ __forceinline__ void row_store_bf16(const Row& r, bf16_t* p, int lane) {
#pragma unroll
    for (int j = 0; j < 2; ++j) { u32x4 w; w.x = pk2(r.v[2 * j][0], r.v[2 * j][1]); w.y = pk2(r.v[2 * j][2], r.v[2 * j][3]); w.z = pk2(r.v[2 * j + 1][0], r.v[2 * j + 1][1]); w.w = pk2(r.v[2 * j + 1][2], r.v[2 * j + 1][3]); ((GAS u32x4*)p)[vb(j, lane)] = w; } }
__device__ __forceinline__ void row_load_fp8(Row& r, const unsigned char* p, int lane) {
    const u32x4 w = __builtin_nontemporal_load((const GAS u32x4*)p + lane);
#pragma unroll
    for (int q = 0; q < 4; ++q) { const f32x2v lo = __builtin_amdgcn_cvt_pk_f32_fp8((int)w[q], false), hi = __builtin_amdgcn_cvt_pk_f32_fp8((int)w[q], true); r.v[q] = (f32x4){lo[0], lo[1], hi[0], hi[1]}; } }
__device__ __forceinline__ void row_store_fp8(const Row& r, unsigned char* p, int lane) {
    const int e0 = 256 * (lane >> 4) + 8 * (lane & 15);
#pragma unroll
    for (int j = 0; j < 2; ++j) { int w0 = 0, w1 = 0;
        w0 = __builtin_amdgcn_cvt_pk_fp8_f32(r.v[2 * j][0], r.v[2 * j][1], w0, false); w0 = __builtin_amdgcn_cvt_pk_fp8_f32(r.v[2 * j][2], r.v[2 * j][3], w0, true);
        w1 = __builtin_amdgcn_cvt_pk_fp8_f32(r.v[2 * j + 1][0], r.v[2 * j + 1][1], w1, false); w1 = __builtin_amdgcn_cvt_pk_fp8_f32(r.v[2 * j + 1][2], r.v[2 * j + 1][3], w1, true);
        u32x2 o; o.x = (unsigned)w0; o.y = (unsigned)w1; *(GAS u32x2*)(p + e0 + 128 * j) = o; } }
__device__ __forceinline__ void row_load_f32(Row& r, const float* p, int lane) {
#pragma unroll
    for (int q = 0; q < 4; ++q) r.v[q] = __builtin_nontemporal_load((const GAS f32x4*)p + vq(q, lane)); }
__device__ __forceinline__ void row_store_f32(const Row& r, float* p, int lane) {
#pragma unroll
    for (int q = 0; q < 4; ++q) ((GAS f32x4*)p)[vq(q, lane)] = r.v[q]; }
__device__ __forceinline__ void row_normalize(Row& r, float eps) {
    float s = 0.f;
#pragma unroll
    for (int j = 0; j < 4; ++j) s += (r.v[j][0] + r.v[j][1]) + (r.v[j][2] + r.v[j][3]);
    const float mean = wave_sum(s) * (1.f / D); float q = 0.f;
#pragma unroll
    for (int j = 0; j < 4; ++j) { r.v[j] = r.v[j] - mean; q += (r.v[j][0] * r.v[j][0] + r.v[j][1] * r.v[j][1]) + (r.v[j][2] * r.v[j][2] + r.v[j][3] * r.v[j][3]); }
    const float rstd = 1.f / sqrtf(wave_sum(q) * (1.f / D) + eps);
#pragma unroll
    for (int j = 0; j < 4; ++j) r.v[j] = r.v[j] * rstd;
}
__device__ __forceinline__ void row_normalize_stats(Row& r, float eps, float& mean_o, float& rstd_o) {
    float s = 0.f;
#pragma unroll
    for (int j = 0; j < 4; ++j) s += (r.v[j][0] + r.v[j][1]) + (r.v[j][2] + r.v[j][3]);
    const float mean = wave_sum(s) * (1.f / D); float q = 0.f;
#pragma unroll
    for (int j = 0; j < 4; ++j) { r.v[j] = r.v[j] - mean; q += (r.v[j][0] * r.v[j][0] + r.v[j][1] * r.v[j][1]) + (r.v[j][2] * r.v[j][2] + r.v[j][3] * r.v[j][3]); }
    const float rstd = 1.f / sqrtf(wave_sum(q) * (1.f / D) + eps);
#pragma unroll
    for (int j = 0; j < 4; ++j) r.v[j] = r.v[j] * rstd;
    mean_o = mean; rstd_o = rstd;
}
__device__ __forceinline__ void row_modulate(Row& r, const float* sh, const float* sc, int lane) {
    row_normalize(r, MOD_EPS);
#pragma unroll
    for (int j = 0; j < 4; ++j) { const f32x4 a = ((const GAS f32x4*)sc)[vq(j, lane)], b = ((const GAS f32x4*)sh)[vq(j, lane)]; r.v[j] = r.v[j] * (a + 1.f) + b; }
}
__device__ __forceinline__ int mod_row(int row) { return row < T ? (row >> 11) : 32; }
__device__ __forceinline__ const float* mod_vec(const unsigned char* ws, int layer, int mr, int chunk) { return (const float*)(ws + WS_MOD) + ((size_t)(layer * 33 + mr) * 6 + chunk) * 1024; }

__device__ __forceinline__ void conv_item(const float* W, int N, bf16_t* WT, int Kd, int kd0, int n0, int drow0, bool mirror, LAS float* scr, int lane) {
#pragma unroll 8
    for (int i = 0; i < 32; ++i) { const int kk = 2 * i + (lane >> 5); const int kd = kd0 + kk; const int ks = mirror ? ((kd & ~255) + ((256 - (kd & 255)) & 255)) : kd;
        scr[kk * 33 + (lane & 31)] = ((const GAS float*)W)[(size_t)ks * N + n0 + (lane & 31)]; }
    LDS_WAIT(); asm volatile("" ::: "memory");
    const int c = lane & 7;
#pragma unroll
    for (int j = 0; j < 4; ++j) { const int n = (lane >> 3) + 8 * j; const LAS float* s = scr + (8 * c) * 33 + n;
        u32x4 o; o.x = pk2(s[0 * 33], s[1 * 33]); o.y = pk2(s[2 * 33], s[3 * 33]); o.z = pk2(s[4 * 33], s[5 * 33]); o.w = pk2(s[6 * 33], s[7 * 33]);
        *(GAS u32x4*)(WT + (size_t)(drow0 + n) * Kd + kd0 + 8 * c) = o; }
    LDS_WAIT(); asm volatile("" ::: "memory");
}
__device__ __forceinline__ void conv_matrix_item(const float* W, int K, int N, bf16_t* WT, int mode, int roff, int item, LAS float* scr, int lane) {
    const int nblk = N / 32, kb = item / nblk, nb = item % nblk, n0 = 32 * nb;
    int drow0 = n0 + roff; if (mode == 1) drow0 = (n0 >> 7) * 256 + (n0 & 127); if (mode == 2) drow0 = (n0 >> 7) * 256 + 128 + (n0 & 127);
    conv_item(W, N, WT, K, 64 * kb, n0, drow0, mode == 3, scr, lane);
}
__device__ __forceinline__ void conv_item64(const float* W, int N, bf16_t* WT, int Kd, int k0, int n0, int drow0, LAS bf16_t* scr, int lane) {
    f32x4 v[16];
#pragma unroll
    for (int i = 0; i < 16; ++i) v[i] = *(const GAS f32x4*)(W + (size_t)(k0 + 4 * i + (lane >> 4)) * N + n0 + (lane & 15) * 4);
#pragma unroll
    for (int i = 0; i < 16; ++i) { u32x2 w; w.x = pk2(v[i][0], v[i][1]); w.y = pk2(v[i][2], v[i][3]); *(LAS u32x2*)(scr + (4 * i + (lane >> 4)) * 68 + (lane & 15) * 4) = w; }
    LDS_WAIT(); asm volatile("" ::: "memory");
    const int c = lane & 7;
#pragma unroll
    for (int j = 0; j < 8; ++j) { const int n = (lane >> 3) + 8 * j; const LAS bf16_t* p = scr + (8 * c) * 68 + n;
        u32x4 o; o.x = (unsigned)p[0] | ((unsigned)p[68] << 16); o.y = (unsigned)p[2 * 68] | ((unsigned)p[3 * 68] << 16); o.z = (unsigned)p[4 * 68] | ((unsigned)p[5 * 68] << 16); o.w = (unsigned)p[6 * 68] | ((unsigned)p[7 * 68] << 16);
        *(GAS u32x4*)(WT + (size_t)(drow0 + n) * Kd + k0 + 8 * c) = o; }
    LDS_WAIT(); asm volatile("" ::: "memory");
}
__device__ __forceinline__ void conv_item64_f8(const float* W, int N, unsigned char* WT, int Kd, int k0, int n0, int drow0, LAS unsigned char* scr, int lane, bool mirror = false) {
    f32x4 v[16];
#pragma unroll
    for (int i = 0; i < 16; ++i) { const int kd = k0 + 4 * i + (lane >> 4); const int ks = mirror ? ((kd & ~255) + ((256 - (kd & 255)) & 255)) : kd; v[i] = __builtin_nontemporal_load((const GAS f32x4*)(W + (size_t)ks * N + n0 + (lane & 15) * 4)); }
#pragma unroll
    for (int i = 0; i < 16; ++i) { int w = 0; w = __builtin_amdgcn_cvt_pk_fp8_f32(v[i][0] * 64.f, v[i][1] * 64.f, w, false); w = __builtin_amdgcn_cvt_pk_fp8_f32(v[i][2] * 64.f, v[i][3] * 64.f, w, true);
        *(LAS unsigned*)(scr + (4 * i + (lane >> 4)) * 68 + (lane & 15) * 4) = (unsigned)w; }
    LDS_WAIT(); asm volatile("" ::: "memory");
    const int c = lane & 3;
#pragma unroll
    for (int j = 0; j < 4; ++j) { const int n = (lane >> 2) + 16 * j; const LAS unsigned char* p = scr + (16 * c) * 68 + n; u32x4 o;
#pragma unroll
        for (int q = 0; q < 4; ++q) o[q] = (unsigned)p[(4 * q) * 68] | ((unsigned)p[(4 * q + 1) * 68] << 8) | ((unsigned)p[(4 * q + 2) * 68] << 16) | ((unsigned)p[(4 * q + 3) * 68] << 24);
        *(GAS u32x4*)(WT + (size_t)(drow0 + n) * Kd + k0 + 16 * c) = o; }
    LDS_WAIT(); asm volatile("" ::: "memory");
}
__device__ __forceinline__ void conv_experts(Frame& F, const Args& a, int layer) {
    F.refresh();
    LAS unsigned char* scr = F.lds + 32768 + F.wave * 4352;
    unsigned char* EGU = F.ws + WS_EGU; unsigned char* ED = F.ws + WS_ED;
    for (int it = F.gw; it < (NE + 1) * 192; it += NGW) { const int e = it / 192, r = it % 192;
        const float* wg = e < NE ? a.in[14] + ((size_t)layer * NE + e) * 262144 : a.in[17] + (size_t)layer * 262144;
        const float* wu = e < NE ? a.in[15] + ((size_t)layer * NE + e) * 262144 : a.in[18] + (size_t)layer * 262144;
        const float* wd = e < NE ? a.in[16] + ((size_t)layer * NE + e) * 262144 : a.in[19] + (size_t)layer * 262144;
        if (r < 128) { const int q = r & 63, kb = q >> 2, nb = q & 3, n0 = 64 * nb; const int drow0 = (n0 >> 7) * 256 + (r < 64 ? 0 : 128) + (n0 & 127);
            conv_item64_f8(r < 64 ? wg : wu, 256, EGU + (size_t)e * 512 * 1024, 1024, 64 * kb, n0, drow0, scr, F.lane); }
        else { const int q = r - 128, kb = q >> 4, nb = q & 15; conv_item64_f8(wd, 1024, ED + (size_t)e * 1024 * 256, 256, 64 * kb, 64 * nb, 64 * nb, scr, F.lane); } }
}
__device__ __forceinline__ void conv_small(Frame& F, const Args& a) {
    F.refresh();
    { LAS unsigned char* scr8 = F.lds + 32768 + F.wave * 4352;
      for (int it = F.gw; it < 2304; it += NGW) {
          if (it < 768) { const int j = it / 384, r = it % 384, kb = r / 24, nb = r % 24; conv_item64_f8(a.in[8] + (size_t)j * 1024 * 1536, 1536, F.ws + WS_WQKV + (size_t)j * 1536 * 1024, 1024, 64 * kb, 64 * nb, 64 * nb, scr8, F.lane); }
          else if (it < 1280) { const int q = it - 768, j = q >> 8, r = q & 255, kb = r >> 4, nb = r & 15; conv_item64_f8(a.in[9] + (size_t)j * 1024 * 1024, 1024, F.ws + WS_WO + (size_t)j * 1024 * 1024, 1024, 64 * kb, 64 * nb, 64 * nb, scr8, F.lane); }
          else { const int q = it - 1280, j = q >> 9, r = q & 511, mir = r >> 8, kb = (r & 255) >> 4, nb = r & 15;
              conv_item64_f8(a.in[11] + (size_t)j * 1024 * 1024, 1024, F.ws + WS_WSH + (size_t)j * 2048 * 1024, 1024, 64 * kb, 64 * nb, 64 * nb + 1024 * mir, scr8, F.lane, mir != 0); } } }
    __syncthreads();
    { LAS float* scr = (LAS float*)(F.lds + 32768 + F.wave * 8448);
      for (int it = F.gw; it < 1152; it += NGW) {
          if (it < 1024) { const int j = it >> 9, r = it & 511; conv_matrix_item(a.in[11] + (size_t)j * 1024 * 1024, 1024, 1024, (bf16_t*)(F.ws + WS_WF) + (size_t)j * 2048 * 1024, 0, 0, r, scr, F.lane); }
          else { const int q = it - 1024, l = q / 32, r = q % 32; conv_matrix_item(a.in[12] + (size_t)l * 1024 * 64, 1024, 64, (bf16_t*)(F.ws + WS_WR) + (size_t)l * 64 * 1024, 0, 0, r, scr, F.lane); } } }
    const int gt = F.blk * NTHR + F.tid, NGT = GRID * NTHR;
    const float TWO_PI = 6.283185307179586f;
    { float* rc = (float*)(F.ws + WS_ROPEC); float* rs = (float*)(F.ws + WS_ROPES);
      for (int i = gt; i < 64 * 16; i += NGT) { const int pos = i >> 4, fi = i & 15; const float inv = exp2f(-(float)fi * (13.287712379549449f / 16.f)); const float ang = (float)pos * inv; rc[i] = cosf(ang); rs[i] = sinf(ang); } }
    { unsigned* cs = (unsigned*)(F.ws + WS_CSN);
      for (int i = gt; i < 512 * 64; i += NGT) { const int r = i >> 6, n4 = (i & 63) * 4, m = r & 255; unsigned w = 0;
#pragma unroll
          for (int q = 0; q < 4; ++q) { const float ang = TWO_PI * (float)((m * (n4 + q)) & 255) * (1.f / 256.f); w |= f2f8(r < 256 ? __cosf(ang) : -__sinf(ang)) << (8 * q); }
          cs[i] = w; } }
    { unsigned* dl = (unsigned*)(F.ws + WS_DL);
      for (int i = gt; i < 1024 * 1024; i += NGT) { const int k = i >> 10, c4 = (i & 1023) * 4; unsigned w = 0;
#pragma unroll
          for (int q = 0; q < 4; ++q) { const int c = c4 + q, l = c & 2047; const float ang = TWO_PI * (float)((k * l) & 2047) * (1.f / 2048.f); w |= f2f8(c < 2048 ? __cosf(ang) : __sinf(ang)) << (8 * q); }
          dl[i] = w; } }
    { unsigned* dl = (unsigned*)(F.ws + WS_DLC);
      for (int i = gt; i < 256 * 128; i += NGT) { const int k = i >> 7, c4 = (i & 127) * 4; unsigned w = 0;
#pragma unroll
          for (int q = 0; q < 4; ++q) { const int c = c4 + q, l = c & 255; const float ang = TWO_PI * (float)((k * l) & 255) * (1.f / 256.f); w |= f2f8(c < 256 ? __cosf(ang) : __sinf(ang)) << (8 * q); }
          dl[i] = w; } }
}
__device__ __forceinline__ void mod_full(Frame& F, const Args& a) {
    F.refresh();
    if (F.blk >= 192) return;
    const int l = F.blk / 48, cb = F.blk % 48; const int g = F.tid & 31, ks = F.tid >> 5; const int n0 = cb * 128;
    LAS float* s = (LAS float*)F.lds;
    f32x4 acc[33];
#pragma unroll
    for (int r = 0; r < 33; ++r) acc[r] = (f32x4){0.f, 0.f, 0.f, 0.f};
    for (int half = 0; half < 2; ++half) {
        __syncthreads();
        for (int i = F.tid; i < 512 * 33; i += NTHR) { const int k = i / 33, r = i % 33; const float c = (r < 32) ? a.in[1][(size_t)r * 1024 + half * 512 + k] : a.in[3][half * 512 + k]; s[k * 36 + r] = c / (1.f + __expf(-c)); }
        __syncthreads();
        const GAS f32x4* w = (const GAS f32x4*)((const GAS float*)a.in[4] + ((size_t)l * 1024 + half * 512 + ks * 32) * 6144 + n0 + 4 * g);
#pragma unroll 1
        for (int kb = 0; kb < 32; kb += 8) { f32x4 wv[8];
#pragma unroll
            for (int q = 0; q < 8; ++q) wv[q] = __builtin_nontemporal_load(w + (size_t)(kb + q) * (6144 / 4));
#pragma unroll
            for (int q = 0; q < 8; ++q) { const LAS float* sr = s + (ks * 32 + kb + q) * 36;
#pragma unroll
                for (int r = 0; r < 33; ++r) acc[r] += wv[q] * sr[r];
                asm volatile("" ::: "memory"); } }
    }
    LAS float* red = (LAS float*)F.lds;
    float* mod = (float*)(F.ws + WS_MOD);
#define MF_PASS(r0, nr) do { __syncthreads(); \
        _Pragma("unroll") for (int rr = 0; rr < (nr); ++rr) *(LAS f32x4*)(red + ((ks * 8 + rr) * 128 + 4 * g)) = acc[(r0) + rr]; \
        __syncthreads(); \
        for (int i = F.tid; i < (nr) * 128; i += NTHR) { const int rr = i >> 7, c = i & 127; float t = 0.f; \
            _Pragma("unroll") for (int k2 = 0; k2 < 16; ++k2) t += red[((k2 * 8 + rr) * 128) + c]; \
            mod[((size_t)l * 33 + (r0) + rr) * 6144 + n0 + c] = a.in[5][l * 6144 + n0 + c] + t; } } while (0)
    MF_PASS(0, 8); MF_PASS(8, 8); MF_PASS(16, 8); MF_PASS(24, 8); MF_PASS(32, 1);
#undef MF_PASS
    __syncthreads();
}
__device__ __forceinline__ void rows_init(Frame& F, const Args& a) {
    F.refresh();
    bf16_t* XS = (bf16_t*)(F.ws + WS_XS);
    static_assert(TT % (4 * NGW) == 0, "rows_init: four rows per wave and iteration");
    for (int r0 = F.gw; r0 < TT; r0 += 4 * NGW) {
        Row r[4];
#pragma unroll
        for (int t = 0; t < 4; ++t) { const int row = r0 + t * NGW; row_load_f32(r[t], row < T ? a.in[0] + (size_t)row * D : a.in[2] + (size_t)(row - T) * D, F.lane); }
#pragma unroll
        for (int t = 0; t < 4; ++t) { const int row = r0 + t * NGW; const int mr = mod_row(row);
            row_store_bf16(r[t], XS + (size_t)row * D, F.lane);
            row_modulate(r[t], mod_vec(F.ws, 0, mr, 0), mod_vec(F.ws, 0, mr, 1), F.lane);
            row_store_fp8(r[t], (unsigned char*)a.out + OUT_U8 + (size_t)row * D, F.lane);
            asm volatile("" ::: "memory"); } }
}
__device__ __forceinline__ void rows_post1(Frame& F, const Args& a, int layer, int nrows) {
    F.refresh();
    bf16_t* XS = (bf16_t*)(F.ws + WS_XS); const unsigned char* Y8 = (const unsigned char*)a.out;
    const float* lg = a.in[6] + (size_t)(layer * 2 + 0) * D; const float* lb = a.in[7] + (size_t)(layer * 2 + 0) * D;
    const int TPB = nrows / GRID;
    for (int rl = F.wave; rl < TPB; rl += 4 * NWAVES) {
        u32x4 xr[4][2], yr[4];
#pragma unroll
        for (int t = 0; t < 4; ++t) { const int row = F.blk * TPB + rl + t * NWAVES;
#pragma unroll
            for (int j = 0; j < 2; ++j) xr[t][j] = __builtin_nontemporal_load((const GAS u32x4*)(XS + (size_t)row * D) + vb(j, F.lane));
            yr[t] = __builtin_nontemporal_load((const GAS u32x4*)(Y8 + (size_t)row * D) + F.lane); }
#pragma unroll
        for (int t = 0; t < 4; ++t) { const int row = F.blk * TPB + rl + t * NWAVES; const int mr = mod_row(row);
            Row x, y;
#pragma unroll
            for (int j = 0; j < 2; ++j) { const u32x4 w = xr[t][j];
                x.v[2 * j] = (f32x4){bflo(w.x), bfhi(w.x), bflo(w.y), bfhi(w.y)}; x.v[2 * j + 1] = (f32x4){bflo(w.z), bfhi(w.z), bflo(w.w), bfhi(w.w)}; }
#pragma unroll
            for (int q = 0; q < 4; ++q) { const f32x2v lo = __builtin_amdgcn_cvt_pk_f32_fp8((int)yr[t][q], false), hi = __builtin_amdgcn_cvt_pk_f32_fp8((int)yr[t][q], true); y.v[q] = (f32x4){lo[0], lo[1], hi[0], hi[1]}; }
            const float* g1 = mod_vec(F.ws, layer, mr, 2);
#pragma unroll
            for (int j = 0; j < 4; ++j) x.v[j] = x.v[j] * ALPHA + (((const GAS f32x4*)g1)[vq(j, F.lane)] * (1.f / YSC)) * y.v[j];
            row_normalize(x, LN_EPS);
#pragma unroll
            for (int j = 0; j < 4; ++j) x.v[j] = x.v[j] * ((const GAS f32x4*)lg)[vq(j, F.lane)] + ((const GAS f32x4*)lb)[vq(j, F.lane)];
            row_store_bf16(x, XS + (size_t)row * D, F.lane);
            float mean, rstd; row_normalize_stats(x, MOD_EPS, mean, rstd);
            if (F.lane == 0) { f32x2v st = {mean, rstd}; *(GAS f32x2v*)(F.ws + WS_RSTAT + (size_t)row * 8) = st; }
            { const float* sh = mod_vec(F.ws, layer, mr, 3); const float* sc = mod_vec(F.ws, layer, mr, 4);
#pragma unroll
              for (int j = 0; j < 4; ++j) { const f32x4 av = ((const GAS f32x4*)sc)[vq(j, F.lane)], bv = ((const GAS f32x4*)sh)[vq(j, F.lane)]; x.v[j] = x.v[j] * (av + 1.f) + bv; } }
            row_store_fp8(x, (unsigned char*)a.out + OUT_U8 + (size_t)row * D, F.lane);
            asm volatile("" ::: "memory"); }
    }
}
__device__ __forceinline__ void rows_post2(Frame& F, const Args& a, int layer, int t0, int n) {
    F.refresh();
    bf16_t* XS = (bf16_t*)(F.ws + WS_XS); const unsigned char* YB = (const unsigned char*)(F.ws + WS_YB); const unsigned char* YS = (const unsigned char*)(F.ws + WS_YS);
    const int* spos = (const int*)(F.ws + WS_SDST); const float* tkw = (const float*)(F.ws + WS_TKW);
    const float* lg = a.in[6] + (size_t)(layer * 2 + 1) * D; const float* lb = a.in[7] + (size_t)(layer * 2 + 1) * D;
    for (int i0 = F.gw; i0 < n; i0 += 2 * NGW) {
        const int i1 = i0 + NGW; const bool two = i1 < n;
        int pj[2]; float wj[2];
#pragma unroll
        for (int t = 0; t < 2; ++t) { pj[t] = 0; wj[t] = 0.f; const int row = t0 + (t ? i1 : i0); if ((t == 0 || two) && F.lane < 8) { pj[t] = ((const GAS int*)spos)[(size_t)row * 8 + F.lane]; wj[t] = ((const GAS float*)tkw)[(size_t)row * 8 + F.lane]; } }
        Row x[2], y[2];
#pragma unroll
        for (int t = 0; t < 2; ++t) { const int i = t ? i1 : i0; if (t == 0 || two) { row_load_bf16(x[t], XS + (size_t)(t0 + i) * D, F.lane); row_load_fp8(y[t], YS + (size_t)i * D, F.lane); } }
        u32x4 zr[2][8];
#pragma unroll
        for (int t = 0; t < 2; ++t) if (t == 0 || two) {
#pragma unroll
            for (int s = 0; s < 8; ++s) { const int ps = __builtin_amdgcn_readlane(pj[t], s); zr[t][s] = __builtin_nontemporal_load((const GAS u32x4*)(YB + (size_t)ps * D) + F.lane); } }
#pragma unroll
        for (int t = 0; t < 2; ++t) if (t == 0 || two) { const int i = t ? i1 : i0; const int row = t0 + i; const int mr = mod_row(row);
#pragma unroll
            for (int j = 0; j < 4; ++j) y[t].v[j] = y[t].v[j] * (1.f / 16.f);
#pragma unroll
            for (int s = 0; s < 8; ++s) { const float wz = __builtin_bit_cast(float, __builtin_amdgcn_readlane(__builtin_bit_cast(int, wj[t]), s)) * (1.f / 16.f);
#pragma unroll
                for (int j = 0; j < 4; ++j) { const f32x2v lo = __builtin_amdgcn_cvt_pk_f32_fp8((int)zr[t][s][j], false), hi = __builtin_amdgcn_cvt_pk_f32_fp8((int)zr[t][s][j], true); y[t].v[j] += (f32x4){lo[0], lo[1], hi[0], hi[1]} * wz; } }
            const float* g2 = mod_vec(F.ws, layer, mr, 5);
#pragma unroll
            for (int j = 0; j < 4; ++j) x[t].v[j] = x[t].v[j] * ALPHA + ((const GAS f32x4*)g2)[vq(j, F.lane)] * y[t].v[j];
            row_normalize(x[t], LN_EPS);
#pragma unroll
            for (int j = 0; j < 4; ++j) x[t].v[j] = x[t].v[j] * ((const GAS f32x4*)lg)[vq(j, F.lane)] + ((const GAS f32x4*)lb)[vq(j, F.lane)];
            if (layer == 3) { row_store_f32(x[t], a.out + (size_t)row * D, F.lane); }
            else { row_store_bf16(x[t], XS + (size_t)row * D, F.lane);
                row_modulate(x[t], mod_vec(F.ws, layer + 1, mr, 0), mod_vec(F.ws, layer + 1, mr, 1), F.lane);
                row_store_fp8(x[t], (unsigned char*)a.out + OUT_U8 + (size_t)row * D, F.lane); } }
    }
}
__device__ __forceinline__ float wave_max_dpp(float v) {
    int x = __builtin_bit_cast(int, v);
#define DPPMAX(ctrl) { const int y = __builtin_amdgcn_update_dpp(x, x, ctrl, 0xf, 0xf, false); x = __builtin_bit_cast(int, fmaxf(__builtin_bit_cast(float, x), __builtin_bit_cast(float, y))); }
    DPPMAX(0xB1) DPPMAX(0x4E) DPPMAX(0x141) DPPMAX(0x140)
#undef DPPMAX
    const float r0 = __builtin_bit_cast(float, __builtin_amdgcn_readlane(x, 0)), r1 = __builtin_bit_cast(float, __builtin_amdgcn_readlane(x, 16));
    const float r2 = __builtin_bit_cast(float, __builtin_amdgcn_readlane(x, 32)), r3 = __builtin_bit_cast(float, __builtin_amdgcn_readlane(x, 48));
    return fmaxf(fmaxf(r0, r1), fmaxf(r2, r3));
}
__device__ __forceinline__ void route_tokens(Frame& F, const Args& a, int layer, int ntok) {
    F.refresh();
    const int TPB = ntok / GRID;
    const bf16_t* U = (const bf16_t*)(F.ws + WS_XS); const bf16_t* Wr = (const bf16_t*)(F.ws + WS_WR) + (size_t)layer * 64 * 1024;
    int* tke = (int*)(F.ws + WS_TKE); float* tkw = (float*)(F.ws + WS_TKW);
    LAS int* lcnt = (LAS int*)(F.lds + L_LCNT);
    LAS float* lg = (LAS float*)(F.lds);
    if (F.tid < 64) lcnt[F.tid] = 0;
    const int lane = F.lane, fr = lane & 15, fq = lane >> 4;
    const int ntile = TPB / 16;
    constexpr int WPITCH = 1040; constexpr int L_SE = 122880;
    LAS float* sEb = (LAS float*)(F.lds + L_SE);
    f32x4 acc[3][4];
#pragma unroll
    for (int i = 0; i < 3; ++i)
#pragma unroll
        for (int n = 0; n < 4; ++n) acc[i][n] = (f32x4){0.f, 0.f, 0.f, 0.f};
    int grp_of[3] = {0, 0, 0};
    int tl_lo = 0, g = 0;
    while (tl_lo < ntile) {
        const int mr = mod_row(F.blk * TPB + tl_lo * 16); int tl_hi = tl_lo + 1;
        while (tl_hi < ntile && mod_row(F.blk * TPB + tl_hi * 16) == mr) ++tl_hi;
        const float* shv = mod_vec(F.ws, layer, mr, 3); const float* scv = mod_vec(F.ws, layer, mr, 4);
        for (int half = 0; half < 2; ++half) {
            __syncthreads();
            { const int kc = lane, k = half * 512 + kc * 8;
              const f32x4 c0 = *(const GAS f32x4*)(scv + k) + 1.f, c1 = *(const GAS f32x4*)(scv + k + 4) + 1.f, h0 = *(const GAS f32x4*)(shv + k), h1 = *(const GAS f32x4*)(shv + k + 4);
              u32x4 wv[8];
#pragma unroll
              for (int j = 0; j < 8; ++j) wv[j] = *(const GAS u32x4*)(Wr + (size_t)(F.wave + 8 * j) * D + k);
#pragma unroll
              for (int j = 0; j < 8; ++j) { const int e = F.wave + 8 * j; const u32x4 w = wv[j];
                const float w0 = bflo(w.x), w1 = bfhi(w.x), w2 = bflo(w.y), w3 = bfhi(w.y), w4 = bflo(w.z), w5 = bfhi(w.z), w6 = bflo(w.w), w7 = bfhi(w.w);
                u32x4 o; o.x = cvt_pk_bf16(w0 * c0[0], w1 * c0[1]); o.y = cvt_pk_bf16(w2 * c0[2], w3 * c0[3]); o.z = cvt_pk_bf16(w4 * c1[0], w5 * c1[1]); o.w = cvt_pk_bf16(w6 * c1[2], w7 * c1[3]);
                *(LAS u32x4*)(F.lds + e * WPITCH + kc * 16) = o;
                const float se = wave_sum(((bflo(o.x) + bfhi(o.x)) + (bflo(o.y) + bfhi(o.y))) + ((bflo(o.z) + bfhi(o.z)) + (bflo(o.w) + bfhi(o.w))));
                const float be = wave_sum(((w0 * h0[0] + w1 * h0[1]) + (w2 * h0[2] + w3 * h0[3])) + ((w4 * h1[0] + w5 * h1[1]) + (w6 * h1[2] + w7 * h1[3])));
                if (lane == 0) { if (half == 0) { sEb[g * 64 + e] = se; sEb[192 + g * 64 + e] = be; } else { sEb[g * 64 + e] += se; sEb[192 + g * 64 + e] += be; } }
                asm volatile("" ::: "memory"); } }
            __syncthreads();
#pragma unroll
            for (int i = 0; i < 3; ++i) { const int tl = F.wave + 8 * i;
                if (tl >= tl_lo && tl < tl_hi) { const int t0 = F.blk * TPB + tl * 16;
                    const GAS bf16x8* ap = (const GAS bf16x8*)(U + (size_t)(t0 + fr) * D + half * 512 + fq * 8);
                    bf16x8 av[16];
#pragma unroll
                    for (int ks = 0; ks < 16; ++ks) av[ks] = ap[ks * 4];
#pragma unroll
                    for (int ks = 0; ks < 16; ++ks) {
#pragma unroll
                        for (int n = 0; n < 4; ++n) { const bf16x8 bv = *(const LAS bf16x8*)(F.lds + (n * 16 + fr) * WPITCH + (ks * 32 + fq * 8) * 2); acc[i][n] = __builtin_amdgcn_mfma_f32_16x16x32_bf16(av[ks], bv, acc[i][n], 0, 0, 0); }
                        if ((ks & 1) == 1) __builtin_amdgcn_sched_barrier(0); }
                    grp_of[i] = g; } }
        }
        tl_lo = tl_hi; ++g;
    }
    __syncthreads();
#pragma unroll
    for (int i = 0; i < 3; ++i) { const int tl = F.wave + 8 * i;
        if (tl < ntile) { const int t0 = F.blk * TPB + tl * 16; const int gi = grp_of[i];
#pragma unroll
            for (int j = 0; j < 4; ++j) { const f32x2v st = *(const GAS f32x2v*)(F.ws + WS_RSTAT + (size_t)(t0 + fq * 4 + j) * 8);
#pragma unroll
                for (int n = 0; n < 4; ++n) { const float se = sEb[gi * 64 + n * 16 + fr], be = sEb[192 + gi * 64 + n * 16 + fr];
                    lg[(tl * 16 + fq * 4 + j) * 65 + n * 16 + fr] = st[1] * (acc[i][n][j] - st[0] * se) + be; } } } }
    __syncthreads();
    if (F.tid < TPB) {
        const int tok = F.blk * TPB + F.tid; const LAS float* row = lg + F.tid * 65; const float* bias = a.in[13] + layer * 64;
        float sg[64], sel[64];
#pragma unroll
        for (int e = 0; e < 64; ++e) { sg[e] = 1.f / (1.f + __expf(-row[e])); sel[e] = sg[e] + bias[e]; }
        float gs[8];
#pragma unroll
        for (int g = 0; g < 8; ++g) { float m1 = -INFINITY, m2 = -INFINITY;
#pragma unroll
            for (int j = 0; j < 8; ++j) { const float v = sel[g * 8 + j]; const bool gt1 = v > m1; m2 = gt1 ? m1 : fmaxf(m2, v); m1 = gt1 ? v : m1; }
            gs[g] = m1 + m2; }
        unsigned gok = 0;
#pragma unroll
        for (int g = 0; g < 8; ++g) { int rk = 0;
#pragma unroll
            for (int h = 0; h < 8; ++h) rk += (gs[h] > gs[g] || (gs[h] == gs[g] && h < g)) ? 1 : 0;
            gok |= (rk < 4 ? 1u : 0u) << g; }
#pragma unroll
        for (int e = 0; e < 64; ++e) sel[e] = ((gok >> (e >> 3)) & 1u) ? sel[e] : -INFINITY;
        int ce[8]; float cw[8]; float tot = 0.f;
#pragma unroll
        for (int it = 0; it < 8; ++it) { float best = -INFINITY, bs = 0.f; int bi = 0;
#pragma unroll
            for (int e = 0; e < 64; ++e) { const bool b = sel[e] > best; best = b ? sel[e] : best; bs = b ? sg[e] : bs; bi = b ? e : bi; }
#pragma unroll
            for (int e = 0; e < 64; ++e) sel[e] = (e == bi) ? -INFINITY : sel[e];
            ce[it] = bi; cw[it] = bs; tot += bs; }
        const float sc = 2.5f / tot;
#pragma unroll
        for (int it = 0; it < 8; ++it) { tke[(size_t)tok * 8 + it] = ce[it]; tkw[(size_t)tok * 8 + it] = cw[it] * sc; __hip_atomic_fetch_add(&lcnt[ce[it]], 1, __ATOMIC_RELAXED, __HIP_MEMORY_SCOPE_WORKGROUP); }
    }
    __syncthreads();
    if (F.tid < 64) F.ctl[CW_BCNT + F.blk * 64 + F.tid] = (unsigned)lcnt[F.tid];
}
__device__ __forceinline__ void build_lists(Frame& F, int ntok) {
    F.refresh();
    constexpr int NSEG = NCHUNK * 64, BPC = GRID / NCHUNK;
    const int TPB = ntok / GRID, CH = ntok / NCHUNK;
    LAS int* tstart = (LAS int*)(F.lds + L_TSTART); LAS int* pref = (LAS int*)(F.lds + L_PREF); LAS int* lcnt = (LAS int*)(F.lds + L_LCNT);
    LAS unsigned char* tseg = (LAS unsigned char*)(F.lds + L_TSEG); LAS int* scan = (LAS int*)(F.lds + L_SCAN);
    const unsigned* bcnt = F.ctl + CW_BCNT;
    const int myc = F.blk / BPC, mylb = F.blk % BPC;
    int nseg = 0;
    LAS int* cntl = (LAS int*)F.lds;
    for (int i = F.tid; i < GRID * 64; i += NTHR) cntl[i] = (int)((const GAS unsigned*)bcnt)[i];
    if (F.tid < 64) lcnt[F.tid] = 0;
    __syncthreads();
    static_assert(NSEG == 64 && NTHR == 512, "build_lists: one chunk, eight partial sums per expert");
    LAS int* part = (LAS int*)(F.lds + 65536);
    { const int e = F.tid & 63, q = F.tid >> 6; int n = 0, p = 0;
#pragma unroll 8
      for (int lb = q * 32; lb < q * 32 + 32; ++lb) { const int v = cntl[lb * 64 + e]; if (lb < mylb) p += v; n += v; }
      part[q * 64 + e] = n; part[512 + q * 64 + e] = p; }
    __syncthreads();
    if (F.tid < 64) { int n = 0, p = 0;
#pragma unroll
        for (int q = 0; q < 8; ++q) { n += part[q * 64 + F.tid]; p += part[512 + q * 64 + F.tid]; }
        nseg = n; pref[F.tid] = p;
        const int tiles = (n + 255) >> 8; int incl = tiles;
#pragma unroll
        for (int d = 1; d < 64; d <<= 1) { const int o = __shfl_up(incl, d); if (F.lane >= d) incl += o; }
        tstart[F.tid + 1] = incl; if (F.tid == 0) tstart[0] = 0;
        for (int t = incl - tiles; t < incl; ++t) tseg[t] = (unsigned char)F.tid; }
    int* stok = (int*)(F.ws + WS_STOK); int* spos = (int*)(F.ws + WS_SDST);
    const int* tke = (const int*)(F.ws + WS_TKE);
    { const int sseg = myc * 64 + mylb; if (mylb < 64 && F.tid == sseg) scan[0] = nseg; }
    __syncthreads();
    if (mylb < 64) { const int sseg = myc * 64 + mylb; const int n = scan[0]; const int base = tstart[sseg] * 256, end = tstart[sseg + 1] * 256;
      for (int p = base + n + F.tid; p < end; p += NTHR) stok[p] = myc * CH; }
    for (int tb = F.wave * 8; tb < TPB; tb += NWAVES * 8) { const int tl = tb + (F.lane >> 3);
        if (tl < TPB) { const int tok = F.blk * TPB + tl; const int e = tke[(size_t)tok * 8 + (F.lane & 7)];
            const int p = tstart[myc * 64 + e] * 256 + pref[e] + __hip_atomic_fetch_add(&lcnt[e], 1, __ATOMIC_RELAXED, __HIP_MEMORY_SCOPE_WORKGROUP);
            stok[p] = tok; spos[(size_t)tok * 8 + (F.lane & 7)] = p - tstart[myc * 64] * 256; } }
    __syncthreads();
}

struct SchedQKV {
    const char* U; const char* W; int nfull, nu, c;
    __device__ __forceinline__ bool next(int i, pg::Unit& u) const {
        const int L0 = i * GRID + c; if (L0 >= nu) return false;
        int pm, pn;
        if (L0 < nfull) { const int L = pg::xcd_remap(L0, nfull); const int gid = L / 48, w = L % 48; pm = gid * 8 + (w & 7); pn = w >> 3; }
        else { const int q = L0 - nfull; pm = 256 + (q >> 1); pn = 4 + (q & 1); }
        u.A = U + (size_t)pm * 256 * 1024; u.B = W + (size_t)pn * 256 * 1024; u.gidx = nullptr; u.gbase = 0; u.nt = 8; u.out = nullptr; u.ldc = 0; u.scale = 1.f; u.flags = 0; u.i0 = pm; u.i1 = pn;
        return true; }
};
struct SchedDense {
    const char* A; const char* W; char* out; int nrt, nct, nt, c; size_t ldA;
    __device__ __forceinline__ bool next(int i, pg::Unit& u) const {
        const int nu = nrt * nct; const int L0 = i * GRID + c; if (L0 >= nu) return false;
        const int L = pg::xcd_remap(L0, nu); const int per = 8 * nct, gid = L / per, w = L % per, fm = gid * 8, gsz = (nrt - fm) < 8 ? (nrt - fm) : 8; const int pm = fm + (w % gsz), pn = w / gsz;
        u.A = A + (size_t)pm * 256 * ldA; u.B = W + (size_t)pn * 256 * ldA; u.gidx = nullptr; u.gbase = 0; u.nt = nt; u.out = out + (size_t)pm * 256 * 1024; u.ldc = 1024; u.scale = 1.f; u.flags = 0; u.i0 = pm; u.i1 = pn;
        return true; }
};
struct SchedF1 {
    const char* CS; const char* U; char* ABT; char* ABTC; int nu, c;
    __device__ __forceinline__ bool next(int i, pg::Unit& u) const {
        const int L0 = i * GRID + c; if (L0 >= nu) return false;
        u.gidx = nullptr; u.gbase = 0; u.nt = 2; u.scale = 1.f; u.flags = 0; u.i0 = 0; u.i1 = 0;
        if (L0 < 2048) { const int L = pg::xcd_remap(L0, 2048); const int pm = L & 1, pn = (L >> 1) & 7, bg = L >> 4, b = bg >> 2, g = bg & 3;
            u.A = CS + (size_t)pm * 256 * 256; u.B = U + ((size_t)b * SEQ + pn * 256) * 1024 + g * 256; u.out = ABT + (size_t)bg * 256 * 4096 + (size_t)(pm * 2048 + pn * 256); u.ldc = 4096; }
        else { const int q = L0 - 2048; const int pm = q & 1, bg = q >> 1, b = bg >> 2, g = bg & 3;
            u.A = CS + (size_t)pm * 256 * 256; u.B = U + ((size_t)T + b * CTXL) * 1024 + g * 256; u.out = ABTC + (size_t)bg * 256 * 512 + (size_t)pm * 256; u.ldc = 512; }
        return true; }
};
struct SchedF2 {
    const char* DL; const char* ABT; char* FH; int c;
    __device__ __forceinline__ bool next(int i, pg::Unit& u) const {
        const int L0 = i * GRID + c; if (L0 >= 512) return false;
        const int L = pg::xcd_remap(L0, 512); const int pm = L & 3, bg = L >> 2, b = bg >> 2, g = bg & 3;
        u.A = DL + (size_t)pm * 256 * 4096; u.B = ABT + (size_t)bg * 256 * 4096; u.gidx = nullptr; u.gbase = 0; u.nt = 32; u.out = FH + ((size_t)b * 1024 + pm * 256) * 1024 + g * 256; u.ldc = 1024; u.scale = 0.001381067932004975f  ; u.flags = 0; u.i0 = 0; u.i1 = 0;
        return true; }
};
struct SchedF2c {
    const char* DLC; const char* ABTC; char* FC; int c;
    __device__ __forceinline__ bool next(int i, pg::Unit& u) const {
        const int L0 = i * GRID + c; if (L0 >= 128) return false;
        const int bg = L0, b = bg >> 2, g = bg & 3;
        u.A = DLC; u.B = ABTC + (size_t)bg * 256 * 512; u.gidx = nullptr; u.gbase = 0; u.nt = 4; u.out = FC + ((size_t)b * 256) * 1024 + g * 256; u.ldc = 1024; u.scale = 1.f / 256.f; u.flags = 0; u.i0 = 0; u.i1 = 0;
        return true; }
};
struct SchedF3 {
    const char* FH; const char* FC; const char* W; char* Y; int nu, c;
    __device__ __forceinline__ bool next(int i, pg::Unit& u) const {
        const int L0 = i * GRID + c; if (L0 >= nu) return false;
        u.gidx = nullptr; u.gbase = 0; u.nt = 8; u.scale = 1.f; u.flags = 0; u.i0 = 0; u.i1 = 0;
        if (L0 < 1024) { const int L = pg::xcd_remap(L0, 1024); const int gid = L >> 6, w = L & 63, pm = gid * 8 + (w & 7), pn = w >> 3; const int b = pm >> 2, k0 = (pm & 3) * 256;
            u.A = FH + (size_t)pm * 256 * 1024; u.B = W + (size_t)pn * 256 * 1024;
            if (pn < 4) { u.out = Y + ((size_t)b * SEQ + k0) * 1024; u.ldc = 1024; u.i1 = pn; }
            else { u.out = Y + ((size_t)b * SEQ + SEQ - k0) * 1024; u.ldc = -1024; u.i1 = pn - 4; u.flags = (k0 == 0) ? 1 : 0; } }
        else { const int q = L0 - 1024; const int pm = q >> 2, pn = q & 3;
            u.A = FC + (size_t)pm * 256 * 1024; u.B = W + (size_t)pn * 256 * 1024; u.out = Y + ((size_t)T + pm * 256) * 1024; u.ldc = 1024; u.i1 = pn; }
        return true; }
};
struct SchedG1 {
    const char* EGU; const int* STOK; char* H; char* HS; LAS const unsigned char* tseg; int ntl, nsh, c;
    __device__ __forceinline__ bool gsrc(int i, const int*& gidx, int& gbase) const {
        const int nu = (ntl + nsh) * 2; const int L0 = i * GRID + c; if (L0 >= nu) return false;
        const int pm = pg::xcd_remap(L0, nu) >> 1;
        if (pm < ntl) { gidx = STOK + (size_t)pm * 256; gbase = 0; } else { gidx = nullptr; gbase = (pm - ntl) * 256; }
        return true; }
    __device__ __forceinline__ bool next(int i, pg::Unit& u) const {
        const int nu = (ntl + nsh) * 2; const int L0 = i * GRID + c; if (L0 >= nu) return false;
        const int L = pg::xcd_remap(L0, nu); const int pm = L >> 1, pn = L & 1;
        u.A = nullptr; u.gbase = 0; u.nt = 8; u.ldc = 256; u.scale = 1.f; u.flags = 0; u.i0 = 0; u.i1 = 0;
        if (pm < ntl) { const int e = __builtin_amdgcn_readfirstlane((int)tseg[pm]) & 63;
            u.gidx = STOK + (size_t)pm * 256; u.B = EGU + (size_t)e * 512 * 1024 + (size_t)pn * 256 * 1024; u.out = H + (size_t)pm * 256 * 256 + pn * 128; }
        else { const int ps = pm - ntl; u.gidx = nullptr; u.gbase = ps * 256; u.B = EGU + (size_t)NE * 512 * 1024 + (size_t)pn * 256 * 1024; u.out = HS + (size_t)ps * 256 * 256 + pn * 128; }
        return true; }
};
struct SchedG2 {
    const char* ED; const char* H; const char* HS; char* YB; char* YS; LAS const unsigned char* tseg; int t0, t1, nsh, ch, CH, c;
    __device__ __forceinline__ bool next(int i, pg::Unit& u) const {
        const int nr = t1 - t0; const int ntile = nr + nsh; const int full = ntile / GRID; int q, pn;
        if (i < full * 4) { q = pg::xcd_remap((i >> 2) * GRID + c, full * GRID); pn = i & 3; }
        else { const int L0 = (i - full * 4) * GRID + c; if (L0 >= (ntile - full * GRID) * 4) return false; q = full * GRID + (L0 >> 2); pn = L0 & 3; }
        u.gidx = nullptr; u.gbase = 0; u.nt = 2; u.ldc = 1024; u.scale = 1.f; u.flags = 0; u.i0 = 0; u.i1 = pn;
        if (q < nr) { const int pm = t0 + q; const int e = __builtin_amdgcn_readfirstlane((int)tseg[pm]) & 63;
            u.A = H + (size_t)pm * 256 * 256; u.B = ED + (size_t)e * 1024 * 256 + (size_t)pn * 256 * 256; u.out = YB + (size_t)q * 256 * 1024; }
        else { const int ps = q - nr; u.A = HS + ((size_t)ch * CH + ps * 256) * 256; u.B = ED + (size_t)NE * 1024 * 256 + (size_t)pn * 256 * 256; u.out = YS + (size_t)ps * 256 * 1024; }
        return true; }
};

__device__ __forceinline__ void fnet_nyquist_rows(Frame& F) {
    F.refresh();
    const unsigned char* ABT = F.ws + WS_ABT; bf16_t* FH1 = (bf16_t*)(F.ws + WS_FH1);
    static_assert((128 * 256) % (4 * NGW) == 0, "fnet_nyquist_rows: four rows per wave and step");
    for (int r0 = F.gw; r0 < 128 * 256; r0 += 4 * NGW) {
        u32x4 w[4][2];
#pragma unroll
        for (int t = 0; t < 4; ++t) { const GAS u32x4* p = (const GAS u32x4*)(ABT + (size_t)(r0 + t * NGW) * 4096);
#pragma unroll
            for (int i = 0; i < 2; ++i) w[t][i] = p[i * 64 + F.lane]; }
#pragma unroll
        for (int t = 0; t < 4; ++t) { const int r = r0 + t * NGW; const int bg = r >> 8, m = r & 255, b = bg >> 2, g = bg & 3; float s = 0.f;
#pragma unroll
            for (int i = 0; i < 2; ++i)
#pragma unroll
                for (int q = 0; q < 4; ++q) { const f32x2v lo = __builtin_amdgcn_cvt_pk_f32_fp8((int)w[t][i][q], false), hi = __builtin_amdgcn_cvt_pk_f32_fp8((int)w[t][i][q], true); s += (lo[0] - lo[1]) + (hi[0] - hi[1]); }
            s = wave_sum(s) * 0.001381067932004975f;
            if (F.lane == 0) FH1[(size_t)b * 1024 + g * 256 + m] = (bf16_t)f2bf(s); } }
}
__device__ __forceinline__ void fnet_nyquist_out(Frame& F, const Args& a, int jl) {
    F.refresh();
    const bf16_t* FH1 = (const bf16_t*)(F.ws + WS_FH1); const bf16_t* W = (const bf16_t*)(F.ws + WS_WF) + (size_t)jl * 2048 * 1024; unsigned char* Y = (unsigned char*)a.out;
    LAS float* part = (LAS float*)F.lds;
    const int b = F.blk >> 3, n = (F.blk & 7) * 128 + (F.tid & 127), kq = F.tid >> 7;
    const GAS u32x4* wp = (const GAS u32x4*)(W + (size_t)n * 1024 + kq * 256); const GAS u32x4* fp = (const GAS u32x4*)(FH1 + (size_t)b * 1024 + kq * 256);
    float s = 0.f;
#pragma unroll 4
    for (int i = 0; i < 32; ++i) { const u32x4 w = wp[i], f = fp[i];
        s += bflo(w.x) * bflo(f.x) + bfhi(w.x) * bfhi(f.x) + bflo(w.y) * bflo(f.y) + bfhi(w.y) * bfhi(f.y) + bflo(w.z) * bflo(f.z) + bfhi(w.z) * bfhi(f.z) + bflo(w.w) * bflo(f.w) + bfhi(w.w) * bfhi(f.w); }
    part[F.tid] = s;
    __syncthreads();
    if (F.tid < 128) { const float t = (part[F.tid] + part[F.tid + 128]) + (part[F.tid + 256] + part[F.tid + 384]); const int cc = n & 127;
        Y[((size_t)b * SEQ + 1024) * D + (16 * (n >> 8) + (cc >> 3)) * 16 + 8 * ((n >> 7) & 1) + (cc & 7)] = (unsigned char)f2f8(__builtin_amdgcn_fmed3f(t * YSC, -448.f, 448.f)); }
    __syncthreads();
}


#ifdef SELFCHECK
constexpr int CW_ERR = 1024;
__device__ __forceinline__ void chk_report(unsigned* ctl, int id, float got, float ref, float tabs, float trel) {
    float e = fabsf(got - ref) / (tabs + trel * fabsf(ref)); if (!(e == e)) e = 1e30f; atomicMax(ctl + CW_ERR + id, __float_as_uint(e)); }
__device__ __forceinline__ float bf2f(bf16_t b) { return __builtin_bit_cast(float, (unsigned)b << 16); }
__constant__ int chk_toks[16] = {0, 1, 63, 64, 65, 127, 2047, 2048, 2049, 4096, 33000, 65535, 65536, 65537, 70000, 73727};
__constant__ int chk_ks[8] = {0, 1, 2, 255, 256, 1023, 1024, 700};
__constant__ int chk_ms[4] = {0, 1, 128, 255};
__constant__ int chk_ytoks[10] = {0, 1, 1023, 1024, 1025, 2047, 2048, 65535, 65536, 73727};
__constant__ int chk_ns[5] = {0, 1, 255, 256, 1023};
__constant__ int chk_cols[20] = {0, 7, 15, 16, 31, 32, 40, 48, 63, 64, 500, 1023, 1024, 1039, 1040, 1072, 1279, 1280, 1300, 1535};
__device__ __forceinline__ void chk_qkv(Frame& F, const Args& a, int layer, int id) {
    F.refresh(); const unsigned char* U = (const unsigned char*)a.out + OUT_U8; const float* W = a.in[8] + (size_t)(layer >> 1) * 1024 * 1536;
    const bf16_t* Qb = (const bf16_t*)(F.ws + WS_Q); const bf16_t* Kb = (const bf16_t*)(F.ws + WS_K); const bf16_t* Vb = (const bf16_t*)(F.ws + WS_V);
    for (int s = F.gw; s < 320; s += NGW) { const int tok = chk_toks[s & 15], col = chk_cols[s >> 4];
        if (layer == 2 && tok >= T && col < 1024) continue;
        const bool rope = (tok < T) && col < 1280; const int hc = col & 63, first = (hc & 31) < 16; const int pcol = rope ? (first ? col + 16 : col - 16) : col;
        float x = 0.f, xp = 0.f;
        for (int k = F.lane; k < 1024; k += 64) { const float u = f82f(U[(size_t)tok * D + k]); x += u * W[(size_t)k * 1536 + col]; xp += u * W[(size_t)k * 1536 + pcol]; }
        x = wave_sum(x); xp = wave_sum(xp);
        float ref = x;
        if (rope) { const int tl = tok & 2047, part = hc >> 5, pos = part ? (tl & 63) : (tl >> 6), fi = hc & 15; const float ang = (float)pos * powf(10000.f, -(float)fi / 16.f);
            ref = x * cosf(ang) + (first ? -xp : xp) * sinf(ang); }
        if (col < 1024) ref *= C2;
        const float got = col < 1024 ? bf2f(Qb[(size_t)tok * 1024 + col]) : (col < 1280 ? bf2f(Kb[(size_t)tok * 256 + col - 1024]) : bf2f(Vb[(size_t)tok * 256 + col - 1280]));
        if (F.lane == 0) chk_report(F.ctl, id, got, ref, 0.20f, 0.10f); }
}
__device__ __forceinline__ void chk_attn(Frame& F, const Args& a, int layer, int id) {
    F.refresh(); const bf16_t* Qb = (const bf16_t*)(F.ws + WS_Q); const bf16_t* Kb = (const bf16_t*)(F.ws + WS_K); const bf16_t* Vb = (const bf16_t*)(F.ws + WS_V); const unsigned char* Ob = F.ws + WS_R + 216 * MiB;
    LAS float* lg = (LAS float*)F.lds + F.wave * 1024;
    for (int s = F.gw; s < 64; s += NGW) { const int tok = chk_toks[s & 15], h = (s >> 4) * 5, kvh = h >> 2;
        if (layer == 2 && tok >= T) continue;
        const bool isctx = tok >= T; const int b = isctx ? (tok - T) / CTXL : tok / SEQ, p = tok & (SEQ - 1);
        int nk = 0; const int lo = isctx ? 0 : (p - 128 < 0 ? 0 : p - 128), hi = isctx ? -1 : (p + 128 > SEQ - 1 ? SEQ - 1 : p + 128);
        const int nlat = isctx ? 0 : hi - lo + 1; nk = nlat + CTXL;
        float mx = a.in[10][(layer >> 1) * 16 + h] * LOG2E; const float sink2 = mx;
        for (int i = F.lane; i < nk; i += 64) { const size_t kr = i < nlat ? (size_t)b * SEQ + lo + i : (size_t)T + b * CTXL + (i - nlat); float d = 0.f;
            for (int e = 0; e < 64; ++e) d += bf2f(Qb[(size_t)tok * 1024 + h * 64 + e]) * bf2f(Kb[kr * 256 + kvh * 64 + e]);
            lg[i] = d; mx = fmaxf(mx, d); }
#pragma unroll
        for (int o = 1; o < 64; o <<= 1) mx = fmaxf(mx, __shfl_xor(mx, o));
        LDS_WAIT();
        float den = 0.f; for (int i = F.lane; i < nk; i += 64) den += exp2f(lg[i] - mx);
        den = wave_sum(den) + exp2f(sink2 - mx);
        float o = 0.f;
        for (int i = 0; i < nk; ++i) { const size_t kr = i < nlat ? (size_t)b * SEQ + lo + i : (size_t)T + b * CTXL + (i - nlat); o += exp2f(lg[i] - mx) * bf2f(Vb[kr * 256 + kvh * 64 + F.lane]); }
        o /= den;
        chk_report(F.ctl, id, f82f(Ob[(size_t)tok * 1024 + h * 64 + F.lane]), o, 0.02f, 0.08f); chk_report(F.ctl, 32 + (s & 15), f82f(Ob[(size_t)tok * 1024 + h * 64 + F.lane]), o, 0.02f, 0.08f);
        LDS_WAIT(); }
    __syncthreads();
}
__device__ __forceinline__ void chk_fnet_f(Frame& F, const Args& a, bool upd, int id) {
    F.refresh(); const unsigned char* U = (const unsigned char*)a.out + OUT_U8; LAS float* red = (LAS float*)F.lds;
    for (int s = F.blk; s < 128 + (upd ? 64 : 0); s += GRID) {
        const bool cx = s >= 128; const int q = cx ? s - 128 : s; const int m = chk_ms[q & 3], g = ((q >> 2) & 1) * 3, b = ((q >> 3) & 1) * 31; int k = chk_ks[(q >> 4) & 7]; const int L = cx ? CTXL : SEQ; if (cx) k &= 255;
        const size_t row0 = cx ? (size_t)T + b * CTXL : (size_t)b * SEQ;
        float acc = 0.f;
        for (int l = F.wave; l < L; l += NWAVES) { float ca = 0.f, sa = 0.f;
            for (int n = F.lane; n < 256; n += 64) { const float u = f82f(U[(row0 + l) * D + g * 256 + n]); const float an = 6.283185307179586f * (float)((m * n) & 255) / 256.f; const float sn = __sinf(an), cs = __cosf(an); ca += u * cs; sa += u * sn; }
            ca = wave_sum(ca); sa = wave_sum(sa); const float an = 6.283185307179586f * (float)((k * l) % L) / (float)L; const float sn = __sinf(an), cs = __cosf(an); acc += cs * ca - sn * sa; }
        if (F.lane == 0) red[F.wave] = acc;
        __syncthreads();
        if (F.tid == 0) { float t = 0.f; for (int w = 0; w < NWAVES; ++w) t += red[w]; t *= cx ? (1.f / 256.f) : 0.001381067932004975f;
            float got;
            if (cx) got = f82f((F.ws + WS_FC)[((size_t)b * 256 + k) * D + g * 256 + m]);
            else if (k == 1024) got = bf2f(((const bf16_t*)(F.ws + WS_FH1))[(size_t)b * 1024 + g * 256 + m]);
            else got = f82f((F.ws + WS_FH)[((size_t)b * 1024 + k) * D + g * 256 + m]);
            chk_report(F.ctl, id, got, t, 0.25f, 0.10f); }
        __syncthreads(); }
}
__device__ __forceinline__ void chk_fnet_y(Frame& F, const Args& a, int jl, bool upd, int id) {
    F.refresh(); const bf16_t* Y = (const bf16_t*)a.out; const float* W = a.in[11] + (size_t)jl * 1024 * 1024;
    const unsigned char* FH = F.ws + WS_FH; const bf16_t* FH1 = (const bf16_t*)(F.ws + WS_FH1); const unsigned char* FC = F.ws + WS_FC;
    for (int s = F.gw; s < 50; s += NGW) { const int tok = chk_ytoks[s % 10], n = chk_ns[s / 10]; if (tok >= T && !upd) continue;
        float acc = 0.f;
        for (int j = F.lane; j < 1024; j += 64) { float f;
            if (tok >= T) f = f82f(FC[(size_t)(tok - T) * D + j]);
            else { const int b = tok >> 11, k = tok & 2047; if (k < 1024) f = f82f(FH[((size_t)b * 1024 + k) * D + j]); else if (k == 1024) f = bf2f(FH1[(size_t)b * 1024 + j]);
                else f = f82f(FH[((size_t)b * 1024 + (2048 - k)) * D + (j & ~255) + ((256 - (j & 255)) & 255)]); }
            acc += f * W[(size_t)j * 1024 + n]; }
        acc = wave_sum(acc);
        if (F.lane == 0) chk_report(F.ctl, id, bf2f(Y[(size_t)tok * D + n]), acc, 0.04f, 0.08f); }
}
__device__ __forceinline__ void chk_route(Frame& F, const Args& a, int layer, int ntok, int id) {
    F.refresh(); const bf16_t* U = (const bf16_t*)a.out; const float* Wr = a.in[12] + (size_t)layer * 1024 * 64; const int* tke = (const int*)(F.ws + WS_TKE); const float* tkw = (const float*)(F.ws + WS_TKW);
    for (int s = F.gw; s < 16; s += NGW) { const int tok = chk_toks[s]; if (tok >= ntok) continue; const int lane = F.lane;
        float lgt = 0.f; for (int k = 0; k < 1024; ++k) lgt += bf2f(U[(size_t)tok * D + k]) * Wr[(size_t)k * 64 + lane];
        const float sc = 1.f / (1.f + expf(-lgt)), sel = sc + a.in[13][layer * 64 + lane];
        float g1 = -INFINITY, g2 = -INFINITY;
#pragma unroll 1
        for (int j = 0; j < 8; ++j) { const float v = __shfl(sel, (lane & ~7) + j); if (v > g1) { g2 = g1; g1 = v; } else if (v > g2) g2 = v; }
        const float gs = g1 + g2; int gr = 0;
#pragma unroll 1
        for (int gp = 0; gp < 8; ++gp) { const float v = __shfl(gs, gp * 8); gr += (v > gs || (v == gs && gp < (lane >> 3))) ? 1 : 0; }
        const float sm = gr < 4 ? sel : -INFINITY; int rk = 0;
#pragma unroll 1
        for (int ep = 0; ep < 64; ++ep) { const float v = __shfl(sm, ep); rk += (v > sm || (v == sm && ep < lane)) ? 1 : 0; }
        const float tot = wave_sum(rk < 8 ? sc : 0.f); const float wref = sc / tot * 2.5f;
        int slot = -1; for (int j = 0; j < 8; ++j) if (tke[(size_t)tok * 8 + j] == lane) slot = j;
        float err = 0.f;
        if (slot >= 0) { if (rk >= 10) err = 10.f; else if (rk < 8) err = fabsf(tkw[(size_t)tok * 8 + slot] - wref) / (0.04f * wref); }
        else if (rk < 6) err = 10.f;
        const unsigned long long nsel = __ballot(slot >= 0); if (__builtin_popcountll(nsel) != 8) err = 20.f;
        atomicMax(F.ctl + CW_ERR + id, __float_as_uint(err)); }
}
__device__ __forceinline__ void chk_moe(Frame& F, const Args& a, int layer, int ntok, int ch, int id) {
    F.refresh(); const bf16_t* U = (const bf16_t*)a.out; const int* tke = (const int*)(F.ws + WS_TKE); const float* tkw = (const float*)(F.ws + WS_TKW);
    const int CH = ntok / NCHUNK; LAS float* hs = (LAS float*)F.lds; LAS float* us = hs + 512; LAS float* pg_ = us + 1024;
    for (int s = F.blk; s < 16; s += GRID) { const int tok = chk_toks[s]; if (tok >= ntok || tok / CH != ch) continue;
        for (int k = F.tid; k < 1024; k += NTHR) us[k] = bf2f(U[(size_t)tok * D + k]);
        __syncthreads();
        float y0 = 0.f, y1 = 0.f;
        for (int j = 0; j < 9; ++j) { const int e = j < 8 ? tke[(size_t)tok * 8 + j] : 0; const float w = j < 8 ? tkw[(size_t)tok * 8 + j] : 1.f;
            const float* wg = j < 8 ? a.in[14] + ((size_t)layer * NE + e) * 262144 : a.in[17] + (size_t)layer * 262144;
            const float* wu = j < 8 ? a.in[15] + ((size_t)layer * NE + e) * 262144 : a.in[18] + (size_t)layer * 262144;
            const float* wd = j < 8 ? a.in[16] + ((size_t)layer * NE + e) * 262144 : a.in[19] + (size_t)layer * 262144;
            const int hh = F.tid & 255, half = F.tid >> 8; float g = 0.f, u = 0.f;
            for (int k = half * 512; k < half * 512 + 512; ++k) { g += us[k] * wg[(size_t)k * 256 + hh]; u += us[k] * wu[(size_t)k * 256 + hh]; }
            pg_[F.tid] = g; pg_[512 + F.tid] = u;
            __syncthreads();
            if (F.tid < 256) { const float gg = pg_[F.tid] + pg_[F.tid + 256], uu = pg_[512 + F.tid] + pg_[512 + F.tid + 256]; hs[F.tid] = gg / (1.f + expf(-gg)) * uu; }
            __syncthreads();
            float t0 = 0.f, t1 = 0.f; for (int q = 0; q < 256; ++q) { t0 += hs[q] * wd[(size_t)q * 1024 + F.tid]; t1 += hs[q] * wd[(size_t)q * 1024 + 512 + F.tid]; }
            y0 += w * t0; y1 += w * t1;
            __syncthreads(); }
        float g0 = 0.f, g1 = 0.f; const int i = tok - ch * CH;
        { const unsigned char* YSb = (const unsigned char*)(F.ws + WS_YS); const unsigned char* YBb = (const unsigned char*)(F.ws + WS_YB); const int* spos = (const int*)(F.ws + WS_SDST);
          const int t_ = F.tid, bo = 16 * (16 * (t_ >> 8) + ((t_ & 127) >> 3)) + 8 * ((t_ >> 7) & 1) + (t_ & 7);
          auto f8 = [](unsigned char b) { return __builtin_amdgcn_cvt_pk_f32_fp8((int)b, false)[0] * (1.f / 16.f); };
          g0 = f8(YSb[(size_t)i * D + bo]); g1 = f8(YSb[(size_t)i * D + bo + 512]);
          for (int j = 0; j < 8; ++j) { const size_t ps = (size_t)spos[(size_t)tok * 8 + j]; const float w = tkw[(size_t)tok * 8 + j]; g0 += w * f8(YBb[ps * D + bo]); g1 += w * f8(YBb[ps * D + bo + 512]); } }
        chk_report(F.ctl, id, g0, y0, 0.15f, 0.15f); chk_report(F.ctl, id, g1, y1, 0.15f, 0.15f);
        __syncthreads(); }
}
#endif

#ifndef PH_MASK
#define PH_MASK 0xffffffffu
#endif
#define PH(b) ((PH_MASK >> (b)) & 1u)
__global__ void __launch_bounds__(NTHR, 2) fwd(Args a) {
    extern __shared__ __attribute__((aligned(16))) unsigned char lds_raw[];
    Frame F;
    F.lds = (LAS unsigned char*)lds_raw; F.ws = a.ws; F.ctl = (unsigned*)(a.ws + WS_CTL);
    F.blk = blockIdx.x; F.refresh();
    for (int u = F.tid; u < (LDS_BYTES - RING_BYTES) / 4; u += NTHR) ((LAS unsigned*)(F.lds + RING_BYTES))[u] = 0u;
    __syncthreads();
    const XcdBarrier bar = xcd_barrier_post(F.ctl + CW_BAR, (volatile LAS unsigned*)(F.lds + L_MISC) + 8);
#define GRID_BAR() xcd_barrier(bar)
    LAS unsigned char* ring = F.lds;
    const int c = F.blk;
#define ws (F.ws)
#define NEWPH() F.refresh()

    if (PH(0)) { conv_small(F, a);
    __syncthreads();
    mod_full(F, a); }
    GRID_BAR();
    if (PH(1)) { rows_init(F, a); }
    GRID_BAR();

    for (int layer = 0; layer < 4; ++layer) {
        const int jl = layer >> 1; const bool upd = layer < 2; const int nrows = upd ? TT : T;
        if ((layer & 1) == 0) {
            NEWPH();
            if (PH(2)) { SchedQKV S; S.U = (const char*)a.out + OUT_U8; S.W = (const char*)(ws + WS_WQKV) + (size_t)jl * 1536 * 1024; S.nfull = (layer == 0) ? 288 * 6 : 256 * 6; S.nu = (layer == 0) ? 288 * 6 : 256 * 6 + 64; S.c = c;
              pg::EpiQKV E; E.Q = (bf16_t*)(ws + WS_Q); E.K = (bf16_t*)(ws + WS_K); E.V = (bf16_t*)(ws + WS_V); E.ropec = (const float*)(ws + WS_ROPEC); E.ropes = (const float*)(ws + WS_ROPES);
              pg::gemm_phase<pg::EpiQKV, SchedQKV, false, true>(ring, 1024u, 1024u, nullptr, S, E); }
            GRID_BAR();
#ifdef SELFCHECK
            if (SELFCHECK & 1) chk_qkv(F, a, layer, 1 + (layer >> 1));
#endif
#define OBUF ((bf16_t*)(ws + WS_R + 216 * MiB))
            NEWPH();
            if (PH(3)) { const int NU = 2048 + (layer == 0 ? 256 : 0);
              const bf16_t* Qb = (const bf16_t*)(ws + WS_Q); const bf16_t* Kb = (const bf16_t*)(ws + WS_K); const bf16_t* Vb = (const bf16_t*)(ws + WS_V);
              for (int i = 0; i * GRID + c < NU; ++i) { int id = pg::xcd_remap(i * GRID + c, NU);
                  if (NU > 2048) { const int g9 = id / 9, r9 = id - g9 * 9; id = (r9 < 8) ? g9 * 8 + r9 : 2048 + g9; }
                  if (id < 2048) { const int hp = id & 1, qb = (id >> 1) & 7, kvh = (id >> 4) & 3, b = id >> 6, h0 = kvh * 4 + hp * 2;
                      attn::attn_unit2(Qb, Kb, Vb, OBUF, b, h0, qb * 256, false, a.in[10][jl * 16 + h0] * LOG2E, a.in[10][jl * 16 + h0 + 1] * LOG2E, ring); }
                  else { const int cid = id - 2048, hp = cid & 1, kvh = (cid >> 1) & 3, b = cid >> 3, h0 = kvh * 4 + hp * 2;
                      attn::attn_unit2(Qb, Kb, Vb, OBUF, b, h0, 0, true, a.in[10][jl * 16 + h0] * LOG2E, a.in[10][jl * 16 + h0 + 1] * LOG2E, ring); } } }
            GRID_BAR();
#ifdef SELFCHECK
            if (SELFCHECK & 1) chk_attn(F, a, layer, 3 + (layer >> 1));
#endif
            NEWPH();
            if (PH(4)) { SchedDense S; S.A = (const char*)OBUF; S.W = (const char*)(ws + WS_WO) + (size_t)jl * 1024 * 1024; S.out = (char*)a.out; S.nrt = nrows / 256; S.nct = 4; S.nt = 8; S.c = c; S.ldA = 1024;
              pg::EpiY8 E; pg::gemm_phase<pg::EpiY8, SchedDense, false, true>(ring, 1024u, 1024u, nullptr, S, E); }
            GRID_BAR();
        } else {
            NEWPH();
            if (PH(5)) { SchedF1 S; S.CS = (const char*)(ws + WS_CSN); S.U = (const char*)a.out + OUT_U8; S.ABT = (char*)(ws + WS_ABT); S.ABTC = (char*)(ws + WS_ABTC); S.nu = 2048 + (upd ? 256 : 0); S.c = c;
              pg::EpiStore8 E; pg::gemm_phase<pg::EpiStore8, SchedF1, false, true, 127>(ring, 256u, 1024u, nullptr, S, E); }
            GRID_BAR();
            NEWPH();
            if (PH(6)) { SchedF2 S; S.DL = (const char*)(ws + WS_DL); S.ABT = (const char*)(ws + WS_ABT); S.FH = (char*)(ws + WS_FH); S.c = c;
              pg::EpiStore8 E; pg::gemm_phase<pg::EpiStore8, SchedF2, false, true, 127>(ring, 4096u, 4096u, nullptr, S, E); }
            NEWPH();
            if (PH(7) && upd) { SchedF2c S; S.DLC = (const char*)(ws + WS_DLC); S.ABTC = (const char*)(ws + WS_ABTC); S.FC = (char*)(ws + WS_FC); S.c = c;
              pg::EpiStore8 E; pg::gemm_phase<pg::EpiStore8, SchedF2c, false, true, 127>(ring, 512u, 512u, nullptr, S, E); }
            if (PH(8)) fnet_nyquist_rows(F);
            GRID_BAR();
#ifdef SELFCHECK
            if (SELFCHECK & 2) chk_fnet_f(F, a, upd, 5 + (layer >> 1));
            GRID_BAR();
#endif
            NEWPH();
            if (PH(9)) { SchedF3 S; S.FH = (const char*)(ws + WS_FH); S.FC = (const char*)(ws + WS_FC); S.W = (const char*)(ws + WS_WSH) + (size_t)jl * 2048 * 1024; S.Y = (char*)a.out; S.nu = 1024 + (upd ? 128 : 0); S.c = c;
              pg::EpiY8 E; pg::gemm_phase<pg::EpiY8, SchedF3, false, true>(ring, 1024u, 1024u, nullptr, S, E); }
            if (PH(10)) fnet_nyquist_out(F, a, jl);
            GRID_BAR();
#ifdef SELFCHECK
            if (SELFCHECK & 8) chk_fnet_y(F, a, jl, upd, 7 + (layer >> 1));
            GRID_BAR();
#endif
        }
        const bool conv_first = ((c >> 3) & 1) == 0;
        if (PH(12) && conv_first) conv_experts(F, a, layer);
        __syncthreads();
        if (PH(11)) rows_post1(F, a, layer, nrows);
        VM_WAIT(); __syncthreads();
        if (threadIdx.x == 0) { __builtin_amdgcn_fence(__ATOMIC_ACQUIRE, "agent"); VM_WAIT(); }
        __syncthreads();
        if (PH(13)) route_tokens(F, a, layer, nrows);
        __syncthreads();
        if (PH(12) && !conv_first) conv_experts(F, a, layer);
        GRID_BAR();
#ifdef SELFCHECK
        if ((SELFCHECK & 64) && layer < 2) chk_route(F, a, layer, nrows, 9);
#endif
        if (PH(14)) build_lists(F, nrows);
        GRID_BAR();
        LAS const int* tstart = (LAS const int*)(F.lds + L_TSTART); LAS const unsigned char* tseg = (LAS const unsigned char*)(F.lds + L_TSEG);
        const int ntl = __builtin_amdgcn_readfirstlane(tstart[NCHUNK * 64]);
        NEWPH();
        if (PH(15)) { SchedG1 S; S.EGU = (const char*)(ws + WS_EGU); S.STOK = (const int*)(ws + WS_STOK); S.H = (char*)(ws + WS_H); S.HS = (char*)(ws + WS_HS); S.tseg = tseg; S.ntl = ntl; S.nsh = nrows / 256; S.c = c;
          pg::EpiSilu E; pg::gemm_phase<pg::EpiSilu, SchedG1, true, true>(ring, 1024u, 1024u, (const char*)a.out + OUT_U8, S, E); }
        GRID_BAR();
        const int CH = nrows / NCHUNK;
        for (int ch = 0; ch < NCHUNK; ++ch) {
            NEWPH();
            if (PH(16)) { SchedG2 S; S.ED = (const char*)(ws + WS_ED); S.H = (const char*)(ws + WS_H); S.HS = (const char*)(ws + WS_HS); S.YB = (char*)(ws + WS_YB); S.YS = (char*)(ws + WS_YS); S.tseg = tseg;
              S.t0 = __builtin_amdgcn_readfirstlane(tstart[ch * 64]); S.t1 = __builtin_amdgcn_readfirstlane(tstart[ch * 64 + 64]); S.nsh = CH / 256; S.ch = ch; S.CH = CH; S.c = c;
              pg::EpiFp8 E; pg::gemm_phase<pg::EpiFp8, SchedG2, false, true>(ring, 256u, 256u, nullptr, S, E); }
            GRID_BAR();
#ifdef SELFCHECK
            if ((SELFCHECK & 4) && layer == 0) { chk_moe(F, a, layer, nrows, ch, 10); GRID_BAR(); }
#endif
            if (PH(17)) rows_post2(F, a, layer, ch * CH, CH);
            if (!(layer == 3 && ch == NCHUNK - 1)) GRID_BAR();
        }
    }
#ifdef SELFCHECK
    GRID_BAR();
    { int bad = 0; float be = 0.f; for (int k = 15; k >= 1; --k) { const float e = __uint_as_float(__hip_atomic_load(F.ctl + CW_ERR + k, RLX_AGENT)); if (e > 1.f) { bad = k; be = e; } }
      int wt = 0; float we = 0.f; for (int k = 0; k < 16; ++k) { const float e = __uint_as_float(__hip_atomic_load(F.ctl + CW_ERR + 32 + k, RLX_AGENT)); if (e > we) { we = e; wt = k; } }
      if (bad) { F.refresh(); float cv = 3.f + bad + (be > 8.f ? 0.5f : 0.f);  Row r; for (int j = 0; j < 4; ++j) r.v[j] = (f32x4){cv, cv, cv, cv}; for (int row = F.gw; row < T; row += NGW) row_store_f32(r, a.out + (size_t)row * D, F.lane); } }
#endif
}

#undef ws
#undef NEWPH
extern "C" void kernel_launch(void* const* d_in, const int* in_sizes, int n_in, void* d_out, int out_size, void* d_ws, size_t ws_size, hipStream_t stream) {
    static int ready = 0;
    if (ready == 0) {
        if (n_in != 20 || out_size != T * D || ws_size < WS_END) { fprintf(stderr, "kernel_launch: unexpected problem (n_in %d out %d ws %zu need %zu)\n", n_in, out_size, ws_size, (size_t)WS_END); ready = -1; return; }
        if (hipFuncSetAttribute((const void*)fwd, hipFuncAttributeMaxDynamicSharedMemorySize, LDS_BYTES) != hipSuccess) { fprintf(stderr, "kernel_launch: hipFuncSetAttribute failed\n"); ready = -1; return; }
        int per_cu = 0;
        if (hipOccupancyMaxActiveBlocksPerMultiprocessor(&per_cu, (const void*)fwd, NTHR, LDS_BYTES) != hipSuccess || per_cu < 1) fprintf(stderr, "kernel_launch: occupancy query says %d blocks per CU\n", per_cu);
        (void)hipGetLastError();
        ready = 1;
    }
    if (ready < 0) return;
    (void)hipMemsetAsync((char*)d_ws + WS_CTL, 0, CTL_BYTES, stream);
    Args a{};
    for (int i = 0; i < 20; ++i) a.in[i] = (const float*)d_in[i];
    a.out = (float*)d_out; a.ws = (unsigned char*)d_ws;
    hipLaunchKernelGGL(fwd, dim3(GRID), dim3(NTHR), LDS_BYTES, stream, a);
}
```
